# Optimizing an MI355X kernel written in HIP

```python
import jax, jax.numpy as jnp
from jax import lax
import numpy as np

D_MODEL = 1024
BATCH = 4
SEQ = 4096
DEPTH = 1

CHUNK = 64
N_FOX_HEADS = 8
N_SB_HEADS = 8
HEAD_DIM = D_MODEL // (N_FOX_HEADS + N_SB_HEADS)
FOX_WIDTH = N_FOX_HEADS * HEAD_DIM
SB_WIDTH = N_SB_HEADS * HEAD_DIM
MIX_WIDTH = FOX_WIDTH + SB_WIDTH
PROJ_DIM = 3 * FOX_WIDTH + N_FOX_HEADS + 3 * SB_WIDTH
Q_BLOCK = 128
N_EXPERTS = 32
TOP_K = 4
D_FF = D_MODEL
SWIGLU_LIMIT = 7.0
SWIGLU_ALPHA = 1.702
MOE_BLOCK = 128
RMS_EPS = 1e-5

kernel_name = "hymba_fox_stickbreaking_moe_block"


def _rmsnorm(x, g):
    xf = x.astype(jnp.float32)
    y = xf * lax.rsqrt(jnp.mean(xf * xf, axis=-1, keepdims=True) + RMS_EPS)
    return (y * g.astype(jnp.float32)).astype(x.dtype)


def _to_heads(t, n_heads):
    b, s, _ = t.shape
    return t.reshape(b, s, n_heads, HEAD_DIM).transpose(0, 2, 1, 3).astype(jnp.float32)


def _from_heads(t):
    b, h, s, d = t.shape
    return t.transpose(0, 2, 1, 3).reshape(b, s, h * d)


def _forgetting_attention(q, k, v, c):
    seq = q.shape[2]
    scale = HEAD_DIM ** -0.5
    outs = []
    for i in range(seq // Q_BLOCK):
        q0, q1 = i * Q_BLOCK, (i + 1) * Q_BLOCK
        s = jnp.einsum('bhqd,bhkd->bhqk', q[:, :, q0:q1], k[:, :, :q1]) * scale
        s = s + c[:, :, q0:q1, None] - c[:, :, None, :q1]
        causal = jnp.arange(q0, q1)[:, None] >= jnp.arange(q1)[None, :]
        p = jax.nn.softmax(jnp.where(causal, s, -jnp.inf), axis=-1)
        outs.append(jnp.einsum('bhqk,bhkd->bhqd', p, v[:, :, :q1]))
    return jnp.concatenate(outs, axis=2)


def _stick_breaking_attention(q, k, v):
    seq = q.shape[2]
    scale = HEAD_DIM ** -0.5
    outs = []
    for i in range(seq // Q_BLOCK):
        q0, q1 = i * Q_BLOCK, (i + 1) * Q_BLOCK
        z = jnp.einsum('bhqd,bhkd->bhqk', q[:, :, q0:q1], k[:, :, :q1]) * scale
        strict = jnp.arange(q0, q1)[:, None] > jnp.arange(q1)[None, :]
        log_1mb = jnp.where(strict, jax.nn.log_sigmoid(-z), 0.0)
        suffix = lax.cumsum(log_1mb, axis=3, reverse=True) - log_1mb
        log_a = jnp.where(strict, jax.nn.log_sigmoid(z) + suffix, -jnp.inf)
        outs.append(jnp.einsum('bhqk,bhkd->bhqd', jnp.exp(log_a), v[:, :, :q1]))
    return jnp.concatenate(outs, axis=2)


def _moe(h, w_router, b_router, w1, b1, w2, b2):
    b, s, d = h.shape
    n_tok = b * s
    t = h.reshape(n_tok, d)
    logits = (t @ w_router + b_router).astype(jnp.float32)
    top_v, top_i = lax.top_k(logits, TOP_K)
    top_w = jax.nn.softmax(top_v, axis=-1)
    n_asg = n_tok * TOP_K
    flat_e = top_i.reshape(n_asg).astype(jnp.int32)
    flat_tok = jnp.arange(n_asg, dtype=jnp.int32) // TOP_K
    flat_w = top_w.reshape(n_asg)
    order = jnp.argsort(flat_e)
    se, stok, sw = flat_e[order], flat_tok[order], flat_w[order]
    counts = jnp.zeros((N_EXPERTS,), jnp.int32).at[flat_e].add(1)
    start = jnp.cumsum(counts) - counts
    padded = (counts + MOE_BLOCK - 1) // MOE_BLOCK * MOE_BLOCK
    pend = jnp.cumsum(padded)
    pstart = pend - padded
    dest = pstart[se] + jnp.arange(n_asg, dtype=jnp.int32) - start[se]
    n_blocks = -(-n_asg // MOE_BLOCK) + N_EXPERTS
    n_rows = n_blocks * MOE_BLOCK
    tok_pad = jnp.full((n_rows,), n_tok, jnp.int32).at[dest].set(stok)
    w_pad = jnp.zeros((n_rows,), jnp.float32).at[dest].set(sw)
    block_e = jnp.minimum(
        jnp.searchsorted(pend, jnp.arange(n_blocks, dtype=jnp.int32) * MOE_BLOCK, side='right'),
        N_EXPERTS - 1).astype(jnp.int32)
    t_pad = jnp.concatenate([t, jnp.zeros((1, d), t.dtype)], axis=0)
    xb = t_pad[tok_pad].reshape(n_blocks, MOE_BLOCK, d)

    def expert_rows(args):
        xe, e = args
        hh = xe @ w1[e] + b1[e]
        glu = jnp.minimum(hh[:, :D_FF], SWIGLU_LIMIT)
        lin = jnp.clip(hh[:, D_FF:], -SWIGLU_LIMIT, SWIGLU_LIMIT)
        act = glu * jax.nn.sigmoid(SWIGLU_ALPHA * glu) * (lin + 1.0)
        return act @ w2[e] + b2[e]

    yb = lax.map(expert_rows, (xb, block_e)).reshape(n_rows, d)
    out = jnp.zeros((n_tok + 1, d), jnp.float32).at[tok_pad].add(
        yb.astype(jnp.float32) * w_pad[:, None])
    return out[:n_tok].reshape(b, s, d).astype(h.dtype)


def setup_inputs(seed: int = 0) -> dict:
    key = jax.random.key(seed)
    ks = jax.random.split(key, 16)
    nrm = jax.random.normal
    L = DEPTH
    x = nrm(ks[0], (BATCH, SEQ, D_MODEL), jnp.float32)
    norm1_g = 1.0 + 0.02 * nrm(ks[1], (L, D_MODEL), jnp.float32)
    w_in = nrm(ks[2], (L, D_MODEL, PROJ_DIM), jnp.float32) * D_MODEL ** -0.5
    b_f = jnp.linspace(1.0, 5.0, N_FOX_HEADS, dtype=jnp.float32)[None, :] + 0.1 * nrm(ks[3], (L, N_FOX_HEADS), jnp.float32)
    g_fox = 1.0 + 0.02 * nrm(ks[4], (L, FOX_WIDTH), jnp.float32)
    g_sb = 1.0 + 0.02 * nrm(ks[5], (L, SB_WIDTH), jnp.float32)
    w_out = nrm(ks[6], (L, MIX_WIDTH, D_MODEL), jnp.float32) * MIX_WIDTH ** -0.5
    norm2_g = 1.0 + 0.02 * nrm(ks[7], (L, D_MODEL), jnp.float32)
    w_router = nrm(ks[8], (L, D_MODEL, N_EXPERTS), jnp.float32) * D_MODEL ** -0.5
    b_router = 0.01 * nrm(ks[9], (L, N_EXPERTS), jnp.float32)
    w1 = nrm(ks[10], (L, N_EXPERTS, D_MODEL, 2 * D_FF), jnp.float32) * D_MODEL ** -0.5
    b1 = 0.01 * nrm(ks[11], (L, N_EXPERTS, 2 * D_FF), jnp.float32)
    w2 = nrm(ks[12], (L, N_EXPERTS, D_FF, D_MODEL), jnp.float32) * D_FF ** -0.5
    b2 = 0.01 * nrm(ks[13], (L, N_EXPERTS, D_MODEL), jnp.float32)
    norm_f_g = 1.0 + 0.02 * nrm(ks[14], (D_MODEL,), jnp.float32)
    return {"x": x, "norm1_g": norm1_g, "w_in": w_in, "b_f": b_f, "g_fox": g_fox,
            "g_sb": g_sb, "w_out": w_out, "norm2_g": norm2_g, "w_router": w_router,
            "b_router": b_router, "w1": w1, "b1": b1, "w2": w2, "b2": b2,
            "norm_f_g": norm_f_g}


def reference(x, norm1_g, w_in, b_f, g_fox, g_sb, w_out, norm2_g, w_router,
              b_router, w1, b1, w2, b2, norm_f_g):
    b, s, _ = x.shape
    splits = [FOX_WIDTH, 2 * FOX_WIDTH, 3 * FOX_WIDTH, 3 * FOX_WIDTH + N_FOX_HEADS,
              3 * FOX_WIDTH + N_FOX_HEADS + SB_WIDTH,
              3 * FOX_WIDTH + N_FOX_HEADS + 2 * SB_WIDTH]
    for l in range(DEPTH):
        h = _rmsnorm(x, norm1_g[l])
        proj = h @ w_in[l]
        fq, fk, fv, f_logit, sq, sk, sv = jnp.split(proj, splits, axis=-1)
        log_f = jax.nn.log_sigmoid(f_logit.astype(jnp.float32) + b_f[l].astype(jnp.float32))
        c = jnp.cumsum(log_f, axis=1).transpose(0, 2, 1)
        fox = _forgetting_attention(_to_heads(fq, N_FOX_HEADS), _to_heads(fk, N_FOX_HEADS),
                                    _to_heads(fv, N_FOX_HEADS), c)
        sb = _stick_breaking_attention(_to_heads(sq, N_SB_HEADS), _to_heads(sk, N_SB_HEADS),
                                       _to_heads(sv, N_SB_HEADS))
        mix = jnp.concatenate([_rmsnorm(_from_heads(fox), g_fox[l]),
                               _rmsnorm(_from_heads(sb), g_sb[l])], axis=-1).astype(x.dtype)
        x = x + mix @ w_out[l]
        x = x + _moe(_rmsnorm(x, norm2_g[l]), w_router[l], b_router[l],
                     w1[l], b1[l], w2[l], b2[l])
    return _rmsnorm(x, norm_f_g)
```

```cpp
#include <hip/hip_runtime.h>
#include <cstdio>
#include <cstdint>

typedef unsigned short bf16_t;
typedef short bf16x8 __attribute__((ext_vector_type(8)));
typedef float f32x4 __attribute__((ext_vector_type(4)));

constexpr int NB = 4, SEQ = 4096, DM = 1024, M = NB * SEQ;
constexpr int NH = 8, HD = 64, GW = 512;
constexpr int WIN_N = 3080, NPROJ = 3072;
constexpr int NE = 32, TOPK = 4, DFF = 1024;
constexpr float EPS = 1e-5f;
constexpr float LOG2E = 1.4426950408889634f;
constexpr float C2 = 0.125f * LOG2E;
constexpr int LIST_CAP = M;
constexpr int MAX_TILES = (M * TOPK) / 256 + NE;

constexpr size_t MiB = 1u << 20;
constexpr size_t WS_CTL = 0, CTL_BYTES = 1 * MiB;
constexpr size_t WS_WINT = 2 * MiB;
constexpr size_t WS_WOUTT = 8 * MiB;
constexpr size_t WS_WR = 10 * MiB;
constexpr size_t WS_CUM = 11 * MiB;
constexpr size_t WS_SSQ = 12 * MiB;
constexpr size_t WS_RSTD2 = 14 * MiB;
constexpr size_t WS_RW = 15 * MiB;
constexpr size_t WS_LIST = 16 * MiB;
constexpr size_t WS_FLOG = 18 * MiB;
constexpr size_t WS_XN = 32 * MiB;
constexpr size_t WS_PROJ = 64 * MiB;
constexpr size_t WS_OMIX = 160 * MiB;
constexpr size_t WS_X1B = 192 * MiB;
constexpr size_t WS_W1T = 224 * MiB;
constexpr size_t WS_W2T = 352 * MiB;
constexpr size_t WS_H = 416 * MiB;
constexpr size_t WS_Y = 560 * MiB;
constexpr size_t WS_END = 688 * MiB;
constexpr int CW_CNT = 1024;

__device__ __forceinline__ unsigned short f2bf(float f) { unsigned u = __float_as_uint(f); return (unsigned short)((u + 0x7fffu + ((u >> 16) & 1u)) >> 16); }
__device__ __forceinline__ float bf2f(unsigned short b) { return __uint_as_float(((unsigned)b) << 16); }
__device__ __forceinline__ float wave_sum(float v) {
#pragma unroll
    for (int o = 1; o < 64; o <<= 1) v += __shfl_xor(v, o);
    return v;
}

__device__ __forceinline__ int mapcol(int mode, int n) {
    if (mode == 1) return n < 1536 ? n : n + 8;
    if (mode == 2) { const int pn = n >> 8, j = n & 255; return j < 128 ? 128 * pn + j : 1024 + 128 * pn + (j - 128); }
    return n;
}
__global__ __launch_bounds__(256) void k_transpose_cvt(const float* __restrict__ W, int K, int N, const float* __restrict__ g, const float* __restrict__ gB, int gsplit, bf16_t* __restrict__ WT, int mode, size_t in_stride, size_t out_stride) {
    __shared__ float t[32][33];
    W += (size_t)blockIdx.z * in_stride; WT += (size_t)blockIdx.z * out_stride;
    const int n0 = blockIdx.x * 32, k0 = blockIdx.y * 32, tx = threadIdx.x & 31, ty = threadIdx.x >> 5;
    for (int i = ty; i < 32; i += 8) { const int k = k0 + i; const int col = mapcol(mode, n0 + tx); t[i][tx] = W[(size_t)k * N + col] * (g ? (k < gsplit ? g[k] : gB[k - gsplit]) : 1.f); }
    __syncthreads();
    for (int i = ty; i < 32; i += 8) WT[(size_t)(n0 + i) * K + k0 + tx] = f2bf(t[tx][i]);
}
__global__ void k_prep_wr(const float* __restrict__ wr, const float* __restrict__ g2, float* __restrict__ WR) {
    const int i = blockIdx.x * 256 + threadIdx.x; if (i < DM * NE) WR[i] = wr[i] * g2[i >> 5];
}

__device__ __forceinline__ float log_sigmoid(float v) { return fminf(v, 0.f) - log1pf(expf(-fabsf(v))); }
__global__ __launch_bounds__(256) void k_rms1(const float* __restrict__ x, const float* __restrict__ g1, const float* __restrict__ w_in, const float* __restrict__ b_f,
                                              bf16_t* __restrict__ XN, float* __restrict__ FLOG) {
    const int row = blockIdx.x * 4 + (threadIdx.x >> 6), lane = threadIdx.x & 63;
    const float4* xr = (const float4*)(x + (size_t)row * DM);
    float4 v[4]; float ss = 0.f;
#pragma unroll
    for (int j = 0; j < 4; ++j) { v[j] = xr[lane + 64 * j]; ss += v[j].x * v[j].x + v[j].y * v[j].y + v[j].z * v[j].z + v[j].w * v[j].w; }
    ss = wave_sum(ss);
    const float rstd = rsqrtf(ss * (1.f / DM) + EPS);
    float f0 = 0.f, f1 = 0.f, f2 = 0.f, f3 = 0.f, f4 = 0.f, f5 = 0.f, f6 = 0.f, f7 = 0.f;
#pragma unroll
    for (int j = 0; j < 4; ++j) {
        const int c0 = 4 * (lane + 64 * j);
        uint2 o; o.x = f2bf(v[j].x * rstd) | ((unsigned)f2bf(v[j].y * rstd) << 16); o.y = f2bf(v[j].z * rstd) | ((unsigned)f2bf(v[j].w * rstd) << 16);
        *(uint2*)(XN + (size_t)row * DM + c0) = o;
        const float xs[4] = {v[j].x, v[j].y, v[j].z, v[j].w};
#pragma unroll
        for (int c = 0; c < 4; ++c) {
            const int k = c0 + c; const float xv = xs[c] * g1[k];
            const float4* wp = (const float4*)(w_in + (size_t)k * WIN_N + 1536); const float4 w0 = wp[0], w1 = wp[1];
            f0 += xv * w0.x; f1 += xv * w0.y; f2 += xv * w0.z; f3 += xv * w0.w; f4 += xv * w1.x; f5 += xv * w1.y; f6 += xv * w1.z; f7 += xv * w1.w;
        }
    }
    f0 = wave_sum(f0); f1 = wave_sum(f1); f2 = wave_sum(f2); f3 = wave_sum(f3); f4 = wave_sum(f4); f5 = wave_sum(f5); f6 = wave_sum(f6); f7 = wave_sum(f7);
    if (lane < 8) {
        float f = f0; f = lane == 1 ? f1 : f; f = lane == 2 ? f2 : f; f = lane == 3 ? f3 : f; f = lane == 4 ? f4 : f; f = lane == 5 ? f5 : f; f = lane == 6 ? f6 : f; f = lane == 7 ? f7 : f;
        FLOG[(size_t)row * 8 + lane] = log_sigmoid(f * rstd + b_f[lane]);
    }
}
__global__ __launch_bounds__(256) void k_cumsum(const float* __restrict__ FLOG, float* __restrict__ CUM) {
    __shared__ float part[256];
    const int b = blockIdx.x >> 3, h = blockIdx.x & 7, t = threadIdx.x;
    float loc[16]; float s = 0.f;
#pragma unroll
    for (int i = 0; i < 16; ++i) { loc[i] = FLOG[((size_t)b * SEQ + t * 16 + i) * 8 + h]; s += loc[i]; }
    part[t] = s; __syncthreads();
    float run = 0.f; for (int i = 0; i < t; ++i) run += part[i];
#pragma unroll
    for (int i = 0; i < 16; ++i) { run += loc[i]; CUM[(size_t)blockIdx.x * SEQ + t * 16 + i] = run * LOG2E; }
}

template <int NT> __device__ __forceinline__ void wave_mma(f32x4 (&acc)[NT], const bf16_t* ap, const bf16_t* const (&bp)[NT], int K) {
    for (int k0 = 0; k0 < K; k0 += 32) {
        const bf16x8 a = *(const bf16x8*)(ap + k0);
#pragma unroll
        for (int t = 0; t < NT; ++t) { const bf16x8 b = *(const bf16x8*)(bp[t] + k0); acc[t] = __builtin_amdgcn_mfma_f32_16x16x32_bf16(a, b, acc[t], 0, 0, 0); }
    }
}
__global__ __launch_bounds__(64) void k_gemm_inproj(const bf16_t* __restrict__ XN, const bf16_t* __restrict__ WINT, bf16_t* __restrict__ PROJ) {
    const int n0 = blockIdx.x * 64, m0 = blockIdx.y * 16, lane = threadIdx.x, r = lane & 15, q = lane >> 4;
    f32x4 acc[4];
#pragma unroll
    for (int t = 0; t < 4; ++t) acc[t] = (f32x4){0.f, 0.f, 0.f, 0.f};
    const bf16_t* ap = XN + (size_t)(m0 + r) * DM + 8 * q;
    const bf16_t* bp[4];
#pragma unroll
    for (int t = 0; t < 4; ++t) bp[t] = WINT + (size_t)(n0 + 16 * t + r) * DM + 8 * q;
    wave_mma<4>(acc, ap, bp, DM);
    const float sc = (n0 < 512 || (n0 >= 1536 && n0 < 2048)) ? C2 : 1.f;
#pragma unroll
    for (int t = 0; t < 4; ++t)
#pragma unroll
        for (int j = 0; j < 4; ++j) PROJ[(size_t)(m0 + 4 * q + j) * NPROJ + n0 + 16 * t + r] = f2bf(acc[t][j] * sc);
}

template <int TYPE> __global__ __launch_bounds__(64) void k_attn_naive(const bf16_t* __restrict__ PROJ, const float* __restrict__ CUM, bf16_t* __restrict__ OMIX, float* __restrict__ SSQ) {
    __shared__ float Ks[64][64]; __shared__ float Vs[64][64]; __shared__ float Cs[64];
    const int qblk = blockIdx.x, bh = blockIdx.y, b = bh >> 3, h = bh & 7, lane = threadIdx.x, t = qblk * 64 + lane;
    const size_t row = (size_t)b * SEQ + t;
    const int qcol = (TYPE == 0 ? 0 : 1536) + h * HD, kcol = qcol + 512, vcol = qcol + 1024;
    float q[64], o[64];
#pragma unroll
    for (int c = 0; c < 8; ++c) { const bf16x8 v = *(const bf16x8*)(PROJ + row * NPROJ + qcol + 8 * c);
#pragma unroll
        for (int j = 0; j < 8; ++j) q[8 * c + j] = bf2f((unsigned short)v[j]); }
#pragma unroll
    for (int d = 0; d < 64; ++d) o[d] = 0.f;
    float m = -INFINITY, l = 0.f, R = 1.f;
    const float cq = CUM[(size_t)bh * SEQ + t];
    for (int it = 0; it <= qblk; ++it) {
        const int kt = (TYPE == 0) ? it : qblk - it;
        __syncthreads();
        for (int i = 0; i < 64; ++i) { const size_t kr = ((size_t)b * SEQ + kt * 64 + i) * NPROJ; Ks[i][lane] = bf2f(PROJ[kr + kcol + lane]); Vs[i][lane] = bf2f(PROJ[kr + vcol + lane]); }
        Cs[lane] = CUM[(size_t)bh * SEQ + kt * 64 + lane];
        __syncthreads();
        for (int ss = 0; ss < 64; ++ss) {
            const int s = (TYPE == 0) ? ss : 63 - ss; const int ks = kt * 64 + s;
            float dot = 0.f;
#pragma unroll
            for (int d = 0; d < 64; d += 4) { const float4 kv = *(const float4*)&Ks[s][d]; dot += q[d] * kv.x + q[d + 1] * kv.y + q[d + 2] * kv.z + q[d + 3] * kv.w; }
            if (TYPE == 0) {
                if (ks <= t) {
                    const float xv = dot + cq - Cs[s]; const float mn = fmaxf(m, xv); const float sc = exp2f(m - mn), p = exp2f(xv - mn);
                    l = l * sc + p; m = mn;
#pragma unroll
                    for (int d = 0; d < 64; d += 4) { const float4 vv = *(const float4*)&Vs[s][d]; o[d] = o[d] * sc + p * vv.x; o[d + 1] = o[d + 1] * sc + p * vv.y; o[d + 2] = o[d + 2] * sc + p * vv.z; o[d + 3] = o[d + 3] * sc + p * vv.w; }
                }
            } else {
                if (ks < t) {
                    const float z = fminf(fmaxf(dot, -80.f), 80.f); const float e = exp2f(z); const float rr = 1.f / (1.f + e); const float a = e * rr * R; R *= rr;
#pragma unroll
                    for (int d = 0; d < 64; d += 4) { const float4 vv = *(const float4*)&Vs[s][d]; o[d] += a * vv.x; o[d + 1] += a * vv.y; o[d + 2] += a * vv.z; o[d + 3] += a * vv.w; }
                }
            }
        }
    }
    const float inv = (TYPE == 0) ? 1.f / l : 1.f;
    float ssq = 0.f;
#pragma unroll
    for (int d = 0; d < 64; ++d) { o[d] *= inv; ssq += o[d] * o[d]; }
    SSQ[row * 16 + TYPE * 8 + h] = ssq;
#pragma unroll
    for (int c = 0; c < 8; ++c) { bf16x8 v;
#pragma unroll
        for (int j = 0; j < 8; ++j) v[j] = (short)f2bf(o[8 * c + j]);
        *(bf16x8*)(OMIX + row * DM + TYPE * GW + h * HD + 8 * c) = v; }
}

__global__ __launch_bounds__(64) void k_gemm_wout(const bf16_t* __restrict__ OMIX, const bf16_t* __restrict__ WOUTT, const float* __restrict__ SSQ, const float* __restrict__ x,
                                                  float* __restrict__ X1, bf16_t* __restrict__ X1B) {
    const int n0 = blockIdx.x * 64, m0 = blockIdx.y * 16, lane = threadIdx.x, r = lane & 15, q = lane >> 4;
    f32x4 af[4], as[4];
#pragma unroll
    for (int t = 0; t < 4; ++t) { af[t] = (f32x4){0.f, 0.f, 0.f, 0.f}; as[t] = (f32x4){0.f, 0.f, 0.f, 0.f}; }
    const bf16_t* ap = OMIX + (size_t)(m0 + r) * DM + 8 * q;
    const bf16_t* bp[4]; const bf16_t* bp2[4];
#pragma unroll
    for (int t = 0; t < 4; ++t) { bp[t] = WOUTT + (size_t)(n0 + 16 * t + r) * DM + 8 * q; bp2[t] = bp[t] + GW; }
    wave_mma<4>(af, ap, bp, GW);
    wave_mma<4>(as, ap + GW, bp2, GW);
#pragma unroll
    for (int j = 0; j < 4; ++j) {
        const size_t row = m0 + 4 * q + j; const float* sp = SSQ + row * 16;
        float sf = 0.f, s2 = 0.f;
#pragma unroll
        for (int h = 0; h < 8; ++h) { sf += sp[h]; s2 += sp[8 + h]; }
        const float rf = rsqrtf(sf * (1.f / GW) + EPS), rs = rsqrtf(s2 * (1.f / GW) + EPS);
#pragma unroll
        for (int t = 0; t < 4; ++t) { const size_t idx = row * DM + n0 + 16 * t + r; const float v = x[idx] + rf * af[t][j] + rs * as[t][j]; X1[idx] = v; X1B[idx] = f2bf(v); }
    }
}

__global__ __launch_bounds__(64) void k_router(const float* __restrict__ X1, const float* __restrict__ WR, const float* __restrict__ b_router, float* __restrict__ RSTD2,
                                               float* __restrict__ RW, int* __restrict__ LIST, unsigned* __restrict__ CNT) {
    const int lane = threadIdx.x, e = lane & 31, tok = blockIdx.x * 2 + (lane >> 5);
    const float* xr = X1 + (size_t)tok * DM;
    float acc = 0.f, ss = 0.f;
    for (int k = 0; k < DM; ++k) { const float xv = xr[k]; acc += xv * WR[k * NE + e]; ss += xv * xv; }
    const float rstd = rsqrtf(ss * (1.f / DM) + EPS);
    float logit = acc * rstd + b_router[e];
    if (e == 0) RSTD2[tok] = rstd;
    float tv[4]; int ti[4];
#pragma unroll
    for (int k = 0; k < 4; ++k) {
        float bv = logit; int bi = e;
#pragma unroll
        for (int o = 1; o < 32; o <<= 1) { const float ov = __shfl_xor(bv, o); const int oi = __shfl_xor(bi, o); if (ov > bv || (ov == bv && oi < bi)) { bv = ov; bi = oi; } }
        tv[k] = bv; ti[k] = bi; if (e == bi) logit = -INFINITY;
    }
    const float e0 = 1.f, e1 = expf(tv[1] - tv[0]), e2 = expf(tv[2] - tv[0]), e3 = expf(tv[3] - tv[0]); const float inv = 1.f / (e0 + e1 + e2 + e3);
    const float w0 = e0 * inv, w1 = e1 * inv, w2 = e2 * inv, w3 = e3 * inv;
    int myk = -1; float myw = 0.f;
    if (e == ti[0]) { myk = 0; myw = w0; } if (e == ti[1]) { myk = 1; myw = w1; } if (e == ti[2]) { myk = 2; myw = w2; } if (e == ti[3]) { myk = 3; myw = w3; }
    if (myk >= 0) { const int slot = tok * 4 + myk; const unsigned pos = atomicAdd(&CNT[e], 1u); LIST[(size_t)e * LIST_CAP + pos] = slot; RW[slot] = myw; }
}

__device__ __forceinline__ bool moe_tile(const unsigned* CNT, int g, int& e, int& base, int& p0, int& cnt) {
    const int tile256 = g >> 4; base = 0;
    for (e = 0; e < NE; ++e) { const int nt = ((int)CNT[e] + 255) >> 8; if (tile256 < base + nt) break; base += nt; }
    if (e == NE) return false;
    cnt = (int)CNT[e]; p0 = (g - base * 16) * 16; return p0 < cnt;
}
__global__ __launch_bounds__(64) void k_moe1(const bf16_t* __restrict__ X1B, const bf16_t* __restrict__ W1T, const float* __restrict__ b1, const float* __restrict__ RSTD2,
                                             const unsigned* __restrict__ CNT, const int* __restrict__ LIST, bf16_t* __restrict__ H) {
    int e, base, p0, cnt; if (!moe_tile(CNT, blockIdx.y, e, base, p0, cnt)) return;
    const int lane = threadIdx.x, r = lane & 15, q = lane >> 4, c0 = blockIdx.x * 32, pn = c0 >> 7, j0 = c0 & 127;
    const int* lst = LIST + (size_t)e * LIST_CAP;
    const int prow = p0 + r; const int tok = lst[prow < cnt ? prow : cnt - 1] >> 2;
    f32x4 acc[4];
#pragma unroll
    for (int t = 0; t < 4; ++t) acc[t] = (f32x4){0.f, 0.f, 0.f, 0.f};
    const bf16_t* ap = X1B + (size_t)tok * DM + 8 * q;
    const bf16_t* wb = W1T + (size_t)e * 2048 * DM + (size_t)(256 * pn + j0 + r) * DM + 8 * q;
    const bf16_t* bp[4] = {wb, wb + 16 * DM, wb + 128 * DM, wb + 144 * DM};
    wave_mma<4>(acc, ap, bp, DM);
#pragma unroll
    for (int j = 0; j < 4; ++j) {
        const int pr = p0 + 4 * q + j; if (pr >= cnt) continue;
        const float rs = RSTD2[lst[pr] >> 2];
#pragma unroll
        for (int t = 0; t < 2; ++t) {
            const int col = c0 + 16 * t + r;
            float glu = acc[t][j] * rs + b1[(size_t)e * 2048 + col], lin = acc[t + 2][j] * rs + b1[(size_t)e * 2048 + 1024 + col];
            glu = fminf(glu, 7.f); lin = fminf(fmaxf(lin, -7.f), 7.f);
            const float act = glu * (1.f / (1.f + expf(-1.702f * glu))) * (lin + 1.f);
            H[((size_t)base * 256 + pr) * DM + col] = f2bf(act);
        }
    }
}
__global__ __launch_bounds__(64) void k_moe2(const bf16_t* __restrict__ H, const bf16_t* __restrict__ W2T, const float* __restrict__ b2, const float* __restrict__ RW,
                                             const unsigned* __restrict__ CNT, const int* __restrict__ LIST, bf16_t* __restrict__ Y) {
    int e, base, p0, cnt; if (!moe_tile(CNT, blockIdx.y, e, base, p0, cnt)) return;
    const int lane = threadIdx.x, r = lane & 15, q = lane >> 4, n0 = blockIdx.x * 64;
    const int* lst = LIST + (size_t)e * LIST_CAP;
    f32x4 acc[4];
#pragma unroll
    for (int t = 0; t < 4; ++t) acc[t] = (f32x4){0.f, 0.f, 0.f, 0.f};
    const bf16_t* ap = H + ((size_t)base * 256 + p0 + r) * DM + 8 * q;
    const bf16_t* bp[4];
#pragma unroll
    for (int t = 0; t < 4; ++t) bp[t] = W2T + (size_t)e * DM * DM + (size_t)(n0 + 16 * t + r) * DM + 8 * q;
    wave_mma<4>(acc, ap, bp, DM);
#pragma unroll
    for (int j = 0; j < 4; ++j) {
        const int pr = p0 + 4 * q + j; if (pr >= cnt) continue;
        const int slot = lst[pr]; const float w = RW[slot];
#pragma unroll
        for (int t = 0; t < 4; ++t) { const int col = n0 + 16 * t + r; Y[(size_t)slot * DM + col] = f2bf((acc[t][j] + b2[(size_t)e * DM + col]) * w); }
    }
}

__global__ __launch_bounds__(256) void k_final(const float* X1, const bf16_t* __restrict__ Y, const float* __restrict__ gf, float* out) {
    const int row = blockIdx.x * 4 + (threadIdx.x >> 6), lane = threadIdx.x & 63;
    float4 v[4]; float ss = 0.f;
#pragma unroll
    for (int j = 0; j < 4; ++j) {
        const int c0 = 4 * (lane + 64 * j);
        v[j] = *(const float4*)(X1 + (size_t)row * DM + c0);
#pragma unroll
        for (int k = 0; k < 4; ++k) { const uint2 y = *(const uint2*)(Y + ((size_t)row * 4 + k) * DM + c0);
            v[j].x += bf2f((unsigned short)(y.x & 0xffff)); v[j].y += bf2f((unsigned short)(y.x >> 16)); v[j].z += bf2f((unsigned short)(y.y & 0xffff)); v[j].w += bf2f((unsigned short)(y.y >> 16)); }
        ss += v[j].x * v[j].x + v[j].y * v[j].y + v[j].z * v[j].z + v[j].w * v[j].w;
    }
    ss = wave_sum(ss);
    const float rstd = rsqrtf(ss * (1.f / DM) + EPS);
#pragma unroll
    for (int j = 0; j < 4; ++j) { const int c0 = 4 * (lane + 64 * j); const float4 g = *(const float4*)(gf + c0);
        float4 o; o.x = v[j].x * rstd * g.x; o.y = v[j].y * rstd * g.y; o.z = v[j].z * rstd * g.z; o.w = v[j].w * rstd * g.w; *(float4*)(out + (size_t)row * DM + c0) = o; }
}

extern "C" void kernel_launch(void* const* d_in, const int* in_sizes, int n_in, void* d_out, int out_size, void* d_ws, size_t ws_size, hipStream_t stream) {
    if (n_in != 15 || in_sizes[0] != M * DM || out_size != M * DM || ws_size < WS_END) {
        fprintf(stderr, "kernel_launch: unexpected shapes / workspace (n_in %d, in0 %d, out %d, ws %zu, need %zu)\n", n_in, n_in > 0 ? in_sizes[0] : -1, out_size, ws_size, (size_t)WS_END); return; }
    const float* x = (const float*)d_in[0]; const float* g1 = (const float*)d_in[1]; const float* w_in = (const float*)d_in[2]; const float* b_f = (const float*)d_in[3];
    const float* g_fox = (const float*)d_in[4]; const float* w_out = (const float*)d_in[6]; const float* g2 = (const float*)d_in[7];
    const float* w_router = (const float*)d_in[8]; const float* b_router = (const float*)d_in[9]; const float* w1 = (const float*)d_in[10]; const float* b1 = (const float*)d_in[11];
    const float* w2 = (const float*)d_in[12]; const float* b2 = (const float*)d_in[13]; const float* gf = (const float*)d_in[14];
    const float* g_sb = (const float*)d_in[5];
    char* ws = (char*)d_ws; float* out = (float*)d_out;
    unsigned* CTL = (unsigned*)(ws + WS_CTL);
    bf16_t* WINT = (bf16_t*)(ws + WS_WINT); bf16_t* WOUTT = (bf16_t*)(ws + WS_WOUTT); float* WR = (float*)(ws + WS_WR); float* CUM = (float*)(ws + WS_CUM);
    float* SSQ = (float*)(ws + WS_SSQ); float* RSTD2 = (float*)(ws + WS_RSTD2); float* RW = (float*)(ws + WS_RW); int* LIST = (int*)(ws + WS_LIST); float* FLOG = (float*)(ws + WS_FLOG);
    bf16_t* XN = (bf16_t*)(ws + WS_XN); bf16_t* PROJ = (bf16_t*)(ws + WS_PROJ); bf16_t* OMIX = (bf16_t*)(ws + WS_OMIX); bf16_t* X1B = (bf16_t*)(ws + WS_X1B);
    bf16_t* W1T = (bf16_t*)(ws + WS_W1T); bf16_t* W2T = (bf16_t*)(ws + WS_W2T); bf16_t* H = (bf16_t*)(ws + WS_H); bf16_t* Y = (bf16_t*)(ws + WS_Y);
    hipMemsetAsync(ws + WS_CTL, 0, CTL_BYTES, stream);
    k_transpose_cvt<<<dim3(NPROJ / 32, DM / 32, 1), 256, 0, stream>>>(w_in, DM, WIN_N, g1, nullptr, DM, WINT, 1, 0, 0);
    k_transpose_cvt<<<dim3(DM / 32, DM / 32, 1), 256, 0, stream>>>(w_out, DM, DM, g_fox, g_sb, GW, WOUTT, 0, 0, 0);
    k_transpose_cvt<<<dim3(2048 / 32, DM / 32, NE), 256, 0, stream>>>(w1, DM, 2048, g2, nullptr, DM, W1T, 2, (size_t)DM * 2048, (size_t)2048 * DM);
    k_transpose_cvt<<<dim3(DM / 32, DM / 32, NE), 256, 0, stream>>>(w2, DM, DM, nullptr, nullptr, DM, W2T, 0, (size_t)DM * DM, (size_t)DM * DM);
    k_prep_wr<<<(DM * NE) / 256, 256, 0, stream>>>(w_router, g2, WR);
    (void)TOPK;
    k_rms1<<<M / 4, 256, 0, stream>>>(x, g1, w_in, b_f, XN, FLOG);
    k_cumsum<<<NB * NH, 256, 0, stream>>>(FLOG, CUM);
    k_gemm_inproj<<<dim3(NPROJ / 64, M / 16), 64, 0, stream>>>(XN, WINT, PROJ);
    k_attn_naive<0><<<dim3(SEQ / 64, NB * NH), 64, 0, stream>>>(PROJ, CUM, OMIX, SSQ);
    k_attn_naive<1><<<dim3(SEQ / 64, NB * NH), 64, 0, stream>>>(PROJ, CUM, OMIX, SSQ);
    k_gemm_wout<<<dim3(DM / 64, M / 16), 64, 0, stream>>>(OMIX, WOUTT, SSQ, x, out, X1B);
    k_router<<<M / 2, 64, 0, stream>>>(out, WR, b_router, RSTD2, RW, LIST, CTL + CW_CNT);
    k_moe1<<<dim3(DFF / 32, MAX_TILES * 16), 64, 0, stream>>>(X1B, W1T, b1, RSTD2, CTL + CW_CNT, LIST, H);
    k_moe2<<<dim3(DM / 64, MAX_TILES * 16), 64, 0, stream>>>(H, W2T, b2, RW, CTL + CW_CNT, LIST, Y);
    k_final<<<M / 4, 256, 0, stream>>>(out, Y, gf, out);
}
```

```cpp
#include <hip/hip_runtime.h>
#include <cstdio>
#include <cstdint>

typedef unsigned short bf16_t;
typedef short bf16x8 __attribute__((ext_vector_type(8)));
typedef float f32x4 __attribute__((ext_vector_type(4)));

constexpr int NB = 4, SEQ = 4096, DM = 1024, M = NB * SEQ;
constexpr int NH = 8, HD = 64, GW = 512;
constexpr int WIN_N = 3080, NPROJ = 3072;
constexpr int NE = 32, TOPK = 4, DFF = 1024;
constexpr float EPS = 1e-5f;
constexpr float LOG2E = 1.4426950408889634f;
constexpr float C2 = 0.125f * LOG2E;
constexpr int LIST_CAP = M;
constexpr int MAX_TILES = (M * TOPK) / 256 + NE;

constexpr size_t MiB = 1u << 20;
constexpr size_t WS_CTL = 0, CTL_BYTES = 1 * MiB;
constexpr size_t WS_WINT = 2 * MiB;
constexpr size_t WS_WOUTT = 8 * MiB;
constexpr size_t WS_WR = 10 * MiB;
constexpr size_t WS_CUM = 11 * MiB;
constexpr size_t WS_SSQ = 12 * MiB;
constexpr size_t WS_RSTD2 = 14 * MiB;
constexpr size_t WS_RW = 15 * MiB;
constexpr size_t WS_LIST = 16 * MiB;
constexpr size_t WS_FLOG = 18 * MiB;
constexpr size_t WS_XN = 32 * MiB;
constexpr size_t WS_PROJ = 64 * MiB;
constexpr size_t WS_OMIX = 160 * MiB;
constexpr size_t WS_X1B = 192 * MiB;
constexpr size_t WS_W1T = 224 * MiB;
constexpr size_t WS_W2T = 352 * MiB;
constexpr size_t WS_H = 416 * MiB;
constexpr size_t WS_Y = 560 * MiB;
constexpr size_t WS_END = 688 * MiB;
constexpr int CW_CNT = 1024;

__device__ __forceinline__ unsigned short f2bf(float f) { unsigned u = __float_as_uint(f); return (unsigned short)((u + 0x7fffu + ((u >> 16) & 1u)) >> 16); }
__device__ __forceinline__ float bf2f(unsigned short b) { return __uint_as_float(((unsigned)b) << 16); }
__device__ __forceinline__ float wave_sum(float v) {
#pragma unroll
    for (int o = 1; o < 64; o <<= 1) v += __shfl_xor(v, o);
    return v;
}


#define LAS __attribute__((address_space(3)))
#define GAS __attribute__((address_space(1)))
typedef unsigned v4u __attribute__((ext_vector_type(4)));
#define LDS_WAIT() asm volatile("s_waitcnt lgkmcnt(0)" ::: "memory")
#define VM_WAIT() asm volatile("s_waitcnt vmcnt(0)" ::: "memory")
constexpr int NWAVES = 8, NTHREADS = NWAVES * 64;

#define XB_TMO      128
#define XB_XCNT(j)  (256  + 64 * (j))
#define XB_XSUB(j)  (1280 + 64 * (j))
#define XB_XGEN(j)  (2304 + 64 * (j))
#define XB_TOP      3328
#define XB_TOPGEN   3392
#define XCD_BAR_WORDS 3456
#define XB_SPIN_CAP (1u << 20)
__device__ __forceinline__ unsigned xb_ld(unsigned* p)              { return __hip_atomic_load(p, __ATOMIC_RELAXED, __HIP_MEMORY_SCOPE_AGENT); }
__device__ __forceinline__ unsigned xb_add(unsigned* p, unsigned v) { return __hip_atomic_fetch_add(p, v, __ATOMIC_RELAXED, __HIP_MEMORY_SCOPE_AGENT); }
__device__ __forceinline__ unsigned xb_xcc_id() { return (unsigned)__builtin_amdgcn_s_getreg((3 << 11) | 20) & 0xFu; }
#define XB_SPIN(cond, bar) do { unsigned _sp = 0; while (cond) { __builtin_amdgcn_s_sleep(1); \
    if ((++_sp & 255u) == 0u) { if (xb_ld(&(bar)[XB_TMO])) break; if (_sp > XB_SPIN_CAP) { atomicAdd(&(bar)[XB_TMO], 1u); break; } } } } while (0)
struct XcdBarrier { unsigned* bar; unsigned x; volatile LAS unsigned* st; };
__device__ __forceinline__ XcdBarrier xcd_barrier_post(unsigned* bar, volatile LAS unsigned* st) {
    XcdBarrier b; b.bar = bar; b.x = xb_xcc_id(); b.st = st;
    if (threadIdx.x == 0) (void)xb_add(&bar[XB_XCNT(b.x)], 1u);
    return b;
}
__device__ __forceinline__ void xcd_barrier_complete(unsigned* bar, unsigned x, unsigned& nloc, unsigned& nx) {
    const unsigned G = gridDim.x * gridDim.y * gridDim.z;
    unsigned sum, cnt, mine, sp = 0u;
    for (;;) {
        sum = 0u; cnt = 0u; mine = 0u;
#pragma unroll
        for (unsigned j = 0; j < 16; ++j) { const unsigned c = xb_ld(&bar[XB_XCNT(j)]); sum += c; cnt += (c > 0u) ? 1u : 0u; mine = (j == x) ? c : mine; }
        if (sum == G) break;
        __builtin_amdgcn_s_sleep(1);
        if ((++sp & 255u) == 0u) { if (xb_ld(&bar[XB_TMO])) break; if (sp > XB_SPIN_CAP) { atomicAdd(&bar[XB_TMO], 1u); break; } }
    }
    nloc = mine > 0u ? mine : 1u; nx = cnt > 0u ? cnt : 1u;
}
__device__ __forceinline__ void xcd_barrier(const XcdBarrier& b) {
    asm volatile("s_waitcnt vmcnt(0)" ::: "memory");
    __syncthreads();
    if (threadIdx.x == 0) {
        unsigned* bar = b.bar;
        __builtin_amdgcn_s_waitcnt(0);
        unsigned nloc = b.st[0], nx = b.st[1];
        if (nloc == 0u) { xcd_barrier_complete(bar, b.x, nloc, nx); b.st[0] = nloc; b.st[1] = nx; }
        const unsigned old = xb_add(&bar[XB_XSUB(b.x)], 1u);
        const unsigned gen = old / nloc;
        if (old + 1u == (gen + 1u) * nloc) {
            __builtin_amdgcn_fence(__ATOMIC_RELEASE, "agent");
            asm volatile("s_waitcnt vmcnt(0)" ::: "memory");
            const unsigned og = xb_add(&bar[XB_TOP], 1u);
            const unsigned tg = og / nx;
            if (og + 1u == (tg + 1u) * nx) xb_add(&bar[XB_TOPGEN], 1u);
            else XB_SPIN(xb_ld(&bar[XB_TOPGEN]) == tg, bar);
            __builtin_amdgcn_fence(__ATOMIC_ACQUIRE, "agent");
            xb_add(&bar[XB_XGEN(b.x)], 1u);
            asm volatile("s_waitcnt vmcnt(0)" ::: "memory");
        } else {
            XB_SPIN(xb_ld(&bar[XB_XGEN(b.x)]) == gen, bar);
            __builtin_amdgcn_fence(__ATOMIC_ACQUIRE, "agent");
            asm volatile("s_waitcnt vmcnt(0)" ::: "memory");
        }
    }
    __syncthreads();
}

constexpr int RING_OFF = 0, RING_BYTES = 131072;
constexpr int LDSCTL_OFF = 139264, MISC_OFF = LDSCTL_OFF + 320;
constexpr int LDS_BYTES = 147456;
constexpr int CW_BAR = 4096;

struct Args {
    const float *x, *g1, *w_in, *b_f, *g_fox, *g_sb, *w_out, *g2, *w_router, *b_router, *w1, *b1, *w2, *b2, *gf;
    float* out; unsigned char* ws;
};

__device__ __forceinline__ int mapcol(int mode, int n) {
    if (mode == 1) return n < 1536 ? n : n + 8;
    if (mode == 2) { const int pn = n >> 8, j = n & 255; return j < 128 ? 128 * pn + j : 1024 + 128 * pn + (j - 128); }
    return n;
}
__device__ __forceinline__ unsigned pk2(float lo, float hi) { return (unsigned)f2bf(lo) | ((unsigned)f2bf(hi) << 16); }
__device__ __forceinline__ void transpose_item(const float* __restrict__ W, int K, int Nin, int Nout, int mode, const float* __restrict__ gA, const float* __restrict__ gB, int gsplit,
                                               bf16_t* __restrict__ WT, LAS float* scr, int item, int lane) {
    const int nblk = Nout / 32, kb = item / nblk, nb = item % nblk, k0 = 64 * kb, n0 = 32 * nb;
    const int col = mapcol(mode, n0 + (lane & 31));
#pragma unroll 8
    for (int i = 0; i < 32; ++i) { const int kk = 2 * i + (lane >> 5), k = k0 + kk; const float gs = gA ? (k < gsplit ? gA[k] : gB[k - gsplit]) : 1.f;
        scr[kk * 33 + (lane & 31)] = W[(size_t)k * Nin + col] * gs; }
    LDS_WAIT();
    const int c = lane & 7;
#pragma unroll
    for (int j = 0; j < 4; ++j) { const int n = (lane >> 3) + 8 * j; const LAS float* sp = scr + (8 * c) * 33 + n;
        v4u o; o.x = pk2(sp[0 * 33], sp[1 * 33]); o.y = pk2(sp[2 * 33], sp[3 * 33]); o.z = pk2(sp[4 * 33], sp[5 * 33]); o.w = pk2(sp[6 * 33], sp[7 * 33]);
        *(v4u*)(WT + (size_t)(n0 + n) * K + k0 + 8 * c) = o; }
    LDS_WAIT();
}

__device__ __forceinline__ float log_sigmoid(float v) { return fminf(v, 0.f) - log1pf(expf(-fabsf(v))); }
__device__ __forceinline__ void rms1_row(const float* __restrict__ x, const float* __restrict__ g1, const float* __restrict__ w_in, const float* __restrict__ b_f,
                                         bf16_t* __restrict__ XN, float* __restrict__ FLOG, int row, int lane) {
    const float4* xr = (const float4*)(x + (size_t)row * DM);
    float4 v[4]; float ss = 0.f;
#pragma unroll
    for (int j = 0; j < 4; ++j) { v[j] = xr[lane + 64 * j]; ss += v[j].x * v[j].x + v[j].y * v[j].y + v[j].z * v[j].z + v[j].w * v[j].w; }
    ss = wave_sum(ss);
    const float rstd = rsqrtf(ss * (1.f / DM) + EPS);
    float f0 = 0.f, f1 = 0.f, f2 = 0.f, f3 = 0.f, f4 = 0.f, f5 = 0.f, f6 = 0.f, f7 = 0.f;
#pragma unroll
    for (int j = 0; j < 4; ++j) {
        const int c0 = 4 * (lane + 64 * j);
        uint2 o; o.x = pk2(v[j].x * rstd, v[j].y * rstd); o.y = pk2(v[j].z * rstd, v[j].w * rstd);
        *(uint2*)(XN + (size_t)row * DM + c0) = o;
        const float xs[4] = {v[j].x, v[j].y, v[j].z, v[j].w};
#pragma unroll
        for (int c = 0; c < 4; ++c) {
            const int k = c0 + c; const float xv = xs[c] * g1[k];
            const float4* wp = (const float4*)(w_in + (size_t)k * WIN_N + 1536); const float4 w0 = wp[0], w1 = wp[1];
            f0 += xv * w0.x; f1 += xv * w0.y; f2 += xv * w0.z; f3 += xv * w0.w; f4 += xv * w1.x; f5 += xv * w1.y; f6 += xv * w1.z; f7 += xv * w1.w;
        }
    }
    f0 = wave_sum(f0); f1 = wave_sum(f1); f2 = wave_sum(f2); f3 = wave_sum(f3); f4 = wave_sum(f4); f5 = wave_sum(f5); f6 = wave_sum(f6); f7 = wave_sum(f7);
    if (lane < 8) {
        float f = f0; f = lane == 1 ? f1 : f; f = lane == 2 ? f2 : f; f = lane == 3 ? f3 : f; f = lane == 4 ? f4 : f; f = lane == 5 ? f5 : f; f = lane == 6 ? f6 : f; f = lane == 7 ? f7 : f;
        FLOG[(size_t)row * 8 + lane] = log_sigmoid(f * rstd + b_f[lane]);
    }
}
__device__ __forceinline__ void cumsum_wg(const float* __restrict__ FLOG, float* __restrict__ CUM, int bh, LAS float* part) {
    const int b = bh >> 3, h = bh & 7, t = threadIdx.x;
    float loc[8]; float s = 0.f;
#pragma unroll
    for (int i = 0; i < 8; ++i) { loc[i] = FLOG[((size_t)b * SEQ + t * 8 + i) * 8 + h]; s += loc[i]; }
    part[t] = s; __syncthreads();
    float run = 0.f; for (int i = 0; i < t; ++i) run += part[i];
#pragma unroll
    for (int i = 0; i < 8; ++i) { run += loc[i]; CUM[(size_t)bh * SEQ + t * 8 + i] = run * LOG2E; }
    __syncthreads();
}

template <int NT> __device__ __forceinline__ void wave_mma(f32x4 (&acc)[NT], const bf16_t* ap, const bf16_t* const (&bp)[NT], int K) {
    for (int k0 = 0; k0 < K; k0 += 32) {
        const bf16x8 a = *(const bf16x8*)(ap + k0);
#pragma unroll
        for (int t = 0; t < NT; ++t) { const bf16x8 b = *(const bf16x8*)(bp[t] + k0); acc[t] = __builtin_amdgcn_mfma_f32_16x16x32_bf16(a, b, acc[t], 0, 0, 0); }
    }
}
__device__ __forceinline__ void nv_inproj(const bf16_t* __restrict__ XN, const bf16_t* __restrict__ WINT, bf16_t* __restrict__ PROJ, int item, int lane) {
    const int n0 = (item % 48) * 64, m0 = (item / 48) * 16, r = lane & 15, q = lane >> 4;
    f32x4 acc[4];
#pragma unroll
    for (int t = 0; t < 4; ++t) acc[t] = (f32x4){0.f, 0.f, 0.f, 0.f};
    const bf16_t* ap = XN + (size_t)(m0 + r) * DM + 8 * q;
    const bf16_t* bp[4];
#pragma unroll
    for (int t = 0; t < 4; ++t) bp[t] = WINT + (size_t)(n0 + 16 * t + r) * DM + 8 * q;
    wave_mma<4>(acc, ap, bp, DM);
    const float sc = (n0 < 512 || (n0 >= 1536 && n0 < 2048)) ? C2 : 1.f;
#pragma unroll
    for (int t = 0; t < 4; ++t)
#pragma unroll
        for (int j = 0; j < 4; ++j) PROJ[(size_t)(m0 + 4 * q + j) * NPROJ + n0 + 16 * t + r] = f2bf(acc[t][j] * sc);
}

template <int TYPE> __device__ __forceinline__ void nv_attn(const bf16_t* __restrict__ PROJ, const float* __restrict__ CUM, bf16_t* __restrict__ OMIX, float* __restrict__ SSQ,
                                                          int bh, int qblk, int lane, LAS unsigned char* wl) {
    LAS bf16_t* Ks = (LAS bf16_t*)wl; LAS bf16_t* Vs = (LAS bf16_t*)(wl + 8192); LAS float* Cs = (LAS float*)(wl + 16384);
    const int b = bh >> 3, h = bh & 7, t = qblk * 64 + lane;
    const size_t row = (size_t)b * SEQ + t;
    const int qcol = (TYPE == 0 ? 0 : 1536) + h * HD, kcol = qcol + 512, vcol = qcol + 1024;
    float q[64], o[64];
#pragma unroll
    for (int c = 0; c < 8; ++c) { const bf16x8 v = *(const bf16x8*)(PROJ + row * NPROJ + qcol + 8 * c);
#pragma unroll
        for (int j = 0; j < 8; ++j) q[8 * c + j] = bf2f((unsigned short)v[j]); }
#pragma unroll
    for (int d = 0; d < 64; ++d) o[d] = 0.f;
    float m = -INFINITY, l = 0.f, R = 1.f;
    const float cq = CUM[(size_t)bh * SEQ + t];
    for (int it = 0; it <= qblk; ++it) {
        const int kt = (TYPE == 0) ? it : qblk - it;
        LDS_WAIT();
        for (int i = 0; i < 64; ++i) { const size_t kr = ((size_t)b * SEQ + kt * 64 + i) * NPROJ; Ks[i * 64 + lane] = PROJ[kr + kcol + lane]; Vs[i * 64 + lane] = PROJ[kr + vcol + lane]; }
        Cs[lane] = CUM[(size_t)bh * SEQ + kt * 64 + lane];
        LDS_WAIT();
        for (int ss = 0; ss < 64; ++ss) {
            const int s = (TYPE == 0) ? ss : 63 - ss; const int ks = kt * 64 + s;
            float dot = 0.f;
#pragma unroll
            for (int d = 0; d < 64; d += 8) { const bf16x8 kv = *(const LAS bf16x8*)&Ks[s * 64 + d];
#pragma unroll
                for (int j = 0; j < 8; ++j) dot += q[d + j] * bf2f((unsigned short)kv[j]); }
            if (TYPE == 0) {
                if (ks <= t) {
                    const float xv = dot + cq - Cs[s]; const float mn = fmaxf(m, xv); const float sc = exp2f(m - mn), p = exp2f(xv - mn);
                    l = l * sc + p; m = mn;
#pragma unroll
                    for (int d = 0; d < 64; d += 8) { const bf16x8 vv = *(const LAS bf16x8*)&Vs[s * 64 + d];
#pragma unroll
                        for (int j = 0; j < 8; ++j) o[d + j] = o[d + j] * sc + p * bf2f((unsigned short)vv[j]); }
                }
            } else {
                if (ks < t) {
                    const float z = fminf(fmaxf(dot, -80.f), 80.f); const float e = exp2f(z); const float rr = 1.f / (1.f + e); const float a = e * rr * R; R *= rr;
#pragma unroll
                    for (int d = 0; d < 64; d += 8) { const bf16x8 vv = *(const LAS bf16x8*)&Vs[s * 64 + d];
#pragma unroll
                        for (int j = 0; j < 8; ++j) o[d + j] += a * bf2f((unsigned short)vv[j]); }
                }
            }
        }
    }
    const float inv = (TYPE == 0) ? 1.f / l : 1.f;
    float ssq = 0.f;
#pragma unroll
    for (int d = 0; d < 64; ++d) { o[d] *= inv; ssq += o[d] * o[d]; }
    SSQ[row * 16 + TYPE * 8 + h] = ssq;
#pragma unroll
    for (int c = 0; c < 8; ++c) { bf16x8 v;
#pragma unroll
        for (int j = 0; j < 8; ++j) v[j] = (short)f2bf(o[8 * c + j]);
        *(bf16x8*)(OMIX + row * DM + TYPE * GW + h * HD + 8 * c) = v; }
}

__device__ __forceinline__ void nv_wout(const bf16_t* __restrict__ OMIX, const bf16_t* __restrict__ WOUTT, const float* __restrict__ SSQ, const float* __restrict__ x,
                                        float* __restrict__ X1, bf16_t* __restrict__ X1B, int item, int lane) {
    const int n0 = (item & 15) * 64, m0 = (item >> 4) * 16, r = lane & 15, q = lane >> 4;
    f32x4 af[4], as[4];
#pragma unroll
    for (int t = 0; t < 4; ++t) { af[t] = (f32x4){0.f, 0.f, 0.f, 0.f}; as[t] = (f32x4){0.f, 0.f, 0.f, 0.f}; }
    const bf16_t* ap = OMIX + (size_t)(m0 + r) * DM + 8 * q;
    const bf16_t* bp[4]; const bf16_t* bp2[4];
#pragma unroll
    for (int t = 0; t < 4; ++t) { bp[t] = WOUTT + (size_t)(n0 + 16 * t + r) * DM + 8 * q; bp2[t] = bp[t] + GW; }
    wave_mma<4>(af, ap, bp, GW);
    wave_mma<4>(as, ap + GW, bp2, GW);
#pragma unroll
    for (int j = 0; j < 4; ++j) {
        const size_t row = m0 + 4 * q + j; const float* sp = SSQ + row * 16;
        float sf = 0.f, s2 = 0.f;
#pragma unroll
        for (int h = 0; h < 8; ++h) { sf += sp[h]; s2 += sp[8 + h]; }
        const float rf = rsqrtf(sf * (1.f / GW) + EPS), rs = rsqrtf(s2 * (1.f / GW) + EPS);
#pragma unroll
        for (int t = 0; t < 4; ++t) { const size_t idx = row * DM + n0 + 16 * t + r; const float v = x[idx] + rf * af[t][j] + rs * as[t][j]; X1[idx] = v; X1B[idx] = f2bf(v); }
    }
}

__device__ __forceinline__ void nv_router(const float* __restrict__ X1, const float* __restrict__ WR, const float* __restrict__ b_router, float* __restrict__ RSTD2,
                                          float* __restrict__ RW, int* __restrict__ LIST, unsigned* __restrict__ CNT, int item, int lane) {
    const int e = lane & 31, tok = item * 2 + (lane >> 5);
    const float* xr = X1 + (size_t)tok * DM;
    float acc = 0.f, ss = 0.f;
    for (int k = 0; k < DM; ++k) { const float xv = xr[k]; acc += xv * WR[k * NE + e]; ss += xv * xv; }
    const float rstd = rsqrtf(ss * (1.f / DM) + EPS);
    float logit = acc * rstd + b_router[e];
    if (e == 0) RSTD2[tok] = rstd;
    float tv[4]; int ti[4];
#pragma unroll
    for (int k = 0; k < 4; ++k) {
        float bv = logit; int bi = e;
#pragma unroll
        for (int o = 1; o < 32; o <<= 1) { const float ov = __shfl_xor(bv, o); const int oi = __shfl_xor(bi, o); if (ov > bv || (ov == bv && oi < bi)) { bv = ov; bi = oi; } }
        tv[k] = bv; ti[k] = bi; if (e == bi) logit = -INFINITY;
    }
    const float e0 = 1.f, e1 = expf(tv[1] - tv[0]), e2 = expf(tv[2] - tv[0]), e3 = expf(tv[3] - tv[0]); const float inv = 1.f / (e0 + e1 + e2 + e3);
    const float w0 = e0 * inv, w1 = e1 * inv, w2 = e2 * inv, w3 = e3 * inv;
    int myk = -1; float myw = 0.f;
    if (e == ti[0]) { myk = 0; myw = w0; } if (e == ti[1]) { myk = 1; myw = w1; } if (e == ti[2]) { myk = 2; myw = w2; } if (e == ti[3]) { myk = 3; myw = w3; }
    if (myk >= 0) { const int slot = tok * 4 + myk; const unsigned pos = atomicAdd(&CNT[e], 1u); LIST[(size_t)e * LIST_CAP + pos] = slot; RW[slot] = myw; }
}

__device__ __forceinline__ bool moe_tile(const unsigned* CNT, int g, int& e, int& base, int& p0, int& cnt) {
    const int tile256 = g >> 4; base = 0;
    for (e = 0; e < NE; ++e) { const int nt = ((int)CNT[e] + 255) >> 8; if (tile256 < base + nt) break; base += nt; }
    if (e == NE) return false;
    cnt = (int)CNT[e]; p0 = (g - base * 16) * 16; return p0 < cnt;
}
__device__ __forceinline__ void nv_moe1(const bf16_t* __restrict__ X1B, const bf16_t* __restrict__ W1T, const float* __restrict__ b1, const float* __restrict__ RSTD2,
                                        const int* __restrict__ LIST, bf16_t* __restrict__ H, int e, int base, int p0, int cnt, int cg, int lane) {
    const int r = lane & 15, q = lane >> 4, c0 = cg * 32, pn = c0 >> 7, j0 = c0 & 127;
    const int* lst = LIST + (size_t)e * LIST_CAP;
    const int prow = p0 + r; const int tok = lst[prow < cnt ? prow : cnt - 1] >> 2;
    f32x4 acc[4];
#pragma unroll
    for (int t = 0; t < 4; ++t) acc[t] = (f32x4){0.f, 0.f, 0.f, 0.f};
    const bf16_t* ap = X1B + (size_t)tok * DM + 8 * q;
    const bf16_t* wb = W1T + (size_t)e * 2048 * DM + (size_t)(256 * pn + j0 + r) * DM + 8 * q;
    const bf16_t* bp[4] = {wb, wb + 16 * DM, wb + 128 * DM, wb + 144 * DM};
    wave_mma<4>(acc, ap, bp, DM);
#pragma unroll
    for (int j = 0; j < 4; ++j) {
        const int pr = p0 + 4 * q + j; if (pr >= cnt) continue;
        const float rs = RSTD2[lst[pr] >> 2];
#pragma unroll
        for (int t = 0; t < 2; ++t) {
            const int col = c0 + 16 * t + r;
            float glu = acc[t][j] * rs + b1[(size_t)e * 2048 + col], lin = acc[t + 2][j] * rs + b1[(size_t)e * 2048 + 1024 + col];
            glu = fminf(glu, 7.f); lin = fminf(fmaxf(lin, -7.f), 7.f);
            const float act = glu * (1.f / (1.f + expf(-1.702f * glu))) * (lin + 1.f);
            H[((size_t)base * 256 + pr) * DM + col] = f2bf(act);
        }
    }
}
__device__ __forceinline__ void nv_moe2(const bf16_t* __restrict__ H, const bf16_t* __restrict__ W2T, const float* __restrict__ b2, const float* __restrict__ RW,
                                        const int* __restrict__ LIST, bf16_t* __restrict__ Y, int e, int base, int p0, int cnt, int cg, int lane) {
    const int r = lane & 15, q = lane >> 4, n0 = cg * 64;
    const int* lst = LIST + (size_t)e * LIST_CAP;
    f32x4 acc[4];
#pragma unroll
    for (int t = 0; t < 4; ++t) acc[t] = (f32x4){0.f, 0.f, 0.f, 0.f};
    const bf16_t* ap = H + ((size_t)base * 256 + p0 + r) * DM + 8 * q;
    const bf16_t* bp[4];
#pragma unroll
    for (int t = 0; t < 4; ++t) bp[t] = W2T + (size_t)e * DM * DM + (size_t)(n0 + 16 * t + r) * DM + 8 * q;
    wave_mma<4>(acc, ap, bp, DM);
#pragma unroll
    for (int j = 0; j < 4; ++j) {
        const int pr = p0 + 4 * q + j; if (pr >= cnt) continue;
        const int slot = lst[pr]; const float w = RW[slot];
#pragma unroll
        for (int t = 0; t < 4; ++t) { const int col = n0 + 16 * t + r; Y[(size_t)slot * DM + col] = f2bf((acc[t][j] + b2[(size_t)e * DM + col]) * w); }
    }
}

__device__ __forceinline__ void final_row(const float* X1, const bf16_t* __restrict__ Y, const float* __restrict__ gf, float* out, int row, int lane) {
    float4 v[4]; float ss = 0.f;
#pragma unroll
    for (int j = 0; j < 4; ++j) {
        const int c0 = 4 * (lane + 64 * j);
        v[j] = *(const float4*)(X1 + (size_t)row * DM + c0);
#pragma unroll
        for (int k = 0; k < 4; ++k) { const uint2 y = *(const uint2*)(Y + ((size_t)row * 4 + k) * DM + c0);
            v[j].x += bf2f((unsigned short)(y.x & 0xffff)); v[j].y += bf2f((unsigned short)(y.x >> 16)); v[j].z += bf2f((unsigned short)(y.y & 0xffff)); v[j].w += bf2f((unsigned short)(y.y >> 16)); }
        ss += v[j].x * v[j].x + v[j].y * v[j].y + v[j].z * v[j].z + v[j].w * v[j].w;
    }
    ss = wave_sum(ss);
    const float rstd = rsqrtf(ss * (1.f / DM) + EPS);
#pragma unroll
    for (int j = 0; j < 4; ++j) { const int c0 = 4 * (lane + 64 * j); const float4 g = *(const float4*)(gf + c0);
        float4 o; o.x = v[j].x * rstd * g.x; o.y = v[j].y * rstd * g.y; o.z = v[j].z * rstd * g.z; o.w = v[j].w * rstd * g.w; *(float4*)(out + (size_t)row * DM + c0) = o; }
}

__global__ void __launch_bounds__(NTHREADS, 2) mega_fwd(Args a) {
    extern __shared__ __attribute__((aligned(16))) unsigned char lds[];
    LAS unsigned char* L = (LAS unsigned char*)lds;
    volatile LAS unsigned* MISC = (volatile LAS unsigned*)(L + MISC_OFF);
    const int tid = threadIdx.x, lane = tid & 63, wave = __builtin_amdgcn_readfirstlane(tid >> 6);
    const int G = gridDim.x, bx = blockIdx.x, vcu = (G % 8 == 0) ? (bx % 8) * (G / 8) + bx / 8 : bx;
    const int gw = vcu * NWAVES + wave, NGW = G * NWAVES;
    unsigned char* ws = a.ws;
    unsigned* CTL = (unsigned*)(ws + WS_CTL);
    bf16_t* WINT = (bf16_t*)(ws + WS_WINT); bf16_t* WOUTT = (bf16_t*)(ws + WS_WOUTT); float* WR = (float*)(ws + WS_WR); float* CUM = (float*)(ws + WS_CUM);
    float* SSQ = (float*)(ws + WS_SSQ); float* RSTD2 = (float*)(ws + WS_RSTD2); float* RW = (float*)(ws + WS_RW); int* LIST = (int*)(ws + WS_LIST); float* FLOG = (float*)(ws + WS_FLOG);
    bf16_t* XN = (bf16_t*)(ws + WS_XN); bf16_t* PROJ = (bf16_t*)(ws + WS_PROJ); bf16_t* OMIX = (bf16_t*)(ws + WS_OMIX); bf16_t* X1B = (bf16_t*)(ws + WS_X1B);
    bf16_t* W1T = (bf16_t*)(ws + WS_W1T); bf16_t* W2T = (bf16_t*)(ws + WS_W2T); bf16_t* H = (bf16_t*)(ws + WS_H); bf16_t* Y = (bf16_t*)(ws + WS_Y);
    unsigned* CNT = CTL + CW_CNT;
    for (int u = tid; u < (LDS_BYTES - LDSCTL_OFF) / 4; u += NTHREADS) ((LAS unsigned*)(L + LDSCTL_OFF))[u] = 0u;
    __syncthreads();
    XcdBarrier bar = xcd_barrier_post(CTL + CW_BAR, MISC + 8);

    {
        LAS float* scr = (LAS float*)(L + RING_OFF + wave * 16384);
        constexpr int I_IN = (DM / 64) * (NPROJ / 32), I_OUT = (DM / 64) * (DM / 32), I_W1 = (DM / 64) * (2048 / 32), I_W2 = (DM / 64) * (DM / 32);
        constexpr int NITEMS = I_IN + I_OUT + NE * I_W1 + NE * I_W2;
        for (int it = gw; it < NITEMS; it += NGW) {
            int r = it;
            if (r < I_IN) { transpose_item(a.w_in, DM, WIN_N, NPROJ, 1, a.g1, nullptr, DM, WINT, scr, r, lane); continue; } r -= I_IN;
            if (r < I_OUT) { transpose_item(a.w_out, DM, DM, DM, 0, a.g_fox, a.g_sb, GW, WOUTT, scr, r, lane); continue; } r -= I_OUT;
            if (r < NE * I_W1) { const int e = r / I_W1; transpose_item(a.w1 + (size_t)e * DM * 2048, DM, 2048, 2048, 2, a.g2, nullptr, DM, W1T + (size_t)e * 2048 * DM, scr, r % I_W1, lane); continue; } r -= NE * I_W1;
            { const int e = r / I_W2; transpose_item(a.w2 + (size_t)e * DM * DM, DM, DM, DM, 0, nullptr, nullptr, DM, W2T + (size_t)e * DM * DM, scr, r % I_W2, lane); }
        }
        for (int i = gw * 64 + lane; i < DM * NE; i += NGW * 64) WR[i] = a.w_router[i] * a.g2[i >> 5];
        for (int row = gw; row < M; row += NGW) rms1_row(a.x, a.g1, a.w_in, a.b_f, XN, FLOG, row, lane);
    }
    xcd_barrier(bar);
    if (vcu < NB * NH) cumsum_wg(FLOG, CUM, vcu, (LAS float*)(L + RING_OFF));
    for (int it = gw; it < (M / 16) * (NPROJ / 64); it += NGW) nv_inproj(XN, WINT, PROJ, it, lane);
    xcd_barrier(bar);
    {
        LAS unsigned char* wl = L + RING_OFF + wave * 16640;
        for (int u = gw; u < 4096; u += NGW) {
            const int i = u >> 11, idx = u & 2047, type = idx & 1, bh = (idx >> 1) & 31, j = (idx >> 6) & 31; const int qblk = (i == 0) ? j : 63 - j;
            if (type == 0) nv_attn<0>(PROJ, CUM, OMIX, SSQ, bh, qblk, lane, wl); else nv_attn<1>(PROJ, CUM, OMIX, SSQ, bh, qblk, lane, wl);
        }
    }
    xcd_barrier(bar);
    for (int it = gw; it < (M / 16) * (DM / 64); it += NGW) nv_wout(OMIX, WOUTT, SSQ, a.x, a.out, X1B, it, lane);
    xcd_barrier(bar);
    for (int it = gw; it < M / 2; it += NGW) nv_router(a.out, WR, a.b_router, RSTD2, RW, LIST, CNT, it, lane);
    xcd_barrier(bar);
    for (int g = gw; g < MAX_TILES * 16; g += NGW) {
        int e, base, p0, cnt; if (!moe_tile(CNT, g, e, base, p0, cnt)) continue;
        for (int cg = 0; cg < DFF / 32; ++cg) nv_moe1(X1B, W1T, a.b1, RSTD2, LIST, H, e, base, p0, cnt, cg, lane);
    }
    xcd_barrier(bar);
    for (int g = gw; g < MAX_TILES * 16; g += NGW) {
        int e, base, p0, cnt; if (!moe_tile(CNT, g, e, base, p0, cnt)) continue;
        for (int cg = 0; cg < DM / 64; ++cg) nv_moe2(H, W2T, a.b2, RW, LIST, Y, e, base, p0, cnt, cg, lane);
    }
    xcd_barrier(bar);
    for (int row = gw; row < M; row += NGW) final_row(a.out, Y, a.gf, a.out, row, lane);
}

extern "C" void kernel_launch(void* const* d_in, const int* in_sizes, int n_in, void* d_out, int out_size, void* d_ws, size_t ws_size, hipStream_t stream) {
    static int grid = 0;
    if (grid == 0) {
        if (n_in != 15 || in_sizes[0] != M * DM || out_size != M * DM || ws_size < WS_END) {
            fprintf(stderr, "kernel_launch: unexpected shapes / workspace (n_in %d, in0 %d, out %d, ws %zu, need %zu)\n", n_in, n_in > 0 ? in_sizes[0] : -1, out_size, ws_size, (size_t)WS_END); grid = -1; return; }
        int dev = 0, cus = 0, per_cu = 0;
        if (hipGetDevice(&dev) != hipSuccess || hipDeviceGetAttribute(&cus, hipDeviceAttributeMultiprocessorCount, dev) != hipSuccess) { grid = -1; return; }
        if (hipFuncSetAttribute((const void*)mega_fwd, hipFuncAttributeMaxDynamicSharedMemorySize, LDS_BYTES) != hipSuccess) { fprintf(stderr, "kernel_launch: hipFuncSetAttribute failed\n"); grid = -1; return; }
        if (hipOccupancyMaxActiveBlocksPerMultiprocessor(&per_cu, (const void*)mega_fwd, NTHREADS, LDS_BYTES) != hipSuccess || per_cu < 1) fprintf(stderr, "kernel_launch: occupancy query reports %d\n", per_cu);
        (void)hipGetLastError();
        grid = cus;
    }
    if (grid < 0) return;
    if (hipMemsetAsync((char*)d_ws + WS_CTL, 0, CTL_BYTES, stream) != hipSuccess) return;
    Args a{};
    a.x = (const float*)d_in[0]; a.g1 = (const float*)d_in[1]; a.w_in = (const float*)d_in[2]; a.b_f = (const float*)d_in[3]; a.g_fox = (const float*)d_in[4]; a.g_sb = (const float*)d_in[5];
    a.w_out = (const float*)d_in[6]; a.g2 = (const float*)d_in[7]; a.w_router = (const float*)d_in[8]; a.b_router = (const float*)d_in[9]; a.w1 = (const float*)d_in[10]; a.b1 = (const float*)d_in[11];
    a.w2 = (const float*)d_in[12]; a.b2 = (const float*)d_in[13]; a.gf = (const float*)d_in[14];
    a.out = (float*)d_out; a.ws = (unsigned char*)d_ws;
    hipLaunchKernelGGL(mega_fwd, dim3(grid), dim3(NTHREADS), LDS_BYTES, stream, a);
    const hipError_t le = hipPeekAtLastError();
    if (le != hipSuccess) fprintf(stderr, "kernel_launch: launch failed: %s\n", hipGetErrorName(le));
}
```

```cpp
#include <hip/hip_runtime.h>
#include <cstdio>
#include <cstdint>

typedef unsigned short bf16_t;
typedef short bf16x8 __attribute__((ext_vector_type(8)));
typedef float f32x4 __attribute__((ext_vector_type(4)));

constexpr int NB = 4, SEQ = 4096, DM = 1024, M = NB * SEQ;
constexpr int NH = 8, HD = 64, GW = 512;
constexpr int WIN_N = 3080, NPROJ = 3072;
constexpr int NE = 32, TOPK = 4, DFF = 1024;
constexpr float EPS = 1e-5f;
constexpr float LOG2E = 1.4426950408889634f;
constexpr float C2 = 0.125f * LOG2E;
constexpr int LIST_CAP = M;
constexpr int MAX_TILES = (M * TOPK) / 256 + NE;

constexpr size_t MiB = 1u << 20;
constexpr size_t WS_CTL = 0, CTL_BYTES = 1 * MiB;
constexpr size_t WS_WINT = 2 * MiB;
constexpr size_t WS_WOUTT = 8 * MiB;
constexpr size_t WS_WR = 10 * MiB;
constexpr size_t WS_CUM = 11 * MiB;
constexpr size_t WS_SSQ = 12 * MiB;
constexpr size_t WS_RSTD2 = 14 * MiB;
constexpr size_t WS_RW = 15 * MiB;
constexpr size_t WS_LIST = 16 * MiB;
constexpr size_t WS_FLOG = 18 * MiB;
constexpr size_t WS_XN = 32 * MiB;
constexpr size_t WS_PROJ = 64 * MiB;
constexpr size_t WS_OMIX = 160 * MiB;
constexpr size_t WS_X1B = 192 * MiB;
constexpr size_t WS_W1T = 224 * MiB;
constexpr size_t WS_W2T = 352 * MiB;
constexpr size_t WS_H = 416 * MiB;
constexpr size_t WS_Y = 560 * MiB;
constexpr size_t WS_END = 688 * MiB;
constexpr int CW_CNT = 1024;

__device__ __forceinline__ unsigned short f2bf(float f) { unsigned u = __float_as_uint(f); return (unsigned short)((u + 0x7fffu + ((u >> 16) & 1u)) >> 16); }
__device__ __forceinline__ float bf2f(unsigned short b) { return __uint_as_float(((unsigned)b) << 16); }
__device__ __forceinline__ float wave_sum(float v) {
#pragma unroll
    for (int o = 1; o < 64; o <<= 1) v += __shfl_xor(v, o);
    return v;
}


#define LAS __attribute__((address_space(3)))
#define GAS __attribute__((address_space(1)))
typedef unsigned v4u __attribute__((ext_vector_type(4)));
#define LDS_WAIT() asm volatile("s_waitcnt lgkmcnt(0)" ::: "memory")
#define VM_WAIT() asm volatile("s_waitcnt vmcnt(0)" ::: "memory")
constexpr int NWAVES = 8, NTHREADS = NWAVES * 64;
constexpr bool OPT_GEMM = true;

#define XB_TMO      128
#define XB_XCNT(j)  (256  + 64 * (j))
#define XB_XSUB(j)  (1280 + 64 * (j))
#define XB_XGEN(j)  (2304 + 64 * (j))
#define XB_TOP      3328
#define XB_TOPGEN   3392
#define XCD_BAR_WORDS 3456
#define XB_SPIN_CAP (1u << 20)
__device__ __forceinline__ unsigned xb_ld(unsigned* p)              { return __hip_atomic_load(p, __ATOMIC_RELAXED, __HIP_MEMORY_SCOPE_AGENT); }
__device__ __forceinline__ unsigned xb_add(unsigned* p, unsigned v) { return __hip_atomic_fetch_add(p, v, __ATOMIC_RELAXED, __HIP_MEMORY_SCOPE_AGENT); }
__device__ __forceinline__ unsigned xb_xcc_id() { return (unsigned)__builtin_amdgcn_s_getreg((3 << 11) | 20) & 0xFu; }
#define XB_SPIN(cond, bar) do { unsigned _sp = 0; while (cond) { __builtin_amdgcn_s_sleep(1); \
    if ((++_sp & 255u) == 0u) { if (xb_ld(&(bar)[XB_TMO])) break; if (_sp > XB_SPIN_CAP) { atomicAdd(&(bar)[XB_TMO], 1u); break; } } } } while (0)
struct XcdBarrier { unsigned* bar; unsigned x; volatile LAS unsigned* st; };
__device__ __forceinline__ XcdBarrier xcd_barrier_post(unsigned* bar, volatile LAS unsigned* st) {
    XcdBarrier b; b.bar = bar; b.x = xb_xcc_id(); b.st = st;
    if (threadIdx.x == 0) (void)xb_add(&bar[XB_XCNT(b.x)], 1u);
    return b;
}
__device__ __forceinline__ void xcd_barrier_complete(unsigned* bar, unsigned x, unsigned& nloc, unsigned& nx) {
    const unsigned G = gridDim.x * gridDim.y * gridDim.z;
    unsigned sum, cnt, mine, sp = 0u;
    for (;;) {
        sum = 0u; cnt = 0u; mine = 0u;
#pragma unroll
        for (unsigned j = 0; j < 16; ++j) { const unsigned c = xb_ld(&bar[XB_XCNT(j)]); sum += c; cnt += (c > 0u) ? 1u : 0u; mine = (j == x) ? c : mine; }
        if (sum == G) break;
        __builtin_amdgcn_s_sleep(1);
        if ((++sp & 255u) == 0u) { if (xb_ld(&bar[XB_TMO])) break; if (sp > XB_SPIN_CAP) { atomicAdd(&bar[XB_TMO], 1u); break; } }
    }
    nloc = mine > 0u ? mine : 1u; nx = cnt > 0u ? cnt : 1u;
}
__device__ __forceinline__ void xcd_barrier(const XcdBarrier& b) {
    asm volatile("s_waitcnt vmcnt(0)" ::: "memory");
    __syncthreads();
    if (threadIdx.x == 0) {
        unsigned* bar = b.bar;
        __builtin_amdgcn_s_waitcnt(0);
        unsigned nloc = b.st[0], nx = b.st[1];
        if (nloc == 0u) { xcd_barrier_complete(bar, b.x, nloc, nx); b.st[0] = nloc; b.st[1] = nx; }
        const unsigned old = xb_add(&bar[XB_XSUB(b.x)], 1u);
        const unsigned gen = old / nloc;
        if (old + 1u == (gen + 1u) * nloc) {
            __builtin_amdgcn_fence(__ATOMIC_RELEASE, "agent");
            asm volatile("s_waitcnt vmcnt(0)" ::: "memory");
            const unsigned og = xb_add(&bar[XB_TOP], 1u);
            const unsigned tg = og / nx;
            if (og + 1u == (tg + 1u) * nx) xb_add(&bar[XB_TOPGEN], 1u);
            else XB_SPIN(xb_ld(&bar[XB_TOPGEN]) == tg, bar);
            __builtin_amdgcn_fence(__ATOMIC_ACQUIRE, "agent");
            xb_add(&bar[XB_XGEN(b.x)], 1u);
            asm volatile("s_waitcnt vmcnt(0)" ::: "memory");
        } else {
            XB_SPIN(xb_ld(&bar[XB_XGEN(b.x)]) == gen, bar);
            __builtin_amdgcn_fence(__ATOMIC_ACQUIRE, "agent");
            asm volatile("s_waitcnt vmcnt(0)" ::: "memory");
        }
    }
    __syncthreads();
}

constexpr int RING_OFF = 0, RING_BYTES = 131072;
constexpr int TAB_OFF = 131072;
constexpr int TAB2_OFF = TAB_OFF + 9 * 1024, TB_OFF = TAB_OFF + 18 * 1024;
constexpr int LDSCTL_OFF = 150528, MISC_OFF = LDSCTL_OFF + 320;
constexpr int LDS_BYTES = 155648;
constexpr int CW_BAR = 4096;

struct Args {
    const float *x, *g1, *w_in, *b_f, *g_fox, *g_sb, *w_out, *g2, *w_router, *b_router, *w1, *b1, *w2, *b2, *gf;
    float* out; unsigned char* ws;
};

__device__ __forceinline__ int mapcol(int mode, int n) {
    if (mode == 1) return n < 1536 ? n : n + 8;
    if (mode == 2) { const int pn = n >> 8, j = n & 255; return j < 128 ? 128 * pn + j : 1024 + 128 * pn + (j - 128); }
    return n;
}
__device__ __forceinline__ unsigned pk2(float lo, float hi) { return (unsigned)f2bf(lo) | ((unsigned)f2bf(hi) << 16); }
__device__ __forceinline__ void transpose_item(const float* __restrict__ W, int K, int Nin, int Nout, int mode, const float* __restrict__ gA, const float* __restrict__ gB, int gsplit,
                                               bf16_t* __restrict__ WT, LAS float* scr, int item, int lane) {
    const int nblk = Nout / 32, kb = item / nblk, nb = item % nblk, k0 = 64 * kb, n0 = 32 * nb;
    const int col = mapcol(mode, n0 + (lane & 31));
#pragma unroll 8
    for (int i = 0; i < 32; ++i) { const int kk = 2 * i + (lane >> 5), k = k0 + kk; const float gs = gA ? (k < gsplit ? gA[k] : gB[k - gsplit]) : 1.f;
        scr[kk * 33 + (lane & 31)] = W[(size_t)k * Nin + col] * gs; }
    LDS_WAIT();
    const int c = lane & 7;
#pragma unroll
    for (int j = 0; j < 4; ++j) { const int n = (lane >> 3) + 8 * j; const LAS float* sp = scr + (8 * c) * 33 + n;
        v4u o; o.x = pk2(sp[0 * 33], sp[1 * 33]); o.y = pk2(sp[2 * 33], sp[3 * 33]); o.z = pk2(sp[4 * 33], sp[5 * 33]); o.w = pk2(sp[6 * 33], sp[7 * 33]);
        *(v4u*)(WT + (size_t)(n0 + n) * K + k0 + 8 * c) = o; }
    LDS_WAIT();
}

__device__ __forceinline__ float log_sigmoid(float v) { return fminf(v, 0.f) - log1pf(expf(-fabsf(v))); }
__device__ __forceinline__ void rms1_row(const float* __restrict__ x, const float* __restrict__ g1, const float* __restrict__ w_in, const float* __restrict__ b_f,
                                         bf16_t* __restrict__ XN, float* __restrict__ FLOG, int row, int lane) {
    const float4* xr = (const float4*)(x + (size_t)row * DM);
    float4 v[4]; float ss = 0.f;
#pragma unroll
    for (int j = 0; j < 4; ++j) { v[j] = xr[lane + 64 * j]; ss += v[j].x * v[j].x + v[j].y * v[j].y + v[j].z * v[j].z + v[j].w * v[j].w; }
    ss = wave_sum(ss);
    const float rstd = rsqrtf(ss * (1.f / DM) + EPS);
    float f0 = 0.f, f1 = 0.f, f2 = 0.f, f3 = 0.f, f4 = 0.f, f5 = 0.f, f6 = 0.f, f7 = 0.f;
#pragma unroll
    for (int j = 0; j < 4; ++j) {
        const int c0 = 4 * (lane + 64 * j);
        uint2 o; o.x = pk2(v[j].x * rstd, v[j].y * rstd); o.y = pk2(v[j].z * rstd, v[j].w * rstd);
        *(uint2*)(XN + (size_t)row * DM + c0) = o;
        const float xs[4] = {v[j].x, v[j].y, v[j].z, v[j].w};
#pragma unroll
        for (int c = 0; c < 4; ++c) {
            const int k = c0 + c; const float xv = xs[c] * g1[k];
            const float4* wp = (const float4*)(w_in + (size_t)k * WIN_N + 1536); const float4 w0 = wp[0], w1 = wp[1];
            f0 += xv * w0.x; f1 += xv * w0.y; f2 += xv * w0.z; f3 += xv * w0.w; f4 += xv * w1.x; f5 += xv * w1.y; f6 += xv * w1.z; f7 += xv * w1.w;
        }
    }
    f0 = wave_sum(f0); f1 = wave_sum(f1); f2 = wave_sum(f2); f3 = wave_sum(f3); f4 = wave_sum(f4); f5 = wave_sum(f5); f6 = wave_sum(f6); f7 = wave_sum(f7);
    if (lane < 8) {
        float f = f0; f = lane == 1 ? f1 : f; f = lane == 2 ? f2 : f; f = lane == 3 ? f3 : f; f = lane == 4 ? f4 : f; f = lane == 5 ? f5 : f; f = lane == 6 ? f6 : f; f = lane == 7 ? f7 : f;
        FLOG[(size_t)row * 8 + lane] = log_sigmoid(f * rstd + b_f[lane]);
    }
}
__device__ __forceinline__ void cumsum_wg(const float* __restrict__ FLOG, float* __restrict__ CUM, int bh, LAS float* part) {
    const int b = bh >> 3, h = bh & 7, t = threadIdx.x;
    float loc[8]; float s = 0.f;
#pragma unroll
    for (int i = 0; i < 8; ++i) { loc[i] = FLOG[((size_t)b * SEQ + t * 8 + i) * 8 + h]; s += loc[i]; }
    part[t] = s; __syncthreads();
    float run = 0.f; for (int i = 0; i < t; ++i) run += part[i];
#pragma unroll
    for (int i = 0; i < 8; ++i) { run += loc[i]; CUM[(size_t)bh * SEQ + t * 8 + i] = run * LOG2E; }
    __syncthreads();
}

template <int NT> __device__ __forceinline__ void wave_mma(f32x4 (&acc)[NT], const bf16_t* ap, const bf16_t* const (&bp)[NT], int K) {
    for (int k0 = 0; k0 < K; k0 += 32) {
        const bf16x8 a = *(const bf16x8*)(ap + k0);
#pragma unroll
        for (int t = 0; t < NT; ++t) { const bf16x8 b = *(const bf16x8*)(bp[t] + k0); acc[t] = __builtin_amdgcn_mfma_f32_16x16x32_bf16(a, b, acc[t], 0, 0, 0); }
    }
}
__device__ __forceinline__ void nv_inproj(const bf16_t* __restrict__ XN, const bf16_t* __restrict__ WINT, bf16_t* __restrict__ PROJ, int item, int lane) {
    const int n0 = (item % 48) * 64, m0 = (item / 48) * 16, r = lane & 15, q = lane >> 4;
    f32x4 acc[4];
#pragma unroll
    for (int t = 0; t < 4; ++t) acc[t] = (f32x4){0.f, 0.f, 0.f, 0.f};
    const bf16_t* ap = XN + (size_t)(m0 + r) * DM + 8 * q;
    const bf16_t* bp[4];
#pragma unroll
    for (int t = 0; t < 4; ++t) bp[t] = WINT + (size_t)(n0 + 16 * t + r) * DM + 8 * q;
    wave_mma<4>(acc, ap, bp, DM);
    const float sc = (n0 < 512 || (n0 >= 1536 && n0 < 2048)) ? C2 : 1.f;
#pragma unroll
    for (int t = 0; t < 4; ++t)
#pragma unroll
        for (int j = 0; j < 4; ++j) PROJ[(size_t)(m0 + 4 * q + j) * NPROJ + n0 + 16 * t + r] = f2bf(acc[t][j] * sc);
}

template <int TYPE> __device__ __forceinline__ void nv_attn(const bf16_t* __restrict__ PROJ, const float* __restrict__ CUM, bf16_t* __restrict__ OMIX, float* __restrict__ SSQ,
                                                          int bh, int qblk, int lane, LAS unsigned char* wl) {
    LAS bf16_t* Ks = (LAS bf16_t*)wl; LAS bf16_t* Vs = (LAS bf16_t*)(wl + 8192); LAS float* Cs = (LAS float*)(wl + 16384);
    const int b = bh >> 3, h = bh & 7, t = qblk * 64 + lane;
    const size_t row = (size_t)b * SEQ + t;
    const int qcol = (TYPE == 0 ? 0 : 1536) + h * HD, kcol = qcol + 512, vcol = qcol + 1024;
    float q[64], o[64];
#pragma unroll
    for (int c = 0; c < 8; ++c) { const bf16x8 v = *(const bf16x8*)(PROJ + row * NPROJ + qcol + 8 * c);
#pragma unroll
        for (int j = 0; j < 8; ++j) q[8 * c + j] = bf2f((unsigned short)v[j]); }
#pragma unroll
    for (int d = 0; d < 64; ++d) o[d] = 0.f;
    float m = -INFINITY, l = 0.f, R = 1.f;
    const float cq = CUM[(size_t)bh * SEQ + t];
    for (int it = 0; it <= qblk; ++it) {
        const int kt = (TYPE == 0) ? it : qblk - it;
        LDS_WAIT();
        for (int i = 0; i < 64; ++i) { const size_t kr = ((size_t)b * SEQ + kt * 64 + i) * NPROJ; Ks[i * 64 + lane] = PROJ[kr + kcol + lane]; Vs[i * 64 + lane] = PROJ[kr + vcol + lane]; }
        Cs[lane] = CUM[(size_t)bh * SEQ + kt * 64 + lane];
        LDS_WAIT();
        for (int ss = 0; ss < 64; ++ss) {
            const int s = (TYPE == 0) ? ss : 63 - ss; const int ks = kt * 64 + s;
            float dot = 0.f;
#pragma unroll
            for (int d = 0; d < 64; d += 8) { const bf16x8 kv = *(const LAS bf16x8*)&Ks[s * 64 + d];
#pragma unroll
                for (int j = 0; j < 8; ++j) dot += q[d + j] * bf2f((unsigned short)kv[j]); }
            if (TYPE == 0) {
                if (ks <= t) {
                    const float xv = dot + cq - Cs[s]; const float mn = fmaxf(m, xv); const float sc = exp2f(m - mn), p = exp2f(xv - mn);
                    l = l * sc + p; m = mn;
#pragma unroll
                    for (int d = 0; d < 64; d += 8) { const bf16x8 vv = *(const LAS bf16x8*)&Vs[s * 64 + d];
#pragma unroll
                        for (int j = 0; j < 8; ++j) o[d + j] = o[d + j] * sc + p * bf2f((unsigned short)vv[j]); }
                }
            } else {
                if (ks < t) {
                    const float z = fminf(fmaxf(dot, -80.f), 80.f); const float e = exp2f(z); const float rr = 1.f / (1.f + e); const float a = e * rr * R; R *= rr;
#pragma unroll
                    for (int d = 0; d < 64; d += 8) { const bf16x8 vv = *(const LAS bf16x8*)&Vs[s * 64 + d];
#pragma unroll
                        for (int j = 0; j < 8; ++j) o[d + j] += a * bf2f((unsigned short)vv[j]); }
                }
            }
        }
    }
    const float inv = (TYPE == 0) ? 1.f / l : 1.f;
    float ssq = 0.f;
#pragma unroll
    for (int d = 0; d < 64; ++d) { o[d] *= inv; ssq += o[d] * o[d]; }
    SSQ[row * 16 + TYPE * 8 + h] = ssq;
#pragma unroll
    for (int c = 0; c < 8; ++c) { bf16x8 v;
#pragma unroll
        for (int j = 0; j < 8; ++j) v[j] = (short)f2bf(o[8 * c + j]);
        *(bf16x8*)(OMIX + row * DM + TYPE * GW + h * HD + 8 * c) = v; }
}

__device__ __forceinline__ void nv_wout(const bf16_t* __restrict__ OMIX, const bf16_t* __restrict__ WOUTT, const float* __restrict__ SSQ, const float* __restrict__ x,
                                        float* __restrict__ X1, bf16_t* __restrict__ X1B, int item, int lane) {
    const int n0 = (item & 15) * 64, m0 = (item >> 4) * 16, r = lane & 15, q = lane >> 4;
    f32x4 af[4], as[4];
#pragma unroll
    for (int t = 0; t < 4; ++t) { af[t] = (f32x4){0.f, 0.f, 0.f, 0.f}; as[t] = (f32x4){0.f, 0.f, 0.f, 0.f}; }
    const bf16_t* ap = OMIX + (size_t)(m0 + r) * DM + 8 * q;
    const bf16_t* bp[4]; const bf16_t* bp2[4];
#pragma unroll
    for (int t = 0; t < 4; ++t) { bp[t] = WOUTT + (size_t)(n0 + 16 * t + r) * DM + 8 * q; bp2[t] = bp[t] + GW; }
    wave_mma<4>(af, ap, bp, GW);
    wave_mma<4>(as, ap + GW, bp2, GW);
#pragma unroll
    for (int j = 0; j < 4; ++j) {
        const size_t row = m0 + 4 * q + j; const float* sp = SSQ + row * 16;
        float sf = 0.f, s2 = 0.f;
#pragma unroll
        for (int h = 0; h < 8; ++h) { sf += sp[h]; s2 += sp[8 + h]; }
        const float rf = rsqrtf(sf * (1.f / GW) + EPS), rs = rsqrtf(s2 * (1.f / GW) + EPS);
#pragma unroll
        for (int t = 0; t < 4; ++t) { const size_t idx = row * DM + n0 + 16 * t + r; const float v = x[idx] + rf * af[t][j] + rs * as[t][j]; X1[idx] = v; X1B[idx] = f2bf(v); }
    }
}

__device__ __forceinline__ void nv_router(const float* __restrict__ X1, const float* __restrict__ WR, const float* __restrict__ b_router, float* __restrict__ RSTD2,
                                          float* __restrict__ RW, int* __restrict__ LIST, unsigned* __restrict__ CNT, int item, int lane) {
    const int e = lane & 31, tok = item * 2 + (lane >> 5);
    const float* xr = X1 + (size_t)tok * DM;
    float acc = 0.f, ss = 0.f;
    for (int k = 0; k < DM; ++k) { const float xv = xr[k]; acc += xv * WR[k * NE + e]; ss += xv * xv; }
    const float rstd = rsqrtf(ss * (1.f / DM) + EPS);
    float logit = acc * rstd + b_router[e];
    if (e == 0) RSTD2[tok] = rstd;
    float tv[4]; int ti[4];
#pragma unroll
    for (int k = 0; k < 4; ++k) {
        float bv = logit; int bi = e;
#pragma unroll
        for (int o = 1; o < 32; o <<= 1) { const float ov = __shfl_xor(bv, o); const int oi = __shfl_xor(bi, o); if (ov > bv || (ov == bv && oi < bi)) { bv = ov; bi = oi; } }
        tv[k] = bv; ti[k] = bi; if (e == bi) logit = -INFINITY;
    }
    const float e0 = 1.f, e1 = expf(tv[1] - tv[0]), e2 = expf(tv[2] - tv[0]), e3 = expf(tv[3] - tv[0]); const float inv = 1.f / (e0 + e1 + e2 + e3);
    const float w0 = e0 * inv, w1 = e1 * inv, w2 = e2 * inv, w3 = e3 * inv;
    int myk = -1; float myw = 0.f;
    if (e == ti[0]) { myk = 0; myw = w0; } if (e == ti[1]) { myk = 1; myw = w1; } if (e == ti[2]) { myk = 2; myw = w2; } if (e == ti[3]) { myk = 3; myw = w3; }
    if (myk >= 0) { const int slot = tok * 4 + myk; const unsigned pos = atomicAdd(&CNT[e], 1u); LIST[(size_t)e * LIST_CAP + pos] = slot; RW[slot] = myw; }
}

__device__ __forceinline__ bool moe_tile(const unsigned* CNT, int g, int& e, int& base, int& p0, int& cnt) {
    const int tile256 = g >> 4; base = 0;
    for (e = 0; e < NE; ++e) { const int nt = ((int)CNT[e] + 255) >> 8; if (tile256 < base + nt) break; base += nt; }
    if (e == NE) return false;
    cnt = (int)CNT[e]; p0 = (g - base * 16) * 16; return p0 < cnt;
}
__device__ __forceinline__ void nv_moe1(const bf16_t* __restrict__ X1B, const bf16_t* __restrict__ W1T, const float* __restrict__ b1, const float* __restrict__ RSTD2,
                                        const int* __restrict__ LIST, bf16_t* __restrict__ H, int e, int base, int p0, int cnt, int cg, int lane) {
    const int r = lane & 15, q = lane >> 4, c0 = cg * 32, pn = c0 >> 7, j0 = c0 & 127;
    const int* lst = LIST + (size_t)e * LIST_CAP;
    const int prow = p0 + r; const int tok = lst[prow < cnt ? prow : cnt - 1] >> 2;
    f32x4 acc[4];
#pragma unroll
    for (int t = 0; t < 4; ++t) acc[t] = (f32x4){0.f, 0.f, 0.f, 0.f};
    const bf16_t* ap = X1B + (size_t)tok * DM + 8 * q;
    const bf16_t* wb = W1T + (size_t)e * 2048 * DM + (size_t)(256 * pn + j0 + r) * DM + 8 * q;
    const bf16_t* bp[4] = {wb, wb + 16 * DM, wb + 128 * DM, wb + 144 * DM};
    wave_mma<4>(acc, ap, bp, DM);
#pragma unroll
    for (int j = 0; j < 4; ++j) {
        const int pr = p0 + 4 * q + j; if (pr >= cnt) continue;
        const float rs = RSTD2[lst[pr] >> 2];
#pragma unroll
        for (int t = 0; t < 2; ++t) {
            const int col = c0 + 16 * t + r;
            float glu = acc[t][j] * rs + b1[(size_t)e * 2048 + col], lin = acc[t + 2][j] * rs + b1[(size_t)e * 2048 + 1024 + col];
            glu = fminf(glu, 7.f); lin = fminf(fmaxf(lin, -7.f), 7.f);
            const float act = glu * (1.f / (1.f + expf(-1.702f * glu))) * (lin + 1.f);
            H[((size_t)base * 256 + pr) * DM + col] = f2bf(act);
        }
    }
}
__device__ __forceinline__ void nv_moe2(const bf16_t* __restrict__ H, const bf16_t* __restrict__ W2T, const float* __restrict__ b2, const float* __restrict__ RW,
                                        const int* __restrict__ LIST, bf16_t* __restrict__ Y, int e, int base, int p0, int cnt, int cg, int lane) {
    const int r = lane & 15, q = lane >> 4, n0 = cg * 64;
    const int* lst = LIST + (size_t)e * LIST_CAP;
    f32x4 acc[4];
#pragma unroll
    for (int t = 0; t < 4; ++t) acc[t] = (f32x4){0.f, 0.f, 0.f, 0.f};
    const bf16_t* ap = H + ((size_t)base * 256 + p0 + r) * DM + 8 * q;
    const bf16_t* bp[4];
#pragma unroll
    for (int t = 0; t < 4; ++t) bp[t] = W2T + (size_t)e * DM * DM + (size_t)(n0 + 16 * t + r) * DM + 8 * q;
    wave_mma<4>(acc, ap, bp, DM);
#pragma unroll
    for (int j = 0; j < 4; ++j) {
        const int pr = p0 + 4 * q + j; if (pr >= cnt) continue;
        const int slot = lst[pr]; const float w = RW[slot];
#pragma unroll
        for (int t = 0; t < 4; ++t) { const int col = n0 + 16 * t + r; Y[(size_t)slot * DM + col] = f2bf((acc[t][j] + b2[(size_t)e * DM + col]) * w); }
    }
}

__device__ __forceinline__ void final_row(const float* X1, const bf16_t* __restrict__ Y, const float* __restrict__ gf, float* out, int row, int lane) {
    float4 v[4]; float ss = 0.f;
#pragma unroll
    for (int j = 0; j < 4; ++j) {
        const int c0 = 4 * (lane + 64 * j);
        v[j] = *(const float4*)(X1 + (size_t)row * DM + c0);
#pragma unroll
        for (int k = 0; k < 4; ++k) { const uint2 y = *(const uint2*)(Y + ((size_t)row * 4 + k) * DM + c0);
            v[j].x += bf2f((unsigned short)(y.x & 0xffff)); v[j].y += bf2f((unsigned short)(y.x >> 16)); v[j].z += bf2f((unsigned short)(y.y & 0xffff)); v[j].w += bf2f((unsigned short)(y.y >> 16)); }
        ss += v[j].x * v[j].x + v[j].y * v[j].y + v[j].z * v[j].z + v[j].w * v[j].w;
    }
    ss = wave_sum(ss);
    const float rstd = rsqrtf(ss * (1.f / DM) + EPS);
#pragma unroll
    for (int j = 0; j < 4; ++j) { const int c0 = 4 * (lane + 64 * j); const float4 g = *(const float4*)(gf + c0);
        float4 o; o.x = v[j].x * rstd * g.x; o.y = v[j].y * rstd * g.y; o.z = v[j].z * rstd * g.z; o.w = v[j].w * rstd * g.w; *(float4*)(out + (size_t)row * DM + c0) = o; }
}


namespace pg8 {
#define PG8_LAS __attribute__((address_space(3)))
typedef unsigned u32x4 __attribute__((ext_vector_type(4)));
typedef unsigned u32x2 __attribute__((ext_vector_type(2)));
constexpr int BM = 256, BK = 64, HALF = 128, HTB = HALF * BK * 2  , STAGE_BYTES = 8 * HTB, NXCD = 8, WGM = 8;
__host__ __device__ __forceinline__ int lds_byte(int r, int c) { const int st = (r >> 4) * 2 + (c >> 5), rr = r & 15, cc = c & 31, ob = rr * 64 + cc * 2; return st * 1024 + (ob ^ (((ob >> 9) & 1) << 5)); }
__host__ __device__ __forceinline__ void stage_rc(int b, int& R, int& C) { const int st = b / 1024, sb = b % 1024, swz = sb ^ (((sb >> 9) & 1) << 5); R = (st >> 1) * 16 + swz / 64; C = (st & 1) * 32 + (swz % 64) / 2; }
__host__ __device__ __forceinline__ int perm32(int rho) { const int n = rho >> 4, i = rho & 15; return 8 * (i >> 2) + 4 * n + (i & 3); }
struct Unit { int pm, pn; };
struct Gemm { const bf16_t* A; const bf16_t* Bt; int K; };
struct StaticOrder {
    int nM, nN, nwg, G, c;
    __device__ void init(int M_, int N_, int G_, int c_) { nM = M_ / BM; nN = N_ / BM; nwg = nM * nN; G = G_; c = c_; }
    __device__ bool next(int i, Unit& u) const {
        const long L = (long)i * G + c; if (L >= nwg) return false;
        int wgid = (int)L; { const int q = nwg / NXCD, r = nwg % NXCD, xcd = wgid % NXCD, off = wgid / NXCD; wgid = (xcd < r ? xcd * (q + 1) : r * (q + 1) + (xcd - r) * q) + off; }
        const int nig = WGM * nN, gid = wgid / nig, fm = gid * WGM, gsz = (nM - fm) < WGM ? (nM - fm) : WGM;
        u.pm = fm + ((wgid % nig) % gsz); u.pn = (wgid % nig) / gsz; return true;
    }
    __device__ __forceinline__ const PG8_LAS int* rowtab(int) const { return nullptr; }
};
__device__ __forceinline__ unsigned cvt_pk_bf16(float lo, float hi) { unsigned r; asm volatile("v_cvt_pk_bf16_f32 %0, %1, %2" : "=v"(r) : "v"(lo), "v"(hi)); return r; }

template <class Sched> __device__ __forceinline__ void gather_voffs(const Sched& S, int ui, int tid, int K, unsigned (&o0)[2], unsigned (&o1)[2]) {
    const PG8_LAS int* tab = S.rowtab(ui);
#pragma unroll
    for (int i = 0; i < 2; ++i) { int R, C; stage_rc(tid * 16 + i * 8192, R, C); o0[i] = (unsigned)(tab[R] * K + C) * 2u; o1[i] = (unsigned)(tab[HALF + R] * K + C) * 2u; }
}

template <class Epi, class Sched, bool ALIGN_EPI, bool GATHER>
__device__ __forceinline__ void gemm_phase(PG8_LAS unsigned char* lds, const Gemm g, const Sched& S, const Epi& E) {
    int tid_ = threadIdx.x; asm volatile("" : "+v"(tid_));
    const int tid = tid_, wid = __builtin_amdgcn_readfirstlane(tid >> 6), lane = tid & 63, wr = wid >> 2, wc = wid & 3, fr = lane & 15, fq = lane >> 4;
    const int K = g.K, nt = K / BK;
    unsigned vA0[2], vA1[2], wA0[2], wA1[2], voffB[2];
    const size_t kstep = (size_t)(BK * 2);
    const size_t hstep = (size_t)HALF * K * 2;
    const size_t tstep = 2 * hstep;
#pragma unroll
    for (int i = 0; i < 2; ++i) { int R, C; stage_rc(tid * 16 + i * 8192, R, C); const int Rb = Epi::PERM ? ((R & ~31) + perm32(R & 31)) : R;
        vA0[i] = (unsigned)(R * K + C) * 2u; vA1[i] = vA0[i] + (unsigned)hstep; voffB[i] = (unsigned)(Rb * K + C) * 2u; wA0[i] = vA0[i]; wA1[i] = vA1[i]; }
    const unsigned ldsw = (unsigned)wid * 1024u;
    const int aoff = lds_byte(wr * 64 + fr, fq * 8), boff = lds_byte(wc * 32 + fr, fq * 8);
#define PG8_SA(b, h) (((b) * 2 + (h)) * HTB)
#define PG8_SB(b, h) ((4 + (b) * 2 + (h)) * HTB)
#define PG8_STAGE(bufoff, gbase, voff) do { _Pragma("unroll") for (int _i = 0; _i < 2; ++_i) \
        __builtin_amdgcn_global_load_lds((const unsigned*)((const char*)(gbase) + (voff)[_i]), (PG8_LAS unsigned*)(lds + (bufoff) + ldsw + _i * 8192), 16, 0, 0); } while (0)
#define PG8_LDA(dst, b, h) do { _Pragma("unroll") for (int m = 0; m < 4; ++m) _Pragma("unroll") for (int k = 0; k < 2; ++k) dst[m][k] = *(const PG8_LAS bf16x8*)(lds + PG8_SA(b, h) + aoff + m * 2048 + k * 1024); } while (0)
#define PG8_LDB(dst, b, h) do { _Pragma("unroll") for (int n = 0; n < 2; ++n) _Pragma("unroll") for (int k = 0; k < 2; ++k) dst[n][k] = *(const PG8_LAS bf16x8*)(lds + PG8_SB(b, h) + boff + n * 2048 + k * 1024); } while (0)
#define PG8_MMA(ai, bj, At, Bt) do { __builtin_amdgcn_s_setprio(1); _Pragma("unroll") for (int m = 0; m < 4; ++m) _Pragma("unroll") for (int n = 0; n < 2; ++n) _Pragma("unroll") for (int k = 0; k < 2; ++k) \
        acc[ai][bj][m][n] = __builtin_amdgcn_mfma_f32_16x16x32_bf16(Bt[n][k], At[m][k], acc[ai][bj][m][n], 0, 0, 0); __builtin_amdgcn_s_setprio(0); } while (0)
#define PG8_WAIT_V(n) asm volatile("s_waitcnt vmcnt(" #n ")" ::: "memory")
#define PG8_WAIT_L(n) asm volatile("s_waitcnt lgkmcnt(" #n ")" ::: "memory")
#define PG8_BAR __builtin_amdgcn_s_barrier()
#define PG8_SCHED __builtin_amdgcn_sched_barrier(0)
    Unit cur, nxt; int ui = 0;
    if (!S.next(0, cur)) return;
    f32x4 acc[2][2][4][2];
#pragma unroll
    for (int a = 0; a < 2; ++a)
#pragma unroll
        for (int b = 0; b < 2; ++b)
#pragma unroll
            for (int m = 0; m < 4; ++m)
#pragma unroll
                for (int n = 0; n < 2; ++n) acc[a][b][m][n] = (f32x4){0.f, 0.f, 0.f, 0.f};
    bf16x8 At[4][2], B0[2][2], B1[2][2];
    const char* cA = GATHER ? (const char*)g.A : (const char*)g.A + (size_t)cur.pm * tstep; const char* cB = (const char*)g.Bt + (size_t)cur.pn * tstep;
    if constexpr (GATHER) gather_voffs(S, 0, tid, K, vA0, vA1);
    PG8_STAGE(PG8_SB(0, 0), cB, voffB); PG8_STAGE(PG8_SB(0, 1), cB + hstep, voffB); PG8_STAGE(PG8_SA(0, 0), cA, vA0); PG8_STAGE(PG8_SA(0, 1), cA, vA1);
    if (wr == 1) PG8_BAR;
    PG8_WAIT_V(2); PG8_BAR;
    PG8_STAGE(PG8_SB(1, 0), cB + kstep, voffB); PG8_STAGE(PG8_SA(1, 0), cA + kstep, vA0); PG8_STAGE(PG8_SB(1, 1), cB + hstep + kstep, voffB);
    PG8_WAIT_V(6); PG8_BAR;
    for (;;) {
        const bool has_next = S.next(ui + 1, nxt);
        const char* nA = GATHER ? cA : (has_next ? (const char*)g.A + (size_t)nxt.pm * tstep : cA); const char* nB = has_next ? (const char*)g.Bt + (size_t)nxt.pn * tstep : cB;
        if constexpr (GATHER) { if (has_next) gather_voffs(S, ui + 1, tid, K, wA0, wA1); else { wA0[0] = vA0[0]; wA0[1] = vA0[1]; wA1[0] = vA1[0]; wA1[1] = vA1[1]; } }
        for (int t = 0; t < nt; t += 2) {
            const bool last = (t == nt - 2);
            const char* a1 = cA + (size_t)(t + 1) * kstep;
            const char* a2 = last ? nA : cA + (size_t)(t + 2) * kstep; const char* b2 = last ? nB : cB + (size_t)(t + 2) * kstep;
            const char* a3 = a2 + kstep; const char* b3 = b2 + kstep;
            unsigned sA0[2], sA1[2];
#pragma unroll
            for (int i = 0; i < 2; ++i) { sA0[i] = (GATHER && last) ? wA0[i] : vA0[i]; sA1[i] = (GATHER && last) ? wA1[i] : vA1[i]; }
            if constexpr (Epi::MIDK) { if (t == nt / 2) E.midk(acc, wr, fr); }
            PG8_LDB(B0, 0, 0); PG8_LDB(B1, 0, 1); PG8_SCHED; PG8_LDA(At, 0, 0); PG8_STAGE(PG8_SA(1, 1), a1, vA1);
            PG8_WAIT_V(8); PG8_WAIT_L(0); PG8_BAR; PG8_MMA(0, 0, At, B0); PG8_MMA(0, 1, At, B1); PG8_BAR; PG8_SCHED;
            PG8_LDA(At, 0, 1); PG8_STAGE(PG8_SB(0, 0), b2, voffB); PG8_STAGE(PG8_SB(0, 1), b2 + hstep, voffB); PG8_STAGE(PG8_SA(0, 0), a2, sA0);
            PG8_WAIT_V(8); PG8_WAIT_L(0); PG8_BAR; PG8_MMA(1, 0, At, B0); PG8_MMA(1, 1, At, B1); PG8_BAR; PG8_SCHED;
            PG8_LDB(B0, 1, 0); PG8_LDB(B1, 1, 1); PG8_SCHED; PG8_LDA(At, 1, 0); PG8_STAGE(PG8_SA(0, 1), a2, sA1);
            PG8_WAIT_V(8); PG8_WAIT_L(0); PG8_BAR; PG8_MMA(0, 0, At, B0); PG8_MMA(0, 1, At, B1); PG8_BAR; PG8_SCHED;
            PG8_LDA(At, 1, 1); PG8_STAGE(PG8_SB(1, 0), b3, voffB); PG8_STAGE(PG8_SB(1, 1), b3 + hstep, voffB); PG8_STAGE(PG8_SA(1, 0), a3, sA0);
            PG8_WAIT_V(8); PG8_WAIT_L(0); PG8_BAR; PG8_MMA(1, 0, At, B0); PG8_MMA(1, 1, At, B1); PG8_BAR; PG8_SCHED;
        }
        if constexpr (ALIGN_EPI) { if (wr == 0) PG8_BAR; }
        E(acc, cur, ui, wr, wc, fr, fq);
        if (!has_next) break;
#pragma unroll
        for (int a = 0; a < 2; ++a)
#pragma unroll
            for (int b = 0; b < 2; ++b)
#pragma unroll
                for (int m = 0; m < 4; ++m)
#pragma unroll
                    for (int n = 0; n < 2; ++n) acc[a][b][m][n] = (f32x4){0.f, 0.f, 0.f, 0.f};
        cur = nxt; cA = nA; cB = nB; ++ui;
        if constexpr (GATHER) { vA0[0] = wA0[0]; vA0[1] = wA0[1]; vA1[0] = wA1[0]; vA1[1] = wA1[1]; }
        if constexpr (ALIGN_EPI) { if (wr == 1) PG8_BAR; }
    }
    PG8_WAIT_V(0);
    if constexpr (!ALIGN_EPI) { if (wr == 0) PG8_BAR; }
    PG8_BAR;
#undef PG8_SA
#undef PG8_SB
#undef PG8_STAGE
#undef PG8_LDA
#undef PG8_LDB
#undef PG8_MMA
#undef PG8_WAIT_V
#undef PG8_WAIT_L
#undef PG8_BAR
#undef PG8_SCHED
}

struct EpiProj {
    static constexpr bool PERM = true, MIDK = false;
    bf16_t* O;
    __device__ __forceinline__ void operator()(const f32x4 (&acc)[2][2][4][2], const Unit& u, int, int wr, int wc, int fr, int fq) const {
        const int row0 = u.pm * BM + wr * 64 + fr, col0 = u.pn * BM + wc * 32 + 8 * fq;
        const float sc = (u.pn < 2 || (u.pn >= 6 && u.pn < 8)) ? C2 : 1.f;
#pragma unroll
        for (int ai = 0; ai < 2; ++ai)
#pragma unroll
            for (int m = 0; m < 4; ++m) { bf16_t* rowp = O + (size_t)(row0 + ai * HALF + m * 16) * NPROJ + col0;
#pragma unroll
                for (int bj = 0; bj < 2; ++bj) { const f32x4 v0 = acc[ai][bj][m][0] * sc, v1 = acc[ai][bj][m][1] * sc;
                    u32x4 w; w.x = cvt_pk_bf16(v0[0], v0[1]); w.y = cvt_pk_bf16(v0[2], v0[3]); w.z = cvt_pk_bf16(v1[0], v1[1]); w.w = cvt_pk_bf16(v1[2], v1[3]);
                    *(u32x4*)(rowp + bj * HALF) = w; } }
    }
};
struct EpiWout {
    static constexpr bool PERM = false, MIDK = true;
    const float* x; float* X1; bf16_t* X1B; const PG8_LAS float* ratio; const PG8_LAS float* rs;
    __device__ __forceinline__ void midk(f32x4 (&acc)[2][2][4][2], int wr, int fr) const {
#pragma unroll
        for (int ai = 0; ai < 2; ++ai)
#pragma unroll
            for (int m = 0; m < 4; ++m) { const float f = ratio[ai * HALF + wr * 64 + m * 16 + fr];
#pragma unroll
                for (int bj = 0; bj < 2; ++bj)
#pragma unroll
                    for (int n = 0; n < 2; ++n) acc[ai][bj][m][n] *= f; }
    }
    __device__ __forceinline__ void operator()(const f32x4 (&acc)[2][2][4][2], const Unit& u, int, int wr, int wc, int fr, int fq) const {
        const int col0 = u.pn * BM + wc * 32 + 4 * fq;
#pragma unroll
        for (int ai = 0; ai < 2; ++ai)
#pragma unroll
            for (int m = 0; m < 4; ++m) { const int r = ai * HALF + wr * 64 + m * 16 + fr; const float s = rs[r]; const size_t off = (size_t)(u.pm * BM + r) * DM + col0;
#pragma unroll
                for (int bj = 0; bj < 2; ++bj)
#pragma unroll
                    for (int n = 0; n < 2; ++n) { const f32x4 xv = *(const f32x4*)(x + off + bj * HALF + n * 16); const f32x4 o = xv + acc[ai][bj][m][n] * s;
                        *(f32x4*)(X1 + off + bj * HALF + n * 16) = o; u32x2 w; w.x = cvt_pk_bf16(o[0], o[1]); w.y = cvt_pk_bf16(o[2], o[3]); *(u32x2*)(X1B + off + bj * HALF + n * 16) = w; }
                asm volatile("" ::: "memory"); }
    }
};
constexpr int MOE_MAXU = 9;
struct MoeOrder {
    int NT, c, U; const PG8_LAS int* tb; const PG8_LAS int* tabA;
    __device__ bool next(int i, Unit& u) const {
        if (i >= MOE_MAXU) return false;
        const int x = c & 7, j = c >> 3, q = U >> 3, rem = U & 7, start = x * q + (x < rem ? x : rem), size = q + (x < rem ? 1 : 0), li = i * 32 + j;
        if (li >= size) return false;
        const int f = start + li; int e = 0; while (f >= tb[e + 1] * NT) ++e;
        const int idx = f - tb[e] * NT, nte = tb[e + 1] - tb[e], pg = idx / (4 * nte), rem2 = idx - pg * 4 * nte;
        u.pm = tb[e] + (rem2 >> 2); u.pn = e * NT + pg * 4 + (rem2 & 3); return true;
    }
    __device__ __forceinline__ const PG8_LAS int* rowtab(int ui) const { return tabA + ui * 256; }
};
struct EpiMoe1 {
    static constexpr bool PERM = true, MIDK = false;
    bf16_t* H; const float* b1; const PG8_LAS float* rstab;
    __device__ __forceinline__ void operator()(const f32x4 (&acc)[2][2][4][2], const Unit& u, int ui, int wr, int wc, int fr, int fq) const {
        const int e = u.pn >> 3, pl = u.pn & 7, colA = pl * 128 + wc * 32 + 8 * fq;
        f32x4 bg[2], bl[2];
#pragma unroll
        for (int n = 0; n < 2; ++n) { bg[n] = *(const f32x4*)(b1 + (size_t)e * 2048 + colA + 4 * n); bl[n] = *(const f32x4*)(b1 + (size_t)e * 2048 + 1024 + colA + 4 * n); }
#pragma unroll
        for (int ai = 0; ai < 2; ++ai)
#pragma unroll
            for (int m = 0; m < 4; ++m) { const int r = ai * HALF + wr * 64 + m * 16 + fr; const float rs = rstab[ui * 256 + r];
                float a8[8];
#pragma unroll
                for (int n = 0; n < 2; ++n) { const f32x4 gv = acc[ai][0][m][n] * rs + bg[n], lv = acc[ai][1][m][n] * rs + bl[n];
#pragma unroll
                    for (int i = 0; i < 4; ++i) { const float gl = fminf(gv[i], 7.f), li = fminf(fmaxf(lv[i], -7.f), 7.f);
                        a8[4 * n + i] = gl * __builtin_amdgcn_rcpf(1.f + __builtin_amdgcn_exp2f(-1.702f * LOG2E * gl)) * (li + 1.f); } }
                u32x4 w; w.x = cvt_pk_bf16(a8[0], a8[1]); w.y = cvt_pk_bf16(a8[2], a8[3]); w.z = cvt_pk_bf16(a8[4], a8[5]); w.w = cvt_pk_bf16(a8[6], a8[7]);
                *(u32x4*)(H + (size_t)(u.pm * BM + r) * DM + colA) = w; }
    }
};
struct EpiMoe2 {
    static constexpr bool PERM = true, MIDK = false;
    bf16_t* Y; const float* b2; const PG8_LAS int* slottab; const PG8_LAS float* wtab;
    __device__ __forceinline__ void operator()(const f32x4 (&acc)[2][2][4][2], const Unit& u, int ui, int wr, int wc, int fr, int fq) const {
        const int e = u.pn >> 2, pl = u.pn & 3, col0 = pl * BM + wc * 32 + 8 * fq;
        f32x4 bv[2][2];
#pragma unroll
        for (int bj = 0; bj < 2; ++bj)
#pragma unroll
            for (int n = 0; n < 2; ++n) bv[bj][n] = *(const f32x4*)(b2 + (size_t)e * DM + col0 + bj * HALF + 4 * n);
#pragma unroll
        for (int ai = 0; ai < 2; ++ai)
#pragma unroll
            for (int m = 0; m < 4; ++m) { const int r = ai * HALF + wr * 64 + m * 16 + fr; const int slot = slottab[ui * 256 + r]; const float wt = wtab[ui * 256 + r];
                if (slot >= 0) {
#pragma unroll
                    for (int bj = 0; bj < 2; ++bj) { const f32x4 v0 = (acc[ai][bj][m][0] + bv[bj][0]) * wt, v1 = (acc[ai][bj][m][1] + bv[bj][1]) * wt;
                        u32x4 w; w.x = cvt_pk_bf16(v0[0], v0[1]); w.y = cvt_pk_bf16(v0[2], v0[3]); w.z = cvt_pk_bf16(v1[0], v1[1]); w.w = cvt_pk_bf16(v1[2], v1[3]);
                        *(u32x4*)(Y + (size_t)slot * DM + col0 + bj * HALF) = w; } } }
    }
};
}

__global__ void __launch_bounds__(NTHREADS, 2) mega_fwd(Args a) {
    extern __shared__ __attribute__((aligned(16))) unsigned char lds[];
    LAS unsigned char* L = (LAS unsigned char*)lds;
    volatile LAS unsigned* MISC = (volatile LAS unsigned*)(L + MISC_OFF);
    const int tid = threadIdx.x, lane = tid & 63, wave = __builtin_amdgcn_readfirstlane(tid >> 6);
    const int G = gridDim.x, bx = blockIdx.x, vcu = (G % 8 == 0) ? (bx % 8) * (G / 8) + bx / 8 : bx;
    const int gw = vcu * NWAVES + wave, NGW = G * NWAVES;
    unsigned char* ws = a.ws;
    unsigned* CTL = (unsigned*)(ws + WS_CTL);
    bf16_t* WINT = (bf16_t*)(ws + WS_WINT); bf16_t* WOUTT = (bf16_t*)(ws + WS_WOUTT); float* WR = (float*)(ws + WS_WR); float* CUM = (float*)(ws + WS_CUM);
    float* SSQ = (float*)(ws + WS_SSQ); float* RSTD2 = (float*)(ws + WS_RSTD2); float* RW = (float*)(ws + WS_RW); int* LIST = (int*)(ws + WS_LIST); float* FLOG = (float*)(ws + WS_FLOG);
    bf16_t* XN = (bf16_t*)(ws + WS_XN); bf16_t* PROJ = (bf16_t*)(ws + WS_PROJ); bf16_t* OMIX = (bf16_t*)(ws + WS_OMIX); bf16_t* X1B = (bf16_t*)(ws + WS_X1B);
    bf16_t* W1T = (bf16_t*)(ws + WS_W1T); bf16_t* W2T = (bf16_t*)(ws + WS_W2T); bf16_t* H = (bf16_t*)(ws + WS_H); bf16_t* Y = (bf16_t*)(ws + WS_Y);
    unsigned* CNT = CTL + CW_CNT;
    for (int u = tid; u < (LDS_BYTES - LDSCTL_OFF) / 4; u += NTHREADS) ((LAS unsigned*)(L + LDSCTL_OFF))[u] = 0u;
    __syncthreads();
    XcdBarrier bar = xcd_barrier_post(CTL + CW_BAR, MISC + 8);

    {
        LAS float* scr = (LAS float*)(L + RING_OFF + wave * 16384);
        constexpr int I_IN = (DM / 64) * (NPROJ / 32), I_OUT = (DM / 64) * (DM / 32), I_W1 = (DM / 64) * (2048 / 32), I_W2 = (DM / 64) * (DM / 32);
        constexpr int NITEMS = I_IN + I_OUT + NE * I_W1 + NE * I_W2;
        for (int it = gw; it < NITEMS; it += NGW) {
            int r = it;
            if (r < I_IN) { transpose_item(a.w_in, DM, WIN_N, NPROJ, 1, a.g1, nullptr, DM, WINT, scr, r, lane); continue; } r -= I_IN;
            if (r < I_OUT) { transpose_item(a.w_out, DM, DM, DM, 0, a.g_fox, a.g_sb, GW, WOUTT, scr, r, lane); continue; } r -= I_OUT;
            if (r < NE * I_W1) { const int e = r / I_W1; transpose_item(a.w1 + (size_t)e * DM * 2048, DM, 2048, 2048, 2, a.g2, nullptr, DM, W1T + (size_t)e * 2048 * DM, scr, r % I_W1, lane); continue; } r -= NE * I_W1;
            { const int e = r / I_W2; transpose_item(a.w2 + (size_t)e * DM * DM, DM, DM, DM, 0, nullptr, nullptr, DM, W2T + (size_t)e * DM * DM, scr, r % I_W2, lane); }
        }
        for (int i = gw * 64 + lane; i < DM * NE; i += NGW * 64) WR[i] = a.w_router[i] * a.g2[i >> 5];
        for (int row = gw; row < M; row += NGW) rms1_row(a.x, a.g1, a.w_in, a.b_f, XN, FLOG, row, lane);
    }
    xcd_barrier(bar);
    if (vcu < NB * NH) cumsum_wg(FLOG, CUM, vcu, (LAS float*)(L + RING_OFF));
    if (OPT_GEMM) {
        pg8::Gemm g{XN, WINT, DM}; pg8::StaticOrder S; S.init(M, NPROJ, G, bx); pg8::EpiProj E{PROJ};
        pg8::gemm_phase<pg8::EpiProj, pg8::StaticOrder, true, false>(L + RING_OFF, g, S, E);
    } else { for (int it = gw; it < (M / 16) * (NPROJ / 64); it += NGW) nv_inproj(XN, WINT, PROJ, it, lane); }
    xcd_barrier(bar);
    {
        LAS unsigned char* wl = L + RING_OFF + wave * 16640;
        for (int u = gw; u < 4096; u += NGW) {
            const int i = u >> 11, idx = u & 2047, type = idx & 1, bh = (idx >> 1) & 31, j = (idx >> 6) & 31; const int qblk = (i == 0) ? j : 63 - j;
            if (type == 0) nv_attn<0>(PROJ, CUM, OMIX, SSQ, bh, qblk, lane, wl); else nv_attn<1>(PROJ, CUM, OMIX, SSQ, bh, qblk, lane, wl);
        }
    }
    xcd_barrier(bar);
    if (OPT_GEMM) {
        pg8::Gemm g{OMIX, WOUTT, DM}; pg8::StaticOrder S; S.init(M, DM, G, bx);
        LAS float* ratio = (LAS float*)(L + TAB_OFF); LAS float* rsb = (LAS float*)(L + TAB_OFF + 1024);
        pg8::Unit u0;
        if (S.next(0, u0) && tid < 256) { const float* sp = SSQ + (size_t)(u0.pm * 256 + tid) * 16; float sf = 0.f, s2 = 0.f;
#pragma unroll
            for (int h = 0; h < 8; ++h) { sf += sp[h]; s2 += sp[8 + h]; }
            const float rf = rsqrtf(sf * (1.f / GW) + EPS), rs = rsqrtf(s2 * (1.f / GW) + EPS); ratio[tid] = rf / rs; rsb[tid] = rs; }
        VM_WAIT(); LDS_WAIT(); __syncthreads();
        pg8::EpiWout E{a.x, a.out, X1B, ratio, rsb};
        pg8::gemm_phase<pg8::EpiWout, pg8::StaticOrder, false, false>(L + RING_OFF, g, S, E);
    } else { for (int it = gw; it < (M / 16) * (DM / 64); it += NGW) nv_wout(OMIX, WOUTT, SSQ, a.x, a.out, X1B, it, lane); }
    xcd_barrier(bar);
    for (int it = gw; it < M / 2; it += NGW) nv_router(a.out, WR, a.b_router, RSTD2, RW, LIST, CNT, it, lane);
    xcd_barrier(bar);
    LAS int* tb = (LAS int*)(L + TB_OFF); LAS int* tabA = (LAS int*)(L + TAB_OFF); LAS int* tabB = (LAS int*)(L + TAB2_OFF);
    if (OPT_GEMM) {
        if (tid == 0) { int run = 0; for (int e = 0; e < NE; ++e) { tb[e] = run; run += ((int)CNT[e] + 255) >> 8; } tb[NE] = run; }
        __syncthreads();
        pg8::MoeOrder S{8, bx, tb[NE] * 8, tb, tabA}; pg8::Unit u;
        for (int ui = 0; S.next(ui, u); ++ui) { const int e = u.pn >> 3, mt = u.pm - tb[e], cnt = (int)CNT[e];
            if (tid < 256) { const int p = mt * 256 + tid; const int slot = LIST[(size_t)e * LIST_CAP + (p < cnt ? p : cnt - 1)]; tabA[ui * 256 + tid] = slot >> 2; ((LAS float*)tabB)[ui * 256 + tid] = RSTD2[slot >> 2]; } }
        VM_WAIT(); LDS_WAIT(); __syncthreads();
        pg8::Gemm g{X1B, W1T, DM}; pg8::EpiMoe1 E{H, a.b1, (const LAS float*)tabB};
        pg8::gemm_phase<pg8::EpiMoe1, pg8::MoeOrder, true, true>(L + RING_OFF, g, S, E);
    } else {
    for (int g = gw; g < MAX_TILES * 16; g += NGW) {
        int e, base, p0, cnt; if (!moe_tile(CNT, g, e, base, p0, cnt)) continue;
        for (int cg = 0; cg < DFF / 32; ++cg) nv_moe1(X1B, W1T, a.b1, RSTD2, LIST, H, e, base, p0, cnt, cg, lane);
    } }
    xcd_barrier(bar);
    if (OPT_GEMM) {
        pg8::MoeOrder S{4, bx, tb[NE] * 4, tb, tabA}; pg8::Unit u;
        for (int ui = 0; S.next(ui, u); ++ui) { const int e = u.pn >> 2, mt = u.pm - tb[e], cnt = (int)CNT[e];
            if (tid < 256) { const int p = mt * 256 + tid; const int slot = LIST[(size_t)e * LIST_CAP + (p < cnt ? p : cnt - 1)]; tabA[ui * 256 + tid] = p < cnt ? slot : -1; ((LAS float*)tabB)[ui * 256 + tid] = RW[slot]; } }
        VM_WAIT(); LDS_WAIT(); __syncthreads();
        pg8::Gemm g{H, W2T, DM}; pg8::EpiMoe2 E{Y, a.b2, tabA, (const LAS float*)tabB};
        pg8::gemm_phase<pg8::EpiMoe2, pg8::MoeOrder, true, false>(L + RING_OFF, g, S, E);
    } else {
    for (int g = gw; g < MAX_TILES * 16; g += NGW) {
        int e, base, p0, cnt; if (!moe_tile(CNT, g, e, base, p0, cnt)) continue;
        for (int cg = 0; cg < DM / 64; ++cg) nv_moe2(H, W2T, a.b2, RW, LIST, Y, e, base, p0, cnt, cg, lane);
    } }
    xcd_barrier(bar);
    for (int row = gw; row < M; row += NGW) final_row(a.out, Y, a.gf, a.out, row, lane);
}

extern "C" void kernel_launch(void* const* d_in, const int* in_sizes, int n_in, void* d_out, int out_size, void* d_ws, size_t ws_size, hipStream_t stream) {
    static int grid = 0;
    if (grid == 0) {
        if (n_in != 15 || in_sizes[0] != M * DM || out_size != M * DM || ws_size < WS_END) {
            fprintf(stderr, "kernel_launch: unexpected shapes / workspace (n_in %d, in0 %d, out %d, ws %zu, need %zu)\n", n_in, n_in > 0 ? in_sizes[0] : -1, out_size, ws_size, (size_t)WS_END); grid = -1; return; }
        int dev = 0, cus = 0, per_cu = 0;
        if (hipGetDevice(&dev) != hipSuccess || hipDeviceGetAttribute(&cus, hipDeviceAttributeMultiprocessorCount, dev) != hipSuccess) { grid = -1; return; }
        if (hipFuncSetAttribute((const void*)mega_fwd, hipFuncAttributeMaxDynamicSharedMemorySize, LDS_BYTES) != hipSuccess) { fprintf(stderr, "kernel_launch: hipFuncSetAttribute failed\n"); grid = -1; return; }
        if (hipOccupancyMaxActiveBlocksPerMultiprocessor(&per_cu, (const void*)mega_fwd, NTHREADS, LDS_BYTES) != hipSuccess || per_cu < 1) fprintf(stderr, "kernel_launch: occupancy query reports %d\n", per_cu);
        (void)hipGetLastError();
        grid = cus;
    }
    if (grid < 0) return;
    if (hipMemsetAsync((char*)d_ws + WS_CTL, 0, CTL_BYTES, stream) != hipSuccess) return;
    Args a{};
    a.x = (const float*)d_in[0]; a.g1 = (const float*)d_in[1]; a.w_in = (const float*)d_in[2]; a.b_f = (const float*)d_in[3]; a.g_fox = (const float*)d_in[4]; a.g_sb = (const float*)d_in[5];
    a.w_out = (const float*)d_in[6]; a.g2 = (const float*)d_in[7]; a.w_router = (const float*)d_in[8]; a.b_router = (const float*)d_in[9]; a.w1 = (const float*)d_in[10]; a.b1 = (const float*)d_in[11];
    a.w2 = (const float*)d_in[12]; a.b2 = (const float*)d_in[13]; a.gf = (const float*)d_in[14];
    a.out = (float*)d_out; a.ws = (unsigned char*)d_ws;
    hipLaunchKernelGGL(mega_fwd, dim3(grid), dim3(NTHREADS), LDS_BYTES, stream, a);
    const hipError_t le = hipPeekAtLastError();
    if (le != hipSuccess) fprintf(stderr, "kernel_launch: launch failed: %s\n", hipGetErrorName(le));
}
```

```cpp
#include <hip/hip_runtime.h>
#include <cstdio>
#include <cstdint>

typedef unsigned short bf16_t;
typedef short bf16x8 __attribute__((ext_vector_type(8)));
typedef float f32x4 __attribute__((ext_vector_type(4)));

constexpr int NB = 4, SEQ = 4096, DM = 1024, M = NB * SEQ;
constexpr int NH = 8, HD = 64, GW = 512;
constexpr int WIN_N = 3080, NPROJ = 3072;
constexpr int NE = 32, TOPK = 4, DFF = 1024;
constexpr float EPS = 1e-5f;
constexpr float LOG2E = 1.4426950408889634f;
constexpr float C2 = 0.125f * LOG2E;
constexpr int LIST_CAP = M;
constexpr int MAX_TILES = (M * TOPK) / 256 + NE;

constexpr size_t MiB = 1u << 20;
constexpr size_t WS_CTL = 0, CTL_BYTES = 1 * MiB;
constexpr size_t WS_WINT = 2 * MiB;
constexpr size_t WS_WOUTT = 8 * MiB;
constexpr size_t WS_WR = 10 * MiB;
constexpr size_t WS_CUM = 11 * MiB;
constexpr size_t WS_SSQ = 12 * MiB;
constexpr size_t WS_RSTD2 = 14 * MiB;
constexpr size_t WS_RW = 15 * MiB;
constexpr size_t WS_LIST = 16 * MiB;
constexpr size_t WS_FLOG = 18 * MiB;
constexpr size_t WS_XN = 32 * MiB;
constexpr size_t WS_PROJ = 64 * MiB;
constexpr size_t WS_OMIX = 160 * MiB;
constexpr size_t WS_X1B = 192 * MiB;
constexpr size_t WS_W1T = 224 * MiB;
constexpr size_t WS_W2T = 352 * MiB;
constexpr size_t WS_H = 416 * MiB;
constexpr size_t WS_Y = 560 * MiB;
constexpr size_t WS_END = 688 * MiB;
constexpr int CW_CNT = 1024;

__device__ __forceinline__ unsigned short f2bf(float f) { unsigned u = __float_as_uint(f); return (unsigned short)((u + 0x7fffu + ((u >> 16) & 1u)) >> 16); }
__device__ __forceinline__ float bf2f(unsigned short b) { return __uint_as_float(((unsigned)b) << 16); }
__device__ __forceinline__ float wave_sum(float v) {
#pragma unroll
    for (int o = 1; o < 64; o <<= 1) v += __shfl_xor(v, o);
    return v;
}


#define LAS __attribute__((address_space(3)))
#define GAS __attribute__((address_space(1)))
typedef unsigned v4u __attribute__((ext_vector_type(4)));
#define LDS_WAIT() asm volatile("s_waitcnt lgkmcnt(0)" ::: "memory")
#define VM_WAIT() asm volatile("s_waitcnt vmcnt(0)" ::: "memory")
constexpr int NWAVES = 8, NTHREADS = NWAVES * 64;
constexpr bool OPT_GEMM = true;
constexpr bool OPT_ATTN = true;

#define XB_TMO      128
#define XB_XCNT(j)  (256  + 64 * (j))
#define XB_XSUB(j)  (1280 + 64 * (j))
#define XB_XGEN(j)  (2304 + 64 * (j))
#define XB_TOP      3328
#define XB_TOPGEN   3392
#define XCD_BAR_WORDS 3456
#define XB_SPIN_CAP (1u << 20)
__device__ __forceinline__ unsigned xb_ld(unsigned* p)              { return __hip_atomic_load(p, __ATOMIC_RELAXED, __HIP_MEMORY_SCOPE_AGENT); }
__device__ __forceinline__ unsigned xb_add(unsigned* p, unsigned v) { return __hip_atomic_fetch_add(p, v, __ATOMIC_RELAXED, __HIP_MEMORY_SCOPE_AGENT); }
__device__ __forceinline__ unsigned xb_xcc_id() { return (unsigned)__builtin_amdgcn_s_getreg((3 << 11) | 20) & 0xFu; }
#define XB_SPIN(cond, bar) do { unsigned _sp = 0; while (cond) { __builtin_amdgcn_s_sleep(1); \
    if ((++_sp & 255u) == 0u) { if (xb_ld(&(bar)[XB_TMO])) break; if (_sp > XB_SPIN_CAP) { atomicAdd(&(bar)[XB_TMO], 1u); break; } } } } while (0)
struct XcdBarrier { unsigned* bar; unsigned x; volatile LAS unsigned* st; };
__device__ __forceinline__ XcdBarrier xcd_barrier_post(unsigned* bar, volatile LAS unsigned* st) {
    XcdBarrier b; b.bar = bar; b.x = xb_xcc_id(); b.st = st;
    if (threadIdx.x == 0) (void)xb_add(&bar[XB_XCNT(b.x)], 1u);
    return b;
}
__device__ __forceinline__ void xcd_barrier_complete(unsigned* bar, unsigned x, unsigned& nloc, unsigned& nx) {
    const unsigned G = gridDim.x * gridDim.y * gridDim.z;
    unsigned sum, cnt, mine, sp = 0u;
    for (;;) {
        sum = 0u; cnt = 0u; mine = 0u;
#pragma unroll
        for (unsigned j = 0; j < 16; ++j) { const unsigned c = xb_ld(&bar[XB_XCNT(j)]); sum += c; cnt += (c > 0u) ? 1u : 0u; mine = (j == x) ? c : mine; }
        if (sum == G) break;
        __builtin_amdgcn_s_sleep(1);
        if ((++sp & 255u) == 0u) { if (xb_ld(&bar[XB_TMO])) break; if (sp > XB_SPIN_CAP) { atomicAdd(&bar[XB_TMO], 1u); break; } }
    }
    nloc = mine > 0u ? mine : 1u; nx = cnt > 0u ? cnt : 1u;
}
__device__ __forceinline__ void xcd_barrier(const XcdBarrier& b) {
    asm volatile("s_waitcnt vmcnt(0)" ::: "memory");
    __syncthreads();
    if (threadIdx.x == 0) {
        unsigned* bar = b.bar;
        __builtin_amdgcn_s_waitcnt(0);
        unsigned nloc = b.st[0], nx = b.st[1];
        if (nloc == 0u) { xcd_barrier_complete(bar, b.x, nloc, nx); b.st[0] = nloc; b.st[1] = nx; }
        const unsigned old = xb_add(&bar[XB_XSUB(b.x)], 1u);
        const unsigned gen = old / nloc;
        if (old + 1u == (gen + 1u) * nloc) {
            __builtin_amdgcn_fence(__ATOMIC_RELEASE, "agent");
            asm volatile("s_waitcnt vmcnt(0)" ::: "memory");
            const unsigned og = xb_add(&bar[XB_TOP], 1u);
            const unsigned tg = og / nx;
            if (og + 1u == (tg + 1u) * nx) xb_add(&bar[XB_TOPGEN], 1u);
            else XB_SPIN(xb_ld(&bar[XB_TOPGEN]) == tg, bar);
            __builtin_amdgcn_fence(__ATOMIC_ACQUIRE, "agent");
            xb_add(&bar[XB_XGEN(b.x)], 1u);
            asm volatile("s_waitcnt vmcnt(0)" ::: "memory");
        } else {
            XB_SPIN(xb_ld(&bar[XB_XGEN(b.x)]) == gen, bar);
            __builtin_amdgcn_fence(__ATOMIC_ACQUIRE, "agent");
            asm volatile("s_waitcnt vmcnt(0)" ::: "memory");
        }
    }
    __syncthreads();
}

constexpr int RING_OFF = 0, RING_BYTES = 131072;
constexpr int TAB_OFF = 131072;
constexpr int TAB2_OFF = TAB_OFF + 9 * 1024, TB_OFF = TAB_OFF + 18 * 1024;
constexpr int LDSCTL_OFF = 150528, MISC_OFF = LDSCTL_OFF + 320;
constexpr int LDS_BYTES = 155648;
constexpr int CW_BAR = 4096;

struct Args {
    const float *x, *g1, *w_in, *b_f, *g_fox, *g_sb, *w_out, *g2, *w_router, *b_router, *w1, *b1, *w2, *b2, *gf;
    float* out; unsigned char* ws;
};

__device__ __forceinline__ int mapcol(int mode, int n) {
    if (mode == 1) return n < 1536 ? n : n + 8;
    if (mode == 2) { const int pn = n >> 8, j = n & 255; return j < 128 ? 128 * pn + j : 1024 + 128 * pn + (j - 128); }
    return n;
}
__device__ __forceinline__ unsigned pk2(float lo, float hi) { return (unsigned)f2bf(lo) | ((unsigned)f2bf(hi) << 16); }
__device__ __forceinline__ void transpose_item(const float* __restrict__ W, int K, int Nin, int Nout, int mode, const float* __restrict__ gA, const float* __restrict__ gB, int gsplit,
                                               bf16_t* __restrict__ WT, LAS float* scr, int item, int lane) {
    const int nblk = Nout / 32, kb = item / nblk, nb = item % nblk, k0 = 64 * kb, n0 = 32 * nb;
    const int col = mapcol(mode, n0 + (lane & 31));
#pragma unroll 8
    for (int i = 0; i < 32; ++i) { const int kk = 2 * i + (lane >> 5), k = k0 + kk; const float gs = gA ? (k < gsplit ? gA[k] : gB[k - gsplit]) : 1.f;
        scr[kk * 33 + (lane & 31)] = W[(size_t)k * Nin + col] * gs; }
    LDS_WAIT();
    const int c = lane & 7;
#pragma unroll
    for (int j = 0; j < 4; ++j) { const int n = (lane >> 3) + 8 * j; const LAS float* sp = scr + (8 * c) * 33 + n;
        v4u o; o.x = pk2(sp[0 * 33], sp[1 * 33]); o.y = pk2(sp[2 * 33], sp[3 * 33]); o.z = pk2(sp[4 * 33], sp[5 * 33]); o.w = pk2(sp[6 * 33], sp[7 * 33]);
        *(v4u*)(WT + (size_t)(n0 + n) * K + k0 + 8 * c) = o; }
    LDS_WAIT();
}

__device__ __forceinline__ float log_sigmoid(float v) { return fminf(v, 0.f) - log1pf(expf(-fabsf(v))); }
__device__ __forceinline__ void rms1_row(const float* __restrict__ x, const float* __restrict__ g1, const float* __restrict__ w_in, const float* __restrict__ b_f,
                                         bf16_t* __restrict__ XN, float* __restrict__ FLOG, int row, int lane) {
    const float4* xr = (const float4*)(x + (size_t)row * DM);
    float4 v[4]; float ss = 0.f;
#pragma unroll
    for (int j = 0; j < 4; ++j) { v[j] = xr[lane + 64 * j]; ss += v[j].x * v[j].x + v[j].y * v[j].y + v[j].z * v[j].z + v[j].w * v[j].w; }
    ss = wave_sum(ss);
    const float rstd = rsqrtf(ss * (1.f / DM) + EPS);
    float f0 = 0.f, f1 = 0.f, f2 = 0.f, f3 = 0.f, f4 = 0.f, f5 = 0.f, f6 = 0.f, f7 = 0.f;
#pragma unroll
    for (int j = 0; j < 4; ++j) {
        const int c0 = 4 * (lane + 64 * j);
        uint2 o; o.x = pk2(v[j].x * rstd, v[j].y * rstd); o.y = pk2(v[j].z * rstd, v[j].w * rstd);
        *(uint2*)(XN + (size_t)row * DM + c0) = o;
        const float xs[4] = {v[j].x, v[j].y, v[j].z, v[j].w};
#pragma unroll
        for (int c = 0; c < 4; ++c) {
            const int k = c0 + c; const float xv = xs[c] * g1[k];
            const float4* wp = (const float4*)(w_in + (size_t)k * WIN_N + 1536); const float4 w0 = wp[0], w1 = wp[1];
            f0 += xv * w0.x; f1 += xv * w0.y; f2 += xv * w0.z; f3 += xv * w0.w; f4 += xv * w1.x; f5 += xv * w1.y; f6 += xv * w1.z; f7 += xv * w1.w;
        }
    }
    f0 = wave_sum(f0); f1 = wave_sum(f1); f2 = wave_sum(f2); f3 = wave_sum(f3); f4 = wave_sum(f4); f5 = wave_sum(f5); f6 = wave_sum(f6); f7 = wave_sum(f7);
    if (lane < 8) {
        float f = f0; f = lane == 1 ? f1 : f; f = lane == 2 ? f2 : f; f = lane == 3 ? f3 : f; f = lane == 4 ? f4 : f; f = lane == 5 ? f5 : f; f = lane == 6 ? f6 : f; f = lane == 7 ? f7 : f;
        FLOG[(size_t)row * 8 + lane] = log_sigmoid(f * rstd + b_f[lane]);
    }
}
__device__ __forceinline__ void cumsum_wg(const float* __restrict__ FLOG, float* __restrict__ CUM, int bh, LAS float* part) {
    const int b = bh >> 3, h = bh & 7, t = threadIdx.x;
    float loc[8]; float s = 0.f;
#pragma unroll
    for (int i = 0; i < 8; ++i) { loc[i] = FLOG[((size_t)b * SEQ + t * 8 + i) * 8 + h]; s += loc[i]; }
    part[t] = s; __syncthreads();
    float run = 0.f; for (int i = 0; i < t; ++i) run += part[i];
#pragma unroll
    for (int i = 0; i < 8; ++i) { run += loc[i]; CUM[(size_t)bh * SEQ + t * 8 + i] = run * LOG2E; }
    __syncthreads();
}

template <int NT> __device__ __forceinline__ void wave_mma(f32x4 (&acc)[NT], const bf16_t* ap, const bf16_t* const (&bp)[NT], int K) {
    for (int k0 = 0; k0 < K; k0 += 32) {
        const bf16x8 a = *(const bf16x8*)(ap + k0);
#pragma unroll
        for (int t = 0; t < NT; ++t) { const bf16x8 b = *(const bf16x8*)(bp[t] + k0); acc[t] = __builtin_amdgcn_mfma_f32_16x16x32_bf16(a, b, acc[t], 0, 0, 0); }
    }
}
__device__ __forceinline__ void nv_inproj(const bf16_t* __restrict__ XN, const bf16_t* __restrict__ WINT, bf16_t* __restrict__ PROJ, int item, int lane) {
    const int n0 = (item % 48) * 64, m0 = (item / 48) * 16, r = lane & 15, q = lane >> 4;
    f32x4 acc[4];
#pragma unroll
    for (int t = 0; t < 4; ++t) acc[t] = (f32x4){0.f, 0.f, 0.f, 0.f};
    const bf16_t* ap = XN + (size_t)(m0 + r) * DM + 8 * q;
    const bf16_t* bp[4];
#pragma unroll
    for (int t = 0; t < 4; ++t) bp[t] = WINT + (size_t)(n0 + 16 * t + r) * DM + 8 * q;
    wave_mma<4>(acc, ap, bp, DM);
    const float sc = (n0 < 512 || (n0 >= 1536 && n0 < 2048)) ? C2 : 1.f;
#pragma unroll
    for (int t = 0; t < 4; ++t)
#pragma unroll
        for (int j = 0; j < 4; ++j) PROJ[(size_t)(m0 + 4 * q + j) * NPROJ + n0 + 16 * t + r] = f2bf(acc[t][j] * sc);
}

template <int TYPE> __device__ __forceinline__ void nv_attn(const bf16_t* __restrict__ PROJ, const float* __restrict__ CUM, bf16_t* __restrict__ OMIX, float* __restrict__ SSQ,
                                                          int bh, int qblk, int lane, LAS unsigned char* wl) {
    LAS bf16_t* Ks = (LAS bf16_t*)wl; LAS bf16_t* Vs = (LAS bf16_t*)(wl + 8192); LAS float* Cs = (LAS float*)(wl + 16384);
    const int b = bh >> 3, h = bh & 7, t = qblk * 64 + lane;
    const size_t row = (size_t)b * SEQ + t;
    const int qcol = (TYPE == 0 ? 0 : 1536) + h * HD, kcol = qcol + 512, vcol = qcol + 1024;
    float q[64], o[64];
#pragma unroll
    for (int c = 0; c < 8; ++c) { const bf16x8 v = *(const bf16x8*)(PROJ + row * NPROJ + qcol + 8 * c);
#pragma unroll
        for (int j = 0; j < 8; ++j) q[8 * c + j] = bf2f((unsigned short)v[j]); }
#pragma unroll
    for (int d = 0; d < 64; ++d) o[d] = 0.f;
    float m = -INFINITY, l = 0.f, R = 1.f;
    const float cq = CUM[(size_t)bh * SEQ + t];
    for (int it = 0; it <= qblk; ++it) {
        const int kt = (TYPE == 0) ? it : qblk - it;
        LDS_WAIT();
        for (int i = 0; i < 64; ++i) { const size_t kr = ((size_t)b * SEQ + kt * 64 + i) * NPROJ; Ks[i * 64 + lane] = PROJ[kr + kcol + lane]; Vs[i * 64 + lane] = PROJ[kr + vcol + lane]; }
        Cs[lane] = CUM[(size_t)bh * SEQ + kt * 64 + lane];
        LDS_WAIT();
        for (int ss = 0; ss < 64; ++ss) {
            const int s = (TYPE == 0) ? ss : 63 - ss; const int ks = kt * 64 + s;
            float dot = 0.f;
#pragma unroll
            for (int d = 0; d < 64; d += 8) { const bf16x8 kv = *(const LAS bf16x8*)&Ks[s * 64 + d];
#pragma unroll
                for (int j = 0; j < 8; ++j) dot += q[d + j] * bf2f((unsigned short)kv[j]); }
            if (TYPE == 0) {
                if (ks <= t) {
                    const float xv = dot + cq - Cs[s]; const float mn = fmaxf(m, xv); const float sc = exp2f(m - mn), p = exp2f(xv - mn);
                    l = l * sc + p; m = mn;
#pragma unroll
                    for (int d = 0; d < 64; d += 8) { const bf16x8 vv = *(const LAS bf16x8*)&Vs[s * 64 + d];
#pragma unroll
                        for (int j = 0; j < 8; ++j) o[d + j] = o[d + j] * sc + p * bf2f((unsigned short)vv[j]); }
                }
            } else {
                if (ks < t) {
                    const float z = fminf(fmaxf(dot, -80.f), 80.f); const float e = exp2f(z); const float rr = 1.f / (1.f + e); const float a = e * rr * R; R *= rr;
#pragma unroll
                    for (int d = 0; d < 64; d += 8) { const bf16x8 vv = *(const LAS bf16x8*)&Vs[s * 64 + d];
#pragma unroll
                        for (int j = 0; j < 8; ++j) o[d + j] += a * bf2f((unsigned short)vv[j]); }
                }
            }
        }
    }
    const float inv = (TYPE == 0) ? 1.f / l : 1.f;
    float ssq = 0.f;
#pragma unroll
    for (int d = 0; d < 64; ++d) { o[d] *= inv; ssq += o[d] * o[d]; }
    SSQ[row * 16 + TYPE * 8 + h] = ssq;
#pragma unroll
    for (int c = 0; c < 8; ++c) { bf16x8 v;
#pragma unroll
        for (int j = 0; j < 8; ++j) v[j] = (short)f2bf(o[8 * c + j]);
        *(bf16x8*)(OMIX + row * DM + TYPE * GW + h * HD + 8 * c) = v; }
}

__device__ __forceinline__ void nv_wout(const bf16_t* __restrict__ OMIX, const bf16_t* __restrict__ WOUTT, const float* __restrict__ SSQ, const float* __restrict__ x,
                                        float* __restrict__ X1, bf16_t* __restrict__ X1B, int item, int lane) {
    const int n0 = (item & 15) * 64, m0 = (item >> 4) * 16, r = lane & 15, q = lane >> 4;
    f32x4 af[4], as[4];
#pragma unroll
    for (int t = 0; t < 4; ++t) { af[t] = (f32x4){0.f, 0.f, 0.f, 0.f}; as[t] = (f32x4){0.f, 0.f, 0.f, 0.f}; }
    const bf16_t* ap = OMIX + (size_t)(m0 + r) * DM + 8 * q;
    const bf16_t* bp[4]; const bf16_t* bp2[4];
#pragma unroll
    for (int t = 0; t < 4; ++t) { bp[t] = WOUTT + (size_t)(n0 + 16 * t + r) * DM + 8 * q; bp2[t] = bp[t] + GW; }
    wave_mma<4>(af, ap, bp, GW);
    wave_mma<4>(as, ap + GW, bp2, GW);
#pragma unroll
    for (int j = 0; j < 4; ++j) {
        const size_t row = m0 + 4 * q + j; const float* sp = SSQ + row * 16;
        float sf = 0.f, s2 = 0.f;
#pragma unroll
        for (int h = 0; h < 8; ++h) { sf += sp[h]; s2 += sp[8 + h]; }
        const float rf = rsqrtf(sf * (1.f / GW) + EPS), rs = rsqrtf(s2 * (1.f / GW) + EPS);
#pragma unroll
        for (int t = 0; t < 4; ++t) { const size_t idx = row * DM + n0 + 16 * t + r; const float v = x[idx] + rf * af[t][j] + rs * as[t][j]; X1[idx] = v; X1B[idx] = f2bf(v); }
    }
}

__device__ __forceinline__ void nv_router(const float* __restrict__ X1, const float* __restrict__ WR, const float* __restrict__ b_router, float* __restrict__ RSTD2,
                                          float* __restrict__ RW, int* __restrict__ LIST, unsigned* __restrict__ CNT, int item, int lane) {
    const int e = lane & 31, tok = item * 2 + (lane >> 5);
    const float* xr = X1 + (size_t)tok * DM;
    float acc = 0.f, ss = 0.f;
    for (int k = 0; k < DM; ++k) { const float xv = xr[k]; acc += xv * WR[k * NE + e]; ss += xv * xv; }
    const float rstd = rsqrtf(ss * (1.f / DM) + EPS);
    float logit = acc * rstd + b_router[e];
    if (e == 0) RSTD2[tok] = rstd;
    float tv[4]; int ti[4];
#pragma unroll
    for (int k = 0; k < 4; ++k) {
        float bv = logit; int bi = e;
#pragma unroll
        for (int o = 1; o < 32; o <<= 1) { const float ov = __shfl_xor(bv, o); const int oi = __shfl_xor(bi, o); if (ov > bv || (ov == bv && oi < bi)) { bv = ov; bi = oi; } }
        tv[k] = bv; ti[k] = bi; if (e == bi) logit = -INFINITY;
    }
    const float e0 = 1.f, e1 = expf(tv[1] - tv[0]), e2 = expf(tv[2] - tv[0]), e3 = expf(tv[3] - tv[0]); const float inv = 1.f / (e0 + e1 + e2 + e3);
    const float w0 = e0 * inv, w1 = e1 * inv, w2 = e2 * inv, w3 = e3 * inv;
    int myk = -1; float myw = 0.f;
    if (e == ti[0]) { myk = 0; myw = w0; } if (e == ti[1]) { myk = 1; myw = w1; } if (e == ti[2]) { myk = 2; myw = w2; } if (e == ti[3]) { myk = 3; myw = w3; }
    if (myk >= 0) { const int slot = tok * 4 + myk; const unsigned pos = atomicAdd(&CNT[e], 1u); LIST[(size_t)e * LIST_CAP + pos] = slot; RW[slot] = myw; }
}

__device__ __forceinline__ bool moe_tile(const unsigned* CNT, int g, int& e, int& base, int& p0, int& cnt) {
    const int tile256 = g >> 4; base = 0;
    for (e = 0; e < NE; ++e) { const int nt = ((int)CNT[e] + 255) >> 8; if (tile256 < base + nt) break; base += nt; }
    if (e == NE) return false;
    cnt = (int)CNT[e]; p0 = (g - base * 16) * 16; return p0 < cnt;
}
__device__ __forceinline__ void nv_moe1(const bf16_t* __restrict__ X1B, const bf16_t* __restrict__ W1T, const float* __restrict__ b1, const float* __restrict__ RSTD2,
                                        const int* __restrict__ LIST, bf16_t* __restrict__ H, int e, int base, int p0, int cnt, int cg, int lane) {
    const int r = lane & 15, q = lane >> 4, c0 = cg * 32, pn = c0 >> 7, j0 = c0 & 127;
    const int* lst = LIST + (size_t)e * LIST_CAP;
    const int prow = p0 + r; const int tok = lst[prow < cnt ? prow : cnt - 1] >> 2;
    f32x4 acc[4];
#pragma unroll
    for (int t = 0; t < 4; ++t) acc[t] = (f32x4){0.f, 0.f, 0.f, 0.f};
    const bf16_t* ap = X1B + (size_t)tok * DM + 8 * q;
    const bf16_t* wb = W1T + (size_t)e * 2048 * DM + (size_t)(256 * pn + j0 + r) * DM + 8 * q;
    const bf16_t* bp[4] = {wb, wb + 16 * DM, wb + 128 * DM, wb + 144 * DM};
    wave_mma<4>(acc, ap, bp, DM);
#pragma unroll
    for (int j = 0; j < 4; ++j) {
        const int pr = p0 + 4 * q + j; if (pr >= cnt) continue;
        const float rs = RSTD2[lst[pr] >> 2];
#pragma unroll
        for (int t = 0; t < 2; ++t) {
            const int col = c0 + 16 * t + r;
            float glu = acc[t][j] * rs + b1[(size_t)e * 2048 + col], lin = acc[t + 2][j] * rs + b1[(size_t)e * 2048 + 1024 + col];
            glu = fminf(glu, 7.f); lin = fminf(fmaxf(lin, -7.f), 7.f);
            const float act = glu * (1.f / (1.f + expf(-1.702f * glu))) * (lin + 1.f);
            H[((size_t)base * 256 + pr) * DM + col] = f2bf(act);
        }
    }
}
__device__ __forceinline__ void nv_moe2(const bf16_t* __restrict__ H, const bf16_t* __restrict__ W2T, const float* __restrict__ b2, const float* __restrict__ RW,
                                        const int* __restrict__ LIST, bf16_t* __restrict__ Y, int e, int base, int p0, int cnt, int cg, int lane) {
    const int r = lane & 15, q = lane >> 4, n0 = cg * 64;
    const int* lst = LIST + (size_t)e * LIST_CAP;
    f32x4 acc[4];
#pragma unroll
    for (int t = 0; t < 4; ++t) acc[t] = (f32x4){0.f, 0.f, 0.f, 0.f};
    const bf16_t* ap = H + ((size_t)base * 256 + p0 + r) * DM + 8 * q;
    const bf16_t* bp[4];
#pragma unroll
    for (int t = 0; t < 4; ++t) bp[t] = W2T + (size_t)e * DM * DM + (size_t)(n0 + 16 * t + r) * DM + 8 * q;
    wave_mma<4>(acc, ap, bp, DM);
#pragma unroll
    for (int j = 0; j < 4; ++j) {
        const int pr = p0 + 4 * q + j; if (pr >= cnt) continue;
        const int slot = lst[pr]; const float w = RW[slot];
#pragma unroll
        for (int t = 0; t < 4; ++t) { const int col = n0 + 16 * t + r; Y[(size_t)slot * DM + col] = f2bf((acc[t][j] + b2[(size_t)e * DM + col]) * w); }
    }
}

__device__ __forceinline__ void final_row(const float* X1, const bf16_t* __restrict__ Y, const float* __restrict__ gf, float* out, int row, int lane) {
    float4 v[4]; float ss = 0.f;
#pragma unroll
    for (int j = 0; j < 4; ++j) {
        const int c0 = 4 * (lane + 64 * j);
        v[j] = *(const float4*)(X1 + (size_t)row * DM + c0);
#pragma unroll
        for (int k = 0; k < 4; ++k) { const uint2 y = *(const uint2*)(Y + ((size_t)row * 4 + k) * DM + c0);
            v[j].x += bf2f((unsigned short)(y.x & 0xffff)); v[j].y += bf2f((unsigned short)(y.x >> 16)); v[j].z += bf2f((unsigned short)(y.y & 0xffff)); v[j].w += bf2f((unsigned short)(y.y >> 16)); }
        ss += v[j].x * v[j].x + v[j].y * v[j].y + v[j].z * v[j].z + v[j].w * v[j].w;
    }
    ss = wave_sum(ss);
    const float rstd = rsqrtf(ss * (1.f / DM) + EPS);
#pragma unroll
    for (int j = 0; j < 4; ++j) { const int c0 = 4 * (lane + 64 * j); const float4 g = *(const float4*)(gf + c0);
        float4 o; o.x = v[j].x * rstd * g.x; o.y = v[j].y * rstd * g.y; o.z = v[j].z * rstd * g.z; o.w = v[j].w * rstd * g.w; *(float4*)(out + (size_t)row * DM + c0) = o; }
}


namespace pg8 {
#define PG8_LAS __attribute__((address_space(3)))
typedef unsigned u32x4 __attribute__((ext_vector_type(4)));
typedef unsigned u32x2 __attribute__((ext_vector_type(2)));
constexpr int BM = 256, BK = 64, HALF = 128, HTB = HALF * BK * 2  , STAGE_BYTES = 8 * HTB, NXCD = 8, WGM = 8;
__host__ __device__ __forceinline__ int lds_byte(int r, int c) { const int st = (r >> 4) * 2 + (c >> 5), rr = r & 15, cc = c & 31, ob = rr * 64 + cc * 2; return st * 1024 + (ob ^ (((ob >> 9) & 1) << 5)); }
__host__ __device__ __forceinline__ void stage_rc(int b, int& R, int& C) { const int st = b / 1024, sb = b % 1024, swz = sb ^ (((sb >> 9) & 1) << 5); R = (st >> 1) * 16 + swz / 64; C = (st & 1) * 32 + (swz % 64) / 2; }
__host__ __device__ __forceinline__ int perm32(int rho) { const int n = rho >> 4, i = rho & 15; return 8 * (i >> 2) + 4 * n + (i & 3); }
struct Unit { int pm, pn; };
struct Gemm { const bf16_t* A; const bf16_t* Bt; int K; };
struct StaticOrder {
    int nM, nN, nwg, G, c;
    __device__ void init(int M_, int N_, int G_, int c_) { nM = M_ / BM; nN = N_ / BM; nwg = nM * nN; G = G_; c = c_; }
    __device__ bool next(int i, Unit& u) const {
        const long L = (long)i * G + c; if (L >= nwg) return false;
        int wgid = (int)L; { const int q = nwg / NXCD, r = nwg % NXCD, xcd = wgid % NXCD, off = wgid / NXCD; wgid = (xcd < r ? xcd * (q + 1) : r * (q + 1) + (xcd - r) * q) + off; }
        const int nig = WGM * nN, gid = wgid / nig, fm = gid * WGM, gsz = (nM - fm) < WGM ? (nM - fm) : WGM;
        u.pm = fm + ((wgid % nig) % gsz); u.pn = (wgid % nig) / gsz; return true;
    }
    __device__ __forceinline__ const PG8_LAS int* rowtab(int) const { return nullptr; }
};
__device__ __forceinline__ unsigned cvt_pk_bf16(float lo, float hi) { unsigned r; asm volatile("v_cvt_pk_bf16_f32 %0, %1, %2" : "=v"(r) : "v"(lo), "v"(hi)); return r; }

template <class Sched> __device__ __forceinline__ void gather_voffs(const Sched& S, int ui, int tid, int K, unsigned (&o0)[2], unsigned (&o1)[2]) {
    const PG8_LAS int* tab = S.rowtab(ui);
#pragma unroll
    for (int i = 0; i < 2; ++i) { int R, C; stage_rc(tid * 16 + i * 8192, R, C); o0[i] = (unsigned)(tab[R] * K + C) * 2u; o1[i] = (unsigned)(tab[HALF + R] * K + C) * 2u; }
}

template <class Epi, class Sched, bool ALIGN_EPI, bool GATHER>
__device__ __forceinline__ void gemm_phase(PG8_LAS unsigned char* lds, const Gemm g, const Sched& S, const Epi& E) {
    int tid_ = threadIdx.x; asm volatile("" : "+v"(tid_));
    const int tid = tid_, wid = __builtin_amdgcn_readfirstlane(tid >> 6), lane = tid & 63, wr = wid >> 2, wc = wid & 3, fr = lane & 15, fq = lane >> 4;
    const int K = g.K, nt = K / BK;
    unsigned vA0[2], vA1[2], wA0[2], wA1[2], voffB[2];
    const size_t kstep = (size_t)(BK * 2);
    const size_t hstep = (size_t)HALF * K * 2;
    const size_t tstep = 2 * hstep;
#pragma unroll
    for (int i = 0; i < 2; ++i) { int R, C; stage_rc(tid * 16 + i * 8192, R, C); const int Rb = Epi::PERM ? ((R & ~31) + perm32(R & 31)) : R;
        vA0[i] = (unsigned)(R * K + C) * 2u; vA1[i] = vA0[i] + (unsigned)hstep; voffB[i] = (unsigned)(Rb * K + C) * 2u; wA0[i] = vA0[i]; wA1[i] = vA1[i]; }
    const unsigned ldsw = (unsigned)wid * 1024u;
    const int aoff = lds_byte(wr * 64 + fr, fq * 8), boff = lds_byte(wc * 32 + fr, fq * 8);
#define PG8_SA(b, h) (((b) * 2 + (h)) * HTB)
#define PG8_SB(b, h) ((4 + (b) * 2 + (h)) * HTB)
#define PG8_STAGE(bufoff, gbase, voff) do { _Pragma("unroll") for (int _i = 0; _i < 2; ++_i) \
        __builtin_amdgcn_global_load_lds((const unsigned*)((const char*)(gbase) + (voff)[_i]), (PG8_LAS unsigned*)(lds + (bufoff) + ldsw + _i * 8192), 16, 0, 0); } while (0)
#define PG8_LDA(dst, b, h) do { _Pragma("unroll") for (int m = 0; m < 4; ++m) _Pragma("unroll") for (int k = 0; k < 2; ++k) dst[m][k] = *(const PG8_LAS bf16x8*)(lds + PG8_SA(b, h) + aoff + m * 2048 + k * 1024); } while (0)
#define PG8_LDB(dst, b, h) do { _Pragma("unroll") for (int n = 0; n < 2; ++n) _Pragma("unroll") for (int k = 0; k < 2; ++k) dst[n][k] = *(const PG8_LAS bf16x8*)(lds + PG8_SB(b, h) + boff + n * 2048 + k * 1024); } while (0)
#define PG8_MMA(ai, bj, At, Bt) do { __builtin_amdgcn_s_setprio(1); _Pragma("unroll") for (int m = 0; m < 4; ++m) _Pragma("unroll") for (int n = 0; n < 2; ++n) _Pragma("unroll") for (int k = 0; k < 2; ++k) \
        acc[ai][bj][m][n] = __builtin_amdgcn_mfma_f32_16x16x32_bf16(Bt[n][k], At[m][k], acc[ai][bj][m][n], 0, 0, 0); __builtin_amdgcn_s_setprio(0); } while (0)
#define PG8_WAIT_V(n) asm volatile("s_waitcnt vmcnt(" #n ")" ::: "memory")
#define PG8_WAIT_L(n) asm volatile("s_waitcnt lgkmcnt(" #n ")" ::: "memory")
#define PG8_BAR __builtin_amdgcn_s_barrier()
#define PG8_SCHED __builtin_amdgcn_sched_barrier(0)
    Unit cur, nxt; int ui = 0;
    if (!S.next(0, cur)) return;
    f32x4 acc[2][2][4][2];
#pragma unroll
    for (int a = 0; a < 2; ++a)
#pragma unroll
        for (int b = 0; b < 2; ++b)
#pragma unroll
            for (int m = 0; m < 4; ++m)
#pragma unroll
                for (int n = 0; n < 2; ++n) acc[a][b][m][n] = (f32x4){0.f, 0.f, 0.f, 0.f};
    bf16x8 At[4][2], B0[2][2], B1[2][2];
    const char* cA = GATHER ? (const char*)g.A : (const char*)g.A + (size_t)cur.pm * tstep; const char* cB = (const char*)g.Bt + (size_t)cur.pn * tstep;
    if constexpr (GATHER) gather_voffs(S, 0, tid, K, vA0, vA1);
    PG8_STAGE(PG8_SB(0, 0), cB, voffB); PG8_STAGE(PG8_SB(0, 1), cB + hstep, voffB); PG8_STAGE(PG8_SA(0, 0), cA, vA0); PG8_STAGE(PG8_SA(0, 1), cA, vA1);
    if (wr == 1) PG8_BAR;
    PG8_WAIT_V(2); PG8_BAR;
    PG8_STAGE(PG8_SB(1, 0), cB + kstep, voffB); PG8_STAGE(PG8_SA(1, 0), cA + kstep, vA0); PG8_STAGE(PG8_SB(1, 1), cB + hstep + kstep, voffB);
    PG8_WAIT_V(6); PG8_BAR;
    for (;;) {
        const bool has_next = S.next(ui + 1, nxt);
        const char* nA = GATHER ? cA : (has_next ? (const char*)g.A + (size_t)nxt.pm * tstep : cA); const char* nB = has_next ? (const char*)g.Bt + (size_t)nxt.pn * tstep : cB;
        if constexpr (GATHER) { if (has_next) gather_voffs(S, ui + 1, tid, K, wA0, wA1); else { wA0[0] = vA0[0]; wA0[1] = vA0[1]; wA1[0] = vA1[0]; wA1[1] = vA1[1]; } }
        for (int t = 0; t < nt; t += 2) {
            const bool last = (t == nt - 2);
            const char* a1 = cA + (size_t)(t + 1) * kstep;
            const char* a2 = last ? nA : cA + (size_t)(t + 2) * kstep; const char* b2 = last ? nB : cB + (size_t)(t + 2) * kstep;
            const char* a3 = a2 + kstep; const char* b3 = b2 + kstep;
            unsigned sA0[2], sA1[2];
#pragma unroll
            for (int i = 0; i < 2; ++i) { sA0[i] = (GATHER && last) ? wA0[i] : vA0[i]; sA1[i] = (GATHER && last) ? wA1[i] : vA1[i]; }
            if constexpr (Epi::MIDK) { if (t == nt / 2) E.midk(acc, wr, fr); }
            PG8_LDB(B0, 0, 0); PG8_LDB(B1, 0, 1); PG8_SCHED; PG8_LDA(At, 0, 0); PG8_STAGE(PG8_SA(1, 1), a1, vA1);
            PG8_WAIT_V(8); PG8_WAIT_L(0); PG8_BAR; PG8_MMA(0, 0, At, B0); PG8_MMA(0, 1, At, B1); PG8_BAR; PG8_SCHED;
            PG8_LDA(At, 0, 1); PG8_STAGE(PG8_SB(0, 0), b2, voffB); PG8_STAGE(PG8_SB(0, 1), b2 + hstep, voffB); PG8_STAGE(PG8_SA(0, 0), a2, sA0);
            PG8_WAIT_V(8); PG8_WAIT_L(0); PG8_BAR; PG8_MMA(1, 0, At, B0); PG8_MMA(1, 1, At, B1); PG8_BAR; PG8_SCHED;
            PG8_LDB(B0, 1, 0); PG8_LDB(B1, 1, 1); PG8_SCHED; PG8_LDA(At, 1, 0); PG8_STAGE(PG8_SA(0, 1), a2, sA1);
            PG8_WAIT_V(8); PG8_WAIT_L(0); PG8_BAR; PG8_MMA(0, 0, At, B0); PG8_MMA(0, 1, At, B1); PG8_BAR; PG8_SCHED;
            PG8_LDA(At, 1, 1); PG8_STAGE(PG8_SB(1, 0), b3, voffB); PG8_STAGE(PG8_SB(1, 1), b3 + hstep, voffB); PG8_STAGE(PG8_SA(1, 0), a3, sA0);
            PG8_WAIT_V(8); PG8_WAIT_L(0); PG8_BAR; PG8_MMA(1, 0, At, B0); PG8_MMA(1, 1, At, B1); PG8_BAR; PG8_SCHED;
        }
        if constexpr (ALIGN_EPI) { if (wr == 0) PG8_BAR; }
        E(acc, cur, ui, wr, wc, fr, fq);
        if (!has_next) break;
#pragma unroll
        for (int a = 0; a < 2; ++a)
#pragma unroll
            for (int b = 0; b < 2; ++b)
#pragma unroll
                for (int m = 0; m < 4; ++m)
#pragma unroll
                    for (int n = 0; n < 2; ++n) acc[a][b][m][n] = (f32x4){0.f, 0.f, 0.f, 0.f};
        cur = nxt; cA = nA; cB = nB; ++ui;
        if constexpr (GATHER) { vA0[0] = wA0[0]; vA0[1] = wA0[1]; vA1[0] = wA1[0]; vA1[1] = wA1[1]; }
        if constexpr (ALIGN_EPI) { if (wr == 1) PG8_BAR; }
    }
    PG8_WAIT_V(0);
    if constexpr (!ALIGN_EPI) { if (wr == 0) PG8_BAR; }
    PG8_BAR;
#undef PG8_SA
#undef PG8_SB
#undef PG8_STAGE
#undef PG8_LDA
#undef PG8_LDB
#undef PG8_MMA
#undef PG8_WAIT_V
#undef PG8_WAIT_L
#undef PG8_BAR
#undef PG8_SCHED
}

struct EpiProj {
    static constexpr bool PERM = true, MIDK = false;
    bf16_t* O;
    __device__ __forceinline__ void operator()(const f32x4 (&acc)[2][2][4][2], const Unit& u, int, int wr, int wc, int fr, int fq) const {
        const int row0 = u.pm * BM + wr * 64 + fr, col0 = u.pn * BM + wc * 32 + 8 * fq;
        const float sc = (u.pn < 2 || (u.pn >= 6 && u.pn < 8)) ? C2 : 1.f;
#pragma unroll
        for (int ai = 0; ai < 2; ++ai)
#pragma unroll
            for (int m = 0; m < 4; ++m) { bf16_t* rowp = O + (size_t)(row0 + ai * HALF + m * 16) * NPROJ + col0;
#pragma unroll
                for (int bj = 0; bj < 2; ++bj) { const f32x4 v0 = acc[ai][bj][m][0] * sc, v1 = acc[ai][bj][m][1] * sc;
                    u32x4 w; w.x = cvt_pk_bf16(v0[0], v0[1]); w.y = cvt_pk_bf16(v0[2], v0[3]); w.z = cvt_pk_bf16(v1[0], v1[1]); w.w = cvt_pk_bf16(v1[2], v1[3]);
                    *(u32x4*)(rowp + bj * HALF) = w; } }
    }
};
struct EpiWout {
    static constexpr bool PERM = false, MIDK = true;
    const float* x; float* X1; bf16_t* X1B; const PG8_LAS float* ratio; const PG8_LAS float* rs;
    __device__ __forceinline__ void midk(f32x4 (&acc)[2][2][4][2], int wr, int fr) const {
#pragma unroll
        for (int ai = 0; ai < 2; ++ai)
#pragma unroll
            for (int m = 0; m < 4; ++m) { const float f = ratio[ai * HALF + wr * 64 + m * 16 + fr];
#pragma unroll
                for (int bj = 0; bj < 2; ++bj)
#pragma unroll
                    for (int n = 0; n < 2; ++n) acc[ai][bj][m][n] *= f; }
    }
    __device__ __forceinline__ void operator()(const f32x4 (&acc)[2][2][4][2], const Unit& u, int, int wr, int wc, int fr, int fq) const {
        const int col0 = u.pn * BM + wc * 32 + 4 * fq;
#pragma unroll
        for (int ai = 0; ai < 2; ++ai)
#pragma unroll
            for (int m = 0; m < 4; ++m) { const int r = ai * HALF + wr * 64 + m * 16 + fr; const float s = rs[r]; const size_t off = (size_t)(u.pm * BM + r) * DM + col0;
#pragma unroll
                for (int bj = 0; bj < 2; ++bj)
#pragma unroll
                    for (int n = 0; n < 2; ++n) { const f32x4 xv = *(const f32x4*)(x + off + bj * HALF + n * 16); const f32x4 o = xv + acc[ai][bj][m][n] * s;
                        *(f32x4*)(X1 + off + bj * HALF + n * 16) = o; u32x2 w; w.x = cvt_pk_bf16(o[0], o[1]); w.y = cvt_pk_bf16(o[2], o[3]); *(u32x2*)(X1B + off + bj * HALF + n * 16) = w; }
                asm volatile("" ::: "memory"); }
    }
};
constexpr int MOE_MAXU = 9;
struct MoeOrder {
    int NT, c, U; const PG8_LAS int* tb; const PG8_LAS int* tabA;
    __device__ bool next(int i, Unit& u) const {
        if (i >= MOE_MAXU) return false;
        const int x = c & 7, j = c >> 3, q = U >> 3, rem = U & 7, start = x * q + (x < rem ? x : rem), size = q + (x < rem ? 1 : 0), li = i * 32 + j;
        if (li >= size) return false;
        const int f = start + li; int e = 0; while (f >= tb[e + 1] * NT) ++e;
        const int idx = f - tb[e] * NT, nte = tb[e + 1] - tb[e], pg = idx / (4 * nte), rem2 = idx - pg * 4 * nte;
        u.pm = tb[e] + (rem2 >> 2); u.pn = e * NT + pg * 4 + (rem2 & 3); return true;
    }
    __device__ __forceinline__ const PG8_LAS int* rowtab(int ui) const { return tabA + ui * 256; }
};
struct EpiMoe1 {
    static constexpr bool PERM = true, MIDK = false;
    bf16_t* H; const float* b1; const PG8_LAS float* rstab;
    __device__ __forceinline__ void operator()(const f32x4 (&acc)[2][2][4][2], const Unit& u, int ui, int wr, int wc, int fr, int fq) const {
        const int e = u.pn >> 3, pl = u.pn & 7, colA = pl * 128 + wc * 32 + 8 * fq;
        f32x4 bg[2], bl[2];
#pragma unroll
        for (int n = 0; n < 2; ++n) { bg[n] = *(const f32x4*)(b1 + (size_t)e * 2048 + colA + 4 * n); bl[n] = *(const f32x4*)(b1 + (size_t)e * 2048 + 1024 + colA + 4 * n); }
#pragma unroll
        for (int ai = 0; ai < 2; ++ai)
#pragma unroll
            for (int m = 0; m < 4; ++m) { const int r = ai * HALF + wr * 64 + m * 16 + fr; const float rs = rstab[ui * 256 + r];
                float a8[8];
#pragma unroll
                for (int n = 0; n < 2; ++n) { const f32x4 gv = acc[ai][0][m][n] * rs + bg[n], lv = acc[ai][1][m][n] * rs + bl[n];
#pragma unroll
                    for (int i = 0; i < 4; ++i) { const float gl = fminf(gv[i], 7.f), li = fminf(fmaxf(lv[i], -7.f), 7.f);
                        a8[4 * n + i] = gl * __builtin_amdgcn_rcpf(1.f + __builtin_amdgcn_exp2f(-1.702f * LOG2E * gl)) * (li + 1.f); } }
                u32x4 w; w.x = cvt_pk_bf16(a8[0], a8[1]); w.y = cvt_pk_bf16(a8[2], a8[3]); w.z = cvt_pk_bf16(a8[4], a8[5]); w.w = cvt_pk_bf16(a8[6], a8[7]);
                *(u32x4*)(H + (size_t)(u.pm * BM + r) * DM + colA) = w; }
    }
};
struct EpiMoe2 {
    static constexpr bool PERM = true, MIDK = false;
    bf16_t* Y; const float* b2; const PG8_LAS int* slottab; const PG8_LAS float* wtab;
    __device__ __forceinline__ void operator()(const f32x4 (&acc)[2][2][4][2], const Unit& u, int ui, int wr, int wc, int fr, int fq) const {
        const int e = u.pn >> 2, pl = u.pn & 3, col0 = pl * BM + wc * 32 + 8 * fq;
        f32x4 bv[2][2];
#pragma unroll
        for (int bj = 0; bj < 2; ++bj)
#pragma unroll
            for (int n = 0; n < 2; ++n) bv[bj][n] = *(const f32x4*)(b2 + (size_t)e * DM + col0 + bj * HALF + 4 * n);
#pragma unroll
        for (int ai = 0; ai < 2; ++ai)
#pragma unroll
            for (int m = 0; m < 4; ++m) { const int r = ai * HALF + wr * 64 + m * 16 + fr; const int slot = slottab[ui * 256 + r]; const float wt = wtab[ui * 256 + r];
                if (slot >= 0) {
#pragma unroll
                    for (int bj = 0; bj < 2; ++bj) { const f32x4 v0 = (acc[ai][bj][m][0] + bv[bj][0]) * wt, v1 = (acc[ai][bj][m][1] + bv[bj][1]) * wt;
                        u32x4 w; w.x = cvt_pk_bf16(v0[0], v0[1]); w.y = cvt_pk_bf16(v0[2], v0[3]); w.z = cvt_pk_bf16(v1[0], v1[1]); w.w = cvt_pk_bf16(v1[2], v1[3]);
                        *(u32x4*)(Y + (size_t)slot * DM + col0 + bj * HALF) = w; } } }
    }
};
}

#include <hip/hip_bf16.h>
#include <cmath>
namespace attn_body {

using bf16=__hip_bfloat16;
using bf16x8=__attribute__((ext_vector_type(8)))short;
using s16x4=__attribute__((ext_vector_type(4)))short;
using f32x16=__attribute__((ext_vector_type(16)))float;
using u32x4=__attribute__((ext_vector_type(4)))unsigned;
constexpr int SEQ=4096,D=64,PIN=3072,POUT=1024;
constexpr int NW=8,QBLK=32,QB=QBLK*NW,KVBLK=64,NQB=SEQ/QB;
__device__ __forceinline__ int crow(int r,int hi){return (r&3)+8*(r>>2)+4*hi;}
#define SBAR() __builtin_amdgcn_sched_barrier(0)
__device__ __forceinline__ void cmask(f32x16&p0,f32x16&p1,int jb,int qrel,int hi){
  const float NEG=-INFINITY; int kb=64*jb+4*hi;
  #pragma unroll
  for(int r=0;r<16;++r){int kv=kb+(r&3)+8*(r>>2); if(kv>qrel)p0[r]=NEG; if(kv+32>qrel)p1[r]=NEG;}
}

constexpr int NSLOT=3, SLOTB=8192;
constexpr int LDS_K=0, LDS_V=NSLOT*SLOTB, LDS_WS=2*NSLOT*SLOTB, LDS_OST=LDS_WS+NW*64*4, LDS_CK=LDS_OST+NW*4096, LDS_BYTES=LDS_CK+SEQ*4;
constexpr float C2=0.125f*1.4426950408889634f;
__device__ __forceinline__ void glds16(const void*gsrc,unsigned lds_dst){unsigned keep;
  asm volatile("s_mov_b32 %0, m0\n\ts_mov_b32 m0, %2\n\ts_nop 0\n\tglobal_load_lds_dwordx4 %1, off\n\ts_mov_b32 m0, %0":"=&s"(keep):"v"(gsrc),"s"(lds_dst):"memory");}
__device__ __forceinline__ float max3f(float a,float b,float c){float r;asm("v_max3_f32 %0, %1, %2, %3":"=v"(r):"v"(a),"v"(b),"v"(c));return r;}
__device__ __forceinline__ float max2f(float a,float b){float r;asm("v_max_f32_e32 %0, %1, %2":"=v"(r):"v"(a),"v"(b));return r;}
__device__ __forceinline__ float fadd_s(float a,float b){float r;asm("v_add_f32_e32 %0, %1, %2":"=v"(r):"v"(a),"v"(b));return r;}
__device__ __forceinline__ float fsub_s(float a,float b){float r;asm("v_sub_f32_e32 %0, %1, %2":"=v"(r):"v"(a),"v"(b));return r;}
typedef float f32x2_t __attribute__((ext_vector_type(2))); typedef float f32x4_t __attribute__((ext_vector_type(4))); typedef __bf16 bf16x2_t __attribute__((ext_vector_type(2)));
__device__ __forceinline__ unsigned cvtpk_s(float lo,float hi){f32x2_t v={lo,hi};bf16x2_t b=__builtin_convertvector(v,bf16x2_t);return __builtin_bit_cast(unsigned,b);}
#define WAIT_BAR(N) asm volatile("s_waitcnt vmcnt(" #N ") lgkmcnt(0)\n\ts_barrier":::"memory")

__device__ __forceinline__ void qkt(f32x16&p0,f32x16&p1,const char*Kslot,const bf16x8*qr,const f32x16&negm,int r32,int hi){
  const char*kb=Kslot+hi*1024+r32*16;
  #pragma unroll
  for(int d0=0;d0<4;++d0){
    const bf16x8 b0=*reinterpret_cast<const bf16x8*>(kb+d0*2048);
    const bf16x8 b1=*reinterpret_cast<const bf16x8*>(kb+d0*2048+512);
    if(d0==0){p0=__builtin_amdgcn_mfma_f32_32x32x16_bf16(b0,qr[0],negm,0,0,0);p1=__builtin_amdgcn_mfma_f32_32x32x16_bf16(b1,qr[0],negm,0,0,0);}
    else{p0=__builtin_amdgcn_mfma_f32_32x32x16_bf16(b0,qr[d0],p0,0,0,0);p1=__builtin_amdgcn_mfma_f32_32x32x16_bf16(b1,qr[d0],p1,0,0,0);}}
}
typedef __attribute__((address_space(3))) const char* lds_cptr;
typedef short v4i16_t __attribute__((ext_vector_type(4)));
__device__ __forceinline__ void kload8(bf16x8*kf,lds_cptr kp){
  kf[0]=*(const __attribute__((address_space(3))) bf16x8*)(kp);      kf[1]=*(const __attribute__((address_space(3))) bf16x8*)(kp+512);
  kf[2]=*(const __attribute__((address_space(3))) bf16x8*)(kp+2048); kf[3]=*(const __attribute__((address_space(3))) bf16x8*)(kp+2560);
  kf[4]=*(const __attribute__((address_space(3))) bf16x8*)(kp+4096); kf[5]=*(const __attribute__((address_space(3))) bf16x8*)(kp+4608);
  kf[6]=*(const __attribute__((address_space(3))) bf16x8*)(kp+6144); kf[7]=*(const __attribute__((address_space(3))) bf16x8*)(kp+6656);
}
__device__ __forceinline__ void kload2(bf16x8*kf,lds_cptr kp,int j){ kf[2*j]=*(const __attribute__((address_space(3))) bf16x8*)(kp+j*2048); kf[2*j+1]=*(const __attribute__((address_space(3))) bf16x8*)(kp+j*2048+512); }
__device__ __forceinline__ s16x4 vtr(lds_cptr p){ return __builtin_bit_cast(s16x4,__builtin_amdgcn_ds_read_tr16_b64_v4i16((__attribute__((address_space(3))) v4i16_t*)p)); }
__device__ __forceinline__ float rowmax(const f32x16&p0,const f32x16&p1){
  float a=max3f(p0[0],p0[1],p1[0]),b=max3f(p0[2],p0[3],p1[1]);a=max3f(a,p1[2],p1[3]);
  #pragma unroll
  for(int r=4;r<16;r+=4){a=max3f(a,p0[r],p0[r+1]);b=max3f(b,p0[r+2],p0[r+3]);a=max3f(a,p1[r],p1[r+1]);b=max3f(b,p1[r+2],p1[r+3]);}
  const float m=max2f(a,b);
  auto rr=__builtin_amdgcn_permlane32_swap(__float_as_uint(m),__float_as_uint(m),false,false);
  return max2f(__uint_as_float(rr[0]),__uint_as_float(rr[1]));
}
__device__ __forceinline__ void pv(f32x16*o,int vb,bf16x8 pa0,bf16x8 pa1,bf16x8 pa2,bf16x8 pa3){
  #pragma unroll
  for(int d0=0;d0<2;++d0){s16x4 lo[4],hi[4];
    #pragma unroll
    for(int ks=0;ks<4;++ks){
      asm volatile("ds_read_b64_tr_b16 %0,%1 offset:%c2":"=&v"(lo[ks]):"v"(vb),"i"(d0*4096+ks*1024):"memory");
      asm volatile("ds_read_b64_tr_b16 %0,%1 offset:%c2":"=&v"(hi[ks]):"v"(vb),"i"(d0*4096+ks*1024+512):"memory");}
    asm volatile("s_waitcnt lgkmcnt(0)":::"memory");SBAR();
    #define PK(k) (bf16x8){lo[k][0],lo[k][1],lo[k][2],lo[k][3],hi[k][0],hi[k][1],hi[k][2],hi[k][3]}
    o[d0]=__builtin_amdgcn_mfma_f32_32x32x16_bf16(pa0,PK(0),o[d0],0,0,0);
    o[d0]=__builtin_amdgcn_mfma_f32_32x32x16_bf16(pa1,PK(1),o[d0],0,0,0);
    o[d0]=__builtin_amdgcn_mfma_f32_32x32x16_bf16(pa2,PK(2),o[d0],0,0,0);
    o[d0]=__builtin_amdgcn_mfma_f32_32x32x16_bf16(pa3,PK(3),o[d0],0,0,0);
    #undef PK
  }
}

#ifndef ATTN_STORE16
#define ATTN_STORE16(p,v) (*(u32x4*)(p)=(v))
#endif
template<int THRL> __device__ __forceinline__ void attn_unit(int b,int h,int qb,const bf16*Q,const bf16*__restrict__ K,const bf16*__restrict__ V,bf16*O,const float*__restrict__ CUMbh,float*__restrict__ SSQh,char*shm){
  int tid_=threadIdx.x; asm volatile("":"+v"(tid_));
  const int tid=tid_,lane=tid&63,r32=lane&31,hi=lane>>5; const int wid=__builtin_amdgcn_readfirstlane(tid>>6);
  const long rowbase=(long)b*SEQ; const int q0=qb*QB;
  const bf16*Qw=Q+(rowbase+q0+wid*QBLK)*PIN+h*D;
  const bf16*Kh=K+rowbase*PIN+h*D,*Vh=V+rowbase*PIN+h*D;
  const unsigned lds0=(unsigned)(uintptr_t)shm;
  const lds_cptr shm3=(lds_cptr)shm;
  float*wsf=(float*)(shm+LDS_WS)+wid*64;
  const bf16*ksrc=Kh+(long)lane*PIN+wid*8;
  const bf16*vsrc=Vh+(long)(16*(wid&3)+(lane>>2))*PIN+(wid>>2)*32+(lane&3)*8;
  const unsigned kdst=lds0+LDS_K+wid*1024, vdst=lds0+LDS_V+wid*1024;
  #define DMA_K(t,slot) glds16(ksrc+(long)(t)*KVBLK*PIN,(unsigned)__builtin_amdgcn_readfirstlane(kdst+(slot)))
  #define DMA_V(t,slot) glds16(vsrc+(long)(t)*KVBLK*PIN,(unsigned)__builtin_amdgcn_readfirstlane(vdst+(slot)))
  const int vb0=(int)(lds0+LDS_V)+((lane>>4)&1)*32+(lane&3)*8+(4*hi+((lane&15)>>2))*64;
  const char*Kbase=shm+LDS_K; bf16x8 kf[8];
  const lds_cptr kp0=shm3+LDS_K+hi*1024+r32*16; const lds_cptr vp0=shm3+LDS_V+((lane>>4)&1)*32+(lane&3)*8+(4*hi+((lane&15)>>2))*64;
  const int NT=(q0+QB)/KVBLK;
  DMA_K(0,0);DMA_V(0,0);DMA_K(1,SLOTB);
  bf16x8 qr[4];
  #pragma unroll
  for(int d0=0;d0<4;++d0)qr[d0]=*reinterpret_cast<const bf16x8*>(&Qw[(long)r32*PIN+d0*16+hi*8]);
  const float cbase=CUMbh[q0]; const float cq=CUMbh[q0+wid*QBLK+r32]-cbase;
  { __attribute__((address_space(3))) float*ckw=(__attribute__((address_space(3))) float*)(shm3+LDS_CK); int s0_=tid; asm volatile("":"+v"(s0_));
    _Pragma("nounroll") for(int s=s0_;s<q0+QB;s+=NW*64)ckw[s]=CUMbh[s]-cbase; }
  const __attribute__((address_space(3))) float*ckp=(const __attribute__((address_space(3))) float*)(shm3+LDS_CK)+4*hi;
  float mhat=-cq,l_reg=0.f;f32x16 o[2];o[0]=f32x16{};o[1]=f32x16{};f32x16 negm;
  #pragma unroll
  for(int r=0;r<16;++r)negm[r]=cq;
  asm volatile("":"+v"(negm));
  const int qrel=wid*QBLK+r32;
  #define BIAS(P0,P1,t) do{ const __attribute__((address_space(3))) float*cp_=ckp+(t)*KVBLK; \
    _Pragma("unroll") for(int g_=0;g_<4;++g_){ const f32x4_t c0_=*(const __attribute__((address_space(3))) f32x4_t*)(cp_+8*g_), c1_=*(const __attribute__((address_space(3))) f32x4_t*)(cp_+32+8*g_); \
      _Pragma("unroll") for(int j_=0;j_<4;++j_){ P0[4*g_+j_]-=c0_[j_]; P1[4*g_+j_]-=c1_[j_]; } SBAR(); } }while(0)
  #define CMASK(P0,P1,t) do{int jb_=(t)-(NT-4); if(jb_>=0)cmask(P0,P1,jb_,qrel,hi);}while(0)
  bool resc=false;
  #define START(P0,P1) do{ const float rm=rowmax(P0,P1); resc=false; \
    { const float dl=rm; mhat=fadd_s(mhat,dl); \
      _Pragma("unroll") for(int r=0;r<16;++r){P0[r]=fsub_s(P0[r],dl);P1[r]=fsub_s(P1[r],dl);} \
      _Pragma("unroll") for(int r=0;r<16;++r)negm[r]=-mhat; asm volatile("":"+v"(negm)); } \
    _Pragma("unroll") for(int r=0;r<16;++r)P0[r]=__builtin_amdgcn_exp2f(P0[r]); }while(0)
  #define RESC() do{ if(resc){ asm volatile("s_waitcnt lgkmcnt(0)":::"memory"); \
      _Pragma("unroll") for(int d_=0;d_<2;++d_) _Pragma("unroll") for(int r=0;r<16;++r)o[d_][r]*=wsf[crow(r,hi)]; } }while(0)
  f32x16 pA0,pA1,pB0,pB1;
  int sl_prev=0,sl_cur=0,sl_next=SLOTB;
  #define ROT() do{sl_prev=sl_cur;sl_cur=sl_next;sl_next=(sl_next==(NSLOT-1)*SLOTB)?0:sl_next+SLOTB;}while(0)
  DMA_K(2,2*SLOTB);
  WAIT_BAR(3);
  qkt(pA0,pA1,Kbase,qr,negm,r32,hi);asm volatile("s_nop 15\n\ts_nop 7":"+v"(pA0),"+v"(pA1));BIAS(pA0,pA1,0);CMASK(pA0,pA1,0);
  START(pA0,pA1);
  _Pragma("unroll") for(int r=0;r<16;++r)pA1[r]=__builtin_amdgcn_exp2f(pA1[r]);
  WAIT_BAR(0);
  DMA_K(3,0);DMA_V(1,SLOTB);
  ROT();
  kload8(kf,kp0+sl_cur);
  WAIT_BAR(2);
  s16x4 vlo[8],vhi[8]; u32x4 pw0,pw1,pw2,pw3;
  #define PKW(P,B) cvtpk_s(P[B],P[B+1])
  #define PAF(k) __builtin_bit_cast(bf16x8,pw##k)
  #define VFR(i) (bf16x8){vlo[i][0],vlo[i][1],vlo[i][2],vlo[i][3],vhi[i][0],vhi[i][1],vhi[i][2],vhi[i][3]}
  #define PIN(x) asm volatile("":"+v"(x))
  #define MX3(a,b,c) __builtin_fmaxf(__builtin_fmaxf((a),(b)),(c))
  #define GAPA(MF,A0,A1,A2,A3,W0,W1,PW) do{ MF; sacc+=A0; sacc+=A1; sacc+=A2; sacc+=A3; PIN(sacc); W0; W1; PIN(PW); SBAR(); }while(0)
  #define EX(v) __builtin_amdgcn_exp2f(v)
  #define GAPB(MF,X,B) do{ MF; X[B]=EX(X[B]); X[B+1]=EX(X[B+1]); X[B+2]=EX(X[B+2]); X[B+3]=EX(X[B+3]); PIN(X); SBAR(); }while(0)
  #define VRD(i) do{ vlo[i]=vtr(vp_+(((i)>>2)*4096+((i)&3)*1024)); vhi[i]=vtr(vp_+(((i)>>2)*4096+((i)&3)*1024+512)); }while(0)
  #define KRD(G,j) do{ if(G){ kload2(kf,kp0+sl_next,j); SBAR(); } }while(0)
  #define STEP(C0,C1,P0,P1,t,GK,GV,GL) do{ SBAR(); \
    const lds_cptr vp_=vp0+sl_prev; \
    VRD(0); SBAR(); float sacc=(P0[0]+P0[1]); \
    GAPA(C0=__builtin_amdgcn_mfma_f32_32x32x16_bf16(kf[0],qr[0],negm,0,0,0), P0[2],P0[3],P0[4],P0[5],     pw0[0]=PKW(P0,0), pw0[1]=PKW(P0,2), pw0); \
    VRD(4); SBAR(); GAPA(C1=__builtin_amdgcn_mfma_f32_32x32x16_bf16(kf[1],qr[0],negm,0,0,0), P0[6],P0[7],P0[8],P0[9],     pw0[2]=PKW(P0,4), pw0[3]=PKW(P0,6), pw0); \
    VRD(1); SBAR(); GAPA(C0=__builtin_amdgcn_mfma_f32_32x32x16_bf16(kf[2],qr[1],C0,0,0,0),   P0[10],P0[11],P0[12],P0[13], pw1[0]=PKW(P0,8), pw1[1]=PKW(P0,10), pw1); \
    VRD(5); SBAR(); GAPA(C1=__builtin_amdgcn_mfma_f32_32x32x16_bf16(kf[3],qr[1],C1,0,0,0),   P0[14],P0[15],P1[0],P1[1],   pw1[2]=PKW(P0,12),pw1[3]=PKW(P0,14), pw1); \
    VRD(2); SBAR(); GAPA(C0=__builtin_amdgcn_mfma_f32_32x32x16_bf16(kf[4],qr[2],C0,0,0,0),   P1[2],P1[3],P1[4],P1[5],     pw2[0]=PKW(P1,0), pw2[1]=PKW(P1,2), pw2); \
    VRD(6); SBAR(); GAPA(C1=__builtin_amdgcn_mfma_f32_32x32x16_bf16(kf[5],qr[2],C1,0,0,0),   P1[6],P1[7],P1[8],P1[9],     pw2[2]=PKW(P1,4), pw2[3]=PKW(P1,6), pw2); \
    VRD(3); SBAR(); GAPA(C0=__builtin_amdgcn_mfma_f32_32x32x16_bf16(kf[6],qr[3],C0,0,0,0),   P1[10],P1[11],P1[12],P1[13], pw3[0]=PKW(P1,8), pw3[1]=PKW(P1,10), pw3); \
    VRD(7); SBAR(); GAPA(C1=__builtin_amdgcn_mfma_f32_32x32x16_bf16(kf[7],qr[3],C1,0,0,0),   P1[14],P1[15],0.f,0.f,       pw3[2]=PKW(P1,12),pw3[3]=PKW(P1,14), pw3); \
    l_reg+=sacc; \
    if(GK){DMA_K((t)+3,sl_cur);} if(GV){DMA_V((t)+1,sl_next);} \
    BIAS(C0,C1,t); CMASK(C0,C1,t); \
    { float a=MX3(C0[0],C0[1],C1[0]),b=MX3(C0[2],C0[3],C1[1]); a=MX3(a,C1[2],C1[3]); \
      _Pragma("unroll") for(int r=4;r<16;r+=4){a=MX3(a,C0[r],C0[r+1]);b=MX3(b,C0[r+2],C0[r+3]);a=MX3(a,C1[r],C1[r+1]);b=MX3(b,C1[r+2],C1[r+3]);} \
      float rm=__builtin_fmaxf(a,b); { auto rr=__builtin_amdgcn_permlane32_swap(__float_as_uint(rm),__float_as_uint(rm),false,false); rm=__builtin_fmaxf(__uint_as_float(rr[0]),__uint_as_float(rr[1])); } \
      resc=false; \
      if(__builtin_expect(__any(rm>(float)THRL),0)){ const float dl=__builtin_fmaxf(rm,0.f); mhat+=dl; \
        _Pragma("unroll") for(int r=0;r<16;++r){C0[r]-=dl;C1[r]-=dl;} \
        _Pragma("unroll") for(int r=0;r<16;++r)negm[r]=-mhat; asm volatile("":"+v"(negm)); \
        const float f=__builtin_amdgcn_exp2f(-dl); l_reg*=f; if(hi==0)wsf[r32]=f; resc=true; } } \
    SBAR(); \
    GAPB(o[0]=__builtin_amdgcn_mfma_f32_32x32x16_bf16(PAF(0),VFR(0),o[0],0,0,0), C0,0); \
    GAPB(o[1]=__builtin_amdgcn_mfma_f32_32x32x16_bf16(PAF(0),VFR(4),o[1],0,0,0), C0,4); \
    KRD(GL,0); GAPB(o[0]=__builtin_amdgcn_mfma_f32_32x32x16_bf16(PAF(1),VFR(1),o[0],0,0,0), C0,8); \
    KRD(GL,1); GAPB(o[1]=__builtin_amdgcn_mfma_f32_32x32x16_bf16(PAF(1),VFR(5),o[1],0,0,0), C0,12); \
    KRD(GL,2); GAPB(o[0]=__builtin_amdgcn_mfma_f32_32x32x16_bf16(PAF(2),VFR(2),o[0],0,0,0), C1,0); \
    KRD(GL,3); GAPB(o[1]=__builtin_amdgcn_mfma_f32_32x32x16_bf16(PAF(2),VFR(6),o[1],0,0,0), C1,4); \
    GAPB(o[0]=__builtin_amdgcn_mfma_f32_32x32x16_bf16(PAF(3),VFR(3),o[0],0,0,0), C1,8); \
    GAPB(o[1]=__builtin_amdgcn_mfma_f32_32x32x16_bf16(PAF(3),VFR(7),o[1],0,0,0), C1,12); \
    }while(0)
  int t=1;
  #undef CMASK
  #define CMASK(P0,P1,t) do{}while(0)
  for(;t+5<NT;t+=2){
    STEP(pB0,pB1,pA0,pA1,t,true,true,true);     WAIT_BAR(2); RESC(); ROT();
    STEP(pA0,pA1,pB0,pB1,t+1,true,true,true);   WAIT_BAR(2); RESC(); ROT();
  }
  #undef CMASK
  #define CMASK(P0,P1,t) do{int jb_=(t)-(NT-4); if(jb_>=0)cmask(P0,P1,jb_,qrel,hi);}while(0)
  #define ENDW(tt) do{ if((tt)+3<NT){WAIT_BAR(2);} else if((tt)+2<NT){WAIT_BAR(1);} else {WAIT_BAR(0);} }while(0)
  for(;t+1<NT;t+=2){
    STEP(pB0,pB1,pA0,pA1,t,(t+3<NT),(t+1<NT),(t+1<NT));       ENDW(t);   RESC(); ROT();
    STEP(pA0,pA1,pB0,pB1,t+1,(t+4<NT),(t+2<NT),(t+2<NT));     ENDW(t+1); RESC(); ROT();
  }
  STEP(pB0,pB1,pA0,pA1,NT-1,false,false,false); RESC();
  { float sacc=pB0[0]+pB0[1]; _Pragma("unroll") for(int r=2;r<16;++r)sacc+=pB0[r]; _Pragma("unroll") for(int r=0;r<16;++r)sacc+=pB1[r]; l_reg+=sacc;
    pw0=(u32x4){PKW(pB0,0),PKW(pB0,2),PKW(pB0,4),PKW(pB0,6)};pw1=(u32x4){PKW(pB0,8),PKW(pB0,10),PKW(pB0,12),PKW(pB0,14)};pw2=(u32x4){PKW(pB1,0),PKW(pB1,2),PKW(pB1,4),PKW(pB1,6)};pw3=(u32x4){PKW(pB1,8),PKW(pB1,10),PKW(pB1,12),PKW(pB1,14)};
    SBAR(); pv(o,vb0+sl_cur,PAF(0),PAF(1),PAF(2),PAF(3)); }
  #undef PKW
  #undef PAF
  #undef VFR
  #undef PIN
  #undef MX3
  #undef GAPA
  #undef GAPB
  #undef EX
  #undef VRD
  #undef KRD
  #undef STEP
  #undef ENDW
  {auto rr=__builtin_amdgcn_permlane32_swap(__float_as_uint(l_reg),__float_as_uint(l_reg),false,false);l_reg=__uint_as_float(rr[0])+__uint_as_float(rr[1]);}
  if(hi==0)wsf[32+r32]=l_reg;asm volatile("s_waitcnt lgkmcnt(0)":::"memory");
  float rli[16];
  #pragma unroll
  for(int r=0;r<16;++r)rli[r]=__builtin_amdgcn_rcpf(wsf[32+crow(r,hi)]);
  bf16*Ow=O+(rowbase+q0+wid*QBLK)*POUT+h*D; float*Sw=SSQh+(rowbase+q0+wid*QBLK)*16;
  { bf16*stg=(bf16*)(shm+LDS_OST)+wid*2048;
    #pragma unroll
    for(int r=0;r<16;++r){const int orow=crow(r,hi);
      #pragma unroll
      for(int d0=0;d0<2;++d0)stg[orow*64+d0*32+r32]=__float2bfloat16(o[d0][r]*rli[r]);}
    asm volatile("s_waitcnt lgkmcnt(0)":::"memory");
    #pragma unroll
    for(int i=0;i<4;++i){const int row=i*8+(lane>>3),ch=lane&7; const u32x4 v=*(const u32x4*)(stg+row*64+ch*8); ATTN_STORE16(Ow+(long)row*POUT+ch*8,v);
      float sq=0.f;
      #pragma unroll
      for(int w_=0;w_<4;++w_){const float lo_=__uint_as_float(v[w_]<<16),hi_=__uint_as_float(v[w_]&0xffff0000u);sq+=lo_*lo_+hi_*hi_;}
      sq+=__shfl_xor(sq,1);sq+=__shfl_xor(sq,2);sq+=__shfl_xor(sq,4); if(ch==0)Sw[row*16]=sq;} }
  asm volatile("s_waitcnt lgkmcnt(0)\n\ts_barrier":::"memory");
  #undef DMA_K
  #undef DMA_V
  #undef CMASK
  #undef BIAS
  #undef START
  #undef RESC
  #undef ROT
}
constexpr int ATTN_LDS_BYTES=LDS_BYTES;

__device__ __forceinline__ void sb_unit(int b,int h,int qb,const bf16*Q,const bf16*__restrict__ K,const bf16*__restrict__ V,bf16*O,float*__restrict__ SSQh,char*shm){
  int tid_=threadIdx.x; asm volatile("":"+v"(tid_));
  const int tid=tid_,lane=tid&63,r32=lane&31,hi=lane>>5; const int wid=__builtin_amdgcn_readfirstlane(tid>>6);
  const long rowbase=(long)b*SEQ; const int q0=qb*QB;
  const bf16*Qw=Q+(rowbase+q0+wid*QBLK)*PIN+h*D;
  const bf16*Kh=K+rowbase*PIN+h*D,*Vh=V+rowbase*PIN+h*D;
  const unsigned lds0=(unsigned)(uintptr_t)shm;
  const bf16*ksrc=Kh+(long)lane*PIN+wid*8;
  const bf16*vsrc=Vh+(long)(16*(wid&3)+(lane>>2))*PIN+(wid>>2)*32+(lane&3)*8;
  const unsigned kdst=lds0+LDS_K+wid*1024, vdst=lds0+LDS_V+wid*1024;
  const int vb0=(int)(lds0+LDS_V)+((lane>>4)&1)*32+(lane&3)*8+(4*hi+((lane&15)>>2))*64;
  const char*Kbase=shm+LDS_K;
  const int NT=(q0+QB)/KVBLK;
  #define SB_DMA(i,slot) do{ const long kt_=(long)(NT-1-(i)); glds16(ksrc+kt_*KVBLK*PIN,(unsigned)__builtin_amdgcn_readfirstlane(kdst+(slot))); glds16(vsrc+kt_*KVBLK*PIN,(unsigned)__builtin_amdgcn_readfirstlane(vdst+(slot))); }while(0)
  bf16x8 qr[4];
  #pragma unroll
  for(int d0=0;d0<4;++d0)qr[d0]=*reinterpret_cast<const bf16x8*>(&Qw[(long)r32*PIN+d0*16+hi*8]);
  SB_DMA(0,0); SB_DMA(1,SLOTB);
  f32x16 o[2];o[0]=f32x16{};o[1]=f32x16{};
  float Rc=1.f;
  const int qrel=wid*QBLK+r32;
  int sl_cur=0,sl_n1=SLOTB,sl_n2=2*SLOTB;
  for(int i=0;i<NT;++i){
    if(i+1<NT){WAIT_BAR(2);}else{WAIT_BAR(0);}
    if(i+2<NT)SB_DMA(i+2,sl_n2);
    f32x16 p0,p1; { f32x16 z=f32x16{}; asm volatile("":"+v"(z)); qkt(p0,p1,Kbase+sl_cur,qr,z,r32,hi); }
    f32x16 s0,s1;
    #pragma unroll
    for(int r=0;r<16;++r){
      const float za=__builtin_amdgcn_fmed3f(p0[r],-100.f,100.f), zb=__builtin_amdgcn_fmed3f(p1[r],-100.f,100.f);
      p0[r]=__builtin_amdgcn_exp2f(za); p1[r]=__builtin_amdgcn_exp2f(zb);
      s0[r]=__builtin_amdgcn_rcpf(1.f+p0[r]); s1[r]=__builtin_amdgcn_rcpf(1.f+p1[r]); }
    if(i<4){
      const int kb=64*(3-i)+4*hi;
      #pragma unroll
      for(int r=0;r<16;++r){ const int kv=kb+(r&3)+8*(r>>2); if(kv>=qrel){p0[r]=0.f;s0[r]=1.f;} if(kv+32>=qrel){p1[r]=0.f;s1[r]=1.f;} }
    }
    float gp[8],pp[8];
    #pragma unroll
    for(int g=0;g<4;++g){
      s0[4*g+2]*=s0[4*g+3]; s0[4*g+1]*=s0[4*g+2]; s0[4*g]*=s0[4*g+1]; gp[g]=s0[4*g];
      s1[4*g+2]*=s1[4*g+3]; s1[4*g+1]*=s1[4*g+2]; s1[4*g]*=s1[4*g+1]; gp[4+g]=s1[4*g]; }
    #pragma unroll
    for(int g=0;g<8;++g){ auto rr=__builtin_amdgcn_permlane32_swap(__float_as_uint(gp[g]),__float_as_uint(gp[g]),false,false); pp[g]=__uint_as_float(hi?rr[0]:rr[1]); }
    float st=Rc, outer[8];
    #pragma unroll
    for(int g=7;g>=0;--g){ outer[g]=hi?st:st*pp[g]; st=st*(gp[g]*pp[g]); }
    Rc=st;
    #pragma unroll
    for(int r=0;r<16;++r){ p0[r]=p0[r]*(s0[r]*outer[r>>2]); p1[r]=p1[r]*(s1[r]*outer[4+(r>>2)]); }
    u32x4 pw0,pw1,pw2,pw3;
    pw0=(u32x4){cvtpk_s(p0[0],p0[1]),cvtpk_s(p0[2],p0[3]),cvtpk_s(p0[4],p0[5]),cvtpk_s(p0[6],p0[7])};
    pw1=(u32x4){cvtpk_s(p0[8],p0[9]),cvtpk_s(p0[10],p0[11]),cvtpk_s(p0[12],p0[13]),cvtpk_s(p0[14],p0[15])};
    pw2=(u32x4){cvtpk_s(p1[0],p1[1]),cvtpk_s(p1[2],p1[3]),cvtpk_s(p1[4],p1[5]),cvtpk_s(p1[6],p1[7])};
    pw3=(u32x4){cvtpk_s(p1[8],p1[9]),cvtpk_s(p1[10],p1[11]),cvtpk_s(p1[12],p1[13]),cvtpk_s(p1[14],p1[15])};
    SBAR(); pv(o,vb0+sl_cur,__builtin_bit_cast(bf16x8,pw0),__builtin_bit_cast(bf16x8,pw1),__builtin_bit_cast(bf16x8,pw2),__builtin_bit_cast(bf16x8,pw3));
    { const int t_=sl_cur; sl_cur=sl_n1; sl_n1=sl_n2; sl_n2=t_; }
  }
  #undef SB_DMA
  bf16*Ow=O+(rowbase+q0+wid*QBLK)*POUT+h*D; float*Sw=SSQh+(rowbase+q0+wid*QBLK)*16;
  { bf16*stg=(bf16*)(shm+LDS_OST)+wid*2048;
    #pragma unroll
    for(int r=0;r<16;++r){const int orow=crow(r,hi);
      #pragma unroll
      for(int d0=0;d0<2;++d0)stg[orow*64+d0*32+r32]=__float2bfloat16(o[d0][r]);}
    asm volatile("s_waitcnt lgkmcnt(0)":::"memory");
    #pragma unroll
    for(int i=0;i<4;++i){const int row=i*8+(lane>>3),ch=lane&7; const u32x4 v=*(const u32x4*)(stg+row*64+ch*8); ATTN_STORE16(Ow+(long)row*POUT+ch*8,v);
      float sq=0.f;
      #pragma unroll
      for(int w_=0;w_<4;++w_){const float lo_=__uint_as_float(v[w_]<<16),hi_=__uint_as_float(v[w_]&0xffff0000u);sq+=lo_*lo_+hi_*hi_;}
      sq+=__shfl_xor(sq,1);sq+=__shfl_xor(sq,2);sq+=__shfl_xor(sq,4); if(ch==0)Sw[row*16]=sq;} }
  asm volatile("s_waitcnt lgkmcnt(0)\n\ts_barrier":::"memory");
}
template<int THRL=8> __device__ __forceinline__ void attn_phase(char*lds,const bf16*PROJ,const float*CUM,bf16*OMIX,float*SSQ,int vcu){
  const int bh=vcu>>3,s=vcu&7,b=bh>>3,h=bh&7;
  if(bh>=32)return;
  for(int i=0;i<4;++i){ const int qb=(i&1)?15-s:s;
    if(i<2)attn_unit<THRL>(b,h,qb,PROJ,PROJ+512,PROJ+1024,OMIX,CUM+(size_t)bh*SEQ,SSQ+h,lds);
    else   sb_unit(b,h,qb,PROJ+1536,PROJ+2048,PROJ+2560,OMIX+512,SSQ+8+h,lds); }
}

#undef SBAR
#undef WAIT_BAR
}
__global__ void __launch_bounds__(NTHREADS, 2) mega_fwd(Args a) {
    extern __shared__ __attribute__((aligned(16))) unsigned char lds[];
    LAS unsigned char* L = (LAS unsigned char*)lds;
    volatile LAS unsigned* MISC = (volatile LAS unsigned*)(L + MISC_OFF);
    const int tid = threadIdx.x, lane = tid & 63, wave = __builtin_amdgcn_readfirstlane(tid >> 6);
    const int G = gridDim.x, bx = blockIdx.x, vcu = (G % 8 == 0) ? (bx % 8) * (G / 8) + bx / 8 : bx;
    const int gw = vcu * NWAVES + wave, NGW = G * NWAVES;
    unsigned char* ws = a.ws;
    unsigned* CTL = (unsigned*)(ws + WS_CTL);
    bf16_t* WINT = (bf16_t*)(ws + WS_WINT); bf16_t* WOUTT = (bf16_t*)(ws + WS_WOUTT); float* WR = (float*)(ws + WS_WR); float* CUM = (float*)(ws + WS_CUM);
    float* SSQ = (float*)(ws + WS_SSQ); float* RSTD2 = (float*)(ws + WS_RSTD2); float* RW = (float*)(ws + WS_RW); int* LIST = (int*)(ws + WS_LIST); float* FLOG = (float*)(ws + WS_FLOG);
    bf16_t* XN = (bf16_t*)(ws + WS_XN); bf16_t* PROJ = (bf16_t*)(ws + WS_PROJ); bf16_t* OMIX = (bf16_t*)(ws + WS_OMIX); bf16_t* X1B = (bf16_t*)(ws + WS_X1B);
    bf16_t* W1T = (bf16_t*)(ws + WS_W1T); bf16_t* W2T = (bf16_t*)(ws + WS_W2T); bf16_t* H = (bf16_t*)(ws + WS_H); bf16_t* Y = (bf16_t*)(ws + WS_Y);
    unsigned* CNT = CTL + CW_CNT;
    for (int u = tid; u < (LDS_BYTES - LDSCTL_OFF) / 4; u += NTHREADS) ((LAS unsigned*)(L + LDSCTL_OFF))[u] = 0u;
    __syncthreads();
    XcdBarrier bar = xcd_barrier_post(CTL + CW_BAR, MISC + 8);

    {
        LAS float* scr = (LAS float*)(L + RING_OFF + wave * 16384);
        constexpr int I_IN = (DM / 64) * (NPROJ / 32), I_OUT = (DM / 64) * (DM / 32), I_W1 = (DM / 64) * (2048 / 32), I_W2 = (DM / 64) * (DM / 32);
        constexpr int NITEMS = I_IN + I_OUT + NE * I_W1 + NE * I_W2;
        for (int it = gw; it < NITEMS; it += NGW) {
            int r = it;
            if (r < I_IN) { transpose_item(a.w_in, DM, WIN_N, NPROJ, 1, a.g1, nullptr, DM, WINT, scr, r, lane); continue; } r -= I_IN;
            if (r < I_OUT) { transpose_item(a.w_out, DM, DM, DM, 0, a.g_fox, a.g_sb, GW, WOUTT, scr, r, lane); continue; } r -= I_OUT;
            if (r < NE * I_W1) { const int e = r / I_W1; transpose_item(a.w1 + (size_t)e * DM * 2048, DM, 2048, 2048, 2, a.g2, nullptr, DM, W1T + (size_t)e * 2048 * DM, scr, r % I_W1, lane); continue; } r -= NE * I_W1;
            { const int e = r / I_W2; transpose_item(a.w2 + (size_t)e * DM * DM, DM, DM, DM, 0, nullptr, nullptr, DM, W2T + (size_t)e * DM * DM, scr, r % I_W2, lane); }
        }
        for (int i = gw * 64 + lane; i < DM * NE; i += NGW * 64) WR[i] = a.w_router[i] * a.g2[i >> 5];
        for (int row = gw; row < M; row += NGW) rms1_row(a.x, a.g1, a.w_in, a.b_f, XN, FLOG, row, lane);
    }
    xcd_barrier(bar);
    if (vcu < NB * NH) cumsum_wg(FLOG, CUM, vcu, (LAS float*)(L + RING_OFF));
    if (OPT_GEMM) {
        pg8::Gemm g{XN, WINT, DM}; pg8::StaticOrder S; S.init(M, NPROJ, G, bx); pg8::EpiProj E{PROJ};
        pg8::gemm_phase<pg8::EpiProj, pg8::StaticOrder, true, false>(L + RING_OFF, g, S, E);
    } else { for (int it = gw; it < (M / 16) * (NPROJ / 64); it += NGW) nv_inproj(XN, WINT, PROJ, it, lane); }
    xcd_barrier(bar);
    if (OPT_ATTN) {
        static_assert(attn_body::ATTN_LDS_BYTES <= RING_BYTES, "attention scratch inside the ring region");
        attn_body::attn_phase<8>((char*)lds + RING_OFF, (const attn_body::bf16*)PROJ, CUM, (attn_body::bf16*)OMIX, SSQ, vcu);
    } else {
        LAS unsigned char* wl = L + RING_OFF + wave * 16640;
        for (int u = gw; u < 4096; u += NGW) {
            const int i = u >> 11, idx = u & 2047, type = idx & 1, bh = (idx >> 1) & 31, j = (idx >> 6) & 31; const int qblk = (i == 0) ? j : 63 - j;
            if (type == 0) nv_attn<0>(PROJ, CUM, OMIX, SSQ, bh, qblk, lane, wl); else nv_attn<1>(PROJ, CUM, OMIX, SSQ, bh, qblk, lane, wl);
        }
    }
    xcd_barrier(bar);
    if (OPT_GEMM) {
        pg8::Gemm g{OMIX, WOUTT, DM}; pg8::StaticOrder S; S.init(M, DM, G, bx);
        LAS float* ratio = (LAS float*)(L + TAB_OFF); LAS float* rsb = (LAS float*)(L + TAB_OFF + 1024);
        pg8::Unit u0;
        if (S.next(0, u0) && tid < 256) { const float* sp = SSQ + (size_t)(u0.pm * 256 + tid) * 16; float sf = 0.f, s2 = 0.f;
#pragma unroll
            for (int h = 0; h < 8; ++h) { sf += sp[h]; s2 += sp[8 + h]; }
            const float rf = rsqrtf(sf * (1.f / GW) + EPS), rs = rsqrtf(s2 * (1.f / GW) + EPS); ratio[tid] = rf / rs; rsb[tid] = rs; }
        VM_WAIT(); LDS_WAIT(); __syncthreads();
        pg8::EpiWout E{a.x, a.out, X1B, ratio, rsb};
        pg8::gemm_phase<pg8::EpiWout, pg8::StaticOrder, false, false>(L + RING_OFF, g, S, E);
    } else { for (int it = gw; it < (M / 16) * (DM / 64); it += NGW) nv_wout(OMIX, WOUTT, SSQ, a.x, a.out, X1B, it, lane); }
    xcd_barrier(bar);
    for (int it = gw; it < M / 2; it += NGW) nv_router(a.out, WR, a.b_router, RSTD2, RW, LIST, CNT, it, lane);
    xcd_barrier(bar);
    LAS int* tb = (LAS int*)(L + TB_OFF); LAS int* tabA = (LAS int*)(L + TAB_OFF); LAS int* tabB = (LAS int*)(L + TAB2_OFF);
    if (OPT_GEMM) {
        if (tid == 0) { int run = 0; for (int e = 0; e < NE; ++e) { tb[e] = run; run += ((int)CNT[e] + 255) >> 8; } tb[NE] = run; }
        __syncthreads();
        pg8::MoeOrder S{8, bx, tb[NE] * 8, tb, tabA}; pg8::Unit u;
        for (int ui = 0; S.next(ui, u); ++ui) { const int e = u.pn >> 3, mt = u.pm - tb[e], cnt = (int)CNT[e];
            if (tid < 256) { const int p = mt * 256 + tid; const int slot = LIST[(size_t)e * LIST_CAP + (p < cnt ? p : cnt - 1)]; tabA[ui * 256 + tid] = slot >> 2; ((LAS float*)tabB)[ui * 256 + tid] = RSTD2[slot >> 2]; } }
        VM_WAIT(); LDS_WAIT(); __syncthreads();
        pg8::Gemm g{X1B, W1T, DM}; pg8::EpiMoe1 E{H, a.b1, (const LAS float*)tabB};
        pg8::gemm_phase<pg8::EpiMoe1, pg8::MoeOrder, true, true>(L + RING_OFF, g, S, E);
    } else {
    for (int g = gw; g < MAX_TILES * 16; g += NGW) {
        int e, base, p0, cnt; if (!moe_tile(CNT, g, e, base, p0, cnt)) continue;
        for (int cg = 0; cg < DFF / 32; ++cg) nv_moe1(X1B, W1T, a.b1, RSTD2, LIST, H, e, base, p0, cnt, cg, lane);
    } }
    xcd_barrier(bar);
    if (OPT_GEMM) {
        pg8::MoeOrder S{4, bx, tb[NE] * 4, tb, tabA}; pg8::Unit u;
        for (int ui = 0; S.next(ui, u); ++ui) { const int e = u.pn >> 2, mt = u.pm - tb[e], cnt = (int)CNT[e];
            if (tid < 256) { const int p = mt * 256 + tid; const int slot = LIST[(size_t)e * LIST_CAP + (p < cnt ? p : cnt - 1)]; tabA[ui * 256 + tid] = p < cnt ? slot : -1; ((LAS float*)tabB)[ui * 256 + tid] = RW[slot]; } }
        VM_WAIT(); LDS_WAIT(); __syncthreads();
        pg8::Gemm g{H, W2T, DM}; pg8::EpiMoe2 E{Y, a.b2, tabA, (const LAS float*)tabB};
        pg8::gemm_phase<pg8::EpiMoe2, pg8::MoeOrder, true, false>(L + RING_OFF, g, S, E);
    } else {
    for (int g = gw; g < MAX_TILES * 16; g += NGW) {
        int e, base, p0, cnt; if (!moe_tile(CNT, g, e, base, p0, cnt)) continue;
        for (int cg = 0; cg < DM / 64; ++cg) nv_moe2(H, W2T, a.b2, RW, LIST, Y, e, base, p0, cnt, cg, lane);
    } }
    xcd_barrier(bar);
    for (int row = gw; row < M; row += NGW) final_row(a.out, Y, a.gf, a.out, row, lane);
}

extern "C" void kernel_launch(void* const* d_in, const int* in_sizes, int n_in, void* d_out, int out_size, void* d_ws, size_t ws_size, hipStream_t stream) {
    static int grid = 0;
    if (grid == 0) {
        if (n_in != 15 || in_sizes[0] != M * DM || out_size != M * DM || ws_size < WS_END) {
            fprintf(stderr, "kernel_launch: unexpected shapes / workspace (n_in %d, in0 %d, out %d, ws %zu, need %zu)\n", n_in, n_in > 0 ? in_sizes[0] : -1, out_size, ws_size, (size_t)WS_END); grid = -1; return; }
        int dev = 0, cus = 0, per_cu = 0;
        if (hipGetDevice(&dev) != hipSuccess || hipDeviceGetAttribute(&cus, hipDeviceAttributeMultiprocessorCount, dev) != hipSuccess) { grid = -1; return; }
        if (hipFuncSetAttribute((const void*)mega_fwd, hipFuncAttributeMaxDynamicSharedMemorySize, LDS_BYTES) != hipSuccess) { fprintf(stderr, "kernel_launch: hipFuncSetAttribute failed\n"); grid = -1; return; }
        if (hipOccupancyMaxActiveBlocksPerMultiprocessor(&per_cu, (const void*)mega_fwd, NTHREADS, LDS_BYTES) != hipSuccess || per_cu < 1) fprintf(stderr, "kernel_launch: occupancy query reports %d\n", per_cu);
        (void)hipGetLastError();
        grid = cus;
    }
    if (grid < 0) return;
    if (hipMemsetAsync((char*)d_ws + WS_CTL, 0, CTL_BYTES, stream) != hipSuccess) return;
    Args a{};
    a.x = (const float*)d_in[0]; a.g1 = (const float*)d_in[1]; a.w_in = (const float*)d_in[2]; a.b_f = (const float*)d_in[3]; a.g_fox = (const float*)d_in[4]; a.g_sb = (const float*)d_in[5];
    a.w_out = (const float*)d_in[6]; a.g2 = (const float*)d_in[7]; a.w_router = (const float*)d_in[8]; a.b_router = (const float*)d_in[9]; a.w1 = (const float*)d_in[10]; a.b1 = (const float*)d_in[11];
    a.w2 = (const float*)d_in[12]; a.b2 = (const float*)d_in[13]; a.gf = (const float*)d_in[14];
    a.out = (float*)d_out; a.ws = (unsigned char*)d_ws;
    hipLaunchKernelGGL(mega_fwd, dim3(grid), dim3(NTHREADS), LDS_BYTES, stream, a);
    const hipError_t le = hipPeekAtLastError();
    if (le != hipSuccess) fprintf(stderr, "kernel_launch: launch failed: %s\n", hipGetErrorName(le));
}
```

```cpp
#include <hip/hip_runtime.h>
#include <cstdio>
#include <cstdint>

typedef unsigned short bf16_t;
typedef short bf16x8 __attribute__((ext_vector_type(8)));
typedef float f32x4 __attribute__((ext_vector_type(4)));

constexpr int NB = 4, SEQ = 4096, DM = 1024, M = NB * SEQ;
constexpr int NH = 8, HD = 64, GW = 512;
constexpr int WIN_N = 3080, NPROJ = 3072;
constexpr int NE = 32, TOPK = 4, DFF = 1024;
constexpr float EPS = 1e-5f;
constexpr float LOG2E = 1.4426950408889634f;
constexpr float C2 = 0.125f * LOG2E;
constexpr int LIST_CAP = M;
constexpr int MAX_TILES = (M * TOPK) / 256 + NE;

constexpr size_t MiB = 1u << 20;
constexpr size_t WS_CTL = 0, CTL_BYTES = 1 * MiB;
constexpr size_t WS_WINT = 2 * MiB;
constexpr size_t WS_WOUTT = 8 * MiB;
constexpr size_t WS_WR = 10 * MiB;
constexpr size_t WS_CUM = 11 * MiB;
constexpr size_t WS_SSQ = 12 * MiB;
constexpr size_t WS_RSTD2 = 14 * MiB;
constexpr size_t WS_RW = 15 * MiB;
constexpr size_t WS_LIST = 16 * MiB;
constexpr size_t WS_FLOG = 18 * MiB;
constexpr size_t WS_XN = 32 * MiB;
constexpr size_t WS_PROJ = 64 * MiB;
constexpr size_t WS_OMIX = 160 * MiB;
constexpr size_t WS_X1B = 192 * MiB;
constexpr size_t WS_W1T = 224 * MiB;
constexpr size_t WS_W2T = 352 * MiB;
constexpr size_t WS_H = 416 * MiB;
constexpr size_t WS_Y = 560 * MiB;
constexpr size_t WS_END = 688 * MiB;
constexpr int CW_CNT = 1024;

__device__ __forceinline__ unsigned short f2bf(float f) { unsigned u = __float_as_uint(f); return (unsigned short)((u + 0x7fffu + ((u >> 16) & 1u)) >> 16); }
__device__ __forceinline__ float bf2f(unsigned short b) { return __uint_as_float(((unsigned)b) << 16); }
__device__ __forceinline__ float wave_sum(float v) {
#pragma unroll
    for (int o = 1; o < 64; o <<= 1) v += __shfl_xor(v, o);
    return v;
}


#define LAS __attribute__((address_space(3)))
#define GAS __attribute__((address_space(1)))
typedef unsigned v4u __attribute__((ext_vector_type(4)));
#define LDS_WAIT() asm volatile("s_waitcnt lgkmcnt(0)" ::: "memory")
#define VM_WAIT() asm volatile("s_waitcnt vmcnt(0)" ::: "memory")
constexpr int NWAVES = 8, NTHREADS = NWAVES * 64;
constexpr int REP_PHASE = -1;
#define REPS(k) for (int rep_ = 0; rep_ < ((REP_PHASE == (k)) ? 2 : 1); ++rep_)
constexpr bool OPT_GEMM = true;
constexpr bool OPT_ROUTER = true;
constexpr bool OPT_ATTN = true;

#define XB_TMO      128
#define XB_XCNT(j)  (256  + 64 * (j))
#define XB_XSUB(j)  (1280 + 64 * (j))
#define XB_XGEN(j)  (2304 + 64 * (j))
#define XB_TOP      3328
#define XB_TOPGEN   3392
#define XCD_BAR_WORDS 3456
#define XB_SPIN_CAP (1u << 20)
__device__ __forceinline__ unsigned xb_ld(unsigned* p)              { return __hip_atomic_load(p, __ATOMIC_RELAXED, __HIP_MEMORY_SCOPE_AGENT); }
__device__ __forceinline__ unsigned xb_add(unsigned* p, unsigned v) { return __hip_atomic_fetch_add(p, v, __ATOMIC_RELAXED, __HIP_MEMORY_SCOPE_AGENT); }
__device__ __forceinline__ unsigned xb_xcc_id() { return (unsigned)__builtin_amdgcn_s_getreg((3 << 11) | 20) & 0xFu; }
#define XB_SPIN(cond, bar) do { unsigned _sp = 0; while (cond) { __builtin_amdgcn_s_sleep(1); \
    if ((++_sp & 255u) == 0u) { if (xb_ld(&(bar)[XB_TMO])) break; if (_sp > XB_SPIN_CAP) { atomicAdd(&(bar)[XB_TMO], 1u); break; } } } } while (0)
struct XcdBarrier { unsigned* bar; unsigned x; volatile LAS unsigned* st; };
__device__ __forceinline__ XcdBarrier xcd_barrier_post(unsigned* bar, volatile LAS unsigned* st) {
    XcdBarrier b; b.bar = bar; b.x = xb_xcc_id(); b.st = st;
    if (threadIdx.x == 0) (void)xb_add(&bar[XB_XCNT(b.x)], 1u);
    return b;
}
__device__ __forceinline__ void xcd_barrier_complete(unsigned* bar, unsigned x, unsigned& nloc, unsigned& nx) {
    const unsigned G = gridDim.x * gridDim.y * gridDim.z;
    unsigned sum, cnt, mine, sp = 0u;
    for (;;) {
        sum = 0u; cnt = 0u; mine = 0u;
#pragma unroll
        for (unsigned j = 0; j < 16; ++j) { const unsigned c = xb_ld(&bar[XB_XCNT(j)]); sum += c; cnt += (c > 0u) ? 1u : 0u; mine = (j == x) ? c : mine; }
        if (sum == G) break;
        __builtin_amdgcn_s_sleep(1);
        if ((++sp & 255u) == 0u) { if (xb_ld(&bar[XB_TMO])) break; if (sp > XB_SPIN_CAP) { atomicAdd(&bar[XB_TMO], 1u); break; } }
    }
    nloc = mine > 0u ? mine : 1u; nx = cnt > 0u ? cnt : 1u;
}
__device__ __forceinline__ void xcd_barrier(const XcdBarrier& b) {
    asm volatile("s_waitcnt vmcnt(0)" ::: "memory");
    __syncthreads();
    if (threadIdx.x == 0) {
        unsigned* bar = b.bar;
        __builtin_amdgcn_s_waitcnt(0);
        unsigned nloc = b.st[0], nx = b.st[1];
        if (nloc == 0u) { xcd_barrier_complete(bar, b.x, nloc, nx); b.st[0] = nloc; b.st[1] = nx; }
        const unsigned old = xb_add(&bar[XB_XSUB(b.x)], 1u);
        const unsigned gen = old / nloc;
        if (old + 1u == (gen + 1u) * nloc) {
            __builtin_amdgcn_fence(__ATOMIC_RELEASE, "agent");
            asm volatile("s_waitcnt vmcnt(0)" ::: "memory");
            const unsigned og = xb_add(&bar[XB_TOP], 1u);
            const unsigned tg = og / nx;
            if (og + 1u == (tg + 1u) * nx) xb_add(&bar[XB_TOPGEN], 1u);
            else XB_SPIN(xb_ld(&bar[XB_TOPGEN]) == tg, bar);
            __builtin_amdgcn_fence(__ATOMIC_ACQUIRE, "agent");
            xb_add(&bar[XB_XGEN(b.x)], 1u);
            asm volatile("s_waitcnt vmcnt(0)" ::: "memory");
        } else {
            XB_SPIN(xb_ld(&bar[XB_XGEN(b.x)]) == gen, bar);
            __builtin_amdgcn_fence(__ATOMIC_ACQUIRE, "agent");
            asm volatile("s_waitcnt vmcnt(0)" ::: "memory");
        }
    }
    __syncthreads();
}

constexpr int RING_OFF = 0, RING_BYTES = 131072;
constexpr int TAB_OFF = 131072;
constexpr int TAB2_OFF = TAB_OFF + 9 * 1024, TB_OFF = TAB_OFF + 18 * 1024;
constexpr int LDSCTL_OFF = 150528, MISC_OFF = LDSCTL_OFF + 320;
constexpr int LDS_BYTES = 155648;
constexpr int CW_BAR = 4096;

struct Args {
    const float *x, *g1, *w_in, *b_f, *g_fox, *g_sb, *w_out, *g2, *w_router, *b_router, *w1, *b1, *w2, *b2, *gf;
    float* out; unsigned char* ws;
};

__device__ __forceinline__ int mapcol(int mode, int n) {
    if (mode == 1) return n < 1536 ? n : n + 8;
    if (mode == 2) { const int pn = n >> 8, j = n & 255; return j < 128 ? 128 * pn + j : 1024 + 128 * pn + (j - 128); }
    return n;
}
__device__ __forceinline__ unsigned pk2(float lo, float hi) { return (unsigned)f2bf(lo) | ((unsigned)f2bf(hi) << 16); }
__device__ __forceinline__ void transpose_item(const float* __restrict__ W, int K, int Nin, int Nout, int mode, const float* __restrict__ gA, const float* __restrict__ gB, int gsplit,
                                               bf16_t* __restrict__ WT, LAS float* scr, int item, int lane) {
    const int nblk = Nout / 32, kb = item / nblk, nb = item % nblk, k0 = 64 * kb, n0 = 32 * nb;
    const int l7 = lane & 7, kr = lane >> 3, col = mapcol(mode, n0 + 4 * l7);
    f32x4 v[8];
#pragma unroll
    for (int i = 0; i < 8; ++i) v[i] = *(const f32x4*)(W + (size_t)(k0 + 8 * i + kr) * Nin + col);
#pragma unroll
    for (int i = 0; i < 8; ++i) { const int kk = 8 * i + kr, k = k0 + kk; const float gs = gA ? (k < gsplit ? gA[k] : gB[k - gsplit]) : 1.f;
        LAS float* sp = scr + kk * 33 + 4 * l7; sp[0] = v[i][0] * gs; sp[1] = v[i][1] * gs; sp[2] = v[i][2] * gs; sp[3] = v[i][3] * gs; }
    LDS_WAIT();
    const int c = lane & 7;
#pragma unroll
    for (int j = 0; j < 4; ++j) { const int n = (lane >> 3) + 8 * j; const LAS float* sp = scr + (8 * c) * 33 + n;
        v4u o; o.x = pk2(sp[0 * 33], sp[1 * 33]); o.y = pk2(sp[2 * 33], sp[3 * 33]); o.z = pk2(sp[4 * 33], sp[5 * 33]); o.w = pk2(sp[6 * 33], sp[7 * 33]);
        *(v4u*)(WT + (size_t)(n0 + n) * K + k0 + 8 * c) = o; }
    LDS_WAIT();
}

__device__ __forceinline__ float log_sigmoid(float v) { return fminf(v, 0.f) - log1pf(expf(-fabsf(v))); }
__device__ __forceinline__ void rms1_row(const float* __restrict__ x, const LAS float* wf  , const float* __restrict__ b_f,
                                         bf16_t* __restrict__ XN, float* __restrict__ FLOG, int row, int lane) {
    const float4* xr = (const float4*)(x + (size_t)row * DM);
    float4 v[4]; float ss = 0.f;
#pragma unroll
    for (int j = 0; j < 4; ++j) { v[j] = xr[lane + 64 * j]; ss += v[j].x * v[j].x + v[j].y * v[j].y + v[j].z * v[j].z + v[j].w * v[j].w; }
    ss = wave_sum(ss);
    const float rstd = rsqrtf(ss * (1.f / DM) + EPS);
    float f0 = 0.f, f1 = 0.f, f2 = 0.f, f3 = 0.f, f4 = 0.f, f5 = 0.f, f6 = 0.f, f7 = 0.f;
#pragma unroll
    for (int j = 0; j < 4; ++j) {
        const int c0 = 4 * (lane + 64 * j);
        uint2 o; o.x = pk2(v[j].x * rstd, v[j].y * rstd); o.y = pk2(v[j].z * rstd, v[j].w * rstd);
        *(uint2*)(XN + (size_t)row * DM + c0) = o;
        const float xs[4] = {v[j].x, v[j].y, v[j].z, v[j].w};
#pragma unroll
        for (int c = 0; c < 4; ++c) {
            const int k = c0 + c; const float xv = xs[c];
            const LAS f32x4* wp = (const LAS f32x4*)(wf + k * 8); const f32x4 w0 = wp[0], w1 = wp[1];
            f0 += xv * w0.x; f1 += xv * w0.y; f2 += xv * w0.z; f3 += xv * w0.w; f4 += xv * w1.x; f5 += xv * w1.y; f6 += xv * w1.z; f7 += xv * w1.w;
        }
    }
    f0 = wave_sum(f0); f1 = wave_sum(f1); f2 = wave_sum(f2); f3 = wave_sum(f3); f4 = wave_sum(f4); f5 = wave_sum(f5); f6 = wave_sum(f6); f7 = wave_sum(f7);
    if (lane < 8) {
        float f = f0; f = lane == 1 ? f1 : f; f = lane == 2 ? f2 : f; f = lane == 3 ? f3 : f; f = lane == 4 ? f4 : f; f = lane == 5 ? f5 : f; f = lane == 6 ? f6 : f; f = lane == 7 ? f7 : f;
        FLOG[(size_t)row * 8 + lane] = log_sigmoid(f * rstd + b_f[lane]);
    }
}
__device__ __forceinline__ void cumsum_wg(const float* __restrict__ FLOG, float* __restrict__ CUM, int bh, LAS float* part) {
    const int b = bh >> 3, h = bh & 7, t = threadIdx.x;
    float loc[8]; float s = 0.f;
#pragma unroll
    for (int i = 0; i < 8; ++i) { loc[i] = FLOG[((size_t)b * SEQ + t * 8 + i) * 8 + h]; s += loc[i]; }
    part[t] = s; __syncthreads();
    float run = 0.f; for (int i = 0; i < t; ++i) run += part[i];
#pragma unroll
    for (int i = 0; i < 8; ++i) { run += loc[i]; CUM[(size_t)bh * SEQ + t * 8 + i] = run * LOG2E; }
    __syncthreads();
}

template <int NT> __device__ __forceinline__ void wave_mma(f32x4 (&acc)[NT], const bf16_t* ap, const bf16_t* const (&bp)[NT], int K) {
    for (int k0 = 0; k0 < K; k0 += 32) {
        const bf16x8 a = *(const bf16x8*)(ap + k0);
#pragma unroll
        for (int t = 0; t < NT; ++t) { const bf16x8 b = *(const bf16x8*)(bp[t] + k0); acc[t] = __builtin_amdgcn_mfma_f32_16x16x32_bf16(a, b, acc[t], 0, 0, 0); }
    }
}
__device__ __forceinline__ void nv_inproj(const bf16_t* __restrict__ XN, const bf16_t* __restrict__ WINT, bf16_t* __restrict__ PROJ, int item, int lane) {
    const int n0 = (item % 48) * 64, m0 = (item / 48) * 16, r = lane & 15, q = lane >> 4;
    f32x4 acc[4];
#pragma unroll
    for (int t = 0; t < 4; ++t) acc[t] = (f32x4){0.f, 0.f, 0.f, 0.f};
    const bf16_t* ap = XN + (size_t)(m0 + r) * DM + 8 * q;
    const bf16_t* bp[4];
#pragma unroll
    for (int t = 0; t < 4; ++t) bp[t] = WINT + (size_t)(n0 + 16 * t + r) * DM + 8 * q;
    wave_mma<4>(acc, ap, bp, DM);
    const float sc = (n0 < 512 || (n0 >= 1536 && n0 < 2048)) ? C2 : 1.f;
#pragma unroll
    for (int t = 0; t < 4; ++t)
#pragma unroll
        for (int j = 0; j < 4; ++j) PROJ[(size_t)(m0 + 4 * q + j) * NPROJ + n0 + 16 * t + r] = f2bf(acc[t][j] * sc);
}

template <int TYPE> __device__ __forceinline__ void nv_attn(const bf16_t* __restrict__ PROJ, const float* __restrict__ CUM, bf16_t* __restrict__ OMIX, float* __restrict__ SSQ,
                                                          int bh, int qblk, int lane, LAS unsigned char* wl) {
    LAS bf16_t* Ks = (LAS bf16_t*)wl; LAS bf16_t* Vs = (LAS bf16_t*)(wl + 8192); LAS float* Cs = (LAS float*)(wl + 16384);
    const int b = bh >> 3, h = bh & 7, t = qblk * 64 + lane;
    const size_t row = (size_t)b * SEQ + t;
    const int qcol = (TYPE == 0 ? 0 : 1536) + h * HD, kcol = qcol + 512, vcol = qcol + 1024;
    float q[64], o[64];
#pragma unroll
    for (int c = 0; c < 8; ++c) { const bf16x8 v = *(const bf16x8*)(PROJ + row * NPROJ + qcol + 8 * c);
#pragma unroll
        for (int j = 0; j < 8; ++j) q[8 * c + j] = bf2f((unsigned short)v[j]); }
#pragma unroll
    for (int d = 0; d < 64; ++d) o[d] = 0.f;
    float m = -INFINITY, l = 0.f, R = 1.f;
    const float cq = CUM[(size_t)bh * SEQ + t];
    for (int it = 0; it <= qblk; ++it) {
        const int kt = (TYPE == 0) ? it : qblk - it;
        LDS_WAIT();
        for (int i = 0; i < 64; ++i) { const size_t kr = ((size_t)b * SEQ + kt * 64 + i) * NPROJ; Ks[i * 64 + lane] = PROJ[kr + kcol + lane]; Vs[i * 64 + lane] = PROJ[kr + vcol + lane]; }
        Cs[lane] = CUM[(size_t)bh * SEQ + kt * 64 + lane];
        LDS_WAIT();
        for (int ss = 0; ss < 64; ++ss) {
            const int s = (TYPE == 0) ? ss : 63 - ss; const int ks = kt * 64 + s;
            float dot = 0.f;
#pragma unroll
            for (int d = 0; d < 64; d += 8) { const bf16x8 kv = *(const LAS bf16x8*)&Ks[s * 64 + d];
#pragma unroll
                for (int j = 0; j < 8; ++j) dot += q[d + j] * bf2f((unsigned short)kv[j]); }
            if (TYPE == 0) {
                if (ks <= t) {
                    const float xv = dot + cq - Cs[s]; const float mn = fmaxf(m, xv); const float sc = exp2f(m - mn), p = exp2f(xv - mn);
                    l = l * sc + p; m = mn;
#pragma unroll
                    for (int d = 0; d < 64; d += 8) { const bf16x8 vv = *(const LAS bf16x8*)&Vs[s * 64 + d];
#pragma unroll
                        for (int j = 0; j < 8; ++j) o[d + j] = o[d + j] * sc + p * bf2f((unsigned short)vv[j]); }
                }
            } else {
                if (ks < t) {
                    const float z = fminf(fmaxf(dot, -80.f), 80.f); const float e = exp2f(z); const float rr = 1.f / (1.f + e); const float a = e * rr * R; R *= rr;
#pragma unroll
                    for (int d = 0; d < 64; d += 8) { const bf16x8 vv = *(const LAS bf16x8*)&Vs[s * 64 + d];
#pragma unroll
                        for (int j = 0; j < 8; ++j) o[d + j] += a * bf2f((unsigned short)vv[j]); }
                }
            }
        }
    }
    const float inv = (TYPE == 0) ? 1.f / l : 1.f;
    float ssq = 0.f;
#pragma unroll
    for (int d = 0; d < 64; ++d) { o[d] *= inv; ssq += o[d] * o[d]; }
    SSQ[row * 16 + TYPE * 8 + h] = ssq;
#pragma unroll
    for (int c = 0; c < 8; ++c) { bf16x8 v;
#pragma unroll
        for (int j = 0; j < 8; ++j) v[j] = (short)f2bf(o[8 * c + j]);
        *(bf16x8*)(OMIX + row * DM + TYPE * GW + h * HD + 8 * c) = v; }
}

__device__ __forceinline__ void nv_wout(const bf16_t* __restrict__ OMIX, const bf16_t* __restrict__ WOUTT, const float* __restrict__ SSQ, const float* __restrict__ x,
                                        float* __restrict__ X1, bf16_t* __restrict__ X1B, int item, int lane) {
    const int n0 = (item & 15) * 64, m0 = (item >> 4) * 16, r = lane & 15, q = lane >> 4;
    f32x4 af[4], as[4];
#pragma unroll
    for (int t = 0; t < 4; ++t) { af[t] = (f32x4){0.f, 0.f, 0.f, 0.f}; as[t] = (f32x4){0.f, 0.f, 0.f, 0.f}; }
    const bf16_t* ap = OMIX + (size_t)(m0 + r) * DM + 8 * q;
    const bf16_t* bp[4]; const bf16_t* bp2[4];
#pragma unroll
    for (int t = 0; t < 4; ++t) { bp[t] = WOUTT + (size_t)(n0 + 16 * t + r) * DM + 8 * q; bp2[t] = bp[t] + GW; }
    wave_mma<4>(af, ap, bp, GW);
    wave_mma<4>(as, ap + GW, bp2, GW);
#pragma unroll
    for (int j = 0; j < 4; ++j) {
        const size_t row = m0 + 4 * q + j; const float* sp = SSQ + row * 16;
        float sf = 0.f, s2 = 0.f;
#pragma unroll
        for (int h = 0; h < 8; ++h) { sf += sp[h]; s2 += sp[8 + h]; }
        const float rf = rsqrtf(sf * (1.f / GW) + EPS), rs = rsqrtf(s2 * (1.f / GW) + EPS);
#pragma unroll
        for (int t = 0; t < 4; ++t) { const size_t idx = row * DM + n0 + 16 * t + r; const float v = x[idx] + rf * af[t][j] + rs * as[t][j]; X1[idx] = v; X1B[idx] = f2bf(v); }
    }
}

__device__ __forceinline__ void nv_router(const float* __restrict__ X1, const float* __restrict__ WR, const float* __restrict__ b_router, float* __restrict__ RSTD2,
                                          float* __restrict__ RW, int* __restrict__ LIST, unsigned* __restrict__ CNT, int item, int lane) {
    const int e = lane & 31, tok = item * 2 + (lane >> 5);
    const float* xr = X1 + (size_t)tok * DM;
    float acc = 0.f, ss = 0.f;
    for (int k = 0; k < DM; ++k) { const float xv = xr[k]; acc += xv * WR[k * NE + e]; ss += xv * xv; }
    const float rstd = rsqrtf(ss * (1.f / DM) + EPS);
    float logit = acc * rstd + b_router[e];
    if (e == 0) RSTD2[tok] = rstd;
    float tv[4]; int ti[4];
#pragma unroll
    for (int k = 0; k < 4; ++k) {
        float bv = logit; int bi = e;
#pragma unroll
        for (int o = 1; o < 32; o <<= 1) { const float ov = __shfl_xor(bv, o); const int oi = __shfl_xor(bi, o); if (ov > bv || (ov == bv && oi < bi)) { bv = ov; bi = oi; } }
        tv[k] = bv; ti[k] = bi; if (e == bi) logit = -INFINITY;
    }
    const float e0 = 1.f, e1 = expf(tv[1] - tv[0]), e2 = expf(tv[2] - tv[0]), e3 = expf(tv[3] - tv[0]); const float inv = 1.f / (e0 + e1 + e2 + e3);
    const float w0 = e0 * inv, w1 = e1 * inv, w2 = e2 * inv, w3 = e3 * inv;
    int myk = -1; float myw = 0.f;
    if (e == ti[0]) { myk = 0; myw = w0; } if (e == ti[1]) { myk = 1; myw = w1; } if (e == ti[2]) { myk = 2; myw = w2; } if (e == ti[3]) { myk = 3; myw = w3; }
    if (myk >= 0) { const int slot = tok * 4 + myk; const unsigned pos = atomicAdd(&CNT[e], 1u); LIST[(size_t)e * LIST_CAP + pos] = slot; RW[slot] = myw; }
}


typedef float f32x16 __attribute__((ext_vector_type(16)));
__device__ __forceinline__ void router_wg(const float* __restrict__ X1, const float* __restrict__ WR, const float* __restrict__ b_router, float* __restrict__ RSTD2,
                                          float* __restrict__ RW, int* __restrict__ LIST, unsigned* __restrict__ CNT, int tokbase, LAS unsigned char* L) {
    int tid_ = threadIdx.x; asm volatile("" : "+v"(tid_));
    const int tid = tid_, lane = tid & 63, wave = __builtin_amdgcn_readfirstlane(tid >> 6), kq = wave & 3, tile = wave >> 2, r32 = lane & 31, hi = lane >> 5;
    LAS float* Dx = (LAS float*)L; LAS float* SSx = (LAS float*)(L + 32768); LAS unsigned* lcnt = (LAS unsigned*)(L + 33792); LAS unsigned* lbase = (LAS unsigned*)(L + 33920);
    if (tid < NE) lcnt[tid] = 0u;
    const int tok = tokbase + tile * 32 + r32;
    const float* xp = X1 + (size_t)tok * DM + kq * 256 + 4 * hi;
    const float* wp = WR + (size_t)(kq * 256 + 4 * hi) * NE + r32;
    f32x16 acc;
#pragma unroll
    for (int r = 0; r < 16; ++r) acc[r] = 0.f;
    float ss = 0.f;
#pragma unroll 1
    for (int mc = 0; mc < 4; ++mc) {
        float4 xv[8];
#pragma unroll
        for (int m = 0; m < 8; ++m) xv[m] = *(const float4*)(xp + (mc * 8 + m) * 8);
#pragma unroll
        for (int m = 0; m < 8; ++m) {
            const float* w4 = wp + (size_t)((mc * 8 + m) * 8) * NE;
            const float w0 = w4[0], w1 = w4[NE], w2 = w4[2 * NE], w3 = w4[3 * NE];
            acc = __builtin_amdgcn_mfma_f32_32x32x2f32(w0, xv[m].x, acc, 0, 0, 0);
            acc = __builtin_amdgcn_mfma_f32_32x32x2f32(w1, xv[m].y, acc, 0, 0, 0);
            acc = __builtin_amdgcn_mfma_f32_32x32x2f32(w2, xv[m].z, acc, 0, 0, 0);
            acc = __builtin_amdgcn_mfma_f32_32x32x2f32(w3, xv[m].w, acc, 0, 0, 0);
            ss += xv[m].x * xv[m].x + xv[m].y * xv[m].y + xv[m].z * xv[m].z + xv[m].w * xv[m].w;
        }
    }
    { auto rr = __builtin_amdgcn_permlane32_swap(__float_as_uint(ss), __float_as_uint(ss), false, false); ss = __uint_as_float(rr[0]) + __uint_as_float(rr[1]); }
#pragma unroll
    for (int r = 0; r < 16; ++r) Dx[(wave * 16 + r) * 64 + lane] = acc[r];
    if (hi == 0) SSx[wave * 32 + r32] = ss;
    LDS_WAIT(); __syncthreads();
    int ea = 0, eb = 0; float wa = 0.f, wb = 0.f; unsigned la = 0u, lb = 0u;
    if (kq == 0) {
        float v[16]; float sst = 0.f;
#pragma unroll
        for (int w = 0; w < 4; ++w) sst += SSx[(tile * 4 + w) * 32 + r32];
        const float rstd = rsqrtf(sst * (1.f / DM) + EPS);
#pragma unroll
        for (int r = 0; r < 16; ++r) { float a = 0.f;
#pragma unroll
            for (int w = 0; w < 4; ++w) a += Dx[((tile * 4 + w) * 16 + r) * 64 + lane];
            v[r] = a * rstd + b_router[(r & 3) + 8 * (r >> 2) + 4 * hi]; }
        if (hi == 0) RSTD2[tok] = rstd;
        float tv[4]; int te[4];
#pragma unroll
        for (int k = 0; k < 4; ++k) {
            float bv = v[0]; int br = 0;
#pragma unroll
            for (int r = 1; r < 16; ++r) if (v[r] > bv) { bv = v[r]; br = r; }
            const int be = (br & 3) + 8 * (br >> 2) + 4 * hi;
            auto r1 = __builtin_amdgcn_permlane32_swap(__float_as_uint(bv), __float_as_uint(bv), false, false);
            auto r2 = __builtin_amdgcn_permlane32_swap((unsigned)be, (unsigned)be, false, false);
            const float pv = __uint_as_float(hi ? r1[0] : r1[1]); const int pe = (int)(hi ? r2[0] : r2[1]);
            const bool mine = (bv > pv) || (bv == pv && be < pe);
            tv[k] = mine ? bv : pv; te[k] = mine ? be : pe;
#pragma unroll
            for (int r = 0; r < 16; ++r) v[r] = (mine && r == br) ? -INFINITY : v[r];
        }
        const float e1 = expf(tv[1] - tv[0]), e2 = expf(tv[2] - tv[0]), e3 = expf(tv[3] - tv[0]); const float inv = 1.f / (1.f + e1 + e2 + e3);
        ea = hi ? te[2] : te[0]; eb = hi ? te[3] : te[1]; wa = (hi ? e2 : 1.f) * inv; wb = (hi ? e3 : e1) * inv;
        la = atomicAdd((unsigned*)&lcnt[ea], 1u); lb = atomicAdd((unsigned*)&lcnt[eb], 1u);
    }
    LDS_WAIT(); __syncthreads();
    if (tid < NE) { const unsigned c = lcnt[tid]; lbase[tid] = c ? atomicAdd(&CNT[tid], c) : 0u; }
    LDS_WAIT(); __syncthreads();
    if (kq == 0) {
        const int sa = tok * 4 + 2 * hi, sb = sa + 1;
        LIST[(size_t)ea * LIST_CAP + lbase[ea] + la] = sa; RW[sa] = wa;
        LIST[(size_t)eb * LIST_CAP + lbase[eb] + lb] = sb; RW[sb] = wb;
    }
    LDS_WAIT(); __syncthreads();
}

__device__ __forceinline__ bool moe_tile(const unsigned* CNT, int g, int& e, int& base, int& p0, int& cnt) {
    const int tile256 = g >> 4; base = 0;
    for (e = 0; e < NE; ++e) { const int nt = ((int)CNT[e] + 255) >> 8; if (tile256 < base + nt) break; base += nt; }
    if (e == NE) return false;
    cnt = (int)CNT[e]; p0 = (g - base * 16) * 16; return p0 < cnt;
}
__device__ __forceinline__ void nv_moe1(const bf16_t* __restrict__ X1B, const bf16_t* __restrict__ W1T, const float* __restrict__ b1, const float* __restrict__ RSTD2,
                                        const int* __restrict__ LIST, bf16_t* __restrict__ H, int e, int base, int p0, int cnt, int cg, int lane) {
    const int r = lane & 15, q = lane >> 4, c0 = cg * 32, pn = c0 >> 7, j0 = c0 & 127;
    const int* lst = LIST + (size_t)e * LIST_CAP;
    const int prow = p0 + r; const int tok = lst[prow < cnt ? prow : cnt - 1] >> 2;
    f32x4 acc[4];
#pragma unroll
    for (int t = 0; t < 4; ++t) acc[t] = (f32x4){0.f, 0.f, 0.f, 0.f};
    const bf16_t* ap = X1B + (size_t)tok * DM + 8 * q;
    const bf16_t* wb = W1T + (size_t)e * 2048 * DM + (size_t)(256 * pn + j0 + r) * DM + 8 * q;
    const bf16_t* bp[4] = {wb, wb + 16 * DM, wb + 128 * DM, wb + 144 * DM};
    wave_mma<4>(acc, ap, bp, DM);
#pragma unroll
    for (int j = 0; j < 4; ++j) {
        const int pr = p0 + 4 * q + j; if (pr >= cnt) continue;
        const float rs = RSTD2[lst[pr] >> 2];
#pragma unroll
        for (int t = 0; t < 2; ++t) {
            const int col = c0 + 16 * t + r;
            float glu = acc[t][j] * rs + b1[(size_t)e * 2048 + col], lin = acc[t + 2][j] * rs + b1[(size_t)e * 2048 + 1024 + col];
            glu = fminf(glu, 7.f); lin = fminf(fmaxf(lin, -7.f), 7.f);
            const float act = glu * (1.f / (1.f + expf(-1.702f * glu))) * (lin + 1.f);
            H[((size_t)base * 256 + pr) * DM + col] = f2bf(act);
        }
    }
}
__device__ __forceinline__ void nv_moe2(const bf16_t* __restrict__ H, const bf16_t* __restrict__ W2T, const float* __restrict__ b2, const float* __restrict__ RW,
                                        const int* __restrict__ LIST, bf16_t* __restrict__ Y, int e, int base, int p0, int cnt, int cg, int lane) {
    const int r = lane & 15, q = lane >> 4, n0 = cg * 64;
    const int* lst = LIST + (size_t)e * LIST_CAP;
    f32x4 acc[4];
#pragma unroll
    for (int t = 0; t < 4; ++t) acc[t] = (f32x4){0.f, 0.f, 0.f, 0.f};
    const bf16_t* ap = H + ((size_t)base * 256 + p0 + r) * DM + 8 * q;
    const bf16_t* bp[4];
#pragma unroll
    for (int t = 0; t < 4; ++t) bp[t] = W2T + (size_t)e * DM * DM + (size_t)(n0 + 16 * t + r) * DM + 8 * q;
    wave_mma<4>(acc, ap, bp, DM);
#pragma unroll
    for (int j = 0; j < 4; ++j) {
        const int pr = p0 + 4 * q + j; if (pr >= cnt) continue;
        const int slot = lst[pr]; const float w = RW[slot];
#pragma unroll
        for (int t = 0; t < 4; ++t) { const int col = n0 + 16 * t + r; Y[(size_t)slot * DM + col] = f2bf((acc[t][j] + b2[(size_t)e * DM + col]) * w); }
    }
}

__device__ __forceinline__ void final_row(const float* X1, const bf16_t* __restrict__ Y, const float* __restrict__ gf, float* out, int row, int lane) {
    float4 v[4]; float ss = 0.f;
#pragma unroll
    for (int j = 0; j < 4; ++j) {
        const int c0 = 4 * (lane + 64 * j);
        v[j] = *(const float4*)(X1 + (size_t)row * DM + c0);
#pragma unroll
        for (int k = 0; k < 4; ++k) { const uint2 y = *(const uint2*)(Y + ((size_t)row * 4 + k) * DM + c0);
            v[j].x += bf2f((unsigned short)(y.x & 0xffff)); v[j].y += bf2f((unsigned short)(y.x >> 16)); v[j].z += bf2f((unsigned short)(y.y & 0xffff)); v[j].w += bf2f((unsigned short)(y.y >> 16)); }
        ss += v[j].x * v[j].x + v[j].y * v[j].y + v[j].z * v[j].z + v[j].w * v[j].w;
    }
    ss = wave_sum(ss);
    const float rstd = rsqrtf(ss * (1.f / DM) + EPS);
#pragma unroll
    for (int j = 0; j < 4; ++j) { const int c0 = 4 * (lane + 64 * j); const float4 g = *(const float4*)(gf + c0);
        float4 o; o.x = v[j].x * rstd * g.x; o.y = v[j].y * rstd * g.y; o.z = v[j].z * rstd * g.z; o.w = v[j].w * rstd * g.w; *(float4*)(out + (size_t)row * DM + c0) = o; }
}


namespace pg8 {
#define PG8_LAS __attribute__((address_space(3)))
typedef unsigned u32x4 __attribute__((ext_vector_type(4)));
typedef unsigned u32x2 __attribute__((ext_vector_type(2)));
constexpr int BM = 256, BK = 64, HALF = 128, HTB = HALF * BK * 2  , STAGE_BYTES = 8 * HTB, NXCD = 8, WGM = 8;
__host__ __device__ __forceinline__ int lds_byte(int r, int c) { const int st = (r >> 4) * 2 + (c >> 5), rr = r & 15, cc = c & 31, ob = rr * 64 + cc * 2; return st * 1024 + (ob ^ (((ob >> 9) & 1) << 5)); }
__host__ __device__ __forceinline__ void stage_rc(int b, int& R, int& C) { const int st = b / 1024, sb = b % 1024, swz = sb ^ (((sb >> 9) & 1) << 5); R = (st >> 1) * 16 + swz / 64; C = (st & 1) * 32 + (swz % 64) / 2; }
__host__ __device__ __forceinline__ int perm32(int rho) { const int n = rho >> 4, i = rho & 15; return 8 * (i >> 2) + 4 * n + (i & 3); }
struct Unit { int pm, pn; };
struct Gemm { const bf16_t* A; const bf16_t* Bt; int K; };
struct StaticOrder {
    int nM, nN, nwg, G, c;
    __device__ void init(int M_, int N_, int G_, int c_) { nM = M_ / BM; nN = N_ / BM; nwg = nM * nN; G = G_; c = c_; }
    __device__ bool next(int i, Unit& u) const {
        const long L = (long)i * G + c; if (L >= nwg) return false;
        int wgid = (int)L; { const int q = nwg / NXCD, r = nwg % NXCD, xcd = wgid % NXCD, off = wgid / NXCD; wgid = (xcd < r ? xcd * (q + 1) : r * (q + 1) + (xcd - r) * q) + off; }
        const int nig = WGM * nN, gid = wgid / nig, fm = gid * WGM, gsz = (nM - fm) < WGM ? (nM - fm) : WGM;
        u.pm = fm + ((wgid % nig) % gsz); u.pn = (wgid % nig) / gsz; return true;
    }
    __device__ __forceinline__ const PG8_LAS int* rowtab(int) const { return nullptr; }
};
__device__ __forceinline__ unsigned cvt_pk_bf16(float lo, float hi) { unsigned r; asm volatile("v_cvt_pk_bf16_f32 %0, %1, %2" : "=v"(r) : "v"(lo), "v"(hi)); return r; }

template <class Sched> __device__ __forceinline__ void gather_voffs(const Sched& S, int ui, int tid, int K, unsigned (&o0)[2], unsigned (&o1)[2]) {
    const PG8_LAS int* tab = S.rowtab(ui);
#pragma unroll
    for (int i = 0; i < 2; ++i) { int R, C; stage_rc(tid * 16 + i * 8192, R, C); o0[i] = (unsigned)(tab[R] * K + C) * 2u; o1[i] = (unsigned)(tab[HALF + R] * K + C) * 2u; }
}

template <class Epi, class Sched, bool ALIGN_EPI, bool GATHER>
__device__ __forceinline__ void gemm_phase(PG8_LAS unsigned char* lds, const Gemm g, const Sched& S, const Epi& E) {
    int tid_ = threadIdx.x; asm volatile("" : "+v"(tid_));
    const int tid = tid_, wid = __builtin_amdgcn_readfirstlane(tid >> 6), lane = tid & 63, wr = wid >> 2, wc = wid & 3, fr = lane & 15, fq = lane >> 4;
    const int K = g.K, nt = K / BK;
    unsigned vA0[2], vA1[2], wA0[2], wA1[2], voffB[2];
    const size_t kstep = (size_t)(BK * 2);
    const size_t hstep = (size_t)HALF * K * 2;
    const size_t tstep = 2 * hstep;
#pragma unroll
    for (int i = 0; i < 2; ++i) { int R, C; stage_rc(tid * 16 + i * 8192, R, C); const int Rb = Epi::PERM ? ((R & ~31) + perm32(R & 31)) : R;
        vA0[i] = (unsigned)(R * K + C) * 2u; vA1[i] = vA0[i] + (unsigned)hstep; voffB[i] = (unsigned)(Rb * K + C) * 2u; wA0[i] = vA0[i]; wA1[i] = vA1[i]; }
    const unsigned ldsw = (unsigned)wid * 1024u;
    const int aoff = lds_byte(wr * 64 + fr, fq * 8), boff = lds_byte(wc * 32 + fr, fq * 8);
#define PG8_SA(b, h) (((b) * 2 + (h)) * HTB)
#define PG8_SB(b, h) ((4 + (b) * 2 + (h)) * HTB)
#define PG8_STAGE(bufoff, gbase, voff) do { _Pragma("unroll") for (int _i = 0; _i < 2; ++_i) \
        __builtin_amdgcn_global_load_lds((const unsigned*)((const char*)(gbase) + (voff)[_i]), (PG8_LAS unsigned*)(lds + (bufoff) + ldsw + _i * 8192), 16, 0, 0); } while (0)
#define PG8_LDA(dst, b, h) do { _Pragma("unroll") for (int m = 0; m < 4; ++m) _Pragma("unroll") for (int k = 0; k < 2; ++k) dst[m][k] = *(const PG8_LAS bf16x8*)(lds + PG8_SA(b, h) + aoff + m * 2048 + k * 1024); } while (0)
#define PG8_LDB(dst, b, h) do { _Pragma("unroll") for (int n = 0; n < 2; ++n) _Pragma("unroll") for (int k = 0; k < 2; ++k) dst[n][k] = *(const PG8_LAS bf16x8*)(lds + PG8_SB(b, h) + boff + n * 2048 + k * 1024); } while (0)
#define PG8_MMA(ai, bj, At, Bt) do { __builtin_amdgcn_s_setprio(1); _Pragma("unroll") for (int m = 0; m < 4; ++m) _Pragma("unroll") for (int n = 0; n < 2; ++n) _Pragma("unroll") for (int k = 0; k < 2; ++k) \
        acc[ai][bj][m][n] = __builtin_amdgcn_mfma_f32_16x16x32_bf16(Bt[n][k], At[m][k], acc[ai][bj][m][n], 0, 0, 0); __builtin_amdgcn_s_setprio(0); } while (0)
#define PG8_WAIT_V(n) asm volatile("s_waitcnt vmcnt(" #n ")" ::: "memory")
#define PG8_WAIT_L(n) asm volatile("s_waitcnt lgkmcnt(" #n ")" ::: "memory")
#define PG8_BAR __builtin_amdgcn_s_barrier()
#define PG8_SCHED __builtin_amdgcn_sched_barrier(0)
    Unit cur, nxt; int ui = 0;
    if (!S.next(0, cur)) return;
    f32x4 acc[2][2][4][2];
#pragma unroll
    for (int a = 0; a < 2; ++a)
#pragma unroll
        for (int b = 0; b < 2; ++b)
#pragma unroll
            for (int m = 0; m < 4; ++m)
#pragma unroll
                for (int n = 0; n < 2; ++n) acc[a][b][m][n] = (f32x4){0.f, 0.f, 0.f, 0.f};
    bf16x8 At[4][2], B0[2][2], B1[2][2];
    const char* cA = GATHER ? (const char*)g.A : (const char*)g.A + (size_t)cur.pm * tstep; const char* cB = (const char*)g.Bt + (size_t)cur.pn * tstep;
    if constexpr (GATHER) gather_voffs(S, 0, tid, K, vA0, vA1);
    PG8_STAGE(PG8_SB(0, 0), cB, voffB); PG8_STAGE(PG8_SB(0, 1), cB + hstep, voffB); PG8_STAGE(PG8_SA(0, 0), cA, vA0); PG8_STAGE(PG8_SA(0, 1), cA, vA1);
    if (wr == 1) PG8_BAR;
    PG8_WAIT_V(2); PG8_BAR;
    PG8_STAGE(PG8_SB(1, 0), cB + kstep, voffB); PG8_STAGE(PG8_SA(1, 0), cA + kstep, vA0); PG8_STAGE(PG8_SB(1, 1), cB + hstep + kstep, voffB);
    PG8_WAIT_V(6); PG8_BAR;
    for (;;) {
        const bool has_next = S.next(ui + 1, nxt);
        const char* nA = GATHER ? cA : (has_next ? (const char*)g.A + (size_t)nxt.pm * tstep : cA); const char* nB = has_next ? (const char*)g.Bt + (size_t)nxt.pn * tstep : cB;
        if constexpr (GATHER) { if (has_next) gather_voffs(S, ui + 1, tid, K, wA0, wA1); else { wA0[0] = vA0[0]; wA0[1] = vA0[1]; wA1[0] = vA1[0]; wA1[1] = vA1[1]; } }
        for (int t = 0; t < nt; t += 2) {
            const bool last = (t == nt - 2);
            const char* a1 = cA + (size_t)(t + 1) * kstep;
            const char* a2 = last ? nA : cA + (size_t)(t + 2) * kstep; const char* b2 = last ? nB : cB + (size_t)(t + 2) * kstep;
            const char* a3 = a2 + kstep; const char* b3 = b2 + kstep;
            unsigned sA0[2], sA1[2];
#pragma unroll
            for (int i = 0; i < 2; ++i) { sA0[i] = (GATHER && last) ? wA0[i] : vA0[i]; sA1[i] = (GATHER && last) ? wA1[i] : vA1[i]; }
            if constexpr (Epi::MIDK) { if (t == nt / 2) E.midk(acc, wr, fr); }
            PG8_LDB(B0, 0, 0); PG8_LDB(B1, 0, 1); PG8_SCHED; PG8_LDA(At, 0, 0); PG8_STAGE(PG8_SA(1, 1), a1, vA1);
            PG8_WAIT_V(8); PG8_WAIT_L(0); PG8_BAR; PG8_MMA(0, 0, At, B0); PG8_MMA(0, 1, At, B1); PG8_BAR; PG8_SCHED;
            PG8_LDA(At, 0, 1); PG8_STAGE(PG8_SB(0, 0), b2, voffB); PG8_STAGE(PG8_SB(0, 1), b2 + hstep, voffB); PG8_STAGE(PG8_SA(0, 0), a2, sA0);
            PG8_WAIT_V(8); PG8_WAIT_L(0); PG8_BAR; PG8_MMA(1, 0, At, B0); PG8_MMA(1, 1, At, B1); PG8_BAR; PG8_SCHED;
            PG8_LDB(B0, 1, 0); PG8_LDB(B1, 1, 1); PG8_SCHED; PG8_LDA(At, 1, 0); PG8_STAGE(PG8_SA(0, 1), a2, sA1);
            PG8_WAIT_V(8); PG8_WAIT_L(0); PG8_BAR; PG8_MMA(0, 0, At, B0); PG8_MMA(0, 1, At, B1); PG8_BAR; PG8_SCHED;
            PG8_LDA(At, 1, 1); PG8_STAGE(PG8_SB(1, 0), b3, voffB); PG8_STAGE(PG8_SB(1, 1), b3 + hstep, voffB); PG8_STAGE(PG8_SA(1, 0), a3, sA0);
            PG8_WAIT_V(8); PG8_WAIT_L(0); PG8_BAR; PG8_MMA(1, 0, At, B0); PG8_MMA(1, 1, At, B1); PG8_BAR; PG8_SCHED;
        }
        if constexpr (ALIGN_EPI) { if (wr == 0) PG8_BAR; }
        E(acc, cur, ui, wr, wc, fr, fq);
        if (!has_next) break;
#pragma unroll
        for (int a = 0; a < 2; ++a)
#pragma unroll
            for (int b = 0; b < 2; ++b)
#pragma unroll
                for (int m = 0; m < 4; ++m)
#pragma unroll
                    for (int n = 0; n < 2; ++n) acc[a][b][m][n] = (f32x4){0.f, 0.f, 0.f, 0.f};
        cur = nxt; cA = nA; cB = nB; ++ui;
        if constexpr (GATHER) { vA0[0] = wA0[0]; vA0[1] = wA0[1]; vA1[0] = wA1[0]; vA1[1] = wA1[1]; }
        if constexpr (ALIGN_EPI) { if (wr == 1) PG8_BAR; }
    }
    PG8_WAIT_V(0);
    if constexpr (!ALIGN_EPI) { if (wr == 0) PG8_BAR; }
    PG8_BAR;
#undef PG8_SA
#undef PG8_SB
#undef PG8_STAGE
#undef PG8_LDA
#undef PG8_LDB
#undef PG8_MMA
#undef PG8_WAIT_V
#undef PG8_WAIT_L
#undef PG8_BAR
#undef PG8_SCHED
}

struct EpiProj {
    static constexpr bool PERM = true, MIDK = false;
    bf16_t* O;
    __device__ __forceinline__ void operator()(const f32x4 (&acc)[2][2][4][2], const Unit& u, int, int wr, int wc, int fr, int fq) const {
        const int row0 = u.pm * BM + wr * 64 + fr, col0 = u.pn * BM + wc * 32 + 8 * fq;
        const float sc = (u.pn < 2 || (u.pn >= 6 && u.pn < 8)) ? C2 : 1.f;
#pragma unroll
        for (int ai = 0; ai < 2; ++ai)
#pragma unroll
            for (int m = 0; m < 4; ++m) { bf16_t* rowp = O + (size_t)(row0 + ai * HALF + m * 16) * NPROJ + col0;
#pragma unroll
                for (int bj = 0; bj < 2; ++bj) { const f32x4 v0 = acc[ai][bj][m][0] * sc, v1 = acc[ai][bj][m][1] * sc;
                    u32x4 w; w.x = cvt_pk_bf16(v0[0], v0[1]); w.y = cvt_pk_bf16(v0[2], v0[3]); w.z = cvt_pk_bf16(v1[0], v1[1]); w.w = cvt_pk_bf16(v1[2], v1[3]);
                    *(u32x4*)(rowp + bj * HALF) = w; } }
    }
};
struct EpiWout {
    static constexpr bool PERM = false, MIDK = true;
    const float* x; float* X1; bf16_t* X1B; const PG8_LAS float* ratio; const PG8_LAS float* rs;
    __device__ __forceinline__ void midk(f32x4 (&acc)[2][2][4][2], int wr, int fr) const {
#pragma unroll
        for (int ai = 0; ai < 2; ++ai)
#pragma unroll
            for (int m = 0; m < 4; ++m) { const float f = ratio[ai * HALF + wr * 64 + m * 16 + fr];
#pragma unroll
                for (int bj = 0; bj < 2; ++bj)
#pragma unroll
                    for (int n = 0; n < 2; ++n) acc[ai][bj][m][n] *= f; }
    }
    __device__ __forceinline__ void operator()(const f32x4 (&acc)[2][2][4][2], const Unit& u, int, int wr, int wc, int fr, int fq) const {
        const int col0 = u.pn * BM + wc * 32 + 4 * fq;
#pragma unroll
        for (int ai = 0; ai < 2; ++ai)
#pragma unroll
            for (int m = 0; m < 4; ++m) { const int r = ai * HALF + wr * 64 + m * 16 + fr; const float s = rs[r]; const size_t off = (size_t)(u.pm * BM + r) * DM + col0;
#pragma unroll
                for (int bj = 0; bj < 2; ++bj)
#pragma unroll
                    for (int n = 0; n < 2; ++n) { const f32x4 xv = *(const f32x4*)(x + off + bj * HALF + n * 16); const f32x4 o = xv + acc[ai][bj][m][n] * s;
                        *(f32x4*)(X1 + off + bj * HALF + n * 16) = o; u32x2 w; w.x = cvt_pk_bf16(o[0], o[1]); w.y = cvt_pk_bf16(o[2], o[3]); *(u32x2*)(X1B + off + bj * HALF + n * 16) = w; }
                asm volatile("" ::: "memory"); }
    }
};
constexpr int MOE_MAXU = 9;
struct MoeOrder {
    int NT, c, U; const PG8_LAS int* tb; const PG8_LAS int* tabA;
    __device__ bool next(int i, Unit& u) const {
        if (i >= MOE_MAXU) return false;
        const int x = c & 7, j = c >> 3, q = U >> 3, rem = U & 7, start = x * q + (x < rem ? x : rem), size = q + (x < rem ? 1 : 0), li = i * 32 + j;
        if (li >= size) return false;
        const int f = start + li; int e = 0; while (f >= tb[e + 1] * NT) ++e;
        const int idx = f - tb[e] * NT, nte = tb[e + 1] - tb[e], pg = idx / (4 * nte), rem2 = idx - pg * 4 * nte;
        u.pm = tb[e] + (rem2 >> 2); u.pn = e * NT + pg * 4 + (rem2 & 3); return true;
    }
    __device__ __forceinline__ const PG8_LAS int* rowtab(int ui) const { return tabA + ui * 256; }
};
struct EpiMoe1 {
    static constexpr bool PERM = true, MIDK = false;
    bf16_t* H; const float* b1; const PG8_LAS float* rstab;
    __device__ __forceinline__ void operator()(const f32x4 (&acc)[2][2][4][2], const Unit& u, int ui, int wr, int wc, int fr, int fq) const {
        const int e = u.pn >> 3, pl = u.pn & 7, colA = pl * 128 + wc * 32 + 8 * fq;
        f32x4 bg[2], bl[2];
#pragma unroll
        for (int n = 0; n < 2; ++n) { bg[n] = *(const f32x4*)(b1 + (size_t)e * 2048 + colA + 4 * n); bl[n] = *(const f32x4*)(b1 + (size_t)e * 2048 + 1024 + colA + 4 * n); }
#pragma unroll
        for (int ai = 0; ai < 2; ++ai)
#pragma unroll
            for (int m = 0; m < 4; ++m) { const int r = ai * HALF + wr * 64 + m * 16 + fr; const float rs = rstab[ui * 256 + r];
                float a8[8];
#pragma unroll
                for (int n = 0; n < 2; ++n) { const f32x4 gv = acc[ai][0][m][n] * rs + bg[n], lv = acc[ai][1][m][n] * rs + bl[n];
#pragma unroll
                    for (int i = 0; i < 4; ++i) { const float gl = fminf(gv[i], 7.f), li = fminf(fmaxf(lv[i], -7.f), 7.f);
                        a8[4 * n + i] = gl * __builtin_amdgcn_rcpf(1.f + __builtin_amdgcn_exp2f(-1.702f * LOG2E * gl)) * (li + 1.f); } }
                u32x4 w; w.x = cvt_pk_bf16(a8[0], a8[1]); w.y = cvt_pk_bf16(a8[2], a8[3]); w.z = cvt_pk_bf16(a8[4], a8[5]); w.w = cvt_pk_bf16(a8[6], a8[7]);
                *(u32x4*)(H + (size_t)(u.pm * BM + r) * DM + colA) = w; }
    }
};
struct EpiMoe2 {
    static constexpr bool PERM = true, MIDK = false;
    bf16_t* Y; const float* b2; const PG8_LAS int* slottab; const PG8_LAS float* wtab;
    __device__ __forceinline__ void operator()(const f32x4 (&acc)[2][2][4][2], const Unit& u, int ui, int wr, int wc, int fr, int fq) const {
        const int e = u.pn >> 2, pl = u.pn & 3, col0 = pl * BM + wc * 32 + 8 * fq;
        f32x4 bv[2][2];
#pragma unroll
        for (int bj = 0; bj < 2; ++bj)
#pragma unroll
            for (int n = 0; n < 2; ++n) bv[bj][n] = *(const f32x4*)(b2 + (size_t)e * DM + col0 + bj * HALF + 4 * n);
#pragma unroll
        for (int ai = 0; ai < 2; ++ai)
#pragma unroll
            for (int m = 0; m < 4; ++m) { const int r = ai * HALF + wr * 64 + m * 16 + fr; const int slot = slottab[ui * 256 + r]; const float wt = wtab[ui * 256 + r];
                if (slot >= 0) {
#pragma unroll
                    for (int bj = 0; bj < 2; ++bj) { const f32x4 v0 = (acc[ai][bj][m][0] + bv[bj][0]) * wt, v1 = (acc[ai][bj][m][1] + bv[bj][1]) * wt;
                        u32x4 w; w.x = cvt_pk_bf16(v0[0], v0[1]); w.y = cvt_pk_bf16(v0[2], v0[3]); w.z = cvt_pk_bf16(v1[0], v1[1]); w.w = cvt_pk_bf16(v1[2], v1[3]);
                        *(u32x4*)(Y + (size_t)slot * DM + col0 + bj * HALF) = w; } } }
    }
};
}

#include <hip/hip_bf16.h>
#include <cmath>
namespace attn_body {

using bf16=__hip_bfloat16;
using bf16x8=__attribute__((ext_vector_type(8)))short;
using s16x4=__attribute__((ext_vector_type(4)))short;
using f32x16=__attribute__((ext_vector_type(16)))float;
using u32x4=__attribute__((ext_vector_type(4)))unsigned;
constexpr int SEQ=4096,D=64,PIN=3072,POUT=1024;
constexpr int NW=8,QBLK=32,QB=QBLK*NW,KVBLK=64,NQB=SEQ/QB;
__device__ __forceinline__ int crow(int r,int hi){return (r&3)+8*(r>>2)+4*hi;}
#define SBAR() __builtin_amdgcn_sched_barrier(0)
__device__ __forceinline__ void cmask(f32x16&p0,f32x16&p1,int jb,int qrel,int hi){
  const float NEG=-INFINITY; int kb=64*jb+4*hi;
  #pragma unroll
  for(int r=0;r<16;++r){int kv=kb+(r&3)+8*(r>>2); if(kv>qrel)p0[r]=NEG; if(kv+32>qrel)p1[r]=NEG;}
}

constexpr int NSLOT=3, SLOTB=8192;
constexpr int LDS_K=0, LDS_V=NSLOT*SLOTB, LDS_WS=2*NSLOT*SLOTB, LDS_OST=LDS_WS+NW*64*4, LDS_CK=LDS_OST+NW*4096, LDS_BYTES=LDS_CK+SEQ*4;
constexpr float C2=0.125f*1.4426950408889634f;
__device__ __forceinline__ void glds16(const void*gsrc,unsigned lds_dst){unsigned keep;
  asm volatile("s_mov_b32 %0, m0\n\ts_mov_b32 m0, %2\n\ts_nop 0\n\tglobal_load_lds_dwordx4 %1, off\n\ts_mov_b32 m0, %0":"=&s"(keep):"v"(gsrc),"s"(lds_dst):"memory");}
__device__ __forceinline__ float max3f(float a,float b,float c){float r;asm("v_max3_f32 %0, %1, %2, %3":"=v"(r):"v"(a),"v"(b),"v"(c));return r;}
__device__ __forceinline__ float max2f(float a,float b){float r;asm("v_max_f32_e32 %0, %1, %2":"=v"(r):"v"(a),"v"(b));return r;}
__device__ __forceinline__ float fadd_s(float a,float b){float r;asm("v_add_f32_e32 %0, %1, %2":"=v"(r):"v"(a),"v"(b));return r;}
__device__ __forceinline__ float fsub_s(float a,float b){float r;asm("v_sub_f32_e32 %0, %1, %2":"=v"(r):"v"(a),"v"(b));return r;}
typedef float f32x2_t __attribute__((ext_vector_type(2))); typedef float f32x4_t __attribute__((ext_vector_type(4))); typedef __bf16 bf16x2_t __attribute__((ext_vector_type(2)));
__device__ __forceinline__ unsigned cvtpk_s(float lo,float hi){f32x2_t v={lo,hi};bf16x2_t b=__builtin_convertvector(v,bf16x2_t);return __builtin_bit_cast(unsigned,b);}
#define WAIT_BAR(N) asm volatile("s_waitcnt vmcnt(" #N ") lgkmcnt(0)\n\ts_barrier":::"memory")

__device__ __forceinline__ void qkt(f32x16&p0,f32x16&p1,const char*Kslot,const bf16x8*qr,const f32x16&negm,int r32,int hi){
  const char*kb=Kslot+hi*1024+r32*16;
  #pragma unroll
  for(int d0=0;d0<4;++d0){
    const bf16x8 b0=*reinterpret_cast<const bf16x8*>(kb+d0*2048);
    const bf16x8 b1=*reinterpret_cast<const bf16x8*>(kb+d0*2048+512);
    if(d0==0){p0=__builtin_amdgcn_mfma_f32_32x32x16_bf16(b0,qr[0],negm,0,0,0);p1=__builtin_amdgcn_mfma_f32_32x32x16_bf16(b1,qr[0],negm,0,0,0);}
    else{p0=__builtin_amdgcn_mfma_f32_32x32x16_bf16(b0,qr[d0],p0,0,0,0);p1=__builtin_amdgcn_mfma_f32_32x32x16_bf16(b1,qr[d0],p1,0,0,0);}}
}
typedef __attribute__((address_space(3))) const char* lds_cptr;
typedef short v4i16_t __attribute__((ext_vector_type(4)));
__device__ __forceinline__ void kload8(bf16x8*kf,lds_cptr kp){
  kf[0]=*(const __attribute__((address_space(3))) bf16x8*)(kp);      kf[1]=*(const __attribute__((address_space(3))) bf16x8*)(kp+512);
  kf[2]=*(const __attribute__((address_space(3))) bf16x8*)(kp+2048); kf[3]=*(const __attribute__((address_space(3))) bf16x8*)(kp+2560);
  kf[4]=*(const __attribute__((address_space(3))) bf16x8*)(kp+4096); kf[5]=*(const __attribute__((address_space(3))) bf16x8*)(kp+4608);
  kf[6]=*(const __attribute__((address_space(3))) bf16x8*)(kp+6144); kf[7]=*(const __attribute__((address_space(3))) bf16x8*)(kp+6656);
}
__device__ __forceinline__ void kload2(bf16x8*kf,lds_cptr kp,int j){ kf[2*j]=*(const __attribute__((address_space(3))) bf16x8*)(kp+j*2048); kf[2*j+1]=*(const __attribute__((address_space(3))) bf16x8*)(kp+j*2048+512); }
__device__ __forceinline__ s16x4 vtr(lds_cptr p){ return __builtin_bit_cast(s16x4,__builtin_amdgcn_ds_read_tr16_b64_v4i16((__attribute__((address_space(3))) v4i16_t*)p)); }
__device__ __forceinline__ float rowmax(const f32x16&p0,const f32x16&p1){
  float a=max3f(p0[0],p0[1],p1[0]),b=max3f(p0[2],p0[3],p1[1]);a=max3f(a,p1[2],p1[3]);
  #pragma unroll
  for(int r=4;r<16;r+=4){a=max3f(a,p0[r],p0[r+1]);b=max3f(b,p0[r+2],p0[r+3]);a=max3f(a,p1[r],p1[r+1]);b=max3f(b,p1[r+2],p1[r+3]);}
  const float m=max2f(a,b);
  auto rr=__builtin_amdgcn_permlane32_swap(__float_as_uint(m),__float_as_uint(m),false,false);
  return max2f(__uint_as_float(rr[0]),__uint_as_float(rr[1]));
}
__device__ __forceinline__ void pv(f32x16*o,int vb,bf16x8 pa0,bf16x8 pa1,bf16x8 pa2,bf16x8 pa3){
  #pragma unroll
  for(int d0=0;d0<2;++d0){s16x4 lo[4],hi[4];
    #pragma unroll
    for(int ks=0;ks<4;++ks){
      asm volatile("ds_read_b64_tr_b16 %0,%1 offset:%c2":"=&v"(lo[ks]):"v"(vb),"i"(d0*4096+ks*1024):"memory");
      asm volatile("ds_read_b64_tr_b16 %0,%1 offset:%c2":"=&v"(hi[ks]):"v"(vb),"i"(d0*4096+ks*1024+512):"memory");}
    asm volatile("s_waitcnt lgkmcnt(0)":::"memory");SBAR();
    #define PK(k) (bf16x8){lo[k][0],lo[k][1],lo[k][2],lo[k][3],hi[k][0],hi[k][1],hi[k][2],hi[k][3]}
    o[d0]=__builtin_amdgcn_mfma_f32_32x32x16_bf16(pa0,PK(0),o[d0],0,0,0);
    o[d0]=__builtin_amdgcn_mfma_f32_32x32x16_bf16(pa1,PK(1),o[d0],0,0,0);
    o[d0]=__builtin_amdgcn_mfma_f32_32x32x16_bf16(pa2,PK(2),o[d0],0,0,0);
    o[d0]=__builtin_amdgcn_mfma_f32_32x32x16_bf16(pa3,PK(3),o[d0],0,0,0);
    #undef PK
  }
}

#ifndef ATTN_STORE16
#define ATTN_STORE16(p,v) (*(u32x4*)(p)=(v))
#endif
template<int THRL> __device__ __forceinline__ void attn_unit(int b,int h,int qb,const bf16*Q,const bf16*__restrict__ K,const bf16*__restrict__ V,bf16*O,const float*__restrict__ CUMbh,float*__restrict__ SSQh,char*shm){
  int tid_=threadIdx.x; asm volatile("":"+v"(tid_));
  const int tid=tid_,lane=tid&63,r32=lane&31,hi=lane>>5; const int wid=__builtin_amdgcn_readfirstlane(tid>>6);
  const long rowbase=(long)b*SEQ; const int q0=qb*QB;
  const bf16*Qw=Q+(rowbase+q0+wid*QBLK)*PIN+h*D;
  const bf16*Kh=K+rowbase*PIN+h*D,*Vh=V+rowbase*PIN+h*D;
  const unsigned lds0=(unsigned)(uintptr_t)shm;
  const lds_cptr shm3=(lds_cptr)shm;
  float*wsf=(float*)(shm+LDS_WS)+wid*64;
  const bf16*ksrc=Kh+(long)lane*PIN+wid*8;
  const bf16*vsrc=Vh+(long)(16*(wid&3)+(lane>>2))*PIN+(wid>>2)*32+(lane&3)*8;
  const unsigned kdst=lds0+LDS_K+wid*1024, vdst=lds0+LDS_V+wid*1024;
  #define DMA_K(t,slot) glds16(ksrc+(long)(t)*KVBLK*PIN,(unsigned)__builtin_amdgcn_readfirstlane(kdst+(slot)))
  #define DMA_V(t,slot) glds16(vsrc+(long)(t)*KVBLK*PIN,(unsigned)__builtin_amdgcn_readfirstlane(vdst+(slot)))
  const int vb0=(int)(lds0+LDS_V)+((lane>>4)&1)*32+(lane&3)*8+(4*hi+((lane&15)>>2))*64;
  const char*Kbase=shm+LDS_K; bf16x8 kf[8];
  const lds_cptr kp0=shm3+LDS_K+hi*1024+r32*16; const lds_cptr vp0=shm3+LDS_V+((lane>>4)&1)*32+(lane&3)*8+(4*hi+((lane&15)>>2))*64;
  const int NT=(q0+QB)/KVBLK;
  DMA_K(0,0);DMA_V(0,0);DMA_K(1,SLOTB);
  bf16x8 qr[4];
  #pragma unroll
  for(int d0=0;d0<4;++d0)qr[d0]=*reinterpret_cast<const bf16x8*>(&Qw[(long)r32*PIN+d0*16+hi*8]);
  const float cbase=CUMbh[q0]; const float cq=CUMbh[q0+wid*QBLK+r32]-cbase;
  { __attribute__((address_space(3))) float*ckw=(__attribute__((address_space(3))) float*)(shm3+LDS_CK); int s0_=tid; asm volatile("":"+v"(s0_));
    _Pragma("nounroll") for(int s=s0_;s<q0+QB;s+=NW*64)ckw[s]=CUMbh[s]-cbase; }
  const __attribute__((address_space(3))) float*ckp=(const __attribute__((address_space(3))) float*)(shm3+LDS_CK)+4*hi;
  float mhat=-cq,l_reg=0.f;f32x16 o[2];o[0]=f32x16{};o[1]=f32x16{};f32x16 negm;
  #pragma unroll
  for(int r=0;r<16;++r)negm[r]=cq;
  asm volatile("":"+v"(negm));
  const int qrel=wid*QBLK+r32;
  #define BIAS(P0,P1,t) do{ const __attribute__((address_space(3))) float*cp_=ckp+(t)*KVBLK; \
    _Pragma("unroll") for(int g_=0;g_<4;++g_){ const f32x4_t c0_=*(const __attribute__((address_space(3))) f32x4_t*)(cp_+8*g_), c1_=*(const __attribute__((address_space(3))) f32x4_t*)(cp_+32+8*g_); \
      _Pragma("unroll") for(int j_=0;j_<4;++j_){ P0[4*g_+j_]-=c0_[j_]; P1[4*g_+j_]-=c1_[j_]; } SBAR(); } }while(0)
  #define CMASK(P0,P1,t) do{int jb_=(t)-(NT-4); if(jb_>=0)cmask(P0,P1,jb_,qrel,hi);}while(0)
  bool resc=false;
  #define START(P0,P1) do{ const float rm=rowmax(P0,P1); resc=false; \
    { const float dl=rm; mhat=fadd_s(mhat,dl); \
      _Pragma("unroll") for(int r=0;r<16;++r){P0[r]=fsub_s(P0[r],dl);P1[r]=fsub_s(P1[r],dl);} \
      _Pragma("unroll") for(int r=0;r<16;++r)negm[r]=-mhat; asm volatile("":"+v"(negm)); } \
    _Pragma("unroll") for(int r=0;r<16;++r)P0[r]=__builtin_amdgcn_exp2f(P0[r]); }while(0)
  #define RESC() do{ if(resc){ asm volatile("s_waitcnt lgkmcnt(0)":::"memory"); \
      _Pragma("unroll") for(int d_=0;d_<2;++d_) _Pragma("unroll") for(int r=0;r<16;++r)o[d_][r]*=wsf[crow(r,hi)]; } }while(0)
  f32x16 pA0,pA1,pB0,pB1;
  int sl_prev=0,sl_cur=0,sl_next=SLOTB;
  #define ROT() do{sl_prev=sl_cur;sl_cur=sl_next;sl_next=(sl_next==(NSLOT-1)*SLOTB)?0:sl_next+SLOTB;}while(0)
  DMA_K(2,2*SLOTB);
  WAIT_BAR(3);
  qkt(pA0,pA1,Kbase,qr,negm,r32,hi);asm volatile("s_nop 15\n\ts_nop 7":"+v"(pA0),"+v"(pA1));BIAS(pA0,pA1,0);CMASK(pA0,pA1,0);
  START(pA0,pA1);
  _Pragma("unroll") for(int r=0;r<16;++r)pA1[r]=__builtin_amdgcn_exp2f(pA1[r]);
  WAIT_BAR(0);
  DMA_K(3,0);DMA_V(1,SLOTB);
  ROT();
  kload8(kf,kp0+sl_cur);
  WAIT_BAR(2);
  s16x4 vlo[8],vhi[8]; u32x4 pw0,pw1,pw2,pw3;
  #define PKW(P,B) cvtpk_s(P[B],P[B+1])
  #define PAF(k) __builtin_bit_cast(bf16x8,pw##k)
  #define VFR(i) (bf16x8){vlo[i][0],vlo[i][1],vlo[i][2],vlo[i][3],vhi[i][0],vhi[i][1],vhi[i][2],vhi[i][3]}
  #define PIN(x) asm volatile("":"+v"(x))
  #define MX3(a,b,c) __builtin_fmaxf(__builtin_fmaxf((a),(b)),(c))
  #define GAPA(MF,A0,A1,A2,A3,W0,W1,PW) do{ MF; sacc+=A0; sacc+=A1; sacc+=A2; sacc+=A3; PIN(sacc); W0; W1; PIN(PW); SBAR(); }while(0)
  #define EX(v) __builtin_amdgcn_exp2f(v)
  #define GAPB(MF,X,B) do{ MF; X[B]=EX(X[B]); X[B+1]=EX(X[B+1]); X[B+2]=EX(X[B+2]); X[B+3]=EX(X[B+3]); PIN(X); SBAR(); }while(0)
  #define VRD(i) do{ vlo[i]=vtr(vp_+(((i)>>2)*4096+((i)&3)*1024)); vhi[i]=vtr(vp_+(((i)>>2)*4096+((i)&3)*1024+512)); }while(0)
  #define KRD(G,j) do{ if(G){ kload2(kf,kp0+sl_next,j); SBAR(); } }while(0)
  #define STEP(C0,C1,P0,P1,t,GK,GV,GL) do{ SBAR(); \
    const lds_cptr vp_=vp0+sl_prev; \
    VRD(0); SBAR(); float sacc=(P0[0]+P0[1]); \
    GAPA(C0=__builtin_amdgcn_mfma_f32_32x32x16_bf16(kf[0],qr[0],negm,0,0,0), P0[2],P0[3],P0[4],P0[5],     pw0[0]=PKW(P0,0), pw0[1]=PKW(P0,2), pw0); \
    VRD(4); SBAR(); GAPA(C1=__builtin_amdgcn_mfma_f32_32x32x16_bf16(kf[1],qr[0],negm,0,0,0), P0[6],P0[7],P0[8],P0[9],     pw0[2]=PKW(P0,4), pw0[3]=PKW(P0,6), pw0); \
    VRD(1); SBAR(); GAPA(C0=__builtin_amdgcn_mfma_f32_32x32x16_bf16(kf[2],qr[1],C0,0,0,0),   P0[10],P0[11],P0[12],P0[13], pw1[0]=PKW(P0,8), pw1[1]=PKW(P0,10), pw1); \
    VRD(5); SBAR(); GAPA(C1=__builtin_amdgcn_mfma_f32_32x32x16_bf16(kf[3],qr[1],C1,0,0,0),   P0[14],P0[15],P1[0],P1[1],   pw1[2]=PKW(P0,12),pw1[3]=PKW(P0,14), pw1); \
    VRD(2); SBAR(); GAPA(C0=__builtin_amdgcn_mfma_f32_32x32x16_bf16(kf[4],qr[2],C0,0,0,0),   P1[2],P1[3],P1[4],P1[5],     pw2[0]=PKW(P1,0), pw2[1]=PKW(P1,2), pw2); \
    VRD(6); SBAR(); GAPA(C1=__builtin_amdgcn_mfma_f32_32x32x16_bf16(kf[5],qr[2],C1,0,0,0),   P1[6],P1[7],P1[8],P1[9],     pw2[2]=PKW(P1,4), pw2[3]=PKW(P1,6), pw2); \
    VRD(3); SBAR(); GAPA(C0=__builtin_amdgcn_mfma_f32_32x32x16_bf16(kf[6],qr[3],C0,0,0,0),   P1[10],P1[11],P1[12],P1[13], pw3[0]=PKW(P1,8), pw3[1]=PKW(P1,10), pw3); \
    VRD(7); SBAR(); GAPA(C1=__builtin_amdgcn_mfma_f32_32x32x16_bf16(kf[7],qr[3],C1,0,0,0),   P1[14],P1[15],0.f,0.f,       pw3[2]=PKW(P1,12),pw3[3]=PKW(P1,14), pw3); \
    l_reg+=sacc; \
    if(GK){DMA_K((t)+3,sl_cur);} if(GV){DMA_V((t)+1,sl_next);} \
    BIAS(C0,C1,t); CMASK(C0,C1,t); \
    { float a=MX3(C0[0],C0[1],C1[0]),b=MX3(C0[2],C0[3],C1[1]); a=MX3(a,C1[2],C1[3]); \
      _Pragma("unroll") for(int r=4;r<16;r+=4){a=MX3(a,C0[r],C0[r+1]);b=MX3(b,C0[r+2],C0[r+3]);a=MX3(a,C1[r],C1[r+1]);b=MX3(b,C1[r+2],C1[r+3]);} \
      float rm=__builtin_fmaxf(a,b); { auto rr=__builtin_amdgcn_permlane32_swap(__float_as_uint(rm),__float_as_uint(rm),false,false); rm=__builtin_fmaxf(__uint_as_float(rr[0]),__uint_as_float(rr[1])); } \
      resc=false; \
      if(__builtin_expect(__any(rm>(float)THRL),0)){ const float dl=__builtin_fmaxf(rm,0.f); mhat+=dl; \
        _Pragma("unroll") for(int r=0;r<16;++r){C0[r]-=dl;C1[r]-=dl;} \
        _Pragma("unroll") for(int r=0;r<16;++r)negm[r]=-mhat; asm volatile("":"+v"(negm)); \
        const float f=__builtin_amdgcn_exp2f(-dl); l_reg*=f; if(hi==0)wsf[r32]=f; resc=true; } } \
    SBAR(); \
    GAPB(o[0]=__builtin_amdgcn_mfma_f32_32x32x16_bf16(PAF(0),VFR(0),o[0],0,0,0), C0,0); \
    GAPB(o[1]=__builtin_amdgcn_mfma_f32_32x32x16_bf16(PAF(0),VFR(4),o[1],0,0,0), C0,4); \
    KRD(GL,0); GAPB(o[0]=__builtin_amdgcn_mfma_f32_32x32x16_bf16(PAF(1),VFR(1),o[0],0,0,0), C0,8); \
    KRD(GL,1); GAPB(o[1]=__builtin_amdgcn_mfma_f32_32x32x16_bf16(PAF(1),VFR(5),o[1],0,0,0), C0,12); \
    KRD(GL,2); GAPB(o[0]=__builtin_amdgcn_mfma_f32_32x32x16_bf16(PAF(2),VFR(2),o[0],0,0,0), C1,0); \
    KRD(GL,3); GAPB(o[1]=__builtin_amdgcn_mfma_f32_32x32x16_bf16(PAF(2),VFR(6),o[1],0,0,0), C1,4); \
    GAPB(o[0]=__builtin_amdgcn_mfma_f32_32x32x16_bf16(PAF(3),VFR(3),o[0],0,0,0), C1,8); \
    GAPB(o[1]=__builtin_amdgcn_mfma_f32_32x32x16_bf16(PAF(3),VFR(7),o[1],0,0,0), C1,12); \
    }while(0)
  int t=1;
  #undef CMASK
  #define CMASK(P0,P1,t) do{}while(0)
  for(;t+5<NT;t+=2){
    STEP(pB0,pB1,pA0,pA1,t,true,true,true);     WAIT_BAR(2); RESC(); ROT();
    STEP(pA0,pA1,pB0,pB1,t+1,true,true,true);   WAIT_BAR(2); RESC(); ROT();
  }
  #undef CMASK
  #define CMASK(P0,P1,t) do{int jb_=(t)-(NT-4); if(jb_>=0)cmask(P0,P1,jb_,qrel,hi);}while(0)
  #define ENDW(tt) do{ if((tt)+3<NT){WAIT_BAR(2);} else if((tt)+2<NT){WAIT_BAR(1);} else {WAIT_BAR(0);} }while(0)
  for(;t+1<NT;t+=2){
    STEP(pB0,pB1,pA0,pA1,t,(t+3<NT),(t+1<NT),(t+1<NT));       ENDW(t);   RESC(); ROT();
    STEP(pA0,pA1,pB0,pB1,t+1,(t+4<NT),(t+2<NT),(t+2<NT));     ENDW(t+1); RESC(); ROT();
  }
  STEP(pB0,pB1,pA0,pA1,NT-1,false,false,false); RESC();
  { float sacc=pB0[0]+pB0[1]; _Pragma("unroll") for(int r=2;r<16;++r)sacc+=pB0[r]; _Pragma("unroll") for(int r=0;r<16;++r)sacc+=pB1[r]; l_reg+=sacc;
    pw0=(u32x4){PKW(pB0,0),PKW(pB0,2),PKW(pB0,4),PKW(pB0,6)};pw1=(u32x4){PKW(pB0,8),PKW(pB0,10),PKW(pB0,12),PKW(pB0,14)};pw2=(u32x4){PKW(pB1,0),PKW(pB1,2),PKW(pB1,4),PKW(pB1,6)};pw3=(u32x4){PKW(pB1,8),PKW(pB1,10),PKW(pB1,12),PKW(pB1,14)};
    SBAR(); pv(o,vb0+sl_cur,PAF(0),PAF(1),PAF(2),PAF(3)); }
  #undef PKW
  #undef PAF
  #undef VFR
  #undef PIN
  #undef MX3
  #undef GAPA
  #undef GAPB
  #undef EX
  #undef VRD
  #undef KRD
  #undef STEP
  #undef ENDW
  {auto rr=__builtin_amdgcn_permlane32_swap(__float_as_uint(l_reg),__float_as_uint(l_reg),false,false);l_reg=__uint_as_float(rr[0])+__uint_as_float(rr[1]);}
  if(hi==0)wsf[32+r32]=l_reg;asm volatile("s_waitcnt lgkmcnt(0)":::"memory");
  float rli[16];
  #pragma unroll
  for(int r=0;r<16;++r)rli[r]=__builtin_amdgcn_rcpf(wsf[32+crow(r,hi)]);
  bf16*Ow=O+(rowbase+q0+wid*QBLK)*POUT+h*D; float*Sw=SSQh+(rowbase+q0+wid*QBLK)*16;
  { bf16*stg=(bf16*)(shm+LDS_OST)+wid*2048;
    #pragma unroll
    for(int r=0;r<16;++r){const int orow=crow(r,hi);
      #pragma unroll
      for(int d0=0;d0<2;++d0)stg[orow*64+d0*32+r32]=__float2bfloat16(o[d0][r]*rli[r]);}
    asm volatile("s_waitcnt lgkmcnt(0)":::"memory");
    #pragma unroll
    for(int i=0;i<4;++i){const int row=i*8+(lane>>3),ch=lane&7; const u32x4 v=*(const u32x4*)(stg+row*64+ch*8); ATTN_STORE16(Ow+(long)row*POUT+ch*8,v);
      float sq=0.f;
      #pragma unroll
      for(int w_=0;w_<4;++w_){const float lo_=__uint_as_float(v[w_]<<16),hi_=__uint_as_float(v[w_]&0xffff0000u);sq+=lo_*lo_+hi_*hi_;}
      sq+=__shfl_xor(sq,1);sq+=__shfl_xor(sq,2);sq+=__shfl_xor(sq,4); if(ch==0)Sw[row*16]=sq;} }
  asm volatile("s_waitcnt lgkmcnt(0)\n\ts_barrier":::"memory");
  #undef DMA_K
  #undef DMA_V
  #undef CMASK
  #undef BIAS
  #undef START
  #undef RESC
  #undef ROT
}
constexpr int ATTN_LDS_BYTES=LDS_BYTES;

__device__ __forceinline__ void sb_unit(int b,int h,int qb,const bf16*Q,const bf16*__restrict__ K,const bf16*__restrict__ V,bf16*O,float*__restrict__ SSQh,char*shm){
  int tid_=threadIdx.x; asm volatile("":"+v"(tid_));
  const int tid=tid_,lane=tid&63,r32=lane&31,hi=lane>>5; const int wid=__builtin_amdgcn_readfirstlane(tid>>6);
  const long rowbase=(long)b*SEQ; const int q0=qb*QB;
  const bf16*Qw=Q+(rowbase+q0+wid*QBLK)*PIN+h*D;
  const bf16*Kh=K+rowbase*PIN+h*D,*Vh=V+rowbase*PIN+h*D;
  const unsigned lds0=(unsigned)(uintptr_t)shm;
  const bf16*ksrc=Kh+(long)lane*PIN+wid*8;
  const bf16*vsrc=Vh+(long)(16*(wid&3)+(lane>>2))*PIN+(wid>>2)*32+(lane&3)*8;
  const unsigned kdst=lds0+LDS_K+wid*1024, vdst=lds0+LDS_V+wid*1024;
  const int vb0=(int)(lds0+LDS_V)+((lane>>4)&1)*32+(lane&3)*8+(4*hi+((lane&15)>>2))*64;
  const char*Kbase=shm+LDS_K;
  const int NT=(q0+QB)/KVBLK;
  #define SB_DMA(i,slot) do{ const long kt_=(long)(NT-1-(i)); glds16(ksrc+kt_*KVBLK*PIN,(unsigned)__builtin_amdgcn_readfirstlane(kdst+(slot))); glds16(vsrc+kt_*KVBLK*PIN,(unsigned)__builtin_amdgcn_readfirstlane(vdst+(slot))); }while(0)
  bf16x8 qr[4];
  #pragma unroll
  for(int d0=0;d0<4;++d0)qr[d0]=*reinterpret_cast<const bf16x8*>(&Qw[(long)r32*PIN+d0*16+hi*8]);
  SB_DMA(0,0); SB_DMA(1,SLOTB);
  f32x16 o[2];o[0]=f32x16{};o[1]=f32x16{};
  float Rc=1.f;
  const int qrel=wid*QBLK+r32;
  int sl_cur=0,sl_n1=SLOTB,sl_n2=2*SLOTB;
  for(int i=0;i<NT;++i){
    if(i+1<NT){WAIT_BAR(2);}else{WAIT_BAR(0);}
    if(i+2<NT)SB_DMA(i+2,sl_n2);
    f32x16 p0,p1; { f32x16 z=f32x16{}; asm volatile("":"+v"(z)); qkt(p0,p1,Kbase+sl_cur,qr,z,r32,hi); }
    f32x16 s0,s1;
    #pragma unroll
    for(int r=0;r<16;++r){
      const float za=__builtin_amdgcn_fmed3f(p0[r],-100.f,100.f), zb=__builtin_amdgcn_fmed3f(p1[r],-100.f,100.f);
      p0[r]=__builtin_amdgcn_exp2f(za); p1[r]=__builtin_amdgcn_exp2f(zb);
      s0[r]=__builtin_amdgcn_rcpf(1.f+p0[r]); s1[r]=__builtin_amdgcn_rcpf(1.f+p1[r]); }
    if(i<4){
      const int kb=64*(3-i)+4*hi;
      #pragma unroll
      for(int r=0;r<16;++r){ const int kv=kb+(r&3)+8*(r>>2); if(kv>=qrel){p0[r]=0.f;s0[r]=1.f;} if(kv+32>=qrel){p1[r]=0.f;s1[r]=1.f;} }
    }
    float gp[8],pp[8];
    #pragma unroll
    for(int g=0;g<4;++g){
      s0[4*g+2]*=s0[4*g+3]; s0[4*g+1]*=s0[4*g+2]; s0[4*g]*=s0[4*g+1]; gp[g]=s0[4*g];
      s1[4*g+2]*=s1[4*g+3]; s1[4*g+1]*=s1[4*g+2]; s1[4*g]*=s1[4*g+1]; gp[4+g]=s1[4*g]; }
    #pragma unroll
    for(int g=0;g<8;++g){ auto rr=__builtin_amdgcn_permlane32_swap(__float_as_uint(gp[g]),__float_as_uint(gp[g]),false,false); pp[g]=__uint_as_float(hi?rr[0]:rr[1]); }
    float st=Rc, outer[8];
    #pragma unroll
    for(int g=7;g>=0;--g){ outer[g]=hi?st:st*pp[g]; st=st*(gp[g]*pp[g]); }
    Rc=st;
    #pragma unroll
    for(int r=0;r<16;++r){ p0[r]=p0[r]*(s0[r]*outer[r>>2]); p1[r]=p1[r]*(s1[r]*outer[4+(r>>2)]); }
    u32x4 pw0,pw1,pw2,pw3;
    pw0=(u32x4){cvtpk_s(p0[0],p0[1]),cvtpk_s(p0[2],p0[3]),cvtpk_s(p0[4],p0[5]),cvtpk_s(p0[6],p0[7])};
    pw1=(u32x4){cvtpk_s(p0[8],p0[9]),cvtpk_s(p0[10],p0[11]),cvtpk_s(p0[12],p0[13]),cvtpk_s(p0[14],p0[15])};
    pw2=(u32x4){cvtpk_s(p1[0],p1[1]),cvtpk_s(p1[2],p1[3]),cvtpk_s(p1[4],p1[5]),cvtpk_s(p1[6],p1[7])};
    pw3=(u32x4){cvtpk_s(p1[8],p1[9]),cvtpk_s(p1[10],p1[11]),cvtpk_s(p1[12],p1[13]),cvtpk_s(p1[14],p1[15])};
    SBAR(); pv(o,vb0+sl_cur,__builtin_bit_cast(bf16x8,pw0),__builtin_bit_cast(bf16x8,pw1),__builtin_bit_cast(bf16x8,pw2),__builtin_bit_cast(bf16x8,pw3));
    { const int t_=sl_cur; sl_cur=sl_n1; sl_n1=sl_n2; sl_n2=t_; }
  }
  #undef SB_DMA
  bf16*Ow=O+(rowbase+q0+wid*QBLK)*POUT+h*D; float*Sw=SSQh+(rowbase+q0+wid*QBLK)*16;
  { bf16*stg=(bf16*)(shm+LDS_OST)+wid*2048;
    #pragma unroll
    for(int r=0;r<16;++r){const int orow=crow(r,hi);
      #pragma unroll
      for(int d0=0;d0<2;++d0)stg[orow*64+d0*32+r32]=__float2bfloat16(o[d0][r]);}
    asm volatile("s_waitcnt lgkmcnt(0)":::"memory");
    #pragma unroll
    for(int i=0;i<4;++i){const int row=i*8+(lane>>3),ch=lane&7; const u32x4 v=*(const u32x4*)(stg+row*64+ch*8); ATTN_STORE16(Ow+(long)row*POUT+ch*8,v);
      float sq=0.f;
      #pragma unroll
      for(int w_=0;w_<4;++w_){const float lo_=__uint_as_float(v[w_]<<16),hi_=__uint_as_float(v[w_]&0xffff0000u);sq+=lo_*lo_+hi_*hi_;}
      sq+=__shfl_xor(sq,1);sq+=__shfl_xor(sq,2);sq+=__shfl_xor(sq,4); if(ch==0)Sw[row*16]=sq;} }
  asm volatile("s_waitcnt lgkmcnt(0)\n\ts_barrier":::"memory");
}
template<int THRL=8> __device__ __forceinline__ void attn_phase(char*lds,const bf16*PROJ,const float*CUM,bf16*OMIX,float*SSQ,int vcu){
  const int bh=vcu>>3,s=vcu&7,b=bh>>3,h=bh&7;
  if(bh>=32)return;
  for(int i=0;i<4;++i){ const int qb=(i&1)?15-s:s;
    if(i<2)attn_unit<THRL>(b,h,qb,PROJ,PROJ+512,PROJ+1024,OMIX,CUM+(size_t)bh*SEQ,SSQ+h,lds);
    else   sb_unit(b,h,qb,PROJ+1536,PROJ+2048,PROJ+2560,OMIX+512,SSQ+8+h,lds); }
}

#undef SBAR
#undef WAIT_BAR
}
__global__ void __launch_bounds__(NTHREADS, 2) mega_fwd(Args a) {
    extern __shared__ __attribute__((aligned(16))) unsigned char lds[];
    LAS unsigned char* L = (LAS unsigned char*)lds;
    volatile LAS unsigned* MISC = (volatile LAS unsigned*)(L + MISC_OFF);
    const int tid = threadIdx.x, lane = tid & 63, wave = __builtin_amdgcn_readfirstlane(tid >> 6);
    const int G = gridDim.x, bx = blockIdx.x, vcu = (G % 8 == 0) ? (bx % 8) * (G / 8) + bx / 8 : bx;
    const int gw = vcu * NWAVES + wave, NGW = G * NWAVES;
    unsigned char* ws = a.ws;
    unsigned* CTL = (unsigned*)(ws + WS_CTL);
    bf16_t* WINT = (bf16_t*)(ws + WS_WINT); bf16_t* WOUTT = (bf16_t*)(ws + WS_WOUTT); float* WR = (float*)(ws + WS_WR); float* CUM = (float*)(ws + WS_CUM);
    float* SSQ = (float*)(ws + WS_SSQ); float* RSTD2 = (float*)(ws + WS_RSTD2); float* RW = (float*)(ws + WS_RW); int* LIST = (int*)(ws + WS_LIST); float* FLOG = (float*)(ws + WS_FLOG);
    bf16_t* XN = (bf16_t*)(ws + WS_XN); bf16_t* PROJ = (bf16_t*)(ws + WS_PROJ); bf16_t* OMIX = (bf16_t*)(ws + WS_OMIX); bf16_t* X1B = (bf16_t*)(ws + WS_X1B);
    bf16_t* W1T = (bf16_t*)(ws + WS_W1T); bf16_t* W2T = (bf16_t*)(ws + WS_W2T); bf16_t* H = (bf16_t*)(ws + WS_H); bf16_t* Y = (bf16_t*)(ws + WS_Y);
    unsigned* CNT = CTL + CW_CNT;
    for (int u = tid; u < (LDS_BYTES - LDSCTL_OFF) / 4; u += NTHREADS) ((LAS unsigned*)(L + LDSCTL_OFF))[u] = 0u;
    __syncthreads();
    XcdBarrier bar = xcd_barrier_post(CTL + CW_BAR, MISC + 8);

    REPS(0) {
        LAS float* scr = (LAS float*)(L + RING_OFF + wave * 8448);
        LAS float* wf = (LAS float*)(L + RING_OFF + 98304);
        for (int i = tid; i < DM * 8; i += NTHREADS) { const int k = i >> 3; wf[i] = a.w_in[(size_t)k * WIN_N + 1536 + (i & 7)] * a.g1[k]; }
        LDS_WAIT(); __syncthreads();
        constexpr int I_IN = (DM / 64) * (NPROJ / 32), I_OUT = (DM / 64) * (DM / 32), I_W1 = (DM / 64) * (2048 / 32), I_W2 = (DM / 64) * (DM / 32);
        constexpr int NITEMS = I_IN + I_OUT + NE * I_W1 + NE * I_W2;
        for (int it = gw; it < NITEMS; it += NGW) {
            int r = it;
            if (r < I_IN) { transpose_item(a.w_in, DM, WIN_N, NPROJ, 1, a.g1, nullptr, DM, WINT, scr, r, lane); continue; } r -= I_IN;
            if (r < I_OUT) { transpose_item(a.w_out, DM, DM, DM, 0, a.g_fox, a.g_sb, GW, WOUTT, scr, r, lane); continue; } r -= I_OUT;
            if (r < NE * I_W1) { const int e = r / I_W1; transpose_item(a.w1 + (size_t)e * DM * 2048, DM, 2048, 2048, 2, a.g2, nullptr, DM, W1T + (size_t)e * 2048 * DM, scr, r % I_W1, lane); continue; } r -= NE * I_W1;
            { const int e = r / I_W2; transpose_item(a.w2 + (size_t)e * DM * DM, DM, DM, DM, 0, nullptr, nullptr, DM, W2T + (size_t)e * DM * DM, scr, r % I_W2, lane); }
        }
        for (int i = gw * 64 + lane; i < DM * NE; i += NGW * 64) WR[i] = a.w_router[i] * a.g2[i >> 5];
        for (int row = gw; row < M; row += NGW) rms1_row(a.x, wf, a.b_f, XN, FLOG, row, lane);
    }
    xcd_barrier(bar);
    REPS(1) {
    if (vcu < NB * NH) cumsum_wg(FLOG, CUM, vcu, (LAS float*)(L + RING_OFF));
    if (OPT_GEMM) {
        pg8::Gemm g{XN, WINT, DM}; pg8::StaticOrder S; S.init(M, NPROJ, G, bx); pg8::EpiProj E{PROJ};
        pg8::gemm_phase<pg8::EpiProj, pg8::StaticOrder, true, false>(L + RING_OFF, g, S, E);
    } else { for (int it = gw; it < (M / 16) * (NPROJ / 64); it += NGW) nv_inproj(XN, WINT, PROJ, it, lane); }
    }
    xcd_barrier(bar);
    REPS(2) if (OPT_ATTN) {
        static_assert(attn_body::ATTN_LDS_BYTES <= RING_BYTES, "attention scratch inside the ring region");
        attn_body::attn_phase<8>((char*)lds + RING_OFF, (const attn_body::bf16*)PROJ, CUM, (attn_body::bf16*)OMIX, SSQ, vcu);
    } else {
        LAS unsigned char* wl = L + RING_OFF + wave * 16640;
        for (int u = gw; u < 4096; u += NGW) {
            const int i = u >> 11, idx = u & 2047, type = idx & 1, bh = (idx >> 1) & 31, j = (idx >> 6) & 31; const int qblk = (i == 0) ? j : 63 - j;
            if (type == 0) nv_attn<0>(PROJ, CUM, OMIX, SSQ, bh, qblk, lane, wl); else nv_attn<1>(PROJ, CUM, OMIX, SSQ, bh, qblk, lane, wl);
        }
    }
    xcd_barrier(bar);
    REPS(3) if (OPT_GEMM) {
        pg8::Gemm g{OMIX, WOUTT, DM}; pg8::StaticOrder S; S.init(M, DM, G, bx);
        LAS float* ratio = (LAS float*)(L + TAB_OFF); LAS float* rsb = (LAS float*)(L + TAB_OFF + 1024);
        pg8::Unit u0;
        if (S.next(0, u0) && tid < 256) { const float* sp = SSQ + (size_t)(u0.pm * 256 + tid) * 16; float sf = 0.f, s2 = 0.f;
#pragma unroll
            for (int h = 0; h < 8; ++h) { sf += sp[h]; s2 += sp[8 + h]; }
            const float rf = rsqrtf(sf * (1.f / GW) + EPS), rs = rsqrtf(s2 * (1.f / GW) + EPS); ratio[tid] = rf / rs; rsb[tid] = rs; }
        VM_WAIT(); LDS_WAIT(); __syncthreads();
        pg8::EpiWout E{a.x, a.out, X1B, ratio, rsb};
        pg8::gemm_phase<pg8::EpiWout, pg8::StaticOrder, false, false>(L + RING_OFF, g, S, E);
    } else { for (int it = gw; it < (M / 16) * (DM / 64); it += NGW) nv_wout(OMIX, WOUTT, SSQ, a.x, a.out, X1B, it, lane); }
    xcd_barrier(bar);
    if (OPT_ROUTER) { for (int t64 = vcu; t64 < M / 64; t64 += G) router_wg(a.out, WR, a.b_router, RSTD2, RW, LIST, CNT, t64 * 64, L + RING_OFF); }
    else { for (int it = gw; it < M / 2; it += NGW) nv_router(a.out, WR, a.b_router, RSTD2, RW, LIST, CNT, it, lane); }
    xcd_barrier(bar);
    LAS int* tb = (LAS int*)(L + TB_OFF); LAS int* tabA = (LAS int*)(L + TAB_OFF); LAS int* tabB = (LAS int*)(L + TAB2_OFF);
    REPS(5) if (OPT_GEMM) {
        if (tid == 0) { int run = 0; for (int e = 0; e < NE; ++e) { tb[e] = run; run += ((int)CNT[e] + 255) >> 8; } tb[NE] = run; }
        __syncthreads();
        pg8::MoeOrder S{8, bx, tb[NE] * 8, tb, tabA}; pg8::Unit u;
        for (int ui = 0; S.next(ui, u); ++ui) { const int e = u.pn >> 3, mt = u.pm - tb[e], cnt = (int)CNT[e];
            if (tid < 256) { const int p = mt * 256 + tid; const int slot = LIST[(size_t)e * LIST_CAP + (p < cnt ? p : cnt - 1)]; tabA[ui * 256 + tid] = slot >> 2; ((LAS float*)tabB)[ui * 256 + tid] = RSTD2[slot >> 2]; } }
        VM_WAIT(); LDS_WAIT(); __syncthreads();
        pg8::Gemm g{X1B, W1T, DM}; pg8::EpiMoe1 E{H, a.b1, (const LAS float*)tabB};
        pg8::gemm_phase<pg8::EpiMoe1, pg8::MoeOrder, true, true>(L + RING_OFF, g, S, E);
    } else {
    for (int g = gw; g < MAX_TILES * 16; g += NGW) {
        int e, base, p0, cnt; if (!moe_tile(CNT, g, e, base, p0, cnt)) continue;
        for (int cg = 0; cg < DFF / 32; ++cg) nv_moe1(X1B, W1T, a.b1, RSTD2, LIST, H, e, base, p0, cnt, cg, lane);
    } }
    xcd_barrier(bar);
    REPS(6) if (OPT_GEMM) {
        pg8::MoeOrder S{4, bx, tb[NE] * 4, tb, tabA}; pg8::Unit u;
        for (int ui = 0; S.next(ui, u); ++ui) { const int e = u.pn >> 2, mt = u.pm - tb[e], cnt = (int)CNT[e];
            if (tid < 256) { const int p = mt * 256 + tid; const int slot = LIST[(size_t)e * LIST_CAP + (p < cnt ? p : cnt - 1)]; tabA[ui * 256 + tid] = p < cnt ? slot : -1; ((LAS float*)tabB)[ui * 256 + tid] = RW[slot]; } }
        VM_WAIT(); LDS_WAIT(); __syncthreads();
        pg8::Gemm g{H, W2T, DM}; pg8::EpiMoe2 E{Y, a.b2, tabA, (const LAS float*)tabB};
        pg8::gemm_phase<pg8::EpiMoe2, pg8::MoeOrder, true, false>(L + RING_OFF, g, S, E);
    } else {
    for (int g = gw; g < MAX_TILES * 16; g += NGW) {
        int e, base, p0, cnt; if (!moe_tile(CNT, g, e, base, p0, cnt)) continue;
        for (int cg = 0; cg < DM / 64; ++cg) nv_moe2(H, W2T, a.b2, RW, LIST, Y, e, base, p0, cnt, cg, lane);
    } }
    xcd_barrier(bar);
    for (int row = gw; row < M; row += NGW) final_row(a.out, Y, a.gf, a.out, row, lane);
}

extern "C" void kernel_launch(void* const* d_in, const int* in_sizes, int n_in, void* d_out, int out_size, void* d_ws, size_t ws_size, hipStream_t stream) {
    static int grid = 0;
    if (grid == 0) {
        if (n_in != 15 || in_sizes[0] != M * DM || out_size != M * DM || ws_size < WS_END) {
            fprintf(stderr, "kernel_launch: unexpected shapes / workspace (n_in %d, in0 %d, out %d, ws %zu, need %zu)\n", n_in, n_in > 0 ? in_sizes[0] : -1, out_size, ws_size, (size_t)WS_END); grid = -1; return; }
        int dev = 0, cus = 0, per_cu = 0;
        if (hipGetDevice(&dev) != hipSuccess || hipDeviceGetAttribute(&cus, hipDeviceAttributeMultiprocessorCount, dev) != hipSuccess) { grid = -1; return; }
        if (hipFuncSetAttribute((const void*)mega_fwd, hipFuncAttributeMaxDynamicSharedMemorySize, LDS_BYTES) != hipSuccess) { fprintf(stderr, "kernel_launch: hipFuncSetAttribute failed\n"); grid = -1; return; }
        if (hipOccupancyMaxActiveBlocksPerMultiprocessor(&per_cu, (const void*)mega_fwd, NTHREADS, LDS_BYTES) != hipSuccess || per_cu < 1) fprintf(stderr, "kernel_launch: occupancy query reports %d\n", per_cu);
        (void)hipGetLastError();
        grid = cus;
    }
    if (grid < 0) return;
    if (hipMemsetAsync((char*)d_ws + WS_CTL, 0, CTL_BYTES, stream) != hipSuccess) return;
    Args a{};
    a.x = (const float*)d_in[0]; a.g1 = (const float*)d_in[1]; a.w_in = (const float*)d_in[2]; a.b_f = (const float*)d_in[3]; a.g_fox = (const float*)d_in[4]; a.g_sb = (const float*)d_in[5];
    a.w_out = (const float*)d_in[6]; a.g2 = (const float*)d_in[7]; a.w_router = (const float*)d_in[8]; a.b_router = (const float*)d_in[9]; a.w1 = (const float*)d_in[10]; a.b1 = (const float*)d_in[11];
    a.w2 = (const float*)d_in[12]; a.b2 = (const float*)d_in[13]; a.gf = (const float*)d_in[14];
    a.out = (float*)d_out; a.ws = (unsigned char*)d_ws;
    hipLaunchKernelGGL(mega_fwd, dim3(grid), dim3(NTHREADS), LDS_BYTES, stream, a);
    const hipError_t le = hipPeekAtLastError();
    if (le != hipSuccess) fprintf(stderr, "kernel_launch: launch failed: %s\n", hipGetErrorName(le));
}
```

```cpp
#include <hip/hip_runtime.h>
#include <cstdio>
#include <cstdint>

typedef unsigned short bf16_t;
typedef short bf16x8 __attribute__((ext_vector_type(8)));
typedef float f32x4 __attribute__((ext_vector_type(4)));

constexpr int NB = 4, SEQ = 4096, DM = 1024, M = NB * SEQ;
constexpr int NH = 8, HD = 64, GW = 512;
constexpr int WIN_N = 3080, NPROJ = 3072;
constexpr int NE = 32, TOPK = 4, DFF = 1024;
constexpr float EPS = 1e-5f;
constexpr float LOG2E = 1.4426950408889634f;
constexpr float C2 = 0.125f * LOG2E;
constexpr int LIST_CAP = M;
constexpr int MAX_TILES = (M * TOPK) / 256 + NE;

constexpr size_t MiB = 1u << 20;
constexpr size_t WS_CTL = 0, CTL_BYTES = 1 * MiB;
constexpr size_t WS_WINT = 2 * MiB;
constexpr size_t WS_WOUTT = 8 * MiB;
constexpr size_t WS_WR = 10 * MiB;
constexpr size_t WS_CUM = 11 * MiB;
constexpr size_t WS_SSQ = 12 * MiB;
constexpr size_t WS_RSTD2 = 14 * MiB;
constexpr size_t WS_RW = 15 * MiB;
constexpr size_t WS_LIST = 16 * MiB;
constexpr size_t WS_FLOG = 18 * MiB;
constexpr size_t WS_XN = 32 * MiB;
constexpr size_t WS_PROJ = 64 * MiB;
constexpr size_t WS_OMIX = 160 * MiB;
constexpr size_t WS_X1B = 192 * MiB;
constexpr size_t WS_W1T = 224 * MiB;
constexpr size_t WS_W2T = 352 * MiB;
constexpr size_t WS_H = 416 * MiB;
constexpr size_t WS_Y = 560 * MiB;
constexpr size_t WS_END = 688 * MiB;
constexpr int CW_CNT = 1024;

__device__ __forceinline__ unsigned short f2bf(float f) { unsigned u = __float_as_uint(f); return (unsigned short)((u + 0x7fffu + ((u >> 16) & 1u)) >> 16); }
__device__ __forceinline__ float bf2f(unsigned short b) { return __uint_as_float(((unsigned)b) << 16); }
__device__ __forceinline__ float wave_sum(float v) {
#pragma unroll
    for (int o = 1; o < 64; o <<= 1) v += __shfl_xor(v, o);
    return v;
}


#define LAS __attribute__((address_space(3)))
#define GAS __attribute__((address_space(1)))
typedef unsigned v4u __attribute__((ext_vector_type(4)));
#define LDS_WAIT() asm volatile("s_waitcnt lgkmcnt(0)" ::: "memory")
#define VM_WAIT() asm volatile("s_waitcnt vmcnt(0)" ::: "memory")
constexpr int NWAVES = 8, NTHREADS = NWAVES * 64;
constexpr int REP_PHASE = -1;
#define REPS(k) for (int rep_ = 0; rep_ < ((REP_PHASE == (k)) ? 2 : 1); ++rep_)
constexpr bool OPT_GEMM = true;
constexpr bool OPT_ROUTER = true;
constexpr bool OPT_ATTN = true;

#define XB_TMO      128
#define XB_XCNT(j)  (256  + 64 * (j))
#define XB_XSUB(j)  (1280 + 64 * (j))
#define XB_XGEN(j)  (2304 + 64 * (j))
#define XB_TOP      3328
#define XB_TOPGEN   3392
#define XCD_BAR_WORDS 3456
#define XB_SPIN_CAP (1u << 20)
__device__ __forceinline__ unsigned xb_ld(unsigned* p)              { return __hip_atomic_load(p, __ATOMIC_RELAXED, __HIP_MEMORY_SCOPE_AGENT); }
__device__ __forceinline__ unsigned xb_add(unsigned* p, unsigned v) { return __hip_atomic_fetch_add(p, v, __ATOMIC_RELAXED, __HIP_MEMORY_SCOPE_AGENT); }
__device__ __forceinline__ unsigned xb_xcc_id() { return (unsigned)__builtin_amdgcn_s_getreg((3 << 11) | 20) & 0xFu; }
#define XB_SPIN(cond, bar) do { unsigned _sp = 0; while (cond) { __builtin_amdgcn_s_sleep(1); \
    if ((++_sp & 255u) == 0u) { if (xb_ld(&(bar)[XB_TMO])) break; if (_sp > XB_SPIN_CAP) { atomicAdd(&(bar)[XB_TMO], 1u); break; } } } } while (0)
struct XcdBarrier { unsigned* bar; unsigned x; volatile LAS unsigned* st; };
__device__ __forceinline__ XcdBarrier xcd_barrier_post(unsigned* bar, volatile LAS unsigned* st) {
    XcdBarrier b; b.bar = bar; b.x = xb_xcc_id(); b.st = st;
    if (threadIdx.x == 0) (void)xb_add(&bar[XB_XCNT(b.x)], 1u);
    return b;
}
__device__ __forceinline__ void xcd_barrier_complete(unsigned* bar, unsigned x, unsigned& nloc, unsigned& nx) {
    const unsigned G = gridDim.x * gridDim.y * gridDim.z;
    unsigned sum, cnt, mine, sp = 0u;
    for (;;) {
        sum = 0u; cnt = 0u; mine = 0u;
#pragma unroll
        for (unsigned j = 0; j < 16; ++j) { const unsigned c = xb_ld(&bar[XB_XCNT(j)]); sum += c; cnt += (c > 0u) ? 1u : 0u; mine = (j == x) ? c : mine; }
        if (sum == G) break;
        __builtin_amdgcn_s_sleep(1);
        if ((++sp & 255u) == 0u) { if (xb_ld(&bar[XB_TMO])) break; if (sp > XB_SPIN_CAP) { atomicAdd(&bar[XB_TMO], 1u); break; } }
    }
    nloc = mine > 0u ? mine : 1u; nx = cnt > 0u ? cnt : 1u;
}
__device__ __forceinline__ void xcd_barrier(const XcdBarrier& b) {
    asm volatile("s_waitcnt vmcnt(0)" ::: "memory");
    __syncthreads();
    if (threadIdx.x == 0) {
        unsigned* bar = b.bar;
        __builtin_amdgcn_s_waitcnt(0);
        unsigned nloc = b.st[0], nx = b.st[1];
        if (nloc == 0u) { xcd_barrier_complete(bar, b.x, nloc, nx); b.st[0] = nloc; b.st[1] = nx; }
        const unsigned old = xb_add(&bar[XB_XSUB(b.x)], 1u);
        const unsigned gen = old / nloc;
        if (old + 1u == (gen + 1u) * nloc) {
            __builtin_amdgcn_fence(__ATOMIC_RELEASE, "agent");
            asm volatile("s_waitcnt vmcnt(0)" ::: "memory");
            const unsigned og = xb_add(&bar[XB_TOP], 1u);
            const unsigned tg = og / nx;
            if (og + 1u == (tg + 1u) * nx) xb_add(&bar[XB_TOPGEN], 1u);
            else XB_SPIN(xb_ld(&bar[XB_TOPGEN]) == tg, bar);
            __builtin_amdgcn_fence(__ATOMIC_ACQUIRE, "agent");
            xb_add(&bar[XB_XGEN(b.x)], 1u);
            asm volatile("s_waitcnt vmcnt(0)" ::: "memory");
        } else {
            XB_SPIN(xb_ld(&bar[XB_XGEN(b.x)]) == gen, bar);
            __builtin_amdgcn_fence(__ATOMIC_ACQUIRE, "agent");
            asm volatile("s_waitcnt vmcnt(0)" ::: "memory");
        }
    }
    __syncthreads();
}

constexpr int RING_OFF = 0, RING_BYTES = 131072;
constexpr int TAB_OFF = 131072;
constexpr int TAB2_OFF = TAB_OFF + 9 * 1024, TB_OFF = TAB_OFF + 18 * 1024;
constexpr int LDSCTL_OFF = 150528, MISC_OFF = LDSCTL_OFF + 320;
constexpr int LDS_BYTES = 155648;
constexpr int CW_BAR = 4096;

struct Args {
    const float *x, *g1, *w_in, *b_f, *g_fox, *g_sb, *w_out, *g2, *w_router, *b_router, *w1, *b1, *w2, *b2, *gf;
    float* out; unsigned char* ws;
};

__device__ __forceinline__ int mapcol(int mode, int n) {
    if (mode == 1) return n < 1536 ? n : n + 8;
    if (mode == 2) { const int pn = n >> 8, j = n & 255; return j < 128 ? 128 * pn + j : 1024 + 128 * pn + (j - 128); }
    return n;
}
__device__ __forceinline__ unsigned pk2(float lo, float hi) { return (unsigned)f2bf(lo) | ((unsigned)f2bf(hi) << 16); }
__device__ __forceinline__ void transpose_item(const float* __restrict__ W, int K, int Nin, int Nout, int mode, const float* __restrict__ gA, const float* __restrict__ gB, int gsplit,
                                               bf16_t* __restrict__ WT, LAS float* scr, int item, int lane) {
    const int nblk = Nout / 32, kb = item / nblk, nb = item % nblk, k0 = 64 * kb, n0 = 32 * nb;
    const int l7 = lane & 7, kr = lane >> 3, col = mapcol(mode, n0 + 4 * l7);
    f32x4 v[8];
#pragma unroll
    for (int i = 0; i < 8; ++i) v[i] = *(const f32x4*)(W + (size_t)(k0 + 8 * i + kr) * Nin + col);
#pragma unroll
    for (int i = 0; i < 8; ++i) { const int kk = 8 * i + kr, k = k0 + kk; const float gs = gA ? (k < gsplit ? gA[k] : gB[k - gsplit]) : 1.f;
        LAS float* sp = scr + kk * 33 + 4 * l7; sp[0] = v[i][0] * gs; sp[1] = v[i][1] * gs; sp[2] = v[i][2] * gs; sp[3] = v[i][3] * gs; }
    LDS_WAIT();
    const int c = lane & 7;
#pragma unroll
    for (int j = 0; j < 4; ++j) { const int n = (lane >> 3) + 8 * j; const LAS float* sp = scr + (8 * c) * 33 + n;
        v4u o; o.x = pk2(sp[0 * 33], sp[1 * 33]); o.y = pk2(sp[2 * 33], sp[3 * 33]); o.z = pk2(sp[4 * 33], sp[5 * 33]); o.w = pk2(sp[6 * 33], sp[7 * 33]);
        *(v4u*)(WT + (size_t)(n0 + n) * K + k0 + 8 * c) = o; }
    LDS_WAIT();
}

__device__ __forceinline__ float log_sigmoid(float v) { return fminf(v, 0.f) - log1pf(expf(-fabsf(v))); }
__device__ __forceinline__ void rms1_row(const float* __restrict__ x, const LAS float* wf  , const float* __restrict__ b_f,
                                         bf16_t* __restrict__ XN, float* __restrict__ FLOG, int row, int lane) {
    const float4* xr = (const float4*)(x + (size_t)row * DM);
    float4 v[4]; float ss = 0.f;
#pragma unroll
    for (int j = 0; j < 4; ++j) { v[j] = xr[lane + 64 * j]; ss += v[j].x * v[j].x + v[j].y * v[j].y + v[j].z * v[j].z + v[j].w * v[j].w; }
    ss = wave_sum(ss);
    const float rstd = rsqrtf(ss * (1.f / DM) + EPS);
    float f0 = 0.f, f1 = 0.f, f2 = 0.f, f3 = 0.f, f4 = 0.f, f5 = 0.f, f6 = 0.f, f7 = 0.f;
#pragma unroll
    for (int j = 0; j < 4; ++j) {
        const int c0 = 4 * (lane + 64 * j);
        uint2 o; o.x = pk2(v[j].x * rstd, v[j].y * rstd); o.y = pk2(v[j].z * rstd, v[j].w * rstd);
        *(uint2*)(XN + (size_t)row * DM + c0) = o;
        const float xs[4] = {v[j].x, v[j].y, v[j].z, v[j].w};
#pragma unroll
        for (int c = 0; c < 4; ++c) {
            const int k = c0 + c; const float xv = xs[c];
            const LAS f32x4* wp = (const LAS f32x4*)(wf + k * 8); const f32x4 w0 = wp[0], w1 = wp[1];
            f0 += xv * w0.x; f1 += xv * w0.y; f2 += xv * w0.z; f3 += xv * w0.w; f4 += xv * w1.x; f5 += xv * w1.y; f6 += xv * w1.z; f7 += xv * w1.w;
        }
    }
    f0 = wave_sum(f0); f1 = wave_sum(f1); f2 = wave_sum(f2); f3 = wave_sum(f3); f4 = wave_sum(f4); f5 = wave_sum(f5); f6 = wave_sum(f6); f7 = wave_sum(f7);
    if (lane < 8) {
        float f = f0; f = lane == 1 ? f1 : f; f = lane == 2 ? f2 : f; f = lane == 3 ? f3 : f; f = lane == 4 ? f4 : f; f = lane == 5 ? f5 : f; f = lane == 6 ? f6 : f; f = lane == 7 ? f7 : f;
        FLOG[(size_t)row * 8 + lane] = log_sigmoid(f * rstd + b_f[lane]);
    }
}
__device__ __forceinline__ void cumsum_wg(const float* __restrict__ FLOG, float* __restrict__ CUM, int bh, LAS float* part) {
    const int b = bh >> 3, h = bh & 7, t = threadIdx.x;
    float loc[8]; float s = 0.f;
#pragma unroll
    for (int i = 0; i < 8; ++i) { loc[i] = FLOG[((size_t)b * SEQ + t * 8 + i) * 8 + h]; s += loc[i]; }
    part[t] = s; __syncthreads();
    float run = 0.f; for (int i = 0; i < t; ++i) run += part[i];
#pragma unroll
    for (int i = 0; i < 8; ++i) { run += loc[i]; CUM[(size_t)bh * SEQ + t * 8 + i] = run * LOG2E; }
    __syncthreads();
}

template <int NT> __device__ __forceinline__ void wave_mma(f32x4 (&acc)[NT], const bf16_t* ap, const bf16_t* const (&bp)[NT], int K) {
    for (int k0 = 0; k0 < K; k0 += 32) {
        const bf16x8 a = *(const bf16x8*)(ap + k0);
#pragma unroll
        for (int t = 0; t < NT; ++t) { const bf16x8 b = *(const bf16x8*)(bp[t] + k0); acc[t] = __builtin_amdgcn_mfma_f32_16x16x32_bf16(a, b, acc[t], 0, 0, 0); }
    }
}
__device__ __forceinline__ void nv_inproj(const bf16_t* __restrict__ XN, const bf16_t* __restrict__ WINT, bf16_t* __restrict__ PROJ, int item, int lane) {
    const int n0 = (item % 48) * 64, m0 = (item / 48) * 16, r = lane & 15, q = lane >> 4;
    f32x4 acc[4];
#pragma unroll
    for (int t = 0; t < 4; ++t) acc[t] = (f32x4){0.f, 0.f, 0.f, 0.f};
    const bf16_t* ap = XN + (size_t)(m0 + r) * DM + 8 * q;
    const bf16_t* bp[4];
#pragma unroll
    for (int t = 0; t < 4; ++t) bp[t] = WINT + (size_t)(n0 + 16 * t + r) * DM + 8 * q;
    wave_mma<4>(acc, ap, bp, DM);
    const float sc = (n0 < 512 || (n0 >= 1536 && n0 < 2048)) ? C2 : 1.f;
#pragma unroll
    for (int t = 0; t < 4; ++t)
#pragma unroll
        for (int j = 0; j < 4; ++j) PROJ[(size_t)(m0 + 4 * q + j) * NPROJ + n0 + 16 * t + r] = f2bf(acc[t][j] * sc);
}

template <int TYPE> __device__ __forceinline__ void nv_attn(const bf16_t* __restrict__ PROJ, const float* __restrict__ CUM, bf16_t* __restrict__ OMIX, float* __restrict__ SSQ,
                                                          int bh, int qblk, int lane, LAS unsigned char* wl) {
    LAS bf16_t* Ks = (LAS bf16_t*)wl; LAS bf16_t* Vs = (LAS bf16_t*)(wl + 8192); LAS float* Cs = (LAS float*)(wl + 16384);
    const int b = bh >> 3, h = bh & 7, t = qblk * 64 + lane;
    const size_t row = (size_t)b * SEQ + t;
    const int qcol = (TYPE == 0 ? 0 : 1536) + h * HD, kcol = qcol + 512, vcol = qcol + 1024;
    float q[64], o[64];
#pragma unroll
    for (int c = 0; c < 8; ++c) { const bf16x8 v = *(const bf16x8*)(PROJ + row * NPROJ + qcol + 8 * c);
#pragma unroll
        for (int j = 0; j < 8; ++j) q[8 * c + j] = bf2f((unsigned short)v[j]); }
#pragma unroll
    for (int d = 0; d < 64; ++d) o[d] = 0.f;
    float m = -INFINITY, l = 0.f, R = 1.f;
    const float cq = CUM[(size_t)bh * SEQ + t];
    for (int it = 0; it <= qblk; ++it) {
        const int kt = (TYPE == 0) ? it : qblk - it;
        LDS_WAIT();
        for (int i = 0; i < 64; ++i) { const size_t kr = ((size_t)b * SEQ + kt * 64 + i) * NPROJ; Ks[i * 64 + lane] = PROJ[kr + kcol + lane]; Vs[i * 64 + lane] = PROJ[kr + vcol + lane]; }
        Cs[lane] = CUM[(size_t)bh * SEQ + kt * 64 + lane];
        LDS_WAIT();
        for (int ss = 0; ss < 64; ++ss) {
            const int s = (TYPE == 0) ? ss : 63 - ss; const int ks = kt * 64 + s;
            float dot = 0.f;
#pragma unroll
            for (int d = 0; d < 64; d += 8) { const bf16x8 kv = *(const LAS bf16x8*)&Ks[s * 64 + d];
#pragma unroll
                for (int j = 0; j < 8; ++j) dot += q[d + j] * bf2f((unsigned short)kv[j]); }
            if (TYPE == 0) {
                if (ks <= t) {
                    const float xv = dot + cq - Cs[s]; const float mn = fmaxf(m, xv); const float sc = exp2f(m - mn), p = exp2f(xv - mn);
                    l = l * sc + p; m = mn;
#pragma unroll
                    for (int d = 0; d < 64; d += 8) { const bf16x8 vv = *(const LAS bf16x8*)&Vs[s * 64 + d];
#pragma unroll
                        for (int j = 0; j < 8; ++j) o[d + j] = o[d + j] * sc + p * bf2f((unsigned short)vv[j]); }
                }
            } else {
                if (ks < t) {
                    const float z = fminf(fmaxf(dot, -80.f), 80.f); const float e = exp2f(z); const float rr = 1.f / (1.f + e); const float a = e * rr * R; R *= rr;
#pragma unroll
                    for (int d = 0; d < 64; d += 8) { const bf16x8 vv = *(const LAS bf16x8*)&Vs[s * 64 + d];
#pragma unroll
                        for (int j = 0; j < 8; ++j) o[d + j] += a * bf2f((unsigned short)vv[j]); }
                }
            }
        }
    }
    const float inv = (TYPE == 0) ? 1.f / l : 1.f;
    float ssq = 0.f;
#pragma unroll
    for (int d = 0; d < 64; ++d) { o[d] *= inv; ssq += o[d] * o[d]; }
    SSQ[row * 16 + TYPE * 8 + h] = ssq;
#pragma unroll
    for (int c = 0; c < 8; ++c) { bf16x8 v;
#pragma unroll
        for (int j = 0; j < 8; ++j) v[j] = (short)f2bf(o[8 * c + j]);
        *(bf16x8*)(OMIX + row * DM + TYPE * GW + h * HD + 8 * c) = v; }
}

__device__ __forceinline__ void nv_wout(const bf16_t* __restrict__ OMIX, const bf16_t* __restrict__ WOUTT, const float* __restrict__ SSQ, const float* __restrict__ x,
                                        float* __restrict__ X1, bf16_t* __restrict__ X1B, int item, int lane) {
    const int n0 = (item & 15) * 64, m0 = (item >> 4) * 16, r = lane & 15, q = lane >> 4;
    f32x4 af[4], as[4];
#pragma unroll
    for (int t = 0; t < 4; ++t) { af[t] = (f32x4){0.f, 0.f, 0.f, 0.f}; as[t] = (f32x4){0.f, 0.f, 0.f, 0.f}; }
    const bf16_t* ap = OMIX + (size_t)(m0 + r) * DM + 8 * q;
    const bf16_t* bp[4]; const bf16_t* bp2[4];
#pragma unroll
    for (int t = 0; t < 4; ++t) { bp[t] = WOUTT + (size_t)(n0 + 16 * t + r) * DM + 8 * q; bp2[t] = bp[t] + GW; }
    wave_mma<4>(af, ap, bp, GW);
    wave_mma<4>(as, ap + GW, bp2, GW);
#pragma unroll
    for (int j = 0; j < 4; ++j) {
        const size_t row = m0 + 4 * q + j; const float* sp = SSQ + row * 16;
        float sf = 0.f, s2 = 0.f;
#pragma unroll
        for (int h = 0; h < 8; ++h) { sf += sp[h]; s2 += sp[8 + h]; }
        const float rf = rsqrtf(sf * (1.f / GW) + EPS), rs = rsqrtf(s2 * (1.f / GW) + EPS);
#pragma unroll
        for (int t = 0; t < 4; ++t) { const size_t idx = row * DM + n0 + 16 * t + r; const float v = x[idx] + rf * af[t][j] + rs * as[t][j]; X1[idx] = v; X1B[idx] = f2bf(v); }
    }
}

__device__ __forceinline__ void nv_router(const float* __restrict__ X1, const float* __restrict__ WR, const float* __restrict__ b_router, float* __restrict__ RSTD2,
                                          float* __restrict__ RW, int* __restrict__ LIST, unsigned* __restrict__ CNT, int item, int lane) {
    const int e = lane & 31, tok = item * 2 + (lane >> 5);
    const float* xr = X1 + (size_t)tok * DM;
    float acc = 0.f, ss = 0.f;
    for (int k = 0; k < DM; ++k) { const float xv = xr[k]; acc += xv * WR[k * NE + e]; ss += xv * xv; }
    const float rstd = rsqrtf(ss * (1.f / DM) + EPS);
    float logit = acc * rstd + b_router[e];
    if (e == 0) RSTD2[tok] = rstd;
    float tv[4]; int ti[4];
#pragma unroll
    for (int k = 0; k < 4; ++k) {
        float bv = logit; int bi = e;
#pragma unroll
        for (int o = 1; o < 32; o <<= 1) { const float ov = __shfl_xor(bv, o); const int oi = __shfl_xor(bi, o); if (ov > bv || (ov == bv && oi < bi)) { bv = ov; bi = oi; } }
        tv[k] = bv; ti[k] = bi; if (e == bi) logit = -INFINITY;
    }
    const float e0 = 1.f, e1 = expf(tv[1] - tv[0]), e2 = expf(tv[2] - tv[0]), e3 = expf(tv[3] - tv[0]); const float inv = 1.f / (e0 + e1 + e2 + e3);
    const float w0 = e0 * inv, w1 = e1 * inv, w2 = e2 * inv, w3 = e3 * inv;
    int myk = -1; float myw = 0.f;
    if (e == ti[0]) { myk = 0; myw = w0; } if (e == ti[1]) { myk = 1; myw = w1; } if (e == ti[2]) { myk = 2; myw = w2; } if (e == ti[3]) { myk = 3; myw = w3; }
    if (myk >= 0) { const int slot = tok * 4 + myk; const unsigned pos = atomicAdd(&CNT[e], 1u); LIST[(size_t)e * LIST_CAP + pos] = slot; RW[slot] = myw; }
}


typedef float f32x16 __attribute__((ext_vector_type(16)));
__device__ __forceinline__ void router_wg(const float* __restrict__ X1, const float* __restrict__ WR, const float* __restrict__ b_router, float* __restrict__ RSTD2,
                                          float* __restrict__ RW, int* __restrict__ LIST, unsigned* __restrict__ CNT, int tokbase, LAS unsigned char* L) {
    int tid_ = threadIdx.x; asm volatile("" : "+v"(tid_));
    const int tid = tid_, lane = tid & 63, wave = __builtin_amdgcn_readfirstlane(tid >> 6), kq = wave & 3, tile = wave >> 2, r32 = lane & 31, hi = lane >> 5;
    LAS float* Dx = (LAS float*)L; LAS float* SSx = (LAS float*)(L + 32768); LAS unsigned* lcnt = (LAS unsigned*)(L + 33792); LAS unsigned* lbase = (LAS unsigned*)(L + 33920);
    if (tid < NE) lcnt[tid] = 0u;
    const int tok = tokbase + tile * 32 + r32;
    const float* xp = X1 + (size_t)tok * DM + kq * 256 + 4 * hi;
    const float* wp = WR + (size_t)(kq * 256 + 4 * hi) * NE + r32;
    f32x16 acc;
#pragma unroll
    for (int r = 0; r < 16; ++r) acc[r] = 0.f;
    float ss = 0.f;
#pragma unroll 1
    for (int mc = 0; mc < 4; ++mc) {
        float4 xv[8];
#pragma unroll
        for (int m = 0; m < 8; ++m) xv[m] = *(const float4*)(xp + (mc * 8 + m) * 8);
#pragma unroll
        for (int m = 0; m < 8; ++m) {
            const float* w4 = wp + (size_t)((mc * 8 + m) * 8) * NE;
            const float w0 = w4[0], w1 = w4[NE], w2 = w4[2 * NE], w3 = w4[3 * NE];
            acc = __builtin_amdgcn_mfma_f32_32x32x2f32(w0, xv[m].x, acc, 0, 0, 0);
            acc = __builtin_amdgcn_mfma_f32_32x32x2f32(w1, xv[m].y, acc, 0, 0, 0);
            acc = __builtin_amdgcn_mfma_f32_32x32x2f32(w2, xv[m].z, acc, 0, 0, 0);
            acc = __builtin_amdgcn_mfma_f32_32x32x2f32(w3, xv[m].w, acc, 0, 0, 0);
            ss += xv[m].x * xv[m].x + xv[m].y * xv[m].y + xv[m].z * xv[m].z + xv[m].w * xv[m].w;
        }
    }
    { auto rr = __builtin_amdgcn_permlane32_swap(__float_as_uint(ss), __float_as_uint(ss), false, false); ss = __uint_as_float(rr[0]) + __uint_as_float(rr[1]); }
#pragma unroll
    for (int r = 0; r < 16; ++r) Dx[(wave * 16 + r) * 64 + lane] = acc[r];
    if (hi == 0) SSx[wave * 32 + r32] = ss;
    LDS_WAIT(); __syncthreads();
    int ea = 0, eb = 0; float wa = 0.f, wb = 0.f; unsigned la = 0u, lb = 0u;
    if (kq == 0) {
        float v[16]; float sst = 0.f;
#pragma unroll
        for (int w = 0; w < 4; ++w) sst += SSx[(tile * 4 + w) * 32 + r32];
        const float rstd = rsqrtf(sst * (1.f / DM) + EPS);
#pragma unroll
        for (int r = 0; r < 16; ++r) { float a = 0.f;
#pragma unroll
            for (int w = 0; w < 4; ++w) a += Dx[((tile * 4 + w) * 16 + r) * 64 + lane];
            v[r] = a * rstd + b_router[(r & 3) + 8 * (r >> 2) + 4 * hi]; }
        if (hi == 0) RSTD2[tok] = rstd;
        float tv[4]; int te[4];
#pragma unroll
        for (int k = 0; k < 4; ++k) {
            float bv = v[0]; int br = 0;
#pragma unroll
            for (int r = 1; r < 16; ++r) if (v[r] > bv) { bv = v[r]; br = r; }
            const int be = (br & 3) + 8 * (br >> 2) + 4 * hi;
            auto r1 = __builtin_amdgcn_permlane32_swap(__float_as_uint(bv), __float_as_uint(bv), false, false);
            auto r2 = __builtin_amdgcn_permlane32_swap((unsigned)be, (unsigned)be, false, false);
            const float pv = __uint_as_float(hi ? r1[0] : r1[1]); const int pe = (int)(hi ? r2[0] : r2[1]);
            const bool mine = (bv > pv) || (bv == pv && be < pe);
            tv[k] = mine ? bv : pv; te[k] = mine ? be : pe;
#pragma unroll
            for (int r = 0; r < 16; ++r) v[r] = (mine && r == br) ? -INFINITY : v[r];
        }
        const float e1 = expf(tv[1] - tv[0]), e2 = expf(tv[2] - tv[0]), e3 = expf(tv[3] - tv[0]); const float inv = 1.f / (1.f + e1 + e2 + e3);
        ea = hi ? te[2] : te[0]; eb = hi ? te[3] : te[1]; wa = (hi ? e2 : 1.f) * inv; wb = (hi ? e3 : e1) * inv;
        la = atomicAdd((unsigned*)&lcnt[ea], 1u); lb = atomicAdd((unsigned*)&lcnt[eb], 1u);
    }
    LDS_WAIT(); __syncthreads();
    if (tid < NE) { const unsigned c = lcnt[tid]; lbase[tid] = c ? atomicAdd(&CNT[tid], c) : 0u; }
    LDS_WAIT(); __syncthreads();
    if (kq == 0) {
        const int sa = tok * 4 + 2 * hi, sb = sa + 1;
        LIST[(size_t)ea * LIST_CAP + lbase[ea] + la] = sa; RW[sa] = wa;
        LIST[(size_t)eb * LIST_CAP + lbase[eb] + lb] = sb; RW[sb] = wb;
    }
    LDS_WAIT(); __syncthreads();
}

__device__ __forceinline__ bool moe_tile(const unsigned* CNT, int g, int& e, int& base, int& p0, int& cnt) {
    const int tile256 = g >> 4; base = 0;
    for (e = 0; e < NE; ++e) { const int nt = ((int)CNT[e] + 255) >> 8; if (tile256 < base + nt) break; base += nt; }
    if (e == NE) return false;
    cnt = (int)CNT[e]; p0 = (g - base * 16) * 16; return p0 < cnt;
}
__device__ __forceinline__ void nv_moe1(const bf16_t* __restrict__ X1B, const bf16_t* __restrict__ W1T, const float* __restrict__ b1, const float* __restrict__ RSTD2,
                                        const int* __restrict__ LIST, bf16_t* __restrict__ H, int e, int base, int p0, int cnt, int cg, int lane) {
    const int r = lane & 15, q = lane >> 4, c0 = cg * 32, pn = c0 >> 7, j0 = c0 & 127;
    const int* lst = LIST + (size_t)e * LIST_CAP;
    const int prow = p0 + r; const int tok = lst[prow < cnt ? prow : cnt - 1] >> 2;
    f32x4 acc[4];
#pragma unroll
    for (int t = 0; t < 4; ++t) acc[t] = (f32x4){0.f, 0.f, 0.f, 0.f};
    const bf16_t* ap = X1B + (size_t)tok * DM + 8 * q;
    const bf16_t* wb = W1T + (size_t)e * 2048 * DM + (size_t)(256 * pn + j0 + r) * DM + 8 * q;
    const bf16_t* bp[4] = {wb, wb + 16 * DM, wb + 128 * DM, wb + 144 * DM};
    wave_mma<4>(acc, ap, bp, DM);
#pragma unroll
    for (int j = 0; j < 4; ++j) {
        const int pr = p0 + 4 * q + j; if (pr >= cnt) continue;
        const float rs = RSTD2[lst[pr] >> 2];
#pragma unroll
        for (int t = 0; t < 2; ++t) {
            const int col = c0 + 16 * t + r;
            float glu = acc[t][j] * rs + b1[(size_t)e * 2048 + col], lin = acc[t + 2][j] * rs + b1[(size_t)e * 2048 + 1024 + col];
            glu = fminf(glu, 7.f); lin = fminf(fmaxf(lin, -7.f), 7.f);
            const float act = glu * (1.f / (1.f + expf(-1.702f * glu))) * (lin + 1.f);
            H[((size_t)base * 256 + pr) * DM + col] = f2bf(act);
        }
    }
}
__device__ __forceinline__ void nv_moe2(const bf16_t* __restrict__ H, const bf16_t* __restrict__ W2T, const float* __restrict__ b2, const float* __restrict__ RW,
                                        const int* __restrict__ LIST, bf16_t* __restrict__ Y, int e, int base, int p0, int cnt, int cg, int lane) {
    const int r = lane & 15, q = lane >> 4, n0 = cg * 64;
    const int* lst = LIST + (size_t)e * LIST_CAP;
    f32x4 acc[4];
#pragma unroll
    for (int t = 0; t < 4; ++t) acc[t] = (f32x4){0.f, 0.f, 0.f, 0.f};
    const bf16_t* ap = H + ((size_t)base * 256 + p0 + r) * DM + 8 * q;
    const bf16_t* bp[4];
#pragma unroll
    for (int t = 0; t < 4; ++t) bp[t] = W2T + (size_t)e * DM * DM + (size_t)(n0 + 16 * t + r) * DM + 8 * q;
    wave_mma<4>(acc, ap, bp, DM);
#pragma unroll
    for (int j = 0; j < 4; ++j) {
        const int pr = p0 + 4 * q + j; if (pr >= cnt) continue;
        const int slot = lst[pr]; const float w = RW[slot];
#pragma unroll
        for (int t = 0; t < 4; ++t) { const int col = n0 + 16 * t + r; Y[(size_t)slot * DM + col] = f2bf((acc[t][j] + b2[(size_t)e * DM + col]) * w); }
    }
}

__device__ __forceinline__ void final_row(const float* X1, const bf16_t* __restrict__ Y, const float* __restrict__ gf, float* out, int row, int lane) {
    float4 v[4]; float ss = 0.f;
#pragma unroll
    for (int j = 0; j < 4; ++j) {
        const int c0 = 4 * (lane + 64 * j);
        v[j] = *(const float4*)(X1 + (size_t)row * DM + c0);
#pragma unroll
        for (int k = 0; k < 4; ++k) { const uint2 y = *(const uint2*)(Y + ((size_t)row * 4 + k) * DM + c0);
            v[j].x += bf2f((unsigned short)(y.x & 0xffff)); v[j].y += bf2f((unsigned short)(y.x >> 16)); v[j].z += bf2f((unsigned short)(y.y & 0xffff)); v[j].w += bf2f((unsigned short)(y.y >> 16)); }
        ss += v[j].x * v[j].x + v[j].y * v[j].y + v[j].z * v[j].z + v[j].w * v[j].w;
    }
    ss = wave_sum(ss);
    const float rstd = rsqrtf(ss * (1.f / DM) + EPS);
#pragma unroll
    for (int j = 0; j < 4; ++j) { const int c0 = 4 * (lane + 64 * j); const float4 g = *(const float4*)(gf + c0);
        float4 o; o.x = v[j].x * rstd * g.x; o.y = v[j].y * rstd * g.y; o.z = v[j].z * rstd * g.z; o.w = v[j].w * rstd * g.w; *(float4*)(out + (size_t)row * DM + c0) = o; }
}


namespace pg8 {
#define PG8_LAS __attribute__((address_space(3)))
typedef unsigned u32x4 __attribute__((ext_vector_type(4)));
typedef unsigned u32x2 __attribute__((ext_vector_type(2)));
constexpr int BM = 256, BK = 64, HALF = 128, HTB = HALF * BK * 2  , STAGE_BYTES = 8 * HTB, NXCD = 8, WGM = 8;
__host__ __device__ __forceinline__ int lds_byte(int r, int c) { const int st = (r >> 4) * 2 + (c >> 5), rr = r & 15, cc = c & 31, ob = rr * 64 + cc * 2; return st * 1024 + (ob ^ (((ob >> 9) & 1) << 5)); }
__host__ __device__ __forceinline__ void stage_rc(int b, int& R, int& C) { const int st = b / 1024, sb = b % 1024, swz = sb ^ (((sb >> 9) & 1) << 5); R = (st >> 1) * 16 + swz / 64; C = (st & 1) * 32 + (swz % 64) / 2; }
__host__ __device__ __forceinline__ int perm32(int rho) { const int n = rho >> 4, i = rho & 15; return 8 * (i >> 2) + 4 * n + (i & 3); }
struct Unit { int pm, pn; };
struct Gemm { const bf16_t* A; const bf16_t* Bt; int K; };
struct StaticOrder {
    int nM, nN, nwg, G, c;
    __device__ void init(int M_, int N_, int G_, int c_) { nM = M_ / BM; nN = N_ / BM; nwg = nM * nN; G = G_; c = c_; }
    __device__ bool next(int i, Unit& u) const {
        const long L = (long)i * G + c; if (L >= nwg) return false;
        int wgid = (int)L; { const int q = nwg / NXCD, r = nwg % NXCD, xcd = wgid % NXCD, off = wgid / NXCD; wgid = (xcd < r ? xcd * (q + 1) : r * (q + 1) + (xcd - r) * q) + off; }
        const int nig = WGM * nN, gid = wgid / nig, fm = gid * WGM, gsz = (nM - fm) < WGM ? (nM - fm) : WGM;
        u.pm = fm + ((wgid % nig) % gsz); u.pn = (wgid % nig) / gsz; return true;
    }
    __device__ __forceinline__ const PG8_LAS int* rowtab(int) const { return nullptr; }
};
__device__ __forceinline__ unsigned cvt_pk_bf16(float lo, float hi) { unsigned r; asm volatile("v_cvt_pk_bf16_f32 %0, %1, %2" : "=v"(r) : "v"(lo), "v"(hi)); return r; }

template <class Sched> __device__ __forceinline__ void gather_voffs(const Sched& S, int ui, int tid, int K, unsigned (&o0)[2], unsigned (&o1)[2]) {
    const PG8_LAS int* tab = S.rowtab(ui);
#pragma unroll
    for (int i = 0; i < 2; ++i) { int R, C; stage_rc(tid * 16 + i * 8192, R, C); o0[i] = (unsigned)(tab[R] * K + C) * 2u; o1[i] = (unsigned)(tab[HALF + R] * K + C) * 2u; }
}

template <class Epi, class Sched, bool ALIGN_EPI, bool GATHER>
__device__ __forceinline__ void gemm_phase(PG8_LAS unsigned char* lds, const Gemm g, const Sched& S, const Epi& E) {
    int tid_ = threadIdx.x; asm volatile("" : "+v"(tid_));
    const int tid = tid_, wid = __builtin_amdgcn_readfirstlane(tid >> 6), lane = tid & 63, wr = wid >> 2, wc = wid & 3, fr = lane & 15, fq = lane >> 4;
    const int K = g.K, nt = K / BK;
    unsigned vA0[2], vA1[2], wA0[2], wA1[2], voffB[2];
    const size_t kstep = (size_t)(BK * 2);
    const size_t hstep = (size_t)HALF * K * 2;
    const size_t tstep = 2 * hstep;
#pragma unroll
    for (int i = 0; i < 2; ++i) { int R, C; stage_rc(tid * 16 + i * 8192, R, C); const int Rb = Epi::PERM ? ((R & ~31) + perm32(R & 31)) : R;
        vA0[i] = (unsigned)(R * K + C) * 2u; vA1[i] = vA0[i] + (unsigned)hstep; voffB[i] = (unsigned)(Rb * K + C) * 2u; wA0[i] = vA0[i]; wA1[i] = vA1[i]; }
    const unsigned ldsw = (unsigned)wid * 1024u;
    const int aoff = lds_byte(wr * 64 + fr, fq * 8), boff = lds_byte(wc * 32 + fr, fq * 8);
#define PG8_SA(b, h) (((b) * 2 + (h)) * HTB)
#define PG8_SB(b, h) ((4 + (b) * 2 + (h)) * HTB)
#define PG8_STAGE(bufoff, gbase, voff) do { _Pragma("unroll") for (int _i = 0; _i < 2; ++_i) \
        __builtin_amdgcn_global_load_lds((const unsigned*)((const char*)(gbase) + (voff)[_i]), (PG8_LAS unsigned*)(lds + (bufoff) + ldsw + _i * 8192), 16, 0, 0); } while (0)
#define PG8_LDA(dst, b, h) do { _Pragma("unroll") for (int m = 0; m < 4; ++m) _Pragma("unroll") for (int k = 0; k < 2; ++k) dst[m][k] = *(const PG8_LAS bf16x8*)(lds + PG8_SA(b, h) + aoff + m * 2048 + k * 1024); } while (0)
#define PG8_LDB(dst, b, h) do { _Pragma("unroll") for (int n = 0; n < 2; ++n) _Pragma("unroll") for (int k = 0; k < 2; ++k) dst[n][k] = *(const PG8_LAS bf16x8*)(lds + PG8_SB(b, h) + boff + n * 2048 + k * 1024); } while (0)
#define PG8_MMA(ai, bj, At, Bt) do { __builtin_amdgcn_s_setprio(1); _Pragma("unroll") for (int m = 0; m < 4; ++m) _Pragma("unroll") for (int n = 0; n < 2; ++n) _Pragma("unroll") for (int k = 0; k < 2; ++k) \
        acc[ai][bj][m][n] = __builtin_amdgcn_mfma_f32_16x16x32_bf16(Bt[n][k], At[m][k], acc[ai][bj][m][n], 0, 0, 0); __builtin_amdgcn_s_setprio(0); } while (0)
#define PG8_WAIT_V(n) asm volatile("s_waitcnt vmcnt(" #n ")" ::: "memory")
#define PG8_WAIT_L(n) asm volatile("s_waitcnt lgkmcnt(" #n ")" ::: "memory")
#define PG8_BAR __builtin_amdgcn_s_barrier()
#define PG8_SCHED __builtin_amdgcn_sched_barrier(0)
    Unit cur, nxt; int ui = 0;
    if (!S.next(0, cur)) return;
    f32x4 acc[2][2][4][2];
#pragma unroll
    for (int a = 0; a < 2; ++a)
#pragma unroll
        for (int b = 0; b < 2; ++b)
#pragma unroll
            for (int m = 0; m < 4; ++m)
#pragma unroll
                for (int n = 0; n < 2; ++n) acc[a][b][m][n] = (f32x4){0.f, 0.f, 0.f, 0.f};
    bf16x8 At[4][2], B0[2][2], B1[2][2];
    const char* cA = GATHER ? (const char*)g.A : (const char*)g.A + (size_t)cur.pm * tstep; const char* cB = (const char*)g.Bt + (size_t)cur.pn * tstep;
    if constexpr (GATHER) gather_voffs(S, 0, tid, K, vA0, vA1);
    PG8_STAGE(PG8_SB(0, 0), cB, voffB); PG8_STAGE(PG8_SB(0, 1), cB + hstep, voffB); PG8_STAGE(PG8_SA(0, 0), cA, vA0); PG8_STAGE(PG8_SA(0, 1), cA, vA1);
    if (wr == 1) PG8_BAR;
    PG8_WAIT_V(2); PG8_BAR;
    PG8_STAGE(PG8_SB(1, 0), cB + kstep, voffB); PG8_STAGE(PG8_SA(1, 0), cA + kstep, vA0); PG8_STAGE(PG8_SB(1, 1), cB + hstep + kstep, voffB);
    PG8_WAIT_V(6); PG8_BAR;
    for (;;) {
        const bool has_next = S.next(ui + 1, nxt);
        const char* nA = GATHER ? cA : (has_next ? (const char*)g.A + (size_t)nxt.pm * tstep : cA); const char* nB = has_next ? (const char*)g.Bt + (size_t)nxt.pn * tstep : cB;
        if constexpr (GATHER) { if (has_next) gather_voffs(S, ui + 1, tid, K, wA0, wA1); else { wA0[0] = vA0[0]; wA0[1] = vA0[1]; wA1[0] = vA1[0]; wA1[1] = vA1[1]; } }
        for (int t = 0; t < nt; t += 2) {
            const bool last = (t == nt - 2);
            const char* a1 = cA + (size_t)(t + 1) * kstep;
            const char* a2 = last ? nA : cA + (size_t)(t + 2) * kstep; const char* b2 = last ? nB : cB + (size_t)(t + 2) * kstep;
            const char* a3 = a2 + kstep; const char* b3 = b2 + kstep;
            unsigned sA0[2], sA1[2];
#pragma unroll
            for (int i = 0; i < 2; ++i) { sA0[i] = (GATHER && last) ? wA0[i] : vA0[i]; sA1[i] = (GATHER && last) ? wA1[i] : vA1[i]; }
            if constexpr (Epi::MIDK) { if (t == nt / 2) E.midk(acc, wr, fr); }
            PG8_LDB(B0, 0, 0); PG8_LDB(B1, 0, 1); PG8_SCHED; PG8_LDA(At, 0, 0); PG8_STAGE(PG8_SA(1, 1), a1, vA1);
            PG8_WAIT_V(8); PG8_WAIT_L(0); PG8_BAR; PG8_MMA(0, 0, At, B0); PG8_MMA(0, 1, At, B1); PG8_BAR; PG8_SCHED;
            PG8_LDA(At, 0, 1); PG8_STAGE(PG8_SB(0, 0), b2, voffB); PG8_STAGE(PG8_SB(0, 1), b2 + hstep, voffB); PG8_STAGE(PG8_SA(0, 0), a2, sA0);
            PG8_WAIT_V(8); PG8_WAIT_L(0); PG8_BAR; PG8_MMA(1, 0, At, B0); PG8_MMA(1, 1, At, B1); PG8_BAR; PG8_SCHED;
            PG8_LDB(B0, 1, 0); PG8_LDB(B1, 1, 1); PG8_SCHED; PG8_LDA(At, 1, 0); PG8_STAGE(PG8_SA(0, 1), a2, sA1);
            PG8_WAIT_V(8); PG8_WAIT_L(0); PG8_BAR; PG8_MMA(0, 0, At, B0); PG8_MMA(0, 1, At, B1); PG8_BAR; PG8_SCHED;
            PG8_LDA(At, 1, 1); PG8_STAGE(PG8_SB(1, 0), b3, voffB); PG8_STAGE(PG8_SB(1, 1), b3 + hstep, voffB); PG8_STAGE(PG8_SA(1, 0), a3, sA0);
            PG8_WAIT_V(8); PG8_WAIT_L(0); PG8_BAR; PG8_MMA(1, 0, At, B0); PG8_MMA(1, 1, At, B1); PG8_BAR; PG8_SCHED;
        }
        if constexpr (ALIGN_EPI) { if (wr == 0) PG8_BAR; }
        E(acc, cur, ui, wr, wc, fr, fq);
        if (!has_next) break;
#pragma unroll
        for (int a = 0; a < 2; ++a)
#pragma unroll
            for (int b = 0; b < 2; ++b)
#pragma unroll
                for (int m = 0; m < 4; ++m)
#pragma unroll
                    for (int n = 0; n < 2; ++n) acc[a][b][m][n] = (f32x4){0.f, 0.f, 0.f, 0.f};
        cur = nxt; cA = nA; cB = nB; ++ui;
        if constexpr (GATHER) { vA0[0] = wA0[0]; vA0[1] = wA0[1]; vA1[0] = wA1[0]; vA1[1] = wA1[1]; }
        if constexpr (ALIGN_EPI) { if (wr == 1) PG8_BAR; }
    }
    PG8_WAIT_V(0);
    if constexpr (!ALIGN_EPI) { if (wr == 0) PG8_BAR; }
    PG8_BAR;
#undef PG8_SA
#undef PG8_SB
#undef PG8_STAGE
#undef PG8_LDA
#undef PG8_LDB
#undef PG8_MMA
#undef PG8_WAIT_V
#undef PG8_WAIT_L
#undef PG8_BAR
#undef PG8_SCHED
}

struct EpiProj {
    static constexpr bool PERM = true, MIDK = false;
    bf16_t* O;
    __device__ __forceinline__ void operator()(const f32x4 (&acc)[2][2][4][2], const Unit& u, int, int wr, int wc, int fr, int fq) const {
        const int row0 = u.pm * BM + wr * 64 + fr, col0 = u.pn * BM + wc * 32 + 8 * fq;
        const float sc = (u.pn < 2 || (u.pn >= 6 && u.pn < 8)) ? C2 : 1.f;
#pragma unroll
        for (int ai = 0; ai < 2; ++ai)
#pragma unroll
            for (int m = 0; m < 4; ++m) { bf16_t* rowp = O + (size_t)(row0 + ai * HALF + m * 16) * NPROJ + col0;
#pragma unroll
                for (int bj = 0; bj < 2; ++bj) { const f32x4 v0 = acc[ai][bj][m][0] * sc, v1 = acc[ai][bj][m][1] * sc;
                    u32x4 w; w.x = cvt_pk_bf16(v0[0], v0[1]); w.y = cvt_pk_bf16(v0[2], v0[3]); w.z = cvt_pk_bf16(v1[0], v1[1]); w.w = cvt_pk_bf16(v1[2], v1[3]);
                    *(u32x4*)(rowp + bj * HALF) = w; } }
    }
};
struct EpiWout {
    static constexpr bool PERM = false, MIDK = true;
    const float* x; float* X1; bf16_t* X1B; const PG8_LAS float* ratio; const PG8_LAS float* rs;
    __device__ __forceinline__ void midk(f32x4 (&acc)[2][2][4][2], int wr, int fr) const {
#pragma unroll
        for (int ai = 0; ai < 2; ++ai)
#pragma unroll
            for (int m = 0; m < 4; ++m) { const float f = ratio[ai * HALF + wr * 64 + m * 16 + fr];
#pragma unroll
                for (int bj = 0; bj < 2; ++bj)
#pragma unroll
                    for (int n = 0; n < 2; ++n) acc[ai][bj][m][n] *= f; }
    }
    __device__ __forceinline__ void operator()(const f32x4 (&acc)[2][2][4][2], const Unit& u, int, int wr, int wc, int fr, int fq) const {
        const int col0 = u.pn * BM + wc * 32 + 4 * fq;
#pragma unroll
        for (int ai = 0; ai < 2; ++ai)
#pragma unroll
            for (int m = 0; m < 4; ++m) { const int r = ai * HALF + wr * 64 + m * 16 + fr; const float s = rs[r]; const size_t off = (size_t)(u.pm * BM + r) * DM + col0;
#pragma unroll
                for (int bj = 0; bj < 2; ++bj)
#pragma unroll
                    for (int n = 0; n < 2; ++n) { const f32x4 xv = *(const f32x4*)(x + off + bj * HALF + n * 16); const f32x4 o = xv + acc[ai][bj][m][n] * s;
                        *(f32x4*)(X1 + off + bj * HALF + n * 16) = o; u32x2 w; w.x = cvt_pk_bf16(o[0], o[1]); w.y = cvt_pk_bf16(o[2], o[3]); *(u32x2*)(X1B + off + bj * HALF + n * 16) = w; }
                asm volatile("" ::: "memory"); }
    }
};
constexpr int MOE_MAXU = 9;
struct MoeOrder {
    int NT, c, U; const PG8_LAS int* tb; const PG8_LAS int* tabA;
    __device__ bool next(int i, Unit& u) const {
        if (i >= MOE_MAXU) return false;
        const int x = c & 7, j = c >> 3, q = U >> 3, rem = U & 7, start = x * q + (x < rem ? x : rem), size = q + (x < rem ? 1 : 0), li = i * 32 + j;
        if (li >= size) return false;
        const int f = start + li; int e = 0; while (f >= tb[e + 1] * NT) ++e;
        const int idx = f - tb[e] * NT, nte = tb[e + 1] - tb[e], pg = idx / (4 * nte), rem2 = idx - pg * 4 * nte;
        u.pm = tb[e] + (rem2 >> 2); u.pn = e * NT + pg * 4 + (rem2 & 3); return true;
    }
    __device__ __forceinline__ const PG8_LAS int* rowtab(int ui) const { return tabA + ui * 256; }
};
struct EpiMoe1 {
    static constexpr bool PERM = true, MIDK = false;
    bf16_t* H; const float* b1; const PG8_LAS float* rstab;
    __device__ __forceinline__ void operator()(const f32x4 (&acc)[2][2][4][2], const Unit& u, int ui, int wr, int wc, int fr, int fq) const {
        const int e = u.pn >> 3, pl = u.pn & 7, colA = pl * 128 + wc * 32 + 8 * fq;
        f32x4 bg[2], bl[2];
#pragma unroll
        for (int n = 0; n < 2; ++n) { bg[n] = *(const f32x4*)(b1 + (size_t)e * 2048 + colA + 4 * n); bl[n] = *(const f32x4*)(b1 + (size_t)e * 2048 + 1024 + colA + 4 * n); }
#pragma unroll
        for (int ai = 0; ai < 2; ++ai)
#pragma unroll
            for (int m = 0; m < 4; ++m) { const int r = ai * HALF + wr * 64 + m * 16 + fr; const float rs = rstab[ui * 256 + r];
                float a8[8];
#pragma unroll
                for (int n = 0; n < 2; ++n) { const f32x4 gv = acc[ai][0][m][n] * rs + bg[n], lv = acc[ai][1][m][n] * rs + bl[n];
#pragma unroll
                    for (int i = 0; i < 4; ++i) { const float gl = fminf(gv[i], 7.f), li = fminf(fmaxf(lv[i], -7.f), 7.f);
                        a8[4 * n + i] = gl * __builtin_amdgcn_rcpf(1.f + __builtin_amdgcn_exp2f(-1.702f * LOG2E * gl)) * (li + 1.f); } }
                u32x4 w; w.x = cvt_pk_bf16(a8[0], a8[1]); w.y = cvt_pk_bf16(a8[2], a8[3]); w.z = cvt_pk_bf16(a8[4], a8[5]); w.w = cvt_pk_bf16(a8[6], a8[7]);
                *(u32x4*)(H + (size_t)(u.pm * BM + r) * DM + colA) = w; }
    }
};
struct EpiMoe2 {
    static constexpr bool PERM = true, MIDK = false;
    bf16_t* Y; const float* b2; const PG8_LAS int* slottab; const PG8_LAS float* wtab;
    __device__ __forceinline__ void operator()(const f32x4 (&acc)[2][2][4][2], const Unit& u, int ui, int wr, int wc, int fr, int fq) const {
        const int e = u.pn >> 2, pl = u.pn & 3, col0 = pl * BM + wc * 32 + 8 * fq;
        f32x4 bv[2][2];
#pragma unroll
        for (int bj = 0; bj < 2; ++bj)
#pragma unroll
            for (int n = 0; n < 2; ++n) bv[bj][n] = *(const f32x4*)(b2 + (size_t)e * DM + col0 + bj * HALF + 4 * n);
#pragma unroll
        for (int ai = 0; ai < 2; ++ai)
#pragma unroll
            for (int m = 0; m < 4; ++m) { const int r = ai * HALF + wr * 64 + m * 16 + fr; const int slot = slottab[ui * 256 + r]; const float wt = wtab[ui * 256 + r];
                if (slot >= 0) {
#pragma unroll
                    for (int bj = 0; bj < 2; ++bj) { const f32x4 v0 = (acc[ai][bj][m][0] + bv[bj][0]) * wt, v1 = (acc[ai][bj][m][1] + bv[bj][1]) * wt;
                        u32x4 w; w.x = cvt_pk_bf16(v0[0], v0[1]); w.y = cvt_pk_bf16(v0[2], v0[3]); w.z = cvt_pk_bf16(v1[0], v1[1]); w.w = cvt_pk_bf16(v1[2], v1[3]);
                        *(u32x4*)(Y + (size_t)slot * DM + col0 + bj * HALF) = w; } } }
    }
};
}

#include <hip/hip_bf16.h>
#include <cmath>
namespace attn_body {

using bf16=__hip_bfloat16;
using bf16x8=__attribute__((ext_vector_type(8)))short;
using s16x4=__attribute__((ext_vector_type(4)))short;
using f32x16=__attribute__((ext_vector_type(16)))float;
using u32x4=__attribute__((ext_vector_type(4)))unsigned;
constexpr int SEQ=4096,D=64,PIN=3072,POUT=1024;
constexpr int NW=8,QBLK=32,QB=QBLK*NW,KVBLK=64,NQB=SEQ/QB;
__device__ __forceinline__ int crow(int r,int hi){return (r&3)+8*(r>>2)+4*hi;}
#define SBAR() __builtin_amdgcn_sched_barrier(0)
__device__ __forceinline__ void cmask(f32x16&p0,f32x16&p1,int jb,int qrel,int hi){
  const float NEG=-INFINITY; int kb=64*jb+4*hi;
  #pragma unroll
  for(int r=0;r<16;++r){int kv=kb+(r&3)+8*(r>>2); if(kv>qrel)p0[r]=NEG; if(kv+32>qrel)p1[r]=NEG;}
}

constexpr int NSLOT=3, SLOTB=8192;
constexpr int LDS_K=0, LDS_V=NSLOT*SLOTB, LDS_WS=2*NSLOT*SLOTB, LDS_OST=LDS_WS+NW*64*4, LDS_CK=LDS_OST+NW*4096, LDS_BYTES=LDS_CK+SEQ*4;
constexpr float C2=0.125f*1.4426950408889634f;
__device__ __forceinline__ void glds16(const void*gsrc,unsigned lds_dst){unsigned keep;
  asm volatile("s_mov_b32 %0, m0\n\ts_mov_b32 m0, %2\n\ts_nop 0\n\tglobal_load_lds_dwordx4 %1, off\n\ts_mov_b32 m0, %0":"=&s"(keep):"v"(gsrc),"s"(lds_dst):"memory");}
__device__ __forceinline__ float max3f(float a,float b,float c){float r;asm("v_max3_f32 %0, %1, %2, %3":"=v"(r):"v"(a),"v"(b),"v"(c));return r;}
__device__ __forceinline__ float max2f(float a,float b){float r;asm("v_max_f32_e32 %0, %1, %2":"=v"(r):"v"(a),"v"(b));return r;}
__device__ __forceinline__ float fadd_s(float a,float b){float r;asm("v_add_f32_e32 %0, %1, %2":"=v"(r):"v"(a),"v"(b));return r;}
__device__ __forceinline__ float fsub_s(float a,float b){float r;asm("v_sub_f32_e32 %0, %1, %2":"=v"(r):"v"(a),"v"(b));return r;}
typedef float f32x2_t __attribute__((ext_vector_type(2))); typedef float f32x4_t __attribute__((ext_vector_type(4))); typedef __bf16 bf16x2_t __attribute__((ext_vector_type(2)));
__device__ __forceinline__ unsigned cvtpk_s(float lo,float hi){f32x2_t v={lo,hi};bf16x2_t b=__builtin_convertvector(v,bf16x2_t);return __builtin_bit_cast(unsigned,b);}
#define WAIT_BAR(N) asm volatile("s_waitcnt vmcnt(" #N ") lgkmcnt(0)\n\ts_barrier":::"memory")

__device__ __forceinline__ void qkt(f32x16&p0,f32x16&p1,const char*Kslot,const bf16x8*qr,const f32x16&negm,int r32,int hi){
  const char*kb=Kslot+hi*1024+r32*16;
  #pragma unroll
  for(int d0=0;d0<4;++d0){
    const bf16x8 b0=*reinterpret_cast<const bf16x8*>(kb+d0*2048);
    const bf16x8 b1=*reinterpret_cast<const bf16x8*>(kb+d0*2048+512);
    if(d0==0){p0=__builtin_amdgcn_mfma_f32_32x32x16_bf16(b0,qr[0],negm,0,0,0);p1=__builtin_amdgcn_mfma_f32_32x32x16_bf16(b1,qr[0],negm,0,0,0);}
    else{p0=__builtin_amdgcn_mfma_f32_32x32x16_bf16(b0,qr[d0],p0,0,0,0);p1=__builtin_amdgcn_mfma_f32_32x32x16_bf16(b1,qr[d0],p1,0,0,0);}}
}
typedef __attribute__((address_space(3))) const char* lds_cptr;
typedef short v4i16_t __attribute__((ext_vector_type(4)));
__device__ __forceinline__ void kload8(bf16x8*kf,lds_cptr kp){
  kf[0]=*(const __attribute__((address_space(3))) bf16x8*)(kp);      kf[1]=*(const __attribute__((address_space(3))) bf16x8*)(kp+512);
  kf[2]=*(const __attribute__((address_space(3))) bf16x8*)(kp+2048); kf[3]=*(const __attribute__((address_space(3))) bf16x8*)(kp+2560);
  kf[4]=*(const __attribute__((address_space(3))) bf16x8*)(kp+4096); kf[5]=*(const __attribute__((address_space(3))) bf16x8*)(kp+4608);
  kf[6]=*(const __attribute__((address_space(3))) bf16x8*)(kp+6144); kf[7]=*(const __attribute__((address_space(3))) bf16x8*)(kp+6656);
}
__device__ __forceinline__ void kload2(bf16x8*kf,lds_cptr kp,int j){ kf[2*j]=*(const __attribute__((address_space(3))) bf16x8*)(kp+j*2048); kf[2*j+1]=*(const __attribute__((address_space(3))) bf16x8*)(kp+j*2048+512); }
__device__ __forceinline__ s16x4 vtr(lds_cptr p){ return __builtin_bit_cast(s16x4,__builtin_amdgcn_ds_read_tr16_b64_v4i16((__attribute__((address_space(3))) v4i16_t*)p)); }
__device__ __forceinline__ float rowmax(const f32x16&p0,const f32x16&p1){
  float a=max3f(p0[0],p0[1],p1[0]),b=max3f(p0[2],p0[3],p1[1]);a=max3f(a,p1[2],p1[3]);
  #pragma unroll
  for(int r=4;r<16;r+=4){a=max3f(a,p0[r],p0[r+1]);b=max3f(b,p0[r+2],p0[r+3]);a=max3f(a,p1[r],p1[r+1]);b=max3f(b,p1[r+2],p1[r+3]);}
  const float m=max2f(a,b);
  auto rr=__builtin_amdgcn_permlane32_swap(__float_as_uint(m),__float_as_uint(m),false,false);
  return max2f(__uint_as_float(rr[0]),__uint_as_float(rr[1]));
}
__device__ __forceinline__ void pv(f32x16*o,int vb,bf16x8 pa0,bf16x8 pa1,bf16x8 pa2,bf16x8 pa3){
  #pragma unroll
  for(int d0=0;d0<2;++d0){s16x4 lo[4],hi[4];
    #pragma unroll
    for(int ks=0;ks<4;++ks){
      asm volatile("ds_read_b64_tr_b16 %0,%1 offset:%c2":"=&v"(lo[ks]):"v"(vb),"i"(d0*4096+ks*1024):"memory");
      asm volatile("ds_read_b64_tr_b16 %0,%1 offset:%c2":"=&v"(hi[ks]):"v"(vb),"i"(d0*4096+ks*1024+512):"memory");}
    asm volatile("s_waitcnt lgkmcnt(0)":::"memory");SBAR();
    #define PK(k) (bf16x8){lo[k][0],lo[k][1],lo[k][2],lo[k][3],hi[k][0],hi[k][1],hi[k][2],hi[k][3]}
    o[d0]=__builtin_amdgcn_mfma_f32_32x32x16_bf16(pa0,PK(0),o[d0],0,0,0);
    o[d0]=__builtin_amdgcn_mfma_f32_32x32x16_bf16(pa1,PK(1),o[d0],0,0,0);
    o[d0]=__builtin_amdgcn_mfma_f32_32x32x16_bf16(pa2,PK(2),o[d0],0,0,0);
    o[d0]=__builtin_amdgcn_mfma_f32_32x32x16_bf16(pa3,PK(3),o[d0],0,0,0);
    #undef PK
  }
}

#ifndef ATTN_STORE16
#define ATTN_STORE16(p,v) (*(u32x4*)(p)=(v))
#endif
template<int THRL> __device__ __forceinline__ void attn_unit(int b,int h,int qb,const bf16*Q,const bf16*__restrict__ K,const bf16*__restrict__ V,bf16*O,const float*__restrict__ CUMbh,float*__restrict__ SSQh,char*shm){
  int tid_=threadIdx.x; asm volatile("":"+v"(tid_));
  const int tid=tid_,lane=tid&63,r32=lane&31,hi=lane>>5; const int wid=__builtin_amdgcn_readfirstlane(tid>>6);
  const long rowbase=(long)b*SEQ; const int q0=qb*QB;
  const bf16*Qw=Q+(rowbase+q0+wid*QBLK)*PIN+h*D;
  const bf16*Kh=K+rowbase*PIN+h*D,*Vh=V+rowbase*PIN+h*D;
  const unsigned lds0=(unsigned)(uintptr_t)shm;
  const lds_cptr shm3=(lds_cptr)shm;
  float*wsf=(float*)(shm+LDS_WS)+wid*64;
  const bf16*ksrc=Kh+(long)lane*PIN+wid*8;
  const bf16*vsrc=Vh+(long)(16*(wid&3)+(lane>>2))*PIN+(wid>>2)*32+(lane&3)*8;
  const unsigned kdst=lds0+LDS_K+wid*1024, vdst=lds0+LDS_V+wid*1024;
  #define DMA_K(t,slot) glds16(ksrc+(long)(t)*KVBLK*PIN,(unsigned)__builtin_amdgcn_readfirstlane(kdst+(slot)))
  #define DMA_V(t,slot) glds16(vsrc+(long)(t)*KVBLK*PIN,(unsigned)__builtin_amdgcn_readfirstlane(vdst+(slot)))
  const int vb0=(int)(lds0+LDS_V)+((lane>>4)&1)*32+(lane&3)*8+(4*hi+((lane&15)>>2))*64;
  const char*Kbase=shm+LDS_K; bf16x8 kf[8];
  const lds_cptr kp0=shm3+LDS_K+hi*1024+r32*16; const lds_cptr vp0=shm3+LDS_V+((lane>>4)&1)*32+(lane&3)*8+(4*hi+((lane&15)>>2))*64;
  const int NT=(q0+QB)/KVBLK;
  DMA_K(0,0);DMA_V(0,0);DMA_K(1,SLOTB);
  bf16x8 qr[4];
  #pragma unroll
  for(int d0=0;d0<4;++d0)qr[d0]=*reinterpret_cast<const bf16x8*>(&Qw[(long)r32*PIN+d0*16+hi*8]);
  const float cbase=CUMbh[q0]; const float cq=CUMbh[q0+wid*QBLK+r32]-cbase;
  { __attribute__((address_space(3))) float*ckw=(__attribute__((address_space(3))) float*)(shm3+LDS_CK); int s0_=tid; asm volatile("":"+v"(s0_));
    _Pragma("nounroll") for(int s=s0_;s<q0+QB;s+=NW*64)ckw[s]=CUMbh[s]-cbase; }
  const __attribute__((address_space(3))) float*ckp=(const __attribute__((address_space(3))) float*)(shm3+LDS_CK)+4*hi;
  float mhat=-cq,l_reg=0.f;f32x16 o[2];o[0]=f32x16{};o[1]=f32x16{};f32x16 negm;
  #pragma unroll
  for(int r=0;r<16;++r)negm[r]=cq;
  asm volatile("":"+v"(negm));
  const int qrel=wid*QBLK+r32;
  #define BIAS(P0,P1,t) do{ const __attribute__((address_space(3))) float*cp_=ckp+(t)*KVBLK; \
    _Pragma("unroll") for(int g_=0;g_<4;++g_){ const f32x4_t c0_=*(const __attribute__((address_space(3))) f32x4_t*)(cp_+8*g_), c1_=*(const __attribute__((address_space(3))) f32x4_t*)(cp_+32+8*g_); \
      _Pragma("unroll") for(int j_=0;j_<4;++j_){ P0[4*g_+j_]-=c0_[j_]; P1[4*g_+j_]-=c1_[j_]; } SBAR(); } }while(0)
  #define CMASK(P0,P1,t) do{int jb_=(t)-(NT-4); if(jb_>=0)cmask(P0,P1,jb_,qrel,hi);}while(0)
  bool resc=false;
  #define START(P0,P1) do{ const float rm=rowmax(P0,P1); resc=false; \
    { const float dl=rm; mhat=fadd_s(mhat,dl); \
      _Pragma("unroll") for(int r=0;r<16;++r){P0[r]=fsub_s(P0[r],dl);P1[r]=fsub_s(P1[r],dl);} \
      _Pragma("unroll") for(int r=0;r<16;++r)negm[r]=-mhat; asm volatile("":"+v"(negm)); } \
    _Pragma("unroll") for(int r=0;r<16;++r)P0[r]=__builtin_amdgcn_exp2f(P0[r]); }while(0)
  #define RESC() do{ if(resc){ asm volatile("s_waitcnt lgkmcnt(0)":::"memory"); \
      _Pragma("unroll") for(int d_=0;d_<2;++d_) _Pragma("unroll") for(int r=0;r<16;++r)o[d_][r]*=wsf[crow(r,hi)]; } }while(0)
  f32x16 pA0,pA1,pB0,pB1;
  int sl_prev=0,sl_cur=0,sl_next=SLOTB;
  #define ROT() do{sl_prev=sl_cur;sl_cur=sl_next;sl_next=(sl_next==(NSLOT-1)*SLOTB)?0:sl_next+SLOTB;}while(0)
  DMA_K(2,2*SLOTB);
  WAIT_BAR(3);
  qkt(pA0,pA1,Kbase,qr,negm,r32,hi);asm volatile("s_nop 15\n\ts_nop 7":"+v"(pA0),"+v"(pA1));BIAS(pA0,pA1,0);CMASK(pA0,pA1,0);
  START(pA0,pA1);
  _Pragma("unroll") for(int r=0;r<16;++r)pA1[r]=__builtin_amdgcn_exp2f(pA1[r]);
  WAIT_BAR(0);
  DMA_K(3,0);DMA_V(1,SLOTB);
  ROT();
  kload8(kf,kp0+sl_cur);
  WAIT_BAR(2);
  s16x4 vlo[8],vhi[8]; u32x4 pw0,pw1,pw2,pw3;
  #define PKW(P,B) cvtpk_s(P[B],P[B+1])
  #define PAF(k) __builtin_bit_cast(bf16x8,pw##k)
  #define VFR(i) (bf16x8){vlo[i][0],vlo[i][1],vlo[i][2],vlo[i][3],vhi[i][0],vhi[i][1],vhi[i][2],vhi[i][3]}
  #define PIN(x) asm volatile("":"+v"(x))
  #define MX3(a,b,c) __builtin_fmaxf(__builtin_fmaxf((a),(b)),(c))
  #define GAPA(MF,A0,A1,A2,A3,W0,W1,PW) do{ MF; sacc+=A0; sacc+=A1; sacc+=A2; sacc+=A3; PIN(sacc); W0; W1; PIN(PW); SBAR(); }while(0)
  #define EX(v) __builtin_amdgcn_exp2f(v)
  #define GAPB(MF,X,B) do{ MF; X[B]=EX(X[B]); X[B+1]=EX(X[B+1]); X[B+2]=EX(X[B+2]); X[B+3]=EX(X[B+3]); PIN(X); SBAR(); }while(0)
  #define VRD(i) do{ vlo[i]=vtr(vp_+(((i)>>2)*4096+((i)&3)*1024)); vhi[i]=vtr(vp_+(((i)>>2)*4096+((i)&3)*1024+512)); }while(0)
  #define KRD(G,j) do{ if(G){ kload2(kf,kp0+sl_next,j); SBAR(); } }while(0)
  #define STEP(C0,C1,P0,P1,t,GK,GV,GL) do{ SBAR(); \
    const lds_cptr vp_=vp0+sl_prev; \
    VRD(0); SBAR(); float sacc=(P0[0]+P0[1]); \
    GAPA(C0=__builtin_amdgcn_mfma_f32_32x32x16_bf16(kf[0],qr[0],negm,0,0,0), P0[2],P0[3],P0[4],P0[5],     pw0[0]=PKW(P0,0), pw0[1]=PKW(P0,2), pw0); \
    VRD(4); SBAR(); GAPA(C1=__builtin_amdgcn_mfma_f32_32x32x16_bf16(kf[1],qr[0],negm,0,0,0), P0[6],P0[7],P0[8],P0[9],     pw0[2]=PKW(P0,4), pw0[3]=PKW(P0,6), pw0); \
    VRD(1); SBAR(); GAPA(C0=__builtin_amdgcn_mfma_f32_32x32x16_bf16(kf[2],qr[1],C0,0,0,0),   P0[10],P0[11],P0[12],P0[13], pw1[0]=PKW(P0,8), pw1[1]=PKW(P0,10), pw1); \
    VRD(5); SBAR(); GAPA(C1=__builtin_amdgcn_mfma_f32_32x32x16_bf16(kf[3],qr[1],C1,0,0,0),   P0[14],P0[15],P1[0],P1[1],   pw1[2]=PKW(P0,12),pw1[3]=PKW(P0,14), pw1); \
    VRD(2); SBAR(); GAPA(C0=__builtin_amdgcn_mfma_f32_32x32x16_bf16(kf[4],qr[2],C0,0,0,0),   P1[2],P1[3],P1[4],P1[5],     pw2[0]=PKW(P1,0), pw2[1]=PKW(P1,2), pw2); \
    VRD(6); SBAR(); GAPA(C1=__builtin_amdgcn_mfma_f32_32x32x16_bf16(kf[5],qr[2],C1,0,0,0),   P1[6],P1[7],P1[8],P1[9],     pw2[2]=PKW(P1,4), pw2[3]=PKW(P1,6), pw2); \
    VRD(3); SBAR(); GAPA(C0=__builtin_amdgcn_mfma_f32_32x32x16_bf16(kf[6],qr[3],C0,0,0,0),   P1[10],P1[11],P1[12],P1[13], pw3[0]=PKW(P1,8), pw3[1]=PKW(P1,10), pw3); \
    VRD(7); SBAR(); GAPA(C1=__builtin_amdgcn_mfma_f32_32x32x16_bf16(kf[7],qr[3],C1,0,0,0),   P1[14],P1[15],0.f,0.f,       pw3[2]=PKW(P1,12),pw3[3]=PKW(P1,14), pw3); \
    l_reg+=sacc; \
    if(GK){DMA_K((t)+3,sl_cur);} if(GV){DMA_V((t)+1,sl_next);} \
    BIAS(C0,C1,t); CMASK(C0,C1,t); \
    { float a=MX3(C0[0],C0[1],C1[0]),b=MX3(C0[2],C0[3],C1[1]); a=MX3(a,C1[2],C1[3]); \
      _Pragma("unroll") for(int r=4;r<16;r+=4){a=MX3(a,C0[r],C0[r+1]);b=MX3(b,C0[r+2],C0[r+3]);a=MX3(a,C1[r],C1[r+1]);b=MX3(b,C1[r+2],C1[r+3]);} \
      float rm=__builtin_fmaxf(a,b); { auto rr=__builtin_amdgcn_permlane32_swap(__float_as_uint(rm),__float_as_uint(rm),false,false); rm=__builtin_fmaxf(__uint_as_float(rr[0]),__uint_as_float(rr[1])); } \
      resc=false; \
      if(__builtin_expect(__any(rm>(float)THRL),0)){ const float dl=__builtin_fmaxf(rm,0.f); mhat+=dl; \
        _Pragma("unroll") for(int r=0;r<16;++r){C0[r]-=dl;C1[r]-=dl;} \
        _Pragma("unroll") for(int r=0;r<16;++r)negm[r]=-mhat; asm volatile("":"+v"(negm)); \
        const float f=__builtin_amdgcn_exp2f(-dl); l_reg*=f; if(hi==0)wsf[r32]=f; resc=true; } } \
    SBAR(); \
    GAPB(o[0]=__builtin_amdgcn_mfma_f32_32x32x16_bf16(PAF(0),VFR(0),o[0],0,0,0), C0,0); \
    GAPB(o[1]=__builtin_amdgcn_mfma_f32_32x32x16_bf16(PAF(0),VFR(4),o[1],0,0,0), C0,4); \
    KRD(GL,0); GAPB(o[0]=__builtin_amdgcn_mfma_f32_32x32x16_bf16(PAF(1),VFR(1),o[0],0,0,0), C0,8); \
    KRD(GL,1); GAPB(o[1]=__builtin_amdgcn_mfma_f32_32x32x16_bf16(PAF(1),VFR(5),o[1],0,0,0), C0,12); \
    KRD(GL,2); GAPB(o[0]=__builtin_amdgcn_mfma_f32_32x32x16_bf16(PAF(2),VFR(2),o[0],0,0,0), C1,0); \
    KRD(GL,3); GAPB(o[1]=__builtin_amdgcn_mfma_f32_32x32x16_bf16(PAF(2),VFR(6),o[1],0,0,0), C1,4); \
    GAPB(o[0]=__builtin_amdgcn_mfma_f32_32x32x16_bf16(PAF(3),VFR(3),o[0],0,0,0), C1,8); \
    GAPB(o[1]=__builtin_amdgcn_mfma_f32_32x32x16_bf16(PAF(3),VFR(7),o[1],0,0,0), C1,12); \
    }while(0)
  int t=1;
  #undef CMASK
  #define CMASK(P0,P1,t) do{}while(0)
  for(;t+5<NT;t+=2){
    STEP(pB0,pB1,pA0,pA1,t,true,true,true);     WAIT_BAR(2); RESC(); ROT();
    STEP(pA0,pA1,pB0,pB1,t+1,true,true,true);   WAIT_BAR(2); RESC(); ROT();
  }
  #undef CMASK
  #define CMASK(P0,P1,t) do{int jb_=(t)-(NT-4); if(jb_>=0)cmask(P0,P1,jb_,qrel,hi);}while(0)
  #define ENDW(tt) do{ if((tt)+3<NT){WAIT_BAR(2);} else if((tt)+2<NT){WAIT_BAR(1);} else {WAIT_BAR(0);} }while(0)
  for(;t+1<NT;t+=2){
    STEP(pB0,pB1,pA0,pA1,t,(t+3<NT),(t+1<NT),(t+1<NT));       ENDW(t);   RESC(); ROT();
    STEP(pA0,pA1,pB0,pB1,t+1,(t+4<NT),(t+2<NT),(t+2<NT));     ENDW(t+1); RESC(); ROT();
  }
  STEP(pB0,pB1,pA0,pA1,NT-1,false,false,false); RESC();
  { float sacc=pB0[0]+pB0[1]; _Pragma("unroll") for(int r=2;r<16;++r)sacc+=pB0[r]; _Pragma("unroll") for(int r=0;r<16;++r)sacc+=pB1[r]; l_reg+=sacc;
    pw0=(u32x4){PKW(pB0,0),PKW(pB0,2),PKW(pB0,4),PKW(pB0,6)};pw1=(u32x4){PKW(pB0,8),PKW(pB0,10),PKW(pB0,12),PKW(pB0,14)};pw2=(u32x4){PKW(pB1,0),PKW(pB1,2),PKW(pB1,4),PKW(pB1,6)};pw3=(u32x4){PKW(pB1,8),PKW(pB1,10),PKW(pB1,12),PKW(pB1,14)};
    SBAR(); pv(o,vb0+sl_cur,PAF(0),PAF(1),PAF(2),PAF(3)); }
  #undef PKW
  #undef PAF
  #undef VFR
  #undef PIN
  #undef MX3
  #undef GAPA
  #undef GAPB
  #undef EX
  #undef VRD
  #undef KRD
  #undef STEP
  #undef ENDW
  {auto rr=__builtin_amdgcn_permlane32_swap(__float_as_uint(l_reg),__float_as_uint(l_reg),false,false);l_reg=__uint_as_float(rr[0])+__uint_as_float(rr[1]);}
  if(hi==0)wsf[32+r32]=l_reg;asm volatile("s_waitcnt lgkmcnt(0)":::"memory");
  float rli[16];
  #pragma unroll
  for(int r=0;r<16;++r)rli[r]=__builtin_amdgcn_rcpf(wsf[32+crow(r,hi)]);
  bf16*Ow=O+(rowbase+q0+wid*QBLK)*POUT+h*D; float*Sw=SSQh+(rowbase+q0+wid*QBLK)*16;
  { bf16*stg=(bf16*)(shm+LDS_OST)+wid*2048;
    #pragma unroll
    for(int r=0;r<16;++r){const int orow=crow(r,hi);
      #pragma unroll
      for(int d0=0;d0<2;++d0)stg[orow*64+d0*32+r32]=__float2bfloat16(o[d0][r]*rli[r]);}
    asm volatile("s_waitcnt lgkmcnt(0)":::"memory");
    #pragma unroll
    for(int i=0;i<4;++i){const int row=i*8+(lane>>3),ch=lane&7; const u32x4 v=*(const u32x4*)(stg+row*64+ch*8); ATTN_STORE16(Ow+(long)row*POUT+ch*8,v);
      float sq=0.f;
      #pragma unroll
      for(int w_=0;w_<4;++w_){const float lo_=__uint_as_float(v[w_]<<16),hi_=__uint_as_float(v[w_]&0xffff0000u);sq+=lo_*lo_+hi_*hi_;}
      sq+=__shfl_xor(sq,1);sq+=__shfl_xor(sq,2);sq+=__shfl_xor(sq,4); if(ch==0)Sw[row*16]=sq;} }
  asm volatile("s_waitcnt lgkmcnt(0)\n\ts_barrier":::"memory");
  #undef DMA_K
  #undef DMA_V
  #undef CMASK
  #undef BIAS
  #undef START
  #undef RESC
  #undef ROT
}
constexpr int ATTN_LDS_BYTES=LDS_BYTES;

__device__ __forceinline__ void sb_unit(int b,int h,int qb,const bf16*Q,const bf16*__restrict__ K,const bf16*__restrict__ V,bf16*O,float*__restrict__ SSQh,char*shm){
  int tid_=threadIdx.x; asm volatile("":"+v"(tid_));
  const int tid=tid_,lane=tid&63,r32=lane&31,hi=lane>>5; const int wid=__builtin_amdgcn_readfirstlane(tid>>6);
  const long rowbase=(long)b*SEQ; const int q0=qb*QB;
  const bf16*Qw=Q+(rowbase+q0+wid*QBLK)*PIN+h*D;
  const bf16*Kh=K+rowbase*PIN+h*D,*Vh=V+rowbase*PIN+h*D;
  const unsigned lds0=(unsigned)(uintptr_t)shm;
  const bf16*ksrc=Kh+(long)lane*PIN+wid*8;
  const bf16*vsrc=Vh+(long)(16*(wid&3)+(lane>>2))*PIN+(wid>>2)*32+(lane&3)*8;
  const unsigned kdst=lds0+LDS_K+wid*1024, vdst=lds0+LDS_V+wid*1024;
  const int vb0=(int)(lds0+LDS_V)+((lane>>4)&1)*32+(lane&3)*8+(4*hi+((lane&15)>>2))*64;
  const char*Kbase=shm+LDS_K;
  const int NT=(q0+QB)/KVBLK;
  #define SB_DMA(i,slot) do{ const long kt_=(long)(NT-1-(i)); glds16(ksrc+kt_*KVBLK*PIN,(unsigned)__builtin_amdgcn_readfirstlane(kdst+(slot))); glds16(vsrc+kt_*KVBLK*PIN,(unsigned)__builtin_amdgcn_readfirstlane(vdst+(slot))); }while(0)
  bf16x8 qr[4];
  #pragma unroll
  for(int d0=0;d0<4;++d0)qr[d0]=*reinterpret_cast<const bf16x8*>(&Qw[(long)r32*PIN+d0*16+hi*8]);
  SB_DMA(0,0); SB_DMA(1,SLOTB);
  f32x16 o[2];o[0]=f32x16{};o[1]=f32x16{};
  float Rc=1.f;
  const int qrel=wid*QBLK+r32;
  int sl_cur=0,sl_n1=SLOTB,sl_n2=2*SLOTB;
  volatile __attribute__((address_space(3))) unsigned*flg=(volatile __attribute__((address_space(3))) unsigned*)((lds_cptr)shm+LDS_WS);
  for(int i=0;i<NT;++i){
    if(i+1<NT){WAIT_BAR(2);}else{WAIT_BAR(0);}
    if(i>0){ const int pb=((i-1)&1)*8; unsigned all_=flg[pb]&flg[pb+1]&flg[pb+2]&flg[pb+3]&flg[pb+4]&flg[pb+5]&flg[pb+6]&flg[pb+7]; if(__builtin_amdgcn_readfirstlane(all_))break; }
    if(i+2<NT)SB_DMA(i+2,sl_n2);
    f32x16 p0,p1; { f32x16 z=f32x16{}; asm volatile("":"+v"(z)); qkt(p0,p1,Kbase+sl_cur,qr,z,r32,hi); }
    f32x16 s0,s1;
    #pragma unroll
    for(int r=0;r<16;++r){
      const float za=__builtin_amdgcn_fmed3f(p0[r],-100.f,100.f), zb=__builtin_amdgcn_fmed3f(p1[r],-100.f,100.f);
      p0[r]=__builtin_amdgcn_exp2f(za); p1[r]=__builtin_amdgcn_exp2f(zb);
      s0[r]=__builtin_amdgcn_rcpf(1.f+p0[r]); s1[r]=__builtin_amdgcn_rcpf(1.f+p1[r]); }
    if(i<4){
      const int kb=64*(3-i)+4*hi;
      #pragma unroll
      for(int r=0;r<16;++r){ const int kv=kb+(r&3)+8*(r>>2); if(kv>=qrel){p0[r]=0.f;s0[r]=1.f;} if(kv+32>=qrel){p1[r]=0.f;s1[r]=1.f;} }
    }
    float gp[8],pp[8];
    #pragma unroll
    for(int g=0;g<4;++g){
      s0[4*g+2]*=s0[4*g+3]; s0[4*g+1]*=s0[4*g+2]; s0[4*g]*=s0[4*g+1]; gp[g]=s0[4*g];
      s1[4*g+2]*=s1[4*g+3]; s1[4*g+1]*=s1[4*g+2]; s1[4*g]*=s1[4*g+1]; gp[4+g]=s1[4*g]; }
    #pragma unroll
    for(int g=0;g<8;++g){ auto rr=__builtin_amdgcn_permlane32_swap(__float_as_uint(gp[g]),__float_as_uint(gp[g]),false,false); pp[g]=__uint_as_float(hi?rr[0]:rr[1]); }
    float st=Rc, outer[8];
    #pragma unroll
    for(int g=7;g>=0;--g){ outer[g]=hi?st:st*pp[g]; st=st*(gp[g]*pp[g]); }
    Rc=st;
    { const unsigned dn=__all(Rc==0.f)?1u:0u; if(lane==0)flg[(i&1)*8+wid]=dn; }
    #pragma unroll
    for(int r=0;r<16;++r){ p0[r]=p0[r]*(s0[r]*outer[r>>2]); p1[r]=p1[r]*(s1[r]*outer[4+(r>>2)]); }
    u32x4 pw0,pw1,pw2,pw3;
    pw0=(u32x4){cvtpk_s(p0[0],p0[1]),cvtpk_s(p0[2],p0[3]),cvtpk_s(p0[4],p0[5]),cvtpk_s(p0[6],p0[7])};
    pw1=(u32x4){cvtpk_s(p0[8],p0[9]),cvtpk_s(p0[10],p0[11]),cvtpk_s(p0[12],p0[13]),cvtpk_s(p0[14],p0[15])};
    pw2=(u32x4){cvtpk_s(p1[0],p1[1]),cvtpk_s(p1[2],p1[3]),cvtpk_s(p1[4],p1[5]),cvtpk_s(p1[6],p1[7])};
    pw3=(u32x4){cvtpk_s(p1[8],p1[9]),cvtpk_s(p1[10],p1[11]),cvtpk_s(p1[12],p1[13]),cvtpk_s(p1[14],p1[15])};
    SBAR(); pv(o,vb0+sl_cur,__builtin_bit_cast(bf16x8,pw0),__builtin_bit_cast(bf16x8,pw1),__builtin_bit_cast(bf16x8,pw2),__builtin_bit_cast(bf16x8,pw3));
    { const int t_=sl_cur; sl_cur=sl_n1; sl_n1=sl_n2; sl_n2=t_; }
  }
  #undef SB_DMA
  bf16*Ow=O+(rowbase+q0+wid*QBLK)*POUT+h*D; float*Sw=SSQh+(rowbase+q0+wid*QBLK)*16;
  { bf16*stg=(bf16*)(shm+LDS_OST)+wid*2048;
    #pragma unroll
    for(int r=0;r<16;++r){const int orow=crow(r,hi);
      #pragma unroll
      for(int d0=0;d0<2;++d0)stg[orow*64+d0*32+r32]=__float2bfloat16(o[d0][r]);}
    asm volatile("s_waitcnt lgkmcnt(0)":::"memory");
    #pragma unroll
    for(int i=0;i<4;++i){const int row=i*8+(lane>>3),ch=lane&7; const u32x4 v=*(const u32x4*)(stg+row*64+ch*8); ATTN_STORE16(Ow+(long)row*POUT+ch*8,v);
      float sq=0.f;
      #pragma unroll
      for(int w_=0;w_<4;++w_){const float lo_=__uint_as_float(v[w_]<<16),hi_=__uint_as_float(v[w_]&0xffff0000u);sq+=lo_*lo_+hi_*hi_;}
      sq+=__shfl_xor(sq,1);sq+=__shfl_xor(sq,2);sq+=__shfl_xor(sq,4); if(ch==0)Sw[row*16]=sq;} }
  asm volatile("s_waitcnt vmcnt(0) lgkmcnt(0)\n\ts_barrier":::"memory");
}
template<int THRL=8> __device__ __forceinline__ void attn_phase(char*lds,const bf16*PROJ,const float*CUM,bf16*OMIX,float*SSQ,int vcu){
  const int bh=vcu>>3,s=vcu&7,b=bh>>3,h=bh&7;
  if(bh>=32)return;
  for(int i=0;i<4;++i){ const int qb=(i&1)?15-s:s;
    if(i<2)attn_unit<THRL>(b,h,qb,PROJ,PROJ+512,PROJ+1024,OMIX,CUM+(size_t)bh*SEQ,SSQ+h,lds);
    else   sb_unit(b,h,qb,PROJ+1536,PROJ+2048,PROJ+2560,OMIX+512,SSQ+8+h,lds); }
}

#undef SBAR
#undef WAIT_BAR
}
__global__ void __launch_bounds__(NTHREADS, 2) mega_fwd(Args a) {
    extern __shared__ __attribute__((aligned(16))) unsigned char lds[];
    LAS unsigned char* L = (LAS unsigned char*)lds;
    volatile LAS unsigned* MISC = (volatile LAS unsigned*)(L + MISC_OFF);
    const int tid = threadIdx.x, lane = tid & 63, wave = __builtin_amdgcn_readfirstlane(tid >> 6);
    const int G = gridDim.x, bx = blockIdx.x, vcu = (G % 8 == 0) ? (bx % 8) * (G / 8) + bx / 8 : bx;
    const int gw = vcu * NWAVES + wave, NGW = G * NWAVES;
    unsigned char* ws = a.ws;
    unsigned* CTL = (unsigned*)(ws + WS_CTL);
    bf16_t* WINT = (bf16_t*)(ws + WS_WINT); bf16_t* WOUTT = (bf16_t*)(ws + WS_WOUTT); float* WR = (float*)(ws + WS_WR); float* CUM = (float*)(ws + WS_CUM);
    float* SSQ = (float*)(ws + WS_SSQ); float* RSTD2 = (float*)(ws + WS_RSTD2); float* RW = (float*)(ws + WS_RW); int* LIST = (int*)(ws + WS_LIST); float* FLOG = (float*)(ws + WS_FLOG);
    bf16_t* XN = (bf16_t*)(ws + WS_XN); bf16_t* PROJ = (bf16_t*)(ws + WS_PROJ); bf16_t* OMIX = (bf16_t*)(ws + WS_OMIX); bf16_t* X1B = (bf16_t*)(ws + WS_X1B);
    bf16_t* W1T = (bf16_t*)(ws + WS_W1T); bf16_t* W2T = (bf16_t*)(ws + WS_W2T); bf16_t* H = (bf16_t*)(ws + WS_H); bf16_t* Y = (bf16_t*)(ws + WS_Y);
    unsigned* CNT = CTL + CW_CNT;
    for (int u = tid; u < (LDS_BYTES - LDSCTL_OFF) / 4; u += NTHREADS) ((LAS unsigned*)(L + LDSCTL_OFF))[u] = 0u;
    __syncthreads();
    XcdBarrier bar = xcd_barrier_post(CTL + CW_BAR, MISC + 8);

    REPS(0) {
        LAS float* scr = (LAS float*)(L + RING_OFF + wave * 8448);
        LAS float* wf = (LAS float*)(L + RING_OFF + 98304);
        for (int i = tid; i < DM * 8; i += NTHREADS) { const int k = i >> 3; wf[i] = a.w_in[(size_t)k * WIN_N + 1536 + (i & 7)] * a.g1[k]; }
        LDS_WAIT(); __syncthreads();
        constexpr int I_IN = (DM / 64) * (NPROJ / 32), I_OUT = (DM / 64) * (DM / 32), I_W1 = (DM / 64) * (2048 / 32), I_W2 = (DM / 64) * (DM / 32);
        constexpr int NITEMS = I_IN + I_OUT + NE * I_W1 + NE * I_W2;
        for (int it = gw; it < NITEMS; it += NGW) {
            int r = it;
            if (r < I_IN) { transpose_item(a.w_in, DM, WIN_N, NPROJ, 1, a.g1, nullptr, DM, WINT, scr, r, lane); continue; } r -= I_IN;
            if (r < I_OUT) { transpose_item(a.w_out, DM, DM, DM, 0, a.g_fox, a.g_sb, GW, WOUTT, scr, r, lane); continue; } r -= I_OUT;
            if (r < NE * I_W1) { const int e = r / I_W1; transpose_item(a.w1 + (size_t)e * DM * 2048, DM, 2048, 2048, 2, a.g2, nullptr, DM, W1T + (size_t)e * 2048 * DM, scr, r % I_W1, lane); continue; } r -= NE * I_W1;
            { const int e = r / I_W2; transpose_item(a.w2 + (size_t)e * DM * DM, DM, DM, DM, 0, nullptr, nullptr, DM, W2T + (size_t)e * DM * DM, scr, r % I_W2, lane); }
        }
        for (int i = gw * 64 + lane; i < DM * NE; i += NGW * 64) WR[i] = a.w_router[i] * a.g2[i >> 5];
        for (int row = gw; row < M; row += NGW) rms1_row(a.x, wf, a.b_f, XN, FLOG, row, lane);
    }
    xcd_barrier(bar);
    REPS(1) {
    if (vcu < NB * NH) cumsum_wg(FLOG, CUM, vcu, (LAS float*)(L + RING_OFF));
    if (OPT_GEMM) {
        pg8::Gemm g{XN, WINT, DM}; pg8::StaticOrder S; S.init(M, NPROJ, G, bx); pg8::EpiProj E{PROJ};
        pg8::gemm_phase<pg8::EpiProj, pg8::StaticOrder, true, false>(L + RING_OFF, g, S, E);
    } else { for (int it = gw; it < (M / 16) * (NPROJ / 64); it += NGW) nv_inproj(XN, WINT, PROJ, it, lane); }
    }
    xcd_barrier(bar);
    REPS(2) if (OPT_ATTN) {
        static_assert(attn_body::ATTN_LDS_BYTES <= RING_BYTES, "attention scratch inside the ring region");
        attn_body::attn_phase<8>((char*)lds + RING_OFF, (const attn_body::bf16*)PROJ, CUM, (attn_body::bf16*)OMIX, SSQ, vcu);
    } else {
        LAS unsigned char* wl = L + RING_OFF + wave * 16640;
        for (int u = gw; u < 4096; u += NGW) {
            const int i = u >> 11, idx = u & 2047, type = idx & 1, bh = (idx >> 1) & 31, j = (idx >> 6) & 31; const int qblk = (i == 0) ? j : 63 - j;
            if (type == 0) nv_attn<0>(PROJ, CUM, OMIX, SSQ, bh, qblk, lane, wl); else nv_attn<1>(PROJ, CUM, OMIX, SSQ, bh, qblk, lane, wl);
        }
    }
    xcd_barrier(bar);
    REPS(3) if (OPT_GEMM) {
        pg8::Gemm g{OMIX, WOUTT, DM}; pg8::StaticOrder S; S.init(M, DM, G, bx);
        LAS float* ratio = (LAS float*)(L + TAB_OFF); LAS float* rsb = (LAS float*)(L + TAB_OFF + 1024);
        pg8::Unit u0;
        if (S.next(0, u0) && tid < 256) { const float* sp = SSQ + (size_t)(u0.pm * 256 + tid) * 16; float sf = 0.f, s2 = 0.f;
#pragma unroll
            for (int h = 0; h < 8; ++h) { sf += sp[h]; s2 += sp[8 + h]; }
            const float rf = rsqrtf(sf * (1.f / GW) + EPS), rs = rsqrtf(s2 * (1.f / GW) + EPS); ratio[tid] = rf / rs; rsb[tid] = rs; }
        VM_WAIT(); LDS_WAIT(); __syncthreads();
        pg8::EpiWout E{a.x, a.out, X1B, ratio, rsb};
        pg8::gemm_phase<pg8::EpiWout, pg8::StaticOrder, false, false>(L + RING_OFF, g, S, E);
    } else { for (int it = gw; it < (M / 16) * (DM / 64); it += NGW) nv_wout(OMIX, WOUTT, SSQ, a.x, a.out, X1B, it, lane); }
    xcd_barrier(bar);
    if (OPT_ROUTER) { for (int t64 = vcu; t64 < M / 64; t64 += G) router_wg(a.out, WR, a.b_router, RSTD2, RW, LIST, CNT, t64 * 64, L + RING_OFF); }
    else { for (int it = gw; it < M / 2; it += NGW) nv_router(a.out, WR, a.b_router, RSTD2, RW, LIST, CNT, it, lane); }
    xcd_barrier(bar);
    LAS int* tb = (LAS int*)(L + TB_OFF); LAS int* tabA = (LAS int*)(L + TAB_OFF); LAS int* tabB = (LAS int*)(L + TAB2_OFF);
    REPS(5) if (OPT_GEMM) {
        if (tid == 0) { int run = 0; for (int e = 0; e < NE; ++e) { tb[e] = run; run += ((int)CNT[e] + 255) >> 8; } tb[NE] = run; }
        __syncthreads();
        pg8::MoeOrder S{8, bx, tb[NE] * 8, tb, tabA}; pg8::Unit u;
        for (int ui = 0; S.next(ui, u); ++ui) { const int e = u.pn >> 3, mt = u.pm - tb[e], cnt = (int)CNT[e];
            if (tid < 256) { const int p = mt * 256 + tid; const int slot = LIST[(size_t)e * LIST_CAP + (p < cnt ? p : cnt - 1)]; tabA[ui * 256 + tid] = slot >> 2; ((LAS float*)tabB)[ui * 256 + tid] = RSTD2[slot >> 2]; } }
        VM_WAIT(); LDS_WAIT(); __syncthreads();
        pg8::Gemm g{X1B, W1T, DM}; pg8::EpiMoe1 E{H, a.b1, (const LAS float*)tabB};
        pg8::gemm_phase<pg8::EpiMoe1, pg8::MoeOrder, true, true>(L + RING_OFF, g, S, E);
    } else {
    for (int g = gw; g < MAX_TILES * 16; g += NGW) {
        int e, base, p0, cnt; if (!moe_tile(CNT, g, e, base, p0, cnt)) continue;
        for (int cg = 0; cg < DFF / 32; ++cg) nv_moe1(X1B, W1T, a.b1, RSTD2, LIST, H, e, base, p0, cnt, cg, lane);
    } }
    xcd_barrier(bar);
    REPS(6) if (OPT_GEMM) {
        pg8::MoeOrder S{4, bx, tb[NE] * 4, tb, tabA}; pg8::Unit u;
        for (int ui = 0; S.next(ui, u); ++ui) { const int e = u.pn >> 2, mt = u.pm - tb[e], cnt = (int)CNT[e];
            if (tid < 256) { const int p = mt * 256 + tid; const int slot = LIST[(size_t)e * LIST_CAP + (p < cnt ? p : cnt - 1)]; tabA[ui * 256 + tid] = p < cnt ? slot : -1; ((LAS float*)tabB)[ui * 256 + tid] = RW[slot]; } }
        VM_WAIT(); LDS_WAIT(); __syncthreads();
        pg8::Gemm g{H, W2T, DM}; pg8::EpiMoe2 E{Y, a.b2, tabA, (const LAS float*)tabB};
        pg8::gemm_phase<pg8::EpiMoe2, pg8::MoeOrder, true, false>(L + RING_OFF, g, S, E);
    } else {
    for (int g = gw; g < MAX_TILES * 16; g += NGW) {
        int e, base, p0, cnt; if (!moe_tile(CNT, g, e, base, p0, cnt)) continue;
        for (int cg = 0; cg < DM / 64; ++cg) nv_moe2(H, W2T, a.b2, RW, LIST, Y, e, base, p0, cnt, cg, lane);
    } }
    xcd_barrier(bar);
    for (int row = gw; row < M; row += NGW) final_row(a.out, Y, a.gf, a.out, row, lane);
}

extern "C" void kernel_launch(void* const* d_in, const int* in_sizes, int n_in, void* d_out, int out_size, void* d_ws, size_t ws_size, hipStream_t stream) {
    static int grid = 0;
    if (grid == 0) {
        if (n_in != 15 || in_sizes[0] != M * DM || out_size != M * DM || ws_size < WS_END) {
            fprintf(stderr, "kernel_launch: unexpected shapes / workspace (n_in %d, in0 %d, out %d, ws %zu, need %zu)\n", n_in, n_in > 0 ? in_sizes[0] : -1, out_size, ws_size, (size_t)WS_END); grid = -1; return; }
        int dev = 0, cus = 0, per_cu = 0;
        if (hipGetDevice(&dev) != hipSuccess || hipDeviceGetAttribute(&cus, hipDeviceAttributeMultiprocessorCount, dev) != hipSuccess) { grid = -1; return; }
        if (hipFuncSetAttribute((const void*)mega_fwd, hipFuncAttributeMaxDynamicSharedMemorySize, LDS_BYTES) != hipSuccess) { fprintf(stderr, "kernel_launch: hipFuncSetAttribute failed\n"); grid = -1; return; }
        if (hipOccupancyMaxActiveBlocksPerMultiprocessor(&per_cu, (const void*)mega_fwd, NTHREADS, LDS_BYTES) != hipSuccess || per_cu < 1) fprintf(stderr, "kernel_launch: occupancy query reports %d\n", per_cu);
        (void)hipGetLastError();
        grid = cus;
    }
    if (grid < 0) return;
    if (hipMemsetAsync((char*)d_ws + WS_CTL, 0, CTL_BYTES, stream) != hipSuccess) return;
    Args a{};
    a.x = (const float*)d_in[0]; a.g1 = (const float*)d_in[1]; a.w_in = (const float*)d_in[2]; a.b_f = (const float*)d_in[3]; a.g_fox = (const float*)d_in[4]; a.g_sb = (const float*)d_in[5];
    a.w_out = (const float*)d_in[6]; a.g2 = (const float*)d_in[7]; a.w_router = (const float*)d_in[8]; a.b_router = (const float*)d_in[9]; a.w1 = (const float*)d_in[10]; a.b1 = (const float*)d_in[11];
    a.w2 = (const float*)d_in[12]; a.b2 = (const float*)d_in[13]; a.gf = (const float*)d_in[14];
    a.out = (float*)d_out; a.ws = (unsigned char*)d_ws;
    hipLaunchKernelGGL(mega_fwd, dim3(grid), dim3(NTHREADS), LDS_BYTES, stream, a);
    const hipError_t le = hipPeekAtLastError();
    if (le != hipSuccess) fprintf(stderr, "kernel_launch: launch failed: %s\n", hipGetErrorName(le));
}
```

```cpp
#include <hip/hip_runtime.h>
#include <cstdio>
#include <cstdint>

typedef unsigned short bf16_t;
typedef short bf16x8 __attribute__((ext_vector_type(8)));
typedef float f32x4 __attribute__((ext_vector_type(4)));

constexpr int NB = 4, SEQ = 4096, DM = 1024, M = NB * SEQ;
constexpr int NH = 8, HD = 64, GW = 512;
constexpr int WIN_N = 3080, NPROJ = 3072;
constexpr int NE = 32, TOPK = 4, DFF = 1024;
constexpr float EPS = 1e-5f;
constexpr float LOG2E = 1.4426950408889634f;
constexpr float C2 = 0.125f * LOG2E;
constexpr int LIST_CAP = M;
constexpr int MAX_TILES = (M * TOPK) / 256 + NE;

constexpr size_t MiB = 1u << 20;
constexpr size_t WS_CTL = 0, CTL_BYTES = 1 * MiB;
constexpr size_t WS_WINT = 2 * MiB;
constexpr size_t WS_WOUTT = 8 * MiB;
constexpr size_t WS_WR = 10 * MiB;
constexpr size_t WS_CUM = 11 * MiB;
constexpr size_t WS_SSQ = 12 * MiB;
constexpr size_t WS_RSTD2 = 14 * MiB;
constexpr size_t WS_RW = 15 * MiB;
constexpr size_t WS_SLOTEP = 15 * MiB + 512 * 1024;
constexpr size_t WS_TBG = 14 * MiB + 512 * 1024;
constexpr size_t WS_LIST = 16 * MiB;
constexpr size_t WS_FLOG = 18 * MiB;
constexpr size_t WS_XN = 32 * MiB;
constexpr size_t WS_PROJ = 64 * MiB;
constexpr size_t WS_OMIX = 160 * MiB;
constexpr size_t WS_X1B = 192 * MiB;
constexpr size_t WS_W1T = 224 * MiB;
constexpr size_t WS_W2T = 352 * MiB;
constexpr size_t WS_H = 416 * MiB;
constexpr size_t WS_Y = 560 * MiB;
constexpr size_t WS_END = 704 * MiB;
constexpr int CW_CNT = 1024;

__device__ __forceinline__ unsigned short f2bf(float f) { unsigned u = __float_as_uint(f); return (unsigned short)((u + 0x7fffu + ((u >> 16) & 1u)) >> 16); }
__device__ __forceinline__ float bf2f(unsigned short b) { return __uint_as_float(((unsigned)b) << 16); }
__device__ __forceinline__ float wave_sum(float v) {
#pragma unroll
    for (int o = 1; o < 64; o <<= 1) v += __shfl_xor(v, o);
    return v;
}


#define LAS __attribute__((address_space(3)))
#define GAS __attribute__((address_space(1)))
typedef unsigned v4u __attribute__((ext_vector_type(4)));
#define LDS_WAIT() asm volatile("s_waitcnt lgkmcnt(0)" ::: "memory")
#define VM_WAIT() asm volatile("s_waitcnt vmcnt(0)" ::: "memory")
constexpr int NWAVES = 8, NTHREADS = NWAVES * 64;
constexpr int REP_PHASE = -1;
#define REPS(k) for (int rep_ = 0; rep_ < ((REP_PHASE == (k)) ? 2 : 1); ++rep_)
constexpr bool OPT_GEMM = true;
constexpr bool OPT_ROUTER = true;
constexpr bool OPT_ATTN = true;

#define XB_TMO      128
#define XB_XCNT(j)  (256  + 64 * (j))
#define XB_XSUB(j)  (1280 + 64 * (j))
#define XB_XGEN(j)  (2304 + 64 * (j))
#define XB_TOP      3328
#define XB_TOPGEN   3392
#define XCD_BAR_WORDS 3456
#define XB_SPIN_CAP (1u << 20)
__device__ __forceinline__ unsigned xb_ld(unsigned* p)              { return __hip_atomic_load(p, __ATOMIC_RELAXED, __HIP_MEMORY_SCOPE_AGENT); }
__device__ __forceinline__ unsigned xb_add(unsigned* p, unsigned v) { return __hip_atomic_fetch_add(p, v, __ATOMIC_RELAXED, __HIP_MEMORY_SCOPE_AGENT); }
__device__ __forceinline__ unsigned xb_xcc_id() { return (unsigned)__builtin_amdgcn_s_getreg((3 << 11) | 20) & 0xFu; }
#define XB_SPIN(cond, bar) do { unsigned _sp = 0; while (cond) { __builtin_amdgcn_s_sleep(1); \
    if ((++_sp & 255u) == 0u) { if (xb_ld(&(bar)[XB_TMO])) break; if (_sp > XB_SPIN_CAP) { atomicAdd(&(bar)[XB_TMO], 1u); break; } } } } while (0)
struct XcdBarrier { unsigned* bar; unsigned x; volatile LAS unsigned* st; };
__device__ __forceinline__ XcdBarrier xcd_barrier_post(unsigned* bar, volatile LAS unsigned* st) {
    XcdBarrier b; b.bar = bar; b.x = xb_xcc_id(); b.st = st;
    if (threadIdx.x == 0) (void)xb_add(&bar[XB_XCNT(b.x)], 1u);
    return b;
}
__device__ __forceinline__ void xcd_barrier_complete(unsigned* bar, unsigned x, unsigned& nloc, unsigned& nx) {
    const unsigned G = gridDim.x * gridDim.y * gridDim.z;
    unsigned sum, cnt, mine, sp = 0u;
    for (;;) {
        sum = 0u; cnt = 0u; mine = 0u;
#pragma unroll
        for (unsigned j = 0; j < 16; ++j) { const unsigned c = xb_ld(&bar[XB_XCNT(j)]); sum += c; cnt += (c > 0u) ? 1u : 0u; mine = (j == x) ? c : mine; }
        if (sum == G) break;
        __builtin_amdgcn_s_sleep(1);
        if ((++sp & 255u) == 0u) { if (xb_ld(&bar[XB_TMO])) break; if (sp > XB_SPIN_CAP) { atomicAdd(&bar[XB_TMO], 1u); break; } }
    }
    nloc = mine > 0u ? mine : 1u; nx = cnt > 0u ? cnt : 1u;
}
__device__ __forceinline__ void xcd_barrier(const XcdBarrier& b) {
    asm volatile("s_waitcnt vmcnt(0)" ::: "memory");
    __syncthreads();
    if (threadIdx.x == 0) {
        unsigned* bar = b.bar;
        __builtin_amdgcn_s_waitcnt(0);
        unsigned nloc = b.st[0], nx = b.st[1];
        if (nloc == 0u) { xcd_barrier_complete(bar, b.x, nloc, nx); b.st[0] = nloc; b.st[1] = nx; }
        const unsigned old = xb_add(&bar[XB_XSUB(b.x)], 1u);
        const unsigned gen = old / nloc;
        if (old + 1u == (gen + 1u) * nloc) {
            __builtin_amdgcn_fence(__ATOMIC_RELEASE, "agent");
            asm volatile("s_waitcnt vmcnt(0)" ::: "memory");
            const unsigned og = xb_add(&bar[XB_TOP], 1u);
            const unsigned tg = og / nx;
            if (og + 1u == (tg + 1u) * nx) xb_add(&bar[XB_TOPGEN], 1u);
            else XB_SPIN(xb_ld(&bar[XB_TOPGEN]) == tg, bar);
            __builtin_amdgcn_fence(__ATOMIC_ACQUIRE, "agent");
            xb_add(&bar[XB_XGEN(b.x)], 1u);
            asm volatile("s_waitcnt vmcnt(0)" ::: "memory");
        } else {
            XB_SPIN(xb_ld(&bar[XB_XGEN(b.x)]) == gen, bar);
            __builtin_amdgcn_fence(__ATOMIC_ACQUIRE, "agent");
            asm volatile("s_waitcnt vmcnt(0)" ::: "memory");
        }
    }
    __syncthreads();
}

constexpr int RING_OFF = 0, RING_BYTES = 131072;
constexpr int TAB_OFF = 131072;
constexpr int TAB2_OFF = TAB_OFF + 10 * 1024, TB_OFF = TAB_OFF + 20 * 1024;
constexpr int LDSCTL_OFF = 152576, MISC_OFF = LDSCTL_OFF + 320;
constexpr int LDS_BYTES = 155648;
constexpr int CW_BAR = 4096;

struct Args {
    const float *x, *g1, *w_in, *b_f, *g_fox, *g_sb, *w_out, *g2, *w_router, *b_router, *w1, *b1, *w2, *b2, *gf;
    float* out; unsigned char* ws;
};

__device__ __forceinline__ int mapcol(int mode, int n) {
    if (mode == 1) return n < 1536 ? n : n + 8;
    if (mode == 2) { const int pn = n >> 8, j = n & 255; return j < 128 ? 128 * pn + j : 1024 + 128 * pn + (j - 128); }
    return n;
}
__device__ __forceinline__ unsigned pk2(float lo, float hi) { return (unsigned)f2bf(lo) | ((unsigned)f2bf(hi) << 16); }
__device__ __forceinline__ void transpose_item(const float* __restrict__ W, int K, int Nin, int Nout, int mode, const float* __restrict__ gA, const float* __restrict__ gB, int gsplit,
                                               bf16_t* __restrict__ WT, LAS float* scr, int item, int lane) {
    const int nblk = Nout / 32, kb = item / nblk, nb = item % nblk, k0 = 64 * kb, n0 = 32 * nb;
    const int l7 = lane & 7, kr = lane >> 3, col = mapcol(mode, n0 + 4 * l7);
    f32x4 v[8];
#pragma unroll
    for (int i = 0; i < 8; ++i) v[i] = *(const f32x4*)(W + (size_t)(k0 + 8 * i + kr) * Nin + col);
#pragma unroll
    for (int i = 0; i < 8; ++i) { const int kk = 8 * i + kr, k = k0 + kk; const float gs = gA ? (k < gsplit ? gA[k] : gB[k - gsplit]) : 1.f;
        LAS float* sp = scr + kk * 33 + 4 * l7; sp[0] = v[i][0] * gs; sp[1] = v[i][1] * gs; sp[2] = v[i][2] * gs; sp[3] = v[i][3] * gs; }
    LDS_WAIT();
    const int c = lane & 7;
#pragma unroll
    for (int j = 0; j < 4; ++j) { const int n = (lane >> 3) + 8 * j; const LAS float* sp = scr + (8 * c) * 33 + n;
        v4u o; o.x = pk2(sp[0 * 33], sp[1 * 33]); o.y = pk2(sp[2 * 33], sp[3 * 33]); o.z = pk2(sp[4 * 33], sp[5 * 33]); o.w = pk2(sp[6 * 33], sp[7 * 33]);
        *(v4u*)(WT + (size_t)(n0 + n) * K + k0 + 8 * c) = o; }
    LDS_WAIT();
}

__device__ __forceinline__ float log_sigmoid(float v) { return fminf(v, 0.f) - log1pf(expf(-fabsf(v))); }
__device__ __forceinline__ void rms1_row(const float* __restrict__ x, const LAS float* wf  , const float* __restrict__ b_f,
                                         bf16_t* __restrict__ XN, float* __restrict__ FLOG, int row, int lane) {
    const float4* xr = (const float4*)(x + (size_t)row * DM);
    float4 v[4]; float ss = 0.f;
#pragma unroll
    for (int j = 0; j < 4; ++j) { v[j] = xr[lane + 64 * j]; ss += v[j].x * v[j].x + v[j].y * v[j].y + v[j].z * v[j].z + v[j].w * v[j].w; }
    ss = wave_sum(ss);
    const float rstd = rsqrtf(ss * (1.f / DM) + EPS);
    float f0 = 0.f, f1 = 0.f, f2 = 0.f, f3 = 0.f, f4 = 0.f, f5 = 0.f, f6 = 0.f, f7 = 0.f;
#pragma unroll
    for (int j = 0; j < 4; ++j) {
        const int c0 = 4 * (lane + 64 * j);
        uint2 o; o.x = pk2(v[j].x * rstd, v[j].y * rstd); o.y = pk2(v[j].z * rstd, v[j].w * rstd);
        *(uint2*)(XN + (size_t)row * DM + c0) = o;
        const float xs[4] = {v[j].x, v[j].y, v[j].z, v[j].w};
#pragma unroll
        for (int c = 0; c < 4; ++c) {
            const int k = c0 + c; const float xv = xs[c];
            const LAS f32x4* wp = (const LAS f32x4*)(wf + k * 8); const f32x4 w0 = wp[0], w1 = wp[1];
            f0 += xv * w0.x; f1 += xv * w0.y; f2 += xv * w0.z; f3 += xv * w0.w; f4 += xv * w1.x; f5 += xv * w1.y; f6 += xv * w1.z; f7 += xv * w1.w;
        }
    }
    f0 = wave_sum(f0); f1 = wave_sum(f1); f2 = wave_sum(f2); f3 = wave_sum(f3); f4 = wave_sum(f4); f5 = wave_sum(f5); f6 = wave_sum(f6); f7 = wave_sum(f7);
    if (lane < 8) {
        float f = f0; f = lane == 1 ? f1 : f; f = lane == 2 ? f2 : f; f = lane == 3 ? f3 : f; f = lane == 4 ? f4 : f; f = lane == 5 ? f5 : f; f = lane == 6 ? f6 : f; f = lane == 7 ? f7 : f;
        FLOG[(size_t)row * 8 + lane] = log_sigmoid(f * rstd + b_f[lane]);
    }
}
__device__ __forceinline__ void cumsum_wg(const float* __restrict__ FLOG, float* __restrict__ CUM, int bh, LAS float* part) {
    const int b = bh >> 3, h = bh & 7, t = threadIdx.x;
    float loc[8]; float s = 0.f;
#pragma unroll
    for (int i = 0; i < 8; ++i) { loc[i] = FLOG[((size_t)b * SEQ + t * 8 + i) * 8 + h]; s += loc[i]; }
    part[t] = s; __syncthreads();
    float run = 0.f; for (int i = 0; i < t; ++i) run += part[i];
#pragma unroll
    for (int i = 0; i < 8; ++i) { run += loc[i]; CUM[(size_t)bh * SEQ + t * 8 + i] = run * LOG2E; }
    __syncthreads();
}

template <int NT> __device__ __forceinline__ void wave_mma(f32x4 (&acc)[NT], const bf16_t* ap, const bf16_t* const (&bp)[NT], int K) {
    for (int k0 = 0; k0 < K; k0 += 32) {
        const bf16x8 a = *(const bf16x8*)(ap + k0);
#pragma unroll
        for (int t = 0; t < NT; ++t) { const bf16x8 b = *(const bf16x8*)(bp[t] + k0); acc[t] = __builtin_amdgcn_mfma_f32_16x16x32_bf16(a, b, acc[t], 0, 0, 0); }
    }
}
__device__ __forceinline__ void nv_inproj(const bf16_t* __restrict__ XN, const bf16_t* __restrict__ WINT, bf16_t* __restrict__ PROJ, int item, int lane) {
    const int n0 = (item % 48) * 64, m0 = (item / 48) * 16, r = lane & 15, q = lane >> 4;
    f32x4 acc[4];
#pragma unroll
    for (int t = 0; t < 4; ++t) acc[t] = (f32x4){0.f, 0.f, 0.f, 0.f};
    const bf16_t* ap = XN + (size_t)(m0 + r) * DM + 8 * q;
    const bf16_t* bp[4];
#pragma unroll
    for (int t = 0; t < 4; ++t) bp[t] = WINT + (size_t)(n0 + 16 * t + r) * DM + 8 * q;
    wave_mma<4>(acc, ap, bp, DM);
    const float sc = (n0 < 512 || (n0 >= 1536 && n0 < 2048)) ? C2 : 1.f;
#pragma unroll
    for (int t = 0; t < 4; ++t)
#pragma unroll
        for (int j = 0; j < 4; ++j) PROJ[(size_t)(m0 + 4 * q + j) * NPROJ + n0 + 16 * t + r] = f2bf(acc[t][j] * sc);
}

template <int TYPE> __device__ __forceinline__ void nv_attn(const bf16_t* __restrict__ PROJ, const float* __restrict__ CUM, bf16_t* __restrict__ OMIX, float* __restrict__ SSQ,
                                                          int bh, int qblk, int lane, LAS unsigned char* wl) {
    LAS bf16_t* Ks = (LAS bf16_t*)wl; LAS bf16_t* Vs = (LAS bf16_t*)(wl + 8192); LAS float* Cs = (LAS float*)(wl + 16384);
    const int b = bh >> 3, h = bh & 7, t = qblk * 64 + lane;
    const size_t row = (size_t)b * SEQ + t;
    const int qcol = (TYPE == 0 ? 0 : 1536) + h * HD, kcol = qcol + 512, vcol = qcol + 1024;
    float q[64], o[64];
#pragma unroll
    for (int c = 0; c < 8; ++c) { const bf16x8 v = *(const bf16x8*)(PROJ + row * NPROJ + qcol + 8 * c);
#pragma unroll
        for (int j = 0; j < 8; ++j) q[8 * c + j] = bf2f((unsigned short)v[j]); }
#pragma unroll
    for (int d = 0; d < 64; ++d) o[d] = 0.f;
    float m = -INFINITY, l = 0.f, R = 1.f;
    const float cq = CUM[(size_t)bh * SEQ + t];
    for (int it = 0; it <= qblk; ++it) {
        const int kt = (TYPE == 0) ? it : qblk - it;
        LDS_WAIT();
        for (int i = 0; i < 64; ++i) { const size_t kr = ((size_t)b * SEQ + kt * 64 + i) * NPROJ; Ks[i * 64 + lane] = PROJ[kr + kcol + lane]; Vs[i * 64 + lane] = PROJ[kr + vcol + lane]; }
        Cs[lane] = CUM[(size_t)bh * SEQ + kt * 64 + lane];
        LDS_WAIT();
        for (int ss = 0; ss < 64; ++ss) {
            const int s = (TYPE == 0) ? ss : 63 - ss; const int ks = kt * 64 + s;
            float dot = 0.f;
#pragma unroll
            for (int d = 0; d < 64; d += 8) { const bf16x8 kv = *(const LAS bf16x8*)&Ks[s * 64 + d];
#pragma unroll
                for (int j = 0; j < 8; ++j) dot += q[d + j] * bf2f((unsigned short)kv[j]); }
            if (TYPE == 0) {
                if (ks <= t) {
                    const float xv = dot + cq - Cs[s]; const float mn = fmaxf(m, xv); const float sc = exp2f(m - mn), p = exp2f(xv - mn);
                    l = l * sc + p; m = mn;
#pragma unroll
                    for (int d = 0; d < 64; d += 8) { const bf16x8 vv = *(const LAS bf16x8*)&Vs[s * 64 + d];
#pragma unroll
                        for (int j = 0; j < 8; ++j) o[d + j] = o[d + j] * sc + p * bf2f((unsigned short)vv[j]); }
                }
            } else {
                if (ks < t) {
                    const float z = fminf(fmaxf(dot, -80.f), 80.f); const float e = exp2f(z); const float rr = 1.f / (1.f + e); const float a = e * rr * R; R *= rr;
#pragma unroll
                    for (int d = 0; d < 64; d += 8) { const bf16x8 vv = *(const LAS bf16x8*)&Vs[s * 64 + d];
#pragma unroll
                        for (int j = 0; j < 8; ++j) o[d + j] += a * bf2f((unsigned short)vv[j]); }
                }
            }
        }
    }
    const float inv = (TYPE == 0) ? 1.f / l : 1.f;
    float ssq = 0.f;
#pragma unroll
    for (int d = 0; d < 64; ++d) { o[d] *= inv; ssq += o[d] * o[d]; }
    SSQ[row * 16 + TYPE * 8 + h] = ssq;
#pragma unroll
    for (int c = 0; c < 8; ++c) { bf16x8 v;
#pragma unroll
        for (int j = 0; j < 8; ++j) v[j] = (short)f2bf(o[8 * c + j]);
        *(bf16x8*)(OMIX + row * DM + TYPE * GW + h * HD + 8 * c) = v; }
}

__device__ __forceinline__ void nv_wout(const bf16_t* __restrict__ OMIX, const bf16_t* __restrict__ WOUTT, const float* __restrict__ SSQ, const float* __restrict__ x,
                                        float* __restrict__ X1, bf16_t* __restrict__ X1B, int item, int lane) {
    const int n0 = (item & 15) * 64, m0 = (item >> 4) * 16, r = lane & 15, q = lane >> 4;
    f32x4 af[4], as[4];
#pragma unroll
    for (int t = 0; t < 4; ++t) { af[t] = (f32x4){0.f, 0.f, 0.f, 0.f}; as[t] = (f32x4){0.f, 0.f, 0.f, 0.f}; }
    const bf16_t* ap = OMIX + (size_t)(m0 + r) * DM + 8 * q;
    const bf16_t* bp[4]; const bf16_t* bp2[4];
#pragma unroll
    for (int t = 0; t < 4; ++t) { bp[t] = WOUTT + (size_t)(n0 + 16 * t + r) * DM + 8 * q; bp2[t] = bp[t] + GW; }
    wave_mma<4>(af, ap, bp, GW);
    wave_mma<4>(as, ap + GW, bp2, GW);
#pragma unroll
    for (int j = 0; j < 4; ++j) {
        const size_t row = m0 + 4 * q + j; const float* sp = SSQ + row * 16;
        float sf = 0.f, s2 = 0.f;
#pragma unroll
        for (int h = 0; h < 8; ++h) { sf += sp[h]; s2 += sp[8 + h]; }
        const float rf = rsqrtf(sf * (1.f / GW) + EPS), rs = rsqrtf(s2 * (1.f / GW) + EPS);
#pragma unroll
        for (int t = 0; t < 4; ++t) { const size_t idx = row * DM + n0 + 16 * t + r; const float v = x[idx] + rf * af[t][j] + rs * as[t][j]; X1[idx] = v; X1B[idx] = f2bf(v); }
    }
}

__device__ __forceinline__ void nv_router(const float* __restrict__ X1, const float* __restrict__ WR, const float* __restrict__ b_router, float* __restrict__ RSTD2,
                                          float* __restrict__ RW, int* __restrict__ LIST, int* __restrict__ SLOTEP, unsigned* __restrict__ CNT, int item, int lane) {
    const int e = lane & 31, tok = item * 2 + (lane >> 5);
    const float* xr = X1 + (size_t)tok * DM;
    float acc = 0.f, ss = 0.f;
    for (int k = 0; k < DM; ++k) { const float xv = xr[k]; acc += xv * WR[k * NE + e]; ss += xv * xv; }
    const float rstd = rsqrtf(ss * (1.f / DM) + EPS);
    float logit = acc * rstd + b_router[e];
    if (e == 0) RSTD2[tok] = rstd;
    float tv[4]; int ti[4];
#pragma unroll
    for (int k = 0; k < 4; ++k) {
        float bv = logit; int bi = e;
#pragma unroll
        for (int o = 1; o < 32; o <<= 1) { const float ov = __shfl_xor(bv, o); const int oi = __shfl_xor(bi, o); if (ov > bv || (ov == bv && oi < bi)) { bv = ov; bi = oi; } }
        tv[k] = bv; ti[k] = bi; if (e == bi) logit = -INFINITY;
    }
    const float e0 = 1.f, e1 = expf(tv[1] - tv[0]), e2 = expf(tv[2] - tv[0]), e3 = expf(tv[3] - tv[0]); const float inv = 1.f / (e0 + e1 + e2 + e3);
    const float w0 = e0 * inv, w1 = e1 * inv, w2 = e2 * inv, w3 = e3 * inv;
    int myk = -1; float myw = 0.f;
    if (e == ti[0]) { myk = 0; myw = w0; } if (e == ti[1]) { myk = 1; myw = w1; } if (e == ti[2]) { myk = 2; myw = w2; } if (e == ti[3]) { myk = 3; myw = w3; }
    if (myk >= 0) { const int slot = tok * 4 + myk; const unsigned pos = atomicAdd(&CNT[e], 1u); LIST[(size_t)e * LIST_CAP + pos] = slot; RW[slot] = myw; SLOTEP[slot] = e * 16384 + (int)pos; }
}


typedef float f32x16 __attribute__((ext_vector_type(16)));
__device__ __forceinline__ void router_wg(const float* __restrict__ X1, const float* __restrict__ WR, const float* __restrict__ b_router, float* __restrict__ RSTD2,
                                          float* __restrict__ RW, int* __restrict__ LIST, int* __restrict__ SLOTEP, unsigned* __restrict__ CNT, int tokbase, LAS unsigned char* L) {
    int tid_ = threadIdx.x; asm volatile("" : "+v"(tid_));
    const int tid = tid_, lane = tid & 63, wave = __builtin_amdgcn_readfirstlane(tid >> 6), kq = wave & 3, tile = wave >> 2, r32 = lane & 31, hi = lane >> 5;
    LAS float* Dx = (LAS float*)L; LAS float* SSx = (LAS float*)(L + 32768); LAS unsigned* lcnt = (LAS unsigned*)(L + 33792); LAS unsigned* lbase = (LAS unsigned*)(L + 33920);
    if (tid < NE) lcnt[tid] = 0u;
    const int tok = tokbase + tile * 32 + r32;
    const float* xp = X1 + (size_t)tok * DM + kq * 256 + 4 * hi;
    const float* wp = WR + (size_t)(kq * 256 + 4 * hi) * NE + r32;
    f32x16 acc;
#pragma unroll
    for (int r = 0; r < 16; ++r) acc[r] = 0.f;
    float ss = 0.f;
#pragma unroll 1
    for (int mc = 0; mc < 4; ++mc) {
        float4 xv[8];
#pragma unroll
        for (int m = 0; m < 8; ++m) xv[m] = *(const float4*)(xp + (mc * 8 + m) * 8);
#pragma unroll
        for (int m = 0; m < 8; ++m) {
            const float* w4 = wp + (size_t)((mc * 8 + m) * 8) * NE;
            const float w0 = w4[0], w1 = w4[NE], w2 = w4[2 * NE], w3 = w4[3 * NE];
            acc = __builtin_amdgcn_mfma_f32_32x32x2f32(w0, xv[m].x, acc, 0, 0, 0);
            acc = __builtin_amdgcn_mfma_f32_32x32x2f32(w1, xv[m].y, acc, 0, 0, 0);
            acc = __builtin_amdgcn_mfma_f32_32x32x2f32(w2, xv[m].z, acc, 0, 0, 0);
            acc = __builtin_amdgcn_mfma_f32_32x32x2f32(w3, xv[m].w, acc, 0, 0, 0);
            ss += xv[m].x * xv[m].x + xv[m].y * xv[m].y + xv[m].z * xv[m].z + xv[m].w * xv[m].w;
        }
    }
    { auto rr = __builtin_amdgcn_permlane32_swap(__float_as_uint(ss), __float_as_uint(ss), false, false); ss = __uint_as_float(rr[0]) + __uint_as_float(rr[1]); }
#pragma unroll
    for (int r = 0; r < 16; ++r) Dx[(wave * 16 + r) * 64 + lane] = acc[r];
    if (hi == 0) SSx[wave * 32 + r32] = ss;
    LDS_WAIT(); __syncthreads();
    int ea = 0, eb = 0; float wa = 0.f, wb = 0.f; unsigned la = 0u, lb = 0u;
    if (kq == 0) {
        float v[16]; float sst = 0.f;
#pragma unroll
        for (int w = 0; w < 4; ++w) sst += SSx[(tile * 4 + w) * 32 + r32];
        const float rstd = rsqrtf(sst * (1.f / DM) + EPS);
#pragma unroll
        for (int r = 0; r < 16; ++r) { float a = 0.f;
#pragma unroll
            for (int w = 0; w < 4; ++w) a += Dx[((tile * 4 + w) * 16 + r) * 64 + lane];
            v[r] = a * rstd + b_router[(r & 3) + 8 * (r >> 2) + 4 * hi]; }
        if (hi == 0) RSTD2[tok] = rstd;
        float tv[4]; int te[4];
#pragma unroll
        for (int k = 0; k < 4; ++k) {
            float bv = v[0]; int br = 0;
#pragma unroll
            for (int r = 1; r < 16; ++r) if (v[r] > bv) { bv = v[r]; br = r; }
            const int be = (br & 3) + 8 * (br >> 2) + 4 * hi;
            auto r1 = __builtin_amdgcn_permlane32_swap(__float_as_uint(bv), __float_as_uint(bv), false, false);
            auto r2 = __builtin_amdgcn_permlane32_swap((unsigned)be, (unsigned)be, false, false);
            const float pv = __uint_as_float(hi ? r1[0] : r1[1]); const int pe = (int)(hi ? r2[0] : r2[1]);
            const bool mine = (bv > pv) || (bv == pv && be < pe);
            tv[k] = mine ? bv : pv; te[k] = mine ? be : pe;
#pragma unroll
            for (int r = 0; r < 16; ++r) v[r] = (mine && r == br) ? -INFINITY : v[r];
        }
        const float e1 = expf(tv[1] - tv[0]), e2 = expf(tv[2] - tv[0]), e3 = expf(tv[3] - tv[0]); const float inv = 1.f / (1.f + e1 + e2 + e3);
        ea = hi ? te[2] : te[0]; eb = hi ? te[3] : te[1]; wa = (hi ? e2 : 1.f) * inv; wb = (hi ? e3 : e1) * inv;
        la = atomicAdd((unsigned*)&lcnt[ea], 1u); lb = atomicAdd((unsigned*)&lcnt[eb], 1u);
    }
    LDS_WAIT(); __syncthreads();
    if (tid < NE) { const unsigned c = lcnt[tid]; lbase[tid] = c ? atomicAdd(&CNT[tid], c) : 0u; }
    LDS_WAIT(); __syncthreads();
    if (kq == 0) {
        const int sa = tok * 4 + 2 * hi, sb = sa + 1;
        const int pa = (int)(lbase[ea] + la), pb = (int)(lbase[eb] + lb);
        LIST[(size_t)ea * LIST_CAP + pa] = sa; RW[sa] = wa; SLOTEP[sa] = ea * 16384 + pa;
        LIST[(size_t)eb * LIST_CAP + pb] = sb; RW[sb] = wb; SLOTEP[sb] = eb * 16384 + pb;
    }
    LDS_WAIT(); __syncthreads();
}

__device__ __forceinline__ bool moe_tile(const unsigned* CNT, int g, int& e, int& base, int& p0, int& cnt) {
    const int tile256 = g >> 4; base = 0;
    for (e = 0; e < NE; ++e) { const int nt = ((int)CNT[e] + 255) >> 8; if (tile256 < base + nt) break; base += nt; }
    if (e == NE) return false;
    cnt = (int)CNT[e]; p0 = (g - base * 16) * 16; return p0 < cnt;
}
__device__ __forceinline__ void nv_moe1(const bf16_t* __restrict__ X1B, const bf16_t* __restrict__ W1T, const float* __restrict__ b1, const float* __restrict__ RSTD2,
                                        const int* __restrict__ LIST, bf16_t* __restrict__ H, int e, int base, int p0, int cnt, int cg, int lane) {
    const int r = lane & 15, q = lane >> 4, c0 = cg * 32, pn = c0 >> 7, j0 = c0 & 127;
    const int* lst = LIST + (size_t)e * LIST_CAP;
    const int prow = p0 + r; const int tok = lst[prow < cnt ? prow : cnt - 1] >> 2;
    f32x4 acc[4];
#pragma unroll
    for (int t = 0; t < 4; ++t) acc[t] = (f32x4){0.f, 0.f, 0.f, 0.f};
    const bf16_t* ap = X1B + (size_t)tok * DM + 8 * q;
    const bf16_t* wb = W1T + (size_t)e * 2048 * DM + (size_t)(256 * pn + j0 + r) * DM + 8 * q;
    const bf16_t* bp[4] = {wb, wb + 16 * DM, wb + 128 * DM, wb + 144 * DM};
    wave_mma<4>(acc, ap, bp, DM);
#pragma unroll
    for (int j = 0; j < 4; ++j) {
        const int pr = p0 + 4 * q + j; if (pr >= cnt) continue;
        const float rs = RSTD2[lst[pr] >> 2];
#pragma unroll
        for (int t = 0; t < 2; ++t) {
            const int col = c0 + 16 * t + r;
            float glu = acc[t][j] * rs + b1[(size_t)e * 2048 + col], lin = acc[t + 2][j] * rs + b1[(size_t)e * 2048 + 1024 + col];
            glu = fminf(glu, 7.f); lin = fminf(fmaxf(lin, -7.f), 7.f);
            const float act = glu * (1.f / (1.f + expf(-1.702f * glu))) * (lin + 1.f);
            H[((size_t)base * 256 + pr) * DM + col] = f2bf(act);
        }
    }
}
__device__ __forceinline__ void nv_moe2(const bf16_t* __restrict__ H, const bf16_t* __restrict__ W2T, const float* __restrict__ b2, const float* __restrict__ RW,
                                        const int* __restrict__ LIST, bf16_t* __restrict__ Y, int e, int base, int p0, int cnt, int cg, int lane) {
    const int r = lane & 15, q = lane >> 4, n0 = cg * 64;
    const int* lst = LIST + (size_t)e * LIST_CAP;
    f32x4 acc[4];
#pragma unroll
    for (int t = 0; t < 4; ++t) acc[t] = (f32x4){0.f, 0.f, 0.f, 0.f};
    const bf16_t* ap = H + ((size_t)base * 256 + p0 + r) * DM + 8 * q;
    const bf16_t* bp[4];
#pragma unroll
    for (int t = 0; t < 4; ++t) bp[t] = W2T + (size_t)e * DM * DM + (size_t)(n0 + 16 * t + r) * DM + 8 * q;
    wave_mma<4>(acc, ap, bp, DM);
#pragma unroll
    for (int j = 0; j < 4; ++j) {
        const int pr = p0 + 4 * q + j; if (pr >= cnt) continue;
        const int slot = lst[pr]; const float w = RW[slot];
#pragma unroll
        for (int t = 0; t < 4; ++t) { const int col = n0 + 16 * t + r; Y[((size_t)base * 256 + pr) * DM + col] = f2bf((acc[t][j] + b2[(size_t)e * DM + col]) * w); }
    }
}

__device__ __forceinline__ void final_row(const float* X1, const bf16_t* __restrict__ Y, const int* __restrict__ SLOTEP, const int* __restrict__ TBG, const float* __restrict__ gf, float* out, int row, int lane) {
    float4 v[4]; float ss = 0.f; int yr[4];
#pragma unroll
    for (int k = 0; k < 4; ++k) { const int ep = SLOTEP[row * 4 + k]; yr[k] = TBG[ep >> 14] * 256 + (ep & 16383); }
#pragma unroll
    for (int j = 0; j < 4; ++j) {
        const int c0 = 4 * (lane + 64 * j);
        v[j] = *(const float4*)(X1 + (size_t)row * DM + c0);
#pragma unroll
        for (int k = 0; k < 4; ++k) { const uint2 y = *(const uint2*)(Y + (size_t)yr[k] * DM + c0);
            v[j].x += bf2f((unsigned short)(y.x & 0xffff)); v[j].y += bf2f((unsigned short)(y.x >> 16)); v[j].z += bf2f((unsigned short)(y.y & 0xffff)); v[j].w += bf2f((unsigned short)(y.y >> 16)); }
        ss += v[j].x * v[j].x + v[j].y * v[j].y + v[j].z * v[j].z + v[j].w * v[j].w;
    }
    ss = wave_sum(ss);
    const float rstd = rsqrtf(ss * (1.f / DM) + EPS);
#pragma unroll
    for (int j = 0; j < 4; ++j) { const int c0 = 4 * (lane + 64 * j); const float4 g = *(const float4*)(gf + c0);
        float4 o; o.x = v[j].x * rstd * g.x; o.y = v[j].y * rstd * g.y; o.z = v[j].z * rstd * g.z; o.w = v[j].w * rstd * g.w; *(float4*)(out + (size_t)row * DM + c0) = o; }
}


namespace pg8 {
#define PG8_LAS __attribute__((address_space(3)))
typedef unsigned u32x4 __attribute__((ext_vector_type(4)));
typedef unsigned u32x2 __attribute__((ext_vector_type(2)));
constexpr int BM = 256, BK = 64, HALF = 128, HTB = HALF * BK * 2  , STAGE_BYTES = 8 * HTB, NXCD = 8, WGM = 8;
__host__ __device__ __forceinline__ int lds_byte(int r, int c) { const int st = (r >> 4) * 2 + (c >> 5), rr = r & 15, cc = c & 31, ob = rr * 64 + cc * 2; return st * 1024 + (ob ^ (((ob >> 9) & 1) << 5)); }
__host__ __device__ __forceinline__ void stage_rc(int b, int& R, int& C) { const int st = b / 1024, sb = b % 1024, swz = sb ^ (((sb >> 9) & 1) << 5); R = (st >> 1) * 16 + swz / 64; C = (st & 1) * 32 + (swz % 64) / 2; }
__host__ __device__ __forceinline__ int perm32(int rho) { const int n = rho >> 4, i = rho & 15; return 8 * (i >> 2) + 4 * n + (i & 3); }
struct Unit { int pm, pn, nr; };
struct Gemm { const bf16_t* A; const bf16_t* Bt; int K; };
struct StaticOrder {
    int nM, nN, nwg, G, c;
    __device__ void init(int M_, int N_, int G_, int c_) { nM = M_ / BM; nN = N_ / BM; nwg = nM * nN; G = G_; c = c_; }
    __device__ bool next(int i, Unit& u) const {
        const long L = (long)i * G + c; if (L >= nwg) return false;
        int wgid = (int)L; { const int q = nwg / NXCD, r = nwg % NXCD, xcd = wgid % NXCD, off = wgid / NXCD; wgid = (xcd < r ? xcd * (q + 1) : r * (q + 1) + (xcd - r) * q) + off; }
        const int nig = WGM * nN, gid = wgid / nig, fm = gid * WGM, gsz = (nM - fm) < WGM ? (nM - fm) : WGM;
        u.pm = fm + ((wgid % nig) % gsz); u.pn = (wgid % nig) / gsz; u.nr = BM; return true;
    }
    __device__ __forceinline__ const PG8_LAS int* rowtab(int) const { return nullptr; }
};
__device__ __forceinline__ unsigned cvt_pk_bf16(float lo, float hi) { unsigned r; asm volatile("v_cvt_pk_bf16_f32 %0, %1, %2" : "=v"(r) : "v"(lo), "v"(hi)); return r; }

template <class Sched> __device__ __forceinline__ void gather_voffs(const Sched& S, int ui, int tid, int K, unsigned (&o0)[2], unsigned (&o1)[2]) {
    const PG8_LAS int* tab = S.rowtab(ui);
#pragma unroll
    for (int i = 0; i < 2; ++i) { int R, C; stage_rc(tid * 16 + i * 8192, R, C); o0[i] = (unsigned)(tab[R] * K + C) * 2u; o1[i] = (unsigned)(tab[HALF + R] * K + C) * 2u; }
}

template <class Epi, class Sched, bool ALIGN_EPI, bool GATHER>
__device__ __forceinline__ void gemm_phase(PG8_LAS unsigned char* lds, const Gemm g, const Sched& S, const Epi& E) {
    int tid_ = threadIdx.x; asm volatile("" : "+v"(tid_));
    const int tid = tid_, wid = __builtin_amdgcn_readfirstlane(tid >> 6), lane = tid & 63, wr = wid >> 2, wc = wid & 3, fr = lane & 15, fq = lane >> 4;
    const int K = g.K, nt = K / BK;
    unsigned vA0[2], vA1[2], wA0[2], wA1[2], voffB[2];
    const size_t kstep = (size_t)(BK * 2);
    const size_t hstep = (size_t)HALF * K * 2;
    const size_t tstep = 2 * hstep;
#pragma unroll
    for (int i = 0; i < 2; ++i) { int R, C; stage_rc(tid * 16 + i * 8192, R, C); const int Rb = Epi::PERM ? ((R & ~31) + perm32(R & 31)) : R;
        vA0[i] = (unsigned)(R * K + C) * 2u; vA1[i] = vA0[i] + (unsigned)hstep; voffB[i] = (unsigned)(Rb * K + C) * 2u; wA0[i] = vA0[i]; wA1[i] = vA1[i]; }
    const unsigned ldsw = (unsigned)wid * 1024u;
    const int aoff = lds_byte(wr * 64 + fr, fq * 8), boff = lds_byte(wc * 32 + fr, fq * 8);
#define PG8_SA(b, h) (((b) * 2 + (h)) * HTB)
#define PG8_SB(b, h) ((4 + (b) * 2 + (h)) * HTB)
#define PG8_STAGE(bufoff, gbase, voff) do { _Pragma("unroll") for (int _i = 0; _i < 2; ++_i) \
        __builtin_amdgcn_global_load_lds((const unsigned*)((const char*)(gbase) + (voff)[_i]), (PG8_LAS unsigned*)(lds + (bufoff) + ldsw + _i * 8192), 16, 0, 0); } while (0)
#define PG8_LDA(dst, b, h) do { _Pragma("unroll") for (int m = 0; m < 4; ++m) _Pragma("unroll") for (int k = 0; k < 2; ++k) dst[m][k] = *(const PG8_LAS bf16x8*)(lds + PG8_SA(b, h) + aoff + m * 2048 + k * 1024); } while (0)
#define PG8_LDB(dst, b, h) do { _Pragma("unroll") for (int n = 0; n < 2; ++n) _Pragma("unroll") for (int k = 0; k < 2; ++k) dst[n][k] = *(const PG8_LAS bf16x8*)(lds + PG8_SB(b, h) + boff + n * 2048 + k * 1024); } while (0)
#define PG8_MMA(ai, bj, At, Bt) do { if (cur.nr > 128 * (ai) + 64 * wr) { __builtin_amdgcn_s_setprio(1); _Pragma("unroll") for (int m = 0; m < 4; ++m) _Pragma("unroll") for (int n = 0; n < 2; ++n) _Pragma("unroll") for (int k = 0; k < 2; ++k) \
        acc[ai][bj][m][n] = __builtin_amdgcn_mfma_f32_16x16x32_bf16(Bt[n][k], At[m][k], acc[ai][bj][m][n], 0, 0, 0); __builtin_amdgcn_s_setprio(0); } } while (0)
#define PG8_WAIT_V(n) asm volatile("s_waitcnt vmcnt(" #n ")" ::: "memory")
#define PG8_WAIT_L(n) asm volatile("s_waitcnt lgkmcnt(" #n ")" ::: "memory")
#define PG8_BAR __builtin_amdgcn_s_barrier()
#define PG8_SCHED __builtin_amdgcn_sched_barrier(0)
    Unit cur, nxt; int ui = 0;
    if (!S.next(0, cur)) return;
    f32x4 acc[2][2][4][2];
#pragma unroll
    for (int a = 0; a < 2; ++a)
#pragma unroll
        for (int b = 0; b < 2; ++b)
#pragma unroll
            for (int m = 0; m < 4; ++m)
#pragma unroll
                for (int n = 0; n < 2; ++n) acc[a][b][m][n] = (f32x4){0.f, 0.f, 0.f, 0.f};
    bf16x8 At[4][2], B0[2][2], B1[2][2];
    const char* cA = GATHER ? (const char*)g.A : (const char*)g.A + (size_t)cur.pm * tstep; const char* cB = (const char*)g.Bt + (size_t)cur.pn * tstep;
    if constexpr (GATHER) gather_voffs(S, 0, tid, K, vA0, vA1);
    PG8_STAGE(PG8_SB(0, 0), cB, voffB); PG8_STAGE(PG8_SB(0, 1), cB + hstep, voffB); PG8_STAGE(PG8_SA(0, 0), cA, vA0); PG8_STAGE(PG8_SA(0, 1), cA, vA1);
    if (wr == 1) PG8_BAR;
    PG8_WAIT_V(2); PG8_BAR;
    PG8_STAGE(PG8_SB(1, 0), cB + kstep, voffB); PG8_STAGE(PG8_SA(1, 0), cA + kstep, vA0); PG8_STAGE(PG8_SB(1, 1), cB + hstep + kstep, voffB);
    PG8_WAIT_V(6); PG8_BAR;
    for (;;) {
        const bool has_next = S.next(ui + 1, nxt);
        const char* nA = GATHER ? cA : (has_next ? (const char*)g.A + (size_t)nxt.pm * tstep : cA); const char* nB = has_next ? (const char*)g.Bt + (size_t)nxt.pn * tstep : cB;
        if constexpr (GATHER) { if (has_next) gather_voffs(S, ui + 1, tid, K, wA0, wA1); else { wA0[0] = vA0[0]; wA0[1] = vA0[1]; wA1[0] = vA1[0]; wA1[1] = vA1[1]; } }
        for (int t = 0; t < nt; t += 2) {
            const bool last = (t == nt - 2);
            const char* a1 = cA + (size_t)(t + 1) * kstep;
            const char* a2 = last ? nA : cA + (size_t)(t + 2) * kstep; const char* b2 = last ? nB : cB + (size_t)(t + 2) * kstep;
            const char* a3 = a2 + kstep; const char* b3 = b2 + kstep;
            unsigned sA0[2], sA1[2];
#pragma unroll
            for (int i = 0; i < 2; ++i) { sA0[i] = (GATHER && last) ? wA0[i] : vA0[i]; sA1[i] = (GATHER && last) ? wA1[i] : vA1[i]; }
            if constexpr (Epi::MIDK) { if (t == nt / 2) E.midk(acc, wr, fr); }
            PG8_LDB(B0, 0, 0); PG8_LDB(B1, 0, 1); PG8_SCHED; PG8_LDA(At, 0, 0); PG8_STAGE(PG8_SA(1, 1), a1, vA1);
            PG8_WAIT_V(8); PG8_WAIT_L(0); PG8_BAR; PG8_MMA(0, 0, At, B0); PG8_MMA(0, 1, At, B1); PG8_BAR; PG8_SCHED;
            PG8_LDA(At, 0, 1); PG8_STAGE(PG8_SB(0, 0), b2, voffB); PG8_STAGE(PG8_SB(0, 1), b2 + hstep, voffB); PG8_STAGE(PG8_SA(0, 0), a2, sA0);
            PG8_WAIT_V(8); PG8_WAIT_L(0); PG8_BAR; PG8_MMA(1, 0, At, B0); PG8_MMA(1, 1, At, B1); PG8_BAR; PG8_SCHED;
            PG8_LDB(B0, 1, 0); PG8_LDB(B1, 1, 1); PG8_SCHED; PG8_LDA(At, 1, 0); PG8_STAGE(PG8_SA(0, 1), a2, sA1);
            PG8_WAIT_V(8); PG8_WAIT_L(0); PG8_BAR; PG8_MMA(0, 0, At, B0); PG8_MMA(0, 1, At, B1); PG8_BAR; PG8_SCHED;
            PG8_LDA(At, 1, 1); PG8_STAGE(PG8_SB(1, 0), b3, voffB); PG8_STAGE(PG8_SB(1, 1), b3 + hstep, voffB); PG8_STAGE(PG8_SA(1, 0), a3, sA0);
            PG8_WAIT_V(8); PG8_WAIT_L(0); PG8_BAR; PG8_MMA(1, 0, At, B0); PG8_MMA(1, 1, At, B1); PG8_BAR; PG8_SCHED;
        }
        if constexpr (ALIGN_EPI) { if (wr == 0) PG8_BAR; }
        E(acc, cur, ui, wr, wc, fr, fq);
        if (!has_next) break;
#pragma unroll
        for (int a = 0; a < 2; ++a)
#pragma unroll
            for (int b = 0; b < 2; ++b)
#pragma unroll
                for (int m = 0; m < 4; ++m)
#pragma unroll
                    for (int n = 0; n < 2; ++n) acc[a][b][m][n] = (f32x4){0.f, 0.f, 0.f, 0.f};
        cur = nxt; cA = nA; cB = nB; ++ui;
        if constexpr (GATHER) { vA0[0] = wA0[0]; vA0[1] = wA0[1]; vA1[0] = wA1[0]; vA1[1] = wA1[1]; }
        if constexpr (ALIGN_EPI) { if (wr == 1) PG8_BAR; }
    }
    PG8_WAIT_V(0);
    if constexpr (!ALIGN_EPI) { if (wr == 0) PG8_BAR; }
    PG8_BAR;
#undef PG8_SA
#undef PG8_SB
#undef PG8_STAGE
#undef PG8_LDA
#undef PG8_LDB
#undef PG8_MMA
#undef PG8_WAIT_V
#undef PG8_WAIT_L
#undef PG8_BAR
#undef PG8_SCHED
}

struct EpiProj {
    static constexpr bool PERM = true, MIDK = false;
    bf16_t* O;
    __device__ __forceinline__ void operator()(const f32x4 (&acc)[2][2][4][2], const Unit& u, int, int wr, int wc, int fr, int fq) const {
        const int row0 = u.pm * BM + wr * 64 + fr, col0 = u.pn * BM + wc * 32 + 8 * fq;
        const float sc = (u.pn < 2 || (u.pn >= 6 && u.pn < 8)) ? C2 : 1.f;
#pragma unroll
        for (int ai = 0; ai < 2; ++ai)
#pragma unroll
            for (int m = 0; m < 4; ++m) { bf16_t* rowp = O + (size_t)(row0 + ai * HALF + m * 16) * NPROJ + col0;
#pragma unroll
                for (int bj = 0; bj < 2; ++bj) { const f32x4 v0 = acc[ai][bj][m][0] * sc, v1 = acc[ai][bj][m][1] * sc;
                    u32x4 w; w.x = cvt_pk_bf16(v0[0], v0[1]); w.y = cvt_pk_bf16(v0[2], v0[3]); w.z = cvt_pk_bf16(v1[0], v1[1]); w.w = cvt_pk_bf16(v1[2], v1[3]);
                    *(u32x4*)(rowp + bj * HALF) = w; } }
    }
};
struct EpiWout {
    static constexpr bool PERM = false, MIDK = true;
    const float* x; float* X1; bf16_t* X1B; const PG8_LAS float* ratio; const PG8_LAS float* rs;
    __device__ __forceinline__ void midk(f32x4 (&acc)[2][2][4][2], int wr, int fr) const {
#pragma unroll
        for (int ai = 0; ai < 2; ++ai)
#pragma unroll
            for (int m = 0; m < 4; ++m) { const float f = ratio[ai * HALF + wr * 64 + m * 16 + fr];
#pragma unroll
                for (int bj = 0; bj < 2; ++bj)
#pragma unroll
                    for (int n = 0; n < 2; ++n) acc[ai][bj][m][n] *= f; }
    }
    __device__ __forceinline__ void operator()(const f32x4 (&acc)[2][2][4][2], const Unit& u, int, int wr, int wc, int fr, int fq) const {
        const int col0 = u.pn * BM + wc * 32 + 4 * fq;
#pragma unroll
        for (int ai = 0; ai < 2; ++ai)
#pragma unroll
            for (int m = 0; m < 4; ++m) { const int r = ai * HALF + wr * 64 + m * 16 + fr; const float s = rs[r]; const size_t off = (size_t)(u.pm * BM + r) * DM + col0;
#pragma unroll
                for (int bj = 0; bj < 2; ++bj)
#pragma unroll
                    for (int n = 0; n < 2; ++n) { const f32x4 xv = *(const f32x4*)(x + off + bj * HALF + n * 16); const f32x4 o = xv + acc[ai][bj][m][n] * s;
                        *(f32x4*)(X1 + off + bj * HALF + n * 16) = o; u32x2 w; w.x = cvt_pk_bf16(o[0], o[1]); w.y = cvt_pk_bf16(o[2], o[3]); *(u32x2*)(X1B + off + bj * HALF + n * 16) = w; }
                asm volatile("" ::: "memory"); }
    }
};
constexpr int MOE_MAXU = 10;
struct MoeOrder {
    int NT, c; const PG8_LAS int* tb; const PG8_LAS int* tbE; const PG8_LAS int* tbC; const PG8_LAS int* cnt; const PG8_LAS int* tabA;
    int probe = 0;
    __device__ bool next(int i, Unit& u) const {
        if (i >= MOE_MAXU) return false;
        const int x = c & 7, j = c >> 3, UE = tbE[32] * NT, UC = tbC[32] * NT;
        const int qE = UE >> 3, rE = UE & 7, sE = x * qE + (x < rE ? x : rE), nE = qE + (x < rE ? 1 : 0);
        const int qC = UC >> 3, rC = UC & 7, sC = x * qC + (x < rC ? x : rC), nC = qC + (x < rC ? 1 : 0);
        const int nEj = (j < nE) ? ((nE - j + 31) >> 5) : 0;
        if (i < nEj) {
            const int f = sE + i * 32 + j; int e = 0; while (f >= tbE[e + 1] * NT) ++e;
            const int idx = f - tbE[e] * NT, nte = tbE[e + 1] - tbE[e], pg = idx / (4 * nte), rem2 = idx - pg * 4 * nte, mt = rem2 >> 2;
            u.pm = tb[e] + mt; u.pn = e * NT + pg * 4 + (rem2 & 3); const int left = cnt[e] - 256 * mt; u.nr = left < BM ? left : BM;
        } else {
            const int jj = (j - (nE & 31) + 32) & 31, lc = (i - nEj) * 32 + jj; if (lc >= nC) return false;
            const int f = sC + lc; int e = 0; while (f >= tbC[e + 1] * NT) ++e;
            const int mt = tbE[e + 1] - tbE[e]; u.pm = tb[e] + mt; u.pn = e * NT + (f - tbC[e] * NT); u.nr = cnt[e] - 256 * mt;
        }
        if (probe) { u.pm &= 31; u.pn &= 7; if (probe == 2) u.nr = 32; }
        return true;
    }
    __device__ __forceinline__ const PG8_LAS int* rowtab(int ui) const { return tabA + ui * 256; }
};
struct EpiMoe1 {
    static constexpr bool PERM = true, MIDK = false;
    bf16_t* H; const float* b1; const PG8_LAS float* rstab;
    __device__ __forceinline__ void operator()(const f32x4 (&acc)[2][2][4][2], const Unit& u, int ui, int wr, int wc, int fr, int fq) const {
        const int e = u.pn >> 3, pl = u.pn & 7, colA = pl * 128 + wc * 32 + 8 * fq;
        f32x4 bg[2], bl[2];
#pragma unroll
        for (int n = 0; n < 2; ++n) { bg[n] = *(const f32x4*)(b1 + (size_t)e * 2048 + colA + 4 * n); bl[n] = *(const f32x4*)(b1 + (size_t)e * 2048 + 1024 + colA + 4 * n); }
#pragma unroll
        for (int ai = 0; ai < 2; ++ai)
#pragma unroll
            for (int m = 0; m < 4; ++m) { const int r = ai * HALF + wr * 64 + m * 16 + fr; const float rs = rstab[ui * 256 + r];
                float a8[8];
#pragma unroll
                for (int n = 0; n < 2; ++n) { const f32x4 gv = acc[ai][0][m][n] * rs + bg[n], lv = acc[ai][1][m][n] * rs + bl[n];
#pragma unroll
                    for (int i = 0; i < 4; ++i) { const float gl = fminf(gv[i], 7.f), li = fminf(fmaxf(lv[i], -7.f), 7.f);
                        a8[4 * n + i] = gl * __builtin_amdgcn_rcpf(1.f + __builtin_amdgcn_exp2f(-1.702f * LOG2E * gl)) * (li + 1.f); } }
                u32x4 w; w.x = cvt_pk_bf16(a8[0], a8[1]); w.y = cvt_pk_bf16(a8[2], a8[3]); w.z = cvt_pk_bf16(a8[4], a8[5]); w.w = cvt_pk_bf16(a8[6], a8[7]);
                *(u32x4*)(H + (size_t)(u.pm * BM + r) * DM + colA) = w; }
    }
};
struct EpiMoe2 {
    static constexpr bool PERM = true, MIDK = false;
    bf16_t* Y; const float* b2; const PG8_LAS float* wtab;
    __device__ __forceinline__ void operator()(const f32x4 (&acc)[2][2][4][2], const Unit& u, int ui, int wr, int wc, int fr, int fq) const {
        const int e = u.pn >> 2, pl = u.pn & 3, col0 = pl * BM + wc * 32 + 8 * fq;
        f32x4 bv[2][2];
#pragma unroll
        for (int bj = 0; bj < 2; ++bj)
#pragma unroll
            for (int n = 0; n < 2; ++n) bv[bj][n] = *(const f32x4*)(b2 + (size_t)e * DM + col0 + bj * HALF + 4 * n);
#pragma unroll
        for (int ai = 0; ai < 2; ++ai)
#pragma unroll
            for (int m = 0; m < 4; ++m) { const int r = ai * HALF + wr * 64 + m * 16 + fr; const float wt = wtab[ui * 256 + r]; bf16_t* rowp = Y + (size_t)(u.pm * BM + r) * DM + col0;
#pragma unroll
                for (int bj = 0; bj < 2; ++bj) { const f32x4 v0 = (acc[ai][bj][m][0] + bv[bj][0]) * wt, v1 = (acc[ai][bj][m][1] + bv[bj][1]) * wt;
                    u32x4 w; w.x = cvt_pk_bf16(v0[0], v0[1]); w.y = cvt_pk_bf16(v0[2], v0[3]); w.z = cvt_pk_bf16(v1[0], v1[1]); w.w = cvt_pk_bf16(v1[2], v1[3]);
                    *(u32x4*)(rowp + bj * HALF) = w; } }
    }
};
struct ListOrder {
    const PG8_LAS int* ud; int n; const PG8_LAS int* tabA;
    __device__ __forceinline__ bool next(int i, Unit& u) const { if (i >= n) return false; u.pm = ud[3 * i]; u.pn = ud[3 * i + 1]; u.nr = ud[3 * i + 2]; return true; }
    __device__ __forceinline__ const PG8_LAS int* rowtab(int ui) const { return tabA + ui * 256; }
};
struct EpiNull {
    static constexpr bool PERM = true, MIDK = false; float* O;
    __device__ __forceinline__ void operator()(const f32x4 (&acc)[2][2][4][2], const Unit& u, int ui, int wr, int wc, int fr, int fq) const {
        f32x4 t = (f32x4){0.f, 0.f, 0.f, 0.f};
#pragma unroll
        for (int ai = 0; ai < 2; ++ai)
#pragma unroll
            for (int bj = 0; bj < 2; ++bj)
#pragma unroll
                for (int m = 0; m < 4; ++m)
#pragma unroll
                    for (int n = 0; n < 2; ++n) t += acc[ai][bj][m][n];
        O[(size_t)(u.pm & 31) * 65536 + (u.pn & 7) * 8192 + (wr * 4 + wc) * 64 + fq * 16 + fr + ui] = t[0] + t[1] + t[2] + t[3];
    }
};
}

#include <hip/hip_bf16.h>
#include <cmath>
namespace attn_body {

using bf16=__hip_bfloat16;
using bf16x8=__attribute__((ext_vector_type(8)))short;
using s16x4=__attribute__((ext_vector_type(4)))short;
using f32x16=__attribute__((ext_vector_type(16)))float;
using u32x4=__attribute__((ext_vector_type(4)))unsigned;
constexpr int SEQ=4096,D=64,PIN=3072,POUT=1024;
constexpr int NW=8,QBLK=32,QB=QBLK*NW,KVBLK=64,NQB=SEQ/QB;
__device__ __forceinline__ int crow(int r,int hi){return (r&3)+8*(r>>2)+4*hi;}
#define SBAR() __builtin_amdgcn_sched_barrier(0)
__device__ __forceinline__ void cmask(f32x16&p0,f32x16&p1,int jb,int qrel,int hi){
  const float NEG=-INFINITY; int kb=64*jb+4*hi;
  #pragma unroll
  for(int r=0;r<16;++r){int kv=kb+(r&3)+8*(r>>2); if(kv>qrel)p0[r]=NEG; if(kv+32>qrel)p1[r]=NEG;}
}

constexpr int NSLOT=3, SLOTB=8192;
constexpr int LDS_K=0, LDS_V=NSLOT*SLOTB, LDS_WS=2*NSLOT*SLOTB, LDS_OST=LDS_WS+NW*64*4, LDS_CK=LDS_OST+NW*4096, LDS_BYTES=LDS_CK+SEQ*4;
constexpr float C2=0.125f*1.4426950408889634f;
__device__ __forceinline__ void glds16(const void*gsrc,unsigned lds_dst){unsigned keep;
  asm volatile("s_mov_b32 %0, m0\n\ts_mov_b32 m0, %2\n\ts_nop 0\n\tglobal_load_lds_dwordx4 %1, off\n\ts_mov_b32 m0, %0":"=&s"(keep):"v"(gsrc),"s"(lds_dst):"memory");}
__device__ __forceinline__ float max3f(float a,float b,float c){float r;asm("v_max3_f32 %0, %1, %2, %3":"=v"(r):"v"(a),"v"(b),"v"(c));return r;}
__device__ __forceinline__ float max2f(float a,float b){float r;asm("v_max_f32_e32 %0, %1, %2":"=v"(r):"v"(a),"v"(b));return r;}
__device__ __forceinline__ float fadd_s(float a,float b){float r;asm("v_add_f32_e32 %0, %1, %2":"=v"(r):"v"(a),"v"(b));return r;}
__device__ __forceinline__ float fsub_s(float a,float b){float r;asm("v_sub_f32_e32 %0, %1, %2":"=v"(r):"v"(a),"v"(b));return r;}
typedef float f32x2_t __attribute__((ext_vector_type(2))); typedef float f32x4_t __attribute__((ext_vector_type(4))); typedef __bf16 bf16x2_t __attribute__((ext_vector_type(2)));
__device__ __forceinline__ unsigned cvtpk_s(float lo,float hi){f32x2_t v={lo,hi};bf16x2_t b=__builtin_convertvector(v,bf16x2_t);return __builtin_bit_cast(unsigned,b);}
#define WAIT_BAR(N) asm volatile("s_waitcnt vmcnt(" #N ") lgkmcnt(0)\n\ts_barrier":::"memory")

__device__ __forceinline__ void qkt(f32x16&p0,f32x16&p1,const char*Kslot,const bf16x8*qr,const f32x16&negm,int r32,int hi){
  const char*kb=Kslot+hi*1024+r32*16;
  #pragma unroll
  for(int d0=0;d0<4;++d0){
    const bf16x8 b0=*reinterpret_cast<const bf16x8*>(kb+d0*2048);
    const bf16x8 b1=*reinterpret_cast<const bf16x8*>(kb+d0*2048+512);
    if(d0==0){p0=__builtin_amdgcn_mfma_f32_32x32x16_bf16(b0,qr[0],negm,0,0,0);p1=__builtin_amdgcn_mfma_f32_32x32x16_bf16(b1,qr[0],negm,0,0,0);}
    else{p0=__builtin_amdgcn_mfma_f32_32x32x16_bf16(b0,qr[d0],p0,0,0,0);p1=__builtin_amdgcn_mfma_f32_32x32x16_bf16(b1,qr[d0],p1,0,0,0);}}
}
typedef __attribute__((address_space(3))) const char* lds_cptr;
typedef short v4i16_t __attribute__((ext_vector_type(4)));
__device__ __forceinline__ void kload8(bf16x8*kf,lds_cptr kp){
  kf[0]=*(const __attribute__((address_space(3))) bf16x8*)(kp);      kf[1]=*(const __attribute__((address_space(3))) bf16x8*)(kp+512);
  kf[2]=*(const __attribute__((address_space(3))) bf16x8*)(kp+2048); kf[3]=*(const __attribute__((address_space(3))) bf16x8*)(kp+2560);
  kf[4]=*(const __attribute__((address_space(3))) bf16x8*)(kp+4096); kf[5]=*(const __attribute__((address_space(3))) bf16x8*)(kp+4608);
  kf[6]=*(const __attribute__((address_space(3))) bf16x8*)(kp+6144); kf[7]=*(const __attribute__((address_space(3))) bf16x8*)(kp+6656);
}
__device__ __forceinline__ void kload2(bf16x8*kf,lds_cptr kp,int j){ kf[2*j]=*(const __attribute__((address_space(3))) bf16x8*)(kp+j*2048); kf[2*j+1]=*(const __attribute__((address_space(3))) bf16x8*)(kp+j*2048+512); }
__device__ __forceinline__ s16x4 vtr(lds_cptr p){ return __builtin_bit_cast(s16x4,__builtin_amdgcn_ds_read_tr16_b64_v4i16((__attribute__((address_space(3))) v4i16_t*)p)); }
__device__ __forceinline__ float rowmax(const f32x16&p0,const f32x16&p1){
  float a=max3f(p0[0],p0[1],p1[0]),b=max3f(p0[2],p0[3],p1[1]);a=max3f(a,p1[2],p1[3]);
  #pragma unroll
  for(int r=4;r<16;r+=4){a=max3f(a,p0[r],p0[r+1]);b=max3f(b,p0[r+2],p0[r+3]);a=max3f(a,p1[r],p1[r+1]);b=max3f(b,p1[r+2],p1[r+3]);}
  const float m=max2f(a,b);
  auto rr=__builtin_amdgcn_permlane32_swap(__float_as_uint(m),__float_as_uint(m),false,false);
  return max2f(__uint_as_float(rr[0]),__uint_as_float(rr[1]));
}
__device__ __forceinline__ void pv(f32x16*o,int vb,bf16x8 pa0,bf16x8 pa1,bf16x8 pa2,bf16x8 pa3){
  #pragma unroll
  for(int d0=0;d0<2;++d0){s16x4 lo[4],hi[4];
    #pragma unroll
    for(int ks=0;ks<4;++ks){
      asm volatile("ds_read_b64_tr_b16 %0,%1 offset:%c2":"=&v"(lo[ks]):"v"(vb),"i"(d0*4096+ks*1024):"memory");
      asm volatile("ds_read_b64_tr_b16 %0,%1 offset:%c2":"=&v"(hi[ks]):"v"(vb),"i"(d0*4096+ks*1024+512):"memory");}
    asm volatile("s_waitcnt lgkmcnt(0)":::"memory");SBAR();
    #define PK(k) (bf16x8){lo[k][0],lo[k][1],lo[k][2],lo[k][3],hi[k][0],hi[k][1],hi[k][2],hi[k][3]}
    o[d0]=__builtin_amdgcn_mfma_f32_32x32x16_bf16(pa0,PK(0),o[d0],0,0,0);
    o[d0]=__builtin_amdgcn_mfma_f32_32x32x16_bf16(pa1,PK(1),o[d0],0,0,0);
    o[d0]=__builtin_amdgcn_mfma_f32_32x32x16_bf16(pa2,PK(2),o[d0],0,0,0);
    o[d0]=__builtin_amdgcn_mfma_f32_32x32x16_bf16(pa3,PK(3),o[d0],0,0,0);
    #undef PK
  }
}

#ifndef ATTN_STORE16
#define ATTN_STORE16(p,v) (*(u32x4*)(p)=(v))
#endif
template<int THRL> __device__ __forceinline__ void attn_unit(int b,int h,int qb,const bf16*Q,const bf16*__restrict__ K,const bf16*__restrict__ V,bf16*O,const float*__restrict__ CUMbh,float*__restrict__ SSQh,char*shm){
  int tid_=threadIdx.x; asm volatile("":"+v"(tid_));
  const int tid=tid_,lane=tid&63,r32=lane&31,hi=lane>>5; const int wid=__builtin_amdgcn_readfirstlane(tid>>6);
  const long rowbase=(long)b*SEQ; const int q0=qb*QB;
  const bf16*Qw=Q+(rowbase+q0+wid*QBLK)*PIN+h*D;
  const bf16*Kh=K+rowbase*PIN+h*D,*Vh=V+rowbase*PIN+h*D;
  const unsigned lds0=(unsigned)(uintptr_t)shm;
  const lds_cptr shm3=(lds_cptr)shm;
  float*wsf=(float*)(shm+LDS_WS)+wid*64;
  const bf16*ksrc=Kh+(long)lane*PIN+wid*8;
  const bf16*vsrc=Vh+(long)(16*(wid&3)+(lane>>2))*PIN+(wid>>2)*32+(lane&3)*8;
  const unsigned kdst=lds0+LDS_K+wid*1024, vdst=lds0+LDS_V+wid*1024;
  #define DMA_K(t,slot) glds16(ksrc+(long)(t)*KVBLK*PIN,(unsigned)__builtin_amdgcn_readfirstlane(kdst+(slot)))
  #define DMA_V(t,slot) glds16(vsrc+(long)(t)*KVBLK*PIN,(unsigned)__builtin_amdgcn_readfirstlane(vdst+(slot)))
  const int vb0=(int)(lds0+LDS_V)+((lane>>4)&1)*32+(lane&3)*8+(4*hi+((lane&15)>>2))*64;
  const char*Kbase=shm+LDS_K; bf16x8 kf[8];
  const lds_cptr kp0=shm3+LDS_K+hi*1024+r32*16; const lds_cptr vp0=shm3+LDS_V+((lane>>4)&1)*32+(lane&3)*8+(4*hi+((lane&15)>>2))*64;
  const int NT=(q0+QB)/KVBLK;
  DMA_K(0,0);DMA_V(0,0);DMA_K(1,SLOTB);
  bf16x8 qr[4];
  #pragma unroll
  for(int d0=0;d0<4;++d0)qr[d0]=*reinterpret_cast<const bf16x8*>(&Qw[(long)r32*PIN+d0*16+hi*8]);
  const float cbase=CUMbh[q0]; const float cq=CUMbh[q0+wid*QBLK+r32]-cbase;
  { __attribute__((address_space(3))) float*ckw=(__attribute__((address_space(3))) float*)(shm3+LDS_CK); int s0_=tid; asm volatile("":"+v"(s0_));
    _Pragma("nounroll") for(int s=s0_;s<q0+QB;s+=NW*64)ckw[s]=CUMbh[s]-cbase; }
  const __attribute__((address_space(3))) float*ckp=(const __attribute__((address_space(3))) float*)(shm3+LDS_CK)+4*hi;
  float mhat=-cq,l_reg=0.f;f32x16 o[2];o[0]=f32x16{};o[1]=f32x16{};f32x16 negm;
  #pragma unroll
  for(int r=0;r<16;++r)negm[r]=cq;
  asm volatile("":"+v"(negm));
  const int qrel=wid*QBLK+r32;
  #define BIAS(P0,P1,t) do{ const __attribute__((address_space(3))) float*cp_=ckp+(t)*KVBLK; \
    _Pragma("unroll") for(int g_=0;g_<4;++g_){ const f32x4_t c0_=*(const __attribute__((address_space(3))) f32x4_t*)(cp_+8*g_), c1_=*(const __attribute__((address_space(3))) f32x4_t*)(cp_+32+8*g_); \
      _Pragma("unroll") for(int j_=0;j_<4;++j_){ P0[4*g_+j_]-=c0_[j_]; P1[4*g_+j_]-=c1_[j_]; } SBAR(); } }while(0)
  #define CMASK(P0,P1,t) do{int jb_=(t)-(NT-4); if(jb_>=0)cmask(P0,P1,jb_,qrel,hi);}while(0)
  bool resc=false;
  #define START(P0,P1) do{ const float rm=rowmax(P0,P1); resc=false; \
    { const float dl=rm; mhat=fadd_s(mhat,dl); \
      _Pragma("unroll") for(int r=0;r<16;++r){P0[r]=fsub_s(P0[r],dl);P1[r]=fsub_s(P1[r],dl);} \
      _Pragma("unroll") for(int r=0;r<16;++r)negm[r]=-mhat; asm volatile("":"+v"(negm)); } \
    _Pragma("unroll") for(int r=0;r<16;++r)P0[r]=__builtin_amdgcn_exp2f(P0[r]); }while(0)
  #define RESC() do{ if(resc){ asm volatile("s_waitcnt lgkmcnt(0)":::"memory"); \
      _Pragma("unroll") for(int d_=0;d_<2;++d_) _Pragma("unroll") for(int r=0;r<16;++r)o[d_][r]*=wsf[crow(r,hi)]; } }while(0)
  f32x16 pA0,pA1,pB0,pB1;
  int sl_prev=0,sl_cur=0,sl_next=SLOTB;
  #define ROT() do{sl_prev=sl_cur;sl_cur=sl_next;sl_next=(sl_next==(NSLOT-1)*SLOTB)?0:sl_next+SLOTB;}while(0)
  DMA_K(2,2*SLOTB);
  WAIT_BAR(3);
  qkt(pA0,pA1,Kbase,qr,negm,r32,hi);asm volatile("s_nop 15\n\ts_nop 7":"+v"(pA0),"+v"(pA1));BIAS(pA0,pA1,0);CMASK(pA0,pA1,0);
  START(pA0,pA1);
  _Pragma("unroll") for(int r=0;r<16;++r)pA1[r]=__builtin_amdgcn_exp2f(pA1[r]);
  WAIT_BAR(0);
  DMA_K(3,0);DMA_V(1,SLOTB);
  ROT();
  kload8(kf,kp0+sl_cur);
  WAIT_BAR(2);
  s16x4 vlo[8],vhi[8]; u32x4 pw0,pw1,pw2,pw3;
  #define PKW(P,B) cvtpk_s(P[B],P[B+1])
  #define PAF(k) __builtin_bit_cast(bf16x8,pw##k)
  #define VFR(i) (bf16x8){vlo[i][0],vlo[i][1],vlo[i][2],vlo[i][3],vhi[i][0],vhi[i][1],vhi[i][2],vhi[i][3]}
  #define PIN(x) asm volatile("":"+v"(x))
  #define MX3(a,b,c) __builtin_fmaxf(__builtin_fmaxf((a),(b)),(c))
  #define GAPA(MF,A0,A1,A2,A3,W0,W1,PW) do{ MF; sacc+=A0; sacc+=A1; sacc+=A2; sacc+=A3; PIN(sacc); W0; W1; PIN(PW); SBAR(); }while(0)
  #define EX(v) __builtin_amdgcn_exp2f(v)
  #define GAPB(MF,X,B) do{ MF; X[B]=EX(X[B]); X[B+1]=EX(X[B+1]); X[B+2]=EX(X[B+2]); X[B+3]=EX(X[B+3]); PIN(X); SBAR(); }while(0)
  #define VRD(i) do{ vlo[i]=vtr(vp_+(((i)>>2)*4096+((i)&3)*1024)); vhi[i]=vtr(vp_+(((i)>>2)*4096+((i)&3)*1024+512)); }while(0)
  #define KRD(G,j) do{ if(G){ kload2(kf,kp0+sl_next,j); SBAR(); } }while(0)
  #define STEP(C0,C1,P0,P1,t,GK,GV,GL) do{ SBAR(); \
    const lds_cptr vp_=vp0+sl_prev; \
    VRD(0); SBAR(); float sacc=(P0[0]+P0[1]); \
    GAPA(C0=__builtin_amdgcn_mfma_f32_32x32x16_bf16(kf[0],qr[0],negm,0,0,0), P0[2],P0[3],P0[4],P0[5],     pw0[0]=PKW(P0,0), pw0[1]=PKW(P0,2), pw0); \
    VRD(4); SBAR(); GAPA(C1=__builtin_amdgcn_mfma_f32_32x32x16_bf16(kf[1],qr[0],negm,0,0,0), P0[6],P0[7],P0[8],P0[9],     pw0[2]=PKW(P0,4), pw0[3]=PKW(P0,6), pw0); \
    VRD(1); SBAR(); GAPA(C0=__builtin_amdgcn_mfma_f32_32x32x16_bf16(kf[2],qr[1],C0,0,0,0),   P0[10],P0[11],P0[12],P0[13], pw1[0]=PKW(P0,8), pw1[1]=PKW(P0,10), pw1); \
    VRD(5); SBAR(); GAPA(C1=__builtin_amdgcn_mfma_f32_32x32x16_bf16(kf[3],qr[1],C1,0,0,0),   P0[14],P0[15],P1[0],P1[1],   pw1[2]=PKW(P0,12),pw1[3]=PKW(P0,14), pw1); \
    VRD(2); SBAR(); GAPA(C0=__builtin_amdgcn_mfma_f32_32x32x16_bf16(kf[4],qr[2],C0,0,0,0),   P1[2],P1[3],P1[4],P1[5],     pw2[0]=PKW(P1,0), pw2[1]=PKW(P1,2), pw2); \
    VRD(6); SBAR(); GAPA(C1=__builtin_amdgcn_mfma_f32_32x32x16_bf16(kf[5],qr[2],C1,0,0,0),   P1[6],P1[7],P1[8],P1[9],     pw2[2]=PKW(P1,4), pw2[3]=PKW(P1,6), pw2); \
    VRD(3); SBAR(); GAPA(C0=__builtin_amdgcn_mfma_f32_32x32x16_bf16(kf[6],qr[3],C0,0,0,0),   P1[10],P1[11],P1[12],P1[13], pw3[0]=PKW(P1,8), pw3[1]=PKW(P1,10), pw3); \
    VRD(7); SBAR(); GAPA(C1=__builtin_amdgcn_mfma_f32_32x32x16_bf16(kf[7],qr[3],C1,0,0,0),   P1[14],P1[15],0.f,0.f,       pw3[2]=PKW(P1,12),pw3[3]=PKW(P1,14), pw3); \
    l_reg+=sacc; \
    if(GK){DMA_K((t)+3,sl_cur);} if(GV){DMA_V((t)+1,sl_next);} \
    BIAS(C0,C1,t); CMASK(C0,C1,t); \
    { float a=MX3(C0[0],C0[1],C1[0]),b=MX3(C0[2],C0[3],C1[1]); a=MX3(a,C1[2],C1[3]); \
      _Pragma("unroll") for(int r=4;r<16;r+=4){a=MX3(a,C0[r],C0[r+1]);b=MX3(b,C0[r+2],C0[r+3]);a=MX3(a,C1[r],C1[r+1]);b=MX3(b,C1[r+2],C1[r+3]);} \
      float rm=__builtin_fmaxf(a,b); { auto rr=__builtin_amdgcn_permlane32_swap(__float_as_uint(rm),__float_as_uint(rm),false,false); rm=__builtin_fmaxf(__uint_as_float(rr[0]),__uint_as_float(rr[1])); } \
      resc=false; \
      if(__builtin_expect(__any(rm>(float)THRL),0)){ const float dl=__builtin_fmaxf(rm,0.f); mhat+=dl; \
        _Pragma("unroll") for(int r=0;r<16;++r){C0[r]-=dl;C1[r]-=dl;} \
        _Pragma("unroll") for(int r=0;r<16;++r)negm[r]=-mhat; asm volatile("":"+v"(negm)); \
        const float f=__builtin_amdgcn_exp2f(-dl); l_reg*=f; if(hi==0)wsf[r32]=f; resc=true; } } \
    SBAR(); \
    GAPB(o[0]=__builtin_amdgcn_mfma_f32_32x32x16_bf16(PAF(0),VFR(0),o[0],0,0,0), C0,0); \
    GAPB(o[1]=__builtin_amdgcn_mfma_f32_32x32x16_bf16(PAF(0),VFR(4),o[1],0,0,0), C0,4); \
    KRD(GL,0); GAPB(o[0]=__builtin_amdgcn_mfma_f32_32x32x16_bf16(PAF(1),VFR(1),o[0],0,0,0), C0,8); \
    KRD(GL,1); GAPB(o[1]=__builtin_amdgcn_mfma_f32_32x32x16_bf16(PAF(1),VFR(5),o[1],0,0,0), C0,12); \
    KRD(GL,2); GAPB(o[0]=__builtin_amdgcn_mfma_f32_32x32x16_bf16(PAF(2),VFR(2),o[0],0,0,0), C1,0); \
    KRD(GL,3); GAPB(o[1]=__builtin_amdgcn_mfma_f32_32x32x16_bf16(PAF(2),VFR(6),o[1],0,0,0), C1,4); \
    GAPB(o[0]=__builtin_amdgcn_mfma_f32_32x32x16_bf16(PAF(3),VFR(3),o[0],0,0,0), C1,8); \
    GAPB(o[1]=__builtin_amdgcn_mfma_f32_32x32x16_bf16(PAF(3),VFR(7),o[1],0,0,0), C1,12); \
    }while(0)
  int t=1;
  #undef CMASK
  #define CMASK(P0,P1,t) do{}while(0)
  for(;t+5<NT;t+=2){
    STEP(pB0,pB1,pA0,pA1,t,true,true,true);     WAIT_BAR(2); RESC(); ROT();
    STEP(pA0,pA1,pB0,pB1,t+1,true,true,true);   WAIT_BAR(2); RESC(); ROT();
  }
  #undef CMASK
  #define CMASK(P0,P1,t) do{int jb_=(t)-(NT-4); if(jb_>=0)cmask(P0,P1,jb_,qrel,hi);}while(0)
  #define ENDW(tt) do{ if((tt)+3<NT){WAIT_BAR(2);} else if((tt)+2<NT){WAIT_BAR(1);} else {WAIT_BAR(0);} }while(0)
  for(;t+1<NT;t+=2){
    STEP(pB0,pB1,pA0,pA1,t,(t+3<NT),(t+1<NT),(t+1<NT));       ENDW(t);   RESC(); ROT();
    STEP(pA0,pA1,pB0,pB1,t+1,(t+4<NT),(t+2<NT),(t+2<NT));     ENDW(t+1); RESC(); ROT();
  }
  STEP(pB0,pB1,pA0,pA1,NT-1,false,false,false); RESC();
  { float sacc=pB0[0]+pB0[1]; _Pragma("unroll") for(int r=2;r<16;++r)sacc+=pB0[r]; _Pragma("unroll") for(int r=0;r<16;++r)sacc+=pB1[r]; l_reg+=sacc;
    pw0=(u32x4){PKW(pB0,0),PKW(pB0,2),PKW(pB0,4),PKW(pB0,6)};pw1=(u32x4){PKW(pB0,8),PKW(pB0,10),PKW(pB0,12),PKW(pB0,14)};pw2=(u32x4){PKW(pB1,0),PKW(pB1,2),PKW(pB1,4),PKW(pB1,6)};pw3=(u32x4){PKW(pB1,8),PKW(pB1,10),PKW(pB1,12),PKW(pB1,14)};
    SBAR(); pv(o,vb0+sl_cur,PAF(0),PAF(1),PAF(2),PAF(3)); }
  #undef PKW
  #undef PAF
  #undef VFR
  #undef PIN
  #undef MX3
  #undef GAPA
  #undef GAPB
  #undef EX
  #undef VRD
  #undef KRD
  #undef STEP
  #undef ENDW
  {auto rr=__builtin_amdgcn_permlane32_swap(__float_as_uint(l_reg),__float_as_uint(l_reg),false,false);l_reg=__uint_as_float(rr[0])+__uint_as_float(rr[1]);}
  if(hi==0)wsf[32+r32]=l_reg;asm volatile("s_waitcnt lgkmcnt(0)":::"memory");
  float rli[16];
  #pragma unroll
  for(int r=0;r<16;++r)rli[r]=__builtin_amdgcn_rcpf(wsf[32+crow(r,hi)]);
  bf16*Ow=O+(rowbase+q0+wid*QBLK)*POUT+h*D; float*Sw=SSQh+(rowbase+q0+wid*QBLK)*16;
  { bf16*stg=(bf16*)(shm+LDS_OST)+wid*2048;
    #pragma unroll
    for(int r=0;r<16;++r){const int orow=crow(r,hi);
      #pragma unroll
      for(int d0=0;d0<2;++d0)stg[orow*64+d0*32+r32]=__float2bfloat16(o[d0][r]*rli[r]);}
    asm volatile("s_waitcnt lgkmcnt(0)":::"memory");
    #pragma unroll
    for(int i=0;i<4;++i){const int row=i*8+(lane>>3),ch=lane&7; const u32x4 v=*(const u32x4*)(stg+row*64+ch*8); ATTN_STORE16(Ow+(long)row*POUT+ch*8,v);
      float sq=0.f;
      #pragma unroll
      for(int w_=0;w_<4;++w_){const float lo_=__uint_as_float(v[w_]<<16),hi_=__uint_as_float(v[w_]&0xffff0000u);sq+=lo_*lo_+hi_*hi_;}
      sq+=__shfl_xor(sq,1);sq+=__shfl_xor(sq,2);sq+=__shfl_xor(sq,4); if(ch==0)Sw[row*16]=sq;} }
  asm volatile("s_waitcnt lgkmcnt(0)\n\ts_barrier":::"memory");
  #undef DMA_K
  #undef DMA_V
  #undef CMASK
  #undef BIAS
  #undef START
  #undef RESC
  #undef ROT
}
constexpr int ATTN_LDS_BYTES=LDS_BYTES;

__device__ __forceinline__ void sb_unit(int b,int h,int qb,const bf16*Q,const bf16*__restrict__ K,const bf16*__restrict__ V,bf16*O,float*__restrict__ SSQh,char*shm){
  int tid_=threadIdx.x; asm volatile("":"+v"(tid_));
  const int tid=tid_,lane=tid&63,r32=lane&31,hi=lane>>5; const int wid=__builtin_amdgcn_readfirstlane(tid>>6);
  const long rowbase=(long)b*SEQ; const int q0=qb*QB;
  const bf16*Qw=Q+(rowbase+q0+wid*QBLK)*PIN+h*D;
  const bf16*Kh=K+rowbase*PIN+h*D,*Vh=V+rowbase*PIN+h*D;
  const unsigned lds0=(unsigned)(uintptr_t)shm;
  const bf16*ksrc=Kh+(long)lane*PIN+wid*8;
  const bf16*vsrc=Vh+(long)(16*(wid&3)+(lane>>2))*PIN+(wid>>2)*32+(lane&3)*8;
  const unsigned kdst=lds0+LDS_K+wid*1024, vdst=lds0+LDS_V+wid*1024;
  const int vb0=(int)(lds0+LDS_V)+((lane>>4)&1)*32+(lane&3)*8+(4*hi+((lane&15)>>2))*64;
  const char*Kbase=shm+LDS_K;
  const int NT=(q0+QB)/KVBLK;
  #define SB_DMA(i,slot) do{ const long kt_=(long)(NT-1-(i)); glds16(ksrc+kt_*KVBLK*PIN,(unsigned)__builtin_amdgcn_readfirstlane(kdst+(slot))); glds16(vsrc+kt_*KVBLK*PIN,(unsigned)__builtin_amdgcn_readfirstlane(vdst+(slot))); }while(0)
  bf16x8 qr[4];
  #pragma unroll
  for(int d0=0;d0<4;++d0)qr[d0]=*reinterpret_cast<const bf16x8*>(&Qw[(long)r32*PIN+d0*16+hi*8]);
  SB_DMA(0,0); SB_DMA(1,SLOTB);
  f32x16 o[2];o[0]=f32x16{};o[1]=f32x16{};
  float Rc=1.f;
  const int qrel=wid*QBLK+r32;
  int sl_cur=0,sl_n1=SLOTB,sl_n2=2*SLOTB;
  volatile __attribute__((address_space(3))) unsigned*flg=(volatile __attribute__((address_space(3))) unsigned*)((lds_cptr)shm+LDS_WS);
  for(int i=0;i<NT;++i){
    if(i+1<NT){WAIT_BAR(2);}else{WAIT_BAR(0);}
    if(i>0){ const int pb=((i-1)&1)*8; unsigned all_=flg[pb]&flg[pb+1]&flg[pb+2]&flg[pb+3]&flg[pb+4]&flg[pb+5]&flg[pb+6]&flg[pb+7]; if(__builtin_amdgcn_readfirstlane(all_))break; }
    if(i+2<NT)SB_DMA(i+2,sl_n2);
    f32x16 p0,p1; { f32x16 z=f32x16{}; asm volatile("":"+v"(z)); qkt(p0,p1,Kbase+sl_cur,qr,z,r32,hi); }
    f32x16 s0,s1;
    #pragma unroll
    for(int r=0;r<16;++r){
      const float za=__builtin_amdgcn_fmed3f(p0[r],-100.f,100.f), zb=__builtin_amdgcn_fmed3f(p1[r],-100.f,100.f);
      p0[r]=__builtin_amdgcn_exp2f(za); p1[r]=__builtin_amdgcn_exp2f(zb);
      s0[r]=__builtin_amdgcn_rcpf(1.f+p0[r]); s1[r]=__builtin_amdgcn_rcpf(1.f+p1[r]); }
    if(i<4){
      const int kb=64*(3-i)+4*hi;
      #pragma unroll
      for(int r=0;r<16;++r){ const int kv=kb+(r&3)+8*(r>>2); if(kv>=qrel){p0[r]=0.f;s0[r]=1.f;} if(kv+32>=qrel){p1[r]=0.f;s1[r]=1.f;} }
    }
    float gp[8],pp[8];
    #pragma unroll
    for(int g=0;g<4;++g){
      s0[4*g+2]*=s0[4*g+3]; s0[4*g+1]*=s0[4*g+2]; s0[4*g]*=s0[4*g+1]; gp[g]=s0[4*g];
      s1[4*g+2]*=s1[4*g+3]; s1[4*g+1]*=s1[4*g+2]; s1[4*g]*=s1[4*g+1]; gp[4+g]=s1[4*g]; }
    #pragma unroll
    for(int g=0;g<8;++g){ auto rr=__builtin_amdgcn_permlane32_swap(__float_as_uint(gp[g]),__float_as_uint(gp[g]),false,false); pp[g]=__uint_as_float(hi?rr[0]:rr[1]); }
    float st=Rc, outer[8];
    #pragma unroll
    for(int g=7;g>=0;--g){ outer[g]=hi?st:st*pp[g]; st=st*(gp[g]*pp[g]); }
    Rc=st;
    { const unsigned dn=__all(Rc==0.f)?1u:0u; if(lane==0)flg[(i&1)*8+wid]=dn; }
    #pragma unroll
    for(int r=0;r<16;++r){ p0[r]=p0[r]*(s0[r]*outer[r>>2]); p1[r]=p1[r]*(s1[r]*outer[4+(r>>2)]); }
    u32x4 pw0,pw1,pw2,pw3;
    pw0=(u32x4){cvtpk_s(p0[0],p0[1]),cvtpk_s(p0[2],p0[3]),cvtpk_s(p0[4],p0[5]),cvtpk_s(p0[6],p0[7])};
    pw1=(u32x4){cvtpk_s(p0[8],p0[9]),cvtpk_s(p0[10],p0[11]),cvtpk_s(p0[12],p0[13]),cvtpk_s(p0[14],p0[15])};
    pw2=(u32x4){cvtpk_s(p1[0],p1[1]),cvtpk_s(p1[2],p1[3]),cvtpk_s(p1[4],p1[5]),cvtpk_s(p1[6],p1[7])};
    pw3=(u32x4){cvtpk_s(p1[8],p1[9]),cvtpk_s(p1[10],p1[11]),cvtpk_s(p1[12],p1[13]),cvtpk_s(p1[14],p1[15])};
    SBAR(); pv(o,vb0+sl_cur,__builtin_bit_cast(bf16x8,pw0),__builtin_bit_cast(bf16x8,pw1),__builtin_bit_cast(bf16x8,pw2),__builtin_bit_cast(bf16x8,pw3));
    { const int t_=sl_cur; sl_cur=sl_n1; sl_n1=sl_n2; sl_n2=t_; }
  }
  #undef SB_DMA
  bf16*Ow=O+(rowbase+q0+wid*QBLK)*POUT+h*D; float*Sw=SSQh+(rowbase+q0+wid*QBLK)*16;
  { bf16*stg=(bf16*)(shm+LDS_OST)+wid*2048;
    #pragma unroll
    for(int r=0;r<16;++r){const int orow=crow(r,hi);
      #pragma unroll
      for(int d0=0;d0<2;++d0)stg[orow*64+d0*32+r32]=__float2bfloat16(o[d0][r]);}
    asm volatile("s_waitcnt lgkmcnt(0)":::"memory");
    #pragma unroll
    for(int i=0;i<4;++i){const int row=i*8+(lane>>3),ch=lane&7; const u32x4 v=*(const u32x4*)(stg+row*64+ch*8); ATTN_STORE16(Ow+(long)row*POUT+ch*8,v);
      float sq=0.f;
      #pragma unroll
      for(int w_=0;w_<4;++w_){const float lo_=__uint_as_float(v[w_]<<16),hi_=__uint_as_float(v[w_]&0xffff0000u);sq+=lo_*lo_+hi_*hi_;}
      sq+=__shfl_xor(sq,1);sq+=__shfl_xor(sq,2);sq+=__shfl_xor(sq,4); if(ch==0)Sw[row*16]=sq;} }
  asm volatile("s_waitcnt vmcnt(0) lgkmcnt(0)\n\ts_barrier":::"memory");
}
template<int THRL=8> __device__ __forceinline__ void attn_phase(char*lds,const bf16*PROJ,const float*CUM,bf16*OMIX,float*SSQ,int vcu){
  const int bh=vcu>>3,s=vcu&7,b=bh>>3,h=bh&7;
  if(bh>=32)return;
  for(int i=(REP_PHASE==9?-2:0);i<(REP_PHASE==10?6:4);++i){ const int qb=(i&1)?15-s:s;
    if(i<2)attn_unit<THRL>(b,h,qb,PROJ,PROJ+512,PROJ+1024,OMIX,CUM+(size_t)bh*SEQ,SSQ+h,lds);
    else   sb_unit(b,h,qb,PROJ+1536,PROJ+2048,PROJ+2560,OMIX+512,SSQ+8+h,lds); }
}

#undef SBAR
#undef WAIT_BAR
}
__global__ void __launch_bounds__(NTHREADS, 2) mega_fwd(Args a) {
    extern __shared__ __attribute__((aligned(16))) unsigned char lds[];
    LAS unsigned char* L = (LAS unsigned char*)lds;
    volatile LAS unsigned* MISC = (volatile LAS unsigned*)(L + MISC_OFF);
    const int tid = threadIdx.x, lane = tid & 63, wave = __builtin_amdgcn_readfirstlane(tid >> 6);
    const int G = gridDim.x, bx = blockIdx.x, vcu = (G % 8 == 0) ? (bx % 8) * (G / 8) + bx / 8 : bx;
    const int gw = vcu * NWAVES + wave, NGW = G * NWAVES;
    unsigned char* ws = a.ws;
    unsigned* CTL = (unsigned*)(ws + WS_CTL);
    bf16_t* WINT = (bf16_t*)(ws + WS_WINT); bf16_t* WOUTT = (bf16_t*)(ws + WS_WOUTT); float* WR = (float*)(ws + WS_WR); float* CUM = (float*)(ws + WS_CUM);
    float* SSQ = (float*)(ws + WS_SSQ); float* RSTD2 = (float*)(ws + WS_RSTD2); float* RW = (float*)(ws + WS_RW); int* SLOTEP = (int*)(ws + WS_SLOTEP); int* TBG = (int*)(ws + WS_TBG); int* LIST = (int*)(ws + WS_LIST); float* FLOG = (float*)(ws + WS_FLOG);
    bf16_t* XN = (bf16_t*)(ws + WS_XN); bf16_t* PROJ = (bf16_t*)(ws + WS_PROJ); bf16_t* OMIX = (bf16_t*)(ws + WS_OMIX); bf16_t* X1B = (bf16_t*)(ws + WS_X1B);
    bf16_t* W1T = (bf16_t*)(ws + WS_W1T); bf16_t* W2T = (bf16_t*)(ws + WS_W2T); bf16_t* H = (bf16_t*)(ws + WS_H); bf16_t* Y = (bf16_t*)(ws + WS_Y);
    unsigned* CNT = CTL + CW_CNT;
    for (int u = tid; u < (LDS_BYTES - LDSCTL_OFF) / 4; u += NTHREADS) ((LAS unsigned*)(L + LDSCTL_OFF))[u] = 0u;
    __syncthreads();
    XcdBarrier bar = xcd_barrier_post(CTL + CW_BAR, MISC + 8);

    REPS(0) {
        LAS float* scr = (LAS float*)(L + RING_OFF + wave * 8448);
        LAS float* wf = (LAS float*)(L + RING_OFF + 98304);
        for (int i = tid; i < DM * 8; i += NTHREADS) { const int k = i >> 3; wf[i] = a.w_in[(size_t)k * WIN_N + 1536 + (i & 7)] * a.g1[k]; }
        LDS_WAIT(); __syncthreads();
        constexpr int I_IN = (DM / 64) * (NPROJ / 32), I_OUT = (DM / 64) * (DM / 32), I_W1 = (DM / 64) * (2048 / 32), I_W2 = (DM / 64) * (DM / 32);
        constexpr int NITEMS = I_IN + I_OUT + NE * I_W1 + NE * I_W2;
        for (int it = gw; it < NITEMS; it += NGW) {
            int r = it;
            if (r < I_IN) { transpose_item(a.w_in, DM, WIN_N, NPROJ, 1, a.g1, nullptr, DM, WINT, scr, r, lane); continue; } r -= I_IN;
            if (r < I_OUT) { transpose_item(a.w_out, DM, DM, DM, 0, a.g_fox, a.g_sb, GW, WOUTT, scr, r, lane); continue; } r -= I_OUT;
            if (r < NE * I_W1) { const int e = r / I_W1; transpose_item(a.w1 + (size_t)e * DM * 2048, DM, 2048, 2048, 2, a.g2, nullptr, DM, W1T + (size_t)e * 2048 * DM, scr, r % I_W1, lane); continue; } r -= NE * I_W1;
            { const int e = r / I_W2; transpose_item(a.w2 + (size_t)e * DM * DM, DM, DM, DM, 0, nullptr, nullptr, DM, W2T + (size_t)e * DM * DM, scr, r % I_W2, lane); }
        }
        for (int i = gw * 64 + lane; i < DM * NE; i += NGW * 64) WR[i] = a.w_router[i] * a.g2[i >> 5];
        for (int row = gw; row < M; row += NGW) rms1_row(a.x, wf, a.b_f, XN, FLOG, row, lane);
    }
    xcd_barrier(bar); if (REP_PHASE == 8) xcd_barrier(bar);
    REPS(1) {
    if (vcu < NB * NH) cumsum_wg(FLOG, CUM, vcu, (LAS float*)(L + RING_OFF));
    if (OPT_GEMM) {
        pg8::Gemm g{XN, WINT, DM}; pg8::StaticOrder S; S.init(M, NPROJ, G, bx); pg8::EpiProj E{PROJ};
        pg8::gemm_phase<pg8::EpiProj, pg8::StaticOrder, true, false>(L + RING_OFF, g, S, E);
    } else { for (int it = gw; it < (M / 16) * (NPROJ / 64); it += NGW) nv_inproj(XN, WINT, PROJ, it, lane); }
    }
    xcd_barrier(bar); if (REP_PHASE == 8) xcd_barrier(bar);
    REPS(2) if (OPT_ATTN) {
        static_assert(attn_body::ATTN_LDS_BYTES <= RING_BYTES, "attention scratch inside the ring region");
        attn_body::attn_phase<8>((char*)lds + RING_OFF, (const attn_body::bf16*)PROJ, CUM, (attn_body::bf16*)OMIX, SSQ, vcu);
    } else {
        LAS unsigned char* wl = L + RING_OFF + wave * 16640;
        for (int u = gw; u < 4096; u += NGW) {
            const int i = u >> 11, idx = u & 2047, type = idx & 1, bh = (idx >> 1) & 31, j = (idx >> 6) & 31; const int qblk = (i == 0) ? j : 63 - j;
            if (type == 0) nv_attn<0>(PROJ, CUM, OMIX, SSQ, bh, qblk, lane, wl); else nv_attn<1>(PROJ, CUM, OMIX, SSQ, bh, qblk, lane, wl);
        }
    }
    xcd_barrier(bar); if (REP_PHASE == 8) xcd_barrier(bar);
    REPS(3) if (OPT_GEMM) {
        pg8::Gemm g{OMIX, WOUTT, DM}; pg8::StaticOrder S; S.init(M, DM, G, bx);
        LAS float* ratio = (LAS float*)(L + TAB_OFF); LAS float* rsb = (LAS float*)(L + TAB_OFF + 1024);
        pg8::Unit u0;
        if (S.next(0, u0) && tid < 256) { const float* sp = SSQ + (size_t)(u0.pm * 256 + tid) * 16; float sf = 0.f, s2 = 0.f;
#pragma unroll
            for (int h = 0; h < 8; ++h) { sf += sp[h]; s2 += sp[8 + h]; }
            const float rf = rsqrtf(sf * (1.f / GW) + EPS), rs = rsqrtf(s2 * (1.f / GW) + EPS); ratio[tid] = rf / rs; rsb[tid] = rs; }
        VM_WAIT(); LDS_WAIT(); __syncthreads();
        pg8::EpiWout E{a.x, a.out, X1B, ratio, rsb};
        pg8::gemm_phase<pg8::EpiWout, pg8::StaticOrder, false, false>(L + RING_OFF, g, S, E);
    } else { for (int it = gw; it < (M / 16) * (DM / 64); it += NGW) nv_wout(OMIX, WOUTT, SSQ, a.x, a.out, X1B, it, lane); }
    xcd_barrier(bar); if (REP_PHASE == 8) xcd_barrier(bar);
    if (REP_PHASE == 4) { for (int t64 = vcu; t64 < M / 64; t64 += G) router_wg(a.out, WR, a.b_router, (float*)H, (float*)H + M, (int*)Y, (int*)Y + NE * LIST_CAP, CNT + 64, t64 * 64, L + RING_OFF); }
    if (OPT_ROUTER) { for (int t64 = vcu; t64 < M / 64; t64 += G) router_wg(a.out, WR, a.b_router, RSTD2, RW, LIST, SLOTEP, CNT, t64 * 64, L + RING_OFF); }
    else { for (int it = gw; it < M / 2; it += NGW) nv_router(a.out, WR, a.b_router, RSTD2, RW, LIST, SLOTEP, CNT, it, lane); }
    xcd_barrier(bar); if (REP_PHASE == 8) xcd_barrier(bar);
    LAS int* tb = (LAS int*)(L + TB_OFF); LAS int* tbE = tb + 64; LAS int* tbC = tb + 128; LAS int* cntl = tb + 192; LAS int* udl = tb + 224; LAS int* tabA = (LAS int*)(L + TAB_OFF); LAS int* tabB = (LAS int*)(L + TAB2_OFF);
    REPS(5) if (OPT_GEMM) {
        if (tid == 0) { int run = 0, runE = 0, runC = 0; for (int e = 0; e < NE; ++e) { const int cn = (int)CNT[e], nt = (cn + 255) >> 8, rem = cn & 255, ch = (rem != 0 && rem <= 128) ? 1 : 0;
                tb[e] = run; tbE[e] = runE; tbC[e] = runC; cntl[e] = cn; run += nt; runE += nt - ch; runC += ch; } tb[NE] = run; tbE[NE] = runE; tbC[NE] = runC; }
        LDS_WAIT(); __syncthreads();
        if (bx == 0 && tid <= NE) TBG[tid] = tb[tid];
        pg8::MoeOrder S{8, bx, tb, tbE, tbC, cntl, tabA}; pg8::Unit u; int nun = 0;
        for (int ui = 0; S.next(ui, u); ++ui) { const int e = u.pn >> 3, mt = u.pm - tb[e], cnt = (int)CNT[e]; nun = ui + 1;
            if (tid == 0) { udl[3 * ui] = u.pm; udl[3 * ui + 1] = u.pn; udl[3 * ui + 2] = u.nr; }
            if (tid < 256) { const int p = mt * 256 + tid; const int slot = LIST[(size_t)e * LIST_CAP + (p < cnt ? p : cnt - 1)]; tabA[ui * 256 + tid] = slot >> 2; ((LAS float*)tabB)[ui * 256 + tid] = RSTD2[slot >> 2]; } }
        VM_WAIT(); LDS_WAIT(); __syncthreads();
        pg8::Gemm g{X1B, W1T, DM}; pg8::EpiMoe1 E{H, a.b1, (const LAS float*)tabB}; pg8::ListOrder SL{udl, nun, tabA};
        pg8::gemm_phase<pg8::EpiMoe1, pg8::ListOrder, true, true>(L + RING_OFF, g, SL, E);
        if (REP_PHASE == 11) { pg8::Gemm g2{H, W1T, DM}; pg8::EpiMoe1 E2{Y, a.b1, (const LAS float*)tabB}; pg8::gemm_phase<pg8::EpiMoe1, pg8::MoeOrder, true, false>(L + RING_OFF, g2, S, E2); }
        if (REP_PHASE == 14) { pg8::Gemm g2{XN, W1T, DM}; pg8::EpiNull E2{(float*)Y}; pg8::MoeOrder S2 = S; S2.probe = 1; pg8::gemm_phase<pg8::EpiNull, pg8::MoeOrder, true, false>(L + RING_OFF, g2, S2, E2); }
        if (REP_PHASE == 12 || REP_PHASE == 13) { pg8::Gemm g2{XN, W1T, DM}; pg8::EpiMoe1 E2{Y, a.b1, (const LAS float*)tabB}; pg8::MoeOrder S2 = S; S2.probe = (REP_PHASE == 13) ? 2 : 1; pg8::gemm_phase<pg8::EpiMoe1, pg8::MoeOrder, true, false>(L + RING_OFF, g2, S2, E2); }
    } else {
    for (int g = gw; g < MAX_TILES * 16; g += NGW) {
        int e, base, p0, cnt; if (!moe_tile(CNT, g, e, base, p0, cnt)) continue;
        for (int cg = 0; cg < DFF / 32; ++cg) nv_moe1(X1B, W1T, a.b1, RSTD2, LIST, H, e, base, p0, cnt, cg, lane);
    } }
    xcd_barrier(bar); if (REP_PHASE == 8) xcd_barrier(bar);
    REPS(6) if (OPT_GEMM) {
        pg8::MoeOrder S{4, bx, tb, tbE, tbC, cntl, tabA}; pg8::Unit u; int nun = 0;
        for (int ui = 0; S.next(ui, u); ++ui) { const int e = u.pn >> 2, mt = u.pm - tb[e], cnt = (int)CNT[e]; nun = ui + 1;
            if (tid == 0) { udl[3 * ui] = u.pm; udl[3 * ui + 1] = u.pn; udl[3 * ui + 2] = u.nr; }
            if (tid < 256) { const int p = mt * 256 + tid; const int slot = LIST[(size_t)e * LIST_CAP + (p < cnt ? p : cnt - 1)]; ((LAS float*)tabB)[ui * 256 + tid] = RW[slot]; } }
        VM_WAIT(); LDS_WAIT(); __syncthreads();
        pg8::Gemm g{H, W2T, DM}; pg8::EpiMoe2 E{Y, a.b2, (const LAS float*)tabB}; pg8::ListOrder SL{udl, nun, tabA};
        pg8::gemm_phase<pg8::EpiMoe2, pg8::ListOrder, true, false>(L + RING_OFF, g, SL, E);
    } else {
    for (int g = gw; g < MAX_TILES * 16; g += NGW) {
        int e, base, p0, cnt; if (!moe_tile(CNT, g, e, base, p0, cnt)) continue;
        for (int cg = 0; cg < DM / 64; ++cg) nv_moe2(H, W2T, a.b2, RW, LIST, Y, e, base, p0, cnt, cg, lane);
    } }
    xcd_barrier(bar); if (REP_PHASE == 8) xcd_barrier(bar);
    if (REP_PHASE == 7) { for (int row = gw; row < M; row += NGW) final_row(a.out, Y, SLOTEP, TBG, a.gf, (float*)H, row, lane); }
    for (int row = gw; row < M; row += NGW) final_row(a.out, Y, SLOTEP, TBG, a.gf, a.out, row, lane);
}

extern "C" void kernel_launch(void* const* d_in, const int* in_sizes, int n_in, void* d_out, int out_size, void* d_ws, size_t ws_size, hipStream_t stream) {
    static int grid = 0;
    if (grid == 0) {
        if (n_in != 15 || in_sizes[0] != M * DM || out_size != M * DM || ws_size < WS_END) {
            fprintf(stderr, "kernel_launch: unexpected shapes / workspace (n_in %d, in0 %d, out %d, ws %zu, need %zu)\n", n_in, n_in > 0 ? in_sizes[0] : -1, out_size, ws_size, (size_t)WS_END); grid = -1; return; }
        int dev = 0, cus = 0, per_cu = 0;
        if (hipGetDevice(&dev) != hipSuccess || hipDeviceGetAttribute(&cus, hipDeviceAttributeMultiprocessorCount, dev) != hipSuccess) { grid = -1; return; }
        if (hipFuncSetAttribute((const void*)mega_fwd, hipFuncAttributeMaxDynamicSharedMemorySize, LDS_BYTES) != hipSuccess) { fprintf(stderr, "kernel_launch: hipFuncSetAttribute failed\n"); grid = -1; return; }
        if (hipOccupancyMaxActiveBlocksPerMultiprocessor(&per_cu, (const void*)mega_fwd, NTHREADS, LDS_BYTES) != hipSuccess || per_cu < 1) fprintf(stderr, "kernel_launch: occupancy query reports %d\n", per_cu);
        (void)hipGetLastError();
        grid = cus;
    }
    if (grid < 0) return;
    if (hipMemsetAsync((char*)d_ws + WS_CTL, 0, CTL_BYTES, stream) != hipSuccess) return;
    Args a{};
    a.x = (const float*)d_in[0]; a.g1 = (const float*)d_in[1]; a.w_in = (const float*)d_in[2]; a.b_f = (const float*)d_in[3]; a.g_fox = (const float*)d_in[4]; a.g_sb = (const float*)d_in[5];
    a.w_out = (const float*)d_in[6]; a.g2 = (const float*)d_in[7]; a.w_router = (const float*)d_in[8]; a.b_router = (const float*)d_in[9]; a.w1 = (const float*)d_in[10]; a.b1 = (const float*)d_in[11];
    a.w2 = (const float*)d_in[12]; a.b2 = (const float*)d_in[13]; a.gf = (const float*)d_in[14];
    a.out = (float*)d_out; a.ws = (unsigned char*)d_ws;
    hipLaunchKernelGGL(mega_fwd, dim3(grid), dim3(NTHREADS), LDS_BYTES, stream, a);
    const hipError_t le = hipPeekAtLastError();
    if (le != hipSuccess) fprintf(stderr, "kernel_launch: launch failed: %s\n", hipGetErrorName(le));
}
```

```cpp
#include <hip/hip_runtime.h>
#include <cstdio>
#include <cstdint>

typedef unsigned short bf16_t;
typedef short bf16x8 __attribute__((ext_vector_type(8)));
typedef float f32x4 __attribute__((ext_vector_type(4)));

constexpr int NB = 4, SEQ = 4096, DM = 1024, M = NB * SEQ;
constexpr int NH = 8, HD = 64, GW = 512;
constexpr int WIN_N = 3080, NPROJ = 3072;
constexpr int NE = 32, TOPK = 4, DFF = 1024;
constexpr float EPS = 1e-5f;
constexpr float LOG2E = 1.4426950408889634f;
constexpr float C2 = 0.125f * LOG2E;
constexpr int LIST_CAP = M;
constexpr int MAX_TILES = (M * TOPK) / 256 + NE;

constexpr size_t MiB = 1u << 20;
constexpr size_t WS_CTL = 0, CTL_BYTES = 1 * MiB;
constexpr size_t WS_WINT = 2 * MiB;
constexpr size_t WS_WOUTT = 8 * MiB;
constexpr size_t WS_WR = 10 * MiB;
constexpr size_t WS_CUM = 11 * MiB;
constexpr size_t WS_SSQ = 12 * MiB;
constexpr size_t WS_RSTD2 = 14 * MiB;
constexpr size_t WS_RW = 15 * MiB;
constexpr size_t WS_SLOTEP = 15 * MiB + 512 * 1024;
constexpr size_t WS_TBG = 14 * MiB + 512 * 1024;
constexpr size_t WS_LIST = 16 * MiB;
constexpr size_t WS_FLOG = 18 * MiB;
constexpr size_t WS_XN = 32 * MiB;
constexpr size_t WS_PROJ = 64 * MiB;
constexpr size_t WS_OMIX = 160 * MiB;
constexpr size_t WS_X1B = 192 * MiB;
constexpr size_t WS_W1T = 224 * MiB;
constexpr size_t WS_W2T = 352 * MiB;
constexpr size_t WS_H = 416 * MiB;
constexpr size_t WS_Y = 560 * MiB;
constexpr size_t WS_END = 704 * MiB;
constexpr int CW_CNT = 1024;

__device__ __forceinline__ unsigned short f2bf(float f) { unsigned u = __float_as_uint(f); return (unsigned short)((u + 0x7fffu + ((u >> 16) & 1u)) >> 16); }
__device__ __forceinline__ float bf2f(unsigned short b) { return __uint_as_float(((unsigned)b) << 16); }
__device__ __forceinline__ float wave_sum(float v) {
#pragma unroll
    for (int o = 1; o < 64; o <<= 1) v += __shfl_xor(v, o);
    return v;
}


#define LAS __attribute__((address_space(3)))
#define GAS __attribute__((address_space(1)))
typedef unsigned v4u __attribute__((ext_vector_type(4)));
#define LDS_WAIT() asm volatile("s_waitcnt lgkmcnt(0)" ::: "memory")
#define VM_WAIT() asm volatile("s_waitcnt vmcnt(0)" ::: "memory")
constexpr int NWAVES = 8, NTHREADS = NWAVES * 64;
constexpr int REP_PHASE = -1;
#define REPS(k) for (int rep_ = 0; rep_ < ((REP_PHASE == (k)) ? 2 : 1); ++rep_)
constexpr int CVT_SPLIT = 24 * 512;
constexpr bool OVERLAP_CVT = true;
constexpr bool OPT_GEMM = true;
constexpr bool OPT_ROUTER = true;
constexpr bool OPT_ATTN = true;

#define XB_TMO      128
#define XB_XCNT(j)  (256  + 64 * (j))
#define XB_XSUB(j)  (1280 + 64 * (j))
#define XB_XGEN(j)  (2304 + 64 * (j))
#define XB_TOP      3328
#define XB_TOPGEN   3392
#define XCD_BAR_WORDS 3456
#define XB_SPIN_CAP (1u << 20)
__device__ __forceinline__ unsigned xb_ld(unsigned* p)              { return __hip_atomic_load(p, __ATOMIC_RELAXED, __HIP_MEMORY_SCOPE_AGENT); }
__device__ __forceinline__ unsigned xb_add(unsigned* p, unsigned v) { return __hip_atomic_fetch_add(p, v, __ATOMIC_RELAXED, __HIP_MEMORY_SCOPE_AGENT); }
__device__ __forceinline__ unsigned xb_xcc_id() { return (unsigned)__builtin_amdgcn_s_getreg((3 << 11) | 20) & 0xFu; }
#define XB_SPIN(cond, bar) do { unsigned _sp = 0; while (cond) { __builtin_amdgcn_s_sleep(1); \
    if ((++_sp & 255u) == 0u) { if (xb_ld(&(bar)[XB_TMO])) break; if (_sp > XB_SPIN_CAP) { atomicAdd(&(bar)[XB_TMO], 1u); break; } } } } while (0)
struct XcdBarrier { unsigned* bar; unsigned x; volatile LAS unsigned* st; };
__device__ __forceinline__ XcdBarrier xcd_barrier_post(unsigned* bar, volatile LAS unsigned* st) {
    XcdBarrier b; b.bar = bar; b.x = xb_xcc_id(); b.st = st;
    if (threadIdx.x == 0) (void)xb_add(&bar[XB_XCNT(b.x)], 1u);
    return b;
}
__device__ __forceinline__ void xcd_barrier_complete(unsigned* bar, unsigned x, unsigned& nloc, unsigned& nx) {
    const unsigned G = gridDim.x * gridDim.y * gridDim.z;
    unsigned sum, cnt, mine, sp = 0u;
    for (;;) {
        sum = 0u; cnt = 0u; mine = 0u;
#pragma unroll
        for (unsigned j = 0; j < 16; ++j) { const unsigned c = xb_ld(&bar[XB_XCNT(j)]); sum += c; cnt += (c > 0u) ? 1u : 0u; mine = (j == x) ? c : mine; }
        if (sum == G) break;
        __builtin_amdgcn_s_sleep(1);
        if ((++sp & 255u) == 0u) { if (xb_ld(&bar[XB_TMO])) break; if (sp > XB_SPIN_CAP) { atomicAdd(&bar[XB_TMO], 1u); break; } }
    }
    nloc = mine > 0u ? mine : 1u; nx = cnt > 0u ? cnt : 1u;
}
__device__ __forceinline__ void xcd_barrier(const XcdBarrier& b) {
    asm volatile("s_waitcnt vmcnt(0)" ::: "memory");
    __syncthreads();
    if (threadIdx.x == 0) {
        unsigned* bar = b.bar;
        __builtin_amdgcn_s_waitcnt(0);
        unsigned nloc = b.st[0], nx = b.st[1];
        if (nloc == 0u) { xcd_barrier_complete(bar, b.x, nloc, nx); b.st[0] = nloc; b.st[1] = nx; }
        const unsigned old = xb_add(&bar[XB_XSUB(b.x)], 1u);
        const unsigned gen = old / nloc;
        if (old + 1u == (gen + 1u) * nloc) {
            __builtin_amdgcn_fence(__ATOMIC_RELEASE, "agent");
            asm volatile("s_waitcnt vmcnt(0)" ::: "memory");
            const unsigned og = xb_add(&bar[XB_TOP], 1u);
            const unsigned tg = og / nx;
            if (og + 1u == (tg + 1u) * nx) xb_add(&bar[XB_TOPGEN], 1u);
            else XB_SPIN(xb_ld(&bar[XB_TOPGEN]) == tg, bar);
            __builtin_amdgcn_fence(__ATOMIC_ACQUIRE, "agent");
            xb_add(&bar[XB_XGEN(b.x)], 1u);
            asm volatile("s_waitcnt vmcnt(0)" ::: "memory");
        } else {
            XB_SPIN(xb_ld(&bar[XB_XGEN(b.x)]) == gen, bar);
            __builtin_amdgcn_fence(__ATOMIC_ACQUIRE, "agent");
            asm volatile("s_waitcnt vmcnt(0)" ::: "memory");
        }
    }
    __syncthreads();
}

constexpr int RING_OFF = 0, RING_BYTES = 131072;
constexpr int TAB_OFF = 131072;
constexpr int TAB2_OFF = TAB_OFF + 10 * 1024, TB_OFF = TAB_OFF + 20 * 1024;
constexpr int LDSCTL_OFF = 152576, MISC_OFF = LDSCTL_OFF + 320;
constexpr int LDS_BYTES = 155648;
constexpr int CW_BAR = 4096;

struct Args {
    const float *x, *g1, *w_in, *b_f, *g_fox, *g_sb, *w_out, *g2, *w_router, *b_router, *w1, *b1, *w2, *b2, *gf;
    float* out; unsigned char* ws;
};

__device__ __forceinline__ int mapcol(int mode, int n) {
    if (mode == 1) return n < 1536 ? n : n + 8;
    if (mode == 2) { const int pn = n >> 8, j = n & 255; return j < 128 ? 128 * pn + j : 1024 + 128 * pn + (j - 128); }
    return n;
}
__device__ __forceinline__ unsigned pk2(float lo, float hi) { unsigned r; asm("v_cvt_pk_bf16_f32 %0, %1, %2" : "=v"(r) : "v"(lo), "v"(hi)); return r; }
struct TrItem { const float* W; bf16_t* WT; const float* gA; const float* gB; int K, Nin, Nout, mode, gsplit, item, nbsh; };
template <bool NT> __device__ __forceinline__ void tr_load(const TrItem& t, int lane, f32x4 (&v)[8]) {
    const int nblk = t.Nout / 32, kb = t.nbsh >= 0 ? (t.item >> t.nbsh) : t.item / nblk, nb = t.nbsh >= 0 ? (t.item & (nblk - 1)) : t.item % nblk, k0 = 64 * kb, n0 = 32 * nb, l7 = lane & 7, kr = lane >> 3, col = mapcol(t.mode, n0 + 4 * l7);
#pragma unroll
    for (int i = 0; i < 8; ++i) { const f32x4* p = (const f32x4*)(t.W + (size_t)(k0 + 8 * i + kr) * t.Nin + col); v[i] = NT ? __builtin_nontemporal_load(p) : *p; }
}
__device__ __forceinline__ void tr_store(const TrItem& t, int lane, const f32x4 (&v)[8], LAS float* scr) {
    const int nblk = t.Nout / 32, kb = t.nbsh >= 0 ? (t.item >> t.nbsh) : t.item / nblk, nb = t.nbsh >= 0 ? (t.item & (nblk - 1)) : t.item % nblk, k0 = 64 * kb, n0 = 32 * nb, l7 = lane & 7, kr = lane >> 3;
#pragma unroll
    for (int i = 0; i < 8; ++i) { const int kk = 8 * i + kr, k = k0 + kk; const float gs = t.gA ? (k < t.gsplit ? t.gA[k] : t.gB[k - t.gsplit]) : 1.f;
        LAS float* sp = scr + kk * 33 + 4 * l7; sp[0] = v[i][0] * gs; sp[1] = v[i][1] * gs; sp[2] = v[i][2] * gs; sp[3] = v[i][3] * gs; }
    LDS_WAIT();
    const int c = lane & 7;
#pragma unroll
    for (int j = 0; j < 4; ++j) { const int n = (lane >> 3) + 8 * j; const LAS float* sp = scr + (8 * c) * 33 + n;
        v4u o; o.x = pk2(sp[0 * 33], sp[1 * 33]); o.y = pk2(sp[2 * 33], sp[3 * 33]); o.z = pk2(sp[4 * 33], sp[5 * 33]); o.w = pk2(sp[6 * 33], sp[7 * 33]);
        *(v4u*)(t.WT + (size_t)(n0 + n) * t.K + k0 + 8 * c) = o; }
    LDS_WAIT();
}
constexpr int I_W1 = (DM / 64) * (2048 / 32), I_W2 = (DM / 64) * (DM / 32), N_EXP_ITEMS = NE * (I_W1 + I_W2);
__device__ __forceinline__ TrItem expert_item(const float* w1, const float* w2, const float* g2, bf16_t* W1T, bf16_t* W2T, int r) {
    TrItem t;
    if (r < NE * I_W1) { const int e = r / I_W1; t.W = w1 + (size_t)e * DM * 2048; t.WT = W1T + (size_t)e * 2048 * DM; t.gA = g2; t.gB = nullptr; t.K = DM; t.Nin = 2048; t.Nout = 2048; t.mode = 2; t.gsplit = DM; t.item = r % I_W1; t.nbsh = 6; }
    else { r -= NE * I_W1; const int e = r / I_W2; t.W = w2 + (size_t)e * DM * DM; t.WT = W2T + (size_t)e * DM * DM; t.gA = nullptr; t.gB = nullptr; t.K = DM; t.Nin = DM; t.Nout = DM; t.mode = 0; t.gsplit = DM; t.item = r % I_W2; t.nbsh = 5; }
    return t;
}
__device__ __forceinline__ void convert_experts(const float* w1, const float* w2, const float* g2, bf16_t* W1T, bf16_t* W2T, int first, int stride, int N_END, int lane, LAS float* scr) {
    f32x4 v0[8], v1[8];
#define CVT_LOAD(v, idx) do { if ((idx) < N_END) { const TrItem t_ = expert_item(w1, w2, g2, W1T, W2T, (idx)); tr_load<true>(t_, lane, v); } } while (0)
#define CVT_STORE(v, idx) do { if ((idx) < N_END) { const TrItem t_ = expert_item(w1, w2, g2, W1T, W2T, (idx)); tr_store(t_, lane, v, scr); } } while (0)
    int it = first; asm volatile("" : "+v"(lane));
    CVT_LOAD(v0, it);
#pragma unroll 1
    for (; it < N_END; it += 2 * stride) {
        CVT_LOAD(v1, it + stride); CVT_STORE(v0, it);
        CVT_LOAD(v0, it + 2 * stride); CVT_STORE(v1, it + stride);
    }
#undef CVT_LOAD
#undef CVT_STORE
}

__device__ __forceinline__ float log_sigmoid(float v) { return fminf(v, 0.f) - log1pf(expf(-fabsf(v))); }
__device__ __forceinline__ void rms1_row(const float* __restrict__ x, const LAS float* wf  , const float* __restrict__ b_f,
                                         bf16_t* __restrict__ XN, float* __restrict__ FLOG, int row, int lane) {
    const float4* xr = (const float4*)(x + (size_t)row * DM);
    float4 v[4]; float ss = 0.f;
#pragma unroll
    for (int j = 0; j < 4; ++j) { v[j] = xr[lane + 64 * j]; ss += v[j].x * v[j].x + v[j].y * v[j].y + v[j].z * v[j].z + v[j].w * v[j].w; }
    ss = wave_sum(ss);
    const float rstd = rsqrtf(ss * (1.f / DM) + EPS);
    float f0 = 0.f, f1 = 0.f, f2 = 0.f, f3 = 0.f, f4 = 0.f, f5 = 0.f, f6 = 0.f, f7 = 0.f;
#pragma unroll
    for (int j = 0; j < 4; ++j) {
        const int c0 = 4 * (lane + 64 * j);
        uint2 o; o.x = pk2(v[j].x * rstd, v[j].y * rstd); o.y = pk2(v[j].z * rstd, v[j].w * rstd);
        *(uint2*)(XN + (size_t)row * DM + c0) = o;
        const float xs[4] = {v[j].x, v[j].y, v[j].z, v[j].w};
#pragma unroll
        for (int c = 0; c < 4; ++c) {
            const int k = c0 + c; const float xv = xs[c];
            const LAS f32x4* wp = (const LAS f32x4*)(wf + k * 8); const f32x4 w0 = wp[0], w1 = wp[1];
            f0 += xv * w0.x; f1 += xv * w0.y; f2 += xv * w0.z; f3 += xv * w0.w; f4 += xv * w1.x; f5 += xv * w1.y; f6 += xv * w1.z; f7 += xv * w1.w;
        }
    }
    f0 = wave_sum(f0); f1 = wave_sum(f1); f2 = wave_sum(f2); f3 = wave_sum(f3); f4 = wave_sum(f4); f5 = wave_sum(f5); f6 = wave_sum(f6); f7 = wave_sum(f7);
    if (lane < 8) {
        float f = f0; f = lane == 1 ? f1 : f; f = lane == 2 ? f2 : f; f = lane == 3 ? f3 : f; f = lane == 4 ? f4 : f; f = lane == 5 ? f5 : f; f = lane == 6 ? f6 : f; f = lane == 7 ? f7 : f;
        FLOG[(size_t)row * 8 + lane] = log_sigmoid(f * rstd + b_f[lane]);
    }
}
__device__ __forceinline__ void cumsum_wg(const float* __restrict__ FLOG, float* __restrict__ CUM, int bh, LAS float* part) {
    const int b = bh >> 3, h = bh & 7, t = threadIdx.x;
    float loc[8]; float s = 0.f;
#pragma unroll
    for (int i = 0; i < 8; ++i) { loc[i] = FLOG[((size_t)b * SEQ + t * 8 + i) * 8 + h]; s += loc[i]; }
    part[t] = s; __syncthreads();
    float run = 0.f; for (int i = 0; i < t; ++i) run += part[i];
#pragma unroll
    for (int i = 0; i < 8; ++i) { run += loc[i]; CUM[(size_t)bh * SEQ + t * 8 + i] = run * LOG2E; }
    __syncthreads();
}

template <int NT> __device__ __forceinline__ void wave_mma(f32x4 (&acc)[NT], const bf16_t* ap, const bf16_t* const (&bp)[NT], int K) {
    for (int k0 = 0; k0 < K; k0 += 32) {
        const bf16x8 a = *(const bf16x8*)(ap + k0);
#pragma unroll
        for (int t = 0; t < NT; ++t) { const bf16x8 b = *(const bf16x8*)(bp[t] + k0); acc[t] = __builtin_amdgcn_mfma_f32_16x16x32_bf16(a, b, acc[t], 0, 0, 0); }
    }
}
__device__ __forceinline__ void nv_inproj(const bf16_t* __restrict__ XN, const bf16_t* __restrict__ WINT, bf16_t* __restrict__ PROJ, int item, int lane) {
    const int n0 = (item % 48) * 64, m0 = (item / 48) * 16, r = lane & 15, q = lane >> 4;
    f32x4 acc[4];
#pragma unroll
    for (int t = 0; t < 4; ++t) acc[t] = (f32x4){0.f, 0.f, 0.f, 0.f};
    const bf16_t* ap = XN + (size_t)(m0 + r) * DM + 8 * q;
    const bf16_t* bp[4];
#pragma unroll
    for (int t = 0; t < 4; ++t) bp[t] = WINT + (size_t)(n0 + 16 * t + r) * DM + 8 * q;
    wave_mma<4>(acc, ap, bp, DM);
    const float sc = (n0 < 512 || (n0 >= 1536 && n0 < 2048)) ? C2 : 1.f;
#pragma unroll
    for (int t = 0; t < 4; ++t)
#pragma unroll
        for (int j = 0; j < 4; ++j) PROJ[(size_t)(m0 + 4 * q + j) * NPROJ + n0 + 16 * t + r] = f2bf(acc[t][j] * sc);
}

template <int TYPE> __device__ __forceinline__ void nv_attn(const bf16_t* __restrict__ PROJ, const float* __restrict__ CUM, bf16_t* __restrict__ OMIX, float* __restrict__ SSQ,
                                                          int bh, int qblk, int lane, LAS unsigned char* wl) {
    LAS bf16_t* Ks = (LAS bf16_t*)wl; LAS bf16_t* Vs = (LAS bf16_t*)(wl + 8192); LAS float* Cs = (LAS float*)(wl + 16384);
    const int b = bh >> 3, h = bh & 7, t = qblk * 64 + lane;
    const size_t row = (size_t)b * SEQ + t;
    const int qcol = (TYPE == 0 ? 0 : 1536) + h * HD, kcol = qcol + 512, vcol = qcol + 1024;
    float q[64], o[64];
#pragma unroll
    for (int c = 0; c < 8; ++c) { const bf16x8 v = *(const bf16x8*)(PROJ + row * NPROJ + qcol + 8 * c);
#pragma unroll
        for (int j = 0; j < 8; ++j) q[8 * c + j] = bf2f((unsigned short)v[j]); }
#pragma unroll
    for (int d = 0; d < 64; ++d) o[d] = 0.f;
    float m = -INFINITY, l = 0.f, R = 1.f;
    const float cq = CUM[(size_t)bh * SEQ + t];
    for (int it = 0; it <= qblk; ++it) {
        const int kt = (TYPE == 0) ? it : qblk - it;
        LDS_WAIT();
        for (int i = 0; i < 64; ++i) { const size_t kr = ((size_t)b * SEQ + kt * 64 + i) * NPROJ; Ks[i * 64 + lane] = PROJ[kr + kcol + lane]; Vs[i * 64 + lane] = PROJ[kr + vcol + lane]; }
        Cs[lane] = CUM[(size_t)bh * SEQ + kt * 64 + lane];
        LDS_WAIT();
        for (int ss = 0; ss < 64; ++ss) {
            const int s = (TYPE == 0) ? ss : 63 - ss; const int ks = kt * 64 + s;
            float dot = 0.f;
#pragma unroll
            for (int d = 0; d < 64; d += 8) { const bf16x8 kv = *(const LAS bf16x8*)&Ks[s * 64 + d];
#pragma unroll
                for (int j = 0; j < 8; ++j) dot += q[d + j] * bf2f((unsigned short)kv[j]); }
            if (TYPE == 0) {
                if (ks <= t) {
                    const float xv = dot + cq - Cs[s]; const float mn = fmaxf(m, xv); const float sc = exp2f(m - mn), p = exp2f(xv - mn);
                    l = l * sc + p; m = mn;
#pragma unroll
                    for (int d = 0; d < 64; d += 8) { const bf16x8 vv = *(const LAS bf16x8*)&Vs[s * 64 + d];
#pragma unroll
                        for (int j = 0; j < 8; ++j) o[d + j] = o[d + j] * sc + p * bf2f((unsigned short)vv[j]); }
                }
            } else {
                if (ks < t) {
                    const float z = fminf(fmaxf(dot, -80.f), 80.f); const float e = exp2f(z); const float rr = 1.f / (1.f + e); const float a = e * rr * R; R *= rr;
#pragma unroll
                    for (int d = 0; d < 64; d += 8) { const bf16x8 vv = *(const LAS bf16x8*)&Vs[s * 64 + d];
#pragma unroll
                        for (int j = 0; j < 8; ++j) o[d + j] += a * bf2f((unsigned short)vv[j]); }
                }
            }
        }
    }
    const float inv = (TYPE == 0) ? 1.f / l : 1.f;
    float ssq = 0.f;
#pragma unroll
    for (int d = 0; d < 64; ++d) { o[d] *= inv; ssq += o[d] * o[d]; }
    SSQ[row * 16 + TYPE * 8 + h] = ssq;
#pragma unroll
    for (int c = 0; c < 8; ++c) { bf16x8 v;
#pragma unroll
        for (int j = 0; j < 8; ++j) v[j] = (short)f2bf(o[8 * c + j]);
        *(bf16x8*)(OMIX + row * DM + TYPE * GW + h * HD + 8 * c) = v; }
}

__device__ __forceinline__ void nv_wout(const bf16_t* __restrict__ OMIX, const bf16_t* __restrict__ WOUTT, const float* __restrict__ SSQ, const float* __restrict__ x,
                                        float* __restrict__ X1, bf16_t* __restrict__ X1B, int item, int lane) {
    const int n0 = (item & 15) * 64, m0 = (item >> 4) * 16, r = lane & 15, q = lane >> 4;
    f32x4 af[4], as[4];
#pragma unroll
    for (int t = 0; t < 4; ++t) { af[t] = (f32x4){0.f, 0.f, 0.f, 0.f}; as[t] = (f32x4){0.f, 0.f, 0.f, 0.f}; }
    const bf16_t* ap = OMIX + (size_t)(m0 + r) * DM + 8 * q;
    const bf16_t* bp[4]; const bf16_t* bp2[4];
#pragma unroll
    for (int t = 0; t < 4; ++t) { bp[t] = WOUTT + (size_t)(n0 + 16 * t + r) * DM + 8 * q; bp2[t] = bp[t] + GW; }
    wave_mma<4>(af, ap, bp, GW);
    wave_mma<4>(as, ap + GW, bp2, GW);
#pragma unroll
    for (int j = 0; j < 4; ++j) {
        const size_t row = m0 + 4 * q + j; const float* sp = SSQ + row * 16;
        float sf = 0.f, s2 = 0.f;
#pragma unroll
        for (int h = 0; h < 8; ++h) { sf += sp[h]; s2 += sp[8 + h]; }
        const float rf = rsqrtf(sf * (1.f / GW) + EPS), rs = rsqrtf(s2 * (1.f / GW) + EPS);
#pragma unroll
        for (int t = 0; t < 4; ++t) { const size_t idx = row * DM + n0 + 16 * t + r; const float v = x[idx] + rf * af[t][j] + rs * as[t][j]; X1[idx] = v; X1B[idx] = f2bf(v); }
    }
}

__device__ __forceinline__ void nv_router(const float* __restrict__ X1, const float* __restrict__ WR, const float* __restrict__ b_router, float* __restrict__ RSTD2,
                                          float* __restrict__ RW, int* __restrict__ LIST, int* __restrict__ SLOTEP, unsigned* __restrict__ CNT, int item, int lane) {
    const int e = lane & 31, tok = item * 2 + (lane >> 5);
    const float* xr = X1 + (size_t)tok * DM;
    float acc = 0.f, ss = 0.f;
    for (int k = 0; k < DM; ++k) { const float xv = xr[k]; acc += xv * WR[k * NE + e]; ss += xv * xv; }
    const float rstd = rsqrtf(ss * (1.f / DM) + EPS);
    float logit = acc * rstd + b_router[e];
    if (e == 0) RSTD2[tok] = rstd;
    float tv[4]; int ti[4];
#pragma unroll
    for (int k = 0; k < 4; ++k) {
        float bv = logit; int bi = e;
#pragma unroll
        for (int o = 1; o < 32; o <<= 1) { const float ov = __shfl_xor(bv, o); const int oi = __shfl_xor(bi, o); if (ov > bv || (ov == bv && oi < bi)) { bv = ov; bi = oi; } }
        tv[k] = bv; ti[k] = bi; if (e == bi) logit = -INFINITY;
    }
    const float e0 = 1.f, e1 = expf(tv[1] - tv[0]), e2 = expf(tv[2] - tv[0]), e3 = expf(tv[3] - tv[0]); const float inv = 1.f / (e0 + e1 + e2 + e3);
    const float w0 = e0 * inv, w1 = e1 * inv, w2 = e2 * inv, w3 = e3 * inv;
    int myk = -1; float myw = 0.f;
    if (e == ti[0]) { myk = 0; myw = w0; } if (e == ti[1]) { myk = 1; myw = w1; } if (e == ti[2]) { myk = 2; myw = w2; } if (e == ti[3]) { myk = 3; myw = w3; }
    if (myk >= 0) { const int slot = tok * 4 + myk; const unsigned pos = atomicAdd(&CNT[e], 1u); LIST[(size_t)e * LIST_CAP + pos] = slot; RW[slot] = myw; SLOTEP[slot] = e * 16384 + (int)pos; }
}


typedef float f32x16 __attribute__((ext_vector_type(16)));
__device__ __forceinline__ void router_wg(const float* __restrict__ X1, const float* __restrict__ WR, const float* __restrict__ b_router, float* __restrict__ RSTD2,
                                          float* __restrict__ RW, int* __restrict__ LIST, int* __restrict__ SLOTEP, unsigned* __restrict__ CNT, int tokbase, LAS unsigned char* L) {
    int tid_ = threadIdx.x; asm volatile("" : "+v"(tid_));
    const int tid = tid_, lane = tid & 63, wave = __builtin_amdgcn_readfirstlane(tid >> 6), kq = wave & 3, tile = wave >> 2, r32 = lane & 31, hi = lane >> 5;
    LAS float* Dx = (LAS float*)L; LAS float* SSx = (LAS float*)(L + 32768); LAS unsigned* lcnt = (LAS unsigned*)(L + 33792); LAS unsigned* lbase = (LAS unsigned*)(L + 33920);
    if (tid < NE) lcnt[tid] = 0u;
    const int tok = tokbase + tile * 32 + r32;
    const float* xp = X1 + (size_t)tok * DM + kq * 256 + 4 * hi;
    const float* wp = WR + (size_t)(kq * 256 + 4 * hi) * NE + r32;
    f32x16 acc;
#pragma unroll
    for (int r = 0; r < 16; ++r) acc[r] = 0.f;
    float ss = 0.f;
#pragma unroll 1
    for (int mc = 0; mc < 4; ++mc) {
        float4 xv[8];
#pragma unroll
        for (int m = 0; m < 8; ++m) xv[m] = *(const float4*)(xp + (mc * 8 + m) * 8);
#pragma unroll
        for (int m = 0; m < 8; ++m) {
            const float* w4 = wp + (size_t)((mc * 8 + m) * 8) * NE;
            const float w0 = w4[0], w1 = w4[NE], w2 = w4[2 * NE], w3 = w4[3 * NE];
            acc = __builtin_amdgcn_mfma_f32_32x32x2f32(w0, xv[m].x, acc, 0, 0, 0);
            acc = __builtin_amdgcn_mfma_f32_32x32x2f32(w1, xv[m].y, acc, 0, 0, 0);
            acc = __builtin_amdgcn_mfma_f32_32x32x2f32(w2, xv[m].z, acc, 0, 0, 0);
            acc = __builtin_amdgcn_mfma_f32_32x32x2f32(w3, xv[m].w, acc, 0, 0, 0);
            ss += xv[m].x * xv[m].x + xv[m].y * xv[m].y + xv[m].z * xv[m].z + xv[m].w * xv[m].w;
        }
    }
    { auto rr = __builtin_amdgcn_permlane32_swap(__float_as_uint(ss), __float_as_uint(ss), false, false); ss = __uint_as_float(rr[0]) + __uint_as_float(rr[1]); }
#pragma unroll
    for (int r = 0; r < 16; ++r) Dx[(wave * 16 + r) * 64 + lane] = acc[r];
    if (hi == 0) SSx[wave * 32 + r32] = ss;
    LDS_WAIT(); __syncthreads();
    int ea = 0, eb = 0; float wa = 0.f, wb = 0.f; unsigned la = 0u, lb = 0u;
    if (kq == 0) {
        float v[16]; float sst = 0.f;
#pragma unroll
        for (int w = 0; w < 4; ++w) sst += SSx[(tile * 4 + w) * 32 + r32];
        const float rstd = rsqrtf(sst * (1.f / DM) + EPS);
#pragma unroll
        for (int r = 0; r < 16; ++r) { float a = 0.f;
#pragma unroll
            for (int w = 0; w < 4; ++w) a += Dx[((tile * 4 + w) * 16 + r) * 64 + lane];
            v[r] = a * rstd + b_router[(r & 3) + 8 * (r >> 2) + 4 * hi]; }
        if (hi == 0) RSTD2[tok] = rstd;
        float tv[4]; int te[4];
#pragma unroll
        for (int k = 0; k < 4; ++k) {
            float bv = v[0]; int br = 0;
#pragma unroll
            for (int r = 1; r < 16; ++r) if (v[r] > bv) { bv = v[r]; br = r; }
            const int be = (br & 3) + 8 * (br >> 2) + 4 * hi;
            auto r1 = __builtin_amdgcn_permlane32_swap(__float_as_uint(bv), __float_as_uint(bv), false, false);
            auto r2 = __builtin_amdgcn_permlane32_swap((unsigned)be, (unsigned)be, false, false);
            const float pv = __uint_as_float(hi ? r1[0] : r1[1]); const int pe = (int)(hi ? r2[0] : r2[1]);
            const bool mine = (bv > pv) || (bv == pv && be < pe);
            tv[k] = mine ? bv : pv; te[k] = mine ? be : pe;
#pragma unroll
            for (int r = 0; r < 16; ++r) v[r] = (mine && r == br) ? -INFINITY : v[r];
        }
        const float e1 = expf(tv[1] - tv[0]), e2 = expf(tv[2] - tv[0]), e3 = expf(tv[3] - tv[0]); const float inv = 1.f / (1.f + e1 + e2 + e3);
        ea = hi ? te[2] : te[0]; eb = hi ? te[3] : te[1]; wa = (hi ? e2 : 1.f) * inv; wb = (hi ? e3 : e1) * inv;
        la = atomicAdd((unsigned*)&lcnt[ea], 1u); lb = atomicAdd((unsigned*)&lcnt[eb], 1u);
    }
    LDS_WAIT(); __syncthreads();
    if (tid < NE) { const unsigned c = lcnt[tid]; lbase[tid] = c ? atomicAdd(&CNT[tid], c) : 0u; }
    LDS_WAIT(); __syncthreads();
    if (kq == 0) {
        const int sa = tok * 4 + 2 * hi, sb = sa + 1;
        const int pa = (int)(lbase[ea] + la), pb = (int)(lbase[eb] + lb);
        LIST[(size_t)ea * LIST_CAP + pa] = sa; RW[sa] = wa; SLOTEP[sa] = ea * 16384 + pa;
        LIST[(size_t)eb * LIST_CAP + pb] = sb; RW[sb] = wb; SLOTEP[sb] = eb * 16384 + pb;
    }
    LDS_WAIT(); __syncthreads();
}

__device__ __forceinline__ bool moe_tile(const unsigned* CNT, int g, int& e, int& base, int& p0, int& cnt) {
    const int tile256 = g >> 4; base = 0;
    for (e = 0; e < NE; ++e) { const int nt = ((int)CNT[e] + 255) >> 8; if (tile256 < base + nt) break; base += nt; }
    if (e == NE) return false;
    cnt = (int)CNT[e]; p0 = (g - base * 16) * 16; return p0 < cnt;
}
__device__ __forceinline__ void nv_moe1(const bf16_t* __restrict__ X1B, const bf16_t* __restrict__ W1T, const float* __restrict__ b1, const float* __restrict__ RSTD2,
                                        const int* __restrict__ LIST, bf16_t* __restrict__ H, int e, int base, int p0, int cnt, int cg, int lane) {
    const int r = lane & 15, q = lane >> 4, c0 = cg * 32, pn = c0 >> 7, j0 = c0 & 127;
    const int* lst = LIST + (size_t)e * LIST_CAP;
    const int prow = p0 + r; const int tok = lst[prow < cnt ? prow : cnt - 1] >> 2;
    f32x4 acc[4];
#pragma unroll
    for (int t = 0; t < 4; ++t) acc[t] = (f32x4){0.f, 0.f, 0.f, 0.f};
    const bf16_t* ap = X1B + (size_t)tok * DM + 8 * q;
    const bf16_t* wb = W1T + (size_t)e * 2048 * DM + (size_t)(256 * pn + j0 + r) * DM + 8 * q;
    const bf16_t* bp[4] = {wb, wb + 16 * DM, wb + 128 * DM, wb + 144 * DM};
    wave_mma<4>(acc, ap, bp, DM);
#pragma unroll
    for (int j = 0; j < 4; ++j) {
        const int pr = p0 + 4 * q + j; if (pr >= cnt) continue;
        const float rs = RSTD2[lst[pr] >> 2];
#pragma unroll
        for (int t = 0; t < 2; ++t) {
            const int col = c0 + 16 * t + r;
            float glu = acc[t][j] * rs + b1[(size_t)e * 2048 + col], lin = acc[t + 2][j] * rs + b1[(size_t)e * 2048 + 1024 + col];
            glu = fminf(glu, 7.f); lin = fminf(fmaxf(lin, -7.f), 7.f);
            const float act = glu * (1.f / (1.f + expf(-1.702f * glu))) * (lin + 1.f);
            H[((size_t)base * 256 + pr) * DM + col] = f2bf(act);
        }
    }
}
__device__ __forceinline__ void nv_moe2(const bf16_t* __restrict__ H, const bf16_t* __restrict__ W2T, const float* __restrict__ b2, const float* __restrict__ RW,
                                        const int* __restrict__ LIST, bf16_t* __restrict__ Y, int e, int base, int p0, int cnt, int cg, int lane) {
    const int r = lane & 15, q = lane >> 4, n0 = cg * 64;
    const int* lst = LIST + (size_t)e * LIST_CAP;
    f32x4 acc[4];
#pragma unroll
    for (int t = 0; t < 4; ++t) acc[t] = (f32x4){0.f, 0.f, 0.f, 0.f};
    const bf16_t* ap = H + ((size_t)base * 256 + p0 + r) * DM + 8 * q;
    const bf16_t* bp[4];
#pragma unroll
    for (int t = 0; t < 4; ++t) bp[t] = W2T + (size_t)e * DM * DM + (size_t)(n0 + 16 * t + r) * DM + 8 * q;
    wave_mma<4>(acc, ap, bp, DM);
#pragma unroll
    for (int j = 0; j < 4; ++j) {
        const int pr = p0 + 4 * q + j; if (pr >= cnt) continue;
        const int slot = lst[pr]; const float w = RW[slot];
#pragma unroll
        for (int t = 0; t < 4; ++t) { const int col = n0 + 16 * t + r; Y[((size_t)base * 256 + pr) * DM + col] = f2bf((acc[t][j] + b2[(size_t)e * DM + col]) * w); }
    }
}

__device__ __forceinline__ void final_row(const float* X1, const bf16_t* __restrict__ Y, const int* __restrict__ SLOTEP, const int* __restrict__ TBG, const float* __restrict__ gf, float* out, int row, int lane) {
    float4 v[4]; float ss = 0.f; int yr[4];
#pragma unroll
    for (int k = 0; k < 4; ++k) { const int ep = SLOTEP[row * 4 + k]; yr[k] = TBG[ep >> 14] * 256 + (ep & 16383); }
#pragma unroll
    for (int j = 0; j < 4; ++j) {
        const int c0 = 4 * (lane + 64 * j);
        v[j] = *(const float4*)(X1 + (size_t)row * DM + c0);
#pragma unroll
        for (int k = 0; k < 4; ++k) { const uint2 y = *(const uint2*)(Y + (size_t)yr[k] * DM + c0);
            v[j].x += bf2f((unsigned short)(y.x & 0xffff)); v[j].y += bf2f((unsigned short)(y.x >> 16)); v[j].z += bf2f((unsigned short)(y.y & 0xffff)); v[j].w += bf2f((unsigned short)(y.y >> 16)); }
        ss += v[j].x * v[j].x + v[j].y * v[j].y + v[j].z * v[j].z + v[j].w * v[j].w;
    }
    ss = wave_sum(ss);
    const float rstd = rsqrtf(ss * (1.f / DM) + EPS);
#pragma unroll
    for (int j = 0; j < 4; ++j) { const int c0 = 4 * (lane + 64 * j); const float4 g = *(const float4*)(gf + c0);
        float4 o; o.x = v[j].x * rstd * g.x; o.y = v[j].y * rstd * g.y; o.z = v[j].z * rstd * g.z; o.w = v[j].w * rstd * g.w; *(float4*)(out + (size_t)row * DM + c0) = o; }
}


namespace pg8 {
#define PG8_LAS __attribute__((address_space(3)))
typedef unsigned u32x4 __attribute__((ext_vector_type(4)));
typedef unsigned u32x2 __attribute__((ext_vector_type(2)));
constexpr int BM = 256, BK = 64, HALF = 128, HTB = HALF * BK * 2  , STAGE_BYTES = 8 * HTB, NXCD = 8, WGM = 8;
__host__ __device__ __forceinline__ int lds_byte(int r, int c) { const int st = (r >> 4) * 2 + (c >> 5), rr = r & 15, cc = c & 31, ob = rr * 64 + cc * 2; return st * 1024 + (ob ^ (((ob >> 9) & 1) << 5)); }
__host__ __device__ __forceinline__ void stage_rc(int b, int& R, int& C) { const int st = b / 1024, sb = b % 1024, swz = sb ^ (((sb >> 9) & 1) << 5); R = (st >> 1) * 16 + swz / 64; C = (st & 1) * 32 + (swz % 64) / 2; }
__host__ __device__ __forceinline__ int perm32(int rho) { const int n = rho >> 4, i = rho & 15; return 8 * (i >> 2) + 4 * n + (i & 3); }
struct Unit { int pm, pn, nr; };
struct Gemm { const bf16_t* A; const bf16_t* Bt; int K; };
struct StaticOrder {
    int nM, nN, nwg, G, c;
    __device__ void init(int M_, int N_, int G_, int c_) { nM = M_ / BM; nN = N_ / BM; nwg = nM * nN; G = G_; c = c_; }
    __device__ bool next(int i, Unit& u) const {
        const long L = (long)i * G + c; if (L >= nwg) return false;
        int wgid = (int)L; { const int q = nwg / NXCD, r = nwg % NXCD, xcd = wgid % NXCD, off = wgid / NXCD; wgid = (xcd < r ? xcd * (q + 1) : r * (q + 1) + (xcd - r) * q) + off; }
        const int nig = WGM * nN, gid = wgid / nig, fm = gid * WGM, gsz = (nM - fm) < WGM ? (nM - fm) : WGM;
        u.pm = fm + ((wgid % nig) % gsz); u.pn = (wgid % nig) / gsz; u.nr = BM; return true;
    }
    __device__ __forceinline__ const PG8_LAS int* rowtab(int) const { return nullptr; }
};
__device__ __forceinline__ unsigned cvt_pk_bf16(float lo, float hi) { unsigned r; asm volatile("v_cvt_pk_bf16_f32 %0, %1, %2" : "=v"(r) : "v"(lo), "v"(hi)); return r; }

template <class Sched> __device__ __forceinline__ void gather_voffs(const Sched& S, int ui, int tid, int K, unsigned (&o0)[2], unsigned (&o1)[2]) {
    const PG8_LAS int* tab = S.rowtab(ui);
#pragma unroll
    for (int i = 0; i < 2; ++i) { int R, C; stage_rc(tid * 16 + i * 8192, R, C); o0[i] = (unsigned)(tab[R] * K + C) * 2u; o1[i] = (unsigned)(tab[HALF + R] * K + C) * 2u; }
}

template <class Epi, class Sched, bool ALIGN_EPI, bool GATHER>
__device__ __forceinline__ void gemm_phase(PG8_LAS unsigned char* lds, const Gemm g, const Sched& S, const Epi& E) {
    int tid_ = threadIdx.x; asm volatile("" : "+v"(tid_));
    const int tid = tid_, wid = __builtin_amdgcn_readfirstlane(tid >> 6), lane = tid & 63, wr = wid >> 2, wc = wid & 3, fr = lane & 15, fq = lane >> 4;
    const int K = g.K, nt = K / BK;
    unsigned vA0[2], vA1[2], wA0[2], wA1[2], voffB[2];
    const size_t kstep = (size_t)(BK * 2);
    const size_t hstep = (size_t)HALF * K * 2;
    const size_t tstep = 2 * hstep;
#pragma unroll
    for (int i = 0; i < 2; ++i) { int R, C; stage_rc(tid * 16 + i * 8192, R, C); const int Rb = Epi::PERM ? ((R & ~31) + perm32(R & 31)) : R;
        vA0[i] = (unsigned)(R * K + C) * 2u; vA1[i] = vA0[i] + (unsigned)hstep; voffB[i] = (unsigned)(Rb * K + C) * 2u; wA0[i] = vA0[i]; wA1[i] = vA1[i]; }
    const unsigned ldsw = (unsigned)wid * 1024u;
    const int aoff = lds_byte(wr * 64 + fr, fq * 8), boff = lds_byte(wc * 32 + fr, fq * 8);
#define PG8_SA(b, h) (((b) * 2 + (h)) * HTB)
#define PG8_SB(b, h) ((4 + (b) * 2 + (h)) * HTB)
#define PG8_STAGE(bufoff, gbase, voff) do { _Pragma("unroll") for (int _i = 0; _i < 2; ++_i) \
        __builtin_amdgcn_global_load_lds((const unsigned*)((const char*)(gbase) + (voff)[_i]), (PG8_LAS unsigned*)(lds + (bufoff) + ldsw + _i * 8192), 16, 0, 0); } while (0)
#define PG8_LDA(dst, b, h) do { _Pragma("unroll") for (int m = 0; m < 4; ++m) _Pragma("unroll") for (int k = 0; k < 2; ++k) dst[m][k] = *(const PG8_LAS bf16x8*)(lds + PG8_SA(b, h) + aoff + m * 2048 + k * 1024); } while (0)
#define PG8_LDB(dst, b, h) do { _Pragma("unroll") for (int n = 0; n < 2; ++n) _Pragma("unroll") for (int k = 0; k < 2; ++k) dst[n][k] = *(const PG8_LAS bf16x8*)(lds + PG8_SB(b, h) + boff + n * 2048 + k * 1024); } while (0)
#define PG8_MMA(ai, bj, At, Bt) do { if (cur.nr > 128 * (ai) + 64 * wr) { __builtin_amdgcn_s_setprio(1); _Pragma("unroll") for (int m = 0; m < 4; ++m) _Pragma("unroll") for (int n = 0; n < 2; ++n) _Pragma("unroll") for (int k = 0; k < 2; ++k) \
        acc[ai][bj][m][n] = __builtin_amdgcn_mfma_f32_16x16x32_bf16(Bt[n][k], At[m][k], acc[ai][bj][m][n], 0, 0, 0); __builtin_amdgcn_s_setprio(0); } } while (0)
#define PG8_WAIT_V(n) asm volatile("s_waitcnt vmcnt(" #n ")" ::: "memory")
#define PG8_WAIT_L(n) asm volatile("s_waitcnt lgkmcnt(" #n ")" ::: "memory")
#define PG8_BAR __builtin_amdgcn_s_barrier()
#define PG8_SCHED __builtin_amdgcn_sched_barrier(0)
    Unit cur, nxt; int ui = 0;
    if (!S.next(0, cur)) return;
    f32x4 acc[2][2][4][2];
#pragma unroll
    for (int a = 0; a < 2; ++a)
#pragma unroll
        for (int b = 0; b < 2; ++b)
#pragma unroll
            for (int m = 0; m < 4; ++m)
#pragma unroll
                for (int n = 0; n < 2; ++n) acc[a][b][m][n] = (f32x4){0.f, 0.f, 0.f, 0.f};
    bf16x8 At[4][2], B0[2][2], B1[2][2];
    const char* cA = GATHER ? (const char*)g.A : (const char*)g.A + (size_t)cur.pm * tstep; const char* cB = (const char*)g.Bt + (size_t)cur.pn * tstep;
    if constexpr (GATHER) gather_voffs(S, 0, tid, K, vA0, vA1);
    PG8_STAGE(PG8_SB(0, 0), cB, voffB); PG8_STAGE(PG8_SB(0, 1), cB + hstep, voffB); PG8_STAGE(PG8_SA(0, 0), cA, vA0); PG8_STAGE(PG8_SA(0, 1), cA, vA1);
    if (wr == 1) PG8_BAR;
    PG8_WAIT_V(2); PG8_BAR;
    PG8_STAGE(PG8_SB(1, 0), cB + kstep, voffB); PG8_STAGE(PG8_SA(1, 0), cA + kstep, vA0); PG8_STAGE(PG8_SB(1, 1), cB + hstep + kstep, voffB);
    PG8_WAIT_V(6); PG8_BAR;
    for (;;) {
        const bool has_next = S.next(ui + 1, nxt);
        const char* nA = GATHER ? cA : (has_next ? (const char*)g.A + (size_t)nxt.pm * tstep : cA); const char* nB = has_next ? (const char*)g.Bt + (size_t)nxt.pn * tstep : cB;
        if constexpr (GATHER) { if (has_next) gather_voffs(S, ui + 1, tid, K, wA0, wA1); else { wA0[0] = vA0[0]; wA0[1] = vA0[1]; wA1[0] = vA1[0]; wA1[1] = vA1[1]; } }
        for (int t = 0; t < nt; t += 2) {
            const bool last = (t == nt - 2);
            const char* a1 = cA + (size_t)(t + 1) * kstep;
            const char* a2 = last ? nA : cA + (size_t)(t + 2) * kstep; const char* b2 = last ? nB : cB + (size_t)(t + 2) * kstep;
            const char* a3 = a2 + kstep; const char* b3 = b2 + kstep;
            unsigned sA0[2], sA1[2];
#pragma unroll
            for (int i = 0; i < 2; ++i) { sA0[i] = (GATHER && last) ? wA0[i] : vA0[i]; sA1[i] = (GATHER && last) ? wA1[i] : vA1[i]; }
            if constexpr (Epi::MIDK) { if (t == nt / 2) E.midk(acc, wr, fr); }
            PG8_LDB(B0, 0, 0); PG8_LDB(B1, 0, 1); PG8_SCHED; PG8_LDA(At, 0, 0); PG8_STAGE(PG8_SA(1, 1), a1, vA1);
            PG8_WAIT_V(8); PG8_WAIT_L(0); PG8_BAR; PG8_MMA(0, 0, At, B0); PG8_MMA(0, 1, At, B1); PG8_BAR; PG8_SCHED;
            PG8_LDA(At, 0, 1); PG8_STAGE(PG8_SB(0, 0), b2, voffB); PG8_STAGE(PG8_SB(0, 1), b2 + hstep, voffB); PG8_STAGE(PG8_SA(0, 0), a2, sA0);
            PG8_WAIT_V(8); PG8_WAIT_L(0); PG8_BAR; PG8_MMA(1, 0, At, B0); PG8_MMA(1, 1, At, B1); PG8_BAR; PG8_SCHED;
            PG8_LDB(B0, 1, 0); PG8_LDB(B1, 1, 1); PG8_SCHED; PG8_LDA(At, 1, 0); PG8_STAGE(PG8_SA(0, 1), a2, sA1);
            PG8_WAIT_V(8); PG8_WAIT_L(0); PG8_BAR; PG8_MMA(0, 0, At, B0); PG8_MMA(0, 1, At, B1); PG8_BAR; PG8_SCHED;
            PG8_LDA(At, 1, 1); PG8_STAGE(PG8_SB(1, 0), b3, voffB); PG8_STAGE(PG8_SB(1, 1), b3 + hstep, voffB); PG8_STAGE(PG8_SA(1, 0), a3, sA0);
            PG8_WAIT_V(8); PG8_WAIT_L(0); PG8_BAR; PG8_MMA(1, 0, At, B0); PG8_MMA(1, 1, At, B1); PG8_BAR; PG8_SCHED;
        }
        if constexpr (ALIGN_EPI) { if (wr == 0) PG8_BAR; }
        E(acc, cur, ui, wr, wc, fr, fq);
        if (!has_next) break;
#pragma unroll
        for (int a = 0; a < 2; ++a)
#pragma unroll
            for (int b = 0; b < 2; ++b)
#pragma unroll
                for (int m = 0; m < 4; ++m)
#pragma unroll
                    for (int n = 0; n < 2; ++n) acc[a][b][m][n] = (f32x4){0.f, 0.f, 0.f, 0.f};
        cur = nxt; cA = nA; cB = nB; ++ui;
        if constexpr (GATHER) { vA0[0] = wA0[0]; vA0[1] = wA0[1]; vA1[0] = wA1[0]; vA1[1] = wA1[1]; }
        if constexpr (ALIGN_EPI) { if (wr == 1) PG8_BAR; }
    }
    PG8_WAIT_V(0);
    if constexpr (!ALIGN_EPI) { if (wr == 0) PG8_BAR; }
    PG8_BAR;
#undef PG8_SA
#undef PG8_SB
#undef PG8_STAGE
#undef PG8_LDA
#undef PG8_LDB
#undef PG8_MMA
#undef PG8_WAIT_V
#undef PG8_WAIT_L
#undef PG8_BAR
#undef PG8_SCHED
}

struct EpiProj {
    static constexpr bool PERM = true, MIDK = false;
    bf16_t* O;
    __device__ __forceinline__ void operator()(const f32x4 (&acc)[2][2][4][2], const Unit& u, int, int wr, int wc, int fr, int fq) const {
        const int row0 = u.pm * BM + wr * 64 + fr, col0 = u.pn * BM + wc * 32 + 8 * fq;
        const float sc = (u.pn < 2 || (u.pn >= 6 && u.pn < 8)) ? C2 : 1.f;
#pragma unroll
        for (int ai = 0; ai < 2; ++ai)
#pragma unroll
            for (int m = 0; m < 4; ++m) { bf16_t* rowp = O + (size_t)(row0 + ai * HALF + m * 16) * NPROJ + col0;
#pragma unroll
                for (int bj = 0; bj < 2; ++bj) { const f32x4 v0 = acc[ai][bj][m][0] * sc, v1 = acc[ai][bj][m][1] * sc;
                    u32x4 w; w.x = cvt_pk_bf16(v0[0], v0[1]); w.y = cvt_pk_bf16(v0[2], v0[3]); w.z = cvt_pk_bf16(v1[0], v1[1]); w.w = cvt_pk_bf16(v1[2], v1[3]);
                    *(u32x4*)(rowp + bj * HALF) = w; } }
    }
};
struct EpiWout {
    static constexpr bool PERM = false, MIDK = true;
    const float* x; float* X1; bf16_t* X1B; const PG8_LAS float* ratio; const PG8_LAS float* rs;
    __device__ __forceinline__ void midk(f32x4 (&acc)[2][2][4][2], int wr, int fr) const {
#pragma unroll
        for (int ai = 0; ai < 2; ++ai)
#pragma unroll
            for (int m = 0; m < 4; ++m) { const float f = ratio[ai * HALF + wr * 64 + m * 16 + fr];
#pragma unroll
                for (int bj = 0; bj < 2; ++bj)
#pragma unroll
                    for (int n = 0; n < 2; ++n) acc[ai][bj][m][n] *= f; }
    }
    __device__ __forceinline__ void operator()(const f32x4 (&acc)[2][2][4][2], const Unit& u, int, int wr, int wc, int fr, int fq) const {
        const int col0 = u.pn * BM + wc * 32 + 4 * fq;
#pragma unroll
        for (int ai = 0; ai < 2; ++ai)
#pragma unroll
            for (int m = 0; m < 4; ++m) { const int r = ai * HALF + wr * 64 + m * 16 + fr; const float s = rs[r]; const size_t off = (size_t)(u.pm * BM + r) * DM + col0;
#pragma unroll
                for (int bj = 0; bj < 2; ++bj)
#pragma unroll
                    for (int n = 0; n < 2; ++n) { const f32x4 xv = *(const f32x4*)(x + off + bj * HALF + n * 16); const f32x4 o = xv + acc[ai][bj][m][n] * s;
                        *(f32x4*)(X1 + off + bj * HALF + n * 16) = o; u32x2 w; w.x = cvt_pk_bf16(o[0], o[1]); w.y = cvt_pk_bf16(o[2], o[3]); *(u32x2*)(X1B + off + bj * HALF + n * 16) = w; }
                asm volatile("" ::: "memory"); }
    }
};
constexpr int MOE_MAXU = 10;
struct MoeOrder {
    int NT, c; const PG8_LAS int* tb; const PG8_LAS int* tbE; const PG8_LAS int* tbC; const PG8_LAS int* cnt; const PG8_LAS int* tabA;
    int probe = 0;
    __device__ bool next(int i, Unit& u) const {
        if (i >= MOE_MAXU) return false;
        const int x = c & 7, j = c >> 3, UE = tbE[32] * NT, UC = tbC[32] * NT;
        const int qE = UE >> 3, rE = UE & 7, sE = x * qE + (x < rE ? x : rE), nE = qE + (x < rE ? 1 : 0);
        const int qC = UC >> 3, rC = UC & 7, sC = x * qC + (x < rC ? x : rC), nC = qC + (x < rC ? 1 : 0);
        const int nEj = (j < nE) ? ((nE - j + 31) >> 5) : 0;
        if (i < nEj) {
            const int f = sE + i * 32 + j; int e = 0; while (f >= tbE[e + 1] * NT) ++e;
            const int idx = f - tbE[e] * NT, nte = tbE[e + 1] - tbE[e], pg = idx / (4 * nte), rem2 = idx - pg * 4 * nte, mt = rem2 >> 2;
            u.pm = tb[e] + mt; u.pn = e * NT + pg * 4 + (rem2 & 3); const int left = cnt[e] - 256 * mt; u.nr = left < BM ? left : BM;
        } else {
            const int jj = (j - (nE & 31) + 32) & 31, lc = (i - nEj) * 32 + jj; if (lc >= nC) return false;
            const int f = sC + lc; int e = 0; while (f >= tbC[e + 1] * NT) ++e;
            const int mt = tbE[e + 1] - tbE[e]; u.pm = tb[e] + mt; u.pn = e * NT + (f - tbC[e] * NT); u.nr = cnt[e] - 256 * mt;
        }
        if (probe) { u.pm &= 31; u.pn &= 7; if (probe == 2) u.nr = 32; }
        return true;
    }
    __device__ __forceinline__ const PG8_LAS int* rowtab(int ui) const { return tabA + ui * 256; }
};
struct EpiMoe1 {
    static constexpr bool PERM = true, MIDK = false;
    bf16_t* H; const float* b1; const PG8_LAS float* rstab;
    __device__ __forceinline__ void operator()(const f32x4 (&acc)[2][2][4][2], const Unit& u, int ui, int wr, int wc, int fr, int fq) const {
        const int e = u.pn >> 3, pl = u.pn & 7, colA = pl * 128 + wc * 32 + 8 * fq;
        f32x4 bg[2], bl[2];
#pragma unroll
        for (int n = 0; n < 2; ++n) { bg[n] = *(const f32x4*)(b1 + (size_t)e * 2048 + colA + 4 * n); bl[n] = *(const f32x4*)(b1 + (size_t)e * 2048 + 1024 + colA + 4 * n); }
#pragma unroll
        for (int ai = 0; ai < 2; ++ai)
#pragma unroll
            for (int m = 0; m < 4; ++m) { const int r = ai * HALF + wr * 64 + m * 16 + fr; const float rs = rstab[ui * 256 + r];
                float a8[8];
#pragma unroll
                for (int n = 0; n < 2; ++n) { const f32x4 gv = acc[ai][0][m][n] * rs + bg[n], lv = acc[ai][1][m][n] * rs + bl[n];
#pragma unroll
                    for (int i = 0; i < 4; ++i) { const float gl = fminf(gv[i], 7.f), li = fminf(fmaxf(lv[i], -7.f), 7.f);
                        a8[4 * n + i] = gl * __builtin_amdgcn_rcpf(1.f + __builtin_amdgcn_exp2f(-1.702f * LOG2E * gl)) * (li + 1.f); } }
                u32x4 w; w.x = cvt_pk_bf16(a8[0], a8[1]); w.y = cvt_pk_bf16(a8[2], a8[3]); w.z = cvt_pk_bf16(a8[4], a8[5]); w.w = cvt_pk_bf16(a8[6], a8[7]);
                *(u32x4*)(H + (size_t)(u.pm * BM + r) * DM + colA) = w; }
    }
};
struct EpiMoe2 {
    static constexpr bool PERM = true, MIDK = false;
    bf16_t* Y; const float* b2; const PG8_LAS float* wtab;
    __device__ __forceinline__ void operator()(const f32x4 (&acc)[2][2][4][2], const Unit& u, int ui, int wr, int wc, int fr, int fq) const {
        const int e = u.pn >> 2, pl = u.pn & 3, col0 = pl * BM + wc * 32 + 8 * fq;
        f32x4 bv[2][2];
#pragma unroll
        for (int bj = 0; bj < 2; ++bj)
#pragma unroll
            for (int n = 0; n < 2; ++n) bv[bj][n] = *(const f32x4*)(b2 + (size_t)e * DM + col0 + bj * HALF + 4 * n);
#pragma unroll
        for (int ai = 0; ai < 2; ++ai)
#pragma unroll
            for (int m = 0; m < 4; ++m) { const int r = ai * HALF + wr * 64 + m * 16 + fr; const float wt = wtab[ui * 256 + r]; bf16_t* rowp = Y + (size_t)(u.pm * BM + r) * DM + col0;
#pragma unroll
                for (int bj = 0; bj < 2; ++bj) { const f32x4 v0 = (acc[ai][bj][m][0] + bv[bj][0]) * wt, v1 = (acc[ai][bj][m][1] + bv[bj][1]) * wt;
                    u32x4 w; w.x = cvt_pk_bf16(v0[0], v0[1]); w.y = cvt_pk_bf16(v0[2], v0[3]); w.z = cvt_pk_bf16(v1[0], v1[1]); w.w = cvt_pk_bf16(v1[2], v1[3]);
                    *(u32x4*)(rowp + bj * HALF) = w; } }
    }
};
struct ListOrder {
    const PG8_LAS int* ud; int n; const PG8_LAS int* tabA;
    __device__ __forceinline__ bool next(int i, Unit& u) const { if (i >= n) return false; u.pm = ud[3 * i]; u.pn = ud[3 * i + 1]; u.nr = ud[3 * i + 2]; return true; }
    __device__ __forceinline__ const PG8_LAS int* rowtab(int ui) const { return tabA + ui * 256; }
};
struct EpiNull {
    static constexpr bool PERM = true, MIDK = false; float* O;
    __device__ __forceinline__ void operator()(const f32x4 (&acc)[2][2][4][2], const Unit& u, int ui, int wr, int wc, int fr, int fq) const {
        f32x4 t = (f32x4){0.f, 0.f, 0.f, 0.f};
#pragma unroll
        for (int ai = 0; ai < 2; ++ai)
#pragma unroll
            for (int bj = 0; bj < 2; ++bj)
#pragma unroll
                for (int m = 0; m < 4; ++m)
#pragma unroll
                    for (int n = 0; n < 2; ++n) t += acc[ai][bj][m][n];
        O[(size_t)(u.pm & 31) * 65536 + (u.pn & 7) * 8192 + (wr * 4 + wc) * 64 + fq * 16 + fr + ui] = t[0] + t[1] + t[2] + t[3];
    }
};
}

#include <hip/hip_bf16.h>
#include <cmath>
namespace attn_body {

using bf16=__hip_bfloat16;
using bf16x8=__attribute__((ext_vector_type(8)))short;
using s16x4=__attribute__((ext_vector_type(4)))short;
using f32x16=__attribute__((ext_vector_type(16)))float;
using u32x4=__attribute__((ext_vector_type(4)))unsigned;
constexpr int SEQ=4096,D=64,PIN=3072,POUT=1024;
constexpr int NW=8,QBLK=32,QB=QBLK*NW,KVBLK=64,NQB=SEQ/QB;
__device__ __forceinline__ int crow(int r,int hi){return (r&3)+8*(r>>2)+4*hi;}
#define SBAR() __builtin_amdgcn_sched_barrier(0)
__device__ __forceinline__ void cmask(f32x16&p0,f32x16&p1,int jb,int qrel,int hi){
  const float NEG=-INFINITY; int kb=64*jb+4*hi;
  #pragma unroll
  for(int r=0;r<16;++r){int kv=kb+(r&3)+8*(r>>2); if(kv>qrel)p0[r]=NEG; if(kv+32>qrel)p1[r]=NEG;}
}

constexpr int NSLOT=3, SLOTB=8192;
constexpr int LDS_K=0, LDS_V=NSLOT*SLOTB, LDS_WS=2*NSLOT*SLOTB, LDS_OST=LDS_WS+NW*64*4, LDS_CK=LDS_OST+NW*4096, LDS_BYTES=LDS_CK+SEQ*4;
constexpr float C2=0.125f*1.4426950408889634f;
__device__ __forceinline__ void glds16(const void*gsrc,unsigned lds_dst){unsigned keep;
  asm volatile("s_mov_b32 %0, m0\n\ts_mov_b32 m0, %2\n\ts_nop 0\n\tglobal_load_lds_dwordx4 %1, off\n\ts_mov_b32 m0, %0":"=&s"(keep):"v"(gsrc),"s"(lds_dst):"memory");}
__device__ __forceinline__ float max3f(float a,float b,float c){float r;asm("v_max3_f32 %0, %1, %2, %3":"=v"(r):"v"(a),"v"(b),"v"(c));return r;}
__device__ __forceinline__ float max2f(float a,float b){float r;asm("v_max_f32_e32 %0, %1, %2":"=v"(r):"v"(a),"v"(b));return r;}
__device__ __forceinline__ float fadd_s(float a,float b){float r;asm("v_add_f32_e32 %0, %1, %2":"=v"(r):"v"(a),"v"(b));return r;}
__device__ __forceinline__ float fsub_s(float a,float b){float r;asm("v_sub_f32_e32 %0, %1, %2":"=v"(r):"v"(a),"v"(b));return r;}
typedef float f32x2_t __attribute__((ext_vector_type(2))); typedef float f32x4_t __attribute__((ext_vector_type(4))); typedef __bf16 bf16x2_t __attribute__((ext_vector_type(2)));
__device__ __forceinline__ unsigned cvtpk_s(float lo,float hi){f32x2_t v={lo,hi};bf16x2_t b=__builtin_convertvector(v,bf16x2_t);return __builtin_bit_cast(unsigned,b);}
#define WAIT_BAR(N) asm volatile("s_waitcnt vmcnt(" #N ") lgkmcnt(0)\n\ts_barrier":::"memory")

__device__ __forceinline__ void qkt(f32x16&p0,f32x16&p1,const char*Kslot,const bf16x8*qr,const f32x16&negm,int r32,int hi){
  const char*kb=Kslot+hi*1024+r32*16;
  #pragma unroll
  for(int d0=0;d0<4;++d0){
    const bf16x8 b0=*reinterpret_cast<const bf16x8*>(kb+d0*2048);
    const bf16x8 b1=*reinterpret_cast<const bf16x8*>(kb+d0*2048+512);
    if(d0==0){p0=__builtin_amdgcn_mfma_f32_32x32x16_bf16(b0,qr[0],negm,0,0,0);p1=__builtin_amdgcn_mfma_f32_32x32x16_bf16(b1,qr[0],negm,0,0,0);}
    else{p0=__builtin_amdgcn_mfma_f32_32x32x16_bf16(b0,qr[d0],p0,0,0,0);p1=__builtin_amdgcn_mfma_f32_32x32x16_bf16(b1,qr[d0],p1,0,0,0);}}
}
typedef __attribute__((address_space(3))) const char* lds_cptr;
typedef short v4i16_t __attribute__((ext_vector_type(4)));
__device__ __forceinline__ void kload8(bf16x8*kf,lds_cptr kp){
  kf[0]=*(const __attribute__((address_space(3))) bf16x8*)(kp);      kf[1]=*(const __attribute__((address_space(3))) bf16x8*)(kp+512);
  kf[2]=*(const __attribute__((address_space(3))) bf16x8*)(kp+2048); kf[3]=*(const __attribute__((address_space(3))) bf16x8*)(kp+2560);
  kf[4]=*(const __attribute__((address_space(3))) bf16x8*)(kp+4096); kf[5]=*(const __attribute__((address_space(3))) bf16x8*)(kp+4608);
  kf[6]=*(const __attribute__((address_space(3))) bf16x8*)(kp+6144); kf[7]=*(const __attribute__((address_space(3))) bf16x8*)(kp+6656);
}
__device__ __forceinline__ void kload2(bf16x8*kf,lds_cptr kp,int j){ kf[2*j]=*(const __attribute__((address_space(3))) bf16x8*)(kp+j*2048); kf[2*j+1]=*(const __attribute__((address_space(3))) bf16x8*)(kp+j*2048+512); }
__device__ __forceinline__ s16x4 vtr(lds_cptr p){ return __builtin_bit_cast(s16x4,__builtin_amdgcn_ds_read_tr16_b64_v4i16((__attribute__((address_space(3))) v4i16_t*)p)); }
__device__ __forceinline__ float rowmax(const f32x16&p0,const f32x16&p1){
  float a=max3f(p0[0],p0[1],p1[0]),b=max3f(p0[2],p0[3],p1[1]);a=max3f(a,p1[2],p1[3]);
  #pragma unroll
  for(int r=4;r<16;r+=4){a=max3f(a,p0[r],p0[r+1]);b=max3f(b,p0[r+2],p0[r+3]);a=max3f(a,p1[r],p1[r+1]);b=max3f(b,p1[r+2],p1[r+3]);}
  const float m=max2f(a,b);
  auto rr=__builtin_amdgcn_permlane32_swap(__float_as_uint(m),__float_as_uint(m),false,false);
  return max2f(__uint_as_float(rr[0]),__uint_as_float(rr[1]));
}
__device__ __forceinline__ void pv(f32x16*o,int vb,bf16x8 pa0,bf16x8 pa1,bf16x8 pa2,bf16x8 pa3){
  #pragma unroll
  for(int d0=0;d0<2;++d0){s16x4 lo[4],hi[4];
    #pragma unroll
    for(int ks=0;ks<4;++ks){
      asm volatile("ds_read_b64_tr_b16 %0,%1 offset:%c2":"=&v"(lo[ks]):"v"(vb),"i"(d0*4096+ks*1024):"memory");
      asm volatile("ds_read_b64_tr_b16 %0,%1 offset:%c2":"=&v"(hi[ks]):"v"(vb),"i"(d0*4096+ks*1024+512):"memory");}
    asm volatile("s_waitcnt lgkmcnt(0)":::"memory");SBAR();
    #define PK(k) (bf16x8){lo[k][0],lo[k][1],lo[k][2],lo[k][3],hi[k][0],hi[k][1],hi[k][2],hi[k][3]}
    o[d0]=__builtin_amdgcn_mfma_f32_32x32x16_bf16(pa0,PK(0),o[d0],0,0,0);
    o[d0]=__builtin_amdgcn_mfma_f32_32x32x16_bf16(pa1,PK(1),o[d0],0,0,0);
    o[d0]=__builtin_amdgcn_mfma_f32_32x32x16_bf16(pa2,PK(2),o[d0],0,0,0);
    o[d0]=__builtin_amdgcn_mfma_f32_32x32x16_bf16(pa3,PK(3),o[d0],0,0,0);
    #undef PK
  }
}

#ifndef ATTN_STORE16
#define ATTN_STORE16(p,v) (*(u32x4*)(p)=(v))
#endif
template<int THRL> __device__ __forceinline__ void attn_unit(int b,int h,int qb,const bf16*Q,const bf16*__restrict__ K,const bf16*__restrict__ V,bf16*O,const float*__restrict__ CUMbh,float*__restrict__ SSQh,char*shm){
  int tid_=threadIdx.x; asm volatile("":"+v"(tid_));
  const int tid=tid_,lane=tid&63,r32=lane&31,hi=lane>>5; const int wid=__builtin_amdgcn_readfirstlane(tid>>6);
  const long rowbase=(long)b*SEQ; const int q0=qb*QB;
  const bf16*Qw=Q+(rowbase+q0+wid*QBLK)*PIN+h*D;
  const bf16*Kh=K+rowbase*PIN+h*D,*Vh=V+rowbase*PIN+h*D;
  const unsigned lds0=(unsigned)(uintptr_t)shm;
  const lds_cptr shm3=(lds_cptr)shm;
  float*wsf=(float*)(shm+LDS_WS)+wid*64;
  const bf16*ksrc=Kh+(long)lane*PIN+wid*8;
  const bf16*vsrc=Vh+(long)(16*(wid&3)+(lane>>2))*PIN+(wid>>2)*32+(lane&3)*8;
  const unsigned kdst=lds0+LDS_K+wid*1024, vdst=lds0+LDS_V+wid*1024;
  #define DMA_K(t,slot) glds16(ksrc+(long)(t)*KVBLK*PIN,(unsigned)__builtin_amdgcn_readfirstlane(kdst+(slot)))
  #define DMA_V(t,slot) glds16(vsrc+(long)(t)*KVBLK*PIN,(unsigned)__builtin_amdgcn_readfirstlane(vdst+(slot)))
  const int vb0=(int)(lds0+LDS_V)+((lane>>4)&1)*32+(lane&3)*8+(4*hi+((lane&15)>>2))*64;
  const char*Kbase=shm+LDS_K; bf16x8 kf[8];
  const lds_cptr kp0=shm3+LDS_K+hi*1024+r32*16; const lds_cptr vp0=shm3+LDS_V+((lane>>4)&1)*32+(lane&3)*8+(4*hi+((lane&15)>>2))*64;
  const int NT=(q0+QB)/KVBLK;
  DMA_K(0,0);DMA_V(0,0);DMA_K(1,SLOTB);
  bf16x8 qr[4];
  #pragma unroll
  for(int d0=0;d0<4;++d0)qr[d0]=*reinterpret_cast<const bf16x8*>(&Qw[(long)r32*PIN+d0*16+hi*8]);
  const float cbase=CUMbh[q0]; const float cq=CUMbh[q0+wid*QBLK+r32]-cbase;
  { __attribute__((address_space(3))) float*ckw=(__attribute__((address_space(3))) float*)(shm3+LDS_CK); int s0_=tid; asm volatile("":"+v"(s0_));
    _Pragma("nounroll") for(int s=s0_;s<q0+QB;s+=NW*64)ckw[s]=CUMbh[s]-cbase; }
  const __attribute__((address_space(3))) float*ckp=(const __attribute__((address_space(3))) float*)(shm3+LDS_CK)+4*hi;
  float mhat=-cq,l_reg=0.f;f32x16 o[2];o[0]=f32x16{};o[1]=f32x16{};f32x16 negm;
  #pragma unroll
  for(int r=0;r<16;++r)negm[r]=cq;
  asm volatile("":"+v"(negm));
  const int qrel=wid*QBLK+r32;
  #define BIAS(P0,P1,t) do{ const __attribute__((address_space(3))) float*cp_=ckp+(t)*KVBLK; \
    _Pragma("unroll") for(int g_=0;g_<4;++g_){ const f32x4_t c0_=*(const __attribute__((address_space(3))) f32x4_t*)(cp_+8*g_), c1_=*(const __attribute__((address_space(3))) f32x4_t*)(cp_+32+8*g_); \
      _Pragma("unroll") for(int j_=0;j_<4;++j_){ P0[4*g_+j_]-=c0_[j_]; P1[4*g_+j_]-=c1_[j_]; } SBAR(); } }while(0)
  #define CMASK(P0,P1,t) do{int jb_=(t)-(NT-4); if(jb_>=0)cmask(P0,P1,jb_,qrel,hi);}while(0)
  bool resc=false;
  #define START(P0,P1) do{ const float rm=rowmax(P0,P1); resc=false; \
    { const float dl=rm; mhat=fadd_s(mhat,dl); \
      _Pragma("unroll") for(int r=0;r<16;++r){P0[r]=fsub_s(P0[r],dl);P1[r]=fsub_s(P1[r],dl);} \
      _Pragma("unroll") for(int r=0;r<16;++r)negm[r]=-mhat; asm volatile("":"+v"(negm)); } \
    _Pragma("unroll") for(int r=0;r<16;++r)P0[r]=__builtin_amdgcn_exp2f(P0[r]); }while(0)
  #define RESC() do{ if(resc){ asm volatile("s_waitcnt lgkmcnt(0)":::"memory"); \
      _Pragma("unroll") for(int d_=0;d_<2;++d_) _Pragma("unroll") for(int r=0;r<16;++r)o[d_][r]*=wsf[crow(r,hi)]; } }while(0)
  f32x16 pA0,pA1,pB0,pB1;
  int sl_prev=0,sl_cur=0,sl_next=SLOTB;
  #define ROT() do{sl_prev=sl_cur;sl_cur=sl_next;sl_next=(sl_next==(NSLOT-1)*SLOTB)?0:sl_next+SLOTB;}while(0)
  DMA_K(2,2*SLOTB);
  WAIT_BAR(3);
  qkt(pA0,pA1,Kbase,qr,negm,r32,hi);asm volatile("s_nop 15\n\ts_nop 7":"+v"(pA0),"+v"(pA1));BIAS(pA0,pA1,0);CMASK(pA0,pA1,0);
  START(pA0,pA1);
  _Pragma("unroll") for(int r=0;r<16;++r)pA1[r]=__builtin_amdgcn_exp2f(pA1[r]);
  WAIT_BAR(0);
  DMA_K(3,0);DMA_V(1,SLOTB);
  ROT();
  kload8(kf,kp0+sl_cur);
  WAIT_BAR(2);
  s16x4 vlo[8],vhi[8]; u32x4 pw0,pw1,pw2,pw3;
  #define PKW(P,B) cvtpk_s(P[B],P[B+1])
  #define PAF(k) __builtin_bit_cast(bf16x8,pw##k)
  #define VFR(i) (bf16x8){vlo[i][0],vlo[i][1],vlo[i][2],vlo[i][3],vhi[i][0],vhi[i][1],vhi[i][2],vhi[i][3]}
  #define PIN(x) asm volatile("":"+v"(x))
  #define MX3(a,b,c) __builtin_fmaxf(__builtin_fmaxf((a),(b)),(c))
  #define GAPA(MF,A0,A1,A2,A3,W0,W1,PW) do{ MF; sacc+=A0; sacc+=A1; sacc+=A2; sacc+=A3; PIN(sacc); W0; W1; PIN(PW); SBAR(); }while(0)
  #define EX(v) __builtin_amdgcn_exp2f(v)
  #define GAPB(MF,X,B) do{ MF; X[B]=EX(X[B]); X[B+1]=EX(X[B+1]); X[B+2]=EX(X[B+2]); X[B+3]=EX(X[B+3]); PIN(X); SBAR(); }while(0)
  #define VRD(i) do{ vlo[i]=vtr(vp_+(((i)>>2)*4096+((i)&3)*1024)); vhi[i]=vtr(vp_+(((i)>>2)*4096+((i)&3)*1024+512)); }while(0)
  #define KRD(G,j) do{ if(G){ kload2(kf,kp0+sl_next,j); SBAR(); } }while(0)
  #define STEP(C0,C1,P0,P1,t,GK,GV,GL) do{ SBAR(); \
    const lds_cptr vp_=vp0+sl_prev; \
    VRD(0); SBAR(); float sacc=(P0[0]+P0[1]); \
    GAPA(C0=__builtin_amdgcn_mfma_f32_32x32x16_bf16(kf[0],qr[0],negm,0,0,0), P0[2],P0[3],P0[4],P0[5],     pw0[0]=PKW(P0,0), pw0[1]=PKW(P0,2), pw0); \
    VRD(4); SBAR(); GAPA(C1=__builtin_amdgcn_mfma_f32_32x32x16_bf16(kf[1],qr[0],negm,0,0,0), P0[6],P0[7],P0[8],P0[9],     pw0[2]=PKW(P0,4), pw0[3]=PKW(P0,6), pw0); \
    VRD(1); SBAR(); GAPA(C0=__builtin_amdgcn_mfma_f32_32x32x16_bf16(kf[2],qr[1],C0,0,0,0),   P0[10],P0[11],P0[12],P0[13], pw1[0]=PKW(P0,8), pw1[1]=PKW(P0,10), pw1); \
    VRD(5); SBAR(); GAPA(C1=__builtin_amdgcn_mfma_f32_32x32x16_bf16(kf[3],qr[1],C1,0,0,0),   P0[14],P0[15],P1[0],P1[1],   pw1[2]=PKW(P0,12),pw1[3]=PKW(P0,14), pw1); \
    VRD(2); SBAR(); GAPA(C0=__builtin_amdgcn_mfma_f32_32x32x16_bf16(kf[4],qr[2],C0,0,0,0),   P1[2],P1[3],P1[4],P1[5],     pw2[0]=PKW(P1,0), pw2[1]=PKW(P1,2), pw2); \
    VRD(6); SBAR(); GAPA(C1=__builtin_amdgcn_mfma_f32_32x32x16_bf16(kf[5],qr[2],C1,0,0,0),   P1[6],P1[7],P1[8],P1[9],     pw2[2]=PKW(P1,4), pw2[3]=PKW(P1,6), pw2); \
    VRD(3); SBAR(); GAPA(C0=__builtin_amdgcn_mfma_f32_32x32x16_bf16(kf[6],qr[3],C0,0,0,0),   P1[10],P1[11],P1[12],P1[13], pw3[0]=PKW(P1,8), pw3[1]=PKW(P1,10), pw3); \
    VRD(7); SBAR(); GAPA(C1=__builtin_amdgcn_mfma_f32_32x32x16_bf16(kf[7],qr[3],C1,0,0,0),   P1[14],P1[15],0.f,0.f,       pw3[2]=PKW(P1,12),pw3[3]=PKW(P1,14), pw3); \
    l_reg+=sacc; \
    if(GK){DMA_K((t)+3,sl_cur);} if(GV){DMA_V((t)+1,sl_next);} \
    BIAS(C0,C1,t); CMASK(C0,C1,t); \
    { float a=MX3(C0[0],C0[1],C1[0]),b=MX3(C0[2],C0[3],C1[1]); a=MX3(a,C1[2],C1[3]); \
      _Pragma("unroll") for(int r=4;r<16;r+=4){a=MX3(a,C0[r],C0[r+1]);b=MX3(b,C0[r+2],C0[r+3]);a=MX3(a,C1[r],C1[r+1]);b=MX3(b,C1[r+2],C1[r+3]);} \
      float rm=__builtin_fmaxf(a,b); { auto rr=__builtin_amdgcn_permlane32_swap(__float_as_uint(rm),__float_as_uint(rm),false,false); rm=__builtin_fmaxf(__uint_as_float(rr[0]),__uint_as_float(rr[1])); } \
      resc=false; \
      if(__builtin_expect(__any(rm>(float)THRL),0)){ const float dl=__builtin_fmaxf(rm,0.f); mhat+=dl; \
        _Pragma("unroll") for(int r=0;r<16;++r){C0[r]-=dl;C1[r]-=dl;} \
        _Pragma("unroll") for(int r=0;r<16;++r)negm[r]=-mhat; asm volatile("":"+v"(negm)); \
        const float f=__builtin_amdgcn_exp2f(-dl); l_reg*=f; if(hi==0)wsf[r32]=f; resc=true; } } \
    SBAR(); \
    GAPB(o[0]=__builtin_amdgcn_mfma_f32_32x32x16_bf16(PAF(0),VFR(0),o[0],0,0,0), C0,0); \
    GAPB(o[1]=__builtin_amdgcn_mfma_f32_32x32x16_bf16(PAF(0),VFR(4),o[1],0,0,0), C0,4); \
    KRD(GL,0); GAPB(o[0]=__builtin_amdgcn_mfma_f32_32x32x16_bf16(PAF(1),VFR(1),o[0],0,0,0), C0,8); \
    KRD(GL,1); GAPB(o[1]=__builtin_amdgcn_mfma_f32_32x32x16_bf16(PAF(1),VFR(5),o[1],0,0,0), C0,12); \
    KRD(GL,2); GAPB(o[0]=__builtin_amdgcn_mfma_f32_32x32x16_bf16(PAF(2),VFR(2),o[0],0,0,0), C1,0); \
    KRD(GL,3); GAPB(o[1]=__builtin_amdgcn_mfma_f32_32x32x16_bf16(PAF(2),VFR(6),o[1],0,0,0), C1,4); \
    GAPB(o[0]=__builtin_amdgcn_mfma_f32_32x32x16_bf16(PAF(3),VFR(3),o[0],0,0,0), C1,8); \
    GAPB(o[1]=__builtin_amdgcn_mfma_f32_32x32x16_bf16(PAF(3),VFR(7),o[1],0,0,0), C1,12); \
    }while(0)
  int t=1;
  #undef CMASK
  #define CMASK(P0,P1,t) do{}while(0)
  for(;t+5<NT;t+=2){
    STEP(pB0,pB1,pA0,pA1,t,true,true,true);     WAIT_BAR(2); RESC(); ROT();
    STEP(pA0,pA1,pB0,pB1,t+1,true,true,true);   WAIT_BAR(2); RESC(); ROT();
  }
  #undef CMASK
  #define CMASK(P0,P1,t) do{int jb_=(t)-(NT-4); if(jb_>=0)cmask(P0,P1,jb_,qrel,hi);}while(0)
  #define ENDW(tt) do{ if((tt)+3<NT){WAIT_BAR(2);} else if((tt)+2<NT){WAIT_BAR(1);} else {WAIT_BAR(0);} }while(0)
  for(;t+1<NT;t+=2){
    STEP(pB0,pB1,pA0,pA1,t,(t+3<NT),(t+1<NT),(t+1<NT));       ENDW(t);   RESC(); ROT();
    STEP(pA0,pA1,pB0,pB1,t+1,(t+4<NT),(t+2<NT),(t+2<NT));     ENDW(t+1); RESC(); ROT();
  }
  STEP(pB0,pB1,pA0,pA1,NT-1,false,false,false); RESC();
  { float sacc=pB0[0]+pB0[1]; _Pragma("unroll") for(int r=2;r<16;++r)sacc+=pB0[r]; _Pragma("unroll") for(int r=0;r<16;++r)sacc+=pB1[r]; l_reg+=sacc;
    pw0=(u32x4){PKW(pB0,0),PKW(pB0,2),PKW(pB0,4),PKW(pB0,6)};pw1=(u32x4){PKW(pB0,8),PKW(pB0,10),PKW(pB0,12),PKW(pB0,14)};pw2=(u32x4){PKW(pB1,0),PKW(pB1,2),PKW(pB1,4),PKW(pB1,6)};pw3=(u32x4){PKW(pB1,8),PKW(pB1,10),PKW(pB1,12),PKW(pB1,14)};
    SBAR(); pv(o,vb0+sl_cur,PAF(0),PAF(1),PAF(2),PAF(3)); }
  #undef PKW
  #undef PAF
  #undef VFR
  #undef PIN
  #undef MX3
  #undef GAPA
  #undef GAPB
  #undef EX
  #undef VRD
  #undef KRD
  #undef STEP
  #undef ENDW
  {auto rr=__builtin_amdgcn_permlane32_swap(__float_as_uint(l_reg),__float_as_uint(l_reg),false,false);l_reg=__uint_as_float(rr[0])+__uint_as_float(rr[1]);}
  if(hi==0)wsf[32+r32]=l_reg;asm volatile("s_waitcnt lgkmcnt(0)":::"memory");
  float rli[16];
  #pragma unroll
  for(int r=0;r<16;++r)rli[r]=__builtin_amdgcn_rcpf(wsf[32+crow(r,hi)]);
  bf16*Ow=O+(rowbase+q0+wid*QBLK)*POUT+h*D; float*Sw=SSQh+(rowbase+q0+wid*QBLK)*16;
  { bf16*stg=(bf16*)(shm+LDS_OST)+wid*2048;
    #pragma unroll
    for(int r=0;r<16;++r){const int orow=crow(r,hi);
      #pragma unroll
      for(int d0=0;d0<2;++d0)stg[orow*64+d0*32+r32]=__float2bfloat16(o[d0][r]*rli[r]);}
    asm volatile("s_waitcnt lgkmcnt(0)":::"memory");
    #pragma unroll
    for(int i=0;i<4;++i){const int row=i*8+(lane>>3),ch=lane&7; const u32x4 v=*(const u32x4*)(stg+row*64+ch*8); ATTN_STORE16(Ow+(long)row*POUT+ch*8,v);
      float sq=0.f;
      #pragma unroll
      for(int w_=0;w_<4;++w_){const float lo_=__uint_as_float(v[w_]<<16),hi_=__uint_as_float(v[w_]&0xffff0000u);sq+=lo_*lo_+hi_*hi_;}
      sq+=__shfl_xor(sq,1);sq+=__shfl_xor(sq,2);sq+=__shfl_xor(sq,4); if(ch==0)Sw[row*16]=sq;} }
  asm volatile("s_waitcnt lgkmcnt(0)\n\ts_barrier":::"memory");
  #undef DMA_K
  #undef DMA_V
  #undef CMASK
  #undef BIAS
  #undef START
  #undef RESC
  #undef ROT
}
constexpr int ATTN_LDS_BYTES=LDS_BYTES;

__device__ __forceinline__ void sb_unit(int b,int h,int qb,const bf16*Q,const bf16*__restrict__ K,const bf16*__restrict__ V,bf16*O,float*__restrict__ SSQh,char*shm){
  int tid_=threadIdx.x; asm volatile("":"+v"(tid_));
  const int tid=tid_,lane=tid&63,r32=lane&31,hi=lane>>5; const int wid=__builtin_amdgcn_readfirstlane(tid>>6);
  const long rowbase=(long)b*SEQ; const int q0=qb*QB;
  const bf16*Qw=Q+(rowbase+q0+wid*QBLK)*PIN+h*D;
  const bf16*Kh=K+rowbase*PIN+h*D,*Vh=V+rowbase*PIN+h*D;
  const unsigned lds0=(unsigned)(uintptr_t)shm;
  const bf16*ksrc=Kh+(long)lane*PIN+wid*8;
  const bf16*vsrc=Vh+(long)(16*(wid&3)+(lane>>2))*PIN+(wid>>2)*32+(lane&3)*8;
  const unsigned kdst=lds0+LDS_K+wid*1024, vdst=lds0+LDS_V+wid*1024;
  const int vb0=(int)(lds0+LDS_V)+((lane>>4)&1)*32+(lane&3)*8+(4*hi+((lane&15)>>2))*64;
  const char*Kbase=shm+LDS_K;
  const int NT=(q0+QB)/KVBLK;
  #define SB_DMA(i,slot) do{ const long kt_=(long)(NT-1-(i)); glds16(ksrc+kt_*KVBLK*PIN,(unsigned)__builtin_amdgcn_readfirstlane(kdst+(slot))); glds16(vsrc+kt_*KVBLK*PIN,(unsigned)__builtin_amdgcn_readfirstlane(vdst+(slot))); }while(0)
  bf16x8 qr[4];
  #pragma unroll
  for(int d0=0;d0<4;++d0)qr[d0]=*reinterpret_cast<const bf16x8*>(&Qw[(long)r32*PIN+d0*16+hi*8]);
  SB_DMA(0,0); SB_DMA(1,SLOTB);
  f32x16 o[2];o[0]=f32x16{};o[1]=f32x16{};
  float Rc=1.f;
  const int qrel=wid*QBLK+r32;
  int sl_cur=0,sl_n1=SLOTB,sl_n2=2*SLOTB;
  volatile __attribute__((address_space(3))) unsigned*flg=(volatile __attribute__((address_space(3))) unsigned*)((lds_cptr)shm+LDS_WS);
  for(int i=0;i<NT;++i){
    if(i+1<NT){WAIT_BAR(2);}else{WAIT_BAR(0);}
    if(i>0){ const int pb=((i-1)&1)*8; unsigned all_=flg[pb]&flg[pb+1]&flg[pb+2]&flg[pb+3]&flg[pb+4]&flg[pb+5]&flg[pb+6]&flg[pb+7]; if(__builtin_amdgcn_readfirstlane(all_))break; }
    if(i+2<NT)SB_DMA(i+2,sl_n2);
    f32x16 p0,p1; { f32x16 z=f32x16{}; asm volatile("":"+v"(z)); qkt(p0,p1,Kbase+sl_cur,qr,z,r32,hi); }
    f32x16 s0,s1;
    #pragma unroll
    for(int r=0;r<16;++r){
      const float za=__builtin_amdgcn_fmed3f(p0[r],-100.f,100.f), zb=__builtin_amdgcn_fmed3f(p1[r],-100.f,100.f);
      p0[r]=__builtin_amdgcn_exp2f(za); p1[r]=__builtin_amdgcn_exp2f(zb);
      s0[r]=__builtin_amdgcn_rcpf(1.f+p0[r]); s1[r]=__builtin_amdgcn_rcpf(1.f+p1[r]); }
    if(i<4){
      const int kb=64*(3-i)+4*hi;
      #pragma unroll
      for(int r=0;r<16;++r){ const int kv=kb+(r&3)+8*(r>>2); if(kv>=qrel){p0[r]=0.f;s0[r]=1.f;} if(kv+32>=qrel){p1[r]=0.f;s1[r]=1.f;} }
    }
    float gp[8],pp[8];
    #pragma unroll
    for(int g=0;g<4;++g){
      s0[4*g+2]*=s0[4*g+3]; s0[4*g+1]*=s0[4*g+2]; s0[4*g]*=s0[4*g+1]; gp[g]=s0[4*g];
      s1[4*g+2]*=s1[4*g+3]; s1[4*g+1]*=s1[4*g+2]; s1[4*g]*=s1[4*g+1]; gp[4+g]=s1[4*g]; }
    #pragma unroll
    for(int g=0;g<8;++g){ auto rr=__builtin_amdgcn_permlane32_swap(__float_as_uint(gp[g]),__float_as_uint(gp[g]),false,false); pp[g]=__uint_as_float(hi?rr[0]:rr[1]); }
    float st=Rc, outer[8];
    #pragma unroll
    for(int g=7;g>=0;--g){ outer[g]=hi?st:st*pp[g]; st=st*(gp[g]*pp[g]); }
    Rc=st;
    { const unsigned dn=__all(Rc==0.f)?1u:0u; if(lane==0)flg[(i&1)*8+wid]=dn; }
    #pragma unroll
    for(int r=0;r<16;++r){ p0[r]=p0[r]*(s0[r]*outer[r>>2]); p1[r]=p1[r]*(s1[r]*outer[4+(r>>2)]); }
    u32x4 pw0,pw1,pw2,pw3;
    pw0=(u32x4){cvtpk_s(p0[0],p0[1]),cvtpk_s(p0[2],p0[3]),cvtpk_s(p0[4],p0[5]),cvtpk_s(p0[6],p0[7])};
    pw1=(u32x4){cvtpk_s(p0[8],p0[9]),cvtpk_s(p0[10],p0[11]),cvtpk_s(p0[12],p0[13]),cvtpk_s(p0[14],p0[15])};
    pw2=(u32x4){cvtpk_s(p1[0],p1[1]),cvtpk_s(p1[2],p1[3]),cvtpk_s(p1[4],p1[5]),cvtpk_s(p1[6],p1[7])};
    pw3=(u32x4){cvtpk_s(p1[8],p1[9]),cvtpk_s(p1[10],p1[11]),cvtpk_s(p1[12],p1[13]),cvtpk_s(p1[14],p1[15])};
    SBAR(); pv(o,vb0+sl_cur,__builtin_bit_cast(bf16x8,pw0),__builtin_bit_cast(bf16x8,pw1),__builtin_bit_cast(bf16x8,pw2),__builtin_bit_cast(bf16x8,pw3));
    { const int t_=sl_cur; sl_cur=sl_n1; sl_n1=sl_n2; sl_n2=t_; }
  }
  #undef SB_DMA
  bf16*Ow=O+(rowbase+q0+wid*QBLK)*POUT+h*D; float*Sw=SSQh+(rowbase+q0+wid*QBLK)*16;
  { bf16*stg=(bf16*)(shm+LDS_OST)+wid*2048;
    #pragma unroll
    for(int r=0;r<16;++r){const int orow=crow(r,hi);
      #pragma unroll
      for(int d0=0;d0<2;++d0)stg[orow*64+d0*32+r32]=__float2bfloat16(o[d0][r]);}
    asm volatile("s_waitcnt lgkmcnt(0)":::"memory");
    #pragma unroll
    for(int i=0;i<4;++i){const int row=i*8+(lane>>3),ch=lane&7; const u32x4 v=*(const u32x4*)(stg+row*64+ch*8); ATTN_STORE16(Ow+(long)row*POUT+ch*8,v);
      float sq=0.f;
      #pragma unroll
      for(int w_=0;w_<4;++w_){const float lo_=__uint_as_float(v[w_]<<16),hi_=__uint_as_float(v[w_]&0xffff0000u);sq+=lo_*lo_+hi_*hi_;}
      sq+=__shfl_xor(sq,1);sq+=__shfl_xor(sq,2);sq+=__shfl_xor(sq,4); if(ch==0)Sw[row*16]=sq;} }
  asm volatile("s_waitcnt vmcnt(0) lgkmcnt(0)\n\ts_barrier":::"memory");
}
template<int THRL=8> __device__ __forceinline__ void attn_phase(char*lds,const bf16*PROJ,const float*CUM,bf16*OMIX,float*SSQ,int bh,int role){
  const int b=bh>>3,h=bh&7;
  const int nf=role<5?2:6;
  for(int i=0;i<nf;++i){ const int qb=role<5?(i==0?15-role:6+role):5-i;
    attn_unit<THRL>(b,h,qb,PROJ,PROJ+512,PROJ+1024,OMIX,CUM+(size_t)bh*SEQ,SSQ+h,lds); }
  const int sb0=role<3?3+3*role:(role==3?12:(role==4?14:0)), ns=(role==3||role==4)?2:3;
  for(int i=0;i<ns;++i) sb_unit(b,h,sb0+i,PROJ+1536,PROJ+2048,PROJ+2560,OMIX+512,SSQ+8+h,lds);
}
template<int THRL=8> __device__ __forceinline__ void attn_phase8(char*lds,const bf16*PROJ,const float*CUM,bf16*OMIX,float*SSQ,int vcu){
  const int bh=vcu>>3,s=vcu&7,b=bh>>3,h=bh&7;
  if(bh>=32)return;
  for(int i=0;i<4;++i){ const int qb=(i&1)?15-s:s;
    if(i<2)attn_unit<THRL>(b,h,qb,PROJ,PROJ+512,PROJ+1024,OMIX,CUM+(size_t)bh*SEQ,SSQ+h,lds);
    else   sb_unit(b,h,qb,PROJ+1536,PROJ+2048,PROJ+2560,OMIX+512,SSQ+8+h,lds); }
}
#undef SBAR
#undef WAIT_BAR
}

template <int NT, bool UP> __device__ __forceinline__ int moe_prepare(const unsigned* __restrict__ CNT, const int* __restrict__ LIST, const float* __restrict__ RSTD2, const float* __restrict__ RW,
                                                                     int* __restrict__ TBG, int bx, LAS unsigned char* L) {
    int tid_ = threadIdx.x; asm volatile("" : "+v"(tid_)); const int tid = tid_;
    LAS int* tb = (LAS int*)(L + TB_OFF); LAS int* tbE = tb + 64; LAS int* tbC = tb + 128; LAS int* cntl = tb + 192; LAS int* udl = tb + 224; LAS int* tabA = (LAS int*)(L + TAB_OFF); LAS float* tabB = (LAS float*)(L + TAB2_OFF);
    if (tid < 64) {
        const int cn = tid < NE ? (int)CNT[tid] : 0, nt = (cn + 255) >> 8, rem = cn & 255, ch = (rem != 0 && rem <= 128) ? 1 : 0;
        int a = nt, c = ch;
#pragma unroll
        for (int o = 1; o < 32; o <<= 1) { const int ta = __shfl_up(a, o), tc = __shfl_up(c, o); if ((tid & 63) >= o) { a += ta; c += tc; } }
        if (tid < NE) { tb[tid + 1] = a; tbC[tid + 1] = c; tbE[tid + 1] = a - c; cntl[tid] = cn; }
        if (tid == 0) { tb[0] = 0; tbC[0] = 0; tbE[0] = 0; }
    }
    LDS_WAIT(); __syncthreads();
    if (bx == 0 && tid <= NE) TBG[tid] = tb[tid];
    pg8::MoeOrder S{NT, bx, tb, tbE, tbC, cntl, tabA};
    if (tid < pg8::MOE_MAXU) { pg8::Unit u; const bool ok = S.next(tid, u); udl[3 * tid] = ok ? u.pm : -1; udl[3 * tid + 1] = u.pn; udl[3 * tid + 2] = u.nr; }
    LDS_WAIT(); __syncthreads();
    int nun = 0;
#pragma unroll
    for (int i = 0; i < pg8::MOE_MAXU; ++i) nun += (udl[3 * i] >= 0) ? 1 : 0;
    int slot[5];
#pragma unroll
    for (int j = 0; j < 5; ++j) { const int idx = tid + NTHREADS * j, ui = idx >> 8, r = idx & 255; slot[j] = 0;
        if (ui < nun) { const int e = udl[3 * ui + 1] / NT, mt = udl[3 * ui] - tb[e], cnt = cntl[e], p = mt * 256 + r; slot[j] = LIST[(size_t)e * LIST_CAP + (p < cnt ? p : cnt - 1)]; } }
#pragma unroll
    for (int j = 0; j < 5; ++j) { const int idx = tid + NTHREADS * j, ui = idx >> 8;
        if (ui < nun) { if (UP) { tabA[idx] = slot[j] >> 2; tabB[idx] = RSTD2[slot[j] >> 2]; } else tabB[idx] = RW[slot[j]]; } }
    VM_WAIT(); LDS_WAIT(); __syncthreads();
    return nun;
}

__global__ void __launch_bounds__(NTHREADS, 2) mega_fwd(Args a) {
    extern __shared__ __attribute__((aligned(16))) unsigned char lds[];
    LAS unsigned char* L = (LAS unsigned char*)lds;
    volatile LAS unsigned* MISC = (volatile LAS unsigned*)(L + MISC_OFF);
    const int tid = threadIdx.x, lane = tid & 63, wave = __builtin_amdgcn_readfirstlane(tid >> 6);
    const int G = gridDim.x, bx = blockIdx.x, vcu = (G % 8 == 0) ? (bx % 8) * (G / 8) + bx / 8 : bx;
    const int gw = vcu * NWAVES + wave, NGW = G * NWAVES;
    const bool cvt_role = (vcu & 31) >= 24;
    const int cvt_first = ((vcu >> 5) * 8 + ((vcu & 31) - 24)) * NWAVES + wave;
    unsigned char* ws = a.ws;
    unsigned* CTL = (unsigned*)(ws + WS_CTL);
    bf16_t* WINT = (bf16_t*)(ws + WS_WINT); bf16_t* WOUTT = (bf16_t*)(ws + WS_WOUTT); float* WR = (float*)(ws + WS_WR); float* CUM = (float*)(ws + WS_CUM);
    float* SSQ = (float*)(ws + WS_SSQ); float* RSTD2 = (float*)(ws + WS_RSTD2); float* RW = (float*)(ws + WS_RW); int* SLOTEP = (int*)(ws + WS_SLOTEP); int* TBG = (int*)(ws + WS_TBG); int* LIST = (int*)(ws + WS_LIST); float* FLOG = (float*)(ws + WS_FLOG);
    bf16_t* XN = (bf16_t*)(ws + WS_XN); bf16_t* PROJ = (bf16_t*)(ws + WS_PROJ); bf16_t* OMIX = (bf16_t*)(ws + WS_OMIX); bf16_t* X1B = (bf16_t*)(ws + WS_X1B);
    bf16_t* W1T = (bf16_t*)(ws + WS_W1T); bf16_t* W2T = (bf16_t*)(ws + WS_W2T); bf16_t* H = (bf16_t*)(ws + WS_H); bf16_t* Y = (bf16_t*)(ws + WS_Y);
    unsigned* CNT = CTL + CW_CNT;
    for (int u = tid; u < (LDS_BYTES - LDSCTL_OFF) / 4; u += NTHREADS) ((LAS unsigned*)(L + LDSCTL_OFF))[u] = 0u;
    __syncthreads();
    XcdBarrier bar = xcd_barrier_post(CTL + CW_BAR, MISC + 8);

    REPS(0) {
        LAS float* scr = (LAS float*)(L + RING_OFF + wave * 8448);
        LAS float* wf = (LAS float*)(L + RING_OFF + 98304);
        for (int i = tid; i < DM * 8; i += NTHREADS) { const int k = i >> 3; wf[i] = a.w_in[(size_t)k * WIN_N + 1536 + (i & 7)] * a.g1[k]; }
        LDS_WAIT(); __syncthreads();
        constexpr int I_IN = (DM / 64) * (NPROJ / 32), I_OUT = (DM / 64) * (DM / 32);
        for (int it = gw; it < I_IN + I_OUT; it += NGW) {
            TrItem t; f32x4 v[8];
            if (it < I_IN) { t.W = a.w_in; t.WT = WINT; t.gA = a.g1; t.gB = nullptr; t.K = DM; t.Nin = WIN_N; t.Nout = NPROJ; t.mode = 1; t.gsplit = DM; t.item = it; t.nbsh = -1; }
            else { t.W = a.w_out; t.WT = WOUTT; t.gA = a.g_fox; t.gB = a.g_sb; t.K = DM; t.Nin = DM; t.Nout = DM; t.mode = 0; t.gsplit = GW; t.item = it - I_IN; t.nbsh = 5; }
            tr_load<false>(t, lane, v); tr_store(t, lane, v, scr);
        }
        if (!OVERLAP_CVT) convert_experts(a.w1, a.w2, a.g2, W1T, W2T, gw, NGW, N_EXP_ITEMS, lane, scr);
        for (int i = gw * 64 + lane; i < DM * NE; i += NGW * 64) WR[i] = a.w_router[i] * a.g2[i >> 5];
        for (int row = gw; row < M; row += NGW) rms1_row(a.x, wf, a.b_f, XN, FLOG, row, lane);
    }
    xcd_barrier(bar); if (REP_PHASE == 8) xcd_barrier(bar);
    REPS(1) {
    if (vcu < NB * NH) cumsum_wg(FLOG, CUM, vcu, (LAS float*)(L + RING_OFF));
    if (OPT_GEMM) {
        if (OVERLAP_CVT && cvt_role) convert_experts(a.w1, a.w2, a.g2, W1T, W2T, cvt_first, 64 * NWAVES, CVT_SPLIT, lane, (LAS float*)(L + RING_OFF + wave * 8448));
        else {
        pg8::Gemm g{XN, WINT, DM}; pg8::StaticOrder S; if (OVERLAP_CVT) S.init(M, NPROJ, 192, (vcu & 31) * 8 + (vcu >> 5)); else S.init(M, NPROJ, G, bx); pg8::EpiProj E{PROJ};
        pg8::gemm_phase<pg8::EpiProj, pg8::StaticOrder, true, false>(L + RING_OFF, g, S, E);
        }
    } else { for (int it = gw; it < (M / 16) * (NPROJ / 64); it += NGW) nv_inproj(XN, WINT, PROJ, it, lane); }
    }
    xcd_barrier(bar); if (REP_PHASE == 8) xcd_barrier(bar);
    REPS(2) if (OPT_ATTN) {
        static_assert(attn_body::ATTN_LDS_BYTES <= RING_BYTES, "attention scratch inside the ring region");
        if (OVERLAP_CVT) {
            const int xl = vcu >> 5, l = vcu & 31;
            if (cvt_role) convert_experts(a.w1, a.w2, a.g2, W1T, W2T, CVT_SPLIT + cvt_first, 64 * NWAVES, N_EXP_ITEMS, lane, (LAS float*)(L + RING_OFF + wave * 8448));
            if (l < 24) attn_body::attn_phase<8>((char*)lds + RING_OFF, (const attn_body::bf16*)PROJ, CUM, (attn_body::bf16*)OMIX, SSQ, xl * 4 + l / 6, l % 6);
        } else attn_body::attn_phase8<8>((char*)lds + RING_OFF, (const attn_body::bf16*)PROJ, CUM, (attn_body::bf16*)OMIX, SSQ, vcu);
    } else {
        LAS unsigned char* wl = L + RING_OFF + wave * 16640;
        for (int u = gw; u < 4096; u += NGW) {
            const int i = u >> 11, idx = u & 2047, type = idx & 1, bh = (idx >> 1) & 31, j = (idx >> 6) & 31; const int qblk = (i == 0) ? j : 63 - j;
            if (type == 0) nv_attn<0>(PROJ, CUM, OMIX, SSQ, bh, qblk, lane, wl); else nv_attn<1>(PROJ, CUM, OMIX, SSQ, bh, qblk, lane, wl);
        }
    }
    xcd_barrier(bar); if (REP_PHASE == 8) xcd_barrier(bar);
    REPS(3) if (OPT_GEMM) {
        pg8::Gemm g{OMIX, WOUTT, DM}; pg8::StaticOrder S; S.init(M, DM, G, bx);
        LAS float* ratio = (LAS float*)(L + TAB_OFF); LAS float* rsb = (LAS float*)(L + TAB_OFF + 1024);
        pg8::Unit u0;
        if (S.next(0, u0) && tid < 256) { const float* sp = SSQ + (size_t)(u0.pm * 256 + tid) * 16; float sf = 0.f, s2 = 0.f;
#pragma unroll
            for (int h = 0; h < 8; ++h) { sf += sp[h]; s2 += sp[8 + h]; }
            const float rf = rsqrtf(sf * (1.f / GW) + EPS), rs = rsqrtf(s2 * (1.f / GW) + EPS); ratio[tid] = rf / rs; rsb[tid] = rs; }
        VM_WAIT(); LDS_WAIT(); __syncthreads();
        pg8::EpiWout E{a.x, a.out, X1B, ratio, rsb};
        pg8::gemm_phase<pg8::EpiWout, pg8::StaticOrder, false, false>(L + RING_OFF, g, S, E);
    } else { for (int it = gw; it < (M / 16) * (DM / 64); it += NGW) nv_wout(OMIX, WOUTT, SSQ, a.x, a.out, X1B, it, lane); }
    xcd_barrier(bar); if (REP_PHASE == 8) xcd_barrier(bar);
    if (REP_PHASE == 4) { for (int t64 = vcu; t64 < M / 64; t64 += G) router_wg(a.out, WR, a.b_router, (float*)H, (float*)H + M, (int*)Y, (int*)Y + NE * LIST_CAP, CNT + 64, t64 * 64, L + RING_OFF); }
    if (OPT_ROUTER) { for (int t64 = vcu; t64 < M / 64; t64 += G) router_wg(a.out, WR, a.b_router, RSTD2, RW, LIST, SLOTEP, CNT, t64 * 64, L + RING_OFF); }
    else { for (int it = gw; it < M / 2; it += NGW) nv_router(a.out, WR, a.b_router, RSTD2, RW, LIST, SLOTEP, CNT, it, lane); }
    xcd_barrier(bar); if (REP_PHASE == 8) xcd_barrier(bar);
    LAS int* tb = (LAS int*)(L + TB_OFF); LAS int* tbE = tb + 64; LAS int* tbC = tb + 128; LAS int* cntl = tb + 192; LAS int* udl = tb + 224; LAS int* tabA = (LAS int*)(L + TAB_OFF); LAS int* tabB = (LAS int*)(L + TAB2_OFF);
    REPS(5) if (OPT_GEMM) {
        const int nun = moe_prepare<8, true>(CNT, LIST, RSTD2, RW, TBG, bx, L);
        pg8::Gemm g{X1B, W1T, DM}; pg8::EpiMoe1 E{H, a.b1, (const LAS float*)tabB}; pg8::ListOrder SL{udl, nun, tabA};
        pg8::gemm_phase<pg8::EpiMoe1, pg8::ListOrder, true, true>(L + RING_OFF, g, SL, E);
    } else {
    for (int g = gw; g < MAX_TILES * 16; g += NGW) {
        int e, base, p0, cnt; if (!moe_tile(CNT, g, e, base, p0, cnt)) continue;
        for (int cg = 0; cg < DFF / 32; ++cg) nv_moe1(X1B, W1T, a.b1, RSTD2, LIST, H, e, base, p0, cnt, cg, lane);
    } }
    xcd_barrier(bar); if (REP_PHASE == 8) xcd_barrier(bar);
    REPS(6) if (OPT_GEMM) {
        const int nun = moe_prepare<4, false>(CNT, LIST, RSTD2, RW, TBG, bx, L);
        pg8::Gemm g{H, W2T, DM}; pg8::EpiMoe2 E{Y, a.b2, (const LAS float*)tabB}; pg8::ListOrder SL{udl, nun, tabA};
        pg8::gemm_phase<pg8::EpiMoe2, pg8::ListOrder, true, false>(L + RING_OFF, g, SL, E);
    } else {
    for (int g = gw; g < MAX_TILES * 16; g += NGW) {
        int e, base, p0, cnt; if (!moe_tile(CNT, g, e, base, p0, cnt)) continue;
        for (int cg = 0; cg < DM / 64; ++cg) nv_moe2(H, W2T, a.b2, RW, LIST, Y, e, base, p0, cnt, cg, lane);
    } }
    xcd_barrier(bar); if (REP_PHASE == 8) xcd_barrier(bar);
    if (REP_PHASE == 7) { for (int row = gw; row < M; row += NGW) final_row(a.out, Y, SLOTEP, TBG, a.gf, (float*)H, row, lane); }
    for (int row = gw; row < M; row += NGW) final_row(a.out, Y, SLOTEP, TBG, a.gf, a.out, row, lane);
}

extern "C" void kernel_launch(void* const* d_in, const int* in_sizes, int n_in, void* d_out, int out_size, void* d_ws, size_t ws_size, hipStream_t stream) {
    static int grid = 0;
    if (grid == 0) {
        if (n_in != 15 || in_sizes[0] != M * DM || out_size != M * DM || ws_size < WS_END) {
            fprintf(stderr, "kernel_launch: unexpected shapes / workspace (n_in %d, in0 %d, out %d, ws %zu, need %zu)\n", n_in, n_in > 0 ? in_sizes[0] : -1, out_size, ws_size, (size_t)WS_END); grid = -1; return; }
        int dev = 0, cus = 0, per_cu = 0;
        if (hipGetDevice(&dev) != hipSuccess || hipDeviceGetAttribute(&cus, hipDeviceAttributeMultiprocessorCount, dev) != hipSuccess) { grid = -1; return; }
        if (hipFuncSetAttribute((const void*)mega_fwd, hipFuncAttributeMaxDynamicSharedMemorySize, LDS_BYTES) != hipSuccess) { fprintf(stderr, "kernel_launch: hipFuncSetAttribute failed\n"); grid = -1; return; }
        if (hipOccupancyMaxActiveBlocksPerMultiprocessor(&per_cu, (const void*)mega_fwd, NTHREADS, LDS_BYTES) != hipSuccess || per_cu < 1) fprintf(stderr, "kernel_launch: occupancy query reports %d\n", per_cu);
        (void)hipGetLastError();
        grid = cus;
    }
    if (grid < 0) return;
    if (hipMemsetAsync((char*)d_ws + WS_CTL, 0, CTL_BYTES, stream) != hipSuccess) return;
    Args a{};
    a.x = (const float*)d_in[0]; a.g1 = (const float*)d_in[1]; a.w_in = (const float*)d_in[2]; a.b_f = (const float*)d_in[3]; a.g_fox = (const float*)d_in[4]; a.g_sb = (const float*)d_in[5];
    a.w_out = (const float*)d_in[6]; a.g2 = (const float*)d_in[7]; a.w_router = (const float*)d_in[8]; a.b_router = (const float*)d_in[9]; a.w1 = (const float*)d_in[10]; a.b1 = (const float*)d_in[11];
    a.w2 = (const float*)d_in[12]; a.b2 = (const float*)d_in[13]; a.gf = (const float*)d_in[14];
    a.out = (float*)d_out; a.ws = (unsigned char*)d_ws;
    hipLaunchKernelGGL(mega_fwd, dim3(grid), dim3(NTHREADS), LDS_BYTES, stream, a);
    const hipError_t le = hipPeekAtLastError();
    if (le != hipSuccess) fprintf(stderr, "kernel_launch: launch failed: %s\n", hipGetErrorName(le));
}
```

```cpp
#include <hip/hip_runtime.h>
#include <cstdio>
#include <cstdint>

typedef unsigned short bf16_t;
typedef short bf16x8 __attribute__((ext_vector_type(8)));
typedef float f32x4 __attribute__((ext_vector_type(4)));

constexpr int NB = 4, SEQ = 4096, DM = 1024, M = NB * SEQ;
constexpr int NH = 8, HD = 64, GW = 512;
constexpr int WIN_N = 3080, NPROJ = 3072;
constexpr int NE = 32, TOPK = 4, DFF = 1024;
constexpr float EPS = 1e-5f;
constexpr float LOG2E = 1.4426950408889634f;
constexpr float C2 = 0.125f * LOG2E;
constexpr int LIST_CAP = M;
constexpr int MAX_TILES = (M * TOPK) / 256 + NE;

constexpr size_t MiB = 1u << 20;
constexpr size_t WS_CTL = 0, CTL_BYTES = 1 * MiB;
constexpr size_t WS_WINT = 2 * MiB;
constexpr size_t WS_WOUTT = 8 * MiB;
constexpr size_t WS_WR = 10 * MiB;
constexpr size_t WS_CUM = 11 * MiB;
constexpr size_t WS_SSQ = 12 * MiB;
constexpr size_t WS_RSTD2 = 14 * MiB;
constexpr size_t WS_RW = 15 * MiB;
constexpr size_t WS_SLOTEP = 15 * MiB + 512 * 1024;
constexpr size_t WS_TBG = 14 * MiB + 512 * 1024;
constexpr size_t WS_LIST = 16 * MiB;
constexpr size_t WS_FLOG = 18 * MiB;
constexpr size_t WS_XN = 32 * MiB;
constexpr size_t WS_PROJ = 64 * MiB;
constexpr size_t WS_OMIX = 160 * MiB;
constexpr size_t WS_X1B = 192 * MiB;
constexpr size_t WS_W1T = 224 * MiB;
constexpr size_t WS_W2T = 352 * MiB;
constexpr size_t WS_H = 416 * MiB;
constexpr size_t WS_Y = 560 * MiB;
constexpr size_t WS_END = 704 * MiB;
constexpr int CW_CNT = 1024;

__device__ __forceinline__ unsigned short f2bf(float f) { unsigned u = __float_as_uint(f); return (unsigned short)((u + 0x7fffu + ((u >> 16) & 1u)) >> 16); }
__device__ __forceinline__ float bf2f(unsigned short b) { return __uint_as_float(((unsigned)b) << 16); }
__device__ __forceinline__ float wave_sum(float v) {
#pragma unroll
    for (int o = 1; o < 64; o <<= 1) v += __shfl_xor(v, o);
    return v;
}


#define LAS __attribute__((address_space(3)))
#define GAS __attribute__((address_space(1)))
typedef unsigned v4u __attribute__((ext_vector_type(4)));
#define LDS_WAIT() asm volatile("s_waitcnt lgkmcnt(0)" ::: "memory")
#define VM_WAIT() asm volatile("s_waitcnt vmcnt(0)" ::: "memory")
constexpr int NWAVES = 8, NTHREADS = NWAVES * 64;
constexpr int REP_PHASE = -1;
#define REPS(k) for (int rep_ = 0; rep_ < ((REP_PHASE == (k)) ? 2 : 1); ++rep_)
constexpr bool MOE_F8 = true;
constexpr int CVT_SPLIT = 24 * 512;
constexpr bool OVERLAP_CVT = true;
constexpr bool OPT_GEMM = true;
constexpr bool OPT_ROUTER = true;
constexpr bool OPT_ATTN = true;

#define XB_TMO      128
#define XB_XCNT(j)  (256  + 64 * (j))
#define XB_XSUB(j)  (1280 + 64 * (j))
#define XB_XGEN(j)  (2304 + 64 * (j))
#define XB_TOP      3328
#define XB_TOPGEN   3392
#define XCD_BAR_WORDS 3456
#define XB_SPIN_CAP (1u << 20)
__device__ __forceinline__ unsigned xb_ld(unsigned* p)              { return __hip_atomic_load(p, __ATOMIC_RELAXED, __HIP_MEMORY_SCOPE_AGENT); }
__device__ __forceinline__ unsigned xb_add(unsigned* p, unsigned v) { return __hip_atomic_fetch_add(p, v, __ATOMIC_RELAXED, __HIP_MEMORY_SCOPE_AGENT); }
__device__ __forceinline__ unsigned xb_xcc_id() { return (unsigned)__builtin_amdgcn_s_getreg((3 << 11) | 20) & 0xFu; }
#define XB_SPIN(cond, bar) do { unsigned _sp = 0; while (cond) { __builtin_amdgcn_s_sleep(1); \
    if ((++_sp & 255u) == 0u) { if (xb_ld(&(bar)[XB_TMO])) break; if (_sp > XB_SPIN_CAP) { atomicAdd(&(bar)[XB_TMO], 1u); break; } } } } while (0)
struct XcdBarrier { unsigned* bar; unsigned x; volatile LAS unsigned* st; };
__device__ __forceinline__ XcdBarrier xcd_barrier_post(unsigned* bar, volatile LAS unsigned* st) {
    XcdBarrier b; b.bar = bar; b.x = xb_xcc_id(); b.st = st;
    if (threadIdx.x == 0) (void)xb_add(&bar[XB_XCNT(b.x)], 1u);
    return b;
}
__device__ __forceinline__ void xcd_barrier_complete(unsigned* bar, unsigned x, unsigned& nloc, unsigned& nx) {
    const unsigned G = gridDim.x * gridDim.y * gridDim.z;
    unsigned sum, cnt, mine, sp = 0u;
    for (;;) {
        sum = 0u; cnt = 0u; mine = 0u;
#pragma unroll
        for (unsigned j = 0; j < 16; ++j) { const unsigned c = xb_ld(&bar[XB_XCNT(j)]); sum += c; cnt += (c > 0u) ? 1u : 0u; mine = (j == x) ? c : mine; }
        if (sum == G) break;
        __builtin_amdgcn_s_sleep(1);
        if ((++sp & 255u) == 0u) { if (xb_ld(&bar[XB_TMO])) break; if (sp > XB_SPIN_CAP) { atomicAdd(&bar[XB_TMO], 1u); break; } }
    }
    nloc = mine > 0u ? mine : 1u; nx = cnt > 0u ? cnt : 1u;
}
__device__ __forceinline__ void xcd_barrier(const XcdBarrier& b) {
    asm volatile("s_waitcnt vmcnt(0)" ::: "memory");
    __syncthreads();
    if (threadIdx.x == 0) {
        unsigned* bar = b.bar;
        __builtin_amdgcn_s_waitcnt(0);
        unsigned nloc = b.st[0], nx = b.st[1];
        if (nloc == 0u) { xcd_barrier_complete(bar, b.x, nloc, nx); b.st[0] = nloc; b.st[1] = nx; }
        const unsigned old = xb_add(&bar[XB_XSUB(b.x)], 1u);
        const unsigned gen = old / nloc;
        if (old + 1u == (gen + 1u) * nloc) {
            __builtin_amdgcn_fence(__ATOMIC_RELEASE, "agent");
            asm volatile("s_waitcnt vmcnt(0)" ::: "memory");
            const unsigned og = xb_add(&bar[XB_TOP], 1u);
            const unsigned tg = og / nx;
            if (og + 1u == (tg + 1u) * nx) xb_add(&bar[XB_TOPGEN], 1u);
            else XB_SPIN(xb_ld(&bar[XB_TOPGEN]) == tg, bar);
            __builtin_amdgcn_fence(__ATOMIC_ACQUIRE, "agent");
            xb_add(&bar[XB_XGEN(b.x)], 1u);
            asm volatile("s_waitcnt vmcnt(0)" ::: "memory");
        } else {
            XB_SPIN(xb_ld(&bar[XB_XGEN(b.x)]) == gen, bar);
            __builtin_amdgcn_fence(__ATOMIC_ACQUIRE, "agent");
            asm volatile("s_waitcnt vmcnt(0)" ::: "memory");
        }
    }
    __syncthreads();
}

constexpr int RING_OFF = 0, RING_BYTES = 131072;
constexpr int TAB_OFF = 131072;
constexpr int TAB2_OFF = TAB_OFF + 10 * 1024, TB_OFF = TAB_OFF + 20 * 1024;
constexpr int LDSCTL_OFF = 152576, MISC_OFF = LDSCTL_OFF + 320;
constexpr int LDS_BYTES = 155648;
constexpr int CW_BAR = 4096;

struct Args {
    const float *x, *g1, *w_in, *b_f, *g_fox, *g_sb, *w_out, *g2, *w_router, *b_router, *w1, *b1, *w2, *b2, *gf;
    float* out; unsigned char* ws;
};

__device__ __forceinline__ int mapcol(int mode, int n) {
    if (mode == 1) return n < 1536 ? n : n + 8;
    if (mode == 2) { const int pn = n >> 8, j = n & 255; return j < 128 ? 128 * pn + j : 1024 + 128 * pn + (j - 128); }
    return n;
}
__device__ __forceinline__ unsigned pk4_fp8(float a, float b, float c, float d) {
    a = __builtin_amdgcn_fmed3f(a, -448.f, 448.f); b = __builtin_amdgcn_fmed3f(b, -448.f, 448.f); c = __builtin_amdgcn_fmed3f(c, -448.f, 448.f); d = __builtin_amdgcn_fmed3f(d, -448.f, 448.f);
    int w = __builtin_amdgcn_cvt_pk_fp8_f32(a, b, 0, false); w = __builtin_amdgcn_cvt_pk_fp8_f32(c, d, w, true); return (unsigned)w;
}
__device__ __forceinline__ unsigned pk2(float lo, float hi) { unsigned r; asm("v_cvt_pk_bf16_f32 %0, %1, %2" : "=v"(r) : "v"(lo), "v"(hi)); return r; }
struct TrItem { const float* W; bf16_t* WT; const float* gA; const float* gB; int K, Nin, Nout, mode, gsplit, item, nbsh, f8; };
template <bool NT> __device__ __forceinline__ void tr_load(const TrItem& t, int lane, f32x4 (&v)[8]) {
    const int nblk = t.Nout / 32, kb = t.nbsh >= 0 ? (t.item >> t.nbsh) : t.item / nblk, nb = t.nbsh >= 0 ? (t.item & (nblk - 1)) : t.item % nblk, k0 = 64 * kb, n0 = 32 * nb, l7 = lane & 7, kr = lane >> 3, col = mapcol(t.mode, n0 + 4 * l7);
#pragma unroll
    for (int i = 0; i < 8; ++i) { const f32x4* p = (const f32x4*)(t.W + (size_t)(k0 + 8 * i + kr) * t.Nin + col); v[i] = NT ? __builtin_nontemporal_load(p) : *p; }
}
__device__ __forceinline__ void tr_store(const TrItem& t, int lane, const f32x4 (&v)[8], LAS float* scr) {
    const int nblk = t.Nout / 32, kb = t.nbsh >= 0 ? (t.item >> t.nbsh) : t.item / nblk, nb = t.nbsh >= 0 ? (t.item & (nblk - 1)) : t.item % nblk, k0 = 64 * kb, n0 = 32 * nb, l7 = lane & 7, kr = lane >> 3;
#pragma unroll
    for (int i = 0; i < 8; ++i) { const int kk = 8 * i + kr, k = k0 + kk; const float gs = t.gA ? (k < t.gsplit ? t.gA[k] : t.gB[k - t.gsplit]) : 1.f;
        LAS float* sp = scr + kk * 33 + 4 * l7; sp[0] = v[i][0] * gs; sp[1] = v[i][1] * gs; sp[2] = v[i][2] * gs; sp[3] = v[i][3] * gs; }
    LDS_WAIT();
    if (t.f8) {
        const int c = lane & 3;
#pragma unroll
        for (int j = 0; j < 2; ++j) { const int n = (lane >> 2) + 16 * j; const LAS float* sp = scr + (16 * c) * 33 + n;
            v4u o; o.x = pk4_fp8(32.f * sp[0 * 33], 32.f * sp[1 * 33], 32.f * sp[2 * 33], 32.f * sp[3 * 33]); o.y = pk4_fp8(32.f * sp[4 * 33], 32.f * sp[5 * 33], 32.f * sp[6 * 33], 32.f * sp[7 * 33]);
            o.z = pk4_fp8(32.f * sp[8 * 33], 32.f * sp[9 * 33], 32.f * sp[10 * 33], 32.f * sp[11 * 33]); o.w = pk4_fp8(32.f * sp[12 * 33], 32.f * sp[13 * 33], 32.f * sp[14 * 33], 32.f * sp[15 * 33]);
            *(v4u*)((unsigned char*)t.WT + (size_t)(n0 + n) * t.K + k0 + 16 * c) = o; }
    } else {
    const int c = lane & 7;
#pragma unroll
    for (int j = 0; j < 4; ++j) { const int n = (lane >> 3) + 8 * j; const LAS float* sp = scr + (8 * c) * 33 + n;
        v4u o; o.x = pk2(sp[0 * 33], sp[1 * 33]); o.y = pk2(sp[2 * 33], sp[3 * 33]); o.z = pk2(sp[4 * 33], sp[5 * 33]); o.w = pk2(sp[6 * 33], sp[7 * 33]);
        *(v4u*)(t.WT + (size_t)(n0 + n) * t.K + k0 + 8 * c) = o; }
    }
    LDS_WAIT();
}
constexpr int I_W1 = (DM / 64) * (2048 / 32), I_W2 = (DM / 64) * (DM / 32), N_EXP_ITEMS = NE * (I_W1 + I_W2);
__device__ __forceinline__ TrItem expert_item(const float* w1, const float* w2, const float* g2, bf16_t* W1T, bf16_t* W2T, int r) {
    TrItem t;
    t.f8 = MOE_F8 ? 1 : 0;
    if (r < NE * I_W1) { const int e = r / I_W1; t.W = w1 + (size_t)e * DM * 2048; t.WT = MOE_F8 ? (bf16_t*)((unsigned char*)W1T + (size_t)e * 2048 * DM) : W1T + (size_t)e * 2048 * DM; t.gA = g2; t.gB = nullptr; t.K = DM; t.Nin = 2048; t.Nout = 2048; t.mode = 2; t.gsplit = DM; t.item = r % I_W1; t.nbsh = 6; }
    else { r -= NE * I_W1; const int e = r / I_W2; t.W = w2 + (size_t)e * DM * DM; t.WT = MOE_F8 ? (bf16_t*)((unsigned char*)W2T + (size_t)e * DM * DM) : W2T + (size_t)e * DM * DM; t.gA = nullptr; t.gB = nullptr; t.K = DM; t.Nin = DM; t.Nout = DM; t.mode = 0; t.gsplit = DM; t.item = r % I_W2; t.nbsh = 5; }
    return t;
}
__device__ __forceinline__ void convert_experts(const float* w1, const float* w2, const float* g2, bf16_t* W1T, bf16_t* W2T, int first, int stride, int N_END, int lane, LAS float* scr) {
    f32x4 v0[8], v1[8];
#define CVT_LOAD(v, idx) do { if ((idx) < N_END) { const TrItem t_ = expert_item(w1, w2, g2, W1T, W2T, (idx)); tr_load<true>(t_, lane, v); } } while (0)
#define CVT_STORE(v, idx) do { if ((idx) < N_END) { const TrItem t_ = expert_item(w1, w2, g2, W1T, W2T, (idx)); tr_store(t_, lane, v, scr); } } while (0)
    int it = first; asm volatile("" : "+v"(lane));
    CVT_LOAD(v0, it);
#pragma unroll 1
    for (; it < N_END; it += 2 * stride) {
        CVT_LOAD(v1, it + stride); CVT_STORE(v0, it);
        CVT_LOAD(v0, it + 2 * stride); CVT_STORE(v1, it + stride);
    }
#undef CVT_LOAD
#undef CVT_STORE
}

__device__ __forceinline__ float log_sigmoid(float v) { return fminf(v, 0.f) - log1pf(expf(-fabsf(v))); }
__device__ __forceinline__ void rms1_row(const float* __restrict__ x, const LAS float* wf  , const float* __restrict__ b_f,
                                         bf16_t* __restrict__ XN, float* __restrict__ FLOG, int row, int lane) {
    const float4* xr = (const float4*)(x + (size_t)row * DM);
    float4 v[4]; float ss = 0.f;
#pragma unroll
    for (int j = 0; j < 4; ++j) { v[j] = xr[lane + 64 * j]; ss += v[j].x * v[j].x + v[j].y * v[j].y + v[j].z * v[j].z + v[j].w * v[j].w; }
    ss = wave_sum(ss);
    const float rstd = rsqrtf(ss * (1.f / DM) + EPS);
    float f0 = 0.f, f1 = 0.f, f2 = 0.f, f3 = 0.f, f4 = 0.f, f5 = 0.f, f6 = 0.f, f7 = 0.f;
#pragma unroll
    for (int j = 0; j < 4; ++j) {
        const int c0 = 4 * (lane + 64 * j);
        uint2 o; o.x = pk2(v[j].x * rstd, v[j].y * rstd); o.y = pk2(v[j].z * rstd, v[j].w * rstd);
        *(uint2*)(XN + (size_t)row * DM + c0) = o;
        const float xs[4] = {v[j].x, v[j].y, v[j].z, v[j].w};
#pragma unroll
        for (int c = 0; c < 4; ++c) {
            const int k = c0 + c; const float xv = xs[c];
            const LAS f32x4* wp = (const LAS f32x4*)(wf + k * 8); const f32x4 w0 = wp[0], w1 = wp[1];
            f0 += xv * w0.x; f1 += xv * w0.y; f2 += xv * w0.z; f3 += xv * w0.w; f4 += xv * w1.x; f5 += xv * w1.y; f6 += xv * w1.z; f7 += xv * w1.w;
        }
    }
    f0 = wave_sum(f0); f1 = wave_sum(f1); f2 = wave_sum(f2); f3 = wave_sum(f3); f4 = wave_sum(f4); f5 = wave_sum(f5); f6 = wave_sum(f6); f7 = wave_sum(f7);
    if (lane < 8) {
        float f = f0; f = lane == 1 ? f1 : f; f = lane == 2 ? f2 : f; f = lane == 3 ? f3 : f; f = lane == 4 ? f4 : f; f = lane == 5 ? f5 : f; f = lane == 6 ? f6 : f; f = lane == 7 ? f7 : f;
        FLOG[(size_t)row * 8 + lane] = log_sigmoid(f * rstd + b_f[lane]);
    }
}
__device__ __forceinline__ void cumsum_wg(const float* __restrict__ FLOG, float* __restrict__ CUM, int bh, LAS float* part) {
    const int b = bh >> 3, h = bh & 7, t = threadIdx.x;
    float loc[8]; float s = 0.f;
#pragma unroll
    for (int i = 0; i < 8; ++i) { loc[i] = FLOG[((size_t)b * SEQ + t * 8 + i) * 8 + h]; s += loc[i]; }
    part[t] = s; __syncthreads();
    float run = 0.f; for (int i = 0; i < t; ++i) run += part[i];
#pragma unroll
    for (int i = 0; i < 8; ++i) { run += loc[i]; CUM[(size_t)bh * SEQ + t * 8 + i] = run * LOG2E; }
    __syncthreads();
}

template <int NT> __device__ __forceinline__ void wave_mma(f32x4 (&acc)[NT], const bf16_t* ap, const bf16_t* const (&bp)[NT], int K) {
    for (int k0 = 0; k0 < K; k0 += 32) {
        const bf16x8 a = *(const bf16x8*)(ap + k0);
#pragma unroll
        for (int t = 0; t < NT; ++t) { const bf16x8 b = *(const bf16x8*)(bp[t] + k0); acc[t] = __builtin_amdgcn_mfma_f32_16x16x32_bf16(a, b, acc[t], 0, 0, 0); }
    }
}
__device__ __forceinline__ void nv_inproj(const bf16_t* __restrict__ XN, const bf16_t* __restrict__ WINT, bf16_t* __restrict__ PROJ, int item, int lane) {
    const int n0 = (item % 48) * 64, m0 = (item / 48) * 16, r = lane & 15, q = lane >> 4;
    f32x4 acc[4];
#pragma unroll
    for (int t = 0; t < 4; ++t) acc[t] = (f32x4){0.f, 0.f, 0.f, 0.f};
    const bf16_t* ap = XN + (size_t)(m0 + r) * DM + 8 * q;
    const bf16_t* bp[4];
#pragma unroll
    for (int t = 0; t < 4; ++t) bp[t] = WINT + (size_t)(n0 + 16 * t + r) * DM + 8 * q;
    wave_mma<4>(acc, ap, bp, DM);
    const float sc = (n0 < 512 || (n0 >= 1536 && n0 < 2048)) ? C2 : 1.f;
#pragma unroll
    for (int t = 0; t < 4; ++t)
#pragma unroll
        for (int j = 0; j < 4; ++j) PROJ[(size_t)(m0 + 4 * q + j) * NPROJ + n0 + 16 * t + r] = f2bf(acc[t][j] * sc);
}

template <int TYPE> __device__ __forceinline__ void nv_attn(const bf16_t* __restrict__ PROJ, const float* __restrict__ CUM, bf16_t* __restrict__ OMIX, float* __restrict__ SSQ,
                                                          int bh, int qblk, int lane, LAS unsigned char* wl) {
    LAS bf16_t* Ks = (LAS bf16_t*)wl; LAS bf16_t* Vs = (LAS bf16_t*)(wl + 8192); LAS float* Cs = (LAS float*)(wl + 16384);
    const int b = bh >> 3, h = bh & 7, t = qblk * 64 + lane;
    const size_t row = (size_t)b * SEQ + t;
    const int qcol = (TYPE == 0 ? 0 : 1536) + h * HD, kcol = qcol + 512, vcol = qcol + 1024;
    float q[64], o[64];
#pragma unroll
    for (int c = 0; c < 8; ++c) { const bf16x8 v = *(const bf16x8*)(PROJ + row * NPROJ + qcol + 8 * c);
#pragma unroll
        for (int j = 0; j < 8; ++j) q[8 * c + j] = bf2f((unsigned short)v[j]); }
#pragma unroll
    for (int d = 0; d < 64; ++d) o[d] = 0.f;
    float m = -INFINITY, l = 0.f, R = 1.f;
    const float cq = CUM[(size_t)bh * SEQ + t];
    for (int it = 0; it <= qblk; ++it) {
        const int kt = (TYPE == 0) ? it : qblk - it;
        LDS_WAIT();
        for (int i = 0; i < 64; ++i) { const size_t kr = ((size_t)b * SEQ + kt * 64 + i) * NPROJ; Ks[i * 64 + lane] = PROJ[kr + kcol + lane]; Vs[i * 64 + lane] = PROJ[kr + vcol + lane]; }
        Cs[lane] = CUM[(size_t)bh * SEQ + kt * 64 + lane];
        LDS_WAIT();
        for (int ss = 0; ss < 64; ++ss) {
            const int s = (TYPE == 0) ? ss : 63 - ss; const int ks = kt * 64 + s;
            float dot = 0.f;
#pragma unroll
            for (int d = 0; d < 64; d += 8) { const bf16x8 kv = *(const LAS bf16x8*)&Ks[s * 64 + d];
#pragma unroll
                for (int j = 0; j < 8; ++j) dot += q[d + j] * bf2f((unsigned short)kv[j]); }
            if (TYPE == 0) {
                if (ks <= t) {
                    const float xv = dot + cq - Cs[s]; const float mn = fmaxf(m, xv); const float sc = exp2f(m - mn), p = exp2f(xv - mn);
                    l = l * sc + p; m = mn;
#pragma unroll
                    for (int d = 0; d < 64; d += 8) { const bf16x8 vv = *(const LAS bf16x8*)&Vs[s * 64 + d];
#pragma unroll
                        for (int j = 0; j < 8; ++j) o[d + j] = o[d + j] * sc + p * bf2f((unsigned short)vv[j]); }
                }
            } else {
                if (ks < t) {
                    const float z = fminf(fmaxf(dot, -80.f), 80.f); const float e = exp2f(z); const float rr = 1.f / (1.f + e); const float a = e * rr * R; R *= rr;
#pragma unroll
                    for (int d = 0; d < 64; d += 8) { const bf16x8 vv = *(const LAS bf16x8*)&Vs[s * 64 + d];
#pragma unroll
                        for (int j = 0; j < 8; ++j) o[d + j] += a * bf2f((unsigned short)vv[j]); }
                }
            }
        }
    }
    const float inv = (TYPE == 0) ? 1.f / l : 1.f;
    float ssq = 0.f;
#pragma unroll
    for (int d = 0; d < 64; ++d) { o[d] *= inv; ssq += o[d] * o[d]; }
    SSQ[row * 16 + TYPE * 8 + h] = ssq;
#pragma unroll
    for (int c = 0; c < 8; ++c) { bf16x8 v;
#pragma unroll
        for (int j = 0; j < 8; ++j) v[j] = (short)f2bf(o[8 * c + j]);
        *(bf16x8*)(OMIX + row * DM + TYPE * GW + h * HD + 8 * c) = v; }
}

__device__ __forceinline__ void nv_wout(const bf16_t* __restrict__ OMIX, const bf16_t* __restrict__ WOUTT, const float* __restrict__ SSQ, const float* __restrict__ x,
                                        float* __restrict__ X1, bf16_t* __restrict__ X1B, int item, int lane) {
    const int n0 = (item & 15) * 64, m0 = (item >> 4) * 16, r = lane & 15, q = lane >> 4;
    f32x4 af[4], as[4];
#pragma unroll
    for (int t = 0; t < 4; ++t) { af[t] = (f32x4){0.f, 0.f, 0.f, 0.f}; as[t] = (f32x4){0.f, 0.f, 0.f, 0.f}; }
    const bf16_t* ap = OMIX + (size_t)(m0 + r) * DM + 8 * q;
    const bf16_t* bp[4]; const bf16_t* bp2[4];
#pragma unroll
    for (int t = 0; t < 4; ++t) { bp[t] = WOUTT + (size_t)(n0 + 16 * t + r) * DM + 8 * q; bp2[t] = bp[t] + GW; }
    wave_mma<4>(af, ap, bp, GW);
    wave_mma<4>(as, ap + GW, bp2, GW);
#pragma unroll
    for (int j = 0; j < 4; ++j) {
        const size_t row = m0 + 4 * q + j; const float* sp = SSQ + row * 16;
        float sf = 0.f, s2 = 0.f;
#pragma unroll
        for (int h = 0; h < 8; ++h) { sf += sp[h]; s2 += sp[8 + h]; }
        const float rf = rsqrtf(sf * (1.f / GW) + EPS), rs = rsqrtf(s2 * (1.f / GW) + EPS);
#pragma unroll
        for (int t = 0; t < 4; ++t) { const size_t idx = row * DM + n0 + 16 * t + r; const float v = x[idx] + rf * af[t][j] + rs * as[t][j]; X1[idx] = v; X1B[idx] = f2bf(v); }
    }
}

__device__ __forceinline__ void nv_router(const float* __restrict__ X1, const float* __restrict__ WR, const float* __restrict__ b_router, float* __restrict__ RSTD2,
                                          float* __restrict__ RW, int* __restrict__ LIST, int* __restrict__ SLOTEP, unsigned* __restrict__ CNT, int item, int lane) {
    const int e = lane & 31, tok = item * 2 + (lane >> 5);
    const float* xr = X1 + (size_t)tok * DM;
    float acc = 0.f, ss = 0.f;
    for (int k = 0; k < DM; ++k) { const float xv = xr[k]; acc += xv * WR[k * NE + e]; ss += xv * xv; }
    const float rstd = rsqrtf(ss * (1.f / DM) + EPS);
    float logit = acc * rstd + b_router[e];
    if (e == 0) RSTD2[tok] = rstd;
    float tv[4]; int ti[4];
#pragma unroll
    for (int k = 0; k < 4; ++k) {
        float bv = logit; int bi = e;
#pragma unroll
        for (int o = 1; o < 32; o <<= 1) { const float ov = __shfl_xor(bv, o); const int oi = __shfl_xor(bi, o); if (ov > bv || (ov == bv && oi < bi)) { bv = ov; bi = oi; } }
        tv[k] = bv; ti[k] = bi; if (e == bi) logit = -INFINITY;
    }
    const float e0 = 1.f, e1 = expf(tv[1] - tv[0]), e2 = expf(tv[2] - tv[0]), e3 = expf(tv[3] - tv[0]); const float inv = 1.f / (e0 + e1 + e2 + e3);
    const float w0 = e0 * inv, w1 = e1 * inv, w2 = e2 * inv, w3 = e3 * inv;
    int myk = -1; float myw = 0.f;
    if (e == ti[0]) { myk = 0; myw = w0; } if (e == ti[1]) { myk = 1; myw = w1; } if (e == ti[2]) { myk = 2; myw = w2; } if (e == ti[3]) { myk = 3; myw = w3; }
    if (myk >= 0) { const int slot = tok * 4 + myk; const unsigned pos = atomicAdd(&CNT[e], 1u); LIST[(size_t)e * LIST_CAP + pos] = slot; RW[slot] = myw; SLOTEP[slot] = e * 16384 + (int)pos; }
}


typedef float f32x16 __attribute__((ext_vector_type(16)));
__device__ __forceinline__ void router_wg(const float* __restrict__ X1, const float* __restrict__ WR, const float* __restrict__ b_router, float* __restrict__ RSTD2,
                                          float* __restrict__ RW, int* __restrict__ LIST, int* __restrict__ SLOTEP, unsigned* __restrict__ CNT, int tokbase, LAS unsigned char* L) {
    int tid_ = threadIdx.x; asm volatile("" : "+v"(tid_));
    const int tid = tid_, lane = tid & 63, wave = __builtin_amdgcn_readfirstlane(tid >> 6), kq = wave & 3, tile = wave >> 2, r32 = lane & 31, hi = lane >> 5;
    LAS float* Dx = (LAS float*)L; LAS float* SSx = (LAS float*)(L + 32768); LAS unsigned* lcnt = (LAS unsigned*)(L + 33792); LAS unsigned* lbase = (LAS unsigned*)(L + 33920);
    if (tid < NE) lcnt[tid] = 0u;
    const int tok = tokbase + tile * 32 + r32;
    const float* xp = X1 + (size_t)tok * DM + kq * 256 + 4 * hi;
    const float* wp = WR + (size_t)(kq * 256 + 4 * hi) * NE + r32;
    f32x16 acc;
#pragma unroll
    for (int r = 0; r < 16; ++r) acc[r] = 0.f;
    float ss = 0.f;
#pragma unroll 1
    for (int mc = 0; mc < 4; ++mc) {
        float4 xv[8];
#pragma unroll
        for (int m = 0; m < 8; ++m) xv[m] = *(const float4*)(xp + (mc * 8 + m) * 8);
#pragma unroll
        for (int m = 0; m < 8; ++m) {
            const float* w4 = wp + (size_t)((mc * 8 + m) * 8) * NE;
            const float w0 = w4[0], w1 = w4[NE], w2 = w4[2 * NE], w3 = w4[3 * NE];
            acc = __builtin_amdgcn_mfma_f32_32x32x2f32(w0, xv[m].x, acc, 0, 0, 0);
            acc = __builtin_amdgcn_mfma_f32_32x32x2f32(w1, xv[m].y, acc, 0, 0, 0);
            acc = __builtin_amdgcn_mfma_f32_32x32x2f32(w2, xv[m].z, acc, 0, 0, 0);
            acc = __builtin_amdgcn_mfma_f32_32x32x2f32(w3, xv[m].w, acc, 0, 0, 0);
            ss += xv[m].x * xv[m].x + xv[m].y * xv[m].y + xv[m].z * xv[m].z + xv[m].w * xv[m].w;
        }
    }
    { auto rr = __builtin_amdgcn_permlane32_swap(__float_as_uint(ss), __float_as_uint(ss), false, false); ss = __uint_as_float(rr[0]) + __uint_as_float(rr[1]); }
#pragma unroll
    for (int r = 0; r < 16; ++r) Dx[(wave * 16 + r) * 64 + lane] = acc[r];
    if (hi == 0) SSx[wave * 32 + r32] = ss;
    LDS_WAIT(); __syncthreads();
    int ea = 0, eb = 0; float wa = 0.f, wb = 0.f; unsigned la = 0u, lb = 0u;
    if (kq == 0) {
        float v[16]; float sst = 0.f;
#pragma unroll
        for (int w = 0; w < 4; ++w) sst += SSx[(tile * 4 + w) * 32 + r32];
        const float rstd = rsqrtf(sst * (1.f / DM) + EPS);
#pragma unroll
        for (int r = 0; r < 16; ++r) { float a = 0.f;
#pragma unroll
            for (int w = 0; w < 4; ++w) a += Dx[((tile * 4 + w) * 16 + r) * 64 + lane];
            v[r] = a * rstd + b_router[(r & 3) + 8 * (r >> 2) + 4 * hi]; }
        if (hi == 0) RSTD2[tok] = rstd;
        float tv[4]; int te[4];
#pragma unroll
        for (int k = 0; k < 4; ++k) {
            float bv = v[0]; int br = 0;
#pragma unroll
            for (int r = 1; r < 16; ++r) if (v[r] > bv) { bv = v[r]; br = r; }
            const int be = (br & 3) + 8 * (br >> 2) + 4 * hi;
            auto r1 = __builtin_amdgcn_permlane32_swap(__float_as_uint(bv), __float_as_uint(bv), false, false);
            auto r2 = __builtin_amdgcn_permlane32_swap((unsigned)be, (unsigned)be, false, false);
            const float pv = __uint_as_float(hi ? r1[0] : r1[1]); const int pe = (int)(hi ? r2[0] : r2[1]);
            const bool mine = (bv > pv) || (bv == pv && be < pe);
            tv[k] = mine ? bv : pv; te[k] = mine ? be : pe;
#pragma unroll
            for (int r = 0; r < 16; ++r) v[r] = (mine && r == br) ? -INFINITY : v[r];
        }
        const float e1 = expf(tv[1] - tv[0]), e2 = expf(tv[2] - tv[0]), e3 = expf(tv[3] - tv[0]); const float inv = 1.f / (1.f + e1 + e2 + e3);
        ea = hi ? te[2] : te[0]; eb = hi ? te[3] : te[1]; wa = (hi ? e2 : 1.f) * inv; wb = (hi ? e3 : e1) * inv;
        la = atomicAdd((unsigned*)&lcnt[ea], 1u); lb = atomicAdd((unsigned*)&lcnt[eb], 1u);
    }
    LDS_WAIT(); __syncthreads();
    if (tid < NE) { const unsigned c = lcnt[tid]; lbase[tid] = c ? atomicAdd(&CNT[tid], c) : 0u; }
    LDS_WAIT(); __syncthreads();
    if (kq == 0) {
        const int sa = tok * 4 + 2 * hi, sb = sa + 1;
        const int pa = (int)(lbase[ea] + la), pb = (int)(lbase[eb] + lb);
        LIST[(size_t)ea * LIST_CAP + pa] = sa; RW[sa] = wa; SLOTEP[sa] = ea * 16384 + pa;
        LIST[(size_t)eb * LIST_CAP + pb] = sb; RW[sb] = wb; SLOTEP[sb] = eb * 16384 + pb;
    }
    LDS_WAIT(); __syncthreads();
}

__device__ __forceinline__ bool moe_tile(const unsigned* CNT, int g, int& e, int& base, int& p0, int& cnt) {
    const int tile256 = g >> 4; base = 0;
    for (e = 0; e < NE; ++e) { const int nt = ((int)CNT[e] + 255) >> 8; if (tile256 < base + nt) break; base += nt; }
    if (e == NE) return false;
    cnt = (int)CNT[e]; p0 = (g - base * 16) * 16; return p0 < cnt;
}
__device__ __forceinline__ void nv_moe1(const bf16_t* __restrict__ X1B, const bf16_t* __restrict__ W1T, const float* __restrict__ b1, const float* __restrict__ RSTD2,
                                        const int* __restrict__ LIST, bf16_t* __restrict__ H, int e, int base, int p0, int cnt, int cg, int lane) {
    const int r = lane & 15, q = lane >> 4, c0 = cg * 32, pn = c0 >> 7, j0 = c0 & 127;
    const int* lst = LIST + (size_t)e * LIST_CAP;
    const int prow = p0 + r; const int tok = lst[prow < cnt ? prow : cnt - 1] >> 2;
    f32x4 acc[4];
#pragma unroll
    for (int t = 0; t < 4; ++t) acc[t] = (f32x4){0.f, 0.f, 0.f, 0.f};
    const bf16_t* ap = X1B + (size_t)tok * DM + 8 * q;
    const bf16_t* wb = W1T + (size_t)e * 2048 * DM + (size_t)(256 * pn + j0 + r) * DM + 8 * q;
    const bf16_t* bp[4] = {wb, wb + 16 * DM, wb + 128 * DM, wb + 144 * DM};
    wave_mma<4>(acc, ap, bp, DM);
#pragma unroll
    for (int j = 0; j < 4; ++j) {
        const int pr = p0 + 4 * q + j; if (pr >= cnt) continue;
        const float rs = RSTD2[lst[pr] >> 2];
#pragma unroll
        for (int t = 0; t < 2; ++t) {
            const int col = c0 + 16 * t + r;
            float glu = acc[t][j] * rs + b1[(size_t)e * 2048 + col], lin = acc[t + 2][j] * rs + b1[(size_t)e * 2048 + 1024 + col];
            glu = fminf(glu, 7.f); lin = fminf(fmaxf(lin, -7.f), 7.f);
            const float act = glu * (1.f / (1.f + expf(-1.702f * glu))) * (lin + 1.f);
            H[((size_t)base * 256 + pr) * DM + col] = f2bf(act);
        }
    }
}
__device__ __forceinline__ void nv_moe2(const bf16_t* __restrict__ H, const bf16_t* __restrict__ W2T, const float* __restrict__ b2, const float* __restrict__ RW,
                                        const int* __restrict__ LIST, bf16_t* __restrict__ Y, int e, int base, int p0, int cnt, int cg, int lane) {
    const int r = lane & 15, q = lane >> 4, n0 = cg * 64;
    const int* lst = LIST + (size_t)e * LIST_CAP;
    f32x4 acc[4];
#pragma unroll
    for (int t = 0; t < 4; ++t) acc[t] = (f32x4){0.f, 0.f, 0.f, 0.f};
    const bf16_t* ap = H + ((size_t)base * 256 + p0 + r) * DM + 8 * q;
    const bf16_t* bp[4];
#pragma unroll
    for (int t = 0; t < 4; ++t) bp[t] = W2T + (size_t)e * DM * DM + (size_t)(n0 + 16 * t + r) * DM + 8 * q;
    wave_mma<4>(acc, ap, bp, DM);
#pragma unroll
    for (int j = 0; j < 4; ++j) {
        const int pr = p0 + 4 * q + j; if (pr >= cnt) continue;
        const int slot = lst[pr]; const float w = RW[slot];
#pragma unroll
        for (int t = 0; t < 4; ++t) { const int col = n0 + 16 * t + r; Y[((size_t)base * 256 + pr) * DM + col] = f2bf((acc[t][j] + b2[(size_t)e * DM + col]) * w); }
    }
}

__device__ __forceinline__ void final_row(const float* X1, const bf16_t* __restrict__ Y, const int* __restrict__ SLOTEP, const int* __restrict__ TBG, const float* __restrict__ gf, float* out, int row, int lane) {
    float4 v[4]; float ss = 0.f; int yr[4];
#pragma unroll
    for (int k = 0; k < 4; ++k) { const int ep = SLOTEP[row * 4 + k]; yr[k] = TBG[ep >> 14] * 256 + (ep & 16383); }
#pragma unroll
    for (int j = 0; j < 4; ++j) {
        const int c0 = 4 * (lane + 64 * j);
        v[j] = *(const float4*)(X1 + (size_t)row * DM + c0);
#pragma unroll
        for (int k = 0; k < 4; ++k) { const uint2 y = *(const uint2*)(Y + (size_t)yr[k] * DM + c0);
            v[j].x += bf2f((unsigned short)(y.x & 0xffff)); v[j].y += bf2f((unsigned short)(y.x >> 16)); v[j].z += bf2f((unsigned short)(y.y & 0xffff)); v[j].w += bf2f((unsigned short)(y.y >> 16)); }
        ss += v[j].x * v[j].x + v[j].y * v[j].y + v[j].z * v[j].z + v[j].w * v[j].w;
    }
    ss = wave_sum(ss);
    const float rstd = rsqrtf(ss * (1.f / DM) + EPS);
#pragma unroll
    for (int j = 0; j < 4; ++j) { const int c0 = 4 * (lane + 64 * j); const float4 g = *(const float4*)(gf + c0);
        float4 o; o.x = v[j].x * rstd * g.x; o.y = v[j].y * rstd * g.y; o.z = v[j].z * rstd * g.z; o.w = v[j].w * rstd * g.w; *(float4*)(out + (size_t)row * DM + c0) = o; }
}


namespace pg8 {
#define PG8_LAS __attribute__((address_space(3)))
typedef unsigned u32x4 __attribute__((ext_vector_type(4)));
typedef unsigned u32x2 __attribute__((ext_vector_type(2)));
typedef int i32x8 __attribute__((ext_vector_type(8)));
constexpr int BM = 256, BK = 64, HALF = 128, HTB = HALF * BK * 2  , STAGE_BYTES = 8 * HTB, NXCD = 8, WGM = 8;
__host__ __device__ __forceinline__ int lds_byte(int r, int c) { const int st = (r >> 4) * 2 + (c >> 5), rr = r & 15, cc = c & 31, ob = rr * 64 + cc * 2; return st * 1024 + (ob ^ (((ob >> 9) & 1) << 5)); }
__host__ __device__ __forceinline__ void stage_rc(int b, int& R, int& C) { const int st = b / 1024, sb = b % 1024, swz = sb ^ (((sb >> 9) & 1) << 5); R = (st >> 1) * 16 + swz / 64; C = (st & 1) * 32 + (swz % 64) / 2; }
__host__ __device__ __forceinline__ int perm32(int rho) { const int n = rho >> 4, i = rho & 15; return 8 * (i >> 2) + 4 * n + (i & 3); }
struct Unit { int pm, pn, nr; };
struct Gemm { const bf16_t* A; const bf16_t* Bt; int K; };
struct StaticOrder {
    int nM, nN, nwg, G, c;
    __device__ void init(int M_, int N_, int G_, int c_) { nM = M_ / BM; nN = N_ / BM; nwg = nM * nN; G = G_; c = c_; }
    __device__ bool next(int i, Unit& u) const {
        const long L = (long)i * G + c; if (L >= nwg) return false;
        int wgid = (int)L; { const int q = nwg / NXCD, r = nwg % NXCD, xcd = wgid % NXCD, off = wgid / NXCD; wgid = (xcd < r ? xcd * (q + 1) : r * (q + 1) + (xcd - r) * q) + off; }
        const int nig = WGM * nN, gid = wgid / nig, fm = gid * WGM, gsz = (nM - fm) < WGM ? (nM - fm) : WGM;
        u.pm = fm + ((wgid % nig) % gsz); u.pn = (wgid % nig) / gsz; u.nr = BM; return true;
    }
    __device__ __forceinline__ const PG8_LAS int* rowtab(int) const { return nullptr; }
};
__device__ __forceinline__ unsigned cvt_pk_bf16(float lo, float hi) { unsigned r; asm volatile("v_cvt_pk_bf16_f32 %0, %1, %2" : "=v"(r) : "v"(lo), "v"(hi)); return r; }

template <class Sched> __device__ __forceinline__ void gather_voffs(const Sched& S, int ui, int tid, int K, unsigned (&o0)[2], unsigned (&o1)[2]) {
    const PG8_LAS int* tab = S.rowtab(ui);
#pragma unroll
    for (int i = 0; i < 2; ++i) { int R, C; stage_rc(tid * 16 + i * 8192, R, C); o0[i] = (unsigned)(tab[R] * K + C) * 2u; o1[i] = (unsigned)(tab[HALF + R] * K + C) * 2u; }
}

template <class Epi, class Sched, bool ALIGN_EPI, bool GATHER, bool F8 = false>
__device__ __forceinline__ void gemm_phase(PG8_LAS unsigned char* lds, const Gemm g, const Sched& S, const Epi& E) {
    int tid_ = threadIdx.x; asm volatile("" : "+v"(tid_));
    const int tid = tid_, wid = __builtin_amdgcn_readfirstlane(tid >> 6), lane = tid & 63, wr = wid >> 2, wc = wid & 3, fr = lane & 15, fq = lane >> 4;
    const int K = g.K, nt = K / BK;
    unsigned vA0[2], vA1[2], wA0[2], wA1[2], voffB[2];
    const size_t kstep = (size_t)(BK * 2);
    const size_t hstep = (size_t)HALF * K * 2;
    const size_t tstep = 2 * hstep;
#pragma unroll
    for (int i = 0; i < 2; ++i) { int R, C; stage_rc(tid * 16 + i * 8192, R, C); const int Rb = Epi::PERM ? ((R & ~31) + perm32(R & 31)) : R;
        vA0[i] = (unsigned)(R * K + C) * 2u; vA1[i] = vA0[i] + (unsigned)hstep; voffB[i] = (unsigned)(Rb * K + C) * 2u; wA0[i] = vA0[i]; wA1[i] = vA1[i]; }
    const unsigned ldsw = (unsigned)wid * 1024u;
    const int aoff = lds_byte(wr * 64 + fr, fq * 8), boff = lds_byte(wc * 32 + fr, fq * 8);
    const int a8o0 = lds_byte(wr * 64 + fr, fq * 16), a8o1 = lds_byte(wr * 64 + fr, fq * 16 + 8), b8o0 = lds_byte(wc * 32 + fr, fq * 16), b8o1 = lds_byte(wc * 32 + fr, fq * 16 + 8);
#define PG8_SA(b, h) (((b) * 2 + (h)) * HTB)
#define PG8_SB(b, h) ((4 + (b) * 2 + (h)) * HTB)
#define PG8_STAGE(bufoff, gbase, voff) do { _Pragma("unroll") for (int _i = 0; _i < 2; ++_i) \
        __builtin_amdgcn_global_load_lds((const unsigned*)((const char*)(gbase) + (voff)[_i]), (PG8_LAS unsigned*)(lds + (bufoff) + ldsw + _i * 8192), 16, 0, 0); } while (0)
#define PG8_LDA_BF(dst, b, h) do { _Pragma("unroll") for (int m = 0; m < 4; ++m) _Pragma("unroll") for (int k = 0; k < 2; ++k) dst[m][k] = *(const PG8_LAS bf16x8*)(lds + PG8_SA(b, h) + aoff + m * 2048 + k * 1024); } while (0)
#define PG8_LDB_BF(dst, b, h) do { _Pragma("unroll") for (int n = 0; n < 2; ++n) _Pragma("unroll") for (int k = 0; k < 2; ++k) dst[n][k] = *(const PG8_LAS bf16x8*)(lds + PG8_SB(b, h) + boff + n * 2048 + k * 1024); } while (0)
#define PG8_MMA_BF(ai, bj, At, Bt) do { if (cur.nr > 128 * (ai) + 64 * wr) { __builtin_amdgcn_s_setprio(1); _Pragma("unroll") for (int m = 0; m < 4; ++m) _Pragma("unroll") for (int n = 0; n < 2; ++n) _Pragma("unroll") for (int k = 0; k < 2; ++k) \
        acc[ai][bj][m][n] = __builtin_amdgcn_mfma_f32_16x16x32_bf16(Bt[n][k], At[m][k], acc[ai][bj][m][n], 0, 0, 0); __builtin_amdgcn_s_setprio(0); } } while (0)
#define PG8_LD8(dst, i_, base_, o0_, o1_) do { const u32x4 lo_ = *(const PG8_LAS u32x4*)(lds + (base_) + (o0_) + (i_) * 2048), hi_ = *(const PG8_LAS u32x4*)(lds + (base_) + (o1_) + (i_) * 2048); \
        dst[i_] = (i32x8){(int)lo_.x, (int)lo_.y, (int)lo_.z, (int)lo_.w, (int)hi_.x, (int)hi_.y, (int)hi_.z, (int)hi_.w}; } while (0)
#define PG8_LDA_F8(dst, b, h) do { _Pragma("unroll") for (int m = 0; m < 4; ++m) PG8_LD8(dst, m, PG8_SA(b, h), a8o0, a8o1); } while (0)
#define PG8_LDB_F8(dst, b, h) do { _Pragma("unroll") for (int n = 0; n < 2; ++n) PG8_LD8(dst, n, PG8_SB(b, h), b8o0, b8o1); } while (0)
#define PG8_MMA_F8(ai, bj, At, Bt) do { if (cur.nr > 128 * (ai) + 64 * wr) { __builtin_amdgcn_s_setprio(1); _Pragma("unroll") for (int m = 0; m < 4; ++m) _Pragma("unroll") for (int n = 0; n < 2; ++n) \
        acc[ai][bj][m][n] = __builtin_amdgcn_mfma_scale_f32_16x16x128_f8f6f4(Bt[n], At[m], acc[ai][bj][m][n], 0, 0, 0, 0x7A7A7A7A  , 0, 0x7F7F7F7F  ); __builtin_amdgcn_s_setprio(0); } } while (0)
#define PG8_LDA(dst, b, h) do { if constexpr (F8) { PG8_LDA_F8(dst##8, b, h); } else { PG8_LDA_BF(dst, b, h); } } while (0)
#define PG8_LDB(dst, b, h) do { if constexpr (F8) { PG8_LDB_F8(dst##8, b, h); } else { PG8_LDB_BF(dst, b, h); } } while (0)
#define PG8_MMA(ai, bj, At, Bt) do { if constexpr (F8) { PG8_MMA_F8(ai, bj, At##8, Bt##8); } else { PG8_MMA_BF(ai, bj, At, Bt); } } while (0)
#define PG8_WAIT_V(n) asm volatile("s_waitcnt vmcnt(" #n ")" ::: "memory")
#define PG8_WAIT_L(n) asm volatile("s_waitcnt lgkmcnt(" #n ")" ::: "memory")
#define PG8_BAR __builtin_amdgcn_s_barrier()
#define PG8_SCHED __builtin_amdgcn_sched_barrier(0)
    Unit cur, nxt; int ui = 0;
    if (!S.next(0, cur)) return;
    f32x4 acc[2][2][4][2];
#pragma unroll
    for (int a = 0; a < 2; ++a)
#pragma unroll
        for (int b = 0; b < 2; ++b)
#pragma unroll
            for (int m = 0; m < 4; ++m)
#pragma unroll
                for (int n = 0; n < 2; ++n) acc[a][b][m][n] = (f32x4){0.f, 0.f, 0.f, 0.f};
    bf16x8 At[4][2], B0[2][2], B1[2][2]; i32x8 At8[4], B08[2], B18[2];
    const char* cA = GATHER ? (const char*)g.A : (const char*)g.A + (size_t)cur.pm * tstep; const char* cB = (const char*)g.Bt + (size_t)cur.pn * tstep;
    if constexpr (GATHER) gather_voffs(S, 0, tid, K, vA0, vA1);
    PG8_STAGE(PG8_SB(0, 0), cB, voffB); PG8_STAGE(PG8_SB(0, 1), cB + hstep, voffB); PG8_STAGE(PG8_SA(0, 0), cA, vA0); PG8_STAGE(PG8_SA(0, 1), cA, vA1);
    if (wr == 1) PG8_BAR;
    PG8_WAIT_V(2); PG8_BAR;
    PG8_STAGE(PG8_SB(1, 0), cB + kstep, voffB); PG8_STAGE(PG8_SA(1, 0), cA + kstep, vA0); PG8_STAGE(PG8_SB(1, 1), cB + hstep + kstep, voffB);
    PG8_WAIT_V(6); PG8_BAR;
    for (;;) {
        const bool has_next = S.next(ui + 1, nxt);
        const char* nA = GATHER ? cA : (has_next ? (const char*)g.A + (size_t)nxt.pm * tstep : cA); const char* nB = has_next ? (const char*)g.Bt + (size_t)nxt.pn * tstep : cB;
        if constexpr (GATHER) { if (has_next) gather_voffs(S, ui + 1, tid, K, wA0, wA1); else { wA0[0] = vA0[0]; wA0[1] = vA0[1]; wA1[0] = vA1[0]; wA1[1] = vA1[1]; } }
        for (int t = 0; t < nt; t += 2) {
            const bool last = (t == nt - 2);
            const char* a1 = cA + (size_t)(t + 1) * kstep;
            const char* a2 = last ? nA : cA + (size_t)(t + 2) * kstep; const char* b2 = last ? nB : cB + (size_t)(t + 2) * kstep;
            const char* a3 = a2 + kstep; const char* b3 = b2 + kstep;
            unsigned sA0[2], sA1[2];
#pragma unroll
            for (int i = 0; i < 2; ++i) { sA0[i] = (GATHER && last) ? wA0[i] : vA0[i]; sA1[i] = (GATHER && last) ? wA1[i] : vA1[i]; }
            if constexpr (Epi::MIDK) { if (t == nt / 2) E.midk(acc, wr, fr); }
            PG8_LDB(B0, 0, 0); PG8_LDB(B1, 0, 1); PG8_SCHED; PG8_LDA(At, 0, 0); PG8_STAGE(PG8_SA(1, 1), a1, vA1);
            PG8_WAIT_V(8); PG8_WAIT_L(0); PG8_BAR; PG8_MMA(0, 0, At, B0); PG8_MMA(0, 1, At, B1); PG8_BAR; PG8_SCHED;
            PG8_LDA(At, 0, 1); PG8_STAGE(PG8_SB(0, 0), b2, voffB); PG8_STAGE(PG8_SB(0, 1), b2 + hstep, voffB); PG8_STAGE(PG8_SA(0, 0), a2, sA0);
            PG8_WAIT_V(8); PG8_WAIT_L(0); PG8_BAR; PG8_MMA(1, 0, At, B0); PG8_MMA(1, 1, At, B1); PG8_BAR; PG8_SCHED;
            PG8_LDB(B0, 1, 0); PG8_LDB(B1, 1, 1); PG8_SCHED; PG8_LDA(At, 1, 0); PG8_STAGE(PG8_SA(0, 1), a2, sA1);
            PG8_WAIT_V(8); PG8_WAIT_L(0); PG8_BAR; PG8_MMA(0, 0, At, B0); PG8_MMA(0, 1, At, B1); PG8_BAR; PG8_SCHED;
            PG8_LDA(At, 1, 1); PG8_STAGE(PG8_SB(1, 0), b3, voffB); PG8_STAGE(PG8_SB(1, 1), b3 + hstep, voffB); PG8_STAGE(PG8_SA(1, 0), a3, sA0);
            PG8_WAIT_V(8); PG8_WAIT_L(0); PG8_BAR; PG8_MMA(1, 0, At, B0); PG8_MMA(1, 1, At, B1); PG8_BAR; PG8_SCHED;
        }
        if constexpr (ALIGN_EPI) { if (wr == 0) PG8_BAR; }
        E(acc, cur, ui, wr, wc, fr, fq);
        if (!has_next) break;
#pragma unroll
        for (int a = 0; a < 2; ++a)
#pragma unroll
            for (int b = 0; b < 2; ++b)
#pragma unroll
                for (int m = 0; m < 4; ++m)
#pragma unroll
                    for (int n = 0; n < 2; ++n) acc[a][b][m][n] = (f32x4){0.f, 0.f, 0.f, 0.f};
        cur = nxt; cA = nA; cB = nB; ++ui;
        if constexpr (GATHER) { vA0[0] = wA0[0]; vA0[1] = wA0[1]; vA1[0] = wA1[0]; vA1[1] = wA1[1]; }
        if constexpr (ALIGN_EPI) { if (wr == 1) PG8_BAR; }
    }
    PG8_WAIT_V(0);
    if constexpr (!ALIGN_EPI) { if (wr == 0) PG8_BAR; }
    PG8_BAR;
#undef PG8_SA
#undef PG8_SB
#undef PG8_STAGE
#undef PG8_LDA
#undef PG8_LDB
#undef PG8_MMA
#undef PG8_LDA_BF
#undef PG8_LDB_BF
#undef PG8_MMA_BF
#undef PG8_LD8
#undef PG8_LDA_F8
#undef PG8_LDB_F8
#undef PG8_MMA_F8
#undef PG8_WAIT_V
#undef PG8_WAIT_L
#undef PG8_BAR
#undef PG8_SCHED
}

struct EpiProj {
    static constexpr bool PERM = true, MIDK = false;
    bf16_t* O;
    __device__ __forceinline__ void operator()(const f32x4 (&acc)[2][2][4][2], const Unit& u, int, int wr, int wc, int fr, int fq) const {
        const int row0 = u.pm * BM + wr * 64 + fr, col0 = u.pn * BM + wc * 32 + 8 * fq;
        const float sc = (u.pn < 2 || (u.pn >= 6 && u.pn < 8)) ? C2 : 1.f;
#pragma unroll
        for (int ai = 0; ai < 2; ++ai)
#pragma unroll
            for (int m = 0; m < 4; ++m) { bf16_t* rowp = O + (size_t)(row0 + ai * HALF + m * 16) * NPROJ + col0;
#pragma unroll
                for (int bj = 0; bj < 2; ++bj) { const f32x4 v0 = acc[ai][bj][m][0] * sc, v1 = acc[ai][bj][m][1] * sc;
                    u32x4 w; w.x = cvt_pk_bf16(v0[0], v0[1]); w.y = cvt_pk_bf16(v0[2], v0[3]); w.z = cvt_pk_bf16(v1[0], v1[1]); w.w = cvt_pk_bf16(v1[2], v1[3]);
                    *(u32x4*)(rowp + bj * HALF) = w; } }
    }
};
struct EpiWout {
    static constexpr bool PERM = false, MIDK = true;
    const float* x; float* X1; bf16_t* X1B; const PG8_LAS float* ratio; const PG8_LAS float* rs;
    __device__ __forceinline__ void midk(f32x4 (&acc)[2][2][4][2], int wr, int fr) const {
#pragma unroll
        for (int ai = 0; ai < 2; ++ai)
#pragma unroll
            for (int m = 0; m < 4; ++m) { const float f = ratio[ai * HALF + wr * 64 + m * 16 + fr];
#pragma unroll
                for (int bj = 0; bj < 2; ++bj)
#pragma unroll
                    for (int n = 0; n < 2; ++n) acc[ai][bj][m][n] *= f; }
    }
    __device__ __forceinline__ void operator()(const f32x4 (&acc)[2][2][4][2], const Unit& u, int, int wr, int wc, int fr, int fq) const {
        const int col0 = u.pn * BM + wc * 32 + 4 * fq;
#pragma unroll
        for (int ai = 0; ai < 2; ++ai)
#pragma unroll
            for (int m = 0; m < 4; ++m) { const int r = ai * HALF + wr * 64 + m * 16 + fr; const float s = rs[r]; const size_t off = (size_t)(u.pm * BM + r) * DM + col0;
#pragma unroll
                for (int bj = 0; bj < 2; ++bj)
#pragma unroll
                    for (int n = 0; n < 2; ++n) { const f32x4 xv = *(const f32x4*)(x + off + bj * HALF + n * 16); const f32x4 o = xv + acc[ai][bj][m][n] * s;
                        *(f32x4*)(X1 + off + bj * HALF + n * 16) = o;
                        if (MOE_F8) *(unsigned*)((unsigned char*)X1B + off + bj * HALF + n * 16) = pk4_fp8(o[0], o[1], o[2], o[3]);
                        else { u32x2 w; w.x = cvt_pk_bf16(o[0], o[1]); w.y = cvt_pk_bf16(o[2], o[3]); *(u32x2*)(X1B + off + bj * HALF + n * 16) = w; } }
                asm volatile("" ::: "memory"); }
    }
};
constexpr int MOE_MAXU = 10;
struct MoeOrder {
    int NT, c; const PG8_LAS int* tb; const PG8_LAS int* tbE; const PG8_LAS int* tbC; const PG8_LAS int* cnt; const PG8_LAS int* tabA;
    int probe = 0;
    __device__ bool next(int i, Unit& u) const {
        if (i >= MOE_MAXU) return false;
        const int x = c & 7, j = c >> 3, UE = tbE[32] * NT, UC = tbC[32] * NT;
        const int qE = UE >> 3, rE = UE & 7, sE = x * qE + (x < rE ? x : rE), nE = qE + (x < rE ? 1 : 0);
        const int qC = UC >> 3, rC = UC & 7, sC = x * qC + (x < rC ? x : rC), nC = qC + (x < rC ? 1 : 0);
        const int nEj = (j < nE) ? ((nE - j + 31) >> 5) : 0;
        if (i < nEj) {
            const int f = sE + i * 32 + j; int e = 0; while (f >= tbE[e + 1] * NT) ++e;
            const int idx = f - tbE[e] * NT, nte = tbE[e + 1] - tbE[e], pg = idx / (4 * nte), rem2 = idx - pg * 4 * nte, mt = rem2 >> 2;
            u.pm = tb[e] + mt; u.pn = e * NT + pg * 4 + (rem2 & 3); const int left = cnt[e] - 256 * mt; u.nr = left < BM ? left : BM;
        } else {
            const int jj = (j - (nE & 31) + 32) & 31, lc = (i - nEj) * 32 + jj; if (lc >= nC) return false;
            const int f = sC + lc; int e = 0; while (f >= tbC[e + 1] * NT) ++e;
            const int mt = tbE[e + 1] - tbE[e]; u.pm = tb[e] + mt; u.pn = e * NT + (f - tbC[e] * NT); u.nr = cnt[e] - 256 * mt;
        }
        if (probe) { u.pm &= 31; u.pn &= 7; if (probe == 2) u.nr = 32; }
        return true;
    }
    __device__ __forceinline__ const PG8_LAS int* rowtab(int ui) const { return tabA + ui * 256; }
};
struct EpiMoe1 {
    static constexpr bool PERM = true, MIDK = false;
    bf16_t* H; const float* b1; const PG8_LAS float* rstab;
    __device__ __forceinline__ void operator()(const f32x4 (&acc)[2][2][4][2], const Unit& u, int ui, int wr, int wc, int fr, int fq) const {
        const int e = u.pn >> 3, pl = u.pn & 7, colA = pl * 128 + wc * 32 + 8 * fq;
        f32x4 bg[2], bl[2];
#pragma unroll
        for (int n = 0; n < 2; ++n) { bg[n] = *(const f32x4*)(b1 + (size_t)e * 2048 + colA + 4 * n); bl[n] = *(const f32x4*)(b1 + (size_t)e * 2048 + 1024 + colA + 4 * n); }
#pragma unroll
        for (int ai = 0; ai < 2; ++ai)
#pragma unroll
            for (int m = 0; m < 4; ++m) { const int r = ai * HALF + wr * 64 + m * 16 + fr; const float rs = rstab[ui * 256 + r];
                float a8[8];
#pragma unroll
                for (int n = 0; n < 2; ++n) { const f32x4 gv = acc[ai][0][m][n] * rs + bg[n], lv = acc[ai][1][m][n] * rs + bl[n];
#pragma unroll
                    for (int i = 0; i < 4; ++i) { const float gl = fminf(gv[i], 7.f), li = fminf(fmaxf(lv[i], -7.f), 7.f);
                        a8[4 * n + i] = gl * __builtin_amdgcn_rcpf(1.f + __builtin_amdgcn_exp2f(-1.702f * LOG2E * gl)) * (li + 1.f); } }
                if (MOE_F8) { u32x2 w; w.x = pk4_fp8(a8[0], a8[1], a8[2], a8[3]); w.y = pk4_fp8(a8[4], a8[5], a8[6], a8[7]); *(u32x2*)((unsigned char*)H + (size_t)(u.pm * BM + r) * DM + colA) = w; }
                else { u32x4 w; w.x = cvt_pk_bf16(a8[0], a8[1]); w.y = cvt_pk_bf16(a8[2], a8[3]); w.z = cvt_pk_bf16(a8[4], a8[5]); w.w = cvt_pk_bf16(a8[6], a8[7]);
                *(u32x4*)(H + (size_t)(u.pm * BM + r) * DM + colA) = w; } }
    }
};
struct EpiMoe2 {
    static constexpr bool PERM = true, MIDK = false;
    bf16_t* Y; const float* b2; const PG8_LAS float* wtab;
    __device__ __forceinline__ void operator()(const f32x4 (&acc)[2][2][4][2], const Unit& u, int ui, int wr, int wc, int fr, int fq) const {
        const int e = u.pn >> 2, pl = u.pn & 3, col0 = pl * BM + wc * 32 + 8 * fq;
        f32x4 bv[2][2];
#pragma unroll
        for (int bj = 0; bj < 2; ++bj)
#pragma unroll
            for (int n = 0; n < 2; ++n) bv[bj][n] = *(const f32x4*)(b2 + (size_t)e * DM + col0 + bj * HALF + 4 * n);
#pragma unroll
        for (int ai = 0; ai < 2; ++ai)
#pragma unroll
            for (int m = 0; m < 4; ++m) { const int r = ai * HALF + wr * 64 + m * 16 + fr; const float wt = wtab[ui * 256 + r]; bf16_t* rowp = Y + (size_t)(u.pm * BM + r) * DM + col0;
#pragma unroll
                for (int bj = 0; bj < 2; ++bj) { const f32x4 v0 = (acc[ai][bj][m][0] + bv[bj][0]) * wt, v1 = (acc[ai][bj][m][1] + bv[bj][1]) * wt;
                    u32x4 w; w.x = cvt_pk_bf16(v0[0], v0[1]); w.y = cvt_pk_bf16(v0[2], v0[3]); w.z = cvt_pk_bf16(v1[0], v1[1]); w.w = cvt_pk_bf16(v1[2], v1[3]);
                    *(u32x4*)(rowp + bj * HALF) = w; } }
    }
};
struct ListOrder {
    const PG8_LAS int* ud; int n; const PG8_LAS int* tabA;
    __device__ __forceinline__ bool next(int i, Unit& u) const { if (i >= n) return false; u.pm = ud[3 * i]; u.pn = ud[3 * i + 1]; u.nr = ud[3 * i + 2]; return true; }
    __device__ __forceinline__ const PG8_LAS int* rowtab(int ui) const { return tabA + ui * 256; }
};
struct EpiNull {
    static constexpr bool PERM = true, MIDK = false; float* O;
    __device__ __forceinline__ void operator()(const f32x4 (&acc)[2][2][4][2], const Unit& u, int ui, int wr, int wc, int fr, int fq) const {
        f32x4 t = (f32x4){0.f, 0.f, 0.f, 0.f};
#pragma unroll
        for (int ai = 0; ai < 2; ++ai)
#pragma unroll
            for (int bj = 0; bj < 2; ++bj)
#pragma unroll
                for (int m = 0; m < 4; ++m)
#pragma unroll
                    for (int n = 0; n < 2; ++n) t += acc[ai][bj][m][n];
        O[(size_t)(u.pm & 31) * 65536 + (u.pn & 7) * 8192 + (wr * 4 + wc) * 64 + fq * 16 + fr + ui] = t[0] + t[1] + t[2] + t[3];
    }
};
}

#include <hip/hip_bf16.h>
#include <cmath>
namespace attn_body {

using bf16=__hip_bfloat16;
using bf16x8=__attribute__((ext_vector_type(8)))short;
using s16x4=__attribute__((ext_vector_type(4)))short;
using f32x16=__attribute__((ext_vector_type(16)))float;
using u32x4=__attribute__((ext_vector_type(4)))unsigned;
constexpr int SEQ=4096,D=64,PIN=3072,POUT=1024;
constexpr int NW=8,QBLK=32,QB=QBLK*NW,KVBLK=64,NQB=SEQ/QB;
__device__ __forceinline__ int crow(int r,int hi){return (r&3)+8*(r>>2)+4*hi;}
#define SBAR() __builtin_amdgcn_sched_barrier(0)
__device__ __forceinline__ void cmask(f32x16&p0,f32x16&p1,int jb,int qrel,int hi){
  const float NEG=-INFINITY; int kb=64*jb+4*hi;
  #pragma unroll
  for(int r=0;r<16;++r){int kv=kb+(r&3)+8*(r>>2); if(kv>qrel)p0[r]=NEG; if(kv+32>qrel)p1[r]=NEG;}
}

constexpr int NSLOT=3, SLOTB=8192;
constexpr int LDS_K=0, LDS_V=NSLOT*SLOTB, LDS_WS=2*NSLOT*SLOTB, LDS_OST=LDS_WS+NW*64*4, LDS_CK=LDS_OST+NW*4096, LDS_BYTES=LDS_CK+SEQ*4;
constexpr float C2=0.125f*1.4426950408889634f;
__device__ __forceinline__ void glds16(const void*gsrc,unsigned lds_dst){unsigned keep;
  asm volatile("s_mov_b32 %0, m0\n\ts_mov_b32 m0, %2\n\ts_nop 0\n\tglobal_load_lds_dwordx4 %1, off\n\ts_mov_b32 m0, %0":"=&s"(keep):"v"(gsrc),"s"(lds_dst):"memory");}
__device__ __forceinline__ float max3f(float a,float b,float c){float r;asm("v_max3_f32 %0, %1, %2, %3":"=v"(r):"v"(a),"v"(b),"v"(c));return r;}
__device__ __forceinline__ float max2f(float a,float b){float r;asm("v_max_f32_e32 %0, %1, %2":"=v"(r):"v"(a),"v"(b));return r;}
__device__ __forceinline__ float fadd_s(float a,float b){float r;asm("v_add_f32_e32 %0, %1, %2":"=v"(r):"v"(a),"v"(b));return r;}
__device__ __forceinline__ float fsub_s(float a,float b){float r;asm("v_sub_f32_e32 %0, %1, %2":"=v"(r):"v"(a),"v"(b));return r;}
typedef float f32x2_t __attribute__((ext_vector_type(2))); typedef float f32x4_t __attribute__((ext_vector_type(4))); typedef __bf16 bf16x2_t __attribute__((ext_vector_type(2)));
__device__ __forceinline__ unsigned cvtpk_s(float lo,float hi){f32x2_t v={lo,hi};bf16x2_t b=__builtin_convertvector(v,bf16x2_t);return __builtin_bit_cast(unsigned,b);}
#define WAIT_BAR(N) asm volatile("s_waitcnt vmcnt(" #N ") lgkmcnt(0)\n\ts_barrier":::"memory")

__device__ __forceinline__ void qkt(f32x16&p0,f32x16&p1,const char*Kslot,const bf16x8*qr,const f32x16&negm,int r32,int hi){
  const char*kb=Kslot+hi*1024+r32*16;
  #pragma unroll
  for(int d0=0;d0<4;++d0){
    const bf16x8 b0=*reinterpret_cast<const bf16x8*>(kb+d0*2048);
    const bf16x8 b1=*reinterpret_cast<const bf16x8*>(kb+d0*2048+512);
    if(d0==0){p0=__builtin_amdgcn_mfma_f32_32x32x16_bf16(b0,qr[0],negm,0,0,0);p1=__builtin_amdgcn_mfma_f32_32x32x16_bf16(b1,qr[0],negm,0,0,0);}
    else{p0=__builtin_amdgcn_mfma_f32_32x32x16_bf16(b0,qr[d0],p0,0,0,0);p1=__builtin_amdgcn_mfma_f32_32x32x16_bf16(b1,qr[d0],p1,0,0,0);}}
}
typedef __attribute__((address_space(3))) const char* lds_cptr;
typedef short v4i16_t __attribute__((ext_vector_type(4)));
__device__ __forceinline__ void kload8(bf16x8*kf,lds_cptr kp){
  kf[0]=*(const __attribute__((address_space(3))) bf16x8*)(kp);      kf[1]=*(const __attribute__((address_space(3))) bf16x8*)(kp+512);
  kf[2]=*(const __attribute__((address_space(3))) bf16x8*)(kp+2048); kf[3]=*(const __attribute__((address_space(3))) bf16x8*)(kp+2560);
  kf[4]=*(const __attribute__((address_space(3))) bf16x8*)(kp+4096); kf[5]=*(const __attribute__((address_space(3))) bf16x8*)(kp+4608);
  kf[6]=*(const __attribute__((address_space(3))) bf16x8*)(kp+6144); kf[7]=*(const __attribute__((address_space(3))) bf16x8*)(kp+6656);
}
__device__ __forceinline__ void kload2(bf16x8*kf,lds_cptr kp,int j){ kf[2*j]=*(const __attribute__((address_space(3))) bf16x8*)(kp+j*2048); kf[2*j+1]=*(const __attribute__((address_space(3))) bf16x8*)(kp+j*2048+512); }
__device__ __forceinline__ s16x4 vtr(lds_cptr p){ return __builtin_bit_cast(s16x4,__builtin_amdgcn_ds_read_tr16_b64_v4i16((__attribute__((address_space(3))) v4i16_t*)p)); }
__device__ __forceinline__ float rowmax(const f32x16&p0,const f32x16&p1){
  float a=max3f(p0[0],p0[1],p1[0]),b=max3f(p0[2],p0[3],p1[1]);a=max3f(a,p1[2],p1[3]);
  #pragma unroll
  for(int r=4;r<16;r+=4){a=max3f(a,p0[r],p0[r+1]);b=max3f(b,p0[r+2],p0[r+3]);a=max3f(a,p1[r],p1[r+1]);b=max3f(b,p1[r+2],p1[r+3]);}
  const float m=max2f(a,b);
  auto rr=__builtin_amdgcn_permlane32_swap(__float_as_uint(m),__float_as_uint(m),false,false);
  return max2f(__uint_as_float(rr[0]),__uint_as_float(rr[1]));
}
__device__ __forceinline__ void pv(f32x16*o,int vb,bf16x8 pa0,bf16x8 pa1,bf16x8 pa2,bf16x8 pa3){
  #pragma unroll
  for(int d0=0;d0<2;++d0){s16x4 lo[4],hi[4];
    #pragma unroll
    for(int ks=0;ks<4;++ks){
      asm volatile("ds_read_b64_tr_b16 %0,%1 offset:%c2":"=&v"(lo[ks]):"v"(vb),"i"(d0*4096+ks*1024):"memory");
      asm volatile("ds_read_b64_tr_b16 %0,%1 offset:%c2":"=&v"(hi[ks]):"v"(vb),"i"(d0*4096+ks*1024+512):"memory");}
    asm volatile("s_waitcnt lgkmcnt(0)":::"memory");SBAR();
    #define PK(k) (bf16x8){lo[k][0],lo[k][1],lo[k][2],lo[k][3],hi[k][0],hi[k][1],hi[k][2],hi[k][3]}
    o[d0]=__builtin_amdgcn_mfma_f32_32x32x16_bf16(pa0,PK(0),o[d0],0,0,0);
    o[d0]=__builtin_amdgcn_mfma_f32_32x32x16_bf16(pa1,PK(1),o[d0],0,0,0);
    o[d0]=__builtin_amdgcn_mfma_f32_32x32x16_bf16(pa2,PK(2),o[d0],0,0,0);
    o[d0]=__builtin_amdgcn_mfma_f32_32x32x16_bf16(pa3,PK(3),o[d0],0,0,0);
    #undef PK
  }
}

#ifndef ATTN_STORE16
#define ATTN_STORE16(p,v) (*(u32x4*)(p)=(v))
#endif
template<int THRL> __device__ __forceinline__ void attn_unit(int b,int h,int qb,const bf16*Q,const bf16*__restrict__ K,const bf16*__restrict__ V,bf16*O,const float*__restrict__ CUMbh,float*__restrict__ SSQh,char*shm){
  int tid_=threadIdx.x; asm volatile("":"+v"(tid_));
  const int tid=tid_,lane=tid&63,r32=lane&31,hi=lane>>5; const int wid=__builtin_amdgcn_readfirstlane(tid>>6);
  const long rowbase=(long)b*SEQ; const int q0=qb*QB;
  const bf16*Qw=Q+(rowbase+q0+wid*QBLK)*PIN+h*D;
  const bf16*Kh=K+rowbase*PIN+h*D,*Vh=V+rowbase*PIN+h*D;
  const unsigned lds0=(unsigned)(uintptr_t)shm;
  const lds_cptr shm3=(lds_cptr)shm;
  float*wsf=(float*)(shm+LDS_WS)+wid*64;
  const bf16*ksrc=Kh+(long)lane*PIN+wid*8;
  const bf16*vsrc=Vh+(long)(16*(wid&3)+(lane>>2))*PIN+(wid>>2)*32+(lane&3)*8;
  const unsigned kdst=lds0+LDS_K+wid*1024, vdst=lds0+LDS_V+wid*1024;
  #define DMA_K(t,slot) glds16(ksrc+(long)(t)*KVBLK*PIN,(unsigned)__builtin_amdgcn_readfirstlane(kdst+(slot)))
  #define DMA_V(t,slot) glds16(vsrc+(long)(t)*KVBLK*PIN,(unsigned)__builtin_amdgcn_readfirstlane(vdst+(slot)))
  const int vb0=(int)(lds0+LDS_V)+((lane>>4)&1)*32+(lane&3)*8+(4*hi+((lane&15)>>2))*64;
  const char*Kbase=shm+LDS_K; bf16x8 kf[8];
  const lds_cptr kp0=shm3+LDS_K+hi*1024+r32*16; const lds_cptr vp0=shm3+LDS_V+((lane>>4)&1)*32+(lane&3)*8+(4*hi+((lane&15)>>2))*64;
  const int NT=(q0+QB)/KVBLK;
  DMA_K(0,0);DMA_V(0,0);DMA_K(1,SLOTB);
  bf16x8 qr[4];
  #pragma unroll
  for(int d0=0;d0<4;++d0)qr[d0]=*reinterpret_cast<const bf16x8*>(&Qw[(long)r32*PIN+d0*16+hi*8]);
  const float cbase=CUMbh[q0]; const float cq=CUMbh[q0+wid*QBLK+r32]-cbase;
  { __attribute__((address_space(3))) float*ckw=(__attribute__((address_space(3))) float*)(shm3+LDS_CK); int s0_=tid; asm volatile("":"+v"(s0_));
    _Pragma("nounroll") for(int s=s0_;s<q0+QB;s+=NW*64)ckw[s]=CUMbh[s]-cbase; }
  const __attribute__((address_space(3))) float*ckp=(const __attribute__((address_space(3))) float*)(shm3+LDS_CK)+4*hi;
  float mhat=-cq,l_reg=0.f;f32x16 o[2];o[0]=f32x16{};o[1]=f32x16{};f32x16 negm;
  #pragma unroll
  for(int r=0;r<16;++r)negm[r]=cq;
  asm volatile("":"+v"(negm));
  const int qrel=wid*QBLK+r32;
  #define BIAS(P0,P1,t) do{ const __attribute__((address_space(3))) float*cp_=ckp+(t)*KVBLK; \
    _Pragma("unroll") for(int g_=0;g_<4;++g_){ const f32x4_t c0_=*(const __attribute__((address_space(3))) f32x4_t*)(cp_+8*g_), c1_=*(const __attribute__((address_space(3))) f32x4_t*)(cp_+32+8*g_); \
      _Pragma("unroll") for(int j_=0;j_<4;++j_){ P0[4*g_+j_]-=c0_[j_]; P1[4*g_+j_]-=c1_[j_]; } SBAR(); } }while(0)
  #define CMASK(P0,P1,t) do{int jb_=(t)-(NT-4); if(jb_>=0)cmask(P0,P1,jb_,qrel,hi);}while(0)
  bool resc=false;
  #define START(P0,P1) do{ const float rm=rowmax(P0,P1); resc=false; \
    { const float dl=rm; mhat=fadd_s(mhat,dl); \
      _Pragma("unroll") for(int r=0;r<16;++r){P0[r]=fsub_s(P0[r],dl);P1[r]=fsub_s(P1[r],dl);} \
      _Pragma("unroll") for(int r=0;r<16;++r)negm[r]=-mhat; asm volatile("":"+v"(negm)); } \
    _Pragma("unroll") for(int r=0;r<16;++r)P0[r]=__builtin_amdgcn_exp2f(P0[r]); }while(0)
  #define RESC() do{ if(resc){ asm volatile("s_waitcnt lgkmcnt(0)":::"memory"); \
      _Pragma("unroll") for(int d_=0;d_<2;++d_) _Pragma("unroll") for(int r=0;r<16;++r)o[d_][r]*=wsf[crow(r,hi)]; } }while(0)
  f32x16 pA0,pA1,pB0,pB1;
  int sl_prev=0,sl_cur=0,sl_next=SLOTB;
  #define ROT() do{sl_prev=sl_cur;sl_cur=sl_next;sl_next=(sl_next==(NSLOT-1)*SLOTB)?0:sl_next+SLOTB;}while(0)
  DMA_K(2,2*SLOTB);
  WAIT_BAR(3);
  qkt(pA0,pA1,Kbase,qr,negm,r32,hi);asm volatile("s_nop 15\n\ts_nop 7":"+v"(pA0),"+v"(pA1));BIAS(pA0,pA1,0);CMASK(pA0,pA1,0);
  START(pA0,pA1);
  _Pragma("unroll") for(int r=0;r<16;++r)pA1[r]=__builtin_amdgcn_exp2f(pA1[r]);
  WAIT_BAR(0);
  DMA_K(3,0);DMA_V(1,SLOTB);
  ROT();
  kload8(kf,kp0+sl_cur);
  WAIT_BAR(2);
  s16x4 vlo[8],vhi[8]; u32x4 pw0,pw1,pw2,pw3;
  #define PKW(P,B) cvtpk_s(P[B],P[B+1])
  #define PAF(k) __builtin_bit_cast(bf16x8,pw##k)
  #define VFR(i) (bf16x8){vlo[i][0],vlo[i][1],vlo[i][2],vlo[i][3],vhi[i][0],vhi[i][1],vhi[i][2],vhi[i][3]}
  #define PIN(x) asm volatile("":"+v"(x))
  #define MX3(a,b,c) __builtin_fmaxf(__builtin_fmaxf((a),(b)),(c))
  #define GAPA(MF,A0,A1,A2,A3,W0,W1,PW) do{ MF; sacc+=A0; sacc+=A1; sacc+=A2; sacc+=A3; PIN(sacc); W0; W1; PIN(PW); SBAR(); }while(0)
  #define EX(v) __builtin_amdgcn_exp2f(v)
  #define GAPB(MF,X,B) do{ MF; X[B]=EX(X[B]); X[B+1]=EX(X[B+1]); X[B+2]=EX(X[B+2]); X[B+3]=EX(X[B+3]); PIN(X); SBAR(); }while(0)
  #define VRD(i) do{ vlo[i]=vtr(vp_+(((i)>>2)*4096+((i)&3)*1024)); vhi[i]=vtr(vp_+(((i)>>2)*4096+((i)&3)*1024+512)); }while(0)
  #define KRD(G,j) do{ if(G){ kload2(kf,kp0+sl_next,j); SBAR(); } }while(0)
  #define STEP(C0,C1,P0,P1,t,GK,GV,GL) do{ SBAR(); \
    const lds_cptr vp_=vp0+sl_prev; \
    VRD(0); SBAR(); float sacc=(P0[0]+P0[1]); \
    GAPA(C0=__builtin_amdgcn_mfma_f32_32x32x16_bf16(kf[0],qr[0],negm,0,0,0), P0[2],P0[3],P0[4],P0[5],     pw0[0]=PKW(P0,0), pw0[1]=PKW(P0,2), pw0); \
    VRD(4); SBAR(); GAPA(C1=__builtin_amdgcn_mfma_f32_32x32x16_bf16(kf[1],qr[0],negm,0,0,0), P0[6],P0[7],P0[8],P0[9],     pw0[2]=PKW(P0,4), pw0[3]=PKW(P0,6), pw0); \
    VRD(1); SBAR(); GAPA(C0=__builtin_amdgcn_mfma_f32_32x32x16_bf16(kf[2],qr[1],C0,0,0,0),   P0[10],P0[11],P0[12],P0[13], pw1[0]=PKW(P0,8), pw1[1]=PKW(P0,10), pw1); \
    VRD(5); SBAR(); GAPA(C1=__builtin_amdgcn_mfma_f32_32x32x16_bf16(kf[3],qr[1],C1,0,0,0),   P0[14],P0[15],P1[0],P1[1],   pw1[2]=PKW(P0,12),pw1[3]=PKW(P0,14), pw1); \
    VRD(2); SBAR(); GAPA(C0=__builtin_amdgcn_mfma_f32_32x32x16_bf16(kf[4],qr[2],C0,0,0,0),   P1[2],P1[3],P1[4],P1[5],     pw2[0]=PKW(P1,0), pw2[1]=PKW(P1,2), pw2); \
    VRD(6); SBAR(); GAPA(C1=__builtin_amdgcn_mfma_f32_32x32x16_bf16(kf[5],qr[2],C1,0,0,0),   P1[6],P1[7],P1[8],P1[9],     pw2[2]=PKW(P1,4), pw2[3]=PKW(P1,6), pw2); \
    VRD(3); SBAR(); GAPA(C0=__builtin_amdgcn_mfma_f32_32x32x16_bf16(kf[6],qr[3],C0,0,0,0),   P1[10],P1[11],P1[12],P1[13], pw3[0]=PKW(P1,8), pw3[1]=PKW(P1,10), pw3); \
    VRD(7); SBAR(); GAPA(C1=__builtin_amdgcn_mfma_f32_32x32x16_bf16(kf[7],qr[3],C1,0,0,0),   P1[14],P1[15],0.f,0.f,       pw3[2]=PKW(P1,12),pw3[3]=PKW(P1,14), pw3); \
    l_reg+=sacc; \
    if(GK){DMA_K((t)+3,sl_cur);} if(GV){DMA_V((t)+1,sl_next);} \
    BIAS(C0,C1,t); CMASK(C0,C1,t); \
    { float a=MX3(C0[0],C0[1],C1[0]),b=MX3(C0[2],C0[3],C1[1]); a=MX3(a,C1[2],C1[3]); \
      _Pragma("unroll") for(int r=4;r<16;r+=4){a=MX3(a,C0[r],C0[r+1]);b=MX3(b,C0[r+2],C0[r+3]);a=MX3(a,C1[r],C1[r+1]);b=MX3(b,C1[r+2],C1[r+3]);} \
      float rm=__builtin_fmaxf(a,b); { auto rr=__builtin_amdgcn_permlane32_swap(__float_as_uint(rm),__float_as_uint(rm),false,false); rm=__builtin_fmaxf(__uint_as_float(rr[0]),__uint_as_float(rr[1])); } \
      resc=false; \
      if(__builtin_expect(__any(rm>(float)THRL),0)){ const float dl=__builtin_fmaxf(rm,0.f); mhat+=dl; \
        _Pragma("unroll") for(int r=0;r<16;++r){C0[r]-=dl;C1[r]-=dl;} \
        _Pragma("unroll") for(int r=0;r<16;++r)negm[r]=-mhat; asm volatile("":"+v"(negm)); \
        const float f=__builtin_amdgcn_exp2f(-dl); l_reg*=f; if(hi==0)wsf[r32]=f; resc=true; } } \
    SBAR(); \
    GAPB(o[0]=__builtin_amdgcn_mfma_f32_32x32x16_bf16(PAF(0),VFR(0),o[0],0,0,0), C0,0); \
    GAPB(o[1]=__builtin_amdgcn_mfma_f32_32x32x16_bf16(PAF(0),VFR(4),o[1],0,0,0), C0,4); \
    KRD(GL,0); GAPB(o[0]=__builtin_amdgcn_mfma_f32_32x32x16_bf16(PAF(1),VFR(1),o[0],0,0,0), C0,8); \
    KRD(GL,1); GAPB(o[1]=__builtin_amdgcn_mfma_f32_32x32x16_bf16(PAF(1),VFR(5),o[1],0,0,0), C0,12); \
    KRD(GL,2); GAPB(o[0]=__builtin_amdgcn_mfma_f32_32x32x16_bf16(PAF(2),VFR(2),o[0],0,0,0), C1,0); \
    KRD(GL,3); GAPB(o[1]=__builtin_amdgcn_mfma_f32_32x32x16_bf16(PAF(2),VFR(6),o[1],0,0,0), C1,4); \
    GAPB(o[0]=__builtin_amdgcn_mfma_f32_32x32x16_bf16(PAF(3),VFR(3),o[0],0,0,0), C1,8); \
    GAPB(o[1]=__builtin_amdgcn_mfma_f32_32x32x16_bf16(PAF(3),VFR(7),o[1],0,0,0), C1,12); \
    }while(0)
  int t=1;
  #undef CMASK
  #define CMASK(P0,P1,t) do{}while(0)
  for(;t+5<NT;t+=2){
    STEP(pB0,pB1,pA0,pA1,t,true,true,true);     WAIT_BAR(2); RESC(); ROT();
    STEP(pA0,pA1,pB0,pB1,t+1,true,true,true);   WAIT_BAR(2); RESC(); ROT();
  }
  #undef CMASK
  #define CMASK(P0,P1,t) do{int jb_=(t)-(NT-4); if(jb_>=0)cmask(P0,P1,jb_,qrel,hi);}while(0)
  #define ENDW(tt) do{ if((tt)+3<NT){WAIT_BAR(2);} else if((tt)+2<NT){WAIT_BAR(1);} else {WAIT_BAR(0);} }while(0)
  for(;t+1<NT;t+=2){
    STEP(pB0,pB1,pA0,pA1,t,(t+3<NT),(t+1<NT),(t+1<NT));       ENDW(t);   RESC(); ROT();
    STEP(pA0,pA1,pB0,pB1,t+1,(t+4<NT),(t+2<NT),(t+2<NT));     ENDW(t+1); RESC(); ROT();
  }
  STEP(pB0,pB1,pA0,pA1,NT-1,false,false,false); RESC();
  { float sacc=pB0[0]+pB0[1]; _Pragma("unroll") for(int r=2;r<16;++r)sacc+=pB0[r]; _Pragma("unroll") for(int r=0;r<16;++r)sacc+=pB1[r]; l_reg+=sacc;
    pw0=(u32x4){PKW(pB0,0),PKW(pB0,2),PKW(pB0,4),PKW(pB0,6)};pw1=(u32x4){PKW(pB0,8),PKW(pB0,10),PKW(pB0,12),PKW(pB0,14)};pw2=(u32x4){PKW(pB1,0),PKW(pB1,2),PKW(pB1,4),PKW(pB1,6)};pw3=(u32x4){PKW(pB1,8),PKW(pB1,10),PKW(pB1,12),PKW(pB1,14)};
    SBAR(); pv(o,vb0+sl_cur,PAF(0),PAF(1),PAF(2),PAF(3)); }
  #undef PKW
  #undef PAF
  #undef VFR
  #undef PIN
  #undef MX3
  #undef GAPA
  #undef GAPB
  #undef EX
  #undef VRD
  #undef KRD
  #undef STEP
  #undef ENDW
  {auto rr=__builtin_amdgcn_permlane32_swap(__float_as_uint(l_reg),__float_as_uint(l_reg),false,false);l_reg=__uint_as_float(rr[0])+__uint_as_float(rr[1]);}
  if(hi==0)wsf[32+r32]=l_reg;asm volatile("s_waitcnt lgkmcnt(0)":::"memory");
  float rli[16];
  #pragma unroll
  for(int r=0;r<16;++r)rli[r]=__builtin_amdgcn_rcpf(wsf[32+crow(r,hi)]);
  bf16*Ow=O+(rowbase+q0+wid*QBLK)*POUT+h*D; float*Sw=SSQh+(rowbase+q0+wid*QBLK)*16;
  { bf16*stg=(bf16*)(shm+LDS_OST)+wid*2048;
    #pragma unroll
    for(int r=0;r<16;++r){const int orow=crow(r,hi);
      #pragma unroll
      for(int d0=0;d0<2;++d0)stg[orow*64+d0*32+r32]=__float2bfloat16(o[d0][r]*rli[r]);}
    asm volatile("s_waitcnt lgkmcnt(0)":::"memory");
    #pragma unroll
    for(int i=0;i<4;++i){const int row=i*8+(lane>>3),ch=lane&7; const u32x4 v=*(const u32x4*)(stg+row*64+ch*8); ATTN_STORE16(Ow+(long)row*POUT+ch*8,v);
      float sq=0.f;
      #pragma unroll
      for(int w_=0;w_<4;++w_){const float lo_=__uint_as_float(v[w_]<<16),hi_=__uint_as_float(v[w_]&0xffff0000u);sq+=lo_*lo_+hi_*hi_;}
      sq+=__shfl_xor(sq,1);sq+=__shfl_xor(sq,2);sq+=__shfl_xor(sq,4); if(ch==0)Sw[row*16]=sq;} }
  asm volatile("s_waitcnt lgkmcnt(0)\n\ts_barrier":::"memory");
  #undef DMA_K
  #undef DMA_V
  #undef CMASK
  #undef BIAS
  #undef START
  #undef RESC
  #undef ROT
}
constexpr int ATTN_LDS_BYTES=LDS_BYTES;

__device__ __forceinline__ void sb_unit(int b,int h,int qb,const bf16*Q,const bf16*__restrict__ K,const bf16*__restrict__ V,bf16*O,float*__restrict__ SSQh,char*shm){
  int tid_=threadIdx.x; asm volatile("":"+v"(tid_));
  const int tid=tid_,lane=tid&63,r32=lane&31,hi=lane>>5; const int wid=__builtin_amdgcn_readfirstlane(tid>>6);
  const long rowbase=(long)b*SEQ; const int q0=qb*QB;
  const bf16*Qw=Q+(rowbase+q0+wid*QBLK)*PIN+h*D;
  const bf16*Kh=K+rowbase*PIN+h*D,*Vh=V+rowbase*PIN+h*D;
  const unsigned lds0=(unsigned)(uintptr_t)shm;
  const bf16*ksrc=Kh+(long)lane*PIN+wid*8;
  const bf16*vsrc=Vh+(long)(16*(wid&3)+(lane>>2))*PIN+(wid>>2)*32+(lane&3)*8;
  const unsigned kdst=lds0+LDS_K+wid*1024, vdst=lds0+LDS_V+wid*1024;
  const int vb0=(int)(lds0+LDS_V)+((lane>>4)&1)*32+(lane&3)*8+(4*hi+((lane&15)>>2))*64;
  const char*Kbase=shm+LDS_K;
  const int NT=(q0+QB)/KVBLK;
  #define SB_DMA(i,slot) do{ const long kt_=(long)(NT-1-(i)); glds16(ksrc+kt_*KVBLK*PIN,(unsigned)__builtin_amdgcn_readfirstlane(kdst+(slot))); glds16(vsrc+kt_*KVBLK*PIN,(unsigned)__builtin_amdgcn_readfirstlane(vdst+(slot))); }while(0)
  bf16x8 qr[4];
  #pragma unroll
  for(int d0=0;d0<4;++d0)qr[d0]=*reinterpret_cast<const bf16x8*>(&Qw[(long)r32*PIN+d0*16+hi*8]);
  SB_DMA(0,0); SB_DMA(1,SLOTB);
  f32x16 o[2];o[0]=f32x16{};o[1]=f32x16{};
  float Rc=1.f;
  const int qrel=wid*QBLK+r32;
  int sl_cur=0,sl_n1=SLOTB,sl_n2=2*SLOTB;
  volatile __attribute__((address_space(3))) unsigned*flg=(volatile __attribute__((address_space(3))) unsigned*)((lds_cptr)shm+LDS_WS);
  for(int i=0;i<NT;++i){
    if(i+1<NT){WAIT_BAR(2);}else{WAIT_BAR(0);}
    if(i>0){ const int pb=((i-1)&1)*8; unsigned all_=flg[pb]&flg[pb+1]&flg[pb+2]&flg[pb+3]&flg[pb+4]&flg[pb+5]&flg[pb+6]&flg[pb+7]; if(__builtin_amdgcn_readfirstlane(all_))break; }
    if(i+2<NT)SB_DMA(i+2,sl_n2);
    f32x16 p0,p1; { f32x16 z=f32x16{}; asm volatile("":"+v"(z)); qkt(p0,p1,Kbase+sl_cur,qr,z,r32,hi); }
    f32x16 s0,s1;
    #pragma unroll
    for(int r=0;r<16;++r){
      const float za=__builtin_amdgcn_fmed3f(p0[r],-100.f,100.f), zb=__builtin_amdgcn_fmed3f(p1[r],-100.f,100.f);
      p0[r]=__builtin_amdgcn_exp2f(za); p1[r]=__builtin_amdgcn_exp2f(zb);
      s0[r]=__builtin_amdgcn_rcpf(1.f+p0[r]); s1[r]=__builtin_amdgcn_rcpf(1.f+p1[r]); }
    if(i<4){
      const int kb=64*(3-i)+4*hi;
      #pragma unroll
      for(int r=0;r<16;++r){ const int kv=kb+(r&3)+8*(r>>2); if(kv>=qrel){p0[r]=0.f;s0[r]=1.f;} if(kv+32>=qrel){p1[r]=0.f;s1[r]=1.f;} }
    }
    float gp[8],pp[8];
    #pragma unroll
    for(int g=0;g<4;++g){
      s0[4*g+2]*=s0[4*g+3]; s0[4*g+1]*=s0[4*g+2]; s0[4*g]*=s0[4*g+1]; gp[g]=s0[4*g];
      s1[4*g+2]*=s1[4*g+3]; s1[4*g+1]*=s1[4*g+2]; s1[4*g]*=s1[4*g+1]; gp[4+g]=s1[4*g]; }
    #pragma unroll
    for(int g=0;g<8;++g){ auto rr=__builtin_amdgcn_permlane32_swap(__float_as_uint(gp[g]),__float_as_uint(gp[g]),false,false); pp[g]=__uint_as_float(hi?rr[0]:rr[1]); }
    float st=Rc, outer[8];
    #pragma unroll
    for(int g=7;g>=0;--g){ outer[g]=hi?st:st*pp[g]; st=st*(gp[g]*pp[g]); }
    Rc=st;
    { const unsigned dn=__all(Rc==0.f)?1u:0u; if(lane==0)flg[(i&1)*8+wid]=dn; }
    #pragma unroll
    for(int r=0;r<16;++r){ p0[r]=p0[r]*(s0[r]*outer[r>>2]); p1[r]=p1[r]*(s1[r]*outer[4+(r>>2)]); }
    u32x4 pw0,pw1,pw2,pw3;
    pw0=(u32x4){cvtpk_s(p0[0],p0[1]),cvtpk_s(p0[2],p0[3]),cvtpk_s(p0[4],p0[5]),cvtpk_s(p0[6],p0[7])};
    pw1=(u32x4){cvtpk_s(p0[8],p0[9]),cvtpk_s(p0[10],p0[11]),cvtpk_s(p0[12],p0[13]),cvtpk_s(p0[14],p0[15])};
    pw2=(u32x4){cvtpk_s(p1[0],p1[1]),cvtpk_s(p1[2],p1[3]),cvtpk_s(p1[4],p1[5]),cvtpk_s(p1[6],p1[7])};
    pw3=(u32x4){cvtpk_s(p1[8],p1[9]),cvtpk_s(p1[10],p1[11]),cvtpk_s(p1[12],p1[13]),cvtpk_s(p1[14],p1[15])};
    SBAR(); pv(o,vb0+sl_cur,__builtin_bit_cast(bf16x8,pw0),__builtin_bit_cast(bf16x8,pw1),__builtin_bit_cast(bf16x8,pw2),__builtin_bit_cast(bf16x8,pw3));
    { const int t_=sl_cur; sl_cur=sl_n1; sl_n1=sl_n2; sl_n2=t_; }
  }
  #undef SB_DMA
  bf16*Ow=O+(rowbase+q0+wid*QBLK)*POUT+h*D; float*Sw=SSQh+(rowbase+q0+wid*QBLK)*16;
  { bf16*stg=(bf16*)(shm+LDS_OST)+wid*2048;
    #pragma unroll
    for(int r=0;r<16;++r){const int orow=crow(r,hi);
      #pragma unroll
      for(int d0=0;d0<2;++d0)stg[orow*64+d0*32+r32]=__float2bfloat16(o[d0][r]);}
    asm volatile("s_waitcnt lgkmcnt(0)":::"memory");
    #pragma unroll
    for(int i=0;i<4;++i){const int row=i*8+(lane>>3),ch=lane&7; const u32x4 v=*(const u32x4*)(stg+row*64+ch*8); ATTN_STORE16(Ow+(long)row*POUT+ch*8,v);
      float sq=0.f;
      #pragma unroll
      for(int w_=0;w_<4;++w_){const float lo_=__uint_as_float(v[w_]<<16),hi_=__uint_as_float(v[w_]&0xffff0000u);sq+=lo_*lo_+hi_*hi_;}
      sq+=__shfl_xor(sq,1);sq+=__shfl_xor(sq,2);sq+=__shfl_xor(sq,4); if(ch==0)Sw[row*16]=sq;} }
  asm volatile("s_waitcnt vmcnt(0) lgkmcnt(0)\n\ts_barrier":::"memory");
}
template<int THRL=8> __device__ __forceinline__ void attn_phase(char*lds,const bf16*PROJ,const float*CUM,bf16*OMIX,float*SSQ,int bh,int role){
  const int b=bh>>3,h=bh&7;
  const int nf=role<5?2:6;
  for(int i=0;i<nf;++i){ const int qb=role<5?(i==0?15-role:6+role):5-i;
    attn_unit<THRL>(b,h,qb,PROJ,PROJ+512,PROJ+1024,OMIX,CUM+(size_t)bh*SEQ,SSQ+h,lds); }
  const int sb0=role<3?3+3*role:(role==3?12:(role==4?14:0)), ns=(role==3||role==4)?2:3;
  for(int i=0;i<ns;++i) sb_unit(b,h,sb0+i,PROJ+1536,PROJ+2048,PROJ+2560,OMIX+512,SSQ+8+h,lds);
}
template<int THRL=8> __device__ __forceinline__ void attn_phase8(char*lds,const bf16*PROJ,const float*CUM,bf16*OMIX,float*SSQ,int vcu){
  const int bh=vcu>>3,s=vcu&7,b=bh>>3,h=bh&7;
  if(bh>=32)return;
  for(int i=0;i<4;++i){ const int qb=(i&1)?15-s:s;
    if(i<2)attn_unit<THRL>(b,h,qb,PROJ,PROJ+512,PROJ+1024,OMIX,CUM+(size_t)bh*SEQ,SSQ+h,lds);
    else   sb_unit(b,h,qb,PROJ+1536,PROJ+2048,PROJ+2560,OMIX+512,SSQ+8+h,lds); }
}
#undef SBAR
#undef WAIT_BAR
}

template <int NT, bool UP> __device__ __forceinline__ int moe_prepare(const unsigned* __restrict__ CNT, const int* __restrict__ LIST, const float* __restrict__ RSTD2, const float* __restrict__ RW,
                                                                     int* __restrict__ TBG, int bx, LAS unsigned char* L) {
    int tid_ = threadIdx.x; asm volatile("" : "+v"(tid_)); const int tid = tid_;
    LAS int* tb = (LAS int*)(L + TB_OFF); LAS int* tbE = tb + 64; LAS int* tbC = tb + 128; LAS int* cntl = tb + 192; LAS int* udl = tb + 224; LAS int* tabA = (LAS int*)(L + TAB_OFF); LAS float* tabB = (LAS float*)(L + TAB2_OFF);
    if (tid < 64) {
        const int cn = tid < NE ? (int)CNT[tid] : 0, nt = (cn + 255) >> 8, rem = cn & 255, ch = (rem != 0 && rem <= 128) ? 1 : 0;
        int a = nt, c = ch;
#pragma unroll
        for (int o = 1; o < 32; o <<= 1) { const int ta = __shfl_up(a, o), tc = __shfl_up(c, o); if ((tid & 63) >= o) { a += ta; c += tc; } }
        if (tid < NE) { tb[tid + 1] = a; tbC[tid + 1] = c; tbE[tid + 1] = a - c; cntl[tid] = cn; }
        if (tid == 0) { tb[0] = 0; tbC[0] = 0; tbE[0] = 0; }
    }
    LDS_WAIT(); __syncthreads();
    if (bx == 0 && tid <= NE) TBG[tid] = tb[tid];
    pg8::MoeOrder S{NT, bx, tb, tbE, tbC, cntl, tabA};
    if (tid < pg8::MOE_MAXU) { pg8::Unit u; const bool ok = S.next(tid, u); udl[3 * tid] = ok ? u.pm : -1; udl[3 * tid + 1] = u.pn; udl[3 * tid + 2] = u.nr; }
    LDS_WAIT(); __syncthreads();
    int nun = 0;
#pragma unroll
    for (int i = 0; i < pg8::MOE_MAXU; ++i) nun += (udl[3 * i] >= 0) ? 1 : 0;
    int slot[5];
#pragma unroll
    for (int j = 0; j < 5; ++j) { const int idx = tid + NTHREADS * j, ui = idx >> 8, r = idx & 255; slot[j] = 0;
        if (ui < nun) { const int e = udl[3 * ui + 1] / NT, mt = udl[3 * ui] - tb[e], cnt = cntl[e], p = mt * 256 + r; slot[j] = LIST[(size_t)e * LIST_CAP + (p < cnt ? p : cnt - 1)]; } }
#pragma unroll
    for (int j = 0; j < 5; ++j) { const int idx = tid + NTHREADS * j, ui = idx >> 8;
        if (ui < nun) { if (UP) { tabA[idx] = slot[j] >> 2; tabB[idx] = RSTD2[slot[j] >> 2]; } else tabB[idx] = RW[slot[j]]; } }
    VM_WAIT(); LDS_WAIT(); __syncthreads();
    return nun;
}

__global__ void __launch_bounds__(NTHREADS, 2) mega_fwd(Args a) {
    extern __shared__ __attribute__((aligned(16))) unsigned char lds[];
    LAS unsigned char* L = (LAS unsigned char*)lds;
    volatile LAS unsigned* MISC = (volatile LAS unsigned*)(L + MISC_OFF);
    const int tid = threadIdx.x, lane = tid & 63, wave = __builtin_amdgcn_readfirstlane(tid >> 6);
    const int G = gridDim.x, bx = blockIdx.x, vcu = (G % 8 == 0) ? (bx % 8) * (G / 8) + bx / 8 : bx;
    const int gw = vcu * NWAVES + wave, NGW = G * NWAVES;
    const bool cvt_role = (vcu & 31) >= 24;
    const int cvt_first = ((vcu >> 5) * 8 + ((vcu & 31) - 24)) * NWAVES + wave;
    unsigned char* ws = a.ws;
    unsigned* CTL = (unsigned*)(ws + WS_CTL);
    bf16_t* WINT = (bf16_t*)(ws + WS_WINT); bf16_t* WOUTT = (bf16_t*)(ws + WS_WOUTT); float* WR = (float*)(ws + WS_WR); float* CUM = (float*)(ws + WS_CUM);
    float* SSQ = (float*)(ws + WS_SSQ); float* RSTD2 = (float*)(ws + WS_RSTD2); float* RW = (float*)(ws + WS_RW); int* SLOTEP = (int*)(ws + WS_SLOTEP); int* TBG = (int*)(ws + WS_TBG); int* LIST = (int*)(ws + WS_LIST); float* FLOG = (float*)(ws + WS_FLOG);
    bf16_t* XN = (bf16_t*)(ws + WS_XN); bf16_t* PROJ = (bf16_t*)(ws + WS_PROJ); bf16_t* OMIX = (bf16_t*)(ws + WS_OMIX); bf16_t* X1B = (bf16_t*)(ws + WS_X1B);
    bf16_t* W1T = (bf16_t*)(ws + WS_W1T); bf16_t* W2T = (bf16_t*)(ws + WS_W2T); bf16_t* H = (bf16_t*)(ws + WS_H); bf16_t* Y = (bf16_t*)(ws + WS_Y);
    unsigned* CNT = CTL + CW_CNT;
    for (int u = tid; u < (LDS_BYTES - LDSCTL_OFF) / 4; u += NTHREADS) ((LAS unsigned*)(L + LDSCTL_OFF))[u] = 0u;
    __syncthreads();
    XcdBarrier bar = xcd_barrier_post(CTL + CW_BAR, MISC + 8);

    REPS(0) {
        LAS float* scr = (LAS float*)(L + RING_OFF + wave * 8448);
        LAS float* wf = (LAS float*)(L + RING_OFF + 98304);
        for (int i = tid; i < DM * 8; i += NTHREADS) { const int k = i >> 3; wf[i] = a.w_in[(size_t)k * WIN_N + 1536 + (i & 7)] * a.g1[k]; }
        LDS_WAIT(); __syncthreads();
        constexpr int I_IN = (DM / 64) * (NPROJ / 32), I_OUT = (DM / 64) * (DM / 32);
        for (int it = gw; it < I_IN + I_OUT; it += NGW) {
            TrItem t; f32x4 v[8];
            if (it < I_IN) { t.W = a.w_in; t.WT = WINT; t.gA = a.g1; t.gB = nullptr; t.K = DM; t.Nin = WIN_N; t.Nout = NPROJ; t.mode = 1; t.gsplit = DM; t.item = it; t.nbsh = -1; t.f8 = 0; }
            else { t.W = a.w_out; t.WT = WOUTT; t.gA = a.g_fox; t.gB = a.g_sb; t.K = DM; t.Nin = DM; t.Nout = DM; t.mode = 0; t.gsplit = GW; t.item = it - I_IN; t.nbsh = 5; t.f8 = 0; }
            tr_load<false>(t, lane, v); tr_store(t, lane, v, scr);
        }
        if (!OVERLAP_CVT) convert_experts(a.w1, a.w2, a.g2, W1T, W2T, gw, NGW, N_EXP_ITEMS, lane, scr);
        for (int i = gw * 64 + lane; i < DM * NE; i += NGW * 64) WR[i] = a.w_router[i] * a.g2[i >> 5];
        for (int row = gw; row < M; row += NGW) rms1_row(a.x, wf, a.b_f, XN, FLOG, row, lane);
    }
    xcd_barrier(bar); if (REP_PHASE == 8) xcd_barrier(bar);
    REPS(1) {
    if (vcu < NB * NH) cumsum_wg(FLOG, CUM, vcu, (LAS float*)(L + RING_OFF));
    if (OPT_GEMM) {
        if (OVERLAP_CVT && cvt_role) convert_experts(a.w1, a.w2, a.g2, W1T, W2T, cvt_first, 64 * NWAVES, CVT_SPLIT, lane, (LAS float*)(L + RING_OFF + wave * 8448));
        else {
        pg8::Gemm g{XN, WINT, DM}; pg8::StaticOrder S; if (OVERLAP_CVT) S.init(M, NPROJ, 192, (vcu & 31) * 8 + (vcu >> 5)); else S.init(M, NPROJ, G, bx); pg8::EpiProj E{PROJ};
        pg8::gemm_phase<pg8::EpiProj, pg8::StaticOrder, true, false>(L + RING_OFF, g, S, E);
        }
    } else { for (int it = gw; it < (M / 16) * (NPROJ / 64); it += NGW) nv_inproj(XN, WINT, PROJ, it, lane); }
    }
    xcd_barrier(bar); if (REP_PHASE == 8) xcd_barrier(bar);
    REPS(2) if (OPT_ATTN) {
        static_assert(attn_body::ATTN_LDS_BYTES <= RING_BYTES, "attention scratch inside the ring region");
        if (OVERLAP_CVT) {
            const int xl = vcu >> 5, l = vcu & 31;
            if (cvt_role) convert_experts(a.w1, a.w2, a.g2, W1T, W2T, CVT_SPLIT + cvt_first, 64 * NWAVES, N_EXP_ITEMS, lane, (LAS float*)(L + RING_OFF + wave * 8448));
            if (l < 24) attn_body::attn_phase<8>((char*)lds + RING_OFF, (const attn_body::bf16*)PROJ, CUM, (attn_body::bf16*)OMIX, SSQ, xl * 4 + l / 6, l % 6);
        } else attn_body::attn_phase8<8>((char*)lds + RING_OFF, (const attn_body::bf16*)PROJ, CUM, (attn_body::bf16*)OMIX, SSQ, vcu);
    } else {
        LAS unsigned char* wl = L + RING_OFF + wave * 16640;
        for (int u = gw; u < 4096; u += NGW) {
            const int i = u >> 11, idx = u & 2047, type = idx & 1, bh = (idx >> 1) & 31, j = (idx >> 6) & 31; const int qblk = (i == 0) ? j : 63 - j;
            if (type == 0) nv_attn<0>(PROJ, CUM, OMIX, SSQ, bh, qblk, lane, wl); else nv_attn<1>(PROJ, CUM, OMIX, SSQ, bh, qblk, lane, wl);
        }
    }
    xcd_barrier(bar); if (REP_PHASE == 8) xcd_barrier(bar);
    REPS(3) if (OPT_GEMM) {
        pg8::Gemm g{OMIX, WOUTT, DM}; pg8::StaticOrder S; S.init(M, DM, G, bx);
        LAS float* ratio = (LAS float*)(L + TAB_OFF); LAS float* rsb = (LAS float*)(L + TAB_OFF + 1024);
        pg8::Unit u0;
        if (S.next(0, u0) && tid < 256) { const float* sp = SSQ + (size_t)(u0.pm * 256 + tid) * 16; float sf = 0.f, s2 = 0.f;
#pragma unroll
            for (int h = 0; h < 8; ++h) { sf += sp[h]; s2 += sp[8 + h]; }
            const float rf = rsqrtf(sf * (1.f / GW) + EPS), rs = rsqrtf(s2 * (1.f / GW) + EPS); ratio[tid] = rf / rs; rsb[tid] = rs; }
        VM_WAIT(); LDS_WAIT(); __syncthreads();
        pg8::EpiWout E{a.x, a.out, X1B, ratio, rsb};
        pg8::gemm_phase<pg8::EpiWout, pg8::StaticOrder, false, false>(L + RING_OFF, g, S, E);
    } else { for (int it = gw; it < (M / 16) * (DM / 64); it += NGW) nv_wout(OMIX, WOUTT, SSQ, a.x, a.out, X1B, it, lane); }
    xcd_barrier(bar); if (REP_PHASE == 8) xcd_barrier(bar);
    if (REP_PHASE == 4) { for (int t64 = vcu; t64 < M / 64; t64 += G) router_wg(a.out, WR, a.b_router, (float*)H, (float*)H + M, (int*)Y, (int*)Y + NE * LIST_CAP, CNT + 64, t64 * 64, L + RING_OFF); }
    if (OPT_ROUTER) { for (int t64 = vcu; t64 < M / 64; t64 += G) router_wg(a.out, WR, a.b_router, RSTD2, RW, LIST, SLOTEP, CNT, t64 * 64, L + RING_OFF); }
    else { for (int it = gw; it < M / 2; it += NGW) nv_router(a.out, WR, a.b_router, RSTD2, RW, LIST, SLOTEP, CNT, it, lane); }
    xcd_barrier(bar); if (REP_PHASE == 8) xcd_barrier(bar);
    LAS int* tb = (LAS int*)(L + TB_OFF); LAS int* tbE = tb + 64; LAS int* tbC = tb + 128; LAS int* cntl = tb + 192; LAS int* udl = tb + 224; LAS int* tabA = (LAS int*)(L + TAB_OFF); LAS int* tabB = (LAS int*)(L + TAB2_OFF);
    REPS(5) if (OPT_GEMM) {
        const int nun = moe_prepare<8, true>(CNT, LIST, RSTD2, RW, TBG, bx, L);
        pg8::Gemm g{X1B, W1T, MOE_F8 ? DM / 2 : DM}; pg8::EpiMoe1 E{H, a.b1, (const LAS float*)tabB}; pg8::ListOrder SL{udl, nun, tabA};
        pg8::gemm_phase<pg8::EpiMoe1, pg8::ListOrder, true, true, MOE_F8>(L + RING_OFF, g, SL, E);
    } else {
    for (int g = gw; g < MAX_TILES * 16; g += NGW) {
        int e, base, p0, cnt; if (!moe_tile(CNT, g, e, base, p0, cnt)) continue;
        for (int cg = 0; cg < DFF / 32; ++cg) nv_moe1(X1B, W1T, a.b1, RSTD2, LIST, H, e, base, p0, cnt, cg, lane);
    } }
    xcd_barrier(bar); if (REP_PHASE == 8) xcd_barrier(bar);
    REPS(6) if (OPT_GEMM) {
        const int nun = moe_prepare<4, false>(CNT, LIST, RSTD2, RW, TBG, bx, L);
        pg8::Gemm g{H, W2T, MOE_F8 ? DM / 2 : DM}; pg8::EpiMoe2 E{Y, a.b2, (const LAS float*)tabB}; pg8::ListOrder SL{udl, nun, tabA};
        pg8::gemm_phase<pg8::EpiMoe2, pg8::ListOrder, true, false, MOE_F8>(L + RING_OFF, g, SL, E);
    } else {
    for (int g = gw; g < MAX_TILES * 16; g += NGW) {
        int e, base, p0, cnt; if (!moe_tile(CNT, g, e, base, p0, cnt)) continue;
        for (int cg = 0; cg < DM / 64; ++cg) nv_moe2(H, W2T, a.b2, RW, LIST, Y, e, base, p0, cnt, cg, lane);
    } }
    xcd_barrier(bar); if (REP_PHASE == 8) xcd_barrier(bar);
    if (REP_PHASE == 7) { for (int row = gw; row < M; row += NGW) final_row(a.out, Y, SLOTEP, TBG, a.gf, (float*)H, row, lane); }
    for (int row = gw; row < M; row += NGW) final_row(a.out, Y, SLOTEP, TBG, a.gf, a.out, row, lane);
}

extern "C" void kernel_launch(void* const* d_in, const int* in_sizes, int n_in, void* d_out, int out_size, void* d_ws, size_t ws_size, hipStream_t stream) {
    static int grid = 0;
    if (grid == 0) {
        if (n_in != 15 || in_sizes[0] != M * DM || out_size != M * DM || ws_size < WS_END) {
            fprintf(stderr, "kernel_launch: unexpected shapes / workspace (n_in %d, in0 %d, out %d, ws %zu, need %zu)\n", n_in, n_in > 0 ? in_sizes[0] : -1, out_size, ws_size, (size_t)WS_END); grid = -1; return; }
        int dev = 0, cus = 0, per_cu = 0;
        if (hipGetDevice(&dev) != hipSuccess || hipDeviceGetAttribute(&cus, hipDeviceAttributeMultiprocessorCount, dev) != hipSuccess) { grid = -1; return; }
        if (hipFuncSetAttribute((const void*)mega_fwd, hipFuncAttributeMaxDynamicSharedMemorySize, LDS_BYTES) != hipSuccess) { fprintf(stderr, "kernel_launch: hipFuncSetAttribute failed\n"); grid = -1; return; }
        if (hipOccupancyMaxActiveBlocksPerMultiprocessor(&per_cu, (const void*)mega_fwd, NTHREADS, LDS_BYTES) != hipSuccess || per_cu < 1) fprintf(stderr, "kernel_launch: occupancy query reports %d\n", per_cu);
        (void)hipGetLastError();
        grid = cus;
    }
    if (grid < 0) return;
    if (hipMemsetAsync((char*)d_ws + WS_CTL, 0, CTL_BYTES, stream) != hipSuccess) return;
    Args a{};
    a.x = (const float*)d_in[0]; a.g1 = (const float*)d_in[1]; a.w_in = (const float*)d_in[2]; a.b_f = (const float*)d_in[3]; a.g_fox = (const float*)d_in[4]; a.g_sb = (const float*)d_in[5];
    a.w_out = (const float*)d_in[6]; a.g2 = (const float*)d_in[7]; a.w_router = (const float*)d_in[8]; a.b_router = (const float*)d_in[9]; a.w1 = (const float*)d_in[10]; a.b1 = (const float*)d_in[11];
    a.w2 = (const float*)d_in[12]; a.b2 = (const float*)d_in[13]; a.gf = (const float*)d_in[14];
    a.out = (float*)d_out; a.ws = (unsigned char*)d_ws;
    hipLaunchKernelGGL(mega_fwd, dim3(grid), dim3(NTHREADS), LDS_BYTES, stream, a);
    const hipError_t le = hipPeekAtLastError();
    if (le != hipSuccess) fprintf(stderr, "kernel_launch: launch failed: %s\n", hipGetErrorName(le));
}
```

```cpp
#include <hip/hip_runtime.h>
#include <cstdio>
#include <cstdint>

typedef unsigned short bf16_t;
typedef short bf16x8 __attribute__((ext_vector_type(8)));
typedef float f32x4 __attribute__((ext_vector_type(4)));

constexpr int NB = 4, SEQ = 4096, DM = 1024, M = NB * SEQ;
constexpr int NH = 8, HD = 64, GW = 512;
constexpr int WIN_N = 3080, NPROJ = 3072;
constexpr int NE = 32, TOPK = 4, DFF = 1024;
constexpr float EPS = 1e-5f;
constexpr float LOG2E = 1.4426950408889634f;
constexpr float C2 = 0.125f * LOG2E;
constexpr int LIST_CAP = M;
constexpr int MAX_TILES = (M * TOPK) / 256 + NE;

constexpr size_t MiB = 1u << 20;
constexpr size_t WS_CTL = 0, CTL_BYTES = 1 * MiB;
constexpr size_t WS_WINT = 2 * MiB;
constexpr size_t WS_WOUTT = 8 * MiB;
constexpr size_t WS_WR = 10 * MiB;
constexpr size_t WS_CUM = 11 * MiB;
constexpr size_t WS_SSQ = 12 * MiB;
constexpr size_t WS_RSTD2 = 14 * MiB;
constexpr size_t WS_RW = 15 * MiB;
constexpr size_t WS_SLOTEP = 15 * MiB + 512 * 1024;
constexpr size_t WS_TBG = 14 * MiB + 512 * 1024;
constexpr size_t WS_LIST = 16 * MiB;
constexpr size_t WS_FLOG = 18 * MiB;
constexpr size_t WS_XN = 32 * MiB;
constexpr size_t WS_PROJ = 64 * MiB;
constexpr size_t WS_OMIX = 160 * MiB;
constexpr size_t WS_X1B = 192 * MiB;
constexpr size_t WS_W1T = 224 * MiB;
constexpr size_t WS_W2T = 352 * MiB;
constexpr size_t WS_H = 416 * MiB;
constexpr size_t WS_Y = 560 * MiB;
constexpr size_t WS_END = 704 * MiB;
constexpr int CW_CNT = 1024;

__device__ __forceinline__ unsigned short f2bf(float f) { unsigned u = __float_as_uint(f); return (unsigned short)((u + 0x7fffu + ((u >> 16) & 1u)) >> 16); }
__device__ __forceinline__ float bf2f(unsigned short b) { return __uint_as_float(((unsigned)b) << 16); }
__device__ __forceinline__ float wave_sum(float v) {
#pragma unroll
    for (int o = 1; o < 64; o <<= 1) v += __shfl_xor(v, o);
    return v;
}


#define LAS __attribute__((address_space(3)))
#define GAS __attribute__((address_space(1)))
typedef unsigned v4u __attribute__((ext_vector_type(4)));
#define LDS_WAIT() asm volatile("s_waitcnt lgkmcnt(0)" ::: "memory")
#define VM_WAIT() asm volatile("s_waitcnt vmcnt(0)" ::: "memory")
constexpr int NWAVES = 8, NTHREADS = NWAVES * 64;
constexpr int REP_PHASE = -1;
#define REPS(k) for (int rep_ = 0; rep_ < ((REP_PHASE == (k)) ? 2 : 1); ++rep_)
constexpr bool WT_STORES = false;
constexpr bool MOE_F8 = true;
constexpr int CVT_SPLIT = 24 * 512;
constexpr bool OVERLAP_CVT = true;
constexpr bool OPT_GEMM = true;
constexpr bool OPT_ROUTER = true;
constexpr bool OPT_ATTN = true;

#define XB_TMO      128
#define XB_XCNT(j)  (256  + 64 * (j))
#define XB_XSUB(j)  (1280 + 64 * (j))
#define XB_XGEN(j)  (2304 + 64 * (j))
#define XB_TOP      3328
#define XB_TOPGEN   3392
#define XCD_BAR_WORDS 3456
#define XB_SPIN_CAP (1u << 20)
__device__ __forceinline__ unsigned xb_ld(unsigned* p)              { return __hip_atomic_load(p, __ATOMIC_RELAXED, __HIP_MEMORY_SCOPE_AGENT); }
__device__ __forceinline__ unsigned xb_add(unsigned* p, unsigned v) { return __hip_atomic_fetch_add(p, v, __ATOMIC_RELAXED, __HIP_MEMORY_SCOPE_AGENT); }
__device__ __forceinline__ unsigned xb_xcc_id() { return (unsigned)__builtin_amdgcn_s_getreg((3 << 11) | 20) & 0xFu; }
#define XB_SPIN(cond, bar) do { unsigned _sp = 0; while (cond) { __builtin_amdgcn_s_sleep(1); \
    if ((++_sp & 255u) == 0u) { if (xb_ld(&(bar)[XB_TMO])) break; if (_sp > XB_SPIN_CAP) { atomicAdd(&(bar)[XB_TMO], 1u); break; } } } } while (0)
struct XcdBarrier { unsigned* bar; unsigned x; volatile LAS unsigned* st; };
__device__ __forceinline__ XcdBarrier xcd_barrier_post(unsigned* bar, volatile LAS unsigned* st) {
    XcdBarrier b; b.bar = bar; b.x = xb_xcc_id(); b.st = st;
    if (threadIdx.x == 0) (void)xb_add(&bar[XB_XCNT(b.x)], 1u);
    return b;
}
__device__ __forceinline__ void xcd_barrier_complete(unsigned* bar, unsigned x, unsigned& nloc, unsigned& nx) {
    const unsigned G = gridDim.x * gridDim.y * gridDim.z;
    unsigned sum, cnt, mine, sp = 0u;
    for (;;) {
        sum = 0u; cnt = 0u; mine = 0u;
#pragma unroll
        for (unsigned j = 0; j < 16; ++j) { const unsigned c = xb_ld(&bar[XB_XCNT(j)]); sum += c; cnt += (c > 0u) ? 1u : 0u; mine = (j == x) ? c : mine; }
        if (sum == G) break;
        __builtin_amdgcn_s_sleep(1);
        if ((++sp & 255u) == 0u) { if (xb_ld(&bar[XB_TMO])) break; if (sp > XB_SPIN_CAP) { atomicAdd(&bar[XB_TMO], 1u); break; } }
    }
    nloc = mine > 0u ? mine : 1u; nx = cnt > 0u ? cnt : 1u;
}
__device__ __forceinline__ void xcd_barrier(const XcdBarrier& b) {
    asm volatile("s_waitcnt vmcnt(0)" ::: "memory");
    __syncthreads();
    if (threadIdx.x == 0) {
        unsigned* bar = b.bar;
        __builtin_amdgcn_s_waitcnt(0);
        unsigned nloc = b.st[0], nx = b.st[1];
        if (nloc == 0u) { xcd_barrier_complete(bar, b.x, nloc, nx); b.st[0] = nloc; b.st[1] = nx; }
        const unsigned old = xb_add(&bar[XB_XSUB(b.x)], 1u);
        const unsigned gen = old / nloc;
        if (old + 1u == (gen + 1u) * nloc) {
            __builtin_amdgcn_fence(__ATOMIC_RELEASE, "agent");
            asm volatile("s_waitcnt vmcnt(0)" ::: "memory");
            const unsigned og = xb_add(&bar[XB_TOP], 1u);
            const unsigned tg = og / nx;
            if (og + 1u == (tg + 1u) * nx) xb_add(&bar[XB_TOPGEN], 1u);
            else XB_SPIN(xb_ld(&bar[XB_TOPGEN]) == tg, bar);
            __builtin_amdgcn_fence(__ATOMIC_ACQUIRE, "agent");
            xb_add(&bar[XB_XGEN(b.x)], 1u);
            asm volatile("s_waitcnt vmcnt(0)" ::: "memory");
        } else {
            XB_SPIN(xb_ld(&bar[XB_XGEN(b.x)]) == gen, bar);
            __builtin_amdgcn_fence(__ATOMIC_ACQUIRE, "agent");
            asm volatile("s_waitcnt vmcnt(0)" ::: "memory");
        }
    }
    __syncthreads();
}

constexpr int RING_OFF = 0, RING_BYTES = 131072;
constexpr int TAB_OFF = 131072;
constexpr int TAB2_OFF = TAB_OFF + 10 * 1024, TB_OFF = TAB_OFF + 20 * 1024;
constexpr int LDSCTL_OFF = 152576, MISC_OFF = LDSCTL_OFF + 320;
constexpr int LDS_BYTES = 155648;
constexpr int CW_BAR = 4096;

struct Args {
    const float *x, *g1, *w_in, *b_f, *g_fox, *g_sb, *w_out, *g2, *w_router, *b_router, *w1, *b1, *w2, *b2, *gf;
    float* out; unsigned char* ws;
};

__device__ __forceinline__ int mapcol(int mode, int n) {
    if (mode == 1) return n < 1536 ? n : n + 8;
    if (mode == 2) { const int pn = n >> 8, j = n & 255; return j < 128 ? 128 * pn + j : 1024 + 128 * pn + (j - 128); }
    return n;
}
__device__ __forceinline__ unsigned pk4_fp8(float a, float b, float c, float d) {
    a = __builtin_amdgcn_fmed3f(a, -448.f, 448.f); b = __builtin_amdgcn_fmed3f(b, -448.f, 448.f); c = __builtin_amdgcn_fmed3f(c, -448.f, 448.f); d = __builtin_amdgcn_fmed3f(d, -448.f, 448.f);
    int w = __builtin_amdgcn_cvt_pk_fp8_f32(a, b, 0, false); w = __builtin_amdgcn_cvt_pk_fp8_f32(c, d, w, true); return (unsigned)w;
}
__device__ __forceinline__ unsigned pk2(float lo, float hi) { unsigned r; asm("v_cvt_pk_bf16_f32 %0, %1, %2" : "=v"(r) : "v"(lo), "v"(hi)); return r; }
struct TrItem { const float* W; bf16_t* WT; const float* gA; const float* gB; int K, Nin, Nout, mode, gsplit, item, nbsh, f8; };
template <bool NT> __device__ __forceinline__ void tr_load(const TrItem& t, int lane, f32x4 (&v)[8]) {
    const int nblk = t.Nout / 32, kb = t.nbsh >= 0 ? (t.item >> t.nbsh) : t.item / nblk, nb = t.nbsh >= 0 ? (t.item & (nblk - 1)) : t.item % nblk, k0 = 64 * kb, n0 = 32 * nb, l7 = lane & 7, kr = lane >> 3, col = mapcol(t.mode, n0 + 4 * l7);
#pragma unroll
    for (int i = 0; i < 8; ++i) { const f32x4* p = (const f32x4*)(t.W + (size_t)(k0 + 8 * i + kr) * t.Nin + col); v[i] = NT ? __builtin_nontemporal_load(p) : *p; }
}
__device__ __forceinline__ void tr_store(const TrItem& t, int lane, const f32x4 (&v)[8], LAS float* scr) {
    const int nblk = t.Nout / 32, kb = t.nbsh >= 0 ? (t.item >> t.nbsh) : t.item / nblk, nb = t.nbsh >= 0 ? (t.item & (nblk - 1)) : t.item % nblk, k0 = 64 * kb, n0 = 32 * nb, l7 = lane & 7, kr = lane >> 3;
#pragma unroll
    for (int i = 0; i < 8; ++i) { const int kk = 8 * i + kr, k = k0 + kk; const float gs = t.gA ? (k < t.gsplit ? t.gA[k] : t.gB[k - t.gsplit]) : 1.f;
        LAS float* sp = scr + kk * 33 + 4 * l7; sp[0] = v[i][0] * gs; sp[1] = v[i][1] * gs; sp[2] = v[i][2] * gs; sp[3] = v[i][3] * gs; }
    LDS_WAIT();
    if (t.f8) {
        const int c = lane & 3;
#pragma unroll
        for (int j = 0; j < 2; ++j) { const int n = (lane >> 2) + 16 * j; const LAS float* sp = scr + (16 * c) * 33 + n;
            v4u o; o.x = pk4_fp8(32.f * sp[0 * 33], 32.f * sp[1 * 33], 32.f * sp[2 * 33], 32.f * sp[3 * 33]); o.y = pk4_fp8(32.f * sp[4 * 33], 32.f * sp[5 * 33], 32.f * sp[6 * 33], 32.f * sp[7 * 33]);
            o.z = pk4_fp8(32.f * sp[8 * 33], 32.f * sp[9 * 33], 32.f * sp[10 * 33], 32.f * sp[11 * 33]); o.w = pk4_fp8(32.f * sp[12 * 33], 32.f * sp[13 * 33], 32.f * sp[14 * 33], 32.f * sp[15 * 33]);
            *(v4u*)((unsigned char*)t.WT + (size_t)(n0 + n) * t.K + k0 + 16 * c) = o; }
    } else {
    const int c = lane & 7;
#pragma unroll
    for (int j = 0; j < 4; ++j) { const int n = (lane >> 3) + 8 * j; const LAS float* sp = scr + (8 * c) * 33 + n;
        v4u o; o.x = pk2(sp[0 * 33], sp[1 * 33]); o.y = pk2(sp[2 * 33], sp[3 * 33]); o.z = pk2(sp[4 * 33], sp[5 * 33]); o.w = pk2(sp[6 * 33], sp[7 * 33]);
        *(v4u*)(t.WT + (size_t)(n0 + n) * t.K + k0 + 8 * c) = o; }
    }
    LDS_WAIT();
}
constexpr int I_W1 = (DM / 64) * (2048 / 32), I_W2 = (DM / 64) * (DM / 32), N_EXP_ITEMS = NE * (I_W1 + I_W2);
__device__ __forceinline__ TrItem expert_item(const float* w1, const float* w2, const float* g2, bf16_t* W1T, bf16_t* W2T, int r) {
    TrItem t;
    t.f8 = MOE_F8 ? 1 : 0;
    if (r < NE * I_W1) { const int e = r / I_W1; t.W = w1 + (size_t)e * DM * 2048; t.WT = MOE_F8 ? (bf16_t*)((unsigned char*)W1T + (size_t)e * 2048 * DM) : W1T + (size_t)e * 2048 * DM; t.gA = g2; t.gB = nullptr; t.K = DM; t.Nin = 2048; t.Nout = 2048; t.mode = 2; t.gsplit = DM; t.item = r % I_W1; t.nbsh = 6; }
    else { r -= NE * I_W1; const int e = r / I_W2; t.W = w2 + (size_t)e * DM * DM; t.WT = MOE_F8 ? (bf16_t*)((unsigned char*)W2T + (size_t)e * DM * DM) : W2T + (size_t)e * DM * DM; t.gA = nullptr; t.gB = nullptr; t.K = DM; t.Nin = DM; t.Nout = DM; t.mode = 0; t.gsplit = DM; t.item = r % I_W2; t.nbsh = 5; }
    return t;
}
__device__ __forceinline__ void convert_experts(const float* w1, const float* w2, const float* g2, bf16_t* W1T, bf16_t* W2T, int first, int stride, int N_END, int lane, LAS float* scr) {
    f32x4 v0[8], v1[8];
#define CVT_LOAD(v, idx) do { if ((idx) < N_END) { const TrItem t_ = expert_item(w1, w2, g2, W1T, W2T, (idx)); tr_load<true>(t_, lane, v); } } while (0)
#define CVT_STORE(v, idx) do { if ((idx) < N_END) { const TrItem t_ = expert_item(w1, w2, g2, W1T, W2T, (idx)); tr_store(t_, lane, v, scr); } } while (0)
    int it = first; asm volatile("" : "+v"(lane));
    CVT_LOAD(v0, it);
#pragma unroll 1
    for (; it < N_END; it += 2 * stride) {
        CVT_LOAD(v1, it + stride); CVT_STORE(v0, it);
        CVT_LOAD(v0, it + 2 * stride); CVT_STORE(v1, it + stride);
    }
#undef CVT_LOAD
#undef CVT_STORE
}

__device__ __forceinline__ float log_sigmoid(float v) { return fminf(v, 0.f) - log1pf(expf(-fabsf(v))); }
__device__ __forceinline__ void rms1_row(const float* __restrict__ x, const LAS float* wf  , const float* __restrict__ b_f,
                                         bf16_t* __restrict__ XN, float* __restrict__ FLOG, int row, int lane) {
    const float4* xr = (const float4*)(x + (size_t)row * DM);
    float4 v[4]; float ss = 0.f;
#pragma unroll
    for (int j = 0; j < 4; ++j) { v[j] = xr[lane + 64 * j]; ss += v[j].x * v[j].x + v[j].y * v[j].y + v[j].z * v[j].z + v[j].w * v[j].w; }
    ss = wave_sum(ss);
    const float rstd = rsqrtf(ss * (1.f / DM) + EPS);
    float f0 = 0.f, f1 = 0.f, f2 = 0.f, f3 = 0.f, f4 = 0.f, f5 = 0.f, f6 = 0.f, f7 = 0.f;
#pragma unroll
    for (int j = 0; j < 4; ++j) {
        const int c0 = 4 * (lane + 64 * j);
        uint2 o; o.x = pk2(v[j].x * rstd, v[j].y * rstd); o.y = pk2(v[j].z * rstd, v[j].w * rstd);
        *(uint2*)(XN + (size_t)row * DM + c0) = o;
        const float xs[4] = {v[j].x, v[j].y, v[j].z, v[j].w};
#pragma unroll
        for (int c = 0; c < 4; ++c) {
            const int k = c0 + c; const float xv = xs[c];
            const LAS f32x4* wp = (const LAS f32x4*)(wf + k * 8); const f32x4 w0 = wp[0], w1 = wp[1];
            f0 += xv * w0.x; f1 += xv * w0.y; f2 += xv * w0.z; f3 += xv * w0.w; f4 += xv * w1.x; f5 += xv * w1.y; f6 += xv * w1.z; f7 += xv * w1.w;
        }
    }
    f0 = wave_sum(f0); f1 = wave_sum(f1); f2 = wave_sum(f2); f3 = wave_sum(f3); f4 = wave_sum(f4); f5 = wave_sum(f5); f6 = wave_sum(f6); f7 = wave_sum(f7);
    if (lane < 8) {
        float f = f0; f = lane == 1 ? f1 : f; f = lane == 2 ? f2 : f; f = lane == 3 ? f3 : f; f = lane == 4 ? f4 : f; f = lane == 5 ? f5 : f; f = lane == 6 ? f6 : f; f = lane == 7 ? f7 : f;
        FLOG[(size_t)row * 8 + lane] = log_sigmoid(f * rstd + b_f[lane]);
    }
}
__device__ __forceinline__ void cumsum_wg(const float* __restrict__ FLOG, float* __restrict__ CUM, int bh, LAS float* part) {
    const int b = bh >> 3, h = bh & 7, t = threadIdx.x;
    float loc[8]; float s = 0.f;
#pragma unroll
    for (int i = 0; i < 8; ++i) { loc[i] = FLOG[((size_t)b * SEQ + t * 8 + i) * 8 + h]; s += loc[i]; }
    part[t] = s; __syncthreads();
    float run = 0.f; for (int i = 0; i < t; ++i) run += part[i];
#pragma unroll
    for (int i = 0; i < 8; ++i) { run += loc[i]; CUM[(size_t)bh * SEQ + t * 8 + i] = run * LOG2E; }
    __syncthreads();
}

template <int NT> __device__ __forceinline__ void wave_mma(f32x4 (&acc)[NT], const bf16_t* ap, const bf16_t* const (&bp)[NT], int K) {
    for (int k0 = 0; k0 < K; k0 += 32) {
        const bf16x8 a = *(const bf16x8*)(ap + k0);
#pragma unroll
        for (int t = 0; t < NT; ++t) { const bf16x8 b = *(const bf16x8*)(bp[t] + k0); acc[t] = __builtin_amdgcn_mfma_f32_16x16x32_bf16(a, b, acc[t], 0, 0, 0); }
    }
}
__device__ __forceinline__ void nv_inproj(const bf16_t* __restrict__ XN, const bf16_t* __restrict__ WINT, bf16_t* __restrict__ PROJ, int item, int lane) {
    const int n0 = (item % 48) * 64, m0 = (item / 48) * 16, r = lane & 15, q = lane >> 4;
    f32x4 acc[4];
#pragma unroll
    for (int t = 0; t < 4; ++t) acc[t] = (f32x4){0.f, 0.f, 0.f, 0.f};
    const bf16_t* ap = XN + (size_t)(m0 + r) * DM + 8 * q;
    const bf16_t* bp[4];
#pragma unroll
    for (int t = 0; t < 4; ++t) bp[t] = WINT + (size_t)(n0 + 16 * t + r) * DM + 8 * q;
    wave_mma<4>(acc, ap, bp, DM);
    const float sc = (n0 < 512 || (n0 >= 1536 && n0 < 2048)) ? C2 : 1.f;
#pragma unroll
    for (int t = 0; t < 4; ++t)
#pragma unroll
        for (int j = 0; j < 4; ++j) PROJ[(size_t)(m0 + 4 * q + j) * NPROJ + n0 + 16 * t + r] = f2bf(acc[t][j] * sc);
}

template <int TYPE> __device__ __forceinline__ void nv_attn(const bf16_t* __restrict__ PROJ, const float* __restrict__ CUM, bf16_t* __restrict__ OMIX, float* __restrict__ SSQ,
                                                          int bh, int qblk, int lane, LAS unsigned char* wl) {
    LAS bf16_t* Ks = (LAS bf16_t*)wl; LAS bf16_t* Vs = (LAS bf16_t*)(wl + 8192); LAS float* Cs = (LAS float*)(wl + 16384);
    const int b = bh >> 3, h = bh & 7, t = qblk * 64 + lane;
    const size_t row = (size_t)b * SEQ + t;
    const int qcol = (TYPE == 0 ? 0 : 1536) + h * HD, kcol = qcol + 512, vcol = qcol + 1024;
    float q[64], o[64];
#pragma unroll
    for (int c = 0; c < 8; ++c) { const bf16x8 v = *(const bf16x8*)(PROJ + row * NPROJ + qcol + 8 * c);
#pragma unroll
        for (int j = 0; j < 8; ++j) q[8 * c + j] = bf2f((unsigned short)v[j]); }
#pragma unroll
    for (int d = 0; d < 64; ++d) o[d] = 0.f;
    float m = -INFINITY, l = 0.f, R = 1.f;
    const float cq = CUM[(size_t)bh * SEQ + t];
    for (int it = 0; it <= qblk; ++it) {
        const int kt = (TYPE == 0) ? it : qblk - it;
        LDS_WAIT();
        for (int i = 0; i < 64; ++i) { const size_t kr = ((size_t)b * SEQ + kt * 64 + i) * NPROJ; Ks[i * 64 + lane] = PROJ[kr + kcol + lane]; Vs[i * 64 + lane] = PROJ[kr + vcol + lane]; }
        Cs[lane] = CUM[(size_t)bh * SEQ + kt * 64 + lane];
        LDS_WAIT();
        for (int ss = 0; ss < 64; ++ss) {
            const int s = (TYPE == 0) ? ss : 63 - ss; const int ks = kt * 64 + s;
            float dot = 0.f;
#pragma unroll
            for (int d = 0; d < 64; d += 8) { const bf16x8 kv = *(const LAS bf16x8*)&Ks[s * 64 + d];
#pragma unroll
                for (int j = 0; j < 8; ++j) dot += q[d + j] * bf2f((unsigned short)kv[j]); }
            if (TYPE == 0) {
                if (ks <= t) {
                    const float xv = dot + cq - Cs[s]; const float mn = fmaxf(m, xv); const float sc = exp2f(m - mn), p = exp2f(xv - mn);
                    l = l * sc + p; m = mn;
#pragma unroll
                    for (int d = 0; d < 64; d += 8) { const bf16x8 vv = *(const LAS bf16x8*)&Vs[s * 64 + d];
#pragma unroll
                        for (int j = 0; j < 8; ++j) o[d + j] = o[d + j] * sc + p * bf2f((unsigned short)vv[j]); }
                }
            } else {
                if (ks < t) {
                    const float z = fminf(fmaxf(dot, -80.f), 80.f); const float e = exp2f(z); const float rr = 1.f / (1.f + e); const float a = e * rr * R; R *= rr;
#pragma unroll
                    for (int d = 0; d < 64; d += 8) { const bf16x8 vv = *(const LAS bf16x8*)&Vs[s * 64 + d];
#pragma unroll
                        for (int j = 0; j < 8; ++j) o[d + j] += a * bf2f((unsigned short)vv[j]); }
                }
            }
        }
    }
    const float inv = (TYPE == 0) ? 1.f / l : 1.f;
    float ssq = 0.f;
#pragma unroll
    for (int d = 0; d < 64; ++d) { o[d] *= inv; ssq += o[d] * o[d]; }
    SSQ[row * 16 + TYPE * 8 + h] = ssq;
#pragma unroll
    for (int c = 0; c < 8; ++c) { bf16x8 v;
#pragma unroll
        for (int j = 0; j < 8; ++j) v[j] = (short)f2bf(o[8 * c + j]);
        *(bf16x8*)(OMIX + row * DM + TYPE * GW + h * HD + 8 * c) = v; }
}

__device__ __forceinline__ void nv_wout(const bf16_t* __restrict__ OMIX, const bf16_t* __restrict__ WOUTT, const float* __restrict__ SSQ, const float* __restrict__ x,
                                        float* __restrict__ X1, bf16_t* __restrict__ X1B, int item, int lane) {
    const int n0 = (item & 15) * 64, m0 = (item >> 4) * 16, r = lane & 15, q = lane >> 4;
    f32x4 af[4], as[4];
#pragma unroll
    for (int t = 0; t < 4; ++t) { af[t] = (f32x4){0.f, 0.f, 0.f, 0.f}; as[t] = (f32x4){0.f, 0.f, 0.f, 0.f}; }
    const bf16_t* ap = OMIX + (size_t)(m0 + r) * DM + 8 * q;
    const bf16_t* bp[4]; const bf16_t* bp2[4];
#pragma unroll
    for (int t = 0; t < 4; ++t) { bp[t] = WOUTT + (size_t)(n0 + 16 * t + r) * DM + 8 * q; bp2[t] = bp[t] + GW; }
    wave_mma<4>(af, ap, bp, GW);
    wave_mma<4>(as, ap + GW, bp2, GW);
#pragma unroll
    for (int j = 0; j < 4; ++j) {
        const size_t row = m0 + 4 * q + j; const float* sp = SSQ + row * 16;
        float sf = 0.f, s2 = 0.f;
#pragma unroll
        for (int h = 0; h < 8; ++h) { sf += sp[h]; s2 += sp[8 + h]; }
        const float rf = rsqrtf(sf * (1.f / GW) + EPS), rs = rsqrtf(s2 * (1.f / GW) + EPS);
#pragma unroll
        for (int t = 0; t < 4; ++t) { const size_t idx = row * DM + n0 + 16 * t + r; const float v = x[idx] + rf * af[t][j] + rs * as[t][j]; X1[idx] = v; X1B[idx] = f2bf(v); }
    }
}

__device__ __forceinline__ void nv_router(const float* __restrict__ X1, const float* __restrict__ WR, const float* __restrict__ b_router, float* __restrict__ RSTD2,
                                          float* __restrict__ RW, int* __restrict__ LIST, int* __restrict__ SLOTEP, unsigned* __restrict__ CNT, int item, int lane) {
    const int e = lane & 31, tok = item * 2 + (lane >> 5);
    const float* xr = X1 + (size_t)tok * DM;
    float acc = 0.f, ss = 0.f;
    for (int k = 0; k < DM; ++k) { const float xv = xr[k]; acc += xv * WR[k * NE + e]; ss += xv * xv; }
    const float rstd = rsqrtf(ss * (1.f / DM) + EPS);
    float logit = acc * rstd + b_router[e];
    if (e == 0) RSTD2[tok] = rstd;
    float tv[4]; int ti[4];
#pragma unroll
    for (int k = 0; k < 4; ++k) {
        float bv = logit; int bi = e;
#pragma unroll
        for (int o = 1; o < 32; o <<= 1) { const float ov = __shfl_xor(bv, o); const int oi = __shfl_xor(bi, o); if (ov > bv || (ov == bv && oi < bi)) { bv = ov; bi = oi; } }
        tv[k] = bv; ti[k] = bi; if (e == bi) logit = -INFINITY;
    }
    const float e0 = 1.f, e1 = expf(tv[1] - tv[0]), e2 = expf(tv[2] - tv[0]), e3 = expf(tv[3] - tv[0]); const float inv = 1.f / (e0 + e1 + e2 + e3);
    const float w0 = e0 * inv, w1 = e1 * inv, w2 = e2 * inv, w3 = e3 * inv;
    int myk = -1; float myw = 0.f;
    if (e == ti[0]) { myk = 0; myw = w0; } if (e == ti[1]) { myk = 1; myw = w1; } if (e == ti[2]) { myk = 2; myw = w2; } if (e == ti[3]) { myk = 3; myw = w3; }
    if (myk >= 0) { const int slot = tok * 4 + myk; const unsigned pos = atomicAdd(&CNT[e], 1u); LIST[(size_t)e * LIST_CAP + pos] = slot; RW[slot] = myw; SLOTEP[slot] = e * 16384 + (int)pos; }
}


typedef float f32x16 __attribute__((ext_vector_type(16)));
__device__ __forceinline__ void router_wg(const float* __restrict__ X1, const float* __restrict__ WR, const float* __restrict__ b_router, float* __restrict__ RSTD2,
                                          float* __restrict__ RW, int* __restrict__ LIST, int* __restrict__ SLOTEP, unsigned* __restrict__ CNT, int tokbase, LAS unsigned char* L) {
    int tid_ = threadIdx.x; asm volatile("" : "+v"(tid_));
    const int tid = tid_, lane = tid & 63, wave = __builtin_amdgcn_readfirstlane(tid >> 6), kq = wave & 3, tile = wave >> 2, r32 = lane & 31, hi = lane >> 5;
    LAS float* Dx = (LAS float*)L; LAS float* SSx = (LAS float*)(L + 32768); LAS unsigned* lcnt = (LAS unsigned*)(L + 33792); LAS unsigned* lbase = (LAS unsigned*)(L + 33920);
    if (tid < NE) lcnt[tid] = 0u;
    const int tok = tokbase + tile * 32 + r32;
    const float* xp = X1 + (size_t)tok * DM + kq * 256 + 4 * hi;
    const float* wp = WR + (size_t)(kq * 256 + 4 * hi) * NE + r32;
    f32x16 acc;
#pragma unroll
    for (int r = 0; r < 16; ++r) acc[r] = 0.f;
    float ss = 0.f;
#pragma unroll 1
    for (int mc = 0; mc < 4; ++mc) {
        float4 xv[8];
#pragma unroll
        for (int m = 0; m < 8; ++m) xv[m] = *(const float4*)(xp + (mc * 8 + m) * 8);
#pragma unroll
        for (int m = 0; m < 8; ++m) {
            const float* w4 = wp + (size_t)((mc * 8 + m) * 8) * NE;
            const float w0 = w4[0], w1 = w4[NE], w2 = w4[2 * NE], w3 = w4[3 * NE];
            acc = __builtin_amdgcn_mfma_f32_32x32x2f32(w0, xv[m].x, acc, 0, 0, 0);
            acc = __builtin_amdgcn_mfma_f32_32x32x2f32(w1, xv[m].y, acc, 0, 0, 0);
            acc = __builtin_amdgcn_mfma_f32_32x32x2f32(w2, xv[m].z, acc, 0, 0, 0);
            acc = __builtin_amdgcn_mfma_f32_32x32x2f32(w3, xv[m].w, acc, 0, 0, 0);
            ss += xv[m].x * xv[m].x + xv[m].y * xv[m].y + xv[m].z * xv[m].z + xv[m].w * xv[m].w;
        }
    }
    { auto rr = __builtin_amdgcn_permlane32_swap(__float_as_uint(ss), __float_as_uint(ss), false, false); ss = __uint_as_float(rr[0]) + __uint_as_float(rr[1]); }
#pragma unroll
    for (int r = 0; r < 16; ++r) Dx[(wave * 16 + r) * 64 + lane] = acc[r];
    if (hi == 0) SSx[wave * 32 + r32] = ss;
    LDS_WAIT(); __syncthreads();
    int ea = 0, eb = 0; float wa = 0.f, wb = 0.f; unsigned la = 0u, lb = 0u;
    if (kq == 0) {
        float v[16]; float sst = 0.f;
#pragma unroll
        for (int w = 0; w < 4; ++w) sst += SSx[(tile * 4 + w) * 32 + r32];
        const float rstd = rsqrtf(sst * (1.f / DM) + EPS);
#pragma unroll
        for (int r = 0; r < 16; ++r) { float a = 0.f;
#pragma unroll
            for (int w = 0; w < 4; ++w) a += Dx[((tile * 4 + w) * 16 + r) * 64 + lane];
            v[r] = a * rstd + b_router[(r & 3) + 8 * (r >> 2) + 4 * hi]; }
        if (hi == 0) RSTD2[tok] = rstd;
        float tv[4]; int te[4];
#pragma unroll
        for (int k = 0; k < 4; ++k) {
            float bv = v[0]; int br = 0;
#pragma unroll
            for (int r = 1; r < 16; ++r) if (v[r] > bv) { bv = v[r]; br = r; }
            const int be = (br & 3) + 8 * (br >> 2) + 4 * hi;
            auto r1 = __builtin_amdgcn_permlane32_swap(__float_as_uint(bv), __float_as_uint(bv), false, false);
            auto r2 = __builtin_amdgcn_permlane32_swap((unsigned)be, (unsigned)be, false, false);
            const float pv = __uint_as_float(hi ? r1[0] : r1[1]); const int pe = (int)(hi ? r2[0] : r2[1]);
            const bool mine = (bv > pv) || (bv == pv && be < pe);
            tv[k] = mine ? bv : pv; te[k] = mine ? be : pe;
#pragma unroll
            for (int r = 0; r < 16; ++r) v[r] = (mine && r == br) ? -INFINITY : v[r];
        }
        const float e1 = expf(tv[1] - tv[0]), e2 = expf(tv[2] - tv[0]), e3 = expf(tv[3] - tv[0]); const float inv = 1.f / (1.f + e1 + e2 + e3);
        ea = hi ? te[2] : te[0]; eb = hi ? te[3] : te[1]; wa = (hi ? e2 : 1.f) * inv; wb = (hi ? e3 : e1) * inv;
        la = atomicAdd((unsigned*)&lcnt[ea], 1u); lb = atomicAdd((unsigned*)&lcnt[eb], 1u);
    }
    LDS_WAIT(); __syncthreads();
    if (tid < NE) { const unsigned c = lcnt[tid]; lbase[tid] = c ? atomicAdd(&CNT[tid], c) : 0u; }
    LDS_WAIT(); __syncthreads();
    if (kq == 0) {
        const int sa = tok * 4 + 2 * hi, sb = sa + 1;
        const int pa = (int)(lbase[ea] + la), pb = (int)(lbase[eb] + lb);
        LIST[(size_t)ea * LIST_CAP + pa] = sa; RW[sa] = wa; SLOTEP[sa] = ea * 16384 + pa;
        LIST[(size_t)eb * LIST_CAP + pb] = sb; RW[sb] = wb; SLOTEP[sb] = eb * 16384 + pb;
    }
    LDS_WAIT(); __syncthreads();
}

__device__ __forceinline__ bool moe_tile(const unsigned* CNT, int g, int& e, int& base, int& p0, int& cnt) {
    const int tile256 = g >> 4; base = 0;
    for (e = 0; e < NE; ++e) { const int nt = ((int)CNT[e] + 255) >> 8; if (tile256 < base + nt) break; base += nt; }
    if (e == NE) return false;
    cnt = (int)CNT[e]; p0 = (g - base * 16) * 16; return p0 < cnt;
}
__device__ __forceinline__ void nv_moe1(const bf16_t* __restrict__ X1B, const bf16_t* __restrict__ W1T, const float* __restrict__ b1, const float* __restrict__ RSTD2,
                                        const int* __restrict__ LIST, bf16_t* __restrict__ H, int e, int base, int p0, int cnt, int cg, int lane) {
    const int r = lane & 15, q = lane >> 4, c0 = cg * 32, pn = c0 >> 7, j0 = c0 & 127;
    const int* lst = LIST + (size_t)e * LIST_CAP;
    const int prow = p0 + r; const int tok = lst[prow < cnt ? prow : cnt - 1] >> 2;
    f32x4 acc[4];
#pragma unroll
    for (int t = 0; t < 4; ++t) acc[t] = (f32x4){0.f, 0.f, 0.f, 0.f};
    const bf16_t* ap = X1B + (size_t)tok * DM + 8 * q;
    const bf16_t* wb = W1T + (size_t)e * 2048 * DM + (size_t)(256 * pn + j0 + r) * DM + 8 * q;
    const bf16_t* bp[4] = {wb, wb + 16 * DM, wb + 128 * DM, wb + 144 * DM};
    wave_mma<4>(acc, ap, bp, DM);
#pragma unroll
    for (int j = 0; j < 4; ++j) {
        const int pr = p0 + 4 * q + j; if (pr >= cnt) continue;
        const float rs = RSTD2[lst[pr] >> 2];
#pragma unroll
        for (int t = 0; t < 2; ++t) {
            const int col = c0 + 16 * t + r;
            float glu = acc[t][j] * rs + b1[(size_t)e * 2048 + col], lin = acc[t + 2][j] * rs + b1[(size_t)e * 2048 + 1024 + col];
            glu = fminf(glu, 7.f); lin = fminf(fmaxf(lin, -7.f), 7.f);
            const float act = glu * (1.f / (1.f + expf(-1.702f * glu))) * (lin + 1.f);
            H[((size_t)base * 256 + pr) * DM + col] = f2bf(act);
        }
    }
}
__device__ __forceinline__ void nv_moe2(const bf16_t* __restrict__ H, const bf16_t* __restrict__ W2T, const float* __restrict__ b2, const float* __restrict__ RW,
                                        const int* __restrict__ LIST, bf16_t* __restrict__ Y, int e, int base, int p0, int cnt, int cg, int lane) {
    const int r = lane & 15, q = lane >> 4, n0 = cg * 64;
    const int* lst = LIST + (size_t)e * LIST_CAP;
    f32x4 acc[4];
#pragma unroll
    for (int t = 0; t < 4; ++t) acc[t] = (f32x4){0.f, 0.f, 0.f, 0.f};
    const bf16_t* ap = H + ((size_t)base * 256 + p0 + r) * DM + 8 * q;
    const bf16_t* bp[4];
#pragma unroll
    for (int t = 0; t < 4; ++t) bp[t] = W2T + (size_t)e * DM * DM + (size_t)(n0 + 16 * t + r) * DM + 8 * q;
    wave_mma<4>(acc, ap, bp, DM);
#pragma unroll
    for (int j = 0; j < 4; ++j) {
        const int pr = p0 + 4 * q + j; if (pr >= cnt) continue;
        const int slot = lst[pr]; const float w = RW[slot];
#pragma unroll
        for (int t = 0; t < 4; ++t) { const int col = n0 + 16 * t + r; Y[((size_t)base * 256 + pr) * DM + col] = f2bf((acc[t][j] + b2[(size_t)e * DM + col]) * w); }
    }
}

__device__ __forceinline__ void final_row(const float* X1, const bf16_t* __restrict__ Y, const int* __restrict__ SLOTEP, const int* __restrict__ TBG, const float* __restrict__ gf, float* out, int row, int lane) {
    float4 v[4]; float ss = 0.f; int yr[4];
#pragma unroll
    for (int k = 0; k < 4; ++k) { const int ep = SLOTEP[row * 4 + k]; yr[k] = TBG[ep >> 14] * 256 + (ep & 16383); }
#pragma unroll
    for (int j = 0; j < 4; ++j) {
        const int c0 = 4 * (lane + 64 * j);
        v[j] = *(const float4*)(X1 + (size_t)row * DM + c0);
#pragma unroll
        for (int k = 0; k < 4; ++k) { const uint2 y = *(const uint2*)(Y + (size_t)yr[k] * DM + c0);
            v[j].x += bf2f((unsigned short)(y.x & 0xffff)); v[j].y += bf2f((unsigned short)(y.x >> 16)); v[j].z += bf2f((unsigned short)(y.y & 0xffff)); v[j].w += bf2f((unsigned short)(y.y >> 16)); }
        ss += v[j].x * v[j].x + v[j].y * v[j].y + v[j].z * v[j].z + v[j].w * v[j].w;
    }
    ss = wave_sum(ss);
    const float rstd = rsqrtf(ss * (1.f / DM) + EPS);
#pragma unroll
    for (int j = 0; j < 4; ++j) { const int c0 = 4 * (lane + 64 * j); const float4 g = *(const float4*)(gf + c0);
        float4 o; o.x = v[j].x * rstd * g.x; o.y = v[j].y * rstd * g.y; o.z = v[j].z * rstd * g.z; o.w = v[j].w * rstd * g.w; *(float4*)(out + (size_t)row * DM + c0) = o; }
}


namespace pg8 {
#define PG8_LAS __attribute__((address_space(3)))
typedef unsigned u32x4 __attribute__((ext_vector_type(4)));
typedef unsigned u32x2 __attribute__((ext_vector_type(2)));
typedef int i32x8 __attribute__((ext_vector_type(8)));
constexpr int BM = 256, BK = 64, HALF = 128, HTB = HALF * BK * 2  , STAGE_BYTES = 8 * HTB, NXCD = 8, WGM = 8;
__host__ __device__ __forceinline__ int lds_byte(int r, int c) { const int st = (r >> 4) * 2 + (c >> 5), rr = r & 15, cc = c & 31, ob = rr * 64 + cc * 2; return st * 1024 + (ob ^ (((ob >> 9) & 1) << 5)); }
__host__ __device__ __forceinline__ void stage_rc(int b, int& R, int& C) { const int st = b / 1024, sb = b % 1024, swz = sb ^ (((sb >> 9) & 1) << 5); R = (st >> 1) * 16 + swz / 64; C = (st & 1) * 32 + (swz % 64) / 2; }
__host__ __device__ __forceinline__ int perm32(int rho) { const int n = rho >> 4, i = rho & 15; return 8 * (i >> 2) + 4 * n + (i & 3); }
struct Unit { int pm, pn, nr; };
struct Gemm { const bf16_t* A; const bf16_t* Bt; int K; };
__device__ __forceinline__ void st16_wt(void* p, u32x4 v) { if (WT_STORES) asm volatile("global_store_dwordx4 %0, %1, off sc0 sc1\n\ts_nop 1" :: "v"(p), "v"(v) : "memory"); else *(u32x4*)p = v; }
__device__ __forceinline__ void st8_wt(void* p, u32x2 v) { if (WT_STORES) asm volatile("global_store_dwordx2 %0, %1, off sc0 sc1\n\ts_nop 1" :: "v"(p), "v"(v) : "memory"); else *(u32x2*)p = v; }
struct StaticOrder {
    int nM, nN, nwg, G, c;
    __device__ void init(int M_, int N_, int G_, int c_) { nM = M_ / BM; nN = N_ / BM; nwg = nM * nN; G = G_; c = c_; }
    __device__ bool next(int i, Unit& u) const {
        const long L = (long)i * G + c; if (L >= nwg) return false;
        int wgid = (int)L; { const int q = nwg / NXCD, r = nwg % NXCD, xcd = wgid % NXCD, off = wgid / NXCD; wgid = (xcd < r ? xcd * (q + 1) : r * (q + 1) + (xcd - r) * q) + off; }
        const int nig = WGM * nN, gid = wgid / nig, fm = gid * WGM, gsz = (nM - fm) < WGM ? (nM - fm) : WGM;
        u.pm = fm + ((wgid % nig) % gsz); u.pn = (wgid % nig) / gsz; u.nr = BM; return true;
    }
    __device__ __forceinline__ const PG8_LAS int* rowtab(int) const { return nullptr; }
};
__device__ __forceinline__ unsigned cvt_pk_bf16(float lo, float hi) { unsigned r; asm volatile("v_cvt_pk_bf16_f32 %0, %1, %2" : "=v"(r) : "v"(lo), "v"(hi)); return r; }

template <class Sched> __device__ __forceinline__ void gather_voffs(const Sched& S, int ui, int tid, int K, unsigned (&o0)[2], unsigned (&o1)[2]) {
    const PG8_LAS int* tab = S.rowtab(ui);
#pragma unroll
    for (int i = 0; i < 2; ++i) { int R, C; stage_rc(tid * 16 + i * 8192, R, C); o0[i] = (unsigned)((tab[R] & 0xffff) * K + C) * 2u; o1[i] = (unsigned)((tab[HALF + R] & 0xffff) * K + C) * 2u; }
}

template <class Epi, class Sched, bool ALIGN_EPI, bool GATHER, bool F8 = false>
__device__ __forceinline__ void gemm_phase(PG8_LAS unsigned char* lds, const Gemm g, const Sched& S, const Epi& E) {
    int tid_ = threadIdx.x; asm volatile("" : "+v"(tid_));
    const int tid = tid_, wid = __builtin_amdgcn_readfirstlane(tid >> 6), lane = tid & 63, wr = wid >> 2, wc = wid & 3, fr = lane & 15, fq = lane >> 4;
    const int K = g.K, nt = K / BK;
    unsigned vA0[2], vA1[2], wA0[2], wA1[2], voffB[2];
    const size_t kstep = (size_t)(BK * 2);
    const size_t hstep = (size_t)HALF * K * 2;
    const size_t tstep = 2 * hstep;
#pragma unroll
    for (int i = 0; i < 2; ++i) { int R, C; stage_rc(tid * 16 + i * 8192, R, C); const int Rb = Epi::PERM ? ((R & ~31) + perm32(R & 31)) : R;
        vA0[i] = (unsigned)(R * K + C) * 2u; vA1[i] = vA0[i] + (unsigned)hstep; voffB[i] = (unsigned)(Rb * K + C) * 2u; wA0[i] = vA0[i]; wA1[i] = vA1[i]; }
    const unsigned ldsw = (unsigned)wid * 1024u;
    const int aoff = lds_byte(wr * 64 + fr, fq * 8), boff = lds_byte(wc * 32 + fr, fq * 8);
    const int a8o0 = lds_byte(wr * 64 + fr, fq * 16), a8o1 = lds_byte(wr * 64 + fr, fq * 16 + 8), b8o0 = lds_byte(wc * 32 + fr, fq * 16), b8o1 = lds_byte(wc * 32 + fr, fq * 16 + 8);
#define PG8_SA(b, h) (((b) * 2 + (h)) * HTB)
#define PG8_SB(b, h) ((4 + (b) * 2 + (h)) * HTB)
#define PG8_STAGE(bufoff, gbase, voff) do { _Pragma("unroll") for (int _i = 0; _i < 2; ++_i) \
        __builtin_amdgcn_global_load_lds((const unsigned*)((const char*)(gbase) + (voff)[_i]), (PG8_LAS unsigned*)(lds + (bufoff) + ldsw + _i * 8192), 16, 0, 0); } while (0)
#define PG8_LDA_BF(dst, b, h) do { _Pragma("unroll") for (int m = 0; m < 4; ++m) _Pragma("unroll") for (int k = 0; k < 2; ++k) dst[m][k] = *(const PG8_LAS bf16x8*)(lds + PG8_SA(b, h) + aoff + m * 2048 + k * 1024); } while (0)
#define PG8_LDB_BF(dst, b, h) do { _Pragma("unroll") for (int n = 0; n < 2; ++n) _Pragma("unroll") for (int k = 0; k < 2; ++k) dst[n][k] = *(const PG8_LAS bf16x8*)(lds + PG8_SB(b, h) + boff + n * 2048 + k * 1024); } while (0)
#define PG8_MMA_BF(ai, bj, At, Bt) do { if (cur.nr > 128 * (ai) + 64 * wr) { __builtin_amdgcn_s_setprio(1); _Pragma("unroll") for (int m = 0; m < 4; ++m) _Pragma("unroll") for (int n = 0; n < 2; ++n) _Pragma("unroll") for (int k = 0; k < 2; ++k) \
        acc[ai][bj][m][n] = __builtin_amdgcn_mfma_f32_16x16x32_bf16(Bt[n][k], At[m][k], acc[ai][bj][m][n], 0, 0, 0); __builtin_amdgcn_s_setprio(0); } } while (0)
#define PG8_LD8(dst, i_, base_, o0_, o1_) do { const u32x4 lo_ = *(const PG8_LAS u32x4*)(lds + (base_) + (o0_) + (i_) * 2048), hi_ = *(const PG8_LAS u32x4*)(lds + (base_) + (o1_) + (i_) * 2048); \
        dst[i_] = (i32x8){(int)lo_.x, (int)lo_.y, (int)lo_.z, (int)lo_.w, (int)hi_.x, (int)hi_.y, (int)hi_.z, (int)hi_.w}; } while (0)
#define PG8_LDA_F8(dst, b, h) do { _Pragma("unroll") for (int m = 0; m < 4; ++m) PG8_LD8(dst, m, PG8_SA(b, h), a8o0, a8o1); } while (0)
#define PG8_LDB_F8(dst, b, h) do { _Pragma("unroll") for (int n = 0; n < 2; ++n) PG8_LD8(dst, n, PG8_SB(b, h), b8o0, b8o1); } while (0)
#define PG8_MMA_F8(ai, bj, At, Bt) do { if (cur.nr > 128 * (ai) + 64 * wr) { __builtin_amdgcn_s_setprio(1); _Pragma("unroll") for (int m = 0; m < 4; ++m) _Pragma("unroll") for (int n = 0; n < 2; ++n) \
        acc[ai][bj][m][n] = __builtin_amdgcn_mfma_scale_f32_16x16x128_f8f6f4(Bt[n], At[m], acc[ai][bj][m][n], 0, 0, 0, 0x7A7A7A7A  , 0, 0x7F7F7F7F  ); __builtin_amdgcn_s_setprio(0); } } while (0)
#define PG8_LDA(dst, b, h) do { if constexpr (F8) { PG8_LDA_F8(dst##8, b, h); } else { PG8_LDA_BF(dst, b, h); } } while (0)
#define PG8_LDB(dst, b, h) do { if constexpr (F8) { PG8_LDB_F8(dst##8, b, h); } else { PG8_LDB_BF(dst, b, h); } } while (0)
#define PG8_MMA(ai, bj, At, Bt) do { if constexpr (F8) { PG8_MMA_F8(ai, bj, At##8, Bt##8); } else { PG8_MMA_BF(ai, bj, At, Bt); } } while (0)
#define PG8_WAIT_V(n) asm volatile("s_waitcnt vmcnt(" #n ")" ::: "memory")
#define PG8_WAIT_L(n) asm volatile("s_waitcnt lgkmcnt(" #n ")" ::: "memory")
#define PG8_BAR __builtin_amdgcn_s_barrier()
#define PG8_SCHED __builtin_amdgcn_sched_barrier(0)
    Unit cur, nxt; int ui = 0;
    if (!S.next(0, cur)) return;
    f32x4 acc[2][2][4][2];
#pragma unroll
    for (int a = 0; a < 2; ++a)
#pragma unroll
        for (int b = 0; b < 2; ++b)
#pragma unroll
            for (int m = 0; m < 4; ++m)
#pragma unroll
                for (int n = 0; n < 2; ++n) acc[a][b][m][n] = (f32x4){0.f, 0.f, 0.f, 0.f};
    bf16x8 At[4][2], B0[2][2], B1[2][2]; i32x8 At8[4], B08[2], B18[2];
    const char* cA = GATHER ? (const char*)g.A : (const char*)g.A + (size_t)cur.pm * tstep; const char* cB = (const char*)g.Bt + (size_t)cur.pn * tstep;
    if constexpr (GATHER) gather_voffs(S, 0, tid, K, vA0, vA1);
    PG8_STAGE(PG8_SB(0, 0), cB, voffB); PG8_STAGE(PG8_SB(0, 1), cB + hstep, voffB); PG8_STAGE(PG8_SA(0, 0), cA, vA0); PG8_STAGE(PG8_SA(0, 1), cA, vA1);
    if (wr == 1) PG8_BAR;
    PG8_WAIT_V(2); PG8_BAR;
    PG8_STAGE(PG8_SB(1, 0), cB + kstep, voffB); PG8_STAGE(PG8_SA(1, 0), cA + kstep, vA0); PG8_STAGE(PG8_SB(1, 1), cB + hstep + kstep, voffB);
    PG8_WAIT_V(6); PG8_BAR;
    for (;;) {
        const bool has_next = S.next(ui + 1, nxt);
        const char* nA = GATHER ? cA : (has_next ? (const char*)g.A + (size_t)nxt.pm * tstep : cA); const char* nB = has_next ? (const char*)g.Bt + (size_t)nxt.pn * tstep : cB;
        if constexpr (GATHER) { if (has_next) gather_voffs(S, ui + 1, tid, K, wA0, wA1); else { wA0[0] = vA0[0]; wA0[1] = vA0[1]; wA1[0] = vA1[0]; wA1[1] = vA1[1]; } }
        for (int t = 0; t < nt; t += 2) {
            const bool last = (t == nt - 2);
            const char* a1 = cA + (size_t)(t + 1) * kstep;
            const char* a2 = last ? nA : cA + (size_t)(t + 2) * kstep; const char* b2 = last ? nB : cB + (size_t)(t + 2) * kstep;
            const char* a3 = a2 + kstep; const char* b3 = b2 + kstep;
            unsigned sA0[2], sA1[2];
#pragma unroll
            for (int i = 0; i < 2; ++i) { sA0[i] = (GATHER && last) ? wA0[i] : vA0[i]; sA1[i] = (GATHER && last) ? wA1[i] : vA1[i]; }
            if constexpr (Epi::MIDK) { if (t == nt / 2) E.midk(acc, wr, fr); }
            PG8_LDB(B0, 0, 0); PG8_LDB(B1, 0, 1); PG8_SCHED; PG8_LDA(At, 0, 0); PG8_STAGE(PG8_SA(1, 1), a1, vA1);
            PG8_WAIT_V(8); PG8_WAIT_L(0); PG8_BAR; PG8_MMA(0, 0, At, B0); PG8_MMA(0, 1, At, B1); PG8_BAR; PG8_SCHED;
            PG8_LDA(At, 0, 1); PG8_STAGE(PG8_SB(0, 0), b2, voffB); PG8_STAGE(PG8_SB(0, 1), b2 + hstep, voffB); PG8_STAGE(PG8_SA(0, 0), a2, sA0);
            PG8_WAIT_V(8); PG8_WAIT_L(0); PG8_BAR; PG8_MMA(1, 0, At, B0); PG8_MMA(1, 1, At, B1); PG8_BAR; PG8_SCHED;
            PG8_LDB(B0, 1, 0); PG8_LDB(B1, 1, 1); PG8_SCHED; PG8_LDA(At, 1, 0); PG8_STAGE(PG8_SA(0, 1), a2, sA1);
            PG8_WAIT_V(8); PG8_WAIT_L(0); PG8_BAR; PG8_MMA(0, 0, At, B0); PG8_MMA(0, 1, At, B1); PG8_BAR; PG8_SCHED;
            PG8_LDA(At, 1, 1); PG8_STAGE(PG8_SB(1, 0), b3, voffB); PG8_STAGE(PG8_SB(1, 1), b3 + hstep, voffB); PG8_STAGE(PG8_SA(1, 0), a3, sA0);
            PG8_WAIT_V(8); PG8_WAIT_L(0); PG8_BAR; PG8_MMA(1, 0, At, B0); PG8_MMA(1, 1, At, B1); PG8_BAR; PG8_SCHED;
        }
        if constexpr (ALIGN_EPI) { if (wr == 0) PG8_BAR; }
        E(acc, cur, ui, wr, wc, fr, fq);
        if (!has_next) break;
#pragma unroll
        for (int a = 0; a < 2; ++a)
#pragma unroll
            for (int b = 0; b < 2; ++b)
#pragma unroll
                for (int m = 0; m < 4; ++m)
#pragma unroll
                    for (int n = 0; n < 2; ++n) acc[a][b][m][n] = (f32x4){0.f, 0.f, 0.f, 0.f};
        cur = nxt; cA = nA; cB = nB; ++ui;
        if constexpr (GATHER) { vA0[0] = wA0[0]; vA0[1] = wA0[1]; vA1[0] = wA1[0]; vA1[1] = wA1[1]; }
        if constexpr (ALIGN_EPI) { if (wr == 1) PG8_BAR; }
    }
    PG8_WAIT_V(0);
    if constexpr (!ALIGN_EPI) { if (wr == 0) PG8_BAR; }
    PG8_BAR;
#undef PG8_SA
#undef PG8_SB
#undef PG8_STAGE
#undef PG8_LDA
#undef PG8_LDB
#undef PG8_MMA
#undef PG8_LDA_BF
#undef PG8_LDB_BF
#undef PG8_MMA_BF
#undef PG8_LD8
#undef PG8_LDA_F8
#undef PG8_LDB_F8
#undef PG8_MMA_F8
#undef PG8_WAIT_V
#undef PG8_WAIT_L
#undef PG8_BAR
#undef PG8_SCHED
}

struct EpiProj {
    static constexpr bool PERM = true, MIDK = false;
    bf16_t* O;
    __device__ __forceinline__ void operator()(const f32x4 (&acc)[2][2][4][2], const Unit& u, int, int wr, int wc, int fr, int fq) const {
        const int row0 = u.pm * BM + wr * 64 + fr, col0 = u.pn * BM + wc * 32 + 8 * fq;
        const float sc = (u.pn < 2 || (u.pn >= 6 && u.pn < 8)) ? C2 : 1.f;
#pragma unroll
        for (int ai = 0; ai < 2; ++ai)
#pragma unroll
            for (int m = 0; m < 4; ++m) { bf16_t* rowp = O + (size_t)(row0 + ai * HALF + m * 16) * NPROJ + col0;
#pragma unroll
                for (int bj = 0; bj < 2; ++bj) { const f32x4 v0 = acc[ai][bj][m][0] * sc, v1 = acc[ai][bj][m][1] * sc;
                    u32x4 w; w.x = cvt_pk_bf16(v0[0], v0[1]); w.y = cvt_pk_bf16(v0[2], v0[3]); w.z = cvt_pk_bf16(v1[0], v1[1]); w.w = cvt_pk_bf16(v1[2], v1[3]);
                    st16_wt(rowp + bj * HALF, w); } }
    }
};
struct EpiWout {
    static constexpr bool PERM = false, MIDK = true;
    const float* x; float* X1; bf16_t* X1B; const PG8_LAS float* ratio; const PG8_LAS float* rs;
    __device__ __forceinline__ void midk(f32x4 (&acc)[2][2][4][2], int wr, int fr) const {
#pragma unroll
        for (int ai = 0; ai < 2; ++ai)
#pragma unroll
            for (int m = 0; m < 4; ++m) { const float f = ratio[ai * HALF + wr * 64 + m * 16 + fr];
#pragma unroll
                for (int bj = 0; bj < 2; ++bj)
#pragma unroll
                    for (int n = 0; n < 2; ++n) acc[ai][bj][m][n] *= f; }
    }
    __device__ __forceinline__ void operator()(const f32x4 (&acc)[2][2][4][2], const Unit& u, int, int wr, int wc, int fr, int fq) const {
        const int col0 = u.pn * BM + wc * 32 + 4 * fq;
#pragma unroll
        for (int ai = 0; ai < 2; ++ai)
#pragma unroll
            for (int m = 0; m < 4; ++m) { const int r = ai * HALF + wr * 64 + m * 16 + fr; const float s = rs[r]; const size_t off = (size_t)(u.pm * BM + r) * DM + col0;
#pragma unroll
                for (int bj = 0; bj < 2; ++bj)
#pragma unroll
                    for (int n = 0; n < 2; ++n) { const f32x4 xv = *(const f32x4*)(x + off + bj * HALF + n * 16); const f32x4 o = xv + acc[ai][bj][m][n] * s;
                        *(f32x4*)(X1 + off + bj * HALF + n * 16) = o;
                        if (MOE_F8) *(unsigned*)((unsigned char*)X1B + off + bj * HALF + n * 16) = pk4_fp8(o[0], o[1], o[2], o[3]);
                        else { u32x2 w; w.x = cvt_pk_bf16(o[0], o[1]); w.y = cvt_pk_bf16(o[2], o[3]); *(u32x2*)(X1B + off + bj * HALF + n * 16) = w; } }
                asm volatile("" ::: "memory"); }
    }
};
constexpr int MOE_MAXU = 10;
struct MoeOrder {
    int NT, c; const PG8_LAS int* tb; const PG8_LAS int* tbE; const PG8_LAS int* tbC; const PG8_LAS int* cnt; const PG8_LAS int* tabA;
    int probe = 0;
    __device__ bool next(int i, Unit& u) const {
        if (i >= MOE_MAXU) return false;
        const int x = c & 7, j = c >> 3, UE = tbE[32] * NT, UC = tbC[32] * NT;
        const int qE = UE >> 3, rE = UE & 7, sE = x * qE + (x < rE ? x : rE), nE = qE + (x < rE ? 1 : 0);
        const int qC = UC >> 3, rC = UC & 7, sC = x * qC + (x < rC ? x : rC), nC = qC + (x < rC ? 1 : 0);
        const int nEj = (j < nE) ? ((nE - j + 31) >> 5) : 0;
        if (i < nEj) {
            const int f = sE + i * 32 + j; int e = 0; while (f >= tbE[e + 1] * NT) ++e;
            const int idx = f - tbE[e] * NT, nte = tbE[e + 1] - tbE[e], pg = idx / (4 * nte), rem2 = idx - pg * 4 * nte, mt = rem2 >> 2;
            u.pm = tb[e] + mt; u.pn = e * NT + pg * 4 + (rem2 & 3); const int left = cnt[e] - 256 * mt; u.nr = left < BM ? left : BM;
        } else {
            const int jj = (j - (nE & 31) + 32) & 31, lc = (i - nEj) * 32 + jj; if (lc >= nC) return false;
            const int f = sC + lc; int e = 0; while (f >= tbC[e + 1] * NT) ++e;
            const int mt = tbE[e + 1] - tbE[e]; u.pm = tb[e] + mt; u.pn = e * NT + (f - tbC[e] * NT); u.nr = cnt[e] - 256 * mt;
        }
        if (probe) { u.pm &= 31; u.pn &= 7; if (probe == 2) u.nr = 32; }
        return true;
    }
    __device__ __forceinline__ const PG8_LAS int* rowtab(int ui) const { return tabA + ui * 256; }
};
struct EpiMoe1 {
    static constexpr bool PERM = true, MIDK = false;
    bf16_t* H; const PG8_LAS int* rowtab; const PG8_LAS float* btab;
    __device__ __forceinline__ void operator()(const f32x4 (&acc)[2][2][4][2], const Unit& u, int ui, int wr, int wc, int fr, int fq) const {
        const int pl = u.pn & 7, cl = wc * 32 + 8 * fq, colA = pl * 128 + cl;
        f32x4 bg[2], bl[2];
#pragma unroll
        for (int n = 0; n < 2; ++n) { bg[n] = *(const PG8_LAS f32x4*)(btab + ui * 256 + cl + 4 * n); bl[n] = *(const PG8_LAS f32x4*)(btab + ui * 256 + 128 + cl + 4 * n); }
#pragma unroll
        for (int ai = 0; ai < 2; ++ai)
#pragma unroll
            for (int m = 0; m < 4; ++m) { const int r = ai * HALF + wr * 64 + m * 16 + fr; const float rs = __uint_as_float((unsigned)rowtab[ui * 256 + r] & 0xffff0000u);
                float a8[8];
#pragma unroll
                for (int n = 0; n < 2; ++n) { const f32x4 gv = acc[ai][0][m][n] * rs + bg[n], lv = acc[ai][1][m][n] * rs + bl[n];
#pragma unroll
                    for (int i = 0; i < 4; ++i) { const float gl = fminf(gv[i], 7.f), li = fminf(fmaxf(lv[i], -7.f), 7.f);
                        a8[4 * n + i] = gl * __builtin_amdgcn_rcpf(1.f + __builtin_amdgcn_exp2f(-1.702f * LOG2E * gl)) * (li + 1.f); } }
                if (MOE_F8) { u32x2 w;
                    int w0 = __builtin_amdgcn_cvt_pk_fp8_f32(a8[0], a8[1], 0, false); w0 = __builtin_amdgcn_cvt_pk_fp8_f32(a8[2], a8[3], w0, true);
                    int w1 = __builtin_amdgcn_cvt_pk_fp8_f32(a8[4], a8[5], 0, false); w1 = __builtin_amdgcn_cvt_pk_fp8_f32(a8[6], a8[7], w1, true);
                    w.x = (unsigned)w0; w.y = (unsigned)w1; *(u32x2*)((unsigned char*)H + (size_t)(u.pm * BM + r) * DM + colA) = w; }
                else { u32x4 w; w.x = cvt_pk_bf16(a8[0], a8[1]); w.y = cvt_pk_bf16(a8[2], a8[3]); w.z = cvt_pk_bf16(a8[4], a8[5]); w.w = cvt_pk_bf16(a8[6], a8[7]);
                *(u32x4*)(H + (size_t)(u.pm * BM + r) * DM + colA) = w; } }
    }
};
struct EpiMoe2 {
    static constexpr bool PERM = true, MIDK = false;
    bf16_t* Y; const PG8_LAS float* wtab; const PG8_LAS float* btab;
    __device__ __forceinline__ void operator()(const f32x4 (&acc)[2][2][4][2], const Unit& u, int ui, int wr, int wc, int fr, int fq) const {
        const int pl = u.pn & 3, cl = wc * 32 + 8 * fq, col0 = pl * BM + cl;
        f32x4 bv[2][2];
#pragma unroll
        for (int bj = 0; bj < 2; ++bj)
#pragma unroll
            for (int n = 0; n < 2; ++n) bv[bj][n] = *(const PG8_LAS f32x4*)(btab + ui * 256 + cl + bj * HALF + 4 * n);
#pragma unroll
        for (int ai = 0; ai < 2; ++ai)
#pragma unroll
            for (int m = 0; m < 4; ++m) { const int r = ai * HALF + wr * 64 + m * 16 + fr; const float wt = wtab[ui * 256 + r]; bf16_t* rowp = Y + (size_t)(u.pm * BM + r) * DM + col0;
#pragma unroll
                for (int bj = 0; bj < 2; ++bj) { const f32x4 v0 = (acc[ai][bj][m][0] + bv[bj][0]) * wt, v1 = (acc[ai][bj][m][1] + bv[bj][1]) * wt;
                    u32x4 w; w.x = cvt_pk_bf16(v0[0], v0[1]); w.y = cvt_pk_bf16(v0[2], v0[3]); w.z = cvt_pk_bf16(v1[0], v1[1]); w.w = cvt_pk_bf16(v1[2], v1[3]);
                    *(u32x4*)(rowp + bj * HALF) = w; } }
    }
};
struct ListOrder {
    const PG8_LAS int* ud; int n; const PG8_LAS int* tabA;
    __device__ __forceinline__ bool next(int i, Unit& u) const { if (i >= n) return false; u.pm = ud[3 * i]; u.pn = ud[3 * i + 1]; u.nr = ud[3 * i + 2]; return true; }
    __device__ __forceinline__ const PG8_LAS int* rowtab(int ui) const { return tabA + ui * 256; }
};
struct EpiNull {
    static constexpr bool PERM = true, MIDK = false; float* O;
    __device__ __forceinline__ void operator()(const f32x4 (&acc)[2][2][4][2], const Unit& u, int ui, int wr, int wc, int fr, int fq) const {
        f32x4 t = (f32x4){0.f, 0.f, 0.f, 0.f};
#pragma unroll
        for (int ai = 0; ai < 2; ++ai)
#pragma unroll
            for (int bj = 0; bj < 2; ++bj)
#pragma unroll
                for (int m = 0; m < 4; ++m)
#pragma unroll
                    for (int n = 0; n < 2; ++n) t += acc[ai][bj][m][n];
        O[(size_t)(u.pm & 31) * 65536 + (u.pn & 7) * 8192 + (wr * 4 + wc) * 64 + fq * 16 + fr + ui] = t[0] + t[1] + t[2] + t[3];
    }
};
}

#include <hip/hip_bf16.h>
#include <cmath>
namespace attn_body {

using bf16=__hip_bfloat16;
using bf16x8=__attribute__((ext_vector_type(8)))short;
using s16x4=__attribute__((ext_vector_type(4)))short;
using f32x16=__attribute__((ext_vector_type(16)))float;
using u32x4=__attribute__((ext_vector_type(4)))unsigned;
constexpr int SEQ=4096,D=64,PIN=3072,POUT=1024;
constexpr int NW=8,QBLK=32,QB=QBLK*NW,KVBLK=64,NQB=SEQ/QB;
__device__ __forceinline__ int crow(int r,int hi){return (r&3)+8*(r>>2)+4*hi;}
#define SBAR() __builtin_amdgcn_sched_barrier(0)
__device__ __forceinline__ void cmask(f32x16&p0,f32x16&p1,int jb,int qrel,int hi){
  const float NEG=-INFINITY; int kb=64*jb+4*hi;
  #pragma unroll
  for(int r=0;r<16;++r){int kv=kb+(r&3)+8*(r>>2); if(kv>qrel)p0[r]=NEG; if(kv+32>qrel)p1[r]=NEG;}
}

constexpr int NSLOT=3, SLOTB=8192;
constexpr int LDS_K=0, LDS_V=NSLOT*SLOTB, LDS_WS=2*NSLOT*SLOTB, LDS_OST=LDS_WS+NW*64*4, LDS_CK=LDS_OST+NW*4096, LDS_BYTES=LDS_CK+SEQ*4;
constexpr float C2=0.125f*1.4426950408889634f;
__device__ __forceinline__ void glds16(const void*gsrc,unsigned lds_dst){unsigned keep;
  asm volatile("s_mov_b32 %0, m0\n\ts_mov_b32 m0, %2\n\ts_nop 0\n\tglobal_load_lds_dwordx4 %1, off\n\ts_mov_b32 m0, %0":"=&s"(keep):"v"(gsrc),"s"(lds_dst):"memory");}
__device__ __forceinline__ float max3f(float a,float b,float c){float r;asm("v_max3_f32 %0, %1, %2, %3":"=v"(r):"v"(a),"v"(b),"v"(c));return r;}
__device__ __forceinline__ float max2f(float a,float b){float r;asm("v_max_f32_e32 %0, %1, %2":"=v"(r):"v"(a),"v"(b));return r;}
__device__ __forceinline__ float fadd_s(float a,float b){float r;asm("v_add_f32_e32 %0, %1, %2":"=v"(r):"v"(a),"v"(b));return r;}
__device__ __forceinline__ float fsub_s(float a,float b){float r;asm("v_sub_f32_e32 %0, %1, %2":"=v"(r):"v"(a),"v"(b));return r;}
typedef float f32x2_t __attribute__((ext_vector_type(2))); typedef float f32x4_t __attribute__((ext_vector_type(4))); typedef __bf16 bf16x2_t __attribute__((ext_vector_type(2)));
__device__ __forceinline__ unsigned cvtpk_s(float lo,float hi){f32x2_t v={lo,hi};bf16x2_t b=__builtin_convertvector(v,bf16x2_t);return __builtin_bit_cast(unsigned,b);}
#define WAIT_BAR(N) asm volatile("s_waitcnt vmcnt(" #N ") lgkmcnt(0)\n\ts_barrier":::"memory")

__device__ __forceinline__ void qkt(f32x16&p0,f32x16&p1,const char*Kslot,const bf16x8*qr,const f32x16&negm,int r32,int hi){
  const char*kb=Kslot+hi*1024+r32*16;
  #pragma unroll
  for(int d0=0;d0<4;++d0){
    const bf16x8 b0=*reinterpret_cast<const bf16x8*>(kb+d0*2048);
    const bf16x8 b1=*reinterpret_cast<const bf16x8*>(kb+d0*2048+512);
    if(d0==0){p0=__builtin_amdgcn_mfma_f32_32x32x16_bf16(b0,qr[0],negm,0,0,0);p1=__builtin_amdgcn_mfma_f32_32x32x16_bf16(b1,qr[0],negm,0,0,0);}
    else{p0=__builtin_amdgcn_mfma_f32_32x32x16_bf16(b0,qr[d0],p0,0,0,0);p1=__builtin_amdgcn_mfma_f32_32x32x16_bf16(b1,qr[d0],p1,0,0,0);}}
}
typedef __attribute__((address_space(3))) const char* lds_cptr;
typedef short v4i16_t __attribute__((ext_vector_type(4)));
__device__ __forceinline__ void kload8(bf16x8*kf,lds_cptr kp){
  kf[0]=*(const __attribute__((address_space(3))) bf16x8*)(kp);      kf[1]=*(const __attribute__((address_space(3))) bf16x8*)(kp+512);
  kf[2]=*(const __attribute__((address_space(3))) bf16x8*)(kp+2048); kf[3]=*(const __attribute__((address_space(3))) bf16x8*)(kp+2560);
  kf[4]=*(const __attribute__((address_space(3))) bf16x8*)(kp+4096); kf[5]=*(const __attribute__((address_space(3))) bf16x8*)(kp+4608);
  kf[6]=*(const __attribute__((address_space(3))) bf16x8*)(kp+6144); kf[7]=*(const __attribute__((address_space(3))) bf16x8*)(kp+6656);
}
__device__ __forceinline__ void kload2(bf16x8*kf,lds_cptr kp,int j){ kf[2*j]=*(const __attribute__((address_space(3))) bf16x8*)(kp+j*2048); kf[2*j+1]=*(const __attribute__((address_space(3))) bf16x8*)(kp+j*2048+512); }
__device__ __forceinline__ s16x4 vtr(lds_cptr p){ return __builtin_bit_cast(s16x4,__builtin_amdgcn_ds_read_tr16_b64_v4i16((__attribute__((address_space(3))) v4i16_t*)p)); }
__device__ __forceinline__ float rowmax(const f32x16&p0,const f32x16&p1){
  float a=max3f(p0[0],p0[1],p1[0]),b=max3f(p0[2],p0[3],p1[1]);a=max3f(a,p1[2],p1[3]);
  #pragma unroll
  for(int r=4;r<16;r+=4){a=max3f(a,p0[r],p0[r+1]);b=max3f(b,p0[r+2],p0[r+3]);a=max3f(a,p1[r],p1[r+1]);b=max3f(b,p1[r+2],p1[r+3]);}
  const float m=max2f(a,b);
  auto rr=__builtin_amdgcn_permlane32_swap(__float_as_uint(m),__float_as_uint(m),false,false);
  return max2f(__uint_as_float(rr[0]),__uint_as_float(rr[1]));
}
__device__ __forceinline__ void pv(f32x16*o,int vb,bf16x8 pa0,bf16x8 pa1,bf16x8 pa2,bf16x8 pa3){
  #pragma unroll
  for(int d0=0;d0<2;++d0){s16x4 lo[4],hi[4];
    #pragma unroll
    for(int ks=0;ks<4;++ks){
      asm volatile("ds_read_b64_tr_b16 %0,%1 offset:%c2":"=&v"(lo[ks]):"v"(vb),"i"(d0*4096+ks*1024):"memory");
      asm volatile("ds_read_b64_tr_b16 %0,%1 offset:%c2":"=&v"(hi[ks]):"v"(vb),"i"(d0*4096+ks*1024+512):"memory");}
    asm volatile("s_waitcnt lgkmcnt(0)":::"memory");SBAR();
    #define PK(k) (bf16x8){lo[k][0],lo[k][1],lo[k][2],lo[k][3],hi[k][0],hi[k][1],hi[k][2],hi[k][3]}
    o[d0]=__builtin_amdgcn_mfma_f32_32x32x16_bf16(pa0,PK(0),o[d0],0,0,0);
    o[d0]=__builtin_amdgcn_mfma_f32_32x32x16_bf16(pa1,PK(1),o[d0],0,0,0);
    o[d0]=__builtin_amdgcn_mfma_f32_32x32x16_bf16(pa2,PK(2),o[d0],0,0,0);
    o[d0]=__builtin_amdgcn_mfma_f32_32x32x16_bf16(pa3,PK(3),o[d0],0,0,0);
    #undef PK
  }
}

#ifndef ATTN_STORE16
#define ATTN_STORE16(p,v) (*(u32x4*)(p)=(v))
#endif
template<int THRL> __device__ __forceinline__ void attn_unit(int b,int h,int qb,const bf16*Q,const bf16*__restrict__ K,const bf16*__restrict__ V,bf16*O,const float*__restrict__ CUMbh,float*__restrict__ SSQh,char*shm){
  int tid_=threadIdx.x; asm volatile("":"+v"(tid_));
  const int tid=tid_,lane=tid&63,r32=lane&31,hi=lane>>5; const int wid=__builtin_amdgcn_readfirstlane(tid>>6);
  const long rowbase=(long)b*SEQ; const int q0=qb*QB;
  const bf16*Qw=Q+(rowbase+q0+wid*QBLK)*PIN+h*D;
  const bf16*Kh=K+rowbase*PIN+h*D,*Vh=V+rowbase*PIN+h*D;
  const unsigned lds0=(unsigned)(uintptr_t)shm;
  const lds_cptr shm3=(lds_cptr)shm;
  float*wsf=(float*)(shm+LDS_WS)+wid*64;
  const bf16*ksrc=Kh+(long)lane*PIN+wid*8;
  const bf16*vsrc=Vh+(long)(16*(wid&3)+(lane>>2))*PIN+(wid>>2)*32+(lane&3)*8;
  const unsigned kdst=lds0+LDS_K+wid*1024, vdst=lds0+LDS_V+wid*1024;
  #define DMA_K(t,slot) glds16(ksrc+(long)(t)*KVBLK*PIN,(unsigned)__builtin_amdgcn_readfirstlane(kdst+(slot)))
  #define DMA_V(t,slot) glds16(vsrc+(long)(t)*KVBLK*PIN,(unsigned)__builtin_amdgcn_readfirstlane(vdst+(slot)))
  const int vb0=(int)(lds0+LDS_V)+((lane>>4)&1)*32+(lane&3)*8+(4*hi+((lane&15)>>2))*64;
  const char*Kbase=shm+LDS_K; bf16x8 kf[8];
  const lds_cptr kp0=shm3+LDS_K+hi*1024+r32*16; const lds_cptr vp0=shm3+LDS_V+((lane>>4)&1)*32+(lane&3)*8+(4*hi+((lane&15)>>2))*64;
  const int NT=(q0+QB)/KVBLK;
  DMA_K(0,0);DMA_V(0,0);DMA_K(1,SLOTB);
  bf16x8 qr[4];
  #pragma unroll
  for(int d0=0;d0<4;++d0)qr[d0]=*reinterpret_cast<const bf16x8*>(&Qw[(long)r32*PIN+d0*16+hi*8]);
  const float cbase=CUMbh[q0]; const float cq=CUMbh[q0+wid*QBLK+r32]-cbase;
  { __attribute__((address_space(3))) float*ckw=(__attribute__((address_space(3))) float*)(shm3+LDS_CK); int s0_=tid; asm volatile("":"+v"(s0_));
    _Pragma("nounroll") for(int s=s0_;s<q0+QB;s+=NW*64)ckw[s]=CUMbh[s]-cbase; }
  const __attribute__((address_space(3))) float*ckp=(const __attribute__((address_space(3))) float*)(shm3+LDS_CK)+4*hi;
  float mhat=-cq,l_reg=0.f;f32x16 o[2];o[0]=f32x16{};o[1]=f32x16{};f32x16 negm;
  #pragma unroll
  for(int r=0;r<16;++r)negm[r]=cq;
  asm volatile("":"+v"(negm));
  const int qrel=wid*QBLK+r32;
  #define BIAS(P0,P1,t) do{ const __attribute__((address_space(3))) float*cp_=ckp+(t)*KVBLK; \
    _Pragma("unroll") for(int g_=0;g_<4;++g_){ const f32x4_t c0_=*(const __attribute__((address_space(3))) f32x4_t*)(cp_+8*g_), c1_=*(const __attribute__((address_space(3))) f32x4_t*)(cp_+32+8*g_); \
      _Pragma("unroll") for(int j_=0;j_<4;++j_){ P0[4*g_+j_]-=c0_[j_]; P1[4*g_+j_]-=c1_[j_]; } SBAR(); } }while(0)
  #define CMASK(P0,P1,t) do{int jb_=(t)-(NT-4); if(jb_>=0)cmask(P0,P1,jb_,qrel,hi);}while(0)
  bool resc=false;
  #define START(P0,P1) do{ const float rm=rowmax(P0,P1); resc=false; \
    { const float dl=rm; mhat=fadd_s(mhat,dl); \
      _Pragma("unroll") for(int r=0;r<16;++r){P0[r]=fsub_s(P0[r],dl);P1[r]=fsub_s(P1[r],dl);} \
      _Pragma("unroll") for(int r=0;r<16;++r)negm[r]=-mhat; asm volatile("":"+v"(negm)); } \
    _Pragma("unroll") for(int r=0;r<16;++r)P0[r]=__builtin_amdgcn_exp2f(P0[r]); }while(0)
  #define RESC() do{ if(resc){ asm volatile("s_waitcnt lgkmcnt(0)":::"memory"); \
      _Pragma("unroll") for(int d_=0;d_<2;++d_) _Pragma("unroll") for(int r=0;r<16;++r)o[d_][r]*=wsf[crow(r,hi)]; } }while(0)
  f32x16 pA0,pA1,pB0,pB1;
  int sl_prev=0,sl_cur=0,sl_next=SLOTB;
  #define ROT() do{sl_prev=sl_cur;sl_cur=sl_next;sl_next=(sl_next==(NSLOT-1)*SLOTB)?0:sl_next+SLOTB;}while(0)
  DMA_K(2,2*SLOTB);
  WAIT_BAR(3);
  qkt(pA0,pA1,Kbase,qr,negm,r32,hi);asm volatile("s_nop 15\n\ts_nop 7":"+v"(pA0),"+v"(pA1));BIAS(pA0,pA1,0);CMASK(pA0,pA1,0);
  START(pA0,pA1);
  _Pragma("unroll") for(int r=0;r<16;++r)pA1[r]=__builtin_amdgcn_exp2f(pA1[r]);
  WAIT_BAR(0);
  DMA_K(3,0);DMA_V(1,SLOTB);
  ROT();
  kload8(kf,kp0+sl_cur);
  WAIT_BAR(2);
  s16x4 vlo[8],vhi[8]; u32x4 pw0,pw1,pw2,pw3;
  #define PKW(P,B) cvtpk_s(P[B],P[B+1])
  #define PAF(k) __builtin_bit_cast(bf16x8,pw##k)
  #define VFR(i) (bf16x8){vlo[i][0],vlo[i][1],vlo[i][2],vlo[i][3],vhi[i][0],vhi[i][1],vhi[i][2],vhi[i][3]}
  #define PIN(x) asm volatile("":"+v"(x))
  #define MX3(a,b,c) __builtin_fmaxf(__builtin_fmaxf((a),(b)),(c))
  #define GAPA(MF,A0,A1,A2,A3,W0,W1,PW) do{ MF; sacc+=A0; sacc+=A1; sacc+=A2; sacc+=A3; PIN(sacc); W0; W1; PIN(PW); SBAR(); }while(0)
  #define EX(v) __builtin_amdgcn_exp2f(v)
  #define GAPB(MF,X,B) do{ MF; X[B]=EX(X[B]); X[B+1]=EX(X[B+1]); X[B+2]=EX(X[B+2]); X[B+3]=EX(X[B+3]); PIN(X); SBAR(); }while(0)
  #define VRD(i) do{ vlo[i]=vtr(vp_+(((i)>>2)*4096+((i)&3)*1024)); vhi[i]=vtr(vp_+(((i)>>2)*4096+((i)&3)*1024+512)); }while(0)
  #define KRD(G,j) do{ if(G){ kload2(kf,kp0+sl_next,j); SBAR(); } }while(0)
  #define STEP(C0,C1,P0,P1,t,GK,GV,GL) do{ SBAR(); \
    const lds_cptr vp_=vp0+sl_prev; \
    VRD(0); SBAR(); float sacc=(P0[0]+P0[1]); \
    GAPA(C0=__builtin_amdgcn_mfma_f32_32x32x16_bf16(kf[0],qr[0],negm,0,0,0), P0[2],P0[3],P0[4],P0[5],     pw0[0]=PKW(P0,0), pw0[1]=PKW(P0,2), pw0); \
    VRD(4); SBAR(); GAPA(C1=__builtin_amdgcn_mfma_f32_32x32x16_bf16(kf[1],qr[0],negm,0,0,0), P0[6],P0[7],P0[8],P0[9],     pw0[2]=PKW(P0,4), pw0[3]=PKW(P0,6), pw0); \
    VRD(1); SBAR(); GAPA(C0=__builtin_amdgcn_mfma_f32_32x32x16_bf16(kf[2],qr[1],C0,0,0,0),   P0[10],P0[11],P0[12],P0[13], pw1[0]=PKW(P0,8), pw1[1]=PKW(P0,10), pw1); \
    VRD(5); SBAR(); GAPA(C1=__builtin_amdgcn_mfma_f32_32x32x16_bf16(kf[3],qr[1],C1,0,0,0),   P0[14],P0[15],P1[0],P1[1],   pw1[2]=PKW(P0,12),pw1[3]=PKW(P0,14), pw1); \
    VRD(2); SBAR(); GAPA(C0=__builtin_amdgcn_mfma_f32_32x32x16_bf16(kf[4],qr[2],C0,0,0,0),   P1[2],P1[3],P1[4],P1[5],     pw2[0]=PKW(P1,0), pw2[1]=PKW(P1,2), pw2); \
    VRD(6); SBAR(); GAPA(C1=__builtin_amdgcn_mfma_f32_32x32x16_bf16(kf[5],qr[2],C1,0,0,0),   P1[6],P1[7],P1[8],P1[9],     pw2[2]=PKW(P1,4), pw2[3]=PKW(P1,6), pw2); \
    VRD(3); SBAR(); GAPA(C0=__builtin_amdgcn_mfma_f32_32x32x16_bf16(kf[6],qr[3],C0,0,0,0),   P1[10],P1[11],P1[12],P1[13], pw3[0]=PKW(P1,8), pw3[1]=PKW(P1,10), pw3); \
    VRD(7); SBAR(); GAPA(C1=__builtin_amdgcn_mfma_f32_32x32x16_bf16(kf[7],qr[3],C1,0,0,0),   P1[14],P1[15],0.f,0.f,       pw3[2]=PKW(P1,12),pw3[3]=PKW(P1,14), pw3); \
    l_reg+=sacc; \
    if(GK){DMA_K((t)+3,sl_cur);} if(GV){DMA_V((t)+1,sl_next);} \
    BIAS(C0,C1,t); CMASK(C0,C1,t); \
    { float a=MX3(C0[0],C0[1],C1[0]),b=MX3(C0[2],C0[3],C1[1]); a=MX3(a,C1[2],C1[3]); \
      _Pragma("unroll") for(int r=4;r<16;r+=4){a=MX3(a,C0[r],C0[r+1]);b=MX3(b,C0[r+2],C0[r+3]);a=MX3(a,C1[r],C1[r+1]);b=MX3(b,C1[r+2],C1[r+3]);} \
      float rm=__builtin_fmaxf(a,b); { auto rr=__builtin_amdgcn_permlane32_swap(__float_as_uint(rm),__float_as_uint(rm),false,false); rm=__builtin_fmaxf(__uint_as_float(rr[0]),__uint_as_float(rr[1])); } \
      resc=false; \
      if(__builtin_expect(__any(rm>(float)THRL),0)){ const float dl=__builtin_fmaxf(rm,0.f); mhat+=dl; \
        _Pragma("unroll") for(int r=0;r<16;++r){C0[r]-=dl;C1[r]-=dl;} \
        _Pragma("unroll") for(int r=0;r<16;++r)negm[r]=-mhat; asm volatile("":"+v"(negm)); \
        const float f=__builtin_amdgcn_exp2f(-dl); l_reg*=f; if(hi==0)wsf[r32]=f; resc=true; } } \
    SBAR(); \
    GAPB(o[0]=__builtin_amdgcn_mfma_f32_32x32x16_bf16(PAF(0),VFR(0),o[0],0,0,0), C0,0); \
    GAPB(o[1]=__builtin_amdgcn_mfma_f32_32x32x16_bf16(PAF(0),VFR(4),o[1],0,0,0), C0,4); \
    KRD(GL,0); GAPB(o[0]=__builtin_amdgcn_mfma_f32_32x32x16_bf16(PAF(1),VFR(1),o[0],0,0,0), C0,8); \
    KRD(GL,1); GAPB(o[1]=__builtin_amdgcn_mfma_f32_32x32x16_bf16(PAF(1),VFR(5),o[1],0,0,0), C0,12); \
    KRD(GL,2); GAPB(o[0]=__builtin_amdgcn_mfma_f32_32x32x16_bf16(PAF(2),VFR(2),o[0],0,0,0), C1,0); \
    KRD(GL,3); GAPB(o[1]=__builtin_amdgcn_mfma_f32_32x32x16_bf16(PAF(2),VFR(6),o[1],0,0,0), C1,4); \
    GAPB(o[0]=__builtin_amdgcn_mfma_f32_32x32x16_bf16(PAF(3),VFR(3),o[0],0,0,0), C1,8); \
    GAPB(o[1]=__builtin_amdgcn_mfma_f32_32x32x16_bf16(PAF(3),VFR(7),o[1],0,0,0), C1,12); \
    }while(0)
  int t=1;
  #undef CMASK
  #define CMASK(P0,P1,t) do{}while(0)
  for(;t+5<NT;t+=2){
    STEP(pB0,pB1,pA0,pA1,t,true,true,true);     WAIT_BAR(2); RESC(); ROT();
    STEP(pA0,pA1,pB0,pB1,t+1,true,true,true);   WAIT_BAR(2); RESC(); ROT();
  }
  #undef CMASK
  #define CMASK(P0,P1,t) do{int jb_=(t)-(NT-4); if(jb_>=0)cmask(P0,P1,jb_,qrel,hi);}while(0)
  #define ENDW(tt) do{ if((tt)+3<NT){WAIT_BAR(2);} else if((tt)+2<NT){WAIT_BAR(1);} else {WAIT_BAR(0);} }while(0)
  for(;t+1<NT;t+=2){
    STEP(pB0,pB1,pA0,pA1,t,(t+3<NT),(t+1<NT),(t+1<NT));       ENDW(t);   RESC(); ROT();
    STEP(pA0,pA1,pB0,pB1,t+1,(t+4<NT),(t+2<NT),(t+2<NT));     ENDW(t+1); RESC(); ROT();
  }
  STEP(pB0,pB1,pA0,pA1,NT-1,false,false,false); RESC();
  { float sacc=pB0[0]+pB0[1]; _Pragma("unroll") for(int r=2;r<16;++r)sacc+=pB0[r]; _Pragma("unroll") for(int r=0;r<16;++r)sacc+=pB1[r]; l_reg+=sacc;
    pw0=(u32x4){PKW(pB0,0),PKW(pB0,2),PKW(pB0,4),PKW(pB0,6)};pw1=(u32x4){PKW(pB0,8),PKW(pB0,10),PKW(pB0,12),PKW(pB0,14)};pw2=(u32x4){PKW(pB1,0),PKW(pB1,2),PKW(pB1,4),PKW(pB1,6)};pw3=(u32x4){PKW(pB1,8),PKW(pB1,10),PKW(pB1,12),PKW(pB1,14)};
    SBAR(); pv(o,vb0+sl_cur,PAF(0),PAF(1),PAF(2),PAF(3)); }
  #undef PKW
  #undef PAF
  #undef VFR
  #undef PIN
  #undef MX3
  #undef GAPA
  #undef GAPB
  #undef EX
  #undef VRD
  #undef KRD
  #undef STEP
  #undef ENDW
  {auto rr=__builtin_amdgcn_permlane32_swap(__float_as_uint(l_reg),__float_as_uint(l_reg),false,false);l_reg=__uint_as_float(rr[0])+__uint_as_float(rr[1]);}
  if(hi==0)wsf[32+r32]=l_reg;asm volatile("s_waitcnt lgkmcnt(0)":::"memory");
  float rli[16];
  #pragma unroll
  for(int r=0;r<16;++r)rli[r]=__builtin_amdgcn_rcpf(wsf[32+crow(r,hi)]);
  bf16*Ow=O+(rowbase+q0+wid*QBLK)*POUT+h*D; float*Sw=SSQh+(rowbase+q0+wid*QBLK)*16;
  { bf16*stg=(bf16*)(shm+LDS_OST)+wid*2048;
    #pragma unroll
    for(int r=0;r<16;++r){const int orow=crow(r,hi);
      #pragma unroll
      for(int d0=0;d0<2;++d0)stg[orow*64+d0*32+r32]=__float2bfloat16(o[d0][r]*rli[r]);}
    asm volatile("s_waitcnt lgkmcnt(0)":::"memory");
    #pragma unroll
    for(int i=0;i<4;++i){const int row=i*8+(lane>>3),ch=lane&7; const u32x4 v=*(const u32x4*)(stg+row*64+ch*8); ATTN_STORE16(Ow+(long)row*POUT+ch*8,v);
      float sq=0.f;
      #pragma unroll
      for(int w_=0;w_<4;++w_){const float lo_=__uint_as_float(v[w_]<<16),hi_=__uint_as_float(v[w_]&0xffff0000u);sq+=lo_*lo_+hi_*hi_;}
      sq+=__shfl_xor(sq,1);sq+=__shfl_xor(sq,2);sq+=__shfl_xor(sq,4); if(ch==0)Sw[row*16]=sq;} }
  asm volatile("s_waitcnt lgkmcnt(0)\n\ts_barrier":::"memory");
  #undef DMA_K
  #undef DMA_V
  #undef CMASK
  #undef BIAS
  #undef START
  #undef RESC
  #undef ROT
}
constexpr int ATTN_LDS_BYTES=LDS_BYTES;

__device__ __forceinline__ void sb_unit(int b,int h,int qb,const bf16*Q,const bf16*__restrict__ K,const bf16*__restrict__ V,bf16*O,float*__restrict__ SSQh,char*shm){
  int tid_=threadIdx.x; asm volatile("":"+v"(tid_));
  const int tid=tid_,lane=tid&63,r32=lane&31,hi=lane>>5; const int wid=__builtin_amdgcn_readfirstlane(tid>>6);
  const long rowbase=(long)b*SEQ; const int q0=qb*QB;
  const bf16*Qw=Q+(rowbase+q0+wid*QBLK)*PIN+h*D;
  const bf16*Kh=K+rowbase*PIN+h*D,*Vh=V+rowbase*PIN+h*D;
  const unsigned lds0=(unsigned)(uintptr_t)shm;
  const bf16*ksrc=Kh+(long)lane*PIN+wid*8;
  const bf16*vsrc=Vh+(long)(16*(wid&3)+(lane>>2))*PIN+(wid>>2)*32+(lane&3)*8;
  const unsigned kdst=lds0+LDS_K+wid*1024, vdst=lds0+LDS_V+wid*1024;
  const int vb0=(int)(lds0+LDS_V)+((lane>>4)&1)*32+(lane&3)*8+(4*hi+((lane&15)>>2))*64;
  const char*Kbase=shm+LDS_K;
  const int NT=(q0+QB)/KVBLK;
  #define SB_DMA(i,slot) do{ const long kt_=(long)(NT-1-(i)); glds16(ksrc+kt_*KVBLK*PIN,(unsigned)__builtin_amdgcn_readfirstlane(kdst+(slot))); glds16(vsrc+kt_*KVBLK*PIN,(unsigned)__builtin_amdgcn_readfirstlane(vdst+(slot))); }while(0)
  bf16x8 qr[4];
  #pragma unroll
  for(int d0=0;d0<4;++d0)qr[d0]=*reinterpret_cast<const bf16x8*>(&Qw[(long)r32*PIN+d0*16+hi*8]);
  SB_DMA(0,0); SB_DMA(1,SLOTB);
  f32x16 o[2];o[0]=f32x16{};o[1]=f32x16{};
  float Rc=1.f;
  const int qrel=wid*QBLK+r32;
  int sl_cur=0,sl_n1=SLOTB,sl_n2=2*SLOTB;
  volatile __attribute__((address_space(3))) unsigned*flg=(volatile __attribute__((address_space(3))) unsigned*)((lds_cptr)shm+LDS_WS);
  for(int i=0;i<NT;++i){
    if(i+1<NT){WAIT_BAR(2);}else{WAIT_BAR(0);}
    if(i>0){ const int pb=((i-1)&1)*8; unsigned all_=flg[pb]&flg[pb+1]&flg[pb+2]&flg[pb+3]&flg[pb+4]&flg[pb+5]&flg[pb+6]&flg[pb+7]; if(__builtin_amdgcn_readfirstlane(all_))break; }
    if(i+2<NT)SB_DMA(i+2,sl_n2);
    f32x16 p0,p1; { f32x16 z=f32x16{}; asm volatile("":"+v"(z)); qkt(p0,p1,Kbase+sl_cur,qr,z,r32,hi); }
    f32x16 s0,s1;
    #pragma unroll
    for(int r=0;r<16;++r){
      const float za=__builtin_amdgcn_fmed3f(p0[r],-100.f,100.f), zb=__builtin_amdgcn_fmed3f(p1[r],-100.f,100.f);
      p0[r]=__builtin_amdgcn_exp2f(za); p1[r]=__builtin_amdgcn_exp2f(zb);
      s0[r]=__builtin_amdgcn_rcpf(1.f+p0[r]); s1[r]=__builtin_amdgcn_rcpf(1.f+p1[r]); }
    if(i<4){
      const int kb=64*(3-i)+4*hi;
      #pragma unroll
      for(int r=0;r<16;++r){ const int kv=kb+(r&3)+8*(r>>2); if(kv>=qrel){p0[r]=0.f;s0[r]=1.f;} if(kv+32>=qrel){p1[r]=0.f;s1[r]=1.f;} }
    }
    float gp[8],pp[8];
    #pragma unroll
    for(int g=0;g<4;++g){
      s0[4*g+2]*=s0[4*g+3]; s0[4*g+1]*=s0[4*g+2]; s0[4*g]*=s0[4*g+1]; gp[g]=s0[4*g];
      s1[4*g+2]*=s1[4*g+3]; s1[4*g+1]*=s1[4*g+2]; s1[4*g]*=s1[4*g+1]; gp[4+g]=s1[4*g]; }
    #pragma unroll
    for(int g=0;g<8;++g){ auto rr=__builtin_amdgcn_permlane32_swap(__float_as_uint(gp[g]),__float_as_uint(gp[g]),false,false); pp[g]=__uint_as_float(hi?rr[0]:rr[1]); }
    float st=Rc, outer[8];
    #pragma unroll
    for(int g=7;g>=0;--g){ outer[g]=hi?st:st*pp[g]; st=st*(gp[g]*pp[g]); }
    Rc=st;
    { const unsigned dn=__all(Rc==0.f)?1u:0u; if(lane==0)flg[(i&1)*8+wid]=dn; }
    #pragma unroll
    for(int r=0;r<16;++r){ p0[r]=p0[r]*(s0[r]*outer[r>>2]); p1[r]=p1[r]*(s1[r]*outer[4+(r>>2)]); }
    u32x4 pw0,pw1,pw2,pw3;
    pw0=(u32x4){cvtpk_s(p0[0],p0[1]),cvtpk_s(p0[2],p0[3]),cvtpk_s(p0[4],p0[5]),cvtpk_s(p0[6],p0[7])};
    pw1=(u32x4){cvtpk_s(p0[8],p0[9]),cvtpk_s(p0[10],p0[11]),cvtpk_s(p0[12],p0[13]),cvtpk_s(p0[14],p0[15])};
    pw2=(u32x4){cvtpk_s(p1[0],p1[1]),cvtpk_s(p1[2],p1[3]),cvtpk_s(p1[4],p1[5]),cvtpk_s(p1[6],p1[7])};
    pw3=(u32x4){cvtpk_s(p1[8],p1[9]),cvtpk_s(p1[10],p1[11]),cvtpk_s(p1[12],p1[13]),cvtpk_s(p1[14],p1[15])};
    SBAR(); pv(o,vb0+sl_cur,__builtin_bit_cast(bf16x8,pw0),__builtin_bit_cast(bf16x8,pw1),__builtin_bit_cast(bf16x8,pw2),__builtin_bit_cast(bf16x8,pw3));
    { const int t_=sl_cur; sl_cur=sl_n1; sl_n1=sl_n2; sl_n2=t_; }
  }
  #undef SB_DMA
  bf16*Ow=O+(rowbase+q0+wid*QBLK)*POUT+h*D; float*Sw=SSQh+(rowbase+q0+wid*QBLK)*16;
  { bf16*stg=(bf16*)(shm+LDS_OST)+wid*2048;
    #pragma unroll
    for(int r=0;r<16;++r){const int orow=crow(r,hi);
      #pragma unroll
      for(int d0=0;d0<2;++d0)stg[orow*64+d0*32+r32]=__float2bfloat16(o[d0][r]);}
    asm volatile("s_waitcnt lgkmcnt(0)":::"memory");
    #pragma unroll
    for(int i=0;i<4;++i){const int row=i*8+(lane>>3),ch=lane&7; const u32x4 v=*(const u32x4*)(stg+row*64+ch*8); ATTN_STORE16(Ow+(long)row*POUT+ch*8,v);
      float sq=0.f;
      #pragma unroll
      for(int w_=0;w_<4;++w_){const float lo_=__uint_as_float(v[w_]<<16),hi_=__uint_as_float(v[w_]&0xffff0000u);sq+=lo_*lo_+hi_*hi_;}
      sq+=__shfl_xor(sq,1);sq+=__shfl_xor(sq,2);sq+=__shfl_xor(sq,4); if(ch==0)Sw[row*16]=sq;} }
  asm volatile("s_waitcnt vmcnt(0) lgkmcnt(0)\n\ts_barrier":::"memory");
}
template<int THRL=8> __device__ __forceinline__ void attn_phase(char*lds,const bf16*PROJ,const float*CUM,bf16*OMIX,float*SSQ,int bh,int role){
  const int b=bh>>3,h=bh&7;
  const int nf=role<5?2:6;
  for(int i=0;i<nf;++i){ const int qb=role<5?(i==0?15-role:6+role):5-i;
    attn_unit<THRL>(b,h,qb,PROJ,PROJ+512,PROJ+1024,OMIX,CUM+(size_t)bh*SEQ,SSQ+h,lds); }
  const int sb0=role<3?3+3*role:(role==3?12:(role==4?14:0)), ns=(role==3||role==4)?2:3;
  for(int i=0;i<ns;++i) sb_unit(b,h,sb0+i,PROJ+1536,PROJ+2048,PROJ+2560,OMIX+512,SSQ+8+h,lds);
}
template<int THRL=8> __device__ __forceinline__ void attn_phase8(char*lds,const bf16*PROJ,const float*CUM,bf16*OMIX,float*SSQ,int vcu){
  const int bh=vcu>>3,s=vcu&7,b=bh>>3,h=bh&7;
  if(bh>=32)return;
  for(int i=0;i<4;++i){ const int qb=(i&1)?15-s:s;
    if(i<2)attn_unit<THRL>(b,h,qb,PROJ,PROJ+512,PROJ+1024,OMIX,CUM+(size_t)bh*SEQ,SSQ+h,lds);
    else   sb_unit(b,h,qb,PROJ+1536,PROJ+2048,PROJ+2560,OMIX+512,SSQ+8+h,lds); }
}
#undef SBAR
#undef WAIT_BAR
}

template <int NT, bool UP> __device__ __forceinline__ int moe_prepare(const unsigned* __restrict__ CNT, const int* __restrict__ LIST, const float* __restrict__ RSTD2, const float* __restrict__ RW,
                                                                     const float* __restrict__ bias, int* __restrict__ TBG, int bx, LAS unsigned char* L) {
    int tid_ = threadIdx.x; asm volatile("" : "+v"(tid_)); const int tid = tid_;
    LAS int* tb = (LAS int*)(L + TB_OFF); LAS int* tbE = tb + 64; LAS int* tbC = tb + 128; LAS int* cntl = tb + 192; LAS int* udl = tb + 224; LAS int* tabA = (LAS int*)(L + TAB_OFF); LAS float* tabB = (LAS float*)(L + TAB2_OFF);
    if (tid < 64) {
        const int cn = tid < NE ? (int)CNT[tid] : 0, nt = (cn + 255) >> 8, rem = cn & 255, ch = (rem != 0 && rem <= 128) ? 1 : 0;
        int a = nt, c = ch;
#pragma unroll
        for (int o = 1; o < 32; o <<= 1) { const int ta = __shfl_up(a, o), tc = __shfl_up(c, o); if ((tid & 63) >= o) { a += ta; c += tc; } }
        if (tid < NE) { tb[tid + 1] = a; tbC[tid + 1] = c; tbE[tid + 1] = a - c; cntl[tid] = cn; }
        if (tid == 0) { tb[0] = 0; tbC[0] = 0; tbE[0] = 0; }
    }
    LDS_WAIT(); __syncthreads();
    if (bx == 0 && tid <= NE) TBG[tid] = tb[tid];
    pg8::MoeOrder S{NT, bx, tb, tbE, tbC, cntl, tabA};
    if (tid < pg8::MOE_MAXU) { pg8::Unit u; const bool ok = S.next(tid, u); udl[3 * tid] = ok ? u.pm : -1; udl[3 * tid + 1] = u.pn; udl[3 * tid + 2] = u.nr; }
    LDS_WAIT(); __syncthreads();
    int nun = 0;
#pragma unroll
    for (int i = 0; i < pg8::MOE_MAXU; ++i) nun += (udl[3 * i] >= 0) ? 1 : 0;
    int slot[5];
#pragma unroll
    for (int j = 0; j < 5; ++j) { const int idx = tid + NTHREADS * j, ui = idx >> 8, r = idx & 255; slot[j] = 0;
        if (ui < nun) { const int e = udl[3 * ui + 1] / NT, mt = udl[3 * ui] - tb[e], cnt = cntl[e], p = mt * 256 + r; slot[j] = LIST[(size_t)e * LIST_CAP + (p < cnt ? p : cnt - 1)]; } }
#pragma unroll
    for (int j = 0; j < 5; ++j) { const int idx = tid + NTHREADS * j, ui = idx >> 8;
        if (ui < nun) { const int pn = udl[3 * ui + 1];
            if (UP) { const int tok = slot[j] >> 2; tabA[idx] = tok | (int)(__float_as_uint(RSTD2[tok]) & 0xffff0000u);
                      const int e = pn >> 3, pl = pn & 7, c = idx & 255; tabB[idx] = bias[(size_t)e * 2048 + (c < 128 ? pl * 128 + c : 1024 + pl * 128 + (c - 128))]; }
            else { ((LAS float*)tabA)[idx] = RW[slot[j]]; const int e = pn >> 2, pl = pn & 3; tabB[idx] = bias[(size_t)e * DM + pl * 256 + (idx & 255)]; } } }
    VM_WAIT(); LDS_WAIT(); __syncthreads();
    return nun;
}

__global__ void __launch_bounds__(NTHREADS, 2) mega_fwd(Args a) {
    extern __shared__ __attribute__((aligned(16))) unsigned char lds[];
    LAS unsigned char* L = (LAS unsigned char*)lds;
    volatile LAS unsigned* MISC = (volatile LAS unsigned*)(L + MISC_OFF);
    const int tid = threadIdx.x, lane = tid & 63, wave = __builtin_amdgcn_readfirstlane(tid >> 6);
    const int G = gridDim.x, bx = blockIdx.x, vcu = (G % 8 == 0) ? (bx % 8) * (G / 8) + bx / 8 : bx;
    const int gw = vcu * NWAVES + wave, NGW = G * NWAVES;
    const bool cvt_role = (vcu & 31) >= 24;
    const int cvt_first = ((vcu >> 5) * 8 + ((vcu & 31) - 24)) * NWAVES + wave;
    unsigned char* ws = a.ws;
    unsigned* CTL = (unsigned*)(ws + WS_CTL);
    bf16_t* WINT = (bf16_t*)(ws + WS_WINT); bf16_t* WOUTT = (bf16_t*)(ws + WS_WOUTT); float* WR = (float*)(ws + WS_WR); float* CUM = (float*)(ws + WS_CUM);
    float* SSQ = (float*)(ws + WS_SSQ); float* RSTD2 = (float*)(ws + WS_RSTD2); float* RW = (float*)(ws + WS_RW); int* SLOTEP = (int*)(ws + WS_SLOTEP); int* TBG = (int*)(ws + WS_TBG); int* LIST = (int*)(ws + WS_LIST); float* FLOG = (float*)(ws + WS_FLOG);
    bf16_t* XN = (bf16_t*)(ws + WS_XN); bf16_t* PROJ = (bf16_t*)(ws + WS_PROJ); bf16_t* OMIX = (bf16_t*)(ws + WS_OMIX); bf16_t* X1B = (bf16_t*)(ws + WS_X1B);
    bf16_t* W1T = (bf16_t*)(ws + WS_W1T); bf16_t* W2T = (bf16_t*)(ws + WS_W2T); bf16_t* H = (bf16_t*)(ws + WS_H); bf16_t* Y = (bf16_t*)(ws + WS_Y);
    unsigned* CNT = CTL + CW_CNT;
    for (int u = tid; u < (LDS_BYTES - LDSCTL_OFF) / 4; u += NTHREADS) ((LAS unsigned*)(L + LDSCTL_OFF))[u] = 0u;
    __syncthreads();
    XcdBarrier bar = xcd_barrier_post(CTL + CW_BAR, MISC + 8);

    REPS(0) {
        LAS float* scr = (LAS float*)(L + RING_OFF + wave * 8448);
        LAS float* wf = (LAS float*)(L + RING_OFF + 98304);
        for (int i = tid; i < DM * 8; i += NTHREADS) { const int k = i >> 3; wf[i] = a.w_in[(size_t)k * WIN_N + 1536 + (i & 7)] * a.g1[k]; }
        LDS_WAIT(); __syncthreads();
        constexpr int I_IN = (DM / 64) * (NPROJ / 32), I_OUT = (DM / 64) * (DM / 32);
        for (int it = gw; it < I_IN + I_OUT; it += NGW) {
            TrItem t; f32x4 v[8];
            if (it < I_IN) { t.W = a.w_in; t.WT = WINT; t.gA = a.g1; t.gB = nullptr; t.K = DM; t.Nin = WIN_N; t.Nout = NPROJ; t.mode = 1; t.gsplit = DM; t.item = it; t.nbsh = -1; t.f8 = 0; }
            else { t.W = a.w_out; t.WT = WOUTT; t.gA = a.g_fox; t.gB = a.g_sb; t.K = DM; t.Nin = DM; t.Nout = DM; t.mode = 0; t.gsplit = GW; t.item = it - I_IN; t.nbsh = 5; t.f8 = 0; }
            tr_load<false>(t, lane, v); tr_store(t, lane, v, scr);
        }
        if (!OVERLAP_CVT) convert_experts(a.w1, a.w2, a.g2, W1T, W2T, gw, NGW, N_EXP_ITEMS, lane, scr);
        for (int i = gw * 64 + lane; i < DM * NE; i += NGW * 64) WR[i] = a.w_router[i] * a.g2[i >> 5];
        for (int row = gw; row < M; row += NGW) rms1_row(a.x, wf, a.b_f, XN, FLOG, row, lane);
    }
    xcd_barrier(bar); if (REP_PHASE == 8) xcd_barrier(bar);
    REPS(1) {
    if (vcu < NB * NH) cumsum_wg(FLOG, CUM, vcu, (LAS float*)(L + RING_OFF));
    if (OPT_GEMM) {
        if (OVERLAP_CVT && cvt_role) convert_experts(a.w1, a.w2, a.g2, W1T, W2T, cvt_first, 64 * NWAVES, CVT_SPLIT, lane, (LAS float*)(L + RING_OFF + wave * 8448));
        else {
        pg8::Gemm g{XN, WINT, DM}; pg8::StaticOrder S; if (OVERLAP_CVT) S.init(M, NPROJ, 192, (vcu & 31) * 8 + (vcu >> 5)); else S.init(M, NPROJ, G, bx); pg8::EpiProj E{PROJ};
        pg8::gemm_phase<pg8::EpiProj, pg8::StaticOrder, true, false>(L + RING_OFF, g, S, E);
        }
    } else { for (int it = gw; it < (M / 16) * (NPROJ / 64); it += NGW) nv_inproj(XN, WINT, PROJ, it, lane); }
    }
    xcd_barrier(bar); if (REP_PHASE == 8) xcd_barrier(bar);
    REPS(2) if (OPT_ATTN) {
        static_assert(attn_body::ATTN_LDS_BYTES <= RING_BYTES, "attention scratch inside the ring region");
        if (OVERLAP_CVT) {
            const int xl = vcu >> 5, l = vcu & 31;
            if (cvt_role) convert_experts(a.w1, a.w2, a.g2, W1T, W2T, CVT_SPLIT + cvt_first, 64 * NWAVES, N_EXP_ITEMS, lane, (LAS float*)(L + RING_OFF + wave * 8448));
            if (l < 24) attn_body::attn_phase<8>((char*)lds + RING_OFF, (const attn_body::bf16*)PROJ, CUM, (attn_body::bf16*)OMIX, SSQ, xl * 4 + l / 6, l % 6);
        } else attn_body::attn_phase8<8>((char*)lds + RING_OFF, (const attn_body::bf16*)PROJ, CUM, (attn_body::bf16*)OMIX, SSQ, vcu);
    } else {
        LAS unsigned char* wl = L + RING_OFF + wave * 16640;
        for (int u = gw; u < 4096; u += NGW) {
            const int i = u >> 11, idx = u & 2047, type = idx & 1, bh = (idx >> 1) & 31, j = (idx >> 6) & 31; const int qblk = (i == 0) ? j : 63 - j;
            if (type == 0) nv_attn<0>(PROJ, CUM, OMIX, SSQ, bh, qblk, lane, wl); else nv_attn<1>(PROJ, CUM, OMIX, SSQ, bh, qblk, lane, wl);
        }
    }
    xcd_barrier(bar); if (REP_PHASE == 8) xcd_barrier(bar);
    REPS(3) if (OPT_GEMM) {
        pg8::Gemm g{OMIX, WOUTT, DM}; pg8::StaticOrder S; S.init(M, DM, G, bx);
        LAS float* ratio = (LAS float*)(L + TAB_OFF); LAS float* rsb = (LAS float*)(L + TAB_OFF + 1024);
        pg8::Unit u0;
        if (S.next(0, u0) && tid < 256) { const float* sp = SSQ + (size_t)(u0.pm * 256 + tid) * 16; float sf = 0.f, s2 = 0.f;
#pragma unroll
            for (int h = 0; h < 8; ++h) { sf += sp[h]; s2 += sp[8 + h]; }
            const float rf = rsqrtf(sf * (1.f / GW) + EPS), rs = rsqrtf(s2 * (1.f / GW) + EPS); ratio[tid] = rf / rs; rsb[tid] = rs; }
        VM_WAIT(); LDS_WAIT(); __syncthreads();
        pg8::EpiWout E{a.x, a.out, X1B, ratio, rsb};
        pg8::gemm_phase<pg8::EpiWout, pg8::StaticOrder, false, false>(L + RING_OFF, g, S, E);
    } else { for (int it = gw; it < (M / 16) * (DM / 64); it += NGW) nv_wout(OMIX, WOUTT, SSQ, a.x, a.out, X1B, it, lane); }
    xcd_barrier(bar); if (REP_PHASE == 8) xcd_barrier(bar);
    if (REP_PHASE == 4) { for (int t64 = vcu; t64 < M / 64; t64 += G) router_wg(a.out, WR, a.b_router, (float*)H, (float*)H + M, (int*)Y, (int*)Y + NE * LIST_CAP, CNT + 64, t64 * 64, L + RING_OFF); }
    if (OPT_ROUTER) { for (int t64 = vcu; t64 < M / 64; t64 += G) router_wg(a.out, WR, a.b_router, RSTD2, RW, LIST, SLOTEP, CNT, t64 * 64, L + RING_OFF); }
    else { for (int it = gw; it < M / 2; it += NGW) nv_router(a.out, WR, a.b_router, RSTD2, RW, LIST, SLOTEP, CNT, it, lane); }
    xcd_barrier(bar); if (REP_PHASE == 8) xcd_barrier(bar);
    LAS int* tb = (LAS int*)(L + TB_OFF); LAS int* tbE = tb + 64; LAS int* tbC = tb + 128; LAS int* cntl = tb + 192; LAS int* udl = tb + 224; LAS int* tabA = (LAS int*)(L + TAB_OFF); LAS int* tabB = (LAS int*)(L + TAB2_OFF);
    REPS(5) if (OPT_GEMM) {
        const int nun = moe_prepare<8, true>(CNT, LIST, RSTD2, RW, a.b1, TBG, bx, L);
        pg8::Gemm g{X1B, W1T, MOE_F8 ? DM / 2 : DM}; pg8::EpiMoe1 E{H, tabA, (const LAS float*)tabB}; pg8::ListOrder SL{udl, nun, tabA};
        pg8::gemm_phase<pg8::EpiMoe1, pg8::ListOrder, true, true, MOE_F8>(L + RING_OFF, g, SL, E);
    } else {
    for (int g = gw; g < MAX_TILES * 16; g += NGW) {
        int e, base, p0, cnt; if (!moe_tile(CNT, g, e, base, p0, cnt)) continue;
        for (int cg = 0; cg < DFF / 32; ++cg) nv_moe1(X1B, W1T, a.b1, RSTD2, LIST, H, e, base, p0, cnt, cg, lane);
    } }
    xcd_barrier(bar); if (REP_PHASE == 8) xcd_barrier(bar);
    REPS(6) if (OPT_GEMM) {
        const int nun = moe_prepare<4, false>(CNT, LIST, RSTD2, RW, a.b2, TBG, bx, L);
        pg8::Gemm g{H, W2T, MOE_F8 ? DM / 2 : DM}; pg8::EpiMoe2 E{Y, (const LAS float*)tabA, (const LAS float*)tabB}; pg8::ListOrder SL{udl, nun, tabA};
        pg8::gemm_phase<pg8::EpiMoe2, pg8::ListOrder, true, false, MOE_F8>(L + RING_OFF, g, SL, E);
    } else {
    for (int g = gw; g < MAX_TILES * 16; g += NGW) {
        int e, base, p0, cnt; if (!moe_tile(CNT, g, e, base, p0, cnt)) continue;
        for (int cg = 0; cg < DM / 64; ++cg) nv_moe2(H, W2T, a.b2, RW, LIST, Y, e, base, p0, cnt, cg, lane);
    } }
    xcd_barrier(bar); if (REP_PHASE == 8) xcd_barrier(bar);
    if (REP_PHASE == 7) { for (int row = gw; row < M; row += NGW) final_row(a.out, Y, SLOTEP, TBG, a.gf, (float*)H, row, lane); }
    for (int row = gw; row < M; row += NGW) final_row(a.out, Y, SLOTEP, TBG, a.gf, a.out, row, lane);
}

extern "C" void kernel_launch(void* const* d_in, const int* in_sizes, int n_in, void* d_out, int out_size, void* d_ws, size_t ws_size, hipStream_t stream) {
    static int grid = 0;
    if (grid == 0) {
        if (n_in != 15 || in_sizes[0] != M * DM || out_size != M * DM || ws_size < WS_END) {
            fprintf(stderr, "kernel_launch: unexpected shapes / workspace (n_in %d, in0 %d, out %d, ws %zu, need %zu)\n", n_in, n_in > 0 ? in_sizes[0] : -1, out_size, ws_size, (size_t)WS_END); grid = -1; return; }
        int dev = 0, cus = 0, per_cu = 0;
        if (hipGetDevice(&dev) != hipSuccess || hipDeviceGetAttribute(&cus, hipDeviceAttributeMultiprocessorCount, dev) != hipSuccess) { grid = -1; return; }
        if (hipFuncSetAttribute((const void*)mega_fwd, hipFuncAttributeMaxDynamicSharedMemorySize, LDS_BYTES) != hipSuccess) { fprintf(stderr, "kernel_launch: hipFuncSetAttribute failed\n"); grid = -1; return; }
        if (hipOccupancyMaxActiveBlocksPerMultiprocessor(&per_cu, (const void*)mega_fwd, NTHREADS, LDS_BYTES) != hipSuccess || per_cu < 1) fprintf(stderr, "kernel_launch: occupancy query reports %d\n", per_cu);
        (void)hipGetLastError();
        grid = cus;
    }
    if (grid < 0) return;
    if (hipMemsetAsync((char*)d_ws + WS_CTL, 0, CTL_BYTES, stream) != hipSuccess) return;
    Args a{};
    a.x = (const float*)d_in[0]; a.g1 = (const float*)d_in[1]; a.w_in = (const float*)d_in[2]; a.b_f = (const float*)d_in[3]; a.g_fox = (const float*)d_in[4]; a.g_sb = (const float*)d_in[5];
    a.w_out = (const float*)d_in[6]; a.g2 = (const float*)d_in[7]; a.w_router = (const float*)d_in[8]; a.b_router = (const float*)d_in[9]; a.w1 = (const float*)d_in[10]; a.b1 = (const float*)d_in[11];
    a.w2 = (const float*)d_in[12]; a.b2 = (const float*)d_in[13]; a.gf = (const float*)d_in[14];
    a.out = (float*)d_out; a.ws = (unsigned char*)d_ws;
    hipLaunchKernelGGL(mega_fwd, dim3(grid), dim3(NTHREADS), LDS_BYTES, stream, a);
    const hipError_t le = hipPeekAtLastError();
    if (le != hipSuccess) fprintf(stderr, "kernel_launch: launch failed: %s\n", hipGetErrorName(le));
}
```

```cpp
#include <hip/hip_runtime.h>
#include <cstdio>
#include <cstdint>

typedef unsigned short bf16_t;
typedef short bf16x8 __attribute__((ext_vector_type(8)));
typedef float f32x4 __attribute__((ext_vector_type(4)));

constexpr int NB = 4, SEQ = 4096, DM = 1024, M = NB * SEQ;
constexpr int NH = 8, HD = 64, GW = 512;
constexpr int WIN_N = 3080, NPROJ = 3072;
constexpr int NE = 32, TOPK = 4, DFF = 1024;
constexpr float EPS = 1e-5f;
constexpr float LOG2E = 1.4426950408889634f;
constexpr float C2 = 0.125f * LOG2E;
constexpr int LIST_CAP = M;
constexpr int MAX_TILES = (M * TOPK) / 256 + NE;

constexpr size_t MiB = 1u << 20;
constexpr size_t WS_CTL = 0, CTL_BYTES = 1 * MiB;
constexpr size_t WS_WINT = 2 * MiB;
constexpr size_t WS_WOUTT = 8 * MiB;
constexpr size_t WS_WR = 10 * MiB;
constexpr size_t WS_CUM = 11 * MiB;
constexpr size_t WS_SSQ = 12 * MiB;
constexpr size_t WS_RSTD2 = 14 * MiB;
constexpr size_t WS_RW = 15 * MiB;
constexpr size_t WS_SLOTEP = 15 * MiB + 512 * 1024;
constexpr size_t WS_TBG = 14 * MiB + 512 * 1024;
constexpr size_t WS_LIST = 16 * MiB;
constexpr size_t WS_FLOG = 18 * MiB;
constexpr size_t WS_XN = 32 * MiB;
constexpr size_t WS_PROJ = 64 * MiB;
constexpr size_t WS_OMIX = 160 * MiB;
constexpr size_t WS_X1B = 192 * MiB;
constexpr size_t WS_W1T = 224 * MiB;
constexpr size_t WS_W2T = 352 * MiB;
constexpr size_t WS_H = 416 * MiB;
constexpr size_t WS_Y = 560 * MiB;
constexpr size_t WS_END = 704 * MiB;
constexpr int CW_CNT = 1024;
constexpr int CW_QHP = 2048, CW_KHP = 2112;

__device__ __forceinline__ unsigned short f2bf(float f) { unsigned u = __float_as_uint(f); return (unsigned short)((u + 0x7fffu + ((u >> 16) & 1u)) >> 16); }
__device__ __forceinline__ float bf2f(unsigned short b) { return __uint_as_float(((unsigned)b) << 16); }
__device__ __forceinline__ float wave_sum(float v) {
#pragma unroll
    for (int o = 1; o < 64; o <<= 1) v += __shfl_xor(v, o);
    return v;
}


#define LAS __attribute__((address_space(3)))
#define GAS __attribute__((address_space(1)))
typedef unsigned v4u __attribute__((ext_vector_type(4)));
#define LDS_WAIT() asm volatile("s_waitcnt lgkmcnt(0)" ::: "memory")
#define VM_WAIT() asm volatile("s_waitcnt vmcnt(0)" ::: "memory")
constexpr int NWAVES = 8, NTHREADS = NWAVES * 64;
constexpr int REP_PHASE = -1;
#define REPS(k) for (int rep_ = 0; rep_ < ((REP_PHASE == (k)) ? 2 : 1); ++rep_)
constexpr bool ATTN_SCHED = true;
constexpr bool FOX_SKIP = true;
constexpr bool WT_STORES = false;
constexpr bool Y_F8 = false;
constexpr bool MOE_F8 = true;
constexpr int NCVT = 10;
constexpr int CVT_SPLIT = 20 * 512;
constexpr bool OVERLAP_CVT = true;
constexpr bool OPT_GEMM = true;
constexpr bool OPT_ROUTER = true;
constexpr bool OPT_ATTN = true;

#define XB_TMO      128
#define XB_XCNT(j)  (256  + 64 * (j))
#define XB_XSUB(j)  (1280 + 64 * (j))
#define XB_XGEN(j)  (2304 + 64 * (j))
#define XB_TOP      3328
#define XB_TOPGEN   3392
#define XCD_BAR_WORDS 3456
#define XB_SPIN_CAP (1u << 20)
__device__ __forceinline__ unsigned xb_ld(unsigned* p)              { return __hip_atomic_load(p, __ATOMIC_RELAXED, __HIP_MEMORY_SCOPE_AGENT); }
__device__ __forceinline__ unsigned xb_add(unsigned* p, unsigned v) { return __hip_atomic_fetch_add(p, v, __ATOMIC_RELAXED, __HIP_MEMORY_SCOPE_AGENT); }
__device__ __forceinline__ unsigned xb_xcc_id() { return (unsigned)__builtin_amdgcn_s_getreg((3 << 11) | 20) & 0xFu; }
#define XB_SPIN(cond, bar) do { unsigned _sp = 0; while (cond) { __builtin_amdgcn_s_sleep(1); \
    if ((++_sp & 255u) == 0u) { if (xb_ld(&(bar)[XB_TMO])) break; if (_sp > XB_SPIN_CAP) { atomicAdd(&(bar)[XB_TMO], 1u); break; } } } } while (0)
struct XcdBarrier { unsigned* bar; unsigned x; volatile LAS unsigned* st; };
__device__ __forceinline__ XcdBarrier xcd_barrier_post(unsigned* bar, volatile LAS unsigned* st) {
    XcdBarrier b; b.bar = bar; b.x = xb_xcc_id(); b.st = st;
    if (threadIdx.x == 0) (void)xb_add(&bar[XB_XCNT(b.x)], 1u);
    return b;
}
__device__ __forceinline__ void xcd_barrier_complete(unsigned* bar, unsigned x, unsigned& nloc, unsigned& nx) {
    const unsigned G = gridDim.x * gridDim.y * gridDim.z;
    unsigned sum, cnt, mine, sp = 0u;
    for (;;) {
        sum = 0u; cnt = 0u; mine = 0u;
#pragma unroll
        for (unsigned j = 0; j < 16; ++j) { const unsigned c = xb_ld(&bar[XB_XCNT(j)]); sum += c; cnt += (c > 0u) ? 1u : 0u; mine = (j == x) ? c : mine; }
        if (sum == G) break;
        __builtin_amdgcn_s_sleep(1);
        if ((++sp & 255u) == 0u) { if (xb_ld(&bar[XB_TMO])) break; if (sp > XB_SPIN_CAP) { atomicAdd(&bar[XB_TMO], 1u); break; } }
    }
    nloc = mine > 0u ? mine : 1u; nx = cnt > 0u ? cnt : 1u;
}
__device__ __forceinline__ void xcd_barrier(const XcdBarrier& b) {
    asm volatile("s_waitcnt vmcnt(0)" ::: "memory");
    __syncthreads();
    if (threadIdx.x == 0) {
        unsigned* bar = b.bar;
        __builtin_amdgcn_s_waitcnt(0);
        unsigned nloc = b.st[0], nx = b.st[1];
        if (nloc == 0u) { xcd_barrier_complete(bar, b.x, nloc, nx); b.st[0] = nloc; b.st[1] = nx; }
        const unsigned old = xb_add(&bar[XB_XSUB(b.x)], 1u);
        const unsigned gen = old / nloc;
        if (old + 1u == (gen + 1u) * nloc) {
            __builtin_amdgcn_fence(__ATOMIC_RELEASE, "agent");
            asm volatile("s_waitcnt vmcnt(0)" ::: "memory");
            const unsigned og = xb_add(&bar[XB_TOP], 1u);
            const unsigned tg = og / nx;
            if (og + 1u == (tg + 1u) * nx) xb_add(&bar[XB_TOPGEN], 1u);
            else XB_SPIN(xb_ld(&bar[XB_TOPGEN]) == tg, bar);
            __builtin_amdgcn_fence(__ATOMIC_ACQUIRE, "agent");
            xb_add(&bar[XB_XGEN(b.x)], 1u);
            asm volatile("s_waitcnt vmcnt(0)" ::: "memory");
        } else {
            XB_SPIN(xb_ld(&bar[XB_XGEN(b.x)]) == gen, bar);
            __builtin_amdgcn_fence(__ATOMIC_ACQUIRE, "agent");
            asm volatile("s_waitcnt vmcnt(0)" ::: "memory");
        }
    }
    __syncthreads();
}

constexpr int RING_OFF = 0, RING_BYTES = 131072;
constexpr int TAB_OFF = 131072;
constexpr int TAB2_OFF = TAB_OFF + 10 * 1024, TB_OFF = TAB_OFF + 20 * 1024;
constexpr int LDSCTL_OFF = 152576, MISC_OFF = LDSCTL_OFF + 320;
constexpr int LDS_BYTES = 155648;
constexpr int CW_BAR = 4096;

struct Args {
    const float *x, *g1, *w_in, *b_f, *g_fox, *g_sb, *w_out, *g2, *w_router, *b_router, *w1, *b1, *w2, *b2, *gf;
    float* out; unsigned char* ws;
};

__device__ __forceinline__ int mapcol(int mode, int n) {
    if (mode == 1) return n < 1536 ? n : n + 8;
    if (mode == 2) { const int pn = n >> 8, j = n & 255; return j < 128 ? 128 * pn + j : 1024 + 128 * pn + (j - 128); }
    return n;
}
__device__ __forceinline__ unsigned pk4_fp8(float a, float b, float c, float d) {
    a = __builtin_amdgcn_fmed3f(a, -448.f, 448.f); b = __builtin_amdgcn_fmed3f(b, -448.f, 448.f); c = __builtin_amdgcn_fmed3f(c, -448.f, 448.f); d = __builtin_amdgcn_fmed3f(d, -448.f, 448.f);
    int w = __builtin_amdgcn_cvt_pk_fp8_f32(a, b, 0, false); w = __builtin_amdgcn_cvt_pk_fp8_f32(c, d, w, true); return (unsigned)w;
}
__device__ __forceinline__ unsigned pk2(float lo, float hi) { unsigned r; asm("v_cvt_pk_bf16_f32 %0, %1, %2" : "=v"(r) : "v"(lo), "v"(hi)); return r; }
struct TrItem { const float* W; bf16_t* WT; const float* gA; const float* gB; int K, Nin, Nout, mode, gsplit, item, nbsh, f8; };
template <bool NT> __device__ __forceinline__ void tr_load(const TrItem& t, int lane, f32x4 (&v)[8]) {
    const int nblk = t.Nout / 32, kb = t.nbsh >= 0 ? (t.item >> t.nbsh) : t.item / nblk, nb = t.nbsh >= 0 ? (t.item & (nblk - 1)) : t.item % nblk, k0 = 64 * kb, n0 = 32 * nb, l7 = lane & 7, kr = lane >> 3, col = mapcol(t.mode, n0 + 4 * l7);
#pragma unroll
    for (int i = 0; i < 8; ++i) { const f32x4* p = (const f32x4*)(t.W + (size_t)(k0 + 8 * i + kr) * t.Nin + col); v[i] = NT ? __builtin_nontemporal_load(p) : *p; }
}
__device__ __forceinline__ void tr_store(const TrItem& t, int lane, const f32x4 (&v)[8], LAS float* scr) {
    const int nblk = t.Nout / 32, kb = t.nbsh >= 0 ? (t.item >> t.nbsh) : t.item / nblk, nb = t.nbsh >= 0 ? (t.item & (nblk - 1)) : t.item % nblk, k0 = 64 * kb, n0 = 32 * nb, l7 = lane & 7, kr = lane >> 3;
#pragma unroll
    for (int i = 0; i < 8; ++i) { const int kk = 8 * i + kr, k = k0 + kk; const float gs = t.gA ? (k < t.gsplit ? t.gA[k] : t.gB[k - t.gsplit]) : 1.f;
        LAS float* sp = scr + kk * 33 + 4 * l7; sp[0] = v[i][0] * gs; sp[1] = v[i][1] * gs; sp[2] = v[i][2] * gs; sp[3] = v[i][3] * gs; }
    LDS_WAIT();
    if (t.f8) {
        const int c = lane & 3;
#pragma unroll
        for (int j = 0; j < 2; ++j) { const int n = (lane >> 2) + 16 * j; const LAS float* sp = scr + (16 * c) * 33 + n;
            v4u o; o.x = pk4_fp8(32.f * sp[0 * 33], 32.f * sp[1 * 33], 32.f * sp[2 * 33], 32.f * sp[3 * 33]); o.y = pk4_fp8(32.f * sp[4 * 33], 32.f * sp[5 * 33], 32.f * sp[6 * 33], 32.f * sp[7 * 33]);
            o.z = pk4_fp8(32.f * sp[8 * 33], 32.f * sp[9 * 33], 32.f * sp[10 * 33], 32.f * sp[11 * 33]); o.w = pk4_fp8(32.f * sp[12 * 33], 32.f * sp[13 * 33], 32.f * sp[14 * 33], 32.f * sp[15 * 33]);
            *(v4u*)((unsigned char*)t.WT + (size_t)(n0 + n) * t.K + k0 + 16 * c) = o; }
    } else {
    const int c = lane & 7;
#pragma unroll
    for (int j = 0; j < 4; ++j) { const int n = (lane >> 3) + 8 * j; const LAS float* sp = scr + (8 * c) * 33 + n;
        v4u o; o.x = pk2(sp[0 * 33], sp[1 * 33]); o.y = pk2(sp[2 * 33], sp[3 * 33]); o.z = pk2(sp[4 * 33], sp[5 * 33]); o.w = pk2(sp[6 * 33], sp[7 * 33]);
        *(v4u*)(t.WT + (size_t)(n0 + n) * t.K + k0 + 8 * c) = o; }
    }
    LDS_WAIT();
}
constexpr int I_W1 = (DM / 64) * (2048 / 32), I_W2 = (DM / 64) * (DM / 32), N_EXP_ITEMS = NE * (I_W1 + I_W2);
__device__ __forceinline__ TrItem expert_item(const float* w1, const float* w2, const float* g2, bf16_t* W1T, bf16_t* W2T, int r) {
    TrItem t;
    t.f8 = MOE_F8 ? 1 : 0;
    if (r < NE * I_W1) { const int e = r / I_W1; t.W = w1 + (size_t)e * DM * 2048; t.WT = MOE_F8 ? (bf16_t*)((unsigned char*)W1T + (size_t)e * 2048 * DM) : W1T + (size_t)e * 2048 * DM; t.gA = g2; t.gB = nullptr; t.K = DM; t.Nin = 2048; t.Nout = 2048; t.mode = 2; t.gsplit = DM; t.item = r % I_W1; t.nbsh = 6; }
    else { r -= NE * I_W1; const int e = r / I_W2; t.W = w2 + (size_t)e * DM * DM; t.WT = MOE_F8 ? (bf16_t*)((unsigned char*)W2T + (size_t)e * DM * DM) : W2T + (size_t)e * DM * DM; t.gA = nullptr; t.gB = nullptr; t.K = DM; t.Nin = DM; t.Nout = DM; t.mode = 0; t.gsplit = DM; t.item = r % I_W2; t.nbsh = 5; }
    return t;
}
__device__ __forceinline__ void convert_experts(const float* w1, const float* w2, const float* g2, bf16_t* W1T, bf16_t* W2T, int first, int stride, int N_END, int lane, LAS float* scr) {
    f32x4 v0[8], v1[8];
#define CVT_LOAD(v, idx) do { if ((idx) < N_END) { const TrItem t_ = expert_item(w1, w2, g2, W1T, W2T, (idx)); tr_load<true>(t_, lane, v); } } while (0)
#define CVT_STORE(v, idx) do { if ((idx) < N_END) { const TrItem t_ = expert_item(w1, w2, g2, W1T, W2T, (idx)); tr_store(t_, lane, v, scr); } } while (0)
    int it = first; asm volatile("" : "+v"(lane));
    CVT_LOAD(v0, it);
#pragma unroll 1
    for (; it < N_END; it += 2 * stride) {
        CVT_LOAD(v1, it + stride); CVT_STORE(v0, it);
        CVT_LOAD(v0, it + 2 * stride); CVT_STORE(v1, it + stride);
    }
#undef CVT_LOAD
#undef CVT_STORE
}

__device__ __forceinline__ float log_sigmoid(float v) { return fminf(v, 0.f) - log1pf(expf(-fabsf(v))); }
__device__ __forceinline__ void rms1_row(const float* __restrict__ x, const LAS float* wf  , const float* __restrict__ b_f,
                                         bf16_t* __restrict__ XN, float* __restrict__ FLOG, int row, int lane) {
    const float4* xr = (const float4*)(x + (size_t)row * DM);
    float4 v[4]; float ss = 0.f;
#pragma unroll
    for (int j = 0; j < 4; ++j) { v[j] = xr[lane + 64 * j]; ss += v[j].x * v[j].x + v[j].y * v[j].y + v[j].z * v[j].z + v[j].w * v[j].w; }
    ss = wave_sum(ss);
    const float rstd = rsqrtf(ss * (1.f / DM) + EPS);
    float f0 = 0.f, f1 = 0.f, f2 = 0.f, f3 = 0.f, f4 = 0.f, f5 = 0.f, f6 = 0.f, f7 = 0.f;
#pragma unroll
    for (int j = 0; j < 4; ++j) {
        const int c0 = 4 * (lane + 64 * j);
        uint2 o; o.x = pk2(v[j].x * rstd, v[j].y * rstd); o.y = pk2(v[j].z * rstd, v[j].w * rstd);
        *(uint2*)(XN + (size_t)row * DM + c0) = o;
        const float xs[4] = {v[j].x, v[j].y, v[j].z, v[j].w};
#pragma unroll
        for (int c = 0; c < 4; ++c) {
            const int k = c0 + c; const float xv = xs[c];
            const LAS f32x4* wp = (const LAS f32x4*)(wf + k * 8); const f32x4 w0 = wp[0], w1 = wp[1];
            f0 += xv * w0.x; f1 += xv * w0.y; f2 += xv * w0.z; f3 += xv * w0.w; f4 += xv * w1.x; f5 += xv * w1.y; f6 += xv * w1.z; f7 += xv * w1.w;
        }
    }
    f0 = wave_sum(f0); f1 = wave_sum(f1); f2 = wave_sum(f2); f3 = wave_sum(f3); f4 = wave_sum(f4); f5 = wave_sum(f5); f6 = wave_sum(f6); f7 = wave_sum(f7);
    if (lane < 8) {
        float f = f0; f = lane == 1 ? f1 : f; f = lane == 2 ? f2 : f; f = lane == 3 ? f3 : f; f = lane == 4 ? f4 : f; f = lane == 5 ? f5 : f; f = lane == 6 ? f6 : f; f = lane == 7 ? f7 : f;
        FLOG[(size_t)row * 8 + lane] = log_sigmoid(f * rstd + b_f[lane]);
    }
}
__device__ __forceinline__ void cumsum_wg(const float* __restrict__ FLOG, float* __restrict__ CUM, int bh, LAS float* part) {
    const int b = bh >> 3, h = bh & 7, t = threadIdx.x;
    float loc[8]; float s = 0.f;
#pragma unroll
    for (int i = 0; i < 8; ++i) { loc[i] = FLOG[((size_t)b * SEQ + t * 8 + i) * 8 + h]; s += loc[i]; }
    part[t] = s; __syncthreads();
    float run = 0.f; for (int i = 0; i < t; ++i) run += part[i];
#pragma unroll
    for (int i = 0; i < 8; ++i) { run += loc[i]; CUM[(size_t)bh * SEQ + t * 8 + i] = run * LOG2E; }
    __syncthreads();
}

template <int NT> __device__ __forceinline__ void wave_mma(f32x4 (&acc)[NT], const bf16_t* ap, const bf16_t* const (&bp)[NT], int K) {
    for (int k0 = 0; k0 < K; k0 += 32) {
        const bf16x8 a = *(const bf16x8*)(ap + k0);
#pragma unroll
        for (int t = 0; t < NT; ++t) { const bf16x8 b = *(const bf16x8*)(bp[t] + k0); acc[t] = __builtin_amdgcn_mfma_f32_16x16x32_bf16(a, b, acc[t], 0, 0, 0); }
    }
}
__device__ __forceinline__ void nv_inproj(const bf16_t* __restrict__ XN, const bf16_t* __restrict__ WINT, bf16_t* __restrict__ PROJ, int item, int lane) {
    const int n0 = (item % 48) * 64, m0 = (item / 48) * 16, r = lane & 15, q = lane >> 4;
    f32x4 acc[4];
#pragma unroll
    for (int t = 0; t < 4; ++t) acc[t] = (f32x4){0.f, 0.f, 0.f, 0.f};
    const bf16_t* ap = XN + (size_t)(m0 + r) * DM + 8 * q;
    const bf16_t* bp[4];
#pragma unroll
    for (int t = 0; t < 4; ++t) bp[t] = WINT + (size_t)(n0 + 16 * t + r) * DM + 8 * q;
    wave_mma<4>(acc, ap, bp, DM);
    const float sc = (n0 < 512 || (n0 >= 1536 && n0 < 2048)) ? C2 : 1.f;
#pragma unroll
    for (int t = 0; t < 4; ++t)
#pragma unroll
        for (int j = 0; j < 4; ++j) PROJ[(size_t)(m0 + 4 * q + j) * NPROJ + n0 + 16 * t + r] = f2bf(acc[t][j] * sc);
}

template <int TYPE> __device__ __forceinline__ void nv_attn(const bf16_t* __restrict__ PROJ, const float* __restrict__ CUM, bf16_t* __restrict__ OMIX, float* __restrict__ SSQ,
                                                          int bh, int qblk, int lane, LAS unsigned char* wl) {
    LAS bf16_t* Ks = (LAS bf16_t*)wl; LAS bf16_t* Vs = (LAS bf16_t*)(wl + 8192); LAS float* Cs = (LAS float*)(wl + 16384);
    const int b = bh >> 3, h = bh & 7, t = qblk * 64 + lane;
    const size_t row = (size_t)b * SEQ + t;
    const int qcol = (TYPE == 0 ? 0 : 1536) + h * HD, kcol = qcol + 512, vcol = qcol + 1024;
    float q[64], o[64];
#pragma unroll
    for (int c = 0; c < 8; ++c) { const bf16x8 v = *(const bf16x8*)(PROJ + row * NPROJ + qcol + 8 * c);
#pragma unroll
        for (int j = 0; j < 8; ++j) q[8 * c + j] = bf2f((unsigned short)v[j]); }
#pragma unroll
    for (int d = 0; d < 64; ++d) o[d] = 0.f;
    float m = -INFINITY, l = 0.f, R = 1.f;
    const float cq = CUM[(size_t)bh * SEQ + t];
    for (int it = 0; it <= qblk; ++it) {
        const int kt = (TYPE == 0) ? it : qblk - it;
        LDS_WAIT();
        for (int i = 0; i < 64; ++i) { const size_t kr = ((size_t)b * SEQ + kt * 64 + i) * NPROJ; Ks[i * 64 + lane] = PROJ[kr + kcol + lane]; Vs[i * 64 + lane] = PROJ[kr + vcol + lane]; }
        Cs[lane] = CUM[(size_t)bh * SEQ + kt * 64 + lane];
        LDS_WAIT();
        for (int ss = 0; ss < 64; ++ss) {
            const int s = (TYPE == 0) ? ss : 63 - ss; const int ks = kt * 64 + s;
            float dot = 0.f;
#pragma unroll
            for (int d = 0; d < 64; d += 8) { const bf16x8 kv = *(const LAS bf16x8*)&Ks[s * 64 + d];
#pragma unroll
                for (int j = 0; j < 8; ++j) dot += q[d + j] * bf2f((unsigned short)kv[j]); }
            if (TYPE == 0) {
                if (ks <= t) {
                    const float xv = dot + cq - Cs[s]; const float mn = fmaxf(m, xv); const float sc = exp2f(m - mn), p = exp2f(xv - mn);
                    l = l * sc + p; m = mn;
#pragma unroll
                    for (int d = 0; d < 64; d += 8) { const bf16x8 vv = *(const LAS bf16x8*)&Vs[s * 64 + d];
#pragma unroll
                        for (int j = 0; j < 8; ++j) o[d + j] = o[d + j] * sc + p * bf2f((unsigned short)vv[j]); }
                }
            } else {
                if (ks < t) {
                    const float z = fminf(fmaxf(dot, -80.f), 80.f); const float e = exp2f(z); const float rr = 1.f / (1.f + e); const float a = e * rr * R; R *= rr;
#pragma unroll
                    for (int d = 0; d < 64; d += 8) { const bf16x8 vv = *(const LAS bf16x8*)&Vs[s * 64 + d];
#pragma unroll
                        for (int j = 0; j < 8; ++j) o[d + j] += a * bf2f((unsigned short)vv[j]); }
                }
            }
        }
    }
    const float inv = (TYPE == 0) ? 1.f / l : 1.f;
    float ssq = 0.f;
#pragma unroll
    for (int d = 0; d < 64; ++d) { o[d] *= inv; ssq += o[d] * o[d]; }
    SSQ[row * 16 + TYPE * 8 + h] = ssq;
#pragma unroll
    for (int c = 0; c < 8; ++c) { bf16x8 v;
#pragma unroll
        for (int j = 0; j < 8; ++j) v[j] = (short)f2bf(o[8 * c + j]);
        *(bf16x8*)(OMIX + row * DM + TYPE * GW + h * HD + 8 * c) = v; }
}

__device__ __forceinline__ void nv_wout(const bf16_t* __restrict__ OMIX, const bf16_t* __restrict__ WOUTT, const float* __restrict__ SSQ, const float* __restrict__ x,
                                        float* __restrict__ X1, bf16_t* __restrict__ X1B, int item, int lane) {
    const int n0 = (item & 15) * 64, m0 = (item >> 4) * 16, r = lane & 15, q = lane >> 4;
    f32x4 af[4], as[4];
#pragma unroll
    for (int t = 0; t < 4; ++t) { af[t] = (f32x4){0.f, 0.f, 0.f, 0.f}; as[t] = (f32x4){0.f, 0.f, 0.f, 0.f}; }
    const bf16_t* ap = OMIX + (size_t)(m0 + r) * DM + 8 * q;
    const bf16_t* bp[4]; const bf16_t* bp2[4];
#pragma unroll
    for (int t = 0; t < 4; ++t) { bp[t] = WOUTT + (size_t)(n0 + 16 * t + r) * DM + 8 * q; bp2[t] = bp[t] + GW; }
    wave_mma<4>(af, ap, bp, GW);
    wave_mma<4>(as, ap + GW, bp2, GW);
#pragma unroll
    for (int j = 0; j < 4; ++j) {
        const size_t row = m0 + 4 * q + j; const float* sp = SSQ + row * 16;
        float sf = 0.f, s2 = 0.f;
#pragma unroll
        for (int h = 0; h < 8; ++h) { sf += sp[h]; s2 += sp[8 + h]; }
        const float rf = rsqrtf(sf * (1.f / GW) + EPS), rs = rsqrtf(s2 * (1.f / GW) + EPS);
#pragma unroll
        for (int t = 0; t < 4; ++t) { const size_t idx = row * DM + n0 + 16 * t + r; const float v = x[idx] + rf * af[t][j] + rs * as[t][j]; X1[idx] = v; X1B[idx] = f2bf(v); }
    }
}

__device__ __forceinline__ void nv_router(const float* __restrict__ X1, const float* __restrict__ WR, const float* __restrict__ b_router, float* __restrict__ RSTD2,
                                          float* __restrict__ RW, int* __restrict__ LIST, int* __restrict__ SLOTEP, unsigned* __restrict__ CNT, int item, int lane) {
    const int e = lane & 31, tok = item * 2 + (lane >> 5);
    const float* xr = X1 + (size_t)tok * DM;
    float acc = 0.f, ss = 0.f;
    for (int k = 0; k < DM; ++k) { const float xv = xr[k]; acc += xv * WR[k * NE + e]; ss += xv * xv; }
    const float rstd = rsqrtf(ss * (1.f / DM) + EPS);
    float logit = acc * rstd + b_router[e];
    if (e == 0) RSTD2[tok] = rstd;
    float tv[4]; int ti[4];
#pragma unroll
    for (int k = 0; k < 4; ++k) {
        float bv = logit; int bi = e;
#pragma unroll
        for (int o = 1; o < 32; o <<= 1) { const float ov = __shfl_xor(bv, o); const int oi = __shfl_xor(bi, o); if (ov > bv || (ov == bv && oi < bi)) { bv = ov; bi = oi; } }
        tv[k] = bv; ti[k] = bi; if (e == bi) logit = -INFINITY;
    }
    const float e0 = 1.f, e1 = expf(tv[1] - tv[0]), e2 = expf(tv[2] - tv[0]), e3 = expf(tv[3] - tv[0]); const float inv = 1.f / (e0 + e1 + e2 + e3);
    const float w0 = e0 * inv, w1 = e1 * inv, w2 = e2 * inv, w3 = e3 * inv;
    int myk = -1; float myw = 0.f;
    if (e == ti[0]) { myk = 0; myw = w0; } if (e == ti[1]) { myk = 1; myw = w1; } if (e == ti[2]) { myk = 2; myw = w2; } if (e == ti[3]) { myk = 3; myw = w3; }
    if (myk >= 0) { const int slot = tok * 4 + myk; const unsigned pos = atomicAdd(&CNT[e], 1u); LIST[(size_t)e * LIST_CAP + pos] = slot; RW[slot] = myw; SLOTEP[slot] = e * 16384 + (int)pos; }
}


typedef float f32x16 __attribute__((ext_vector_type(16)));
__device__ __forceinline__ void router_wg(const float* __restrict__ X1, const float* __restrict__ WR, const float* __restrict__ b_router, float* __restrict__ RSTD2,
                                          float* __restrict__ RW, int* __restrict__ LIST, int* __restrict__ SLOTEP, unsigned* __restrict__ CNT, int tokbase, LAS unsigned char* L) {
    int tid_ = threadIdx.x; asm volatile("" : "+v"(tid_));
    const int tid = tid_, lane = tid & 63, wave = __builtin_amdgcn_readfirstlane(tid >> 6), kq = wave & 3, tile = wave >> 2, r32 = lane & 31, hi = lane >> 5;
    LAS float* Dx = (LAS float*)L; LAS float* SSx = (LAS float*)(L + 32768); LAS unsigned* lcnt = (LAS unsigned*)(L + 33792); LAS unsigned* lbase = (LAS unsigned*)(L + 33920);
    if (tid < NE) lcnt[tid] = 0u;
    const int tok = tokbase + tile * 32 + r32;
    const float* xp = X1 + (size_t)tok * DM + kq * 256 + 4 * hi;
    const float* wp = WR + (size_t)(kq * 256 + 4 * hi) * NE + r32;
    f32x16 acc;
#pragma unroll
    for (int r = 0; r < 16; ++r) acc[r] = 0.f;
    float ss = 0.f;
#pragma unroll 1
    for (int mc = 0; mc < 4; ++mc) {
        float4 xv[8];
#pragma unroll
        for (int m = 0; m < 8; ++m) xv[m] = *(const float4*)(xp + (mc * 8 + m) * 8);
#pragma unroll
        for (int m = 0; m < 8; ++m) {
            const float* w4 = wp + (size_t)((mc * 8 + m) * 8) * NE;
            const float w0 = w4[0], w1 = w4[NE], w2 = w4[2 * NE], w3 = w4[3 * NE];
            acc = __builtin_amdgcn_mfma_f32_32x32x2f32(w0, xv[m].x, acc, 0, 0, 0);
            acc = __builtin_amdgcn_mfma_f32_32x32x2f32(w1, xv[m].y, acc, 0, 0, 0);
            acc = __builtin_amdgcn_mfma_f32_32x32x2f32(w2, xv[m].z, acc, 0, 0, 0);
            acc = __builtin_amdgcn_mfma_f32_32x32x2f32(w3, xv[m].w, acc, 0, 0, 0);
            ss += xv[m].x * xv[m].x + xv[m].y * xv[m].y + xv[m].z * xv[m].z + xv[m].w * xv[m].w;
        }
    }
    { auto rr = __builtin_amdgcn_permlane32_swap(__float_as_uint(ss), __float_as_uint(ss), false, false); ss = __uint_as_float(rr[0]) + __uint_as_float(rr[1]); }
#pragma unroll
    for (int r = 0; r < 16; ++r) Dx[(wave * 16 + r) * 64 + lane] = acc[r];
    if (hi == 0) SSx[wave * 32 + r32] = ss;
    LDS_WAIT(); __syncthreads();
    int ea = 0, eb = 0; float wa = 0.f, wb = 0.f; unsigned la = 0u, lb = 0u;
    if (kq == 0) {
        float v[16]; float sst = 0.f;
#pragma unroll
        for (int w = 0; w < 4; ++w) sst += SSx[(tile * 4 + w) * 32 + r32];
        const float rstd = rsqrtf(sst * (1.f / DM) + EPS);
#pragma unroll
        for (int r = 0; r < 16; ++r) { float a = 0.f;
#pragma unroll
            for (int w = 0; w < 4; ++w) a += Dx[((tile * 4 + w) * 16 + r) * 64 + lane];
            v[r] = a * rstd + b_router[(r & 3) + 8 * (r >> 2) + 4 * hi]; }
        if (hi == 0) RSTD2[tok] = rstd;
        float tv[4]; int te[4];
#pragma unroll
        for (int k = 0; k < 4; ++k) {
            float bv = v[0]; int br = 0;
#pragma unroll
            for (int r = 1; r < 16; ++r) if (v[r] > bv) { bv = v[r]; br = r; }
            const int be = (br & 3) + 8 * (br >> 2) + 4 * hi;
            auto r1 = __builtin_amdgcn_permlane32_swap(__float_as_uint(bv), __float_as_uint(bv), false, false);
            auto r2 = __builtin_amdgcn_permlane32_swap((unsigned)be, (unsigned)be, false, false);
            const float pv = __uint_as_float(hi ? r1[0] : r1[1]); const int pe = (int)(hi ? r2[0] : r2[1]);
            const bool mine = (bv > pv) || (bv == pv && be < pe);
            tv[k] = mine ? bv : pv; te[k] = mine ? be : pe;
#pragma unroll
            for (int r = 0; r < 16; ++r) v[r] = (mine && r == br) ? -INFINITY : v[r];
        }
        const float e1 = expf(tv[1] - tv[0]), e2 = expf(tv[2] - tv[0]), e3 = expf(tv[3] - tv[0]); const float inv = 1.f / (1.f + e1 + e2 + e3);
        ea = hi ? te[2] : te[0]; eb = hi ? te[3] : te[1]; wa = (hi ? e2 : 1.f) * inv; wb = (hi ? e3 : e1) * inv;
        la = atomicAdd((unsigned*)&lcnt[ea], 1u); lb = atomicAdd((unsigned*)&lcnt[eb], 1u);
    }
    LDS_WAIT(); __syncthreads();
    if (tid < NE) { const unsigned c = lcnt[tid]; lbase[tid] = c ? atomicAdd(&CNT[tid], c) : 0u; }
    LDS_WAIT(); __syncthreads();
    if (kq == 0) {
        const int sa = tok * 4 + 2 * hi, sb = sa + 1;
        const int pa = (int)(lbase[ea] + la), pb = (int)(lbase[eb] + lb);
        LIST[(size_t)ea * LIST_CAP + pa] = sa; RW[sa] = wa; SLOTEP[sa] = ea * 16384 + pa;
        LIST[(size_t)eb * LIST_CAP + pb] = sb; RW[sb] = wb; SLOTEP[sb] = eb * 16384 + pb;
    }
    LDS_WAIT(); __syncthreads();
}

__device__ __forceinline__ bool moe_tile(const unsigned* CNT, int g, int& e, int& base, int& p0, int& cnt) {
    const int tile256 = g >> 4; base = 0;
    for (e = 0; e < NE; ++e) { const int nt = ((int)CNT[e] + 255) >> 8; if (tile256 < base + nt) break; base += nt; }
    if (e == NE) return false;
    cnt = (int)CNT[e]; p0 = (g - base * 16) * 16; return p0 < cnt;
}
__device__ __forceinline__ void nv_moe1(const bf16_t* __restrict__ X1B, const bf16_t* __restrict__ W1T, const float* __restrict__ b1, const float* __restrict__ RSTD2,
                                        const int* __restrict__ LIST, bf16_t* __restrict__ H, int e, int base, int p0, int cnt, int cg, int lane) {
    const int r = lane & 15, q = lane >> 4, c0 = cg * 32, pn = c0 >> 7, j0 = c0 & 127;
    const int* lst = LIST + (size_t)e * LIST_CAP;
    const int prow = p0 + r; const int tok = lst[prow < cnt ? prow : cnt - 1] >> 2;
    f32x4 acc[4];
#pragma unroll
    for (int t = 0; t < 4; ++t) acc[t] = (f32x4){0.f, 0.f, 0.f, 0.f};
    const bf16_t* ap = X1B + (size_t)tok * DM + 8 * q;
    const bf16_t* wb = W1T + (size_t)e * 2048 * DM + (size_t)(256 * pn + j0 + r) * DM + 8 * q;
    const bf16_t* bp[4] = {wb, wb + 16 * DM, wb + 128 * DM, wb + 144 * DM};
    wave_mma<4>(acc, ap, bp, DM);
#pragma unroll
    for (int j = 0; j < 4; ++j) {
        const int pr = p0 + 4 * q + j; if (pr >= cnt) continue;
        const float rs = RSTD2[lst[pr] >> 2];
#pragma unroll
        for (int t = 0; t < 2; ++t) {
            const int col = c0 + 16 * t + r;
            float glu = acc[t][j] * rs + b1[(size_t)e * 2048 + col], lin = acc[t + 2][j] * rs + b1[(size_t)e * 2048 + 1024 + col];
            glu = fminf(glu, 7.f); lin = fminf(fmaxf(lin, -7.f), 7.f);
            const float act = glu * (1.f / (1.f + expf(-1.702f * glu))) * (lin + 1.f);
            H[((size_t)base * 256 + pr) * DM + col] = f2bf(act);
        }
    }
}
__device__ __forceinline__ void nv_moe2(const bf16_t* __restrict__ H, const bf16_t* __restrict__ W2T, const float* __restrict__ b2, const float* __restrict__ RW,
                                        const int* __restrict__ LIST, bf16_t* __restrict__ Y, int e, int base, int p0, int cnt, int cg, int lane) {
    const int r = lane & 15, q = lane >> 4, n0 = cg * 64;
    const int* lst = LIST + (size_t)e * LIST_CAP;
    f32x4 acc[4];
#pragma unroll
    for (int t = 0; t < 4; ++t) acc[t] = (f32x4){0.f, 0.f, 0.f, 0.f};
    const bf16_t* ap = H + ((size_t)base * 256 + p0 + r) * DM + 8 * q;
    const bf16_t* bp[4];
#pragma unroll
    for (int t = 0; t < 4; ++t) bp[t] = W2T + (size_t)e * DM * DM + (size_t)(n0 + 16 * t + r) * DM + 8 * q;
    wave_mma<4>(acc, ap, bp, DM);
#pragma unroll
    for (int j = 0; j < 4; ++j) {
        const int pr = p0 + 4 * q + j; if (pr >= cnt) continue;
        const int slot = lst[pr]; const float w = RW[slot];
#pragma unroll
        for (int t = 0; t < 4; ++t) { const int col = n0 + 16 * t + r; Y[((size_t)base * 256 + pr) * DM + col] = f2bf((acc[t][j] + b2[(size_t)e * DM + col]) * w); }
    }
}

__device__ __forceinline__ void final_row(const float* X1, const bf16_t* __restrict__ Y, const int* __restrict__ SLOTEP, const int* __restrict__ TBG, const float* __restrict__ gf, float* out, int row, int lane) {
    int yr[4];
#pragma unroll
    for (int k = 0; k < 4; ++k) { const int ep = SLOTEP[row * 4 + k]; yr[k] = TBG[ep >> 14] * 256 + (ep & 16383); }
    float ss = 0.f;
    if (Y_F8) {
        const int c0 = 16 * lane; f32x4 v[4];
#pragma unroll
        for (int j = 0; j < 4; ++j) v[j] = *(const f32x4*)(X1 + (size_t)row * DM + c0 + 4 * j);
#pragma unroll
        for (int k = 0; k < 4; ++k) { const v4u y = *(const v4u*)((const unsigned char*)Y + (size_t)yr[k] * DM + c0);
#pragma unroll
            for (int j = 0; j < 4; ++j) { const auto lo = __builtin_amdgcn_cvt_pk_f32_fp8((int)y[j], false), hi = __builtin_amdgcn_cvt_pk_f32_fp8((int)y[j], true);
                v[j][0] += lo[0] * 0.0625f; v[j][1] += lo[1] * 0.0625f; v[j][2] += hi[0] * 0.0625f; v[j][3] += hi[1] * 0.0625f; } }
#pragma unroll
        for (int j = 0; j < 4; ++j) ss += v[j][0] * v[j][0] + v[j][1] * v[j][1] + v[j][2] * v[j][2] + v[j][3] * v[j][3];
        ss = wave_sum(ss);
        const float rstd = rsqrtf(ss * (1.f / DM) + EPS);
#pragma unroll
        for (int j = 0; j < 4; ++j) { const f32x4 g = *(const f32x4*)(gf + c0 + 4 * j); *(f32x4*)(out + (size_t)row * DM + c0 + 4 * j) = v[j] * rstd * g; }
        return;
    }
    float4 v[4];
#pragma unroll
    for (int j = 0; j < 4; ++j) {
        const int c0 = 4 * (lane + 64 * j);
        v[j] = *(const float4*)(X1 + (size_t)row * DM + c0);
#pragma unroll
        for (int k = 0; k < 4; ++k) { const uint2 y = *(const uint2*)(Y + (size_t)yr[k] * DM + c0);
            v[j].x += bf2f((unsigned short)(y.x & 0xffff)); v[j].y += bf2f((unsigned short)(y.x >> 16)); v[j].z += bf2f((unsigned short)(y.y & 0xffff)); v[j].w += bf2f((unsigned short)(y.y >> 16)); }
        ss += v[j].x * v[j].x + v[j].y * v[j].y + v[j].z * v[j].z + v[j].w * v[j].w;
    }
    ss = wave_sum(ss);
    const float rstd = rsqrtf(ss * (1.f / DM) + EPS);
#pragma unroll
    for (int j = 0; j < 4; ++j) { const int c0 = 4 * (lane + 64 * j); const float4 g = *(const float4*)(gf + c0);
        float4 o; o.x = v[j].x * rstd * g.x; o.y = v[j].y * rstd * g.y; o.z = v[j].z * rstd * g.z; o.w = v[j].w * rstd * g.w; *(float4*)(out + (size_t)row * DM + c0) = o; }
}


namespace pg8 {
#define PG8_LAS __attribute__((address_space(3)))
typedef unsigned u32x4 __attribute__((ext_vector_type(4)));
typedef unsigned u32x2 __attribute__((ext_vector_type(2)));
typedef int i32x8 __attribute__((ext_vector_type(8)));
constexpr int BM = 256, BK = 64, HALF = 128, HTB = HALF * BK * 2  , STAGE_BYTES = 8 * HTB, NXCD = 8, WGM = 8;
__host__ __device__ __forceinline__ int lds_byte(int r, int c) { const int st = (r >> 4) * 2 + (c >> 5), rr = r & 15, cc = c & 31, ob = rr * 64 + cc * 2; return st * 1024 + (ob ^ (((ob >> 9) & 1) << 5)); }
__host__ __device__ __forceinline__ void stage_rc(int b, int& R, int& C) { const int st = b / 1024, sb = b % 1024, swz = sb ^ (((sb >> 9) & 1) << 5); R = (st >> 1) * 16 + swz / 64; C = (st & 1) * 32 + (swz % 64) / 2; }
__host__ __device__ __forceinline__ int perm32(int rho) { const int n = rho >> 4, i = rho & 15; return 8 * (i >> 2) + 4 * n + (i & 3); }
struct Unit { int pm, pn, nr; };
struct Gemm { const bf16_t* A; const bf16_t* Bt; int K; };
__device__ __forceinline__ void st16_wt(void* p, u32x4 v) { if (WT_STORES) asm volatile("global_store_dwordx4 %0, %1, off sc0 sc1\n\ts_nop 1" :: "v"(p), "v"(v) : "memory"); else *(u32x4*)p = v; }
__device__ __forceinline__ void st8_wt(void* p, u32x2 v) { if (WT_STORES) asm volatile("global_store_dwordx2 %0, %1, off sc0 sc1\n\ts_nop 1" :: "v"(p), "v"(v) : "memory"); else *(u32x2*)p = v; }
struct StaticOrder {
    int nM, nN, nwg, G, c;
    __device__ void init(int M_, int N_, int G_, int c_) { nM = M_ / BM; nN = N_ / BM; nwg = nM * nN; G = G_; c = c_; }
    __device__ bool next(int i, Unit& u) const {
        const long L = (long)i * G + c; if (L >= nwg) return false;
        int wgid = (int)L; { const int q = nwg / NXCD, r = nwg % NXCD, xcd = wgid % NXCD, off = wgid / NXCD; wgid = (xcd < r ? xcd * (q + 1) : r * (q + 1) + (xcd - r) * q) + off; }
        const int nig = WGM * nN, gid = wgid / nig, fm = gid * WGM, gsz = (nM - fm) < WGM ? (nM - fm) : WGM;
        u.pm = fm + ((wgid % nig) % gsz); u.pn = (wgid % nig) / gsz; u.nr = BM; return true;
    }
    __device__ __forceinline__ const PG8_LAS int* rowtab(int) const { return nullptr; }
};
__device__ __forceinline__ unsigned cvt_pk_bf16(float lo, float hi) { unsigned r; asm volatile("v_cvt_pk_bf16_f32 %0, %1, %2" : "=v"(r) : "v"(lo), "v"(hi)); return r; }

template <class Sched> __device__ __forceinline__ void gather_voffs(const Sched& S, int ui, int tid, int K, unsigned (&o0)[2], unsigned (&o1)[2]) {
    const PG8_LAS int* tab = S.rowtab(ui);
#pragma unroll
    for (int i = 0; i < 2; ++i) { int R, C; stage_rc(tid * 16 + i * 8192, R, C); o0[i] = (unsigned)((tab[R] & 0xffff) * K + C) * 2u; o1[i] = (unsigned)((tab[HALF + R] & 0xffff) * K + C) * 2u; }
}

template <class Epi, class Sched, bool ALIGN_EPI, bool GATHER, bool F8 = false>
__device__ __forceinline__ void gemm_phase(PG8_LAS unsigned char* lds, const Gemm g, const Sched& S, const Epi& E) {
    int tid_ = threadIdx.x; asm volatile("" : "+v"(tid_));
    const int tid = tid_, wid = __builtin_amdgcn_readfirstlane(tid >> 6), lane = tid & 63, wr = wid >> 2, wc = wid & 3, fr = lane & 15, fq = lane >> 4;
    const int K = g.K, nt = K / BK;
    unsigned vA0[2], vA1[2], wA0[2], wA1[2], voffB[2];
    const size_t kstep = (size_t)(BK * 2);
    const size_t hstep = (size_t)HALF * K * 2;
    const size_t tstep = 2 * hstep;
#pragma unroll
    for (int i = 0; i < 2; ++i) { int R, C; stage_rc(tid * 16 + i * 8192, R, C); const int Rb = Epi::PERM ? ((R & ~31) + perm32(R & 31)) : R;
        vA0[i] = (unsigned)(R * K + C) * 2u; vA1[i] = vA0[i] + (unsigned)hstep; voffB[i] = (unsigned)(Rb * K + C) * 2u; wA0[i] = vA0[i]; wA1[i] = vA1[i]; }
    const unsigned ldsw = (unsigned)wid * 1024u;
    const int aoff = lds_byte(wr * 64 + fr, fq * 8), boff = lds_byte(wc * 32 + fr, fq * 8);
    const int a8o0 = lds_byte(wr * 64 + fr, fq * 16), a8o1 = lds_byte(wr * 64 + fr, fq * 16 + 8), b8o0 = lds_byte(wc * 32 + fr, fq * 16), b8o1 = lds_byte(wc * 32 + fr, fq * 16 + 8);
#define PG8_SA(b, h) (((b) * 2 + (h)) * HTB)
#define PG8_SB(b, h) ((4 + (b) * 2 + (h)) * HTB)
#define PG8_STAGE(bufoff, gbase, voff) do { _Pragma("unroll") for (int _i = 0; _i < 2; ++_i) \
        __builtin_amdgcn_global_load_lds((const unsigned*)((const char*)(gbase) + (voff)[_i]), (PG8_LAS unsigned*)(lds + (bufoff) + ldsw + _i * 8192), 16, 0, 0); } while (0)
#define PG8_LDA_BF(dst, b, h) do { _Pragma("unroll") for (int m = 0; m < 4; ++m) _Pragma("unroll") for (int k = 0; k < 2; ++k) dst[m][k] = *(const PG8_LAS bf16x8*)(lds + PG8_SA(b, h) + aoff + m * 2048 + k * 1024); } while (0)
#define PG8_LDB_BF(dst, b, h) do { _Pragma("unroll") for (int n = 0; n < 2; ++n) _Pragma("unroll") for (int k = 0; k < 2; ++k) dst[n][k] = *(const PG8_LAS bf16x8*)(lds + PG8_SB(b, h) + boff + n * 2048 + k * 1024); } while (0)
#define PG8_MMA_BF(ai, bj, At, Bt) do { if (cur.nr > 128 * (ai) + 64 * wr) { __builtin_amdgcn_s_setprio(1); _Pragma("unroll") for (int m = 0; m < 4; ++m) _Pragma("unroll") for (int n = 0; n < 2; ++n) _Pragma("unroll") for (int k = 0; k < 2; ++k) \
        acc[ai][bj][m][n] = __builtin_amdgcn_mfma_f32_16x16x32_bf16(Bt[n][k], At[m][k], acc[ai][bj][m][n], 0, 0, 0); __builtin_amdgcn_s_setprio(0); } } while (0)
#define PG8_LD8(dst, i_, base_, o0_, o1_) do { const u32x4 lo_ = *(const PG8_LAS u32x4*)(lds + (base_) + (o0_) + (i_) * 2048), hi_ = *(const PG8_LAS u32x4*)(lds + (base_) + (o1_) + (i_) * 2048); \
        dst[i_] = (i32x8){(int)lo_.x, (int)lo_.y, (int)lo_.z, (int)lo_.w, (int)hi_.x, (int)hi_.y, (int)hi_.z, (int)hi_.w}; } while (0)
#define PG8_LDA_F8(dst, b, h) do { _Pragma("unroll") for (int m = 0; m < 4; ++m) PG8_LD8(dst, m, PG8_SA(b, h), a8o0, a8o1); } while (0)
#define PG8_LDB_F8(dst, b, h) do { _Pragma("unroll") for (int n = 0; n < 2; ++n) PG8_LD8(dst, n, PG8_SB(b, h), b8o0, b8o1); } while (0)
#define PG8_MMA_F8(ai, bj, At, Bt) do { if (cur.nr > 128 * (ai) + 64 * wr) { __builtin_amdgcn_s_setprio(1); _Pragma("unroll") for (int m = 0; m < 4; ++m) _Pragma("unroll") for (int n = 0; n < 2; ++n) \
        acc[ai][bj][m][n] = __builtin_amdgcn_mfma_scale_f32_16x16x128_f8f6f4(Bt[n], At[m], acc[ai][bj][m][n], 0, 0, 0, 0x7A7A7A7A  , 0, 0x7F7F7F7F  ); __builtin_amdgcn_s_setprio(0); } } while (0)
#define PG8_LDA(dst, b, h) do { if constexpr (F8) { PG8_LDA_F8(dst##8, b, h); } else { PG8_LDA_BF(dst, b, h); } } while (0)
#define PG8_LDB(dst, b, h) do { if constexpr (F8) { PG8_LDB_F8(dst##8, b, h); } else { PG8_LDB_BF(dst, b, h); } } while (0)
#define PG8_MMA(ai, bj, At, Bt) do { if constexpr (F8) { PG8_MMA_F8(ai, bj, At##8, Bt##8); } else { PG8_MMA_BF(ai, bj, At, Bt); } } while (0)
#define PG8_WAIT_V(n) asm volatile("s_waitcnt vmcnt(" #n ")" ::: "memory")
#define PG8_WAIT_L(n) asm volatile("s_waitcnt lgkmcnt(" #n ")" ::: "memory")
#define PG8_BAR __builtin_amdgcn_s_barrier()
#define PG8_SCHED __builtin_amdgcn_sched_barrier(0)
    Unit cur, nxt; int ui = 0;
    if (!S.next(0, cur)) return;
    f32x4 acc[2][2][4][2];
#pragma unroll
    for (int a = 0; a < 2; ++a)
#pragma unroll
        for (int b = 0; b < 2; ++b)
#pragma unroll
            for (int m = 0; m < 4; ++m)
#pragma unroll
                for (int n = 0; n < 2; ++n) acc[a][b][m][n] = (f32x4){0.f, 0.f, 0.f, 0.f};
    bf16x8 At[4][2], B0[2][2], B1[2][2]; i32x8 At8[4], B08[2], B18[2];
    const char* cA = GATHER ? (const char*)g.A : (const char*)g.A + (size_t)cur.pm * tstep; const char* cB = (const char*)g.Bt + (size_t)cur.pn * tstep;
    if constexpr (GATHER) gather_voffs(S, 0, tid, K, vA0, vA1);
    PG8_STAGE(PG8_SB(0, 0), cB, voffB); PG8_STAGE(PG8_SB(0, 1), cB + hstep, voffB); PG8_STAGE(PG8_SA(0, 0), cA, vA0); PG8_STAGE(PG8_SA(0, 1), cA, vA1);
    if (wr == 1) PG8_BAR;
    PG8_WAIT_V(2); PG8_BAR;
    PG8_STAGE(PG8_SB(1, 0), cB + kstep, voffB); PG8_STAGE(PG8_SA(1, 0), cA + kstep, vA0); PG8_STAGE(PG8_SB(1, 1), cB + hstep + kstep, voffB);
    PG8_WAIT_V(6); PG8_BAR;
    for (;;) {
        const bool has_next = S.next(ui + 1, nxt);
        const char* nA = GATHER ? cA : (has_next ? (const char*)g.A + (size_t)nxt.pm * tstep : cA); const char* nB = has_next ? (const char*)g.Bt + (size_t)nxt.pn * tstep : cB;
        if constexpr (GATHER) { if (has_next) gather_voffs(S, ui + 1, tid, K, wA0, wA1); else { wA0[0] = vA0[0]; wA0[1] = vA0[1]; wA1[0] = vA1[0]; wA1[1] = vA1[1]; } }
        for (int t = 0; t < nt; t += 2) {
            const bool last = (t == nt - 2);
            const char* a1 = cA + (size_t)(t + 1) * kstep;
            const char* a2 = last ? nA : cA + (size_t)(t + 2) * kstep; const char* b2 = last ? nB : cB + (size_t)(t + 2) * kstep;
            const char* a3 = a2 + kstep; const char* b3 = b2 + kstep;
            unsigned sA0[2], sA1[2];
#pragma unroll
            for (int i = 0; i < 2; ++i) { sA0[i] = (GATHER && last) ? wA0[i] : vA0[i]; sA1[i] = (GATHER && last) ? wA1[i] : vA1[i]; }
            if constexpr (Epi::MIDK) { if (t == nt / 2) E.midk(acc, wr, fr); }
            PG8_LDB(B0, 0, 0); PG8_LDB(B1, 0, 1); PG8_SCHED; PG8_LDA(At, 0, 0); PG8_STAGE(PG8_SA(1, 1), a1, vA1);
            PG8_WAIT_V(8); PG8_WAIT_L(0); PG8_BAR; PG8_MMA(0, 0, At, B0); PG8_MMA(0, 1, At, B1); PG8_BAR; PG8_SCHED;
            PG8_LDA(At, 0, 1); PG8_STAGE(PG8_SB(0, 0), b2, voffB); PG8_STAGE(PG8_SB(0, 1), b2 + hstep, voffB); PG8_STAGE(PG8_SA(0, 0), a2, sA0);
            PG8_WAIT_V(8); PG8_WAIT_L(0); PG8_BAR; PG8_MMA(1, 0, At, B0); PG8_MMA(1, 1, At, B1); PG8_BAR; PG8_SCHED;
            PG8_LDB(B0, 1, 0); PG8_LDB(B1, 1, 1); PG8_SCHED; PG8_LDA(At, 1, 0); PG8_STAGE(PG8_SA(0, 1), a2, sA1);
            PG8_WAIT_V(8); PG8_WAIT_L(0); PG8_BAR; PG8_MMA(0, 0, At, B0); PG8_MMA(0, 1, At, B1); PG8_BAR; PG8_SCHED;
            PG8_LDA(At, 1, 1); PG8_STAGE(PG8_SB(1, 0), b3, voffB); PG8_STAGE(PG8_SB(1, 1), b3 + hstep, voffB); PG8_STAGE(PG8_SA(1, 0), a3, sA0);
            PG8_WAIT_V(8); PG8_WAIT_L(0); PG8_BAR; PG8_MMA(1, 0, At, B0); PG8_MMA(1, 1, At, B1); PG8_BAR; PG8_SCHED;
        }
        if constexpr (ALIGN_EPI) { if (wr == 0) PG8_BAR; }
        E(acc, cur, ui, wr, wc, fr, fq);
        if (!has_next) break;
#pragma unroll
        for (int a = 0; a < 2; ++a)
#pragma unroll
            for (int b = 0; b < 2; ++b)
#pragma unroll
                for (int m = 0; m < 4; ++m)
#pragma unroll
                    for (int n = 0; n < 2; ++n) acc[a][b][m][n] = (f32x4){0.f, 0.f, 0.f, 0.f};
        cur = nxt; cA = nA; cB = nB; ++ui;
        if constexpr (GATHER) { vA0[0] = wA0[0]; vA0[1] = wA0[1]; vA1[0] = wA1[0]; vA1[1] = wA1[1]; }
        if constexpr (ALIGN_EPI) { if (wr == 1) PG8_BAR; }
    }
    PG8_WAIT_V(0);
    if constexpr (!ALIGN_EPI) { if (wr == 0) PG8_BAR; }
    PG8_BAR;
#undef PG8_SA
#undef PG8_SB
#undef PG8_STAGE
#undef PG8_LDA
#undef PG8_LDB
#undef PG8_MMA
#undef PG8_LDA_BF
#undef PG8_LDB_BF
#undef PG8_MMA_BF
#undef PG8_LD8
#undef PG8_LDA_F8
#undef PG8_LDB_F8
#undef PG8_MMA_F8
#undef PG8_WAIT_V
#undef PG8_WAIT_L
#undef PG8_BAR
#undef PG8_SCHED
}

struct EpiProj {
    static constexpr bool PERM = true, MIDK = false;
    bf16_t* O; unsigned* hp;
    __device__ __forceinline__ void operator()(const f32x4 (&acc)[2][2][4][2], const Unit& u, int, int wr, int wc, int fr, int fq) const {
        const int row0 = u.pm * BM + wr * 64 + fr, col0 = u.pn * BM + wc * 32 + 8 * fq;
        const float sc = (u.pn < 2 || (u.pn >= 6 && u.pn < 8)) ? C2 : 1.f;
        if (u.pn < 4) {
            float mx = 0.f;
#pragma unroll
            for (int ai = 0; ai < 2; ++ai)
#pragma unroll
                for (int m = 0; m < 4; ++m)
#pragma unroll
                    for (int bj = 0; bj < 2; ++bj) { const f32x4 a0 = acc[ai][bj][m][0] * sc, a1 = acc[ai][bj][m][1] * sc;
                        float q = a0[0] * a0[0] + a0[1] * a0[1] + a0[2] * a0[2] + a0[3] * a0[3] + a1[0] * a1[0] + a1[1] * a1[1] + a1[2] * a1[2] + a1[3] * a1[3];
                        q += __shfl_xor(q, 16); q += __shfl_xor(q, 32); mx = fmaxf(mx, q); }
#pragma unroll
            for (int o = 1; o < 16; o <<= 1) mx = fmaxf(mx, __shfl_xor(mx, o));
            if ((threadIdx.x & 63) == 0) atomicMax(hp + (u.pn < 2 ? 0 : 64), __float_as_uint(mx));
        }
#pragma unroll
        for (int ai = 0; ai < 2; ++ai)
#pragma unroll
            for (int m = 0; m < 4; ++m) { bf16_t* rowp = O + (size_t)(row0 + ai * HALF + m * 16) * NPROJ + col0;
#pragma unroll
                for (int bj = 0; bj < 2; ++bj) { const f32x4 v0 = acc[ai][bj][m][0] * sc, v1 = acc[ai][bj][m][1] * sc;
                    u32x4 w; w.x = cvt_pk_bf16(v0[0], v0[1]); w.y = cvt_pk_bf16(v0[2], v0[3]); w.z = cvt_pk_bf16(v1[0], v1[1]); w.w = cvt_pk_bf16(v1[2], v1[3]);
                    st16_wt(rowp + bj * HALF, w); } }
    }
};
struct EpiWout {
    static constexpr bool PERM = false, MIDK = true;
    const float* x; float* X1; bf16_t* X1B; const PG8_LAS float* ratio; const PG8_LAS float* rs;
    __device__ __forceinline__ void midk(f32x4 (&acc)[2][2][4][2], int wr, int fr) const {
#pragma unroll
        for (int ai = 0; ai < 2; ++ai)
#pragma unroll
            for (int m = 0; m < 4; ++m) { const float f = ratio[ai * HALF + wr * 64 + m * 16 + fr];
#pragma unroll
                for (int bj = 0; bj < 2; ++bj)
#pragma unroll
                    for (int n = 0; n < 2; ++n) acc[ai][bj][m][n] *= f; }
    }
    __device__ __forceinline__ void operator()(const f32x4 (&acc)[2][2][4][2], const Unit& u, int, int wr, int wc, int fr, int fq) const {
        const int col0 = u.pn * BM + wc * 32 + 4 * fq;
#pragma unroll
        for (int ai = 0; ai < 2; ++ai)
#pragma unroll
            for (int m = 0; m < 4; ++m) { const int r = ai * HALF + wr * 64 + m * 16 + fr; const float s = rs[r]; const size_t off = (size_t)(u.pm * BM + r) * DM + col0;
#pragma unroll
                for (int bj = 0; bj < 2; ++bj)
#pragma unroll
                    for (int n = 0; n < 2; ++n) { const f32x4 xv = *(const f32x4*)(x + off + bj * HALF + n * 16); const f32x4 o = xv + acc[ai][bj][m][n] * s;
                        *(f32x4*)(X1 + off + bj * HALF + n * 16) = o;
                        if (MOE_F8) *(unsigned*)((unsigned char*)X1B + off + bj * HALF + n * 16) = pk4_fp8(o[0], o[1], o[2], o[3]);
                        else { u32x2 w; w.x = cvt_pk_bf16(o[0], o[1]); w.y = cvt_pk_bf16(o[2], o[3]); *(u32x2*)(X1B + off + bj * HALF + n * 16) = w; } }
                asm volatile("" ::: "memory"); }
    }
};
constexpr int MOE_MAXU = 10;
struct MoeOrder {
    int NT, c; const PG8_LAS int* tb; const PG8_LAS int* tbE; const PG8_LAS int* tbC; const PG8_LAS int* cnt; const PG8_LAS int* tabA;
    int probe = 0;
    __device__ bool next(int i, Unit& u) const {
        if (i >= MOE_MAXU) return false;
        const int x = c & 7, j = c >> 3, UE = tbE[32] * NT, UC = tbC[32] * NT;
        const int qE = UE >> 3, rE = UE & 7, sE = x * qE + (x < rE ? x : rE), nE = qE + (x < rE ? 1 : 0);
        const int qC = UC >> 3, rC = UC & 7, sC = x * qC + (x < rC ? x : rC), nC = qC + (x < rC ? 1 : 0);
        const int nEj = (j < nE) ? ((nE - j + 31) >> 5) : 0;
        if (i < nEj) {
            const int f = sE + i * 32 + j; int e = 0; while (f >= tbE[e + 1] * NT) ++e;
            const int idx = f - tbE[e] * NT, nte = tbE[e + 1] - tbE[e], pg = idx / (4 * nte), rem2 = idx - pg * 4 * nte, mt = rem2 >> 2;
            u.pm = tb[e] + mt; u.pn = e * NT + pg * 4 + (rem2 & 3); const int left = cnt[e] - 256 * mt; u.nr = left < BM ? left : BM;
        } else {
            const int jj = (j - (nE & 31) + 32) & 31, lc = (i - nEj) * 32 + jj; if (lc >= nC) return false;
            const int f = sC + lc; int e = 0; while (f >= tbC[e + 1] * NT) ++e;
            const int mt = tbE[e + 1] - tbE[e]; u.pm = tb[e] + mt; u.pn = e * NT + (f - tbC[e] * NT); u.nr = cnt[e] - 256 * mt;
        }
        if (probe) { u.pm &= 31; u.pn &= 7; if (probe == 2) u.nr = 32; }
        return true;
    }
    __device__ __forceinline__ const PG8_LAS int* rowtab(int ui) const { return tabA + ui * 256; }
};
struct EpiMoe1 {
    static constexpr bool PERM = true, MIDK = false;
    bf16_t* H; const PG8_LAS int* rowtab; const PG8_LAS float* btab;
    __device__ __forceinline__ void operator()(const f32x4 (&acc)[2][2][4][2], const Unit& u, int ui, int wr, int wc, int fr, int fq) const {
        const int pl = u.pn & 7, cl = wc * 32 + 8 * fq, colA = pl * 128 + cl;
        f32x4 bg[2], bl[2];
#pragma unroll
        for (int n = 0; n < 2; ++n) { bg[n] = *(const PG8_LAS f32x4*)(btab + ui * 256 + cl + 4 * n); bl[n] = *(const PG8_LAS f32x4*)(btab + ui * 256 + 128 + cl + 4 * n); }
#pragma unroll
        for (int ai = 0; ai < 2; ++ai)
#pragma unroll
            for (int m = 0; m < 4; ++m) { const int r = ai * HALF + wr * 64 + m * 16 + fr; const float rs = __uint_as_float((unsigned)rowtab[ui * 256 + r] & 0xffff0000u);
                float a8[8];
#pragma unroll
                for (int n = 0; n < 2; ++n) { const f32x4 gv = acc[ai][0][m][n] * rs + bg[n], lv = acc[ai][1][m][n] * rs + bl[n];
#pragma unroll
                    for (int i = 0; i < 4; ++i) { const float gl = fminf(gv[i], 7.f), li = fminf(fmaxf(lv[i], -7.f), 7.f);
                        a8[4 * n + i] = gl * __builtin_amdgcn_rcpf(1.f + __builtin_amdgcn_exp2f(-1.702f * LOG2E * gl)) * (li + 1.f); } }
                if (MOE_F8) { u32x2 w;
                    int w0 = __builtin_amdgcn_cvt_pk_fp8_f32(a8[0], a8[1], 0, false); w0 = __builtin_amdgcn_cvt_pk_fp8_f32(a8[2], a8[3], w0, true);
                    int w1 = __builtin_amdgcn_cvt_pk_fp8_f32(a8[4], a8[5], 0, false); w1 = __builtin_amdgcn_cvt_pk_fp8_f32(a8[6], a8[7], w1, true);
                    w.x = (unsigned)w0; w.y = (unsigned)w1; *(u32x2*)((unsigned char*)H + (size_t)(u.pm * BM + r) * DM + colA) = w; }
                else { u32x4 w; w.x = cvt_pk_bf16(a8[0], a8[1]); w.y = cvt_pk_bf16(a8[2], a8[3]); w.z = cvt_pk_bf16(a8[4], a8[5]); w.w = cvt_pk_bf16(a8[6], a8[7]);
                *(u32x4*)(H + (size_t)(u.pm * BM + r) * DM + colA) = w; } }
    }
};
struct EpiMoe2 {
    static constexpr bool PERM = true, MIDK = false;
    bf16_t* Y; const PG8_LAS float* wtab; const PG8_LAS float* btab;
    __device__ __forceinline__ void operator()(const f32x4 (&acc)[2][2][4][2], const Unit& u, int ui, int wr, int wc, int fr, int fq) const {
        const int pl = u.pn & 3, cl = wc * 32 + 8 * fq, col0 = pl * BM + cl;
        f32x4 bv[2][2];
#pragma unroll
        for (int bj = 0; bj < 2; ++bj)
#pragma unroll
            for (int n = 0; n < 2; ++n) bv[bj][n] = *(const PG8_LAS f32x4*)(btab + ui * 256 + cl + bj * HALF + 4 * n);
#pragma unroll
        for (int ai = 0; ai < 2; ++ai)
#pragma unroll
            for (int m = 0; m < 4; ++m) { const int r = ai * HALF + wr * 64 + m * 16 + fr; const float wt = wtab[ui * 256 + r]; bf16_t* rowp = Y + (size_t)(u.pm * BM + r) * DM + col0;
#pragma unroll
                for (int bj = 0; bj < 2; ++bj) { const f32x4 v0 = (acc[ai][bj][m][0] + bv[bj][0]) * wt, v1 = (acc[ai][bj][m][1] + bv[bj][1]) * wt;
                    if (Y_F8) { u32x2 w; w.x = pk4_fp8(v0[0], v0[1], v0[2], v0[3]); w.y = pk4_fp8(v1[0], v1[1], v1[2], v1[3]); *(u32x2*)((unsigned char*)Y + (size_t)(u.pm * BM + r) * DM + col0 + bj * HALF) = w; }
                    else { u32x4 w; w.x = cvt_pk_bf16(v0[0], v0[1]); w.y = cvt_pk_bf16(v0[2], v0[3]); w.z = cvt_pk_bf16(v1[0], v1[1]); w.w = cvt_pk_bf16(v1[2], v1[3]);
                    *(u32x4*)(rowp + bj * HALF) = w; } } }
    }
};
struct ListOrder {
    const PG8_LAS int* ud; int n; const PG8_LAS int* tabA;
    __device__ __forceinline__ bool next(int i, Unit& u) const { if (i >= n) return false; u.pm = ud[3 * i]; u.pn = ud[3 * i + 1]; u.nr = ud[3 * i + 2]; return true; }
    __device__ __forceinline__ const PG8_LAS int* rowtab(int ui) const { return tabA + ui * 256; }
};
struct EpiNull {
    static constexpr bool PERM = true, MIDK = false; float* O;
    __device__ __forceinline__ void operator()(const f32x4 (&acc)[2][2][4][2], const Unit& u, int ui, int wr, int wc, int fr, int fq) const {
        f32x4 t = (f32x4){0.f, 0.f, 0.f, 0.f};
#pragma unroll
        for (int ai = 0; ai < 2; ++ai)
#pragma unroll
            for (int bj = 0; bj < 2; ++bj)
#pragma unroll
                for (int m = 0; m < 4; ++m)
#pragma unroll
                    for (int n = 0; n < 2; ++n) t += acc[ai][bj][m][n];
        O[(size_t)(u.pm & 31) * 65536 + (u.pn & 7) * 8192 + (wr * 4 + wc) * 64 + fq * 16 + fr + ui] = t[0] + t[1] + t[2] + t[3];
    }
};
}

#include <hip/hip_bf16.h>
#include <cmath>
namespace attn_body {

using bf16=__hip_bfloat16;
using bf16x8=__attribute__((ext_vector_type(8)))short;
using s16x4=__attribute__((ext_vector_type(4)))short;
using f32x16=__attribute__((ext_vector_type(16)))float;
using u32x4=__attribute__((ext_vector_type(4)))unsigned;
constexpr int SEQ=4096,D=64,PIN=3072,POUT=1024;
constexpr int NW=8,QBLK=32,QB=QBLK*NW,KVBLK=64,NQB=SEQ/QB;
__device__ __forceinline__ int crow(int r,int hi){return (r&3)+8*(r>>2)+4*hi;}
#define SBAR() __builtin_amdgcn_sched_barrier(0)
__device__ __forceinline__ void cmask(f32x16&p0,f32x16&p1,int jb,int qrel,int hi){
  const float NEG=-INFINITY; int kb=64*jb+4*hi;
  #pragma unroll
  for(int r=0;r<16;++r){int kv=kb+(r&3)+8*(r>>2); if(kv>qrel)p0[r]=NEG; if(kv+32>qrel)p1[r]=NEG;}
}

constexpr int NSLOT=3, SLOTB=8192;
constexpr int LDS_K=0, LDS_V=NSLOT*SLOTB, LDS_WS=2*NSLOT*SLOTB, LDS_OST=LDS_WS+NW*64*4, LDS_CK=LDS_OST+NW*4096, LDS_BYTES=LDS_CK+SEQ*4;
constexpr float C2=0.125f*1.4426950408889634f;
__device__ __forceinline__ void glds16(const void*gsrc,unsigned lds_dst){unsigned keep;
  asm volatile("s_mov_b32 %0, m0\n\ts_mov_b32 m0, %2\n\ts_nop 0\n\tglobal_load_lds_dwordx4 %1, off\n\ts_mov_b32 m0, %0":"=&s"(keep):"v"(gsrc),"s"(lds_dst):"memory");}
__device__ __forceinline__ float max3f(float a,float b,float c){float r;asm("v_max3_f32 %0, %1, %2, %3":"=v"(r):"v"(a),"v"(b),"v"(c));return r;}
__device__ __forceinline__ float max2f(float a,float b){float r;asm("v_max_f32_e32 %0, %1, %2":"=v"(r):"v"(a),"v"(b));return r;}
__device__ __forceinline__ float fadd_s(float a,float b){float r;asm("v_add_f32_e32 %0, %1, %2":"=v"(r):"v"(a),"v"(b));return r;}
__device__ __forceinline__ float fsub_s(float a,float b){float r;asm("v_sub_f32_e32 %0, %1, %2":"=v"(r):"v"(a),"v"(b));return r;}
typedef float f32x2_t __attribute__((ext_vector_type(2))); typedef float f32x4_t __attribute__((ext_vector_type(4))); typedef __bf16 bf16x2_t __attribute__((ext_vector_type(2)));
__device__ __forceinline__ unsigned cvtpk_s(float lo,float hi){f32x2_t v={lo,hi};bf16x2_t b=__builtin_convertvector(v,bf16x2_t);return __builtin_bit_cast(unsigned,b);}
#define WAIT_BAR(N) asm volatile("s_waitcnt vmcnt(" #N ") lgkmcnt(0)\n\ts_barrier":::"memory")

__device__ __forceinline__ void qkt(f32x16&p0,f32x16&p1,const char*Kslot,const bf16x8*qr,const f32x16&negm,int r32,int hi){
  const char*kb=Kslot+hi*1024+r32*16;
  #pragma unroll
  for(int d0=0;d0<4;++d0){
    const bf16x8 b0=*reinterpret_cast<const bf16x8*>(kb+d0*2048);
    const bf16x8 b1=*reinterpret_cast<const bf16x8*>(kb+d0*2048+512);
    if(d0==0){p0=__builtin_amdgcn_mfma_f32_32x32x16_bf16(b0,qr[0],negm,0,0,0);p1=__builtin_amdgcn_mfma_f32_32x32x16_bf16(b1,qr[0],negm,0,0,0);}
    else{p0=__builtin_amdgcn_mfma_f32_32x32x16_bf16(b0,qr[d0],p0,0,0,0);p1=__builtin_amdgcn_mfma_f32_32x32x16_bf16(b1,qr[d0],p1,0,0,0);}}
}
typedef __attribute__((address_space(3))) const char* lds_cptr;
typedef short v4i16_t __attribute__((ext_vector_type(4)));
__device__ __forceinline__ void kload8(bf16x8*kf,lds_cptr kp){
  kf[0]=*(const __attribute__((address_space(3))) bf16x8*)(kp);      kf[1]=*(const __attribute__((address_space(3))) bf16x8*)(kp+512);
  kf[2]=*(const __attribute__((address_space(3))) bf16x8*)(kp+2048); kf[3]=*(const __attribute__((address_space(3))) bf16x8*)(kp+2560);
  kf[4]=*(const __attribute__((address_space(3))) bf16x8*)(kp+4096); kf[5]=*(const __attribute__((address_space(3))) bf16x8*)(kp+4608);
  kf[6]=*(const __attribute__((address_space(3))) bf16x8*)(kp+6144); kf[7]=*(const __attribute__((address_space(3))) bf16x8*)(kp+6656);
}
__device__ __forceinline__ void kload2(bf16x8*kf,lds_cptr kp,int j){ kf[2*j]=*(const __attribute__((address_space(3))) bf16x8*)(kp+j*2048); kf[2*j+1]=*(const __attribute__((address_space(3))) bf16x8*)(kp+j*2048+512); }
__device__ __forceinline__ s16x4 vtr(lds_cptr p){ return __builtin_bit_cast(s16x4,__builtin_amdgcn_ds_read_tr16_b64_v4i16((__attribute__((address_space(3))) v4i16_t*)p)); }
__device__ __forceinline__ float rowmax(const f32x16&p0,const f32x16&p1){
  float a=max3f(p0[0],p0[1],p1[0]),b=max3f(p0[2],p0[3],p1[1]);a=max3f(a,p1[2],p1[3]);
  #pragma unroll
  for(int r=4;r<16;r+=4){a=max3f(a,p0[r],p0[r+1]);b=max3f(b,p0[r+2],p0[r+3]);a=max3f(a,p1[r],p1[r+1]);b=max3f(b,p1[r+2],p1[r+3]);}
  const float m=max2f(a,b);
  auto rr=__builtin_amdgcn_permlane32_swap(__float_as_uint(m),__float_as_uint(m),false,false);
  return max2f(__uint_as_float(rr[0]),__uint_as_float(rr[1]));
}
__device__ __forceinline__ void pv(f32x16*o,int vb,bf16x8 pa0,bf16x8 pa1,bf16x8 pa2,bf16x8 pa3){
  #pragma unroll
  for(int d0=0;d0<2;++d0){s16x4 lo[4],hi[4];
    #pragma unroll
    for(int ks=0;ks<4;++ks){
      asm volatile("ds_read_b64_tr_b16 %0,%1 offset:%c2":"=&v"(lo[ks]):"v"(vb),"i"(d0*4096+ks*1024):"memory");
      asm volatile("ds_read_b64_tr_b16 %0,%1 offset:%c2":"=&v"(hi[ks]):"v"(vb),"i"(d0*4096+ks*1024+512):"memory");}
    asm volatile("s_waitcnt lgkmcnt(0)":::"memory");SBAR();
    #define PK(k) (bf16x8){lo[k][0],lo[k][1],lo[k][2],lo[k][3],hi[k][0],hi[k][1],hi[k][2],hi[k][3]}
    o[d0]=__builtin_amdgcn_mfma_f32_32x32x16_bf16(pa0,PK(0),o[d0],0,0,0);
    o[d0]=__builtin_amdgcn_mfma_f32_32x32x16_bf16(pa1,PK(1),o[d0],0,0,0);
    o[d0]=__builtin_amdgcn_mfma_f32_32x32x16_bf16(pa2,PK(2),o[d0],0,0,0);
    o[d0]=__builtin_amdgcn_mfma_f32_32x32x16_bf16(pa3,PK(3),o[d0],0,0,0);
    #undef PK
  }
}

#ifndef ATTN_STORE16
#define ATTN_STORE16(p,v) (*(u32x4*)(p)=(v))
#endif
template<int THRL> __device__ __forceinline__ void attn_unit(int b,int h,int qb,const bf16*Q,const bf16*__restrict__ K,const bf16*__restrict__ V,bf16*O,const float*__restrict__ CUMbh,float*__restrict__ SSQh,float skipth,char*shm){
  int tid_=threadIdx.x; asm volatile("":"+v"(tid_));
  const int tid=tid_,lane=tid&63,r32=lane&31,hi=lane>>5; const int wid=__builtin_amdgcn_readfirstlane(tid>>6);
  const long rowbase=(long)b*SEQ; const int q0=qb*QB;
  const bf16*Qw=Q+(rowbase+q0+wid*QBLK)*PIN+h*D;
  int t0;
  { const int NT0=(q0+QB)/KVBLK; const bool sk=(lane<NT0-4)&&(CUMbh[64*lane+63]-CUMbh[q0]>=skipth); t0=__builtin_popcountll(__ballot(sk))&~1; t0=__builtin_amdgcn_readfirstlane(t0); }
  const bf16*Kh=K+(rowbase+(long)t0*KVBLK)*PIN+h*D,*Vh=V+(rowbase+(long)t0*KVBLK)*PIN+h*D;
  const unsigned lds0=(unsigned)(uintptr_t)shm;
  const lds_cptr shm3=(lds_cptr)shm;
  float*wsf=(float*)(shm+LDS_WS)+wid*64;
  const bf16*ksrc=Kh+(long)lane*PIN+wid*8;
  const bf16*vsrc=Vh+(long)(16*(wid&3)+(lane>>2))*PIN+(wid>>2)*32+(lane&3)*8;
  const unsigned kdst=lds0+LDS_K+wid*1024, vdst=lds0+LDS_V+wid*1024;
  #define DMA_K(t,slot) glds16(ksrc+(long)(t)*KVBLK*PIN,(unsigned)__builtin_amdgcn_readfirstlane(kdst+(slot)))
  #define DMA_V(t,slot) glds16(vsrc+(long)(t)*KVBLK*PIN,(unsigned)__builtin_amdgcn_readfirstlane(vdst+(slot)))
  const int vb0=(int)(lds0+LDS_V)+((lane>>4)&1)*32+(lane&3)*8+(4*hi+((lane&15)>>2))*64;
  const char*Kbase=shm+LDS_K; bf16x8 kf[8];
  const lds_cptr kp0=shm3+LDS_K+hi*1024+r32*16; const lds_cptr vp0=shm3+LDS_V+((lane>>4)&1)*32+(lane&3)*8+(4*hi+((lane&15)>>2))*64;
  const int NT=(q0+QB)/KVBLK-t0;
  DMA_K(0,0);DMA_V(0,0);DMA_K(1,SLOTB);
  bf16x8 qr[4];
  #pragma unroll
  for(int d0=0;d0<4;++d0)qr[d0]=*reinterpret_cast<const bf16x8*>(&Qw[(long)r32*PIN+d0*16+hi*8]);
  const float cbase=CUMbh[q0]; const float cq=CUMbh[q0+wid*QBLK+r32]-cbase;
  { __attribute__((address_space(3))) float*ckw=(__attribute__((address_space(3))) float*)(shm3+LDS_CK); int s0_=tid; asm volatile("":"+v"(s0_));
    _Pragma("nounroll") for(int s=s0_;s<q0+QB;s+=NW*64)ckw[s]=CUMbh[s]-cbase; }
  const __attribute__((address_space(3))) float*ckp=(const __attribute__((address_space(3))) float*)(shm3+LDS_CK)+4*hi+t0*KVBLK;
  float mhat=-cq,l_reg=0.f;f32x16 o[2];o[0]=f32x16{};o[1]=f32x16{};f32x16 negm;
  #pragma unroll
  for(int r=0;r<16;++r)negm[r]=cq;
  asm volatile("":"+v"(negm));
  const int qrel=wid*QBLK+r32;
  #define BIAS(P0,P1,t) do{ const __attribute__((address_space(3))) float*cp_=ckp+(t)*KVBLK; \
    _Pragma("unroll") for(int g_=0;g_<4;++g_){ const f32x4_t c0_=*(const __attribute__((address_space(3))) f32x4_t*)(cp_+8*g_), c1_=*(const __attribute__((address_space(3))) f32x4_t*)(cp_+32+8*g_); \
      _Pragma("unroll") for(int j_=0;j_<4;++j_){ P0[4*g_+j_]-=c0_[j_]; P1[4*g_+j_]-=c1_[j_]; } SBAR(); } }while(0)
  #define CMASK(P0,P1,t) do{int jb_=(t)-(NT-4); if(jb_>=0)cmask(P0,P1,jb_,qrel,hi);}while(0)
  bool resc=false;
  #define START(P0,P1) do{ const float rm=rowmax(P0,P1); resc=false; \
    { const float dl=rm; mhat=fadd_s(mhat,dl); \
      _Pragma("unroll") for(int r=0;r<16;++r){P0[r]=fsub_s(P0[r],dl);P1[r]=fsub_s(P1[r],dl);} \
      _Pragma("unroll") for(int r=0;r<16;++r)negm[r]=-mhat; asm volatile("":"+v"(negm)); } \
    _Pragma("unroll") for(int r=0;r<16;++r)P0[r]=__builtin_amdgcn_exp2f(P0[r]); }while(0)
  #define RESC() do{ if(resc){ asm volatile("s_waitcnt lgkmcnt(0)":::"memory"); \
      _Pragma("unroll") for(int d_=0;d_<2;++d_) _Pragma("unroll") for(int r=0;r<16;++r)o[d_][r]*=wsf[crow(r,hi)]; } }while(0)
  f32x16 pA0,pA1,pB0,pB1;
  int sl_prev=0,sl_cur=0,sl_next=SLOTB;
  #define ROT() do{sl_prev=sl_cur;sl_cur=sl_next;sl_next=(sl_next==(NSLOT-1)*SLOTB)?0:sl_next+SLOTB;}while(0)
  DMA_K(2,2*SLOTB);
  WAIT_BAR(3);
  qkt(pA0,pA1,Kbase,qr,negm,r32,hi);asm volatile("s_nop 15\n\ts_nop 7":"+v"(pA0),"+v"(pA1));BIAS(pA0,pA1,0);CMASK(pA0,pA1,0);
  START(pA0,pA1);
  _Pragma("unroll") for(int r=0;r<16;++r)pA1[r]=__builtin_amdgcn_exp2f(pA1[r]);
  WAIT_BAR(0);
  DMA_K(3,0);DMA_V(1,SLOTB);
  ROT();
  kload8(kf,kp0+sl_cur);
  WAIT_BAR(2);
  s16x4 vlo[8],vhi[8]; u32x4 pw0,pw1,pw2,pw3;
  #define PKW(P,B) cvtpk_s(P[B],P[B+1])
  #define PAF(k) __builtin_bit_cast(bf16x8,pw##k)
  #define VFR(i) (bf16x8){vlo[i][0],vlo[i][1],vlo[i][2],vlo[i][3],vhi[i][0],vhi[i][1],vhi[i][2],vhi[i][3]}
  #define PIN(x) asm volatile("":"+v"(x))
  #define MX3(a,b,c) __builtin_fmaxf(__builtin_fmaxf((a),(b)),(c))
  #define GAPA(MF,A0,A1,A2,A3,W0,W1,PW) do{ MF; sacc+=A0; sacc+=A1; sacc+=A2; sacc+=A3; PIN(sacc); W0; W1; PIN(PW); SBAR(); }while(0)
  #define EX(v) __builtin_amdgcn_exp2f(v)
  #define GAPB(MF,X,B) do{ MF; X[B]=EX(X[B]); X[B+1]=EX(X[B+1]); X[B+2]=EX(X[B+2]); X[B+3]=EX(X[B+3]); PIN(X); SBAR(); }while(0)
  #define VRD(i) do{ vlo[i]=vtr(vp_+(((i)>>2)*4096+((i)&3)*1024)); vhi[i]=vtr(vp_+(((i)>>2)*4096+((i)&3)*1024+512)); }while(0)
  #define KRD(G,j) do{ if(G){ kload2(kf,kp0+sl_next,j); SBAR(); } }while(0)
  #define STEP(C0,C1,P0,P1,t,GK,GV,GL) do{ SBAR(); \
    const lds_cptr vp_=vp0+sl_prev; \
    VRD(0); SBAR(); float sacc=(P0[0]+P0[1]); \
    GAPA(C0=__builtin_amdgcn_mfma_f32_32x32x16_bf16(kf[0],qr[0],negm,0,0,0), P0[2],P0[3],P0[4],P0[5],     pw0[0]=PKW(P0,0), pw0[1]=PKW(P0,2), pw0); \
    VRD(4); SBAR(); GAPA(C1=__builtin_amdgcn_mfma_f32_32x32x16_bf16(kf[1],qr[0],negm,0,0,0), P0[6],P0[7],P0[8],P0[9],     pw0[2]=PKW(P0,4), pw0[3]=PKW(P0,6), pw0); \
    VRD(1); SBAR(); GAPA(C0=__builtin_amdgcn_mfma_f32_32x32x16_bf16(kf[2],qr[1],C0,0,0,0),   P0[10],P0[11],P0[12],P0[13], pw1[0]=PKW(P0,8), pw1[1]=PKW(P0,10), pw1); \
    VRD(5); SBAR(); GAPA(C1=__builtin_amdgcn_mfma_f32_32x32x16_bf16(kf[3],qr[1],C1,0,0,0),   P0[14],P0[15],P1[0],P1[1],   pw1[2]=PKW(P0,12),pw1[3]=PKW(P0,14), pw1); \
    VRD(2); SBAR(); GAPA(C0=__builtin_amdgcn_mfma_f32_32x32x16_bf16(kf[4],qr[2],C0,0,0,0),   P1[2],P1[3],P1[4],P1[5],     pw2[0]=PKW(P1,0), pw2[1]=PKW(P1,2), pw2); \
    VRD(6); SBAR(); GAPA(C1=__builtin_amdgcn_mfma_f32_32x32x16_bf16(kf[5],qr[2],C1,0,0,0),   P1[6],P1[7],P1[8],P1[9],     pw2[2]=PKW(P1,4), pw2[3]=PKW(P1,6), pw2); \
    VRD(3); SBAR(); GAPA(C0=__builtin_amdgcn_mfma_f32_32x32x16_bf16(kf[6],qr[3],C0,0,0,0),   P1[10],P1[11],P1[12],P1[13], pw3[0]=PKW(P1,8), pw3[1]=PKW(P1,10), pw3); \
    VRD(7); SBAR(); GAPA(C1=__builtin_amdgcn_mfma_f32_32x32x16_bf16(kf[7],qr[3],C1,0,0,0),   P1[14],P1[15],0.f,0.f,       pw3[2]=PKW(P1,12),pw3[3]=PKW(P1,14), pw3); \
    l_reg+=sacc; \
    if(GK){DMA_K((t)+3,sl_cur);} if(GV){DMA_V((t)+1,sl_next);} \
    BIAS(C0,C1,t); CMASK(C0,C1,t); \
    { float a=MX3(C0[0],C0[1],C1[0]),b=MX3(C0[2],C0[3],C1[1]); a=MX3(a,C1[2],C1[3]); \
      _Pragma("unroll") for(int r=4;r<16;r+=4){a=MX3(a,C0[r],C0[r+1]);b=MX3(b,C0[r+2],C0[r+3]);a=MX3(a,C1[r],C1[r+1]);b=MX3(b,C1[r+2],C1[r+3]);} \
      float rm=__builtin_fmaxf(a,b); { auto rr=__builtin_amdgcn_permlane32_swap(__float_as_uint(rm),__float_as_uint(rm),false,false); rm=__builtin_fmaxf(__uint_as_float(rr[0]),__uint_as_float(rr[1])); } \
      resc=false; \
      if(__builtin_expect(__any(rm>(float)THRL),0)){ const float dl=__builtin_fmaxf(rm,0.f); mhat+=dl; \
        _Pragma("unroll") for(int r=0;r<16;++r){C0[r]-=dl;C1[r]-=dl;} \
        _Pragma("unroll") for(int r=0;r<16;++r)negm[r]=-mhat; asm volatile("":"+v"(negm)); \
        const float f=__builtin_amdgcn_exp2f(-dl); l_reg*=f; if(hi==0)wsf[r32]=f; resc=true; } } \
    SBAR(); \
    GAPB(o[0]=__builtin_amdgcn_mfma_f32_32x32x16_bf16(PAF(0),VFR(0),o[0],0,0,0), C0,0); \
    GAPB(o[1]=__builtin_amdgcn_mfma_f32_32x32x16_bf16(PAF(0),VFR(4),o[1],0,0,0), C0,4); \
    KRD(GL,0); GAPB(o[0]=__builtin_amdgcn_mfma_f32_32x32x16_bf16(PAF(1),VFR(1),o[0],0,0,0), C0,8); \
    KRD(GL,1); GAPB(o[1]=__builtin_amdgcn_mfma_f32_32x32x16_bf16(PAF(1),VFR(5),o[1],0,0,0), C0,12); \
    KRD(GL,2); GAPB(o[0]=__builtin_amdgcn_mfma_f32_32x32x16_bf16(PAF(2),VFR(2),o[0],0,0,0), C1,0); \
    KRD(GL,3); GAPB(o[1]=__builtin_amdgcn_mfma_f32_32x32x16_bf16(PAF(2),VFR(6),o[1],0,0,0), C1,4); \
    GAPB(o[0]=__builtin_amdgcn_mfma_f32_32x32x16_bf16(PAF(3),VFR(3),o[0],0,0,0), C1,8); \
    GAPB(o[1]=__builtin_amdgcn_mfma_f32_32x32x16_bf16(PAF(3),VFR(7),o[1],0,0,0), C1,12); \
    }while(0)
  int t=1;
  #undef CMASK
  #define CMASK(P0,P1,t) do{}while(0)
  for(;t+5<NT;t+=2){
    STEP(pB0,pB1,pA0,pA1,t,true,true,true);     WAIT_BAR(2); RESC(); ROT();
    STEP(pA0,pA1,pB0,pB1,t+1,true,true,true);   WAIT_BAR(2); RESC(); ROT();
  }
  #undef CMASK
  #define CMASK(P0,P1,t) do{int jb_=(t)-(NT-4); if(jb_>=0)cmask(P0,P1,jb_,qrel,hi);}while(0)
  #define ENDW(tt) do{ if((tt)+3<NT){WAIT_BAR(2);} else if((tt)+2<NT){WAIT_BAR(1);} else {WAIT_BAR(0);} }while(0)
  for(;t+1<NT;t+=2){
    STEP(pB0,pB1,pA0,pA1,t,(t+3<NT),(t+1<NT),(t+1<NT));       ENDW(t);   RESC(); ROT();
    STEP(pA0,pA1,pB0,pB1,t+1,(t+4<NT),(t+2<NT),(t+2<NT));     ENDW(t+1); RESC(); ROT();
  }
  STEP(pB0,pB1,pA0,pA1,NT-1,false,false,false); RESC();
  { float sacc=pB0[0]+pB0[1]; _Pragma("unroll") for(int r=2;r<16;++r)sacc+=pB0[r]; _Pragma("unroll") for(int r=0;r<16;++r)sacc+=pB1[r]; l_reg+=sacc;
    pw0=(u32x4){PKW(pB0,0),PKW(pB0,2),PKW(pB0,4),PKW(pB0,6)};pw1=(u32x4){PKW(pB0,8),PKW(pB0,10),PKW(pB0,12),PKW(pB0,14)};pw2=(u32x4){PKW(pB1,0),PKW(pB1,2),PKW(pB1,4),PKW(pB1,6)};pw3=(u32x4){PKW(pB1,8),PKW(pB1,10),PKW(pB1,12),PKW(pB1,14)};
    SBAR(); pv(o,vb0+sl_cur,PAF(0),PAF(1),PAF(2),PAF(3)); }
  #undef PKW
  #undef PAF
  #undef VFR
  #undef PIN
  #undef MX3
  #undef GAPA
  #undef GAPB
  #undef EX
  #undef VRD
  #undef KRD
  #undef STEP
  #undef ENDW
  {auto rr=__builtin_amdgcn_permlane32_swap(__float_as_uint(l_reg),__float_as_uint(l_reg),false,false);l_reg=__uint_as_float(rr[0])+__uint_as_float(rr[1]);}
  if(hi==0)wsf[32+r32]=l_reg;asm volatile("s_waitcnt lgkmcnt(0)":::"memory");
  float rli[16];
  #pragma unroll
  for(int r=0;r<16;++r)rli[r]=__builtin_amdgcn_rcpf(wsf[32+crow(r,hi)]);
  bf16*Ow=O+(rowbase+q0+wid*QBLK)*POUT+h*D; float*Sw=SSQh+(rowbase+q0+wid*QBLK)*16;
  { bf16*stg=(bf16*)(shm+LDS_OST)+wid*2048;
    #pragma unroll
    for(int r=0;r<16;++r){const int orow=crow(r,hi);
      #pragma unroll
      for(int d0=0;d0<2;++d0)stg[orow*64+d0*32+r32]=__float2bfloat16(o[d0][r]*rli[r]);}
    asm volatile("s_waitcnt lgkmcnt(0)":::"memory");
    #pragma unroll
    for(int i=0;i<4;++i){const int row=i*8+(lane>>3),ch=lane&7; const u32x4 v=*(const u32x4*)(stg+row*64+ch*8); ATTN_STORE16(Ow+(long)row*POUT+ch*8,v);
      float sq=0.f;
      #pragma unroll
      for(int w_=0;w_<4;++w_){const float lo_=__uint_as_float(v[w_]<<16),hi_=__uint_as_float(v[w_]&0xffff0000u);sq+=lo_*lo_+hi_*hi_;}
      sq+=__shfl_xor(sq,1);sq+=__shfl_xor(sq,2);sq+=__shfl_xor(sq,4); if(ch==0)Sw[row*16]=sq;} }
  asm volatile("s_waitcnt lgkmcnt(0)\n\ts_barrier":::"memory");
  #undef DMA_K
  #undef DMA_V
  #undef CMASK
  #undef BIAS
  #undef START
  #undef RESC
  #undef ROT
}
constexpr int ATTN_LDS_BYTES=LDS_BYTES;

__device__ __forceinline__ void sb_unit(int b,int h,int qb,const bf16*Q,const bf16*__restrict__ K,const bf16*__restrict__ V,bf16*O,float*__restrict__ SSQh,char*shm){
  int tid_=threadIdx.x; asm volatile("":"+v"(tid_));
  const int tid=tid_,lane=tid&63,r32=lane&31,hi=lane>>5; const int wid=__builtin_amdgcn_readfirstlane(tid>>6);
  const long rowbase=(long)b*SEQ; const int q0=qb*QB;
  const bf16*Qw=Q+(rowbase+q0+wid*QBLK)*PIN+h*D;
  const bf16*Kh=K+rowbase*PIN+h*D,*Vh=V+rowbase*PIN+h*D;
  const unsigned lds0=(unsigned)(uintptr_t)shm;
  const bf16*ksrc=Kh+(long)lane*PIN+wid*8;
  const bf16*vsrc=Vh+(long)(16*(wid&3)+(lane>>2))*PIN+(wid>>2)*32+(lane&3)*8;
  const unsigned kdst=lds0+LDS_K+wid*1024, vdst=lds0+LDS_V+wid*1024;
  const int vb0=(int)(lds0+LDS_V)+((lane>>4)&1)*32+(lane&3)*8+(4*hi+((lane&15)>>2))*64;
  const char*Kbase=shm+LDS_K;
  const int NT=(q0+QB)/KVBLK;
  #define SB_DMA(i,slot) do{ const long kt_=(long)(NT-1-(i)); glds16(ksrc+kt_*KVBLK*PIN,(unsigned)__builtin_amdgcn_readfirstlane(kdst+(slot))); glds16(vsrc+kt_*KVBLK*PIN,(unsigned)__builtin_amdgcn_readfirstlane(vdst+(slot))); }while(0)
  bf16x8 qr[4];
  #pragma unroll
  for(int d0=0;d0<4;++d0)qr[d0]=*reinterpret_cast<const bf16x8*>(&Qw[(long)r32*PIN+d0*16+hi*8]);
  SB_DMA(0,0); SB_DMA(1,SLOTB);
  f32x16 o[2];o[0]=f32x16{};o[1]=f32x16{};
  float Rc=1.f;
  const int qrel=wid*QBLK+r32;
  int sl_cur=0,sl_n1=SLOTB,sl_n2=2*SLOTB;
  volatile __attribute__((address_space(3))) unsigned*flg=(volatile __attribute__((address_space(3))) unsigned*)((lds_cptr)shm+LDS_WS);
  for(int i=0;i<NT;++i){
    if(i+1<NT){WAIT_BAR(2);}else{WAIT_BAR(0);}
    if(i>0){ const int pb=((i-1)&1)*8; unsigned all_=flg[pb]&flg[pb+1]&flg[pb+2]&flg[pb+3]&flg[pb+4]&flg[pb+5]&flg[pb+6]&flg[pb+7]; if(__builtin_amdgcn_readfirstlane(all_))break; }
    if(i+2<NT)SB_DMA(i+2,sl_n2);
    f32x16 p0,p1; { f32x16 z=f32x16{}; asm volatile("":"+v"(z)); qkt(p0,p1,Kbase+sl_cur,qr,z,r32,hi); }
    f32x16 s0,s1;
    #pragma unroll
    for(int r=0;r<16;++r){
      const float za=__builtin_amdgcn_fmed3f(p0[r],-100.f,100.f), zb=__builtin_amdgcn_fmed3f(p1[r],-100.f,100.f);
      p0[r]=__builtin_amdgcn_exp2f(za); p1[r]=__builtin_amdgcn_exp2f(zb);
      s0[r]=__builtin_amdgcn_rcpf(1.f+p0[r]); s1[r]=__builtin_amdgcn_rcpf(1.f+p1[r]); }
    if(i<4){
      const int kb=64*(3-i)+4*hi;
      #pragma unroll
      for(int r=0;r<16;++r){ const int kv=kb+(r&3)+8*(r>>2); if(kv>=qrel){p0[r]=0.f;s0[r]=1.f;} if(kv+32>=qrel){p1[r]=0.f;s1[r]=1.f;} }
    }
    float gp[8],pp[8];
    #pragma unroll
    for(int g=0;g<4;++g){
      s0[4*g+2]*=s0[4*g+3]; s0[4*g+1]*=s0[4*g+2]; s0[4*g]*=s0[4*g+1]; gp[g]=s0[4*g];
      s1[4*g+2]*=s1[4*g+3]; s1[4*g+1]*=s1[4*g+2]; s1[4*g]*=s1[4*g+1]; gp[4+g]=s1[4*g]; }
    #pragma unroll
    for(int g=0;g<8;++g){ auto rr=__builtin_amdgcn_permlane32_swap(__float_as_uint(gp[g]),__float_as_uint(gp[g]),false,false); pp[g]=__uint_as_float(hi?rr[0]:rr[1]); }
    float st=Rc, outer[8];
    #pragma unroll
    for(int g=7;g>=0;--g){ outer[g]=hi?st:st*pp[g]; st=st*(gp[g]*pp[g]); }
    Rc=st;
    { const unsigned dn=__all(Rc==0.f)?1u:0u; if(lane==0)flg[(i&1)*8+wid]=dn; }
    #pragma unroll
    for(int r=0;r<16;++r){ p0[r]=p0[r]*(s0[r]*outer[r>>2]); p1[r]=p1[r]*(s1[r]*outer[4+(r>>2)]); }
    u32x4 pw0,pw1,pw2,pw3;
    pw0=(u32x4){cvtpk_s(p0[0],p0[1]),cvtpk_s(p0[2],p0[3]),cvtpk_s(p0[4],p0[5]),cvtpk_s(p0[6],p0[7])};
    pw1=(u32x4){cvtpk_s(p0[8],p0[9]),cvtpk_s(p0[10],p0[11]),cvtpk_s(p0[12],p0[13]),cvtpk_s(p0[14],p0[15])};
    pw2=(u32x4){cvtpk_s(p1[0],p1[1]),cvtpk_s(p1[2],p1[3]),cvtpk_s(p1[4],p1[5]),cvtpk_s(p1[6],p1[7])};
    pw3=(u32x4){cvtpk_s(p1[8],p1[9]),cvtpk_s(p1[10],p1[11]),cvtpk_s(p1[12],p1[13]),cvtpk_s(p1[14],p1[15])};
    SBAR(); pv(o,vb0+sl_cur,__builtin_bit_cast(bf16x8,pw0),__builtin_bit_cast(bf16x8,pw1),__builtin_bit_cast(bf16x8,pw2),__builtin_bit_cast(bf16x8,pw3));
    { const int t_=sl_cur; sl_cur=sl_n1; sl_n1=sl_n2; sl_n2=t_; }
  }
  #undef SB_DMA
  bf16*Ow=O+(rowbase+q0+wid*QBLK)*POUT+h*D; float*Sw=SSQh+(rowbase+q0+wid*QBLK)*16;
  { bf16*stg=(bf16*)(shm+LDS_OST)+wid*2048;
    #pragma unroll
    for(int r=0;r<16;++r){const int orow=crow(r,hi);
      #pragma unroll
      for(int d0=0;d0<2;++d0)stg[orow*64+d0*32+r32]=__float2bfloat16(o[d0][r]);}
    asm volatile("s_waitcnt lgkmcnt(0)":::"memory");
    #pragma unroll
    for(int i=0;i<4;++i){const int row=i*8+(lane>>3),ch=lane&7; const u32x4 v=*(const u32x4*)(stg+row*64+ch*8); ATTN_STORE16(Ow+(long)row*POUT+ch*8,v);
      float sq=0.f;
      #pragma unroll
      for(int w_=0;w_<4;++w_){const float lo_=__uint_as_float(v[w_]<<16),hi_=__uint_as_float(v[w_]&0xffff0000u);sq+=lo_*lo_+hi_*hi_;}
      sq+=__shfl_xor(sq,1);sq+=__shfl_xor(sq,2);sq+=__shfl_xor(sq,4); if(ch==0)Sw[row*16]=sq;} }
  asm volatile("s_waitcnt vmcnt(0) lgkmcnt(0)\n\ts_barrier":::"memory");
}
template<int THRL=8> __device__ __forceinline__ void attn_phase(char*lds,const bf16*PROJ,const float*CUM,bf16*OMIX,float*SSQ,float skipth,int bh,int role){
  const int b=bh>>3,h=bh&7;
  const int nf=role<5?2:6;
  for(int i=0;i<nf;++i){ const int qb=role<5?(i==0?15-role:6+role):5-i;
    attn_unit<THRL>(b,h,qb,PROJ,PROJ+512,PROJ+1024,OMIX,CUM+(size_t)bh*SEQ,SSQ+h,skipth,lds); }
  const int sb0=role<3?3+3*role:(role==3?12:(role==4?14:0)), ns=(role==3||role==4)?2:3;
  for(int i=0;i<ns;++i) sb_unit(b,h,sb0+i,PROJ+1536,PROJ+2048,PROJ+2560,OMIX+512,SSQ+8+h,lds);
}
template<int THRL,int NA> __device__ __forceinline__ void attn_sched(char*lds,const bf16*PROJ,const float*CUM,bf16*OMIX,float*SSQ,float skipth,int xl,int c){
  int tid_=threadIdx.x; asm volatile("":"+v"(tid_)); const int tid=tid_;
  volatile __attribute__((address_space(3))) float*cost=(volatile __attribute__((address_space(3))) float*)((lds_cptr)lds+114688);
  volatile __attribute__((address_space(3))) int*order=(volatile __attribute__((address_space(3))) int*)((lds_cptr)lds+114688+512);
  #define BH_OF(i) ((xl>>1)*8+(((xl&1)?0x4361:0x5270)>>(4*(i))&15))
  if(tid<128){ const int bi=tid>>5,type=(tid>>4)&1,qb=tid&15,bh=BH_OF(bi),NT0=4*(qb+1); float cs;
    if(type==0){ const float rate=-CUM[(size_t)bh*SEQ+SEQ-1]*(1.f/SEQ); const float w=skipth/fmaxf(rate,1e-6f); const float sk=fmaxf(0.f,(float)(qb*QB)-w);
      int t0=((int)(sk*(1.f/KVBLK)))&~1; if(t0>NT0-4)t0=NT0-4; cs=5.f+1.65f*(float)(NT0-t0); }
    else cs=3.f+2.6f*(float)(NT0<8?NT0:8);
    cost[tid]=cs; }
  asm volatile("s_waitcnt lgkmcnt(0)":::"memory"); __syncthreads();
  if(tid<128){ const float mc=cost[tid]; int rk=0; for(int j=0;j<128;++j){ const float cj=cost[j]; rk+=(cj>mc||(cj==mc&&j<tid))?1:0; } order[rk]=tid; }
  asm volatile("s_waitcnt lgkmcnt(0)":::"memory"); __syncthreads();
  for(int k=0;;++k){ const int r=NA*k+((k&1)?NA-1-c:c); if(r>=128)break;
    const int u=__builtin_amdgcn_readfirstlane(order[r]); const int bi=u>>5,type=(u>>4)&1,qb=u&15,bh=BH_OF(bi),b=bh>>3,h=bh&7;
    if(type==0)attn_unit<THRL>(b,h,qb,PROJ,PROJ+512,PROJ+1024,OMIX,CUM+(size_t)bh*SEQ,SSQ+h,skipth,lds);
    else sb_unit(b,h,qb,PROJ+1536,PROJ+2048,PROJ+2560,OMIX+512,SSQ+8+h,lds); }
  #undef BH_OF
}
template<int THRL=8> __device__ __forceinline__ void attn_phase8(char*lds,const bf16*PROJ,const float*CUM,bf16*OMIX,float*SSQ,int vcu){
  const int bh=vcu>>3,s=vcu&7,b=bh>>3,h=bh&7;
  if(bh>=32)return;
  for(int i=0;i<4;++i){ const int qb=(i&1)?15-s:s;
    if(i<2)attn_unit<THRL>(b,h,qb,PROJ,PROJ+512,PROJ+1024,OMIX,CUM+(size_t)bh*SEQ,SSQ+h,3.0e38f,lds);
    else   sb_unit(b,h,qb,PROJ+1536,PROJ+2048,PROJ+2560,OMIX+512,SSQ+8+h,lds); }
}
#undef SBAR
#undef WAIT_BAR
}

template <int NT, bool UP> __device__ __forceinline__ int moe_prepare(const unsigned* __restrict__ CNT, const int* __restrict__ LIST, const float* __restrict__ RSTD2, const float* __restrict__ RW,
                                                                     const float* __restrict__ bias, int* __restrict__ TBG, int bx, LAS unsigned char* L) {
    int tid_ = threadIdx.x; asm volatile("" : "+v"(tid_)); const int tid = tid_;
    LAS int* tb = (LAS int*)(L + TB_OFF); LAS int* tbE = tb + 64; LAS int* tbC = tb + 128; LAS int* cntl = tb + 192; LAS int* udl = tb + 224; LAS int* tabA = (LAS int*)(L + TAB_OFF); LAS float* tabB = (LAS float*)(L + TAB2_OFF);
    if (tid < 64) {
        const int cn = tid < NE ? (int)CNT[tid] : 0, nt = (cn + 255) >> 8, rem = cn & 255, ch = (rem != 0 && rem <= 128) ? 1 : 0;
        int a = nt, c = ch;
#pragma unroll
        for (int o = 1; o < 32; o <<= 1) { const int ta = __shfl_up(a, o), tc = __shfl_up(c, o); if ((tid & 63) >= o) { a += ta; c += tc; } }
        if (tid < NE) { tb[tid + 1] = a; tbC[tid + 1] = c; tbE[tid + 1] = a - c; cntl[tid] = cn; }
        if (tid == 0) { tb[0] = 0; tbC[0] = 0; tbE[0] = 0; }
    }
    LDS_WAIT(); __syncthreads();
    if (bx == 0 && tid <= NE) TBG[tid] = tb[tid];
    pg8::MoeOrder S{NT, bx, tb, tbE, tbC, cntl, tabA};
    if (tid < pg8::MOE_MAXU) { pg8::Unit u; const bool ok = S.next(tid, u); udl[3 * tid] = ok ? u.pm : -1; udl[3 * tid + 1] = u.pn; udl[3 * tid + 2] = u.nr; }
    LDS_WAIT(); __syncthreads();
    int nun = 0;
#pragma unroll
    for (int i = 0; i < pg8::MOE_MAXU; ++i) nun += (udl[3 * i] >= 0) ? 1 : 0;
    int slot[5];
#pragma unroll
    for (int j = 0; j < 5; ++j) { const int idx = tid + NTHREADS * j, ui = idx >> 8, r = idx & 255; slot[j] = 0;
        if (ui < nun) { const int e = udl[3 * ui + 1] / NT, mt = udl[3 * ui] - tb[e], cnt = cntl[e], p = mt * 256 + r; slot[j] = LIST[(size_t)e * LIST_CAP + (p < cnt ? p : cnt - 1)]; } }
#pragma unroll
    for (int j = 0; j < 5; ++j) { const int idx = tid + NTHREADS * j, ui = idx >> 8;
        if (ui < nun) { const int pn = udl[3 * ui + 1];
            if (UP) { const int tok = slot[j] >> 2; tabA[idx] = tok | (int)(__float_as_uint(RSTD2[tok]) & 0xffff0000u);
                      const int e = pn >> 3, pl = pn & 7, c = idx & 255; tabB[idx] = bias[(size_t)e * 2048 + (c < 128 ? pl * 128 + c : 1024 + pl * 128 + (c - 128))]; }
            else { ((LAS float*)tabA)[idx] = RW[slot[j]] * (Y_F8 ? 16.f : 1.f); const int e = pn >> 2, pl = pn & 3; tabB[idx] = bias[(size_t)e * DM + pl * 256 + (idx & 255)]; } } }
    VM_WAIT(); LDS_WAIT(); __syncthreads();
    return nun;
}

__global__ void __launch_bounds__(NTHREADS, 2) mega_fwd(Args a) {
    extern __shared__ __attribute__((aligned(16))) unsigned char lds[];
    LAS unsigned char* L = (LAS unsigned char*)lds;
    volatile LAS unsigned* MISC = (volatile LAS unsigned*)(L + MISC_OFF);
    const int tid = threadIdx.x, lane = tid & 63, wave = __builtin_amdgcn_readfirstlane(tid >> 6);
    const int G = gridDim.x, bx = blockIdx.x, vcu = (G % 8 == 0) ? (bx % 8) * (G / 8) + bx / 8 : bx;
    const int gw = vcu * NWAVES + wave, NGW = G * NWAVES;
    const bool cvt_role = (vcu & 31) >= 32 - NCVT;
    const int cvt_first = ((vcu >> 5) * NCVT + ((vcu & 31) - (32 - NCVT))) * NWAVES + wave;
    const bool cvt1_role = (vcu & 31) >= 24; const int cvt1_first = ((vcu >> 5) * 8 + ((vcu & 31) - 24)) * NWAVES + wave;
    unsigned char* ws = a.ws;
    unsigned* CTL = (unsigned*)(ws + WS_CTL);
    bf16_t* WINT = (bf16_t*)(ws + WS_WINT); bf16_t* WOUTT = (bf16_t*)(ws + WS_WOUTT); float* WR = (float*)(ws + WS_WR); float* CUM = (float*)(ws + WS_CUM);
    float* SSQ = (float*)(ws + WS_SSQ); float* RSTD2 = (float*)(ws + WS_RSTD2); float* RW = (float*)(ws + WS_RW); int* SLOTEP = (int*)(ws + WS_SLOTEP); int* TBG = (int*)(ws + WS_TBG); int* LIST = (int*)(ws + WS_LIST); float* FLOG = (float*)(ws + WS_FLOG);
    bf16_t* XN = (bf16_t*)(ws + WS_XN); bf16_t* PROJ = (bf16_t*)(ws + WS_PROJ); bf16_t* OMIX = (bf16_t*)(ws + WS_OMIX); bf16_t* X1B = (bf16_t*)(ws + WS_X1B);
    bf16_t* W1T = (bf16_t*)(ws + WS_W1T); bf16_t* W2T = (bf16_t*)(ws + WS_W2T); bf16_t* H = (bf16_t*)(ws + WS_H); bf16_t* Y = (bf16_t*)(ws + WS_Y);
    unsigned* CNT = CTL + CW_CNT;
    for (int u = tid; u < (LDS_BYTES - LDSCTL_OFF) / 4; u += NTHREADS) ((LAS unsigned*)(L + LDSCTL_OFF))[u] = 0u;
    __syncthreads();
    XcdBarrier bar = xcd_barrier_post(CTL + CW_BAR, MISC + 8);

    REPS(0) {
        LAS float* scr = (LAS float*)(L + RING_OFF + wave * 8448);
        LAS float* wf = (LAS float*)(L + RING_OFF + 98304);
        for (int i = tid; i < DM * 8; i += NTHREADS) { const int k = i >> 3; wf[i] = a.w_in[(size_t)k * WIN_N + 1536 + (i & 7)] * a.g1[k]; }
        LDS_WAIT(); __syncthreads();
        constexpr int I_IN = (DM / 64) * (NPROJ / 32), I_OUT = (DM / 64) * (DM / 32);
        for (int it = gw; it < I_IN + I_OUT; it += NGW) {
            TrItem t; f32x4 v[8];
            if (it < I_IN) { t.W = a.w_in; t.WT = WINT; t.gA = a.g1; t.gB = nullptr; t.K = DM; t.Nin = WIN_N; t.Nout = NPROJ; t.mode = 1; t.gsplit = DM; t.item = it; t.nbsh = -1; t.f8 = 0; }
            else { t.W = a.w_out; t.WT = WOUTT; t.gA = a.g_fox; t.gB = a.g_sb; t.K = DM; t.Nin = DM; t.Nout = DM; t.mode = 0; t.gsplit = GW; t.item = it - I_IN; t.nbsh = 5; t.f8 = 0; }
            tr_load<false>(t, lane, v); tr_store(t, lane, v, scr);
        }
        if (!OVERLAP_CVT) convert_experts(a.w1, a.w2, a.g2, W1T, W2T, gw, NGW, N_EXP_ITEMS, lane, scr);
        for (int i = gw * 64 + lane; i < DM * NE; i += NGW * 64) WR[i] = a.w_router[i] * a.g2[i >> 5];
        for (int row = gw; row < M; row += NGW) rms1_row(a.x, wf, a.b_f, XN, FLOG, row, lane);
    }
    xcd_barrier(bar); if (REP_PHASE == 8) xcd_barrier(bar);
    REPS(1) {
    if (vcu < NB * NH) cumsum_wg(FLOG, CUM, vcu, (LAS float*)(L + RING_OFF));
    if (OPT_GEMM) {
        if (OVERLAP_CVT && CVT_SPLIT > 0 && cvt1_role) convert_experts(a.w1, a.w2, a.g2, W1T, W2T, cvt1_first, 64 * NWAVES, CVT_SPLIT, lane, (LAS float*)(L + RING_OFF + wave * 8448));
        else {
        pg8::Gemm g{XN, WINT, DM}; pg8::StaticOrder S; if (OVERLAP_CVT && CVT_SPLIT > 0) S.init(M, NPROJ, 192, (vcu & 31) * 8 + (vcu >> 5)); else S.init(M, NPROJ, G, bx); pg8::EpiProj E{PROJ, CTL + CW_QHP};
        pg8::gemm_phase<pg8::EpiProj, pg8::StaticOrder, true, false>(L + RING_OFF, g, S, E);
        }
    } else { for (int it = gw; it < (M / 16) * (NPROJ / 64); it += NGW) nv_inproj(XN, WINT, PROJ, it, lane); }
    }
    xcd_barrier(bar); if (REP_PHASE == 8) xcd_barrier(bar);
    REPS(2) if (OPT_ATTN) {
        static_assert(attn_body::ATTN_LDS_BYTES <= RING_BYTES, "attention scratch inside the ring region");
        if (OVERLAP_CVT) {
            const int xl = vcu >> 5, l = vcu & 31;
            if (cvt_role) convert_experts(a.w1, a.w2, a.g2, W1T, W2T, CVT_SPLIT + cvt_first, 8 * NCVT * NWAVES, N_EXP_ITEMS, lane, (LAS float*)(L + RING_OFF + wave * 8448));
            const float bnd = 2.04f * sqrtf(__uint_as_float(CTL[CW_QHP]) * __uint_as_float(CTL[CW_KHP])), skipth = FOX_SKIP ? 160.f + 2.f * bnd : 3.0e38f;
            if (l < 32 - NCVT) { if (ATTN_SCHED) attn_body::attn_sched<8, 32 - NCVT>((char*)lds + RING_OFF, (const attn_body::bf16*)PROJ, CUM, (attn_body::bf16*)OMIX, SSQ, skipth, xl, l);
                          else attn_body::attn_phase<8>((char*)lds + RING_OFF, (const attn_body::bf16*)PROJ, CUM, (attn_body::bf16*)OMIX, SSQ, skipth, xl * 4 + l / 6, l % 6); }
        } else attn_body::attn_phase8<8>((char*)lds + RING_OFF, (const attn_body::bf16*)PROJ, CUM, (attn_body::bf16*)OMIX, SSQ, vcu);
    } else {
        LAS unsigned char* wl = L + RING_OFF + wave * 16640;
        for (int u = gw; u < 4096; u += NGW) {
            const int i = u >> 11, idx = u & 2047, type = idx & 1, bh = (idx >> 1) & 31, j = (idx >> 6) & 31; const int qblk = (i == 0) ? j : 63 - j;
            if (type == 0) nv_attn<0>(PROJ, CUM, OMIX, SSQ, bh, qblk, lane, wl); else nv_attn<1>(PROJ, CUM, OMIX, SSQ, bh, qblk, lane, wl);
        }
    }
    xcd_barrier(bar); if (REP_PHASE == 8) xcd_barrier(bar);
    REPS(3) if (OPT_GEMM) {
        pg8::Gemm g{OMIX, WOUTT, DM}; pg8::StaticOrder S; S.init(M, DM, G, bx);
        LAS float* ratio = (LAS float*)(L + TAB_OFF); LAS float* rsb = (LAS float*)(L + TAB_OFF + 1024);
        pg8::Unit u0;
        if (S.next(0, u0) && tid < 256) { const float* sp = SSQ + (size_t)(u0.pm * 256 + tid) * 16; float sf = 0.f, s2 = 0.f;
#pragma unroll
            for (int h = 0; h < 8; ++h) { sf += sp[h]; s2 += sp[8 + h]; }
            const float rf = rsqrtf(sf * (1.f / GW) + EPS), rs = rsqrtf(s2 * (1.f / GW) + EPS); ratio[tid] = rf / rs; rsb[tid] = rs; }
        VM_WAIT(); LDS_WAIT(); __syncthreads();
        pg8::EpiWout E{a.x, a.out, X1B, ratio, rsb};
        pg8::gemm_phase<pg8::EpiWout, pg8::StaticOrder, false, false>(L + RING_OFF, g, S, E);
    } else { for (int it = gw; it < (M / 16) * (DM / 64); it += NGW) nv_wout(OMIX, WOUTT, SSQ, a.x, a.out, X1B, it, lane); }
    xcd_barrier(bar); if (REP_PHASE == 8) xcd_barrier(bar);
    if (REP_PHASE == 4) { for (int t64 = vcu; t64 < M / 64; t64 += G) router_wg(a.out, WR, a.b_router, (float*)H, (float*)H + M, (int*)Y, (int*)Y + NE * LIST_CAP, CNT + 64, t64 * 64, L + RING_OFF); }
    if (OPT_ROUTER) { for (int t64 = vcu; t64 < M / 64; t64 += G) router_wg(a.out, WR, a.b_router, RSTD2, RW, LIST, SLOTEP, CNT, t64 * 64, L + RING_OFF); }
    else { for (int it = gw; it < M / 2; it += NGW) nv_router(a.out, WR, a.b_router, RSTD2, RW, LIST, SLOTEP, CNT, it, lane); }
    xcd_barrier(bar); if (REP_PHASE == 8) xcd_barrier(bar);
    LAS int* tb = (LAS int*)(L + TB_OFF); LAS int* tbE = tb + 64; LAS int* tbC = tb + 128; LAS int* cntl = tb + 192; LAS int* udl = tb + 224; LAS int* tabA = (LAS int*)(L + TAB_OFF); LAS int* tabB = (LAS int*)(L + TAB2_OFF);
    REPS(5) if (OPT_GEMM) {
        const int nun = moe_prepare<8, true>(CNT, LIST, RSTD2, RW, a.b1, TBG, bx, L);
        pg8::Gemm g{X1B, W1T, MOE_F8 ? DM / 2 : DM}; pg8::EpiMoe1 E{H, tabA, (const LAS float*)tabB}; pg8::ListOrder SL{udl, nun, tabA};
        pg8::gemm_phase<pg8::EpiMoe1, pg8::ListOrder, true, true, MOE_F8>(L + RING_OFF, g, SL, E);
    } else {
    for (int g = gw; g < MAX_TILES * 16; g += NGW) {
        int e, base, p0, cnt; if (!moe_tile(CNT, g, e, base, p0, cnt)) continue;
        for (int cg = 0; cg < DFF / 32; ++cg) nv_moe1(X1B, W1T, a.b1, RSTD2, LIST, H, e, base, p0, cnt, cg, lane);
    } }
    xcd_barrier(bar); if (REP_PHASE == 8) xcd_barrier(bar);
    REPS(6) if (OPT_GEMM) {
        const int nun = moe_prepare<4, false>(CNT, LIST, RSTD2, RW, a.b2, TBG, bx, L);
        pg8::Gemm g{H, W2T, MOE_F8 ? DM / 2 : DM}; pg8::EpiMoe2 E{Y, (const LAS float*)tabA, (const LAS float*)tabB}; pg8::ListOrder SL{udl, nun, tabA};
        pg8::gemm_phase<pg8::EpiMoe2, pg8::ListOrder, true, false, MOE_F8>(L + RING_OFF, g, SL, E);
    } else {
    for (int g = gw; g < MAX_TILES * 16; g += NGW) {
        int e, base, p0, cnt; if (!moe_tile(CNT, g, e, base, p0, cnt)) continue;
        for (int cg = 0; cg < DM / 64; ++cg) nv_moe2(H, W2T, a.b2, RW, LIST, Y, e, base, p0, cnt, cg, lane);
    } }
    xcd_barrier(bar); if (REP_PHASE == 8) xcd_barrier(bar);
    if (REP_PHASE == 7) { for (int row = gw; row < M; row += NGW) final_row(a.out, Y, SLOTEP, TBG, a.gf, (float*)H, row, lane); }
    for (int row = gw; row < M; row += NGW) final_row(a.out, Y, SLOTEP, TBG, a.gf, a.out, row, lane);
}

extern "C" void kernel_launch(void* const* d_in, const int* in_sizes, int n_in, void* d_out, int out_size, void* d_ws, size_t ws_size, hipStream_t stream) {
    static int grid = 0;
    if (grid == 0) {
        if (n_in != 15 || in_sizes[0] != M * DM || out_size != M * DM || ws_size < WS_END) {
            fprintf(stderr, "kernel_launch: unexpected shapes / workspace (n_in %d, in0 %d, out %d, ws %zu, need %zu)\n", n_in, n_in > 0 ? in_sizes[0] : -1, out_size, ws_size, (size_t)WS_END); grid = -1; return; }
        int dev = 0, cus = 0, per_cu = 0;
        if (hipGetDevice(&dev) != hipSuccess || hipDeviceGetAttribute(&cus, hipDeviceAttributeMultiprocessorCount, dev) != hipSuccess) { grid = -1; return; }
        if (hipFuncSetAttribute((const void*)mega_fwd, hipFuncAttributeMaxDynamicSharedMemorySize, LDS_BYTES) != hipSuccess) { fprintf(stderr, "kernel_launch: hipFuncSetAttribute failed\n"); grid = -1; return; }
        if (hipOccupancyMaxActiveBlocksPerMultiprocessor(&per_cu, (const void*)mega_fwd, NTHREADS, LDS_BYTES) != hipSuccess || per_cu < 1) fprintf(stderr, "kernel_launch: occupancy query reports %d\n", per_cu);
        (void)hipGetLastError();
        grid = cus;
    }
    if (grid < 0) return;
    if (hipMemsetAsync((char*)d_ws + WS_CTL, 0, CTL_BYTES, stream) != hipSuccess) return;
    Args a{};
    a.x = (const float*)d_in[0]; a.g1 = (const float*)d_in[1]; a.w_in = (const float*)d_in[2]; a.b_f = (const float*)d_in[3]; a.g_fox = (const float*)d_in[4]; a.g_sb = (const float*)d_in[5];
    a.w_out = (const float*)d_in[6]; a.g2 = (const float*)d_in[7]; a.w_router = (const float*)d_in[8]; a.b_router = (const float*)d_in[9]; a.w1 = (const float*)d_in[10]; a.b1 = (const float*)d_in[11];
    a.w2 = (const float*)d_in[12]; a.b2 = (const float*)d_in[13]; a.gf = (const float*)d_in[14];
    a.out = (float*)d_out; a.ws = (unsigned char*)d_ws;
    hipLaunchKernelGGL(mega_fwd, dim3(grid), dim3(NTHREADS), LDS_BYTES, stream, a);
    const hipError_t le = hipPeekAtLastError();
    if (le != hipSuccess) fprintf(stderr, "kernel_launch: launch failed: %s\n", hipGetErrorName(le));
}
```

```cpp
#include <hip/hip_runtime.h>
#include <cstdio>
#include <cstdint>

typedef unsigned short bf16_t;
typedef short bf16x8 __attribute__((ext_vector_type(8)));
typedef float f32x4 __attribute__((ext_vector_type(4)));

constexpr int NB = 4, SEQ = 4096, DM = 1024, M = NB * SEQ;
constexpr int NH = 8, HD = 64, GW = 512;
constexpr int WIN_N = 3080, NPROJ = 3072;
constexpr int NE = 32, TOPK = 4, DFF = 1024;
constexpr float EPS = 1e-5f;
constexpr float LOG2E = 1.4426950408889634f;
constexpr float C2 = 0.125f * LOG2E;
constexpr int LIST_CAP = M;
constexpr int MAX_TILES = (M * TOPK) / 256 + NE;

constexpr size_t MiB = 1u << 20;
constexpr size_t WS_CTL = 0, CTL_BYTES = 1 * MiB;
constexpr size_t WS_WINT = 2 * MiB;
constexpr size_t WS_WOUTT = 8 * MiB;
constexpr size_t WS_WR = 10 * MiB;
constexpr size_t WS_CUM = 11 * MiB;
constexpr size_t WS_SSQ = 12 * MiB;
constexpr size_t WS_RSTD2 = 14 * MiB;
constexpr size_t WS_RW = 15 * MiB;
constexpr size_t WS_SLOTEP = 15 * MiB + 512 * 1024;
constexpr size_t WS_TBG = 14 * MiB + 512 * 1024;
constexpr size_t WS_LIST = 16 * MiB;
constexpr size_t WS_FLOG = 18 * MiB;
constexpr size_t WS_XN = 32 * MiB;
constexpr size_t WS_PROJ = 64 * MiB;
constexpr size_t WS_OMIX = 160 * MiB;
constexpr size_t WS_X1B = 192 * MiB;
constexpr size_t WS_W1T = 224 * MiB;
constexpr size_t WS_W2T = 352 * MiB;
constexpr size_t WS_H = 416 * MiB;
constexpr size_t WS_Y = 560 * MiB;
constexpr size_t WS_END = 704 * MiB;
constexpr int CW_CNT = 1024;
constexpr int CW_QHP = 2048, CW_KHP = 2112;

__device__ __forceinline__ unsigned short f2bf(float f) { unsigned u = __float_as_uint(f); return (unsigned short)((u + 0x7fffu + ((u >> 16) & 1u)) >> 16); }
__device__ __forceinline__ float bf2f(unsigned short b) { return __uint_as_float(((unsigned)b) << 16); }
__device__ __forceinline__ float wave_sum(float v) {
#pragma unroll
    for (int o = 1; o < 64; o <<= 1) v += __shfl_xor(v, o);
    return v;
}


#define LAS __attribute__((address_space(3)))
#define GAS __attribute__((address_space(1)))
typedef unsigned v4u __attribute__((ext_vector_type(4)));
#define LDS_WAIT() asm volatile("s_waitcnt lgkmcnt(0)" ::: "memory")
#define VM_WAIT() asm volatile("s_waitcnt vmcnt(0)" ::: "memory")
constexpr int NWAVES = 8, NTHREADS = NWAVES * 64;
constexpr int REP_PHASE = -1;
#define REPS(k) for (int rep_ = 0; rep_ < ((REP_PHASE == (k)) ? 2 : 1); ++rep_)
constexpr bool ATTN_SCHED = true;
constexpr bool FOX_SKIP = true;
constexpr bool WT_STORES = false;
constexpr bool Y_F8 = false;
constexpr bool MOE_F8 = true;
constexpr int NCVT = 10;
constexpr int CVT_SPLIT = 20 * 512;
constexpr bool OVERLAP_CVT = true;
constexpr bool OPT_GEMM = true;
constexpr bool OPT_ROUTER = true;
constexpr bool OPT_ATTN = true;

#define XB_TMO      128
#define XB_XCNT(j)  (256  + 64 * (j))
#define XB_XSUB(j)  (1280 + 64 * (j))
#define XB_XGEN(j)  (2304 + 64 * (j))
#define XB_TOP      3328
#define XB_TOPGEN   3392
#define XCD_BAR_WORDS 3456
#define XB_SPIN_CAP (1u << 20)
__device__ __forceinline__ unsigned xb_ld(unsigned* p)              { return __hip_atomic_load(p, __ATOMIC_RELAXED, __HIP_MEMORY_SCOPE_AGENT); }
__device__ __forceinline__ unsigned xb_add(unsigned* p, unsigned v) { return __hip_atomic_fetch_add(p, v, __ATOMIC_RELAXED, __HIP_MEMORY_SCOPE_AGENT); }
__device__ __forceinline__ unsigned xb_xcc_id() { return (unsigned)__builtin_amdgcn_s_getreg((3 << 11) | 20) & 0xFu; }
#define XB_SPIN(cond, bar) do { unsigned _sp = 0; while (cond) { __builtin_amdgcn_s_sleep(1); \
    if ((++_sp & 255u) == 0u) { if (xb_ld(&(bar)[XB_TMO])) break; if (_sp > XB_SPIN_CAP) { atomicAdd(&(bar)[XB_TMO], 1u); break; } } } } while (0)
struct XcdBarrier { unsigned* bar; unsigned x; volatile LAS unsigned* st; };
__device__ __forceinline__ XcdBarrier xcd_barrier_post(unsigned* bar, volatile LAS unsigned* st) {
    XcdBarrier b; b.bar = bar; b.x = xb_xcc_id(); b.st = st;
    if (threadIdx.x == 0) (void)xb_add(&bar[XB_XCNT(b.x)], 1u);
    return b;
}
__device__ __forceinline__ void xcd_barrier_complete(unsigned* bar, unsigned x, unsigned& nloc, unsigned& nx) {
    const unsigned G = gridDim.x * gridDim.y * gridDim.z;
    unsigned sum, cnt, mine, sp = 0u;
    for (;;) {
        sum = 0u; cnt = 0u; mine = 0u;
#pragma unroll
        for (unsigned j = 0; j < 16; ++j) { const unsigned c = xb_ld(&bar[XB_XCNT(j)]); sum += c; cnt += (c > 0u) ? 1u : 0u; mine = (j == x) ? c : mine; }
        if (sum == G) break;
        __builtin_amdgcn_s_sleep(1);
        if ((++sp & 255u) == 0u) { if (xb_ld(&bar[XB_TMO])) break; if (sp > XB_SPIN_CAP) { atomicAdd(&bar[XB_TMO], 1u); break; } }
    }
    nloc = mine > 0u ? mine : 1u; nx = cnt > 0u ? cnt : 1u;
}
__device__ __forceinline__ void xcd_barrier(const XcdBarrier& b) {
    asm volatile("s_waitcnt vmcnt(0)" ::: "memory");
    __syncthreads();
    if (threadIdx.x == 0) {
        unsigned* bar = b.bar;
        __builtin_amdgcn_s_waitcnt(0);
        unsigned nloc = b.st[0], nx = b.st[1];
        if (nloc == 0u) { xcd_barrier_complete(bar, b.x, nloc, nx); b.st[0] = nloc; b.st[1] = nx; }
        const unsigned old = xb_add(&bar[XB_XSUB(b.x)], 1u);
        const unsigned gen = old / nloc;
        if (old + 1u == (gen + 1u) * nloc) {
            __builtin_amdgcn_fence(__ATOMIC_RELEASE, "agent");
            asm volatile("s_waitcnt vmcnt(0)" ::: "memory");
            const unsigned og = xb_add(&bar[XB_TOP], 1u);
            const unsigned tg = og / nx;
            if (og + 1u == (tg + 1u) * nx) xb_add(&bar[XB_TOPGEN], 1u);
            else XB_SPIN(xb_ld(&bar[XB_TOPGEN]) == tg, bar);
            __builtin_amdgcn_fence(__ATOMIC_ACQUIRE, "agent");
            xb_add(&bar[XB_XGEN(b.x)], 1u);
            asm volatile("s_waitcnt vmcnt(0)" ::: "memory");
        } else {
            XB_SPIN(xb_ld(&bar[XB_XGEN(b.x)]) == gen, bar);
            __builtin_amdgcn_fence(__ATOMIC_ACQUIRE, "agent");
            asm volatile("s_waitcnt vmcnt(0)" ::: "memory");
        }
    }
    __syncthreads();
}

constexpr int RING_OFF = 0, RING_BYTES = 131072;
constexpr int TAB_OFF = 131072;
constexpr int TAB2_OFF = TAB_OFF + 10 * 1024, TB_OFF = TAB_OFF + 20 * 1024;
constexpr int LDSCTL_OFF = 152576, MISC_OFF = LDSCTL_OFF + 320;
constexpr int LDS_BYTES = 155648;
constexpr int CW_BAR = 4096;

struct Args {
    const float *x, *g1, *w_in, *b_f, *g_fox, *g_sb, *w_out, *g2, *w_router, *b_router, *w1, *b1, *w2, *b2, *gf;
    float* out; unsigned char* ws;
};

__device__ __forceinline__ int mapcol(int mode, int n) {
    if (mode == 1) return n < 1536 ? n : n + 8;
    if (mode == 2) { const int pn = n >> 8, j = n & 255; return j < 128 ? 128 * pn + j : 1024 + 128 * pn + (j - 128); }
    return n;
}
__device__ __forceinline__ unsigned pk4_fp8(float a, float b, float c, float d) {
    a = __builtin_amdgcn_fmed3f(a, -448.f, 448.f); b = __builtin_amdgcn_fmed3f(b, -448.f, 448.f); c = __builtin_amdgcn_fmed3f(c, -448.f, 448.f); d = __builtin_amdgcn_fmed3f(d, -448.f, 448.f);
    int w = __builtin_amdgcn_cvt_pk_fp8_f32(a, b, 0, false); w = __builtin_amdgcn_cvt_pk_fp8_f32(c, d, w, true); return (unsigned)w;
}
__device__ __forceinline__ unsigned pk2(float lo, float hi) { unsigned r; asm("v_cvt_pk_bf16_f32 %0, %1, %2" : "=v"(r) : "v"(lo), "v"(hi)); return r; }
struct TrItem { const float* W; bf16_t* WT; const float* gA; const float* gB; int K, Nin, Nout, mode, gsplit, item, nbsh, f8; };
template <bool NT> __device__ __forceinline__ void tr_load(const TrItem& t, int lane, f32x4 (&v)[8]) {
    const int nblk = t.Nout / 32, kb = t.nbsh >= 0 ? (t.item >> t.nbsh) : t.item / nblk, nb = t.nbsh >= 0 ? (t.item & (nblk - 1)) : t.item % nblk, k0 = 64 * kb, n0 = 32 * nb, l7 = lane & 7, kr = lane >> 3, col = mapcol(t.mode, n0 + 4 * l7);
#pragma unroll
    for (int i = 0; i < 8; ++i) { const f32x4* p = (const f32x4*)(t.W + (size_t)(k0 + 8 * i + kr) * t.Nin + col); v[i] = NT ? __builtin_nontemporal_load(p) : *p; }
}
__device__ __forceinline__ void tr_store(const TrItem& t, int lane, const f32x4 (&v)[8], LAS float* scr) {
    const int nblk = t.Nout / 32, kb = t.nbsh >= 0 ? (t.item >> t.nbsh) : t.item / nblk, nb = t.nbsh >= 0 ? (t.item & (nblk - 1)) : t.item % nblk, k0 = 64 * kb, n0 = 32 * nb, l7 = lane & 7, kr = lane >> 3;
#pragma unroll
    for (int i = 0; i < 8; ++i) { const int kk = 8 * i + kr, k = k0 + kk; const float gs = t.gA ? (k < t.gsplit ? t.gA[k] : t.gB[k - t.gsplit]) : 1.f;
        LAS float* sp = scr + kk * 33 + 4 * l7; sp[0] = v[i][0] * gs; sp[1] = v[i][1] * gs; sp[2] = v[i][2] * gs; sp[3] = v[i][3] * gs; }
    LDS_WAIT();
    if (t.f8) {
        const int c = lane & 3;
#pragma unroll
        for (int j = 0; j < 2; ++j) { const int n = (lane >> 2) + 16 * j; const LAS float* sp = scr + (16 * c) * 33 + n;
            v4u o; o.x = pk4_fp8(32.f * sp[0 * 33], 32.f * sp[1 * 33], 32.f * sp[2 * 33], 32.f * sp[3 * 33]); o.y = pk4_fp8(32.f * sp[4 * 33], 32.f * sp[5 * 33], 32.f * sp[6 * 33], 32.f * sp[7 * 33]);
            o.z = pk4_fp8(32.f * sp[8 * 33], 32.f * sp[9 * 33], 32.f * sp[10 * 33], 32.f * sp[11 * 33]); o.w = pk4_fp8(32.f * sp[12 * 33], 32.f * sp[13 * 33], 32.f * sp[14 * 33], 32.f * sp[15 * 33]);
            *(v4u*)((unsigned char*)t.WT + (size_t)(n0 + n) * t.K + k0 + 16 * c) = o; }
    } else {
    const int c = lane & 7;
#pragma unroll
    for (int j = 0; j < 4; ++j) { const int n = (lane >> 3) + 8 * j; const LAS float* sp = scr + (8 * c) * 33 + n;
        v4u o; o.x = pk2(sp[0 * 33], sp[1 * 33]); o.y = pk2(sp[2 * 33], sp[3 * 33]); o.z = pk2(sp[4 * 33], sp[5 * 33]); o.w = pk2(sp[6 * 33], sp[7 * 33]);
        *(v4u*)(t.WT + (size_t)(n0 + n) * t.K + k0 + 8 * c) = o; }
    }
    LDS_WAIT();
}
constexpr int I_W1 = (DM / 64) * (2048 / 32), I_W2 = (DM / 64) * (DM / 32), N_EXP_ITEMS = NE * (I_W1 + I_W2);
__device__ __forceinline__ TrItem expert_item(const float* w1, const float* w2, const float* g2, bf16_t* W1T, bf16_t* W2T, int r) {
    TrItem t;
    t.f8 = MOE_F8 ? 1 : 0;
    if (r < NE * I_W1) { const int e = r / I_W1; t.W = w1 + (size_t)e * DM * 2048; t.WT = MOE_F8 ? (bf16_t*)((unsigned char*)W1T + (size_t)e * 2048 * DM) : W1T + (size_t)e * 2048 * DM; t.gA = g2; t.gB = nullptr; t.K = DM; t.Nin = 2048; t.Nout = 2048; t.mode = 2; t.gsplit = DM; t.item = r % I_W1; t.nbsh = 6; }
    else { r -= NE * I_W1; const int e = r / I_W2; t.W = w2 + (size_t)e * DM * DM; t.WT = MOE_F8 ? (bf16_t*)((unsigned char*)W2T + (size_t)e * DM * DM) : W2T + (size_t)e * DM * DM; t.gA = nullptr; t.gB = nullptr; t.K = DM; t.Nin = DM; t.Nout = DM; t.mode = 0; t.gsplit = DM; t.item = r % I_W2; t.nbsh = 5; }
    return t;
}
__device__ __forceinline__ void convert_experts(const float* w1, const float* w2, const float* g2, bf16_t* W1T, bf16_t* W2T, int first, int stride, int N_END, int lane, LAS float* scr) {
    f32x4 v0[8], v1[8];
#define CVT_LOAD(v, idx) do { if ((idx) < N_END) { const TrItem t_ = expert_item(w1, w2, g2, W1T, W2T, (idx)); tr_load<true>(t_, lane, v); } } while (0)
#define CVT_STORE(v, idx) do { if ((idx) < N_END) { const TrItem t_ = expert_item(w1, w2, g2, W1T, W2T, (idx)); tr_store(t_, lane, v, scr); } } while (0)
    int it = first; asm volatile("" : "+v"(lane));
    CVT_LOAD(v0, it);
#pragma unroll 1
    for (; it < N_END; it += 2 * stride) {
        CVT_LOAD(v1, it + stride); CVT_STORE(v0, it);
        CVT_LOAD(v0, it + 2 * stride); CVT_STORE(v1, it + stride);
    }
#undef CVT_LOAD
#undef CVT_STORE
}

__device__ __forceinline__ float log_sigmoid(float v) { return fminf(v, 0.f) - log1pf(expf(-fabsf(v))); }
__device__ __forceinline__ void rms1_row(const float* __restrict__ x, const LAS float* wf  , const float* __restrict__ b_f,
                                         bf16_t* __restrict__ XN, float* __restrict__ FLOG, int row, int lane) {
    const float4* xr = (const float4*)(x + (size_t)row * DM);
    float4 v[4]; float ss = 0.f;
#pragma unroll
    for (int j = 0; j < 4; ++j) { v[j] = xr[lane + 64 * j]; ss += v[j].x * v[j].x + v[j].y * v[j].y + v[j].z * v[j].z + v[j].w * v[j].w; }
    ss = wave_sum(ss);
    const float rstd = rsqrtf(ss * (1.f / DM) + EPS);
    float f0 = 0.f, f1 = 0.f, f2 = 0.f, f3 = 0.f, f4 = 0.f, f5 = 0.f, f6 = 0.f, f7 = 0.f;
#pragma unroll
    for (int j = 0; j < 4; ++j) {
        const int c0 = 4 * (lane + 64 * j);
        uint2 o; o.x = pk2(v[j].x * rstd, v[j].y * rstd); o.y = pk2(v[j].z * rstd, v[j].w * rstd);
        *(uint2*)(XN + (size_t)row * DM + c0) = o;
        const float xs[4] = {v[j].x, v[j].y, v[j].z, v[j].w};
#pragma unroll
        for (int c = 0; c < 4; ++c) {
            const int k = c0 + c; const float xv = xs[c];
            const LAS f32x4* wp = (const LAS f32x4*)(wf + k * 8); const f32x4 w0 = wp[0], w1 = wp[1];
            f0 += xv * w0.x; f1 += xv * w0.y; f2 += xv * w0.z; f3 += xv * w0.w; f4 += xv * w1.x; f5 += xv * w1.y; f6 += xv * w1.z; f7 += xv * w1.w;
        }
    }
    f0 = wave_sum(f0); f1 = wave_sum(f1); f2 = wave_sum(f2); f3 = wave_sum(f3); f4 = wave_sum(f4); f5 = wave_sum(f5); f6 = wave_sum(f6); f7 = wave_sum(f7);
    if (lane < 8) {
        float f = f0; f = lane == 1 ? f1 : f; f = lane == 2 ? f2 : f; f = lane == 3 ? f3 : f; f = lane == 4 ? f4 : f; f = lane == 5 ? f5 : f; f = lane == 6 ? f6 : f; f = lane == 7 ? f7 : f;
        FLOG[(size_t)row * 8 + lane] = log_sigmoid(f * rstd + b_f[lane]);
    }
}
__device__ __forceinline__ void cumsum_wg(const float* __restrict__ FLOG, float* __restrict__ CUM, int bh, LAS float* part) {
    const int b = bh >> 3, h = bh & 7, t = threadIdx.x;
    float loc[8]; float s = 0.f;
#pragma unroll
    for (int i = 0; i < 8; ++i) { loc[i] = FLOG[((size_t)b * SEQ + t * 8 + i) * 8 + h]; s += loc[i]; }
    part[t] = s; __syncthreads();
    float run = 0.f; for (int i = 0; i < t; ++i) run += part[i];
#pragma unroll
    for (int i = 0; i < 8; ++i) { run += loc[i]; CUM[(size_t)bh * SEQ + t * 8 + i] = run * LOG2E; }
    __syncthreads();
}

template <int NT> __device__ __forceinline__ void wave_mma(f32x4 (&acc)[NT], const bf16_t* ap, const bf16_t* const (&bp)[NT], int K) {
    for (int k0 = 0; k0 < K; k0 += 32) {
        const bf16x8 a = *(const bf16x8*)(ap + k0);
#pragma unroll
        for (int t = 0; t < NT; ++t) { const bf16x8 b = *(const bf16x8*)(bp[t] + k0); acc[t] = __builtin_amdgcn_mfma_f32_16x16x32_bf16(a, b, acc[t], 0, 0, 0); }
    }
}
__device__ __forceinline__ void nv_inproj(const bf16_t* __restrict__ XN, const bf16_t* __restrict__ WINT, bf16_t* __restrict__ PROJ, int item, int lane) {
    const int n0 = (item % 48) * 64, m0 = (item / 48) * 16, r = lane & 15, q = lane >> 4;
    f32x4 acc[4];
#pragma unroll
    for (int t = 0; t < 4; ++t) acc[t] = (f32x4){0.f, 0.f, 0.f, 0.f};
    const bf16_t* ap = XN + (size_t)(m0 + r) * DM + 8 * q;
    const bf16_t* bp[4];
#pragma unroll
    for (int t = 0; t < 4; ++t) bp[t] = WINT + (size_t)(n0 + 16 * t + r) * DM + 8 * q;
    wave_mma<4>(acc, ap, bp, DM);
    const float sc = (n0 < 512 || (n0 >= 1536 && n0 < 2048)) ? C2 : 1.f;
#pragma unroll
    for (int t = 0; t < 4; ++t)
#pragma unroll
        for (int j = 0; j < 4; ++j) PROJ[(size_t)(m0 + 4 * q + j) * NPROJ + n0 + 16 * t + r] = f2bf(acc[t][j] * sc);
}

template <int TYPE> __device__ __forceinline__ void nv_attn(const bf16_t* __restrict__ PROJ, const float* __restrict__ CUM, bf16_t* __restrict__ OMIX, float* __restrict__ SSQ,
                                                          int bh, int qblk, int lane, LAS unsigned char* wl) {
    LAS bf16_t* Ks = (LAS bf16_t*)wl; LAS bf16_t* Vs = (LAS bf16_t*)(wl + 8192); LAS float* Cs = (LAS float*)(wl + 16384);
    const int b = bh >> 3, h = bh & 7, t = qblk * 64 + lane;
    const size_t row = (size_t)b * SEQ + t;
    const int qcol = (TYPE == 0 ? 0 : 1536) + h * HD, kcol = qcol + 512, vcol = qcol + 1024;
    float q[64], o[64];
#pragma unroll
    for (int c = 0; c < 8; ++c) { const bf16x8 v = *(const bf16x8*)(PROJ + row * NPROJ + qcol + 8 * c);
#pragma unroll
        for (int j = 0; j < 8; ++j) q[8 * c + j] = bf2f((unsigned short)v[j]); }
#pragma unroll
    for (int d = 0; d < 64; ++d) o[d] = 0.f;
    float m = -INFINITY, l = 0.f, R = 1.f;
    const float cq = CUM[(size_t)bh * SEQ + t];
    for (int it = 0; it <= qblk; ++it) {
        const int kt = (TYPE == 0) ? it : qblk - it;
        LDS_WAIT();
        for (int i = 0; i < 64; ++i) { const size_t kr = ((size_t)b * SEQ + kt * 64 + i) * NPROJ; Ks[i * 64 + lane] = PROJ[kr + kcol + lane]; Vs[i * 64 + lane] = PROJ[kr + vcol + lane]; }
        Cs[lane] = CUM[(size_t)bh * SEQ + kt * 64 + lane];
        LDS_WAIT();
        for (int ss = 0; ss < 64; ++ss) {
            const int s = (TYPE == 0) ? ss : 63 - ss; const int ks = kt * 64 + s;
            float dot = 0.f;
#pragma unroll
            for (int d = 0; d < 64; d += 8) { const bf16x8 kv = *(const LAS bf16x8*)&Ks[s * 64 + d];
#pragma unroll
                for (int j = 0; j < 8; ++j) dot += q[d + j] * bf2f((unsigned short)kv[j]); }
            if (TYPE == 0) {
                if (ks <= t) {
                    const float xv = dot + cq - Cs[s]; const float mn = fmaxf(m, xv); const float sc = exp2f(m - mn), p = exp2f(xv - mn);
                    l = l * sc + p; m = mn;
#pragma unroll
                    for (int d = 0; d < 64; d += 8) { const bf16x8 vv = *(const LAS bf16x8*)&Vs[s * 64 + d];
#pragma unroll
                        for (int j = 0; j < 8; ++j) o[d + j] = o[d + j] * sc + p * bf2f((unsigned short)vv[j]); }
                }
            } else {
                if (ks < t) {
                    const float z = fminf(fmaxf(dot, -80.f), 80.f); const float e = exp2f(z); const float rr = 1.f / (1.f + e); const float a = e * rr * R; R *= rr;
#pragma unroll
                    for (int d = 0; d < 64; d += 8) { const bf16x8 vv = *(const LAS bf16x8*)&Vs[s * 64 + d];
#pragma unroll
                        for (int j = 0; j < 8; ++j) o[d + j] += a * bf2f((unsigned short)vv[j]); }
                }
            }
        }
    }
    const float inv = (TYPE == 0) ? 1.f / l : 1.f;
    float ssq = 0.f;
#pragma unroll
    for (int d = 0; d < 64; ++d) { o[d] *= inv; ssq += o[d] * o[d]; }
    SSQ[row * 16 + TYPE * 8 + h] = ssq;
#pragma unroll
    for (int c = 0; c < 8; ++c) { bf16x8 v;
#pragma unroll
        for (int j = 0; j < 8; ++j) v[j] = (short)f2bf(o[8 * c + j]);
        *(bf16x8*)(OMIX + row * DM + TYPE * GW + h * HD + 8 * c) = v; }
}

__device__ __forceinline__ void nv_wout(const bf16_t* __restrict__ OMIX, const bf16_t* __restrict__ WOUTT, const float* __restrict__ SSQ, const float* __restrict__ x,
                                        float* __restrict__ X1, bf16_t* __restrict__ X1B, int item, int lane) {
    const int n0 = (item & 15) * 64, m0 = (item >> 4) * 16, r = lane & 15, q = lane >> 4;
    f32x4 af[4], as[4];
#pragma unroll
    for (int t = 0; t < 4; ++t) { af[t] = (f32x4){0.f, 0.f, 0.f, 0.f}; as[t] = (f32x4){0.f, 0.f, 0.f, 0.f}; }
    const bf16_t* ap = OMIX + (size_t)(m0 + r) * DM + 8 * q;
    const bf16_t* bp[4]; const bf16_t* bp2[4];
#pragma unroll
    for (int t = 0; t < 4; ++t) { bp[t] = WOUTT + (size_t)(n0 + 16 * t + r) * DM + 8 * q; bp2[t] = bp[t] + GW; }
    wave_mma<4>(af, ap, bp, GW);
    wave_mma<4>(as, ap + GW, bp2, GW);
#pragma unroll
    for (int j = 0; j < 4; ++j) {
        const size_t row = m0 + 4 * q + j; const float* sp = SSQ + row * 16;
        float sf = 0.f, s2 = 0.f;
#pragma unroll
        for (int h = 0; h < 8; ++h) { sf += sp[h]; s2 += sp[8 + h]; }
        const float rf = rsqrtf(sf * (1.f / GW) + EPS), rs = rsqrtf(s2 * (1.f / GW) + EPS);
#pragma unroll
        for (int t = 0; t < 4; ++t) { const size_t idx = row * DM + n0 + 16 * t + r; const float v = x[idx] + rf * af[t][j] + rs * as[t][j]; X1[idx] = v; X1B[idx] = f2bf(v); }
    }
}

__device__ __forceinline__ void nv_router(const float* __restrict__ X1, const float* __restrict__ WR, const float* __restrict__ b_router, float* __restrict__ RSTD2,
                                          float* __restrict__ RW, int* __restrict__ LIST, int* __restrict__ SLOTEP, unsigned* __restrict__ CNT, int item, int lane) {
    const int e = lane & 31, tok = item * 2 + (lane >> 5);
    const float* xr = X1 + (size_t)tok * DM;
    float acc = 0.f, ss = 0.f;
    for (int k = 0; k < DM; ++k) { const float xv = xr[k]; acc += xv * WR[k * NE + e]; ss += xv * xv; }
    const float rstd = rsqrtf(ss * (1.f / DM) + EPS);
    float logit = acc * rstd + b_router[e];
    if (e == 0) RSTD2[tok] = rstd;
    float tv[4]; int ti[4];
#pragma unroll
    for (int k = 0; k < 4; ++k) {
        float bv = logit; int bi = e;
#pragma unroll
        for (int o = 1; o < 32; o <<= 1) { const float ov = __shfl_xor(bv, o); const int oi = __shfl_xor(bi, o); if (ov > bv || (ov == bv && oi < bi)) { bv = ov; bi = oi; } }
        tv[k] = bv; ti[k] = bi; if (e == bi) logit = -INFINITY;
    }
    const float e0 = 1.f, e1 = expf(tv[1] - tv[0]), e2 = expf(tv[2] - tv[0]), e3 = expf(tv[3] - tv[0]); const float inv = 1.f / (e0 + e1 + e2 + e3);
    const float w0 = e0 * inv, w1 = e1 * inv, w2 = e2 * inv, w3 = e3 * inv;
    int myk = -1; float myw = 0.f;
    if (e == ti[0]) { myk = 0; myw = w0; } if (e == ti[1]) { myk = 1; myw = w1; } if (e == ti[2]) { myk = 2; myw = w2; } if (e == ti[3]) { myk = 3; myw = w3; }
    if (myk >= 0) { const int slot = tok * 4 + myk; const unsigned pos = atomicAdd(&CNT[e], 1u); LIST[(size_t)e * LIST_CAP + pos] = slot; RW[slot] = myw; SLOTEP[slot] = e * 16384 + (int)pos; }
}


typedef float f32x16 __attribute__((ext_vector_type(16)));
__device__ __forceinline__ void router_wg(const float* __restrict__ X1, const float* __restrict__ WR, const float* __restrict__ b_router, float* __restrict__ RSTD2,
                                          float* __restrict__ RW, int* __restrict__ LIST, int* __restrict__ SLOTEP, unsigned* __restrict__ CNT, int tokbase, LAS unsigned char* L) {
    int tid_ = threadIdx.x; asm volatile("" : "+v"(tid_));
    const int tid = tid_, lane = tid & 63, wave = __builtin_amdgcn_readfirstlane(tid >> 6), kq = wave & 3, tile = wave >> 2, r32 = lane & 31, hi = lane >> 5;
    LAS float* Dx = (LAS float*)L; LAS float* SSx = (LAS float*)(L + 32768); LAS unsigned* lcnt = (LAS unsigned*)(L + 33792); LAS unsigned* lbase = (LAS unsigned*)(L + 33920);
    if (tid < NE) lcnt[tid] = 0u;
    const int tok = tokbase + tile * 32 + r32;
    const float* xp = X1 + (size_t)tok * DM + kq * 256 + 4 * hi;
    const float* wp = WR + (size_t)(kq * 256 + 4 * hi) * NE + r32;
    f32x16 acc;
#pragma unroll
    for (int r = 0; r < 16; ++r) acc[r] = 0.f;
    float ss = 0.f;
#pragma unroll 1
    for (int mc = 0; mc < 4; ++mc) {
        float4 xv[8];
#pragma unroll
        for (int m = 0; m < 8; ++m) xv[m] = *(const float4*)(xp + (mc * 8 + m) * 8);
#pragma unroll
        for (int m = 0; m < 8; ++m) {
            const float* w4 = wp + (size_t)((mc * 8 + m) * 8) * NE;
            const float w0 = w4[0], w1 = w4[NE], w2 = w4[2 * NE], w3 = w4[3 * NE];
            acc = __builtin_amdgcn_mfma_f32_32x32x2f32(w0, xv[m].x, acc, 0, 0, 0);
            acc = __builtin_amdgcn_mfma_f32_32x32x2f32(w1, xv[m].y, acc, 0, 0, 0);
            acc = __builtin_amdgcn_mfma_f32_32x32x2f32(w2, xv[m].z, acc, 0, 0, 0);
            acc = __builtin_amdgcn_mfma_f32_32x32x2f32(w3, xv[m].w, acc, 0, 0, 0);
            ss += xv[m].x * xv[m].x + xv[m].y * xv[m].y + xv[m].z * xv[m].z + xv[m].w * xv[m].w;
        }
    }
    { auto rr = __builtin_amdgcn_permlane32_swap(__float_as_uint(ss), __float_as_uint(ss), false, false); ss = __uint_as_float(rr[0]) + __uint_as_float(rr[1]); }
#pragma unroll
    for (int r = 0; r < 16; ++r) Dx[(wave * 16 + r) * 64 + lane] = acc[r];
    if (hi == 0) SSx[wave * 32 + r32] = ss;
    LDS_WAIT(); __syncthreads();
    int ea = 0, eb = 0; float wa = 0.f, wb = 0.f; unsigned la = 0u, lb = 0u;
    if (kq == 0) {
        float v[16]; float sst = 0.f;
#pragma unroll
        for (int w = 0; w < 4; ++w) sst += SSx[(tile * 4 + w) * 32 + r32];
        const float rstd = rsqrtf(sst * (1.f / DM) + EPS);
#pragma unroll
        for (int r = 0; r < 16; ++r) { float a = 0.f;
#pragma unroll
            for (int w = 0; w < 4; ++w) a += Dx[((tile * 4 + w) * 16 + r) * 64 + lane];
            v[r] = a * rstd + b_router[(r & 3) + 8 * (r >> 2) + 4 * hi]; }
        if (hi == 0) RSTD2[tok] = rstd;
        float tv[4]; int te[4];
#pragma unroll
        for (int k = 0; k < 4; ++k) {
            float bv = v[0]; int br = 0;
#pragma unroll
            for (int r = 1; r < 16; ++r) if (v[r] > bv) { bv = v[r]; br = r; }
            const int be = (br & 3) + 8 * (br >> 2) + 4 * hi;
            auto r1 = __builtin_amdgcn_permlane32_swap(__float_as_uint(bv), __float_as_uint(bv), false, false);
            auto r2 = __builtin_amdgcn_permlane32_swap((unsigned)be, (unsigned)be, false, false);
            const float pv = __uint_as_float(hi ? r1[0] : r1[1]); const int pe = (int)(hi ? r2[0] : r2[1]);
            const bool mine = (bv > pv) || (bv == pv && be < pe);
            tv[k] = mine ? bv : pv; te[k] = mine ? be : pe;
#pragma unroll
            for (int r = 0; r < 16; ++r) v[r] = (mine && r == br) ? -INFINITY : v[r];
        }
        const float e1 = expf(tv[1] - tv[0]), e2 = expf(tv[2] - tv[0]), e3 = expf(tv[3] - tv[0]); const float inv = 1.f / (1.f + e1 + e2 + e3);
        ea = hi ? te[2] : te[0]; eb = hi ? te[3] : te[1]; wa = (hi ? e2 : 1.f) * inv; wb = (hi ? e3 : e1) * inv;
        la = atomicAdd((unsigned*)&lcnt[ea], 1u); lb = atomicAdd((unsigned*)&lcnt[eb], 1u);
    }
    LDS_WAIT(); __syncthreads();
    if (tid < NE) { const unsigned c = lcnt[tid]; lbase[tid] = c ? atomicAdd(&CNT[tid], c) : 0u; }
    LDS_WAIT(); __syncthreads();
    if (kq == 0) {
        const int sa = tok * 4 + 2 * hi, sb = sa + 1;
        const int pa = (int)(lbase[ea] + la), pb = (int)(lbase[eb] + lb);
        LIST[(size_t)ea * LIST_CAP + pa] = sa; RW[sa] = wa; SLOTEP[sa] = ea * 16384 + pa;
        LIST[(size_t)eb * LIST_CAP + pb] = sb; RW[sb] = wb; SLOTEP[sb] = eb * 16384 + pb;
    }
    LDS_WAIT(); __syncthreads();
}

__device__ __forceinline__ bool moe_tile(const unsigned* CNT, int g, int& e, int& base, int& p0, int& cnt) {
    const int tile256 = g >> 4; base = 0;
    for (e = 0; e < NE; ++e) { const int nt = ((int)CNT[e] + 255) >> 8; if (tile256 < base + nt) break; base += nt; }
    if (e == NE) return false;
    cnt = (int)CNT[e]; p0 = (g - base * 16) * 16; return p0 < cnt;
}
__device__ __forceinline__ void nv_moe1(const bf16_t* __restrict__ X1B, const bf16_t* __restrict__ W1T, const float* __restrict__ b1, const float* __restrict__ RSTD2,
                                        const int* __restrict__ LIST, bf16_t* __restrict__ H, int e, int base, int p0, int cnt, int cg, int lane) {
    const int r = lane & 15, q = lane >> 4, c0 = cg * 32, pn = c0 >> 7, j0 = c0 & 127;
    const int* lst = LIST + (size_t)e * LIST_CAP;
    const int prow = p0 + r; const int tok = lst[prow < cnt ? prow : cnt - 1] >> 2;
    f32x4 acc[4];
#pragma unroll
    for (int t = 0; t < 4; ++t) acc[t] = (f32x4){0.f, 0.f, 0.f, 0.f};
    const bf16_t* ap = X1B + (size_t)tok * DM + 8 * q;
    const bf16_t* wb = W1T + (size_t)e * 2048 * DM + (size_t)(256 * pn + j0 + r) * DM + 8 * q;
    const bf16_t* bp[4] = {wb, wb + 16 * DM, wb + 128 * DM, wb + 144 * DM};
    wave_mma<4>(acc, ap, bp, DM);
#pragma unroll
    for (int j = 0; j < 4; ++j) {
        const int pr = p0 + 4 * q + j; if (pr >= cnt) continue;
        const float rs = RSTD2[lst[pr] >> 2];
#pragma unroll
        for (int t = 0; t < 2; ++t) {
            const int col = c0 + 16 * t + r;
            float glu = acc[t][j] * rs + b1[(size_t)e * 2048 + col], lin = acc[t + 2][j] * rs + b1[(size_t)e * 2048 + 1024 + col];
            glu = fminf(glu, 7.f); lin = fminf(fmaxf(lin, -7.f), 7.f);
            const float act = glu * (1.f / (1.f + expf(-1.702f * glu))) * (lin + 1.f);
            H[((size_t)base * 256 + pr) * DM + col] = f2bf(act);
        }
    }
}
__device__ __forceinline__ void nv_moe2(const bf16_t* __restrict__ H, const bf16_t* __restrict__ W2T, const float* __restrict__ b2, const float* __restrict__ RW,
                                        const int* __restrict__ LIST, bf16_t* __restrict__ Y, int e, int base, int p0, int cnt, int cg, int lane) {
    const int r = lane & 15, q = lane >> 4, n0 = cg * 64;
    const int* lst = LIST + (size_t)e * LIST_CAP;
    f32x4 acc[4];
#pragma unroll
    for (int t = 0; t < 4; ++t) acc[t] = (f32x4){0.f, 0.f, 0.f, 0.f};
    const bf16_t* ap = H + ((size_t)base * 256 + p0 + r) * DM + 8 * q;
    const bf16_t* bp[4];
#pragma unroll
    for (int t = 0; t < 4; ++t) bp[t] = W2T + (size_t)e * DM * DM + (size_t)(n0 + 16 * t + r) * DM + 8 * q;
    wave_mma<4>(acc, ap, bp, DM);
#pragma unroll
    for (int j = 0; j < 4; ++j) {
        const int pr = p0 + 4 * q + j; if (pr >= cnt) continue;
        const int slot = lst[pr]; const float w = RW[slot];
#pragma unroll
        for (int t = 0; t < 4; ++t) { const int col = n0 + 16 * t + r; Y[((size_t)base * 256 + pr) * DM + col] = f2bf((acc[t][j] + b2[(size_t)e * DM + col]) * w); }
    }
}

__device__ __forceinline__ void final_row(const float* X1, const bf16_t* __restrict__ Y, const int* __restrict__ SLOTEP, const int* __restrict__ TBG, const float* __restrict__ gf, float* out, int row, int lane) {
    int yr[4];
#pragma unroll
    for (int k = 0; k < 4; ++k) { const int ep = SLOTEP[row * 4 + k]; yr[k] = TBG[ep >> 14] * 256 + (ep & 16383); }
    float ss = 0.f;
    if (Y_F8) {
        const int c0 = 16 * lane; f32x4 v[4];
#pragma unroll
        for (int j = 0; j < 4; ++j) v[j] = *(const f32x4*)(X1 + (size_t)row * DM + c0 + 4 * j);
#pragma unroll
        for (int k = 0; k < 4; ++k) { const v4u y = *(const v4u*)((const unsigned char*)Y + (size_t)yr[k] * DM + c0);
#pragma unroll
            for (int j = 0; j < 4; ++j) { const auto lo = __builtin_amdgcn_cvt_pk_f32_fp8((int)y[j], false), hi = __builtin_amdgcn_cvt_pk_f32_fp8((int)y[j], true);
                v[j][0] += lo[0] * 0.0625f; v[j][1] += lo[1] * 0.0625f; v[j][2] += hi[0] * 0.0625f; v[j][3] += hi[1] * 0.0625f; } }
#pragma unroll
        for (int j = 0; j < 4; ++j) ss += v[j][0] * v[j][0] + v[j][1] * v[j][1] + v[j][2] * v[j][2] + v[j][3] * v[j][3];
        ss = wave_sum(ss);
        const float rstd = rsqrtf(ss * (1.f / DM) + EPS);
#pragma unroll
        for (int j = 0; j < 4; ++j) { const f32x4 g = *(const f32x4*)(gf + c0 + 4 * j); *(f32x4*)(out + (size_t)row * DM + c0 + 4 * j) = v[j] * rstd * g; }
        return;
    }
    float4 v[4];
#pragma unroll
    for (int j = 0; j < 4; ++j) {
        const int c0 = 4 * (lane + 64 * j);
        v[j] = *(const float4*)(X1 + (size_t)row * DM + c0);
#pragma unroll
        for (int k = 0; k < 4; ++k) { const uint2 y = *(const uint2*)(Y + (size_t)yr[k] * DM + c0);
            v[j].x += bf2f((unsigned short)(y.x & 0xffff)); v[j].y += bf2f((unsigned short)(y.x >> 16)); v[j].z += bf2f((unsigned short)(y.y & 0xffff)); v[j].w += bf2f((unsigned short)(y.y >> 16)); }
        ss += v[j].x * v[j].x + v[j].y * v[j].y + v[j].z * v[j].z + v[j].w * v[j].w;
    }
    ss = wave_sum(ss);
    const float rstd = rsqrtf(ss * (1.f / DM) + EPS);
#pragma unroll
    for (int j = 0; j < 4; ++j) { const int c0 = 4 * (lane + 64 * j); const float4 g = *(const float4*)(gf + c0);
        float4 o; o.x = v[j].x * rstd * g.x; o.y = v[j].y * rstd * g.y; o.z = v[j].z * rstd * g.z; o.w = v[j].w * rstd * g.w; *(float4*)(out + (size_t)row * DM + c0) = o; }
}


namespace pg8 {
#define PG8_LAS __attribute__((address_space(3)))
typedef unsigned u32x4 __attribute__((ext_vector_type(4)));
typedef unsigned u32x2 __attribute__((ext_vector_type(2)));
typedef int i32x8 __attribute__((ext_vector_type(8)));
constexpr int BM = 256, BK = 64, HALF = 128, HTB = HALF * BK * 2  , STAGE_BYTES = 8 * HTB, NXCD = 8, WGM = 8;
__host__ __device__ __forceinline__ int lds_byte(int r, int c) { const int st = (r >> 4) * 2 + (c >> 5), rr = r & 15, cc = c & 31, ob = rr * 64 + cc * 2; return st * 1024 + (ob ^ (((ob >> 9) & 1) << 5)); }
__host__ __device__ __forceinline__ void stage_rc(int b, int& R, int& C) { const int st = b / 1024, sb = b % 1024, swz = sb ^ (((sb >> 9) & 1) << 5); R = (st >> 1) * 16 + swz / 64; C = (st & 1) * 32 + (swz % 64) / 2; }
__host__ __device__ __forceinline__ int perm32(int rho) { const int n = rho >> 4, i = rho & 15; return 8 * (i >> 2) + 4 * n + (i & 3); }
struct Unit { int pm, pn, nr; };
struct Gemm { const bf16_t* A; const bf16_t* Bt; int K; };
__device__ __forceinline__ void st16_wt(void* p, u32x4 v) { if (WT_STORES) asm volatile("global_store_dwordx4 %0, %1, off sc0 sc1\n\ts_nop 1" :: "v"(p), "v"(v) : "memory"); else *(u32x4*)p = v; }
__device__ __forceinline__ void st8_wt(void* p, u32x2 v) { if (WT_STORES) asm volatile("global_store_dwordx2 %0, %1, off sc0 sc1\n\ts_nop 1" :: "v"(p), "v"(v) : "memory"); else *(u32x2*)p = v; }
struct StaticOrder {
    int nM, nN, nwg, G, c;
    __device__ void init(int M_, int N_, int G_, int c_) { nM = M_ / BM; nN = N_ / BM; nwg = nM * nN; G = G_; c = c_; }
    __device__ bool next(int i, Unit& u) const {
        const long L = (long)i * G + c; if (L >= nwg) return false;
        int wgid = (int)L; { const int q = nwg / NXCD, r = nwg % NXCD, xcd = wgid % NXCD, off = wgid / NXCD; wgid = (xcd < r ? xcd * (q + 1) : r * (q + 1) + (xcd - r) * q) + off; }
        const int nig = WGM * nN, gid = wgid / nig, fm = gid * WGM, gsz = (nM - fm) < WGM ? (nM - fm) : WGM;
        u.pm = fm + ((wgid % nig) % gsz); u.pn = (wgid % nig) / gsz; u.nr = BM; return true;
    }
    __device__ __forceinline__ const PG8_LAS int* rowtab(int) const { return nullptr; }
};
__device__ __forceinline__ unsigned cvt_pk_bf16(float lo, float hi) { unsigned r; asm volatile("v_cvt_pk_bf16_f32 %0, %1, %2" : "=v"(r) : "v"(lo), "v"(hi)); return r; }

template <class Sched> __device__ __forceinline__ void gather_voffs(const Sched& S, int ui, int tid, int K, unsigned (&o0)[2], unsigned (&o1)[2]) {
    const PG8_LAS int* tab = S.rowtab(ui);
#pragma unroll
    for (int i = 0; i < 2; ++i) { int R, C; stage_rc(tid * 16 + i * 8192, R, C); o0[i] = (unsigned)((tab[R] & 0xffff) * K + C) * 2u; o1[i] = (unsigned)((tab[HALF + R] & 0xffff) * K + C) * 2u; }
}

template <class Epi, class Sched, bool ALIGN_EPI, bool GATHER, bool F8 = false>
__device__ __forceinline__ void gemm_phase(PG8_LAS unsigned char* lds, const Gemm g, const Sched& S, const Epi& E) {
    int tid_ = threadIdx.x; asm volatile("" : "+v"(tid_));
    const int tid = tid_, wid = __builtin_amdgcn_readfirstlane(tid >> 6), lane = tid & 63, wr = wid >> 2, wc = wid & 3, fr = lane & 15, fq = lane >> 4;
    const int K = g.K, nt = K / BK;
    unsigned vA0[2], vA1[2], wA0[2], wA1[2], voffB[2];
    const size_t kstep = (size_t)(BK * 2);
    const size_t hstep = (size_t)HALF * K * 2;
    const size_t tstep = 2 * hstep;
#pragma unroll
    for (int i = 0; i < 2; ++i) { int R, C; stage_rc(tid * 16 + i * 8192, R, C); const int Rb = Epi::PERM ? ((R & ~31) + perm32(R & 31)) : R;
        vA0[i] = (unsigned)(R * K + C) * 2u; vA1[i] = vA0[i] + (unsigned)hstep; voffB[i] = (unsigned)(Rb * K + C) * 2u; wA0[i] = vA0[i]; wA1[i] = vA1[i]; }
    const unsigned ldsw = (unsigned)wid * 1024u;
    const int aoff = lds_byte(wr * 64 + fr, fq * 8), boff = lds_byte(wc * 32 + fr, fq * 8);
    const int a8o0 = lds_byte(wr * 64 + fr, fq * 16), a8o1 = lds_byte(wr * 64 + fr, fq * 16 + 8), b8o0 = lds_byte(wc * 32 + fr, fq * 16), b8o1 = lds_byte(wc * 32 + fr, fq * 16 + 8);
#define PG8_SA(b, h) (((b) * 2 + (h)) * HTB)
#define PG8_SB(b, h) ((4 + (b) * 2 + (h)) * HTB)
#define PG8_STAGE(bufoff, gbase, voff) do { _Pragma("unroll") for (int _i = 0; _i < 2; ++_i) \
        __builtin_amdgcn_global_load_lds((const unsigned*)((const char*)(gbase) + (voff)[_i]), (PG8_LAS unsigned*)(lds + (bufoff) + ldsw + _i * 8192), 16, 0, 0); } while (0)
#define PG8_LDA_BF(dst, b, h) do { _Pragma("unroll") for (int m = 0; m < 4; ++m) _Pragma("unroll") for (int k = 0; k < 2; ++k) dst[m][k] = *(const PG8_LAS bf16x8*)(lds + PG8_SA(b, h) + aoff + m * 2048 + k * 1024); } while (0)
#define PG8_LDB_BF(dst, b, h) do { _Pragma("unroll") for (int n = 0; n < 2; ++n) _Pragma("unroll") for (int k = 0; k < 2; ++k) dst[n][k] = *(const PG8_LAS bf16x8*)(lds + PG8_SB(b, h) + boff + n * 2048 + k * 1024); } while (0)
#define PG8_MMA_BF(ai, bj, At, Bt) do { if (cur.nr > 128 * (ai) + 64 * wr) { __builtin_amdgcn_s_setprio(1); _Pragma("unroll") for (int m = 0; m < 4; ++m) _Pragma("unroll") for (int n = 0; n < 2; ++n) _Pragma("unroll") for (int k = 0; k < 2; ++k) \
        acc[ai][bj][m][n] = __builtin_amdgcn_mfma_f32_16x16x32_bf16(Bt[n][k], At[m][k], acc[ai][bj][m][n], 0, 0, 0); __builtin_amdgcn_s_setprio(0); } } while (0)
#define PG8_LD8(dst, i_, base_, o0_, o1_) do { const u32x4 lo_ = *(const PG8_LAS u32x4*)(lds + (base_) + (o0_) + (i_) * 2048), hi_ = *(const PG8_LAS u32x4*)(lds + (base_) + (o1_) + (i_) * 2048); \
        dst[i_] = (i32x8){(int)lo_.x, (int)lo_.y, (int)lo_.z, (int)lo_.w, (int)hi_.x, (int)hi_.y, (int)hi_.z, (int)hi_.w}; } while (0)
#define PG8_LDA_F8(dst, b, h) do { _Pragma("unroll") for (int m = 0; m < 4; ++m) PG8_LD8(dst, m, PG8_SA(b, h), a8o0, a8o1); } while (0)
#define PG8_LDB_F8(dst, b, h) do { _Pragma("unroll") for (int n = 0; n < 2; ++n) PG8_LD8(dst, n, PG8_SB(b, h), b8o0, b8o1); } while (0)
#define PG8_MMA_F8(ai, bj, At, Bt) do { if (cur.nr > 128 * (ai) + 64 * wr) { __builtin_amdgcn_s_setprio(1); _Pragma("unroll") for (int m = 0; m < 4; ++m) _Pragma("unroll") for (int n = 0; n < 2; ++n) \
        acc[ai][bj][m][n] = __builtin_amdgcn_mfma_scale_f32_16x16x128_f8f6f4(Bt[n], At[m], acc[ai][bj][m][n], 0, 0, 0, 0x7A7A7A7A  , 0, 0x7F7F7F7F  ); __builtin_amdgcn_s_setprio(0); } } while (0)
#define PG8_LDA(dst, b, h) do { if constexpr (F8) { PG8_LDA_F8(dst##8, b, h); } else { PG8_LDA_BF(dst, b, h); } } while (0)
#define PG8_LDB(dst, b, h) do { if constexpr (F8) { PG8_LDB_F8(dst##8, b, h); } else { PG8_LDB_BF(dst, b, h); } } while (0)
#define PG8_MMA(ai, bj, At, Bt) do { if constexpr (F8) { PG8_MMA_F8(ai, bj, At##8, Bt##8); } else { PG8_MMA_BF(ai, bj, At, Bt); } } while (0)
#define PG8_WAIT_V(n) asm volatile("s_waitcnt vmcnt(" #n ")" ::: "memory")
#define PG8_WAIT_L(n) asm volatile("s_waitcnt lgkmcnt(" #n ")" ::: "memory")
#define PG8_BAR __builtin_amdgcn_s_barrier()
#define PG8_SCHED __builtin_amdgcn_sched_barrier(0)
    Unit cur, nxt; int ui = 0;
    if (!S.next(0, cur)) return;
    f32x4 acc[2][2][4][2];
#pragma unroll
    for (int a = 0; a < 2; ++a)
#pragma unroll
        for (int b = 0; b < 2; ++b)
#pragma unroll
            for (int m = 0; m < 4; ++m)
#pragma unroll
                for (int n = 0; n < 2; ++n) acc[a][b][m][n] = (f32x4){0.f, 0.f, 0.f, 0.f};
    bf16x8 At[4][2], B0[2][2], B1[2][2]; i32x8 At8[4], B08[2], B18[2];
    const char* cA = GATHER ? (const char*)g.A : (const char*)g.A + (size_t)cur.pm * tstep; const char* cB = (const char*)g.Bt + (size_t)cur.pn * tstep;
    if constexpr (GATHER) gather_voffs(S, 0, tid, K, vA0, vA1);
    PG8_STAGE(PG8_SB(0, 0), cB, voffB); PG8_STAGE(PG8_SB(0, 1), cB + hstep, voffB); PG8_STAGE(PG8_SA(0, 0), cA, vA0); PG8_STAGE(PG8_SA(0, 1), cA, vA1);
    if (wr == 1) PG8_BAR;
    PG8_WAIT_V(2); PG8_BAR;
    PG8_STAGE(PG8_SB(1, 0), cB + kstep, voffB); PG8_STAGE(PG8_SA(1, 0), cA + kstep, vA0); PG8_STAGE(PG8_SB(1, 1), cB + hstep + kstep, voffB);
    PG8_WAIT_V(6); PG8_BAR;
    for (;;) {
        const bool has_next = S.next(ui + 1, nxt);
        const char* nA = GATHER ? cA : (has_next ? (const char*)g.A + (size_t)nxt.pm * tstep : cA); const char* nB = has_next ? (const char*)g.Bt + (size_t)nxt.pn * tstep : cB;
        if constexpr (GATHER) { if (has_next) gather_voffs(S, ui + 1, tid, K, wA0, wA1); else { wA0[0] = vA0[0]; wA0[1] = vA0[1]; wA1[0] = vA1[0]; wA1[1] = vA1[1]; } }
        for (int t = 0; t < nt; t += 2) {
            const bool last = (t == nt - 2);
            const char* a1 = cA + (size_t)(t + 1) * kstep;
            const char* a2 = last ? nA : cA + (size_t)(t + 2) * kstep; const char* b2 = last ? nB : cB + (size_t)(t + 2) * kstep;
            const char* a3 = a2 + kstep; const char* b3 = b2 + kstep;
            unsigned sA0[2], sA1[2];
#pragma unroll
            for (int i = 0; i < 2; ++i) { sA0[i] = (GATHER && last) ? wA0[i] : vA0[i]; sA1[i] = (GATHER && last) ? wA1[i] : vA1[i]; }
            if constexpr (Epi::MIDK) { if (t == nt / 2) E.midk(acc, wr, fr); }
            PG8_LDB(B0, 0, 0); PG8_LDB(B1, 0, 1); PG8_SCHED; PG8_LDA(At, 0, 0); PG8_STAGE(PG8_SA(1, 1), a1, vA1);
            PG8_WAIT_V(8); PG8_WAIT_L(0); PG8_BAR; PG8_MMA(0, 0, At, B0); PG8_MMA(0, 1, At, B1); PG8_BAR; PG8_SCHED;
            PG8_LDA(At, 0, 1); PG8_STAGE(PG8_SB(0, 0), b2, voffB); PG8_STAGE(PG8_SB(0, 1), b2 + hstep, voffB); PG8_STAGE(PG8_SA(0, 0), a2, sA0);
            PG8_WAIT_V(8); PG8_WAIT_L(0); PG8_BAR; PG8_MMA(1, 0, At, B0); PG8_MMA(1, 1, At, B1); PG8_BAR; PG8_SCHED;
            PG8_LDB(B0, 1, 0); PG8_LDB(B1, 1, 1); PG8_SCHED; PG8_LDA(At, 1, 0); PG8_STAGE(PG8_SA(0, 1), a2, sA1);
            PG8_WAIT_V(8); PG8_WAIT_L(0); PG8_BAR; PG8_MMA(0, 0, At, B0); PG8_MMA(0, 1, At, B1); PG8_BAR; PG8_SCHED;
            PG8_LDA(At, 1, 1); PG8_STAGE(PG8_SB(1, 0), b3, voffB); PG8_STAGE(PG8_SB(1, 1), b3 + hstep, voffB); PG8_STAGE(PG8_SA(1, 0), a3, sA0);
            PG8_WAIT_V(8); PG8_WAIT_L(0); PG8_BAR; PG8_MMA(1, 0, At, B0); PG8_MMA(1, 1, At, B1); PG8_BAR; PG8_SCHED;
        }
        if constexpr (ALIGN_EPI) { if (wr == 0) PG8_BAR; }
        E(acc, cur, ui, wr, wc, fr, fq);
        if (!has_next) break;
#pragma unroll
        for (int a = 0; a < 2; ++a)
#pragma unroll
            for (int b = 0; b < 2; ++b)
#pragma unroll
                for (int m = 0; m < 4; ++m)
#pragma unroll
                    for (int n = 0; n < 2; ++n) acc[a][b][m][n] = (f32x4){0.f, 0.f, 0.f, 0.f};
        cur = nxt; cA = nA; cB = nB; ++ui;
        if constexpr (GATHER) { vA0[0] = wA0[0]; vA0[1] = wA0[1]; vA1[0] = wA1[0]; vA1[1] = wA1[1]; }
        if constexpr (ALIGN_EPI) { if (wr == 1) PG8_BAR; }
    }
    PG8_WAIT_V(0);
    if constexpr (!ALIGN_EPI) { if (wr == 0) PG8_BAR; }
    PG8_BAR;
#undef PG8_SA
#undef PG8_SB
#undef PG8_STAGE
#undef PG8_LDA
#undef PG8_LDB
#undef PG8_MMA
#undef PG8_LDA_BF
#undef PG8_LDB_BF
#undef PG8_MMA_BF
#undef PG8_LD8
#undef PG8_LDA_F8
#undef PG8_LDB_F8
#undef PG8_MMA_F8
#undef PG8_WAIT_V
#undef PG8_WAIT_L
#undef PG8_BAR
#undef PG8_SCHED
}

struct EpiProj {
    static constexpr bool PERM = true, MIDK = false;
    bf16_t* O; unsigned* hp;
    __device__ __forceinline__ void operator()(const f32x4 (&acc)[2][2][4][2], const Unit& u, int, int wr, int wc, int fr, int fq) const {
        const int row0 = u.pm * BM + wr * 64 + fr, col0 = u.pn * BM + wc * 32 + 8 * fq;
        const float sc = (u.pn < 2 || (u.pn >= 6 && u.pn < 8)) ? C2 : 1.f;
        if (u.pn < 4) {
            float mx = 0.f;
#pragma unroll
            for (int ai = 0; ai < 2; ++ai)
#pragma unroll
                for (int m = 0; m < 4; ++m)
#pragma unroll
                    for (int bj = 0; bj < 2; ++bj) { const f32x4 a0 = acc[ai][bj][m][0] * sc, a1 = acc[ai][bj][m][1] * sc;
                        float q = a0[0] * a0[0] + a0[1] * a0[1] + a0[2] * a0[2] + a0[3] * a0[3] + a1[0] * a1[0] + a1[1] * a1[1] + a1[2] * a1[2] + a1[3] * a1[3];
                        q += __shfl_xor(q, 16); q += __shfl_xor(q, 32); mx = fmaxf(mx, q); }
#pragma unroll
            for (int o = 1; o < 16; o <<= 1) mx = fmaxf(mx, __shfl_xor(mx, o));
            if ((threadIdx.x & 63) == 0) atomicMax(hp + (u.pn < 2 ? 0 : 64), __float_as_uint(mx));
        }
#pragma unroll
        for (int ai = 0; ai < 2; ++ai)
#pragma unroll
            for (int m = 0; m < 4; ++m) { bf16_t* rowp = O + (size_t)(row0 + ai * HALF + m * 16) * NPROJ + col0;
#pragma unroll
                for (int bj = 0; bj < 2; ++bj) { const f32x4 v0 = acc[ai][bj][m][0] * sc, v1 = acc[ai][bj][m][1] * sc;
                    u32x4 w; w.x = cvt_pk_bf16(v0[0], v0[1]); w.y = cvt_pk_bf16(v0[2], v0[3]); w.z = cvt_pk_bf16(v1[0], v1[1]); w.w = cvt_pk_bf16(v1[2], v1[3]);
                    st16_wt(rowp + bj * HALF, w); } }
    }
};
struct EpiWout {
    static constexpr bool PERM = false, MIDK = true;
    const float* x; float* X1; bf16_t* X1B; const PG8_LAS float* ratio; const PG8_LAS float* rs;
    __device__ __forceinline__ void midk(f32x4 (&acc)[2][2][4][2], int wr, int fr) const {
#pragma unroll
        for (int ai = 0; ai < 2; ++ai)
#pragma unroll
            for (int m = 0; m < 4; ++m) { const float f = ratio[ai * HALF + wr * 64 + m * 16 + fr];
#pragma unroll
                for (int bj = 0; bj < 2; ++bj)
#pragma unroll
                    for (int n = 0; n < 2; ++n) acc[ai][bj][m][n] *= f; }
    }
    __device__ __forceinline__ void operator()(const f32x4 (&acc)[2][2][4][2], const Unit& u, int, int wr, int wc, int fr, int fq) const {
        const int col0 = u.pn * BM + wc * 32 + 4 * fq;
#pragma unroll
        for (int ai = 0; ai < 2; ++ai)
#pragma unroll
            for (int m = 0; m < 4; ++m) { const int r = ai * HALF + wr * 64 + m * 16 + fr; const float s = rs[r]; const size_t off = (size_t)(u.pm * BM + r) * DM + col0;
#pragma unroll
                for (int bj = 0; bj < 2; ++bj)
#pragma unroll
                    for (int n = 0; n < 2; ++n) { const f32x4 xv = *(const f32x4*)(x + off + bj * HALF + n * 16); const f32x4 o = xv + acc[ai][bj][m][n] * s;
                        *(f32x4*)(X1 + off + bj * HALF + n * 16) = o;
                        if (MOE_F8) *(unsigned*)((unsigned char*)X1B + off + bj * HALF + n * 16) = pk4_fp8(o[0], o[1], o[2], o[3]);
                        else { u32x2 w; w.x = cvt_pk_bf16(o[0], o[1]); w.y = cvt_pk_bf16(o[2], o[3]); *(u32x2*)(X1B + off + bj * HALF + n * 16) = w; } }
                asm volatile("" ::: "memory"); }
    }
};
constexpr int MOE_MAXU = 10;
struct MoeOrder {
    int NT, c; const PG8_LAS int* tb; const PG8_LAS int* tbE; const PG8_LAS int* tbC; const PG8_LAS int* cnt; const PG8_LAS int* tabA;
    int probe = 0;
    __device__ bool next(int i, Unit& u) const {
        if (i >= MOE_MAXU) return false;
        const int x = c & 7, j = c >> 3, UE = tbE[32] * NT, UC = tbC[32] * NT;
        const int qE = UE >> 3, rE = UE & 7, sE = x * qE + (x < rE ? x : rE), nE = qE + (x < rE ? 1 : 0);
        const int qC = UC >> 3, rC = UC & 7, sC = x * qC + (x < rC ? x : rC), nC = qC + (x < rC ? 1 : 0);
        const int nEj = (j < nE) ? ((nE - j + 31) >> 5) : 0;
        if (i < nEj) {
            const int f = sE + i * 32 + j; int e = 0; while (f >= tbE[e + 1] * NT) ++e;
            const int idx = f - tbE[e] * NT, nte = tbE[e + 1] - tbE[e], pg = idx / (4 * nte), rem2 = idx - pg * 4 * nte, mt = rem2 >> 2;
            u.pm = tb[e] + mt; u.pn = e * NT + pg * 4 + (rem2 & 3); const int left = cnt[e] - 256 * mt; u.nr = left < BM ? left : BM;
        } else {
            const int jj = (j - (nE & 31) + 32) & 31, lc = (i - nEj) * 32 + jj; if (lc >= nC) return false;
            const int f = sC + lc; int e = 0; while (f >= tbC[e + 1] * NT) ++e;
            const int mt = tbE[e + 1] - tbE[e]; u.pm = tb[e] + mt; u.pn = e * NT + (f - tbC[e] * NT); u.nr = cnt[e] - 256 * mt;
        }
        if (probe) { u.pm &= 31; u.pn &= 7; if (probe == 2) u.nr = 32; }
        return true;
    }
    __device__ __forceinline__ const PG8_LAS int* rowtab(int ui) const { return tabA + ui * 256; }
};
struct EpiMoe1 {
    static constexpr bool PERM = true, MIDK = false;
    bf16_t* H; const PG8_LAS int* rowtab; const PG8_LAS float* btab;
    __device__ __forceinline__ void operator()(const f32x4 (&acc)[2][2][4][2], const Unit& u, int ui, int wr, int wc, int fr, int fq) const {
        const int pl = u.pn & 7, cl = wc * 32 + 8 * fq, colA = pl * 128 + cl;
        f32x4 bg[2], bl[2];
#pragma unroll
        for (int n = 0; n < 2; ++n) { bg[n] = *(const PG8_LAS f32x4*)(btab + ui * 256 + cl + 4 * n); bl[n] = *(const PG8_LAS f32x4*)(btab + ui * 256 + 128 + cl + 4 * n); }
#pragma unroll
        for (int ai = 0; ai < 2; ++ai)
#pragma unroll
            for (int m = 0; m < 4; ++m) { const int r = ai * HALF + wr * 64 + m * 16 + fr; const float rs = __uint_as_float((unsigned)rowtab[ui * 256 + r] & 0xffff0000u);
                float a8[8];
#pragma unroll
                for (int n = 0; n < 2; ++n) { const f32x4 gv = acc[ai][0][m][n] * rs + bg[n], lv = acc[ai][1][m][n] * rs + bl[n];
#pragma unroll
                    for (int i = 0; i < 4; ++i) { const float gl = fminf(gv[i], 7.f), li = fminf(fmaxf(lv[i], -7.f), 7.f);
                        a8[4 * n + i] = gl * __builtin_amdgcn_rcpf(1.f + __builtin_amdgcn_exp2f(-1.702f * LOG2E * gl)) * (li + 1.f); } }
                if (MOE_F8) { u32x2 w;
                    int w0 = __builtin_amdgcn_cvt_pk_fp8_f32(a8[0], a8[1], 0, false); w0 = __builtin_amdgcn_cvt_pk_fp8_f32(a8[2], a8[3], w0, true);
                    int w1 = __builtin_amdgcn_cvt_pk_fp8_f32(a8[4], a8[5], 0, false); w1 = __builtin_amdgcn_cvt_pk_fp8_f32(a8[6], a8[7], w1, true);
                    w.x = (unsigned)w0; w.y = (unsigned)w1; *(u32x2*)((unsigned char*)H + (size_t)(u.pm * BM + r) * DM + colA) = w; }
                else { u32x4 w; w.x = cvt_pk_bf16(a8[0], a8[1]); w.y = cvt_pk_bf16(a8[2], a8[3]); w.z = cvt_pk_bf16(a8[4], a8[5]); w.w = cvt_pk_bf16(a8[6], a8[7]);
                *(u32x4*)(H + (size_t)(u.pm * BM + r) * DM + colA) = w; } }
    }
};
struct EpiMoe2 {
    static constexpr bool PERM = true, MIDK = false;
    bf16_t* Y; const PG8_LAS float* wtab; const PG8_LAS float* btab;
    __device__ __forceinline__ void operator()(const f32x4 (&acc)[2][2][4][2], const Unit& u, int ui, int wr, int wc, int fr, int fq) const {
        const int pl = u.pn & 3, cl = wc * 32 + 8 * fq, col0 = pl * BM + cl;
        f32x4 bv[2][2];
#pragma unroll
        for (int bj = 0; bj < 2; ++bj)
#pragma unroll
            for (int n = 0; n < 2; ++n) bv[bj][n] = *(const PG8_LAS f32x4*)(btab + ui * 256 + cl + bj * HALF + 4 * n);
#pragma unroll
        for (int ai = 0; ai < 2; ++ai)
#pragma unroll
            for (int m = 0; m < 4; ++m) { const int r = ai * HALF + wr * 64 + m * 16 + fr; const float wt = wtab[ui * 256 + r]; bf16_t* rowp = Y + (size_t)(u.pm * BM + r) * DM + col0;
#pragma unroll
                for (int bj = 0; bj < 2; ++bj) { const f32x4 v0 = (acc[ai][bj][m][0] + bv[bj][0]) * wt, v1 = (acc[ai][bj][m][1] + bv[bj][1]) * wt;
                    if (Y_F8) { u32x2 w; w.x = pk4_fp8(v0[0], v0[1], v0[2], v0[3]); w.y = pk4_fp8(v1[0], v1[1], v1[2], v1[3]); *(u32x2*)((unsigned char*)Y + (size_t)(u.pm * BM + r) * DM + col0 + bj * HALF) = w; }
                    else { u32x4 w; w.x = cvt_pk_bf16(v0[0], v0[1]); w.y = cvt_pk_bf16(v0[2], v0[3]); w.z = cvt_pk_bf16(v1[0], v1[1]); w.w = cvt_pk_bf16(v1[2], v1[3]);
                    *(u32x4*)(rowp + bj * HALF) = w; } } }
    }
};
struct ListOrder {
    const PG8_LAS int* ud; int n; const PG8_LAS int* tabA;
    __device__ __forceinline__ bool next(int i, Unit& u) const { if (i >= n) return false; u.pm = ud[3 * i]; u.pn = ud[3 * i + 1]; u.nr = ud[3 * i + 2]; return true; }
    __device__ __forceinline__ const PG8_LAS int* rowtab(int ui) const { return tabA + ui * 256; }
};
struct EpiNull {
    static constexpr bool PERM = true, MIDK = false; float* O;
    __device__ __forceinline__ void operator()(const f32x4 (&acc)[2][2][4][2], const Unit& u, int ui, int wr, int wc, int fr, int fq) const {
        f32x4 t = (f32x4){0.f, 0.f, 0.f, 0.f};
#pragma unroll
        for (int ai = 0; ai < 2; ++ai)
#pragma unroll
            for (int bj = 0; bj < 2; ++bj)
#pragma unroll
                for (int m = 0; m < 4; ++m)
#pragma unroll
                    for (int n = 0; n < 2; ++n) t += acc[ai][bj][m][n];
        O[(size_t)(u.pm & 31) * 65536 + (u.pn & 7) * 8192 + (wr * 4 + wc) * 64 + fq * 16 + fr + ui] = t[0] + t[1] + t[2] + t[3];
    }
};
}

#include <hip/hip_bf16.h>
#include <cmath>
namespace attn_body {

using bf16=__hip_bfloat16;
using bf16x8=__attribute__((ext_vector_type(8)))short;
using s16x4=__attribute__((ext_vector_type(4)))short;
using f32x16=__attribute__((ext_vector_type(16)))float;
using u32x4=__attribute__((ext_vector_type(4)))unsigned;
constexpr int SEQ=4096,D=64,PIN=3072,POUT=1024;
constexpr int NW=8,QBLK=32,QB=QBLK*NW,KVBLK=64,NQB=SEQ/QB;
__device__ __forceinline__ int crow(int r,int hi){return (r&3)+8*(r>>2)+4*hi;}
#define SBAR() __builtin_amdgcn_sched_barrier(0)
__device__ __forceinline__ void cmask(f32x16&p0,f32x16&p1,int jb,int qrel,int hi){
  const float NEG=-INFINITY; int kb=64*jb+4*hi;
  #pragma unroll
  for(int r=0;r<16;++r){int kv=kb+(r&3)+8*(r>>2); if(kv>qrel)p0[r]=NEG; if(kv+32>qrel)p1[r]=NEG;}
}

constexpr int NSLOT=3, SLOTB=8192;
constexpr int LDS_K=0, LDS_V=NSLOT*SLOTB, LDS_WS=2*NSLOT*SLOTB, LDS_OST=LDS_WS+NW*64*4, LDS_CK=LDS_OST+NW*4096, LDS_BYTES=LDS_CK+SEQ*4;
constexpr float C2=0.125f*1.4426950408889634f;
__device__ __forceinline__ void glds16(const void*gsrc,unsigned lds_dst){unsigned keep;
  asm volatile("s_mov_b32 %0, m0\n\ts_mov_b32 m0, %2\n\ts_nop 0\n\tglobal_load_lds_dwordx4 %1, off\n\ts_mov_b32 m0, %0":"=&s"(keep):"v"(gsrc),"s"(lds_dst):"memory");}
__device__ __forceinline__ float max3f(float a,float b,float c){float r;asm("v_max3_f32 %0, %1, %2, %3":"=v"(r):"v"(a),"v"(b),"v"(c));return r;}
__device__ __forceinline__ float max2f(float a,float b){float r;asm("v_max_f32_e32 %0, %1, %2":"=v"(r):"v"(a),"v"(b));return r;}
__device__ __forceinline__ float fadd_s(float a,float b){float r;asm("v_add_f32_e32 %0, %1, %2":"=v"(r):"v"(a),"v"(b));return r;}
__device__ __forceinline__ float fsub_s(float a,float b){float r;asm("v_sub_f32_e32 %0, %1, %2":"=v"(r):"v"(a),"v"(b));return r;}
typedef float f32x2_t __attribute__((ext_vector_type(2))); typedef float f32x4_t __attribute__((ext_vector_type(4))); typedef __bf16 bf16x2_t __attribute__((ext_vector_type(2)));
__device__ __forceinline__ unsigned cvtpk_s(float lo,float hi){f32x2_t v={lo,hi};bf16x2_t b=__builtin_convertvector(v,bf16x2_t);return __builtin_bit_cast(unsigned,b);}
#define WAIT_BAR(N) asm volatile("s_waitcnt vmcnt(" #N ") lgkmcnt(0)\n\ts_barrier":::"memory")

__device__ __forceinline__ void qkt(f32x16&p0,f32x16&p1,const char*Kslot,const bf16x8*qr,const f32x16&negm,int r32,int hi){
  const char*kb=Kslot+hi*1024+r32*16;
  #pragma unroll
  for(int d0=0;d0<4;++d0){
    const bf16x8 b0=*reinterpret_cast<const bf16x8*>(kb+d0*2048);
    const bf16x8 b1=*reinterpret_cast<const bf16x8*>(kb+d0*2048+512);
    if(d0==0){p0=__builtin_amdgcn_mfma_f32_32x32x16_bf16(b0,qr[0],negm,0,0,0);p1=__builtin_amdgcn_mfma_f32_32x32x16_bf16(b1,qr[0],negm,0,0,0);}
    else{p0=__builtin_amdgcn_mfma_f32_32x32x16_bf16(b0,qr[d0],p0,0,0,0);p1=__builtin_amdgcn_mfma_f32_32x32x16_bf16(b1,qr[d0],p1,0,0,0);}}
}
typedef __attribute__((address_space(3))) const char* lds_cptr;
typedef short v4i16_t __attribute__((ext_vector_type(4)));
__device__ __forceinline__ void kload8(bf16x8*kf,lds_cptr kp){
  kf[0]=*(const __attribute__((address_space(3))) bf16x8*)(kp);      kf[1]=*(const __attribute__((address_space(3))) bf16x8*)(kp+512);
  kf[2]=*(const __attribute__((address_space(3))) bf16x8*)(kp+2048); kf[3]=*(const __attribute__((address_space(3))) bf16x8*)(kp+2560);
  kf[4]=*(const __attribute__((address_space(3))) bf16x8*)(kp+4096); kf[5]=*(const __attribute__((address_space(3))) bf16x8*)(kp+4608);
  kf[6]=*(const __attribute__((address_space(3))) bf16x8*)(kp+6144); kf[7]=*(const __attribute__((address_space(3))) bf16x8*)(kp+6656);
}
__device__ __forceinline__ void kload2(bf16x8*kf,lds_cptr kp,int j){ kf[2*j]=*(const __attribute__((address_space(3))) bf16x8*)(kp+j*2048); kf[2*j+1]=*(const __attribute__((address_space(3))) bf16x8*)(kp+j*2048+512); }
__device__ __forceinline__ s16x4 vtr(lds_cptr p){ return __builtin_bit_cast(s16x4,__builtin_amdgcn_ds_read_tr16_b64_v4i16((__attribute__((address_space(3))) v4i16_t*)p)); }
__device__ __forceinline__ float rowmax(const f32x16&p0,const f32x16&p1){
  float a=max3f(p0[0],p0[1],p1[0]),b=max3f(p0[2],p0[3],p1[1]);a=max3f(a,p1[2],p1[3]);
  #pragma unroll
  for(int r=4;r<16;r+=4){a=max3f(a,p0[r],p0[r+1]);b=max3f(b,p0[r+2],p0[r+3]);a=max3f(a,p1[r],p1[r+1]);b=max3f(b,p1[r+2],p1[r+3]);}
  const float m=max2f(a,b);
  auto rr=__builtin_amdgcn_permlane32_swap(__float_as_uint(m),__float_as_uint(m),false,false);
  return max2f(__uint_as_float(rr[0]),__uint_as_float(rr[1]));
}
__device__ __forceinline__ void pv(f32x16*o,int vb,bf16x8 pa0,bf16x8 pa1,bf16x8 pa2,bf16x8 pa3){
  #pragma unroll
  for(int d0=0;d0<2;++d0){s16x4 lo[4],hi[4];
    #pragma unroll
    for(int ks=0;ks<4;++ks){
      asm volatile("ds_read_b64_tr_b16 %0,%1 offset:%c2":"=&v"(lo[ks]):"v"(vb),"i"(d0*4096+ks*1024):"memory");
      asm volatile("ds_read_b64_tr_b16 %0,%1 offset:%c2":"=&v"(hi[ks]):"v"(vb),"i"(d0*4096+ks*1024+512):"memory");}
    asm volatile("s_waitcnt lgkmcnt(0)":::"memory");SBAR();
    #define PK(k) (bf16x8){lo[k][0],lo[k][1],lo[k][2],lo[k][3],hi[k][0],hi[k][1],hi[k][2],hi[k][3]}
    o[d0]=__builtin_amdgcn_mfma_f32_32x32x16_bf16(pa0,PK(0),o[d0],0,0,0);
    o[d0]=__builtin_amdgcn_mfma_f32_32x32x16_bf16(pa1,PK(1),o[d0],0,0,0);
    o[d0]=__builtin_amdgcn_mfma_f32_32x32x16_bf16(pa2,PK(2),o[d0],0,0,0);
    o[d0]=__builtin_amdgcn_mfma_f32_32x32x16_bf16(pa3,PK(3),o[d0],0,0,0);
    #undef PK
  }
}

#ifndef ATTN_STORE16
#define ATTN_STORE16(p,v) (*(u32x4*)(p)=(v))
#endif
template<int THRL> __device__ __forceinline__ void attn_unit(int b,int h,int qb,const bf16*Q,const bf16*__restrict__ K,const bf16*__restrict__ V,bf16*O,const float*__restrict__ CUMbh,float*__restrict__ SSQh,float skipth,char*shm){
  int tid_=threadIdx.x; asm volatile("":"+v"(tid_));
  const int tid=tid_,lane=tid&63,r32=lane&31,hi=lane>>5; const int wid=__builtin_amdgcn_readfirstlane(tid>>6);
  const long rowbase=(long)b*SEQ; const int q0=qb*QB;
  const bf16*Qw=Q+(rowbase+q0+wid*QBLK)*PIN+h*D;
  int t0;
  { const int NT0=(q0+QB)/KVBLK; const bool sk=(lane<NT0-4)&&(CUMbh[64*lane+63]-CUMbh[q0]>=skipth); t0=__builtin_popcountll(__ballot(sk))&~1; t0=__builtin_amdgcn_readfirstlane(t0); }
  const bf16*Kh=K+(rowbase+(long)t0*KVBLK)*PIN+h*D,*Vh=V+(rowbase+(long)t0*KVBLK)*PIN+h*D;
  const unsigned lds0=(unsigned)(uintptr_t)shm;
  const lds_cptr shm3=(lds_cptr)shm;
  float*wsf=(float*)(shm+LDS_WS)+wid*64;
  const bf16*ksrc=Kh+(long)lane*PIN+wid*8;
  const bf16*vsrc=Vh+(long)(16*(wid&3)+(lane>>2))*PIN+(wid>>2)*32+(lane&3)*8;
  const unsigned kdst=lds0+LDS_K+wid*1024, vdst=lds0+LDS_V+wid*1024;
  #define DMA_K(t,slot) glds16(ksrc+(long)(t)*KVBLK*PIN,(unsigned)__builtin_amdgcn_readfirstlane(kdst+(slot)))
  #define DMA_V(t,slot) glds16(vsrc+(long)(t)*KVBLK*PIN,(unsigned)__builtin_amdgcn_readfirstlane(vdst+(slot)))
  const int vb0=(int)(lds0+LDS_V)+((lane>>4)&1)*32+(lane&3)*8+(4*hi+((lane&15)>>2))*64;
  const char*Kbase=shm+LDS_K; bf16x8 kf[8];
  const lds_cptr kp0=shm3+LDS_K+hi*1024+r32*16; const lds_cptr vp0=shm3+LDS_V+((lane>>4)&1)*32+(lane&3)*8+(4*hi+((lane&15)>>2))*64;
  const int NT=(q0+QB)/KVBLK-t0;
  DMA_K(0,0);DMA_V(0,0);DMA_K(1,SLOTB);
  bf16x8 qr[4];
  #pragma unroll
  for(int d0=0;d0<4;++d0)qr[d0]=*reinterpret_cast<const bf16x8*>(&Qw[(long)r32*PIN+d0*16+hi*8]);
  const float cbase=CUMbh[q0]; const float cq=CUMbh[q0+wid*QBLK+r32]-cbase;
  { __attribute__((address_space(3))) float*ckw=(__attribute__((address_space(3))) float*)(shm3+LDS_CK); int s0_=tid; asm volatile("":"+v"(s0_));
    _Pragma("nounroll") for(int s=s0_;s<q0+QB;s+=NW*64)ckw[s]=CUMbh[s]-cbase; }
  const __attribute__((address_space(3))) float*ckp=(const __attribute__((address_space(3))) float*)(shm3+LDS_CK)+4*hi+t0*KVBLK;
  float mhat=-cq,l_reg=0.f;f32x16 o[2];o[0]=f32x16{};o[1]=f32x16{};f32x16 negm;
  #pragma unroll
  for(int r=0;r<16;++r)negm[r]=cq;
  asm volatile("":"+v"(negm));
  const int qrel=wid*QBLK+r32;
  #define BIAS(P0,P1,t) do{ const __attribute__((address_space(3))) float*cp_=ckp+(t)*KVBLK; \
    _Pragma("unroll") for(int g_=0;g_<4;++g_){ const f32x4_t c0_=*(const __attribute__((address_space(3))) f32x4_t*)(cp_+8*g_), c1_=*(const __attribute__((address_space(3))) f32x4_t*)(cp_+32+8*g_); \
      _Pragma("unroll") for(int j_=0;j_<4;++j_){ P0[4*g_+j_]-=c0_[j_]; P1[4*g_+j_]-=c1_[j_]; } SBAR(); } }while(0)
  #define CMASK(P0,P1,t) do{int jb_=(t)-(NT-4); if(jb_>=0)cmask(P0,P1,jb_,qrel,hi);}while(0)
  bool resc=false;
  #define START(P0,P1) do{ const float rm=rowmax(P0,P1); resc=false; \
    { const float dl=rm; mhat=fadd_s(mhat,dl); \
      _Pragma("unroll") for(int r=0;r<16;++r){P0[r]=fsub_s(P0[r],dl);P1[r]=fsub_s(P1[r],dl);} \
      _Pragma("unroll") for(int r=0;r<16;++r)negm[r]=-mhat; asm volatile("":"+v"(negm)); } \
    _Pragma("unroll") for(int r=0;r<16;++r)P0[r]=__builtin_amdgcn_exp2f(P0[r]); }while(0)
  #define RESC() do{ if(resc){ asm volatile("s_waitcnt lgkmcnt(0)":::"memory"); \
      _Pragma("unroll") for(int d_=0;d_<2;++d_) _Pragma("unroll") for(int r=0;r<16;++r)o[d_][r]*=wsf[crow(r,hi)]; } }while(0)
  f32x16 pA0,pA1,pB0,pB1;
  int sl_prev=0,sl_cur=0,sl_next=SLOTB;
  #define ROT() do{sl_prev=sl_cur;sl_cur=sl_next;sl_next=(sl_next==(NSLOT-1)*SLOTB)?0:sl_next+SLOTB;}while(0)
  DMA_K(2,2*SLOTB);
  WAIT_BAR(3);
  qkt(pA0,pA1,Kbase,qr,negm,r32,hi);asm volatile("s_nop 15\n\ts_nop 7":"+v"(pA0),"+v"(pA1));BIAS(pA0,pA1,0);CMASK(pA0,pA1,0);
  START(pA0,pA1);
  _Pragma("unroll") for(int r=0;r<16;++r)pA1[r]=__builtin_amdgcn_exp2f(pA1[r]);
  WAIT_BAR(0);
  DMA_K(3,0);DMA_V(1,SLOTB);
  ROT();
  kload8(kf,kp0+sl_cur);
  WAIT_BAR(2);
  s16x4 vlo[8],vhi[8]; u32x4 pw0,pw1,pw2,pw3;
  #define PKW(P,B) cvtpk_s(P[B],P[B+1])
  #define PAF(k) __builtin_bit_cast(bf16x8,pw##k)
  #define VFR(i) (bf16x8){vlo[i][0],vlo[i][1],vlo[i][2],vlo[i][3],vhi[i][0],vhi[i][1],vhi[i][2],vhi[i][3]}
  #define PIN(x) asm volatile("":"+v"(x))
  #define MX3(a,b,c) __builtin_fmaxf(__builtin_fmaxf((a),(b)),(c))
  #define GAPA(MF,A0,A1,A2,A3,W0,W1,PW) do{ MF; sacc+=A0; sacc+=A1; sacc+=A2; sacc+=A3; PIN(sacc); W0; W1; PIN(PW); SBAR(); }while(0)
  #define EX(v) __builtin_amdgcn_exp2f(v)
  #define GAPB(MF,X,B) do{ MF; X[B]=EX(X[B]); X[B+1]=EX(X[B+1]); X[B+2]=EX(X[B+2]); X[B+3]=EX(X[B+3]); PIN(X); SBAR(); }while(0)
  #define VRD(i) do{ vlo[i]=vtr(vp_+(((i)>>2)*4096+((i)&3)*1024)); vhi[i]=vtr(vp_+(((i)>>2)*4096+((i)&3)*1024+512)); }while(0)
  #define KRD(G,j) do{ if(G){ kload2(kf,kp0+sl_next,j); SBAR(); } }while(0)
  #define STEP(C0,C1,P0,P1,t,GK,GV,GL) do{ SBAR(); \
    const lds_cptr vp_=vp0+sl_prev; \
    VRD(0); SBAR(); float sacc=(P0[0]+P0[1]); \
    GAPA(C0=__builtin_amdgcn_mfma_f32_32x32x16_bf16(kf[0],qr[0],negm,0,0,0), P0[2],P0[3],P0[4],P0[5],     pw0[0]=PKW(P0,0), pw0[1]=PKW(P0,2), pw0); \
    VRD(4); SBAR(); GAPA(C1=__builtin_amdgcn_mfma_f32_32x32x16_bf16(kf[1],qr[0],negm,0,0,0), P0[6],P0[7],P0[8],P0[9],     pw0[2]=PKW(P0,4), pw0[3]=PKW(P0,6), pw0); \
    VRD(1); SBAR(); GAPA(C0=__builtin_amdgcn_mfma_f32_32x32x16_bf16(kf[2],qr[1],C0,0,0,0),   P0[10],P0[11],P0[12],P0[13], pw1[0]=PKW(P0,8), pw1[1]=PKW(P0,10), pw1); \
    VRD(5); SBAR(); GAPA(C1=__builtin_amdgcn_mfma_f32_32x32x16_bf16(kf[3],qr[1],C1,0,0,0),   P0[14],P0[15],P1[0],P1[1],   pw1[2]=PKW(P0,12),pw1[3]=PKW(P0,14), pw1); \
    VRD(2); SBAR(); GAPA(C0=__builtin_amdgcn_mfma_f32_32x32x16_bf16(kf[4],qr[2],C0,0,0,0),   P1[2],P1[3],P1[4],P1[5],     pw2[0]=PKW(P1,0), pw2[1]=PKW(P1,2), pw2); \
    VRD(6); SBAR(); GAPA(C1=__builtin_amdgcn_mfma_f32_32x32x16_bf16(kf[5],qr[2],C1,0,0,0),   P1[6],P1[7],P1[8],P1[9],     pw2[2]=PKW(P1,4), pw2[3]=PKW(P1,6), pw2); \
    VRD(3); SBAR(); GAPA(C0=__builtin_amdgcn_mfma_f32_32x32x16_bf16(kf[6],qr[3],C0,0,0,0),   P1[10],P1[11],P1[12],P1[13], pw3[0]=PKW(P1,8), pw3[1]=PKW(P1,10), pw3); \
    VRD(7); SBAR(); GAPA(C1=__builtin_amdgcn_mfma_f32_32x32x16_bf16(kf[7],qr[3],C1,0,0,0),   P1[14],P1[15],0.f,0.f,       pw3[2]=PKW(P1,12),pw3[3]=PKW(P1,14), pw3); \
    l_reg+=sacc; \
    if(GK){DMA_K((t)+3,sl_cur);} if(GV){DMA_V((t)+1,sl_next);} \
    BIAS(C0,C1,t); CMASK(C0,C1,t); \
    { float a=MX3(C0[0],C0[1],C1[0]),b=MX3(C0[2],C0[3],C1[1]); a=MX3(a,C1[2],C1[3]); \
      _Pragma("unroll") for(int r=4;r<16;r+=4){a=MX3(a,C0[r],C0[r+1]);b=MX3(b,C0[r+2],C0[r+3]);a=MX3(a,C1[r],C1[r+1]);b=MX3(b,C1[r+2],C1[r+3]);} \
      float rm=__builtin_fmaxf(a,b); { auto rr=__builtin_amdgcn_permlane32_swap(__float_as_uint(rm),__float_as_uint(rm),false,false); rm=__builtin_fmaxf(__uint_as_float(rr[0]),__uint_as_float(rr[1])); } \
      resc=false; \
      if(__builtin_expect(__any(rm>(float)THRL),0)){ const float dl=__builtin_fmaxf(rm,0.f); mhat+=dl; \
        _Pragma("unroll") for(int r=0;r<16;++r){C0[r]-=dl;C1[r]-=dl;} \
        _Pragma("unroll") for(int r=0;r<16;++r)negm[r]=-mhat; asm volatile("":"+v"(negm)); \
        const float f=__builtin_amdgcn_exp2f(-dl); l_reg*=f; if(hi==0)wsf[r32]=f; resc=true; } } \
    SBAR(); \
    GAPB(o[0]=__builtin_amdgcn_mfma_f32_32x32x16_bf16(PAF(0),VFR(0),o[0],0,0,0), C0,0); \
    GAPB(o[1]=__builtin_amdgcn_mfma_f32_32x32x16_bf16(PAF(0),VFR(4),o[1],0,0,0), C0,4); \
    KRD(GL,0); GAPB(o[0]=__builtin_amdgcn_mfma_f32_32x32x16_bf16(PAF(1),VFR(1),o[0],0,0,0), C0,8); \
    KRD(GL,1); GAPB(o[1]=__builtin_amdgcn_mfma_f32_32x32x16_bf16(PAF(1),VFR(5),o[1],0,0,0), C0,12); \
    KRD(GL,2); GAPB(o[0]=__builtin_amdgcn_mfma_f32_32x32x16_bf16(PAF(2),VFR(2),o[0],0,0,0), C1,0); \
    KRD(GL,3); GAPB(o[1]=__builtin_amdgcn_mfma_f32_32x32x16_bf16(PAF(2),VFR(6),o[1],0,0,0), C1,4); \
    GAPB(o[0]=__builtin_amdgcn_mfma_f32_32x32x16_bf16(PAF(3),VFR(3),o[0],0,0,0), C1,8); \
    GAPB(o[1]=__builtin_amdgcn_mfma_f32_32x32x16_bf16(PAF(3),VFR(7),o[1],0,0,0), C1,12); \
    }while(0)
  int t=1;
  #undef CMASK
  #define CMASK(P0,P1,t) do{}while(0)
  for(;t+5<NT;t+=2){
    STEP(pB0,pB1,pA0,pA1,t,true,true,true);     WAIT_BAR(2); RESC(); ROT();
    STEP(pA0,pA1,pB0,pB1,t+1,true,true,true);   WAIT_BAR(2); RESC(); ROT();
  }
  #undef CMASK
  #define CMASK(P0,P1,t) do{int jb_=(t)-(NT-4); if(jb_>=0)cmask(P0,P1,jb_,qrel,hi);}while(0)
  #define ENDW(tt) do{ if((tt)+3<NT){WAIT_BAR(2);} else if((tt)+2<NT){WAIT_BAR(1);} else {WAIT_BAR(0);} }while(0)
  for(;t+1<NT;t+=2){
    STEP(pB0,pB1,pA0,pA1,t,(t+3<NT),(t+1<NT),(t+1<NT));       ENDW(t);   RESC(); ROT();
    STEP(pA0,pA1,pB0,pB1,t+1,(t+4<NT),(t+2<NT),(t+2<NT));     ENDW(t+1); RESC(); ROT();
  }
  STEP(pB0,pB1,pA0,pA1,NT-1,false,false,false); RESC();
  { float sacc=pB0[0]+pB0[1]; _Pragma("unroll") for(int r=2;r<16;++r)sacc+=pB0[r]; _Pragma("unroll") for(int r=0;r<16;++r)sacc+=pB1[r]; l_reg+=sacc;
    pw0=(u32x4){PKW(pB0,0),PKW(pB0,2),PKW(pB0,4),PKW(pB0,6)};pw1=(u32x4){PKW(pB0,8),PKW(pB0,10),PKW(pB0,12),PKW(pB0,14)};pw2=(u32x4){PKW(pB1,0),PKW(pB1,2),PKW(pB1,4),PKW(pB1,6)};pw3=(u32x4){PKW(pB1,8),PKW(pB1,10),PKW(pB1,12),PKW(pB1,14)};
    SBAR(); pv(o,vb0+sl_cur,PAF(0),PAF(1),PAF(2),PAF(3)); }
  #undef PKW
  #undef PAF
  #undef VFR
  #undef PIN
  #undef MX3
  #undef GAPA
  #undef GAPB
  #undef EX
  #undef VRD
  #undef KRD
  #undef STEP
  #undef ENDW
  {auto rr=__builtin_amdgcn_permlane32_swap(__float_as_uint(l_reg),__float_as_uint(l_reg),false,false);l_reg=__uint_as_float(rr[0])+__uint_as_float(rr[1]);}
  if(hi==0)wsf[32+r32]=l_reg;asm volatile("s_waitcnt lgkmcnt(0)":::"memory");
  float rli[16];
  #pragma unroll
  for(int r=0;r<16;++r)rli[r]=__builtin_amdgcn_rcpf(wsf[32+crow(r,hi)]);
  bf16*Ow=O+(rowbase+q0+wid*QBLK)*POUT+h*D; float*Sw=SSQh+(rowbase+q0+wid*QBLK)*16;
  { bf16*stg=(bf16*)(shm+LDS_OST)+wid*2048;
    #pragma unroll
    for(int r=0;r<16;++r){const int orow=crow(r,hi);
      #pragma unroll
      for(int d0=0;d0<2;++d0)stg[orow*64+d0*32+r32]=__float2bfloat16(o[d0][r]*rli[r]);}
    asm volatile("s_waitcnt lgkmcnt(0)":::"memory");
    #pragma unroll
    for(int i=0;i<4;++i){const int row=i*8+(lane>>3),ch=lane&7; const u32x4 v=*(const u32x4*)(stg+row*64+ch*8); ATTN_STORE16(Ow+(long)row*POUT+ch*8,v);
      float sq=0.f;
      #pragma unroll
      for(int w_=0;w_<4;++w_){const float lo_=__uint_as_float(v[w_]<<16),hi_=__uint_as_float(v[w_]&0xffff0000u);sq+=lo_*lo_+hi_*hi_;}
      sq+=__shfl_xor(sq,1);sq+=__shfl_xor(sq,2);sq+=__shfl_xor(sq,4); if(ch==0)Sw[row*16]=sq;} }
  asm volatile("s_waitcnt lgkmcnt(0)\n\ts_barrier":::"memory");
  #undef DMA_K
  #undef DMA_V
  #undef CMASK
  #undef BIAS
  #undef START
  #undef RESC
  #undef ROT
}
constexpr int ATTN_LDS_BYTES=LDS_BYTES;

__device__ __forceinline__ void sb_unit(int b,int h,int qb,const bf16*Q,const bf16*__restrict__ K,const bf16*__restrict__ V,bf16*O,float*__restrict__ SSQh,char*shm){
  int tid_=threadIdx.x; asm volatile("":"+v"(tid_));
  const int tid=tid_,lane=tid&63,r32=lane&31,hi=lane>>5; const int wid=__builtin_amdgcn_readfirstlane(tid>>6);
  const long rowbase=(long)b*SEQ; const int q0=qb*QB;
  const bf16*Qw=Q+(rowbase+q0+wid*QBLK)*PIN+h*D;
  const bf16*Kh=K+rowbase*PIN+h*D,*Vh=V+rowbase*PIN+h*D;
  const unsigned lds0=(unsigned)(uintptr_t)shm;
  const bf16*ksrc=Kh+(long)lane*PIN+wid*8;
  const bf16*vsrc=Vh+(long)(16*(wid&3)+(lane>>2))*PIN+(wid>>2)*32+(lane&3)*8;
  const unsigned kdst=lds0+LDS_K+wid*1024, vdst=lds0+LDS_V+wid*1024;
  const int vb0=(int)(lds0+LDS_V)+((lane>>4)&1)*32+(lane&3)*8+(4*hi+((lane&15)>>2))*64;
  const char*Kbase=shm+LDS_K;
  const int NT=(q0+QB)/KVBLK;
  #define SB_DMA(i,slot) do{ const long kt_=(long)(NT-1-(i)); glds16(ksrc+kt_*KVBLK*PIN,(unsigned)__builtin_amdgcn_readfirstlane(kdst+(slot))); glds16(vsrc+kt_*KVBLK*PIN,(unsigned)__builtin_amdgcn_readfirstlane(vdst+(slot))); }while(0)
  bf16x8 qr[4];
  #pragma unroll
  for(int d0=0;d0<4;++d0)qr[d0]=*reinterpret_cast<const bf16x8*>(&Qw[(long)r32*PIN+d0*16+hi*8]);
  SB_DMA(0,0); SB_DMA(1,SLOTB);
  f32x16 o[2];o[0]=f32x16{};o[1]=f32x16{};
  float Rc=1.f;
  const int qrel=wid*QBLK+r32;
  int sl_cur=0,sl_n1=SLOTB,sl_n2=2*SLOTB;
  volatile __attribute__((address_space(3))) unsigned*flg=(volatile __attribute__((address_space(3))) unsigned*)((lds_cptr)shm+LDS_WS);
  f32x16 pA0,pA1,pB0,pB1;
  WAIT_BAR(3);
  { f32x16 z=f32x16{}; asm volatile("":"+v"(z)); qkt(pA0,pA1,Kbase+sl_cur,qr,z,r32,hi); }
  bool done_=false;
  #define SB_STEP(i,P0,P1,N0,N1) do{ \
    if((i)+1<NT){WAIT_BAR(1);}else{WAIT_BAR(0);} \
    if((i)>0){ const int pb=(((i)-1)&1)*8; unsigned all_=flg[pb]&flg[pb+1]&flg[pb+2]&flg[pb+3]&flg[pb+4]&flg[pb+5]&flg[pb+6]&flg[pb+7]; if(__builtin_amdgcn_readfirstlane(all_)){done_=true;break;} } \
    if((i)+2<NT)SB_DMA((i)+2,sl_n2); \
    if((i)+1<NT){ f32x16 z=f32x16{}; asm volatile("":"+v"(z)); qkt(N0,N1,Kbase+sl_n1,qr,z,r32,hi); SBAR(); } \
    f32x16 s0,s1; \
    _Pragma("unroll") for(int r=0;r<16;++r){ \
      const float za=__builtin_amdgcn_fmed3f(P0[r],-100.f,100.f), zb=__builtin_amdgcn_fmed3f(P1[r],-100.f,100.f); \
      P0[r]=__builtin_amdgcn_exp2f(za); P1[r]=__builtin_amdgcn_exp2f(zb); \
      s0[r]=__builtin_amdgcn_rcpf(1.f+P0[r]); s1[r]=__builtin_amdgcn_rcpf(1.f+P1[r]); } \
    if((i)<4){ const int kb=64*(3-(i))+4*hi; \
      _Pragma("unroll") for(int r=0;r<16;++r){ const int kv=kb+(r&3)+8*(r>>2); if(kv>=qrel){P0[r]=0.f;s0[r]=1.f;} if(kv+32>=qrel){P1[r]=0.f;s1[r]=1.f;} } } \
    float gp[8],pp[8]; \
    _Pragma("unroll") for(int g=0;g<4;++g){ \
      s0[4*g+2]*=s0[4*g+3]; s0[4*g+1]*=s0[4*g+2]; s0[4*g]*=s0[4*g+1]; gp[g]=s0[4*g]; \
      s1[4*g+2]*=s1[4*g+3]; s1[4*g+1]*=s1[4*g+2]; s1[4*g]*=s1[4*g+1]; gp[4+g]=s1[4*g]; } \
    _Pragma("unroll") for(int g=0;g<8;++g){ auto rr=__builtin_amdgcn_permlane32_swap(__float_as_uint(gp[g]),__float_as_uint(gp[g]),false,false); pp[g]=__uint_as_float(hi?rr[0]:rr[1]); } \
    float st=Rc, outer[8]; \
    _Pragma("unroll") for(int g=7;g>=0;--g){ outer[g]=hi?st:st*pp[g]; st=st*(gp[g]*pp[g]); } \
    Rc=st; \
    { const unsigned dn=__all(Rc==0.f)?1u:0u; if(lane==0)flg[((i)&1)*8+wid]=dn; } \
    _Pragma("unroll") for(int r=0;r<16;++r){ P0[r]=P0[r]*(s0[r]*outer[r>>2]); P1[r]=P1[r]*(s1[r]*outer[4+(r>>2)]); } \
    u32x4 pw0,pw1,pw2,pw3; \
    pw0=(u32x4){cvtpk_s(P0[0],P0[1]),cvtpk_s(P0[2],P0[3]),cvtpk_s(P0[4],P0[5]),cvtpk_s(P0[6],P0[7])}; \
    pw1=(u32x4){cvtpk_s(P0[8],P0[9]),cvtpk_s(P0[10],P0[11]),cvtpk_s(P0[12],P0[13]),cvtpk_s(P0[14],P0[15])}; \
    pw2=(u32x4){cvtpk_s(P1[0],P1[1]),cvtpk_s(P1[2],P1[3]),cvtpk_s(P1[4],P1[5]),cvtpk_s(P1[6],P1[7])}; \
    pw3=(u32x4){cvtpk_s(P1[8],P1[9]),cvtpk_s(P1[10],P1[11]),cvtpk_s(P1[12],P1[13]),cvtpk_s(P1[14],P1[15])}; \
    SBAR(); pv(o,vb0+sl_cur,__builtin_bit_cast(bf16x8,pw0),__builtin_bit_cast(bf16x8,pw1),__builtin_bit_cast(bf16x8,pw2),__builtin_bit_cast(bf16x8,pw3)); \
    { const int t_=sl_cur; sl_cur=sl_n1; sl_n1=sl_n2; sl_n2=t_; } \
  }while(0)
  for(int i=0;i<NT&&!done_;i+=2){
    SB_STEP(i,pA0,pA1,pB0,pB1); if(done_)break;
    SB_STEP(i+1,pB0,pB1,pA0,pA1);
  }
  #undef SB_STEP
  #undef SB_DMA
  bf16*Ow=O+(rowbase+q0+wid*QBLK)*POUT+h*D; float*Sw=SSQh+(rowbase+q0+wid*QBLK)*16;
  { bf16*stg=(bf16*)(shm+LDS_OST)+wid*2048;
    #pragma unroll
    for(int r=0;r<16;++r){const int orow=crow(r,hi);
      #pragma unroll
      for(int d0=0;d0<2;++d0)stg[orow*64+d0*32+r32]=__float2bfloat16(o[d0][r]);}
    asm volatile("s_waitcnt lgkmcnt(0)":::"memory");
    #pragma unroll
    for(int i=0;i<4;++i){const int row=i*8+(lane>>3),ch=lane&7; const u32x4 v=*(const u32x4*)(stg+row*64+ch*8); ATTN_STORE16(Ow+(long)row*POUT+ch*8,v);
      float sq=0.f;
      #pragma unroll
      for(int w_=0;w_<4;++w_){const float lo_=__uint_as_float(v[w_]<<16),hi_=__uint_as_float(v[w_]&0xffff0000u);sq+=lo_*lo_+hi_*hi_;}
      sq+=__shfl_xor(sq,1);sq+=__shfl_xor(sq,2);sq+=__shfl_xor(sq,4); if(ch==0)Sw[row*16]=sq;} }
  asm volatile("s_waitcnt vmcnt(0) lgkmcnt(0)\n\ts_barrier":::"memory");
}
template<int THRL=8> __device__ __forceinline__ void attn_phase(char*lds,const bf16*PROJ,const float*CUM,bf16*OMIX,float*SSQ,float skipth,int bh,int role){
  const int b=bh>>3,h=bh&7;
  const int nf=role<5?2:6;
  for(int i=0;i<nf;++i){ const int qb=role<5?(i==0?15-role:6+role):5-i;
    attn_unit<THRL>(b,h,qb,PROJ,PROJ+512,PROJ+1024,OMIX,CUM+(size_t)bh*SEQ,SSQ+h,skipth,lds); }
  const int sb0=role<3?3+3*role:(role==3?12:(role==4?14:0)), ns=(role==3||role==4)?2:3;
  for(int i=0;i<ns;++i) sb_unit(b,h,sb0+i,PROJ+1536,PROJ+2048,PROJ+2560,OMIX+512,SSQ+8+h,lds);
}
template<int THRL,int NA> __device__ __forceinline__ void attn_sched(char*lds,const bf16*PROJ,const float*CUM,bf16*OMIX,float*SSQ,float skipth,int xl,int c){
  int tid_=threadIdx.x; asm volatile("":"+v"(tid_)); const int tid=tid_;
  volatile __attribute__((address_space(3))) float*cost=(volatile __attribute__((address_space(3))) float*)((lds_cptr)lds+114688);
  volatile __attribute__((address_space(3))) int*order=(volatile __attribute__((address_space(3))) int*)((lds_cptr)lds+114688+512);
  #define BH_OF(i) ((xl>>1)*8+(((xl&1)?0x4361:0x5270)>>(4*(i))&15))
  if(tid<128){ const int bi=tid>>5,type=(tid>>4)&1,qb=tid&15,bh=BH_OF(bi),NT0=4*(qb+1); float cs;
    if(type==0){ const float rate=-CUM[(size_t)bh*SEQ+SEQ-1]*(1.f/SEQ); const float w=skipth/fmaxf(rate,1e-6f); const float sk=fmaxf(0.f,(float)(qb*QB)-w);
      int t0=((int)(sk*(1.f/KVBLK)))&~1; if(t0>NT0-4)t0=NT0-4; cs=5.f+1.65f*(float)(NT0-t0); }
    else cs=3.f+2.6f*(float)(NT0<8?NT0:8);
    cost[tid]=cs; }
  asm volatile("s_waitcnt lgkmcnt(0)":::"memory"); __syncthreads();
  if(tid<128){ const float mc=cost[tid]; int rk=0; for(int j=0;j<128;++j){ const float cj=cost[j]; rk+=(cj>mc||(cj==mc&&j<tid))?1:0; } order[rk]=tid; }
  asm volatile("s_waitcnt lgkmcnt(0)":::"memory"); __syncthreads();
  for(int k=0;;++k){ const int r=NA*k+((k&1)?NA-1-c:c); if(r>=128)break;
    const int u=__builtin_amdgcn_readfirstlane(order[r]); const int bi=u>>5,type=(u>>4)&1,qb=u&15,bh=BH_OF(bi),b=bh>>3,h=bh&7;
    if(type==0)attn_unit<THRL>(b,h,qb,PROJ,PROJ+512,PROJ+1024,OMIX,CUM+(size_t)bh*SEQ,SSQ+h,skipth,lds);
    else sb_unit(b,h,qb,PROJ+1536,PROJ+2048,PROJ+2560,OMIX+512,SSQ+8+h,lds); }
  #undef BH_OF
}
template<int THRL=8> __device__ __forceinline__ void attn_phase8(char*lds,const bf16*PROJ,const float*CUM,bf16*OMIX,float*SSQ,int vcu){
  const int bh=vcu>>3,s=vcu&7,b=bh>>3,h=bh&7;
  if(bh>=32)return;
  for(int i=0;i<4;++i){ const int qb=(i&1)?15-s:s;
    if(i<2)attn_unit<THRL>(b,h,qb,PROJ,PROJ+512,PROJ+1024,OMIX,CUM+(size_t)bh*SEQ,SSQ+h,3.0e38f,lds);
    else   sb_unit(b,h,qb,PROJ+1536,PROJ+2048,PROJ+2560,OMIX+512,SSQ+8+h,lds); }
}
#undef SBAR
#undef WAIT_BAR
}

template <int NT, bool UP> __device__ __forceinline__ int moe_prepare(const unsigned* __restrict__ CNT, const int* __restrict__ LIST, const float* __restrict__ RSTD2, const float* __restrict__ RW,
                                                                     const float* __restrict__ bias, int* __restrict__ TBG, int bx, LAS unsigned char* L) {
    int tid_ = threadIdx.x; asm volatile("" : "+v"(tid_)); const int tid = tid_;
    LAS int* tb = (LAS int*)(L + TB_OFF); LAS int* tbE = tb + 64; LAS int* tbC = tb + 128; LAS int* cntl = tb + 192; LAS int* udl = tb + 224; LAS int* tabA = (LAS int*)(L + TAB_OFF); LAS float* tabB = (LAS float*)(L + TAB2_OFF);
    if (tid < 64) {
        const int cn = tid < NE ? (int)CNT[tid] : 0, nt = (cn + 255) >> 8, rem = cn & 255, ch = (rem != 0 && rem <= 128) ? 1 : 0;
        int a = nt, c = ch;
#pragma unroll
        for (int o = 1; o < 32; o <<= 1) { const int ta = __shfl_up(a, o), tc = __shfl_up(c, o); if ((tid & 63) >= o) { a += ta; c += tc; } }
        if (tid < NE) { tb[tid + 1] = a; tbC[tid + 1] = c; tbE[tid + 1] = a - c; cntl[tid] = cn; }
        if (tid == 0) { tb[0] = 0; tbC[0] = 0; tbE[0] = 0; }
    }
    LDS_WAIT(); __syncthreads();
    if (bx == 0 && tid <= NE) TBG[tid] = tb[tid];
    pg8::MoeOrder S{NT, bx, tb, tbE, tbC, cntl, tabA};
    if (tid < pg8::MOE_MAXU) { pg8::Unit u; const bool ok = S.next(tid, u); udl[3 * tid] = ok ? u.pm : -1; udl[3 * tid + 1] = u.pn; udl[3 * tid + 2] = u.nr; }
    LDS_WAIT(); __syncthreads();
    int nun = 0;
#pragma unroll
    for (int i = 0; i < pg8::MOE_MAXU; ++i) nun += (udl[3 * i] >= 0) ? 1 : 0;
    int slot[5];
#pragma unroll
    for (int j = 0; j < 5; ++j) { const int idx = tid + NTHREADS * j, ui = idx >> 8, r = idx & 255; slot[j] = 0;
        if (ui < nun) { const int e = udl[3 * ui + 1] / NT, mt = udl[3 * ui] - tb[e], cnt = cntl[e], p = mt * 256 + r; slot[j] = LIST[(size_t)e * LIST_CAP + (p < cnt ? p : cnt - 1)]; } }
#pragma unroll
    for (int j = 0; j < 5; ++j) { const int idx = tid + NTHREADS * j, ui = idx >> 8;
        if (ui < nun) { const int pn = udl[3 * ui + 1];
            if (UP) { const int tok = slot[j] >> 2; tabA[idx] = tok | (int)(__float_as_uint(RSTD2[tok]) & 0xffff0000u);
                      const int e = pn >> 3, pl = pn & 7, c = idx & 255; tabB[idx] = bias[(size_t)e * 2048 + (c < 128 ? pl * 128 + c : 1024 + pl * 128 + (c - 128))]; }
            else { ((LAS float*)tabA)[idx] = RW[slot[j]] * (Y_F8 ? 16.f : 1.f); const int e = pn >> 2, pl = pn & 3; tabB[idx] = bias[(size_t)e * DM + pl * 256 + (idx & 255)]; } } }
    VM_WAIT(); LDS_WAIT(); __syncthreads();
    return nun;
}

__global__ void __launch_bounds__(NTHREADS, 2) mega_fwd(Args a) {
    extern __shared__ __attribute__((aligned(16))) unsigned char lds[];
    LAS unsigned char* L = (LAS unsigned char*)lds;
    volatile LAS unsigned* MISC = (volatile LAS unsigned*)(L + MISC_OFF);
    const int tid = threadIdx.x, lane = tid & 63, wave = __builtin_amdgcn_readfirstlane(tid >> 6);
    const int G = gridDim.x, bx = blockIdx.x, vcu = (G % 8 == 0) ? (bx % 8) * (G / 8) + bx / 8 : bx;
    const int gw = vcu * NWAVES + wave, NGW = G * NWAVES;
    const bool cvt_role = (vcu & 31) >= 32 - NCVT;
    const int cvt_first = ((vcu >> 5) * NCVT + ((vcu & 31) - (32 - NCVT))) * NWAVES + wave;
    const bool cvt1_role = (vcu & 31) >= 24; const int cvt1_first = ((vcu >> 5) * 8 + ((vcu & 31) - 24)) * NWAVES + wave;
    unsigned char* ws = a.ws;
    unsigned* CTL = (unsigned*)(ws + WS_CTL);
    bf16_t* WINT = (bf16_t*)(ws + WS_WINT); bf16_t* WOUTT = (bf16_t*)(ws + WS_WOUTT); float* WR = (float*)(ws + WS_WR); float* CUM = (float*)(ws + WS_CUM);
    float* SSQ = (float*)(ws + WS_SSQ); float* RSTD2 = (float*)(ws + WS_RSTD2); float* RW = (float*)(ws + WS_RW); int* SLOTEP = (int*)(ws + WS_SLOTEP); int* TBG = (int*)(ws + WS_TBG); int* LIST = (int*)(ws + WS_LIST); float* FLOG = (float*)(ws + WS_FLOG);
    bf16_t* XN = (bf16_t*)(ws + WS_XN); bf16_t* PROJ = (bf16_t*)(ws + WS_PROJ); bf16_t* OMIX = (bf16_t*)(ws + WS_OMIX); bf16_t* X1B = (bf16_t*)(ws + WS_X1B);
    bf16_t* W1T = (bf16_t*)(ws + WS_W1T); bf16_t* W2T = (bf16_t*)(ws + WS_W2T); bf16_t* H = (bf16_t*)(ws + WS_H); bf16_t* Y = (bf16_t*)(ws + WS_Y);
    unsigned* CNT = CTL + CW_CNT;
    for (int u = tid; u < (LDS_BYTES - LDSCTL_OFF) / 4; u += NTHREADS) ((LAS unsigned*)(L + LDSCTL_OFF))[u] = 0u;
    __syncthreads();
    XcdBarrier bar = xcd_barrier_post(CTL + CW_BAR, MISC + 8);

    REPS(0) {
        LAS float* scr = (LAS float*)(L + RING_OFF + wave * 8448);
        LAS float* wf = (LAS float*)(L + RING_OFF + 98304);
        for (int i = tid; i < DM * 8; i += NTHREADS) { const int k = i >> 3; wf[i] = a.w_in[(size_t)k * WIN_N + 1536 + (i & 7)] * a.g1[k]; }
        LDS_WAIT(); __syncthreads();
        constexpr int I_IN = (DM / 64) * (NPROJ / 32), I_OUT = (DM / 64) * (DM / 32);
        for (int it = gw; it < I_IN + I_OUT; it += NGW) {
            TrItem t; f32x4 v[8];
            if (it < I_IN) { t.W = a.w_in; t.WT = WINT; t.gA = a.g1; t.gB = nullptr; t.K = DM; t.Nin = WIN_N; t.Nout = NPROJ; t.mode = 1; t.gsplit = DM; t.item = it; t.nbsh = -1; t.f8 = 0; }
            else { t.W = a.w_out; t.WT = WOUTT; t.gA = a.g_fox; t.gB = a.g_sb; t.K = DM; t.Nin = DM; t.Nout = DM; t.mode = 0; t.gsplit = GW; t.item = it - I_IN; t.nbsh = 5; t.f8 = 0; }
            tr_load<false>(t, lane, v); tr_store(t, lane, v, scr);
        }
        if (!OVERLAP_CVT) convert_experts(a.w1, a.w2, a.g2, W1T, W2T, gw, NGW, N_EXP_ITEMS, lane, scr);
        for (int i = gw * 64 + lane; i < DM * NE; i += NGW * 64) WR[i] = a.w_router[i] * a.g2[i >> 5];
        for (int row = gw; row < M; row += NGW) rms1_row(a.x, wf, a.b_f, XN, FLOG, row, lane);
    }
    xcd_barrier(bar); if (REP_PHASE == 8) xcd_barrier(bar);
    REPS(1) {
    if (vcu < NB * NH) cumsum_wg(FLOG, CUM, vcu, (LAS float*)(L + RING_OFF));
    if (OPT_GEMM) {
        if (OVERLAP_CVT && CVT_SPLIT > 0 && cvt1_role) convert_experts(a.w1, a.w2, a.g2, W1T, W2T, cvt1_first, 64 * NWAVES, CVT_SPLIT, lane, (LAS float*)(L + RING_OFF + wave * 8448));
        else {
        pg8::Gemm g{XN, WINT, DM}; pg8::StaticOrder S; if (OVERLAP_CVT && CVT_SPLIT > 0) S.init(M, NPROJ, 192, (vcu & 31) * 8 + (vcu >> 5)); else S.init(M, NPROJ, G, bx); pg8::EpiProj E{PROJ, CTL + CW_QHP};
        pg8::gemm_phase<pg8::EpiProj, pg8::StaticOrder, true, false>(L + RING_OFF, g, S, E);
        }
    } else { for (int it = gw; it < (M / 16) * (NPROJ / 64); it += NGW) nv_inproj(XN, WINT, PROJ, it, lane); }
    }
    xcd_barrier(bar); if (REP_PHASE == 8) xcd_barrier(bar);
    REPS(2) if (OPT_ATTN) {
        static_assert(attn_body::ATTN_LDS_BYTES <= RING_BYTES, "attention scratch inside the ring region");
        if (OVERLAP_CVT) {
            const int xl = vcu >> 5, l = vcu & 31;
            if (cvt_role) convert_experts(a.w1, a.w2, a.g2, W1T, W2T, CVT_SPLIT + cvt_first, 8 * NCVT * NWAVES, N_EXP_ITEMS, lane, (LAS float*)(L + RING_OFF + wave * 8448));
            const float bnd = 2.04f * sqrtf(__uint_as_float(CTL[CW_QHP]) * __uint_as_float(CTL[CW_KHP])), skipth = FOX_SKIP ? 160.f + 2.f * bnd : 3.0e38f;
            if (l < 32 - NCVT) { if (ATTN_SCHED) attn_body::attn_sched<8, 32 - NCVT>((char*)lds + RING_OFF, (const attn_body::bf16*)PROJ, CUM, (attn_body::bf16*)OMIX, SSQ, skipth, xl, l);
                          else attn_body::attn_phase<8>((char*)lds + RING_OFF, (const attn_body::bf16*)PROJ, CUM, (attn_body::bf16*)OMIX, SSQ, skipth, xl * 4 + l / 6, l % 6); }
        } else attn_body::attn_phase8<8>((char*)lds + RING_OFF, (const attn_body::bf16*)PROJ, CUM, (attn_body::bf16*)OMIX, SSQ, vcu);
    } else {
        LAS unsigned char* wl = L + RING_OFF + wave * 16640;
        for (int u = gw; u < 4096; u += NGW) {
            const int i = u >> 11, idx = u & 2047, type = idx & 1, bh = (idx >> 1) & 31, j = (idx >> 6) & 31; const int qblk = (i == 0) ? j : 63 - j;
            if (type == 0) nv_attn<0>(PROJ, CUM, OMIX, SSQ, bh, qblk, lane, wl); else nv_attn<1>(PROJ, CUM, OMIX, SSQ, bh, qblk, lane, wl);
        }
    }
    xcd_barrier(bar); if (REP_PHASE == 8) xcd_barrier(bar);
    REPS(3) if (OPT_GEMM) {
        pg8::Gemm g{OMIX, WOUTT, DM}; pg8::StaticOrder S; S.init(M, DM, G, bx);
        LAS float* ratio = (LAS float*)(L + TAB_OFF); LAS float* rsb = (LAS float*)(L + TAB_OFF + 1024);
        pg8::Unit u0;
        if (S.next(0, u0) && tid < 256) { const float* sp = SSQ + (size_t)(u0.pm * 256 + tid) * 16; float sf = 0.f, s2 = 0.f;
#pragma unroll
            for (int h = 0; h < 8; ++h) { sf += sp[h]; s2 += sp[8 + h]; }
            const float rf = rsqrtf(sf * (1.f / GW) + EPS), rs = rsqrtf(s2 * (1.f / GW) + EPS); ratio[tid] = rf / rs; rsb[tid] = rs; }
        VM_WAIT(); LDS_WAIT(); __syncthreads();
        pg8::EpiWout E{a.x, a.out, X1B, ratio, rsb};
        pg8::gemm_phase<pg8::EpiWout, pg8::StaticOrder, false, false>(L + RING_OFF, g, S, E);
    } else { for (int it = gw; it < (M / 16) * (DM / 64); it += NGW) nv_wout(OMIX, WOUTT, SSQ, a.x, a.out, X1B, it, lane); }
    xcd_barrier(bar); if (REP_PHASE == 8) xcd_barrier(bar);
    if (REP_PHASE == 4) { for (int t64 = vcu; t64 < M / 64; t64 += G) router_wg(a.out, WR, a.b_router, (float*)H, (float*)H + M, (int*)Y, (int*)Y + NE * LIST_CAP, CNT + 64, t64 * 64, L + RING_OFF); }
    if (OPT_ROUTER) { for (int t64 = vcu; t64 < M / 64; t64 += G) router_wg(a.out, WR, a.b_router, RSTD2, RW, LIST, SLOTEP, CNT, t64 * 64, L + RING_OFF); }
    else { for (int it = gw; it < M / 2; it += NGW) nv_router(a.out, WR, a.b_router, RSTD2, RW, LIST, SLOTEP, CNT, it, lane); }
    xcd_barrier(bar); if (REP_PHASE == 8) xcd_barrier(bar);
    LAS int* tb = (LAS int*)(L + TB_OFF); LAS int* tbE = tb + 64; LAS int* tbC = tb + 128; LAS int* cntl = tb + 192; LAS int* udl = tb + 224; LAS int* tabA = (LAS int*)(L + TAB_OFF); LAS int* tabB = (LAS int*)(L + TAB2_OFF);
    REPS(5) if (OPT_GEMM) {
        const int nun = moe_prepare<8, true>(CNT, LIST, RSTD2, RW, a.b1, TBG, bx, L);
        pg8::Gemm g{X1B, W1T, MOE_F8 ? DM / 2 : DM}; pg8::EpiMoe1 E{H, tabA, (const LAS float*)tabB}; pg8::ListOrder SL{udl, nun, tabA};
        pg8::gemm_phase<pg8::EpiMoe1, pg8::ListOrder, true, true, MOE_F8>(L + RING_OFF, g, SL, E);
    } else {
    for (int g = gw; g < MAX_TILES * 16; g += NGW) {
        int e, base, p0, cnt; if (!moe_tile(CNT, g, e, base, p0, cnt)) continue;
        for (int cg = 0; cg < DFF / 32; ++cg) nv_moe1(X1B, W1T, a.b1, RSTD2, LIST, H, e, base, p0, cnt, cg, lane);
    } }
    xcd_barrier(bar); if (REP_PHASE == 8) xcd_barrier(bar);
    REPS(6) if (OPT_GEMM) {
        const int nun = moe_prepare<4, false>(CNT, LIST, RSTD2, RW, a.b2, TBG, bx, L);
        pg8::Gemm g{H, W2T, MOE_F8 ? DM / 2 : DM}; pg8::EpiMoe2 E{Y, (const LAS float*)tabA, (const LAS float*)tabB}; pg8::ListOrder SL{udl, nun, tabA};
        pg8::gemm_phase<pg8::EpiMoe2, pg8::ListOrder, true, false, MOE_F8>(L + RING_OFF, g, SL, E);
    } else {
    for (int g = gw; g < MAX_TILES * 16; g += NGW) {
        int e, base, p0, cnt; if (!moe_tile(CNT, g, e, base, p0, cnt)) continue;
        for (int cg = 0; cg < DM / 64; ++cg) nv_moe2(H, W2T, a.b2, RW, LIST, Y, e, base, p0, cnt, cg, lane);
    } }
    xcd_barrier(bar); if (REP_PHASE == 8) xcd_barrier(bar);
    if (REP_PHASE == 7) { for (int row = gw; row < M; row += NGW) final_row(a.out, Y, SLOTEP, TBG, a.gf, (float*)H, row, lane); }
    for (int row = gw; row < M; row += NGW) final_row(a.out, Y, SLOTEP, TBG, a.gf, a.out, row, lane);
}

extern "C" void kernel_launch(void* const* d_in, const int* in_sizes, int n_in, void* d_out, int out_size, void* d_ws, size_t ws_size, hipStream_t stream) {
    static int grid = 0;
    if (grid == 0) {
        if (n_in != 15 || in_sizes[0] != M * DM || out_size != M * DM || ws_size < WS_END) {
            fprintf(stderr, "kernel_launch: unexpected shapes / workspace (n_in %d, in0 %d, out %d, ws %zu, need %zu)\n", n_in, n_in > 0 ? in_sizes[0] : -1, out_size, ws_size, (size_t)WS_END); grid = -1; return; }
        int dev = 0, cus = 0, per_cu = 0;
        if (hipGetDevice(&dev) != hipSuccess || hipDeviceGetAttribute(&cus, hipDeviceAttributeMultiprocessorCount, dev) != hipSuccess) { grid = -1; return; }
        if (hipFuncSetAttribute((const void*)mega_fwd, hipFuncAttributeMaxDynamicSharedMemorySize, LDS_BYTES) != hipSuccess) { fprintf(stderr, "kernel_launch: hipFuncSetAttribute failed\n"); grid = -1; return; }
        if (hipOccupancyMaxActiveBlocksPerMultiprocessor(&per_cu, (const void*)mega_fwd, NTHREADS, LDS_BYTES) != hipSuccess || per_cu < 1) fprintf(stderr, "kernel_launch: occupancy query reports %d\n", per_cu);
        (void)hipGetLastError();
        grid = cus;
        if (cus != 256) { fprintf(stderr, "kernel_launch: built for 256 CUs (8 XCDs x 32), found %d; nothing launched\n", cus); grid = -1; return; }
    }
    if (grid < 0) return;
    if (hipMemsetAsync((char*)d_ws + WS_CTL, 0, CTL_BYTES, stream) != hipSuccess) return;
    Args a{};
    a.x = (const float*)d_in[0]; a.g1 = (const float*)d_in[1]; a.w_in = (const float*)d_in[2]; a.b_f = (const float*)d_in[3]; a.g_fox = (const float*)d_in[4]; a.g_sb = (const float*)d_in[5];
    a.w_out = (const float*)d_in[6]; a.g2 = (const float*)d_in[7]; a.w_router = (const float*)d_in[8]; a.b_router = (const float*)d_in[9]; a.w1 = (const float*)d_in[10]; a.b1 = (const float*)d_in[11];
    a.w2 = (const float*)d_in[12]; a.b2 = (const float*)d_in[13]; a.gf = (const float*)d_in[14];
    a.out = (float*)d_out; a.ws = (unsigned char*)d_ws;
    hipLaunchKernelGGL(mega_fwd, dim3(grid), dim3(NTHREADS), LDS_BYTES, stream, a);
    const hipError_t le = hipPeekAtLastError();
    if (le != hipSuccess) fprintf(stderr, "kernel_launch: launch failed: %s\n", hipGetErrorName(le));
}
```

```cpp
#include <hip/hip_runtime.h>
#include <cstdio>
#include <cstdint>

typedef unsigned short bf16_t;
typedef short bf16x8 __attribute__((ext_vector_type(8)));
typedef float f32x4 __attribute__((ext_vector_type(4)));

constexpr int NB = 4, SEQ = 4096, DM = 1024, M = NB * SEQ;
constexpr int NH = 8, HD = 64, GW = 512;
constexpr int WIN_N = 3080, NPROJ = 3072;
constexpr int NE = 32, TOPK = 4, DFF = 1024;
constexpr float EPS = 1e-5f;
constexpr float LOG2E = 1.4426950408889634f;
constexpr float C2 = 0.125f * LOG2E;
constexpr int LIST_CAP = M;
constexpr int MAX_TILES = (M * TOPK) / 256 + NE;

constexpr size_t MiB = 1u << 20;
constexpr size_t WS_CTL = 0, CTL_BYTES = 1 * MiB;
constexpr size_t WS_WINT = 2 * MiB;
constexpr size_t WS_WOUTT = 8 * MiB;
constexpr size_t WS_WR = 10 * MiB;
constexpr size_t WS_CUM = 11 * MiB;
constexpr size_t WS_SSQ = 12 * MiB;
constexpr size_t WS_RSTD2 = 14 * MiB;
constexpr size_t WS_RW = 15 * MiB;
constexpr size_t WS_SLOTEP = 15 * MiB + 512 * 1024;
constexpr size_t WS_TBG = 14 * MiB + 512 * 1024;
constexpr size_t WS_LIST = 16 * MiB;
constexpr size_t WS_FLOG = 18 * MiB;
constexpr size_t WS_XN = 32 * MiB;
constexpr size_t WS_PROJ = 64 * MiB;
constexpr size_t WS_OMIX = 160 * MiB;
constexpr size_t WS_X1B = 192 * MiB;
constexpr size_t WS_W1T = 224 * MiB;
constexpr size_t WS_W2T = 352 * MiB;
constexpr size_t WS_H = 416 * MiB;
constexpr size_t WS_Y = 560 * MiB;
constexpr size_t WS_END = 704 * MiB;
constexpr int CW_CNT = 1024;
constexpr int CW_QHP = 2048, CW_KHP = 2112;

__device__ __forceinline__ unsigned short f2bf(float f) { unsigned u = __float_as_uint(f); return (unsigned short)((u + 0x7fffu + ((u >> 16) & 1u)) >> 16); }
__device__ __forceinline__ float bf2f(unsigned short b) { return __uint_as_float(((unsigned)b) << 16); }
__device__ __forceinline__ float wave_sum(float v) {
#pragma unroll
    for (int o = 1; o < 64; o <<= 1) v += __shfl_xor(v, o);
    return v;
}


#define LAS __attribute__((address_space(3)))
#define GAS __attribute__((address_space(1)))
typedef unsigned v4u __attribute__((ext_vector_type(4)));
#define LDS_WAIT() asm volatile("s_waitcnt lgkmcnt(0)" ::: "memory")
#define VM_WAIT() asm volatile("s_waitcnt vmcnt(0)" ::: "memory")
constexpr int NWAVES = 8, NTHREADS = NWAVES * 64;
constexpr int REP_PHASE = -1;
#define REPS(k) for (int rep_ = 0; rep_ < ((REP_PHASE == (k)) ? 2 : 1); ++rep_)
constexpr bool ATTN_SCHED = true;
constexpr bool FOX_SKIP = true;
constexpr bool WT_STORES = false;
constexpr bool Y_F8 = false;
constexpr bool MOE_F8 = true;
constexpr bool CVT_DMA = true;
constexpr int NCVT = 8;
constexpr int CVT_SPLIT = 20 * 512;
constexpr bool OVERLAP_CVT = true;
constexpr bool OPT_GEMM = true;
constexpr bool OPT_ROUTER = true;
constexpr bool OPT_ATTN = true;

#define XB_TMO      128
#define XB_XCNT(j)  (256  + 64 * (j))
#define XB_XSUB(j)  (1280 + 64 * (j))
#define XB_XGEN(j)  (2304 + 64 * (j))
#define XB_TOP      3328
#define XB_TOPGEN   3392
#define XCD_BAR_WORDS 3456
#define XB_SPIN_CAP (1u << 20)
__device__ __forceinline__ unsigned xb_ld(unsigned* p)              { return __hip_atomic_load(p, __ATOMIC_RELAXED, __HIP_MEMORY_SCOPE_AGENT); }
__device__ __forceinline__ unsigned xb_add(unsigned* p, unsigned v) { return __hip_atomic_fetch_add(p, v, __ATOMIC_RELAXED, __HIP_MEMORY_SCOPE_AGENT); }
__device__ __forceinline__ unsigned xb_xcc_id() { return (unsigned)__builtin_amdgcn_s_getreg((3 << 11) | 20) & 0xFu; }
#define XB_SPIN(cond, bar) do { unsigned _sp = 0; while (cond) { __builtin_amdgcn_s_sleep(1); \
    if ((++_sp & 255u) == 0u) { if (xb_ld(&(bar)[XB_TMO])) break; if (_sp > XB_SPIN_CAP) { atomicAdd(&(bar)[XB_TMO], 1u); break; } } } } while (0)
struct XcdBarrier { unsigned* bar; unsigned x; volatile LAS unsigned* st; };
__device__ __forceinline__ XcdBarrier xcd_barrier_post(unsigned* bar, volatile LAS unsigned* st) {
    XcdBarrier b; b.bar = bar; b.x = xb_xcc_id(); b.st = st;
    if (threadIdx.x == 0) (void)xb_add(&bar[XB_XCNT(b.x)], 1u);
    return b;
}
__device__ __forceinline__ void xcd_barrier_complete(unsigned* bar, unsigned x, unsigned& nloc, unsigned& nx) {
    const unsigned G = gridDim.x * gridDim.y * gridDim.z;
    unsigned sum, cnt, mine, sp = 0u;
    for (;;) {
        sum = 0u; cnt = 0u; mine = 0u;
#pragma unroll
        for (unsigned j = 0; j < 16; ++j) { const unsigned c = xb_ld(&bar[XB_XCNT(j)]); sum += c; cnt += (c > 0u) ? 1u : 0u; mine = (j == x) ? c : mine; }
        if (sum == G) break;
        __builtin_amdgcn_s_sleep(1);
        if ((++sp & 255u) == 0u) { if (xb_ld(&bar[XB_TMO])) break; if (sp > XB_SPIN_CAP) { atomicAdd(&bar[XB_TMO], 1u); break; } }
    }
    nloc = mine > 0u ? mine : 1u; nx = cnt > 0u ? cnt : 1u;
}
__device__ __forceinline__ void xcd_barrier(const XcdBarrier& b) {
    asm volatile("s_waitcnt vmcnt(0)" ::: "memory");
    __syncthreads();
    if (threadIdx.x == 0) {
        unsigned* bar = b.bar;
        __builtin_amdgcn_s_waitcnt(0);
        unsigned nloc = b.st[0], nx = b.st[1];
        if (nloc == 0u) { xcd_barrier_complete(bar, b.x, nloc, nx); b.st[0] = nloc; b.st[1] = nx; }
        const unsigned old = xb_add(&bar[XB_XSUB(b.x)], 1u);
        const unsigned gen = old / nloc;
        if (old + 1u == (gen + 1u) * nloc) {
            __builtin_amdgcn_fence(__ATOMIC_RELEASE, "agent");
            asm volatile("s_waitcnt vmcnt(0)" ::: "memory");
            const unsigned og = xb_add(&bar[XB_TOP], 1u);
            const unsigned tg = og / nx;
            if (og + 1u == (tg + 1u) * nx) xb_add(&bar[XB_TOPGEN], 1u);
            else XB_SPIN(xb_ld(&bar[XB_TOPGEN]) == tg, bar);
            __builtin_amdgcn_fence(__ATOMIC_ACQUIRE, "agent");
            xb_add(&bar[XB_XGEN(b.x)], 1u);
            asm volatile("s_waitcnt vmcnt(0)" ::: "memory");
        } else {
            XB_SPIN(xb_ld(&bar[XB_XGEN(b.x)]) == gen, bar);
            __builtin_amdgcn_fence(__ATOMIC_ACQUIRE, "agent");
            asm volatile("s_waitcnt vmcnt(0)" ::: "memory");
        }
    }
    __syncthreads();
}

constexpr int RING_OFF = 0, RING_BYTES = 131072;
constexpr int TAB_OFF = 131072;
constexpr int TAB2_OFF = TAB_OFF + 10 * 1024, TB_OFF = TAB_OFF + 20 * 1024;
constexpr int LDSCTL_OFF = 152576, MISC_OFF = LDSCTL_OFF + 320;
constexpr int LDS_BYTES = 155648;
constexpr int CW_BAR = 4096;

struct Args {
    const float *x, *g1, *w_in, *b_f, *g_fox, *g_sb, *w_out, *g2, *w_router, *b_router, *w1, *b1, *w2, *b2, *gf;
    float* out; unsigned char* ws;
};

__device__ __forceinline__ int mapcol(int mode, int n) {
    if (mode == 1) return n < 1536 ? n : n + 8;
    if (mode == 2) { const int pn = n >> 8, j = n & 255; return j < 128 ? 128 * pn + j : 1024 + 128 * pn + (j - 128); }
    return n;
}
__device__ __forceinline__ unsigned pk4_fp8(float a, float b, float c, float d) {
    a = __builtin_amdgcn_fmed3f(a, -448.f, 448.f); b = __builtin_amdgcn_fmed3f(b, -448.f, 448.f); c = __builtin_amdgcn_fmed3f(c, -448.f, 448.f); d = __builtin_amdgcn_fmed3f(d, -448.f, 448.f);
    int w = __builtin_amdgcn_cvt_pk_fp8_f32(a, b, 0, false); w = __builtin_amdgcn_cvt_pk_fp8_f32(c, d, w, true); return (unsigned)w;
}
__device__ __forceinline__ unsigned pk2(float lo, float hi) { unsigned r; asm("v_cvt_pk_bf16_f32 %0, %1, %2" : "=v"(r) : "v"(lo), "v"(hi)); return r; }
struct TrItem { const float* W; bf16_t* WT; const float* gA; const float* gB; int K, Nin, Nout, mode, gsplit, item, nbsh, f8; };
template <bool NT> __device__ __forceinline__ void tr_load(const TrItem& t, int lane, f32x4 (&v)[8]) {
    const int nblk = t.Nout / 32, kb = t.nbsh >= 0 ? (t.item >> t.nbsh) : t.item / nblk, nb = t.nbsh >= 0 ? (t.item & (nblk - 1)) : t.item % nblk, k0 = 64 * kb, n0 = 32 * nb, l7 = lane & 7, kr = lane >> 3, col = mapcol(t.mode, n0 + 4 * l7);
#pragma unroll
    for (int i = 0; i < 8; ++i) { const f32x4* p = (const f32x4*)(t.W + (size_t)(k0 + 8 * i + kr) * t.Nin + col); v[i] = NT ? __builtin_nontemporal_load(p) : *p; }
}
__device__ __forceinline__ void tr_store(const TrItem& t, int lane, const f32x4 (&v)[8], LAS float* scr) {
    const int nblk = t.Nout / 32, kb = t.nbsh >= 0 ? (t.item >> t.nbsh) : t.item / nblk, nb = t.nbsh >= 0 ? (t.item & (nblk - 1)) : t.item % nblk, k0 = 64 * kb, n0 = 32 * nb, l7 = lane & 7, kr = lane >> 3;
#pragma unroll
    for (int i = 0; i < 8; ++i) { const int kk = 8 * i + kr, k = k0 + kk; const float gs = t.gA ? (k < t.gsplit ? t.gA[k] : t.gB[k - t.gsplit]) : 1.f;
        LAS float* sp = scr + kk * 33 + 4 * l7; sp[0] = v[i][0] * gs; sp[1] = v[i][1] * gs; sp[2] = v[i][2] * gs; sp[3] = v[i][3] * gs; }
    LDS_WAIT();
    if (t.f8) {
        const int c = lane & 3;
#pragma unroll
        for (int j = 0; j < 2; ++j) { const int n = (lane >> 2) + 16 * j; const LAS float* sp = scr + (16 * c) * 33 + n;
            v4u o; o.x = pk4_fp8(32.f * sp[0 * 33], 32.f * sp[1 * 33], 32.f * sp[2 * 33], 32.f * sp[3 * 33]); o.y = pk4_fp8(32.f * sp[4 * 33], 32.f * sp[5 * 33], 32.f * sp[6 * 33], 32.f * sp[7 * 33]);
            o.z = pk4_fp8(32.f * sp[8 * 33], 32.f * sp[9 * 33], 32.f * sp[10 * 33], 32.f * sp[11 * 33]); o.w = pk4_fp8(32.f * sp[12 * 33], 32.f * sp[13 * 33], 32.f * sp[14 * 33], 32.f * sp[15 * 33]);
            *(v4u*)((unsigned char*)t.WT + (size_t)(n0 + n) * t.K + k0 + 16 * c) = o; }
    } else {
    const int c = lane & 7;
#pragma unroll
    for (int j = 0; j < 4; ++j) { const int n = (lane >> 3) + 8 * j; const LAS float* sp = scr + (8 * c) * 33 + n;
        v4u o; o.x = pk2(sp[0 * 33], sp[1 * 33]); o.y = pk2(sp[2 * 33], sp[3 * 33]); o.z = pk2(sp[4 * 33], sp[5 * 33]); o.w = pk2(sp[6 * 33], sp[7 * 33]);
        *(v4u*)(t.WT + (size_t)(n0 + n) * t.K + k0 + 8 * c) = o; }
    }
    LDS_WAIT();
}
constexpr int I_W1 = (DM / 64) * (2048 / 32), I_W2 = (DM / 64) * (DM / 32), N_EXP_ITEMS = NE * (I_W1 + I_W2);
__device__ __forceinline__ TrItem expert_item(const float* w1, const float* w2, const float* g2, bf16_t* W1T, bf16_t* W2T, int r) {
    TrItem t;
    t.f8 = MOE_F8 ? 1 : 0;
    if (r < NE * I_W1) { const int e = r / I_W1; t.W = w1 + (size_t)e * DM * 2048; t.WT = MOE_F8 ? (bf16_t*)((unsigned char*)W1T + (size_t)e * 2048 * DM) : W1T + (size_t)e * 2048 * DM; t.gA = g2; t.gB = nullptr; t.K = DM; t.Nin = 2048; t.Nout = 2048; t.mode = 2; t.gsplit = DM; t.item = r % I_W1; t.nbsh = 6; }
    else { r -= NE * I_W1; const int e = r / I_W2; t.W = w2 + (size_t)e * DM * DM; t.WT = MOE_F8 ? (bf16_t*)((unsigned char*)W2T + (size_t)e * DM * DM) : W2T + (size_t)e * DM * DM; t.gA = nullptr; t.gB = nullptr; t.K = DM; t.Nin = DM; t.Nout = DM; t.mode = 0; t.gsplit = DM; t.item = r % I_W2; t.nbsh = 5; }
    return t;
}
__device__ __forceinline__ void convert_experts(const float* w1, const float* w2, const float* g2, bf16_t* W1T, bf16_t* W2T, int first, int stride, int N_END, int lane, LAS float* scr) {
    f32x4 v0[8], v1[8];
#define CVT_LOAD(v, idx) do { if ((idx) < N_END) { const TrItem t_ = expert_item(w1, w2, g2, W1T, W2T, (idx)); tr_load<true>(t_, lane, v); } } while (0)
#define CVT_STORE(v, idx) do { if ((idx) < N_END) { const TrItem t_ = expert_item(w1, w2, g2, W1T, W2T, (idx)); tr_store(t_, lane, v, scr); } } while (0)
    int it = first; asm volatile("" : "+v"(lane));
    CVT_LOAD(v0, it);
#pragma unroll 1
    for (; it < N_END; it += 2 * stride) {
        CVT_LOAD(v1, it + stride); CVT_STORE(v0, it);
        CVT_LOAD(v0, it + 2 * stride); CVT_STORE(v1, it + stride);
    }
#undef CVT_LOAD
#undef CVT_STORE
}

__device__ __forceinline__ void dma16(const void* gsrc, unsigned lds_dst) { unsigned keep;
    asm volatile("s_mov_b32 %0, m0\n\ts_mov_b32 m0, %2\n\ts_nop 0\n\tglobal_load_lds_dwordx4 %1, off\n\ts_mov_b32 m0, %0" : "=&s"(keep) : "v"(gsrc), "s"(lds_dst) : "memory"); }
struct CvtItem { const float* W; unsigned char* WT; int Nin, k0, n0, col0, useg; };
__device__ __forceinline__ CvtItem cvt_item(const float* w1, const float* w2, bf16_t* W1T, bf16_t* W2T, int r) {
    CvtItem t;
    if (r < NE * I_W1) { const int e = r / I_W1, it = r % I_W1; t.W = w1 + (size_t)e * DM * 2048; t.WT = (unsigned char*)W1T + (size_t)e * 2048 * DM; t.Nin = 2048; t.k0 = 64 * (it >> 6); t.n0 = 32 * (it & 63); t.col0 = mapcol(2, t.n0); t.useg = 1; }
    else { r -= NE * I_W1; const int e = r / I_W2, it = r % I_W2; t.W = w2 + (size_t)e * DM * DM; t.WT = (unsigned char*)W2T + (size_t)e * DM * DM; t.Nin = DM; t.k0 = 64 * (it >> 5); t.n0 = 32 * (it & 31); t.col0 = t.n0; t.useg = 0; }
    return t;
}
__device__ __forceinline__ void cvt_issue(const CvtItem& t, int lane, unsigned ldsbuf) {
#pragma unroll
    for (int i = 0; i < 8; ++i) { const int kl = 8 * i + (lane >> 3), qs = ((lane & 7) - 2 * (kl >> 4)) & 7;
        dma16(t.W + (size_t)(t.k0 + kl) * t.Nin + t.col0 + 4 * qs, (unsigned)__builtin_amdgcn_readfirstlane(ldsbuf + i * 1024)); }
}
__device__ __forceinline__ void cvt_finish(const CvtItem& t, int lane, const LAS float* buf, const LAS float* gl) {
    const int c = lane & 3;
    f32x4 g[4];
#pragma unroll
    for (int m = 0; m < 4; ++m) g[m] = t.useg ? *(const LAS f32x4*)(gl + t.k0 + 16 * c + 4 * m) * 32.f : (f32x4){32.f, 32.f, 32.f, 32.f};
#pragma unroll
    for (int j = 0; j < 2; ++j) { const int n = (lane >> 2) + 16 * j; const LAS float* sp = buf + (16 * c) * 32 + ((n + 8 * c) & 31);
        v4u o;
        o.x = pk4_fp8(sp[0 * 32] * g[0][0], sp[1 * 32] * g[0][1], sp[2 * 32] * g[0][2], sp[3 * 32] * g[0][3]);   o.y = pk4_fp8(sp[4 * 32] * g[1][0], sp[5 * 32] * g[1][1], sp[6 * 32] * g[1][2], sp[7 * 32] * g[1][3]);
        o.z = pk4_fp8(sp[8 * 32] * g[2][0], sp[9 * 32] * g[2][1], sp[10 * 32] * g[2][2], sp[11 * 32] * g[2][3]); o.w = pk4_fp8(sp[12 * 32] * g[3][0], sp[13 * 32] * g[3][1], sp[14 * 32] * g[3][2], sp[15 * 32] * g[3][3]);
        *(v4u*)(t.WT + (size_t)(t.n0 + n) * DM + t.k0 + 16 * c) = o; }
}
__device__ __forceinline__ void convert_experts_dma(const float* w1, const float* w2, bf16_t* W1T, bf16_t* W2T, int first, int stride, int N_END, int lane_, unsigned lds0, const LAS float* buf0, const LAS float* gl) {
    int lane = lane_; asm volatile("" : "+v"(lane));
    int it = first;
    if (it < N_END) { const CvtItem t = cvt_item(w1, w2, W1T, W2T, it); cvt_issue(t, lane, lds0); }
#pragma unroll 1
    for (; it < N_END; it += 2 * stride) {
        const int nx = it + stride, nn = it + 2 * stride;
        if (nx < N_END) { const CvtItem t = cvt_item(w1, w2, W1T, W2T, nx); cvt_issue(t, lane, lds0 + 8192); asm volatile("s_waitcnt vmcnt(8)" ::: "memory"); } else asm volatile("s_waitcnt vmcnt(0)" ::: "memory");
        { const CvtItem t = cvt_item(w1, w2, W1T, W2T, it); cvt_finish(t, lane, buf0, gl); }
        if (nx < N_END) {
            asm volatile("s_waitcnt lgkmcnt(0)" ::: "memory");
            if (nn < N_END) { const CvtItem t = cvt_item(w1, w2, W1T, W2T, nn); cvt_issue(t, lane, lds0); asm volatile("s_waitcnt vmcnt(8)" ::: "memory"); } else asm volatile("s_waitcnt vmcnt(0)" ::: "memory");
            { const CvtItem t = cvt_item(w1, w2, W1T, W2T, nx); cvt_finish(t, lane, buf0 + 2048, gl); }
            asm volatile("s_waitcnt lgkmcnt(0)" ::: "memory");
        }
    }
    asm volatile("s_waitcnt vmcnt(0)" ::: "memory");
}

__device__ __forceinline__ float log_sigmoid(float v) { return fminf(v, 0.f) - log1pf(expf(-fabsf(v))); }
__device__ __forceinline__ void rms1_row(const float* __restrict__ x, const LAS float* wf  , const float* __restrict__ b_f,
                                         bf16_t* __restrict__ XN, float* __restrict__ FLOG, int row, int lane) {
    const float4* xr = (const float4*)(x + (size_t)row * DM);
    float4 v[4]; float ss = 0.f;
#pragma unroll
    for (int j = 0; j < 4; ++j) { v[j] = xr[lane + 64 * j]; ss += v[j].x * v[j].x + v[j].y * v[j].y + v[j].z * v[j].z + v[j].w * v[j].w; }
    ss = wave_sum(ss);
    const float rstd = rsqrtf(ss * (1.f / DM) + EPS);
    float f0 = 0.f, f1 = 0.f, f2 = 0.f, f3 = 0.f, f4 = 0.f, f5 = 0.f, f6 = 0.f, f7 = 0.f;
#pragma unroll
    for (int j = 0; j < 4; ++j) {
        const int c0 = 4 * (lane + 64 * j);
        uint2 o; o.x = pk2(v[j].x * rstd, v[j].y * rstd); o.y = pk2(v[j].z * rstd, v[j].w * rstd);
        *(uint2*)(XN + (size_t)row * DM + c0) = o;
        const float xs[4] = {v[j].x, v[j].y, v[j].z, v[j].w};
#pragma unroll
        for (int c = 0; c < 4; ++c) {
            const int k = c0 + c; const float xv = xs[c];
            const LAS f32x4* wp = (const LAS f32x4*)(wf + k * 8); const f32x4 w0 = wp[0], w1 = wp[1];
            f0 += xv * w0.x; f1 += xv * w0.y; f2 += xv * w0.z; f3 += xv * w0.w; f4 += xv * w1.x; f5 += xv * w1.y; f6 += xv * w1.z; f7 += xv * w1.w;
        }
    }
    f0 = wave_sum(f0); f1 = wave_sum(f1); f2 = wave_sum(f2); f3 = wave_sum(f3); f4 = wave_sum(f4); f5 = wave_sum(f5); f6 = wave_sum(f6); f7 = wave_sum(f7);
    if (lane < 8) {
        float f = f0; f = lane == 1 ? f1 : f; f = lane == 2 ? f2 : f; f = lane == 3 ? f3 : f; f = lane == 4 ? f4 : f; f = lane == 5 ? f5 : f; f = lane == 6 ? f6 : f; f = lane == 7 ? f7 : f;
        FLOG[(size_t)row * 8 + lane] = log_sigmoid(f * rstd + b_f[lane]);
    }
}
__device__ __forceinline__ void cumsum_wg(const float* __restrict__ FLOG, float* __restrict__ CUM, int bh, LAS float* part) {
    const int b = bh >> 3, h = bh & 7, t = threadIdx.x;
    float loc[8]; float s = 0.f;
#pragma unroll
    for (int i = 0; i < 8; ++i) { loc[i] = FLOG[((size_t)b * SEQ + t * 8 + i) * 8 + h]; s += loc[i]; }
    part[t] = s; __syncthreads();
    float run = 0.f; for (int i = 0; i < t; ++i) run += part[i];
#pragma unroll
    for (int i = 0; i < 8; ++i) { run += loc[i]; CUM[(size_t)bh * SEQ + t * 8 + i] = run * LOG2E; }
    __syncthreads();
}

template <int NT> __device__ __forceinline__ void wave_mma(f32x4 (&acc)[NT], const bf16_t* ap, const bf16_t* const (&bp)[NT], int K) {
    for (int k0 = 0; k0 < K; k0 += 32) {
        const bf16x8 a = *(const bf16x8*)(ap + k0);
#pragma unroll
        for (int t = 0; t < NT; ++t) { const bf16x8 b = *(const bf16x8*)(bp[t] + k0); acc[t] = __builtin_amdgcn_mfma_f32_16x16x32_bf16(a, b, acc[t], 0, 0, 0); }
    }
}
__device__ __forceinline__ void nv_inproj(const bf16_t* __restrict__ XN, const bf16_t* __restrict__ WINT, bf16_t* __restrict__ PROJ, int item, int lane) {
    const int n0 = (item % 48) * 64, m0 = (item / 48) * 16, r = lane & 15, q = lane >> 4;
    f32x4 acc[4];
#pragma unroll
    for (int t = 0; t < 4; ++t) acc[t] = (f32x4){0.f, 0.f, 0.f, 0.f};
    const bf16_t* ap = XN + (size_t)(m0 + r) * DM + 8 * q;
    const bf16_t* bp[4];
#pragma unroll
    for (int t = 0; t < 4; ++t) bp[t] = WINT + (size_t)(n0 + 16 * t + r) * DM + 8 * q;
    wave_mma<4>(acc, ap, bp, DM);
    const float sc = (n0 < 512 || (n0 >= 1536 && n0 < 2048)) ? C2 : 1.f;
#pragma unroll
    for (int t = 0; t < 4; ++t)
#pragma unroll
        for (int j = 0; j < 4; ++j) PROJ[(size_t)(m0 + 4 * q + j) * NPROJ + n0 + 16 * t + r] = f2bf(acc[t][j] * sc);
}

template <int TYPE> __device__ __forceinline__ void nv_attn(const bf16_t* __restrict__ PROJ, const float* __restrict__ CUM, bf16_t* __restrict__ OMIX, float* __restrict__ SSQ,
                                                          int bh, int qblk, int lane, LAS unsigned char* wl) {
    LAS bf16_t* Ks = (LAS bf16_t*)wl; LAS bf16_t* Vs = (LAS bf16_t*)(wl + 8192); LAS float* Cs = (LAS float*)(wl + 16384);
    const int b = bh >> 3, h = bh & 7, t = qblk * 64 + lane;
    const size_t row = (size_t)b * SEQ + t;
    const int qcol = (TYPE == 0 ? 0 : 1536) + h * HD, kcol = qcol + 512, vcol = qcol + 1024;
    float q[64], o[64];
#pragma unroll
    for (int c = 0; c < 8; ++c) { const bf16x8 v = *(const bf16x8*)(PROJ + row * NPROJ + qcol + 8 * c);
#pragma unroll
        for (int j = 0; j < 8; ++j) q[8 * c + j] = bf2f((unsigned short)v[j]); }
#pragma unroll
    for (int d = 0; d < 64; ++d) o[d] = 0.f;
    float m = -INFINITY, l = 0.f, R = 1.f;
    const float cq = CUM[(size_t)bh * SEQ + t];
    for (int it = 0; it <= qblk; ++it) {
        const int kt = (TYPE == 0) ? it : qblk - it;
        LDS_WAIT();
        for (int i = 0; i < 64; ++i) { const size_t kr = ((size_t)b * SEQ + kt * 64 + i) * NPROJ; Ks[i * 64 + lane] = PROJ[kr + kcol + lane]; Vs[i * 64 + lane] = PROJ[kr + vcol + lane]; }
        Cs[lane] = CUM[(size_t)bh * SEQ + kt * 64 + lane];
        LDS_WAIT();
        for (int ss = 0; ss < 64; ++ss) {
            const int s = (TYPE == 0) ? ss : 63 - ss; const int ks = kt * 64 + s;
            float dot = 0.f;
#pragma unroll
            for (int d = 0; d < 64; d += 8) { const bf16x8 kv = *(const LAS bf16x8*)&Ks[s * 64 + d];
#pragma unroll
                for (int j = 0; j < 8; ++j) dot += q[d + j] * bf2f((unsigned short)kv[j]); }
            if (TYPE == 0) {
                if (ks <= t) {
                    const float xv = dot + cq - Cs[s]; const float mn = fmaxf(m, xv); const float sc = exp2f(m - mn), p = exp2f(xv - mn);
                    l = l * sc + p; m = mn;
#pragma unroll
                    for (int d = 0; d < 64; d += 8) { const bf16x8 vv = *(const LAS bf16x8*)&Vs[s * 64 + d];
#pragma unroll
                        for (int j = 0; j < 8; ++j) o[d + j] = o[d + j] * sc + p * bf2f((unsigned short)vv[j]); }
                }
            } else {
                if (ks < t) {
                    const float z = fminf(fmaxf(dot, -80.f), 80.f); const float e = exp2f(z); const float rr = 1.f / (1.f + e); const float a = e * rr * R; R *= rr;
#pragma unroll
                    for (int d = 0; d < 64; d += 8) { const bf16x8 vv = *(const LAS bf16x8*)&Vs[s * 64 + d];
#pragma unroll
                        for (int j = 0; j < 8; ++j) o[d + j] += a * bf2f((unsigned short)vv[j]); }
                }
            }
        }
    }
    const float inv = (TYPE == 0) ? 1.f / l : 1.f;
    float ssq = 0.f;
#pragma unroll
    for (int d = 0; d < 64; ++d) { o[d] *= inv; ssq += o[d] * o[d]; }
    SSQ[row * 16 + TYPE * 8 + h] = ssq;
#pragma unroll
    for (int c = 0; c < 8; ++c) { bf16x8 v;
#pragma unroll
        for (int j = 0; j < 8; ++j) v[j] = (short)f2bf(o[8 * c + j]);
        *(bf16x8*)(OMIX + row * DM + TYPE * GW + h * HD + 8 * c) = v; }
}

__device__ __forceinline__ void nv_wout(const bf16_t* __restrict__ OMIX, const bf16_t* __restrict__ WOUTT, const float* __restrict__ SSQ, const float* __restrict__ x,
                                        float* __restrict__ X1, bf16_t* __restrict__ X1B, int item, int lane) {
    const int n0 = (item & 15) * 64, m0 = (item >> 4) * 16, r = lane & 15, q = lane >> 4;
    f32x4 af[4], as[4];
#pragma unroll
    for (int t = 0; t < 4; ++t) { af[t] = (f32x4){0.f, 0.f, 0.f, 0.f}; as[t] = (f32x4){0.f, 0.f, 0.f, 0.f}; }
    const bf16_t* ap = OMIX + (size_t)(m0 + r) * DM + 8 * q;
    const bf16_t* bp[4]; const bf16_t* bp2[4];
#pragma unroll
    for (int t = 0; t < 4; ++t) { bp[t] = WOUTT + (size_t)(n0 + 16 * t + r) * DM + 8 * q; bp2[t] = bp[t] + GW; }
    wave_mma<4>(af, ap, bp, GW);
    wave_mma<4>(as, ap + GW, bp2, GW);
#pragma unroll
    for (int j = 0; j < 4; ++j) {
        const size_t row = m0 + 4 * q + j; const float* sp = SSQ + row * 16;
        float sf = 0.f, s2 = 0.f;
#pragma unroll
        for (int h = 0; h < 8; ++h) { sf += sp[h]; s2 += sp[8 + h]; }
        const float rf = rsqrtf(sf * (1.f / GW) + EPS), rs = rsqrtf(s2 * (1.f / GW) + EPS);
#pragma unroll
        for (int t = 0; t < 4; ++t) { const size_t idx = row * DM + n0 + 16 * t + r; const float v = x[idx] + rf * af[t][j] + rs * as[t][j]; X1[idx] = v; X1B[idx] = f2bf(v); }
    }
}

__device__ __forceinline__ void nv_router(const float* __restrict__ X1, const float* __restrict__ WR, const float* __restrict__ b_router, float* __restrict__ RSTD2,
                                          float* __restrict__ RW, int* __restrict__ LIST, int* __restrict__ SLOTEP, unsigned* __restrict__ CNT, int item, int lane) {
    const int e = lane & 31, tok = item * 2 + (lane >> 5);
    const float* xr = X1 + (size_t)tok * DM;
    float acc = 0.f, ss = 0.f;
    for (int k = 0; k < DM; ++k) { const float xv = xr[k]; acc += xv * WR[k * NE + e]; ss += xv * xv; }
    const float rstd = rsqrtf(ss * (1.f / DM) + EPS);
    float logit = acc * rstd + b_router[e];
    if (e == 0) RSTD2[tok] = rstd;
    float tv[4]; int ti[4];
#pragma unroll
    for (int k = 0; k < 4; ++k) {
        float bv = logit; int bi = e;
#pragma unroll
        for (int o = 1; o < 32; o <<= 1) { const float ov = __shfl_xor(bv, o); const int oi = __shfl_xor(bi, o); if (ov > bv || (ov == bv && oi < bi)) { bv = ov; bi = oi; } }
        tv[k] = bv; ti[k] = bi; if (e == bi) logit = -INFINITY;
    }
    const float e0 = 1.f, e1 = expf(tv[1] - tv[0]), e2 = expf(tv[2] - tv[0]), e3 = expf(tv[3] - tv[0]); const float inv = 1.f / (e0 + e1 + e2 + e3);
    const float w0 = e0 * inv, w1 = e1 * inv, w2 = e2 * inv, w3 = e3 * inv;
    int myk = -1; float myw = 0.f;
    if (e == ti[0]) { myk = 0; myw = w0; } if (e == ti[1]) { myk = 1; myw = w1; } if (e == ti[2]) { myk = 2; myw = w2; } if (e == ti[3]) { myk = 3; myw = w3; }
    if (myk >= 0) { const int slot = tok * 4 + myk; const unsigned pos = atomicAdd(&CNT[e], 1u); LIST[(size_t)e * LIST_CAP + pos] = slot; RW[slot] = myw; SLOTEP[slot] = e * 16384 + (int)pos; }
}


typedef float f32x16 __attribute__((ext_vector_type(16)));
__device__ __forceinline__ void router_wg(const float* __restrict__ X1, const float* __restrict__ WR, const float* __restrict__ b_router, float* __restrict__ RSTD2,
                                          float* __restrict__ RW, int* __restrict__ LIST, int* __restrict__ SLOTEP, unsigned* __restrict__ CNT, int tokbase, LAS unsigned char* L) {
    int tid_ = threadIdx.x; asm volatile("" : "+v"(tid_));
    const int tid = tid_, lane = tid & 63, wave = __builtin_amdgcn_readfirstlane(tid >> 6), kq = wave & 3, tile = wave >> 2, r32 = lane & 31, hi = lane >> 5;
    LAS float* Dx = (LAS float*)L; LAS float* SSx = (LAS float*)(L + 32768); LAS unsigned* lcnt = (LAS unsigned*)(L + 33792); LAS unsigned* lbase = (LAS unsigned*)(L + 33920);
    if (tid < NE) lcnt[tid] = 0u;
    const int tok = tokbase + tile * 32 + r32;
    const float* xp = X1 + (size_t)tok * DM + kq * 256 + 4 * hi;
    const float* wp = WR + (size_t)(kq * 256 + 4 * hi) * NE + r32;
    f32x16 acc;
#pragma unroll
    for (int r = 0; r < 16; ++r) acc[r] = 0.f;
    float ss = 0.f;
#pragma unroll 1
    for (int mc = 0; mc < 4; ++mc) {
        float4 xv[8];
#pragma unroll
        for (int m = 0; m < 8; ++m) xv[m] = *(const float4*)(xp + (mc * 8 + m) * 8);
#pragma unroll
        for (int m = 0; m < 8; ++m) {
            const float* w4 = wp + (size_t)((mc * 8 + m) * 8) * NE;
            const float w0 = w4[0], w1 = w4[NE], w2 = w4[2 * NE], w3 = w4[3 * NE];
            acc = __builtin_amdgcn_mfma_f32_32x32x2f32(w0, xv[m].x, acc, 0, 0, 0);
            acc = __builtin_amdgcn_mfma_f32_32x32x2f32(w1, xv[m].y, acc, 0, 0, 0);
            acc = __builtin_amdgcn_mfma_f32_32x32x2f32(w2, xv[m].z, acc, 0, 0, 0);
            acc = __builtin_amdgcn_mfma_f32_32x32x2f32(w3, xv[m].w, acc, 0, 0, 0);
            ss += xv[m].x * xv[m].x + xv[m].y * xv[m].y + xv[m].z * xv[m].z + xv[m].w * xv[m].w;
        }
    }
    { auto rr = __builtin_amdgcn_permlane32_swap(__float_as_uint(ss), __float_as_uint(ss), false, false); ss = __uint_as_float(rr[0]) + __uint_as_float(rr[1]); }
#pragma unroll
    for (int r = 0; r < 16; ++r) Dx[(wave * 16 + r) * 64 + lane] = acc[r];
    if (hi == 0) SSx[wave * 32 + r32] = ss;
    LDS_WAIT(); __syncthreads();
    int ea = 0, eb = 0; float wa = 0.f, wb = 0.f; unsigned la = 0u, lb = 0u;
    if (kq == 0) {
        float v[16]; float sst = 0.f;
#pragma unroll
        for (int w = 0; w < 4; ++w) sst += SSx[(tile * 4 + w) * 32 + r32];
        const float rstd = rsqrtf(sst * (1.f / DM) + EPS);
#pragma unroll
        for (int r = 0; r < 16; ++r) { float a = 0.f;
#pragma unroll
            for (int w = 0; w < 4; ++w) a += Dx[((tile * 4 + w) * 16 + r) * 64 + lane];
            v[r] = a * rstd + b_router[(r & 3) + 8 * (r >> 2) + 4 * hi]; }
        if (hi == 0) RSTD2[tok] = rstd;
        float tv[4]; int te[4];
#pragma unroll
        for (int k = 0; k < 4; ++k) {
            float bv = v[0]; int br = 0;
#pragma unroll
            for (int r = 1; r < 16; ++r) if (v[r] > bv) { bv = v[r]; br = r; }
            const int be = (br & 3) + 8 * (br >> 2) + 4 * hi;
            auto r1 = __builtin_amdgcn_permlane32_swap(__float_as_uint(bv), __float_as_uint(bv), false, false);
            auto r2 = __builtin_amdgcn_permlane32_swap((unsigned)be, (unsigned)be, false, false);
            const float pv = __uint_as_float(hi ? r1[0] : r1[1]); const int pe = (int)(hi ? r2[0] : r2[1]);
            const bool mine = (bv > pv) || (bv == pv && be < pe);
            tv[k] = mine ? bv : pv; te[k] = mine ? be : pe;
#pragma unroll
            for (int r = 0; r < 16; ++r) v[r] = (mine && r == br) ? -INFINITY : v[r];
        }
        const float e1 = expf(tv[1] - tv[0]), e2 = expf(tv[2] - tv[0]), e3 = expf(tv[3] - tv[0]); const float inv = 1.f / (1.f + e1 + e2 + e3);
        ea = hi ? te[2] : te[0]; eb = hi ? te[3] : te[1]; wa = (hi ? e2 : 1.f) * inv; wb = (hi ? e3 : e1) * inv;
        la = atomicAdd((unsigned*)&lcnt[ea], 1u); lb = atomicAdd((unsigned*)&lcnt[eb], 1u);
    }
    LDS_WAIT(); __syncthreads();
    if (tid < NE) { const unsigned c = lcnt[tid]; lbase[tid] = c ? atomicAdd(&CNT[tid], c) : 0u; }
    LDS_WAIT(); __syncthreads();
    if (kq == 0) {
        const int sa = tok * 4 + 2 * hi, sb = sa + 1;
        const int pa = (int)(lbase[ea] + la), pb = (int)(lbase[eb] + lb);
        LIST[(size_t)ea * LIST_CAP + pa] = sa; RW[sa] = wa; SLOTEP[sa] = ea * 16384 + pa;
        LIST[(size_t)eb * LIST_CAP + pb] = sb; RW[sb] = wb; SLOTEP[sb] = eb * 16384 + pb;
    }
    LDS_WAIT(); __syncthreads();
}

__device__ __forceinline__ bool moe_tile(const unsigned* CNT, int g, int& e, int& base, int& p0, int& cnt) {
    const int tile256 = g >> 4; base = 0;
    for (e = 0; e < NE; ++e) { const int nt = ((int)CNT[e] + 255) >> 8; if (tile256 < base + nt) break; base += nt; }
    if (e == NE) return false;
    cnt = (int)CNT[e]; p0 = (g - base * 16) * 16; return p0 < cnt;
}
__device__ __forceinline__ void nv_moe1(const bf16_t* __restrict__ X1B, const bf16_t* __restrict__ W1T, const float* __restrict__ b1, const float* __restrict__ RSTD2,
                                        const int* __restrict__ LIST, bf16_t* __restrict__ H, int e, int base, int p0, int cnt, int cg, int lane) {
    const int r = lane & 15, q = lane >> 4, c0 = cg * 32, pn = c0 >> 7, j0 = c0 & 127;
    const int* lst = LIST + (size_t)e * LIST_CAP;
    const int prow = p0 + r; const int tok = lst[prow < cnt ? prow : cnt - 1] >> 2;
    f32x4 acc[4];
#pragma unroll
    for (int t = 0; t < 4; ++t) acc[t] = (f32x4){0.f, 0.f, 0.f, 0.f};
    const bf16_t* ap = X1B + (size_t)tok * DM + 8 * q;
    const bf16_t* wb = W1T + (size_t)e * 2048 * DM + (size_t)(256 * pn + j0 + r) * DM + 8 * q;
    const bf16_t* bp[4] = {wb, wb + 16 * DM, wb + 128 * DM, wb + 144 * DM};
    wave_mma<4>(acc, ap, bp, DM);
#pragma unroll
    for (int j = 0; j < 4; ++j) {
        const int pr = p0 + 4 * q + j; if (pr >= cnt) continue;
        const float rs = RSTD2[lst[pr] >> 2];
#pragma unroll
        for (int t = 0; t < 2; ++t) {
            const int col = c0 + 16 * t + r;
            float glu = acc[t][j] * rs + b1[(size_t)e * 2048 + col], lin = acc[t + 2][j] * rs + b1[(size_t)e * 2048 + 1024 + col];
            glu = fminf(glu, 7.f); lin = fminf(fmaxf(lin, -7.f), 7.f);
            const float act = glu * (1.f / (1.f + expf(-1.702f * glu))) * (lin + 1.f);
            H[((size_t)base * 256 + pr) * DM + col] = f2bf(act);
        }
    }
}
__device__ __forceinline__ void nv_moe2(const bf16_t* __restrict__ H, const bf16_t* __restrict__ W2T, const float* __restrict__ b2, const float* __restrict__ RW,
                                        const int* __restrict__ LIST, bf16_t* __restrict__ Y, int e, int base, int p0, int cnt, int cg, int lane) {
    const int r = lane & 15, q = lane >> 4, n0 = cg * 64;
    const int* lst = LIST + (size_t)e * LIST_CAP;
    f32x4 acc[4];
#pragma unroll
    for (int t = 0; t < 4; ++t) acc[t] = (f32x4){0.f, 0.f, 0.f, 0.f};
    const bf16_t* ap = H + ((size_t)base * 256 + p0 + r) * DM + 8 * q;
    const bf16_t* bp[4];
#pragma unroll
    for (int t = 0; t < 4; ++t) bp[t] = W2T + (size_t)e * DM * DM + (size_t)(n0 + 16 * t + r) * DM + 8 * q;
    wave_mma<4>(acc, ap, bp, DM);
#pragma unroll
    for (int j = 0; j < 4; ++j) {
        const int pr = p0 + 4 * q + j; if (pr >= cnt) continue;
        const int slot = lst[pr]; const float w = RW[slot];
#pragma unroll
        for (int t = 0; t < 4; ++t) { const int col = n0 + 16 * t + r; Y[((size_t)base * 256 + pr) * DM + col] = f2bf((acc[t][j] + b2[(size_t)e * DM + col]) * w); }
    }
}

__device__ __forceinline__ void final_row(const float* X1, const bf16_t* __restrict__ Y, const int* __restrict__ SLOTEP, const int* __restrict__ TBG, const float* __restrict__ gf, float* out, int row, int lane) {
    int yr[4];
#pragma unroll
    for (int k = 0; k < 4; ++k) { const int ep = SLOTEP[row * 4 + k]; yr[k] = TBG[ep >> 14] * 256 + (ep & 16383); }
    float ss = 0.f;
    if (Y_F8) {
        const int c0 = 16 * lane; f32x4 v[4];
#pragma unroll
        for (int j = 0; j < 4; ++j) v[j] = *(const f32x4*)(X1 + (size_t)row * DM + c0 + 4 * j);
#pragma unroll
        for (int k = 0; k < 4; ++k) { const v4u y = *(const v4u*)((const unsigned char*)Y + (size_t)yr[k] * DM + c0);
#pragma unroll
            for (int j = 0; j < 4; ++j) { const auto lo = __builtin_amdgcn_cvt_pk_f32_fp8((int)y[j], false), hi = __builtin_amdgcn_cvt_pk_f32_fp8((int)y[j], true);
                v[j][0] += lo[0] * 0.0625f; v[j][1] += lo[1] * 0.0625f; v[j][2] += hi[0] * 0.0625f; v[j][3] += hi[1] * 0.0625f; } }
#pragma unroll
        for (int j = 0; j < 4; ++j) ss += v[j][0] * v[j][0] + v[j][1] * v[j][1] + v[j][2] * v[j][2] + v[j][3] * v[j][3];
        ss = wave_sum(ss);
        const float rstd = rsqrtf(ss * (1.f / DM) + EPS);
#pragma unroll
        for (int j = 0; j < 4; ++j) { const f32x4 g = *(const f32x4*)(gf + c0 + 4 * j); *(f32x4*)(out + (size_t)row * DM + c0 + 4 * j) = v[j] * rstd * g; }
        return;
    }
    float4 v[4];
#pragma unroll
    for (int j = 0; j < 4; ++j) {
        const int c0 = 4 * (lane + 64 * j);
        v[j] = *(const float4*)(X1 + (size_t)row * DM + c0);
#pragma unroll
        for (int k = 0; k < 4; ++k) { const uint2 y = *(const uint2*)(Y + (size_t)yr[k] * DM + c0);
            v[j].x += bf2f((unsigned short)(y.x & 0xffff)); v[j].y += bf2f((unsigned short)(y.x >> 16)); v[j].z += bf2f((unsigned short)(y.y & 0xffff)); v[j].w += bf2f((unsigned short)(y.y >> 16)); }
        ss += v[j].x * v[j].x + v[j].y * v[j].y + v[j].z * v[j].z + v[j].w * v[j].w;
    }
    ss = wave_sum(ss);
    const float rstd = rsqrtf(ss * (1.f / DM) + EPS);
#pragma unroll
    for (int j = 0; j < 4; ++j) { const int c0 = 4 * (lane + 64 * j); const float4 g = *(const float4*)(gf + c0);
        float4 o; o.x = v[j].x * rstd * g.x; o.y = v[j].y * rstd * g.y; o.z = v[j].z * rstd * g.z; o.w = v[j].w * rstd * g.w; *(float4*)(out + (size_t)row * DM + c0) = o; }
}


namespace pg8 {
#define PG8_LAS __attribute__((address_space(3)))
typedef unsigned u32x4 __attribute__((ext_vector_type(4)));
typedef unsigned u32x2 __attribute__((ext_vector_type(2)));
typedef int i32x8 __attribute__((ext_vector_type(8)));
constexpr int BM = 256, BK = 64, HALF = 128, HTB = HALF * BK * 2  , STAGE_BYTES = 8 * HTB, NXCD = 8, WGM = 8;
__host__ __device__ __forceinline__ int lds_byte(int r, int c) { const int st = (r >> 4) * 2 + (c >> 5), rr = r & 15, cc = c & 31, ob = rr * 64 + cc * 2; return st * 1024 + (ob ^ (((ob >> 9) & 1) << 5)); }
__host__ __device__ __forceinline__ void stage_rc(int b, int& R, int& C) { const int st = b / 1024, sb = b % 1024, swz = sb ^ (((sb >> 9) & 1) << 5); R = (st >> 1) * 16 + swz / 64; C = (st & 1) * 32 + (swz % 64) / 2; }
__host__ __device__ __forceinline__ int perm32(int rho) { const int n = rho >> 4, i = rho & 15; return 8 * (i >> 2) + 4 * n + (i & 3); }
struct Unit { int pm, pn, nr; };
struct Gemm { const bf16_t* A; const bf16_t* Bt; int K; };
__device__ __forceinline__ void st16_wt(void* p, u32x4 v) { if (WT_STORES) asm volatile("global_store_dwordx4 %0, %1, off sc0 sc1\n\ts_nop 1" :: "v"(p), "v"(v) : "memory"); else *(u32x4*)p = v; }
__device__ __forceinline__ void st8_wt(void* p, u32x2 v) { if (WT_STORES) asm volatile("global_store_dwordx2 %0, %1, off sc0 sc1\n\ts_nop 1" :: "v"(p), "v"(v) : "memory"); else *(u32x2*)p = v; }
struct StaticOrder {
    int nM, nN, nwg, G, c;
    __device__ void init(int M_, int N_, int G_, int c_) { nM = M_ / BM; nN = N_ / BM; nwg = nM * nN; G = G_; c = c_; }
    __device__ bool next(int i, Unit& u) const {
        const long L = (long)i * G + c; if (L >= nwg) return false;
        int wgid = (int)L; { const int q = nwg / NXCD, r = nwg % NXCD, xcd = wgid % NXCD, off = wgid / NXCD; wgid = (xcd < r ? xcd * (q + 1) : r * (q + 1) + (xcd - r) * q) + off; }
        const int nig = WGM * nN, gid = wgid / nig, fm = gid * WGM, gsz = (nM - fm) < WGM ? (nM - fm) : WGM;
        u.pm = fm + ((wgid % nig) % gsz); u.pn = (wgid % nig) / gsz; u.nr = BM; return true;
    }
    __device__ __forceinline__ const PG8_LAS int* rowtab(int) const { return nullptr; }
};
__device__ __forceinline__ unsigned cvt_pk_bf16(float lo, float hi) { unsigned r; asm volatile("v_cvt_pk_bf16_f32 %0, %1, %2" : "=v"(r) : "v"(lo), "v"(hi)); return r; }

template <class Sched> __device__ __forceinline__ void gather_voffs(const Sched& S, int ui, int tid, int K, unsigned (&o0)[2], unsigned (&o1)[2]) {
    const PG8_LAS int* tab = S.rowtab(ui);
#pragma unroll
    for (int i = 0; i < 2; ++i) { int R, C; stage_rc(tid * 16 + i * 8192, R, C); o0[i] = (unsigned)((tab[R] & 0xffff) * K + C) * 2u; o1[i] = (unsigned)((tab[HALF + R] & 0xffff) * K + C) * 2u; }
}

template <class Epi, class Sched, bool ALIGN_EPI, bool GATHER, bool F8 = false>
__device__ __forceinline__ void gemm_phase(PG8_LAS unsigned char* lds, const Gemm g, const Sched& S, const Epi& E) {
    int tid_ = threadIdx.x; asm volatile("" : "+v"(tid_));
    const int tid = tid_, wid = __builtin_amdgcn_readfirstlane(tid >> 6), lane = tid & 63, wr = wid >> 2, wc = wid & 3, fr = lane & 15, fq = lane >> 4;
    const int K = g.K, nt = K / BK;
    unsigned vA0[2], vA1[2], wA0[2], wA1[2], voffB[2];
    const size_t kstep = (size_t)(BK * 2);
    const size_t hstep = (size_t)HALF * K * 2;
    const size_t tstep = 2 * hstep;
#pragma unroll
    for (int i = 0; i < 2; ++i) { int R, C; stage_rc(tid * 16 + i * 8192, R, C); const int Rb = Epi::PERM ? ((R & ~31) + perm32(R & 31)) : R;
        vA0[i] = (unsigned)(R * K + C) * 2u; vA1[i] = vA0[i] + (unsigned)hstep; voffB[i] = (unsigned)(Rb * K + C) * 2u; wA0[i] = vA0[i]; wA1[i] = vA1[i]; }
    const unsigned ldsw = (unsigned)wid * 1024u;
    const int aoff = lds_byte(wr * 64 + fr, fq * 8), boff = lds_byte(wc * 32 + fr, fq * 8);
    const int a8o0 = lds_byte(wr * 64 + fr, fq * 16), a8o1 = lds_byte(wr * 64 + fr, fq * 16 + 8), b8o0 = lds_byte(wc * 32 + fr, fq * 16), b8o1 = lds_byte(wc * 32 + fr, fq * 16 + 8);
#define PG8_SA(b, h) (((b) * 2 + (h)) * HTB)
#define PG8_SB(b, h) ((4 + (b) * 2 + (h)) * HTB)
#define PG8_STAGE(bufoff, gbase, voff) do { _Pragma("unroll") for (int _i = 0; _i < 2; ++_i) \
        __builtin_amdgcn_global_load_lds((const unsigned*)((const char*)(gbase) + (voff)[_i]), (PG8_LAS unsigned*)(lds + (bufoff) + ldsw + _i * 8192), 16, 0, 0); } while (0)
#define PG8_LDA_BF(dst, b, h) do { _Pragma("unroll") for (int m = 0; m < 4; ++m) _Pragma("unroll") for (int k = 0; k < 2; ++k) dst[m][k] = *(const PG8_LAS bf16x8*)(lds + PG8_SA(b, h) + aoff + m * 2048 + k * 1024); } while (0)
#define PG8_LDB_BF(dst, b, h) do { _Pragma("unroll") for (int n = 0; n < 2; ++n) _Pragma("unroll") for (int k = 0; k < 2; ++k) dst[n][k] = *(const PG8_LAS bf16x8*)(lds + PG8_SB(b, h) + boff + n * 2048 + k * 1024); } while (0)
#define PG8_MMA_BF(ai, bj, At, Bt) do { if (cur.nr > 128 * (ai) + 64 * wr) { __builtin_amdgcn_s_setprio(1); _Pragma("unroll") for (int m = 0; m < 4; ++m) _Pragma("unroll") for (int n = 0; n < 2; ++n) _Pragma("unroll") for (int k = 0; k < 2; ++k) \
        acc[ai][bj][m][n] = __builtin_amdgcn_mfma_f32_16x16x32_bf16(Bt[n][k], At[m][k], acc[ai][bj][m][n], 0, 0, 0); __builtin_amdgcn_s_setprio(0); } } while (0)
#define PG8_LD8(dst, i_, base_, o0_, o1_) do { const u32x4 lo_ = *(const PG8_LAS u32x4*)(lds + (base_) + (o0_) + (i_) * 2048), hi_ = *(const PG8_LAS u32x4*)(lds + (base_) + (o1_) + (i_) * 2048); \
        dst[i_] = (i32x8){(int)lo_.x, (int)lo_.y, (int)lo_.z, (int)lo_.w, (int)hi_.x, (int)hi_.y, (int)hi_.z, (int)hi_.w}; } while (0)
#define PG8_LDA_F8(dst, b, h) do { _Pragma("unroll") for (int m = 0; m < 4; ++m) PG8_LD8(dst, m, PG8_SA(b, h), a8o0, a8o1); } while (0)
#define PG8_LDB_F8(dst, b, h) do { _Pragma("unroll") for (int n = 0; n < 2; ++n) PG8_LD8(dst, n, PG8_SB(b, h), b8o0, b8o1); } while (0)
#define PG8_MMA_F8(ai, bj, At, Bt) do { if (cur.nr > 128 * (ai) + 64 * wr) { __builtin_amdgcn_s_setprio(1); _Pragma("unroll") for (int m = 0; m < 4; ++m) _Pragma("unroll") for (int n = 0; n < 2; ++n) \
        acc[ai][bj][m][n] = __builtin_amdgcn_mfma_scale_f32_16x16x128_f8f6f4(Bt[n], At[m], acc[ai][bj][m][n], 0, 0, 0, 0x7A7A7A7A  , 0, 0x7F7F7F7F  ); __builtin_amdgcn_s_setprio(0); } } while (0)
#define PG8_LDA(dst, b, h) do { if constexpr (F8) { PG8_LDA_F8(dst##8, b, h); } else { PG8_LDA_BF(dst, b, h); } } while (0)
#define PG8_LDB(dst, b, h) do { if constexpr (F8) { PG8_LDB_F8(dst##8, b, h); } else { PG8_LDB_BF(dst, b, h); } } while (0)
#define PG8_MMA(ai, bj, At, Bt) do { if constexpr (F8) { PG8_MMA_F8(ai, bj, At##8, Bt##8); } else { PG8_MMA_BF(ai, bj, At, Bt); } } while (0)
#define PG8_WAIT_V(n) asm volatile("s_waitcnt vmcnt(" #n ")" ::: "memory")
#define PG8_WAIT_L(n) asm volatile("s_waitcnt lgkmcnt(" #n ")" ::: "memory")
#define PG8_BAR __builtin_amdgcn_s_barrier()
#define PG8_SCHED __builtin_amdgcn_sched_barrier(0)
    Unit cur, nxt; int ui = 0;
    if (!S.next(0, cur)) return;
    f32x4 acc[2][2][4][2];
#pragma unroll
    for (int a = 0; a < 2; ++a)
#pragma unroll
        for (int b = 0; b < 2; ++b)
#pragma unroll
            for (int m = 0; m < 4; ++m)
#pragma unroll
                for (int n = 0; n < 2; ++n) acc[a][b][m][n] = (f32x4){0.f, 0.f, 0.f, 0.f};
    bf16x8 At[4][2], B0[2][2], B1[2][2]; i32x8 At8[4], B08[2], B18[2];
    const char* cA = GATHER ? (const char*)g.A : (const char*)g.A + (size_t)cur.pm * tstep; const char* cB = (const char*)g.Bt + (size_t)cur.pn * tstep;
    if constexpr (GATHER) gather_voffs(S, 0, tid, K, vA0, vA1);
    PG8_STAGE(PG8_SB(0, 0), cB, voffB); PG8_STAGE(PG8_SB(0, 1), cB + hstep, voffB); PG8_STAGE(PG8_SA(0, 0), cA, vA0); PG8_STAGE(PG8_SA(0, 1), cA, vA1);
    if (wr == 1) PG8_BAR;
    PG8_WAIT_V(2); PG8_BAR;
    PG8_STAGE(PG8_SB(1, 0), cB + kstep, voffB); PG8_STAGE(PG8_SA(1, 0), cA + kstep, vA0); PG8_STAGE(PG8_SB(1, 1), cB + hstep + kstep, voffB);
    PG8_WAIT_V(6); PG8_BAR;
    for (;;) {
        const bool has_next = S.next(ui + 1, nxt);
        const char* nA = GATHER ? cA : (has_next ? (const char*)g.A + (size_t)nxt.pm * tstep : cA); const char* nB = has_next ? (const char*)g.Bt + (size_t)nxt.pn * tstep : cB;
        if constexpr (GATHER) { if (has_next) gather_voffs(S, ui + 1, tid, K, wA0, wA1); else { wA0[0] = vA0[0]; wA0[1] = vA0[1]; wA1[0] = vA1[0]; wA1[1] = vA1[1]; } }
        for (int t = 0; t < nt; t += 2) {
            const bool last = (t == nt - 2);
            const char* a1 = cA + (size_t)(t + 1) * kstep;
            const char* a2 = last ? nA : cA + (size_t)(t + 2) * kstep; const char* b2 = last ? nB : cB + (size_t)(t + 2) * kstep;
            const char* a3 = a2 + kstep; const char* b3 = b2 + kstep;
            unsigned sA0[2], sA1[2];
#pragma unroll
            for (int i = 0; i < 2; ++i) { sA0[i] = (GATHER && last) ? wA0[i] : vA0[i]; sA1[i] = (GATHER && last) ? wA1[i] : vA1[i]; }
            if constexpr (Epi::MIDK) { if (t == nt / 2) E.midk(acc, wr, fr); }
            PG8_LDB(B0, 0, 0); PG8_LDB(B1, 0, 1); PG8_SCHED; PG8_LDA(At, 0, 0); PG8_STAGE(PG8_SA(1, 1), a1, vA1);
            PG8_WAIT_V(8); PG8_WAIT_L(0); PG8_BAR; PG8_MMA(0, 0, At, B0); PG8_MMA(0, 1, At, B1); PG8_BAR; PG8_SCHED;
            PG8_LDA(At, 0, 1); PG8_STAGE(PG8_SB(0, 0), b2, voffB); PG8_STAGE(PG8_SB(0, 1), b2 + hstep, voffB); PG8_STAGE(PG8_SA(0, 0), a2, sA0);
            PG8_WAIT_V(8); PG8_WAIT_L(0); PG8_BAR; PG8_MMA(1, 0, At, B0); PG8_MMA(1, 1, At, B1); PG8_BAR; PG8_SCHED;
            PG8_LDB(B0, 1, 0); PG8_LDB(B1, 1, 1); PG8_SCHED; PG8_LDA(At, 1, 0); PG8_STAGE(PG8_SA(0, 1), a2, sA1);
            PG8_WAIT_V(8); PG8_WAIT_L(0); PG8_BAR; PG8_MMA(0, 0, At, B0); PG8_MMA(0, 1, At, B1); PG8_BAR; PG8_SCHED;
            PG8_LDA(At, 1, 1); PG8_STAGE(PG8_SB(1, 0), b3, voffB); PG8_STAGE(PG8_SB(1, 1), b3 + hstep, voffB); PG8_STAGE(PG8_SA(1, 0), a3, sA0);
            PG8_WAIT_V(8); PG8_WAIT_L(0); PG8_BAR; PG8_MMA(1, 0, At, B0); PG8_MMA(1, 1, At, B1); PG8_BAR; PG8_SCHED;
        }
        if constexpr (ALIGN_EPI) { if (wr == 0) PG8_BAR; }
        E(acc, cur, ui, wr, wc, fr, fq);
        if (!has_next) break;
#pragma unroll
        for (int a = 0; a < 2; ++a)
#pragma unroll
            for (int b = 0; b < 2; ++b)
#pragma unroll
                for (int m = 0; m < 4; ++m)
#pragma unroll
                    for (int n = 0; n < 2; ++n) acc[a][b][m][n] = (f32x4){0.f, 0.f, 0.f, 0.f};
        cur = nxt; cA = nA; cB = nB; ++ui;
        if constexpr (GATHER) { vA0[0] = wA0[0]; vA0[1] = wA0[1]; vA1[0] = wA1[0]; vA1[1] = wA1[1]; }
        if constexpr (ALIGN_EPI) { if (wr == 1) PG8_BAR; }
    }
    PG8_WAIT_V(0);
    if constexpr (!ALIGN_EPI) { if (wr == 0) PG8_BAR; }
    PG8_BAR;
#undef PG8_SA
#undef PG8_SB
#undef PG8_STAGE
#undef PG8_LDA
#undef PG8_LDB
#undef PG8_MMA
#undef PG8_LDA_BF
#undef PG8_LDB_BF
#undef PG8_MMA_BF
#undef PG8_LD8
#undef PG8_LDA_F8
#undef PG8_LDB_F8
#undef PG8_MMA_F8
#undef PG8_WAIT_V
#undef PG8_WAIT_L
#undef PG8_BAR
#undef PG8_SCHED
}

struct EpiProj {
    static constexpr bool PERM = true, MIDK = false;
    bf16_t* O; unsigned* hp;
    __device__ __forceinline__ void operator()(const f32x4 (&acc)[2][2][4][2], const Unit& u, int, int wr, int wc, int fr, int fq) const {
        const int row0 = u.pm * BM + wr * 64 + fr, col0 = u.pn * BM + wc * 32 + 8 * fq;
        const float sc = (u.pn < 2 || (u.pn >= 6 && u.pn < 8)) ? C2 : 1.f;
        if (u.pn < 4) {
            float mx = 0.f;
#pragma unroll
            for (int ai = 0; ai < 2; ++ai)
#pragma unroll
                for (int m = 0; m < 4; ++m)
#pragma unroll
                    for (int bj = 0; bj < 2; ++bj) { const f32x4 a0 = acc[ai][bj][m][0] * sc, a1 = acc[ai][bj][m][1] * sc;
                        float q = a0[0] * a0[0] + a0[1] * a0[1] + a0[2] * a0[2] + a0[3] * a0[3] + a1[0] * a1[0] + a1[1] * a1[1] + a1[2] * a1[2] + a1[3] * a1[3];
                        q += __shfl_xor(q, 16); q += __shfl_xor(q, 32); mx = fmaxf(mx, q); }
#pragma unroll
            for (int o = 1; o < 16; o <<= 1) mx = fmaxf(mx, __shfl_xor(mx, o));
            if ((threadIdx.x & 63) == 0) atomicMax(hp + (u.pn < 2 ? 0 : 64), __float_as_uint(mx));
        }
#pragma unroll
        for (int ai = 0; ai < 2; ++ai)
#pragma unroll
            for (int m = 0; m < 4; ++m) { bf16_t* rowp = O + (size_t)(row0 + ai * HALF + m * 16) * NPROJ + col0;
#pragma unroll
                for (int bj = 0; bj < 2; ++bj) { const f32x4 v0 = acc[ai][bj][m][0] * sc, v1 = acc[ai][bj][m][1] * sc;
                    u32x4 w; w.x = cvt_pk_bf16(v0[0], v0[1]); w.y = cvt_pk_bf16(v0[2], v0[3]); w.z = cvt_pk_bf16(v1[0], v1[1]); w.w = cvt_pk_bf16(v1[2], v1[3]);
                    st16_wt(rowp + bj * HALF, w); } }
    }
};
struct EpiWout {
    static constexpr bool PERM = false, MIDK = true;
    const float* x; float* X1; bf16_t* X1B; const PG8_LAS float* ratio; const PG8_LAS float* rs;
    __device__ __forceinline__ void midk(f32x4 (&acc)[2][2][4][2], int wr, int fr) const {
#pragma unroll
        for (int ai = 0; ai < 2; ++ai)
#pragma unroll
            for (int m = 0; m < 4; ++m) { const float f = ratio[ai * HALF + wr * 64 + m * 16 + fr];
#pragma unroll
                for (int bj = 0; bj < 2; ++bj)
#pragma unroll
                    for (int n = 0; n < 2; ++n) acc[ai][bj][m][n] *= f; }
    }
    __device__ __forceinline__ void operator()(const f32x4 (&acc)[2][2][4][2], const Unit& u, int, int wr, int wc, int fr, int fq) const {
        const int col0 = u.pn * BM + wc * 32 + 4 * fq;
#pragma unroll
        for (int ai = 0; ai < 2; ++ai)
#pragma unroll
            for (int m = 0; m < 4; ++m) { const int r = ai * HALF + wr * 64 + m * 16 + fr; const float s = rs[r]; const size_t off = (size_t)(u.pm * BM + r) * DM + col0;
#pragma unroll
                for (int bj = 0; bj < 2; ++bj)
#pragma unroll
                    for (int n = 0; n < 2; ++n) { const f32x4 xv = *(const f32x4*)(x + off + bj * HALF + n * 16); const f32x4 o = xv + acc[ai][bj][m][n] * s;
                        *(f32x4*)(X1 + off + bj * HALF + n * 16) = o;
                        if (MOE_F8) *(unsigned*)((unsigned char*)X1B + off + bj * HALF + n * 16) = pk4_fp8(o[0], o[1], o[2], o[3]);
                        else { u32x2 w; w.x = cvt_pk_bf16(o[0], o[1]); w.y = cvt_pk_bf16(o[2], o[3]); *(u32x2*)(X1B + off + bj * HALF + n * 16) = w; } }
                asm volatile("" ::: "memory"); }
    }
};
constexpr int MOE_MAXU = 10;
struct MoeOrder {
    int NT, c; const PG8_LAS int* tb; const PG8_LAS int* tbE; const PG8_LAS int* tbC; const PG8_LAS int* cnt; const PG8_LAS int* tabA;
    int probe = 0;
    __device__ bool next(int i, Unit& u) const {
        if (i >= MOE_MAXU) return false;
        const int x = c & 7, j = c >> 3, UE = tbE[32] * NT, UC = tbC[32] * NT;
        const int qE = UE >> 3, rE = UE & 7, sE = x * qE + (x < rE ? x : rE), nE = qE + (x < rE ? 1 : 0);
        const int qC = UC >> 3, rC = UC & 7, sC = x * qC + (x < rC ? x : rC), nC = qC + (x < rC ? 1 : 0);
        const int nEj = (j < nE) ? ((nE - j + 31) >> 5) : 0;
        if (i < nEj) {
            const int f = sE + i * 32 + j; int e = 0; while (f >= tbE[e + 1] * NT) ++e;
            const int idx = f - tbE[e] * NT, nte = tbE[e + 1] - tbE[e], pg = idx / (4 * nte), rem2 = idx - pg * 4 * nte, mt = rem2 >> 2;
            u.pm = tb[e] + mt; u.pn = e * NT + pg * 4 + (rem2 & 3); const int left = cnt[e] - 256 * mt; u.nr = left < BM ? left : BM;
        } else {
            const int jj = (j - (nE & 31) + 32) & 31, lc = (i - nEj) * 32 + jj; if (lc >= nC) return false;
            const int f = sC + lc; int e = 0; while (f >= tbC[e + 1] * NT) ++e;
            const int mt = tbE[e + 1] - tbE[e]; u.pm = tb[e] + mt; u.pn = e * NT + (f - tbC[e] * NT); u.nr = cnt[e] - 256 * mt;
        }
        if (probe) { u.pm &= 31; u.pn &= 7; if (probe == 2) u.nr = 32; }
        return true;
    }
    __device__ __forceinline__ const PG8_LAS int* rowtab(int ui) const { return tabA + ui * 256; }
};
struct EpiMoe1 {
    static constexpr bool PERM = true, MIDK = false;
    bf16_t* H; const PG8_LAS int* rowtab; const PG8_LAS float* btab;
    __device__ __forceinline__ void operator()(const f32x4 (&acc)[2][2][4][2], const Unit& u, int ui, int wr, int wc, int fr, int fq) const {
        const int pl = u.pn & 7, cl = wc * 32 + 8 * fq, colA = pl * 128 + cl;
        f32x4 bg[2], bl[2];
#pragma unroll
        for (int n = 0; n < 2; ++n) { bg[n] = *(const PG8_LAS f32x4*)(btab + ui * 256 + cl + 4 * n); bl[n] = *(const PG8_LAS f32x4*)(btab + ui * 256 + 128 + cl + 4 * n); }
#pragma unroll
        for (int ai = 0; ai < 2; ++ai)
#pragma unroll
            for (int m = 0; m < 4; ++m) { const int r = ai * HALF + wr * 64 + m * 16 + fr; const float rs = __uint_as_float((unsigned)rowtab[ui * 256 + r] & 0xffff0000u);
                float a8[8];
#pragma unroll
                for (int n = 0; n < 2; ++n) { const f32x4 gv = acc[ai][0][m][n] * rs + bg[n], lv = acc[ai][1][m][n] * rs + bl[n];
#pragma unroll
                    for (int i = 0; i < 4; ++i) { const float gl = fminf(gv[i], 7.f), li = fminf(fmaxf(lv[i], -7.f), 7.f);
                        a8[4 * n + i] = gl * __builtin_amdgcn_rcpf(1.f + __builtin_amdgcn_exp2f(-1.702f * LOG2E * gl)) * (li + 1.f); } }
                if (MOE_F8) { u32x2 w;
                    int w0 = __builtin_amdgcn_cvt_pk_fp8_f32(a8[0], a8[1], 0, false); w0 = __builtin_amdgcn_cvt_pk_fp8_f32(a8[2], a8[3], w0, true);
                    int w1 = __builtin_amdgcn_cvt_pk_fp8_f32(a8[4], a8[5], 0, false); w1 = __builtin_amdgcn_cvt_pk_fp8_f32(a8[6], a8[7], w1, true);
                    w.x = (unsigned)w0; w.y = (unsigned)w1; *(u32x2*)((unsigned char*)H + (size_t)(u.pm * BM + r) * DM + colA) = w; }
                else { u32x4 w; w.x = cvt_pk_bf16(a8[0], a8[1]); w.y = cvt_pk_bf16(a8[2], a8[3]); w.z = cvt_pk_bf16(a8[4], a8[5]); w.w = cvt_pk_bf16(a8[6], a8[7]);
                *(u32x4*)(H + (size_t)(u.pm * BM + r) * DM + colA) = w; } }
    }
};
struct EpiMoe2 {
    static constexpr bool PERM = true, MIDK = false;
    bf16_t* Y; const PG8_LAS float* wtab; const PG8_LAS float* btab;
    __device__ __forceinline__ void operator()(const f32x4 (&acc)[2][2][4][2], const Unit& u, int ui, int wr, int wc, int fr, int fq) const {
        const int pl = u.pn & 3, cl = wc * 32 + 8 * fq, col0 = pl * BM + cl;
        f32x4 bv[2][2];
#pragma unroll
        for (int bj = 0; bj < 2; ++bj)
#pragma unroll
            for (int n = 0; n < 2; ++n) bv[bj][n] = *(const PG8_LAS f32x4*)(btab + ui * 256 + cl + bj * HALF + 4 * n);
#pragma unroll
        for (int ai = 0; ai < 2; ++ai)
#pragma unroll
            for (int m = 0; m < 4; ++m) { const int r = ai * HALF + wr * 64 + m * 16 + fr; const float wt = wtab[ui * 256 + r]; bf16_t* rowp = Y + (size_t)(u.pm * BM + r) * DM + col0;
#pragma unroll
                for (int bj = 0; bj < 2; ++bj) { const f32x4 v0 = (acc[ai][bj][m][0] + bv[bj][0]) * wt, v1 = (acc[ai][bj][m][1] + bv[bj][1]) * wt;
                    if (Y_F8) { u32x2 w; w.x = pk4_fp8(v0[0], v0[1], v0[2], v0[3]); w.y = pk4_fp8(v1[0], v1[1], v1[2], v1[3]); *(u32x2*)((unsigned char*)Y + (size_t)(u.pm * BM + r) * DM + col0 + bj * HALF) = w; }
                    else { u32x4 w; w.x = cvt_pk_bf16(v0[0], v0[1]); w.y = cvt_pk_bf16(v0[2], v0[3]); w.z = cvt_pk_bf16(v1[0], v1[1]); w.w = cvt_pk_bf16(v1[2], v1[3]);
                    *(u32x4*)(rowp + bj * HALF) = w; } } }
    }
};
struct ListOrder {
    const PG8_LAS int* ud; int n; const PG8_LAS int* tabA;
    __device__ __forceinline__ bool next(int i, Unit& u) const { if (i >= n) return false; u.pm = ud[3 * i]; u.pn = ud[3 * i + 1]; u.nr = ud[3 * i + 2]; return true; }
    __device__ __forceinline__ const PG8_LAS int* rowtab(int ui) const { return tabA + ui * 256; }
};
struct EpiNull {
    static constexpr bool PERM = true, MIDK = false; float* O;
    __device__ __forceinline__ void operator()(const f32x4 (&acc)[2][2][4][2], const Unit& u, int ui, int wr, int wc, int fr, int fq) const {
        f32x4 t = (f32x4){0.f, 0.f, 0.f, 0.f};
#pragma unroll
        for (int ai = 0; ai < 2; ++ai)
#pragma unroll
            for (int bj = 0; bj < 2; ++bj)
#pragma unroll
                for (int m = 0; m < 4; ++m)
#pragma unroll
                    for (int n = 0; n < 2; ++n) t += acc[ai][bj][m][n];
        O[(size_t)(u.pm & 31) * 65536 + (u.pn & 7) * 8192 + (wr * 4 + wc) * 64 + fq * 16 + fr + ui] = t[0] + t[1] + t[2] + t[3];
    }
};
}

#include <hip/hip_bf16.h>
#include <cmath>
namespace attn_body {

using bf16=__hip_bfloat16;
using bf16x8=__attribute__((ext_vector_type(8)))short;
using s16x4=__attribute__((ext_vector_type(4)))short;
using f32x16=__attribute__((ext_vector_type(16)))float;
using u32x4=__attribute__((ext_vector_type(4)))unsigned;
constexpr int SEQ=4096,D=64,PIN=3072,POUT=1024;
constexpr int NW=8,QBLK=32,QB=QBLK*NW,KVBLK=64,NQB=SEQ/QB;
__device__ __forceinline__ int crow(int r,int hi){return (r&3)+8*(r>>2)+4*hi;}
#define SBAR() __builtin_amdgcn_sched_barrier(0)
__device__ __forceinline__ void cmask(f32x16&p0,f32x16&p1,int jb,int qrel,int hi){
  const float NEG=-INFINITY; int kb=64*jb+4*hi;
  #pragma unroll
  for(int r=0;r<16;++r){int kv=kb+(r&3)+8*(r>>2); if(kv>qrel)p0[r]=NEG; if(kv+32>qrel)p1[r]=NEG;}
}

constexpr int NSLOT=3, SLOTB=8192;
constexpr int LDS_K=0, LDS_V=NSLOT*SLOTB, LDS_WS=2*NSLOT*SLOTB, LDS_OST=LDS_WS+NW*64*4, LDS_CK=LDS_OST+NW*4096, LDS_BYTES=LDS_CK+SEQ*4;
constexpr float C2=0.125f*1.4426950408889634f;
__device__ __forceinline__ void glds16(const void*gsrc,unsigned lds_dst){unsigned keep;
  asm volatile("s_mov_b32 %0, m0\n\ts_mov_b32 m0, %2\n\ts_nop 0\n\tglobal_load_lds_dwordx4 %1, off\n\ts_mov_b32 m0, %0":"=&s"(keep):"v"(gsrc),"s"(lds_dst):"memory");}
__device__ __forceinline__ float max3f(float a,float b,float c){float r;asm("v_max3_f32 %0, %1, %2, %3":"=v"(r):"v"(a),"v"(b),"v"(c));return r;}
__device__ __forceinline__ float max2f(float a,float b){float r;asm("v_max_f32_e32 %0, %1, %2":"=v"(r):"v"(a),"v"(b));return r;}
__device__ __forceinline__ float fadd_s(float a,float b){float r;asm("v_add_f32_e32 %0, %1, %2":"=v"(r):"v"(a),"v"(b));return r;}
__device__ __forceinline__ float fsub_s(float a,float b){float r;asm("v_sub_f32_e32 %0, %1, %2":"=v"(r):"v"(a),"v"(b));return r;}
typedef float f32x2_t __attribute__((ext_vector_type(2))); typedef float f32x4_t __attribute__((ext_vector_type(4))); typedef __bf16 bf16x2_t __attribute__((ext_vector_type(2)));
__device__ __forceinline__ unsigned cvtpk_s(float lo,float hi){f32x2_t v={lo,hi};bf16x2_t b=__builtin_convertvector(v,bf16x2_t);return __builtin_bit_cast(unsigned,b);}
#define WAIT_BAR(N) asm volatile("s_waitcnt vmcnt(" #N ") lgkmcnt(0)\n\ts_barrier":::"memory")

__device__ __forceinline__ void qkt(f32x16&p0,f32x16&p1,const char*Kslot,const bf16x8*qr,const f32x16&negm,int r32,int hi){
  const char*kb=Kslot+hi*1024+r32*16;
  #pragma unroll
  for(int d0=0;d0<4;++d0){
    const bf16x8 b0=*reinterpret_cast<const bf16x8*>(kb+d0*2048);
    const bf16x8 b1=*reinterpret_cast<const bf16x8*>(kb+d0*2048+512);
    if(d0==0){p0=__builtin_amdgcn_mfma_f32_32x32x16_bf16(b0,qr[0],negm,0,0,0);p1=__builtin_amdgcn_mfma_f32_32x32x16_bf16(b1,qr[0],negm,0,0,0);}
    else{p0=__builtin_amdgcn_mfma_f32_32x32x16_bf16(b0,qr[d0],p0,0,0,0);p1=__builtin_amdgcn_mfma_f32_32x32x16_bf16(b1,qr[d0],p1,0,0,0);}}
}
typedef __attribute__((address_space(3))) const char* lds_cptr;
typedef short v4i16_t __attribute__((ext_vector_type(4)));
__device__ __forceinline__ void kload8(bf16x8*kf,lds_cptr kp){
  kf[0]=*(const __attribute__((address_space(3))) bf16x8*)(kp);      kf[1]=*(const __attribute__((address_space(3))) bf16x8*)(kp+512);
  kf[2]=*(const __attribute__((address_space(3))) bf16x8*)(kp+2048); kf[3]=*(const __attribute__((address_space(3))) bf16x8*)(kp+2560);
  kf[4]=*(const __attribute__((address_space(3))) bf16x8*)(kp+4096); kf[5]=*(const __attribute__((address_space(3))) bf16x8*)(kp+4608);
  kf[6]=*(const __attribute__((address_space(3))) bf16x8*)(kp+6144); kf[7]=*(const __attribute__((address_space(3))) bf16x8*)(kp+6656);
}
__device__ __forceinline__ void kload2(bf16x8*kf,lds_cptr kp,int j){ kf[2*j]=*(const __attribute__((address_space(3))) bf16x8*)(kp+j*2048); kf[2*j+1]=*(const __attribute__((address_space(3))) bf16x8*)(kp+j*2048+512); }
__device__ __forceinline__ s16x4 vtr(lds_cptr p){ return __builtin_bit_cast(s16x4,__builtin_amdgcn_ds_read_tr16_b64_v4i16((__attribute__((address_space(3))) v4i16_t*)p)); }
__device__ __forceinline__ float rowmax(const f32x16&p0,const f32x16&p1){
  float a=max3f(p0[0],p0[1],p1[0]),b=max3f(p0[2],p0[3],p1[1]);a=max3f(a,p1[2],p1[3]);
  #pragma unroll
  for(int r=4;r<16;r+=4){a=max3f(a,p0[r],p0[r+1]);b=max3f(b,p0[r+2],p0[r+3]);a=max3f(a,p1[r],p1[r+1]);b=max3f(b,p1[r+2],p1[r+3]);}
  const float m=max2f(a,b);
  auto rr=__builtin_amdgcn_permlane32_swap(__float_as_uint(m),__float_as_uint(m),false,false);
  return max2f(__uint_as_float(rr[0]),__uint_as_float(rr[1]));
}
__device__ __forceinline__ void pv(f32x16*o,int vb,bf16x8 pa0,bf16x8 pa1,bf16x8 pa2,bf16x8 pa3){
  #pragma unroll
  for(int d0=0;d0<2;++d0){s16x4 lo[4],hi[4];
    #pragma unroll
    for(int ks=0;ks<4;++ks){
      asm volatile("ds_read_b64_tr_b16 %0,%1 offset:%c2":"=&v"(lo[ks]):"v"(vb),"i"(d0*4096+ks*1024):"memory");
      asm volatile("ds_read_b64_tr_b16 %0,%1 offset:%c2":"=&v"(hi[ks]):"v"(vb),"i"(d0*4096+ks*1024+512):"memory");}
    asm volatile("s_waitcnt lgkmcnt(0)":::"memory");SBAR();
    #define PK(k) (bf16x8){lo[k][0],lo[k][1],lo[k][2],lo[k][3],hi[k][0],hi[k][1],hi[k][2],hi[k][3]}
    o[d0]=__builtin_amdgcn_mfma_f32_32x32x16_bf16(pa0,PK(0),o[d0],0,0,0);
    o[d0]=__builtin_amdgcn_mfma_f32_32x32x16_bf16(pa1,PK(1),o[d0],0,0,0);
    o[d0]=__builtin_amdgcn_mfma_f32_32x32x16_bf16(pa2,PK(2),o[d0],0,0,0);
    o[d0]=__builtin_amdgcn_mfma_f32_32x32x16_bf16(pa3,PK(3),o[d0],0,0,0);
    #undef PK
  }
}

#ifndef ATTN_STORE16
#define ATTN_STORE16(p,v) (*(u32x4*)(p)=(v))
#endif
template<int THRL> __device__ __forceinline__ void attn_unit(int b,int h,int qb,const bf16*Q,const bf16*__restrict__ K,const bf16*__restrict__ V,bf16*O,const float*__restrict__ CUMbh,float*__restrict__ SSQh,float skipth,char*shm){
  int tid_=threadIdx.x; asm volatile("":"+v"(tid_));
  const int tid=tid_,lane=tid&63,r32=lane&31,hi=lane>>5; const int wid=__builtin_amdgcn_readfirstlane(tid>>6);
  const long rowbase=(long)b*SEQ; const int q0=qb*QB;
  const bf16*Qw=Q+(rowbase+q0+wid*QBLK)*PIN+h*D;
  int t0;
  { const int NT0=(q0+QB)/KVBLK; const bool sk=(lane<NT0-4)&&(CUMbh[64*lane+63]-CUMbh[q0]>=skipth); t0=__builtin_popcountll(__ballot(sk))&~1; t0=__builtin_amdgcn_readfirstlane(t0); }
  const bf16*Kh=K+(rowbase+(long)t0*KVBLK)*PIN+h*D,*Vh=V+(rowbase+(long)t0*KVBLK)*PIN+h*D;
  const unsigned lds0=(unsigned)(uintptr_t)shm;
  const lds_cptr shm3=(lds_cptr)shm;
  float*wsf=(float*)(shm+LDS_WS)+wid*64;
  const bf16*ksrc=Kh+(long)lane*PIN+wid*8;
  const bf16*vsrc=Vh+(long)(16*(wid&3)+(lane>>2))*PIN+(wid>>2)*32+(lane&3)*8;
  const unsigned kdst=lds0+LDS_K+wid*1024, vdst=lds0+LDS_V+wid*1024;
  #define DMA_K(t,slot) glds16(ksrc+(long)(t)*KVBLK*PIN,(unsigned)__builtin_amdgcn_readfirstlane(kdst+(slot)))
  #define DMA_V(t,slot) glds16(vsrc+(long)(t)*KVBLK*PIN,(unsigned)__builtin_amdgcn_readfirstlane(vdst+(slot)))
  const int vb0=(int)(lds0+LDS_V)+((lane>>4)&1)*32+(lane&3)*8+(4*hi+((lane&15)>>2))*64;
  const char*Kbase=shm+LDS_K; bf16x8 kf[8];
  const lds_cptr kp0=shm3+LDS_K+hi*1024+r32*16; const lds_cptr vp0=shm3+LDS_V+((lane>>4)&1)*32+(lane&3)*8+(4*hi+((lane&15)>>2))*64;
  const int NT=(q0+QB)/KVBLK-t0;
  DMA_K(0,0);DMA_V(0,0);DMA_K(1,SLOTB);
  bf16x8 qr[4];
  #pragma unroll
  for(int d0=0;d0<4;++d0)qr[d0]=*reinterpret_cast<const bf16x8*>(&Qw[(long)r32*PIN+d0*16+hi*8]);
  const float cbase=CUMbh[q0]; const float cq=CUMbh[q0+wid*QBLK+r32]-cbase;
  { __attribute__((address_space(3))) float*ckw=(__attribute__((address_space(3))) float*)(shm3+LDS_CK); int s0_=tid; asm volatile("":"+v"(s0_));
    _Pragma("nounroll") for(int s=s0_;s<q0+QB;s+=NW*64)ckw[s]=CUMbh[s]-cbase; }
  const __attribute__((address_space(3))) float*ckp=(const __attribute__((address_space(3))) float*)(shm3+LDS_CK)+4*hi+t0*KVBLK;
  float mhat=-cq,l_reg=0.f;f32x16 o[2];o[0]=f32x16{};o[1]=f32x16{};f32x16 negm;
  #pragma unroll
  for(int r=0;r<16;++r)negm[r]=cq;
  asm volatile("":"+v"(negm));
  const int qrel=wid*QBLK+r32;
  #define BIAS(P0,P1,t) do{ const __attribute__((address_space(3))) float*cp_=ckp+(t)*KVBLK; \
    _Pragma("unroll") for(int g_=0;g_<4;++g_){ const f32x4_t c0_=*(const __attribute__((address_space(3))) f32x4_t*)(cp_+8*g_), c1_=*(const __attribute__((address_space(3))) f32x4_t*)(cp_+32+8*g_); \
      _Pragma("unroll") for(int j_=0;j_<4;++j_){ P0[4*g_+j_]-=c0_[j_]; P1[4*g_+j_]-=c1_[j_]; } SBAR(); } }while(0)
  #define CMASK(P0,P1,t) do{int jb_=(t)-(NT-4); if(jb_>=0)cmask(P0,P1,jb_,qrel,hi);}while(0)
  bool resc=false;
  #define START(P0,P1) do{ const float rm=rowmax(P0,P1); resc=false; \
    { const float dl=rm; mhat=fadd_s(mhat,dl); \
      _Pragma("unroll") for(int r=0;r<16;++r){P0[r]=fsub_s(P0[r],dl);P1[r]=fsub_s(P1[r],dl);} \
      _Pragma("unroll") for(int r=0;r<16;++r)negm[r]=-mhat; asm volatile("":"+v"(negm)); } \
    _Pragma("unroll") for(int r=0;r<16;++r)P0[r]=__builtin_amdgcn_exp2f(P0[r]); }while(0)
  #define RESC() do{ if(resc){ asm volatile("s_waitcnt lgkmcnt(0)":::"memory"); \
      _Pragma("unroll") for(int d_=0;d_<2;++d_) _Pragma("unroll") for(int r=0;r<16;++r)o[d_][r]*=wsf[crow(r,hi)]; } }while(0)
  f32x16 pA0,pA1,pB0,pB1;
  int sl_prev=0,sl_cur=0,sl_next=SLOTB;
  #define ROT() do{sl_prev=sl_cur;sl_cur=sl_next;sl_next=(sl_next==(NSLOT-1)*SLOTB)?0:sl_next+SLOTB;}while(0)
  DMA_K(2,2*SLOTB);
  WAIT_BAR(3);
  qkt(pA0,pA1,Kbase,qr,negm,r32,hi);asm volatile("s_nop 15\n\ts_nop 7":"+v"(pA0),"+v"(pA1));BIAS(pA0,pA1,0);CMASK(pA0,pA1,0);
  START(pA0,pA1);
  _Pragma("unroll") for(int r=0;r<16;++r)pA1[r]=__builtin_amdgcn_exp2f(pA1[r]);
  WAIT_BAR(0);
  DMA_K(3,0);DMA_V(1,SLOTB);
  ROT();
  kload8(kf,kp0+sl_cur);
  WAIT_BAR(2);
  s16x4 vlo[8],vhi[8]; u32x4 pw0,pw1,pw2,pw3;
  #define PKW(P,B) cvtpk_s(P[B],P[B+1])
  #define PAF(k) __builtin_bit_cast(bf16x8,pw##k)
  #define VFR(i) (bf16x8){vlo[i][0],vlo[i][1],vlo[i][2],vlo[i][3],vhi[i][0],vhi[i][1],vhi[i][2],vhi[i][3]}
  #define PIN(x) asm volatile("":"+v"(x))
  #define MX3(a,b,c) __builtin_fmaxf(__builtin_fmaxf((a),(b)),(c))
  #define GAPA(MF,A0,A1,A2,A3,W0,W1,PW) do{ MF; sacc+=A0; sacc+=A1; sacc+=A2; sacc+=A3; PIN(sacc); W0; W1; PIN(PW); SBAR(); }while(0)
  #define EX(v) __builtin_amdgcn_exp2f(v)
  #define GAPB(MF,X,B) do{ MF; X[B]=EX(X[B]); X[B+1]=EX(X[B+1]); X[B+2]=EX(X[B+2]); X[B+3]=EX(X[B+3]); PIN(X); SBAR(); }while(0)
  #define VRD(i) do{ vlo[i]=vtr(vp_+(((i)>>2)*4096+((i)&3)*1024)); vhi[i]=vtr(vp_+(((i)>>2)*4096+((i)&3)*1024+512)); }while(0)
  #define KRD(G,j) do{ if(G){ kload2(kf,kp0+sl_next,j); SBAR(); } }while(0)
  #define STEP(C0,C1,P0,P1,t,GK,GV,GL) do{ SBAR(); \
    const lds_cptr vp_=vp0+sl_prev; \
    VRD(0); SBAR(); float sacc=(P0[0]+P0[1]); \
    GAPA(C0=__builtin_amdgcn_mfma_f32_32x32x16_bf16(kf[0],qr[0],negm,0,0,0), P0[2],P0[3],P0[4],P0[5],     pw0[0]=PKW(P0,0), pw0[1]=PKW(P0,2), pw0); \
    VRD(4); SBAR(); GAPA(C1=__builtin_amdgcn_mfma_f32_32x32x16_bf16(kf[1],qr[0],negm,0,0,0), P0[6],P0[7],P0[8],P0[9],     pw0[2]=PKW(P0,4), pw0[3]=PKW(P0,6), pw0); \
    VRD(1); SBAR(); GAPA(C0=__builtin_amdgcn_mfma_f32_32x32x16_bf16(kf[2],qr[1],C0,0,0,0),   P0[10],P0[11],P0[12],P0[13], pw1[0]=PKW(P0,8), pw1[1]=PKW(P0,10), pw1); \
    VRD(5); SBAR(); GAPA(C1=__builtin_amdgcn_mfma_f32_32x32x16_bf16(kf[3],qr[1],C1,0,0,0),   P0[14],P0[15],P1[0],P1[1],   pw1[2]=PKW(P0,12),pw1[3]=PKW(P0,14), pw1); \
    VRD(2); SBAR(); GAPA(C0=__builtin_amdgcn_mfma_f32_32x32x16_bf16(kf[4],qr[2],C0,0,0,0),   P1[2],P1[3],P1[4],P1[5],     pw2[0]=PKW(P1,0), pw2[1]=PKW(P1,2), pw2); \
    VRD(6); SBAR(); GAPA(C1=__builtin_amdgcn_mfma_f32_32x32x16_bf16(kf[5],qr[2],C1,0,0,0),   P1[6],P1[7],P1[8],P1[9],     pw2[2]=PKW(P1,4), pw2[3]=PKW(P1,6), pw2); \
    VRD(3); SBAR(); GAPA(C0=__builtin_amdgcn_mfma_f32_32x32x16_bf16(kf[6],qr[3],C0,0,0,0),   P1[10],P1[11],P1[12],P1[13], pw3[0]=PKW(P1,8), pw3[1]=PKW(P1,10), pw3); \
    VRD(7); SBAR(); GAPA(C1=__builtin_amdgcn_mfma_f32_32x32x16_bf16(kf[7],qr[3],C1,0,0,0),   P1[14],P1[15],0.f,0.f,       pw3[2]=PKW(P1,12),pw3[3]=PKW(P1,14), pw3); \
    l_reg+=sacc; \
    if(GK){DMA_K((t)+3,sl_cur);} if(GV){DMA_V((t)+1,sl_next);} \
    BIAS(C0,C1,t); CMASK(C0,C1,t); \
    { float a=MX3(C0[0],C0[1],C1[0]),b=MX3(C0[2],C0[3],C1[1]); a=MX3(a,C1[2],C1[3]); \
      _Pragma("unroll") for(int r=4;r<16;r+=4){a=MX3(a,C0[r],C0[r+1]);b=MX3(b,C0[r+2],C0[r+3]);a=MX3(a,C1[r],C1[r+1]);b=MX3(b,C1[r+2],C1[r+3]);} \
      float rm=__builtin_fmaxf(a,b); { auto rr=__builtin_amdgcn_permlane32_swap(__float_as_uint(rm),__float_as_uint(rm),false,false); rm=__builtin_fmaxf(__uint_as_float(rr[0]),__uint_as_float(rr[1])); } \
      resc=false; \
      if(__builtin_expect(__any(rm>(float)THRL),0)){ const float dl=__builtin_fmaxf(rm,0.f); mhat+=dl; \
        _Pragma("unroll") for(int r=0;r<16;++r){C0[r]-=dl;C1[r]-=dl;} \
        _Pragma("unroll") for(int r=0;r<16;++r)negm[r]=-mhat; asm volatile("":"+v"(negm)); \
        const float f=__builtin_amdgcn_exp2f(-dl); l_reg*=f; if(hi==0)wsf[r32]=f; resc=true; } } \
    SBAR(); \
    GAPB(o[0]=__builtin_amdgcn_mfma_f32_32x32x16_bf16(PAF(0),VFR(0),o[0],0,0,0), C0,0); \
    GAPB(o[1]=__builtin_amdgcn_mfma_f32_32x32x16_bf16(PAF(0),VFR(4),o[1],0,0,0), C0,4); \
    KRD(GL,0); GAPB(o[0]=__builtin_amdgcn_mfma_f32_32x32x16_bf16(PAF(1),VFR(1),o[0],0,0,0), C0,8); \
    KRD(GL,1); GAPB(o[1]=__builtin_amdgcn_mfma_f32_32x32x16_bf16(PAF(1),VFR(5),o[1],0,0,0), C0,12); \
    KRD(GL,2); GAPB(o[0]=__builtin_amdgcn_mfma_f32_32x32x16_bf16(PAF(2),VFR(2),o[0],0,0,0), C1,0); \
    KRD(GL,3); GAPB(o[1]=__builtin_amdgcn_mfma_f32_32x32x16_bf16(PAF(2),VFR(6),o[1],0,0,0), C1,4); \
    GAPB(o[0]=__builtin_amdgcn_mfma_f32_32x32x16_bf16(PAF(3),VFR(3),o[0],0,0,0), C1,8); \
    GAPB(o[1]=__builtin_amdgcn_mfma_f32_32x32x16_bf16(PAF(3),VFR(7),o[1],0,0,0), C1,12); \
    }while(0)
  int t=1;
  #undef CMASK
  #define CMASK(P0,P1,t) do{}while(0)
  for(;t+5<NT;t+=2){
    STEP(pB0,pB1,pA0,pA1,t,true,true,true);     WAIT_BAR(2); RESC(); ROT();
    STEP(pA0,pA1,pB0,pB1,t+1,true,true,true);   WAIT_BAR(2); RESC(); ROT();
  }
  #undef CMASK
  #define CMASK(P0,P1,t) do{int jb_=(t)-(NT-4); if(jb_>=0)cmask(P0,P1,jb_,qrel,hi);}while(0)
  #define ENDW(tt) do{ if((tt)+3<NT){WAIT_BAR(2);} else if((tt)+2<NT){WAIT_BAR(1);} else {WAIT_BAR(0);} }while(0)
  for(;t+1<NT;t+=2){
    STEP(pB0,pB1,pA0,pA1,t,(t+3<NT),(t+1<NT),(t+1<NT));       ENDW(t);   RESC(); ROT();
    STEP(pA0,pA1,pB0,pB1,t+1,(t+4<NT),(t+2<NT),(t+2<NT));     ENDW(t+1); RESC(); ROT();
  }
  STEP(pB0,pB1,pA0,pA1,NT-1,false,false,false); RESC();
  { float sacc=pB0[0]+pB0[1]; _Pragma("unroll") for(int r=2;r<16;++r)sacc+=pB0[r]; _Pragma("unroll") for(int r=0;r<16;++r)sacc+=pB1[r]; l_reg+=sacc;
    pw0=(u32x4){PKW(pB0,0),PKW(pB0,2),PKW(pB0,4),PKW(pB0,6)};pw1=(u32x4){PKW(pB0,8),PKW(pB0,10),PKW(pB0,12),PKW(pB0,14)};pw2=(u32x4){PKW(pB1,0),PKW(pB1,2),PKW(pB1,4),PKW(pB1,6)};pw3=(u32x4){PKW(pB1,8),PKW(pB1,10),PKW(pB1,12),PKW(pB1,14)};
    SBAR(); pv(o,vb0+sl_cur,PAF(0),PAF(1),PAF(2),PAF(3)); }
  #undef PKW
  #undef PAF
  #undef VFR
  #undef PIN
  #undef MX3
  #undef GAPA
  #undef GAPB
  #undef EX
  #undef VRD
  #undef KRD
  #undef STEP
  #undef ENDW
  {auto rr=__builtin_amdgcn_permlane32_swap(__float_as_uint(l_reg),__float_as_uint(l_reg),false,false);l_reg=__uint_as_float(rr[0])+__uint_as_float(rr[1]);}
  if(hi==0)wsf[32+r32]=l_reg;asm volatile("s_waitcnt lgkmcnt(0)":::"memory");
  float rli[16];
  #pragma unroll
  for(int r=0;r<16;++r)rli[r]=__builtin_amdgcn_rcpf(wsf[32+crow(r,hi)]);
  bf16*Ow=O+(rowbase+q0+wid*QBLK)*POUT+h*D; float*Sw=SSQh+(rowbase+q0+wid*QBLK)*16;
  { bf16*stg=(bf16*)(shm+LDS_OST)+wid*2048;
    #pragma unroll
    for(int r=0;r<16;++r){const int orow=crow(r,hi);
      #pragma unroll
      for(int d0=0;d0<2;++d0)stg[orow*64+d0*32+r32]=__float2bfloat16(o[d0][r]*rli[r]);}
    asm volatile("s_waitcnt lgkmcnt(0)":::"memory");
    #pragma unroll
    for(int i=0;i<4;++i){const int row=i*8+(lane>>3),ch=lane&7; const u32x4 v=*(const u32x4*)(stg+row*64+ch*8); ATTN_STORE16(Ow+(long)row*POUT+ch*8,v);
      float sq=0.f;
      #pragma unroll
      for(int w_=0;w_<4;++w_){const float lo_=__uint_as_float(v[w_]<<16),hi_=__uint_as_float(v[w_]&0xffff0000u);sq+=lo_*lo_+hi_*hi_;}
      sq+=__shfl_xor(sq,1);sq+=__shfl_xor(sq,2);sq+=__shfl_xor(sq,4); if(ch==0)Sw[row*16]=sq;} }
  asm volatile("s_waitcnt lgkmcnt(0)\n\ts_barrier":::"memory");
  #undef DMA_K
  #undef DMA_V
  #undef CMASK
  #undef BIAS
  #undef START
  #undef RESC
  #undef ROT
}
constexpr int ATTN_LDS_BYTES=LDS_BYTES;

__device__ __forceinline__ void sb_unit(int b,int h,int qb,const bf16*Q,const bf16*__restrict__ K,const bf16*__restrict__ V,bf16*O,float*__restrict__ SSQh,char*shm){
  int tid_=threadIdx.x; asm volatile("":"+v"(tid_));
  const int tid=tid_,lane=tid&63,r32=lane&31,hi=lane>>5; const int wid=__builtin_amdgcn_readfirstlane(tid>>6);
  const long rowbase=(long)b*SEQ; const int q0=qb*QB;
  const bf16*Qw=Q+(rowbase+q0+wid*QBLK)*PIN+h*D;
  const bf16*Kh=K+rowbase*PIN+h*D,*Vh=V+rowbase*PIN+h*D;
  const unsigned lds0=(unsigned)(uintptr_t)shm;
  const bf16*ksrc=Kh+(long)lane*PIN+wid*8;
  const bf16*vsrc=Vh+(long)(16*(wid&3)+(lane>>2))*PIN+(wid>>2)*32+(lane&3)*8;
  const unsigned kdst=lds0+LDS_K+wid*1024, vdst=lds0+LDS_V+wid*1024;
  const int vb0=(int)(lds0+LDS_V)+((lane>>4)&1)*32+(lane&3)*8+(4*hi+((lane&15)>>2))*64;
  const char*Kbase=shm+LDS_K;
  const int NT=(q0+QB)/KVBLK;
  #define SB_DMA(i,slot) do{ const long kt_=(long)(NT-1-(i)); glds16(ksrc+kt_*KVBLK*PIN,(unsigned)__builtin_amdgcn_readfirstlane(kdst+(slot))); glds16(vsrc+kt_*KVBLK*PIN,(unsigned)__builtin_amdgcn_readfirstlane(vdst+(slot))); }while(0)
  bf16x8 qr[4];
  #pragma unroll
  for(int d0=0;d0<4;++d0)qr[d0]=*reinterpret_cast<const bf16x8*>(&Qw[(long)r32*PIN+d0*16+hi*8]);
  SB_DMA(0,0); SB_DMA(1,SLOTB);
  f32x16 o[2];o[0]=f32x16{};o[1]=f32x16{};
  float Rc=1.f;
  const int qrel=wid*QBLK+r32;
  int sl_cur=0,sl_n1=SLOTB,sl_n2=2*SLOTB;
  volatile __attribute__((address_space(3))) unsigned*flg=(volatile __attribute__((address_space(3))) unsigned*)((lds_cptr)shm+LDS_WS);
  f32x16 pA0,pA1,pB0,pB1;
  WAIT_BAR(3);
  { f32x16 z=f32x16{}; asm volatile("":"+v"(z)); qkt(pA0,pA1,Kbase+sl_cur,qr,z,r32,hi); }
  bool done_=false;
  #define SB_STEP(i,P0,P1,N0,N1) do{ \
    if((i)+1<NT){WAIT_BAR(1);}else{WAIT_BAR(0);} \
    if((i)>0){ const int pb=(((i)-1)&1)*8; unsigned all_=flg[pb]&flg[pb+1]&flg[pb+2]&flg[pb+3]&flg[pb+4]&flg[pb+5]&flg[pb+6]&flg[pb+7]; if(__builtin_amdgcn_readfirstlane(all_)){done_=true;break;} } \
    if((i)+2<NT)SB_DMA((i)+2,sl_n2); \
    if((i)+1<NT){ f32x16 z=f32x16{}; asm volatile("":"+v"(z)); qkt(N0,N1,Kbase+sl_n1,qr,z,r32,hi); SBAR(); } \
    f32x16 s0,s1; \
    _Pragma("unroll") for(int r=0;r<16;++r){ \
      const float za=__builtin_amdgcn_fmed3f(P0[r],-100.f,100.f), zb=__builtin_amdgcn_fmed3f(P1[r],-100.f,100.f); \
      P0[r]=__builtin_amdgcn_exp2f(za); P1[r]=__builtin_amdgcn_exp2f(zb); \
      s0[r]=__builtin_amdgcn_rcpf(1.f+P0[r]); s1[r]=__builtin_amdgcn_rcpf(1.f+P1[r]); } \
    if((i)<4){ const int kb=64*(3-(i))+4*hi; \
      _Pragma("unroll") for(int r=0;r<16;++r){ const int kv=kb+(r&3)+8*(r>>2); if(kv>=qrel){P0[r]=0.f;s0[r]=1.f;} if(kv+32>=qrel){P1[r]=0.f;s1[r]=1.f;} } } \
    float gp[8],pp[8]; \
    _Pragma("unroll") for(int g=0;g<4;++g){ \
      s0[4*g+2]*=s0[4*g+3]; s0[4*g+1]*=s0[4*g+2]; s0[4*g]*=s0[4*g+1]; gp[g]=s0[4*g]; \
      s1[4*g+2]*=s1[4*g+3]; s1[4*g+1]*=s1[4*g+2]; s1[4*g]*=s1[4*g+1]; gp[4+g]=s1[4*g]; } \
    _Pragma("unroll") for(int g=0;g<8;++g){ auto rr=__builtin_amdgcn_permlane32_swap(__float_as_uint(gp[g]),__float_as_uint(gp[g]),false,false); pp[g]=__uint_as_float(hi?rr[0]:rr[1]); } \
    float st=Rc, outer[8]; \
    _Pragma("unroll") for(int g=7;g>=0;--g){ outer[g]=hi?st:st*pp[g]; st=st*(gp[g]*pp[g]); } \
    Rc=st; \
    { const unsigned dn=__all(Rc==0.f)?1u:0u; if(lane==0)flg[((i)&1)*8+wid]=dn; } \
    _Pragma("unroll") for(int r=0;r<16;++r){ P0[r]=P0[r]*(s0[r]*outer[r>>2]); P1[r]=P1[r]*(s1[r]*outer[4+(r>>2)]); } \
    u32x4 pw0,pw1,pw2,pw3; \
    pw0=(u32x4){cvtpk_s(P0[0],P0[1]),cvtpk_s(P0[2],P0[3]),cvtpk_s(P0[4],P0[5]),cvtpk_s(P0[6],P0[7])}; \
    pw1=(u32x4){cvtpk_s(P0[8],P0[9]),cvtpk_s(P0[10],P0[11]),cvtpk_s(P0[12],P0[13]),cvtpk_s(P0[14],P0[15])}; \
    pw2=(u32x4){cvtpk_s(P1[0],P1[1]),cvtpk_s(P1[2],P1[3]),cvtpk_s(P1[4],P1[5]),cvtpk_s(P1[6],P1[7])}; \
    pw3=(u32x4){cvtpk_s(P1[8],P1[9]),cvtpk_s(P1[10],P1[11]),cvtpk_s(P1[12],P1[13]),cvtpk_s(P1[14],P1[15])}; \
    SBAR(); pv(o,vb0+sl_cur,__builtin_bit_cast(bf16x8,pw0),__builtin_bit_cast(bf16x8,pw1),__builtin_bit_cast(bf16x8,pw2),__builtin_bit_cast(bf16x8,pw3)); \
    { const int t_=sl_cur; sl_cur=sl_n1; sl_n1=sl_n2; sl_n2=t_; } \
  }while(0)
  for(int i=0;i<NT&&!done_;i+=2){
    SB_STEP(i,pA0,pA1,pB0,pB1); if(done_)break;
    SB_STEP(i+1,pB0,pB1,pA0,pA1);
  }
  #undef SB_STEP
  #undef SB_DMA
  bf16*Ow=O+(rowbase+q0+wid*QBLK)*POUT+h*D; float*Sw=SSQh+(rowbase+q0+wid*QBLK)*16;
  { bf16*stg=(bf16*)(shm+LDS_OST)+wid*2048;
    #pragma unroll
    for(int r=0;r<16;++r){const int orow=crow(r,hi);
      #pragma unroll
      for(int d0=0;d0<2;++d0)stg[orow*64+d0*32+r32]=__float2bfloat16(o[d0][r]);}
    asm volatile("s_waitcnt lgkmcnt(0)":::"memory");
    #pragma unroll
    for(int i=0;i<4;++i){const int row=i*8+(lane>>3),ch=lane&7; const u32x4 v=*(const u32x4*)(stg+row*64+ch*8); ATTN_STORE16(Ow+(long)row*POUT+ch*8,v);
      float sq=0.f;
      #pragma unroll
      for(int w_=0;w_<4;++w_){const float lo_=__uint_as_float(v[w_]<<16),hi_=__uint_as_float(v[w_]&0xffff0000u);sq+=lo_*lo_+hi_*hi_;}
      sq+=__shfl_xor(sq,1);sq+=__shfl_xor(sq,2);sq+=__shfl_xor(sq,4); if(ch==0)Sw[row*16]=sq;} }
  asm volatile("s_waitcnt vmcnt(0) lgkmcnt(0)\n\ts_barrier":::"memory");
}
template<int THRL=8> __device__ __forceinline__ void attn_phase(char*lds,const bf16*PROJ,const float*CUM,bf16*OMIX,float*SSQ,float skipth,int bh,int role){
  const int b=bh>>3,h=bh&7;
  const int nf=role<5?2:6;
  for(int i=0;i<nf;++i){ const int qb=role<5?(i==0?15-role:6+role):5-i;
    attn_unit<THRL>(b,h,qb,PROJ,PROJ+512,PROJ+1024,OMIX,CUM+(size_t)bh*SEQ,SSQ+h,skipth,lds); }
  const int sb0=role<3?3+3*role:(role==3?12:(role==4?14:0)), ns=(role==3||role==4)?2:3;
  for(int i=0;i<ns;++i) sb_unit(b,h,sb0+i,PROJ+1536,PROJ+2048,PROJ+2560,OMIX+512,SSQ+8+h,lds);
}
template<int THRL,int NA> __device__ __forceinline__ void attn_sched(char*lds,const bf16*PROJ,const float*CUM,bf16*OMIX,float*SSQ,float skipth,int xl,int c){
  int tid_=threadIdx.x; asm volatile("":"+v"(tid_)); const int tid=tid_;
  volatile __attribute__((address_space(3))) float*cost=(volatile __attribute__((address_space(3))) float*)((lds_cptr)lds+114688);
  volatile __attribute__((address_space(3))) int*order=(volatile __attribute__((address_space(3))) int*)((lds_cptr)lds+114688+512);
  #define BH_OF(i) ((xl>>1)*8+(((xl&1)?0x4361:0x5270)>>(4*(i))&15))
  if(tid<128){ const int bi=tid>>5,type=(tid>>4)&1,qb=tid&15,bh=BH_OF(bi),NT0=4*(qb+1); float cs;
    if(type==0){ const float rate=-CUM[(size_t)bh*SEQ+SEQ-1]*(1.f/SEQ); const float w=skipth/fmaxf(rate,1e-6f); const float sk=fmaxf(0.f,(float)(qb*QB)-w);
      int t0=((int)(sk*(1.f/KVBLK)))&~1; if(t0>NT0-4)t0=NT0-4; cs=5.f+1.65f*(float)(NT0-t0); }
    else cs=3.f+2.6f*(float)(NT0<8?NT0:8);
    cost[tid]=cs; }
  asm volatile("s_waitcnt lgkmcnt(0)":::"memory"); __syncthreads();
  if(tid<128){ const float mc=cost[tid]; int rk=0; for(int j=0;j<128;++j){ const float cj=cost[j]; rk+=(cj>mc||(cj==mc&&j<tid))?1:0; } order[rk]=tid; }
  asm volatile("s_waitcnt lgkmcnt(0)":::"memory"); __syncthreads();
  for(int k=0;;++k){ const int r=NA*k+((k&1)?NA-1-c:c); if(r>=128)break;
    const int u=__builtin_amdgcn_readfirstlane(order[r]); const int bi=u>>5,type=(u>>4)&1,qb=u&15,bh=BH_OF(bi),b=bh>>3,h=bh&7;
    if(type==0)attn_unit<THRL>(b,h,qb,PROJ,PROJ+512,PROJ+1024,OMIX,CUM+(size_t)bh*SEQ,SSQ+h,skipth,lds);
    else sb_unit(b,h,qb,PROJ+1536,PROJ+2048,PROJ+2560,OMIX+512,SSQ+8+h,lds); }
  #undef BH_OF
}
template<int THRL=8> __device__ __forceinline__ void attn_phase8(char*lds,const bf16*PROJ,const float*CUM,bf16*OMIX,float*SSQ,int vcu){
  const int bh=vcu>>3,s=vcu&7,b=bh>>3,h=bh&7;
  if(bh>=32)return;
  for(int i=0;i<4;++i){ const int qb=(i&1)?15-s:s;
    if(i<2)attn_unit<THRL>(b,h,qb,PROJ,PROJ+512,PROJ+1024,OMIX,CUM+(size_t)bh*SEQ,SSQ+h,3.0e38f,lds);
    else   sb_unit(b,h,qb,PROJ+1536,PROJ+2048,PROJ+2560,OMIX+512,SSQ+8+h,lds); }
}
#undef SBAR
#undef WAIT_BAR
}

template <int NT, bool UP> __device__ __forceinline__ int moe_prepare(const unsigned* __restrict__ CNT, const int* __restrict__ LIST, const float* __restrict__ RSTD2, const float* __restrict__ RW,
                                                                     const float* __restrict__ bias, int* __restrict__ TBG, int bx, LAS unsigned char* L) {
    int tid_ = threadIdx.x; asm volatile("" : "+v"(tid_)); const int tid = tid_;
    LAS int* tb = (LAS int*)(L + TB_OFF); LAS int* tbE = tb + 64; LAS int* tbC = tb + 128; LAS int* cntl = tb + 192; LAS int* udl = tb + 224; LAS int* tabA = (LAS int*)(L + TAB_OFF); LAS float* tabB = (LAS float*)(L + TAB2_OFF);
    if (tid < 64) {
        const int cn = tid < NE ? (int)CNT[tid] : 0, nt = (cn + 255) >> 8, rem = cn & 255, ch = (rem != 0 && rem <= 128) ? 1 : 0;
        int a = nt, c = ch;
#pragma unroll
        for (int o = 1; o < 32; o <<= 1) { const int ta = __shfl_up(a, o), tc = __shfl_up(c, o); if ((tid & 63) >= o) { a += ta; c += tc; } }
        if (tid < NE) { tb[tid + 1] = a; tbC[tid + 1] = c; tbE[tid + 1] = a - c; cntl[tid] = cn; }
        if (tid == 0) { tb[0] = 0; tbC[0] = 0; tbE[0] = 0; }
    }
    LDS_WAIT(); __syncthreads();
    if (bx == 0 && tid <= NE) TBG[tid] = tb[tid];
    pg8::MoeOrder S{NT, bx, tb, tbE, tbC, cntl, tabA};
    if (tid < pg8::MOE_MAXU) { pg8::Unit u; const bool ok = S.next(tid, u); udl[3 * tid] = ok ? u.pm : -1; udl[3 * tid + 1] = u.pn; udl[3 * tid + 2] = u.nr; }
    LDS_WAIT(); __syncthreads();
    int nun = 0;
#pragma unroll
    for (int i = 0; i < pg8::MOE_MAXU; ++i) nun += (udl[3 * i] >= 0) ? 1 : 0;
    int slot[5];
#pragma unroll
    for (int j = 0; j < 5; ++j) { const int idx = tid + NTHREADS * j, ui = idx >> 8, r = idx & 255; slot[j] = 0;
        if (ui < nun) { const int e = udl[3 * ui + 1] / NT, mt = udl[3 * ui] - tb[e], cnt = cntl[e], p = mt * 256 + r; slot[j] = LIST[(size_t)e * LIST_CAP + (p < cnt ? p : cnt - 1)]; } }
#pragma unroll
    for (int j = 0; j < 5; ++j) { const int idx = tid + NTHREADS * j, ui = idx >> 8;
        if (ui < nun) { const int pn = udl[3 * ui + 1];
            if (UP) { const int tok = slot[j] >> 2; tabA[idx] = tok | (int)(__float_as_uint(RSTD2[tok]) & 0xffff0000u);
                      const int e = pn >> 3, pl = pn & 7, c = idx & 255; tabB[idx] = bias[(size_t)e * 2048 + (c < 128 ? pl * 128 + c : 1024 + pl * 128 + (c - 128))]; }
            else { ((LAS float*)tabA)[idx] = RW[slot[j]] * (Y_F8 ? 16.f : 1.f); const int e = pn >> 2, pl = pn & 3; tabB[idx] = bias[(size_t)e * DM + pl * 256 + (idx & 255)]; } } }
    VM_WAIT(); LDS_WAIT(); __syncthreads();
    return nun;
}

__global__ void __launch_bounds__(NTHREADS, 2) mega_fwd(Args a) {
    extern __shared__ __attribute__((aligned(16))) unsigned char lds[];
    LAS unsigned char* L = (LAS unsigned char*)lds;
    volatile LAS unsigned* MISC = (volatile LAS unsigned*)(L + MISC_OFF);
    const int tid = threadIdx.x, lane = tid & 63, wave = __builtin_amdgcn_readfirstlane(tid >> 6);
    const int G = gridDim.x, bx = blockIdx.x, vcu = (G % 8 == 0) ? (bx % 8) * (G / 8) + bx / 8 : bx;
    const int gw = vcu * NWAVES + wave, NGW = G * NWAVES;
    const bool cvt_role = (vcu & 31) >= 32 - NCVT;
    const int cvt_first = ((vcu >> 5) * NCVT + ((vcu & 31) - (32 - NCVT))) * NWAVES + wave;
    const bool cvt1_role = (vcu & 31) >= 24; const int cvt1_first = ((vcu >> 5) * 8 + ((vcu & 31) - 24)) * NWAVES + wave;
    unsigned char* ws = a.ws;
    unsigned* CTL = (unsigned*)(ws + WS_CTL);
    bf16_t* WINT = (bf16_t*)(ws + WS_WINT); bf16_t* WOUTT = (bf16_t*)(ws + WS_WOUTT); float* WR = (float*)(ws + WS_WR); float* CUM = (float*)(ws + WS_CUM);
    float* SSQ = (float*)(ws + WS_SSQ); float* RSTD2 = (float*)(ws + WS_RSTD2); float* RW = (float*)(ws + WS_RW); int* SLOTEP = (int*)(ws + WS_SLOTEP); int* TBG = (int*)(ws + WS_TBG); int* LIST = (int*)(ws + WS_LIST); float* FLOG = (float*)(ws + WS_FLOG);
    bf16_t* XN = (bf16_t*)(ws + WS_XN); bf16_t* PROJ = (bf16_t*)(ws + WS_PROJ); bf16_t* OMIX = (bf16_t*)(ws + WS_OMIX); bf16_t* X1B = (bf16_t*)(ws + WS_X1B);
    bf16_t* W1T = (bf16_t*)(ws + WS_W1T); bf16_t* W2T = (bf16_t*)(ws + WS_W2T); bf16_t* H = (bf16_t*)(ws + WS_H); bf16_t* Y = (bf16_t*)(ws + WS_Y);
    unsigned* CNT = CTL + CW_CNT;
    for (int u = tid; u < (LDS_BYTES - LDSCTL_OFF) / 4; u += NTHREADS) ((LAS unsigned*)(L + LDSCTL_OFF))[u] = 0u;
    __syncthreads();
    XcdBarrier bar = xcd_barrier_post(CTL + CW_BAR, MISC + 8);

    REPS(0) {
        LAS float* scr = (LAS float*)(L + RING_OFF + wave * 8448);
        LAS float* wf = (LAS float*)(L + RING_OFF + 98304);
        for (int i = tid; i < DM * 8; i += NTHREADS) { const int k = i >> 3; wf[i] = a.w_in[(size_t)k * WIN_N + 1536 + (i & 7)] * a.g1[k]; }
        LDS_WAIT(); __syncthreads();
        constexpr int I_IN = (DM / 64) * (NPROJ / 32), I_OUT = (DM / 64) * (DM / 32);
        for (int it = gw; it < I_IN + I_OUT; it += NGW) {
            TrItem t; f32x4 v[8];
            if (it < I_IN) { t.W = a.w_in; t.WT = WINT; t.gA = a.g1; t.gB = nullptr; t.K = DM; t.Nin = WIN_N; t.Nout = NPROJ; t.mode = 1; t.gsplit = DM; t.item = it; t.nbsh = -1; t.f8 = 0; }
            else { t.W = a.w_out; t.WT = WOUTT; t.gA = a.g_fox; t.gB = a.g_sb; t.K = DM; t.Nin = DM; t.Nout = DM; t.mode = 0; t.gsplit = GW; t.item = it - I_IN; t.nbsh = 5; t.f8 = 0; }
            tr_load<false>(t, lane, v); tr_store(t, lane, v, scr);
        }
        if (!OVERLAP_CVT) convert_experts(a.w1, a.w2, a.g2, W1T, W2T, gw, NGW, N_EXP_ITEMS, lane, scr);
        for (int i = gw * 64 + lane; i < DM * NE; i += NGW * 64) WR[i] = a.w_router[i] * a.g2[i >> 5];
        for (int row = gw; row < M; row += NGW) rms1_row(a.x, wf, a.b_f, XN, FLOG, row, lane);
    }
    xcd_barrier(bar); if (REP_PHASE == 8) xcd_barrier(bar);
    REPS(1) {
    if (vcu < NB * NH) cumsum_wg(FLOG, CUM, vcu, (LAS float*)(L + RING_OFF));
    if (OPT_GEMM) {
        if (OVERLAP_CVT && CVT_SPLIT > 0 && cvt1_role) {
            if (CVT_DMA) { LAS float* gl = (LAS float*)(L + TAB_OFF); for (int i = tid; i < DM; i += NTHREADS) gl[i] = a.g2[i]; LDS_WAIT(); __syncthreads();
                convert_experts_dma(a.w1, a.w2, W1T, W2T, cvt1_first, 64 * NWAVES, CVT_SPLIT, lane, (unsigned)(uintptr_t)((char*)lds + RING_OFF + wave * 16384), (const LAS float*)(L + RING_OFF + wave * 16384), gl); }
            else convert_experts(a.w1, a.w2, a.g2, W1T, W2T, cvt1_first, 64 * NWAVES, CVT_SPLIT, lane, (LAS float*)(L + RING_OFF + wave * 8448)); }
        else {
        pg8::Gemm g{XN, WINT, DM}; pg8::StaticOrder S; if (OVERLAP_CVT && CVT_SPLIT > 0) S.init(M, NPROJ, 192, (vcu & 31) * 8 + (vcu >> 5)); else S.init(M, NPROJ, G, bx); pg8::EpiProj E{PROJ, CTL + CW_QHP};
        pg8::gemm_phase<pg8::EpiProj, pg8::StaticOrder, true, false>(L + RING_OFF, g, S, E);
        }
    } else { for (int it = gw; it < (M / 16) * (NPROJ / 64); it += NGW) nv_inproj(XN, WINT, PROJ, it, lane); }
    }
    xcd_barrier(bar); if (REP_PHASE == 8) xcd_barrier(bar);
    REPS(2) if (OPT_ATTN) {
        static_assert(attn_body::ATTN_LDS_BYTES <= RING_BYTES, "attention scratch inside the ring region");
        if (OVERLAP_CVT) {
            const int xl = vcu >> 5, l = vcu & 31;
            if (cvt_role) {
                if (CVT_DMA) { LAS float* gl = (LAS float*)(L + TAB_OFF); for (int i = tid; i < DM; i += NTHREADS) gl[i] = a.g2[i]; LDS_WAIT(); __syncthreads();
                    convert_experts_dma(a.w1, a.w2, W1T, W2T, CVT_SPLIT + cvt_first, 8 * NCVT * NWAVES, N_EXP_ITEMS, lane, (unsigned)(uintptr_t)((char*)lds + RING_OFF + wave * 16384), (const LAS float*)(L + RING_OFF + wave * 16384), gl); }
                else convert_experts(a.w1, a.w2, a.g2, W1T, W2T, CVT_SPLIT + cvt_first, 8 * NCVT * NWAVES, N_EXP_ITEMS, lane, (LAS float*)(L + RING_OFF + wave * 8448)); }
            const float bnd = 2.04f * sqrtf(__uint_as_float(CTL[CW_QHP]) * __uint_as_float(CTL[CW_KHP])), skipth = FOX_SKIP ? 160.f + 2.f * bnd : 3.0e38f;
            if (l < 32 - NCVT) { if (ATTN_SCHED) attn_body::attn_sched<8, 32 - NCVT>((char*)lds + RING_OFF, (const attn_body::bf16*)PROJ, CUM, (attn_body::bf16*)OMIX, SSQ, skipth, xl, l);
                          else attn_body::attn_phase<8>((char*)lds + RING_OFF, (const attn_body::bf16*)PROJ, CUM, (attn_body::bf16*)OMIX, SSQ, skipth, xl * 4 + l / 6, l % 6); }
        } else attn_body::attn_phase8<8>((char*)lds + RING_OFF, (const attn_body::bf16*)PROJ, CUM, (attn_body::bf16*)OMIX, SSQ, vcu);
    } else {
        LAS unsigned char* wl = L + RING_OFF + wave * 16640;
        for (int u = gw; u < 4096; u += NGW) {
            const int i = u >> 11, idx = u & 2047, type = idx & 1, bh = (idx >> 1) & 31, j = (idx >> 6) & 31; const int qblk = (i == 0) ? j : 63 - j;
            if (type == 0) nv_attn<0>(PROJ, CUM, OMIX, SSQ, bh, qblk, lane, wl); else nv_attn<1>(PROJ, CUM, OMIX, SSQ, bh, qblk, lane, wl);
        }
    }
    xcd_barrier(bar); if (REP_PHASE == 8) xcd_barrier(bar);
    REPS(3) if (OPT_GEMM) {
        pg8::Gemm g{OMIX, WOUTT, DM}; pg8::StaticOrder S; S.init(M, DM, G, bx);
        LAS float* ratio = (LAS float*)(L + TAB_OFF); LAS float* rsb = (LAS float*)(L + TAB_OFF + 1024);
        pg8::Unit u0;
        if (S.next(0, u0) && tid < 256) { const float* sp = SSQ + (size_t)(u0.pm * 256 + tid) * 16; float sf = 0.f, s2 = 0.f;
#pragma unroll
            for (int h = 0; h < 8; ++h) { sf += sp[h]; s2 += sp[8 + h]; }
            const float rf = rsqrtf(sf * (1.f / GW) + EPS), rs = rsqrtf(s2 * (1.f / GW) + EPS); ratio[tid] = rf / rs; rsb[tid] = rs; }
        VM_WAIT(); LDS_WAIT(); __syncthreads();
        pg8::EpiWout E{a.x, a.out, X1B, ratio, rsb};
        pg8::gemm_phase<pg8::EpiWout, pg8::StaticOrder, false, false>(L + RING_OFF, g, S, E);
    } else { for (int it = gw; it < (M / 16) * (DM / 64); it += NGW) nv_wout(OMIX, WOUTT, SSQ, a.x, a.out, X1B, it, lane); }
    xcd_barrier(bar); if (REP_PHASE == 8) xcd_barrier(bar);
    if (REP_PHASE == 4) { for (int t64 = vcu; t64 < M / 64; t64 += G) router_wg(a.out, WR, a.b_router, (float*)H, (float*)H + M, (int*)Y, (int*)Y + NE * LIST_CAP, CNT + 64, t64 * 64, L + RING_OFF); }
    if (OPT_ROUTER) { for (int t64 = vcu; t64 < M / 64; t64 += G) router_wg(a.out, WR, a.b_router, RSTD2, RW, LIST, SLOTEP, CNT, t64 * 64, L + RING_OFF); }
    else { for (int it = gw; it < M / 2; it += NGW) nv_router(a.out, WR, a.b_router, RSTD2, RW, LIST, SLOTEP, CNT, it, lane); }
    xcd_barrier(bar); if (REP_PHASE == 8) xcd_barrier(bar);
    LAS int* tb = (LAS int*)(L + TB_OFF); LAS int* tbE = tb + 64; LAS int* tbC = tb + 128; LAS int* cntl = tb + 192; LAS int* udl = tb + 224; LAS int* tabA = (LAS int*)(L + TAB_OFF); LAS int* tabB = (LAS int*)(L + TAB2_OFF);
    REPS(5) if (OPT_GEMM) {
        const int nun = moe_prepare<8, true>(CNT, LIST, RSTD2, RW, a.b1, TBG, bx, L);
        pg8::Gemm g{X1B, W1T, MOE_F8 ? DM / 2 : DM}; pg8::EpiMoe1 E{H, tabA, (const LAS float*)tabB}; pg8::ListOrder SL{udl, nun, tabA};
        pg8::gemm_phase<pg8::EpiMoe1, pg8::ListOrder, true, true, MOE_F8>(L + RING_OFF, g, SL, E);
    } else {
    for (int g = gw; g < MAX_TILES * 16; g += NGW) {
        int e, base, p0, cnt; if (!moe_tile(CNT, g, e, base, p0, cnt)) continue;
        for (int cg = 0; cg < DFF / 32; ++cg) nv_moe1(X1B, W1T, a.b1, RSTD2, LIST, H, e, base, p0, cnt, cg, lane);
    } }
    xcd_barrier(bar); if (REP_PHASE == 8) xcd_barrier(bar);
    REPS(6) if (OPT_GEMM) {
        const int nun = moe_prepare<4, false>(CNT, LIST, RSTD2, RW, a.b2, TBG, bx, L);
        pg8::Gemm g{H, W2T, MOE_F8 ? DM / 2 : DM}; pg8::EpiMoe2 E{Y, (const LAS float*)tabA, (const LAS float*)tabB}; pg8::ListOrder SL{udl, nun, tabA};
        pg8::gemm_phase<pg8::EpiMoe2, pg8::ListOrder, true, false, MOE_F8>(L + RING_OFF, g, SL, E);
    } else {
    for (int g = gw; g < MAX_TILES * 16; g += NGW) {
        int e, base, p0, cnt; if (!moe_tile(CNT, g, e, base, p0, cnt)) continue;
        for (int cg = 0; cg < DM / 64; ++cg) nv_moe2(H, W2T, a.b2, RW, LIST, Y, e, base, p0, cnt, cg, lane);
    } }
    xcd_barrier(bar); if (REP_PHASE == 8) xcd_barrier(bar);
    if (REP_PHASE == 7) { for (int row = gw; row < M; row += NGW) final_row(a.out, Y, SLOTEP, TBG, a.gf, (float*)H, row, lane); }
    for (int row = gw; row < M; row += NGW) final_row(a.out, Y, SLOTEP, TBG, a.gf, a.out, row, lane);
}

extern "C" void kernel_launch(void* const* d_in, const int* in_sizes, int n_in, void* d_out, int out_size, void* d_ws, size_t ws_size, hipStream_t stream) {
    static int grid = 0;
    if (grid == 0) {
        if (n_in != 15 || in_sizes[0] != M * DM || out_size != M * DM || ws_size < WS_END) {
            fprintf(stderr, "kernel_launch: unexpected shapes / workspace (n_in %d, in0 %d, out %d, ws %zu, need %zu)\n", n_in, n_in > 0 ? in_sizes[0] : -1, out_size, ws_size, (size_t)WS_END); grid = -1; return; }
        int dev = 0, cus = 0, per_cu = 0;
        if (hipGetDevice(&dev) != hipSuccess || hipDeviceGetAttribute(&cus, hipDeviceAttributeMultiprocessorCount, dev) != hipSuccess) { grid = -1; return; }
        if (hipFuncSetAttribute((const void*)mega_fwd, hipFuncAttributeMaxDynamicSharedMemorySize, LDS_BYTES) != hipSuccess) { fprintf(stderr, "kernel_launch: hipFuncSetAttribute failed\n"); grid = -1; return; }
        if (hipOccupancyMaxActiveBlocksPerMultiprocessor(&per_cu, (const void*)mega_fwd, NTHREADS, LDS_BYTES) != hipSuccess || per_cu < 1) fprintf(stderr, "kernel_launch: occupancy query reports %d\n", per_cu);
        (void)hipGetLastError();
        grid = cus;
        if (cus != 256) { fprintf(stderr, "kernel_launch: built for 256 CUs (8 XCDs x 32), found %d; nothing launched\n", cus); grid = -1; return; }
    }
    if (grid < 0) return;
    if (hipMemsetAsync((char*)d_ws + WS_CTL, 0, CTL_BYTES, stream) != hipSuccess) return;
    Args a{};
    a.x = (const float*)d_in[0]; a.g1 = (const float*)d_in[1]; a.w_in = (const float*)d_in[2]; a.b_f = (const float*)d_in[3]; a.g_fox = (const float*)d_in[4]; a.g_sb = (const float*)d_in[5];
    a.w_out = (const float*)d_in[6]; a.g2 = (const float*)d_in[7]; a.w_router = (const float*)d_in[8]; a.b_router = (const float*)d_in[9]; a.w1 = (const float*)d_in[10]; a.b1 = (const float*)d_in[11];
    a.w2 = (const float*)d_in[12]; a.b2 = (const float*)d_in[13]; a.gf = (const float*)d_in[14];
    a.out = (float*)d_out; a.ws = (unsigned char*)d_ws;
    hipLaunchKernelGGL(mega_fwd, dim3(grid), dim3(NTHREADS), LDS_BYTES, stream, a);
    const hipError_t le = hipPeekAtLastError();
    if (le != hipSuccess) fprintf(stderr, "kernel_launch: launch failed: %s\n", hipGetErrorName(le));
}
```

```cpp
#include <hip/hip_runtime.h>
#include <cstdio>
#include <cstdint>

typedef unsigned short bf16_t;
typedef short bf16x8 __attribute__((ext_vector_type(8)));
typedef float f32x4 __attribute__((ext_vector_type(4)));

constexpr int NB = 4, SEQ = 4096, DM = 1024, M = NB * SEQ;
constexpr int NH = 8, HD = 64, GW = 512;
constexpr int WIN_N = 3080, NPROJ = 3072;
constexpr int NE = 32, TOPK = 4, DFF = 1024;
constexpr float EPS = 1e-5f;
constexpr float LOG2E = 1.4426950408889634f;
constexpr float C2 = 0.125f * LOG2E;
constexpr int LIST_CAP = M;
constexpr int MAX_TILES = (M * TOPK) / 256 + NE;

constexpr size_t MiB = 1u << 20;
constexpr size_t WS_CTL = 0, CTL_BYTES = 1 * MiB;
constexpr size_t WS_WINT = 2 * MiB;
constexpr size_t WS_WOUTT = 8 * MiB;
constexpr size_t WS_WR = 10 * MiB;
constexpr size_t WS_CUM = 11 * MiB;
constexpr size_t WS_SSQ = 12 * MiB;
constexpr size_t WS_RSTD2 = 14 * MiB;
constexpr size_t WS_RW = 15 * MiB;
constexpr size_t WS_SLOTEP = 15 * MiB + 512 * 1024;
constexpr size_t WS_TBG = 14 * MiB + 512 * 1024;
constexpr size_t WS_LIST = 16 * MiB;
constexpr size_t WS_FLOG = 18 * MiB;
constexpr size_t WS_XN = 32 * MiB;
constexpr size_t WS_PROJ = 64 * MiB;
constexpr size_t WS_OMIX = 160 * MiB;
constexpr size_t WS_X1B = 192 * MiB;
constexpr size_t WS_W1T = 224 * MiB;
constexpr size_t WS_W2T = 352 * MiB;
constexpr size_t WS_H = 416 * MiB;
constexpr size_t WS_Y = 560 * MiB;
constexpr size_t WS_END = 704 * MiB;
constexpr int CW_CNT = 1024;
constexpr int CW_QHP = 2048, CW_KHP = 2112;

__device__ __forceinline__ unsigned short f2bf(float f) { unsigned u = __float_as_uint(f); return (unsigned short)((u + 0x7fffu + ((u >> 16) & 1u)) >> 16); }
__device__ __forceinline__ float bf2f(unsigned short b) { return __uint_as_float(((unsigned)b) << 16); }
__device__ __forceinline__ float wave_sum(float v) {
#pragma unroll
    for (int o = 1; o < 64; o <<= 1) v += __shfl_xor(v, o);
    return v;
}


#define LAS __attribute__((address_space(3)))
#define GAS __attribute__((address_space(1)))
typedef unsigned v4u __attribute__((ext_vector_type(4)));
#define LDS_WAIT() asm volatile("s_waitcnt lgkmcnt(0)" ::: "memory")
#define VM_WAIT() asm volatile("s_waitcnt vmcnt(0)" ::: "memory")
constexpr int NWAVES = 8, NTHREADS = NWAVES * 64;
constexpr int PROBE_T = -1;
constexpr int REP_PHASE = -1;
#define REPS(k) for (int rep_ = 0; rep_ < ((REP_PHASE == (k)) ? 2 : 1); ++rep_)
constexpr bool ATTN_SCHED = true;
constexpr bool FOX_SKIP = true;
constexpr bool WT_STORES = false;
constexpr bool Y_F8 = true;
constexpr bool MOE_F8 = true;
constexpr bool CVT_DMA = true;
constexpr int NCVT = 8;
constexpr int CVT_SPLIT = 20 * 512;
constexpr bool OVERLAP_CVT = true;
constexpr bool OPT_GEMM = true;
constexpr bool OPT_ROUTER = true;
constexpr bool OPT_ATTN = true;

#define XB_TMO      128
#define XB_XCNT(j)  (256  + 64 * (j))
#define XB_XSUB(j)  (1280 + 64 * (j))
#define XB_XGEN(j)  (2304 + 64 * (j))
#define XB_TOP      3328
#define XB_TOPGEN   3392
#define XCD_BAR_WORDS 3456
#define XB_SPIN_CAP (1u << 20)
__device__ __forceinline__ unsigned xb_ld(unsigned* p)              { return __hip_atomic_load(p, __ATOMIC_RELAXED, __HIP_MEMORY_SCOPE_AGENT); }
__device__ __forceinline__ unsigned xb_add(unsigned* p, unsigned v) { return __hip_atomic_fetch_add(p, v, __ATOMIC_RELAXED, __HIP_MEMORY_SCOPE_AGENT); }
__device__ __forceinline__ unsigned xb_xcc_id() { return (unsigned)__builtin_amdgcn_s_getreg((3 << 11) | 20) & 0xFu; }
#define XB_SPIN(cond, bar) do { unsigned _sp = 0; while (cond) { __builtin_amdgcn_s_sleep(1); \
    if ((++_sp & 255u) == 0u) { if (xb_ld(&(bar)[XB_TMO])) break; if (_sp > XB_SPIN_CAP) { atomicAdd(&(bar)[XB_TMO], 1u); break; } } } } while (0)
struct XcdBarrier { unsigned* bar; unsigned x; volatile LAS unsigned* st; };
__device__ __forceinline__ XcdBarrier xcd_barrier_post(unsigned* bar, volatile LAS unsigned* st) {
    XcdBarrier b; b.bar = bar; b.x = xb_xcc_id(); b.st = st;
    if (threadIdx.x == 0) (void)xb_add(&bar[XB_XCNT(b.x)], 1u);
    return b;
}
__device__ __forceinline__ void xcd_barrier_complete(unsigned* bar, unsigned x, unsigned& nloc, unsigned& nx) {
    const unsigned G = gridDim.x * gridDim.y * gridDim.z;
    unsigned sum, cnt, mine, sp = 0u;
    for (;;) {
        sum = 0u; cnt = 0u; mine = 0u;
#pragma unroll
        for (unsigned j = 0; j < 16; ++j) { const unsigned c = xb_ld(&bar[XB_XCNT(j)]); sum += c; cnt += (c > 0u) ? 1u : 0u; mine = (j == x) ? c : mine; }
        if (sum == G) break;
        __builtin_amdgcn_s_sleep(1);
        if ((++sp & 255u) == 0u) { if (xb_ld(&bar[XB_TMO])) break; if (sp > XB_SPIN_CAP) { atomicAdd(&bar[XB_TMO], 1u); break; } }
    }
    nloc = mine > 0u ? mine : 1u; nx = cnt > 0u ? cnt : 1u;
}
__device__ __forceinline__ void xcd_barrier(const XcdBarrier& b) {
    asm volatile("s_waitcnt vmcnt(0)" ::: "memory");
    __syncthreads();
    if (threadIdx.x == 0) {
        unsigned* bar = b.bar;
        __builtin_amdgcn_s_waitcnt(0);
        unsigned nloc = b.st[0], nx = b.st[1];
        if (nloc == 0u) { xcd_barrier_complete(bar, b.x, nloc, nx); b.st[0] = nloc; b.st[1] = nx; }
        const unsigned old = xb_add(&bar[XB_XSUB(b.x)], 1u);
        const unsigned gen = old / nloc;
        if (old + 1u == (gen + 1u) * nloc) {
            __builtin_amdgcn_fence(__ATOMIC_RELEASE, "agent");
            asm volatile("s_waitcnt vmcnt(0)" ::: "memory");
            const unsigned og = xb_add(&bar[XB_TOP], 1u);
            const unsigned tg = og / nx;
            if (og + 1u == (tg + 1u) * nx) xb_add(&bar[XB_TOPGEN], 1u);
            else XB_SPIN(xb_ld(&bar[XB_TOPGEN]) == tg, bar);
            __builtin_amdgcn_fence(__ATOMIC_ACQUIRE, "agent");
            xb_add(&bar[XB_XGEN(b.x)], 1u);
            asm volatile("s_waitcnt vmcnt(0)" ::: "memory");
        } else {
            XB_SPIN(xb_ld(&bar[XB_XGEN(b.x)]) == gen, bar);
            __builtin_amdgcn_fence(__ATOMIC_ACQUIRE, "agent");
            asm volatile("s_waitcnt vmcnt(0)" ::: "memory");
        }
    }
    __syncthreads();
}

constexpr int RING_OFF = 0, RING_BYTES = 131072;
constexpr int TAB_OFF = 131072;
constexpr int TAB2_OFF = TAB_OFF + 10 * 1024, TB_OFF = TAB_OFF + 20 * 1024;
constexpr int LDSCTL_OFF = 152576, MISC_OFF = LDSCTL_OFF + 320;
constexpr int LDS_BYTES = 155648;
constexpr int CW_BAR = 4096;

struct Args {
    const float *x, *g1, *w_in, *b_f, *g_fox, *g_sb, *w_out, *g2, *w_router, *b_router, *w1, *b1, *w2, *b2, *gf;
    float* out; unsigned char* ws;
};

__device__ __forceinline__ int mapcol(int mode, int n) {
    if (mode == 1) return n < 1536 ? n : n + 8;
    if (mode == 2) { const int pn = n >> 8, j = n & 255; return j < 128 ? 128 * pn + j : 1024 + 128 * pn + (j - 128); }
    return n;
}
__device__ __forceinline__ unsigned pk4_fp8(float a, float b, float c, float d) {
    a = __builtin_amdgcn_fmed3f(a, -448.f, 448.f); b = __builtin_amdgcn_fmed3f(b, -448.f, 448.f); c = __builtin_amdgcn_fmed3f(c, -448.f, 448.f); d = __builtin_amdgcn_fmed3f(d, -448.f, 448.f);
    int w = __builtin_amdgcn_cvt_pk_fp8_f32(a, b, 0, false); w = __builtin_amdgcn_cvt_pk_fp8_f32(c, d, w, true); return (unsigned)w;
}
__device__ __forceinline__ unsigned pk2(float lo, float hi) { unsigned r; asm("v_cvt_pk_bf16_f32 %0, %1, %2" : "=v"(r) : "v"(lo), "v"(hi)); return r; }
struct TrItem { const float* W; bf16_t* WT; const float* gA; const float* gB; int K, Nin, Nout, mode, gsplit, item, nbsh, f8; };
template <bool NT> __device__ __forceinline__ void tr_load(const TrItem& t, int lane, f32x4 (&v)[8]) {
    const int nblk = t.Nout / 32, kb = t.nbsh >= 0 ? (t.item >> t.nbsh) : t.item / nblk, nb = t.nbsh >= 0 ? (t.item & (nblk - 1)) : t.item % nblk, k0 = 64 * kb, n0 = 32 * nb, l7 = lane & 7, kr = lane >> 3, col = mapcol(t.mode, n0 + 4 * l7);
#pragma unroll
    for (int i = 0; i < 8; ++i) { const f32x4* p = (const f32x4*)(t.W + (size_t)(k0 + 8 * i + kr) * t.Nin + col); v[i] = NT ? __builtin_nontemporal_load(p) : *p; }
}
__device__ __forceinline__ void tr_store(const TrItem& t, int lane, const f32x4 (&v)[8], LAS float* scr) {
    const int nblk = t.Nout / 32, kb = t.nbsh >= 0 ? (t.item >> t.nbsh) : t.item / nblk, nb = t.nbsh >= 0 ? (t.item & (nblk - 1)) : t.item % nblk, k0 = 64 * kb, n0 = 32 * nb, l7 = lane & 7, kr = lane >> 3;
#pragma unroll
    for (int i = 0; i < 8; ++i) { const int kk = 8 * i + kr, k = k0 + kk; const float gs = t.gA ? (k < t.gsplit ? t.gA[k] : t.gB[k - t.gsplit]) : 1.f;
        LAS float* sp = scr + kk * 33 + 4 * l7; sp[0] = v[i][0] * gs; sp[1] = v[i][1] * gs; sp[2] = v[i][2] * gs; sp[3] = v[i][3] * gs; }
    LDS_WAIT();
    if (t.f8) {
        const int c = lane & 3;
#pragma unroll
        for (int j = 0; j < 2; ++j) { const int n = (lane >> 2) + 16 * j; const LAS float* sp = scr + (16 * c) * 33 + n;
            v4u o; o.x = pk4_fp8(32.f * sp[0 * 33], 32.f * sp[1 * 33], 32.f * sp[2 * 33], 32.f * sp[3 * 33]); o.y = pk4_fp8(32.f * sp[4 * 33], 32.f * sp[5 * 33], 32.f * sp[6 * 33], 32.f * sp[7 * 33]);
            o.z = pk4_fp8(32.f * sp[8 * 33], 32.f * sp[9 * 33], 32.f * sp[10 * 33], 32.f * sp[11 * 33]); o.w = pk4_fp8(32.f * sp[12 * 33], 32.f * sp[13 * 33], 32.f * sp[14 * 33], 32.f * sp[15 * 33]);
            *(v4u*)((unsigned char*)t.WT + (size_t)(n0 + n) * t.K + k0 + 16 * c) = o; }
    } else {
    const int c = lane & 7;
#pragma unroll
    for (int j = 0; j < 4; ++j) { const int n = (lane >> 3) + 8 * j; const LAS float* sp = scr + (8 * c) * 33 + n;
        v4u o; o.x = pk2(sp[0 * 33], sp[1 * 33]); o.y = pk2(sp[2 * 33], sp[3 * 33]); o.z = pk2(sp[4 * 33], sp[5 * 33]); o.w = pk2(sp[6 * 33], sp[7 * 33]);
        *(v4u*)(t.WT + (size_t)(n0 + n) * t.K + k0 + 8 * c) = o; }
    }
    LDS_WAIT();
}
constexpr int I_W1 = (DM / 64) * (2048 / 32), I_W2 = (DM / 64) * (DM / 32), N_EXP_ITEMS = NE * (I_W1 + I_W2);
__device__ __forceinline__ TrItem expert_item(const float* w1, const float* w2, const float* g2, bf16_t* W1T, bf16_t* W2T, int r) {
    TrItem t;
    t.f8 = MOE_F8 ? 1 : 0;
    if (r < NE * I_W1) { const int e = r / I_W1; t.W = w1 + (size_t)e * DM * 2048; t.WT = MOE_F8 ? (bf16_t*)((unsigned char*)W1T + (size_t)e * 2048 * DM) : W1T + (size_t)e * 2048 * DM; t.gA = g2; t.gB = nullptr; t.K = DM; t.Nin = 2048; t.Nout = 2048; t.mode = 2; t.gsplit = DM; t.item = r % I_W1; t.nbsh = 6; }
    else { r -= NE * I_W1; const int e = r / I_W2; t.W = w2 + (size_t)e * DM * DM; t.WT = MOE_F8 ? (bf16_t*)((unsigned char*)W2T + (size_t)e * DM * DM) : W2T + (size_t)e * DM * DM; t.gA = nullptr; t.gB = nullptr; t.K = DM; t.Nin = DM; t.Nout = DM; t.mode = 0; t.gsplit = DM; t.item = r % I_W2; t.nbsh = 5; }
    return t;
}
__device__ __forceinline__ void convert_experts(const float* w1, const float* w2, const float* g2, bf16_t* W1T, bf16_t* W2T, int first, int stride, int N_END, int lane, LAS float* scr) {
    f32x4 v0[8], v1[8];
#define CVT_LOAD(v, idx) do { if ((idx) < N_END) { const TrItem t_ = expert_item(w1, w2, g2, W1T, W2T, (idx)); tr_load<true>(t_, lane, v); } } while (0)
#define CVT_STORE(v, idx) do { if ((idx) < N_END) { const TrItem t_ = expert_item(w1, w2, g2, W1T, W2T, (idx)); tr_store(t_, lane, v, scr); } } while (0)
    int it = first; asm volatile("" : "+v"(lane));
    CVT_LOAD(v0, it);
#pragma unroll 1
    for (; it < N_END; it += 2 * stride) {
        CVT_LOAD(v1, it + stride); CVT_STORE(v0, it);
        CVT_LOAD(v0, it + 2 * stride); CVT_STORE(v1, it + stride);
    }
#undef CVT_LOAD
#undef CVT_STORE
}

__device__ __forceinline__ void dma16(const void* gsrc, unsigned lds_dst) { unsigned keep;
    asm volatile("s_mov_b32 %0, m0\n\ts_mov_b32 m0, %2\n\ts_nop 0\n\tglobal_load_lds_dwordx4 %1, off\n\ts_mov_b32 m0, %0" : "=&s"(keep) : "v"(gsrc), "s"(lds_dst) : "memory"); }
struct CvtItem { const float* W; unsigned char* WT; int Nin, k0, n0, col0, useg; };
__device__ __forceinline__ CvtItem cvt_item(const float* w1, const float* w2, bf16_t* W1T, bf16_t* W2T, int r) {
    CvtItem t;
    if (r < NE * I_W1) { const int e = r / I_W1, it = r % I_W1; t.W = w1 + (size_t)e * DM * 2048; t.WT = (unsigned char*)W1T + (size_t)e * 2048 * DM; t.Nin = 2048; t.k0 = 64 * (it >> 6); t.n0 = 32 * (it & 63); t.col0 = mapcol(2, t.n0); t.useg = 1; }
    else { r -= NE * I_W1; const int e = r / I_W2, it = r % I_W2; t.W = w2 + (size_t)e * DM * DM; t.WT = (unsigned char*)W2T + (size_t)e * DM * DM; t.Nin = DM; t.k0 = 64 * (it >> 5); t.n0 = 32 * (it & 31); t.col0 = t.n0; t.useg = 0; }
    return t;
}
__device__ __forceinline__ void cvt_issue(const CvtItem& t, int lane, unsigned ldsbuf) {
#pragma unroll
    for (int i = 0; i < 8; ++i) { const int kl = 8 * i + (lane >> 3), qs = ((lane & 7) - 2 * (kl >> 4)) & 7;
        dma16(t.W + (size_t)(t.k0 + kl) * t.Nin + t.col0 + 4 * qs, (unsigned)__builtin_amdgcn_readfirstlane(ldsbuf + i * 1024)); }
}
__device__ __forceinline__ void cvt_finish(const CvtItem& t, int lane, const LAS float* buf, const LAS float* gl) {
    const int c = lane & 3;
    f32x4 g[4];
#pragma unroll
    for (int m = 0; m < 4; ++m) g[m] = t.useg ? *(const LAS f32x4*)(gl + t.k0 + 16 * c + 4 * m) * 32.f : (f32x4){32.f, 32.f, 32.f, 32.f};
#pragma unroll
    for (int j = 0; j < 2; ++j) { const int n = (lane >> 2) + 16 * j; const LAS float* sp = buf + (16 * c) * 32 + ((n + 8 * c) & 31);
        v4u o;
        o.x = pk4_fp8(sp[0 * 32] * g[0][0], sp[1 * 32] * g[0][1], sp[2 * 32] * g[0][2], sp[3 * 32] * g[0][3]);   o.y = pk4_fp8(sp[4 * 32] * g[1][0], sp[5 * 32] * g[1][1], sp[6 * 32] * g[1][2], sp[7 * 32] * g[1][3]);
        o.z = pk4_fp8(sp[8 * 32] * g[2][0], sp[9 * 32] * g[2][1], sp[10 * 32] * g[2][2], sp[11 * 32] * g[2][3]); o.w = pk4_fp8(sp[12 * 32] * g[3][0], sp[13 * 32] * g[3][1], sp[14 * 32] * g[3][2], sp[15 * 32] * g[3][3]);
        *(v4u*)(t.WT + (size_t)(t.n0 + n) * DM + t.k0 + 16 * c) = o; }
}
__device__ __forceinline__ void convert_experts_dma(const float* w1, const float* w2, bf16_t* W1T, bf16_t* W2T, int first, int stride, int N_END, int lane_, unsigned lds0, const LAS float* buf0, const LAS float* gl) {
    int lane = lane_; asm volatile("" : "+v"(lane));
    int it = first;
    if (it < N_END) { const CvtItem t = cvt_item(w1, w2, W1T, W2T, it); cvt_issue(t, lane, lds0); }
#pragma unroll 1
    for (; it < N_END; it += 2 * stride) {
        const int nx = it + stride, nn = it + 2 * stride;
        if (nx < N_END) { const CvtItem t = cvt_item(w1, w2, W1T, W2T, nx); cvt_issue(t, lane, lds0 + 8192); asm volatile("s_waitcnt vmcnt(8)" ::: "memory"); } else asm volatile("s_waitcnt vmcnt(0)" ::: "memory");
        { const CvtItem t = cvt_item(w1, w2, W1T, W2T, it); cvt_finish(t, lane, buf0, gl); }
        if (nx < N_END) {
            asm volatile("s_waitcnt lgkmcnt(0)" ::: "memory");
            if (nn < N_END) { const CvtItem t = cvt_item(w1, w2, W1T, W2T, nn); cvt_issue(t, lane, lds0); asm volatile("s_waitcnt vmcnt(8)" ::: "memory"); } else asm volatile("s_waitcnt vmcnt(0)" ::: "memory");
            { const CvtItem t = cvt_item(w1, w2, W1T, W2T, nx); cvt_finish(t, lane, buf0 + 2048, gl); }
            asm volatile("s_waitcnt lgkmcnt(0)" ::: "memory");
        }
    }
    asm volatile("s_waitcnt vmcnt(0)" ::: "memory");
}

__device__ __forceinline__ float log_sigmoid(float v) { return fminf(v, 0.f) - log1pf(expf(-fabsf(v))); }
__device__ __forceinline__ void rms1_row(const float4 (&v)[4], const LAS float* wf  , const float* __restrict__ b_f,
                                         bf16_t* __restrict__ XN, float* __restrict__ FLOG, int row, int lane) {
    float ss = 0.f;
#pragma unroll
    for (int j = 0; j < 4; ++j) ss += v[j].x * v[j].x + v[j].y * v[j].y + v[j].z * v[j].z + v[j].w * v[j].w;
    ss = wave_sum(ss);
    const float rstd = rsqrtf(ss * (1.f / DM) + EPS);
    float fg[8];
#pragma unroll
    for (int g = 0; g < 8; ++g) fg[g] = 0.f;
#pragma unroll
    for (int j = 0; j < 4; ++j) {
        const int c0 = 4 * (lane + 64 * j);
        uint2 o; o.x = pk2(v[j].x * rstd, v[j].y * rstd); o.y = pk2(v[j].z * rstd, v[j].w * rstd);
        *(uint2*)(XN + (size_t)row * DM + c0) = o;
#pragma unroll
        for (int g = 0; g < 8; ++g) { const f32x4 w = *(const LAS f32x4*)(wf + g * DM + c0);
            fg[g] += v[j].x * w[0] + v[j].y * w[1] + v[j].z * w[2] + v[j].w * w[3]; }
    }
    const bool b0 = lane & 1, b1 = lane & 2, b2 = lane & 4;
    float g4[4], h2[2];
#pragma unroll
    for (int i = 0; i < 4; ++i) g4[i] = (b0 ? fg[2 * i + 1] : fg[2 * i]) + __shfl_xor(b0 ? fg[2 * i] : fg[2 * i + 1], 1);
#pragma unroll
    for (int i = 0; i < 2; ++i) h2[i] = (b1 ? g4[2 * i + 1] : g4[2 * i]) + __shfl_xor(b1 ? g4[2 * i] : g4[2 * i + 1], 2);
    float f = (b2 ? h2[1] : h2[0]) + __shfl_xor(b2 ? h2[0] : h2[1], 4);
    f += __shfl_xor(f, 8); f += __shfl_xor(f, 16); f += __shfl_xor(f, 32);
    if (lane < 8) FLOG[(size_t)row * 8 + lane] = log_sigmoid(f * rstd + b_f[lane]);
}
__device__ __forceinline__ void cumsum_wg(const float* __restrict__ FLOG, float* __restrict__ CUM, int bh, LAS float* part) {
    const int b = bh >> 3, h = bh & 7, t = threadIdx.x;
    float loc[8]; float s = 0.f;
#pragma unroll
    for (int i = 0; i < 8; ++i) { loc[i] = FLOG[((size_t)b * SEQ + t * 8 + i) * 8 + h]; s += loc[i]; }
    part[t] = s; __syncthreads();
    float run = 0.f; for (int i = 0; i < t; ++i) run += part[i];
#pragma unroll
    for (int i = 0; i < 8; ++i) { run += loc[i]; CUM[(size_t)bh * SEQ + t * 8 + i] = run * LOG2E; }
    __syncthreads();
}

template <int NT> __device__ __forceinline__ void wave_mma(f32x4 (&acc)[NT], const bf16_t* ap, const bf16_t* const (&bp)[NT], int K) {
    for (int k0 = 0; k0 < K; k0 += 32) {
        const bf16x8 a = *(const bf16x8*)(ap + k0);
#pragma unroll
        for (int t = 0; t < NT; ++t) { const bf16x8 b = *(const bf16x8*)(bp[t] + k0); acc[t] = __builtin_amdgcn_mfma_f32_16x16x32_bf16(a, b, acc[t], 0, 0, 0); }
    }
}
__device__ __forceinline__ void nv_inproj(const bf16_t* __restrict__ XN, const bf16_t* __restrict__ WINT, bf16_t* __restrict__ PROJ, int item, int lane) {
    const int n0 = (item % 48) * 64, m0 = (item / 48) * 16, r = lane & 15, q = lane >> 4;
    f32x4 acc[4];
#pragma unroll
    for (int t = 0; t < 4; ++t) acc[t] = (f32x4){0.f, 0.f, 0.f, 0.f};
    const bf16_t* ap = XN + (size_t)(m0 + r) * DM + 8 * q;
    const bf16_t* bp[4];
#pragma unroll
    for (int t = 0; t < 4; ++t) bp[t] = WINT + (size_t)(n0 + 16 * t + r) * DM + 8 * q;
    wave_mma<4>(acc, ap, bp, DM);
    const float sc = (n0 < 512 || (n0 >= 1536 && n0 < 2048)) ? C2 : 1.f;
#pragma unroll
    for (int t = 0; t < 4; ++t)
#pragma unroll
        for (int j = 0; j < 4; ++j) PROJ[(size_t)(m0 + 4 * q + j) * NPROJ + n0 + 16 * t + r] = f2bf(acc[t][j] * sc);
}

template <int TYPE> __device__ __forceinline__ void nv_attn(const bf16_t* __restrict__ PROJ, const float* __restrict__ CUM, bf16_t* __restrict__ OMIX, float* __restrict__ SSQ,
                                                          int bh, int qblk, int lane, LAS unsigned char* wl) {
    LAS bf16_t* Ks = (LAS bf16_t*)wl; LAS bf16_t* Vs = (LAS bf16_t*)(wl + 8192); LAS float* Cs = (LAS float*)(wl + 16384);
    const int b = bh >> 3, h = bh & 7, t = qblk * 64 + lane;
    const size_t row = (size_t)b * SEQ + t;
    const int qcol = (TYPE == 0 ? 0 : 1536) + h * HD, kcol = qcol + 512, vcol = qcol + 1024;
    float q[64], o[64];
#pragma unroll
    for (int c = 0; c < 8; ++c) { const bf16x8 v = *(const bf16x8*)(PROJ + row * NPROJ + qcol + 8 * c);
#pragma unroll
        for (int j = 0; j < 8; ++j) q[8 * c + j] = bf2f((unsigned short)v[j]); }
#pragma unroll
    for (int d = 0; d < 64; ++d) o[d] = 0.f;
    float m = -INFINITY, l = 0.f, R = 1.f;
    const float cq = CUM[(size_t)bh * SEQ + t];
    for (int it = 0; it <= qblk; ++it) {
        const int kt = (TYPE == 0) ? it : qblk - it;
        LDS_WAIT();
        for (int i = 0; i < 64; ++i) { const size_t kr = ((size_t)b * SEQ + kt * 64 + i) * NPROJ; Ks[i * 64 + lane] = PROJ[kr + kcol + lane]; Vs[i * 64 + lane] = PROJ[kr + vcol + lane]; }
        Cs[lane] = CUM[(size_t)bh * SEQ + kt * 64 + lane];
        LDS_WAIT();
        for (int ss = 0; ss < 64; ++ss) {
            const int s = (TYPE == 0) ? ss : 63 - ss; const int ks = kt * 64 + s;
            float dot = 0.f;
#pragma unroll
            for (int d = 0; d < 64; d += 8) { const bf16x8 kv = *(const LAS bf16x8*)&Ks[s * 64 + d];
#pragma unroll
                for (int j = 0; j < 8; ++j) dot += q[d + j] * bf2f((unsigned short)kv[j]); }
            if (TYPE == 0) {
                if (ks <= t) {
                    const float xv = dot + cq - Cs[s]; const float mn = fmaxf(m, xv); const float sc = exp2f(m - mn), p = exp2f(xv - mn);
                    l = l * sc + p; m = mn;
#pragma unroll
                    for (int d = 0; d < 64; d += 8) { const bf16x8 vv = *(const LAS bf16x8*)&Vs[s * 64 + d];
#pragma unroll
                        for (int j = 0; j < 8; ++j) o[d + j] = o[d + j] * sc + p * bf2f((unsigned short)vv[j]); }
                }
            } else {
                if (ks < t) {
                    const float z = fminf(fmaxf(dot, -80.f), 80.f); const float e = exp2f(z); const float rr = 1.f / (1.f + e); const float a = e * rr * R; R *= rr;
#pragma unroll
                    for (int d = 0; d < 64; d += 8) { const bf16x8 vv = *(const LAS bf16x8*)&Vs[s * 64 + d];
#pragma unroll
                        for (int j = 0; j < 8; ++j) o[d + j] += a * bf2f((unsigned short)vv[j]); }
                }
            }
        }
    }
    const float inv = (TYPE == 0) ? 1.f / l : 1.f;
    float ssq = 0.f;
#pragma unroll
    for (int d = 0; d < 64; ++d) { o[d] *= inv; ssq += o[d] * o[d]; }
    SSQ[row * 16 + TYPE * 8 + h] = ssq;
#pragma unroll
    for (int c = 0; c < 8; ++c) { bf16x8 v;
#pragma unroll
        for (int j = 0; j < 8; ++j) v[j] = (short)f2bf(o[8 * c + j]);
        *(bf16x8*)(OMIX + row * DM + TYPE * GW + h * HD + 8 * c) = v; }
}

__device__ __forceinline__ void nv_wout(const bf16_t* __restrict__ OMIX, const bf16_t* __restrict__ WOUTT, const float* __restrict__ SSQ, const float* __restrict__ x,
                                        float* __restrict__ X1, bf16_t* __restrict__ X1B, int item, int lane) {
    const int n0 = (item & 15) * 64, m0 = (item >> 4) * 16, r = lane & 15, q = lane >> 4;
    f32x4 af[4], as[4];
#pragma unroll
    for (int t = 0; t < 4; ++t) { af[t] = (f32x4){0.f, 0.f, 0.f, 0.f}; as[t] = (f32x4){0.f, 0.f, 0.f, 0.f}; }
    const bf16_t* ap = OMIX + (size_t)(m0 + r) * DM + 8 * q;
    const bf16_t* bp[4]; const bf16_t* bp2[4];
#pragma unroll
    for (int t = 0; t < 4; ++t) { bp[t] = WOUTT + (size_t)(n0 + 16 * t + r) * DM + 8 * q; bp2[t] = bp[t] + GW; }
    wave_mma<4>(af, ap, bp, GW);
    wave_mma<4>(as, ap + GW, bp2, GW);
#pragma unroll
    for (int j = 0; j < 4; ++j) {
        const size_t row = m0 + 4 * q + j; const float* sp = SSQ + row * 16;
        float sf = 0.f, s2 = 0.f;
#pragma unroll
        for (int h = 0; h < 8; ++h) { sf += sp[h]; s2 += sp[8 + h]; }
        const float rf = rsqrtf(sf * (1.f / GW) + EPS), rs = rsqrtf(s2 * (1.f / GW) + EPS);
#pragma unroll
        for (int t = 0; t < 4; ++t) { const size_t idx = row * DM + n0 + 16 * t + r; const float v = x[idx] + rf * af[t][j] + rs * as[t][j]; X1[idx] = v; X1B[idx] = f2bf(v); }
    }
}

__device__ __forceinline__ void nv_router(const float* __restrict__ X1, const float* __restrict__ WR, const float* __restrict__ b_router, float* __restrict__ RSTD2,
                                          float* __restrict__ RW, int* __restrict__ LIST, int* __restrict__ SLOTEP, unsigned* __restrict__ CNT, int item, int lane) {
    const int e = lane & 31, tok = item * 2 + (lane >> 5);
    const float* xr = X1 + (size_t)tok * DM;
    float acc = 0.f, ss = 0.f;
    for (int k = 0; k < DM; ++k) { const float xv = xr[k]; acc += xv * WR[k * NE + e]; ss += xv * xv; }
    const float rstd = rsqrtf(ss * (1.f / DM) + EPS);
    float logit = acc * rstd + b_router[e];
    if (e == 0) RSTD2[tok] = rstd;
    float tv[4]; int ti[4];
#pragma unroll
    for (int k = 0; k < 4; ++k) {
        float bv = logit; int bi = e;
#pragma unroll
        for (int o = 1; o < 32; o <<= 1) { const float ov = __shfl_xor(bv, o); const int oi = __shfl_xor(bi, o); if (ov > bv || (ov == bv && oi < bi)) { bv = ov; bi = oi; } }
        tv[k] = bv; ti[k] = bi; if (e == bi) logit = -INFINITY;
    }
    const float e0 = 1.f, e1 = expf(tv[1] - tv[0]), e2 = expf(tv[2] - tv[0]), e3 = expf(tv[3] - tv[0]); const float inv = 1.f / (e0 + e1 + e2 + e3);
    const float w0 = e0 * inv, w1 = e1 * inv, w2 = e2 * inv, w3 = e3 * inv;
    int myk = -1; float myw = 0.f;
    if (e == ti[0]) { myk = 0; myw = w0; } if (e == ti[1]) { myk = 1; myw = w1; } if (e == ti[2]) { myk = 2; myw = w2; } if (e == ti[3]) { myk = 3; myw = w3; }
    if (myk >= 0) { const int slot = tok * 4 + myk; const unsigned pos = atomicAdd(&CNT[e], 1u); LIST[(size_t)e * LIST_CAP + pos] = slot; RW[slot] = myw; SLOTEP[slot] = e * 16384 + (int)pos; }
}


typedef float f32x16 __attribute__((ext_vector_type(16)));
__device__ __forceinline__ void router_wg(const float* __restrict__ X1, const float* __restrict__ WR, const float* __restrict__ b_router, float* __restrict__ RSTD2,
                                          float* __restrict__ RW, int* __restrict__ LIST, int* __restrict__ SLOTEP, unsigned* __restrict__ CNT, int tokbase, LAS unsigned char* L) {
    int tid_ = threadIdx.x; asm volatile("" : "+v"(tid_));
    const int tid = tid_, lane = tid & 63, wave = __builtin_amdgcn_readfirstlane(tid >> 6), kq = wave & 3, tile = wave >> 2, r32 = lane & 31, hi = lane >> 5;
    LAS float* Dx = (LAS float*)L; LAS float* SSx = (LAS float*)(L + 32768); LAS unsigned* lcnt = (LAS unsigned*)(L + 33792); LAS unsigned* lbase = (LAS unsigned*)(L + 33920);
    if (tid < NE) lcnt[tid] = 0u;
    const int tok = tokbase + tile * 32 + r32;
    const float* xp = X1 + (size_t)tok * DM + kq * 256 + 4 * hi;
    const float* wp = WR + (size_t)(kq * 256 + 4 * hi) * NE + r32;
    f32x16 acc;
#pragma unroll
    for (int r = 0; r < 16; ++r) acc[r] = 0.f;
    float ss = 0.f;
#pragma unroll 1
    for (int mc = 0; mc < 4; ++mc) {
        float4 xv[8];
#pragma unroll
        for (int m = 0; m < 8; ++m) xv[m] = *(const float4*)(xp + (mc * 8 + m) * 8);
#pragma unroll
        for (int m = 0; m < 8; ++m) {
            const float* w4 = wp + (size_t)((mc * 8 + m) * 8) * NE;
            const float w0 = w4[0], w1 = w4[NE], w2 = w4[2 * NE], w3 = w4[3 * NE];
            acc = __builtin_amdgcn_mfma_f32_32x32x2f32(w0, xv[m].x, acc, 0, 0, 0);
            acc = __builtin_amdgcn_mfma_f32_32x32x2f32(w1, xv[m].y, acc, 0, 0, 0);
            acc = __builtin_amdgcn_mfma_f32_32x32x2f32(w2, xv[m].z, acc, 0, 0, 0);
            acc = __builtin_amdgcn_mfma_f32_32x32x2f32(w3, xv[m].w, acc, 0, 0, 0);
            ss += xv[m].x * xv[m].x + xv[m].y * xv[m].y + xv[m].z * xv[m].z + xv[m].w * xv[m].w;
        }
    }
    { auto rr = __builtin_amdgcn_permlane32_swap(__float_as_uint(ss), __float_as_uint(ss), false, false); ss = __uint_as_float(rr[0]) + __uint_as_float(rr[1]); }
#pragma unroll
    for (int r = 0; r < 16; ++r) Dx[(wave * 16 + r) * 64 + lane] = acc[r];
    if (hi == 0) SSx[wave * 32 + r32] = ss;
    LDS_WAIT(); __syncthreads();
    int ea = 0, eb = 0; float wa = 0.f, wb = 0.f; unsigned la = 0u, lb = 0u;
    if (kq == 0) {
        float v[16]; float sst = 0.f;
#pragma unroll
        for (int w = 0; w < 4; ++w) sst += SSx[(tile * 4 + w) * 32 + r32];
        const float rstd = rsqrtf(sst * (1.f / DM) + EPS);
#pragma unroll
        for (int r = 0; r < 16; ++r) { float a = 0.f;
#pragma unroll
            for (int w = 0; w < 4; ++w) a += Dx[((tile * 4 + w) * 16 + r) * 64 + lane];
            v[r] = a * rstd + b_router[(r & 3) + 8 * (r >> 2) + 4 * hi]; }
        if (hi == 0) RSTD2[tok] = rstd;
        float tv[4]; int te[4];
#pragma unroll
        for (int k = 0; k < 4; ++k) {
            float bv = v[0]; int br = 0;
#pragma unroll
            for (int r = 1; r < 16; ++r) if (v[r] > bv) { bv = v[r]; br = r; }
            const int be = (br & 3) + 8 * (br >> 2) + 4 * hi;
            auto r1 = __builtin_amdgcn_permlane32_swap(__float_as_uint(bv), __float_as_uint(bv), false, false);
            auto r2 = __builtin_amdgcn_permlane32_swap((unsigned)be, (unsigned)be, false, false);
            const float pv = __uint_as_float(hi ? r1[0] : r1[1]); const int pe = (int)(hi ? r2[0] : r2[1]);
            const bool mine = (bv > pv) || (bv == pv && be < pe);
            tv[k] = mine ? bv : pv; te[k] = mine ? be : pe;
#pragma unroll
            for (int r = 0; r < 16; ++r) v[r] = (mine && r == br) ? -INFINITY : v[r];
        }
        const float e1 = expf(tv[1] - tv[0]), e2 = expf(tv[2] - tv[0]), e3 = expf(tv[3] - tv[0]); const float inv = 1.f / (1.f + e1 + e2 + e3);
        ea = hi ? te[2] : te[0]; eb = hi ? te[3] : te[1]; wa = (hi ? e2 : 1.f) * inv; wb = (hi ? e3 : e1) * inv;
        la = atomicAdd((unsigned*)&lcnt[ea], 1u); lb = atomicAdd((unsigned*)&lcnt[eb], 1u);
    }
    LDS_WAIT(); __syncthreads();
    if (tid < NE) { const unsigned c = lcnt[tid]; lbase[tid] = c ? atomicAdd(&CNT[tid], c) : 0u; }
    LDS_WAIT(); __syncthreads();
    if (kq == 0) {
        const int sa = tok * 4 + 2 * hi, sb = sa + 1;
        const int pa = (int)(lbase[ea] + la), pb = (int)(lbase[eb] + lb);
        LIST[(size_t)ea * LIST_CAP + pa] = sa; RW[sa] = wa; SLOTEP[sa] = ea * 16384 + pa;
        LIST[(size_t)eb * LIST_CAP + pb] = sb; RW[sb] = wb; SLOTEP[sb] = eb * 16384 + pb;
    }
    LDS_WAIT(); __syncthreads();
}

__device__ __forceinline__ bool moe_tile(const unsigned* CNT, int g, int& e, int& base, int& p0, int& cnt) {
    const int tile256 = g >> 4; base = 0;
    for (e = 0; e < NE; ++e) { const int nt = ((int)CNT[e] + 255) >> 8; if (tile256 < base + nt) break; base += nt; }
    if (e == NE) return false;
    cnt = (int)CNT[e]; p0 = (g - base * 16) * 16; return p0 < cnt;
}
__device__ __forceinline__ void nv_moe1(const bf16_t* __restrict__ X1B, const bf16_t* __restrict__ W1T, const float* __restrict__ b1, const float* __restrict__ RSTD2,
                                        const int* __restrict__ LIST, bf16_t* __restrict__ H, int e, int base, int p0, int cnt, int cg, int lane) {
    const int r = lane & 15, q = lane >> 4, c0 = cg * 32, pn = c0 >> 7, j0 = c0 & 127;
    const int* lst = LIST + (size_t)e * LIST_CAP;
    const int prow = p0 + r; const int tok = lst[prow < cnt ? prow : cnt - 1] >> 2;
    f32x4 acc[4];
#pragma unroll
    for (int t = 0; t < 4; ++t) acc[t] = (f32x4){0.f, 0.f, 0.f, 0.f};
    const bf16_t* ap = X1B + (size_t)tok * DM + 8 * q;
    const bf16_t* wb = W1T + (size_t)e * 2048 * DM + (size_t)(256 * pn + j0 + r) * DM + 8 * q;
    const bf16_t* bp[4] = {wb, wb + 16 * DM, wb + 128 * DM, wb + 144 * DM};
    wave_mma<4>(acc, ap, bp, DM);
#pragma unroll
    for (int j = 0; j < 4; ++j) {
        const int pr = p0 + 4 * q + j; if (pr >= cnt) continue;
        const float rs = RSTD2[lst[pr] >> 2];
#pragma unroll
        for (int t = 0; t < 2; ++t) {
            const int col = c0 + 16 * t + r;
            float glu = acc[t][j] * rs + b1[(size_t)e * 2048 + col], lin = acc[t + 2][j] * rs + b1[(size_t)e * 2048 + 1024 + col];
            glu = fminf(glu, 7.f); lin = fminf(fmaxf(lin, -7.f), 7.f);
            const float act = glu * (1.f / (1.f + expf(-1.702f * glu))) * (lin + 1.f);
            H[((size_t)base * 256 + pr) * DM + col] = f2bf(act);
        }
    }
}
__device__ __forceinline__ void nv_moe2(const bf16_t* __restrict__ H, const bf16_t* __restrict__ W2T, const float* __restrict__ b2, const float* __restrict__ RW,
                                        const int* __restrict__ LIST, bf16_t* __restrict__ Y, int e, int base, int p0, int cnt, int cg, int lane) {
    const int r = lane & 15, q = lane >> 4, n0 = cg * 64;
    const int* lst = LIST + (size_t)e * LIST_CAP;
    f32x4 acc[4];
#pragma unroll
    for (int t = 0; t < 4; ++t) acc[t] = (f32x4){0.f, 0.f, 0.f, 0.f};
    const bf16_t* ap = H + ((size_t)base * 256 + p0 + r) * DM + 8 * q;
    const bf16_t* bp[4];
#pragma unroll
    for (int t = 0; t < 4; ++t) bp[t] = W2T + (size_t)e * DM * DM + (size_t)(n0 + 16 * t + r) * DM + 8 * q;
    wave_mma<4>(acc, ap, bp, DM);
#pragma unroll
    for (int j = 0; j < 4; ++j) {
        const int pr = p0 + 4 * q + j; if (pr >= cnt) continue;
        const int slot = lst[pr]; const float w = RW[slot];
#pragma unroll
        for (int t = 0; t < 4; ++t) { const int col = n0 + 16 * t + r; Y[((size_t)base * 256 + pr) * DM + col] = f2bf((acc[t][j] + b2[(size_t)e * DM + col]) * w); }
    }
}

__device__ __forceinline__ void final_row(const float* X1, const bf16_t* __restrict__ Y, const int* __restrict__ SLOTEP, const int* __restrict__ TBG, const float* __restrict__ gf, float* out, int row, int lane) {
    int yr[4];
#pragma unroll
    for (int k = 0; k < 4; ++k) { const int ep = SLOTEP[row * 4 + k]; yr[k] = TBG[ep >> 14] * 256 + (ep & 16383); }
    float ss = 0.f;
    if (Y_F8) {
        const int c0 = 16 * lane; f32x4 v[4];
#pragma unroll
        for (int j = 0; j < 4; ++j) v[j] = *(const f32x4*)(X1 + (size_t)row * DM + c0 + 4 * j);
#pragma unroll
        for (int k = 0; k < 4; ++k) { const v4u y = *(const v4u*)((const unsigned char*)Y + (size_t)yr[k] * DM + c0);
#pragma unroll
            for (int j = 0; j < 4; ++j) { const auto lo = __builtin_amdgcn_cvt_pk_f32_fp8((int)y[j], false), hi = __builtin_amdgcn_cvt_pk_f32_fp8((int)y[j], true);
                v[j][0] += lo[0] * 0.0625f; v[j][1] += lo[1] * 0.0625f; v[j][2] += hi[0] * 0.0625f; v[j][3] += hi[1] * 0.0625f; } }
#pragma unroll
        for (int j = 0; j < 4; ++j) ss += v[j][0] * v[j][0] + v[j][1] * v[j][1] + v[j][2] * v[j][2] + v[j][3] * v[j][3];
        ss = wave_sum(ss);
        const float rstd = rsqrtf(ss * (1.f / DM) + EPS);
#pragma unroll
        for (int j = 0; j < 4; ++j) { const f32x4 g = *(const f32x4*)(gf + c0 + 4 * j); *(f32x4*)(out + (size_t)row * DM + c0 + 4 * j) = v[j] * rstd * g; }
        return;
    }
    float4 v[4];
#pragma unroll
    for (int j = 0; j < 4; ++j) {
        const int c0 = 4 * (lane + 64 * j);
        v[j] = *(const float4*)(X1 + (size_t)row * DM + c0);
#pragma unroll
        for (int k = 0; k < 4; ++k) { const uint2 y = *(const uint2*)(Y + (size_t)yr[k] * DM + c0);
            v[j].x += bf2f((unsigned short)(y.x & 0xffff)); v[j].y += bf2f((unsigned short)(y.x >> 16)); v[j].z += bf2f((unsigned short)(y.y & 0xffff)); v[j].w += bf2f((unsigned short)(y.y >> 16)); }
        ss += v[j].x * v[j].x + v[j].y * v[j].y + v[j].z * v[j].z + v[j].w * v[j].w;
    }
    ss = wave_sum(ss);
    const float rstd = rsqrtf(ss * (1.f / DM) + EPS);
#pragma unroll
    for (int j = 0; j < 4; ++j) { const int c0 = 4 * (lane + 64 * j); const float4 g = *(const float4*)(gf + c0);
        float4 o; o.x = v[j].x * rstd * g.x; o.y = v[j].y * rstd * g.y; o.z = v[j].z * rstd * g.z; o.w = v[j].w * rstd * g.w; *(float4*)(out + (size_t)row * DM + c0) = o; }
}


namespace pg8 {
#define PG8_LAS __attribute__((address_space(3)))
typedef unsigned u32x4 __attribute__((ext_vector_type(4)));
typedef unsigned u32x2 __attribute__((ext_vector_type(2)));
typedef int i32x8 __attribute__((ext_vector_type(8)));
constexpr int BM = 256, BK = 64, HALF = 128, HTB = HALF * BK * 2  , STAGE_BYTES = 8 * HTB, NXCD = 8, WGM = 8;
__host__ __device__ __forceinline__ int lds_byte(int r, int c) { const int st = (r >> 4) * 2 + (c >> 5), rr = r & 15, cc = c & 31, ob = rr * 64 + cc * 2; return st * 1024 + (ob ^ (((ob >> 9) & 1) << 5)); }
__host__ __device__ __forceinline__ void stage_rc(int b, int& R, int& C) { const int st = b / 1024, sb = b % 1024, swz = sb ^ (((sb >> 9) & 1) << 5); R = (st >> 1) * 16 + swz / 64; C = (st & 1) * 32 + (swz % 64) / 2; }
__host__ __device__ __forceinline__ int perm32(int rho) { const int n = rho >> 4, i = rho & 15; return 8 * (i >> 2) + 4 * n + (i & 3); }
struct Unit { int pm, pn, nr; };
struct Gemm { const bf16_t* A; const bf16_t* Bt; int K; };
__device__ __forceinline__ void st16_wt(void* p, u32x4 v) { if (WT_STORES) asm volatile("global_store_dwordx4 %0, %1, off sc0 sc1\n\ts_nop 1" :: "v"(p), "v"(v) : "memory"); else *(u32x4*)p = v; }
__device__ __forceinline__ void st8_wt(void* p, u32x2 v) { if (WT_STORES) asm volatile("global_store_dwordx2 %0, %1, off sc0 sc1\n\ts_nop 1" :: "v"(p), "v"(v) : "memory"); else *(u32x2*)p = v; }
struct StaticOrder {
    int nM, nN, nwg, G, c;
    __device__ void init(int M_, int N_, int G_, int c_) { nM = M_ / BM; nN = N_ / BM; nwg = nM * nN; G = G_; c = c_; }
    __device__ bool next(int i, Unit& u) const {
        const long L = (long)i * G + c; if (L >= nwg) return false;
        int wgid = (int)L; { const int q = nwg / NXCD, r = nwg % NXCD, xcd = wgid % NXCD, off = wgid / NXCD; wgid = (xcd < r ? xcd * (q + 1) : r * (q + 1) + (xcd - r) * q) + off; }
        const int nig = WGM * nN, gid = wgid / nig, fm = gid * WGM, gsz = (nM - fm) < WGM ? (nM - fm) : WGM;
        u.pm = fm + ((wgid % nig) % gsz); u.pn = (wgid % nig) / gsz; u.nr = BM; return true;
    }
    __device__ __forceinline__ const PG8_LAS int* rowtab(int) const { return nullptr; }
};
__device__ __forceinline__ unsigned cvt_pk_bf16(float lo, float hi) { unsigned r; asm volatile("v_cvt_pk_bf16_f32 %0, %1, %2" : "=v"(r) : "v"(lo), "v"(hi)); return r; }

template <class Sched> __device__ __forceinline__ void gather_voffs(const Sched& S, int ui, int tid, int K, unsigned (&o0)[2], unsigned (&o1)[2]) {
    const PG8_LAS int* tab = S.rowtab(ui);
#pragma unroll
    for (int i = 0; i < 2; ++i) { int R, C; stage_rc(tid * 16 + i * 8192, R, C); o0[i] = (unsigned)((tab[R] & 0xffff) * K + C) * 2u; o1[i] = (unsigned)((tab[HALF + R] & 0xffff) * K + C) * 2u; }
}

template <class Epi, class Sched, bool ALIGN_EPI, bool GATHER, bool F8 = false>
__device__ __forceinline__ void gemm_phase(PG8_LAS unsigned char* lds, const Gemm g, const Sched& S, const Epi& E) {
    int tid_ = threadIdx.x; asm volatile("" : "+v"(tid_));
    const int tid = tid_, wid = __builtin_amdgcn_readfirstlane(tid >> 6), lane = tid & 63, wr = wid >> 2, wc = wid & 3, fr = lane & 15, fq = lane >> 4;
    const int K = g.K, nt = K / BK;
    unsigned vA0[2], vA1[2], wA0[2], wA1[2], voffB[2];
    const size_t kstep = (size_t)(BK * 2);
    const size_t hstep = (size_t)HALF * K * 2;
    const size_t tstep = 2 * hstep;
#pragma unroll
    for (int i = 0; i < 2; ++i) { int R, C; stage_rc(tid * 16 + i * 8192, R, C); const int Rb = Epi::PERM ? ((R & ~31) + perm32(R & 31)) : R;
        vA0[i] = (unsigned)(R * K + C) * 2u; vA1[i] = vA0[i] + (unsigned)hstep; voffB[i] = (unsigned)(Rb * K + C) * 2u; wA0[i] = vA0[i]; wA1[i] = vA1[i]; }
    const unsigned ldsw = (unsigned)wid * 1024u;
    const int aoff = lds_byte(wr * 64 + fr, fq * 8), boff = lds_byte(wc * 32 + fr, fq * 8);
    const int a8o0 = lds_byte(wr * 64 + fr, fq * 16), a8o1 = lds_byte(wr * 64 + fr, fq * 16 + 8), b8o0 = lds_byte(wc * 32 + fr, fq * 16), b8o1 = lds_byte(wc * 32 + fr, fq * 16 + 8);
#define PG8_SA(b, h) (((b) * 2 + (h)) * HTB)
#define PG8_SB(b, h) ((4 + (b) * 2 + (h)) * HTB)
#define PG8_STAGE(bufoff, gbase, voff) do { _Pragma("unroll") for (int _i = 0; _i < 2; ++_i) \
        __builtin_amdgcn_global_load_lds((const unsigned*)((const char*)(gbase) + (voff)[_i]), (PG8_LAS unsigned*)(lds + (bufoff) + ldsw + _i * 8192), 16, 0, 0); } while (0)
#define PG8_LDA_BF(dst, b, h) do { _Pragma("unroll") for (int m = 0; m < 4; ++m) _Pragma("unroll") for (int k = 0; k < 2; ++k) dst[m][k] = *(const PG8_LAS bf16x8*)(lds + PG8_SA(b, h) + aoff + m * 2048 + k * 1024); } while (0)
#define PG8_LDB_BF(dst, b, h) do { _Pragma("unroll") for (int n = 0; n < 2; ++n) _Pragma("unroll") for (int k = 0; k < 2; ++k) dst[n][k] = *(const PG8_LAS bf16x8*)(lds + PG8_SB(b, h) + boff + n * 2048 + k * 1024); } while (0)
#define PG8_MMA_BF(ai, bj, At, Bt) do { if (cur.nr > 128 * (ai) + 64 * wr) { __builtin_amdgcn_s_setprio(1); _Pragma("unroll") for (int m = 0; m < 4; ++m) _Pragma("unroll") for (int n = 0; n < 2; ++n) _Pragma("unroll") for (int k = 0; k < 2; ++k) \
        acc[ai][bj][m][n] = __builtin_amdgcn_mfma_f32_16x16x32_bf16(Bt[n][k], At[m][k], acc[ai][bj][m][n], 0, 0, 0); __builtin_amdgcn_s_setprio(0); } } while (0)
#define PG8_LD8(dst, i_, base_, o0_, o1_) do { const u32x4 lo_ = *(const PG8_LAS u32x4*)(lds + (base_) + (o0_) + (i_) * 2048), hi_ = *(const PG8_LAS u32x4*)(lds + (base_) + (o1_) + (i_) * 2048); \
        dst[i_] = (i32x8){(int)lo_.x, (int)lo_.y, (int)lo_.z, (int)lo_.w, (int)hi_.x, (int)hi_.y, (int)hi_.z, (int)hi_.w}; } while (0)
#define PG8_LDA_F8(dst, b, h) do { _Pragma("unroll") for (int m = 0; m < 4; ++m) PG8_LD8(dst, m, PG8_SA(b, h), a8o0, a8o1); } while (0)
#define PG8_LDB_F8(dst, b, h) do { _Pragma("unroll") for (int n = 0; n < 2; ++n) PG8_LD8(dst, n, PG8_SB(b, h), b8o0, b8o1); } while (0)
#define PG8_MMA_F8(ai, bj, At, Bt) do { if (cur.nr > 128 * (ai) + 64 * wr) { __builtin_amdgcn_s_setprio(1); _Pragma("unroll") for (int m = 0; m < 4; ++m) _Pragma("unroll") for (int n = 0; n < 2; ++n) \
        acc[ai][bj][m][n] = __builtin_amdgcn_mfma_scale_f32_16x16x128_f8f6f4(Bt[n], At[m], acc[ai][bj][m][n], 0, 0, 0, 0x7A7A7A7A  , 0, 0x7F7F7F7F  ); __builtin_amdgcn_s_setprio(0); } } while (0)
#define PG8_LDA(dst, b, h) do { if constexpr (F8) { PG8_LDA_F8(dst##8, b, h); } else { PG8_LDA_BF(dst, b, h); } } while (0)
#define PG8_LDB(dst, b, h) do { if constexpr (F8) { PG8_LDB_F8(dst##8, b, h); } else { PG8_LDB_BF(dst, b, h); } } while (0)
#define PG8_MMA(ai, bj, At, Bt) do { if constexpr (F8) { PG8_MMA_F8(ai, bj, At##8, Bt##8); } else { PG8_MMA_BF(ai, bj, At, Bt); } } while (0)
#define PG8_WAIT_V(n) asm volatile("s_waitcnt vmcnt(" #n ")" ::: "memory")
#define PG8_WAIT_L(n) asm volatile("s_waitcnt lgkmcnt(" #n ")" ::: "memory")
#define PG8_BAR __builtin_amdgcn_s_barrier()
#define PG8_SCHED __builtin_amdgcn_sched_barrier(0)
    Unit cur, nxt; int ui = 0;
    if (!S.next(0, cur)) return;
    f32x4 acc[2][2][4][2];
#pragma unroll
    for (int a = 0; a < 2; ++a)
#pragma unroll
        for (int b = 0; b < 2; ++b)
#pragma unroll
            for (int m = 0; m < 4; ++m)
#pragma unroll
                for (int n = 0; n < 2; ++n) acc[a][b][m][n] = (f32x4){0.f, 0.f, 0.f, 0.f};
    bf16x8 At[4][2], B0[2][2], B1[2][2]; i32x8 At8[4], B08[2], B18[2];
    const char* cA = GATHER ? (const char*)g.A : (const char*)g.A + (size_t)cur.pm * tstep; const char* cB = (const char*)g.Bt + (size_t)cur.pn * tstep;
    if constexpr (GATHER) gather_voffs(S, 0, tid, K, vA0, vA1);
    PG8_STAGE(PG8_SB(0, 0), cB, voffB); PG8_STAGE(PG8_SB(0, 1), cB + hstep, voffB); PG8_STAGE(PG8_SA(0, 0), cA, vA0); PG8_STAGE(PG8_SA(0, 1), cA, vA1);
    if (wr == 1) PG8_BAR;
    PG8_WAIT_V(2); PG8_BAR;
    PG8_STAGE(PG8_SB(1, 0), cB + kstep, voffB); PG8_STAGE(PG8_SA(1, 0), cA + kstep, vA0); PG8_STAGE(PG8_SB(1, 1), cB + hstep + kstep, voffB);
    PG8_WAIT_V(6); PG8_BAR;
    for (;;) {
        const bool has_next = S.next(ui + 1, nxt);
        const char* nA = GATHER ? cA : (has_next ? (const char*)g.A + (size_t)nxt.pm * tstep : cA); const char* nB = has_next ? (const char*)g.Bt + (size_t)nxt.pn * tstep : cB;
        if constexpr (GATHER) { if (has_next) gather_voffs(S, ui + 1, tid, K, wA0, wA1); else { wA0[0] = vA0[0]; wA0[1] = vA0[1]; wA1[0] = vA1[0]; wA1[1] = vA1[1]; } }
        for (int t = 0; t < nt; t += 2) {
            const bool last = (t == nt - 2);
            const char* a1 = cA + (size_t)(t + 1) * kstep;
            const char* a2 = last ? nA : cA + (size_t)(t + 2) * kstep; const char* b2 = last ? nB : cB + (size_t)(t + 2) * kstep;
            const char* a3 = a2 + kstep; const char* b3 = b2 + kstep;
            unsigned sA0[2], sA1[2];
#pragma unroll
            for (int i = 0; i < 2; ++i) { sA0[i] = (GATHER && last) ? wA0[i] : vA0[i]; sA1[i] = (GATHER && last) ? wA1[i] : vA1[i]; }
            if constexpr (Epi::MIDK) { if (t == nt / 2) E.midk(acc, wr, fr); }
            PG8_LDB(B0, 0, 0); PG8_LDB(B1, 0, 1); PG8_SCHED; PG8_LDA(At, 0, 0); PG8_STAGE(PG8_SA(1, 1), a1, vA1);
            PG8_WAIT_V(8); PG8_WAIT_L(0); PG8_BAR; PG8_MMA(0, 0, At, B0); PG8_MMA(0, 1, At, B1); PG8_BAR; PG8_SCHED;
            PG8_LDA(At, 0, 1); PG8_STAGE(PG8_SB(0, 0), b2, voffB); PG8_STAGE(PG8_SB(0, 1), b2 + hstep, voffB); PG8_STAGE(PG8_SA(0, 0), a2, sA0);
            PG8_WAIT_V(8); PG8_WAIT_L(0); PG8_BAR; PG8_MMA(1, 0, At, B0); PG8_MMA(1, 1, At, B1); PG8_BAR; PG8_SCHED;
            PG8_LDB(B0, 1, 0); PG8_LDB(B1, 1, 1); PG8_SCHED; PG8_LDA(At, 1, 0); PG8_STAGE(PG8_SA(0, 1), a2, sA1);
            PG8_WAIT_V(8); PG8_WAIT_L(0); PG8_BAR; PG8_MMA(0, 0, At, B0); PG8_MMA(0, 1, At, B1); PG8_BAR; PG8_SCHED;
            PG8_LDA(At, 1, 1); PG8_STAGE(PG8_SB(1, 0), b3, voffB); PG8_STAGE(PG8_SB(1, 1), b3 + hstep, voffB); PG8_STAGE(PG8_SA(1, 0), a3, sA0);
            PG8_WAIT_V(8); PG8_WAIT_L(0); PG8_BAR; PG8_MMA(1, 0, At, B0); PG8_MMA(1, 1, At, B1); PG8_BAR; PG8_SCHED;
        }
        if constexpr (ALIGN_EPI) { if (wr == 0) PG8_BAR; }
        E(acc, cur, ui, wr, wc, fr, fq);
        if (!has_next) break;
#pragma unroll
        for (int a = 0; a < 2; ++a)
#pragma unroll
            for (int b = 0; b < 2; ++b)
#pragma unroll
                for (int m = 0; m < 4; ++m)
#pragma unroll
                    for (int n = 0; n < 2; ++n) acc[a][b][m][n] = (f32x4){0.f, 0.f, 0.f, 0.f};
        cur = nxt; cA = nA; cB = nB; ++ui;
        if constexpr (GATHER) { vA0[0] = wA0[0]; vA0[1] = wA0[1]; vA1[0] = wA1[0]; vA1[1] = wA1[1]; }
        if constexpr (ALIGN_EPI) { if (wr == 1) PG8_BAR; }
    }
    PG8_WAIT_V(0);
    if constexpr (!ALIGN_EPI) { if (wr == 0) PG8_BAR; }
    PG8_BAR;
#undef PG8_SA
#undef PG8_SB
#undef PG8_STAGE
#undef PG8_LDA
#undef PG8_LDB
#undef PG8_MMA
#undef PG8_LDA_BF
#undef PG8_LDB_BF
#undef PG8_MMA_BF
#undef PG8_LD8
#undef PG8_LDA_F8
#undef PG8_LDB_F8
#undef PG8_MMA_F8
#undef PG8_WAIT_V
#undef PG8_WAIT_L
#undef PG8_BAR
#undef PG8_SCHED
}

struct EpiProj {
    static constexpr bool PERM = true, MIDK = false;
    bf16_t* O; unsigned* hp;
    __device__ __forceinline__ void operator()(const f32x4 (&acc)[2][2][4][2], const Unit& u, int, int wr, int wc, int fr, int fq) const {
        const int row0 = u.pm * BM + wr * 64 + fr, col0 = u.pn * BM + wc * 32 + 8 * fq;
        const float sc = (u.pn < 2 || (u.pn >= 6 && u.pn < 8)) ? C2 : 1.f;
        if (u.pn < 4) {
            float mx = 0.f;
#pragma unroll
            for (int ai = 0; ai < 2; ++ai)
#pragma unroll
                for (int m = 0; m < 4; ++m)
#pragma unroll
                    for (int bj = 0; bj < 2; ++bj) { const f32x4 a0 = acc[ai][bj][m][0] * sc, a1 = acc[ai][bj][m][1] * sc;
                        float q = a0[0] * a0[0] + a0[1] * a0[1] + a0[2] * a0[2] + a0[3] * a0[3] + a1[0] * a1[0] + a1[1] * a1[1] + a1[2] * a1[2] + a1[3] * a1[3];
                        q += __shfl_xor(q, 16); q += __shfl_xor(q, 32); mx = fmaxf(mx, q); }
#pragma unroll
            for (int o = 1; o < 16; o <<= 1) mx = fmaxf(mx, __shfl_xor(mx, o));
            if ((threadIdx.x & 63) == 0) atomicMax(hp + (u.pn < 2 ? 0 : 64), __float_as_uint(mx));
        }
#pragma unroll
        for (int ai = 0; ai < 2; ++ai)
#pragma unroll
            for (int m = 0; m < 4; ++m) { bf16_t* rowp = O + (size_t)(row0 + ai * HALF + m * 16) * NPROJ + col0;
#pragma unroll
                for (int bj = 0; bj < 2; ++bj) { const f32x4 v0 = acc[ai][bj][m][0] * sc, v1 = acc[ai][bj][m][1] * sc;
                    u32x4 w; w.x = cvt_pk_bf16(v0[0], v0[1]); w.y = cvt_pk_bf16(v0[2], v0[3]); w.z = cvt_pk_bf16(v1[0], v1[1]); w.w = cvt_pk_bf16(v1[2], v1[3]);
                    st16_wt(rowp + bj * HALF, w); } }
    }
};
struct EpiWout {
    static constexpr bool PERM = false, MIDK = true;
    const float* x; float* X1; bf16_t* X1B; const PG8_LAS float* ratio; const PG8_LAS float* rs;
    __device__ __forceinline__ void midk(f32x4 (&acc)[2][2][4][2], int wr, int fr) const {
#pragma unroll
        for (int ai = 0; ai < 2; ++ai)
#pragma unroll
            for (int m = 0; m < 4; ++m) { const float f = ratio[ai * HALF + wr * 64 + m * 16 + fr];
#pragma unroll
                for (int bj = 0; bj < 2; ++bj)
#pragma unroll
                    for (int n = 0; n < 2; ++n) acc[ai][bj][m][n] *= f; }
    }
    __device__ __forceinline__ void operator()(const f32x4 (&acc)[2][2][4][2], const Unit& u, int, int wr, int wc, int fr, int fq) const {
        const int col0 = u.pn * BM + wc * 32 + 4 * fq;
#pragma unroll
        for (int ai = 0; ai < 2; ++ai)
#pragma unroll
            for (int m = 0; m < 4; ++m) { const int r = ai * HALF + wr * 64 + m * 16 + fr; const float s = rs[r]; const size_t off = (size_t)(u.pm * BM + r) * DM + col0;
#pragma unroll
                for (int bj = 0; bj < 2; ++bj)
#pragma unroll
                    for (int n = 0; n < 2; ++n) { const f32x4 xv = *(const f32x4*)(x + off + bj * HALF + n * 16); const f32x4 o = xv + acc[ai][bj][m][n] * s;
                        *(f32x4*)(X1 + off + bj * HALF + n * 16) = o;
                        if (MOE_F8) *(unsigned*)((unsigned char*)X1B + off + bj * HALF + n * 16) = pk4_fp8(o[0], o[1], o[2], o[3]);
                        else { u32x2 w; w.x = cvt_pk_bf16(o[0], o[1]); w.y = cvt_pk_bf16(o[2], o[3]); *(u32x2*)(X1B + off + bj * HALF + n * 16) = w; } }
                asm volatile("" ::: "memory"); }
    }
};
constexpr int MOE_MAXU = 10;
struct MoeOrder {
    int NT, c; const PG8_LAS int* tb; const PG8_LAS int* tbE; const PG8_LAS int* tbC; const PG8_LAS int* cnt; const PG8_LAS int* tabA;
    int probe = 0;
    __device__ bool next(int i, Unit& u) const {
        if (i >= MOE_MAXU) return false;
        const int x = c & 7, j = c >> 3, UE = tbE[32] * NT, UC = tbC[32] * NT;
        const int qE = UE >> 3, rE = UE & 7, sE = x * qE + (x < rE ? x : rE), nE = qE + (x < rE ? 1 : 0);
        const int qC = UC >> 3, rC = UC & 7, sC = x * qC + (x < rC ? x : rC), nC = qC + (x < rC ? 1 : 0);
        const int nEj = (j < nE) ? ((nE - j + 31) >> 5) : 0;
        if (i < nEj) {
            const int f = sE + i * 32 + j; int e = 0; while (f >= tbE[e + 1] * NT) ++e;
            const int idx = f - tbE[e] * NT, nte = tbE[e + 1] - tbE[e], pg = idx / (4 * nte), rem2 = idx - pg * 4 * nte, mt = rem2 >> 2;
            u.pm = tb[e] + mt; u.pn = e * NT + pg * 4 + (rem2 & 3); const int left = cnt[e] - 256 * mt; u.nr = left < BM ? left : BM;
        } else {
            const int jj = (j - (nE & 31) + 32) & 31, lc = (i - nEj) * 32 + jj; if (lc >= nC) return false;
            const int f = sC + lc; int e = 0; while (f >= tbC[e + 1] * NT) ++e;
            const int mt = tbE[e + 1] - tbE[e]; u.pm = tb[e] + mt; u.pn = e * NT + (f - tbC[e] * NT); u.nr = cnt[e] - 256 * mt;
        }
        if (probe) { u.pm &= 31; u.pn &= 7; if (probe == 2) u.nr = 32; }
        return true;
    }
    __device__ __forceinline__ const PG8_LAS int* rowtab(int ui) const { return tabA + ui * 256; }
};
struct EpiMoe1 {
    static constexpr bool PERM = true, MIDK = false;
    bf16_t* H; const PG8_LAS int* rowtab; const PG8_LAS float* btab;
    __device__ __forceinline__ void operator()(const f32x4 (&acc)[2][2][4][2], const Unit& u, int ui, int wr, int wc, int fr, int fq) const {
        const int pl = u.pn & 7, cl = wc * 32 + 8 * fq, colA = pl * 128 + cl;
        f32x4 bg[2], bl[2];
#pragma unroll
        for (int n = 0; n < 2; ++n) { bg[n] = *(const PG8_LAS f32x4*)(btab + ui * 256 + cl + 4 * n); bl[n] = *(const PG8_LAS f32x4*)(btab + ui * 256 + 128 + cl + 4 * n); }
#pragma unroll
        for (int ai = 0; ai < 2; ++ai)
#pragma unroll
            for (int m = 0; m < 4; ++m) { const int r = ai * HALF + wr * 64 + m * 16 + fr; const float rs = __uint_as_float((unsigned)rowtab[ui * 256 + r] & 0xffff0000u);
                float a8[8];
#pragma unroll
                for (int n = 0; n < 2; ++n) { const f32x4 gv = acc[ai][0][m][n] * rs + bg[n], lv = acc[ai][1][m][n] * rs + bl[n];
#pragma unroll
                    for (int i = 0; i < 4; ++i) { const float gl = fminf(gv[i], 7.f), li = fminf(fmaxf(lv[i], -7.f), 7.f);
                        a8[4 * n + i] = gl * __builtin_amdgcn_rcpf(1.f + __builtin_amdgcn_exp2f(-1.702f * LOG2E * gl)) * (li + 1.f); } }
                if (MOE_F8) { u32x2 w;
                    int w0 = __builtin_amdgcn_cvt_pk_fp8_f32(a8[0], a8[1], 0, false); w0 = __builtin_amdgcn_cvt_pk_fp8_f32(a8[2], a8[3], w0, true);
                    int w1 = __builtin_amdgcn_cvt_pk_fp8_f32(a8[4], a8[5], 0, false); w1 = __builtin_amdgcn_cvt_pk_fp8_f32(a8[6], a8[7], w1, true);
                    w.x = (unsigned)w0; w.y = (unsigned)w1; *(u32x2*)((unsigned char*)H + (size_t)(u.pm * BM + r) * DM + colA) = w; }
                else { u32x4 w; w.x = cvt_pk_bf16(a8[0], a8[1]); w.y = cvt_pk_bf16(a8[2], a8[3]); w.z = cvt_pk_bf16(a8[4], a8[5]); w.w = cvt_pk_bf16(a8[6], a8[7]);
                *(u32x4*)(H + (size_t)(u.pm * BM + r) * DM + colA) = w; } }
    }
};
struct EpiMoe2 {
    static constexpr bool PERM = true, MIDK = false;
    bf16_t* Y; const PG8_LAS float* wtab; const PG8_LAS float* btab;
    __device__ __forceinline__ void operator()(const f32x4 (&acc)[2][2][4][2], const Unit& u, int ui, int wr, int wc, int fr, int fq) const {
        const int pl = u.pn & 3, cl = wc * 32 + 8 * fq, col0 = pl * BM + cl;
        f32x4 bv[2][2];
#pragma unroll
        for (int bj = 0; bj < 2; ++bj)
#pragma unroll
            for (int n = 0; n < 2; ++n) bv[bj][n] = *(const PG8_LAS f32x4*)(btab + ui * 256 + cl + bj * HALF + 4 * n);
#pragma unroll
        for (int ai = 0; ai < 2; ++ai)
#pragma unroll
            for (int m = 0; m < 4; ++m) { const int r = ai * HALF + wr * 64 + m * 16 + fr; const float wt = wtab[ui * 256 + r]; bf16_t* rowp = Y + (size_t)(u.pm * BM + r) * DM + col0;
#pragma unroll
                for (int bj = 0; bj < 2; ++bj) { const f32x4 v0 = (acc[ai][bj][m][0] + bv[bj][0]) * wt, v1 = (acc[ai][bj][m][1] + bv[bj][1]) * wt;
                    if (Y_F8) { u32x2 w; w.x = pk4_fp8(v0[0], v0[1], v0[2], v0[3]); w.y = pk4_fp8(v1[0], v1[1], v1[2], v1[3]); *(u32x2*)((unsigned char*)Y + (size_t)(u.pm * BM + r) * DM + col0 + bj * HALF) = w; }
                    else { u32x4 w; w.x = cvt_pk_bf16(v0[0], v0[1]); w.y = cvt_pk_bf16(v0[2], v0[3]); w.z = cvt_pk_bf16(v1[0], v1[1]); w.w = cvt_pk_bf16(v1[2], v1[3]);
                    *(u32x4*)(rowp + bj * HALF) = w; } } }
    }
};
struct ListOrder {
    const PG8_LAS int* ud; int n; const PG8_LAS int* tabA;
    __device__ __forceinline__ bool next(int i, Unit& u) const { if (i >= n) return false; u.pm = ud[3 * i]; u.pn = ud[3 * i + 1]; u.nr = ud[3 * i + 2]; return true; }
    __device__ __forceinline__ const PG8_LAS int* rowtab(int ui) const { return tabA + ui * 256; }
};
struct EpiNull {
    static constexpr bool PERM = true, MIDK = false; float* O;
    __device__ __forceinline__ void operator()(const f32x4 (&acc)[2][2][4][2], const Unit& u, int ui, int wr, int wc, int fr, int fq) const {
        f32x4 t = (f32x4){0.f, 0.f, 0.f, 0.f};
#pragma unroll
        for (int ai = 0; ai < 2; ++ai)
#pragma unroll
            for (int bj = 0; bj < 2; ++bj)
#pragma unroll
                for (int m = 0; m < 4; ++m)
#pragma unroll
                    for (int n = 0; n < 2; ++n) t += acc[ai][bj][m][n];
        O[(size_t)(u.pm & 31) * 65536 + (u.pn & 7) * 8192 + (wr * 4 + wc) * 64 + fq * 16 + fr + ui] = t[0] + t[1] + t[2] + t[3];
    }
};
}

#include <hip/hip_bf16.h>
#include <cmath>
namespace attn_body {

using bf16=__hip_bfloat16;
using bf16x8=__attribute__((ext_vector_type(8)))short;
using s16x4=__attribute__((ext_vector_type(4)))short;
using f32x16=__attribute__((ext_vector_type(16)))float;
using u32x4=__attribute__((ext_vector_type(4)))unsigned;
constexpr int SEQ=4096,D=64,PIN=3072,POUT=1024;
constexpr int NW=8,QBLK=32,QB=QBLK*NW,KVBLK=64,NQB=SEQ/QB;
__device__ __forceinline__ int crow(int r,int hi){return (r&3)+8*(r>>2)+4*hi;}
#define SBAR() __builtin_amdgcn_sched_barrier(0)
__device__ __forceinline__ void cmask(f32x16&p0,f32x16&p1,int jb,int qrel,int hi){
  const float NEG=-INFINITY; int kb=64*jb+4*hi;
  #pragma unroll
  for(int r=0;r<16;++r){int kv=kb+(r&3)+8*(r>>2); if(kv>qrel)p0[r]=NEG; if(kv+32>qrel)p1[r]=NEG;}
}

constexpr int NSLOT=3, SLOTB=8192;
constexpr int LDS_K=0, LDS_V=NSLOT*SLOTB, LDS_WS=2*NSLOT*SLOTB, LDS_OST=LDS_WS+NW*64*4, LDS_CK=LDS_OST+NW*4096, LDS_BYTES=LDS_CK+SEQ*4;
constexpr float C2=0.125f*1.4426950408889634f;
__device__ __forceinline__ void glds16(const void*gsrc,unsigned lds_dst){unsigned keep;
  asm volatile("s_mov_b32 %0, m0\n\ts_mov_b32 m0, %2\n\ts_nop 0\n\tglobal_load_lds_dwordx4 %1, off\n\ts_mov_b32 m0, %0":"=&s"(keep):"v"(gsrc),"s"(lds_dst):"memory");}
__device__ __forceinline__ float max3f(float a,float b,float c){float r;asm("v_max3_f32 %0, %1, %2, %3":"=v"(r):"v"(a),"v"(b),"v"(c));return r;}
__device__ __forceinline__ float max2f(float a,float b){float r;asm("v_max_f32_e32 %0, %1, %2":"=v"(r):"v"(a),"v"(b));return r;}
__device__ __forceinline__ float fadd_s(float a,float b){float r;asm("v_add_f32_e32 %0, %1, %2":"=v"(r):"v"(a),"v"(b));return r;}
__device__ __forceinline__ float fsub_s(float a,float b){float r;asm("v_sub_f32_e32 %0, %1, %2":"=v"(r):"v"(a),"v"(b));return r;}
typedef float f32x2_t __attribute__((ext_vector_type(2))); typedef float f32x4_t __attribute__((ext_vector_type(4))); typedef __bf16 bf16x2_t __attribute__((ext_vector_type(2)));
__device__ __forceinline__ unsigned cvtpk_s(float lo,float hi){f32x2_t v={lo,hi};bf16x2_t b=__builtin_convertvector(v,bf16x2_t);return __builtin_bit_cast(unsigned,b);}
#define WAIT_BAR(N) asm volatile("s_waitcnt vmcnt(" #N ") lgkmcnt(0)\n\ts_barrier":::"memory")

__device__ __forceinline__ void qkt(f32x16&p0,f32x16&p1,const char*Kslot,const bf16x8*qr,const f32x16&negm,int r32,int hi){
  const char*kb=Kslot+hi*1024+r32*16;
  #pragma unroll
  for(int d0=0;d0<4;++d0){
    const bf16x8 b0=*reinterpret_cast<const bf16x8*>(kb+d0*2048);
    const bf16x8 b1=*reinterpret_cast<const bf16x8*>(kb+d0*2048+512);
    if(d0==0){p0=__builtin_amdgcn_mfma_f32_32x32x16_bf16(b0,qr[0],negm,0,0,0);p1=__builtin_amdgcn_mfma_f32_32x32x16_bf16(b1,qr[0],negm,0,0,0);}
    else{p0=__builtin_amdgcn_mfma_f32_32x32x16_bf16(b0,qr[d0],p0,0,0,0);p1=__builtin_amdgcn_mfma_f32_32x32x16_bf16(b1,qr[d0],p1,0,0,0);}}
}
typedef __attribute__((address_space(3))) const char* lds_cptr;
typedef short v4i16_t __attribute__((ext_vector_type(4)));
__device__ __forceinline__ void kload8(bf16x8*kf,lds_cptr kp){
  kf[0]=*(const __attribute__((address_space(3))) bf16x8*)(kp);      kf[1]=*(const __attribute__((address_space(3))) bf16x8*)(kp+512);
  kf[2]=*(const __attribute__((address_space(3))) bf16x8*)(kp+2048); kf[3]=*(const __attribute__((address_space(3))) bf16x8*)(kp+2560);
  kf[4]=*(const __attribute__((address_space(3))) bf16x8*)(kp+4096); kf[5]=*(const __attribute__((address_space(3))) bf16x8*)(kp+4608);
  kf[6]=*(const __attribute__((address_space(3))) bf16x8*)(kp+6144); kf[7]=*(const __attribute__((address_space(3))) bf16x8*)(kp+6656);
}
__device__ __forceinline__ void kload2(bf16x8*kf,lds_cptr kp,int j){ kf[2*j]=*(const __attribute__((address_space(3))) bf16x8*)(kp+j*2048); kf[2*j+1]=*(const __attribute__((address_space(3))) bf16x8*)(kp+j*2048+512); }
__device__ __forceinline__ s16x4 vtr(lds_cptr p){ return __builtin_bit_cast(s16x4,__builtin_amdgcn_ds_read_tr16_b64_v4i16((__attribute__((address_space(3))) v4i16_t*)p)); }
__device__ __forceinline__ float rowmax(const f32x16&p0,const f32x16&p1){
  float a=max3f(p0[0],p0[1],p1[0]),b=max3f(p0[2],p0[3],p1[1]);a=max3f(a,p1[2],p1[3]);
  #pragma unroll
  for(int r=4;r<16;r+=4){a=max3f(a,p0[r],p0[r+1]);b=max3f(b,p0[r+2],p0[r+3]);a=max3f(a,p1[r],p1[r+1]);b=max3f(b,p1[r+2],p1[r+3]);}
  const float m=max2f(a,b);
  auto rr=__builtin_amdgcn_permlane32_swap(__float_as_uint(m),__float_as_uint(m),false,false);
  return max2f(__uint_as_float(rr[0]),__uint_as_float(rr[1]));
}
__device__ __forceinline__ void pv(f32x16*o,int vb,bf16x8 pa0,bf16x8 pa1,bf16x8 pa2,bf16x8 pa3){
  #pragma unroll
  for(int d0=0;d0<2;++d0){s16x4 lo[4],hi[4];
    #pragma unroll
    for(int ks=0;ks<4;++ks){
      asm volatile("ds_read_b64_tr_b16 %0,%1 offset:%c2":"=&v"(lo[ks]):"v"(vb),"i"(d0*4096+ks*1024):"memory");
      asm volatile("ds_read_b64_tr_b16 %0,%1 offset:%c2":"=&v"(hi[ks]):"v"(vb),"i"(d0*4096+ks*1024+512):"memory");}
    asm volatile("s_waitcnt lgkmcnt(0)":::"memory");SBAR();
    #define PK(k) (bf16x8){lo[k][0],lo[k][1],lo[k][2],lo[k][3],hi[k][0],hi[k][1],hi[k][2],hi[k][3]}
    o[d0]=__builtin_amdgcn_mfma_f32_32x32x16_bf16(pa0,PK(0),o[d0],0,0,0);
    o[d0]=__builtin_amdgcn_mfma_f32_32x32x16_bf16(pa1,PK(1),o[d0],0,0,0);
    o[d0]=__builtin_amdgcn_mfma_f32_32x32x16_bf16(pa2,PK(2),o[d0],0,0,0);
    o[d0]=__builtin_amdgcn_mfma_f32_32x32x16_bf16(pa3,PK(3),o[d0],0,0,0);
    #undef PK
  }
}

#ifndef ATTN_STORE16
#define ATTN_STORE16(p,v) (*(u32x4*)(p)=(v))
#endif
template<int THRL> __device__ __forceinline__ void attn_unit(int b,int h,int qb,const bf16*Q,const bf16*__restrict__ K,const bf16*__restrict__ V,bf16*O,const float*__restrict__ CUMbh,float*__restrict__ SSQh,float skipth,char*shm){
  int tid_=threadIdx.x; asm volatile("":"+v"(tid_));
  const int tid=tid_,lane=tid&63,r32=lane&31,hi=lane>>5; const int wid=__builtin_amdgcn_readfirstlane(tid>>6);
  const long rowbase=(long)b*SEQ; const int q0=qb*QB;
  const bf16*Qw=Q+(rowbase+q0+wid*QBLK)*PIN+h*D;
  int t0;
  { const int NT0=(q0+QB)/KVBLK; const bool sk=(lane<NT0-4)&&(CUMbh[64*lane+63]-CUMbh[q0]>=skipth); t0=__builtin_popcountll(__ballot(sk))&~1; t0=__builtin_amdgcn_readfirstlane(t0); }
  const bf16*Kh=K+(rowbase+(long)t0*KVBLK)*PIN+h*D,*Vh=V+(rowbase+(long)t0*KVBLK)*PIN+h*D;
  const unsigned lds0=(unsigned)(uintptr_t)shm;
  const lds_cptr shm3=(lds_cptr)shm;
  float*wsf=(float*)(shm+LDS_WS)+wid*64;
  const bf16*ksrc=Kh+(long)lane*PIN+wid*8;
  const bf16*vsrc=Vh+(long)(16*(wid&3)+(lane>>2))*PIN+(wid>>2)*32+(lane&3)*8;
  const unsigned kdst=lds0+LDS_K+wid*1024, vdst=lds0+LDS_V+wid*1024;
  #define DMA_K(t,slot) glds16(ksrc+(long)(t)*KVBLK*PIN,(unsigned)__builtin_amdgcn_readfirstlane(kdst+(slot)))
  #define DMA_V(t,slot) glds16(vsrc+(long)(t)*KVBLK*PIN,(unsigned)__builtin_amdgcn_readfirstlane(vdst+(slot)))
  const int vb0=(int)(lds0+LDS_V)+((lane>>4)&1)*32+(lane&3)*8+(4*hi+((lane&15)>>2))*64;
  const char*Kbase=shm+LDS_K; bf16x8 kf[8];
  const lds_cptr kp0=shm3+LDS_K+hi*1024+r32*16; const lds_cptr vp0=shm3+LDS_V+((lane>>4)&1)*32+(lane&3)*8+(4*hi+((lane&15)>>2))*64;
  const int NT=(q0+QB)/KVBLK-t0;
  DMA_K(0,0);DMA_V(0,0);DMA_K(1,SLOTB);
  bf16x8 qr[4];
  #pragma unroll
  for(int d0=0;d0<4;++d0)qr[d0]=*reinterpret_cast<const bf16x8*>(&Qw[(long)r32*PIN+d0*16+hi*8]);
  const float cbase=CUMbh[q0]; const float cq=CUMbh[q0+wid*QBLK+r32]-cbase;
  { __attribute__((address_space(3))) float*ckw=(__attribute__((address_space(3))) float*)(shm3+LDS_CK); int s0_=tid; asm volatile("":"+v"(s0_));
    _Pragma("nounroll") for(int s=s0_;s<q0+QB;s+=NW*64)ckw[s]=CUMbh[s]-cbase; }
  const __attribute__((address_space(3))) float*ckp=(const __attribute__((address_space(3))) float*)(shm3+LDS_CK)+4*hi+t0*KVBLK;
  float mhat=-cq,l_reg=0.f;f32x16 o[2];o[0]=f32x16{};o[1]=f32x16{};f32x16 negm;
  #pragma unroll
  for(int r=0;r<16;++r)negm[r]=cq;
  asm volatile("":"+v"(negm));
  const int qrel=wid*QBLK+r32;
  #define BIAS(P0,P1,t) do{ const __attribute__((address_space(3))) float*cp_=ckp+(t)*KVBLK; \
    _Pragma("unroll") for(int g_=0;g_<4;++g_){ const f32x4_t c0_=*(const __attribute__((address_space(3))) f32x4_t*)(cp_+8*g_), c1_=*(const __attribute__((address_space(3))) f32x4_t*)(cp_+32+8*g_); \
      _Pragma("unroll") for(int j_=0;j_<4;++j_){ P0[4*g_+j_]-=c0_[j_]; P1[4*g_+j_]-=c1_[j_]; } SBAR(); } }while(0)
  #define CMASK(P0,P1,t) do{int jb_=(t)-(NT-4); if(jb_>=0)cmask(P0,P1,jb_,qrel,hi);}while(0)
  bool resc=false;
  #define START(P0,P1) do{ const float rm=rowmax(P0,P1); resc=false; \
    { const float dl=rm; mhat=fadd_s(mhat,dl); \
      _Pragma("unroll") for(int r=0;r<16;++r){P0[r]=fsub_s(P0[r],dl);P1[r]=fsub_s(P1[r],dl);} \
      _Pragma("unroll") for(int r=0;r<16;++r)negm[r]=-mhat; asm volatile("":"+v"(negm)); } \
    _Pragma("unroll") for(int r=0;r<16;++r)P0[r]=__builtin_amdgcn_exp2f(P0[r]); }while(0)
  #define RESC() do{ if(resc){ asm volatile("s_waitcnt lgkmcnt(0)":::"memory"); \
      _Pragma("unroll") for(int d_=0;d_<2;++d_) _Pragma("unroll") for(int r=0;r<16;++r)o[d_][r]*=wsf[crow(r,hi)]; } }while(0)
  f32x16 pA0,pA1,pB0,pB1;
  int sl_prev=0,sl_cur=0,sl_next=SLOTB;
  #define ROT() do{sl_prev=sl_cur;sl_cur=sl_next;sl_next=(sl_next==(NSLOT-1)*SLOTB)?0:sl_next+SLOTB;}while(0)
  DMA_K(2,2*SLOTB);
  WAIT_BAR(3);
  qkt(pA0,pA1,Kbase,qr,negm,r32,hi);asm volatile("s_nop 15\n\ts_nop 7":"+v"(pA0),"+v"(pA1));BIAS(pA0,pA1,0);CMASK(pA0,pA1,0);
  START(pA0,pA1);
  _Pragma("unroll") for(int r=0;r<16;++r)pA1[r]=__builtin_amdgcn_exp2f(pA1[r]);
  WAIT_BAR(0);
  DMA_K(3,0);DMA_V(1,SLOTB);
  ROT();
  kload8(kf,kp0+sl_cur);
  WAIT_BAR(2);
  s16x4 vlo[8],vhi[8]; u32x4 pw0,pw1,pw2,pw3;
  #define PKW(P,B) cvtpk_s(P[B],P[B+1])
  #define PAF(k) __builtin_bit_cast(bf16x8,pw##k)
  #define VFR(i) (bf16x8){vlo[i][0],vlo[i][1],vlo[i][2],vlo[i][3],vhi[i][0],vhi[i][1],vhi[i][2],vhi[i][3]}
  #define PIN(x) asm volatile("":"+v"(x))
  #define MX3(a,b,c) __builtin_fmaxf(__builtin_fmaxf((a),(b)),(c))
  #define GAPA(MF,A0,A1,A2,A3,W0,W1,PW) do{ MF; sacc+=A0; sacc+=A1; sacc+=A2; sacc+=A3; PIN(sacc); W0; W1; PIN(PW); SBAR(); }while(0)
  #define EX(v) __builtin_amdgcn_exp2f(v)
  #define GAPB(MF,X,B) do{ MF; X[B]=EX(X[B]); X[B+1]=EX(X[B+1]); X[B+2]=EX(X[B+2]); X[B+3]=EX(X[B+3]); PIN(X); SBAR(); }while(0)
  #define VRD(i) do{ vlo[i]=vtr(vp_+(((i)>>2)*4096+((i)&3)*1024)); vhi[i]=vtr(vp_+(((i)>>2)*4096+((i)&3)*1024+512)); }while(0)
  #define KRD(G,j) do{ if(G){ kload2(kf,kp0+sl_next,j); SBAR(); } }while(0)
  #define STEP(C0,C1,P0,P1,t,GK,GV,GL) do{ SBAR(); \
    const lds_cptr vp_=vp0+sl_prev; \
    VRD(0); SBAR(); float sacc=(P0[0]+P0[1]); \
    GAPA(C0=__builtin_amdgcn_mfma_f32_32x32x16_bf16(kf[0],qr[0],negm,0,0,0), P0[2],P0[3],P0[4],P0[5],     pw0[0]=PKW(P0,0), pw0[1]=PKW(P0,2), pw0); \
    VRD(4); SBAR(); GAPA(C1=__builtin_amdgcn_mfma_f32_32x32x16_bf16(kf[1],qr[0],negm,0,0,0), P0[6],P0[7],P0[8],P0[9],     pw0[2]=PKW(P0,4), pw0[3]=PKW(P0,6), pw0); \
    VRD(1); SBAR(); GAPA(C0=__builtin_amdgcn_mfma_f32_32x32x16_bf16(kf[2],qr[1],C0,0,0,0),   P0[10],P0[11],P0[12],P0[13], pw1[0]=PKW(P0,8), pw1[1]=PKW(P0,10), pw1); \
    VRD(5); SBAR(); GAPA(C1=__builtin_amdgcn_mfma_f32_32x32x16_bf16(kf[3],qr[1],C1,0,0,0),   P0[14],P0[15],P1[0],P1[1],   pw1[2]=PKW(P0,12),pw1[3]=PKW(P0,14), pw1); \
    VRD(2); SBAR(); GAPA(C0=__builtin_amdgcn_mfma_f32_32x32x16_bf16(kf[4],qr[2],C0,0,0,0),   P1[2],P1[3],P1[4],P1[5],     pw2[0]=PKW(P1,0), pw2[1]=PKW(P1,2), pw2); \
    VRD(6); SBAR(); GAPA(C1=__builtin_amdgcn_mfma_f32_32x32x16_bf16(kf[5],qr[2],C1,0,0,0),   P1[6],P1[7],P1[8],P1[9],     pw2[2]=PKW(P1,4), pw2[3]=PKW(P1,6), pw2); \
    VRD(3); SBAR(); GAPA(C0=__builtin_amdgcn_mfma_f32_32x32x16_bf16(kf[6],qr[3],C0,0,0,0),   P1[10],P1[11],P1[12],P1[13], pw3[0]=PKW(P1,8), pw3[1]=PKW(P1,10), pw3); \
    VRD(7); SBAR(); GAPA(C1=__builtin_amdgcn_mfma_f32_32x32x16_bf16(kf[7],qr[3],C1,0,0,0),   P1[14],P1[15],0.f,0.f,       pw3[2]=PKW(P1,12),pw3[3]=PKW(P1,14), pw3); \
    l_reg+=sacc; \
    if(GK){DMA_K((t)+3,sl_cur);} if(GV){DMA_V((t)+1,sl_next);} \
    BIAS(C0,C1,t); CMASK(C0,C1,t); \
    { float a=MX3(C0[0],C0[1],C1[0]),b=MX3(C0[2],C0[3],C1[1]); a=MX3(a,C1[2],C1[3]); \
      _Pragma("unroll") for(int r=4;r<16;r+=4){a=MX3(a,C0[r],C0[r+1]);b=MX3(b,C0[r+2],C0[r+3]);a=MX3(a,C1[r],C1[r+1]);b=MX3(b,C1[r+2],C1[r+3]);} \
      float rm=__builtin_fmaxf(a,b); { auto rr=__builtin_amdgcn_permlane32_swap(__float_as_uint(rm),__float_as_uint(rm),false,false); rm=__builtin_fmaxf(__uint_as_float(rr[0]),__uint_as_float(rr[1])); } \
      resc=false; \
      if(__builtin_expect(__any(rm>(float)THRL),0)){ const float dl=__builtin_fmaxf(rm,0.f); mhat+=dl; \
        _Pragma("unroll") for(int r=0;r<16;++r){C0[r]-=dl;C1[r]-=dl;} \
        _Pragma("unroll") for(int r=0;r<16;++r)negm[r]=-mhat; asm volatile("":"+v"(negm)); \
        const float f=__builtin_amdgcn_exp2f(-dl); l_reg*=f; if(hi==0)wsf[r32]=f; resc=true; } } \
    SBAR(); \
    GAPB(o[0]=__builtin_amdgcn_mfma_f32_32x32x16_bf16(PAF(0),VFR(0),o[0],0,0,0), C0,0); \
    GAPB(o[1]=__builtin_amdgcn_mfma_f32_32x32x16_bf16(PAF(0),VFR(4),o[1],0,0,0), C0,4); \
    KRD(GL,0); GAPB(o[0]=__builtin_amdgcn_mfma_f32_32x32x16_bf16(PAF(1),VFR(1),o[0],0,0,0), C0,8); \
    KRD(GL,1); GAPB(o[1]=__builtin_amdgcn_mfma_f32_32x32x16_bf16(PAF(1),VFR(5),o[1],0,0,0), C0,12); \
    KRD(GL,2); GAPB(o[0]=__builtin_amdgcn_mfma_f32_32x32x16_bf16(PAF(2),VFR(2),o[0],0,0,0), C1,0); \
    KRD(GL,3); GAPB(o[1]=__builtin_amdgcn_mfma_f32_32x32x16_bf16(PAF(2),VFR(6),o[1],0,0,0), C1,4); \
    GAPB(o[0]=__builtin_amdgcn_mfma_f32_32x32x16_bf16(PAF(3),VFR(3),o[0],0,0,0), C1,8); \
    GAPB(o[1]=__builtin_amdgcn_mfma_f32_32x32x16_bf16(PAF(3),VFR(7),o[1],0,0,0), C1,12); \
    }while(0)
  int t=1;
  #undef CMASK
  #define CMASK(P0,P1,t) do{}while(0)
  for(;t+5<NT;t+=2){
    STEP(pB0,pB1,pA0,pA1,t,true,true,true);     WAIT_BAR(2); RESC(); ROT();
    STEP(pA0,pA1,pB0,pB1,t+1,true,true,true);   WAIT_BAR(2); RESC(); ROT();
  }
  #undef CMASK
  #define CMASK(P0,P1,t) do{int jb_=(t)-(NT-4); if(jb_>=0)cmask(P0,P1,jb_,qrel,hi);}while(0)
  #define ENDW(tt) do{ if((tt)+3<NT){WAIT_BAR(2);} else if((tt)+2<NT){WAIT_BAR(1);} else {WAIT_BAR(0);} }while(0)
  for(;t+1<NT;t+=2){
    STEP(pB0,pB1,pA0,pA1,t,(t+3<NT),(t+1<NT),(t+1<NT));       ENDW(t);   RESC(); ROT();
    STEP(pA0,pA1,pB0,pB1,t+1,(t+4<NT),(t+2<NT),(t+2<NT));     ENDW(t+1); RESC(); ROT();
  }
  STEP(pB0,pB1,pA0,pA1,NT-1,false,false,false); RESC();
  { float sacc=pB0[0]+pB0[1]; _Pragma("unroll") for(int r=2;r<16;++r)sacc+=pB0[r]; _Pragma("unroll") for(int r=0;r<16;++r)sacc+=pB1[r]; l_reg+=sacc;
    pw0=(u32x4){PKW(pB0,0),PKW(pB0,2),PKW(pB0,4),PKW(pB0,6)};pw1=(u32x4){PKW(pB0,8),PKW(pB0,10),PKW(pB0,12),PKW(pB0,14)};pw2=(u32x4){PKW(pB1,0),PKW(pB1,2),PKW(pB1,4),PKW(pB1,6)};pw3=(u32x4){PKW(pB1,8),PKW(pB1,10),PKW(pB1,12),PKW(pB1,14)};
    SBAR(); pv(o,vb0+sl_cur,PAF(0),PAF(1),PAF(2),PAF(3)); }
  #undef PKW
  #undef PAF
  #undef VFR
  #undef PIN
  #undef MX3
  #undef GAPA
  #undef GAPB
  #undef EX
  #undef VRD
  #undef KRD
  #undef STEP
  #undef ENDW
  {auto rr=__builtin_amdgcn_permlane32_swap(__float_as_uint(l_reg),__float_as_uint(l_reg),false,false);l_reg=__uint_as_float(rr[0])+__uint_as_float(rr[1]);}
  if(hi==0)wsf[32+r32]=l_reg;asm volatile("s_waitcnt lgkmcnt(0)":::"memory");
  float rli[16];
  #pragma unroll
  for(int r=0;r<16;++r)rli[r]=__builtin_amdgcn_rcpf(wsf[32+crow(r,hi)]);
  bf16*Ow=O+(rowbase+q0+wid*QBLK)*POUT+h*D; float*Sw=SSQh+(rowbase+q0+wid*QBLK)*16;
  { bf16*stg=(bf16*)(shm+LDS_OST)+wid*2048;
    #pragma unroll
    for(int r=0;r<16;++r){const int orow=crow(r,hi);
      #pragma unroll
      for(int d0=0;d0<2;++d0)stg[orow*64+d0*32+r32]=__float2bfloat16(o[d0][r]*rli[r]);}
    asm volatile("s_waitcnt lgkmcnt(0)":::"memory");
    #pragma unroll
    for(int i=0;i<4;++i){const int row=i*8+(lane>>3),ch=lane&7; const u32x4 v=*(const u32x4*)(stg+row*64+ch*8); ATTN_STORE16(Ow+(long)row*POUT+ch*8,v);
      float sq=0.f;
      #pragma unroll
      for(int w_=0;w_<4;++w_){const float lo_=__uint_as_float(v[w_]<<16),hi_=__uint_as_float(v[w_]&0xffff0000u);sq+=lo_*lo_+hi_*hi_;}
      sq+=__shfl_xor(sq,1);sq+=__shfl_xor(sq,2);sq+=__shfl_xor(sq,4); if(ch==0)Sw[row*16]=sq;} }
  asm volatile("s_waitcnt lgkmcnt(0)\n\ts_barrier":::"memory");
  #undef DMA_K
  #undef DMA_V
  #undef CMASK
  #undef BIAS
  #undef START
  #undef RESC
  #undef ROT
}
constexpr int ATTN_LDS_BYTES=LDS_BYTES;

__device__ __forceinline__ void sb_unit(int b,int h,int qb,const bf16*Q,const bf16*__restrict__ K,const bf16*__restrict__ V,bf16*O,float*__restrict__ SSQh,char*shm){
  int tid_=threadIdx.x; asm volatile("":"+v"(tid_));
  const int tid=tid_,lane=tid&63,r32=lane&31,hi=lane>>5; const int wid=__builtin_amdgcn_readfirstlane(tid>>6);
  const long rowbase=(long)b*SEQ; const int q0=qb*QB;
  const bf16*Qw=Q+(rowbase+q0+wid*QBLK)*PIN+h*D;
  const bf16*Kh=K+rowbase*PIN+h*D,*Vh=V+rowbase*PIN+h*D;
  const unsigned lds0=(unsigned)(uintptr_t)shm;
  const bf16*ksrc=Kh+(long)lane*PIN+wid*8;
  const bf16*vsrc=Vh+(long)(16*(wid&3)+(lane>>2))*PIN+(wid>>2)*32+(lane&3)*8;
  const unsigned kdst=lds0+LDS_K+wid*1024, vdst=lds0+LDS_V+wid*1024;
  const int vb0=(int)(lds0+LDS_V)+((lane>>4)&1)*32+(lane&3)*8+(4*hi+((lane&15)>>2))*64;
  const char*Kbase=shm+LDS_K;
  const int NT=(q0+QB)/KVBLK;
  #define SB_DMA(i,slot) do{ const long kt_=(long)(NT-1-(i)); glds16(ksrc+kt_*KVBLK*PIN,(unsigned)__builtin_amdgcn_readfirstlane(kdst+(slot))); glds16(vsrc+kt_*KVBLK*PIN,(unsigned)__builtin_amdgcn_readfirstlane(vdst+(slot))); }while(0)
  bf16x8 qr[4];
  #pragma unroll
  for(int d0=0;d0<4;++d0)qr[d0]=*reinterpret_cast<const bf16x8*>(&Qw[(long)r32*PIN+d0*16+hi*8]);
  SB_DMA(0,0); SB_DMA(1,SLOTB);
  f32x16 o[2];o[0]=f32x16{};o[1]=f32x16{};
  float Rc=1.f;
  const int qrel=wid*QBLK+r32;
  int sl_cur=0,sl_n1=SLOTB,sl_n2=2*SLOTB;
  volatile __attribute__((address_space(3))) unsigned*flg=(volatile __attribute__((address_space(3))) unsigned*)((lds_cptr)shm+LDS_WS);
  f32x16 pA0,pA1,pB0,pB1;
  WAIT_BAR(3);
  { f32x16 z=f32x16{}; asm volatile("":"+v"(z)); qkt(pA0,pA1,Kbase+sl_cur,qr,z,r32,hi); }
  bool done_=false;
  #define SB_STEP(i,P0,P1,N0,N1) do{ \
    if((i)+1<NT){WAIT_BAR(1);}else{WAIT_BAR(0);} \
    if((i)>0){ const int pb=(((i)-1)&1)*8; unsigned all_=flg[pb]&flg[pb+1]&flg[pb+2]&flg[pb+3]&flg[pb+4]&flg[pb+5]&flg[pb+6]&flg[pb+7]; if(__builtin_amdgcn_readfirstlane(all_)){done_=true;break;} } \
    if((i)+2<NT)SB_DMA((i)+2,sl_n2); \
    if((i)+1<NT){ f32x16 z=f32x16{}; asm volatile("":"+v"(z)); qkt(N0,N1,Kbase+sl_n1,qr,z,r32,hi); SBAR(); } \
    f32x16 s0,s1; \
    _Pragma("unroll") for(int r=0;r<16;++r){ \
      const float za=__builtin_amdgcn_fmed3f(P0[r],-100.f,100.f), zb=__builtin_amdgcn_fmed3f(P1[r],-100.f,100.f); \
      P0[r]=__builtin_amdgcn_exp2f(za); P1[r]=__builtin_amdgcn_exp2f(zb); \
      s0[r]=__builtin_amdgcn_rcpf(1.f+P0[r]); s1[r]=__builtin_amdgcn_rcpf(1.f+P1[r]); } \
    if((i)<4){ const int kb=64*(3-(i))+4*hi; \
      _Pragma("unroll") for(int r=0;r<16;++r){ const int kv=kb+(r&3)+8*(r>>2); if(kv>=qrel){P0[r]=0.f;s0[r]=1.f;} if(kv+32>=qrel){P1[r]=0.f;s1[r]=1.f;} } } \
    float gp[8],pp[8]; \
    _Pragma("unroll") for(int g=0;g<4;++g){ \
      s0[4*g+2]*=s0[4*g+3]; s0[4*g+1]*=s0[4*g+2]; s0[4*g]*=s0[4*g+1]; gp[g]=s0[4*g]; \
      s1[4*g+2]*=s1[4*g+3]; s1[4*g+1]*=s1[4*g+2]; s1[4*g]*=s1[4*g+1]; gp[4+g]=s1[4*g]; } \
    _Pragma("unroll") for(int g=0;g<8;++g){ auto rr=__builtin_amdgcn_permlane32_swap(__float_as_uint(gp[g]),__float_as_uint(gp[g]),false,false); pp[g]=__uint_as_float(hi?rr[0]:rr[1]); } \
    float st=Rc, outer[8]; \
    _Pragma("unroll") for(int g=7;g>=0;--g){ outer[g]=hi?st:st*pp[g]; st=st*(gp[g]*pp[g]); } \
    Rc=st; \
    { const unsigned dn=__all(Rc==0.f)?1u:0u; if(lane==0)flg[((i)&1)*8+wid]=dn; } \
    _Pragma("unroll") for(int r=0;r<16;++r){ P0[r]=P0[r]*(s0[r]*outer[r>>2]); P1[r]=P1[r]*(s1[r]*outer[4+(r>>2)]); } \
    u32x4 pw0,pw1,pw2,pw3; \
    pw0=(u32x4){cvtpk_s(P0[0],P0[1]),cvtpk_s(P0[2],P0[3]),cvtpk_s(P0[4],P0[5]),cvtpk_s(P0[6],P0[7])}; \
    pw1=(u32x4){cvtpk_s(P0[8],P0[9]),cvtpk_s(P0[10],P0[11]),cvtpk_s(P0[12],P0[13]),cvtpk_s(P0[14],P0[15])}; \
    pw2=(u32x4){cvtpk_s(P1[0],P1[1]),cvtpk_s(P1[2],P1[3]),cvtpk_s(P1[4],P1[5]),cvtpk_s(P1[6],P1[7])}; \
    pw3=(u32x4){cvtpk_s(P1[8],P1[9]),cvtpk_s(P1[10],P1[11]),cvtpk_s(P1[12],P1[13]),cvtpk_s(P1[14],P1[15])}; \
    SBAR(); pv(o,vb0+sl_cur,__builtin_bit_cast(bf16x8,pw0),__builtin_bit_cast(bf16x8,pw1),__builtin_bit_cast(bf16x8,pw2),__builtin_bit_cast(bf16x8,pw3)); \
    { const int t_=sl_cur; sl_cur=sl_n1; sl_n1=sl_n2; sl_n2=t_; } \
  }while(0)
  for(int i=0;i<NT&&!done_;i+=2){
    SB_STEP(i,pA0,pA1,pB0,pB1); if(done_)break;
    SB_STEP(i+1,pB0,pB1,pA0,pA1);
  }
  #undef SB_STEP
  #undef SB_DMA
  bf16*Ow=O+(rowbase+q0+wid*QBLK)*POUT+h*D; float*Sw=SSQh+(rowbase+q0+wid*QBLK)*16;
  { bf16*stg=(bf16*)(shm+LDS_OST)+wid*2048;
    #pragma unroll
    for(int r=0;r<16;++r){const int orow=crow(r,hi);
      #pragma unroll
      for(int d0=0;d0<2;++d0)stg[orow*64+d0*32+r32]=__float2bfloat16(o[d0][r]);}
    asm volatile("s_waitcnt lgkmcnt(0)":::"memory");
    #pragma unroll
    for(int i=0;i<4;++i){const int row=i*8+(lane>>3),ch=lane&7; const u32x4 v=*(const u32x4*)(stg+row*64+ch*8); ATTN_STORE16(Ow+(long)row*POUT+ch*8,v);
      float sq=0.f;
      #pragma unroll
      for(int w_=0;w_<4;++w_){const float lo_=__uint_as_float(v[w_]<<16),hi_=__uint_as_float(v[w_]&0xffff0000u);sq+=lo_*lo_+hi_*hi_;}
      sq+=__shfl_xor(sq,1);sq+=__shfl_xor(sq,2);sq+=__shfl_xor(sq,4); if(ch==0)Sw[row*16]=sq;} }
  asm volatile("s_waitcnt vmcnt(0) lgkmcnt(0)\n\ts_barrier":::"memory");
}
template<int THRL=8> __device__ __forceinline__ void attn_phase(char*lds,const bf16*PROJ,const float*CUM,bf16*OMIX,float*SSQ,float skipth,int bh,int role){
  const int b=bh>>3,h=bh&7;
  const int nf=role<5?2:6;
  for(int i=0;i<nf;++i){ const int qb=role<5?(i==0?15-role:6+role):5-i;
    attn_unit<THRL>(b,h,qb,PROJ,PROJ+512,PROJ+1024,OMIX,CUM+(size_t)bh*SEQ,SSQ+h,skipth,lds); }
  const int sb0=role<3?3+3*role:(role==3?12:(role==4?14:0)), ns=(role==3||role==4)?2:3;
  for(int i=0;i<ns;++i) sb_unit(b,h,sb0+i,PROJ+1536,PROJ+2048,PROJ+2560,OMIX+512,SSQ+8+h,lds);
}
template<int THRL,int NA> __device__ __forceinline__ void attn_sched(char*lds,const bf16*PROJ,const float*CUM,bf16*OMIX,float*SSQ,float skipth,int xl,int c){
  int tid_=threadIdx.x; asm volatile("":"+v"(tid_)); const int tid=tid_;
  volatile __attribute__((address_space(3))) float*cost=(volatile __attribute__((address_space(3))) float*)((lds_cptr)lds+114688);
  volatile __attribute__((address_space(3))) int*order=(volatile __attribute__((address_space(3))) int*)((lds_cptr)lds+114688+512);
  #define BH_OF(i) ((xl>>1)*8+(((xl&1)?0x4361:0x5270)>>(4*(i))&15))
  if(tid<128){ const int bi=tid>>5,type=(tid>>4)&1,qb=tid&15,bh=BH_OF(bi),NT0=4*(qb+1); float cs;
    if(type==0){ const float rate=-CUM[(size_t)bh*SEQ+SEQ-1]*(1.f/SEQ); const float w=skipth/fmaxf(rate,1e-6f); const float sk=fmaxf(0.f,(float)(qb*QB)-w);
      int t0=((int)(sk*(1.f/KVBLK)))&~1; if(t0>NT0-4)t0=NT0-4; cs=5.f+1.65f*(float)(NT0-t0); }
    else cs=3.f+2.6f*(float)(NT0<8?NT0:8);
    cost[tid]=cs; }
  asm volatile("s_waitcnt lgkmcnt(0)":::"memory"); __syncthreads();
  if(tid<128){ const float mc=cost[tid]; int rk=0; for(int j=0;j<128;++j){ const float cj=cost[j]; rk+=(cj>mc||(cj==mc&&j<tid))?1:0; } order[rk]=tid; }
  asm volatile("s_waitcnt lgkmcnt(0)":::"memory"); __syncthreads();
  for(int k=0;;++k){ const int r=NA*k+((k&1)?NA-1-c:c); if(r>=128)break;
    const int u=__builtin_amdgcn_readfirstlane(order[r]); const int bi=u>>5,type=(u>>4)&1,qb=u&15,bh=BH_OF(bi),b=bh>>3,h=bh&7;
    if(type==0)attn_unit<THRL>(b,h,qb,PROJ,PROJ+512,PROJ+1024,OMIX,CUM+(size_t)bh*SEQ,SSQ+h,skipth,lds);
    else sb_unit(b,h,qb,PROJ+1536,PROJ+2048,PROJ+2560,OMIX+512,SSQ+8+h,lds); }
  #undef BH_OF
}
template<int THRL=8> __device__ __forceinline__ void attn_phase8(char*lds,const bf16*PROJ,const float*CUM,bf16*OMIX,float*SSQ,int vcu){
  const int bh=vcu>>3,s=vcu&7,b=bh>>3,h=bh&7;
  if(bh>=32)return;
  for(int i=0;i<4;++i){ const int qb=(i&1)?15-s:s;
    if(i<2)attn_unit<THRL>(b,h,qb,PROJ,PROJ+512,PROJ+1024,OMIX,CUM+(size_t)bh*SEQ,SSQ+h,3.0e38f,lds);
    else   sb_unit(b,h,qb,PROJ+1536,PROJ+2048,PROJ+2560,OMIX+512,SSQ+8+h,lds); }
}
#undef SBAR
#undef WAIT_BAR
}

template <int NT, bool UP> __device__ __forceinline__ int moe_prepare(const unsigned* __restrict__ CNT, const int* __restrict__ LIST, const float* __restrict__ RSTD2, const float* __restrict__ RW,
                                                                     const float* __restrict__ bias, int* __restrict__ TBG, int bx, LAS unsigned char* L) {
    int tid_ = threadIdx.x; asm volatile("" : "+v"(tid_)); const int tid = tid_;
    LAS int* tb = (LAS int*)(L + TB_OFF); LAS int* tbE = tb + 64; LAS int* tbC = tb + 128; LAS int* cntl = tb + 192; LAS int* udl = tb + 224; LAS int* tabA = (LAS int*)(L + TAB_OFF); LAS float* tabB = (LAS float*)(L + TAB2_OFF);
    if (tid < 64) {
        const int cn = tid < NE ? (int)CNT[tid] : 0, nt = (cn + 255) >> 8, rem = cn & 255, ch = (rem != 0 && rem <= 128) ? 1 : 0;
        int a = nt, c = ch;
#pragma unroll
        for (int o = 1; o < 32; o <<= 1) { const int ta = __shfl_up(a, o), tc = __shfl_up(c, o); if ((tid & 63) >= o) { a += ta; c += tc; } }
        if (tid < NE) { tb[tid + 1] = a; tbC[tid + 1] = c; tbE[tid + 1] = a - c; cntl[tid] = cn; }
        if (tid == 0) { tb[0] = 0; tbC[0] = 0; tbE[0] = 0; }
    }
    LDS_WAIT(); __syncthreads();
    if (bx == 0 && tid <= NE) TBG[tid] = tb[tid];
    pg8::MoeOrder S{NT, bx, tb, tbE, tbC, cntl, tabA};
    if (tid < pg8::MOE_MAXU) { pg8::Unit u; const bool ok = S.next(tid, u); udl[3 * tid] = ok ? u.pm : -1; udl[3 * tid + 1] = u.pn; udl[3 * tid + 2] = u.nr; }
    LDS_WAIT(); __syncthreads();
    int nun = 0;
#pragma unroll
    for (int i = 0; i < pg8::MOE_MAXU; ++i) nun += (udl[3 * i] >= 0) ? 1 : 0;
    int slot[5];
#pragma unroll
    for (int j = 0; j < 5; ++j) { const int idx = tid + NTHREADS * j, ui = idx >> 8, r = idx & 255; slot[j] = 0;
        if (ui < nun) { const int e = udl[3 * ui + 1] / NT, mt = udl[3 * ui] - tb[e], cnt = cntl[e], p = mt * 256 + r; slot[j] = LIST[(size_t)e * LIST_CAP + (p < cnt ? p : cnt - 1)]; } }
#pragma unroll
    for (int j = 0; j < 5; ++j) { const int idx = tid + NTHREADS * j, ui = idx >> 8;
        if (ui < nun) { const int pn = udl[3 * ui + 1];
            if (UP) { const int tok = slot[j] >> 2; tabA[idx] = tok | (int)(__float_as_uint(RSTD2[tok]) & 0xffff0000u);
                      const int e = pn >> 3, pl = pn & 7, c = idx & 255; tabB[idx] = bias[(size_t)e * 2048 + (c < 128 ? pl * 128 + c : 1024 + pl * 128 + (c - 128))]; }
            else { ((LAS float*)tabA)[idx] = RW[slot[j]] * (Y_F8 ? 16.f : 1.f); const int e = pn >> 2, pl = pn & 3; tabB[idx] = bias[(size_t)e * DM + pl * 256 + (idx & 255)]; } } }
    VM_WAIT(); LDS_WAIT(); __syncthreads();
    return nun;
}

__global__ void __launch_bounds__(NTHREADS, 2) mega_fwd(Args a) {
    extern __shared__ __attribute__((aligned(16))) unsigned char lds[];
    LAS unsigned char* L = (LAS unsigned char*)lds;
    volatile LAS unsigned* MISC = (volatile LAS unsigned*)(L + MISC_OFF);
    const int tid = threadIdx.x, lane = tid & 63, wave = __builtin_amdgcn_readfirstlane(tid >> 6);
    const int G = gridDim.x, bx = blockIdx.x, vcu = (G % 8 == 0) ? (bx % 8) * (G / 8) + bx / 8 : bx;
    const int gw = vcu * NWAVES + wave, NGW = G * NWAVES;
    const bool cvt_role = (vcu & 31) >= 32 - NCVT;
    const int cvt_first = ((vcu >> 5) * NCVT + ((vcu & 31) - (32 - NCVT))) * NWAVES + wave;
    const bool cvt1_role = (vcu & 31) >= 24; const int cvt1_first = ((vcu >> 5) * 8 + ((vcu & 31) - 24)) * NWAVES + wave;
    unsigned char* ws = a.ws;
    unsigned* CTL = (unsigned*)(ws + WS_CTL);
    bf16_t* WINT = (bf16_t*)(ws + WS_WINT); bf16_t* WOUTT = (bf16_t*)(ws + WS_WOUTT); float* WR = (float*)(ws + WS_WR); float* CUM = (float*)(ws + WS_CUM);
    float* SSQ = (float*)(ws + WS_SSQ); float* RSTD2 = (float*)(ws + WS_RSTD2); float* RW = (float*)(ws + WS_RW); int* SLOTEP = (int*)(ws + WS_SLOTEP); int* TBG = (int*)(ws + WS_TBG); int* LIST = (int*)(ws + WS_LIST); float* FLOG = (float*)(ws + WS_FLOG);
    bf16_t* XN = (bf16_t*)(ws + WS_XN); bf16_t* PROJ = (bf16_t*)(ws + WS_PROJ); bf16_t* OMIX = (bf16_t*)(ws + WS_OMIX); bf16_t* X1B = (bf16_t*)(ws + WS_X1B);
    bf16_t* W1T = (bf16_t*)(ws + WS_W1T); bf16_t* W2T = (bf16_t*)(ws + WS_W2T); bf16_t* H = (bf16_t*)(ws + WS_H); bf16_t* Y = (bf16_t*)(ws + WS_Y);
    unsigned* CNT = CTL + CW_CNT;
    for (int u = tid; u < (LDS_BYTES - LDSCTL_OFF) / 4; u += NTHREADS) ((LAS unsigned*)(L + LDSCTL_OFF))[u] = 0u;
    __syncthreads();
    XcdBarrier bar = xcd_barrier_post(CTL + CW_BAR, MISC + 8);
    unsigned long long tsA = 0, tsB = 0;
#define STAMP(k) do { if (PROBE_T >= 0) { if ((k) == PROBE_T) tsA = __builtin_amdgcn_s_memrealtime(); if ((k) == PROBE_T + 1) tsB = __builtin_amdgcn_s_memrealtime(); } } while (0)
    STAMP(0);

    REPS(0) {
        LAS float* scr = (LAS float*)(L + RING_OFF + wave * 8448);
        LAS float* wf = (LAS float*)(L + RING_OFF + 98304);
        for (int i = tid; i < DM * 8; i += NTHREADS) { const int k = i >> 3; wf[(i & 7) * DM + k] = a.w_in[(size_t)k * WIN_N + 1536 + (i & 7)] * a.g1[k]; }
        LDS_WAIT(); __syncthreads();
        constexpr int I_IN = (DM / 64) * (NPROJ / 32), I_OUT = (DM / 64) * (DM / 32);
        for (int it = gw; it < I_IN + I_OUT; it += NGW) {
            TrItem t; f32x4 v[8];
            if (it < I_IN) { t.W = a.w_in; t.WT = WINT; t.gA = a.g1; t.gB = nullptr; t.K = DM; t.Nin = WIN_N; t.Nout = NPROJ; t.mode = 1; t.gsplit = DM; t.item = it; t.nbsh = -1; t.f8 = 0; }
            else { t.W = a.w_out; t.WT = WOUTT; t.gA = a.g_fox; t.gB = a.g_sb; t.K = DM; t.Nin = DM; t.Nout = DM; t.mode = 0; t.gsplit = GW; t.item = it - I_IN; t.nbsh = 5; t.f8 = 0; }
            tr_load<false>(t, lane, v); tr_store(t, lane, v, scr);
        }
        if (!OVERLAP_CVT) convert_experts(a.w1, a.w2, a.g2, W1T, W2T, gw, NGW, N_EXP_ITEMS, lane, scr);
        for (int i = gw * 64 + lane; i < DM * NE; i += NGW * 64) WR[i] = a.w_router[i] * a.g2[i >> 5];
        for (int row = gw; row < M; row += 4 * NGW) {
            float4 v0[4], v1[4], v2[4], v3[4];
#pragma unroll
            for (int j = 0; j < 4; ++j) { v0[j] = ((const float4*)(a.x + (size_t)row * DM))[lane + 64 * j]; v1[j] = ((const float4*)(a.x + (size_t)(row + NGW) * DM))[lane + 64 * j];
                v2[j] = ((const float4*)(a.x + (size_t)(row + 2 * NGW) * DM))[lane + 64 * j]; v3[j] = ((const float4*)(a.x + (size_t)(row + 3 * NGW) * DM))[lane + 64 * j]; }
            rms1_row(v0, wf, a.b_f, XN, FLOG, row, lane); rms1_row(v1, wf, a.b_f, XN, FLOG, row + NGW, lane);
            rms1_row(v2, wf, a.b_f, XN, FLOG, row + 2 * NGW, lane); rms1_row(v3, wf, a.b_f, XN, FLOG, row + 3 * NGW, lane);
        }
    }
    xcd_barrier(bar); if (REP_PHASE == 8) xcd_barrier(bar); STAMP(1);
    REPS(1) {
    { const int ci = (vcu >> 5) * 8 + ((vcu & 31) - 24);
      if (OVERLAP_CVT && CVT_SPLIT > 0) { if (cvt1_role && ((vcu & 31) - 24) < 4) cumsum_wg(FLOG, CUM, (vcu >> 5) * 4 + ((vcu & 31) - 24), (LAS float*)(L + RING_OFF)); }
      else if (vcu < NB * NH) cumsum_wg(FLOG, CUM, vcu, (LAS float*)(L + RING_OFF)); (void)ci; }
    if (OPT_GEMM) {
        if (OVERLAP_CVT && CVT_SPLIT > 0 && cvt1_role) {
            if (CVT_DMA) { LAS float* gl = (LAS float*)(L + TAB_OFF); for (int i = tid; i < DM; i += NTHREADS) gl[i] = a.g2[i]; LDS_WAIT(); __syncthreads();
                convert_experts_dma(a.w1, a.w2, W1T, W2T, cvt1_first, 64 * NWAVES, CVT_SPLIT, lane, (unsigned)(uintptr_t)((char*)lds + RING_OFF + wave * 16384), (const LAS float*)(L + RING_OFF + wave * 16384), gl); }
            else convert_experts(a.w1, a.w2, a.g2, W1T, W2T, cvt1_first, 64 * NWAVES, CVT_SPLIT, lane, (LAS float*)(L + RING_OFF + wave * 8448)); }
        else {
        pg8::Gemm g{XN, WINT, DM}; pg8::StaticOrder S; if (OVERLAP_CVT && CVT_SPLIT > 0) S.init(M, NPROJ, 192, (vcu & 31) * 8 + (vcu >> 5)); else S.init(M, NPROJ, G, bx); pg8::EpiProj E{PROJ, CTL + CW_QHP};
        pg8::gemm_phase<pg8::EpiProj, pg8::StaticOrder, true, false>(L + RING_OFF, g, S, E);
        }
    } else { for (int it = gw; it < (M / 16) * (NPROJ / 64); it += NGW) nv_inproj(XN, WINT, PROJ, it, lane); }
    }
    xcd_barrier(bar); if (REP_PHASE == 8) xcd_barrier(bar); STAMP(2);
    REPS(2) if (OPT_ATTN) {
        static_assert(attn_body::ATTN_LDS_BYTES <= RING_BYTES, "attention scratch inside the ring region");
        if (OVERLAP_CVT) {
            const int xl = vcu >> 5, l = vcu & 31;
            if (cvt_role) {
                if (CVT_DMA) { LAS float* gl = (LAS float*)(L + TAB_OFF); for (int i = tid; i < DM; i += NTHREADS) gl[i] = a.g2[i]; LDS_WAIT(); __syncthreads();
                    convert_experts_dma(a.w1, a.w2, W1T, W2T, CVT_SPLIT + cvt_first, 8 * NCVT * NWAVES, N_EXP_ITEMS, lane, (unsigned)(uintptr_t)((char*)lds + RING_OFF + wave * 16384), (const LAS float*)(L + RING_OFF + wave * 16384), gl); }
                else convert_experts(a.w1, a.w2, a.g2, W1T, W2T, CVT_SPLIT + cvt_first, 8 * NCVT * NWAVES, N_EXP_ITEMS, lane, (LAS float*)(L + RING_OFF + wave * 8448)); }
            const float bnd = 2.04f * sqrtf(__uint_as_float(CTL[CW_QHP]) * __uint_as_float(CTL[CW_KHP])), skipth = FOX_SKIP ? 160.f + 2.f * bnd : 3.0e38f;
            if (l < 32 - NCVT) { if (ATTN_SCHED) attn_body::attn_sched<8, 32 - NCVT>((char*)lds + RING_OFF, (const attn_body::bf16*)PROJ, CUM, (attn_body::bf16*)OMIX, SSQ, skipth, xl, l);
                          else attn_body::attn_phase<8>((char*)lds + RING_OFF, (const attn_body::bf16*)PROJ, CUM, (attn_body::bf16*)OMIX, SSQ, skipth, xl * 4 + l / 6, l % 6); }
        } else attn_body::attn_phase8<8>((char*)lds + RING_OFF, (const attn_body::bf16*)PROJ, CUM, (attn_body::bf16*)OMIX, SSQ, vcu);
    } else {
        LAS unsigned char* wl = L + RING_OFF + wave * 16640;
        for (int u = gw; u < 4096; u += NGW) {
            const int i = u >> 11, idx = u & 2047, type = idx & 1, bh = (idx >> 1) & 31, j = (idx >> 6) & 31; const int qblk = (i == 0) ? j : 63 - j;
            if (type == 0) nv_attn<0>(PROJ, CUM, OMIX, SSQ, bh, qblk, lane, wl); else nv_attn<1>(PROJ, CUM, OMIX, SSQ, bh, qblk, lane, wl);
        }
    }
    xcd_barrier(bar); if (REP_PHASE == 8) xcd_barrier(bar); STAMP(3);
    REPS(3) if (OPT_GEMM) {
        pg8::Gemm g{OMIX, WOUTT, DM}; pg8::StaticOrder S; S.init(M, DM, G, bx);
        LAS float* ratio = (LAS float*)(L + TAB_OFF); LAS float* rsb = (LAS float*)(L + TAB_OFF + 1024);
        pg8::Unit u0;
        if (S.next(0, u0) && tid < 256) { const float* sp = SSQ + (size_t)(u0.pm * 256 + tid) * 16; float sf = 0.f, s2 = 0.f;
#pragma unroll
            for (int h = 0; h < 8; ++h) { sf += sp[h]; s2 += sp[8 + h]; }
            const float rf = rsqrtf(sf * (1.f / GW) + EPS), rs = rsqrtf(s2 * (1.f / GW) + EPS); ratio[tid] = rf / rs; rsb[tid] = rs; }
        VM_WAIT(); LDS_WAIT(); __syncthreads();
        pg8::EpiWout E{a.x, a.out, X1B, ratio, rsb};
        pg8::gemm_phase<pg8::EpiWout, pg8::StaticOrder, false, false>(L + RING_OFF, g, S, E);
    } else { for (int it = gw; it < (M / 16) * (DM / 64); it += NGW) nv_wout(OMIX, WOUTT, SSQ, a.x, a.out, X1B, it, lane); }
    xcd_barrier(bar); if (REP_PHASE == 8) xcd_barrier(bar); STAMP(4);
    if (REP_PHASE == 4) { for (int t64 = vcu; t64 < M / 64; t64 += G) router_wg(a.out, WR, a.b_router, (float*)H, (float*)H + M, (int*)Y, (int*)Y + NE * LIST_CAP, CNT + 64, t64 * 64, L + RING_OFF); }
    if (OPT_ROUTER) { for (int t64 = vcu; t64 < M / 64; t64 += G) router_wg(a.out, WR, a.b_router, RSTD2, RW, LIST, SLOTEP, CNT, t64 * 64, L + RING_OFF); }
    else { for (int it = gw; it < M / 2; it += NGW) nv_router(a.out, WR, a.b_router, RSTD2, RW, LIST, SLOTEP, CNT, it, lane); }
    xcd_barrier(bar); if (REP_PHASE == 8) xcd_barrier(bar); STAMP(5);
    LAS int* tb = (LAS int*)(L + TB_OFF); LAS int* tbE = tb + 64; LAS int* tbC = tb + 128; LAS int* cntl = tb + 192; LAS int* udl = tb + 224; LAS int* tabA = (LAS int*)(L + TAB_OFF); LAS int* tabB = (LAS int*)(L + TAB2_OFF);
    REPS(5) if (OPT_GEMM) {
        const int nun = moe_prepare<8, true>(CNT, LIST, RSTD2, RW, a.b1, TBG, bx, L);
        pg8::Gemm g{X1B, W1T, MOE_F8 ? DM / 2 : DM}; pg8::EpiMoe1 E{H, tabA, (const LAS float*)tabB}; pg8::ListOrder SL{udl, nun, tabA};
        pg8::gemm_phase<pg8::EpiMoe1, pg8::ListOrder, true, true, MOE_F8>(L + RING_OFF, g, SL, E);
    } else {
    for (int g = gw; g < MAX_TILES * 16; g += NGW) {
        int e, base, p0, cnt; if (!moe_tile(CNT, g, e, base, p0, cnt)) continue;
        for (int cg = 0; cg < DFF / 32; ++cg) nv_moe1(X1B, W1T, a.b1, RSTD2, LIST, H, e, base, p0, cnt, cg, lane);
    } }
    xcd_barrier(bar); if (REP_PHASE == 8) xcd_barrier(bar); STAMP(6);
    REPS(6) if (OPT_GEMM) {
        const int nun = moe_prepare<4, false>(CNT, LIST, RSTD2, RW, a.b2, TBG, bx, L);
        pg8::Gemm g{H, W2T, MOE_F8 ? DM / 2 : DM}; pg8::EpiMoe2 E{Y, (const LAS float*)tabA, (const LAS float*)tabB}; pg8::ListOrder SL{udl, nun, tabA};
        pg8::gemm_phase<pg8::EpiMoe2, pg8::ListOrder, true, false, MOE_F8>(L + RING_OFF, g, SL, E);
    } else {
    for (int g = gw; g < MAX_TILES * 16; g += NGW) {
        int e, base, p0, cnt; if (!moe_tile(CNT, g, e, base, p0, cnt)) continue;
        for (int cg = 0; cg < DM / 64; ++cg) nv_moe2(H, W2T, a.b2, RW, LIST, Y, e, base, p0, cnt, cg, lane);
    } }
    xcd_barrier(bar); if (REP_PHASE == 8) xcd_barrier(bar); STAMP(7);
    if (REP_PHASE == 7) { for (int row = gw; row < M; row += NGW) final_row(a.out, Y, SLOTEP, TBG, a.gf, (float*)H, row, lane); }
    for (int row = gw; row < M; row += NGW) final_row(a.out, Y, SLOTEP, TBG, a.gf, a.out, row, lane);
    STAMP(8);
    if (PROBE_T >= 0) { const unsigned long long t0 = __builtin_amdgcn_s_memrealtime(), d = 9ull * (tsB - tsA); while (__builtin_amdgcn_s_memrealtime() - t0 < d) __builtin_amdgcn_s_sleep(8); }
#undef STAMP
}

extern "C" void kernel_launch(void* const* d_in, const int* in_sizes, int n_in, void* d_out, int out_size, void* d_ws, size_t ws_size, hipStream_t stream) {
    static int grid = 0;
    if (grid == 0) {
        if (n_in != 15 || in_sizes[0] != M * DM || out_size != M * DM || ws_size < WS_END) {
            fprintf(stderr, "kernel_launch: unexpected shapes / workspace (n_in %d, in0 %d, out %d, ws %zu, need %zu)\n", n_in, n_in > 0 ? in_sizes[0] : -1, out_size, ws_size, (size_t)WS_END); grid = -1; return; }
        int dev = 0, cus = 0, per_cu = 0;
        if (hipGetDevice(&dev) != hipSuccess || hipDeviceGetAttribute(&cus, hipDeviceAttributeMultiprocessorCount, dev) != hipSuccess) { grid = -1; return; }
        if (hipFuncSetAttribute((const void*)mega_fwd, hipFuncAttributeMaxDynamicSharedMemorySize, LDS_BYTES) != hipSuccess) { fprintf(stderr, "kernel_launch: hipFuncSetAttribute failed\n"); grid = -1; return; }
        if (hipOccupancyMaxActiveBlocksPerMultiprocessor(&per_cu, (const void*)mega_fwd, NTHREADS, LDS_BYTES) != hipSuccess || per_cu < 1) fprintf(stderr, "kernel_launch: occupancy query reports %d\n", per_cu);
        (void)hipGetLastError();
        grid = cus;
        if (cus != 256) { fprintf(stderr, "kernel_launch: built for 256 CUs (8 XCDs x 32), found %d; nothing launched\n", cus); grid = -1; return; }
    }
    if (grid < 0) return;
    if (hipMemsetAsync((char*)d_ws + WS_CTL, 0, CTL_BYTES, stream) != hipSuccess) return;
    Args a{};
    a.x = (const float*)d_in[0]; a.g1 = (const float*)d_in[1]; a.w_in = (const float*)d_in[2]; a.b_f = (const float*)d_in[3]; a.g_fox = (const float*)d_in[4]; a.g_sb = (const float*)d_in[5];
    a.w_out = (const float*)d_in[6]; a.g2 = (const float*)d_in[7]; a.w_router = (const float*)d_in[8]; a.b_router = (const float*)d_in[9]; a.w1 = (const float*)d_in[10]; a.b1 = (const float*)d_in[11];
    a.w2 = (const float*)d_in[12]; a.b2 = (const float*)d_in[13]; a.gf = (const float*)d_in[14];
    a.out = (float*)d_out; a.ws = (unsigned char*)d_ws;
    hipLaunchKernelGGL(mega_fwd, dim3(grid), dim3(NTHREADS), LDS_BYTES, stream, a);
    const hipError_t le = hipPeekAtLastError();
    if (le != hipSuccess) fprintf(stderr, "kernel_launch: launch failed: %s\n", hipGetErrorName(le));
}
```

```cpp
#include <hip/hip_runtime.h>
#include <cstdio>
#include <cstdint>

typedef unsigned short bf16_t;
typedef short bf16x8 __attribute__((ext_vector_type(8)));
typedef float f32x4 __attribute__((ext_vector_type(4)));

constexpr int NB = 4, SEQ = 4096, DM = 1024, M = NB * SEQ;
constexpr int NH = 8, HD = 64, GW = 512;
constexpr int WIN_N = 3080, NPROJ = 3072;
constexpr int NE = 32, TOPK = 4, DFF = 1024;
constexpr float EPS = 1e-5f;
constexpr float LOG2E = 1.4426950408889634f;
constexpr float C2 = 0.125f * LOG2E;
constexpr int LIST_CAP = M;
constexpr int MAX_TILES = (M * TOPK) / 256 + NE;

constexpr size_t MiB = 1u << 20;
constexpr size_t WS_CTL = 0, CTL_BYTES = 1 * MiB;
constexpr size_t WS_WINT = 2 * MiB;
constexpr size_t WS_WOUTT = 8 * MiB;
constexpr size_t WS_WR = 10 * MiB;
constexpr size_t WS_CUM = 11 * MiB;
constexpr size_t WS_SSQ = 12 * MiB;
constexpr size_t WS_RSTD2 = 14 * MiB;
constexpr size_t WS_RW = 15 * MiB;
constexpr size_t WS_SLOTEP = 15 * MiB + 512 * 1024;
constexpr size_t WS_TBG = 14 * MiB + 512 * 1024;
constexpr size_t WS_LIST = 16 * MiB;
constexpr size_t WS_FLOG = 18 * MiB;
constexpr size_t WS_XN = 32 * MiB;
constexpr size_t WS_PROJ = 64 * MiB;
constexpr size_t WS_OMIX = 160 * MiB;
constexpr size_t WS_X1B = 192 * MiB;
constexpr size_t WS_W1T = 224 * MiB;
constexpr size_t WS_W2T = 352 * MiB;
constexpr size_t WS_H = 416 * MiB;
constexpr size_t WS_Y = 560 * MiB;
constexpr size_t WS_END = 704 * MiB;
constexpr int CW_CNT = 1024;
constexpr int CW_QHP = 2048, CW_KHP = 2112;

__device__ __forceinline__ unsigned short f2bf(float f) { unsigned u = __float_as_uint(f); return (unsigned short)((u + 0x7fffu + ((u >> 16) & 1u)) >> 16); }
__device__ __forceinline__ float bf2f(unsigned short b) { return __uint_as_float(((unsigned)b) << 16); }
__device__ __forceinline__ float wave_sum(float v) {
#pragma unroll
    for (int o = 1; o < 64; o <<= 1) v += __shfl_xor(v, o);
    return v;
}


#define LAS __attribute__((address_space(3)))
#define GAS __attribute__((address_space(1)))
typedef unsigned v4u __attribute__((ext_vector_type(4)));
#define LDS_WAIT() asm volatile("s_waitcnt lgkmcnt(0)" ::: "memory")
#define VM_WAIT() asm volatile("s_waitcnt vmcnt(0)" ::: "memory")
constexpr int NWAVES = 8, NTHREADS = NWAVES * 64;
constexpr int PROBE_T = -1;
constexpr int REP_PHASE = -1;
#define REPS(k) for (int rep_ = 0; rep_ < ((REP_PHASE == (k)) ? 2 : 1); ++rep_)
constexpr bool ATTN_SCHED = true;
constexpr bool FOX_SKIP = true;
constexpr bool WT_STORES = false;
constexpr bool X1_BF16 = true;
constexpr bool Y_F8 = true;
constexpr bool MOE_F8 = true;
constexpr bool CVT_DMA = true;
constexpr int NCVT = 8;
constexpr int CVT_SPLIT = 20 * 512;
constexpr bool OVERLAP_CVT = true;
constexpr bool OPT_GEMM = true;
constexpr bool OPT_ROUTER = true;
constexpr bool OPT_ATTN = true;

#define XB_TMO      128
#define XB_XCNT(j)  (256  + 64 * (j))
#define XB_XSUB(j)  (1280 + 64 * (j))
#define XB_XGEN(j)  (2304 + 64 * (j))
#define XB_TOP      3328
#define XB_TOPGEN   3392
#define XCD_BAR_WORDS 3456
#define XB_SPIN_CAP (1u << 20)
__device__ __forceinline__ unsigned xb_ld(unsigned* p)              { return __hip_atomic_load(p, __ATOMIC_RELAXED, __HIP_MEMORY_SCOPE_AGENT); }
__device__ __forceinline__ unsigned xb_add(unsigned* p, unsigned v) { return __hip_atomic_fetch_add(p, v, __ATOMIC_RELAXED, __HIP_MEMORY_SCOPE_AGENT); }
__device__ __forceinline__ unsigned xb_xcc_id() { return (unsigned)__builtin_amdgcn_s_getreg((3 << 11) | 20) & 0xFu; }
#define XB_SPIN(cond, bar) do { unsigned _sp = 0; while (cond) { __builtin_amdgcn_s_sleep(1); \
    if ((++_sp & 255u) == 0u) { if (xb_ld(&(bar)[XB_TMO])) break; if (_sp > XB_SPIN_CAP) { atomicAdd(&(bar)[XB_TMO], 1u); break; } } } } while (0)
struct XcdBarrier { unsigned* bar; unsigned x; volatile LAS unsigned* st; };
__device__ __forceinline__ XcdBarrier xcd_barrier_post(unsigned* bar, volatile LAS unsigned* st) {
    XcdBarrier b; b.bar = bar; b.x = xb_xcc_id(); b.st = st;
    if (threadIdx.x == 0) (void)xb_add(&bar[XB_XCNT(b.x)], 1u);
    return b;
}
__device__ __forceinline__ void xcd_barrier_complete(unsigned* bar, unsigned x, unsigned& nloc, unsigned& nx) {
    const unsigned G = gridDim.x * gridDim.y * gridDim.z;
    unsigned sum, cnt, mine, sp = 0u;
    for (;;) {
        sum = 0u; cnt = 0u; mine = 0u;
#pragma unroll
        for (unsigned j = 0; j < 16; ++j) { const unsigned c = xb_ld(&bar[XB_XCNT(j)]); sum += c; cnt += (c > 0u) ? 1u : 0u; mine = (j == x) ? c : mine; }
        if (sum == G) break;
        __builtin_amdgcn_s_sleep(1);
        if ((++sp & 255u) == 0u) { if (xb_ld(&bar[XB_TMO])) break; if (sp > XB_SPIN_CAP) { atomicAdd(&bar[XB_TMO], 1u); break; } }
    }
    nloc = mine > 0u ? mine : 1u; nx = cnt > 0u ? cnt : 1u;
}
__device__ __forceinline__ void xcd_barrier(const XcdBarrier& b) {
    asm volatile("s_waitcnt vmcnt(0)" ::: "memory");
    __syncthreads();
    if (threadIdx.x == 0) {
        unsigned* bar = b.bar;
        __builtin_amdgcn_s_waitcnt(0);
        unsigned nloc = b.st[0], nx = b.st[1];
        if (nloc == 0u) { xcd_barrier_complete(bar, b.x, nloc, nx); b.st[0] = nloc; b.st[1] = nx; }
        const unsigned old = xb_add(&bar[XB_XSUB(b.x)], 1u);
        const unsigned gen = old / nloc;
        if (old + 1u == (gen + 1u) * nloc) {
            __builtin_amdgcn_fence(__ATOMIC_RELEASE, "agent");
            asm volatile("s_waitcnt vmcnt(0)" ::: "memory");
            const unsigned og = xb_add(&bar[XB_TOP], 1u);
            const unsigned tg = og / nx;
            if (og + 1u == (tg + 1u) * nx) xb_add(&bar[XB_TOPGEN], 1u);
            else XB_SPIN(xb_ld(&bar[XB_TOPGEN]) == tg, bar);
            __builtin_amdgcn_fence(__ATOMIC_ACQUIRE, "agent");
            xb_add(&bar[XB_XGEN(b.x)], 1u);
            asm volatile("s_waitcnt vmcnt(0)" ::: "memory");
        } else {
            XB_SPIN(xb_ld(&bar[XB_XGEN(b.x)]) == gen, bar);
            __builtin_amdgcn_fence(__ATOMIC_ACQUIRE, "agent");
            asm volatile("s_waitcnt vmcnt(0)" ::: "memory");
        }
    }
    __syncthreads();
}

constexpr int RING_OFF = 0, RING_BYTES = 131072;
constexpr int TAB_OFF = 131072;
constexpr int TAB2_OFF = TAB_OFF + 10 * 1024, TB_OFF = TAB_OFF + 20 * 1024;
constexpr int LDSCTL_OFF = 152576, MISC_OFF = LDSCTL_OFF + 320;
constexpr int LDS_BYTES = 155648;
constexpr int CW_BAR = 4096;

struct Args {
    const float *x, *g1, *w_in, *b_f, *g_fox, *g_sb, *w_out, *g2, *w_router, *b_router, *w1, *b1, *w2, *b2, *gf;
    float* out; unsigned char* ws;
};

__device__ __forceinline__ int mapcol(int mode, int n) {
    if (mode == 1) return n < 1536 ? n : n + 8;
    if (mode == 2) { const int pn = n >> 8, j = n & 255; return j < 128 ? 128 * pn + j : 1024 + 128 * pn + (j - 128); }
    return n;
}
__device__ __forceinline__ unsigned pk4_fp8(float a, float b, float c, float d) {
    a = __builtin_amdgcn_fmed3f(a, -448.f, 448.f); b = __builtin_amdgcn_fmed3f(b, -448.f, 448.f); c = __builtin_amdgcn_fmed3f(c, -448.f, 448.f); d = __builtin_amdgcn_fmed3f(d, -448.f, 448.f);
    int w = __builtin_amdgcn_cvt_pk_fp8_f32(a, b, 0, false); w = __builtin_amdgcn_cvt_pk_fp8_f32(c, d, w, true); return (unsigned)w;
}
__device__ __forceinline__ unsigned pk2(float lo, float hi) { unsigned r; asm("v_cvt_pk_bf16_f32 %0, %1, %2" : "=v"(r) : "v"(lo), "v"(hi)); return r; }
struct TrItem { const float* W; bf16_t* WT; const float* gA; const float* gB; int K, Nin, Nout, mode, gsplit, item, nbsh, f8; };
template <bool NT> __device__ __forceinline__ void tr_load(const TrItem& t, int lane, f32x4 (&v)[8]) {
    const int nblk = t.Nout / 32, kb = t.nbsh >= 0 ? (t.item >> t.nbsh) : t.item / nblk, nb = t.nbsh >= 0 ? (t.item & (nblk - 1)) : t.item % nblk, k0 = 64 * kb, n0 = 32 * nb, l7 = lane & 7, kr = lane >> 3, col = mapcol(t.mode, n0 + 4 * l7);
#pragma unroll
    for (int i = 0; i < 8; ++i) { const f32x4* p = (const f32x4*)(t.W + (size_t)(k0 + 8 * i + kr) * t.Nin + col); v[i] = NT ? __builtin_nontemporal_load(p) : *p; }
}
__device__ __forceinline__ void tr_store(const TrItem& t, int lane, const f32x4 (&v)[8], LAS float* scr) {
    const int nblk = t.Nout / 32, kb = t.nbsh >= 0 ? (t.item >> t.nbsh) : t.item / nblk, nb = t.nbsh >= 0 ? (t.item & (nblk - 1)) : t.item % nblk, k0 = 64 * kb, n0 = 32 * nb, l7 = lane & 7, kr = lane >> 3;
#pragma unroll
    for (int i = 0; i < 8; ++i) { const int kk = 8 * i + kr, k = k0 + kk; const float gs = t.gA ? (k < t.gsplit ? t.gA[k] : t.gB[k - t.gsplit]) : 1.f;
        LAS float* sp = scr + kk * 33 + 4 * l7; sp[0] = v[i][0] * gs; sp[1] = v[i][1] * gs; sp[2] = v[i][2] * gs; sp[3] = v[i][3] * gs; }
    LDS_WAIT();
    if (t.f8) {
        const int c = lane & 3;
#pragma unroll
        for (int j = 0; j < 2; ++j) { const int n = (lane >> 2) + 16 * j; const LAS float* sp = scr + (16 * c) * 33 + n;
            v4u o; o.x = pk4_fp8(32.f * sp[0 * 33], 32.f * sp[1 * 33], 32.f * sp[2 * 33], 32.f * sp[3 * 33]); o.y = pk4_fp8(32.f * sp[4 * 33], 32.f * sp[5 * 33], 32.f * sp[6 * 33], 32.f * sp[7 * 33]);
            o.z = pk4_fp8(32.f * sp[8 * 33], 32.f * sp[9 * 33], 32.f * sp[10 * 33], 32.f * sp[11 * 33]); o.w = pk4_fp8(32.f * sp[12 * 33], 32.f * sp[13 * 33], 32.f * sp[14 * 33], 32.f * sp[15 * 33]);
            *(v4u*)((unsigned char*)t.WT + (size_t)(n0 + n) * t.K + k0 + 16 * c) = o; }
    } else {
    const int c = lane & 7;
#pragma unroll
    for (int j = 0; j < 4; ++j) { const int n = (lane >> 3) + 8 * j; const LAS float* sp = scr + (8 * c) * 33 + n;
        v4u o; o.x = pk2(sp[0 * 33], sp[1 * 33]); o.y = pk2(sp[2 * 33], sp[3 * 33]); o.z = pk2(sp[4 * 33], sp[5 * 33]); o.w = pk2(sp[6 * 33], sp[7 * 33]);
        *(v4u*)(t.WT + (size_t)(n0 + n) * t.K + k0 + 8 * c) = o; }
    }
    LDS_WAIT();
}
constexpr int I_W1 = (DM / 64) * (2048 / 32), I_W2 = (DM / 64) * (DM / 32), N_EXP_ITEMS = NE * (I_W1 + I_W2);
__device__ __forceinline__ TrItem expert_item(const float* w1, const float* w2, const float* g2, bf16_t* W1T, bf16_t* W2T, int r) {
    TrItem t;
    t.f8 = MOE_F8 ? 1 : 0;
    if (r < NE * I_W1) { const int e = r / I_W1; t.W = w1 + (size_t)e * DM * 2048; t.WT = MOE_F8 ? (bf16_t*)((unsigned char*)W1T + (size_t)e * 2048 * DM) : W1T + (size_t)e * 2048 * DM; t.gA = g2; t.gB = nullptr; t.K = DM; t.Nin = 2048; t.Nout = 2048; t.mode = 2; t.gsplit = DM; t.item = r % I_W1; t.nbsh = 6; }
    else { r -= NE * I_W1; const int e = r / I_W2; t.W = w2 + (size_t)e * DM * DM; t.WT = MOE_F8 ? (bf16_t*)((unsigned char*)W2T + (size_t)e * DM * DM) : W2T + (size_t)e * DM * DM; t.gA = nullptr; t.gB = nullptr; t.K = DM; t.Nin = DM; t.Nout = DM; t.mode = 0; t.gsplit = DM; t.item = r % I_W2; t.nbsh = 5; }
    return t;
}
__device__ __forceinline__ void convert_experts(const float* w1, const float* w2, const float* g2, bf16_t* W1T, bf16_t* W2T, int first, int stride, int N_END, int lane, LAS float* scr) {
    f32x4 v0[8], v1[8];
#define CVT_LOAD(v, idx) do { if ((idx) < N_END) { const TrItem t_ = expert_item(w1, w2, g2, W1T, W2T, (idx)); tr_load<true>(t_, lane, v); } } while (0)
#define CVT_STORE(v, idx) do { if ((idx) < N_END) { const TrItem t_ = expert_item(w1, w2, g2, W1T, W2T, (idx)); tr_store(t_, lane, v, scr); } } while (0)
    int it = first; asm volatile("" : "+v"(lane));
    CVT_LOAD(v0, it);
#pragma unroll 1
    for (; it < N_END; it += 2 * stride) {
        CVT_LOAD(v1, it + stride); CVT_STORE(v0, it);
        CVT_LOAD(v0, it + 2 * stride); CVT_STORE(v1, it + stride);
    }
#undef CVT_LOAD
#undef CVT_STORE
}

__device__ __forceinline__ void dma16(const void* gsrc, unsigned lds_dst) { unsigned keep;
    asm volatile("s_mov_b32 %0, m0\n\ts_mov_b32 m0, %2\n\ts_nop 0\n\tglobal_load_lds_dwordx4 %1, off\n\ts_mov_b32 m0, %0" : "=&s"(keep) : "v"(gsrc), "s"(lds_dst) : "memory"); }
struct CvtItem { const float* W; unsigned char* WT; int Nin, k0, n0, col0, useg; };
__device__ __forceinline__ CvtItem cvt_item(const float* w1, const float* w2, bf16_t* W1T, bf16_t* W2T, int r) {
    CvtItem t;
    if (r < NE * I_W1) { const int e = r / I_W1, it = r % I_W1; t.W = w1 + (size_t)e * DM * 2048; t.WT = (unsigned char*)W1T + (size_t)e * 2048 * DM; t.Nin = 2048; t.k0 = 64 * (it >> 6); t.n0 = 32 * (it & 63); t.col0 = mapcol(2, t.n0); t.useg = 1; }
    else { r -= NE * I_W1; const int e = r / I_W2, it = r % I_W2; t.W = w2 + (size_t)e * DM * DM; t.WT = (unsigned char*)W2T + (size_t)e * DM * DM; t.Nin = DM; t.k0 = 64 * (it >> 5); t.n0 = 32 * (it & 31); t.col0 = t.n0; t.useg = 0; }
    return t;
}
__device__ __forceinline__ void cvt_issue(const CvtItem& t, int lane, unsigned ldsbuf) {
#pragma unroll
    for (int i = 0; i < 8; ++i) { const int kl = 8 * i + (lane >> 3), qs = ((lane & 7) - 2 * (kl >> 4)) & 7;
        dma16(t.W + (size_t)(t.k0 + kl) * t.Nin + t.col0 + 4 * qs, (unsigned)__builtin_amdgcn_readfirstlane(ldsbuf + i * 1024)); }
}
__device__ __forceinline__ void cvt_finish(const CvtItem& t, int lane, const LAS float* buf, const LAS float* gl) {
    const int c = lane & 3;
    f32x4 g[4];
#pragma unroll
    for (int m = 0; m < 4; ++m) g[m] = t.useg ? *(const LAS f32x4*)(gl + t.k0 + 16 * c + 4 * m) * 32.f : (f32x4){32.f, 32.f, 32.f, 32.f};
#pragma unroll
    for (int j = 0; j < 2; ++j) { const int n = (lane >> 2) + 16 * j; const LAS float* sp = buf + (16 * c) * 32 + ((n + 8 * c) & 31);
        v4u o;
        o.x = pk4_fp8(sp[0 * 32] * g[0][0], sp[1 * 32] * g[0][1], sp[2 * 32] * g[0][2], sp[3 * 32] * g[0][3]);   o.y = pk4_fp8(sp[4 * 32] * g[1][0], sp[5 * 32] * g[1][1], sp[6 * 32] * g[1][2], sp[7 * 32] * g[1][3]);
        o.z = pk4_fp8(sp[8 * 32] * g[2][0], sp[9 * 32] * g[2][1], sp[10 * 32] * g[2][2], sp[11 * 32] * g[2][3]); o.w = pk4_fp8(sp[12 * 32] * g[3][0], sp[13 * 32] * g[3][1], sp[14 * 32] * g[3][2], sp[15 * 32] * g[3][3]);
        *(v4u*)(t.WT + (size_t)(t.n0 + n) * DM + t.k0 + 16 * c) = o; }
}
__device__ __forceinline__ void convert_experts_dma(const float* w1, const float* w2, bf16_t* W1T, bf16_t* W2T, int first, int stride, int N_END, int lane_, unsigned lds0, const LAS float* buf0, const LAS float* gl) {
    int lane = lane_; asm volatile("" : "+v"(lane));
    int it = first;
    if (it < N_END) { const CvtItem t = cvt_item(w1, w2, W1T, W2T, it); cvt_issue(t, lane, lds0); }
#pragma unroll 1
    for (; it < N_END; it += 2 * stride) {
        const int nx = it + stride, nn = it + 2 * stride;
        if (nx < N_END) { const CvtItem t = cvt_item(w1, w2, W1T, W2T, nx); cvt_issue(t, lane, lds0 + 8192); asm volatile("s_waitcnt vmcnt(8)" ::: "memory"); } else asm volatile("s_waitcnt vmcnt(0)" ::: "memory");
        { const CvtItem t = cvt_item(w1, w2, W1T, W2T, it); cvt_finish(t, lane, buf0, gl); }
        if (nx < N_END) {
            asm volatile("s_waitcnt lgkmcnt(0)" ::: "memory");
            if (nn < N_END) { const CvtItem t = cvt_item(w1, w2, W1T, W2T, nn); cvt_issue(t, lane, lds0); asm volatile("s_waitcnt vmcnt(8)" ::: "memory"); } else asm volatile("s_waitcnt vmcnt(0)" ::: "memory");
            { const CvtItem t = cvt_item(w1, w2, W1T, W2T, nx); cvt_finish(t, lane, buf0 + 2048, gl); }
            asm volatile("s_waitcnt lgkmcnt(0)" ::: "memory");
        }
    }
    asm volatile("s_waitcnt vmcnt(0)" ::: "memory");
}

__device__ __forceinline__ float log_sigmoid(float v) { return fminf(v, 0.f) - log1pf(expf(-fabsf(v))); }
__device__ __forceinline__ void rms1_row(const float4 (&v)[4], const LAS float* wf  , const float* __restrict__ b_f,
                                         bf16_t* __restrict__ XN, float* __restrict__ FLOG, int row, int lane) {
    float ss = 0.f;
#pragma unroll
    for (int j = 0; j < 4; ++j) ss += v[j].x * v[j].x + v[j].y * v[j].y + v[j].z * v[j].z + v[j].w * v[j].w;
    ss = wave_sum(ss);
    const float rstd = rsqrtf(ss * (1.f / DM) + EPS);
    float fg[8];
#pragma unroll
    for (int g = 0; g < 8; ++g) fg[g] = 0.f;
#pragma unroll
    for (int j = 0; j < 4; ++j) {
        const int c0 = 4 * (lane + 64 * j);
        uint2 o; o.x = pk2(v[j].x * rstd, v[j].y * rstd); o.y = pk2(v[j].z * rstd, v[j].w * rstd);
        *(uint2*)(XN + (size_t)row * DM + c0) = o;
#pragma unroll
        for (int g = 0; g < 8; ++g) { const f32x4 w = *(const LAS f32x4*)(wf + g * DM + c0);
            fg[g] += v[j].x * w[0] + v[j].y * w[1] + v[j].z * w[2] + v[j].w * w[3]; }
    }
    const bool b0 = lane & 1, b1 = lane & 2, b2 = lane & 4;
    float g4[4], h2[2];
#pragma unroll
    for (int i = 0; i < 4; ++i) g4[i] = (b0 ? fg[2 * i + 1] : fg[2 * i]) + __shfl_xor(b0 ? fg[2 * i] : fg[2 * i + 1], 1);
#pragma unroll
    for (int i = 0; i < 2; ++i) h2[i] = (b1 ? g4[2 * i + 1] : g4[2 * i]) + __shfl_xor(b1 ? g4[2 * i] : g4[2 * i + 1], 2);
    float f = (b2 ? h2[1] : h2[0]) + __shfl_xor(b2 ? h2[0] : h2[1], 4);
    f += __shfl_xor(f, 8); f += __shfl_xor(f, 16); f += __shfl_xor(f, 32);
    if (lane < 8) FLOG[(size_t)row * 8 + lane] = log_sigmoid(f * rstd + b_f[lane]);
}
__device__ __forceinline__ void cumsum_wg(const float* __restrict__ FLOG, float* __restrict__ CUM, int bh, LAS float* part) {
    const int b = bh >> 3, h = bh & 7, t = threadIdx.x;
    float loc[8]; float s = 0.f;
#pragma unroll
    for (int i = 0; i < 8; ++i) { loc[i] = FLOG[((size_t)b * SEQ + t * 8 + i) * 8 + h]; s += loc[i]; }
    part[t] = s; __syncthreads();
    float run = 0.f; for (int i = 0; i < t; ++i) run += part[i];
#pragma unroll
    for (int i = 0; i < 8; ++i) { run += loc[i]; CUM[(size_t)bh * SEQ + t * 8 + i] = run * LOG2E; }
    __syncthreads();
}

template <int NT> __device__ __forceinline__ void wave_mma(f32x4 (&acc)[NT], const bf16_t* ap, const bf16_t* const (&bp)[NT], int K) {
    for (int k0 = 0; k0 < K; k0 += 32) {
        const bf16x8 a = *(const bf16x8*)(ap + k0);
#pragma unroll
        for (int t = 0; t < NT; ++t) { const bf16x8 b = *(const bf16x8*)(bp[t] + k0); acc[t] = __builtin_amdgcn_mfma_f32_16x16x32_bf16(a, b, acc[t], 0, 0, 0); }
    }
}
__device__ __forceinline__ void nv_inproj(const bf16_t* __restrict__ XN, const bf16_t* __restrict__ WINT, bf16_t* __restrict__ PROJ, int item, int lane) {
    const int n0 = (item % 48) * 64, m0 = (item / 48) * 16, r = lane & 15, q = lane >> 4;
    f32x4 acc[4];
#pragma unroll
    for (int t = 0; t < 4; ++t) acc[t] = (f32x4){0.f, 0.f, 0.f, 0.f};
    const bf16_t* ap = XN + (size_t)(m0 + r) * DM + 8 * q;
    const bf16_t* bp[4];
#pragma unroll
    for (int t = 0; t < 4; ++t) bp[t] = WINT + (size_t)(n0 + 16 * t + r) * DM + 8 * q;
    wave_mma<4>(acc, ap, bp, DM);
    const float sc = (n0 < 512 || (n0 >= 1536 && n0 < 2048)) ? C2 : 1.f;
#pragma unroll
    for (int t = 0; t < 4; ++t)
#pragma unroll
        for (int j = 0; j < 4; ++j) PROJ[(size_t)(m0 + 4 * q + j) * NPROJ + n0 + 16 * t + r] = f2bf(acc[t][j] * sc);
}

template <int TYPE> __device__ __forceinline__ void nv_attn(const bf16_t* __restrict__ PROJ, const float* __restrict__ CUM, bf16_t* __restrict__ OMIX, float* __restrict__ SSQ,
                                                          int bh, int qblk, int lane, LAS unsigned char* wl) {
    LAS bf16_t* Ks = (LAS bf16_t*)wl; LAS bf16_t* Vs = (LAS bf16_t*)(wl + 8192); LAS float* Cs = (LAS float*)(wl + 16384);
    const int b = bh >> 3, h = bh & 7, t = qblk * 64 + lane;
    const size_t row = (size_t)b * SEQ + t;
    const int qcol = (TYPE == 0 ? 0 : 1536) + h * HD, kcol = qcol + 512, vcol = qcol + 1024;
    float q[64], o[64];
#pragma unroll
    for (int c = 0; c < 8; ++c) { const bf16x8 v = *(const bf16x8*)(PROJ + row * NPROJ + qcol + 8 * c);
#pragma unroll
        for (int j = 0; j < 8; ++j) q[8 * c + j] = bf2f((unsigned short)v[j]); }
#pragma unroll
    for (int d = 0; d < 64; ++d) o[d] = 0.f;
    float m = -INFINITY, l = 0.f, R = 1.f;
    const float cq = CUM[(size_t)bh * SEQ + t];
    for (int it = 0; it <= qblk; ++it) {
        const int kt = (TYPE == 0) ? it : qblk - it;
        LDS_WAIT();
        for (int i = 0; i < 64; ++i) { const size_t kr = ((size_t)b * SEQ + kt * 64 + i) * NPROJ; Ks[i * 64 + lane] = PROJ[kr + kcol + lane]; Vs[i * 64 + lane] = PROJ[kr + vcol + lane]; }
        Cs[lane] = CUM[(size_t)bh * SEQ + kt * 64 + lane];
        LDS_WAIT();
        for (int ss = 0; ss < 64; ++ss) {
            const int s = (TYPE == 0) ? ss : 63 - ss; const int ks = kt * 64 + s;
            float dot = 0.f;
#pragma unroll
            for (int d = 0; d < 64; d += 8) { const bf16x8 kv = *(const LAS bf16x8*)&Ks[s * 64 + d];
#pragma unroll
                for (int j = 0; j < 8; ++j) dot += q[d + j] * bf2f((unsigned short)kv[j]); }
            if (TYPE == 0) {
                if (ks <= t) {
                    const float xv = dot + cq - Cs[s]; const float mn = fmaxf(m, xv); const float sc = exp2f(m - mn), p = exp2f(xv - mn);
                    l = l * sc + p; m = mn;
#pragma unroll
                    for (int d = 0; d < 64; d += 8) { const bf16x8 vv = *(const LAS bf16x8*)&Vs[s * 64 + d];
#pragma unroll
                        for (int j = 0; j < 8; ++j) o[d + j] = o[d + j] * sc + p * bf2f((unsigned short)vv[j]); }
                }
            } else {
                if (ks < t) {
                    const float z = fminf(fmaxf(dot, -80.f), 80.f); const float e = exp2f(z); const float rr = 1.f / (1.f + e); const float a = e * rr * R; R *= rr;
#pragma unroll
                    for (int d = 0; d < 64; d += 8) { const bf16x8 vv = *(const LAS bf16x8*)&Vs[s * 64 + d];
#pragma unroll
                        for (int j = 0; j < 8; ++j) o[d + j] += a * bf2f((unsigned short)vv[j]); }
                }
            }
        }
    }
    const float inv = (TYPE == 0) ? 1.f / l : 1.f;
    float ssq = 0.f;
#pragma unroll
    for (int d = 0; d < 64; ++d) { o[d] *= inv; ssq += o[d] * o[d]; }
    SSQ[row * 16 + TYPE * 8 + h] = ssq;
#pragma unroll
    for (int c = 0; c < 8; ++c) { bf16x8 v;
#pragma unroll
        for (int j = 0; j < 8; ++j) v[j] = (short)f2bf(o[8 * c + j]);
        *(bf16x8*)(OMIX + row * DM + TYPE * GW + h * HD + 8 * c) = v; }
}

__device__ __forceinline__ void nv_wout(const bf16_t* __restrict__ OMIX, const bf16_t* __restrict__ WOUTT, const float* __restrict__ SSQ, const float* __restrict__ x,
                                        float* __restrict__ X1, bf16_t* __restrict__ X1B, int item, int lane) {
    const int n0 = (item & 15) * 64, m0 = (item >> 4) * 16, r = lane & 15, q = lane >> 4;
    f32x4 af[4], as[4];
#pragma unroll
    for (int t = 0; t < 4; ++t) { af[t] = (f32x4){0.f, 0.f, 0.f, 0.f}; as[t] = (f32x4){0.f, 0.f, 0.f, 0.f}; }
    const bf16_t* ap = OMIX + (size_t)(m0 + r) * DM + 8 * q;
    const bf16_t* bp[4]; const bf16_t* bp2[4];
#pragma unroll
    for (int t = 0; t < 4; ++t) { bp[t] = WOUTT + (size_t)(n0 + 16 * t + r) * DM + 8 * q; bp2[t] = bp[t] + GW; }
    wave_mma<4>(af, ap, bp, GW);
    wave_mma<4>(as, ap + GW, bp2, GW);
#pragma unroll
    for (int j = 0; j < 4; ++j) {
        const size_t row = m0 + 4 * q + j; const float* sp = SSQ + row * 16;
        float sf = 0.f, s2 = 0.f;
#pragma unroll
        for (int h = 0; h < 8; ++h) { sf += sp[h]; s2 += sp[8 + h]; }
        const float rf = rsqrtf(sf * (1.f / GW) + EPS), rs = rsqrtf(s2 * (1.f / GW) + EPS);
#pragma unroll
        for (int t = 0; t < 4; ++t) { const size_t idx = row * DM + n0 + 16 * t + r; const float v = x[idx] + rf * af[t][j] + rs * as[t][j]; X1[idx] = v; X1B[idx] = f2bf(v); }
    }
}

__device__ __forceinline__ void nv_router(const float* __restrict__ X1, const float* __restrict__ WR, const float* __restrict__ b_router, float* __restrict__ RSTD2,
                                          float* __restrict__ RW, int* __restrict__ LIST, int* __restrict__ SLOTEP, unsigned* __restrict__ CNT, int item, int lane) {
    const int e = lane & 31, tok = item * 2 + (lane >> 5);
    const float* xr = X1 + (size_t)tok * DM;
    float acc = 0.f, ss = 0.f;
    for (int k = 0; k < DM; ++k) { const float xv = xr[k]; acc += xv * WR[k * NE + e]; ss += xv * xv; }
    const float rstd = rsqrtf(ss * (1.f / DM) + EPS);
    float logit = acc * rstd + b_router[e];
    if (e == 0) RSTD2[tok] = rstd;
    float tv[4]; int ti[4];
#pragma unroll
    for (int k = 0; k < 4; ++k) {
        float bv = logit; int bi = e;
#pragma unroll
        for (int o = 1; o < 32; o <<= 1) { const float ov = __shfl_xor(bv, o); const int oi = __shfl_xor(bi, o); if (ov > bv || (ov == bv && oi < bi)) { bv = ov; bi = oi; } }
        tv[k] = bv; ti[k] = bi; if (e == bi) logit = -INFINITY;
    }
    const float e0 = 1.f, e1 = expf(tv[1] - tv[0]), e2 = expf(tv[2] - tv[0]), e3 = expf(tv[3] - tv[0]); const float inv = 1.f / (e0 + e1 + e2 + e3);
    const float w0 = e0 * inv, w1 = e1 * inv, w2 = e2 * inv, w3 = e3 * inv;
    int myk = -1; float myw = 0.f;
    if (e == ti[0]) { myk = 0; myw = w0; } if (e == ti[1]) { myk = 1; myw = w1; } if (e == ti[2]) { myk = 2; myw = w2; } if (e == ti[3]) { myk = 3; myw = w3; }
    if (myk >= 0) { const int slot = tok * 4 + myk; const unsigned pos = atomicAdd(&CNT[e], 1u); LIST[(size_t)e * LIST_CAP + pos] = slot; RW[slot] = myw; SLOTEP[slot] = e * 16384 + (int)pos; }
}


typedef float f32x16 __attribute__((ext_vector_type(16)));
__device__ __forceinline__ void router_wg(const float* __restrict__ X1, const float* __restrict__ WR, const float* __restrict__ b_router, float* __restrict__ RSTD2,
                                          float* __restrict__ RW, int* __restrict__ LIST, int* __restrict__ SLOTEP, unsigned* __restrict__ CNT, int tokbase, LAS unsigned char* L) {
    int tid_ = threadIdx.x; asm volatile("" : "+v"(tid_));
    const int tid = tid_, lane = tid & 63, wave = __builtin_amdgcn_readfirstlane(tid >> 6), kq = wave & 3, tile = wave >> 2, r32 = lane & 31, hi = lane >> 5;
    LAS float* Dx = (LAS float*)L; LAS float* SSx = (LAS float*)(L + 32768); LAS unsigned* lcnt = (LAS unsigned*)(L + 33792); LAS unsigned* lbase = (LAS unsigned*)(L + 33920);
    if (tid < NE) lcnt[tid] = 0u;
    const int tok = tokbase + tile * 32 + r32;
    const float* xp = X1 + (size_t)tok * DM + kq * 256 + 4 * hi;
    const float* wp = WR + (size_t)(kq * 256 + 4 * hi) * NE + r32;
    f32x16 acc;
#pragma unroll
    for (int r = 0; r < 16; ++r) acc[r] = 0.f;
    float ss = 0.f;
#pragma unroll 1
    for (int mc = 0; mc < 4; ++mc) {
        float4 xv[8];
#pragma unroll
        for (int m = 0; m < 8; ++m) {
            if (X1_BF16) { const uint2 q = *(const uint2*)((const bf16_t*)X1 + (size_t)tok * DM + kq * 256 + 4 * hi + (mc * 8 + m) * 8);
                xv[m].x = __uint_as_float(q.x << 16); xv[m].y = __uint_as_float(q.x & 0xffff0000u); xv[m].z = __uint_as_float(q.y << 16); xv[m].w = __uint_as_float(q.y & 0xffff0000u); }
            else xv[m] = *(const float4*)(xp + (mc * 8 + m) * 8); }
#pragma unroll
        for (int m = 0; m < 8; ++m) {
            const float* w4 = wp + (size_t)((mc * 8 + m) * 8) * NE;
            const float w0 = w4[0], w1 = w4[NE], w2 = w4[2 * NE], w3 = w4[3 * NE];
            acc = __builtin_amdgcn_mfma_f32_32x32x2f32(w0, xv[m].x, acc, 0, 0, 0);
            acc = __builtin_amdgcn_mfma_f32_32x32x2f32(w1, xv[m].y, acc, 0, 0, 0);
            acc = __builtin_amdgcn_mfma_f32_32x32x2f32(w2, xv[m].z, acc, 0, 0, 0);
            acc = __builtin_amdgcn_mfma_f32_32x32x2f32(w3, xv[m].w, acc, 0, 0, 0);
            ss += xv[m].x * xv[m].x + xv[m].y * xv[m].y + xv[m].z * xv[m].z + xv[m].w * xv[m].w;
        }
    }
    { auto rr = __builtin_amdgcn_permlane32_swap(__float_as_uint(ss), __float_as_uint(ss), false, false); ss = __uint_as_float(rr[0]) + __uint_as_float(rr[1]); }
#pragma unroll
    for (int r = 0; r < 16; ++r) Dx[(wave * 16 + r) * 64 + lane] = acc[r];
    if (hi == 0) SSx[wave * 32 + r32] = ss;
    LDS_WAIT(); __syncthreads();
    int ea = 0, eb = 0; float wa = 0.f, wb = 0.f; unsigned la = 0u, lb = 0u;
    if (kq == 0) {
        float v[16]; float sst = 0.f;
#pragma unroll
        for (int w = 0; w < 4; ++w) sst += SSx[(tile * 4 + w) * 32 + r32];
        const float rstd = rsqrtf(sst * (1.f / DM) + EPS);
#pragma unroll
        for (int r = 0; r < 16; ++r) { float a = 0.f;
#pragma unroll
            for (int w = 0; w < 4; ++w) a += Dx[((tile * 4 + w) * 16 + r) * 64 + lane];
            v[r] = a * rstd + b_router[(r & 3) + 8 * (r >> 2) + 4 * hi]; }
        if (hi == 0) RSTD2[tok] = rstd;
        float tv[4]; int te[4];
#pragma unroll
        for (int k = 0; k < 4; ++k) {
            float bv = v[0]; int br = 0;
#pragma unroll
            for (int r = 1; r < 16; ++r) if (v[r] > bv) { bv = v[r]; br = r; }
            const int be = (br & 3) + 8 * (br >> 2) + 4 * hi;
            auto r1 = __builtin_amdgcn_permlane32_swap(__float_as_uint(bv), __float_as_uint(bv), false, false);
            auto r2 = __builtin_amdgcn_permlane32_swap((unsigned)be, (unsigned)be, false, false);
            const float pv = __uint_as_float(hi ? r1[0] : r1[1]); const int pe = (int)(hi ? r2[0] : r2[1]);
            const bool mine = (bv > pv) || (bv == pv && be < pe);
            tv[k] = mine ? bv : pv; te[k] = mine ? be : pe;
#pragma unroll
            for (int r = 0; r < 16; ++r) v[r] = (mine && r == br) ? -INFINITY : v[r];
        }
        const float e1 = expf(tv[1] - tv[0]), e2 = expf(tv[2] - tv[0]), e3 = expf(tv[3] - tv[0]); const float inv = 1.f / (1.f + e1 + e2 + e3);
        ea = hi ? te[2] : te[0]; eb = hi ? te[3] : te[1]; wa = (hi ? e2 : 1.f) * inv; wb = (hi ? e3 : e1) * inv;
        la = atomicAdd((unsigned*)&lcnt[ea], 1u); lb = atomicAdd((unsigned*)&lcnt[eb], 1u);
    }
    LDS_WAIT(); __syncthreads();
    if (tid < NE) { const unsigned c = lcnt[tid]; lbase[tid] = c ? atomicAdd(&CNT[tid], c) : 0u; }
    LDS_WAIT(); __syncthreads();
    if (kq == 0) {
        const int sa = tok * 4 + 2 * hi, sb = sa + 1;
        const int pa = (int)(lbase[ea] + la), pb = (int)(lbase[eb] + lb);
        LIST[(size_t)ea * LIST_CAP + pa] = sa; RW[sa] = wa; SLOTEP[sa] = ea * 16384 + pa;
        LIST[(size_t)eb * LIST_CAP + pb] = sb; RW[sb] = wb; SLOTEP[sb] = eb * 16384 + pb;
    }
    LDS_WAIT(); __syncthreads();
}

__device__ __forceinline__ bool moe_tile(const unsigned* CNT, int g, int& e, int& base, int& p0, int& cnt) {
    const int tile256 = g >> 4; base = 0;
    for (e = 0; e < NE; ++e) { const int nt = ((int)CNT[e] + 255) >> 8; if (tile256 < base + nt) break; base += nt; }
    if (e == NE) return false;
    cnt = (int)CNT[e]; p0 = (g - base * 16) * 16; return p0 < cnt;
}
__device__ __forceinline__ void nv_moe1(const bf16_t* __restrict__ X1B, const bf16_t* __restrict__ W1T, const float* __restrict__ b1, const float* __restrict__ RSTD2,
                                        const int* __restrict__ LIST, bf16_t* __restrict__ H, int e, int base, int p0, int cnt, int cg, int lane) {
    const int r = lane & 15, q = lane >> 4, c0 = cg * 32, pn = c0 >> 7, j0 = c0 & 127;
    const int* lst = LIST + (size_t)e * LIST_CAP;
    const int prow = p0 + r; const int tok = lst[prow < cnt ? prow : cnt - 1] >> 2;
    f32x4 acc[4];
#pragma unroll
    for (int t = 0; t < 4; ++t) acc[t] = (f32x4){0.f, 0.f, 0.f, 0.f};
    const bf16_t* ap = X1B + (size_t)tok * DM + 8 * q;
    const bf16_t* wb = W1T + (size_t)e * 2048 * DM + (size_t)(256 * pn + j0 + r) * DM + 8 * q;
    const bf16_t* bp[4] = {wb, wb + 16 * DM, wb + 128 * DM, wb + 144 * DM};
    wave_mma<4>(acc, ap, bp, DM);
#pragma unroll
    for (int j = 0; j < 4; ++j) {
        const int pr = p0 + 4 * q + j; if (pr >= cnt) continue;
        const float rs = RSTD2[lst[pr] >> 2];
#pragma unroll
        for (int t = 0; t < 2; ++t) {
            const int col = c0 + 16 * t + r;
            float glu = acc[t][j] * rs + b1[(size_t)e * 2048 + col], lin = acc[t + 2][j] * rs + b1[(size_t)e * 2048 + 1024 + col];
            glu = fminf(glu, 7.f); lin = fminf(fmaxf(lin, -7.f), 7.f);
            const float act = glu * (1.f / (1.f + expf(-1.702f * glu))) * (lin + 1.f);
            H[((size_t)base * 256 + pr) * DM + col] = f2bf(act);
        }
    }
}
__device__ __forceinline__ void nv_moe2(const bf16_t* __restrict__ H, const bf16_t* __restrict__ W2T, const float* __restrict__ b2, const float* __restrict__ RW,
                                        const int* __restrict__ LIST, bf16_t* __restrict__ Y, int e, int base, int p0, int cnt, int cg, int lane) {
    const int r = lane & 15, q = lane >> 4, n0 = cg * 64;
    const int* lst = LIST + (size_t)e * LIST_CAP;
    f32x4 acc[4];
#pragma unroll
    for (int t = 0; t < 4; ++t) acc[t] = (f32x4){0.f, 0.f, 0.f, 0.f};
    const bf16_t* ap = H + ((size_t)base * 256 + p0 + r) * DM + 8 * q;
    const bf16_t* bp[4];
#pragma unroll
    for (int t = 0; t < 4; ++t) bp[t] = W2T + (size_t)e * DM * DM + (size_t)(n0 + 16 * t + r) * DM + 8 * q;
    wave_mma<4>(acc, ap, bp, DM);
#pragma unroll
    for (int j = 0; j < 4; ++j) {
        const int pr = p0 + 4 * q + j; if (pr >= cnt) continue;
        const int slot = lst[pr]; const float w = RW[slot];
#pragma unroll
        for (int t = 0; t < 4; ++t) { const int col = n0 + 16 * t + r; Y[((size_t)base * 256 + pr) * DM + col] = f2bf((acc[t][j] + b2[(size_t)e * DM + col]) * w); }
    }
}

__device__ __forceinline__ void final_row(const float* X1, const bf16_t* __restrict__ Y, const int* __restrict__ SLOTEP, const int* __restrict__ TBG, const float* __restrict__ gf, float* out, int row, int lane) {
    int yr[4];
#pragma unroll
    for (int k = 0; k < 4; ++k) { const int ep = SLOTEP[row * 4 + k]; yr[k] = TBG[ep >> 14] * 256 + (ep & 16383); }
    float ss = 0.f;
    if (Y_F8) {
        const int c0 = 16 * lane; f32x4 v[4];
        if (X1_BF16) { const v4u q0 = *(const v4u*)((const bf16_t*)X1 + (size_t)row * DM + c0), q1 = *(const v4u*)((const bf16_t*)X1 + (size_t)row * DM + c0 + 8);
#pragma unroll
            for (int j = 0; j < 2; ++j) { v[j][0] = __uint_as_float(q0[2 * j] << 16); v[j][1] = __uint_as_float(q0[2 * j] & 0xffff0000u); v[j][2] = __uint_as_float(q0[2 * j + 1] << 16); v[j][3] = __uint_as_float(q0[2 * j + 1] & 0xffff0000u);
                v[2 + j][0] = __uint_as_float(q1[2 * j] << 16); v[2 + j][1] = __uint_as_float(q1[2 * j] & 0xffff0000u); v[2 + j][2] = __uint_as_float(q1[2 * j + 1] << 16); v[2 + j][3] = __uint_as_float(q1[2 * j + 1] & 0xffff0000u); } }
        else
#pragma unroll
        for (int j = 0; j < 4; ++j) v[j] = *(const f32x4*)(X1 + (size_t)row * DM + c0 + 4 * j);
#pragma unroll
        for (int k = 0; k < 4; ++k) { const v4u y = *(const v4u*)((const unsigned char*)Y + (size_t)yr[k] * DM + c0);
#pragma unroll
            for (int j = 0; j < 4; ++j) { const auto lo = __builtin_amdgcn_cvt_pk_f32_fp8((int)y[j], false), hi = __builtin_amdgcn_cvt_pk_f32_fp8((int)y[j], true);
                v[j][0] += lo[0] * 0.0625f; v[j][1] += lo[1] * 0.0625f; v[j][2] += hi[0] * 0.0625f; v[j][3] += hi[1] * 0.0625f; } }
#pragma unroll
        for (int j = 0; j < 4; ++j) ss += v[j][0] * v[j][0] + v[j][1] * v[j][1] + v[j][2] * v[j][2] + v[j][3] * v[j][3];
        ss = wave_sum(ss);
        const float rstd = rsqrtf(ss * (1.f / DM) + EPS);
#pragma unroll
        for (int j = 0; j < 4; ++j) { const f32x4 g = *(const f32x4*)(gf + c0 + 4 * j); *(f32x4*)(out + (size_t)row * DM + c0 + 4 * j) = v[j] * rstd * g; }
        return;
    }
    float4 v[4];
#pragma unroll
    for (int j = 0; j < 4; ++j) {
        const int c0 = 4 * (lane + 64 * j);
        v[j] = *(const float4*)(X1 + (size_t)row * DM + c0);
#pragma unroll
        for (int k = 0; k < 4; ++k) { const uint2 y = *(const uint2*)(Y + (size_t)yr[k] * DM + c0);
            v[j].x += bf2f((unsigned short)(y.x & 0xffff)); v[j].y += bf2f((unsigned short)(y.x >> 16)); v[j].z += bf2f((unsigned short)(y.y & 0xffff)); v[j].w += bf2f((unsigned short)(y.y >> 16)); }
        ss += v[j].x * v[j].x + v[j].y * v[j].y + v[j].z * v[j].z + v[j].w * v[j].w;
    }
    ss = wave_sum(ss);
    const float rstd = rsqrtf(ss * (1.f / DM) + EPS);
#pragma unroll
    for (int j = 0; j < 4; ++j) { const int c0 = 4 * (lane + 64 * j); const float4 g = *(const float4*)(gf + c0);
        float4 o; o.x = v[j].x * rstd * g.x; o.y = v[j].y * rstd * g.y; o.z = v[j].z * rstd * g.z; o.w = v[j].w * rstd * g.w; *(float4*)(out + (size_t)row * DM + c0) = o; }
}


namespace pg8 {
#define PG8_LAS __attribute__((address_space(3)))
typedef unsigned u32x4 __attribute__((ext_vector_type(4)));
typedef unsigned u32x2 __attribute__((ext_vector_type(2)));
typedef int i32x8 __attribute__((ext_vector_type(8)));
constexpr int BM = 256, BK = 64, HALF = 128, HTB = HALF * BK * 2  , STAGE_BYTES = 8 * HTB, NXCD = 8, WGM = 8;
__host__ __device__ __forceinline__ int lds_byte(int r, int c) { const int st = (r >> 4) * 2 + (c >> 5), rr = r & 15, cc = c & 31, ob = rr * 64 + cc * 2; return st * 1024 + (ob ^ (((ob >> 9) & 1) << 5)); }
__host__ __device__ __forceinline__ void stage_rc(int b, int& R, int& C) { const int st = b / 1024, sb = b % 1024, swz = sb ^ (((sb >> 9) & 1) << 5); R = (st >> 1) * 16 + swz / 64; C = (st & 1) * 32 + (swz % 64) / 2; }
__host__ __device__ __forceinline__ int perm32(int rho) { const int n = rho >> 4, i = rho & 15; return 8 * (i >> 2) + 4 * n + (i & 3); }
struct Unit { int pm, pn, nr; };
struct Gemm { const bf16_t* A; const bf16_t* Bt; int K; };
__device__ __forceinline__ void st16_wt(void* p, u32x4 v) { if (WT_STORES) asm volatile("global_store_dwordx4 %0, %1, off sc0 sc1\n\ts_nop 1" :: "v"(p), "v"(v) : "memory"); else *(u32x4*)p = v; }
__device__ __forceinline__ void st8_wt(void* p, u32x2 v) { if (WT_STORES) asm volatile("global_store_dwordx2 %0, %1, off sc0 sc1\n\ts_nop 1" :: "v"(p), "v"(v) : "memory"); else *(u32x2*)p = v; }
struct StaticOrder {
    int nM, nN, nwg, G, c;
    __device__ void init(int M_, int N_, int G_, int c_) { nM = M_ / BM; nN = N_ / BM; nwg = nM * nN; G = G_; c = c_; }
    __device__ bool next(int i, Unit& u) const {
        const long L = (long)i * G + c; if (L >= nwg) return false;
        int wgid = (int)L; { const int q = nwg / NXCD, r = nwg % NXCD, xcd = wgid % NXCD, off = wgid / NXCD; wgid = (xcd < r ? xcd * (q + 1) : r * (q + 1) + (xcd - r) * q) + off; }
        const int nig = WGM * nN, gid = wgid / nig, fm = gid * WGM, gsz = (nM - fm) < WGM ? (nM - fm) : WGM;
        u.pm = fm + ((wgid % nig) % gsz); u.pn = (wgid % nig) / gsz; u.nr = BM; return true;
    }
    __device__ __forceinline__ const PG8_LAS int* rowtab(int) const { return nullptr; }
};
__device__ __forceinline__ unsigned cvt_pk_bf16(float lo, float hi) { unsigned r; asm volatile("v_cvt_pk_bf16_f32 %0, %1, %2" : "=v"(r) : "v"(lo), "v"(hi)); return r; }

template <class Sched> __device__ __forceinline__ void gather_voffs(const Sched& S, int ui, int tid, int K, unsigned (&o0)[2], unsigned (&o1)[2]) {
    const PG8_LAS int* tab = S.rowtab(ui);
#pragma unroll
    for (int i = 0; i < 2; ++i) { int R, C; stage_rc(tid * 16 + i * 8192, R, C); o0[i] = (unsigned)((tab[R] & 0xffff) * K + C) * 2u; o1[i] = (unsigned)((tab[HALF + R] & 0xffff) * K + C) * 2u; }
}

template <class Epi, class Sched, bool ALIGN_EPI, bool GATHER, bool F8 = false>
__device__ __forceinline__ void gemm_phase(PG8_LAS unsigned char* lds, const Gemm g, const Sched& S, const Epi& E) {
    int tid_ = threadIdx.x; asm volatile("" : "+v"(tid_));
    const int tid = tid_, wid = __builtin_amdgcn_readfirstlane(tid >> 6), lane = tid & 63, wr = wid >> 2, wc = wid & 3, fr = lane & 15, fq = lane >> 4;
    const int K = g.K, nt = K / BK;
    unsigned vA0[2], vA1[2], wA0[2], wA1[2], voffB[2];
    const size_t kstep = (size_t)(BK * 2);
    const size_t hstep = (size_t)HALF * K * 2;
    const size_t tstep = 2 * hstep;
#pragma unroll
    for (int i = 0; i < 2; ++i) { int R, C; stage_rc(tid * 16 + i * 8192, R, C); const int Rb = Epi::PERM ? ((R & ~31) + perm32(R & 31)) : R;
        vA0[i] = (unsigned)(R * K + C) * 2u; vA1[i] = vA0[i] + (unsigned)hstep; voffB[i] = (unsigned)(Rb * K + C) * 2u; wA0[i] = vA0[i]; wA1[i] = vA1[i]; }
    const unsigned ldsw = (unsigned)wid * 1024u;
    const int aoff = lds_byte(wr * 64 + fr, fq * 8), boff = lds_byte(wc * 32 + fr, fq * 8);
    const int a8o0 = lds_byte(wr * 64 + fr, fq * 16), a8o1 = lds_byte(wr * 64 + fr, fq * 16 + 8), b8o0 = lds_byte(wc * 32 + fr, fq * 16), b8o1 = lds_byte(wc * 32 + fr, fq * 16 + 8);
#define PG8_SA(b, h) (((b) * 2 + (h)) * HTB)
#define PG8_SB(b, h) ((4 + (b) * 2 + (h)) * HTB)
#define PG8_STAGE(bufoff, gbase, voff) do { _Pragma("unroll") for (int _i = 0; _i < 2; ++_i) \
        __builtin_amdgcn_global_load_lds((const unsigned*)((const char*)(gbase) + (voff)[_i]), (PG8_LAS unsigned*)(lds + (bufoff) + ldsw + _i * 8192), 16, 0, 0); } while (0)
#define PG8_LDA_BF(dst, b, h) do { _Pragma("unroll") for (int m = 0; m < 4; ++m) _Pragma("unroll") for (int k = 0; k < 2; ++k) dst[m][k] = *(const PG8_LAS bf16x8*)(lds + PG8_SA(b, h) + aoff + m * 2048 + k * 1024); } while (0)
#define PG8_LDB_BF(dst, b, h) do { _Pragma("unroll") for (int n = 0; n < 2; ++n) _Pragma("unroll") for (int k = 0; k < 2; ++k) dst[n][k] = *(const PG8_LAS bf16x8*)(lds + PG8_SB(b, h) + boff + n * 2048 + k * 1024); } while (0)
#define PG8_MMA_BF(ai, bj, At, Bt) do { if (cur.nr > 128 * (ai) + 64 * wr) { __builtin_amdgcn_s_setprio(1); _Pragma("unroll") for (int m = 0; m < 4; ++m) _Pragma("unroll") for (int n = 0; n < 2; ++n) _Pragma("unroll") for (int k = 0; k < 2; ++k) \
        acc[ai][bj][m][n] = __builtin_amdgcn_mfma_f32_16x16x32_bf16(Bt[n][k], At[m][k], acc[ai][bj][m][n], 0, 0, 0); __builtin_amdgcn_s_setprio(0); } } while (0)
#define PG8_LD8(dst, i_, base_, o0_, o1_) do { const u32x4 lo_ = *(const PG8_LAS u32x4*)(lds + (base_) + (o0_) + (i_) * 2048), hi_ = *(const PG8_LAS u32x4*)(lds + (base_) + (o1_) + (i_) * 2048); \
        dst[i_] = (i32x8){(int)lo_.x, (int)lo_.y, (int)lo_.z, (int)lo_.w, (int)hi_.x, (int)hi_.y, (int)hi_.z, (int)hi_.w}; } while (0)
#define PG8_LDA_F8(dst, b, h) do { _Pragma("unroll") for (int m = 0; m < 4; ++m) PG8_LD8(dst, m, PG8_SA(b, h), a8o0, a8o1); } while (0)
#define PG8_LDB_F8(dst, b, h) do { _Pragma("unroll") for (int n = 0; n < 2; ++n) PG8_LD8(dst, n, PG8_SB(b, h), b8o0, b8o1); } while (0)
#define PG8_MMA_F8(ai, bj, At, Bt) do { if (cur.nr > 128 * (ai) + 64 * wr) { __builtin_amdgcn_s_setprio(1); _Pragma("unroll") for (int m = 0; m < 4; ++m) _Pragma("unroll") for (int n = 0; n < 2; ++n) \
        acc[ai][bj][m][n] = __builtin_amdgcn_mfma_scale_f32_16x16x128_f8f6f4(Bt[n], At[m], acc[ai][bj][m][n], 0, 0, 0, 0x7A7A7A7A  , 0, 0x7F7F7F7F  ); __builtin_amdgcn_s_setprio(0); } } while (0)
#define PG8_LDA(dst, b, h) do { if constexpr (F8) { PG8_LDA_F8(dst##8, b, h); } else { PG8_LDA_BF(dst, b, h); } } while (0)
#define PG8_LDB(dst, b, h) do { if constexpr (F8) { PG8_LDB_F8(dst##8, b, h); } else { PG8_LDB_BF(dst, b, h); } } while (0)
#define PG8_MMA(ai, bj, At, Bt) do { if constexpr (F8) { PG8_MMA_F8(ai, bj, At##8, Bt##8); } else { PG8_MMA_BF(ai, bj, At, Bt); } } while (0)
#define PG8_WAIT_V(n) asm volatile("s_waitcnt vmcnt(" #n ")" ::: "memory")
#define PG8_WAIT_L(n) asm volatile("s_waitcnt lgkmcnt(" #n ")" ::: "memory")
#define PG8_BAR __builtin_amdgcn_s_barrier()
#define PG8_SCHED __builtin_amdgcn_sched_barrier(0)
    Unit cur, nxt; int ui = 0;
    if (!S.next(0, cur)) return;
    f32x4 acc[2][2][4][2];
#pragma unroll
    for (int a = 0; a < 2; ++a)
#pragma unroll
        for (int b = 0; b < 2; ++b)
#pragma unroll
            for (int m = 0; m < 4; ++m)
#pragma unroll
                for (int n = 0; n < 2; ++n) acc[a][b][m][n] = (f32x4){0.f, 0.f, 0.f, 0.f};
    bf16x8 At[4][2], B0[2][2], B1[2][2]; i32x8 At8[4], B08[2], B18[2];
    const char* cA = GATHER ? (const char*)g.A : (const char*)g.A + (size_t)cur.pm * tstep; const char* cB = (const char*)g.Bt + (size_t)cur.pn * tstep;
    if constexpr (GATHER) gather_voffs(S, 0, tid, K, vA0, vA1);
    PG8_STAGE(PG8_SB(0, 0), cB, voffB); PG8_STAGE(PG8_SB(0, 1), cB + hstep, voffB); PG8_STAGE(PG8_SA(0, 0), cA, vA0); PG8_STAGE(PG8_SA(0, 1), cA, vA1);
    if (wr == 1) PG8_BAR;
    PG8_WAIT_V(2); PG8_BAR;
    PG8_STAGE(PG8_SB(1, 0), cB + kstep, voffB); PG8_STAGE(PG8_SA(1, 0), cA + kstep, vA0); PG8_STAGE(PG8_SB(1, 1), cB + hstep + kstep, voffB);
    PG8_WAIT_V(6); PG8_BAR;
    for (;;) {
        const bool has_next = S.next(ui + 1, nxt);
        const char* nA = GATHER ? cA : (has_next ? (const char*)g.A + (size_t)nxt.pm * tstep : cA); const char* nB = has_next ? (const char*)g.Bt + (size_t)nxt.pn * tstep : cB;
        if constexpr (GATHER) { if (has_next) gather_voffs(S, ui + 1, tid, K, wA0, wA1); else { wA0[0] = vA0[0]; wA0[1] = vA0[1]; wA1[0] = vA1[0]; wA1[1] = vA1[1]; } }
        for (int t = 0; t < nt; t += 2) {
            const bool last = (t == nt - 2);
            const char* a1 = cA + (size_t)(t + 1) * kstep;
            const char* a2 = last ? nA : cA + (size_t)(t + 2) * kstep; const char* b2 = last ? nB : cB + (size_t)(t + 2) * kstep;
            const char* a3 = a2 + kstep; const char* b3 = b2 + kstep;
            unsigned sA0[2], sA1[2];
#pragma unroll
            for (int i = 0; i < 2; ++i) { sA0[i] = (GATHER && last) ? wA0[i] : vA0[i]; sA1[i] = (GATHER && last) ? wA1[i] : vA1[i]; }
            if constexpr (Epi::MIDK) { if (t == nt / 2) E.midk(acc, wr, fr); }
            PG8_LDB(B0, 0, 0); PG8_LDB(B1, 0, 1); PG8_SCHED; PG8_LDA(At, 0, 0); PG8_STAGE(PG8_SA(1, 1), a1, vA1);
            PG8_WAIT_V(8); PG8_WAIT_L(0); PG8_BAR; PG8_MMA(0, 0, At, B0); PG8_MMA(0, 1, At, B1); PG8_BAR; PG8_SCHED;
            PG8_LDA(At, 0, 1); PG8_STAGE(PG8_SB(0, 0), b2, voffB); PG8_STAGE(PG8_SB(0, 1), b2 + hstep, voffB); PG8_STAGE(PG8_SA(0, 0), a2, sA0);
            PG8_WAIT_V(8); PG8_WAIT_L(0); PG8_BAR; PG8_MMA(1, 0, At, B0); PG8_MMA(1, 1, At, B1); PG8_BAR; PG8_SCHED;
            PG8_LDB(B0, 1, 0); PG8_LDB(B1, 1, 1); PG8_SCHED; PG8_LDA(At, 1, 0); PG8_STAGE(PG8_SA(0, 1), a2, sA1);
            PG8_WAIT_V(8); PG8_WAIT_L(0); PG8_BAR; PG8_MMA(0, 0, At, B0); PG8_MMA(0, 1, At, B1); PG8_BAR; PG8_SCHED;
            PG8_LDA(At, 1, 1); PG8_STAGE(PG8_SB(1, 0), b3, voffB); PG8_STAGE(PG8_SB(1, 1), b3 + hstep, voffB); PG8_STAGE(PG8_SA(1, 0), a3, sA0);
            PG8_WAIT_V(8); PG8_WAIT_L(0); PG8_BAR; PG8_MMA(1, 0, At, B0); PG8_MMA(1, 1, At, B1); PG8_BAR; PG8_SCHED;
        }
        if constexpr (ALIGN_EPI) { if (wr == 0) PG8_BAR; }
        E(acc, cur, ui, wr, wc, fr, fq);
        if (!has_next) break;
#pragma unroll
        for (int a = 0; a < 2; ++a)
#pragma unroll
            for (int b = 0; b < 2; ++b)
#pragma unroll
                for (int m = 0; m < 4; ++m)
#pragma unroll
                    for (int n = 0; n < 2; ++n) acc[a][b][m][n] = (f32x4){0.f, 0.f, 0.f, 0.f};
        cur = nxt; cA = nA; cB = nB; ++ui;
        if constexpr (GATHER) { vA0[0] = wA0[0]; vA0[1] = wA0[1]; vA1[0] = wA1[0]; vA1[1] = wA1[1]; }
        if constexpr (ALIGN_EPI) { if (wr == 1) PG8_BAR; }
    }
    PG8_WAIT_V(0);
    if constexpr (!ALIGN_EPI) { if (wr == 0) PG8_BAR; }
    PG8_BAR;
#undef PG8_SA
#undef PG8_SB
#undef PG8_STAGE
#undef PG8_LDA
#undef PG8_LDB
#undef PG8_MMA
#undef PG8_LDA_BF
#undef PG8_LDB_BF
#undef PG8_MMA_BF
#undef PG8_LD8
#undef PG8_LDA_F8
#undef PG8_LDB_F8
#undef PG8_MMA_F8
#undef PG8_WAIT_V
#undef PG8_WAIT_L
#undef PG8_BAR
#undef PG8_SCHED
}

struct EpiProj {
    static constexpr bool PERM = true, MIDK = false;
    bf16_t* O; unsigned* hp;
    __device__ __forceinline__ void operator()(const f32x4 (&acc)[2][2][4][2], const Unit& u, int, int wr, int wc, int fr, int fq) const {
        const int row0 = u.pm * BM + wr * 64 + fr, col0 = u.pn * BM + wc * 32 + 8 * fq;
        const float sc = (u.pn < 2 || (u.pn >= 6 && u.pn < 8)) ? C2 : 1.f;
        if (u.pn < 4) {
            float mx = 0.f;
#pragma unroll
            for (int ai = 0; ai < 2; ++ai)
#pragma unroll
                for (int m = 0; m < 4; ++m)
#pragma unroll
                    for (int bj = 0; bj < 2; ++bj) { const f32x4 a0 = acc[ai][bj][m][0] * sc, a1 = acc[ai][bj][m][1] * sc;
                        float q = a0[0] * a0[0] + a0[1] * a0[1] + a0[2] * a0[2] + a0[3] * a0[3] + a1[0] * a1[0] + a1[1] * a1[1] + a1[2] * a1[2] + a1[3] * a1[3];
                        q += __shfl_xor(q, 16); q += __shfl_xor(q, 32); mx = fmaxf(mx, q); }
#pragma unroll
            for (int o = 1; o < 16; o <<= 1) mx = fmaxf(mx, __shfl_xor(mx, o));
            if ((threadIdx.x & 63) == 0) atomicMax(hp + (u.pn < 2 ? 0 : 64), __float_as_uint(mx));
        }
#pragma unroll
        for (int ai = 0; ai < 2; ++ai)
#pragma unroll
            for (int m = 0; m < 4; ++m) { bf16_t* rowp = O + (size_t)(row0 + ai * HALF + m * 16) * NPROJ + col0;
#pragma unroll
                for (int bj = 0; bj < 2; ++bj) { const f32x4 v0 = acc[ai][bj][m][0] * sc, v1 = acc[ai][bj][m][1] * sc;
                    u32x4 w; w.x = cvt_pk_bf16(v0[0], v0[1]); w.y = cvt_pk_bf16(v0[2], v0[3]); w.z = cvt_pk_bf16(v1[0], v1[1]); w.w = cvt_pk_bf16(v1[2], v1[3]);
                    st16_wt(rowp + bj * HALF, w); } }
    }
};
struct EpiWout {
    static constexpr bool PERM = false, MIDK = true;
    const float* x; float* X1; bf16_t* X1B; const PG8_LAS float* ratio; const PG8_LAS float* rs;
    __device__ __forceinline__ void midk(f32x4 (&acc)[2][2][4][2], int wr, int fr) const {
#pragma unroll
        for (int ai = 0; ai < 2; ++ai)
#pragma unroll
            for (int m = 0; m < 4; ++m) { const float f = ratio[ai * HALF + wr * 64 + m * 16 + fr];
#pragma unroll
                for (int bj = 0; bj < 2; ++bj)
#pragma unroll
                    for (int n = 0; n < 2; ++n) acc[ai][bj][m][n] *= f; }
    }
    __device__ __forceinline__ void operator()(const f32x4 (&acc)[2][2][4][2], const Unit& u, int, int wr, int wc, int fr, int fq) const {
        const int col0 = u.pn * BM + wc * 32 + 4 * fq;
#pragma unroll
        for (int ai = 0; ai < 2; ++ai)
#pragma unroll
            for (int m = 0; m < 4; ++m) { const int r = ai * HALF + wr * 64 + m * 16 + fr; const float s = rs[r]; const size_t off = (size_t)(u.pm * BM + r) * DM + col0;
#pragma unroll
                for (int bj = 0; bj < 2; ++bj)
#pragma unroll
                    for (int n = 0; n < 2; ++n) { const f32x4 xv = *(const f32x4*)(x + off + bj * HALF + n * 16); const f32x4 o = xv + acc[ai][bj][m][n] * s;
                        if (X1_BF16) { u32x2 w; w.x = cvt_pk_bf16(o[0], o[1]); w.y = cvt_pk_bf16(o[2], o[3]); *(u32x2*)((bf16_t*)X1 + off + bj * HALF + n * 16) = w; }
                        else *(f32x4*)(X1 + off + bj * HALF + n * 16) = o;
                        if (MOE_F8) *(unsigned*)((unsigned char*)X1B + off + bj * HALF + n * 16) = pk4_fp8(o[0], o[1], o[2], o[3]);
                        else { u32x2 w; w.x = cvt_pk_bf16(o[0], o[1]); w.y = cvt_pk_bf16(o[2], o[3]); *(u32x2*)(X1B + off + bj * HALF + n * 16) = w; } }
                asm volatile("" ::: "memory"); }
    }
};
constexpr int MOE_MAXU = 10;
struct MoeOrder {
    int NT, c; const PG8_LAS int* tb; const PG8_LAS int* tbE; const PG8_LAS int* tbC; const PG8_LAS int* cnt; const PG8_LAS int* tabA;
    int probe = 0;
    __device__ bool next(int i, Unit& u) const {
        if (i >= MOE_MAXU) return false;
        const int x = c & 7, j = c >> 3, UE = tbE[32] * NT, UC = tbC[32] * NT;
        const int qE = UE >> 3, rE = UE & 7, sE = x * qE + (x < rE ? x : rE), nE = qE + (x < rE ? 1 : 0);
        const int qC = UC >> 3, rC = UC & 7, sC = x * qC + (x < rC ? x : rC), nC = qC + (x < rC ? 1 : 0);
        const int nEj = (j < nE) ? ((nE - j + 31) >> 5) : 0;
        if (i < nEj) {
            const int f = sE + i * 32 + j; int e = 0; while (f >= tbE[e + 1] * NT) ++e;
            const int idx = f - tbE[e] * NT, nte = tbE[e + 1] - tbE[e], pg = idx / (4 * nte), rem2 = idx - pg * 4 * nte, mt = rem2 >> 2;
            u.pm = tb[e] + mt; u.pn = e * NT + pg * 4 + (rem2 & 3); const int left = cnt[e] - 256 * mt; u.nr = left < BM ? left : BM;
        } else {
            const int jj = (j - (nE & 31) + 32) & 31, lc = (i - nEj) * 32 + jj; if (lc >= nC) return false;
            const int f = sC + lc; int e = 0; while (f >= tbC[e + 1] * NT) ++e;
            const int mt = tbE[e + 1] - tbE[e]; u.pm = tb[e] + mt; u.pn = e * NT + (f - tbC[e] * NT); u.nr = cnt[e] - 256 * mt;
        }
        if (probe) { u.pm &= 31; u.pn &= 7; if (probe == 2) u.nr = 32; }
        return true;
    }
    __device__ __forceinline__ const PG8_LAS int* rowtab(int ui) const { return tabA + ui * 256; }
};
struct EpiMoe1 {
    static constexpr bool PERM = true, MIDK = false;
    bf16_t* H; const PG8_LAS int* rowtab; const PG8_LAS float* btab;
    __device__ __forceinline__ void operator()(const f32x4 (&acc)[2][2][4][2], const Unit& u, int ui, int wr, int wc, int fr, int fq) const {
        const int pl = u.pn & 7, cl = wc * 32 + 8 * fq, colA = pl * 128 + cl;
        f32x4 bg[2], bl[2];
#pragma unroll
        for (int n = 0; n < 2; ++n) { bg[n] = *(const PG8_LAS f32x4*)(btab + ui * 256 + cl + 4 * n); bl[n] = *(const PG8_LAS f32x4*)(btab + ui * 256 + 128 + cl + 4 * n); }
#pragma unroll
        for (int ai = 0; ai < 2; ++ai)
#pragma unroll
            for (int m = 0; m < 4; ++m) { const int r = ai * HALF + wr * 64 + m * 16 + fr; const float rs = __uint_as_float((unsigned)rowtab[ui * 256 + r] & 0xffff0000u);
                float a8[8];
#pragma unroll
                for (int n = 0; n < 2; ++n) { const f32x4 gv = acc[ai][0][m][n] * rs + bg[n], lv = acc[ai][1][m][n] * rs + bl[n];
#pragma unroll
                    for (int i = 0; i < 4; ++i) { const float gl = fminf(gv[i], 7.f), li = fminf(fmaxf(lv[i], -7.f), 7.f);
                        a8[4 * n + i] = gl * __builtin_amdgcn_rcpf(1.f + __builtin_amdgcn_exp2f(-1.702f * LOG2E * gl)) * (li + 1.f); } }
                if (MOE_F8) { u32x2 w;
                    int w0 = __builtin_amdgcn_cvt_pk_fp8_f32(a8[0], a8[1], 0, false); w0 = __builtin_amdgcn_cvt_pk_fp8_f32(a8[2], a8[3], w0, true);
                    int w1 = __builtin_amdgcn_cvt_pk_fp8_f32(a8[4], a8[5], 0, false); w1 = __builtin_amdgcn_cvt_pk_fp8_f32(a8[6], a8[7], w1, true);
                    w.x = (unsigned)w0; w.y = (unsigned)w1; *(u32x2*)((unsigned char*)H + (size_t)(u.pm * BM + r) * DM + colA) = w; }
                else { u32x4 w; w.x = cvt_pk_bf16(a8[0], a8[1]); w.y = cvt_pk_bf16(a8[2], a8[3]); w.z = cvt_pk_bf16(a8[4], a8[5]); w.w = cvt_pk_bf16(a8[6], a8[7]);
                *(u32x4*)(H + (size_t)(u.pm * BM + r) * DM + colA) = w; } }
    }
};
struct EpiMoe2 {
    static constexpr bool PERM = true, MIDK = false;
    bf16_t* Y; const PG8_LAS float* wtab; const PG8_LAS float* btab;
    __device__ __forceinline__ void operator()(const f32x4 (&acc)[2][2][4][2], const Unit& u, int ui, int wr, int wc, int fr, int fq) const {
        const int pl = u.pn & 3, cl = wc * 32 + 8 * fq, col0 = pl * BM + cl;
        f32x4 bv[2][2];
#pragma unroll
        for (int bj = 0; bj < 2; ++bj)
#pragma unroll
            for (int n = 0; n < 2; ++n) bv[bj][n] = *(const PG8_LAS f32x4*)(btab + ui * 256 + cl + bj * HALF + 4 * n);
#pragma unroll
        for (int ai = 0; ai < 2; ++ai)
#pragma unroll
            for (int m = 0; m < 4; ++m) { const int r = ai * HALF + wr * 64 + m * 16 + fr; const float wt = wtab[ui * 256 + r]; bf16_t* rowp = Y + (size_t)(u.pm * BM + r) * DM + col0;
#pragma unroll
                for (int bj = 0; bj < 2; ++bj) { const f32x4 v0 = (acc[ai][bj][m][0] + bv[bj][0]) * wt, v1 = (acc[ai][bj][m][1] + bv[bj][1]) * wt;
                    if (Y_F8) { u32x2 w; w.x = pk4_fp8(v0[0], v0[1], v0[2], v0[3]); w.y = pk4_fp8(v1[0], v1[1], v1[2], v1[3]); *(u32x2*)((unsigned char*)Y + (size_t)(u.pm * BM + r) * DM + col0 + bj * HALF) = w; }
                    else { u32x4 w; w.x = cvt_pk_bf16(v0[0], v0[1]); w.y = cvt_pk_bf16(v0[2], v0[3]); w.z = cvt_pk_bf16(v1[0], v1[1]); w.w = cvt_pk_bf16(v1[2], v1[3]);
                    *(u32x4*)(rowp + bj * HALF) = w; } } }
    }
};
struct ListOrder {
    const PG8_LAS int* ud; int n; const PG8_LAS int* tabA;
    __device__ __forceinline__ bool next(int i, Unit& u) const { if (i >= n) return false; u.pm = ud[3 * i]; u.pn = ud[3 * i + 1]; u.nr = ud[3 * i + 2]; return true; }
    __device__ __forceinline__ const PG8_LAS int* rowtab(int ui) const { return tabA + ui * 256; }
};
struct EpiNull {
    static constexpr bool PERM = true, MIDK = false; float* O;
    __device__ __forceinline__ void operator()(const f32x4 (&acc)[2][2][4][2], const Unit& u, int ui, int wr, int wc, int fr, int fq) const {
        f32x4 t = (f32x4){0.f, 0.f, 0.f, 0.f};
#pragma unroll
        for (int ai = 0; ai < 2; ++ai)
#pragma unroll
            for (int bj = 0; bj < 2; ++bj)
#pragma unroll
                for (int m = 0; m < 4; ++m)
#pragma unroll
                    for (int n = 0; n < 2; ++n) t += acc[ai][bj][m][n];
        O[(size_t)(u.pm & 31) * 65536 + (u.pn & 7) * 8192 + (wr * 4 + wc) * 64 + fq * 16 + fr + ui] = t[0] + t[1] + t[2] + t[3];
    }
};
}

#include <hip/hip_bf16.h>
#include <cmath>
namespace attn_body {

using bf16=__hip_bfloat16;
using bf16x8=__attribute__((ext_vector_type(8)))short;
using s16x4=__attribute__((ext_vector_type(4)))short;
using f32x16=__attribute__((ext_vector_type(16)))float;
using u32x4=__attribute__((ext_vector_type(4)))unsigned;
constexpr int SEQ=4096,D=64,PIN=3072,POUT=1024;
constexpr int NW=8,QBLK=32,QB=QBLK*NW,KVBLK=64,NQB=SEQ/QB;
__device__ __forceinline__ int crow(int r,int hi){return (r&3)+8*(r>>2)+4*hi;}
#define SBAR() __builtin_amdgcn_sched_barrier(0)
__device__ __forceinline__ void cmask(f32x16&p0,f32x16&p1,int jb,int qrel,int hi){
  const float NEG=-INFINITY; int kb=64*jb+4*hi;
  #pragma unroll
  for(int r=0;r<16;++r){int kv=kb+(r&3)+8*(r>>2); if(kv>qrel)p0[r]=NEG; if(kv+32>qrel)p1[r]=NEG;}
}

constexpr int NSLOT=3, SLOTB=8192;
constexpr int LDS_K=0, LDS_V=NSLOT*SLOTB, LDS_WS=2*NSLOT*SLOTB, LDS_OST=LDS_WS+NW*64*4, LDS_CK=LDS_OST+NW*4096, LDS_BYTES=LDS_CK+SEQ*4;
constexpr float C2=0.125f*1.4426950408889634f;
__device__ __forceinline__ void glds16(const void*gsrc,unsigned lds_dst){unsigned keep;
  asm volatile("s_mov_b32 %0, m0\n\ts_mov_b32 m0, %2\n\ts_nop 0\n\tglobal_load_lds_dwordx4 %1, off\n\ts_mov_b32 m0, %0":"=&s"(keep):"v"(gsrc),"s"(lds_dst):"memory");}
__device__ __forceinline__ float max3f(float a,float b,float c){float r;asm("v_max3_f32 %0, %1, %2, %3":"=v"(r):"v"(a),"v"(b),"v"(c));return r;}
__device__ __forceinline__ float max2f(float a,float b){float r;asm("v_max_f32_e32 %0, %1, %2":"=v"(r):"v"(a),"v"(b));return r;}
__device__ __forceinline__ float fadd_s(float a,float b){float r;asm("v_add_f32_e32 %0, %1, %2":"=v"(r):"v"(a),"v"(b));return r;}
__device__ __forceinline__ float fsub_s(float a,float b){float r;asm("v_sub_f32_e32 %0, %1, %2":"=v"(r):"v"(a),"v"(b));return r;}
typedef float f32x2_t __attribute__((ext_vector_type(2))); typedef float f32x4_t __attribute__((ext_vector_type(4))); typedef __bf16 bf16x2_t __attribute__((ext_vector_type(2)));
__device__ __forceinline__ unsigned cvtpk_s(float lo,float hi){f32x2_t v={lo,hi};bf16x2_t b=__builtin_convertvector(v,bf16x2_t);return __builtin_bit_cast(unsigned,b);}
#define WAIT_BAR(N) asm volatile("s_waitcnt vmcnt(" #N ") lgkmcnt(0)\n\ts_barrier":::"memory")

__device__ __forceinline__ void qkt(f32x16&p0,f32x16&p1,const char*Kslot,const bf16x8*qr,const f32x16&negm,int r32,int hi){
  const char*kb=Kslot+hi*1024+r32*16;
  #pragma unroll
  for(int d0=0;d0<4;++d0){
    const bf16x8 b0=*reinterpret_cast<const bf16x8*>(kb+d0*2048);
    const bf16x8 b1=*reinterpret_cast<const bf16x8*>(kb+d0*2048+512);
    if(d0==0){p0=__builtin_amdgcn_mfma_f32_32x32x16_bf16(b0,qr[0],negm,0,0,0);p1=__builtin_amdgcn_mfma_f32_32x32x16_bf16(b1,qr[0],negm,0,0,0);}
    else{p0=__builtin_amdgcn_mfma_f32_32x32x16_bf16(b0,qr[d0],p0,0,0,0);p1=__builtin_amdgcn_mfma_f32_32x32x16_bf16(b1,qr[d0],p1,0,0,0);}}
}
typedef __attribute__((address_space(3))) const char* lds_cptr;
typedef short v4i16_t __attribute__((ext_vector_type(4)));
__device__ __forceinline__ void kload8(bf16x8*kf,lds_cptr kp){
  kf[0]=*(const __attribute__((address_space(3))) bf16x8*)(kp);      kf[1]=*(const __attribute__((address_space(3))) bf16x8*)(kp+512);
  kf[2]=*(const __attribute__((address_space(3))) bf16x8*)(kp+2048); kf[3]=*(const __attribute__((address_space(3))) bf16x8*)(kp+2560);
  kf[4]=*(const __attribute__((address_space(3))) bf16x8*)(kp+4096); kf[5]=*(const __attribute__((address_space(3))) bf16x8*)(kp+4608);
  kf[6]=*(const __attribute__((address_space(3))) bf16x8*)(kp+6144); kf[7]=*(const __attribute__((address_space(3))) bf16x8*)(kp+6656);
}
__device__ __forceinline__ void kload2(bf16x8*kf,lds_cptr kp,int j){ kf[2*j]=*(const __attribute__((address_space(3))) bf16x8*)(kp+j*2048); kf[2*j+1]=*(const __attribute__((address_space(3))) bf16x8*)(kp+j*2048+512); }
__device__ __forceinline__ s16x4 vtr(lds_cptr p){ return __builtin_bit_cast(s16x4,__builtin_amdgcn_ds_read_tr16_b64_v4i16((__attribute__((address_space(3))) v4i16_t*)p)); }
__device__ __forceinline__ float rowmax(const f32x16&p0,const f32x16&p1){
  float a=max3f(p0[0],p0[1],p1[0]),b=max3f(p0[2],p0[3],p1[1]);a=max3f(a,p1[2],p1[3]);
  #pragma unroll
  for(int r=4;r<16;r+=4){a=max3f(a,p0[r],p0[r+1]);b=max3f(b,p0[r+2],p0[r+3]);a=max3f(a,p1[r],p1[r+1]);b=max3f(b,p1[r+2],p1[r+3]);}
  const float m=max2f(a,b);
  auto rr=__builtin_amdgcn_permlane32_swap(__float_as_uint(m),__float_as_uint(m),false,false);
  return max2f(__uint_as_float(rr[0]),__uint_as_float(rr[1]));
}
__device__ __forceinline__ void pv(f32x16*o,int vb,bf16x8 pa0,bf16x8 pa1,bf16x8 pa2,bf16x8 pa3){
  #pragma unroll
  for(int d0=0;d0<2;++d0){s16x4 lo[4],hi[4];
    #pragma unroll
    for(int ks=0;ks<4;++ks){
      asm volatile("ds_read_b64_tr_b16 %0,%1 offset:%c2":"=&v"(lo[ks]):"v"(vb),"i"(d0*4096+ks*1024):"memory");
      asm volatile("ds_read_b64_tr_b16 %0,%1 offset:%c2":"=&v"(hi[ks]):"v"(vb),"i"(d0*4096+ks*1024+512):"memory");}
    asm volatile("s_waitcnt lgkmcnt(0)":::"memory");SBAR();
    #define PK(k) (bf16x8){lo[k][0],lo[k][1],lo[k][2],lo[k][3],hi[k][0],hi[k][1],hi[k][2],hi[k][3]}
    o[d0]=__builtin_amdgcn_mfma_f32_32x32x16_bf16(pa0,PK(0),o[d0],0,0,0);
    o[d0]=__builtin_amdgcn_mfma_f32_32x32x16_bf16(pa1,PK(1),o[d0],0,0,0);
    o[d0]=__builtin_amdgcn_mfma_f32_32x32x16_bf16(pa2,PK(2),o[d0],0,0,0);
    o[d0]=__builtin_amdgcn_mfma_f32_32x32x16_bf16(pa3,PK(3),o[d0],0,0,0);
    #undef PK
  }
}

#ifndef ATTN_STORE16
#define ATTN_STORE16(p,v) (*(u32x4*)(p)=(v))
#endif
template<int THRL> __device__ __forceinline__ void attn_unit(int b,int h,int qb,const bf16*Q,const bf16*__restrict__ K,const bf16*__restrict__ V,bf16*O,const float*__restrict__ CUMbh,float*__restrict__ SSQh,float skipth,char*shm){
  int tid_=threadIdx.x; asm volatile("":"+v"(tid_));
  const int tid=tid_,lane=tid&63,r32=lane&31,hi=lane>>5; const int wid=__builtin_amdgcn_readfirstlane(tid>>6);
  const long rowbase=(long)b*SEQ; const int q0=qb*QB;
  const bf16*Qw=Q+(rowbase+q0+wid*QBLK)*PIN+h*D;
  int t0;
  { const int NT0=(q0+QB)/KVBLK; const bool sk=(lane<NT0-4)&&(CUMbh[64*lane+63]-CUMbh[q0]>=skipth); t0=__builtin_popcountll(__ballot(sk))&~1; t0=__builtin_amdgcn_readfirstlane(t0); }
  const bf16*Kh=K+(rowbase+(long)t0*KVBLK)*PIN+h*D,*Vh=V+(rowbase+(long)t0*KVBLK)*PIN+h*D;
  const unsigned lds0=(unsigned)(uintptr_t)shm;
  const lds_cptr shm3=(lds_cptr)shm;
  float*wsf=(float*)(shm+LDS_WS)+wid*64;
  const bf16*ksrc=Kh+(long)lane*PIN+wid*8;
  const bf16*vsrc=Vh+(long)(16*(wid&3)+(lane>>2))*PIN+(wid>>2)*32+(lane&3)*8;
  const unsigned kdst=lds0+LDS_K+wid*1024, vdst=lds0+LDS_V+wid*1024;
  #define DMA_K(t,slot) glds16(ksrc+(long)(t)*KVBLK*PIN,(unsigned)__builtin_amdgcn_readfirstlane(kdst+(slot)))
  #define DMA_V(t,slot) glds16(vsrc+(long)(t)*KVBLK*PIN,(unsigned)__builtin_amdgcn_readfirstlane(vdst+(slot)))
  const int vb0=(int)(lds0+LDS_V)+((lane>>4)&1)*32+(lane&3)*8+(4*hi+((lane&15)>>2))*64;
  const char*Kbase=shm+LDS_K; bf16x8 kf[8];
  const lds_cptr kp0=shm3+LDS_K+hi*1024+r32*16; const lds_cptr vp0=shm3+LDS_V+((lane>>4)&1)*32+(lane&3)*8+(4*hi+((lane&15)>>2))*64;
  const int NT=(q0+QB)/KVBLK-t0;
  DMA_K(0,0);DMA_V(0,0);DMA_K(1,SLOTB);
  bf16x8 qr[4];
  #pragma unroll
  for(int d0=0;d0<4;++d0)qr[d0]=*reinterpret_cast<const bf16x8*>(&Qw[(long)r32*PIN+d0*16+hi*8]);
  const float cbase=CUMbh[q0]; const float cq=CUMbh[q0+wid*QBLK+r32]-cbase;
  { __attribute__((address_space(3))) float*ckw=(__attribute__((address_space(3))) float*)(shm3+LDS_CK); int s0_=tid; asm volatile("":"+v"(s0_));
    _Pragma("nounroll") for(int s=s0_;s<q0+QB;s+=NW*64)ckw[s]=CUMbh[s]-cbase; }
  const __attribute__((address_space(3))) float*ckp=(const __attribute__((address_space(3))) float*)(shm3+LDS_CK)+4*hi+t0*KVBLK;
  float mhat=-cq,l_reg=0.f;f32x16 o[2];o[0]=f32x16{};o[1]=f32x16{};f32x16 negm;
  #pragma unroll
  for(int r=0;r<16;++r)negm[r]=cq;
  asm volatile("":"+v"(negm));
  const int qrel=wid*QBLK+r32;
  #define BIAS(P0,P1,t) do{ const __attribute__((address_space(3))) float*cp_=ckp+(t)*KVBLK; \
    _Pragma("unroll") for(int g_=0;g_<4;++g_){ const f32x4_t c0_=*(const __attribute__((address_space(3))) f32x4_t*)(cp_+8*g_), c1_=*(const __attribute__((address_space(3))) f32x4_t*)(cp_+32+8*g_); \
      _Pragma("unroll") for(int j_=0;j_<4;++j_){ P0[4*g_+j_]-=c0_[j_]; P1[4*g_+j_]-=c1_[j_]; } SBAR(); } }while(0)
  #define CMASK(P0,P1,t) do{int jb_=(t)-(NT-4); if(jb_>=0)cmask(P0,P1,jb_,qrel,hi);}while(0)
  bool resc=false;
  #define START(P0,P1) do{ const float rm=rowmax(P0,P1); resc=false; \
    { const float dl=rm; mhat=fadd_s(mhat,dl); \
      _Pragma("unroll") for(int r=0;r<16;++r){P0[r]=fsub_s(P0[r],dl);P1[r]=fsub_s(P1[r],dl);} \
      _Pragma("unroll") for(int r=0;r<16;++r)negm[r]=-mhat; asm volatile("":"+v"(negm)); } \
    _Pragma("unroll") for(int r=0;r<16;++r)P0[r]=__builtin_amdgcn_exp2f(P0[r]); }while(0)
  #define RESC() do{ if(resc){ asm volatile("s_waitcnt lgkmcnt(0)":::"memory"); \
      _Pragma("unroll") for(int d_=0;d_<2;++d_) _Pragma("unroll") for(int r=0;r<16;++r)o[d_][r]*=wsf[crow(r,hi)]; } }while(0)
  f32x16 pA0,pA1,pB0,pB1;
  int sl_prev=0,sl_cur=0,sl_next=SLOTB;
  #define ROT() do{sl_prev=sl_cur;sl_cur=sl_next;sl_next=(sl_next==(NSLOT-1)*SLOTB)?0:sl_next+SLOTB;}while(0)
  DMA_K(2,2*SLOTB);
  WAIT_BAR(3);
  qkt(pA0,pA1,Kbase,qr,negm,r32,hi);asm volatile("s_nop 15\n\ts_nop 7":"+v"(pA0),"+v"(pA1));BIAS(pA0,pA1,0);CMASK(pA0,pA1,0);
  START(pA0,pA1);
  _Pragma("unroll") for(int r=0;r<16;++r)pA1[r]=__builtin_amdgcn_exp2f(pA1[r]);
  WAIT_BAR(0);
  DMA_K(3,0);DMA_V(1,SLOTB);
  ROT();
  kload8(kf,kp0+sl_cur);
  WAIT_BAR(2);
  s16x4 vlo[8],vhi[8]; u32x4 pw0,pw1,pw2,pw3;
  #define PKW(P,B) cvtpk_s(P[B],P[B+1])
  #define PAF(k) __builtin_bit_cast(bf16x8,pw##k)
  #define VFR(i) (bf16x8){vlo[i][0],vlo[i][1],vlo[i][2],vlo[i][3],vhi[i][0],vhi[i][1],vhi[i][2],vhi[i][3]}
  #define PIN(x) asm volatile("":"+v"(x))
  #define MX3(a,b,c) __builtin_fmaxf(__builtin_fmaxf((a),(b)),(c))
  #define GAPA(MF,A0,A1,A2,A3,W0,W1,PW) do{ MF; sacc+=A0; sacc+=A1; sacc+=A2; sacc+=A3; PIN(sacc); W0; W1; PIN(PW); SBAR(); }while(0)
  #define EX(v) __builtin_amdgcn_exp2f(v)
  #define GAPB(MF,X,B) do{ MF; X[B]=EX(X[B]); X[B+1]=EX(X[B+1]); X[B+2]=EX(X[B+2]); X[B+3]=EX(X[B+3]); PIN(X); SBAR(); }while(0)
  #define VRD(i) do{ vlo[i]=vtr(vp_+(((i)>>2)*4096+((i)&3)*1024)); vhi[i]=vtr(vp_+(((i)>>2)*4096+((i)&3)*1024+512)); }while(0)
  #define KRD(G,j) do{ if(G){ kload2(kf,kp0+sl_next,j); SBAR(); } }while(0)
  #define STEP(C0,C1,P0,P1,t,GK,GV,GL) do{ SBAR(); \
    const lds_cptr vp_=vp0+sl_prev; \
    VRD(0); SBAR(); float sacc=(P0[0]+P0[1]); \
    GAPA(C0=__builtin_amdgcn_mfma_f32_32x32x16_bf16(kf[0],qr[0],negm,0,0,0), P0[2],P0[3],P0[4],P0[5],     pw0[0]=PKW(P0,0), pw0[1]=PKW(P0,2), pw0); \
    VRD(4); SBAR(); GAPA(C1=__builtin_amdgcn_mfma_f32_32x32x16_bf16(kf[1],qr[0],negm,0,0,0), P0[6],P0[7],P0[8],P0[9],     pw0[2]=PKW(P0,4), pw0[3]=PKW(P0,6), pw0); \
    VRD(1); SBAR(); GAPA(C0=__builtin_amdgcn_mfma_f32_32x32x16_bf16(kf[2],qr[1],C0,0,0,0),   P0[10],P0[11],P0[12],P0[13], pw1[0]=PKW(P0,8), pw1[1]=PKW(P0,10), pw1); \
    VRD(5); SBAR(); GAPA(C1=__builtin_amdgcn_mfma_f32_32x32x16_bf16(kf[3],qr[1],C1,0,0,0),   P0[14],P0[15],P1[0],P1[1],   pw1[2]=PKW(P0,12),pw1[3]=PKW(P0,14), pw1); \
    VRD(2); SBAR(); GAPA(C0=__builtin_amdgcn_mfma_f32_32x32x16_bf16(kf[4],qr[2],C0,0,0,0),   P1[2],P1[3],P1[4],P1[5],     pw2[0]=PKW(P1,0), pw2[1]=PKW(P1,2), pw2); \
    VRD(6); SBAR(); GAPA(C1=__builtin_amdgcn_mfma_f32_32x32x16_bf16(kf[5],qr[2],C1,0,0,0),   P1[6],P1[7],P1[8],P1[9],     pw2[2]=PKW(P1,4), pw2[3]=PKW(P1,6), pw2); \
    VRD(3); SBAR(); GAPA(C0=__builtin_amdgcn_mfma_f32_32x32x16_bf16(kf[6],qr[3],C0,0,0,0),   P1[10],P1[11],P1[12],P1[13], pw3[0]=PKW(P1,8), pw3[1]=PKW(P1,10), pw3); \
    VRD(7); SBAR(); GAPA(C1=__builtin_amdgcn_mfma_f32_32x32x16_bf16(kf[7],qr[3],C1,0,0,0),   P1[14],P1[15],0.f,0.f,       pw3[2]=PKW(P1,12),pw3[3]=PKW(P1,14), pw3); \
    l_reg+=sacc; \
    if(GK){DMA_K((t)+3,sl_cur);} if(GV){DMA_V((t)+1,sl_next);} \
    BIAS(C0,C1,t); CMASK(C0,C1,t); \
    { float a=MX3(C0[0],C0[1],C1[0]),b=MX3(C0[2],C0[3],C1[1]); a=MX3(a,C1[2],C1[3]); \
      _Pragma("unroll") for(int r=4;r<16;r+=4){a=MX3(a,C0[r],C0[r+1]);b=MX3(b,C0[r+2],C0[r+3]);a=MX3(a,C1[r],C1[r+1]);b=MX3(b,C1[r+2],C1[r+3]);} \
      float rm=__builtin_fmaxf(a,b); { auto rr=__builtin_amdgcn_permlane32_swap(__float_as_uint(rm),__float_as_uint(rm),false,false); rm=__builtin_fmaxf(__uint_as_float(rr[0]),__uint_as_float(rr[1])); } \
      resc=false; \
      if(__builtin_expect(__any(rm>(float)THRL),0)){ const float dl=__builtin_fmaxf(rm,0.f); mhat+=dl; \
        _Pragma("unroll") for(int r=0;r<16;++r){C0[r]-=dl;C1[r]-=dl;} \
        _Pragma("unroll") for(int r=0;r<16;++r)negm[r]=-mhat; asm volatile("":"+v"(negm)); \
        const float f=__builtin_amdgcn_exp2f(-dl); l_reg*=f; if(hi==0)wsf[r32]=f; resc=true; } } \
    SBAR(); \
    GAPB(o[0]=__builtin_amdgcn_mfma_f32_32x32x16_bf16(PAF(0),VFR(0),o[0],0,0,0), C0,0); \
    GAPB(o[1]=__builtin_amdgcn_mfma_f32_32x32x16_bf16(PAF(0),VFR(4),o[1],0,0,0), C0,4); \
    KRD(GL,0); GAPB(o[0]=__builtin_amdgcn_mfma_f32_32x32x16_bf16(PAF(1),VFR(1),o[0],0,0,0), C0,8); \
    KRD(GL,1); GAPB(o[1]=__builtin_amdgcn_mfma_f32_32x32x16_bf16(PAF(1),VFR(5),o[1],0,0,0), C0,12); \
    KRD(GL,2); GAPB(o[0]=__builtin_amdgcn_mfma_f32_32x32x16_bf16(PAF(2),VFR(2),o[0],0,0,0), C1,0); \
    KRD(GL,3); GAPB(o[1]=__builtin_amdgcn_mfma_f32_32x32x16_bf16(PAF(2),VFR(6),o[1],0,0,0), C1,4); \
    GAPB(o[0]=__builtin_amdgcn_mfma_f32_32x32x16_bf16(PAF(3),VFR(3),o[0],0,0,0), C1,8); \
    GAPB(o[1]=__builtin_amdgcn_mfma_f32_32x32x16_bf16(PAF(3),VFR(7),o[1],0,0,0), C1,12); \
    }while(0)
  int t=1;
  #undef CMASK
  #define CMASK(P0,P1,t) do{}while(0)
  for(;t+5<NT;t+=2){
    STEP(pB0,pB1,pA0,pA1,t,true,true,true);     WAIT_BAR(2); RESC(); ROT();
    STEP(pA0,pA1,pB0,pB1,t+1,true,true,true);   WAIT_BAR(2); RESC(); ROT();
  }
  #undef CMASK
  #define CMASK(P0,P1,t) do{int jb_=(t)-(NT-4); if(jb_>=0)cmask(P0,P1,jb_,qrel,hi);}while(0)
  #define ENDW(tt) do{ if((tt)+3<NT){WAIT_BAR(2);} else if((tt)+2<NT){WAIT_BAR(1);} else {WAIT_BAR(0);} }while(0)
  for(;t+1<NT;t+=2){
    STEP(pB0,pB1,pA0,pA1,t,(t+3<NT),(t+1<NT),(t+1<NT));       ENDW(t);   RESC(); ROT();
    STEP(pA0,pA1,pB0,pB1,t+1,(t+4<NT),(t+2<NT),(t+2<NT));     ENDW(t+1); RESC(); ROT();
  }
  STEP(pB0,pB1,pA0,pA1,NT-1,false,false,false); RESC();
  { float sacc=pB0[0]+pB0[1]; _Pragma("unroll") for(int r=2;r<16;++r)sacc+=pB0[r]; _Pragma("unroll") for(int r=0;r<16;++r)sacc+=pB1[r]; l_reg+=sacc;
    pw0=(u32x4){PKW(pB0,0),PKW(pB0,2),PKW(pB0,4),PKW(pB0,6)};pw1=(u32x4){PKW(pB0,8),PKW(pB0,10),PKW(pB0,12),PKW(pB0,14)};pw2=(u32x4){PKW(pB1,0),PKW(pB1,2),PKW(pB1,4),PKW(pB1,6)};pw3=(u32x4){PKW(pB1,8),PKW(pB1,10),PKW(pB1,12),PKW(pB1,14)};
    SBAR(); pv(o,vb0+sl_cur,PAF(0),PAF(1),PAF(2),PAF(3)); }
  #undef PKW
  #undef PAF
  #undef VFR
  #undef PIN
  #undef MX3
  #undef GAPA
  #undef GAPB
  #undef EX
  #undef VRD
  #undef KRD
  #undef STEP
  #undef ENDW
  {auto rr=__builtin_amdgcn_permlane32_swap(__float_as_uint(l_reg),__float_as_uint(l_reg),false,false);l_reg=__uint_as_float(rr[0])+__uint_as_float(rr[1]);}
  if(hi==0)wsf[32+r32]=l_reg;asm volatile("s_waitcnt lgkmcnt(0)":::"memory");
  float rli[16];
  #pragma unroll
  for(int r=0;r<16;++r)rli[r]=__builtin_amdgcn_rcpf(wsf[32+crow(r,hi)]);
  bf16*Ow=O+(rowbase+q0+wid*QBLK)*POUT+h*D; float*Sw=SSQh+(rowbase+q0+wid*QBLK)*16;
  { bf16*stg=(bf16*)(shm+LDS_OST)+wid*2048;
    #pragma unroll
    for(int r=0;r<16;++r){const int orow=crow(r,hi);
      #pragma unroll
      for(int d0=0;d0<2;++d0)stg[orow*64+d0*32+r32]=__float2bfloat16(o[d0][r]*rli[r]);}
    asm volatile("s_waitcnt lgkmcnt(0)":::"memory");
    #pragma unroll
    for(int i=0;i<4;++i){const int row=i*8+(lane>>3),ch=lane&7; const u32x4 v=*(const u32x4*)(stg+row*64+ch*8); ATTN_STORE16(Ow+(long)row*POUT+ch*8,v);
      float sq=0.f;
      #pragma unroll
      for(int w_=0;w_<4;++w_){const float lo_=__uint_as_float(v[w_]<<16),hi_=__uint_as_float(v[w_]&0xffff0000u);sq+=lo_*lo_+hi_*hi_;}
      sq+=__shfl_xor(sq,1);sq+=__shfl_xor(sq,2);sq+=__shfl_xor(sq,4); if(ch==0)Sw[row*16]=sq;} }
  asm volatile("s_waitcnt lgkmcnt(0)\n\ts_barrier":::"memory");
  #undef DMA_K
  #undef DMA_V
  #undef CMASK
  #undef BIAS
  #undef START
  #undef RESC
  #undef ROT
}
constexpr int ATTN_LDS_BYTES=LDS_BYTES;

__device__ __forceinline__ void sb_unit(int b,int h,int qb,const bf16*Q,const bf16*__restrict__ K,const bf16*__restrict__ V,bf16*O,float*__restrict__ SSQh,char*shm){
  int tid_=threadIdx.x; asm volatile("":"+v"(tid_));
  const int tid=tid_,lane=tid&63,r32=lane&31,hi=lane>>5; const int wid=__builtin_amdgcn_readfirstlane(tid>>6);
  const long rowbase=(long)b*SEQ; const int q0=qb*QB;
  const bf16*Qw=Q+(rowbase+q0+wid*QBLK)*PIN+h*D;
  const bf16*Kh=K+rowbase*PIN+h*D,*Vh=V+rowbase*PIN+h*D;
  const unsigned lds0=(unsigned)(uintptr_t)shm;
  const bf16*ksrc=Kh+(long)lane*PIN+wid*8;
  const bf16*vsrc=Vh+(long)(16*(wid&3)+(lane>>2))*PIN+(wid>>2)*32+(lane&3)*8;
  const unsigned kdst=lds0+LDS_K+wid*1024, vdst=lds0+LDS_V+wid*1024;
  const int vb0=(int)(lds0+LDS_V)+((lane>>4)&1)*32+(lane&3)*8+(4*hi+((lane&15)>>2))*64;
  const char*Kbase=shm+LDS_K;
  const int NT=(q0+QB)/KVBLK;
  #define SB_DMA(i,slot) do{ const long kt_=(long)(NT-1-(i)); glds16(ksrc+kt_*KVBLK*PIN,(unsigned)__builtin_amdgcn_readfirstlane(kdst+(slot))); glds16(vsrc+kt_*KVBLK*PIN,(unsigned)__builtin_amdgcn_readfirstlane(vdst+(slot))); }while(0)
  bf16x8 qr[4];
  #pragma unroll
  for(int d0=0;d0<4;++d0)qr[d0]=*reinterpret_cast<const bf16x8*>(&Qw[(long)r32*PIN+d0*16+hi*8]);
  SB_DMA(0,0); SB_DMA(1,SLOTB);
  f32x16 o[2];o[0]=f32x16{};o[1]=f32x16{};
  float Rc=1.f;
  const int qrel=wid*QBLK+r32;
  int sl_cur=0,sl_n1=SLOTB,sl_n2=2*SLOTB;
  volatile __attribute__((address_space(3))) unsigned*flg=(volatile __attribute__((address_space(3))) unsigned*)((lds_cptr)shm+LDS_WS);
  f32x16 pA0,pA1,pB0,pB1;
  WAIT_BAR(3);
  { f32x16 z=f32x16{}; asm volatile("":"+v"(z)); qkt(pA0,pA1,Kbase+sl_cur,qr,z,r32,hi); }
  bool done_=false;
  #define SB_STEP(i,P0,P1,N0,N1) do{ \
    if((i)+1<NT){WAIT_BAR(1);}else{WAIT_BAR(0);} \
    if((i)>0){ const int pb=(((i)-1)&1)*8; unsigned all_=flg[pb]&flg[pb+1]&flg[pb+2]&flg[pb+3]&flg[pb+4]&flg[pb+5]&flg[pb+6]&flg[pb+7]; if(__builtin_amdgcn_readfirstlane(all_)){done_=true;break;} } \
    if((i)+2<NT)SB_DMA((i)+2,sl_n2); \
    if((i)+1<NT){ f32x16 z=f32x16{}; asm volatile("":"+v"(z)); qkt(N0,N1,Kbase+sl_n1,qr,z,r32,hi); SBAR(); } \
    f32x16 s0,s1; \
    _Pragma("unroll") for(int r=0;r<16;++r){ \
      const float za=__builtin_amdgcn_fmed3f(P0[r],-100.f,100.f), zb=__builtin_amdgcn_fmed3f(P1[r],-100.f,100.f); \
      P0[r]=__builtin_amdgcn_exp2f(za); P1[r]=__builtin_amdgcn_exp2f(zb); \
      s0[r]=__builtin_amdgcn_rcpf(1.f+P0[r]); s1[r]=__builtin_amdgcn_rcpf(1.f+P1[r]); } \
    if((i)<4){ const int kb=64*(3-(i))+4*hi; \
      _Pragma("unroll") for(int r=0;r<16;++r){ const int kv=kb+(r&3)+8*(r>>2); if(kv>=qrel){P0[r]=0.f;s0[r]=1.f;} if(kv+32>=qrel){P1[r]=0.f;s1[r]=1.f;} } } \
    float gp[8],pp[8]; \
    _Pragma("unroll") for(int g=0;g<4;++g){ \
      s0[4*g+2]*=s0[4*g+3]; s0[4*g+1]*=s0[4*g+2]; s0[4*g]*=s0[4*g+1]; gp[g]=s0[4*g]; \
      s1[4*g+2]*=s1[4*g+3]; s1[4*g+1]*=s1[4*g+2]; s1[4*g]*=s1[4*g+1]; gp[4+g]=s1[4*g]; } \
    _Pragma("unroll") for(int g=0;g<8;++g){ auto rr=__builtin_amdgcn_permlane32_swap(__float_as_uint(gp[g]),__float_as_uint(gp[g]),false,false); pp[g]=__uint_as_float(hi?rr[0]:rr[1]); } \
    float st=Rc, outer[8]; \
    _Pragma("unroll") for(int g=7;g>=0;--g){ outer[g]=hi?st:st*pp[g]; st=st*(gp[g]*pp[g]); } \
    Rc=st; \
    { const unsigned dn=__all(Rc==0.f)?1u:0u; if(lane==0)flg[((i)&1)*8+wid]=dn; } \
    _Pragma("unroll") for(int r=0;r<16;++r){ P0[r]=P0[r]*(s0[r]*outer[r>>2]); P1[r]=P1[r]*(s1[r]*outer[4+(r>>2)]); } \
    u32x4 pw0,pw1,pw2,pw3; \
    pw0=(u32x4){cvtpk_s(P0[0],P0[1]),cvtpk_s(P0[2],P0[3]),cvtpk_s(P0[4],P0[5]),cvtpk_s(P0[6],P0[7])}; \
    pw1=(u32x4){cvtpk_s(P0[8],P0[9]),cvtpk_s(P0[10],P0[11]),cvtpk_s(P0[12],P0[13]),cvtpk_s(P0[14],P0[15])}; \
    pw2=(u32x4){cvtpk_s(P1[0],P1[1]),cvtpk_s(P1[2],P1[3]),cvtpk_s(P1[4],P1[5]),cvtpk_s(P1[6],P1[7])}; \
    pw3=(u32x4){cvtpk_s(P1[8],P1[9]),cvtpk_s(P1[10],P1[11]),cvtpk_s(P1[12],P1[13]),cvtpk_s(P1[14],P1[15])}; \
    SBAR(); pv(o,vb0+sl_cur,__builtin_bit_cast(bf16x8,pw0),__builtin_bit_cast(bf16x8,pw1),__builtin_bit_cast(bf16x8,pw2),__builtin_bit_cast(bf16x8,pw3)); \
    { const int t_=sl_cur; sl_cur=sl_n1; sl_n1=sl_n2; sl_n2=t_; } \
  }while(0)
  for(int i=0;i<NT&&!done_;i+=2){
    SB_STEP(i,pA0,pA1,pB0,pB1); if(done_)break;
    SB_STEP(i+1,pB0,pB1,pA0,pA1);
  }
  #undef SB_STEP
  #undef SB_DMA
  bf16*Ow=O+(rowbase+q0+wid*QBLK)*POUT+h*D; float*Sw=SSQh+(rowbase+q0+wid*QBLK)*16;
  { bf16*stg=(bf16*)(shm+LDS_OST)+wid*2048;
    #pragma unroll
    for(int r=0;r<16;++r){const int orow=crow(r,hi);
      #pragma unroll
      for(int d0=0;d0<2;++d0)stg[orow*64+d0*32+r32]=__float2bfloat16(o[d0][r]);}
    asm volatile("s_waitcnt lgkmcnt(0)":::"memory");
    #pragma unroll
    for(int i=0;i<4;++i){const int row=i*8+(lane>>3),ch=lane&7; const u32x4 v=*(const u32x4*)(stg+row*64+ch*8); ATTN_STORE16(Ow+(long)row*POUT+ch*8,v);
      float sq=0.f;
      #pragma unroll
      for(int w_=0;w_<4;++w_){const float lo_=__uint_as_float(v[w_]<<16),hi_=__uint_as_float(v[w_]&0xffff0000u);sq+=lo_*lo_+hi_*hi_;}
      sq+=__shfl_xor(sq,1);sq+=__shfl_xor(sq,2);sq+=__shfl_xor(sq,4); if(ch==0)Sw[row*16]=sq;} }
  asm volatile("s_waitcnt vmcnt(0) lgkmcnt(0)\n\ts_barrier":::"memory");
}
template<int THRL=8> __device__ __forceinline__ void attn_phase(char*lds,const bf16*PROJ,const float*CUM,bf16*OMIX,float*SSQ,float skipth,int bh,int role){
  const int b=bh>>3,h=bh&7;
  const int nf=role<5?2:6;
  for(int i=0;i<nf;++i){ const int qb=role<5?(i==0?15-role:6+role):5-i;
    attn_unit<THRL>(b,h,qb,PROJ,PROJ+512,PROJ+1024,OMIX,CUM+(size_t)bh*SEQ,SSQ+h,skipth,lds); }
  const int sb0=role<3?3+3*role:(role==3?12:(role==4?14:0)), ns=(role==3||role==4)?2:3;
  for(int i=0;i<ns;++i) sb_unit(b,h,sb0+i,PROJ+1536,PROJ+2048,PROJ+2560,OMIX+512,SSQ+8+h,lds);
}
template<int THRL,int NA> __device__ __forceinline__ void attn_sched(char*lds,const bf16*PROJ,const float*CUM,bf16*OMIX,float*SSQ,float skipth,int xl,int c){
  int tid_=threadIdx.x; asm volatile("":"+v"(tid_)); const int tid=tid_;
  volatile __attribute__((address_space(3))) float*cost=(volatile __attribute__((address_space(3))) float*)((lds_cptr)lds+114688);
  volatile __attribute__((address_space(3))) int*order=(volatile __attribute__((address_space(3))) int*)((lds_cptr)lds+114688+512);
  #define BH_OF(i) ((xl>>1)*8+(((xl&1)?0x4361:0x5270)>>(4*(i))&15))
  if(tid<128){ const int bi=tid>>5,type=(tid>>4)&1,qb=tid&15,bh=BH_OF(bi),NT0=4*(qb+1); float cs;
    if(type==0){ const float rate=-CUM[(size_t)bh*SEQ+SEQ-1]*(1.f/SEQ); const float w=skipth/fmaxf(rate,1e-6f); const float sk=fmaxf(0.f,(float)(qb*QB)-w);
      int t0=((int)(sk*(1.f/KVBLK)))&~1; if(t0>NT0-4)t0=NT0-4; cs=5.f+1.65f*(float)(NT0-t0); }
    else cs=3.f+2.6f*(float)(NT0<8?NT0:8);
    cost[tid]=cs; }
  asm volatile("s_waitcnt lgkmcnt(0)":::"memory"); __syncthreads();
  if(tid<128){ const float mc=cost[tid]; int rk=0; for(int j=0;j<128;++j){ const float cj=cost[j]; rk+=(cj>mc||(cj==mc&&j<tid))?1:0; } order[rk]=tid; }
  asm volatile("s_waitcnt lgkmcnt(0)":::"memory"); __syncthreads();
  for(int k=0;;++k){ const int r=NA*k+((k&1)?NA-1-c:c); if(r>=128)break;
    const int u=__builtin_amdgcn_readfirstlane(order[r]); const int bi=u>>5,type=(u>>4)&1,qb=u&15,bh=BH_OF(bi),b=bh>>3,h=bh&7;
    if(type==0)attn_unit<THRL>(b,h,qb,PROJ,PROJ+512,PROJ+1024,OMIX,CUM+(size_t)bh*SEQ,SSQ+h,skipth,lds);
    else sb_unit(b,h,qb,PROJ+1536,PROJ+2048,PROJ+2560,OMIX+512,SSQ+8+h,lds); }
  #undef BH_OF
}
template<int THRL=8> __device__ __forceinline__ void attn_phase8(char*lds,const bf16*PROJ,const float*CUM,bf16*OMIX,float*SSQ,int vcu){
  const int bh=vcu>>3,s=vcu&7,b=bh>>3,h=bh&7;
  if(bh>=32)return;
  for(int i=0;i<4;++i){ const int qb=(i&1)?15-s:s;
    if(i<2)attn_unit<THRL>(b,h,qb,PROJ,PROJ+512,PROJ+1024,OMIX,CUM+(size_t)bh*SEQ,SSQ+h,3.0e38f,lds);
    else   sb_unit(b,h,qb,PROJ+1536,PROJ+2048,PROJ+2560,OMIX+512,SSQ+8+h,lds); }
}
#undef SBAR
#undef WAIT_BAR
}

template <int NT, bool UP> __device__ __forceinline__ int moe_prepare(const unsigned* __restrict__ CNT, const int* __restrict__ LIST, const float* __restrict__ RSTD2, const float* __restrict__ RW,
                                                                     const float* __restrict__ bias, int* __restrict__ TBG, int bx, LAS unsigned char* L) {
    int tid_ = threadIdx.x; asm volatile("" : "+v"(tid_)); const int tid = tid_;
    LAS int* tb = (LAS int*)(L + TB_OFF); LAS int* tbE = tb + 64; LAS int* tbC = tb + 128; LAS int* cntl = tb + 192; LAS int* udl = tb + 224; LAS int* tabA = (LAS int*)(L + TAB_OFF); LAS float* tabB = (LAS float*)(L + TAB2_OFF);
    if (tid < 64) {
        const int cn = tid < NE ? (int)CNT[tid] : 0, nt = (cn + 255) >> 8, rem = cn & 255, ch = (rem != 0 && rem <= 128) ? 1 : 0;
        int a = nt, c = ch;
#pragma unroll
        for (int o = 1; o < 32; o <<= 1) { const int ta = __shfl_up(a, o), tc = __shfl_up(c, o); if ((tid & 63) >= o) { a += ta; c += tc; } }
        if (tid < NE) { tb[tid + 1] = a; tbC[tid + 1] = c; tbE[tid + 1] = a - c; cntl[tid] = cn; }
        if (tid == 0) { tb[0] = 0; tbC[0] = 0; tbE[0] = 0; }
    }
    LDS_WAIT(); __syncthreads();
    if (bx == 0 && tid <= NE) TBG[tid] = tb[tid];
    pg8::MoeOrder S{NT, bx, tb, tbE, tbC, cntl, tabA};
    if (tid < pg8::MOE_MAXU) { pg8::Unit u; const bool ok = S.next(tid, u); udl[3 * tid] = ok ? u.pm : -1; udl[3 * tid + 1] = u.pn; udl[3 * tid + 2] = u.nr; }
    LDS_WAIT(); __syncthreads();
    int nun = 0;
#pragma unroll
    for (int i = 0; i < pg8::MOE_MAXU; ++i) nun += (udl[3 * i] >= 0) ? 1 : 0;
    int slot[5];
#pragma unroll
    for (int j = 0; j < 5; ++j) { const int idx = tid + NTHREADS * j, ui = idx >> 8, r = idx & 255; slot[j] = 0;
        if (ui < nun) { const int e = udl[3 * ui + 1] / NT, mt = udl[3 * ui] - tb[e], cnt = cntl[e], p = mt * 256 + r; slot[j] = LIST[(size_t)e * LIST_CAP + (p < cnt ? p : cnt - 1)]; } }
#pragma unroll
    for (int j = 0; j < 5; ++j) { const int idx = tid + NTHREADS * j, ui = idx >> 8;
        if (ui < nun) { const int pn = udl[3 * ui + 1];
            if (UP) { const int tok = slot[j] >> 2; tabA[idx] = tok | (int)(__float_as_uint(RSTD2[tok]) & 0xffff0000u);
                      const int e = pn >> 3, pl = pn & 7, c = idx & 255; tabB[idx] = bias[(size_t)e * 2048 + (c < 128 ? pl * 128 + c : 1024 + pl * 128 + (c - 128))]; }
            else { ((LAS float*)tabA)[idx] = RW[slot[j]] * (Y_F8 ? 16.f : 1.f); const int e = pn >> 2, pl = pn & 3; tabB[idx] = bias[(size_t)e * DM + pl * 256 + (idx & 255)]; } } }
    VM_WAIT(); LDS_WAIT(); __syncthreads();
    return nun;
}

__global__ void __launch_bounds__(NTHREADS, 2) mega_fwd(Args a) {
    extern __shared__ __attribute__((aligned(16))) unsigned char lds[];
    LAS unsigned char* L = (LAS unsigned char*)lds;
    volatile LAS unsigned* MISC = (volatile LAS unsigned*)(L + MISC_OFF);
    const int tid = threadIdx.x, lane = tid & 63, wave = __builtin_amdgcn_readfirstlane(tid >> 6);
    const int G = gridDim.x, bx = blockIdx.x, vcu = (G % 8 == 0) ? (bx % 8) * (G / 8) + bx / 8 : bx;
    const int gw = vcu * NWAVES + wave, NGW = G * NWAVES;
    const bool cvt_role = (vcu & 31) >= 32 - NCVT;
    const int cvt_first = ((vcu >> 5) * NCVT + ((vcu & 31) - (32 - NCVT))) * NWAVES + wave;
    const bool cvt1_role = (vcu & 31) >= 24; const int cvt1_first = ((vcu >> 5) * 8 + ((vcu & 31) - 24)) * NWAVES + wave;
    unsigned char* ws = a.ws;
    unsigned* CTL = (unsigned*)(ws + WS_CTL);
    bf16_t* WINT = (bf16_t*)(ws + WS_WINT); bf16_t* WOUTT = (bf16_t*)(ws + WS_WOUTT); float* WR = (float*)(ws + WS_WR); float* CUM = (float*)(ws + WS_CUM);
    float* SSQ = (float*)(ws + WS_SSQ); float* RSTD2 = (float*)(ws + WS_RSTD2); float* RW = (float*)(ws + WS_RW); int* SLOTEP = (int*)(ws + WS_SLOTEP); int* TBG = (int*)(ws + WS_TBG); int* LIST = (int*)(ws + WS_LIST); float* FLOG = (float*)(ws + WS_FLOG);
    bf16_t* XN = (bf16_t*)(ws + WS_XN); bf16_t* PROJ = (bf16_t*)(ws + WS_PROJ); bf16_t* OMIX = (bf16_t*)(ws + WS_OMIX); bf16_t* X1B = (bf16_t*)(ws + WS_X1B);
    bf16_t* W1T = (bf16_t*)(ws + WS_W1T); bf16_t* W2T = (bf16_t*)(ws + WS_W2T); bf16_t* H = (bf16_t*)(ws + WS_H); bf16_t* Y = (bf16_t*)(ws + WS_Y);
    unsigned* CNT = CTL + CW_CNT;
    for (int u = tid; u < (LDS_BYTES - LDSCTL_OFF) / 4; u += NTHREADS) ((LAS unsigned*)(L + LDSCTL_OFF))[u] = 0u;
    __syncthreads();
    XcdBarrier bar = xcd_barrier_post(CTL + CW_BAR, MISC + 8);
    unsigned long long tsA = 0, tsB = 0;
#define STAMP(k) do { if (PROBE_T >= 0) { if ((k) == PROBE_T) tsA = __builtin_amdgcn_s_memrealtime(); if ((k) == PROBE_T + 1) tsB = __builtin_amdgcn_s_memrealtime(); } } while (0)
    STAMP(0);

    REPS(0) {
        LAS float* scr = (LAS float*)(L + RING_OFF + wave * 8448);
        LAS float* wf = (LAS float*)(L + RING_OFF + 98304);
        for (int i = tid; i < DM * 8; i += NTHREADS) { const int k = i >> 3; wf[(i & 7) * DM + k] = a.w_in[(size_t)k * WIN_N + 1536 + (i & 7)] * a.g1[k]; }
        LDS_WAIT(); __syncthreads();
        constexpr int I_IN = (DM / 64) * (NPROJ / 32), I_OUT = (DM / 64) * (DM / 32);
        for (int it = gw; it < I_IN + I_OUT; it += NGW) {
            TrItem t; f32x4 v[8];
            if (it < I_IN) { t.W = a.w_in; t.WT = WINT; t.gA = a.g1; t.gB = nullptr; t.K = DM; t.Nin = WIN_N; t.Nout = NPROJ; t.mode = 1; t.gsplit = DM; t.item = it; t.nbsh = -1; t.f8 = 0; }
            else { t.W = a.w_out; t.WT = WOUTT; t.gA = a.g_fox; t.gB = a.g_sb; t.K = DM; t.Nin = DM; t.Nout = DM; t.mode = 0; t.gsplit = GW; t.item = it - I_IN; t.nbsh = 5; t.f8 = 0; }
            tr_load<false>(t, lane, v); tr_store(t, lane, v, scr);
        }
        if (!OVERLAP_CVT) convert_experts(a.w1, a.w2, a.g2, W1T, W2T, gw, NGW, N_EXP_ITEMS, lane, scr);
        for (int i = gw * 64 + lane; i < DM * NE; i += NGW * 64) WR[i] = a.w_router[i] * a.g2[i >> 5];
        for (int row = gw; row < M; row += 4 * NGW) {
            float4 v0[4], v1[4], v2[4], v3[4];
#pragma unroll
            for (int j = 0; j < 4; ++j) { v0[j] = ((const float4*)(a.x + (size_t)row * DM))[lane + 64 * j]; v1[j] = ((const float4*)(a.x + (size_t)(row + NGW) * DM))[lane + 64 * j];
                v2[j] = ((const float4*)(a.x + (size_t)(row + 2 * NGW) * DM))[lane + 64 * j]; v3[j] = ((const float4*)(a.x + (size_t)(row + 3 * NGW) * DM))[lane + 64 * j]; }
            rms1_row(v0, wf, a.b_f, XN, FLOG, row, lane); rms1_row(v1, wf, a.b_f, XN, FLOG, row + NGW, lane);
            rms1_row(v2, wf, a.b_f, XN, FLOG, row + 2 * NGW, lane); rms1_row(v3, wf, a.b_f, XN, FLOG, row + 3 * NGW, lane);
        }
    }
    xcd_barrier(bar); if (REP_PHASE == 8) xcd_barrier(bar); STAMP(1);
    REPS(1) {
    { const int ci = (vcu >> 5) * 8 + ((vcu & 31) - 24);
      if (OVERLAP_CVT && CVT_SPLIT > 0) { if (cvt1_role && ((vcu & 31) - 24) < 4) cumsum_wg(FLOG, CUM, (vcu >> 5) * 4 + ((vcu & 31) - 24), (LAS float*)(L + RING_OFF)); }
      else if (vcu < NB * NH) cumsum_wg(FLOG, CUM, vcu, (LAS float*)(L + RING_OFF)); (void)ci; }
    if (OPT_GEMM) {
        if (OVERLAP_CVT && CVT_SPLIT > 0 && cvt1_role) {
            if (CVT_DMA) { LAS float* gl = (LAS float*)(L + TAB_OFF); for (int i = tid; i < DM; i += NTHREADS) gl[i] = a.g2[i]; LDS_WAIT(); __syncthreads();
                convert_experts_dma(a.w1, a.w2, W1T, W2T, cvt1_first, 64 * NWAVES, CVT_SPLIT, lane, (unsigned)(uintptr_t)((char*)lds + RING_OFF + wave * 16384), (const LAS float*)(L + RING_OFF + wave * 16384), gl); }
            else convert_experts(a.w1, a.w2, a.g2, W1T, W2T, cvt1_first, 64 * NWAVES, CVT_SPLIT, lane, (LAS float*)(L + RING_OFF + wave * 8448)); }
        else {
        pg8::Gemm g{XN, WINT, DM}; pg8::StaticOrder S; if (OVERLAP_CVT && CVT_SPLIT > 0) S.init(M, NPROJ, 192, (vcu & 31) * 8 + (vcu >> 5)); else S.init(M, NPROJ, G, bx); pg8::EpiProj E{PROJ, CTL + CW_QHP};
        pg8::gemm_phase<pg8::EpiProj, pg8::StaticOrder, true, false>(L + RING_OFF, g, S, E);
        }
    } else { for (int it = gw; it < (M / 16) * (NPROJ / 64); it += NGW) nv_inproj(XN, WINT, PROJ, it, lane); }
    }
    xcd_barrier(bar); if (REP_PHASE == 8) xcd_barrier(bar); STAMP(2);
    REPS(2) if (OPT_ATTN) {
        static_assert(attn_body::ATTN_LDS_BYTES <= RING_BYTES, "attention scratch inside the ring region");
        if (OVERLAP_CVT) {
            const int xl = vcu >> 5, l = vcu & 31;
            if (cvt_role) {
                if (CVT_DMA) { LAS float* gl = (LAS float*)(L + TAB_OFF); for (int i = tid; i < DM; i += NTHREADS) gl[i] = a.g2[i]; LDS_WAIT(); __syncthreads();
                    convert_experts_dma(a.w1, a.w2, W1T, W2T, CVT_SPLIT + cvt_first, 8 * NCVT * NWAVES, N_EXP_ITEMS, lane, (unsigned)(uintptr_t)((char*)lds + RING_OFF + wave * 16384), (const LAS float*)(L + RING_OFF + wave * 16384), gl); }
                else convert_experts(a.w1, a.w2, a.g2, W1T, W2T, CVT_SPLIT + cvt_first, 8 * NCVT * NWAVES, N_EXP_ITEMS, lane, (LAS float*)(L + RING_OFF + wave * 8448)); }
            const float bnd = 2.04f * sqrtf(__uint_as_float(CTL[CW_QHP]) * __uint_as_float(CTL[CW_KHP])), skipth = FOX_SKIP ? 160.f + 2.f * bnd : 3.0e38f;
            if (l < 32 - NCVT) { if (ATTN_SCHED) attn_body::attn_sched<8, 32 - NCVT>((char*)lds + RING_OFF, (const attn_body::bf16*)PROJ, CUM, (attn_body::bf16*)OMIX, SSQ, skipth, xl, l);
                          else attn_body::attn_phase<8>((char*)lds + RING_OFF, (const attn_body::bf16*)PROJ, CUM, (attn_body::bf16*)OMIX, SSQ, skipth, xl * 4 + l / 6, l % 6); }
        } else attn_body::attn_phase8<8>((char*)lds + RING_OFF, (const attn_body::bf16*)PROJ, CUM, (attn_body::bf16*)OMIX, SSQ, vcu);
    } else {
        LAS unsigned char* wl = L + RING_OFF + wave * 16640;
        for (int u = gw; u < 4096; u += NGW) {
            const int i = u >> 11, idx = u & 2047, type = idx & 1, bh = (idx >> 1) & 31, j = (idx >> 6) & 31; const int qblk = (i == 0) ? j : 63 - j;
            if (type == 0) nv_attn<0>(PROJ, CUM, OMIX, SSQ, bh, qblk, lane, wl); else nv_attn<1>(PROJ, CUM, OMIX, SSQ, bh, qblk, lane, wl);
        }
    }
    xcd_barrier(bar); if (REP_PHASE == 8) xcd_barrier(bar); STAMP(3);
    REPS(3) if (OPT_GEMM) {
        pg8::Gemm g{OMIX, WOUTT, DM}; pg8::StaticOrder S; S.init(M, DM, G, bx);
        LAS float* ratio = (LAS float*)(L + TAB_OFF); LAS float* rsb = (LAS float*)(L + TAB_OFF + 1024);
        pg8::Unit u0;
        if (S.next(0, u0) && tid < 256) { const float* sp = SSQ + (size_t)(u0.pm * 256 + tid) * 16; float sf = 0.f, s2 = 0.f;
#pragma unroll
            for (int h = 0; h < 8; ++h) { sf += sp[h]; s2 += sp[8 + h]; }
            const float rf = rsqrtf(sf * (1.f / GW) + EPS), rs = rsqrtf(s2 * (1.f / GW) + EPS); ratio[tid] = rf / rs; rsb[tid] = rs; }
        VM_WAIT(); LDS_WAIT(); __syncthreads();
        pg8::EpiWout E{a.x, X1_BF16 ? (float*)XN : a.out, X1B, ratio, rsb};
        pg8::gemm_phase<pg8::EpiWout, pg8::StaticOrder, false, false>(L + RING_OFF, g, S, E);
    } else { for (int it = gw; it < (M / 16) * (DM / 64); it += NGW) nv_wout(OMIX, WOUTT, SSQ, a.x, a.out, X1B, it, lane); }
    xcd_barrier(bar); if (REP_PHASE == 8) xcd_barrier(bar); STAMP(4);
    if (REP_PHASE == 4) { for (int t64 = vcu; t64 < M / 64; t64 += G) router_wg(a.out, WR, a.b_router, (float*)H, (float*)H + M, (int*)Y, (int*)Y + NE * LIST_CAP, CNT + 64, t64 * 64, L + RING_OFF); }
    if (OPT_ROUTER) { for (int t64 = vcu; t64 < M / 64; t64 += G) router_wg(X1_BF16 ? (const float*)XN : a.out, WR, a.b_router, RSTD2, RW, LIST, SLOTEP, CNT, t64 * 64, L + RING_OFF); }
    else { for (int it = gw; it < M / 2; it += NGW) nv_router(a.out, WR, a.b_router, RSTD2, RW, LIST, SLOTEP, CNT, it, lane); }
    xcd_barrier(bar); if (REP_PHASE == 8) xcd_barrier(bar); STAMP(5);
    LAS int* tb = (LAS int*)(L + TB_OFF); LAS int* tbE = tb + 64; LAS int* tbC = tb + 128; LAS int* cntl = tb + 192; LAS int* udl = tb + 224; LAS int* tabA = (LAS int*)(L + TAB_OFF); LAS int* tabB = (LAS int*)(L + TAB2_OFF);
    REPS(5) if (OPT_GEMM) {
        const int nun = moe_prepare<8, true>(CNT, LIST, RSTD2, RW, a.b1, TBG, bx, L);
        pg8::Gemm g{X1B, W1T, MOE_F8 ? DM / 2 : DM}; pg8::EpiMoe1 E{H, tabA, (const LAS float*)tabB}; pg8::ListOrder SL{udl, nun, tabA};
        pg8::gemm_phase<pg8::EpiMoe1, pg8::ListOrder, true, true, MOE_F8>(L + RING_OFF, g, SL, E);
    } else {
    for (int g = gw; g < MAX_TILES * 16; g += NGW) {
        int e, base, p0, cnt; if (!moe_tile(CNT, g, e, base, p0, cnt)) continue;
        for (int cg = 0; cg < DFF / 32; ++cg) nv_moe1(X1B, W1T, a.b1, RSTD2, LIST, H, e, base, p0, cnt, cg, lane);
    } }
    xcd_barrier(bar); if (REP_PHASE == 8) xcd_barrier(bar); STAMP(6);
    REPS(6) if (OPT_GEMM) {
        const int nun = moe_prepare<4, false>(CNT, LIST, RSTD2, RW, a.b2, TBG, bx, L);
        pg8::Gemm g{H, W2T, MOE_F8 ? DM / 2 : DM}; pg8::EpiMoe2 E{Y, (const LAS float*)tabA, (const LAS float*)tabB}; pg8::ListOrder SL{udl, nun, tabA};
        pg8::gemm_phase<pg8::EpiMoe2, pg8::ListOrder, true, false, MOE_F8>(L + RING_OFF, g, SL, E);
    } else {
    for (int g = gw; g < MAX_TILES * 16; g += NGW) {
        int e, base, p0, cnt; if (!moe_tile(CNT, g, e, base, p0, cnt)) continue;
        for (int cg = 0; cg < DM / 64; ++cg) nv_moe2(H, W2T, a.b2, RW, LIST, Y, e, base, p0, cnt, cg, lane);
    } }
    xcd_barrier(bar); if (REP_PHASE == 8) xcd_barrier(bar); STAMP(7);
    if (REP_PHASE == 7) { for (int row = gw; row < M; row += NGW) final_row(a.out, Y, SLOTEP, TBG, a.gf, (float*)H, row, lane); }
    for (int row = gw; row < M; row += NGW) final_row(X1_BF16 ? (const float*)XN : a.out, Y, SLOTEP, TBG, a.gf, a.out, row, lane);
    STAMP(8);
    if (PROBE_T >= 0) { const unsigned long long t0 = __builtin_amdgcn_s_memrealtime(), d = 9ull * (tsB - tsA); while (__builtin_amdgcn_s_memrealtime() - t0 < d) __builtin_amdgcn_s_sleep(8); }
#undef STAMP
}

extern "C" void kernel_launch(void* const* d_in, const int* in_sizes, int n_in, void* d_out, int out_size, void* d_ws, size_t ws_size, hipStream_t stream) {
    static int grid = 0;
    if (grid == 0) {
        if (n_in != 15 || in_sizes[0] != M * DM || out_size != M * DM || ws_size < WS_END) {
            fprintf(stderr, "kernel_launch: unexpected shapes / workspace (n_in %d, in0 %d, out %d, ws %zu, need %zu)\n", n_in, n_in > 0 ? in_sizes[0] : -1, out_size, ws_size, (size_t)WS_END); grid = -1; return; }
        int dev = 0, cus = 0, per_cu = 0;
        if (hipGetDevice(&dev) != hipSuccess || hipDeviceGetAttribute(&cus, hipDeviceAttributeMultiprocessorCount, dev) != hipSuccess) { grid = -1; return; }
        if (hipFuncSetAttribute((const void*)mega_fwd, hipFuncAttributeMaxDynamicSharedMemorySize, LDS_BYTES) != hipSuccess) { fprintf(stderr, "kernel_launch: hipFuncSetAttribute failed\n"); grid = -1; return; }
        if (hipOccupancyMaxActiveBlocksPerMultiprocessor(&per_cu, (const void*)mega_fwd, NTHREADS, LDS_BYTES) != hipSuccess || per_cu < 1) fprintf(stderr, "kernel_launch: occupancy query reports %d\n", per_cu);
        (void)hipGetLastError();
        grid = cus;
        if (cus != 256) { fprintf(stderr, "kernel_launch: built for 256 CUs (8 XCDs x 32), found %d; nothing launched\n", cus); grid = -1; return; }
    }
    if (grid < 0) return;
    if (hipMemsetAsync((char*)d_ws + WS_CTL, 0, CTL_BYTES, stream) != hipSuccess) return;
    Args a{};
    a.x = (const float*)d_in[0]; a.g1 = (const float*)d_in[1]; a.w_in = (const float*)d_in[2]; a.b_f = (const float*)d_in[3]; a.g_fox = (const float*)d_in[4]; a.g_sb = (const float*)d_in[5];
    a.w_out = (const float*)d_in[6]; a.g2 = (const float*)d_in[7]; a.w_router = (const float*)d_in[8]; a.b_router = (const float*)d_in[9]; a.w1 = (const float*)d_in[10]; a.b1 = (const float*)d_in[11];
    a.w2 = (const float*)d_in[12]; a.b2 = (const float*)d_in[13]; a.gf = (const float*)d_in[14];
    a.out = (float*)d_out; a.ws = (unsigned char*)d_ws;
    hipLaunchKernelGGL(mega_fwd, dim3(grid), dim3(NTHREADS), LDS_BYTES, stream, a);
    const hipError_t le = hipPeekAtLastError();
    if (le != hipSuccess) fprintf(stderr, "kernel_launch: launch failed: %s\n", hipGetErrorName(le));
}
```

```cpp
#include <hip/hip_runtime.h>
#include <cstdio>
#include <cstdint>

typedef unsigned short bf16_t;
typedef short bf16x8 __attribute__((ext_vector_type(8)));
typedef float f32x4 __attribute__((ext_vector_type(4)));

constexpr int NB = 4, SEQ = 4096, DM = 1024, M = NB * SEQ;
constexpr int NH = 8, HD = 64, GW = 512;
constexpr int WIN_N = 3080, NPROJ = 3072;
constexpr int NE = 32, TOPK = 4, DFF = 1024;
constexpr float EPS = 1e-5f;
constexpr float LOG2E = 1.4426950408889634f;
constexpr float C2 = 0.125f * LOG2E;
constexpr int LIST_CAP = M;
constexpr int MAX_TILES = (M * TOPK) / 256 + NE;

constexpr size_t MiB = 1u << 20;
constexpr size_t WS_CTL = 0, CTL_BYTES = 1 * MiB;
constexpr size_t WS_WINT = 2 * MiB;
constexpr size_t WS_WOUTT = 8 * MiB;
constexpr size_t WS_WR = 10 * MiB;
constexpr size_t WS_CUM = 11 * MiB;
constexpr size_t WS_SSQ = 12 * MiB;
constexpr size_t WS_RSTD2 = 14 * MiB;
constexpr size_t WS_RW = 15 * MiB;
constexpr size_t WS_SLOTEP = 15 * MiB + 512 * 1024;
constexpr size_t WS_TBG = 14 * MiB + 512 * 1024;
constexpr size_t WS_LIST = 16 * MiB;
constexpr size_t WS_FLOG = 18 * MiB;
constexpr size_t WS_XN = 32 * MiB;
constexpr size_t WS_PROJ = 64 * MiB;
constexpr size_t WS_OMIX = 160 * MiB;
constexpr size_t WS_X1B = 192 * MiB;
constexpr size_t WS_W1T = 224 * MiB;
constexpr size_t WS_W2T = 352 * MiB;
constexpr size_t WS_H = 416 * MiB;
constexpr size_t WS_Y = 560 * MiB;
constexpr size_t WS_END = 704 * MiB;
constexpr int CW_CNT = 1024;
constexpr int CW_QCTR = 2304;
constexpr int CW_QHP = 2048, CW_KHP = 2112;

__device__ __forceinline__ unsigned short f2bf(float f) { unsigned u = __float_as_uint(f); return (unsigned short)((u + 0x7fffu + ((u >> 16) & 1u)) >> 16); }
__device__ __forceinline__ float bf2f(unsigned short b) { return __uint_as_float(((unsigned)b) << 16); }
__device__ __forceinline__ float wave_sum(float v) {
#pragma unroll
    for (int o = 1; o < 64; o <<= 1) v += __shfl_xor(v, o);
    return v;
}


#define LAS __attribute__((address_space(3)))
#define GAS __attribute__((address_space(1)))
typedef unsigned v4u __attribute__((ext_vector_type(4)));
#define LDS_WAIT() asm volatile("s_waitcnt lgkmcnt(0)" ::: "memory")
#define VM_WAIT() asm volatile("s_waitcnt vmcnt(0)" ::: "memory")
constexpr int NWAVES = 8, NTHREADS = NWAVES * 64;
constexpr int PROBE_T = -1;
constexpr int REP_PHASE = -1;
#define REPS(k) for (int rep_ = 0; rep_ < ((REP_PHASE == (k)) ? 2 : 1); ++rep_)
constexpr bool ATTN_DYN = true;
constexpr bool ATTN_SCHED = true;
constexpr bool FOX_SKIP = true;
constexpr bool WT_STORES = false;
constexpr bool X1_BF16 = true;
constexpr bool Y_F8 = true;
constexpr bool MOE_F8 = true;
constexpr bool CVT_DMA = true;
constexpr int NCVT = 8;
constexpr int CVT_SPLIT = 20 * 512;
constexpr bool OVERLAP_CVT = true;
constexpr bool OPT_GEMM = true;
constexpr bool OPT_ROUTER = true;
constexpr bool OPT_ATTN = true;

#define XB_TMO      128
#define XB_XCNT(j)  (256  + 64 * (j))
#define XB_XSUB(j)  (1280 + 64 * (j))
#define XB_XGEN(j)  (2304 + 64 * (j))
#define XB_TOP      3328
#define XB_TOPGEN   3392
#define XCD_BAR_WORDS 3456
#define XB_SPIN_CAP (1u << 20)
__device__ __forceinline__ unsigned xb_ld(unsigned* p)              { return __hip_atomic_load(p, __ATOMIC_RELAXED, __HIP_MEMORY_SCOPE_AGENT); }
__device__ __forceinline__ unsigned xb_add(unsigned* p, unsigned v) { return __hip_atomic_fetch_add(p, v, __ATOMIC_RELAXED, __HIP_MEMORY_SCOPE_AGENT); }
__device__ __forceinline__ unsigned xb_xcc_id() { return (unsigned)__builtin_amdgcn_s_getreg((3 << 11) | 20) & 0xFu; }
#define XB_SPIN(cond, bar) do { unsigned _sp = 0; while (cond) { __builtin_amdgcn_s_sleep(1); \
    if ((++_sp & 255u) == 0u) { if (xb_ld(&(bar)[XB_TMO])) break; if (_sp > XB_SPIN_CAP) { atomicAdd(&(bar)[XB_TMO], 1u); break; } } } } while (0)
struct XcdBarrier { unsigned* bar; unsigned x; volatile LAS unsigned* st; };
__device__ __forceinline__ XcdBarrier xcd_barrier_post(unsigned* bar, volatile LAS unsigned* st) {
    XcdBarrier b; b.bar = bar; b.x = xb_xcc_id(); b.st = st;
    if (threadIdx.x == 0) (void)xb_add(&bar[XB_XCNT(b.x)], 1u);
    return b;
}
__device__ __forceinline__ void xcd_barrier_complete(unsigned* bar, unsigned x, unsigned& nloc, unsigned& nx) {
    const unsigned G = gridDim.x * gridDim.y * gridDim.z;
    unsigned sum, cnt, mine, sp = 0u;
    for (;;) {
        sum = 0u; cnt = 0u; mine = 0u;
#pragma unroll
        for (unsigned j = 0; j < 16; ++j) { const unsigned c = xb_ld(&bar[XB_XCNT(j)]); sum += c; cnt += (c > 0u) ? 1u : 0u; mine = (j == x) ? c : mine; }
        if (sum == G) break;
        __builtin_amdgcn_s_sleep(1);
        if ((++sp & 255u) == 0u) { if (xb_ld(&bar[XB_TMO])) break; if (sp > XB_SPIN_CAP) { atomicAdd(&bar[XB_TMO], 1u); break; } }
    }
    nloc = mine > 0u ? mine : 1u; nx = cnt > 0u ? cnt : 1u;
}
__device__ __forceinline__ void xcd_barrier(const XcdBarrier& b) {
    asm volatile("s_waitcnt vmcnt(0)" ::: "memory");
    __syncthreads();
    if (threadIdx.x == 0) {
        unsigned* bar = b.bar;
        __builtin_amdgcn_s_waitcnt(0);
        unsigned nloc = b.st[0], nx = b.st[1];
        if (nloc == 0u) { xcd_barrier_complete(bar, b.x, nloc, nx); b.st[0] = nloc; b.st[1] = nx; }
        const unsigned old = xb_add(&bar[XB_XSUB(b.x)], 1u);
        const unsigned gen = old / nloc;
        if (old + 1u == (gen + 1u) * nloc) {
            __builtin_amdgcn_fence(__ATOMIC_RELEASE, "agent");
            asm volatile("s_waitcnt vmcnt(0)" ::: "memory");
            const unsigned og = xb_add(&bar[XB_TOP], 1u);
            const unsigned tg = og / nx;
            if (og + 1u == (tg + 1u) * nx) xb_add(&bar[XB_TOPGEN], 1u);
            else XB_SPIN(xb_ld(&bar[XB_TOPGEN]) == tg, bar);
            __builtin_amdgcn_fence(__ATOMIC_ACQUIRE, "agent");
            xb_add(&bar[XB_XGEN(b.x)], 1u);
            asm volatile("s_waitcnt vmcnt(0)" ::: "memory");
        } else {
            XB_SPIN(xb_ld(&bar[XB_XGEN(b.x)]) == gen, bar);
            __builtin_amdgcn_fence(__ATOMIC_ACQUIRE, "agent");
            asm volatile("s_waitcnt vmcnt(0)" ::: "memory");
        }
    }
    __syncthreads();
}

constexpr int RING_OFF = 0, RING_BYTES = 131072;
constexpr int TAB_OFF = 131072;
constexpr int TAB2_OFF = TAB_OFF + 10 * 1024, TB_OFF = TAB_OFF + 20 * 1024;
constexpr int LDSCTL_OFF = 152576, MISC_OFF = LDSCTL_OFF + 320;
constexpr int LDS_BYTES = 155648;
constexpr int CW_BAR = 4096;

struct Args {
    const float *x, *g1, *w_in, *b_f, *g_fox, *g_sb, *w_out, *g2, *w_router, *b_router, *w1, *b1, *w2, *b2, *gf;
    float* out; unsigned char* ws;
};

__device__ __forceinline__ int mapcol(int mode, int n) {
    if (mode == 1) return n < 1536 ? n : n + 8;
    if (mode == 2) { const int pn = n >> 8, j = n & 255; return j < 128 ? 128 * pn + j : 1024 + 128 * pn + (j - 128); }
    return n;
}
__device__ __forceinline__ unsigned pk4_fp8(float a, float b, float c, float d) {
    a = __builtin_amdgcn_fmed3f(a, -448.f, 448.f); b = __builtin_amdgcn_fmed3f(b, -448.f, 448.f); c = __builtin_amdgcn_fmed3f(c, -448.f, 448.f); d = __builtin_amdgcn_fmed3f(d, -448.f, 448.f);
    int w = __builtin_amdgcn_cvt_pk_fp8_f32(a, b, 0, false); w = __builtin_amdgcn_cvt_pk_fp8_f32(c, d, w, true); return (unsigned)w;
}
__device__ __forceinline__ unsigned pk2(float lo, float hi) { unsigned r; asm("v_cvt_pk_bf16_f32 %0, %1, %2" : "=v"(r) : "v"(lo), "v"(hi)); return r; }
struct TrItem { const float* W; bf16_t* WT; const float* gA; const float* gB; int K, Nin, Nout, mode, gsplit, item, nbsh, f8; };
template <bool NT> __device__ __forceinline__ void tr_load(const TrItem& t, int lane, f32x4 (&v)[8]) {
    const int nblk = t.Nout / 32, kb = t.nbsh >= 0 ? (t.item >> t.nbsh) : t.item / nblk, nb = t.nbsh >= 0 ? (t.item & (nblk - 1)) : t.item % nblk, k0 = 64 * kb, n0 = 32 * nb, l7 = lane & 7, kr = lane >> 3, col = mapcol(t.mode, n0 + 4 * l7);
#pragma unroll
    for (int i = 0; i < 8; ++i) { const f32x4* p = (const f32x4*)(t.W + (size_t)(k0 + 8 * i + kr) * t.Nin + col); v[i] = NT ? __builtin_nontemporal_load(p) : *p; }
}
__device__ __forceinline__ void tr_store(const TrItem& t, int lane, const f32x4 (&v)[8], LAS float* scr) {
    const int nblk = t.Nout / 32, kb = t.nbsh >= 0 ? (t.item >> t.nbsh) : t.item / nblk, nb = t.nbsh >= 0 ? (t.item & (nblk - 1)) : t.item % nblk, k0 = 64 * kb, n0 = 32 * nb, l7 = lane & 7, kr = lane >> 3;
#pragma unroll
    for (int i = 0; i < 8; ++i) { const int kk = 8 * i + kr, k = k0 + kk; const float gs = t.gA ? (k < t.gsplit ? t.gA[k] : t.gB[k - t.gsplit]) : 1.f;
        LAS float* sp = scr + kk * 33 + 4 * l7; sp[0] = v[i][0] * gs; sp[1] = v[i][1] * gs; sp[2] = v[i][2] * gs; sp[3] = v[i][3] * gs; }
    LDS_WAIT();
    if (t.f8) {
        const int c = lane & 3;
#pragma unroll
        for (int j = 0; j < 2; ++j) { const int n = (lane >> 2) + 16 * j; const LAS float* sp = scr + (16 * c) * 33 + n;
            v4u o; o.x = pk4_fp8(32.f * sp[0 * 33], 32.f * sp[1 * 33], 32.f * sp[2 * 33], 32.f * sp[3 * 33]); o.y = pk4_fp8(32.f * sp[4 * 33], 32.f * sp[5 * 33], 32.f * sp[6 * 33], 32.f * sp[7 * 33]);
            o.z = pk4_fp8(32.f * sp[8 * 33], 32.f * sp[9 * 33], 32.f * sp[10 * 33], 32.f * sp[11 * 33]); o.w = pk4_fp8(32.f * sp[12 * 33], 32.f * sp[13 * 33], 32.f * sp[14 * 33], 32.f * sp[15 * 33]);
            *(v4u*)((unsigned char*)t.WT + (size_t)(n0 + n) * t.K + k0 + 16 * c) = o; }
    } else {
    const int c = lane & 7;
#pragma unroll
    for (int j = 0; j < 4; ++j) { const int n = (lane >> 3) + 8 * j; const LAS float* sp = scr + (8 * c) * 33 + n;
        v4u o; o.x = pk2(sp[0 * 33], sp[1 * 33]); o.y = pk2(sp[2 * 33], sp[3 * 33]); o.z = pk2(sp[4 * 33], sp[5 * 33]); o.w = pk2(sp[6 * 33], sp[7 * 33]);
        *(v4u*)(t.WT + (size_t)(n0 + n) * t.K + k0 + 8 * c) = o; }
    }
    LDS_WAIT();
}
constexpr int I_W1 = (DM / 64) * (2048 / 32), I_W2 = (DM / 64) * (DM / 32), N_EXP_ITEMS = NE * (I_W1 + I_W2);
__device__ __forceinline__ TrItem expert_item(const float* w1, const float* w2, const float* g2, bf16_t* W1T, bf16_t* W2T, int r) {
    TrItem t;
    t.f8 = MOE_F8 ? 1 : 0;
    if (r < NE * I_W1) { const int e = r / I_W1; t.W = w1 + (size_t)e * DM * 2048; t.WT = MOE_F8 ? (bf16_t*)((unsigned char*)W1T + (size_t)e * 2048 * DM) : W1T + (size_t)e * 2048 * DM; t.gA = g2; t.gB = nullptr; t.K = DM; t.Nin = 2048; t.Nout = 2048; t.mode = 2; t.gsplit = DM; t.item = r % I_W1; t.nbsh = 6; }
    else { r -= NE * I_W1; const int e = r / I_W2; t.W = w2 + (size_t)e * DM * DM; t.WT = MOE_F8 ? (bf16_t*)((unsigned char*)W2T + (size_t)e * DM * DM) : W2T + (size_t)e * DM * DM; t.gA = nullptr; t.gB = nullptr; t.K = DM; t.Nin = DM; t.Nout = DM; t.mode = 0; t.gsplit = DM; t.item = r % I_W2; t.nbsh = 5; }
    return t;
}
__device__ __forceinline__ void convert_experts(const float* w1, const float* w2, const float* g2, bf16_t* W1T, bf16_t* W2T, int first, int stride, int N_END, int lane, LAS float* scr) {
    f32x4 v0[8], v1[8];
#define CVT_LOAD(v, idx) do { if ((idx) < N_END) { const TrItem t_ = expert_item(w1, w2, g2, W1T, W2T, (idx)); tr_load<true>(t_, lane, v); } } while (0)
#define CVT_STORE(v, idx) do { if ((idx) < N_END) { const TrItem t_ = expert_item(w1, w2, g2, W1T, W2T, (idx)); tr_store(t_, lane, v, scr); } } while (0)
    int it = first; asm volatile("" : "+v"(lane));
    CVT_LOAD(v0, it);
#pragma unroll 1
    for (; it < N_END; it += 2 * stride) {
        CVT_LOAD(v1, it + stride); CVT_STORE(v0, it);
        CVT_LOAD(v0, it + 2 * stride); CVT_STORE(v1, it + stride);
    }
#undef CVT_LOAD
#undef CVT_STORE
}

__device__ __forceinline__ void dma16(const void* gsrc, unsigned lds_dst) { unsigned keep;
    asm volatile("s_mov_b32 %0, m0\n\ts_mov_b32 m0, %2\n\ts_nop 0\n\tglobal_load_lds_dwordx4 %1, off\n\ts_mov_b32 m0, %0" : "=&s"(keep) : "v"(gsrc), "s"(lds_dst) : "memory"); }
struct CvtItem { const float* W; unsigned char* WT; int Nin, k0, n0, col0, useg; };
__device__ __forceinline__ CvtItem cvt_item(const float* w1, const float* w2, bf16_t* W1T, bf16_t* W2T, int r) {
    CvtItem t;
    if (r < NE * I_W1) { const int e = r / I_W1, it = r % I_W1; t.W = w1 + (size_t)e * DM * 2048; t.WT = (unsigned char*)W1T + (size_t)e * 2048 * DM; t.Nin = 2048; t.k0 = 64 * (it >> 6); t.n0 = 32 * (it & 63); t.col0 = mapcol(2, t.n0); t.useg = 1; }
    else { r -= NE * I_W1; const int e = r / I_W2, it = r % I_W2; t.W = w2 + (size_t)e * DM * DM; t.WT = (unsigned char*)W2T + (size_t)e * DM * DM; t.Nin = DM; t.k0 = 64 * (it >> 5); t.n0 = 32 * (it & 31); t.col0 = t.n0; t.useg = 0; }
    return t;
}
__device__ __forceinline__ void cvt_issue(const CvtItem& t, int lane, unsigned ldsbuf) {
#pragma unroll
    for (int i = 0; i < 8; ++i) { const int kl = 8 * i + (lane >> 3), qs = ((lane & 7) - 2 * (kl >> 4)) & 7;
        dma16(t.W + (size_t)(t.k0 + kl) * t.Nin + t.col0 + 4 * qs, (unsigned)__builtin_amdgcn_readfirstlane(ldsbuf + i * 1024)); }
}
__device__ __forceinline__ void cvt_finish(const CvtItem& t, int lane, const LAS float* buf, const LAS float* gl) {
    const int c = lane & 3;
    f32x4 g[4];
#pragma unroll
    for (int m = 0; m < 4; ++m) g[m] = t.useg ? *(const LAS f32x4*)(gl + t.k0 + 16 * c + 4 * m) * 32.f : (f32x4){32.f, 32.f, 32.f, 32.f};
#pragma unroll
    for (int j = 0; j < 2; ++j) { const int n = (lane >> 2) + 16 * j; const LAS float* sp = buf + (16 * c) * 32 + ((n + 8 * c) & 31);
        v4u o;
        o.x = pk4_fp8(sp[0 * 32] * g[0][0], sp[1 * 32] * g[0][1], sp[2 * 32] * g[0][2], sp[3 * 32] * g[0][3]);   o.y = pk4_fp8(sp[4 * 32] * g[1][0], sp[5 * 32] * g[1][1], sp[6 * 32] * g[1][2], sp[7 * 32] * g[1][3]);
        o.z = pk4_fp8(sp[8 * 32] * g[2][0], sp[9 * 32] * g[2][1], sp[10 * 32] * g[2][2], sp[11 * 32] * g[2][3]); o.w = pk4_fp8(sp[12 * 32] * g[3][0], sp[13 * 32] * g[3][1], sp[14 * 32] * g[3][2], sp[15 * 32] * g[3][3]);
        *(v4u*)(t.WT + (size_t)(t.n0 + n) * DM + t.k0 + 16 * c) = o; }
}
__device__ __forceinline__ void convert_experts_dma(const float* w1, const float* w2, bf16_t* W1T, bf16_t* W2T, int first, int stride, int N_END, int lane_, unsigned lds0, const LAS float* buf0, const LAS float* gl) {
    int lane = lane_; asm volatile("" : "+v"(lane));
    int it = first;
    if (it < N_END) { const CvtItem t = cvt_item(w1, w2, W1T, W2T, it); cvt_issue(t, lane, lds0); }
#pragma unroll 1
    for (; it < N_END; it += 2 * stride) {
        const int nx = it + stride, nn = it + 2 * stride;
        if (nx < N_END) { const CvtItem t = cvt_item(w1, w2, W1T, W2T, nx); cvt_issue(t, lane, lds0 + 8192); asm volatile("s_waitcnt vmcnt(8)" ::: "memory"); } else asm volatile("s_waitcnt vmcnt(0)" ::: "memory");
        { const CvtItem t = cvt_item(w1, w2, W1T, W2T, it); cvt_finish(t, lane, buf0, gl); }
        if (nx < N_END) {
            asm volatile("s_waitcnt lgkmcnt(0)" ::: "memory");
            if (nn < N_END) { const CvtItem t = cvt_item(w1, w2, W1T, W2T, nn); cvt_issue(t, lane, lds0); asm volatile("s_waitcnt vmcnt(8)" ::: "memory"); } else asm volatile("s_waitcnt vmcnt(0)" ::: "memory");
            { const CvtItem t = cvt_item(w1, w2, W1T, W2T, nx); cvt_finish(t, lane, buf0 + 2048, gl); }
            asm volatile("s_waitcnt lgkmcnt(0)" ::: "memory");
        }
    }
    asm volatile("s_waitcnt vmcnt(0)" ::: "memory");
}

__device__ __forceinline__ float log_sigmoid(float v) { return fminf(v, 0.f) - log1pf(expf(-fabsf(v))); }
__device__ __forceinline__ void rms1_row(const float4 (&v)[4], const LAS float* wf  , const float* __restrict__ b_f,
                                         bf16_t* __restrict__ XN, float* __restrict__ FLOG, int row, int lane) {
    float ss = 0.f;
#pragma unroll
    for (int j = 0; j < 4; ++j) ss += v[j].x * v[j].x + v[j].y * v[j].y + v[j].z * v[j].z + v[j].w * v[j].w;
    ss = wave_sum(ss);
    const float rstd = rsqrtf(ss * (1.f / DM) + EPS);
    float fg[8];
#pragma unroll
    for (int g = 0; g < 8; ++g) fg[g] = 0.f;
#pragma unroll
    for (int j = 0; j < 4; ++j) {
        const int c0 = 4 * (lane + 64 * j);
        uint2 o; o.x = pk2(v[j].x * rstd, v[j].y * rstd); o.y = pk2(v[j].z * rstd, v[j].w * rstd);
        *(uint2*)(XN + (size_t)row * DM + c0) = o;
#pragma unroll
        for (int g = 0; g < 8; ++g) { const f32x4 w = *(const LAS f32x4*)(wf + g * DM + c0);
            fg[g] += v[j].x * w[0] + v[j].y * w[1] + v[j].z * w[2] + v[j].w * w[3]; }
    }
    const bool b0 = lane & 1, b1 = lane & 2, b2 = lane & 4;
    float g4[4], h2[2];
#pragma unroll
    for (int i = 0; i < 4; ++i) g4[i] = (b0 ? fg[2 * i + 1] : fg[2 * i]) + __shfl_xor(b0 ? fg[2 * i] : fg[2 * i + 1], 1);
#pragma unroll
    for (int i = 0; i < 2; ++i) h2[i] = (b1 ? g4[2 * i + 1] : g4[2 * i]) + __shfl_xor(b1 ? g4[2 * i] : g4[2 * i + 1], 2);
    float f = (b2 ? h2[1] : h2[0]) + __shfl_xor(b2 ? h2[0] : h2[1], 4);
    f += __shfl_xor(f, 8); f += __shfl_xor(f, 16); f += __shfl_xor(f, 32);
    if (lane < 8) FLOG[(size_t)row * 8 + lane] = log_sigmoid(f * rstd + b_f[lane]);
}
__device__ __forceinline__ void cumsum_wg(const float* __restrict__ FLOG, float* __restrict__ CUM, int bh, LAS float* part) {
    const int b = bh >> 3, h = bh & 7, t = threadIdx.x;
    float loc[8]; float s = 0.f;
#pragma unroll
    for (int i = 0; i < 8; ++i) { loc[i] = FLOG[((size_t)b * SEQ + t * 8 + i) * 8 + h]; s += loc[i]; }
    part[t] = s; __syncthreads();
    float run = 0.f; for (int i = 0; i < t; ++i) run += part[i];
#pragma unroll
    for (int i = 0; i < 8; ++i) { run += loc[i]; CUM[(size_t)bh * SEQ + t * 8 + i] = run * LOG2E; }
    __syncthreads();
}

template <int NT> __device__ __forceinline__ void wave_mma(f32x4 (&acc)[NT], const bf16_t* ap, const bf16_t* const (&bp)[NT], int K) {
    for (int k0 = 0; k0 < K; k0 += 32) {
        const bf16x8 a = *(const bf16x8*)(ap + k0);
#pragma unroll
        for (int t = 0; t < NT; ++t) { const bf16x8 b = *(const bf16x8*)(bp[t] + k0); acc[t] = __builtin_amdgcn_mfma_f32_16x16x32_bf16(a, b, acc[t], 0, 0, 0); }
    }
}
__device__ __forceinline__ void nv_inproj(const bf16_t* __restrict__ XN, const bf16_t* __restrict__ WINT, bf16_t* __restrict__ PROJ, int item, int lane) {
    const int n0 = (item % 48) * 64, m0 = (item / 48) * 16, r = lane & 15, q = lane >> 4;
    f32x4 acc[4];
#pragma unroll
    for (int t = 0; t < 4; ++t) acc[t] = (f32x4){0.f, 0.f, 0.f, 0.f};
    const bf16_t* ap = XN + (size_t)(m0 + r) * DM + 8 * q;
    const bf16_t* bp[4];
#pragma unroll
    for (int t = 0; t < 4; ++t) bp[t] = WINT + (size_t)(n0 + 16 * t + r) * DM + 8 * q;
    wave_mma<4>(acc, ap, bp, DM);
    const float sc = (n0 < 512 || (n0 >= 1536 && n0 < 2048)) ? C2 : 1.f;
#pragma unroll
    for (int t = 0; t < 4; ++t)
#pragma unroll
        for (int j = 0; j < 4; ++j) PROJ[(size_t)(m0 + 4 * q + j) * NPROJ + n0 + 16 * t + r] = f2bf(acc[t][j] * sc);
}

template <int TYPE> __device__ __forceinline__ void nv_attn(const bf16_t* __restrict__ PROJ, const float* __restrict__ CUM, bf16_t* __restrict__ OMIX, float* __restrict__ SSQ,
                                                          int bh, int qblk, int lane, LAS unsigned char* wl) {
    LAS bf16_t* Ks = (LAS bf16_t*)wl; LAS bf16_t* Vs = (LAS bf16_t*)(wl + 8192); LAS float* Cs = (LAS float*)(wl + 16384);
    const int b = bh >> 3, h = bh & 7, t = qblk * 64 + lane;
    const size_t row = (size_t)b * SEQ + t;
    const int qcol = (TYPE == 0 ? 0 : 1536) + h * HD, kcol = qcol + 512, vcol = qcol + 1024;
    float q[64], o[64];
#pragma unroll
    for (int c = 0; c < 8; ++c) { const bf16x8 v = *(const bf16x8*)(PROJ + row * NPROJ + qcol + 8 * c);
#pragma unroll
        for (int j = 0; j < 8; ++j) q[8 * c + j] = bf2f((unsigned short)v[j]); }
#pragma unroll
    for (int d = 0; d < 64; ++d) o[d] = 0.f;
    float m = -INFINITY, l = 0.f, R = 1.f;
    const float cq = CUM[(size_t)bh * SEQ + t];
    for (int it = 0; it <= qblk; ++it) {
        const int kt = (TYPE == 0) ? it : qblk - it;
        LDS_WAIT();
        for (int i = 0; i < 64; ++i) { const size_t kr = ((size_t)b * SEQ + kt * 64 + i) * NPROJ; Ks[i * 64 + lane] = PROJ[kr + kcol + lane]; Vs[i * 64 + lane] = PROJ[kr + vcol + lane]; }
        Cs[lane] = CUM[(size_t)bh * SEQ + kt * 64 + lane];
        LDS_WAIT();
        for (int ss = 0; ss < 64; ++ss) {
            const int s = (TYPE == 0) ? ss : 63 - ss; const int ks = kt * 64 + s;
            float dot = 0.f;
#pragma unroll
            for (int d = 0; d < 64; d += 8) { const bf16x8 kv = *(const LAS bf16x8*)&Ks[s * 64 + d];
#pragma unroll
                for (int j = 0; j < 8; ++j) dot += q[d + j] * bf2f((unsigned short)kv[j]); }
            if (TYPE == 0) {
                if (ks <= t) {
                    const float xv = dot + cq - Cs[s]; const float mn = fmaxf(m, xv); const float sc = exp2f(m - mn), p = exp2f(xv - mn);
                    l = l * sc + p; m = mn;
#pragma unroll
                    for (int d = 0; d < 64; d += 8) { const bf16x8 vv = *(const LAS bf16x8*)&Vs[s * 64 + d];
#pragma unroll
                        for (int j = 0; j < 8; ++j) o[d + j] = o[d + j] * sc + p * bf2f((unsigned short)vv[j]); }
                }
            } else {
                if (ks < t) {
                    const float z = fminf(fmaxf(dot, -80.f), 80.f); const float e = exp2f(z); const float rr = 1.f / (1.f + e); const float a = e * rr * R; R *= rr;
#pragma unroll
                    for (int d = 0; d < 64; d += 8) { const bf16x8 vv = *(const LAS bf16x8*)&Vs[s * 64 + d];
#pragma unroll
                        for (int j = 0; j < 8; ++j) o[d + j] += a * bf2f((unsigned short)vv[j]); }
                }
            }
        }
    }
    const float inv = (TYPE == 0) ? 1.f / l : 1.f;
    float ssq = 0.f;
#pragma unroll
    for (int d = 0; d < 64; ++d) { o[d] *= inv; ssq += o[d] * o[d]; }
    SSQ[row * 16 + TYPE * 8 + h] = ssq;
#pragma unroll
    for (int c = 0; c < 8; ++c) { bf16x8 v;
#pragma unroll
        for (int j = 0; j < 8; ++j) v[j] = (short)f2bf(o[8 * c + j]);
        *(bf16x8*)(OMIX + row * DM + TYPE * GW + h * HD + 8 * c) = v; }
}

__device__ __forceinline__ void nv_wout(const bf16_t* __restrict__ OMIX, const bf16_t* __restrict__ WOUTT, const float* __restrict__ SSQ, const float* __restrict__ x,
                                        float* __restrict__ X1, bf16_t* __restrict__ X1B, int item, int lane) {
    const int n0 = (item & 15) * 64, m0 = (item >> 4) * 16, r = lane & 15, q = lane >> 4;
    f32x4 af[4], as[4];
#pragma unroll
    for (int t = 0; t < 4; ++t) { af[t] = (f32x4){0.f, 0.f, 0.f, 0.f}; as[t] = (f32x4){0.f, 0.f, 0.f, 0.f}; }
    const bf16_t* ap = OMIX + (size_t)(m0 + r) * DM + 8 * q;
    const bf16_t* bp[4]; const bf16_t* bp2[4];
#pragma unroll
    for (int t = 0; t < 4; ++t) { bp[t] = WOUTT + (size_t)(n0 + 16 * t + r) * DM + 8 * q; bp2[t] = bp[t] + GW; }
    wave_mma<4>(af, ap, bp, GW);
    wave_mma<4>(as, ap + GW, bp2, GW);
#pragma unroll
    for (int j = 0; j < 4; ++j) {
        const size_t row = m0 + 4 * q + j; const float* sp = SSQ + row * 16;
        float sf = 0.f, s2 = 0.f;
#pragma unroll
        for (int h = 0; h < 8; ++h) { sf += sp[h]; s2 += sp[8 + h]; }
        const float rf = rsqrtf(sf * (1.f / GW) + EPS), rs = rsqrtf(s2 * (1.f / GW) + EPS);
#pragma unroll
        for (int t = 0; t < 4; ++t) { const size_t idx = row * DM + n0 + 16 * t + r; const float v = x[idx] + rf * af[t][j] + rs * as[t][j]; X1[idx] = v; X1B[idx] = f2bf(v); }
    }
}

__device__ __forceinline__ void nv_router(const float* __restrict__ X1, const float* __restrict__ WR, const float* __restrict__ b_router, float* __restrict__ RSTD2,
                                          float* __restrict__ RW, int* __restrict__ LIST, int* __restrict__ SLOTEP, unsigned* __restrict__ CNT, int item, int lane) {
    const int e = lane & 31, tok = item * 2 + (lane >> 5);
    const float* xr = X1 + (size_t)tok * DM;
    float acc = 0.f, ss = 0.f;
    for (int k = 0; k < DM; ++k) { const float xv = xr[k]; acc += xv * WR[k * NE + e]; ss += xv * xv; }
    const float rstd = rsqrtf(ss * (1.f / DM) + EPS);
    float logit = acc * rstd + b_router[e];
    if (e == 0) RSTD2[tok] = rstd;
    float tv[4]; int ti[4];
#pragma unroll
    for (int k = 0; k < 4; ++k) {
        float bv = logit; int bi = e;
#pragma unroll
        for (int o = 1; o < 32; o <<= 1) { const float ov = __shfl_xor(bv, o); const int oi = __shfl_xor(bi, o); if (ov > bv || (ov == bv && oi < bi)) { bv = ov; bi = oi; } }
        tv[k] = bv; ti[k] = bi; if (e == bi) logit = -INFINITY;
    }
    const float e0 = 1.f, e1 = expf(tv[1] - tv[0]), e2 = expf(tv[2] - tv[0]), e3 = expf(tv[3] - tv[0]); const float inv = 1.f / (e0 + e1 + e2 + e3);
    const float w0 = e0 * inv, w1 = e1 * inv, w2 = e2 * inv, w3 = e3 * inv;
    int myk = -1; float myw = 0.f;
    if (e == ti[0]) { myk = 0; myw = w0; } if (e == ti[1]) { myk = 1; myw = w1; } if (e == ti[2]) { myk = 2; myw = w2; } if (e == ti[3]) { myk = 3; myw = w3; }
    if (myk >= 0) { const int slot = tok * 4 + myk; const unsigned pos = atomicAdd(&CNT[e], 1u); LIST[(size_t)e * LIST_CAP + pos] = slot; RW[slot] = myw; SLOTEP[slot] = e * 16384 + (int)pos; }
}


typedef float f32x16 __attribute__((ext_vector_type(16)));
__device__ __forceinline__ void router_wg(const float* __restrict__ X1, const float* __restrict__ WR, const float* __restrict__ b_router, float* __restrict__ RSTD2,
                                          float* __restrict__ RW, int* __restrict__ LIST, int* __restrict__ SLOTEP, unsigned* __restrict__ CNT, int tokbase, LAS unsigned char* L) {
    int tid_ = threadIdx.x; asm volatile("" : "+v"(tid_));
    const int tid = tid_, lane = tid & 63, wave = __builtin_amdgcn_readfirstlane(tid >> 6), kq = wave & 3, tile = wave >> 2, r32 = lane & 31, hi = lane >> 5;
    LAS float* Dx = (LAS float*)L; LAS float* SSx = (LAS float*)(L + 32768); LAS unsigned* lcnt = (LAS unsigned*)(L + 33792); LAS unsigned* lbase = (LAS unsigned*)(L + 33920);
    if (tid < NE) lcnt[tid] = 0u;
    const int tok = tokbase + tile * 32 + r32;
    const float* xp = X1 + (size_t)tok * DM + kq * 256 + 4 * hi;
    const float* wp = WR + (size_t)(kq * 256 + 4 * hi) * NE + r32;
    f32x16 acc;
#pragma unroll
    for (int r = 0; r < 16; ++r) acc[r] = 0.f;
    float ss = 0.f;
#pragma unroll 1
    for (int mc = 0; mc < 4; ++mc) {
        float4 xv[8];
#pragma unroll
        for (int m = 0; m < 8; ++m) {
            if (X1_BF16) { const uint2 q = *(const uint2*)((const bf16_t*)X1 + (size_t)tok * DM + kq * 256 + 4 * hi + (mc * 8 + m) * 8);
                xv[m].x = __uint_as_float(q.x << 16); xv[m].y = __uint_as_float(q.x & 0xffff0000u); xv[m].z = __uint_as_float(q.y << 16); xv[m].w = __uint_as_float(q.y & 0xffff0000u); }
            else xv[m] = *(const float4*)(xp + (mc * 8 + m) * 8); }
#pragma unroll
        for (int m = 0; m < 8; ++m) {
            const float* w4 = wp + (size_t)((mc * 8 + m) * 8) * NE;
            const float w0 = w4[0], w1 = w4[NE], w2 = w4[2 * NE], w3 = w4[3 * NE];
            acc = __builtin_amdgcn_mfma_f32_32x32x2f32(w0, xv[m].x, acc, 0, 0, 0);
            acc = __builtin_amdgcn_mfma_f32_32x32x2f32(w1, xv[m].y, acc, 0, 0, 0);
            acc = __builtin_amdgcn_mfma_f32_32x32x2f32(w2, xv[m].z, acc, 0, 0, 0);
            acc = __builtin_amdgcn_mfma_f32_32x32x2f32(w3, xv[m].w, acc, 0, 0, 0);
            ss += xv[m].x * xv[m].x + xv[m].y * xv[m].y + xv[m].z * xv[m].z + xv[m].w * xv[m].w;
        }
    }
    { auto rr = __builtin_amdgcn_permlane32_swap(__float_as_uint(ss), __float_as_uint(ss), false, false); ss = __uint_as_float(rr[0]) + __uint_as_float(rr[1]); }
#pragma unroll
    for (int r = 0; r < 16; ++r) Dx[(wave * 16 + r) * 64 + lane] = acc[r];
    if (hi == 0) SSx[wave * 32 + r32] = ss;
    LDS_WAIT(); __syncthreads();
    int ea = 0, eb = 0; float wa = 0.f, wb = 0.f; unsigned la = 0u, lb = 0u;
    if (kq == 0) {
        float v[16]; float sst = 0.f;
#pragma unroll
        for (int w = 0; w < 4; ++w) sst += SSx[(tile * 4 + w) * 32 + r32];
        const float rstd = rsqrtf(sst * (1.f / DM) + EPS);
#pragma unroll
        for (int r = 0; r < 16; ++r) { float a = 0.f;
#pragma unroll
            for (int w = 0; w < 4; ++w) a += Dx[((tile * 4 + w) * 16 + r) * 64 + lane];
            v[r] = a * rstd + b_router[(r & 3) + 8 * (r >> 2) + 4 * hi]; }
        if (hi == 0) RSTD2[tok] = rstd;
        float tv[4]; int te[4];
#pragma unroll
        for (int k = 0; k < 4; ++k) {
            float bv = v[0]; int br = 0;
#pragma unroll
            for (int r = 1; r < 16; ++r) if (v[r] > bv) { bv = v[r]; br = r; }
            const int be = (br & 3) + 8 * (br >> 2) + 4 * hi;
            auto r1 = __builtin_amdgcn_permlane32_swap(__float_as_uint(bv), __float_as_uint(bv), false, false);
            auto r2 = __builtin_amdgcn_permlane32_swap((unsigned)be, (unsigned)be, false, false);
            const float pv = __uint_as_float(hi ? r1[0] : r1[1]); const int pe = (int)(hi ? r2[0] : r2[1]);
            const bool mine = (bv > pv) || (bv == pv && be < pe);
            tv[k] = mine ? bv : pv; te[k] = mine ? be : pe;
#pragma unroll
            for (int r = 0; r < 16; ++r) v[r] = (mine && r == br) ? -INFINITY : v[r];
        }
        const float e1 = expf(tv[1] - tv[0]), e2 = expf(tv[2] - tv[0]), e3 = expf(tv[3] - tv[0]); const float inv = 1.f / (1.f + e1 + e2 + e3);
        ea = hi ? te[2] : te[0]; eb = hi ? te[3] : te[1]; wa = (hi ? e2 : 1.f) * inv; wb = (hi ? e3 : e1) * inv;
        la = atomicAdd((unsigned*)&lcnt[ea], 1u); lb = atomicAdd((unsigned*)&lcnt[eb], 1u);
    }
    LDS_WAIT(); __syncthreads();
    if (tid < NE) { const unsigned c = lcnt[tid]; lbase[tid] = c ? atomicAdd(&CNT[tid], c) : 0u; }
    LDS_WAIT(); __syncthreads();
    if (kq == 0) {
        const int sa = tok * 4 + 2 * hi, sb = sa + 1;
        const int pa = (int)(lbase[ea] + la), pb = (int)(lbase[eb] + lb);
        LIST[(size_t)ea * LIST_CAP + pa] = sa; RW[sa] = wa; SLOTEP[sa] = ea * 16384 + pa;
        LIST[(size_t)eb * LIST_CAP + pb] = sb; RW[sb] = wb; SLOTEP[sb] = eb * 16384 + pb;
    }
    LDS_WAIT(); __syncthreads();
}

__device__ __forceinline__ bool moe_tile(const unsigned* CNT, int g, int& e, int& base, int& p0, int& cnt) {
    const int tile256 = g >> 4; base = 0;
    for (e = 0; e < NE; ++e) { const int nt = ((int)CNT[e] + 255) >> 8; if (tile256 < base + nt) break; base += nt; }
    if (e == NE) return false;
    cnt = (int)CNT[e]; p0 = (g - base * 16) * 16; return p0 < cnt;
}
__device__ __forceinline__ void nv_moe1(const bf16_t* __restrict__ X1B, const bf16_t* __restrict__ W1T, const float* __restrict__ b1, const float* __restrict__ RSTD2,
                                        const int* __restrict__ LIST, bf16_t* __restrict__ H, int e, int base, int p0, int cnt, int cg, int lane) {
    const int r = lane & 15, q = lane >> 4, c0 = cg * 32, pn = c0 >> 7, j0 = c0 & 127;
    const int* lst = LIST + (size_t)e * LIST_CAP;
    const int prow = p0 + r; const int tok = lst[prow < cnt ? prow : cnt - 1] >> 2;
    f32x4 acc[4];
#pragma unroll
    for (int t = 0; t < 4; ++t) acc[t] = (f32x4){0.f, 0.f, 0.f, 0.f};
    const bf16_t* ap = X1B + (size_t)tok * DM + 8 * q;
    const bf16_t* wb = W1T + (size_t)e * 2048 * DM + (size_t)(256 * pn + j0 + r) * DM + 8 * q;
    const bf16_t* bp[4] = {wb, wb + 16 * DM, wb + 128 * DM, wb + 144 * DM};
    wave_mma<4>(acc, ap, bp, DM);
#pragma unroll
    for (int j = 0; j < 4; ++j) {
        const int pr = p0 + 4 * q + j; if (pr >= cnt) continue;
        const float rs = RSTD2[lst[pr] >> 2];
#pragma unroll
        for (int t = 0; t < 2; ++t) {
            const int col = c0 + 16 * t + r;
            float glu = acc[t][j] * rs + b1[(size_t)e * 2048 + col], lin = acc[t + 2][j] * rs + b1[(size_t)e * 2048 + 1024 + col];
            glu = fminf(glu, 7.f); lin = fminf(fmaxf(lin, -7.f), 7.f);
            const float act = glu * (1.f / (1.f + expf(-1.702f * glu))) * (lin + 1.f);
            H[((size_t)base * 256 + pr) * DM + col] = f2bf(act);
        }
    }
}
__device__ __forceinline__ void nv_moe2(const bf16_t* __restrict__ H, const bf16_t* __restrict__ W2T, const float* __restrict__ b2, const float* __restrict__ RW,
                                        const int* __restrict__ LIST, bf16_t* __restrict__ Y, int e, int base, int p0, int cnt, int cg, int lane) {
    const int r = lane & 15, q = lane >> 4, n0 = cg * 64;
    const int* lst = LIST + (size_t)e * LIST_CAP;
    f32x4 acc[4];
#pragma unroll
    for (int t = 0; t < 4; ++t) acc[t] = (f32x4){0.f, 0.f, 0.f, 0.f};
    const bf16_t* ap = H + ((size_t)base * 256 + p0 + r) * DM + 8 * q;
    const bf16_t* bp[4];
#pragma unroll
    for (int t = 0; t < 4; ++t) bp[t] = W2T + (size_t)e * DM * DM + (size_t)(n0 + 16 * t + r) * DM + 8 * q;
    wave_mma<4>(acc, ap, bp, DM);
#pragma unroll
    for (int j = 0; j < 4; ++j) {
        const int pr = p0 + 4 * q + j; if (pr >= cnt) continue;
        const int slot = lst[pr]; const float w = RW[slot];
#pragma unroll
        for (int t = 0; t < 4; ++t) { const int col = n0 + 16 * t + r; Y[((size_t)base * 256 + pr) * DM + col] = f2bf((acc[t][j] + b2[(size_t)e * DM + col]) * w); }
    }
}

__device__ __forceinline__ void final_row(const float* X1, const bf16_t* __restrict__ Y, const int* __restrict__ SLOTEP, const int* __restrict__ TBG, const float* __restrict__ gf, float* out, int row, int lane) {
    int yr[4];
#pragma unroll
    for (int k = 0; k < 4; ++k) { const int ep = SLOTEP[row * 4 + k]; yr[k] = TBG[ep >> 14] * 256 + (ep & 16383); }
    float ss = 0.f;
    if (Y_F8) {
        const int c0 = 16 * lane; f32x4 v[4];
        if (X1_BF16) { const v4u q0 = *(const v4u*)((const bf16_t*)X1 + (size_t)row * DM + c0), q1 = *(const v4u*)((const bf16_t*)X1 + (size_t)row * DM + c0 + 8);
#pragma unroll
            for (int j = 0; j < 2; ++j) { v[j][0] = __uint_as_float(q0[2 * j] << 16); v[j][1] = __uint_as_float(q0[2 * j] & 0xffff0000u); v[j][2] = __uint_as_float(q0[2 * j + 1] << 16); v[j][3] = __uint_as_float(q0[2 * j + 1] & 0xffff0000u);
                v[2 + j][0] = __uint_as_float(q1[2 * j] << 16); v[2 + j][1] = __uint_as_float(q1[2 * j] & 0xffff0000u); v[2 + j][2] = __uint_as_float(q1[2 * j + 1] << 16); v[2 + j][3] = __uint_as_float(q1[2 * j + 1] & 0xffff0000u); } }
        else
#pragma unroll
        for (int j = 0; j < 4; ++j) v[j] = *(const f32x4*)(X1 + (size_t)row * DM + c0 + 4 * j);
#pragma unroll
        for (int k = 0; k < 4; ++k) { const v4u y = *(const v4u*)((const unsigned char*)Y + (size_t)yr[k] * DM + c0);
#pragma unroll
            for (int j = 0; j < 4; ++j) { const auto lo = __builtin_amdgcn_cvt_pk_f32_fp8((int)y[j], false), hi = __builtin_amdgcn_cvt_pk_f32_fp8((int)y[j], true);
                v[j][0] += lo[0] * 0.0625f; v[j][1] += lo[1] * 0.0625f; v[j][2] += hi[0] * 0.0625f; v[j][3] += hi[1] * 0.0625f; } }
#pragma unroll
        for (int j = 0; j < 4; ++j) ss += v[j][0] * v[j][0] + v[j][1] * v[j][1] + v[j][2] * v[j][2] + v[j][3] * v[j][3];
        ss = wave_sum(ss);
        const float rstd = rsqrtf(ss * (1.f / DM) + EPS);
#pragma unroll
        for (int j = 0; j < 4; ++j) { const f32x4 g = *(const f32x4*)(gf + c0 + 4 * j); *(f32x4*)(out + (size_t)row * DM + c0 + 4 * j) = v[j] * rstd * g; }
        return;
    }
    float4 v[4];
#pragma unroll
    for (int j = 0; j < 4; ++j) {
        const int c0 = 4 * (lane + 64 * j);
        v[j] = *(const float4*)(X1 + (size_t)row * DM + c0);
#pragma unroll
        for (int k = 0; k < 4; ++k) { const uint2 y = *(const uint2*)(Y + (size_t)yr[k] * DM + c0);
            v[j].x += bf2f((unsigned short)(y.x & 0xffff)); v[j].y += bf2f((unsigned short)(y.x >> 16)); v[j].z += bf2f((unsigned short)(y.y & 0xffff)); v[j].w += bf2f((unsigned short)(y.y >> 16)); }
        ss += v[j].x * v[j].x + v[j].y * v[j].y + v[j].z * v[j].z + v[j].w * v[j].w;
    }
    ss = wave_sum(ss);
    const float rstd = rsqrtf(ss * (1.f / DM) + EPS);
#pragma unroll
    for (int j = 0; j < 4; ++j) { const int c0 = 4 * (lane + 64 * j); const float4 g = *(const float4*)(gf + c0);
        float4 o; o.x = v[j].x * rstd * g.x; o.y = v[j].y * rstd * g.y; o.z = v[j].z * rstd * g.z; o.w = v[j].w * rstd * g.w; *(float4*)(out + (size_t)row * DM + c0) = o; }
}


namespace pg8 {
#define PG8_LAS __attribute__((address_space(3)))
typedef unsigned u32x4 __attribute__((ext_vector_type(4)));
typedef unsigned u32x2 __attribute__((ext_vector_type(2)));
typedef int i32x8 __attribute__((ext_vector_type(8)));
constexpr int BM = 256, BK = 64, HALF = 128, HTB = HALF * BK * 2  , STAGE_BYTES = 8 * HTB, NXCD = 8, WGM = 8;
__host__ __device__ __forceinline__ int lds_byte(int r, int c) { const int st = (r >> 4) * 2 + (c >> 5), rr = r & 15, cc = c & 31, ob = rr * 64 + cc * 2; return st * 1024 + (ob ^ (((ob >> 9) & 1) << 5)); }
__host__ __device__ __forceinline__ void stage_rc(int b, int& R, int& C) { const int st = b / 1024, sb = b % 1024, swz = sb ^ (((sb >> 9) & 1) << 5); R = (st >> 1) * 16 + swz / 64; C = (st & 1) * 32 + (swz % 64) / 2; }
__host__ __device__ __forceinline__ int perm32(int rho) { const int n = rho >> 4, i = rho & 15; return 8 * (i >> 2) + 4 * n + (i & 3); }
struct Unit { int pm, pn, nr; };
struct Gemm { const bf16_t* A; const bf16_t* Bt; int K; };
__device__ __forceinline__ void st16_wt(void* p, u32x4 v) { if (WT_STORES) asm volatile("global_store_dwordx4 %0, %1, off sc0 sc1\n\ts_nop 1" :: "v"(p), "v"(v) : "memory"); else *(u32x4*)p = v; }
__device__ __forceinline__ void st8_wt(void* p, u32x2 v) { if (WT_STORES) asm volatile("global_store_dwordx2 %0, %1, off sc0 sc1\n\ts_nop 1" :: "v"(p), "v"(v) : "memory"); else *(u32x2*)p = v; }
struct StaticOrder {
    int nM, nN, nwg, G, c;
    __device__ void init(int M_, int N_, int G_, int c_) { nM = M_ / BM; nN = N_ / BM; nwg = nM * nN; G = G_; c = c_; }
    __device__ bool next(int i, Unit& u) const {
        const long L = (long)i * G + c; if (L >= nwg) return false;
        int wgid = (int)L; { const int q = nwg / NXCD, r = nwg % NXCD, xcd = wgid % NXCD, off = wgid / NXCD; wgid = (xcd < r ? xcd * (q + 1) : r * (q + 1) + (xcd - r) * q) + off; }
        const int nig = WGM * nN, gid = wgid / nig, fm = gid * WGM, gsz = (nM - fm) < WGM ? (nM - fm) : WGM;
        u.pm = fm + ((wgid % nig) % gsz); u.pn = (wgid % nig) / gsz; u.nr = BM; return true;
    }
    __device__ __forceinline__ const PG8_LAS int* rowtab(int) const { return nullptr; }
};
__device__ __forceinline__ unsigned cvt_pk_bf16(float lo, float hi) { unsigned r; asm volatile("v_cvt_pk_bf16_f32 %0, %1, %2" : "=v"(r) : "v"(lo), "v"(hi)); return r; }

template <class Sched> __device__ __forceinline__ void gather_voffs(const Sched& S, int ui, int tid, int K, unsigned (&o0)[2], unsigned (&o1)[2]) {
    const PG8_LAS int* tab = S.rowtab(ui);
#pragma unroll
    for (int i = 0; i < 2; ++i) { int R, C; stage_rc(tid * 16 + i * 8192, R, C); o0[i] = (unsigned)((tab[R] & 0xffff) * K + C) * 2u; o1[i] = (unsigned)((tab[HALF + R] & 0xffff) * K + C) * 2u; }
}

template <class Epi, class Sched, bool ALIGN_EPI, bool GATHER, bool F8 = false>
__device__ __forceinline__ void gemm_phase(PG8_LAS unsigned char* lds, const Gemm g, const Sched& S, const Epi& E) {
    int tid_ = threadIdx.x; asm volatile("" : "+v"(tid_));
    const int tid = tid_, wid = __builtin_amdgcn_readfirstlane(tid >> 6), lane = tid & 63, wr = wid >> 2, wc = wid & 3, fr = lane & 15, fq = lane >> 4;
    const int K = g.K, nt = K / BK;
    unsigned vA0[2], vA1[2], wA0[2], wA1[2], voffB[2];
    const size_t kstep = (size_t)(BK * 2);
    const size_t hstep = (size_t)HALF * K * 2;
    const size_t tstep = 2 * hstep;
#pragma unroll
    for (int i = 0; i < 2; ++i) { int R, C; stage_rc(tid * 16 + i * 8192, R, C); const int Rb = Epi::PERM ? ((R & ~31) + perm32(R & 31)) : R;
        vA0[i] = (unsigned)(R * K + C) * 2u; vA1[i] = vA0[i] + (unsigned)hstep; voffB[i] = (unsigned)(Rb * K + C) * 2u; wA0[i] = vA0[i]; wA1[i] = vA1[i]; }
    const unsigned ldsw = (unsigned)wid * 1024u;
    const int aoff = lds_byte(wr * 64 + fr, fq * 8), boff = lds_byte(wc * 32 + fr, fq * 8);
    const int a8o0 = lds_byte(wr * 64 + fr, fq * 16), a8o1 = lds_byte(wr * 64 + fr, fq * 16 + 8), b8o0 = lds_byte(wc * 32 + fr, fq * 16), b8o1 = lds_byte(wc * 32 + fr, fq * 16 + 8);
#define PG8_SA(b, h) (((b) * 2 + (h)) * HTB)
#define PG8_SB(b, h) ((4 + (b) * 2 + (h)) * HTB)
#define PG8_STAGE(bufoff, gbase, voff) do { _Pragma("unroll") for (int _i = 0; _i < 2; ++_i) \
        __builtin_amdgcn_global_load_lds((const unsigned*)((const char*)(gbase) + (voff)[_i]), (PG8_LAS unsigned*)(lds + (bufoff) + ldsw + _i * 8192), 16, 0, 0); } while (0)
#define PG8_LDA_BF(dst, b, h) do { _Pragma("unroll") for (int m = 0; m < 4; ++m) _Pragma("unroll") for (int k = 0; k < 2; ++k) dst[m][k] = *(const PG8_LAS bf16x8*)(lds + PG8_SA(b, h) + aoff + m * 2048 + k * 1024); } while (0)
#define PG8_LDB_BF(dst, b, h) do { _Pragma("unroll") for (int n = 0; n < 2; ++n) _Pragma("unroll") for (int k = 0; k < 2; ++k) dst[n][k] = *(const PG8_LAS bf16x8*)(lds + PG8_SB(b, h) + boff + n * 2048 + k * 1024); } while (0)
#define PG8_MMA_BF(ai, bj, At, Bt) do { if (cur.nr > 128 * (ai) + 64 * wr) { __builtin_amdgcn_s_setprio(1); _Pragma("unroll") for (int m = 0; m < 4; ++m) _Pragma("unroll") for (int n = 0; n < 2; ++n) _Pragma("unroll") for (int k = 0; k < 2; ++k) \
        acc[ai][bj][m][n] = __builtin_amdgcn_mfma_f32_16x16x32_bf16(Bt[n][k], At[m][k], acc[ai][bj][m][n], 0, 0, 0); __builtin_amdgcn_s_setprio(0); } } while (0)
#define PG8_LD8(dst, i_, base_, o0_, o1_) do { const u32x4 lo_ = *(const PG8_LAS u32x4*)(lds + (base_) + (o0_) + (i_) * 2048), hi_ = *(const PG8_LAS u32x4*)(lds + (base_) + (o1_) + (i_) * 2048); \
        dst[i_] = (i32x8){(int)lo_.x, (int)lo_.y, (int)lo_.z, (int)lo_.w, (int)hi_.x, (int)hi_.y, (int)hi_.z, (int)hi_.w}; } while (0)
#define PG8_LDA_F8(dst, b, h) do { _Pragma("unroll") for (int m = 0; m < 4; ++m) PG8_LD8(dst, m, PG8_SA(b, h), a8o0, a8o1); } while (0)
#define PG8_LDB_F8(dst, b, h) do { _Pragma("unroll") for (int n = 0; n < 2; ++n) PG8_LD8(dst, n, PG8_SB(b, h), b8o0, b8o1); } while (0)
#define PG8_MMA_F8(ai, bj, At, Bt) do { if (cur.nr > 128 * (ai) + 64 * wr) { __builtin_amdgcn_s_setprio(1); _Pragma("unroll") for (int m = 0; m < 4; ++m) _Pragma("unroll") for (int n = 0; n < 2; ++n) \
        acc[ai][bj][m][n] = __builtin_amdgcn_mfma_scale_f32_16x16x128_f8f6f4(Bt[n], At[m], acc[ai][bj][m][n], 0, 0, 0, 0x7A7A7A7A  , 0, 0x7F7F7F7F  ); __builtin_amdgcn_s_setprio(0); } } while (0)
#define PG8_LDA(dst, b, h) do { if constexpr (F8) { PG8_LDA_F8(dst##8, b, h); } else { PG8_LDA_BF(dst, b, h); } } while (0)
#define PG8_LDB(dst, b, h) do { if constexpr (F8) { PG8_LDB_F8(dst##8, b, h); } else { PG8_LDB_BF(dst, b, h); } } while (0)
#define PG8_MMA(ai, bj, At, Bt) do { if constexpr (F8) { PG8_MMA_F8(ai, bj, At##8, Bt##8); } else { PG8_MMA_BF(ai, bj, At, Bt); } } while (0)
#define PG8_WAIT_V(n) asm volatile("s_waitcnt vmcnt(" #n ")" ::: "memory")
#define PG8_WAIT_L(n) asm volatile("s_waitcnt lgkmcnt(" #n ")" ::: "memory")
#define PG8_BAR __builtin_amdgcn_s_barrier()
#define PG8_SCHED __builtin_amdgcn_sched_barrier(0)
    Unit cur, nxt; int ui = 0;
    if (!S.next(0, cur)) return;
    f32x4 acc[2][2][4][2];
#pragma unroll
    for (int a = 0; a < 2; ++a)
#pragma unroll
        for (int b = 0; b < 2; ++b)
#pragma unroll
            for (int m = 0; m < 4; ++m)
#pragma unroll
                for (int n = 0; n < 2; ++n) acc[a][b][m][n] = (f32x4){0.f, 0.f, 0.f, 0.f};
    bf16x8 At[4][2], B0[2][2], B1[2][2]; i32x8 At8[4], B08[2], B18[2];
    const char* cA = GATHER ? (const char*)g.A : (const char*)g.A + (size_t)cur.pm * tstep; const char* cB = (const char*)g.Bt + (size_t)cur.pn * tstep;
    if constexpr (GATHER) gather_voffs(S, 0, tid, K, vA0, vA1);
    PG8_STAGE(PG8_SB(0, 0), cB, voffB); PG8_STAGE(PG8_SB(0, 1), cB + hstep, voffB); PG8_STAGE(PG8_SA(0, 0), cA, vA0); PG8_STAGE(PG8_SA(0, 1), cA, vA1);
    if (wr == 1) PG8_BAR;
    PG8_WAIT_V(2); PG8_BAR;
    PG8_STAGE(PG8_SB(1, 0), cB + kstep, voffB); PG8_STAGE(PG8_SA(1, 0), cA + kstep, vA0); PG8_STAGE(PG8_SB(1, 1), cB + hstep + kstep, voffB);
    PG8_WAIT_V(6); PG8_BAR;
    for (;;) {
        const bool has_next = S.next(ui + 1, nxt);
        const char* nA = GATHER ? cA : (has_next ? (const char*)g.A + (size_t)nxt.pm * tstep : cA); const char* nB = has_next ? (const char*)g.Bt + (size_t)nxt.pn * tstep : cB;
        if constexpr (GATHER) { if (has_next) gather_voffs(S, ui + 1, tid, K, wA0, wA1); else { wA0[0] = vA0[0]; wA0[1] = vA0[1]; wA1[0] = vA1[0]; wA1[1] = vA1[1]; } }
        for (int t = 0; t < nt; t += 2) {
            const bool last = (t == nt - 2);
            const char* a1 = cA + (size_t)(t + 1) * kstep;
            const char* a2 = last ? nA : cA + (size_t)(t + 2) * kstep; const char* b2 = last ? nB : cB + (size_t)(t + 2) * kstep;
            const char* a3 = a2 + kstep; const char* b3 = b2 + kstep;
            unsigned sA0[2], sA1[2];
#pragma unroll
            for (int i = 0; i < 2; ++i) { sA0[i] = (GATHER && last) ? wA0[i] : vA0[i]; sA1[i] = (GATHER && last) ? wA1[i] : vA1[i]; }
            if constexpr (Epi::MIDK) { if (t == nt / 2) E.midk(acc, wr, fr); }
            PG8_LDB(B0, 0, 0); PG8_LDB(B1, 0, 1); PG8_SCHED; PG8_LDA(At, 0, 0); PG8_STAGE(PG8_SA(1, 1), a1, vA1);
            PG8_WAIT_V(8); PG8_WAIT_L(0); PG8_BAR; PG8_MMA(0, 0, At, B0); PG8_MMA(0, 1, At, B1); PG8_BAR; PG8_SCHED;
            PG8_LDA(At, 0, 1); PG8_STAGE(PG8_SB(0, 0), b2, voffB); PG8_STAGE(PG8_SB(0, 1), b2 + hstep, voffB); PG8_STAGE(PG8_SA(0, 0), a2, sA0);
            PG8_WAIT_V(8); PG8_WAIT_L(0); PG8_BAR; PG8_MMA(1, 0, At, B0); PG8_MMA(1, 1, At, B1); PG8_BAR; PG8_SCHED;
            PG8_LDB(B0, 1, 0); PG8_LDB(B1, 1, 1); PG8_SCHED; PG8_LDA(At, 1, 0); PG8_STAGE(PG8_SA(0, 1), a2, sA1);
            PG8_WAIT_V(8); PG8_WAIT_L(0); PG8_BAR; PG8_MMA(0, 0, At, B0); PG8_MMA(0, 1, At, B1); PG8_BAR; PG8_SCHED;
            PG8_LDA(At, 1, 1); PG8_STAGE(PG8_SB(1, 0), b3, voffB); PG8_STAGE(PG8_SB(1, 1), b3 + hstep, voffB); PG8_STAGE(PG8_SA(1, 0), a3, sA0);
            PG8_WAIT_V(8); PG8_WAIT_L(0); PG8_BAR; PG8_MMA(1, 0, At, B0); PG8_MMA(1, 1, At, B1); PG8_BAR; PG8_SCHED;
        }
        if constexpr (ALIGN_EPI) { if (wr == 0) PG8_BAR; }
        E(acc, cur, ui, wr, wc, fr, fq);
        if (!has_next) break;
#pragma unroll
        for (int a = 0; a < 2; ++a)
#pragma unroll
            for (int b = 0; b < 2; ++b)
#pragma unroll
                for (int m = 0; m < 4; ++m)
#pragma unroll
                    for (int n = 0; n < 2; ++n) acc[a][b][m][n] = (f32x4){0.f, 0.f, 0.f, 0.f};
        cur = nxt; cA = nA; cB = nB; ++ui;
        if constexpr (GATHER) { vA0[0] = wA0[0]; vA0[1] = wA0[1]; vA1[0] = wA1[0]; vA1[1] = wA1[1]; }
        if constexpr (ALIGN_EPI) { if (wr == 1) PG8_BAR; }
    }
    PG8_WAIT_V(0);
    if constexpr (!ALIGN_EPI) { if (wr == 0) PG8_BAR; }
    PG8_BAR;
#undef PG8_SA
#undef PG8_SB
#undef PG8_STAGE
#undef PG8_LDA
#undef PG8_LDB
#undef PG8_MMA
#undef PG8_LDA_BF
#undef PG8_LDB_BF
#undef PG8_MMA_BF
#undef PG8_LD8
#undef PG8_LDA_F8
#undef PG8_LDB_F8
#undef PG8_MMA_F8
#undef PG8_WAIT_V
#undef PG8_WAIT_L
#undef PG8_BAR
#undef PG8_SCHED
}

struct EpiProj {
    static constexpr bool PERM = true, MIDK = false;
    bf16_t* O; unsigned* hp;
    __device__ __forceinline__ void operator()(const f32x4 (&acc)[2][2][4][2], const Unit& u, int, int wr, int wc, int fr, int fq) const {
        const int row0 = u.pm * BM + wr * 64 + fr, col0 = u.pn * BM + wc * 32 + 8 * fq;
        const float sc = (u.pn < 2 || (u.pn >= 6 && u.pn < 8)) ? C2 : 1.f;
        if (u.pn < 4) {
            float mx = 0.f;
#pragma unroll
            for (int ai = 0; ai < 2; ++ai)
#pragma unroll
                for (int m = 0; m < 4; ++m)
#pragma unroll
                    for (int bj = 0; bj < 2; ++bj) { const f32x4 a0 = acc[ai][bj][m][0] * sc, a1 = acc[ai][bj][m][1] * sc;
                        float q = a0[0] * a0[0] + a0[1] * a0[1] + a0[2] * a0[2] + a0[3] * a0[3] + a1[0] * a1[0] + a1[1] * a1[1] + a1[2] * a1[2] + a1[3] * a1[3];
                        q += __shfl_xor(q, 16); q += __shfl_xor(q, 32); mx = fmaxf(mx, q); }
#pragma unroll
            for (int o = 1; o < 16; o <<= 1) mx = fmaxf(mx, __shfl_xor(mx, o));
            if ((threadIdx.x & 63) == 0) atomicMax(hp + (u.pn < 2 ? 0 : 64), __float_as_uint(mx));
        }
#pragma unroll
        for (int ai = 0; ai < 2; ++ai)
#pragma unroll
            for (int m = 0; m < 4; ++m) { bf16_t* rowp = O + (size_t)(row0 + ai * HALF + m * 16) * NPROJ + col0;
#pragma unroll
                for (int bj = 0; bj < 2; ++bj) { const f32x4 v0 = acc[ai][bj][m][0] * sc, v1 = acc[ai][bj][m][1] * sc;
                    u32x4 w; w.x = cvt_pk_bf16(v0[0], v0[1]); w.y = cvt_pk_bf16(v0[2], v0[3]); w.z = cvt_pk_bf16(v1[0], v1[1]); w.w = cvt_pk_bf16(v1[2], v1[3]);
                    st16_wt(rowp + bj * HALF, w); } }
    }
};
struct EpiWout {
    static constexpr bool PERM = false, MIDK = true;
    const float* x; float* X1; bf16_t* X1B; const PG8_LAS float* ratio; const PG8_LAS float* rs;
    __device__ __forceinline__ void midk(f32x4 (&acc)[2][2][4][2], int wr, int fr) const {
#pragma unroll
        for (int ai = 0; ai < 2; ++ai)
#pragma unroll
            for (int m = 0; m < 4; ++m) { const float f = ratio[ai * HALF + wr * 64 + m * 16 + fr];
#pragma unroll
                for (int bj = 0; bj < 2; ++bj)
#pragma unroll
                    for (int n = 0; n < 2; ++n) acc[ai][bj][m][n] *= f; }
    }
    __device__ __forceinline__ void operator()(const f32x4 (&acc)[2][2][4][2], const Unit& u, int, int wr, int wc, int fr, int fq) const {
        const int col0 = u.pn * BM + wc * 32 + 4 * fq;
#pragma unroll
        for (int ai = 0; ai < 2; ++ai)
#pragma unroll
            for (int m = 0; m < 4; ++m) { const int r = ai * HALF + wr * 64 + m * 16 + fr; const float s = rs[r]; const size_t off = (size_t)(u.pm * BM + r) * DM + col0;
#pragma unroll
                for (int bj = 0; bj < 2; ++bj)
#pragma unroll
                    for (int n = 0; n < 2; ++n) { const f32x4 xv = *(const f32x4*)(x + off + bj * HALF + n * 16); const f32x4 o = xv + acc[ai][bj][m][n] * s;
                        if (X1_BF16) { u32x2 w; w.x = cvt_pk_bf16(o[0], o[1]); w.y = cvt_pk_bf16(o[2], o[3]); *(u32x2*)((bf16_t*)X1 + off + bj * HALF + n * 16) = w; }
                        else *(f32x4*)(X1 + off + bj * HALF + n * 16) = o;
                        if (MOE_F8) *(unsigned*)((unsigned char*)X1B + off + bj * HALF + n * 16) = pk4_fp8(o[0], o[1], o[2], o[3]);
                        else { u32x2 w; w.x = cvt_pk_bf16(o[0], o[1]); w.y = cvt_pk_bf16(o[2], o[3]); *(u32x2*)(X1B + off + bj * HALF + n * 16) = w; } }
                asm volatile("" ::: "memory"); }
    }
};
constexpr int MOE_MAXU = 10;
struct MoeOrder {
    int NT, c; const PG8_LAS int* tb; const PG8_LAS int* tbE; const PG8_LAS int* tbC; const PG8_LAS int* cnt; const PG8_LAS int* tabA;
    int probe = 0;
    __device__ bool next(int i, Unit& u) const {
        if (i >= MOE_MAXU) return false;
        const int x = c & 7, j = c >> 3, UE = tbE[32] * NT, UC = tbC[32] * NT;
        const int qE = UE >> 3, rE = UE & 7, sE = x * qE + (x < rE ? x : rE), nE = qE + (x < rE ? 1 : 0);
        const int qC = UC >> 3, rC = UC & 7, sC = x * qC + (x < rC ? x : rC), nC = qC + (x < rC ? 1 : 0);
        const int nEj = (j < nE) ? ((nE - j + 31) >> 5) : 0;
        if (i < nEj) {
            const int f = sE + i * 32 + j; int e = 0; while (f >= tbE[e + 1] * NT) ++e;
            const int idx = f - tbE[e] * NT, nte = tbE[e + 1] - tbE[e], pg = idx / (4 * nte), rem2 = idx - pg * 4 * nte, mt = rem2 >> 2;
            u.pm = tb[e] + mt; u.pn = e * NT + pg * 4 + (rem2 & 3); const int left = cnt[e] - 256 * mt; u.nr = left < BM ? left : BM;
        } else {
            const int jj = (j - (nE & 31) + 32) & 31, lc = (i - nEj) * 32 + jj; if (lc >= nC) return false;
            const int f = sC + lc; int e = 0; while (f >= tbC[e + 1] * NT) ++e;
            const int mt = tbE[e + 1] - tbE[e]; u.pm = tb[e] + mt; u.pn = e * NT + (f - tbC[e] * NT); u.nr = cnt[e] - 256 * mt;
        }
        if (probe) { u.pm &= 31; u.pn &= 7; if (probe == 2) u.nr = 32; }
        return true;
    }
    __device__ __forceinline__ const PG8_LAS int* rowtab(int ui) const { return tabA + ui * 256; }
};
struct EpiMoe1 {
    static constexpr bool PERM = true, MIDK = false;
    bf16_t* H; const PG8_LAS int* rowtab; const PG8_LAS float* btab;
    __device__ __forceinline__ void operator()(const f32x4 (&acc)[2][2][4][2], const Unit& u, int ui, int wr, int wc, int fr, int fq) const {
        const int pl = u.pn & 7, cl = wc * 32 + 8 * fq, colA = pl * 128 + cl;
        f32x4 bg[2], bl[2];
#pragma unroll
        for (int n = 0; n < 2; ++n) { bg[n] = *(const PG8_LAS f32x4*)(btab + ui * 256 + cl + 4 * n); bl[n] = *(const PG8_LAS f32x4*)(btab + ui * 256 + 128 + cl + 4 * n); }
#pragma unroll
        for (int ai = 0; ai < 2; ++ai)
#pragma unroll
            for (int m = 0; m < 4; ++m) { const int r = ai * HALF + wr * 64 + m * 16 + fr; const float rs = __uint_as_float((unsigned)rowtab[ui * 256 + r] & 0xffff0000u);
                float a8[8];
#pragma unroll
                for (int n = 0; n < 2; ++n) { const f32x4 gv = acc[ai][0][m][n] * rs + bg[n], lv = acc[ai][1][m][n] * rs + bl[n];
#pragma unroll
                    for (int i = 0; i < 4; ++i) { const float gl = fminf(gv[i], 7.f), li = fminf(fmaxf(lv[i], -7.f), 7.f);
                        a8[4 * n + i] = gl * __builtin_amdgcn_rcpf(1.f + __builtin_amdgcn_exp2f(-1.702f * LOG2E * gl)) * (li + 1.f); } }
                if (MOE_F8) { u32x2 w;
                    int w0 = __builtin_amdgcn_cvt_pk_fp8_f32(a8[0], a8[1], 0, false); w0 = __builtin_amdgcn_cvt_pk_fp8_f32(a8[2], a8[3], w0, true);
                    int w1 = __builtin_amdgcn_cvt_pk_fp8_f32(a8[4], a8[5], 0, false); w1 = __builtin_amdgcn_cvt_pk_fp8_f32(a8[6], a8[7], w1, true);
                    w.x = (unsigned)w0; w.y = (unsigned)w1; *(u32x2*)((unsigned char*)H + (size_t)(u.pm * BM + r) * DM + colA) = w; }
                else { u32x4 w; w.x = cvt_pk_bf16(a8[0], a8[1]); w.y = cvt_pk_bf16(a8[2], a8[3]); w.z = cvt_pk_bf16(a8[4], a8[5]); w.w = cvt_pk_bf16(a8[6], a8[7]);
                *(u32x4*)(H + (size_t)(u.pm * BM + r) * DM + colA) = w; } }
    }
};
struct EpiMoe2 {
    static constexpr bool PERM = true, MIDK = false;
    bf16_t* Y; const PG8_LAS float* wtab; const PG8_LAS float* btab;
    __device__ __forceinline__ void operator()(const f32x4 (&acc)[2][2][4][2], const Unit& u, int ui, int wr, int wc, int fr, int fq) const {
        const int pl = u.pn & 3, cl = wc * 32 + 8 * fq, col0 = pl * BM + cl;
        f32x4 bv[2][2];
#pragma unroll
        for (int bj = 0; bj < 2; ++bj)
#pragma unroll
            for (int n = 0; n < 2; ++n) bv[bj][n] = *(const PG8_LAS f32x4*)(btab + ui * 256 + cl + bj * HALF + 4 * n);
#pragma unroll
        for (int ai = 0; ai < 2; ++ai)
#pragma unroll
            for (int m = 0; m < 4; ++m) { const int r = ai * HALF + wr * 64 + m * 16 + fr; const float wt = wtab[ui * 256 + r]; bf16_t* rowp = Y + (size_t)(u.pm * BM + r) * DM + col0;
#pragma unroll
                for (int bj = 0; bj < 2; ++bj) { const f32x4 v0 = (acc[ai][bj][m][0] + bv[bj][0]) * wt, v1 = (acc[ai][bj][m][1] + bv[bj][1]) * wt;
                    if (Y_F8) { u32x2 w; w.x = pk4_fp8(v0[0], v0[1], v0[2], v0[3]); w.y = pk4_fp8(v1[0], v1[1], v1[2], v1[3]); *(u32x2*)((unsigned char*)Y + (size_t)(u.pm * BM + r) * DM + col0 + bj * HALF) = w; }
                    else { u32x4 w; w.x = cvt_pk_bf16(v0[0], v0[1]); w.y = cvt_pk_bf16(v0[2], v0[3]); w.z = cvt_pk_bf16(v1[0], v1[1]); w.w = cvt_pk_bf16(v1[2], v1[3]);
                    *(u32x4*)(rowp + bj * HALF) = w; } } }
    }
};
struct ListOrder {
    const PG8_LAS int* ud; int n; const PG8_LAS int* tabA;
    __device__ __forceinline__ bool next(int i, Unit& u) const { if (i >= n) return false; u.pm = ud[3 * i]; u.pn = ud[3 * i + 1]; u.nr = ud[3 * i + 2]; return true; }
    __device__ __forceinline__ const PG8_LAS int* rowtab(int ui) const { return tabA + ui * 256; }
};
struct EpiNull {
    static constexpr bool PERM = true, MIDK = false; float* O;
    __device__ __forceinline__ void operator()(const f32x4 (&acc)[2][2][4][2], const Unit& u, int ui, int wr, int wc, int fr, int fq) const {
        f32x4 t = (f32x4){0.f, 0.f, 0.f, 0.f};
#pragma unroll
        for (int ai = 0; ai < 2; ++ai)
#pragma unroll
            for (int bj = 0; bj < 2; ++bj)
#pragma unroll
                for (int m = 0; m < 4; ++m)
#pragma unroll
                    for (int n = 0; n < 2; ++n) t += acc[ai][bj][m][n];
        O[(size_t)(u.pm & 31) * 65536 + (u.pn & 7) * 8192 + (wr * 4 + wc) * 64 + fq * 16 + fr + ui] = t[0] + t[1] + t[2] + t[3];
    }
};
}

#include <hip/hip_bf16.h>
#include <cmath>
namespace attn_body {

using bf16=__hip_bfloat16;
using bf16x8=__attribute__((ext_vector_type(8)))short;
using s16x4=__attribute__((ext_vector_type(4)))short;
using f32x16=__attribute__((ext_vector_type(16)))float;
using u32x4=__attribute__((ext_vector_type(4)))unsigned;
constexpr int SEQ=4096,D=64,PIN=3072,POUT=1024;
constexpr int NW=8,QBLK=32,QB=QBLK*NW,KVBLK=64,NQB=SEQ/QB;
__device__ __forceinline__ int crow(int r,int hi){return (r&3)+8*(r>>2)+4*hi;}
#define SBAR() __builtin_amdgcn_sched_barrier(0)
__device__ __forceinline__ void cmask(f32x16&p0,f32x16&p1,int jb,int qrel,int hi){
  const float NEG=-INFINITY; int kb=64*jb+4*hi;
  #pragma unroll
  for(int r=0;r<16;++r){int kv=kb+(r&3)+8*(r>>2); if(kv>qrel)p0[r]=NEG; if(kv+32>qrel)p1[r]=NEG;}
}

constexpr int NSLOT=3, SLOTB=8192;
constexpr int LDS_K=0, LDS_V=NSLOT*SLOTB, LDS_WS=2*NSLOT*SLOTB, LDS_OST=LDS_WS+NW*64*4, LDS_CK=LDS_OST+NW*4096, LDS_BYTES=LDS_CK+SEQ*4;
constexpr float C2=0.125f*1.4426950408889634f;
__device__ __forceinline__ void glds16(const void*gsrc,unsigned lds_dst){unsigned keep;
  asm volatile("s_mov_b32 %0, m0\n\ts_mov_b32 m0, %2\n\ts_nop 0\n\tglobal_load_lds_dwordx4 %1, off\n\ts_mov_b32 m0, %0":"=&s"(keep):"v"(gsrc),"s"(lds_dst):"memory");}
__device__ __forceinline__ float max3f(float a,float b,float c){float r;asm("v_max3_f32 %0, %1, %2, %3":"=v"(r):"v"(a),"v"(b),"v"(c));return r;}
__device__ __forceinline__ float max2f(float a,float b){float r;asm("v_max_f32_e32 %0, %1, %2":"=v"(r):"v"(a),"v"(b));return r;}
__device__ __forceinline__ float fadd_s(float a,float b){float r;asm("v_add_f32_e32 %0, %1, %2":"=v"(r):"v"(a),"v"(b));return r;}
__device__ __forceinline__ float fsub_s(float a,float b){float r;asm("v_sub_f32_e32 %0, %1, %2":"=v"(r):"v"(a),"v"(b));return r;}
typedef float f32x2_t __attribute__((ext_vector_type(2))); typedef float f32x4_t __attribute__((ext_vector_type(4))); typedef __bf16 bf16x2_t __attribute__((ext_vector_type(2)));
__device__ __forceinline__ unsigned cvtpk_s(float lo,float hi){f32x2_t v={lo,hi};bf16x2_t b=__builtin_convertvector(v,bf16x2_t);return __builtin_bit_cast(unsigned,b);}
#define WAIT_BAR(N) asm volatile("s_waitcnt vmcnt(" #N ") lgkmcnt(0)\n\ts_barrier":::"memory")

__device__ __forceinline__ void qkt(f32x16&p0,f32x16&p1,const char*Kslot,const bf16x8*qr,const f32x16&negm,int r32,int hi){
  const char*kb=Kslot+hi*1024+r32*16;
  #pragma unroll
  for(int d0=0;d0<4;++d0){
    const bf16x8 b0=*reinterpret_cast<const bf16x8*>(kb+d0*2048);
    const bf16x8 b1=*reinterpret_cast<const bf16x8*>(kb+d0*2048+512);
    if(d0==0){p0=__builtin_amdgcn_mfma_f32_32x32x16_bf16(b0,qr[0],negm,0,0,0);p1=__builtin_amdgcn_mfma_f32_32x32x16_bf16(b1,qr[0],negm,0,0,0);}
    else{p0=__builtin_amdgcn_mfma_f32_32x32x16_bf16(b0,qr[d0],p0,0,0,0);p1=__builtin_amdgcn_mfma_f32_32x32x16_bf16(b1,qr[d0],p1,0,0,0);}}
}
typedef __attribute__((address_space(3))) const char* lds_cptr;
typedef short v4i16_t __attribute__((ext_vector_type(4)));
__device__ __forceinline__ void kload8(bf16x8*kf,lds_cptr kp){
  kf[0]=*(const __attribute__((address_space(3))) bf16x8*)(kp);      kf[1]=*(const __attribute__((address_space(3))) bf16x8*)(kp+512);
  kf[2]=*(const __attribute__((address_space(3))) bf16x8*)(kp+2048); kf[3]=*(const __attribute__((address_space(3))) bf16x8*)(kp+2560);
  kf[4]=*(const __attribute__((address_space(3))) bf16x8*)(kp+4096); kf[5]=*(const __attribute__((address_space(3))) bf16x8*)(kp+4608);
  kf[6]=*(const __attribute__((address_space(3))) bf16x8*)(kp+6144); kf[7]=*(const __attribute__((address_space(3))) bf16x8*)(kp+6656);
}
__device__ __forceinline__ void kload2(bf16x8*kf,lds_cptr kp,int j){ kf[2*j]=*(const __attribute__((address_space(3))) bf16x8*)(kp+j*2048); kf[2*j+1]=*(const __attribute__((address_space(3))) bf16x8*)(kp+j*2048+512); }
__device__ __forceinline__ s16x4 vtr(lds_cptr p){ return __builtin_bit_cast(s16x4,__builtin_amdgcn_ds_read_tr16_b64_v4i16((__attribute__((address_space(3))) v4i16_t*)p)); }
__device__ __forceinline__ float rowmax(const f32x16&p0,const f32x16&p1){
  float a=max3f(p0[0],p0[1],p1[0]),b=max3f(p0[2],p0[3],p1[1]);a=max3f(a,p1[2],p1[3]);
  #pragma unroll
  for(int r=4;r<16;r+=4){a=max3f(a,p0[r],p0[r+1]);b=max3f(b,p0[r+2],p0[r+3]);a=max3f(a,p1[r],p1[r+1]);b=max3f(b,p1[r+2],p1[r+3]);}
  const float m=max2f(a,b);
  auto rr=__builtin_amdgcn_permlane32_swap(__float_as_uint(m),__float_as_uint(m),false,false);
  return max2f(__uint_as_float(rr[0]),__uint_as_float(rr[1]));
}
__device__ __forceinline__ void pv(f32x16*o,int vb,bf16x8 pa0,bf16x8 pa1,bf16x8 pa2,bf16x8 pa3){
  #pragma unroll
  for(int d0=0;d0<2;++d0){s16x4 lo[4],hi[4];
    #pragma unroll
    for(int ks=0;ks<4;++ks){
      asm volatile("ds_read_b64_tr_b16 %0,%1 offset:%c2":"=&v"(lo[ks]):"v"(vb),"i"(d0*4096+ks*1024):"memory");
      asm volatile("ds_read_b64_tr_b16 %0,%1 offset:%c2":"=&v"(hi[ks]):"v"(vb),"i"(d0*4096+ks*1024+512):"memory");}
    asm volatile("s_waitcnt lgkmcnt(0)":::"memory");SBAR();
    #define PK(k) (bf16x8){lo[k][0],lo[k][1],lo[k][2],lo[k][3],hi[k][0],hi[k][1],hi[k][2],hi[k][3]}
    o[d0]=__builtin_amdgcn_mfma_f32_32x32x16_bf16(pa0,PK(0),o[d0],0,0,0);
    o[d0]=__builtin_amdgcn_mfma_f32_32x32x16_bf16(pa1,PK(1),o[d0],0,0,0);
    o[d0]=__builtin_amdgcn_mfma_f32_32x32x16_bf16(pa2,PK(2),o[d0],0,0,0);
    o[d0]=__builtin_amdgcn_mfma_f32_32x32x16_bf16(pa3,PK(3),o[d0],0,0,0);
    #undef PK
  }
}

#ifndef ATTN_STORE16
#define ATTN_STORE16(p,v) (*(u32x4*)(p)=(v))
#endif
template<int THRL> __device__ __forceinline__ void attn_unit(int b,int h,int qb,const bf16*Q,const bf16*__restrict__ K,const bf16*__restrict__ V,bf16*O,const float*__restrict__ CUMbh,float*__restrict__ SSQh,float skipth,char*shm){
  int tid_=threadIdx.x; asm volatile("":"+v"(tid_));
  const int tid=tid_,lane=tid&63,r32=lane&31,hi=lane>>5; const int wid=__builtin_amdgcn_readfirstlane(tid>>6);
  const long rowbase=(long)b*SEQ; const int q0=qb*QB;
  const bf16*Qw=Q+(rowbase+q0+wid*QBLK)*PIN+h*D;
  int t0;
  { const int NT0=(q0+QB)/KVBLK; const bool sk=(lane<NT0-4)&&(CUMbh[64*lane+63]-CUMbh[q0]>=skipth); t0=__builtin_popcountll(__ballot(sk))&~1; t0=__builtin_amdgcn_readfirstlane(t0); }
  const bf16*Kh=K+(rowbase+(long)t0*KVBLK)*PIN+h*D,*Vh=V+(rowbase+(long)t0*KVBLK)*PIN+h*D;
  const unsigned lds0=(unsigned)(uintptr_t)shm;
  const lds_cptr shm3=(lds_cptr)shm;
  float*wsf=(float*)(shm+LDS_WS)+wid*64;
  const bf16*ksrc=Kh+(long)lane*PIN+wid*8;
  const bf16*vsrc=Vh+(long)(16*(wid&3)+(lane>>2))*PIN+(wid>>2)*32+(lane&3)*8;
  const unsigned kdst=lds0+LDS_K+wid*1024, vdst=lds0+LDS_V+wid*1024;
  #define DMA_K(t,slot) glds16(ksrc+(long)(t)*KVBLK*PIN,(unsigned)__builtin_amdgcn_readfirstlane(kdst+(slot)))
  #define DMA_V(t,slot) glds16(vsrc+(long)(t)*KVBLK*PIN,(unsigned)__builtin_amdgcn_readfirstlane(vdst+(slot)))
  const int vb0=(int)(lds0+LDS_V)+((lane>>4)&1)*32+(lane&3)*8+(4*hi+((lane&15)>>2))*64;
  const char*Kbase=shm+LDS_K; bf16x8 kf[8];
  const lds_cptr kp0=shm3+LDS_K+hi*1024+r32*16; const lds_cptr vp0=shm3+LDS_V+((lane>>4)&1)*32+(lane&3)*8+(4*hi+((lane&15)>>2))*64;
  const int NT=(q0+QB)/KVBLK-t0;
  DMA_K(0,0);DMA_V(0,0);DMA_K(1,SLOTB);
  bf16x8 qr[4];
  #pragma unroll
  for(int d0=0;d0<4;++d0)qr[d0]=*reinterpret_cast<const bf16x8*>(&Qw[(long)r32*PIN+d0*16+hi*8]);
  const float cbase=CUMbh[q0]; const float cq=CUMbh[q0+wid*QBLK+r32]-cbase;
  { __attribute__((address_space(3))) float*ckw=(__attribute__((address_space(3))) float*)(shm3+LDS_CK); int s0_=tid; asm volatile("":"+v"(s0_));
    _Pragma("nounroll") for(int s=s0_;s<q0+QB;s+=NW*64)ckw[s]=CUMbh[s]-cbase; }
  const __attribute__((address_space(3))) float*ckp=(const __attribute__((address_space(3))) float*)(shm3+LDS_CK)+4*hi+t0*KVBLK;
  float mhat=-cq,l_reg=0.f;f32x16 o[2];o[0]=f32x16{};o[1]=f32x16{};f32x16 negm;
  #pragma unroll
  for(int r=0;r<16;++r)negm[r]=cq;
  asm volatile("":"+v"(negm));
  const int qrel=wid*QBLK+r32;
  #define BIAS(P0,P1,t) do{ const __attribute__((address_space(3))) float*cp_=ckp+(t)*KVBLK; \
    _Pragma("unroll") for(int g_=0;g_<4;++g_){ const f32x4_t c0_=*(const __attribute__((address_space(3))) f32x4_t*)(cp_+8*g_), c1_=*(const __attribute__((address_space(3))) f32x4_t*)(cp_+32+8*g_); \
      _Pragma("unroll") for(int j_=0;j_<4;++j_){ P0[4*g_+j_]-=c0_[j_]; P1[4*g_+j_]-=c1_[j_]; } SBAR(); } }while(0)
  #define CMASK(P0,P1,t) do{int jb_=(t)-(NT-4); if(jb_>=0)cmask(P0,P1,jb_,qrel,hi);}while(0)
  bool resc=false;
  #define START(P0,P1) do{ const float rm=rowmax(P0,P1); resc=false; \
    { const float dl=rm; mhat=fadd_s(mhat,dl); \
      _Pragma("unroll") for(int r=0;r<16;++r){P0[r]=fsub_s(P0[r],dl);P1[r]=fsub_s(P1[r],dl);} \
      _Pragma("unroll") for(int r=0;r<16;++r)negm[r]=-mhat; asm volatile("":"+v"(negm)); } \
    _Pragma("unroll") for(int r=0;r<16;++r)P0[r]=__builtin_amdgcn_exp2f(P0[r]); }while(0)
  #define RESC() do{ if(resc){ asm volatile("s_waitcnt lgkmcnt(0)":::"memory"); \
      _Pragma("unroll") for(int d_=0;d_<2;++d_) _Pragma("unroll") for(int r=0;r<16;++r)o[d_][r]*=wsf[crow(r,hi)]; } }while(0)
  f32x16 pA0,pA1,pB0,pB1;
  int sl_prev=0,sl_cur=0,sl_next=SLOTB;
  #define ROT() do{sl_prev=sl_cur;sl_cur=sl_next;sl_next=(sl_next==(NSLOT-1)*SLOTB)?0:sl_next+SLOTB;}while(0)
  DMA_K(2,2*SLOTB);
  WAIT_BAR(3);
  qkt(pA0,pA1,Kbase,qr,negm,r32,hi);asm volatile("s_nop 15\n\ts_nop 7":"+v"(pA0),"+v"(pA1));BIAS(pA0,pA1,0);CMASK(pA0,pA1,0);
  START(pA0,pA1);
  _Pragma("unroll") for(int r=0;r<16;++r)pA1[r]=__builtin_amdgcn_exp2f(pA1[r]);
  WAIT_BAR(0);
  DMA_K(3,0);DMA_V(1,SLOTB);
  ROT();
  kload8(kf,kp0+sl_cur);
  WAIT_BAR(2);
  s16x4 vlo[8],vhi[8]; u32x4 pw0,pw1,pw2,pw3;
  #define PKW(P,B) cvtpk_s(P[B],P[B+1])
  #define PAF(k) __builtin_bit_cast(bf16x8,pw##k)
  #define VFR(i) (bf16x8){vlo[i][0],vlo[i][1],vlo[i][2],vlo[i][3],vhi[i][0],vhi[i][1],vhi[i][2],vhi[i][3]}
  #define PIN(x) asm volatile("":"+v"(x))
  #define MX3(a,b,c) __builtin_fmaxf(__builtin_fmaxf((a),(b)),(c))
  #define GAPA(MF,A0,A1,A2,A3,W0,W1,PW) do{ MF; sacc+=A0; sacc+=A1; sacc+=A2; sacc+=A3; PIN(sacc); W0; W1; PIN(PW); SBAR(); }while(0)
  #define EX(v) __builtin_amdgcn_exp2f(v)
  #define GAPB(MF,X,B) do{ MF; X[B]=EX(X[B]); X[B+1]=EX(X[B+1]); X[B+2]=EX(X[B+2]); X[B+3]=EX(X[B+3]); PIN(X); SBAR(); }while(0)
  #define VRD(i) do{ vlo[i]=vtr(vp_+(((i)>>2)*4096+((i)&3)*1024)); vhi[i]=vtr(vp_+(((i)>>2)*4096+((i)&3)*1024+512)); }while(0)
  #define KRD(G,j) do{ if(G){ kload2(kf,kp0+sl_next,j); SBAR(); } }while(0)
  #define STEP(C0,C1,P0,P1,t,GK,GV,GL) do{ SBAR(); \
    const lds_cptr vp_=vp0+sl_prev; \
    VRD(0); SBAR(); float sacc=(P0[0]+P0[1]); \
    GAPA(C0=__builtin_amdgcn_mfma_f32_32x32x16_bf16(kf[0],qr[0],negm,0,0,0), P0[2],P0[3],P0[4],P0[5],     pw0[0]=PKW(P0,0), pw0[1]=PKW(P0,2), pw0); \
    VRD(4); SBAR(); GAPA(C1=__builtin_amdgcn_mfma_f32_32x32x16_bf16(kf[1],qr[0],negm,0,0,0), P0[6],P0[7],P0[8],P0[9],     pw0[2]=PKW(P0,4), pw0[3]=PKW(P0,6), pw0); \
    VRD(1); SBAR(); GAPA(C0=__builtin_amdgcn_mfma_f32_32x32x16_bf16(kf[2],qr[1],C0,0,0,0),   P0[10],P0[11],P0[12],P0[13], pw1[0]=PKW(P0,8), pw1[1]=PKW(P0,10), pw1); \
    VRD(5); SBAR(); GAPA(C1=__builtin_amdgcn_mfma_f32_32x32x16_bf16(kf[3],qr[1],C1,0,0,0),   P0[14],P0[15],P1[0],P1[1],   pw1[2]=PKW(P0,12),pw1[3]=PKW(P0,14), pw1); \
    VRD(2); SBAR(); GAPA(C0=__builtin_amdgcn_mfma_f32_32x32x16_bf16(kf[4],qr[2],C0,0,0,0),   P1[2],P1[3],P1[4],P1[5],     pw2[0]=PKW(P1,0), pw2[1]=PKW(P1,2), pw2); \
    VRD(6); SBAR(); GAPA(C1=__builtin_amdgcn_mfma_f32_32x32x16_bf16(kf[5],qr[2],C1,0,0,0),   P1[6],P1[7],P1[8],P1[9],     pw2[2]=PKW(P1,4), pw2[3]=PKW(P1,6), pw2); \
    VRD(3); SBAR(); GAPA(C0=__builtin_amdgcn_mfma_f32_32x32x16_bf16(kf[6],qr[3],C0,0,0,0),   P1[10],P1[11],P1[12],P1[13], pw3[0]=PKW(P1,8), pw3[1]=PKW(P1,10), pw3); \
    VRD(7); SBAR(); GAPA(C1=__builtin_amdgcn_mfma_f32_32x32x16_bf16(kf[7],qr[3],C1,0,0,0),   P1[14],P1[15],0.f,0.f,       pw3[2]=PKW(P1,12),pw3[3]=PKW(P1,14), pw3); \
    l_reg+=sacc; \
    if(GK){DMA_K((t)+3,sl_cur);} if(GV){DMA_V((t)+1,sl_next);} \
    BIAS(C0,C1,t); CMASK(C0,C1,t); \
    { float a=MX3(C0[0],C0[1],C1[0]),b=MX3(C0[2],C0[3],C1[1]); a=MX3(a,C1[2],C1[3]); \
      _Pragma("unroll") for(int r=4;r<16;r+=4){a=MX3(a,C0[r],C0[r+1]);b=MX3(b,C0[r+2],C0[r+3]);a=MX3(a,C1[r],C1[r+1]);b=MX3(b,C1[r+2],C1[r+3]);} \
      float rm=__builtin_fmaxf(a,b); { auto rr=__builtin_amdgcn_permlane32_swap(__float_as_uint(rm),__float_as_uint(rm),false,false); rm=__builtin_fmaxf(__uint_as_float(rr[0]),__uint_as_float(rr[1])); } \
      resc=false; \
      if(__builtin_expect(__any(rm>(float)THRL),0)){ const float dl=__builtin_fmaxf(rm,0.f); mhat+=dl; \
        _Pragma("unroll") for(int r=0;r<16;++r){C0[r]-=dl;C1[r]-=dl;} \
        _Pragma("unroll") for(int r=0;r<16;++r)negm[r]=-mhat; asm volatile("":"+v"(negm)); \
        const float f=__builtin_amdgcn_exp2f(-dl); l_reg*=f; if(hi==0)wsf[r32]=f; resc=true; } } \
    SBAR(); \
    GAPB(o[0]=__builtin_amdgcn_mfma_f32_32x32x16_bf16(PAF(0),VFR(0),o[0],0,0,0), C0,0); \
    GAPB(o[1]=__builtin_amdgcn_mfma_f32_32x32x16_bf16(PAF(0),VFR(4),o[1],0,0,0), C0,4); \
    KRD(GL,0); GAPB(o[0]=__builtin_amdgcn_mfma_f32_32x32x16_bf16(PAF(1),VFR(1),o[0],0,0,0), C0,8); \
    KRD(GL,1); GAPB(o[1]=__builtin_amdgcn_mfma_f32_32x32x16_bf16(PAF(1),VFR(5),o[1],0,0,0), C0,12); \
    KRD(GL,2); GAPB(o[0]=__builtin_amdgcn_mfma_f32_32x32x16_bf16(PAF(2),VFR(2),o[0],0,0,0), C1,0); \
    KRD(GL,3); GAPB(o[1]=__builtin_amdgcn_mfma_f32_32x32x16_bf16(PAF(2),VFR(6),o[1],0,0,0), C1,4); \
    GAPB(o[0]=__builtin_amdgcn_mfma_f32_32x32x16_bf16(PAF(3),VFR(3),o[0],0,0,0), C1,8); \
    GAPB(o[1]=__builtin_amdgcn_mfma_f32_32x32x16_bf16(PAF(3),VFR(7),o[1],0,0,0), C1,12); \
    }while(0)
  int t=1;
  #undef CMASK
  #define CMASK(P0,P1,t) do{}while(0)
  for(;t+5<NT;t+=2){
    STEP(pB0,pB1,pA0,pA1,t,true,true,true);     WAIT_BAR(2); RESC(); ROT();
    STEP(pA0,pA1,pB0,pB1,t+1,true,true,true);   WAIT_BAR(2); RESC(); ROT();
  }
  #undef CMASK
  #define CMASK(P0,P1,t) do{int jb_=(t)-(NT-4); if(jb_>=0)cmask(P0,P1,jb_,qrel,hi);}while(0)
  #define ENDW(tt) do{ if((tt)+3<NT){WAIT_BAR(2);} else if((tt)+2<NT){WAIT_BAR(1);} else {WAIT_BAR(0);} }while(0)
  for(;t+1<NT;t+=2){
    STEP(pB0,pB1,pA0,pA1,t,(t+3<NT),(t+1<NT),(t+1<NT));       ENDW(t);   RESC(); ROT();
    STEP(pA0,pA1,pB0,pB1,t+1,(t+4<NT),(t+2<NT),(t+2<NT));     ENDW(t+1); RESC(); ROT();
  }
  STEP(pB0,pB1,pA0,pA1,NT-1,false,false,false); RESC();
  { float sacc=pB0[0]+pB0[1]; _Pragma("unroll") for(int r=2;r<16;++r)sacc+=pB0[r]; _Pragma("unroll") for(int r=0;r<16;++r)sacc+=pB1[r]; l_reg+=sacc;
    pw0=(u32x4){PKW(pB0,0),PKW(pB0,2),PKW(pB0,4),PKW(pB0,6)};pw1=(u32x4){PKW(pB0,8),PKW(pB0,10),PKW(pB0,12),PKW(pB0,14)};pw2=(u32x4){PKW(pB1,0),PKW(pB1,2),PKW(pB1,4),PKW(pB1,6)};pw3=(u32x4){PKW(pB1,8),PKW(pB1,10),PKW(pB1,12),PKW(pB1,14)};
    SBAR(); pv(o,vb0+sl_cur,PAF(0),PAF(1),PAF(2),PAF(3)); }
  #undef PKW
  #undef PAF
  #undef VFR
  #undef PIN
  #undef MX3
  #undef GAPA
  #undef GAPB
  #undef EX
  #undef VRD
  #undef KRD
  #undef STEP
  #undef ENDW
  {auto rr=__builtin_amdgcn_permlane32_swap(__float_as_uint(l_reg),__float_as_uint(l_reg),false,false);l_reg=__uint_as_float(rr[0])+__uint_as_float(rr[1]);}
  if(hi==0)wsf[32+r32]=l_reg;asm volatile("s_waitcnt lgkmcnt(0)":::"memory");
  float rli[16];
  #pragma unroll
  for(int r=0;r<16;++r)rli[r]=__builtin_amdgcn_rcpf(wsf[32+crow(r,hi)]);
  bf16*Ow=O+(rowbase+q0+wid*QBLK)*POUT+h*D; float*Sw=SSQh+(rowbase+q0+wid*QBLK)*16;
  { bf16*stg=(bf16*)(shm+LDS_OST)+wid*2048;
    #pragma unroll
    for(int r=0;r<16;++r){const int orow=crow(r,hi);
      #pragma unroll
      for(int d0=0;d0<2;++d0)stg[orow*64+d0*32+r32]=__float2bfloat16(o[d0][r]*rli[r]);}
    asm volatile("s_waitcnt lgkmcnt(0)":::"memory");
    #pragma unroll
    for(int i=0;i<4;++i){const int row=i*8+(lane>>3),ch=lane&7; const u32x4 v=*(const u32x4*)(stg+row*64+ch*8); ATTN_STORE16(Ow+(long)row*POUT+ch*8,v);
      float sq=0.f;
      #pragma unroll
      for(int w_=0;w_<4;++w_){const float lo_=__uint_as_float(v[w_]<<16),hi_=__uint_as_float(v[w_]&0xffff0000u);sq+=lo_*lo_+hi_*hi_;}
      sq+=__shfl_xor(sq,1);sq+=__shfl_xor(sq,2);sq+=__shfl_xor(sq,4); if(ch==0)Sw[row*16]=sq;} }
  asm volatile("s_waitcnt lgkmcnt(0)\n\ts_barrier":::"memory");
  #undef DMA_K
  #undef DMA_V
  #undef CMASK
  #undef BIAS
  #undef START
  #undef RESC
  #undef ROT
}
constexpr int ATTN_LDS_BYTES=LDS_BYTES;

__device__ __forceinline__ void sb_unit(int b,int h,int qb,const bf16*Q,const bf16*__restrict__ K,const bf16*__restrict__ V,bf16*O,float*__restrict__ SSQh,char*shm){
  int tid_=threadIdx.x; asm volatile("":"+v"(tid_));
  const int tid=tid_,lane=tid&63,r32=lane&31,hi=lane>>5; const int wid=__builtin_amdgcn_readfirstlane(tid>>6);
  const long rowbase=(long)b*SEQ; const int q0=qb*QB;
  const bf16*Qw=Q+(rowbase+q0+wid*QBLK)*PIN+h*D;
  const bf16*Kh=K+rowbase*PIN+h*D,*Vh=V+rowbase*PIN+h*D;
  const unsigned lds0=(unsigned)(uintptr_t)shm;
  const bf16*ksrc=Kh+(long)lane*PIN+wid*8;
  const bf16*vsrc=Vh+(long)(16*(wid&3)+(lane>>2))*PIN+(wid>>2)*32+(lane&3)*8;
  const unsigned kdst=lds0+LDS_K+wid*1024, vdst=lds0+LDS_V+wid*1024;
  const int vb0=(int)(lds0+LDS_V)+((lane>>4)&1)*32+(lane&3)*8+(4*hi+((lane&15)>>2))*64;
  const char*Kbase=shm+LDS_K;
  const int NT=(q0+QB)/KVBLK;
  #define SB_DMA(i,slot) do{ const long kt_=(long)(NT-1-(i)); glds16(ksrc+kt_*KVBLK*PIN,(unsigned)__builtin_amdgcn_readfirstlane(kdst+(slot))); glds16(vsrc+kt_*KVBLK*PIN,(unsigned)__builtin_amdgcn_readfirstlane(vdst+(slot))); }while(0)
  bf16x8 qr[4];
  #pragma unroll
  for(int d0=0;d0<4;++d0)qr[d0]=*reinterpret_cast<const bf16x8*>(&Qw[(long)r32*PIN+d0*16+hi*8]);
  SB_DMA(0,0); SB_DMA(1,SLOTB);
  f32x16 o[2];o[0]=f32x16{};o[1]=f32x16{};
  float Rc=1.f;
  const int qrel=wid*QBLK+r32;
  int sl_cur=0,sl_n1=SLOTB,sl_n2=2*SLOTB;
  volatile __attribute__((address_space(3))) unsigned*flg=(volatile __attribute__((address_space(3))) unsigned*)((lds_cptr)shm+LDS_WS);
  f32x16 pA0,pA1,pB0,pB1;
  WAIT_BAR(3);
  { f32x16 z=f32x16{}; asm volatile("":"+v"(z)); qkt(pA0,pA1,Kbase+sl_cur,qr,z,r32,hi); }
  bool done_=false;
  #define SB_STEP(i,P0,P1,N0,N1) do{ \
    if((i)+1<NT){WAIT_BAR(1);}else{WAIT_BAR(0);} \
    if((i)>0){ const int pb=(((i)-1)&1)*8; unsigned all_=flg[pb]&flg[pb+1]&flg[pb+2]&flg[pb+3]&flg[pb+4]&flg[pb+5]&flg[pb+6]&flg[pb+7]; if(__builtin_amdgcn_readfirstlane(all_)){done_=true;break;} } \
    if((i)+2<NT)SB_DMA((i)+2,sl_n2); \
    if((i)+1<NT){ f32x16 z=f32x16{}; asm volatile("":"+v"(z)); qkt(N0,N1,Kbase+sl_n1,qr,z,r32,hi); SBAR(); } \
    f32x16 s0,s1; \
    _Pragma("unroll") for(int r=0;r<16;++r){ \
      const float za=__builtin_amdgcn_fmed3f(P0[r],-100.f,100.f), zb=__builtin_amdgcn_fmed3f(P1[r],-100.f,100.f); \
      P0[r]=__builtin_amdgcn_exp2f(za); P1[r]=__builtin_amdgcn_exp2f(zb); \
      s0[r]=__builtin_amdgcn_rcpf(1.f+P0[r]); s1[r]=__builtin_amdgcn_rcpf(1.f+P1[r]); } \
    if((i)<4){ const int kb=64*(3-(i))+4*hi; \
      _Pragma("unroll") for(int r=0;r<16;++r){ const int kv=kb+(r&3)+8*(r>>2); if(kv>=qrel){P0[r]=0.f;s0[r]=1.f;} if(kv+32>=qrel){P1[r]=0.f;s1[r]=1.f;} } } \
    float gp[8],pp[8]; \
    _Pragma("unroll") for(int g=0;g<4;++g){ \
      s0[4*g+2]*=s0[4*g+3]; s0[4*g+1]*=s0[4*g+2]; s0[4*g]*=s0[4*g+1]; gp[g]=s0[4*g]; \
      s1[4*g+2]*=s1[4*g+3]; s1[4*g+1]*=s1[4*g+2]; s1[4*g]*=s1[4*g+1]; gp[4+g]=s1[4*g]; } \
    _Pragma("unroll") for(int g=0;g<8;++g){ auto rr=__builtin_amdgcn_permlane32_swap(__float_as_uint(gp[g]),__float_as_uint(gp[g]),false,false); pp[g]=__uint_as_float(hi?rr[0]:rr[1]); } \
    float st=Rc, outer[8]; \
    _Pragma("unroll") for(int g=7;g>=0;--g){ outer[g]=hi?st:st*pp[g]; st=st*(gp[g]*pp[g]); } \
    Rc=st; \
    { const unsigned dn=__all(Rc==0.f)?1u:0u; if(lane==0)flg[((i)&1)*8+wid]=dn; } \
    _Pragma("unroll") for(int r=0;r<16;++r){ P0[r]=P0[r]*(s0[r]*outer[r>>2]); P1[r]=P1[r]*(s1[r]*outer[4+(r>>2)]); } \
    u32x4 pw0,pw1,pw2,pw3; \
    pw0=(u32x4){cvtpk_s(P0[0],P0[1]),cvtpk_s(P0[2],P0[3]),cvtpk_s(P0[4],P0[5]),cvtpk_s(P0[6],P0[7])}; \
    pw1=(u32x4){cvtpk_s(P0[8],P0[9]),cvtpk_s(P0[10],P0[11]),cvtpk_s(P0[12],P0[13]),cvtpk_s(P0[14],P0[15])}; \
    pw2=(u32x4){cvtpk_s(P1[0],P1[1]),cvtpk_s(P1[2],P1[3]),cvtpk_s(P1[4],P1[5]),cvtpk_s(P1[6],P1[7])}; \
    pw3=(u32x4){cvtpk_s(P1[8],P1[9]),cvtpk_s(P1[10],P1[11]),cvtpk_s(P1[12],P1[13]),cvtpk_s(P1[14],P1[15])}; \
    SBAR(); pv(o,vb0+sl_cur,__builtin_bit_cast(bf16x8,pw0),__builtin_bit_cast(bf16x8,pw1),__builtin_bit_cast(bf16x8,pw2),__builtin_bit_cast(bf16x8,pw3)); \
    { const int t_=sl_cur; sl_cur=sl_n1; sl_n1=sl_n2; sl_n2=t_; } \
  }while(0)
  for(int i=0;i<NT&&!done_;i+=2){
    SB_STEP(i,pA0,pA1,pB0,pB1); if(done_)break;
    SB_STEP(i+1,pB0,pB1,pA0,pA1);
  }
  #undef SB_STEP
  #undef SB_DMA
  bf16*Ow=O+(rowbase+q0+wid*QBLK)*POUT+h*D; float*Sw=SSQh+(rowbase+q0+wid*QBLK)*16;
  { bf16*stg=(bf16*)(shm+LDS_OST)+wid*2048;
    #pragma unroll
    for(int r=0;r<16;++r){const int orow=crow(r,hi);
      #pragma unroll
      for(int d0=0;d0<2;++d0)stg[orow*64+d0*32+r32]=__float2bfloat16(o[d0][r]);}
    asm volatile("s_waitcnt lgkmcnt(0)":::"memory");
    #pragma unroll
    for(int i=0;i<4;++i){const int row=i*8+(lane>>3),ch=lane&7; const u32x4 v=*(const u32x4*)(stg+row*64+ch*8); ATTN_STORE16(Ow+(long)row*POUT+ch*8,v);
      float sq=0.f;
      #pragma unroll
      for(int w_=0;w_<4;++w_){const float lo_=__uint_as_float(v[w_]<<16),hi_=__uint_as_float(v[w_]&0xffff0000u);sq+=lo_*lo_+hi_*hi_;}
      sq+=__shfl_xor(sq,1);sq+=__shfl_xor(sq,2);sq+=__shfl_xor(sq,4); if(ch==0)Sw[row*16]=sq;} }
  asm volatile("s_waitcnt vmcnt(0) lgkmcnt(0)\n\ts_barrier":::"memory");
}
template<int THRL=8> __device__ __forceinline__ void attn_phase(char*lds,const bf16*PROJ,const float*CUM,bf16*OMIX,float*SSQ,float skipth,int bh,int role){
  const int b=bh>>3,h=bh&7;
  const int nf=role<5?2:6;
  for(int i=0;i<nf;++i){ const int qb=role<5?(i==0?15-role:6+role):5-i;
    attn_unit<THRL>(b,h,qb,PROJ,PROJ+512,PROJ+1024,OMIX,CUM+(size_t)bh*SEQ,SSQ+h,skipth,lds); }
  const int sb0=role<3?3+3*role:(role==3?12:(role==4?14:0)), ns=(role==3||role==4)?2:3;
  for(int i=0;i<ns;++i) sb_unit(b,h,sb0+i,PROJ+1536,PROJ+2048,PROJ+2560,OMIX+512,SSQ+8+h,lds);
}
template<int THRL,int NA> __device__ __forceinline__ void attn_sched(char*lds,const bf16*PROJ,const float*CUM,bf16*OMIX,float*SSQ,float skipth,unsigned*qctr,int xl,int c){
  int tid_=threadIdx.x; asm volatile("":"+v"(tid_)); const int tid=tid_;
  volatile __attribute__((address_space(3))) float*cost=(volatile __attribute__((address_space(3))) float*)((lds_cptr)lds+114688);
  volatile __attribute__((address_space(3))) int*order=(volatile __attribute__((address_space(3))) int*)((lds_cptr)lds+114688+512);
  #define BH_OF(i) ((xl>>1)*8+(((xl&1)?0x4361:0x5270)>>(4*(i))&15))
  if(tid<128){ const int bi=tid>>5,type=(tid>>4)&1,qb=tid&15,bh=BH_OF(bi),NT0=4*(qb+1); float cs;
    if(type==0){ const float rate=-CUM[(size_t)bh*SEQ+SEQ-1]*(1.f/SEQ); const float w=skipth/fmaxf(rate,1e-6f); const float sk=fmaxf(0.f,(float)(qb*QB)-w);
      int t0=((int)(sk*(1.f/KVBLK)))&~1; if(t0>NT0-4)t0=NT0-4; cs=5.f+1.65f*(float)(NT0-t0); }
    else cs=3.f+2.6f*(float)(NT0<8?NT0:8);
    cost[tid]=cs; }
  asm volatile("s_waitcnt lgkmcnt(0)":::"memory"); __syncthreads();
  if(tid<128){ const float mc=cost[tid]; int rk=0; for(int j=0;j<128;++j){ const float cj=cost[j]; rk+=(cj>mc||(cj==mc&&j<tid))?1:0; } order[rk]=tid; }
  asm volatile("s_waitcnt lgkmcnt(0)":::"memory"); __syncthreads();
  volatile __attribute__((address_space(3))) int*qn=order+128;
  int r=c;
  for(int k=0;;++k){ if(!ATTN_DYN){ r=NA*k+((k&1)?NA-1-c:c); } if(r>=128)break;
    const int u=__builtin_amdgcn_readfirstlane(order[r]); const int bi=u>>5,type=(u>>4)&1,qb=u&15,bh=BH_OF(bi),b=bh>>3,h=bh&7;
    int nx_=0; if(ATTN_DYN&&tid==0)nx_=NA+(int)atomicAdd(qctr,1u);
    if(type==0)attn_unit<THRL>(b,h,qb,PROJ,PROJ+512,PROJ+1024,OMIX,CUM+(size_t)bh*SEQ,SSQ+h,skipth,lds);
    else sb_unit(b,h,qb,PROJ+1536,PROJ+2048,PROJ+2560,OMIX+512,SSQ+8+h,lds);
    if(ATTN_DYN){ if(tid==0)qn[0]=nx_; asm volatile("s_waitcnt vmcnt(0) lgkmcnt(0)":::"memory"); __syncthreads(); r=__builtin_amdgcn_readfirstlane(qn[0]); __syncthreads(); } }
  #undef BH_OF
}
template<int THRL=8> __device__ __forceinline__ void attn_phase8(char*lds,const bf16*PROJ,const float*CUM,bf16*OMIX,float*SSQ,int vcu){
  const int bh=vcu>>3,s=vcu&7,b=bh>>3,h=bh&7;
  if(bh>=32)return;
  for(int i=0;i<4;++i){ const int qb=(i&1)?15-s:s;
    if(i<2)attn_unit<THRL>(b,h,qb,PROJ,PROJ+512,PROJ+1024,OMIX,CUM+(size_t)bh*SEQ,SSQ+h,3.0e38f,lds);
    else   sb_unit(b,h,qb,PROJ+1536,PROJ+2048,PROJ+2560,OMIX+512,SSQ+8+h,lds); }
}
#undef SBAR
#undef WAIT_BAR
}

template <int NT, bool UP> __device__ __forceinline__ int moe_prepare(const unsigned* __restrict__ CNT, const int* __restrict__ LIST, const float* __restrict__ RSTD2, const float* __restrict__ RW,
                                                                     const float* __restrict__ bias, int* __restrict__ TBG, int bx, LAS unsigned char* L) {
    int tid_ = threadIdx.x; asm volatile("" : "+v"(tid_)); const int tid = tid_;
    LAS int* tb = (LAS int*)(L + TB_OFF); LAS int* tbE = tb + 64; LAS int* tbC = tb + 128; LAS int* cntl = tb + 192; LAS int* udl = tb + 224; LAS int* tabA = (LAS int*)(L + TAB_OFF); LAS float* tabB = (LAS float*)(L + TAB2_OFF);
    if (tid < 64) {
        const int cn = tid < NE ? (int)CNT[tid] : 0, nt = (cn + 255) >> 8, rem = cn & 255, ch = (rem != 0 && rem <= 128) ? 1 : 0;
        int a = nt, c = ch;
#pragma unroll
        for (int o = 1; o < 32; o <<= 1) { const int ta = __shfl_up(a, o), tc = __shfl_up(c, o); if ((tid & 63) >= o) { a += ta; c += tc; } }
        if (tid < NE) { tb[tid + 1] = a; tbC[tid + 1] = c; tbE[tid + 1] = a - c; cntl[tid] = cn; }
        if (tid == 0) { tb[0] = 0; tbC[0] = 0; tbE[0] = 0; }
    }
    LDS_WAIT(); __syncthreads();
    if (bx == 0 && tid <= NE) TBG[tid] = tb[tid];
    pg8::MoeOrder S{NT, bx, tb, tbE, tbC, cntl, tabA};
    if (tid < pg8::MOE_MAXU) { pg8::Unit u; const bool ok = S.next(tid, u); udl[3 * tid] = ok ? u.pm : -1; udl[3 * tid + 1] = u.pn; udl[3 * tid + 2] = u.nr; }
    LDS_WAIT(); __syncthreads();
    int nun = 0;
#pragma unroll
    for (int i = 0; i < pg8::MOE_MAXU; ++i) nun += (udl[3 * i] >= 0) ? 1 : 0;
    int slot[5];
#pragma unroll
    for (int j = 0; j < 5; ++j) { const int idx = tid + NTHREADS * j, ui = idx >> 8, r = idx & 255; slot[j] = 0;
        if (ui < nun) { const int e = udl[3 * ui + 1] / NT, mt = udl[3 * ui] - tb[e], cnt = cntl[e], p = mt * 256 + r; slot[j] = LIST[(size_t)e * LIST_CAP + (p < cnt ? p : cnt - 1)]; } }
#pragma unroll
    for (int j = 0; j < 5; ++j) { const int idx = tid + NTHREADS * j, ui = idx >> 8;
        if (ui < nun) { const int pn = udl[3 * ui + 1];
            if (UP) { const int tok = slot[j] >> 2; tabA[idx] = tok | (int)(__float_as_uint(RSTD2[tok]) & 0xffff0000u);
                      const int e = pn >> 3, pl = pn & 7, c = idx & 255; tabB[idx] = bias[(size_t)e * 2048 + (c < 128 ? pl * 128 + c : 1024 + pl * 128 + (c - 128))]; }
            else { ((LAS float*)tabA)[idx] = RW[slot[j]] * (Y_F8 ? 16.f : 1.f); const int e = pn >> 2, pl = pn & 3; tabB[idx] = bias[(size_t)e * DM + pl * 256 + (idx & 255)]; } } }
    VM_WAIT(); LDS_WAIT(); __syncthreads();
    return nun;
}

__global__ void __launch_bounds__(NTHREADS, 2) mega_fwd(Args a) {
    extern __shared__ __attribute__((aligned(16))) unsigned char lds[];
    LAS unsigned char* L = (LAS unsigned char*)lds;
    volatile LAS unsigned* MISC = (volatile LAS unsigned*)(L + MISC_OFF);
    const int tid = threadIdx.x, lane = tid & 63, wave = __builtin_amdgcn_readfirstlane(tid >> 6);
    const int G = gridDim.x, bx = blockIdx.x, vcu = (G % 8 == 0) ? (bx % 8) * (G / 8) + bx / 8 : bx;
    const int gw = vcu * NWAVES + wave, NGW = G * NWAVES;
    const bool cvt_role = (vcu & 31) >= 32 - NCVT;
    const int cvt_first = ((vcu >> 5) * NCVT + ((vcu & 31) - (32 - NCVT))) * NWAVES + wave;
    const bool cvt1_role = (vcu & 31) >= 24; const int cvt1_first = ((vcu >> 5) * 8 + ((vcu & 31) - 24)) * NWAVES + wave;
    unsigned char* ws = a.ws;
    unsigned* CTL = (unsigned*)(ws + WS_CTL);
    bf16_t* WINT = (bf16_t*)(ws + WS_WINT); bf16_t* WOUTT = (bf16_t*)(ws + WS_WOUTT); float* WR = (float*)(ws + WS_WR); float* CUM = (float*)(ws + WS_CUM);
    float* SSQ = (float*)(ws + WS_SSQ); float* RSTD2 = (float*)(ws + WS_RSTD2); float* RW = (float*)(ws + WS_RW); int* SLOTEP = (int*)(ws + WS_SLOTEP); int* TBG = (int*)(ws + WS_TBG); int* LIST = (int*)(ws + WS_LIST); float* FLOG = (float*)(ws + WS_FLOG);
    bf16_t* XN = (bf16_t*)(ws + WS_XN); bf16_t* PROJ = (bf16_t*)(ws + WS_PROJ); bf16_t* OMIX = (bf16_t*)(ws + WS_OMIX); bf16_t* X1B = (bf16_t*)(ws + WS_X1B);
    bf16_t* W1T = (bf16_t*)(ws + WS_W1T); bf16_t* W2T = (bf16_t*)(ws + WS_W2T); bf16_t* H = (bf16_t*)(ws + WS_H); bf16_t* Y = (bf16_t*)(ws + WS_Y);
    unsigned* CNT = CTL + CW_CNT;
    for (int u = tid; u < (LDS_BYTES - LDSCTL_OFF) / 4; u += NTHREADS) ((LAS unsigned*)(L + LDSCTL_OFF))[u] = 0u;
    __syncthreads();
    XcdBarrier bar = xcd_barrier_post(CTL + CW_BAR, MISC + 8);
    unsigned long long tsA = 0, tsB = 0;
#define STAMP(k) do { if (PROBE_T >= 0) { if ((k) == PROBE_T) tsA = __builtin_amdgcn_s_memrealtime(); if ((k) == PROBE_T + 1) tsB = __builtin_amdgcn_s_memrealtime(); } } while (0)
    STAMP(0);

    REPS(0) {
        LAS float* scr = (LAS float*)(L + RING_OFF + wave * 8448);
        LAS float* wf = (LAS float*)(L + RING_OFF + 98304);
        for (int i = tid; i < DM * 8; i += NTHREADS) { const int k = i >> 3; wf[(i & 7) * DM + k] = a.w_in[(size_t)k * WIN_N + 1536 + (i & 7)] * a.g1[k]; }
        LDS_WAIT(); __syncthreads();
        constexpr int I_IN = (DM / 64) * (NPROJ / 32), I_OUT = (DM / 64) * (DM / 32);
        for (int it = gw; it < I_IN + I_OUT; it += NGW) {
            TrItem t; f32x4 v[8];
            if (it < I_IN) { t.W = a.w_in; t.WT = WINT; t.gA = a.g1; t.gB = nullptr; t.K = DM; t.Nin = WIN_N; t.Nout = NPROJ; t.mode = 1; t.gsplit = DM; t.item = it; t.nbsh = -1; t.f8 = 0; }
            else { t.W = a.w_out; t.WT = WOUTT; t.gA = a.g_fox; t.gB = a.g_sb; t.K = DM; t.Nin = DM; t.Nout = DM; t.mode = 0; t.gsplit = GW; t.item = it - I_IN; t.nbsh = 5; t.f8 = 0; }
            tr_load<false>(t, lane, v); tr_store(t, lane, v, scr);
        }
        if (!OVERLAP_CVT) convert_experts(a.w1, a.w2, a.g2, W1T, W2T, gw, NGW, N_EXP_ITEMS, lane, scr);
        for (int i = gw * 64 + lane; i < DM * NE; i += NGW * 64) WR[i] = a.w_router[i] * a.g2[i >> 5];
        for (int row = gw; row < M; row += 4 * NGW) {
            float4 v0[4], v1[4], v2[4], v3[4];
#pragma unroll
            for (int j = 0; j < 4; ++j) { v0[j] = ((const float4*)(a.x + (size_t)row * DM))[lane + 64 * j]; v1[j] = ((const float4*)(a.x + (size_t)(row + NGW) * DM))[lane + 64 * j];
                v2[j] = ((const float4*)(a.x + (size_t)(row + 2 * NGW) * DM))[lane + 64 * j]; v3[j] = ((const float4*)(a.x + (size_t)(row + 3 * NGW) * DM))[lane + 64 * j]; }
            rms1_row(v0, wf, a.b_f, XN, FLOG, row, lane); rms1_row(v1, wf, a.b_f, XN, FLOG, row + NGW, lane);
            rms1_row(v2, wf, a.b_f, XN, FLOG, row + 2 * NGW, lane); rms1_row(v3, wf, a.b_f, XN, FLOG, row + 3 * NGW, lane);
        }
    }
    xcd_barrier(bar); if (REP_PHASE == 8) xcd_barrier(bar); STAMP(1);
    REPS(1) {
    { const int ci = (vcu >> 5) * 8 + ((vcu & 31) - 24);
      if (OVERLAP_CVT && CVT_SPLIT > 0) { if (cvt1_role && ((vcu & 31) - 24) < 4) cumsum_wg(FLOG, CUM, (vcu >> 5) * 4 + ((vcu & 31) - 24), (LAS float*)(L + RING_OFF)); }
      else if (vcu < NB * NH) cumsum_wg(FLOG, CUM, vcu, (LAS float*)(L + RING_OFF)); (void)ci; }
    if (OPT_GEMM) {
        if (OVERLAP_CVT && CVT_SPLIT > 0 && cvt1_role) {
            if (CVT_DMA) { LAS float* gl = (LAS float*)(L + TAB_OFF); for (int i = tid; i < DM; i += NTHREADS) gl[i] = a.g2[i]; LDS_WAIT(); __syncthreads();
                convert_experts_dma(a.w1, a.w2, W1T, W2T, cvt1_first, 64 * NWAVES, CVT_SPLIT, lane, (unsigned)(uintptr_t)((char*)lds + RING_OFF + wave * 16384), (const LAS float*)(L + RING_OFF + wave * 16384), gl); }
            else convert_experts(a.w1, a.w2, a.g2, W1T, W2T, cvt1_first, 64 * NWAVES, CVT_SPLIT, lane, (LAS float*)(L + RING_OFF + wave * 8448)); }
        else {
        pg8::Gemm g{XN, WINT, DM}; pg8::StaticOrder S; if (OVERLAP_CVT && CVT_SPLIT > 0) S.init(M, NPROJ, 192, (vcu & 31) * 8 + (vcu >> 5)); else S.init(M, NPROJ, G, bx); pg8::EpiProj E{PROJ, CTL + CW_QHP};
        pg8::gemm_phase<pg8::EpiProj, pg8::StaticOrder, true, false>(L + RING_OFF, g, S, E);
        }
    } else { for (int it = gw; it < (M / 16) * (NPROJ / 64); it += NGW) nv_inproj(XN, WINT, PROJ, it, lane); }
    }
    xcd_barrier(bar); if (REP_PHASE == 8) xcd_barrier(bar); STAMP(2);
    REPS(2) if (OPT_ATTN) {
        static_assert(attn_body::ATTN_LDS_BYTES <= RING_BYTES, "attention scratch inside the ring region");
        if (OVERLAP_CVT) {
            const int xl = vcu >> 5, l = vcu & 31;
            if (cvt_role) {
                if (CVT_DMA) { LAS float* gl = (LAS float*)(L + TAB_OFF); for (int i = tid; i < DM; i += NTHREADS) gl[i] = a.g2[i]; LDS_WAIT(); __syncthreads();
                    convert_experts_dma(a.w1, a.w2, W1T, W2T, CVT_SPLIT + cvt_first, 8 * NCVT * NWAVES, N_EXP_ITEMS, lane, (unsigned)(uintptr_t)((char*)lds + RING_OFF + wave * 16384), (const LAS float*)(L + RING_OFF + wave * 16384), gl); }
                else convert_experts(a.w1, a.w2, a.g2, W1T, W2T, CVT_SPLIT + cvt_first, 8 * NCVT * NWAVES, N_EXP_ITEMS, lane, (LAS float*)(L + RING_OFF + wave * 8448)); }
            const float bnd = 2.04f * sqrtf(__uint_as_float(CTL[CW_QHP]) * __uint_as_float(CTL[CW_KHP])), skipth = FOX_SKIP ? 160.f + 2.f * bnd : 3.0e38f;
            if (l < 32 - NCVT) { if (ATTN_SCHED) attn_body::attn_sched<8, 32 - NCVT>((char*)lds + RING_OFF, (const attn_body::bf16*)PROJ, CUM, (attn_body::bf16*)OMIX, SSQ, skipth, CTL + CW_QCTR + 64 * xl, xl, l);
                          else attn_body::attn_phase<8>((char*)lds + RING_OFF, (const attn_body::bf16*)PROJ, CUM, (attn_body::bf16*)OMIX, SSQ, skipth, xl * 4 + l / 6, l % 6); }
        } else attn_body::attn_phase8<8>((char*)lds + RING_OFF, (const attn_body::bf16*)PROJ, CUM, (attn_body::bf16*)OMIX, SSQ, vcu);
    } else {
        LAS unsigned char* wl = L + RING_OFF + wave * 16640;
        for (int u = gw; u < 4096; u += NGW) {
            const int i = u >> 11, idx = u & 2047, type = idx & 1, bh = (idx >> 1) & 31, j = (idx >> 6) & 31; const int qblk = (i == 0) ? j : 63 - j;
            if (type == 0) nv_attn<0>(PROJ, CUM, OMIX, SSQ, bh, qblk, lane, wl); else nv_attn<1>(PROJ, CUM, OMIX, SSQ, bh, qblk, lane, wl);
        }
    }
    xcd_barrier(bar); if (REP_PHASE == 8) xcd_barrier(bar); STAMP(3);
    REPS(3) if (OPT_GEMM) {
        pg8::Gemm g{OMIX, WOUTT, DM}; pg8::StaticOrder S; S.init(M, DM, G, bx);
        LAS float* ratio = (LAS float*)(L + TAB_OFF); LAS float* rsb = (LAS float*)(L + TAB_OFF + 1024);
        pg8::Unit u0;
        if (S.next(0, u0) && tid < 256) { const float* sp = SSQ + (size_t)(u0.pm * 256 + tid) * 16; float sf = 0.f, s2 = 0.f;
#pragma unroll
            for (int h = 0; h < 8; ++h) { sf += sp[h]; s2 += sp[8 + h]; }
            const float rf = rsqrtf(sf * (1.f / GW) + EPS), rs = rsqrtf(s2 * (1.f / GW) + EPS); ratio[tid] = rf / rs; rsb[tid] = rs; }
        VM_WAIT(); LDS_WAIT(); __syncthreads();
        pg8::EpiWout E{a.x, X1_BF16 ? (float*)XN : a.out, X1B, ratio, rsb};
        pg8::gemm_phase<pg8::EpiWout, pg8::StaticOrder, false, false>(L + RING_OFF, g, S, E);
    } else { for (int it = gw; it < (M / 16) * (DM / 64); it += NGW) nv_wout(OMIX, WOUTT, SSQ, a.x, a.out, X1B, it, lane); }
    xcd_barrier(bar); if (REP_PHASE == 8) xcd_barrier(bar); STAMP(4);
    if (REP_PHASE == 4) { for (int t64 = vcu; t64 < M / 64; t64 += G) router_wg(a.out, WR, a.b_router, (float*)H, (float*)H + M, (int*)Y, (int*)Y + NE * LIST_CAP, CNT + 64, t64 * 64, L + RING_OFF); }
    if (OPT_ROUTER) { for (int t64 = vcu; t64 < M / 64; t64 += G) router_wg(X1_BF16 ? (const float*)XN : a.out, WR, a.b_router, RSTD2, RW, LIST, SLOTEP, CNT, t64 * 64, L + RING_OFF); }
    else { for (int it = gw; it < M / 2; it += NGW) nv_router(a.out, WR, a.b_router, RSTD2, RW, LIST, SLOTEP, CNT, it, lane); }
    xcd_barrier(bar); if (REP_PHASE == 8) xcd_barrier(bar); STAMP(5);
    LAS int* tb = (LAS int*)(L + TB_OFF); LAS int* tbE = tb + 64; LAS int* tbC = tb + 128; LAS int* cntl = tb + 192; LAS int* udl = tb + 224; LAS int* tabA = (LAS int*)(L + TAB_OFF); LAS int* tabB = (LAS int*)(L + TAB2_OFF);
    REPS(5) if (OPT_GEMM) {
        const int nun = moe_prepare<8, true>(CNT, LIST, RSTD2, RW, a.b1, TBG, bx, L);
        pg8::Gemm g{X1B, W1T, MOE_F8 ? DM / 2 : DM}; pg8::EpiMoe1 E{H, tabA, (const LAS float*)tabB}; pg8::ListOrder SL{udl, nun, tabA};
        pg8::gemm_phase<pg8::EpiMoe1, pg8::ListOrder, true, true, MOE_F8>(L + RING_OFF, g, SL, E);
    } else {
    for (int g = gw; g < MAX_TILES * 16; g += NGW) {
        int e, base, p0, cnt; if (!moe_tile(CNT, g, e, base, p0, cnt)) continue;
        for (int cg = 0; cg < DFF / 32; ++cg) nv_moe1(X1B, W1T, a.b1, RSTD2, LIST, H, e, base, p0, cnt, cg, lane);
    } }
    xcd_barrier(bar); if (REP_PHASE == 8) xcd_barrier(bar); STAMP(6);
    REPS(6) if (OPT_GEMM) {
        const int nun = moe_prepare<4, false>(CNT, LIST, RSTD2, RW, a.b2, TBG, bx, L);
        pg8::Gemm g{H, W2T, MOE_F8 ? DM / 2 : DM}; pg8::EpiMoe2 E{Y, (const LAS float*)tabA, (const LAS float*)tabB}; pg8::ListOrder SL{udl, nun, tabA};
        pg8::gemm_phase<pg8::EpiMoe2, pg8::ListOrder, true, false, MOE_F8>(L + RING_OFF, g, SL, E);
    } else {
    for (int g = gw; g < MAX_TILES * 16; g += NGW) {
        int e, base, p0, cnt; if (!moe_tile(CNT, g, e, base, p0, cnt)) continue;
        for (int cg = 0; cg < DM / 64; ++cg) nv_moe2(H, W2T, a.b2, RW, LIST, Y, e, base, p0, cnt, cg, lane);
    } }
    xcd_barrier(bar); if (REP_PHASE == 8) xcd_barrier(bar); STAMP(7);
    if (REP_PHASE == 7) { for (int row = gw; row < M; row += NGW) final_row(a.out, Y, SLOTEP, TBG, a.gf, (float*)H, row, lane); }
    for (int row = gw; row < M; row += NGW) final_row(X1_BF16 ? (const float*)XN : a.out, Y, SLOTEP, TBG, a.gf, a.out, row, lane);
    STAMP(8);
    if (PROBE_T >= 0) { const unsigned long long t0 = __builtin_amdgcn_s_memrealtime(), d = 9ull * (tsB - tsA); while (__builtin_amdgcn_s_memrealtime() - t0 < d) __builtin_amdgcn_s_sleep(8); }
#undef STAMP
}

extern "C" void kernel_launch(void* const* d_in, const int* in_sizes, int n_in, void* d_out, int out_size, void* d_ws, size_t ws_size, hipStream_t stream) {
    static int grid = 0;
    if (grid == 0) {
        if (n_in != 15 || in_sizes[0] != M * DM || out_size != M * DM || ws_size < WS_END) {
            fprintf(stderr, "kernel_launch: unexpected shapes / workspace (n_in %d, in0 %d, out %d, ws %zu, need %zu)\n", n_in, n_in > 0 ? in_sizes[0] : -1, out_size, ws_size, (size_t)WS_END); grid = -1; return; }
        int dev = 0, cus = 0, per_cu = 0;
        if (hipGetDevice(&dev) != hipSuccess || hipDeviceGetAttribute(&cus, hipDeviceAttributeMultiprocessorCount, dev) != hipSuccess) { grid = -1; return; }
        if (hipFuncSetAttribute((const void*)mega_fwd, hipFuncAttributeMaxDynamicSharedMemorySize, LDS_BYTES) != hipSuccess) { fprintf(stderr, "kernel_launch: hipFuncSetAttribute failed\n"); grid = -1; return; }
        if (hipOccupancyMaxActiveBlocksPerMultiprocessor(&per_cu, (const void*)mega_fwd, NTHREADS, LDS_BYTES) != hipSuccess || per_cu < 1) fprintf(stderr, "kernel_launch: occupancy query reports %d\n", per_cu);
        (void)hipGetLastError();
        grid = cus;
        if (cus != 256) { fprintf(stderr, "kernel_launch: built for 256 CUs (8 XCDs x 32), found %d; nothing launched\n", cus); grid = -1; return; }
    }
    if (grid < 0) return;
    if (hipMemsetAsync((char*)d_ws + WS_CTL, 0, CTL_BYTES, stream) != hipSuccess) return;
    Args a{};
    a.x = (const float*)d_in[0]; a.g1 = (const float*)d_in[1]; a.w_in = (const float*)d_in[2]; a.b_f = (const float*)d_in[3]; a.g_fox = (const float*)d_in[4]; a.g_sb = (const float*)d_in[5];
    a.w_out = (const float*)d_in[6]; a.g2 = (const float*)d_in[7]; a.w_router = (const float*)d_in[8]; a.b_router = (const float*)d_in[9]; a.w1 = (const float*)d_in[10]; a.b1 = (const float*)d_in[11];
    a.w2 = (const float*)d_in[12]; a.b2 = (const float*)d_in[13]; a.gf = (const float*)d_in[14];
    a.out = (float*)d_out; a.ws = (unsigned char*)d_ws;
    hipLaunchKernelGGL(mega_fwd, dim3(grid), dim3(NTHREADS), LDS_BYTES, stream, a);
    const hipError_t le = hipPeekAtLastError();
    if (le != hipSuccess) fprintf(stderr, "kernel_launch: launch failed: %s\n", hipGetErrorName(le));
}
```

```cpp
#include <hip/hip_runtime.h>
#include <cstdio>
#include <cstdint>

typedef unsigned short bf16_t;
typedef short bf16x8 __attribute__((ext_vector_type(8)));
typedef float f32x4 __attribute__((ext_vector_type(4)));
typedef float f32x2 __attribute__((ext_vector_type(2)));

constexpr int NB = 4, SEQ = 4096, DM = 1024, M = NB * SEQ;
constexpr int NH = 8, HD = 64, GW = 512;
constexpr int WIN_N = 3080, NPROJ = 3072;
constexpr int NE = 32, TOPK = 4, DFF = 1024;
constexpr float EPS = 1e-5f;
constexpr float LOG2E = 1.4426950408889634f;
constexpr float C2 = 0.125f * LOG2E;
constexpr int LIST_CAP = M;
constexpr int MAX_TILES = (M * TOPK) / 256 + NE;

constexpr size_t MiB = 1u << 20;
constexpr size_t WS_CTL = 0, CTL_BYTES = 1 * MiB;
constexpr size_t WS_WINT = 2 * MiB;
constexpr size_t WS_WOUTT = 8 * MiB;
constexpr size_t WS_WR = 10 * MiB;
constexpr size_t WS_CUM = 11 * MiB;
constexpr size_t WS_SSQ = 12 * MiB;
constexpr size_t WS_RSTD2 = 14 * MiB;
constexpr size_t WS_RSTD1 = 14 * MiB + 256 * 1024;
constexpr size_t WS_RW = 15 * MiB;
constexpr size_t WS_SLOTEP = 15 * MiB + 512 * 1024;
constexpr size_t WS_TBG = 14 * MiB + 512 * 1024;
constexpr size_t WS_LIST = 16 * MiB;
constexpr size_t WS_FLOG = 18 * MiB;
constexpr size_t WS_XN = 32 * MiB;
constexpr size_t WS_PROJ = 64 * MiB;
constexpr size_t WS_OMIX = 160 * MiB;
constexpr size_t WS_X1B = 192 * MiB;
constexpr size_t WS_W1T = 224 * MiB;
constexpr size_t WS_W2T = 352 * MiB;
constexpr size_t WS_H = 416 * MiB;
constexpr size_t WS_Y = 560 * MiB;
constexpr size_t WS_END = 704 * MiB;
constexpr int CW_DONE = 3072;
constexpr int CW_CNT = 1024;
constexpr int CW_QCTR = 2304;
constexpr int CW_QHP = 2048, CW_KHP = 2112;

__device__ __forceinline__ unsigned short f2bf(float f) { unsigned u = __float_as_uint(f); return (unsigned short)((u + 0x7fffu + ((u >> 16) & 1u)) >> 16); }
__device__ __forceinline__ float bf2f(unsigned short b) { return __uint_as_float(((unsigned)b) << 16); }
__device__ __forceinline__ float xsh(float v, int o) { const int iv = __float_as_int(v); int r;
    switch (o) { case 1: r = __builtin_amdgcn_ds_swizzle(iv, 0x041F); break; case 2: r = __builtin_amdgcn_ds_swizzle(iv, 0x081F); break; case 4: r = __builtin_amdgcn_ds_swizzle(iv, 0x101F); break;
                 case 8: r = __builtin_amdgcn_ds_swizzle(iv, 0x201F); break; default: r = __builtin_amdgcn_ds_swizzle(iv, 0x401F); break; }
    return __int_as_float(r); }
__device__ __forceinline__ float xadd(float v, int o) { if (o == 32) { auto rr = __builtin_amdgcn_permlane32_swap(__float_as_uint(v), __float_as_uint(v), false, false); return __uint_as_float(rr[0]) + __uint_as_float(rr[1]); } return v + xsh(v, o); }
__device__ __forceinline__ int shfl_up_l(int v, int o, int ln) { return __builtin_amdgcn_ds_bpermute(((ln >= o) ? ln - o : ln) << 2, v); }
__device__ __forceinline__ float wave_sum(float v) {
#pragma unroll
    for (int o = 1; o < 64; o <<= 1) v = xadd(v, o);
    return v;
}


#define LAS __attribute__((address_space(3)))
#define GAS __attribute__((address_space(1)))
typedef unsigned v4u __attribute__((ext_vector_type(4)));
#define LDS_WAIT() asm volatile("s_waitcnt lgkmcnt(0)" ::: "memory")
#define VM_WAIT() asm volatile("s_waitcnt vmcnt(0)" ::: "memory")
constexpr int NWAVES = 8, NTHREADS = NWAVES * 64;
constexpr int PROBE_T = -1;
constexpr bool ATTN_DYN = true;
constexpr bool ATTN_SCHED = true;
constexpr bool FOX_SKIP = true;
constexpr bool WT_STORES = true;
constexpr bool X_FROM_XN = false;
constexpr bool X1_BF16 = true;
constexpr bool Y_F8 = true;
constexpr bool MOE_F8 = true;
constexpr bool W_BLK = true;
constexpr bool CVT_REG4 = true;
constexpr bool ROUTER_BF3 = true;
constexpr bool MERGE56 = true;
constexpr bool WIDE_ST = true;
constexpr bool CVT_DMA = true;
constexpr int NCVT = 9;
constexpr int CVT_SPLIT = 0 * 512;
constexpr bool OVERLAP_CVT = true;

#define XB_TMO      128
#define XB_XCNT(j)  (256  + 64 * (j))
#define XB_XSUB(j)  (1280 + 64 * (j))
#define XB_XGEN(j)  (2304 + 64 * (j))
#define XB_TOP      3328
#define XB_TOPGEN   3392
#define XCD_BAR_WORDS 3456
#define XB_SPIN_CAP (1u << 20)
__device__ __forceinline__ unsigned xb_ld(unsigned* p)              { return __hip_atomic_load(p, __ATOMIC_RELAXED, __HIP_MEMORY_SCOPE_AGENT); }
__device__ __forceinline__ unsigned xb_add(unsigned* p, unsigned v) { return __hip_atomic_fetch_add(p, v, __ATOMIC_RELAXED, __HIP_MEMORY_SCOPE_AGENT); }
__device__ __forceinline__ unsigned xb_xcc_id() { return (unsigned)__builtin_amdgcn_s_getreg((3 << 11) | 20) & 0xFu; }
#define XB_SPIN(cond, bar) do { unsigned _sp = 0; while (cond) { __builtin_amdgcn_s_sleep(1); \
    if ((++_sp & 255u) == 0u) { if (xb_ld(&(bar)[XB_TMO])) break; if (_sp > XB_SPIN_CAP) { atomicAdd(&(bar)[XB_TMO], 1u); break; } } } } while (0)
struct XcdBarrier { unsigned* bar; unsigned x; volatile LAS unsigned* st; };
__device__ __forceinline__ XcdBarrier xcd_barrier_post(unsigned* bar, volatile LAS unsigned* st) {
    XcdBarrier b; b.bar = bar; b.x = xb_xcc_id(); b.st = st;
    if (threadIdx.x == 0) (void)xb_add(&bar[XB_XCNT(b.x)], 1u);
    return b;
}
__device__ __forceinline__ void xcd_barrier_complete(unsigned* bar, unsigned x, unsigned& nloc, unsigned& nx) {
    const unsigned G = gridDim.x * gridDim.y * gridDim.z;
    unsigned sum, cnt, mine, sp = 0u;
    for (;;) {
        sum = 0u; cnt = 0u; mine = 0u;
#pragma unroll
        for (unsigned j = 0; j < 16; ++j) { const unsigned c = xb_ld(&bar[XB_XCNT(j)]); sum += c; cnt += (c > 0u) ? 1u : 0u; mine = (j == x) ? c : mine; }
        if (sum == G) break;
        __builtin_amdgcn_s_sleep(1);
        if ((++sp & 255u) == 0u) { if (xb_ld(&bar[XB_TMO])) break; if (sp > XB_SPIN_CAP) { atomicAdd(&bar[XB_TMO], 1u); break; } }
    }
    nloc = mine > 0u ? mine : 1u; nx = cnt > 0u ? cnt : 1u;
}
__device__ __forceinline__ void xcd_barrier(const XcdBarrier& b) {
    asm volatile("s_waitcnt vmcnt(0)" ::: "memory");
    __syncthreads();
    if (threadIdx.x == 0) {
        unsigned* bar = b.bar;
        __builtin_amdgcn_s_waitcnt(0);
        unsigned nloc = b.st[0], nx = b.st[1];
        if (nloc == 0u) { xcd_barrier_complete(bar, b.x, nloc, nx); b.st[0] = nloc; b.st[1] = nx; }
        const unsigned old = xb_add(&bar[XB_XSUB(b.x)], 1u);
        const unsigned gen = old / nloc;
        if (old + 1u == (gen + 1u) * nloc) {
            __builtin_amdgcn_fence(__ATOMIC_RELEASE, "agent");
            asm volatile("s_waitcnt vmcnt(0)" ::: "memory");
            const unsigned og = xb_add(&bar[XB_TOP], 1u);
            const unsigned tg = og / nx;
            if (og + 1u == (tg + 1u) * nx) xb_add(&bar[XB_TOPGEN], 1u);
            else XB_SPIN(xb_ld(&bar[XB_TOPGEN]) == tg, bar);
            __builtin_amdgcn_fence(__ATOMIC_ACQUIRE, "agent");
            xb_add(&bar[XB_XGEN(b.x)], 1u);
            asm volatile("s_waitcnt vmcnt(0)" ::: "memory");
        } else {
            XB_SPIN(xb_ld(&bar[XB_XGEN(b.x)]) == gen, bar);
            __builtin_amdgcn_fence(__ATOMIC_ACQUIRE, "agent");
            asm volatile("s_waitcnt vmcnt(0)" ::: "memory");
        }
    }
    __syncthreads();
}

constexpr int RING_OFF = 0, RING_BYTES = 131072;
constexpr int TAB_OFF = 131072;
constexpr int TAB2_OFF = TAB_OFF + 10 * 1024, TB_OFF = TAB_OFF + 20 * 1024;
constexpr int LDSCTL_OFF = 152576, MISC_OFF = LDSCTL_OFF + 320;
constexpr int LDS_BYTES = 155648;
constexpr int CW_BAR = 4096;

struct Args {
    const float *x, *g1, *w_in, *b_f, *g_fox, *g_sb, *w_out, *g2, *w_router, *b_router, *w1, *b1, *w2, *b2, *gf;
    float* out; unsigned char* ws;
};

__device__ __forceinline__ int mapcol(int mode, int n) {
    if (mode == 1) return n < 1536 ? n : n + 8;
    if (mode == 2) { const int pn = n >> 8, j = n & 255; return j < 128 ? 128 * pn + j : 1024 + 128 * pn + (j - 128); }
    return n;
}
__device__ __forceinline__ unsigned pk4_fp8(float a, float b, float c, float d) {
    a = __builtin_amdgcn_fmed3f(a, -448.f, 448.f); b = __builtin_amdgcn_fmed3f(b, -448.f, 448.f); c = __builtin_amdgcn_fmed3f(c, -448.f, 448.f); d = __builtin_amdgcn_fmed3f(d, -448.f, 448.f);
    int w = __builtin_amdgcn_cvt_pk_fp8_f32(a, b, 0, false); w = __builtin_amdgcn_cvt_pk_fp8_f32(c, d, w, true); return (unsigned)w;
}
__device__ __forceinline__ unsigned pk2(float lo, float hi) { unsigned r; asm("v_cvt_pk_bf16_f32 %0, %1, %2" : "=v"(r) : "v"(lo), "v"(hi)); return r; }
struct TrItem { const float* W; bf16_t* WT; const float* gA; const float* gB; int K, Nin, Nout, mode, gsplit, item, nbsh, f8; };
template <bool NT> __device__ __forceinline__ void tr_load(const TrItem& t, int lane, f32x4 (&v)[8]) {
    const int nblk = t.Nout / 32, kb = t.nbsh >= 0 ? (t.item >> t.nbsh) : t.item / nblk, nb = t.nbsh >= 0 ? (t.item & (nblk - 1)) : t.item % nblk, k0 = 64 * kb, n0 = 32 * nb, l7 = lane & 7, kr = lane >> 3, col = mapcol(t.mode, n0 + 4 * l7);
#pragma unroll
    for (int i = 0; i < 8; ++i) { const f32x4* p = (const f32x4*)(t.W + (size_t)(k0 + 8 * i + kr) * t.Nin + col); v[i] = NT ? __builtin_nontemporal_load(p) : *p; }
}
__device__ __forceinline__ void tr_store(const TrItem& t, int lane, const f32x4 (&v)[8], LAS float* scr, const float* gpre = nullptr) {
    const int nblk = t.Nout / 32, kb = t.nbsh >= 0 ? (t.item >> t.nbsh) : t.item / nblk, nb = t.nbsh >= 0 ? (t.item & (nblk - 1)) : t.item % nblk, k0 = 64 * kb, n0 = 32 * nb, l7 = lane & 7, kr = lane >> 3;
#pragma unroll
    for (int i = 0; i < 8; ++i) { const int kk = 8 * i + kr, k = k0 + kk; const float gs = gpre ? gpre[i] : (t.gA ? (k < t.gsplit ? t.gA[k] : t.gB[k - t.gsplit]) : 1.f);
        LAS float* sp = scr + kk * 33 + 4 * l7; sp[0] = v[i][0] * gs; sp[1] = v[i][1] * gs; sp[2] = v[i][2] * gs; sp[3] = v[i][3] * gs; }
    LDS_WAIT();
    if (t.f8) {
        const int c = lane & 3;
#pragma unroll
        for (int j = 0; j < 2; ++j) { const int n = (lane >> 2) + 16 * j; const LAS float* sp = scr + (16 * c) * 33 + n;
            v4u o; o.x = pk4_fp8(32.f * sp[0 * 33], 32.f * sp[1 * 33], 32.f * sp[2 * 33], 32.f * sp[3 * 33]); o.y = pk4_fp8(32.f * sp[4 * 33], 32.f * sp[5 * 33], 32.f * sp[6 * 33], 32.f * sp[7 * 33]);
            o.z = pk4_fp8(32.f * sp[8 * 33], 32.f * sp[9 * 33], 32.f * sp[10 * 33], 32.f * sp[11 * 33]); o.w = pk4_fp8(32.f * sp[12 * 33], 32.f * sp[13 * 33], 32.f * sp[14 * 33], 32.f * sp[15 * 33]);
            *(v4u*)((unsigned char*)t.WT + (size_t)(n0 + n) * t.K + k0 + 16 * c) = o; }
    } else {
    const int c = lane & 7;
#pragma unroll
    for (int j = 0; j < 4; ++j) { const int n = (lane >> 3) + 8 * j; const LAS float* sp = scr + (8 * c) * 33 + n;
        v4u o; o.x = pk2(sp[0 * 33], sp[1 * 33]); o.y = pk2(sp[2 * 33], sp[3 * 33]); o.z = pk2(sp[4 * 33], sp[5 * 33]); o.w = pk2(sp[6 * 33], sp[7 * 33]);
        *(v4u*)(t.WT + (size_t)(n0 + n) * t.K + k0 + 8 * c) = o; }
    }
    LDS_WAIT();
}
constexpr int I_W1 = (DM / 64) * (2048 / 32), I_W2 = (DM / 64) * (DM / 32), N_EXP_ITEMS = NE * (I_W1 + I_W2);
__device__ __forceinline__ TrItem expert_item(const float* w1, const float* w2, const float* g2, bf16_t* W1T, bf16_t* W2T, int r) {
    TrItem t;
    t.f8 = MOE_F8 ? 1 : 0;
    if (r < NE * I_W1) { const int e = r / I_W1; t.W = w1 + (size_t)e * DM * 2048; t.WT = MOE_F8 ? (bf16_t*)((unsigned char*)W1T + (size_t)e * 2048 * DM) : W1T + (size_t)e * 2048 * DM; t.gA = g2; t.gB = nullptr; t.K = DM; t.Nin = 2048; t.Nout = 2048; t.mode = 2; t.gsplit = DM; t.item = r % I_W1; t.nbsh = 6; }
    else { r -= NE * I_W1; const int e = r / I_W2; t.W = w2 + (size_t)e * DM * DM; t.WT = MOE_F8 ? (bf16_t*)((unsigned char*)W2T + (size_t)e * DM * DM) : W2T + (size_t)e * DM * DM; t.gA = nullptr; t.gB = nullptr; t.K = DM; t.Nin = DM; t.Nout = DM; t.mode = 0; t.gsplit = DM; t.item = r % I_W2; t.nbsh = 5; }
    return t;
}
__device__ __forceinline__ void convert_experts(const float* w1, const float* w2, const float* g2, bf16_t* W1T, bf16_t* W2T, int first, int stride, int N_END, int lane, LAS float* scr) {
    f32x4 v0[8], v1[8];
#define CVT_LOAD(v, idx) do { if ((idx) < N_END) { const TrItem t_ = expert_item(w1, w2, g2, W1T, W2T, (idx)); tr_load<true>(t_, lane, v); } } while (0)
#define CVT_STORE(v, idx) do { if ((idx) < N_END) { const TrItem t_ = expert_item(w1, w2, g2, W1T, W2T, (idx)); tr_store(t_, lane, v, scr); } } while (0)
    int it = first; asm volatile("" : "+v"(lane));
    CVT_LOAD(v0, it);
#pragma unroll 1
    for (; it < N_END; it += 2 * stride) {
        CVT_LOAD(v1, it + stride); CVT_STORE(v0, it);
        CVT_LOAD(v0, it + 2 * stride); CVT_STORE(v1, it + stride);
    }
#undef CVT_LOAD
#undef CVT_STORE
}

__device__ __forceinline__ void dma16(const void* gsrc, unsigned lds_dst) { unsigned keep;
    asm volatile("s_mov_b32 %0, m0\n\ts_mov_b32 m0, %2\n\ts_nop 0\n\tglobal_load_lds_dwordx4 %1, off\n\ts_mov_b32 m0, %0" : "=&s"(keep) : "v"(gsrc), "s"(lds_dst) : "memory"); }
struct CvtItem { const float* W; unsigned char* WT; int Nin, k0, n0, col0, useg; unsigned kbs; };
__device__ __forceinline__ CvtItem cvt_item(const float* w1, const float* w2, bf16_t* W1T, bf16_t* W2T, int r) {
    CvtItem t;
    if (r < NE * I_W1) { const int e = r / I_W1, it = r % I_W1; t.W = w1 + (size_t)e * DM * 2048; t.WT = (unsigned char*)W1T + (size_t)e * 2048 * (W_BLK ? 64 : DM); t.kbs = NE * 2048 * 64; t.Nin = 2048; t.k0 = 64 * (it >> 6); t.n0 = 32 * (it & 63); t.col0 = mapcol(2, t.n0); t.useg = 1; }
    else { r -= NE * I_W1; const int e = r / I_W2, it = r % I_W2; t.W = w2 + (size_t)e * DM * DM; t.WT = (unsigned char*)W2T + (size_t)e * DM * (W_BLK ? 64 : DM); t.kbs = NE * DM * 64; t.Nin = DM; t.k0 = 64 * (it >> 5); t.n0 = 32 * (it & 31); t.col0 = t.n0; t.useg = 0; }
    return t;
}
__device__ __forceinline__ void cvt_issue(const CvtItem& t, int lane, unsigned ldsbuf) {
#pragma unroll
    for (int i = 0; i < 8; ++i) { const int kl = 8 * i + (lane >> 3), qs = ((lane & 7) - 2 * (kl >> 4)) & 7;
        dma16(t.W + (size_t)(t.k0 + kl) * t.Nin + t.col0 + 4 * qs, (unsigned)__builtin_amdgcn_readfirstlane(ldsbuf + i * 1024)); }
}
__device__ __forceinline__ void cvt_finish(const CvtItem& t, int lane, const LAS float* buf, const LAS float* gl) {
    const int c = lane & 3;
    f32x4 g[4];
#pragma unroll
    for (int m = 0; m < 4; ++m) g[m] = t.useg ? *(const LAS f32x4*)(gl + t.k0 + 16 * c + 4 * m) * 32.f : (f32x4){32.f, 32.f, 32.f, 32.f};
#pragma unroll
    for (int j = 0; j < 2; ++j) { const int n = (lane >> 2) + 16 * j; const LAS float* sp = buf + (16 * c) * 32 + ((n + 8 * c) & 31);
        v4u o;
        o.x = pk4_fp8(sp[0 * 32] * g[0][0], sp[1 * 32] * g[0][1], sp[2 * 32] * g[0][2], sp[3 * 32] * g[0][3]);   o.y = pk4_fp8(sp[4 * 32] * g[1][0], sp[5 * 32] * g[1][1], sp[6 * 32] * g[1][2], sp[7 * 32] * g[1][3]);
        o.z = pk4_fp8(sp[8 * 32] * g[2][0], sp[9 * 32] * g[2][1], sp[10 * 32] * g[2][2], sp[11 * 32] * g[2][3]); o.w = pk4_fp8(sp[12 * 32] * g[3][0], sp[13 * 32] * g[3][1], sp[14 * 32] * g[3][2], sp[15 * 32] * g[3][3]);
        if (W_BLK) *(v4u*)(t.WT + (size_t)(t.k0 >> 6) * t.kbs + (size_t)(t.n0 + n) * 64 + 16 * c) = o;
        else *(v4u*)(t.WT + (size_t)(t.n0 + n) * DM + t.k0 + 16 * c) = o; }
}
__device__ __forceinline__ void convert_experts_dma(const float* w1, const float* w2, bf16_t* W1T, bf16_t* W2T, int first, int stride, int N_END, int lane_, unsigned lds0, const LAS float* buf0, const LAS float* gl) {
    int lane = lane_; asm volatile("" : "+v"(lane));
    int it = first;
    if (it < N_END) { const CvtItem t = cvt_item(w1, w2, W1T, W2T, it); cvt_issue(t, lane, lds0); }
#pragma unroll 1
    for (; it < N_END; it += 2 * stride) {
        const int nx = it + stride, nn = it + 2 * stride;
        if (nx < N_END) { const CvtItem t = cvt_item(w1, w2, W1T, W2T, nx); cvt_issue(t, lane, lds0 + 8192); asm volatile("s_waitcnt vmcnt(8)" ::: "memory"); } else asm volatile("s_waitcnt vmcnt(0)" ::: "memory");
        { const CvtItem t = cvt_item(w1, w2, W1T, W2T, it); cvt_finish(t, lane, buf0, gl); }
        if (nx < N_END) {
            asm volatile("s_waitcnt lgkmcnt(0)" ::: "memory");
            if (nn < N_END) { const CvtItem t = cvt_item(w1, w2, W1T, W2T, nn); cvt_issue(t, lane, lds0); asm volatile("s_waitcnt vmcnt(8)" ::: "memory"); } else asm volatile("s_waitcnt vmcnt(0)" ::: "memory");
            { const CvtItem t = cvt_item(w1, w2, W1T, W2T, nx); cvt_finish(t, lane, buf0 + 2048, gl); }
            asm volatile("s_waitcnt lgkmcnt(0)" ::: "memory");
        }
    }
    asm volatile("s_waitcnt vmcnt(0)" ::: "memory");
}

__device__ __forceinline__ void cvtr_load(const CvtItem& t, int lane, f32x4 (&v)[8]) {
    const int l7 = lane & 7, kr = lane >> 3;
#pragma unroll
    for (int i = 0; i < 8; ++i) v[i] = __builtin_nontemporal_load((const f32x4*)(t.W + (size_t)(t.k0 + 8 * i + kr) * t.Nin + t.col0 + 4 * l7));
}
__device__ __forceinline__ void cvtr_store(const CvtItem& t, int lane, const f32x4 (&v)[8], LAS float* scr, const LAS float* gl) {
    const int l7 = lane & 7, kr = lane >> 3;
#pragma unroll
    for (int i = 0; i < 8; ++i) { const int kk = 8 * i + kr; const float gs = t.useg ? gl[t.k0 + kk] * 32.f : 32.f;
        LAS float* sp = scr + kk * 33 + 4 * l7; sp[0] = v[i][0] * gs; sp[1] = v[i][1] * gs; sp[2] = v[i][2] * gs; sp[3] = v[i][3] * gs; }
    LDS_WAIT();
    const int c = lane & 3;
#pragma unroll
    for (int j = 0; j < 2; ++j) { const int n = (lane >> 2) + 16 * j; const LAS float* sp = scr + (16 * c) * 33 + n;
        v4u o; o.x = pk4_fp8(sp[0 * 33], sp[1 * 33], sp[2 * 33], sp[3 * 33]); o.y = pk4_fp8(sp[4 * 33], sp[5 * 33], sp[6 * 33], sp[7 * 33]);
        o.z = pk4_fp8(sp[8 * 33], sp[9 * 33], sp[10 * 33], sp[11 * 33]); o.w = pk4_fp8(sp[12 * 33], sp[13 * 33], sp[14 * 33], sp[15 * 33]);
        *(v4u*)(t.WT + (size_t)(t.k0 >> 6) * t.kbs + (size_t)(t.n0 + n) * 64 + 16 * c) = o; }
    LDS_WAIT();
}
__device__ __forceinline__ void convert_experts_reg4(const float* w1, const float* w2, bf16_t* W1T, bf16_t* W2T, int first, int stride, int N_END, int lane_, LAS float* scr, const LAS float* gl) {
    int lane = lane_; asm volatile("" : "+v"(lane));
    f32x4 v0[8], v1[8], v2[8], v3[8];
#define CVR_LOAD(v, idx) do { const CvtItem t_ = cvt_item(w1, w2, W1T, W2T, (idx) < N_END ? (idx) : 4 * first); cvtr_load(t_, lane, v); } while (0)
#define CVR_STORE(v, idx) do { if ((idx) < N_END) { const CvtItem t_ = cvt_item(w1, w2, W1T, W2T, (idx)); cvtr_store(t_, lane, v, scr, gl); } } while (0)
    int it = first;
    CVR_LOAD(v0, 4 * it); CVR_LOAD(v1, 4 * it + 1); CVR_LOAD(v2, 4 * it + 2); CVR_LOAD(v3, 4 * it + 3);
#pragma unroll 1
    for (; 4 * it < N_END; it += stride) {
        CVR_STORE(v0, 4 * it);     CVR_LOAD(v0, 4 * (it + stride));
        CVR_STORE(v1, 4 * it + 1); CVR_LOAD(v1, 4 * (it + stride) + 1);
        CVR_STORE(v2, 4 * it + 2); CVR_LOAD(v2, 4 * (it + stride) + 2);
        CVR_STORE(v3, 4 * it + 3); CVR_LOAD(v3, 4 * (it + stride) + 3);
    }
#undef CVR_LOAD
#undef CVR_STORE
}

__device__ __forceinline__ float log_sigmoid(float v) { return fminf(v, 0.f) - log1pf(expf(-fabsf(v))); }
__device__ __forceinline__ void rms1_row(const float4 (&v)[4], const LAS float* wf  , const float* __restrict__ b_f,
                                         bf16_t* __restrict__ XN, float* __restrict__ FLOG, float* __restrict__ RSTD1, int row, int lane) {
    float ss = 0.f;
#pragma unroll
    for (int j = 0; j < 4; ++j) ss += v[j].x * v[j].x + v[j].y * v[j].y + v[j].z * v[j].z + v[j].w * v[j].w;
    ss = wave_sum(ss);
    const float rstd = rsqrtf(ss * (1.f / DM) + EPS);
    if (lane == 0) RSTD1[row] = 1.f / rstd;
    float fg[8];
#pragma unroll
    for (int g = 0; g < 8; ++g) fg[g] = 0.f;
#pragma unroll
    for (int j = 0; j < 4; ++j) {
        const int c0 = 4 * (lane + 64 * j);
        uint2 o; o.x = pk2(v[j].x * rstd, v[j].y * rstd); o.y = pk2(v[j].z * rstd, v[j].w * rstd);
        *(uint2*)(XN + (size_t)row * DM + c0) = o;
#pragma unroll
        for (int g = 0; g < 8; ++g) { const f32x4 w = *(const LAS f32x4*)(wf + g * DM + c0);
            fg[g] += v[j].x * w[0] + v[j].y * w[1] + v[j].z * w[2] + v[j].w * w[3]; }
    }
    const bool b0 = lane & 1, b1 = lane & 2, b2 = lane & 4;
    float g4[4], h2[2];
#pragma unroll
    for (int i = 0; i < 4; ++i) g4[i] = (b0 ? fg[2 * i + 1] : fg[2 * i]) + xsh(b0 ? fg[2 * i] : fg[2 * i + 1], 1);
#pragma unroll
    for (int i = 0; i < 2; ++i) h2[i] = (b1 ? g4[2 * i + 1] : g4[2 * i]) + xsh(b1 ? g4[2 * i] : g4[2 * i + 1], 2);
    float f = (b2 ? h2[1] : h2[0]) + xsh(b2 ? h2[0] : h2[1], 4);
    f = xadd(f, 8); f = xadd(f, 16); f = xadd(f, 32);
    if (lane < 8) FLOG[((size_t)(row >> 12) * 8 + lane) * SEQ + (row & (SEQ - 1))] = log_sigmoid(f * rstd + b_f[lane]);
}
__device__ __forceinline__ void rms1_rows4(const float4 (&v0)[4], const float4 (&v1)[4], const float4 (&v2)[4], const float4 (&v3)[4], const LAS float* wf, const float* __restrict__ b_f,
                                           bf16_t* __restrict__ XN, float* __restrict__ FLOG, float* __restrict__ RSTD1, int row, int rstep, int lane_) {
    int lane = lane_; asm volatile("" : "+v"(lane));
    float ss[4] = {0.f, 0.f, 0.f, 0.f};
#pragma unroll
    for (int j = 0; j < 4; ++j) { ss[0] += v0[j].x * v0[j].x + v0[j].y * v0[j].y + v0[j].z * v0[j].z + v0[j].w * v0[j].w; ss[1] += v1[j].x * v1[j].x + v1[j].y * v1[j].y + v1[j].z * v1[j].z + v1[j].w * v1[j].w;
        ss[2] += v2[j].x * v2[j].x + v2[j].y * v2[j].y + v2[j].z * v2[j].z + v2[j].w * v2[j].w; ss[3] += v3[j].x * v3[j].x + v3[j].y * v3[j].y + v3[j].z * v3[j].z + v3[j].w * v3[j].w; }
#pragma unroll
    for (int o = 1; o < 64; o <<= 1) { ss[0] = xadd(ss[0], o); ss[1] = xadd(ss[1], o); ss[2] = xadd(ss[2], o); ss[3] = xadd(ss[3], o); }
    float rstd[4];
#pragma unroll
    for (int i = 0; i < 4; ++i) { rstd[i] = rsqrtf(ss[i] * (1.f / DM) + EPS); if (lane == 0) RSTD1[row + i * rstep] = 1.f / rstd[i]; }
    float fg[4][8];
#pragma unroll
    for (int i = 0; i < 4; ++i)
#pragma unroll
        for (int g = 0; g < 8; ++g) fg[i][g] = 0.f;
#pragma unroll
    for (int j = 0; j < 4; ++j) {
        const int c0 = 4 * (lane + 64 * j);
#define R4_ST(i, vv) do { uint2 o; o.x = pk2(vv[j].x * rstd[i], vv[j].y * rstd[i]); o.y = pk2(vv[j].z * rstd[i], vv[j].w * rstd[i]); *(uint2*)(XN + (size_t)(row + (i) * rstep) * DM + c0) = o; } while (0)
        R4_ST(0, v0); R4_ST(1, v1); R4_ST(2, v2); R4_ST(3, v3);
#undef R4_ST
#pragma unroll
        for (int g = 0; g < 8; ++g) { const f32x4 w = *(const LAS f32x4*)(wf + g * DM + c0);
            fg[0][g] += v0[j].x * w[0] + v0[j].y * w[1] + v0[j].z * w[2] + v0[j].w * w[3]; fg[1][g] += v1[j].x * w[0] + v1[j].y * w[1] + v1[j].z * w[2] + v1[j].w * w[3];
            fg[2][g] += v2[j].x * w[0] + v2[j].y * w[1] + v2[j].z * w[2] + v2[j].w * w[3]; fg[3][g] += v3[j].x * w[0] + v3[j].y * w[1] + v3[j].z * w[2] + v3[j].w * w[3]; }
    }
    const bool b0 = lane & 1, b1 = lane & 2, b2 = lane & 4;
    float f[4];
#pragma unroll
    for (int i = 0; i < 4; ++i) { float g4[4], h2[2];
#pragma unroll
        for (int q = 0; q < 4; ++q) g4[q] = (b0 ? fg[i][2 * q + 1] : fg[i][2 * q]) + xsh(b0 ? fg[i][2 * q] : fg[i][2 * q + 1], 1);
#pragma unroll
        for (int q = 0; q < 2; ++q) h2[q] = (b1 ? g4[2 * q + 1] : g4[2 * q]) + xsh(b1 ? g4[2 * q] : g4[2 * q + 1], 2);
        f[i] = (b2 ? h2[1] : h2[0]) + xsh(b2 ? h2[0] : h2[1], 4); }
#pragma unroll
    for (int o = 8; o < 64; o <<= 1) { f[0] = xadd(f[0], o); f[1] = xadd(f[1], o); f[2] = xadd(f[2], o); f[3] = xadd(f[3], o); }
    if (lane < 8) { const float bf = b_f[lane];
#pragma unroll
        for (int i = 0; i < 4; ++i) { const int r_ = row + i * rstep; FLOG[((size_t)(r_ >> 12) * 8 + lane) * SEQ + (r_ & (SEQ - 1))] = log_sigmoid(f[i] * rstd[i] + bf); } }
}
__device__ __forceinline__ void cumsum_wg(const float* __restrict__ FLOG, float* __restrict__ CUM, int bh, LAS float* part) {
    const int t = threadIdx.x;
    float loc[8]; float s = 0.f;
    { const f32x4 q0 = *(const f32x4*)(FLOG + (size_t)bh * SEQ + t * 8), q1 = *(const f32x4*)(FLOG + (size_t)bh * SEQ + t * 8 + 4);
#pragma unroll
      for (int i = 0; i < 4; ++i) { loc[i] = q0[i]; loc[4 + i] = q1[i]; s += q0[i]; } s += q1[0] + q1[1] + q1[2] + q1[3]; }
    float inc = s;
    int ln_ = t & 63; asm volatile("" : "+v"(ln_));
#pragma unroll
    for (int o = 1; o < 64; o <<= 1) { const float up = __int_as_float(shfl_up_l(__float_as_int(inc), o, ln_)); if (ln_ >= o) inc += up; }
    if ((t & 63) == 63) part[t >> 6] = inc;
    LDS_WAIT(); __syncthreads();
    float run = inc - s;
    for (int w = 0; w < (t >> 6); ++w) run += part[w];
#pragma unroll
    for (int i = 0; i < 8; ++i) { run += loc[i]; CUM[(size_t)bh * SEQ + t * 8 + i] = run * LOG2E; }
    __syncthreads();
}

typedef float f32x16 __attribute__((ext_vector_type(16)));
__device__ __forceinline__ void router_wg(const float* __restrict__ X1, const float* __restrict__ WR, const float* __restrict__ b_router, float* __restrict__ RSTD2,
                                          float* __restrict__ RW, int* __restrict__ LIST, int* __restrict__ SLOTEP, unsigned* __restrict__ CNT, int tokbase, LAS unsigned char* L) {
    int tid_ = threadIdx.x; asm volatile("" : "+v"(tid_));
    const int tid = tid_, lane = tid & 63, wave = __builtin_amdgcn_readfirstlane(tid >> 6), kq = wave & 3, tile = wave >> 2, r32 = lane & 31, hi = lane >> 5;
    LAS float* Dx = (LAS float*)L; LAS float* SSx = (LAS float*)(L + 32768); LAS unsigned* lcnt = (LAS unsigned*)(L + 33792); LAS unsigned* lbase = (LAS unsigned*)(L + 33920);
    if (tid < NE) lcnt[tid] = 0u;
    const int tok = tokbase + tile * 32 + r32;
    const float* xp = X1 + (size_t)tok * DM + kq * 256 + 4 * hi;
    const float* wp = WR + (size_t)(kq * 256 + 4 * hi) * NE + r32;
    f32x16 acc;
#pragma unroll
    for (int r = 0; r < 16; ++r) acc[r] = 0.f;
    float ss = 0.f;
    if (ROUTER_BF3) {
        typedef short bf16x8r __attribute__((ext_vector_type(8)));
        const bf16_t* xq = (const bf16_t*)X1 + (size_t)tok * DM + kq * 256 + 8 * hi;
        const bf16_t* wq = (const bf16_t*)(WR + 65536) + (size_t)(kq * 16 * 3) * 512 + lane * 8;
        v4u xv[16], wa3[4][3], wb3[4][3];
#pragma unroll
        for (int m = 0; m < 16; ++m) xv[m] = *(const v4u*)(xq + m * 16);
#define RB_LOAD(wv, mc) do { _Pragma("unroll") for (int m = 0; m < 4; ++m) { _Pragma("unroll") for (int p = 0; p < 3; ++p) wv[m][p] = *(const v4u*)(wq + (size_t)((((mc) * 4 + m) * 3 + p) * 512)); } } while (0)
#define RB_MMA(wv, mc) do { _Pragma("unroll") for (int m = 0; m < 4; ++m) { const bf16x8r xf = __builtin_bit_cast(bf16x8r, xv[(mc) * 4 + m]); \
            _Pragma("unroll") for (int p = 0; p < 3; ++p) acc = __builtin_amdgcn_mfma_f32_32x32x16_bf16(__builtin_bit_cast(bf16x8r, wv[m][p]), xf, acc, 0, 0, 0); \
            _Pragma("unroll") for (int c = 0; c < 4; ++c) { const float lo = __uint_as_float(xv[(mc) * 4 + m][c] << 16), hi2 = __uint_as_float(xv[(mc) * 4 + m][c] & 0xffff0000u); ss += lo * lo + hi2 * hi2; } } } while (0)
        RB_LOAD(wa3, 0); RB_LOAD(wb3, 1);
        RB_MMA(wa3, 0); RB_LOAD(wa3, 2);
        RB_MMA(wb3, 1); RB_LOAD(wb3, 3);
        RB_MMA(wa3, 2); RB_MMA(wb3, 3);
#undef RB_LOAD
#undef RB_MMA
    } else {
    float4 xa[8], xb[8]; float wa_[32], wb_[32];
#define RT_LOAD(xv, wv, mc) do { _Pragma("unroll") for (int m = 0; m < 8; ++m) { \
            if (X1_BF16) { const uint2 q = *(const uint2*)((const bf16_t*)X1 + (size_t)tok * DM + kq * 256 + 4 * hi + ((mc) * 8 + m) * 8); \
                xv[m].x = __uint_as_float(q.x << 16); xv[m].y = __uint_as_float(q.x & 0xffff0000u); xv[m].z = __uint_as_float(q.y << 16); xv[m].w = __uint_as_float(q.y & 0xffff0000u); } \
            else xv[m] = *(const float4*)(xp + ((mc) * 8 + m) * 8); \
            const float* w4 = wp + (size_t)(((mc) * 8 + m) * 8) * NE; wv[4 * m] = w4[0]; wv[4 * m + 1] = w4[NE]; wv[4 * m + 2] = w4[2 * NE]; wv[4 * m + 3] = w4[3 * NE]; } } while (0)
#define RT_MMA(xv, wv) do { _Pragma("unroll") for (int m = 0; m < 8; ++m) { \
            acc = __builtin_amdgcn_mfma_f32_32x32x2f32(wv[4 * m], xv[m].x, acc, 0, 0, 0); acc = __builtin_amdgcn_mfma_f32_32x32x2f32(wv[4 * m + 1], xv[m].y, acc, 0, 0, 0); \
            acc = __builtin_amdgcn_mfma_f32_32x32x2f32(wv[4 * m + 2], xv[m].z, acc, 0, 0, 0); acc = __builtin_amdgcn_mfma_f32_32x32x2f32(wv[4 * m + 3], xv[m].w, acc, 0, 0, 0); \
            ss += xv[m].x * xv[m].x + xv[m].y * xv[m].y + xv[m].z * xv[m].z + xv[m].w * xv[m].w; } } while (0)
    RT_LOAD(xa, wa_, 0); RT_LOAD(xb, wb_, 1);
    RT_MMA(xa, wa_); RT_LOAD(xa, wa_, 2);
    RT_MMA(xb, wb_); RT_LOAD(xb, wb_, 3);
    RT_MMA(xa, wa_); RT_MMA(xb, wb_);
#undef RT_LOAD
#undef RT_MMA
    }
    { auto rr = __builtin_amdgcn_permlane32_swap(__float_as_uint(ss), __float_as_uint(ss), false, false); ss = __uint_as_float(rr[0]) + __uint_as_float(rr[1]); }
#pragma unroll
    for (int r = 0; r < 16; ++r) Dx[(wave * 16 + r) * 64 + lane] = acc[r];
    if (hi == 0) SSx[wave * 32 + r32] = ss;
    LDS_WAIT(); __syncthreads();
    int ea = 0, eb = 0; float wa = 0.f, wb = 0.f; unsigned la = 0u, lb = 0u;
    if (kq == 0) {
        float v[16]; float sst = 0.f;
#pragma unroll
        for (int w = 0; w < 4; ++w) sst += SSx[(tile * 4 + w) * 32 + r32];
        const float rstd = rsqrtf(sst * (1.f / DM) + EPS);
#pragma unroll
        for (int r = 0; r < 16; ++r) { float a = 0.f;
#pragma unroll
            for (int w = 0; w < 4; ++w) a += Dx[((tile * 4 + w) * 16 + r) * 64 + lane];
            v[r] = a * rstd + b_router[(r & 3) + 8 * (r >> 2) + 4 * hi]; }
        if (hi == 0) RSTD2[tok] = rstd;
        float tv[4]; int te[4];
#pragma unroll
        for (int k = 0; k < 4; ++k) {
            float bv = v[0]; int br = 0;
#pragma unroll
            for (int r = 1; r < 16; ++r) if (v[r] > bv) { bv = v[r]; br = r; }
            const int be = (br & 3) + 8 * (br >> 2) + 4 * hi;
            auto r1 = __builtin_amdgcn_permlane32_swap(__float_as_uint(bv), __float_as_uint(bv), false, false);
            auto r2 = __builtin_amdgcn_permlane32_swap((unsigned)be, (unsigned)be, false, false);
            const float pv = __uint_as_float(hi ? r1[0] : r1[1]); const int pe = (int)(hi ? r2[0] : r2[1]);
            const bool mine = (bv > pv) || (bv == pv && be < pe);
            tv[k] = mine ? bv : pv; te[k] = mine ? be : pe;
#pragma unroll
            for (int r = 0; r < 16; ++r) v[r] = (mine && r == br) ? -INFINITY : v[r];
        }
        const float e1 = expf(tv[1] - tv[0]), e2 = expf(tv[2] - tv[0]), e3 = expf(tv[3] - tv[0]); const float inv = 1.f / (1.f + e1 + e2 + e3);
        ea = hi ? te[2] : te[0]; eb = hi ? te[3] : te[1]; wa = (hi ? e2 : 1.f) * inv; wb = (hi ? e3 : e1) * inv;
        la = atomicAdd((unsigned*)&lcnt[ea], 1u); lb = atomicAdd((unsigned*)&lcnt[eb], 1u);
    }
    LDS_WAIT(); __syncthreads();
    if (tid < NE) { const unsigned c = lcnt[tid]; lbase[tid] = c ? atomicAdd(&CNT[tid], c) : 0u; }
    LDS_WAIT(); __syncthreads();
    if (kq == 0) {
        const int sa = tok * 4 + 2 * hi, sb = sa + 1;
        const int pa = (int)(lbase[ea] + la), pb = (int)(lbase[eb] + lb);
        LIST[(size_t)ea * LIST_CAP + pa] = sa; RW[sa] = wa; SLOTEP[sa] = ea * 16384 + pa;
        LIST[(size_t)eb * LIST_CAP + pb] = sb; RW[sb] = wb; SLOTEP[sb] = eb * 16384 + pb;
    }
    LDS_WAIT(); __syncthreads();
}

template <bool PRE> __device__ __forceinline__ void final_row(const float* X1, const bf16_t* __restrict__ Y, const int* __restrict__ SLOTEP, const int* __restrict__ TBG, const float* __restrict__ gf, float* out, int row, int lane, int y0 = 0, int y1 = 0, int y2 = 0, int y3 = 0) {
    int yr[4];
    if (PRE) { yr[0] = y0; yr[1] = y1; yr[2] = y2; yr[3] = y3; } else {
#pragma unroll
    for (int k = 0; k < 4; ++k) { const int ep = SLOTEP[row * 4 + k]; yr[k] = TBG[ep >> 14] * 256 + (ep & 16383); } }
    float ss = 0.f;
    if (Y_F8) {
        const int c0 = 16 * lane; f32x4 v[4];
        if (X1_BF16) { const v4u q0 = *(const v4u*)((const bf16_t*)X1 + (size_t)row * DM + c0), q1 = *(const v4u*)((const bf16_t*)X1 + (size_t)row * DM + c0 + 8);
#pragma unroll
            for (int j = 0; j < 2; ++j) { v[j][0] = __uint_as_float(q0[2 * j] << 16); v[j][1] = __uint_as_float(q0[2 * j] & 0xffff0000u); v[j][2] = __uint_as_float(q0[2 * j + 1] << 16); v[j][3] = __uint_as_float(q0[2 * j + 1] & 0xffff0000u);
                v[2 + j][0] = __uint_as_float(q1[2 * j] << 16); v[2 + j][1] = __uint_as_float(q1[2 * j] & 0xffff0000u); v[2 + j][2] = __uint_as_float(q1[2 * j + 1] << 16); v[2 + j][3] = __uint_as_float(q1[2 * j + 1] & 0xffff0000u); } }
        else
#pragma unroll
        for (int j = 0; j < 4; ++j) v[j] = *(const f32x4*)(X1 + (size_t)row * DM + c0 + 4 * j);
#pragma unroll
        for (int k = 0; k < 4; ++k) { const v4u y = *(const v4u*)((const unsigned char*)Y + (size_t)yr[k] * DM + c0);
#pragma unroll
            for (int j = 0; j < 4; ++j) { const auto lo = __builtin_amdgcn_cvt_pk_f32_fp8((int)y[j], false), hi = __builtin_amdgcn_cvt_pk_f32_fp8((int)y[j], true);
                v[j][0] += lo[0] * 0.0625f; v[j][1] += lo[1] * 0.0625f; v[j][2] += hi[0] * 0.0625f; v[j][3] += hi[1] * 0.0625f; } }
#pragma unroll
        for (int j = 0; j < 4; ++j) ss += v[j][0] * v[j][0] + v[j][1] * v[j][1] + v[j][2] * v[j][2] + v[j][3] * v[j][3];
        ss = wave_sum(ss);
        const float rstd = rsqrtf(ss * (1.f / DM) + EPS);
#pragma unroll
        for (int j = 0; j < 4; ++j) { const f32x4 g = *(const f32x4*)(gf + c0 + 4 * j); *(f32x4*)(out + (size_t)row * DM + c0 + 4 * j) = v[j] * rstd * g; }
        return;
    }
    float4 v[4];
#pragma unroll
    for (int j = 0; j < 4; ++j) {
        const int c0 = 4 * (lane + 64 * j);
        v[j] = *(const float4*)(X1 + (size_t)row * DM + c0);
#pragma unroll
        for (int k = 0; k < 4; ++k) { const uint2 y = *(const uint2*)(Y + (size_t)yr[k] * DM + c0);
            v[j].x += bf2f((unsigned short)(y.x & 0xffff)); v[j].y += bf2f((unsigned short)(y.x >> 16)); v[j].z += bf2f((unsigned short)(y.y & 0xffff)); v[j].w += bf2f((unsigned short)(y.y >> 16)); }
        ss += v[j].x * v[j].x + v[j].y * v[j].y + v[j].z * v[j].z + v[j].w * v[j].w;
    }
    ss = wave_sum(ss);
    const float rstd = rsqrtf(ss * (1.f / DM) + EPS);
#pragma unroll
    for (int j = 0; j < 4; ++j) { const int c0 = 4 * (lane + 64 * j); const float4 g = *(const float4*)(gf + c0);
        float4 o; o.x = v[j].x * rstd * g.x; o.y = v[j].y * rstd * g.y; o.z = v[j].z * rstd * g.z; o.w = v[j].w * rstd * g.w; *(float4*)(out + (size_t)row * DM + c0) = o; }
}


namespace pg8 {
#define PG8_LAS __attribute__((address_space(3)))
typedef unsigned u32x4 __attribute__((ext_vector_type(4)));
typedef unsigned u32x2 __attribute__((ext_vector_type(2)));
typedef int i32x8 __attribute__((ext_vector_type(8)));
constexpr int BM = 256, BK = 64, HALF = 128, HTB = HALF * BK * 2  , STAGE_BYTES = 8 * HTB, NXCD = 8, WGM = 8;
__host__ __device__ __forceinline__ int lds_byte(int r, int c) { const int st = (r >> 4) * 2 + (c >> 5), rr = r & 15, cc = c & 31, ob = rr * 64 + cc * 2; return st * 1024 + (ob ^ (((ob >> 9) & 1) << 5)); }
__host__ __device__ __forceinline__ void stage_rc(int b, int& R, int& C) { const int st = b / 1024, sb = b % 1024, swz = sb ^ (((sb >> 9) & 1) << 5); R = (st >> 1) * 16 + swz / 64; C = (st & 1) * 32 + (swz % 64) / 2; }
__host__ __device__ __forceinline__ int perm32(int rho) { const int n = rho >> 4, i = rho & 15; return 8 * (i >> 2) + 4 * n + (i & 3); }
struct Unit { int pm, pn, nr; };
struct Gemm { const bf16_t* A; const bf16_t* Bt; int K; unsigned Bkb; };
__device__ __forceinline__ void st16_wt(void* p, u32x4 v) { if (WT_STORES) asm volatile("global_store_dwordx4 %0, %1, off sc1\n\ts_nop 1" :: "v"(p), "v"(v) : "memory"); else *(u32x4*)p = v; }
__device__ __forceinline__ void st8_wt(void* p, u32x2 v) { if (WT_STORES) asm volatile("global_store_dwordx2 %0, %1, off sc1" :: "v"(p), "v"(v) : "memory"); else *(u32x2*)p = v; }
struct StaticOrder {
    int nM, nN, nwg, G, c;
    __device__ void init(int M_, int N_, int G_, int c_) { nM = M_ / BM; nN = N_ / BM; nwg = nM * nN; G = G_; c = c_; }
    __device__ bool next(int i, Unit& u) const {
        const long L = (long)i * G + c; if (L >= nwg) return false;
        int wgid = (int)L; { const int q = nwg / NXCD, r = nwg % NXCD, xcd = wgid % NXCD, off = wgid / NXCD; wgid = (xcd < r ? xcd * (q + 1) : r * (q + 1) + (xcd - r) * q) + off; }
        const int nig = WGM * nN, gid = wgid / nig, fm = gid * WGM, gsz = (nM - fm) < WGM ? (nM - fm) : WGM;
        u.pm = fm + ((wgid % nig) % gsz); u.pn = (wgid % nig) / gsz; u.nr = BM; return true;
    }
    __device__ __forceinline__ const PG8_LAS int* rowtab(int) const { return nullptr; }
};
__device__ __forceinline__ unsigned cvt_pk_bf16(float lo, float hi) { unsigned r; asm volatile("v_cvt_pk_bf16_f32 %0, %1, %2" : "=v"(r) : "v"(lo), "v"(hi)); return r; }

template <class Sched> __device__ __forceinline__ void gather_voffs(const Sched& S, int ui, int tid, int K, unsigned (&o0)[2], unsigned (&o1)[2]) {
    const PG8_LAS int* tab = S.rowtab(ui);
#pragma unroll
    for (int i = 0; i < 2; ++i) { int R, C; stage_rc(tid * 16 + i * 8192, R, C); o0[i] = (unsigned)((tab[R] & 0xffff) * K + C) * 2u; o1[i] = (unsigned)((tab[HALF + R] & 0xffff) * K + C) * 2u; }
}

template <class Epi, class Sched, bool ALIGN_EPI, bool GATHER, bool F8 = false, int SKIPRD = 0, bool BLKB = false>
__device__ __forceinline__ void gemm_phase(PG8_LAS unsigned char* lds, const Gemm g, const Sched& S, const Epi& E) {
    int tid_ = threadIdx.x; asm volatile("" : "+v"(tid_));
    const int tid = tid_, wid = __builtin_amdgcn_readfirstlane(tid >> 6), lane = tid & 63, wr = wid >> 2, wc = wid & 3, fr = lane & 15, fq = lane >> 4;
    const int K = g.K, nt = K / BK;
    unsigned vA0[2], vA1[2], wA0[2], wA1[2], voffB[2];
    const size_t kstep = (size_t)(BK * 2);
    const size_t hstep = (size_t)HALF * K * 2;
    const size_t tstep = 2 * hstep;
    const size_t kstepB = BLKB ? 2 * (size_t)g.Bkb : kstep, hstepB = BLKB ? (size_t)HALF * 64 : hstep, tstepB = 2 * hstepB;
#pragma unroll
    for (int i = 0; i < 2; ++i) { int R, C; stage_rc(tid * 16 + i * 8192, R, C); const int Rb = Epi::PERM ? ((R & ~31) + perm32(R & 31)) : R;
        vA0[i] = (unsigned)(R * K + C) * 2u; vA1[i] = vA0[i] + (unsigned)hstep; voffB[i] = BLKB ? (unsigned)(Rb * 64 + (C & 31) * 2) + (unsigned)(C >> 5) * g.Bkb : (unsigned)(Rb * K + C) * 2u; wA0[i] = vA0[i]; wA1[i] = vA1[i]; }
    const unsigned ldsw = (unsigned)wid * 1024u;
    const int aoff = lds_byte(wr * 64 + fr, fq * 8), boff = lds_byte(wc * 32 + fr, fq * 8);
    const int a8o0 = lds_byte(wr * 64 + fr, fq * 16), a8o1 = lds_byte(wr * 64 + fr, fq * 16 + 8), b8o0 = lds_byte(wc * 32 + fr, fq * 16), b8o1 = lds_byte(wc * 32 + fr, fq * 16 + 8);
#define PG8_SA(b, h) (((b) * 2 + (h)) * HTB)
#define PG8_SB(b, h) ((4 + (b) * 2 + (h)) * HTB)
#define PG8_STAGE(bufoff, gbase, voff) do { _Pragma("unroll") for (int _i = 0; _i < 2; ++_i) \
        __builtin_amdgcn_global_load_lds((const unsigned*)((const char*)(gbase) + (voff)[_i]), (PG8_LAS unsigned*)(lds + (bufoff) + ldsw + _i * 8192), 16, 0, 0); } while (0)
#define PG8_LDA_BF(dst, b, h) do { _Pragma("unroll") for (int m = 0; m < 4; ++m) _Pragma("unroll") for (int k = 0; k < 2; ++k) dst[m][k] = *(const PG8_LAS bf16x8*)(lds + PG8_SA(b, h) + aoff + m * 2048 + k * 1024); } while (0)
#define PG8_LDB_BF(dst, b, h) do { _Pragma("unroll") for (int n = 0; n < 2; ++n) _Pragma("unroll") for (int k = 0; k < 2; ++k) dst[n][k] = *(const PG8_LAS bf16x8*)(lds + PG8_SB(b, h) + boff + n * 2048 + k * 1024); } while (0)
#define PG8_MMA_BF(ai, bj, At, Bt) do { if (cur.nr > 128 * (ai) + 64 * wr) { __builtin_amdgcn_s_setprio(1); _Pragma("unroll") for (int m = 0; m < 4; ++m) _Pragma("unroll") for (int n = 0; n < 2; ++n) _Pragma("unroll") for (int k = 0; k < 2; ++k) \
        acc[ai][bj][m][n] = __builtin_amdgcn_mfma_f32_16x16x32_bf16(Bt[n][k], At[m][k], acc[ai][bj][m][n], 0, 0, 0); __builtin_amdgcn_s_setprio(0); } } while (0)
#define PG8_LD8(dst, i_, base_, o0_, o1_) do { const u32x4 lo_ = *(const PG8_LAS u32x4*)(lds + (base_) + (o0_) + (i_) * 2048), hi_ = *(const PG8_LAS u32x4*)(lds + (base_) + (o1_) + (i_) * 2048); \
        dst[i_] = (i32x8){(int)lo_.x, (int)lo_.y, (int)lo_.z, (int)lo_.w, (int)hi_.x, (int)hi_.y, (int)hi_.z, (int)hi_.w}; } while (0)
#define PG8_LDA_F8(dst, b, h) do { _Pragma("unroll") for (int m = 0; m < 4; ++m) PG8_LD8(dst, m, PG8_SA(b, h), a8o0, a8o1); } while (0)
#define PG8_LDB_F8(dst, b, h) do { _Pragma("unroll") for (int n = 0; n < 2; ++n) PG8_LD8(dst, n, PG8_SB(b, h), b8o0, b8o1); } while (0)
#define PG8_MMA_F8(ai, bj, At, Bt) do { if (cur.nr > 128 * (ai) + 64 * wr) { __builtin_amdgcn_s_setprio(1); _Pragma("unroll") for (int m = 0; m < 4; ++m) _Pragma("unroll") for (int n = 0; n < 2; ++n) \
        acc[ai][bj][m][n] = __builtin_amdgcn_mfma_scale_f32_16x16x128_f8f6f4(Bt[n], At[m], acc[ai][bj][m][n], 0, 0, 0, 0x7A7A7A7A  , 0, 0x7F7F7F7F  ); __builtin_amdgcn_s_setprio(0); } } while (0)
#define PG8_LDA(dst, b, h) do { if (SKIPRD < 1 || cur.nr > 128 * (h) + 64 * wr) { if constexpr (F8) { PG8_LDA_F8(dst##8, b, h); } else { PG8_LDA_BF(dst, b, h); } } } while (0)
#define PG8_LDB(dst, b, h) do { if (SKIPRD < 2 || cur.nr > 64 * wr) { if constexpr (F8) { PG8_LDB_F8(dst##8, b, h); } else { PG8_LDB_BF(dst, b, h); } } } while (0)
#define PG8_MMA(ai, bj, At, Bt) do { if constexpr (F8) { PG8_MMA_F8(ai, bj, At##8, Bt##8); } else { PG8_MMA_BF(ai, bj, At, Bt); } } while (0)
#define PG8_WAIT_V(n) asm volatile("s_waitcnt vmcnt(" #n ")" ::: "memory")
#define PG8_WAIT_L(n) asm volatile("s_waitcnt lgkmcnt(" #n ")" ::: "memory")
#define PG8_BAR __builtin_amdgcn_s_barrier()
#define PG8_SCHED __builtin_amdgcn_sched_barrier(0)
    Unit cur, nxt, prv; int ui = 0; bool has_prv = false;
    if (!S.next(0, cur)) return;
    if constexpr (Epi::WAITA) { if (tid == 0) E.wait_ready(cur); __syncthreads(); }
    f32x4 acc[2][2][4][2];
#pragma unroll
    for (int a = 0; a < 2; ++a)
#pragma unroll
        for (int b = 0; b < 2; ++b)
#pragma unroll
            for (int m = 0; m < 4; ++m)
#pragma unroll
                for (int n = 0; n < 2; ++n) acc[a][b][m][n] = (f32x4){0.f, 0.f, 0.f, 0.f};
    bf16x8 At[4][2], B0[2][2], B1[2][2]; i32x8 At8[4], B08[2], B18[2];
    const char* cA = GATHER ? (const char*)g.A : (const char*)g.A + (size_t)cur.pm * tstep; const char* cB = (const char*)g.Bt + (size_t)cur.pn * tstepB;
    if constexpr (GATHER) gather_voffs(S, 0, tid, K, vA0, vA1);
    PG8_STAGE(PG8_SB(0, 0), cB, voffB); PG8_STAGE(PG8_SB(0, 1), cB + hstepB, voffB); PG8_STAGE(PG8_SA(0, 0), cA, vA0); PG8_STAGE(PG8_SA(0, 1), cA, vA1);
    if constexpr (Epi::PRE) E.pre(cur);
    if (wr == 1) PG8_BAR;
    PG8_WAIT_V(2); PG8_BAR;
    PG8_STAGE(PG8_SB(1, 0), cB + kstepB, voffB); PG8_STAGE(PG8_SA(1, 0), cA + kstep, vA0); PG8_STAGE(PG8_SB(1, 1), cB + hstepB + kstepB, voffB);
    PG8_WAIT_V(6); PG8_BAR;
    for (;;) {
        const bool has_next = S.next(ui + 1, nxt);
        if constexpr (Epi::WAITA) { if (has_next && tid == 0) E.wait_ready(nxt); }
        const char* nA = GATHER ? cA : (has_next ? (const char*)g.A + (size_t)nxt.pm * tstep : cA); const char* nB = has_next ? (const char*)g.Bt + (size_t)nxt.pn * tstepB : cB;
        if constexpr (GATHER) { if (has_next) gather_voffs(S, ui + 1, tid, K, wA0, wA1); else { wA0[0] = vA0[0]; wA0[1] = vA0[1]; wA1[0] = vA1[0]; wA1[1] = vA1[1]; } }
        for (int t = 0; t < nt; t += 2) {
            const bool last = (t == nt - 2);
            const char* a1 = cA + (size_t)(t + 1) * kstep;
            const char* a2 = last ? nA : cA + (size_t)(t + 2) * kstep; const char* b2 = last ? nB : cB + (size_t)(t + 2) * kstepB;
            const char* a3 = a2 + kstep; const char* b3 = b2 + kstepB;
            unsigned sA0[2], sA1[2];
#pragma unroll
            for (int i = 0; i < 2; ++i) { sA0[i] = (GATHER && last) ? wA0[i] : vA0[i]; sA1[i] = (GATHER && last) ? wA1[i] : vA1[i]; }
            if constexpr (Epi::MIDK) { if (t == nt / 2) E.midk(acc, wr, fr); }
            PG8_LDB(B0, 0, 0); PG8_LDB(B1, 0, 1); PG8_SCHED; PG8_LDA(At, 0, 0); PG8_STAGE(PG8_SA(1, 1), a1, vA1);
            PG8_WAIT_V(8); PG8_WAIT_L(0); PG8_BAR; PG8_MMA(0, 0, At, B0); PG8_MMA(0, 1, At, B1); PG8_BAR; PG8_SCHED;
            PG8_LDA(At, 0, 1); PG8_STAGE(PG8_SB(0, 0), b2, voffB); PG8_STAGE(PG8_SB(0, 1), b2 + hstepB, voffB); PG8_STAGE(PG8_SA(0, 0), a2, sA0);
            PG8_WAIT_V(8); PG8_WAIT_L(0); PG8_BAR; PG8_MMA(1, 0, At, B0); PG8_MMA(1, 1, At, B1); PG8_BAR; PG8_SCHED;
            PG8_LDB(B0, 1, 0); PG8_LDB(B1, 1, 1); PG8_SCHED; PG8_LDA(At, 1, 0); PG8_STAGE(PG8_SA(0, 1), a2, sA1);
            PG8_WAIT_V(8); PG8_WAIT_L(0); PG8_BAR; PG8_MMA(0, 0, At, B0); PG8_MMA(0, 1, At, B1); PG8_BAR; PG8_SCHED;
            PG8_LDA(At, 1, 1); PG8_STAGE(PG8_SB(1, 0), b3, voffB); PG8_STAGE(PG8_SB(1, 1), b3 + hstepB, voffB); PG8_STAGE(PG8_SA(1, 0), a3, sA0);
            PG8_WAIT_V(8); PG8_WAIT_L(0); PG8_BAR; PG8_MMA(1, 0, At, B0); PG8_MMA(1, 1, At, B1); PG8_BAR; PG8_SCHED;
        }
        if constexpr (ALIGN_EPI) { if (wr == 0) PG8_BAR; }
        if constexpr (Epi::SIGNAL) { if (has_prv && tid == 0) E.signal(prv); prv = cur; has_prv = true; }
        E(acc, cur, ui, wr, wc, fr, fq);
        if (!has_next) break;
#pragma unroll
        for (int a = 0; a < 2; ++a)
#pragma unroll
            for (int b = 0; b < 2; ++b)
#pragma unroll
                for (int m = 0; m < 4; ++m)
#pragma unroll
                    for (int n = 0; n < 2; ++n) acc[a][b][m][n] = (f32x4){0.f, 0.f, 0.f, 0.f};
        cur = nxt; cA = nA; cB = nB; ++ui;
        if constexpr (GATHER) { vA0[0] = wA0[0]; vA0[1] = wA0[1]; vA1[0] = wA1[0]; vA1[1] = wA1[1]; }
        if constexpr (ALIGN_EPI) { if (wr == 1) PG8_BAR; }
    }
    PG8_WAIT_V(0);
    if constexpr (!ALIGN_EPI) { if (wr == 0) PG8_BAR; }
    PG8_BAR;
    if constexpr (Epi::SIGNAL) { if (has_prv && tid == 0) E.signal(prv); }
#undef PG8_SA
#undef PG8_SB
#undef PG8_STAGE
#undef PG8_LDA
#undef PG8_LDB
#undef PG8_MMA
#undef PG8_LDA_BF
#undef PG8_LDB_BF
#undef PG8_MMA_BF
#undef PG8_LD8
#undef PG8_LDA_F8
#undef PG8_LDB_F8
#undef PG8_MMA_F8
#undef PG8_WAIT_V
#undef PG8_WAIT_L
#undef PG8_BAR
#undef PG8_SCHED
}

struct EpiProj {
    static constexpr bool PERM = true, MIDK = false, SIGNAL = false, WAITA = false, PRE = false;
    bf16_t* O; unsigned* hp;
    __device__ __forceinline__ void operator()(const f32x4 (&acc)[2][2][4][2], const Unit& u, int, int wr, int wc, int fr, int fq) const {
        const int row0 = u.pm * BM + wr * 64 + fr, col0 = u.pn * BM + wc * 32 + 8 * fq;
        const float sc = (u.pn < 2 || (u.pn >= 6 && u.pn < 8)) ? C2 : 1.f;
        if (u.pn < 4) {
            float mx = 0.f;
#pragma unroll
            for (int ai = 0; ai < 2; ++ai)
#pragma unroll
                for (int m = 0; m < 4; ++m)
#pragma unroll
                    for (int bj = 0; bj < 2; ++bj) { const f32x4 a0 = acc[ai][bj][m][0] * sc, a1 = acc[ai][bj][m][1] * sc;
                        float q = a0[0] * a0[0] + a0[1] * a0[1] + a0[2] * a0[2] + a0[3] * a0[3] + a1[0] * a1[0] + a1[1] * a1[1] + a1[2] * a1[2] + a1[3] * a1[3];
                        q = xadd(q, 16); q = xadd(q, 32); mx = fmaxf(mx, q); }
#pragma unroll
            for (int o = 1; o < 16; o <<= 1) mx = fmaxf(mx, xsh(mx, o));
            if ((threadIdx.x & 63) == 0) atomicMax(hp + (u.pn < 2 ? 0 : 64), __float_as_uint(mx));
        }
#pragma unroll
        for (int ai = 0; ai < 2; ++ai)
#pragma unroll
            for (int m = 0; m < 4; ++m) { bf16_t* rowp = O + (size_t)(row0 + ai * HALF + m * 16) * NPROJ + col0;
#pragma unroll
                for (int bj = 0; bj < 2; ++bj) { const f32x4 v0 = acc[ai][bj][m][0] * sc, v1 = acc[ai][bj][m][1] * sc;
                    u32x4 w; w.x = cvt_pk_bf16(v0[0], v0[1]); w.y = cvt_pk_bf16(v0[2], v0[3]); w.z = cvt_pk_bf16(v1[0], v1[1]); w.w = cvt_pk_bf16(v1[2], v1[3]);
                    st16_wt(rowp + bj * HALF, w); } }
    }
};
struct EpiWout {
    static constexpr bool PERM = true, MIDK = true, SIGNAL = false, WAITA = false, PRE = true;
    const float* SSQ; const float* RSTD1;
    __device__ __forceinline__ void pre(const Unit& u) const { const int tid = threadIdx.x;
        if (tid < 256) { const float* sp = SSQ + (size_t)(u.pm * 256 + tid) * 16; float sf = 0.f, s2 = 0.f;
#pragma unroll
            for (int h = 0; h < 8; ++h) { sf += sp[h]; s2 += sp[8 + h]; }
            const float rf = rsqrtf(sf * (1.f / GW) + EPS), rs_ = rsqrtf(s2 * (1.f / GW) + EPS); PG8_LAS float* rt = (PG8_LAS float*)ratio; PG8_LAS float* rw = (PG8_LAS float*)rs;
            rt[tid] = rf / rs_; rw[tid] = rs_; rw[256 + tid] = RSTD1[u.pm * 256 + tid]; }
        asm volatile("s_waitcnt lgkmcnt(0)" ::: "memory"); }
    const float* x; float* X1; bf16_t* X1B; const PG8_LAS float* ratio; const PG8_LAS float* rs;
    __device__ __forceinline__ void midk(f32x4 (&acc)[2][2][4][2], int wr, int fr) const {
#pragma unroll
        for (int ai = 0; ai < 2; ++ai)
#pragma unroll
            for (int m = 0; m < 4; ++m) { const float f = ratio[ai * HALF + wr * 64 + m * 16 + fr];
#pragma unroll
                for (int bj = 0; bj < 2; ++bj)
#pragma unroll
                    for (int n = 0; n < 2; ++n) acc[ai][bj][m][n] *= f; }
    }
    static constexpr int NPF = 4;
    __device__ __forceinline__ void operator()(const f32x4 (&acc)[2][2][4][2], const Unit& u, int, int wr, int wc, int fr, int fq) const {
        static_assert(!X_FROM_XN, "the prefetching epilogue reads the f32 residual");
        const int col0 = u.pn * BM + wc * 32 + 8 * fq;
        f32x4 xr[NPF][4]; u32x2 wp8[2] = {{0u, 0u}, {0u, 0u}};
#define EW_OFF(it) ((size_t)(u.pm * BM + ((it) >> 2) * HALF + wr * 64 + ((it) & 3) * 16 + fr) * DM + col0)
#define EW_LOAD(it) do { const float* xp_ = x + EW_OFF(it); xr[(it) % NPF][0] = *(const f32x4*)(xp_); xr[(it) % NPF][1] = *(const f32x4*)(xp_ + 4); xr[(it) % NPF][2] = *(const f32x4*)(xp_ + HALF); xr[(it) % NPF][3] = *(const f32x4*)(xp_ + HALF + 4); } while (0)
#pragma unroll
        for (int it = 0; it < NPF; ++it) EW_LOAD(it);
#pragma unroll
        for (int it = 0; it < 8; ++it) { const int ai = it >> 2, m = it & 3, r = ai * HALF + wr * 64 + m * 16 + fr; const float s = rs[r]; const size_t off = EW_OFF(it);
#pragma unroll
            for (int bj = 0; bj < 2; ++bj) { const f32x4 o0 = xr[it % NPF][2 * bj] + acc[ai][bj][m][0] * s, o1 = xr[it % NPF][2 * bj + 1] + acc[ai][bj][m][1] * s;
                if (X1_BF16) { u32x4 w; w.x = cvt_pk_bf16(o0[0], o0[1]); w.y = cvt_pk_bf16(o0[2], o0[3]); w.z = cvt_pk_bf16(o1[0], o1[1]); w.w = cvt_pk_bf16(o1[2], o1[3]); *(u32x4*)((bf16_t*)X1 + off + bj * HALF) = w; }
                else { *(f32x4*)(X1 + off + bj * HALF) = o0; *(f32x4*)(X1 + off + bj * HALF + 4) = o1; }
                if (MOE_F8) { u32x2 w; w.x = pk4_fp8(o0[0], o0[1], o0[2], o0[3]); w.y = pk4_fp8(o1[0], o1[1], o1[2], o1[3]);
                    if (WIDE_ST) {
                        if ((it & 1) == 0) wp8[bj] = w;
                        else { u32x2 a = wp8[bj]; { auto rx = __builtin_amdgcn_permlane16_swap(a.x, w.x, false, false); a.x = rx[0]; w.x = rx[1]; auto ry = __builtin_amdgcn_permlane16_swap(a.y, w.y, false, false); a.y = ry[0]; w.y = ry[1]; }
                            const int mo = fq & 1; *(u32x4*)((unsigned char*)X1B + off - (size_t)(16 - 16 * mo) * DM - 8 * mo + bj * HALF) = (u32x4){a.x, a.y, w.x, w.y}; } }
                    else *(u32x2*)((unsigned char*)X1B + off + bj * HALF) = w; }
                else { u32x4 w; w.x = cvt_pk_bf16(o0[0], o0[1]); w.y = cvt_pk_bf16(o0[2], o0[3]); w.z = cvt_pk_bf16(o1[0], o1[1]); w.w = cvt_pk_bf16(o1[2], o1[3]); *(u32x4*)(X1B + off + bj * HALF) = w; } }
            if (it + NPF < 8) EW_LOAD(it + NPF); }
#undef EW_LOAD
#undef EW_OFF
    }
};
constexpr int MOE_MAXU = 10;
struct MoeOrder {
    int NT, c, j0; const PG8_LAS int* tb; const PG8_LAS int* tbE; const PG8_LAS int* tbC; const PG8_LAS int* cnt; const PG8_LAS int* tabA;
    __device__ bool next(int i, Unit& u) const {
        if (i >= MOE_MAXU) return false;
        const int x = c & 7, j = ((c >> 3) - j0 + 32) & 31, UE = tbE[32] * NT, UC = tbC[32] * NT;
        const int qE = UE >> 3, rE = UE & 7, sE = x * qE + (x < rE ? x : rE), nE = qE + (x < rE ? 1 : 0);
        const int qC = UC >> 3, rC = UC & 7, sC = x * qC + (x < rC ? x : rC), nC = qC + (x < rC ? 1 : 0);
        const int nEj = (j < nE) ? ((nE - j + 31) >> 5) : 0;
        if (i < nEj) {
            const int f = sE + i * 32 + j; int e = 0; while (f >= tbE[e + 1] * NT) ++e;
            const int idx = f - tbE[e] * NT, nte = tbE[e + 1] - tbE[e], pg = idx / (4 * nte), rem2 = idx - pg * 4 * nte, mt = rem2 >> 2;
            u.pm = tb[e] + mt; u.pn = e * NT + pg * 4 + (rem2 & 3); const int left = cnt[e] - 256 * mt; u.nr = left < BM ? left : BM;
        } else {
            const int jj = (j - (nE & 31) + 32) & 31, lc = (i - nEj) * 32 + jj; if (lc >= nC) return false;
            const int f = sC + lc; int e = 0; while (f >= tbC[e + 1] * NT) ++e;
            const int mt = tbE[e + 1] - tbE[e]; u.pm = tb[e] + mt; u.pn = e * NT + (f - tbC[e] * NT); u.nr = cnt[e] - 256 * mt;
        }
        return true;
    }
    __device__ __forceinline__ const PG8_LAS int* rowtab(int ui) const { return tabA + ui * 256; }
};
struct EpiMoe1 {
    static constexpr bool PERM = true, MIDK = false, SIGNAL = MERGE56, WAITA = false, PRE = false;
    unsigned* done;
    __device__ __forceinline__ void signal(const Unit& u) const { (void)xb_add(done + u.pm, 1u); }
    bf16_t* H; const PG8_LAS int* rowtab; const PG8_LAS float* btab;
    __device__ __forceinline__ void operator()(const f32x4 (&acc)[2][2][4][2], const Unit& u, int ui, int wr, int wc, int fr, int fq) const {
        const int pl = u.pn & 7, cl = wc * 32 + 8 * fq, colA = pl * 128 + cl;
        f32x4 bg[2], bl[2]; u32x2 wprev = {0u, 0u};
#pragma unroll
        for (int n = 0; n < 2; ++n) { bg[n] = *(const PG8_LAS f32x4*)(btab + ui * 256 + cl + 4 * n); bl[n] = *(const PG8_LAS f32x4*)(btab + ui * 256 + 128 + cl + 4 * n); }
#pragma unroll
        for (int ai = 0; ai < 2; ++ai)
#pragma unroll
            for (int m = 0; m < 4; ++m) { if (u.nr <= ai * HALF + wr * 64) continue;
                const int r = ai * HALF + wr * 64 + m * 16 + fr; const float rs = __uint_as_float((unsigned)rowtab[ui * 256 + r] & 0xffff0000u);
                float a8[8];
                const f32x2 rs2 = {rs, rs};
#pragma unroll
                for (int n = 0; n < 2; ++n)
#pragma unroll
                    for (int h = 0; h < 2; ++h) {
                        const f32x2 ag = {acc[ai][0][m][n][2 * h], acc[ai][0][m][n][2 * h + 1]}, al = {acc[ai][1][m][n][2 * h], acc[ai][1][m][n][2 * h + 1]};
                        const f32x2 gv = ag * rs2 + (f32x2){bg[n][2 * h], bg[n][2 * h + 1]}, lv = al * rs2 + (f32x2){bl[n][2 * h], bl[n][2 * h + 1]};
                        const f32x2 gl = {fminf(gv[0], 7.f), fminf(gv[1], 7.f)}, li = {fminf(fmaxf(lv[0], -6.f), 8.f), fminf(fmaxf(lv[1], -6.f), 8.f)};
                        const f32x2 t = gl * (f32x2){-1.702f * LOG2E, -1.702f * LOG2E};
                        const f32x2 d = (f32x2){__builtin_amdgcn_exp2f(t[0]), __builtin_amdgcn_exp2f(t[1])} + (f32x2){1.f, 1.f};
                        const f32x2 r = {__builtin_amdgcn_rcpf(d[0]), __builtin_amdgcn_rcpf(d[1])};
                        const f32x2 o = (gl * r) * li;
                        a8[4 * n + 2 * h] = o[0]; a8[4 * n + 2 * h + 1] = o[1]; }
                if (MOE_F8) { u32x2 w;
                    int w0 = __builtin_amdgcn_cvt_pk_fp8_f32(a8[0], a8[1], 0, false); w0 = __builtin_amdgcn_cvt_pk_fp8_f32(a8[2], a8[3], w0, true);
                    int w1 = __builtin_amdgcn_cvt_pk_fp8_f32(a8[4], a8[5], 0, false); w1 = __builtin_amdgcn_cvt_pk_fp8_f32(a8[6], a8[7], w1, true);
                    w.x = (unsigned)w0; w.y = (unsigned)w1; unsigned char* hp_ = (unsigned char*)H + (size_t)(u.pm * BM + r) * DM + colA;
                    if (WIDE_ST) {
                        if ((m & 1) == 0) wprev = w;
                        else { { auto rx = __builtin_amdgcn_permlane16_swap(wprev.x, w.x, false, false); wprev.x = rx[0]; w.x = rx[1]; auto ry = __builtin_amdgcn_permlane16_swap(wprev.y, w.y, false, false); wprev.y = ry[0]; w.y = ry[1]; }
                            const int mo = fq & 1; unsigned char* hq_ = (unsigned char*)H + (size_t)(u.pm * BM + r - 16 + 16 * mo) * DM + colA - 8 * mo; const u32x4 w4 = {wprev.x, wprev.y, w.x, w.y};
                            if (MERGE56) asm volatile("global_store_dwordx4 %0, %1, off sc1\n\ts_nop 1" :: "v"(hq_), "v"(w4) : "memory"); else *(u32x4*)hq_ = w4; } }
                    else if (MERGE56) asm volatile("global_store_dwordx2 %0, %1, off sc1" :: "v"(hp_), "v"(w) : "memory"); else *(u32x2*)hp_ = w; }
                else { u32x4 w; w.x = cvt_pk_bf16(a8[0], a8[1]); w.y = cvt_pk_bf16(a8[2], a8[3]); w.z = cvt_pk_bf16(a8[4], a8[5]); w.w = cvt_pk_bf16(a8[6], a8[7]);
                *(u32x4*)(H + (size_t)(u.pm * BM + r) * DM + colA) = w; } }
    }
};
struct EpiMoe2 {
    static constexpr bool PERM = true, MIDK = false, SIGNAL = false, WAITA = MERGE56, PRE = false;
    unsigned* done; unsigned* tmo;
    __device__ __forceinline__ void wait_ready(const Unit& u) const { XB_SPIN(xb_ld(done + u.pm) < 8u, tmo); __builtin_amdgcn_fence(__ATOMIC_ACQUIRE, "agent"); asm volatile("s_waitcnt vmcnt(0)" ::: "memory"); }
    bf16_t* Y; const PG8_LAS float* wtab; const PG8_LAS float* btab;
    __device__ __forceinline__ void operator()(const f32x4 (&acc)[2][2][4][2], const Unit& u, int ui, int wr, int wc, int fr, int fq) const {
        const int pl = u.pn & 3, cl = wc * 32 + 8 * fq, col0 = pl * BM + cl;
        f32x4 bv[2][2];
#pragma unroll
        for (int bj = 0; bj < 2; ++bj)
#pragma unroll
            for (int n = 0; n < 2; ++n) bv[bj][n] = *(const PG8_LAS f32x4*)(btab + ui * 256 + cl + bj * HALF + 4 * n);
        if (WIDE_ST && Y_F8) {
            const int mo = fq & 1, cw = col0 - 8 * mo;
#pragma unroll
            for (int ai = 0; ai < 2; ++ai) { if (u.nr <= ai * HALF + wr * 64) continue;
#pragma unroll
                for (int mp = 0; mp < 4; mp += 2) { const int r0 = ai * HALF + wr * 64 + mp * 16 + fr; const float wt0 = wtab[ui * 256 + r0], wt1 = wtab[ui * 256 + r0 + 16];
                    unsigned char* yp = (unsigned char*)Y + (size_t)(u.pm * BM + r0 + 16 * mo) * DM + cw;
#pragma unroll
                    for (int bj = 0; bj < 2; ++bj) { const f32x4 a0 = (acc[ai][bj][mp][0] + bv[bj][0]) * wt0, a1 = (acc[ai][bj][mp][1] + bv[bj][1]) * wt0, b0 = (acc[ai][bj][mp + 1][0] + bv[bj][0]) * wt1, b1 = (acc[ai][bj][mp + 1][1] + bv[bj][1]) * wt1;
                        unsigned ax = pk4_fp8(a0[0], a0[1], a0[2], a0[3]), ay = pk4_fp8(a1[0], a1[1], a1[2], a1[3]), bx = pk4_fp8(b0[0], b0[1], b0[2], b0[3]), by = pk4_fp8(b1[0], b1[1], b1[2], b1[3]);
                        { auto rx = __builtin_amdgcn_permlane16_swap(ax, bx, false, false); ax = rx[0]; bx = rx[1]; auto ry = __builtin_amdgcn_permlane16_swap(ay, by, false, false); ay = ry[0]; by = ry[1]; }
                        *(u32x4*)(yp + bj * HALF) = (u32x4){ax, ay, bx, by}; } } }
            return; }
#pragma unroll
        for (int ai = 0; ai < 2; ++ai)
#pragma unroll
            for (int m = 0; m < 4; ++m) { if (u.nr <= ai * HALF + wr * 64) continue;
                const int r = ai * HALF + wr * 64 + m * 16 + fr; const float wt = wtab[ui * 256 + r]; bf16_t* rowp = Y + (size_t)(u.pm * BM + r) * DM + col0;
#pragma unroll
                for (int bj = 0; bj < 2; ++bj) { const f32x4 v0 = (acc[ai][bj][m][0] + bv[bj][0]) * wt, v1 = (acc[ai][bj][m][1] + bv[bj][1]) * wt;
                    if (Y_F8) { u32x2 w; w.x = pk4_fp8(v0[0], v0[1], v0[2], v0[3]); w.y = pk4_fp8(v1[0], v1[1], v1[2], v1[3]); *(u32x2*)((unsigned char*)Y + (size_t)(u.pm * BM + r) * DM + col0 + bj * HALF) = w; }
                    else { u32x4 w; w.x = cvt_pk_bf16(v0[0], v0[1]); w.y = cvt_pk_bf16(v0[2], v0[3]); w.z = cvt_pk_bf16(v1[0], v1[1]); w.w = cvt_pk_bf16(v1[2], v1[3]);
                    *(u32x4*)(rowp + bj * HALF) = w; } } }
    }
};
struct ListOrder {
    const PG8_LAS int* ud; int n; const PG8_LAS int* tabA;
    __device__ __forceinline__ bool next(int i, Unit& u) const { if (i >= n) return false; u.pm = ud[3 * i]; u.pn = ud[3 * i + 1]; u.nr = __builtin_amdgcn_readfirstlane(ud[3 * i + 2]); return true; }
    __device__ __forceinline__ const PG8_LAS int* rowtab(int ui) const { return tabA + ui * 256; }
};
}

#include <hip/hip_bf16.h>
#include <cmath>
namespace attn_body {

using bf16=__hip_bfloat16;
using bf16x8=__attribute__((ext_vector_type(8)))short;
using s16x4=__attribute__((ext_vector_type(4)))short;
using f32x16=__attribute__((ext_vector_type(16)))float;
using u32x4=__attribute__((ext_vector_type(4)))unsigned;
using u32x2=__attribute__((ext_vector_type(2)))unsigned;
constexpr int SEQ=4096,D=64,PIN=3072,POUT=1024;
constexpr int NW=8,QBLK=32,QB=QBLK*NW,KVBLK=64,NQB=SEQ/QB;
__device__ __forceinline__ int crow(int r,int hi){return (r&3)+8*(r>>2)+4*hi;}
#define SBAR() __builtin_amdgcn_sched_barrier(0)
__device__ __forceinline__ void cmask(f32x16&p0,f32x16&p1,int jb,int qrel,int hi){
  const float NEG=-INFINITY; int kb=64*jb+4*hi;
  #pragma unroll
  for(int r=0;r<16;++r){int kv=kb+(r&3)+8*(r>>2); if(kv>qrel)p0[r]=NEG; if(kv+32>qrel)p1[r]=NEG;}
}

constexpr int NSLOT=3, SLOTB=8192;
constexpr int LDS_K=0, LDS_V=NSLOT*SLOTB, LDS_WS=2*NSLOT*SLOTB, LDS_OST=LDS_WS+NW*64*4, LDS_CK=LDS_OST+NW*4096, LDS_BYTES=LDS_CK+SEQ*8;
constexpr float C2=0.125f*1.4426950408889634f;
__device__ __forceinline__ void glds16(const void*gsrc,unsigned lds_dst){unsigned keep;
  asm volatile("s_mov_b32 %0, m0\n\ts_mov_b32 m0, %2\n\ts_nop 0\n\tglobal_load_lds_dwordx4 %1, off\n\ts_mov_b32 m0, %0":"=&s"(keep):"v"(gsrc),"s"(lds_dst):"memory");}
__device__ __forceinline__ float max3f(float a,float b,float c){float r;asm("v_max3_f32 %0, %1, %2, %3":"=v"(r):"v"(a),"v"(b),"v"(c));return r;}
__device__ __forceinline__ float max2f(float a,float b){float r;asm("v_max_f32_e32 %0, %1, %2":"=v"(r):"v"(a),"v"(b));return r;}
__device__ __forceinline__ float fadd_s(float a,float b){float r;asm("v_add_f32_e32 %0, %1, %2":"=v"(r):"v"(a),"v"(b));return r;}
__device__ __forceinline__ float fsub_s(float a,float b){float r;asm("v_sub_f32_e32 %0, %1, %2":"=v"(r):"v"(a),"v"(b));return r;}
typedef float f32x2_t __attribute__((ext_vector_type(2))); typedef float f32x4_t __attribute__((ext_vector_type(4))); typedef __bf16 bf16x2_t __attribute__((ext_vector_type(2)));
__device__ __forceinline__ unsigned cvtpk_s(float lo,float hi){f32x2_t v={lo,hi};bf16x2_t b=__builtin_convertvector(v,bf16x2_t);return __builtin_bit_cast(unsigned,b);}
#define WAIT_BAR(N) asm volatile("s_waitcnt vmcnt(" #N ") lgkmcnt(0)\n\ts_barrier":::"memory")

__device__ __forceinline__ void qkt(f32x16&p0,f32x16&p1,const char*Kslot,const bf16x8*qr,const f32x16&negm,int r32,int hi){
  const char*kb=Kslot+hi*1024+r32*16;
  #pragma unroll
  for(int d0=0;d0<4;++d0){
    const bf16x8 b0=*reinterpret_cast<const bf16x8*>(kb+d0*2048);
    const bf16x8 b1=*reinterpret_cast<const bf16x8*>(kb+d0*2048+512);
    if(d0==0){p0=__builtin_amdgcn_mfma_f32_32x32x16_bf16(b0,qr[0],negm,0,0,0);p1=__builtin_amdgcn_mfma_f32_32x32x16_bf16(b1,qr[0],negm,0,0,0);}
    else{p0=__builtin_amdgcn_mfma_f32_32x32x16_bf16(b0,qr[d0],p0,0,0,0);p1=__builtin_amdgcn_mfma_f32_32x32x16_bf16(b1,qr[d0],p1,0,0,0);}}
}
typedef __attribute__((address_space(3))) const char* lds_cptr;
typedef short v4i16_t __attribute__((ext_vector_type(4)));
__device__ __forceinline__ void kload8(bf16x8*kf,lds_cptr kp){
  kf[0]=*(const __attribute__((address_space(3))) bf16x8*)(kp);      kf[1]=*(const __attribute__((address_space(3))) bf16x8*)(kp+512);
  kf[2]=*(const __attribute__((address_space(3))) bf16x8*)(kp+2048); kf[3]=*(const __attribute__((address_space(3))) bf16x8*)(kp+2560);
  kf[4]=*(const __attribute__((address_space(3))) bf16x8*)(kp+4096); kf[5]=*(const __attribute__((address_space(3))) bf16x8*)(kp+4608);
  kf[6]=*(const __attribute__((address_space(3))) bf16x8*)(kp+6144); kf[7]=*(const __attribute__((address_space(3))) bf16x8*)(kp+6656);
}
__device__ __forceinline__ void kload2(bf16x8*kf,lds_cptr kp,int j){ kf[2*j]=*(const __attribute__((address_space(3))) bf16x8*)(kp+j*2048); kf[2*j+1]=*(const __attribute__((address_space(3))) bf16x8*)(kp+j*2048+512); }
__device__ __forceinline__ s16x4 vtr(lds_cptr p){ return __builtin_bit_cast(s16x4,__builtin_amdgcn_ds_read_tr16_b64_v4i16((__attribute__((address_space(3))) v4i16_t*)p)); }
__device__ __forceinline__ float rowmax(const f32x16&p0,const f32x16&p1){
  float a=max3f(p0[0],p0[1],p1[0]),b=max3f(p0[2],p0[3],p1[1]);a=max3f(a,p1[2],p1[3]);
  #pragma unroll
  for(int r=4;r<16;r+=4){a=max3f(a,p0[r],p0[r+1]);b=max3f(b,p0[r+2],p0[r+3]);a=max3f(a,p1[r],p1[r+1]);b=max3f(b,p1[r+2],p1[r+3]);}
  const float m=max2f(a,b);
  auto rr=__builtin_amdgcn_permlane32_swap(__float_as_uint(m),__float_as_uint(m),false,false);
  return max2f(__uint_as_float(rr[0]),__uint_as_float(rr[1]));
}
__device__ __forceinline__ void pv(f32x16*o,int vb,bf16x8 pa0,bf16x8 pa1,bf16x8 pa2,bf16x8 pa3){
  #pragma unroll
  for(int d0=0;d0<2;++d0){s16x4 lo[4],hi[4];
    #pragma unroll
    for(int ks=0;ks<4;++ks){
      asm volatile("ds_read_b64_tr_b16 %0,%1 offset:%c2":"=&v"(lo[ks]):"v"(vb),"i"(d0*4096+ks*1024):"memory");
      asm volatile("ds_read_b64_tr_b16 %0,%1 offset:%c2":"=&v"(hi[ks]):"v"(vb),"i"(d0*4096+ks*1024+512):"memory");}
    asm volatile("s_waitcnt lgkmcnt(0)":::"memory");SBAR();
    #define PK(k) (bf16x8){lo[k][0],lo[k][1],lo[k][2],lo[k][3],hi[k][0],hi[k][1],hi[k][2],hi[k][3]}
    o[d0]=__builtin_amdgcn_mfma_f32_32x32x16_bf16(pa0,PK(0),o[d0],0,0,0);
    o[d0]=__builtin_amdgcn_mfma_f32_32x32x16_bf16(pa1,PK(1),o[d0],0,0,0);
    o[d0]=__builtin_amdgcn_mfma_f32_32x32x16_bf16(pa2,PK(2),o[d0],0,0,0);
    o[d0]=__builtin_amdgcn_mfma_f32_32x32x16_bf16(pa3,PK(3),o[d0],0,0,0);
    #undef PK
  }
}

#ifndef ATTN_STORE16
#define ATTN_STORE16(p,v) (*(u32x4*)(p)=(v))
#endif
template<int THRL> __device__ __forceinline__ void attn_unit(int b,int h,int qb,const bf16*Q,const bf16*__restrict__ K,const bf16*__restrict__ V,bf16*O,const float*__restrict__ CUMbh,float*__restrict__ SSQh,float skipth,char*shm){
  int tid_=threadIdx.x; asm volatile("":"+v"(tid_));
  const int tid=tid_,lane=tid&63,r32=lane&31,hi=lane>>5; const int wid=__builtin_amdgcn_readfirstlane(tid>>6);
  const long rowbase=(long)b*SEQ; const int q0=qb*QB;
  const bf16*Qw=Q+(rowbase+q0+wid*QBLK)*PIN+h*D;
  int t0;
  { const int NT0=(q0+QB)/KVBLK; const bool sk=(lane<NT0-4)&&(CUMbh[64*lane+63]-CUMbh[q0]>=skipth); t0=__builtin_popcountll(__ballot(sk))&~1; t0=__builtin_amdgcn_readfirstlane(t0); }
  const bf16*Kh=K+(rowbase+(long)t0*KVBLK)*PIN+h*D,*Vh=V+(rowbase+(long)t0*KVBLK)*PIN+h*D;
  const unsigned lds0=(unsigned)(uintptr_t)shm;
  const lds_cptr shm3=(lds_cptr)shm;
  float*wsf=(float*)(shm+LDS_WS)+wid*64;
  const bf16*ksrc=Kh+(long)lane*PIN+wid*8;
  const bf16*vsrc=Vh+(long)(16*(wid&3)+(lane>>2))*PIN+(wid>>2)*32+(lane&3)*8;
  const unsigned kdst=lds0+LDS_K+wid*1024, vdst=lds0+LDS_V+wid*1024;
  #define DMA_K(t,slot) glds16(ksrc+(long)(t)*KVBLK*PIN,(unsigned)__builtin_amdgcn_readfirstlane(kdst+(slot)))
  #define DMA_V(t,slot) glds16(vsrc+(long)(t)*KVBLK*PIN,(unsigned)__builtin_amdgcn_readfirstlane(vdst+(slot)))
  const int vb0=(int)(lds0+LDS_V)+((lane>>4)&1)*32+(lane&3)*8+(4*hi+((lane&15)>>2))*64;
  const char*Kbase=shm+LDS_K; bf16x8 kf[8];
  const lds_cptr kp0=shm3+LDS_K+hi*1024+r32*16; const lds_cptr vp0=shm3+LDS_V+((lane>>4)&1)*32+(lane&3)*8+(4*hi+((lane&15)>>2))*64;
  const int NT=(q0+QB)/KVBLK-t0;
  DMA_K(0,0);DMA_V(0,0);DMA_K(1,SLOTB);
  bf16x8 qr[4];
  #pragma unroll
  for(int d0=0;d0<4;++d0)qr[d0]=*reinterpret_cast<const bf16x8*>(&Qw[(long)r32*PIN+d0*16+hi*8]);
  const float cbase=CUMbh[q0]; const float cq=CUMbh[q0+wid*QBLK+r32]-cbase;
  { __attribute__((address_space(3))) u32x2*ckw=(__attribute__((address_space(3))) u32x2*)(shm3+LDS_CK); int s0_=tid+t0*KVBLK; asm volatile("":"+v"(s0_)); const int send_=q0+QB;
    _Pragma("nounroll") for(int s=s0_;s<send_;s+=4*NW*64){ float c4_[4];
      _Pragma("unroll") for(int j_=0;j_<4;++j_) c4_[j_]=(s+j_*NW*64<send_)?CUMbh[s+j_*NW*64]:0.f;
      _Pragma("unroll") for(int j_=0;j_<4;++j_) if(s+j_*NW*64<send_){ const float c_=c4_[j_]-cbase; const unsigned hb_=__float_as_uint(c_)&0xffff0000u; const float r1_=c_-__uint_as_float(hb_);
        const unsigned mb_=__float_as_uint(r1_)&0xffff0000u; const float r2_=r1_-__uint_as_float(mb_); ckw[s+j_*NW*64]=(u32x2){(hb_>>16)|mb_,__float_as_uint(r2_)>>16}; } } }
  const __attribute__((address_space(3))) u32x2*ckf=(const __attribute__((address_space(3))) u32x2*)(shm3+LDS_CK)+t0*KVBLK+r32;
  u32x4 qo_=hi?(u32x4){0u,0u,0u,0u}:(u32x4){0xBF80BF80u,0x0000BF80u,0u,0u}; asm volatile("":"+v"(qo_)); const bf16x8 qone=__builtin_bit_cast(bf16x8,qo_);
  #define KBF(x) __builtin_bit_cast(bf16x8,(u32x4){(x)[0],(x)[1],0u,0u})
  float mhat=-cq,l_reg=0.f;f32x16 o[2];o[0]=f32x16{};o[1]=f32x16{};f32x16 negm;
  #pragma unroll
  for(int r=0;r<16;++r)negm[r]=cq;
  asm volatile("":"+v"(negm));
  const int qrel=wid*QBLK+r32;
  #define CMASK(P0,P1,t) do{int jb_=(t)-(NT-4); if(jb_>=0)cmask(P0,P1,jb_,qrel,hi);}while(0)
  bool resc=false;
  #define START(P0,P1) do{ const float rm=rowmax(P0,P1); resc=false; \
    { const float dl=rm; mhat=fadd_s(mhat,dl); \
      _Pragma("unroll") for(int r=0;r<16;++r){P0[r]=fsub_s(P0[r],dl);P1[r]=fsub_s(P1[r],dl);} \
      _Pragma("unroll") for(int r=0;r<16;++r)negm[r]=-mhat; asm volatile("":"+v"(negm)); } \
    _Pragma("unroll") for(int r=0;r<16;++r)P0[r]=__builtin_amdgcn_exp2f(P0[r]); }while(0)
  #define RESC() do{ if(resc){ asm volatile("s_waitcnt lgkmcnt(0)":::"memory"); \
      _Pragma("unroll") for(int d_=0;d_<2;++d_) _Pragma("unroll") for(int r=0;r<16;++r)o[d_][r]*=wsf[crow(r,hi)]; } }while(0)
  f32x16 pA0,pA1,pB0,pB1;
  int sl_prev=0,sl_cur=0,sl_next=SLOTB;
  #define ROT() do{sl_prev=sl_cur;sl_cur=sl_next;sl_next=(sl_next==(NSLOT-1)*SLOTB)?0:sl_next+SLOTB;}while(0)
  DMA_K(2,2*SLOTB);
  WAIT_BAR(3);
  { const u32x2 kb0_=ckf[0],kb1_=ckf[32]; qkt(pA0,pA1,Kbase,qr,negm,r32,hi);
    pA0=__builtin_amdgcn_mfma_f32_32x32x16_bf16(KBF(kb0_),qone,pA0,0,0,0); pA1=__builtin_amdgcn_mfma_f32_32x32x16_bf16(KBF(kb1_),qone,pA1,0,0,0); }
  asm volatile("s_nop 15\n\ts_nop 7":"+v"(pA0),"+v"(pA1));CMASK(pA0,pA1,0);
  START(pA0,pA1);
  _Pragma("unroll") for(int r=0;r<16;++r)pA1[r]=__builtin_amdgcn_exp2f(pA1[r]);
  WAIT_BAR(0);
  DMA_K(3,0);DMA_V(1,SLOTB);
  ROT();
  kload8(kf,kp0+sl_cur);
  WAIT_BAR(2);
  s16x4 vlo[8],vhi[8]; u32x4 pw0,pw1,pw2,pw3;
  #define PKW(P,B) cvtpk_s(P[B],P[B+1])
  #define PAF(k) __builtin_bit_cast(bf16x8,pw##k)
  #define VFR(i) (bf16x8){vlo[i][0],vlo[i][1],vlo[i][2],vlo[i][3],vhi[i][0],vhi[i][1],vhi[i][2],vhi[i][3]}
  #define PIN(x) asm volatile("":"+v"(x))
  #define MX3(a,b,c) __builtin_fmaxf(__builtin_fmaxf((a),(b)),(c))
  #define GAPA(MF,A0,A1,A2,A3,W0,W1,PW) do{ MF; sacc+=A0; sacc+=A1; sacc+=A2; sacc+=A3; PIN(sacc); W0; W1; PIN(PW); SBAR(); }while(0)
  #define EX(v) __builtin_amdgcn_exp2f(v)
  #define GAPB(MF,X,B) do{ MF; X[B]=EX(X[B]); X[B+1]=EX(X[B+1]); X[B+2]=EX(X[B+2]); X[B+3]=EX(X[B+3]); PIN(X); SBAR(); }while(0)
  #define VRD(i) do{ vlo[i]=vtr(vp_+(((i)>>2)*4096+((i)&3)*1024)); vhi[i]=vtr(vp_+(((i)>>2)*4096+((i)&3)*1024+512)); }while(0)
  #define KRD(G,j) do{ if(G){ kload2(kf,kp0+sl_next,j); SBAR(); } }while(0)
  #define STEP(C0,C1,P0,P1,t,GK,GV,GL) do{ SBAR(); \
    const lds_cptr vp_=vp0+sl_prev; const u32x2 kb0_=ckf[(t)*KVBLK],kb1_=ckf[(t)*KVBLK+32]; \
    VRD(0); SBAR(); float sacc=(P0[0]+P0[1]); \
    GAPA(C0=__builtin_amdgcn_mfma_f32_32x32x16_bf16(kf[0],qr[0],negm,0,0,0), P0[2],P0[3],P0[4],P0[5],     pw0[0]=PKW(P0,0), pw0[1]=PKW(P0,2), pw0); \
    VRD(4); SBAR(); GAPA(C1=__builtin_amdgcn_mfma_f32_32x32x16_bf16(kf[1],qr[0],negm,0,0,0), P0[6],P0[7],P0[8],P0[9],     pw0[2]=PKW(P0,4), pw0[3]=PKW(P0,6), pw0); \
    VRD(1); SBAR(); GAPA(C0=__builtin_amdgcn_mfma_f32_32x32x16_bf16(kf[2],qr[1],C0,0,0,0),   P0[10],P0[11],P0[12],P0[13], pw1[0]=PKW(P0,8), pw1[1]=PKW(P0,10), pw1); \
    VRD(5); SBAR(); GAPA(C1=__builtin_amdgcn_mfma_f32_32x32x16_bf16(kf[3],qr[1],C1,0,0,0),   P0[14],P0[15],P1[0],P1[1],   pw1[2]=PKW(P0,12),pw1[3]=PKW(P0,14), pw1); \
    C0=__builtin_amdgcn_mfma_f32_32x32x16_bf16(KBF(kb0_),qone,C0,0,0,0); C1=__builtin_amdgcn_mfma_f32_32x32x16_bf16(KBF(kb1_),qone,C1,0,0,0); SBAR(); \
    VRD(2); SBAR(); GAPA(C0=__builtin_amdgcn_mfma_f32_32x32x16_bf16(kf[4],qr[2],C0,0,0,0),   P1[2],P1[3],P1[4],P1[5],     pw2[0]=PKW(P1,0), pw2[1]=PKW(P1,2), pw2); \
    VRD(6); SBAR(); GAPA(C1=__builtin_amdgcn_mfma_f32_32x32x16_bf16(kf[5],qr[2],C1,0,0,0),   P1[6],P1[7],P1[8],P1[9],     pw2[2]=PKW(P1,4), pw2[3]=PKW(P1,6), pw2); \
    VRD(3); SBAR(); GAPA(C0=__builtin_amdgcn_mfma_f32_32x32x16_bf16(kf[6],qr[3],C0,0,0,0),   P1[10],P1[11],P1[12],P1[13], pw3[0]=PKW(P1,8), pw3[1]=PKW(P1,10), pw3); \
    VRD(7); SBAR(); GAPA(C1=__builtin_amdgcn_mfma_f32_32x32x16_bf16(kf[7],qr[3],C1,0,0,0),   P1[14],P1[15],0.f,0.f,       pw3[2]=PKW(P1,12),pw3[3]=PKW(P1,14), pw3); \
    l_reg+=sacc; \
    if(GK){DMA_K((t)+3,sl_cur);} if(GV){DMA_V((t)+1,sl_next);} \
    CMASK(C0,C1,t); \
    { float a=MX3(C0[0],C0[1],C1[0]),b=MX3(C0[2],C0[3],C1[1]); a=MX3(a,C1[2],C1[3]); \
      _Pragma("unroll") for(int r=4;r<16;r+=4){a=MX3(a,C0[r],C0[r+1]);b=MX3(b,C0[r+2],C0[r+3]);a=MX3(a,C1[r],C1[r+1]);b=MX3(b,C1[r+2],C1[r+3]);} \
      float rm=__builtin_fmaxf(a,b); { auto rr=__builtin_amdgcn_permlane32_swap(__float_as_uint(rm),__float_as_uint(rm),false,false); rm=__builtin_fmaxf(__uint_as_float(rr[0]),__uint_as_float(rr[1])); } \
      resc=false; \
      if(__builtin_expect(__any(rm>(float)THRL),0)){ const float dl=__builtin_fmaxf(rm,0.f); mhat+=dl; \
        _Pragma("unroll") for(int r=0;r<16;++r){C0[r]-=dl;C1[r]-=dl;} \
        _Pragma("unroll") for(int r=0;r<16;++r)negm[r]=-mhat; asm volatile("":"+v"(negm)); \
        const float f=__builtin_amdgcn_exp2f(-dl); l_reg*=f; if(hi==0)wsf[r32]=f; resc=true; } } \
    SBAR(); \
    GAPB(o[0]=__builtin_amdgcn_mfma_f32_32x32x16_bf16(PAF(0),VFR(0),o[0],0,0,0), C0,0); \
    GAPB(o[1]=__builtin_amdgcn_mfma_f32_32x32x16_bf16(PAF(0),VFR(4),o[1],0,0,0), C0,4); \
    KRD(GL,0); GAPB(o[0]=__builtin_amdgcn_mfma_f32_32x32x16_bf16(PAF(1),VFR(1),o[0],0,0,0), C0,8); \
    KRD(GL,1); GAPB(o[1]=__builtin_amdgcn_mfma_f32_32x32x16_bf16(PAF(1),VFR(5),o[1],0,0,0), C0,12); \
    KRD(GL,2); GAPB(o[0]=__builtin_amdgcn_mfma_f32_32x32x16_bf16(PAF(2),VFR(2),o[0],0,0,0), C1,0); \
    KRD(GL,3); GAPB(o[1]=__builtin_amdgcn_mfma_f32_32x32x16_bf16(PAF(2),VFR(6),o[1],0,0,0), C1,4); \
    GAPB(o[0]=__builtin_amdgcn_mfma_f32_32x32x16_bf16(PAF(3),VFR(3),o[0],0,0,0), C1,8); \
    GAPB(o[1]=__builtin_amdgcn_mfma_f32_32x32x16_bf16(PAF(3),VFR(7),o[1],0,0,0), C1,12); \
    }while(0)
  int t=1;
  #undef CMASK
  #define CMASK(P0,P1,t) do{}while(0)
  for(;t+5<NT;t+=2){
    STEP(pB0,pB1,pA0,pA1,t,true,true,true);     WAIT_BAR(2); RESC(); ROT();
    STEP(pA0,pA1,pB0,pB1,t+1,true,true,true);   WAIT_BAR(2); RESC(); ROT();
  }
  #undef CMASK
  #define CMASK(P0,P1,t) do{int jb_=(t)-(NT-4); if(jb_>=0)cmask(P0,P1,jb_,qrel,hi);}while(0)
  #define ENDW(tt) do{ if((tt)+3<NT){WAIT_BAR(2);} else if((tt)+2<NT){WAIT_BAR(1);} else {WAIT_BAR(0);} }while(0)
  for(;t+1<NT;t+=2){
    STEP(pB0,pB1,pA0,pA1,t,(t+3<NT),(t+1<NT),(t+1<NT));       ENDW(t);   RESC(); ROT();
    STEP(pA0,pA1,pB0,pB1,t+1,(t+4<NT),(t+2<NT),(t+2<NT));     ENDW(t+1); RESC(); ROT();
  }
  STEP(pB0,pB1,pA0,pA1,NT-1,false,false,false); RESC();
  { float sacc=pB0[0]+pB0[1]; _Pragma("unroll") for(int r=2;r<16;++r)sacc+=pB0[r]; _Pragma("unroll") for(int r=0;r<16;++r)sacc+=pB1[r]; l_reg+=sacc;
    pw0=(u32x4){PKW(pB0,0),PKW(pB0,2),PKW(pB0,4),PKW(pB0,6)};pw1=(u32x4){PKW(pB0,8),PKW(pB0,10),PKW(pB0,12),PKW(pB0,14)};pw2=(u32x4){PKW(pB1,0),PKW(pB1,2),PKW(pB1,4),PKW(pB1,6)};pw3=(u32x4){PKW(pB1,8),PKW(pB1,10),PKW(pB1,12),PKW(pB1,14)};
    SBAR(); pv(o,vb0+sl_cur,PAF(0),PAF(1),PAF(2),PAF(3)); }
  #undef PKW
  #undef PAF
  #undef VFR
  #undef PIN
  #undef MX3
  #undef GAPA
  #undef GAPB
  #undef EX
  #undef VRD
  #undef KRD
  #undef STEP
  #undef ENDW
  {auto rr=__builtin_amdgcn_permlane32_swap(__float_as_uint(l_reg),__float_as_uint(l_reg),false,false);l_reg=__uint_as_float(rr[0])+__uint_as_float(rr[1]);}
  if(hi==0)wsf[32+r32]=l_reg;asm volatile("s_waitcnt lgkmcnt(0)":::"memory");
  float rli[16];
  #pragma unroll
  for(int r=0;r<16;++r)rli[r]=__builtin_amdgcn_rcpf(wsf[32+crow(r,hi)]);
  bf16*Ow=O+(rowbase+q0+wid*QBLK)*POUT+h*D; float*Sw=SSQh+(rowbase+q0+wid*QBLK)*16;
  { bf16*stg=(bf16*)(shm+LDS_OST)+wid*2048;
    #pragma unroll
    for(int r=0;r<16;++r){const int orow=crow(r,hi);
      #pragma unroll
      for(int d0=0;d0<2;++d0)stg[orow*64+d0*32+r32]=__float2bfloat16(o[d0][r]*rli[r]);}
    asm volatile("s_waitcnt lgkmcnt(0)":::"memory");
    #pragma unroll
    for(int i=0;i<4;++i){const int row=i*8+(lane>>3),ch=lane&7; const u32x4 v=*(const u32x4*)(stg+row*64+ch*8); ATTN_STORE16(Ow+(long)row*POUT+ch*8,v);
      float sq=0.f;
      #pragma unroll
      for(int w_=0;w_<4;++w_){const float lo_=__uint_as_float(v[w_]<<16),hi_=__uint_as_float(v[w_]&0xffff0000u);sq+=lo_*lo_+hi_*hi_;}
      sq=xadd(sq,1);sq=xadd(sq,2);sq=xadd(sq,4); if(ch==0)Sw[row*16]=sq;} }
  asm volatile("s_waitcnt lgkmcnt(0)\n\ts_barrier":::"memory");
  #undef DMA_K
  #undef DMA_V
  #undef CMASK
  #undef KBF
  #undef START
  #undef RESC
  #undef ROT
}
constexpr int ATTN_LDS_BYTES=LDS_BYTES;

__device__ __forceinline__ void sb_unit(int b,int h,int qb,const bf16*Q,const bf16*__restrict__ K,const bf16*__restrict__ V,bf16*O,float*__restrict__ SSQh,char*shm){
  int tid_=threadIdx.x; asm volatile("":"+v"(tid_));
  const int tid=tid_,lane=tid&63,r32=lane&31,hi=lane>>5; const int wid=__builtin_amdgcn_readfirstlane(tid>>6);
  const long rowbase=(long)b*SEQ; const int q0=qb*QB;
  const bf16*Qw=Q+(rowbase+q0+wid*QBLK)*PIN+h*D;
  const bf16*Kh=K+rowbase*PIN+h*D,*Vh=V+rowbase*PIN+h*D;
  const unsigned lds0=(unsigned)(uintptr_t)shm;
  const bf16*ksrc=Kh+(long)lane*PIN+wid*8;
  const bf16*vsrc=Vh+(long)(16*(wid&3)+(lane>>2))*PIN+(wid>>2)*32+(lane&3)*8;
  const unsigned kdst=lds0+LDS_K+wid*1024, vdst=lds0+LDS_V+wid*1024;
  const int vb0=(int)(lds0+LDS_V)+((lane>>4)&1)*32+(lane&3)*8+(4*hi+((lane&15)>>2))*64;
  const char*Kbase=shm+LDS_K;
  const int NT=(q0+QB)/KVBLK;
  #define SB_DMA(i,slot) do{ const long kt_=(long)(NT-1-(i)); glds16(ksrc+kt_*KVBLK*PIN,(unsigned)__builtin_amdgcn_readfirstlane(kdst+(slot))); glds16(vsrc+kt_*KVBLK*PIN,(unsigned)__builtin_amdgcn_readfirstlane(vdst+(slot))); }while(0)
  bf16x8 qr[4];
  #pragma unroll
  for(int d0=0;d0<4;++d0)qr[d0]=*reinterpret_cast<const bf16x8*>(&Qw[(long)r32*PIN+d0*16+hi*8]);
  SB_DMA(0,0); SB_DMA(1,SLOTB);
  f32x16 o[2];o[0]=f32x16{};o[1]=f32x16{};
  float Rc=1.f;
  const int qrel=wid*QBLK+r32;
  int sl_cur=0,sl_n1=SLOTB,sl_n2=2*SLOTB;
  volatile __attribute__((address_space(3))) unsigned*flg=(volatile __attribute__((address_space(3))) unsigned*)((lds_cptr)shm+LDS_WS);
  f32x16 pA0,pA1,pB0,pB1;
  WAIT_BAR(3);
  { f32x16 z=f32x16{}; asm volatile("":"+v"(z)); qkt(pA0,pA1,Kbase+sl_cur,qr,z,r32,hi); }
  bool done_=false;
  #define SB_STEP(i,P0,P1,N0,N1) do{ \
    if((i)+1<NT){WAIT_BAR(1);}else{WAIT_BAR(0);} \
    if((i)>0){ const int pb=(((i)-1)&1)*8; const u32x4 fa_=*(const __attribute__((address_space(3))) u32x4*)((lds_cptr)shm+LDS_WS+4*pb), fb_=*(const __attribute__((address_space(3))) u32x4*)((lds_cptr)shm+LDS_WS+4*pb+16);   \
      const unsigned all_=fa_[0]&fa_[1]&fa_[2]&fa_[3]&fb_[0]&fb_[1]&fb_[2]&fb_[3]; if(__builtin_amdgcn_readfirstlane(all_)){done_=true;break;} } \
    if((i)+2<NT)SB_DMA((i)+2,sl_n2); \
    if((i)+1<NT){ f32x16 z=f32x16{}; asm volatile("":"+v"(z)); qkt(N0,N1,Kbase+sl_n1,qr,z,r32,hi); SBAR(); } \
    f32x16 s0,s1; \
    _Pragma("unroll") for(int r=0;r<16;++r){ \
      const float za=__builtin_amdgcn_fmed3f(P0[r],-100.f,100.f), zb=__builtin_amdgcn_fmed3f(P1[r],-100.f,100.f); \
      P0[r]=__builtin_amdgcn_exp2f(za); P1[r]=__builtin_amdgcn_exp2f(zb); \
      s0[r]=__builtin_amdgcn_rcpf(1.f+P0[r]); s1[r]=__builtin_amdgcn_rcpf(1.f+P1[r]); } \
    if((i)<4){ const int kb=64*(3-(i))+4*hi; \
      _Pragma("unroll") for(int r=0;r<16;++r){ const int kv=kb+(r&3)+8*(r>>2); if(kv>=qrel){P0[r]=0.f;s0[r]=1.f;} if(kv+32>=qrel){P1[r]=0.f;s1[r]=1.f;} } } \
    float gp[8],pp[8]; \
    _Pragma("unroll") for(int g=0;g<4;++g){ \
      s0[4*g+2]*=s0[4*g+3]; s0[4*g+1]*=s0[4*g+2]; s0[4*g]*=s0[4*g+1]; gp[g]=s0[4*g]; \
      s1[4*g+2]*=s1[4*g+3]; s1[4*g+1]*=s1[4*g+2]; s1[4*g]*=s1[4*g+1]; gp[4+g]=s1[4*g]; } \
    _Pragma("unroll") for(int g=0;g<8;++g){ auto rr=__builtin_amdgcn_permlane32_swap(__float_as_uint(gp[g]),__float_as_uint(gp[g]),false,false); pp[g]=__uint_as_float(hi?rr[0]:rr[1]); } \
    float st=Rc, outer[8]; \
    _Pragma("unroll") for(int g=7;g>=0;--g){ outer[g]=hi?st:st*pp[g]; st=st*(gp[g]*pp[g]); } \
    Rc=st; \
    { const unsigned dn=__all(Rc==0.f)?1u:0u; if(lane==0)flg[((i)&1)*8+wid]=dn; } \
    _Pragma("unroll") for(int r=0;r<16;++r){ P0[r]=P0[r]*(s0[r]*outer[r>>2]); P1[r]=P1[r]*(s1[r]*outer[4+(r>>2)]); } \
    u32x4 pw0,pw1,pw2,pw3; \
    pw0=(u32x4){cvtpk_s(P0[0],P0[1]),cvtpk_s(P0[2],P0[3]),cvtpk_s(P0[4],P0[5]),cvtpk_s(P0[6],P0[7])}; \
    pw1=(u32x4){cvtpk_s(P0[8],P0[9]),cvtpk_s(P0[10],P0[11]),cvtpk_s(P0[12],P0[13]),cvtpk_s(P0[14],P0[15])}; \
    pw2=(u32x4){cvtpk_s(P1[0],P1[1]),cvtpk_s(P1[2],P1[3]),cvtpk_s(P1[4],P1[5]),cvtpk_s(P1[6],P1[7])}; \
    pw3=(u32x4){cvtpk_s(P1[8],P1[9]),cvtpk_s(P1[10],P1[11]),cvtpk_s(P1[12],P1[13]),cvtpk_s(P1[14],P1[15])}; \
    SBAR(); pv(o,vb0+sl_cur,__builtin_bit_cast(bf16x8,pw0),__builtin_bit_cast(bf16x8,pw1),__builtin_bit_cast(bf16x8,pw2),__builtin_bit_cast(bf16x8,pw3)); \
    { const int t_=sl_cur; sl_cur=sl_n1; sl_n1=sl_n2; sl_n2=t_; } \
  }while(0)
  for(int i=0;i<NT&&!done_;i+=2){
    SB_STEP(i,pA0,pA1,pB0,pB1); if(done_)break;
    SB_STEP(i+1,pB0,pB1,pA0,pA1);
  }
  #undef SB_STEP
  #undef SB_DMA
  bf16*Ow=O+(rowbase+q0+wid*QBLK)*POUT+h*D; float*Sw=SSQh+(rowbase+q0+wid*QBLK)*16;
  { bf16*stg=(bf16*)(shm+LDS_OST)+wid*2048;
    #pragma unroll
    for(int r=0;r<16;++r){const int orow=crow(r,hi);
      #pragma unroll
      for(int d0=0;d0<2;++d0)stg[orow*64+d0*32+r32]=__float2bfloat16(o[d0][r]);}
    asm volatile("s_waitcnt lgkmcnt(0)":::"memory");
    #pragma unroll
    for(int i=0;i<4;++i){const int row=i*8+(lane>>3),ch=lane&7; const u32x4 v=*(const u32x4*)(stg+row*64+ch*8); ATTN_STORE16(Ow+(long)row*POUT+ch*8,v);
      float sq=0.f;
      #pragma unroll
      for(int w_=0;w_<4;++w_){const float lo_=__uint_as_float(v[w_]<<16),hi_=__uint_as_float(v[w_]&0xffff0000u);sq+=lo_*lo_+hi_*hi_;}
      sq=xadd(sq,1);sq=xadd(sq,2);sq=xadd(sq,4); if(ch==0)Sw[row*16]=sq;} }
  asm volatile("s_waitcnt vmcnt(0) lgkmcnt(0)\n\ts_barrier":::"memory");
}
template<int THRL=8> __device__ __forceinline__ void attn_phase(char*lds,const bf16*PROJ,const float*CUM,bf16*OMIX,float*SSQ,float skipth,int bh,int role){
  const int b=bh>>3,h=bh&7;
  const int nf=role<5?2:6;
  for(int i=0;i<nf;++i){ const int qb=role<5?(i==0?15-role:6+role):5-i;
    attn_unit<THRL>(b,h,qb,PROJ,PROJ+512,PROJ+1024,OMIX,CUM+(size_t)bh*SEQ,SSQ+h,skipth,lds); }
  const int sb0=role<3?3+3*role:(role==3?12:(role==4?14:0)), ns=(role==3||role==4)?2:3;
  for(int i=0;i<ns;++i) sb_unit(b,h,sb0+i,PROJ+1536,PROJ+2048,PROJ+2560,OMIX+512,SSQ+8+h,lds);
}
template<int THRL,int NA> __device__ __forceinline__ void attn_sched(char*lds,const bf16*PROJ,const float*CUM,bf16*OMIX,float*SSQ,float skipth,unsigned*qctr,int xl,int c){
  int tid_=threadIdx.x; asm volatile("":"+v"(tid_)); const int tid=tid_;
  volatile __attribute__((address_space(3))) float*cost=(volatile __attribute__((address_space(3))) float*)((lds_cptr)lds+120832);
  volatile __attribute__((address_space(3))) int*order=(volatile __attribute__((address_space(3))) int*)((lds_cptr)lds+120832+512);
  #define BH_OF(i) ((xl>>1)*8+(((xl&1)?0x4361:0x5270)>>(4*(i))&15))
  if(tid<128){ const int bi=tid>>5,type=(tid>>4)&1,qb=tid&15,bh=BH_OF(bi),NT0=4*(qb+1); float cs;
    if(type==0){ const float rate=-CUM[(size_t)bh*SEQ+SEQ-1]*(1.f/SEQ); const float w=skipth/fmaxf(rate,1e-6f); const float sk=fmaxf(0.f,(float)(qb*QB)-w);
      int t0=((int)(sk*(1.f/KVBLK)))&~1; if(t0>NT0-4)t0=NT0-4; cs=5.f+1.65f*(float)(NT0-t0); }
    else cs=3.f+2.6f*(float)(NT0<8?NT0:8);
    cost[tid]=cs; }
  asm volatile("s_waitcnt lgkmcnt(0)":::"memory"); __syncthreads();
  if(tid<128){ const __attribute__((address_space(3))) f32x4_t*c4=(const __attribute__((address_space(3))) f32x4_t*)((lds_cptr)lds+120832); const float mc=c4[tid>>2][tid&3]; int rk=0;
    _Pragma("unroll") for(int j4=0;j4<32;++j4){ const f32x4_t cj=c4[j4]; _Pragma("unroll") for(int q=0;q<4;++q){ const int j=4*j4+q; rk+=(cj[q]>mc||(cj[q]==mc&&j<tid))?1:0; } } order[rk]=tid; }
  asm volatile("s_waitcnt lgkmcnt(0)":::"memory"); __syncthreads();
  volatile __attribute__((address_space(3))) int*qn=order+128;
  int r=c;
  const int wid_=__builtin_amdgcn_readfirstlane(tid>>6); if(wid_>=4)__builtin_amdgcn_s_setprio(1);
  for(int k=0;;++k){ if(!ATTN_DYN){ r=NA*k+((k&1)?NA-1-c:c); } if(r>=128)break;
    const int u=__builtin_amdgcn_readfirstlane(order[r]); const int bi=u>>5,type=(u>>4)&1,qb=u&15,bh=BH_OF(bi),b=bh>>3,h=bh&7;
    int nx_=0; if(ATTN_DYN&&tid==0)nx_=NA+(int)atomicAdd(qctr,1u);
    if(type==0)attn_unit<THRL>(b,h,qb,PROJ,PROJ+512,PROJ+1024,OMIX,CUM+(size_t)bh*SEQ,SSQ+h,skipth,lds);
    else sb_unit(b,h,qb,PROJ+1536,PROJ+2048,PROJ+2560,OMIX+512,SSQ+8+h,lds);
    if(ATTN_DYN){ if(tid==0)qn[0]=nx_; asm volatile("s_waitcnt lgkmcnt(0)":::"memory"); __syncthreads(); r=__builtin_amdgcn_readfirstlane(qn[0]); __syncthreads(); } }
  __builtin_amdgcn_s_setprio(0);
  #undef BH_OF
}
#undef SBAR
#undef WAIT_BAR
}

template <int NT, bool UP> __device__ __forceinline__ int moe_prepare(const unsigned* __restrict__ CNT, const int* __restrict__ LIST, const float* __restrict__ RSTD2, const float* __restrict__ RW,
                                                                     const float* __restrict__ bias, int* __restrict__ TBG, int bx, LAS unsigned char* L) {
    int tid_ = threadIdx.x; asm volatile("" : "+v"(tid_)); const int tid = tid_;
    LAS int* tb = (LAS int*)(L + TB_OFF); LAS int* tbE = tb + 64; LAS int* tbC = tb + 128; LAS int* cntl = tb + 192; LAS int* udl = tb + 224; LAS int* tabA = (LAS int*)(L + TAB_OFF); LAS float* tabB = (LAS float*)(L + TAB2_OFF);
    if (tid < 64) {
        const int cn = tid < NE ? (int)CNT[tid] : 0, nt = (cn + 255) >> 8, rem = cn & 255, ch = (rem != 0 && rem <= 128) ? 1 : 0;
        int a = nt, c = ch;
#pragma unroll
        for (int o = 1; o < 32; o <<= 1) { const int ta = shfl_up_l(a, o, tid), tc = shfl_up_l(c, o, tid); if ((tid & 63) >= o) { a += ta; c += tc; } }
        if (tid < NE) { tb[tid + 1] = a; tbC[tid + 1] = c; tbE[tid + 1] = a - c; cntl[tid] = cn; }
        if (tid == 0) { tb[0] = 0; tbC[0] = 0; tbE[0] = 0; }
    }
    LDS_WAIT(); __syncthreads();
    if (bx == 0 && tid <= NE) TBG[tid] = tb[tid];
    int j0 = 0;
    if (MERGE56 && !UP) { const int x = bx & 7, UE5 = tbE[32] * 8, UC5 = tbC[32] * 8; j0 = ((UE5 >> 3) + (x < (UE5 & 7) ? 1 : 0) + (UC5 >> 3) + (x < (UC5 & 7) ? 1 : 0)) & 31; }
    pg8::MoeOrder S{NT, bx, j0, tb, tbE, tbC, cntl, tabA};
    if (tid < pg8::MOE_MAXU) { pg8::Unit u; const bool ok = S.next(tid, u); udl[3 * tid] = ok ? u.pm : -1; udl[3 * tid + 1] = u.pn; udl[3 * tid + 2] = u.nr; }
    LDS_WAIT(); __syncthreads();
    int nun = 0;
#pragma unroll
    for (int i = 0; i < pg8::MOE_MAXU; ++i) nun += (udl[3 * i] >= 0) ? 1 : 0;
    int slot[5];
#pragma unroll
    for (int j = 0; j < 5; ++j) { const int idx = tid + NTHREADS * j, ui = idx >> 8, r = idx & 255; slot[j] = 0;
        if (ui < nun) { const int e = udl[3 * ui + 1] / NT, mt = udl[3 * ui] - tb[e], cnt = cntl[e], p = mt * 256 + r; slot[j] = LIST[(size_t)e * LIST_CAP + (p < cnt ? p : cnt - 1)]; } }
#pragma unroll
    for (int j = 0; j < 5; ++j) { const int idx = tid + NTHREADS * j, ui = idx >> 8;
        if (ui < nun) { const int pn = udl[3 * ui + 1];
            if (UP) { const int tok = slot[j] >> 2; tabA[idx] = tok | (int)(__float_as_uint(RSTD2[tok]) & 0xffff0000u);
                      const int e = pn >> 3, pl = pn & 7, c = idx & 255; tabB[idx] = bias[(size_t)e * 2048 + (c < 128 ? pl * 128 + c : 1024 + pl * 128 + (c - 128))] + (c < 128 ? 0.f : 1.f); }
            else { ((LAS float*)tabA)[idx] = RW[slot[j]] * (Y_F8 ? 16.f : 1.f); const int e = pn >> 2, pl = pn & 3; tabB[idx] = bias[(size_t)e * DM + pl * 256 + (idx & 255)]; } } }
    VM_WAIT(); LDS_WAIT(); __syncthreads();
    return nun;
}

__global__ void __launch_bounds__(NTHREADS, 2) mega_fwd(Args a) {
    extern __shared__ __attribute__((aligned(16))) unsigned char lds[];
    LAS unsigned char* L = (LAS unsigned char*)lds;
    volatile LAS unsigned* MISC = (volatile LAS unsigned*)(L + MISC_OFF);
    const int tid = threadIdx.x, lane = tid & 63, wave = __builtin_amdgcn_readfirstlane(tid >> 6);
    const int G = gridDim.x, bx = blockIdx.x, vcu = (G % 8 == 0) ? (bx % 8) * (G / 8) + bx / 8 : bx;
    const int gw = vcu * NWAVES + wave, NGW = G * NWAVES;
    const bool cvt_role = (vcu & 31) >= 32 - NCVT;
    const int cvt_first = ((vcu >> 5) * NCVT + ((vcu & 31) - (32 - NCVT))) * NWAVES + wave;
    const bool cvt1_role = (vcu & 31) >= 24; const int cvt1_first = ((vcu >> 5) * 8 + ((vcu & 31) - 24)) * NWAVES + wave;
    unsigned char* ws = a.ws;
    unsigned* CTL = (unsigned*)(ws + WS_CTL);
    bf16_t* WINT = (bf16_t*)(ws + WS_WINT); bf16_t* WOUTT = (bf16_t*)(ws + WS_WOUTT); float* WR = (float*)(ws + WS_WR); float* CUM = (float*)(ws + WS_CUM);
    float* SSQ = (float*)(ws + WS_SSQ); float* RSTD2 = (float*)(ws + WS_RSTD2); float* RSTD1 = (float*)(ws + WS_RSTD1); float* RW = (float*)(ws + WS_RW); int* SLOTEP = (int*)(ws + WS_SLOTEP); int* TBG = (int*)(ws + WS_TBG); int* LIST = (int*)(ws + WS_LIST); float* FLOG = (float*)(ws + WS_FLOG);
    bf16_t* XN = (bf16_t*)(ws + WS_XN); bf16_t* PROJ = (bf16_t*)(ws + WS_PROJ); bf16_t* OMIX = (bf16_t*)(ws + WS_OMIX); bf16_t* X1B = (bf16_t*)(ws + WS_X1B);
    bf16_t* W1T = (bf16_t*)(ws + WS_W1T); bf16_t* W2T = (bf16_t*)(ws + WS_W2T); bf16_t* H = (bf16_t*)(ws + WS_H); bf16_t* Y = (bf16_t*)(ws + WS_Y);
    unsigned* CNT = CTL + CW_CNT;
    for (int u = tid; u < (LDS_BYTES - LDSCTL_OFF) / 4; u += NTHREADS) ((LAS unsigned*)(L + LDSCTL_OFF))[u] = 0u;
    __syncthreads();
    XcdBarrier bar = xcd_barrier_post(CTL + CW_BAR, MISC + 8);
    unsigned long long tsA = 0, tsB = 0;
#define STAMP(k) do { if (PROBE_T >= 0) { if ((k) == PROBE_T) tsA = __builtin_amdgcn_s_memrealtime(); if ((k) == PROBE_T + 1) tsB = __builtin_amdgcn_s_memrealtime(); } } while (0)
    STAMP(0);

    {
        LAS float* scr = (LAS float*)(L + RING_OFF + wave * 8448);
        LAS float* wf = (LAS float*)(L + RING_OFF + 98304);
        constexpr int I_IN = (DM / 64) * (NPROJ / 32), I_OUT = (DM / 64) * (DM / 32);
        static_assert(I_IN + I_OUT == 256 * (NTHREADS / 64) && M == 8 * 256 * (NTHREADS / 64) && DM * 8 == 16 * NTHREADS, "one weight item and eight rows per wave (256 workgroups: enforced by kernel_launch)");
        float wv[16], gv[16];
#pragma unroll
        for (int j = 0; j < 16; ++j) { const int i = tid + NTHREADS * j, k = i >> 3; wv[j] = a.w_in[(size_t)k * WIN_N + 1536 + (i & 7)]; gv[j] = a.g1[k]; }
        TrItem t; f32x4 v[8];
        { const int it = gw;
          if (it < I_IN) { t.W = a.w_in; t.WT = WINT; t.gA = a.g1; t.gB = nullptr; t.K = DM; t.Nin = WIN_N; t.Nout = NPROJ; t.mode = 1; t.gsplit = DM; t.item = it; t.nbsh = -1; t.f8 = 0; }
          else { t.W = a.w_out; t.WT = WOUTT; t.gA = a.g_fox; t.gB = a.g_sb; t.K = DM; t.Nin = DM; t.Nout = DM; t.mode = 0; t.gsplit = GW; t.item = it - I_IN; t.nbsh = 5; t.f8 = 0; } }
        tr_load<false>(t, lane, v);
        float gsv[8];
        { const int nblk_ = t.Nout / 32, kb_ = t.nbsh >= 0 ? (t.item >> t.nbsh) : t.item / nblk_, kr_ = lane >> 3;
#pragma unroll
          for (int i = 0; i < 8; ++i) { const int k = 64 * kb_ + 8 * i + kr_; gsv[i] = k < t.gsplit ? t.gA[k] : t.gB[k - t.gsplit]; } }
        float4 v0[4], v1[4], v2[4], v3[4];
#define P0_LOAD4(base) do { _Pragma("unroll") for (int j = 0; j < 4; ++j) { v0[j] = ((const float4*)(a.x + (size_t)((base)) * DM))[lane + 64 * j]; v1[j] = ((const float4*)(a.x + (size_t)((base) + 1) * DM))[lane + 64 * j]; \
            v2[j] = ((const float4*)(a.x + (size_t)((base) + 2) * DM))[lane + 64 * j]; v3[j] = ((const float4*)(a.x + (size_t)((base) + 3) * DM))[lane + 64 * j]; } } while (0)
#pragma unroll
        for (int j = 0; j < 16; ++j) { const int i = tid + NTHREADS * j, k = i >> 3; wf[(i & 7) * DM + k] = wv[j] * gv[j]; }
        LDS_WAIT(); __syncthreads();
        P0_LOAD4(8 * gw);
        float4 u0[4], u1[4], u2[4], u3[4];
#pragma unroll
        for (int j = 0; j < 4; ++j) { u0[j] = ((const float4*)(a.x + (size_t)(8 * gw + 4) * DM))[lane + 64 * j]; u1[j] = ((const float4*)(a.x + (size_t)(8 * gw + 5) * DM))[lane + 64 * j];
            u2[j] = ((const float4*)(a.x + (size_t)(8 * gw + 6) * DM))[lane + 64 * j]; u3[j] = ((const float4*)(a.x + (size_t)(8 * gw + 7) * DM))[lane + 64 * j]; }
        tr_store(t, lane, v, scr, gsv);
        if (!OVERLAP_CVT) convert_experts(a.w1, a.w2, a.g2, W1T, W2T, gw, NGW, N_EXP_ITEMS, lane, scr);
        for (int i = gw * 64 + lane; i < DM * NE; i += NGW * 64) { const float w_ = a.w_router[i] * a.g2[i >> 5];
            if (ROUTER_BF3) { const int k = i >> 5, e = i & 31;
                bf16_t* wt = (bf16_t*)(WR + 65536) + (size_t)((k >> 4) * 3) * 512 + (((k >> 3) & 1) * 32 + e) * 8 + (k & 7);
                const unsigned hb = __float_as_uint(w_) & 0xffff0000u; const float r1 = w_ - __uint_as_float(hb); const unsigned mb = __float_as_uint(r1) & 0xffff0000u; const float r2 = r1 - __uint_as_float(mb);
                wt[0] = (bf16_t)(hb >> 16); wt[512] = (bf16_t)(mb >> 16); wt[1024] = (bf16_t)(__float_as_uint(r2) >> 16); }
            else WR[i] = w_; }
        rms1_rows4(v0, v1, v2, v3, wf, a.b_f, XN, FLOG, RSTD1, 8 * gw, 1, lane);
        { int lane2 = lane; asm volatile("" : "+v"(lane2));
          rms1_rows4(u0, u1, u2, u3, wf, a.b_f, XN, FLOG, RSTD1, 8 * gw + 4, 1, lane2); }
#undef P0_LOAD4
    }
    xcd_barrier(bar); STAMP(1);
    {
    { const int ci = (vcu >> 5) * 8 + ((vcu & 31) - 24);
      if (OVERLAP_CVT && CVT_SPLIT > 0) { if (cvt1_role && ((vcu & 31) - 24) < 4) cumsum_wg(FLOG, CUM, (vcu >> 5) * 4 + ((vcu & 31) - 24), (LAS float*)(L + RING_OFF)); }
      else if (vcu < NB * NH) cumsum_wg(FLOG, CUM, vcu, (LAS float*)(L + RING_OFF)); (void)ci; }
    {
        if (OVERLAP_CVT && CVT_SPLIT > 0 && cvt1_role) {
            if (CVT_DMA) { LAS float* gl = (LAS float*)(L + TAB_OFF); for (int i = tid; i < DM; i += NTHREADS) gl[i] = a.g2[i]; LDS_WAIT(); __syncthreads();
                convert_experts_dma(a.w1, a.w2, W1T, W2T, cvt1_first, 64 * NWAVES, CVT_SPLIT, lane, (unsigned)(uintptr_t)((char*)lds + RING_OFF + wave * 16384), (const LAS float*)(L + RING_OFF + wave * 16384), gl); }
            else convert_experts(a.w1, a.w2, a.g2, W1T, W2T, cvt1_first, 64 * NWAVES, CVT_SPLIT, lane, (LAS float*)(L + RING_OFF + wave * 8448)); }
        else {
        pg8::Gemm g{XN, WINT, DM, 0u}; pg8::StaticOrder S; if (OVERLAP_CVT && CVT_SPLIT > 0) S.init(M, NPROJ, 192, (vcu & 31) * 8 + (vcu >> 5)); else S.init(M, NPROJ, G, bx); pg8::EpiProj E{PROJ, CTL + CW_QHP};
        pg8::gemm_phase<pg8::EpiProj, pg8::StaticOrder, true, false>(L + RING_OFF, g, S, E);
        }
    }
    }
    xcd_barrier(bar); STAMP(2);
    {
        static_assert(attn_body::ATTN_LDS_BYTES <= RING_BYTES, "attention scratch inside the ring region");
        static_assert(!W_BLK || (MOE_F8 && CVT_DMA && OVERLAP_CVT && CVT_SPLIT == 0), "the k-blocked weight layout is written by the LDS-DMA converter only");
        if (OVERLAP_CVT) {
            const int xl = vcu >> 5, l = vcu & 31;
            if (cvt_role) {
                if (CVT_DMA) { LAS float* gl = (LAS float*)(L + TAB_OFF); for (int i = tid; i < DM; i += NTHREADS) gl[i] = a.g2[i]; LDS_WAIT(); __syncthreads();
                    if (CVT_REG4) convert_experts_reg4(a.w1, a.w2, W1T, W2T, CVT_SPLIT + cvt_first, 8 * NCVT * NWAVES, N_EXP_ITEMS, lane, (LAS float*)(L + RING_OFF + wave * 8448), gl); else
                    convert_experts_dma(a.w1, a.w2, W1T, W2T, CVT_SPLIT + cvt_first, 8 * NCVT * NWAVES, N_EXP_ITEMS, lane, (unsigned)(uintptr_t)((char*)lds + RING_OFF + wave * 16384), (const LAS float*)(L + RING_OFF + wave * 16384), gl); }
                else convert_experts(a.w1, a.w2, a.g2, W1T, W2T, CVT_SPLIT + cvt_first, 8 * NCVT * NWAVES, N_EXP_ITEMS, lane, (LAS float*)(L + RING_OFF + wave * 8448)); }
            const float bnd = 2.04f * sqrtf(__uint_as_float(CTL[CW_QHP]) * __uint_as_float(CTL[CW_KHP])), skipth = FOX_SKIP ? 160.f + 2.f * bnd : 3.0e38f;
            if (l < 32 - NCVT) { if (ATTN_SCHED) attn_body::attn_sched<32, 32 - NCVT>((char*)lds + RING_OFF, (const attn_body::bf16*)PROJ, CUM, (attn_body::bf16*)OMIX, SSQ, skipth, CTL + CW_QCTR + 64 * xl, xl, l);
                          else attn_body::attn_phase<8>((char*)lds + RING_OFF, (const attn_body::bf16*)PROJ, CUM, (attn_body::bf16*)OMIX, SSQ, skipth, xl * 4 + l / 6, l % 6); }
        }
    }
    xcd_barrier(bar); STAMP(3);
    {
        pg8::Gemm g{OMIX, WOUTT, DM, 0u}; pg8::StaticOrder S; S.init(M, DM, G, bx);
        LAS float* ratio = (LAS float*)(L + TAB_OFF); LAS float* rsb = (LAS float*)(L + TAB_OFF + 1024);
        pg8::EpiWout E{SSQ, RSTD1, a.x, X1_BF16 ? (float*)XN : a.out, X1B, ratio, rsb};
        pg8::gemm_phase<pg8::EpiWout, pg8::StaticOrder, false, false>(L + RING_OFF, g, S, E);
    }
    xcd_barrier(bar); STAMP(4);
    { for (int t64 = vcu; t64 < M / 64; t64 += G) router_wg(X1_BF16 ? (const float*)XN : a.out, WR, a.b_router, RSTD2, RW, LIST, SLOTEP, CNT, t64 * 64, L + RING_OFF); }
    xcd_barrier(bar); STAMP(5);
    LAS int* tb = (LAS int*)(L + TB_OFF); LAS int* tbE = tb + 64; LAS int* tbC = tb + 128; LAS int* cntl = tb + 192; LAS int* udl = tb + 224; LAS int* tabA = (LAS int*)(L + TAB_OFF); LAS int* tabB = (LAS int*)(L + TAB2_OFF);
    {
        const int nun = moe_prepare<8, true>(CNT, LIST, RSTD2, RW, a.b1, TBG, bx, L);
        pg8::Gemm g{X1B, W1T, MOE_F8 ? DM / 2 : DM, (unsigned)(NE * 2048 * 64)}; pg8::EpiMoe1 E{CTL + CW_DONE, H, tabA, (const LAS float*)tabB}; pg8::ListOrder SL{udl, nun, tabA};
        pg8::gemm_phase<pg8::EpiMoe1, pg8::ListOrder, true, true, MOE_F8, 2, W_BLK>(L + RING_OFF, g, SL, E);
    }
    if (!MERGE56) xcd_barrier(bar);
    STAMP(6);
    {
        const int nun = moe_prepare<4, false>(CNT, LIST, RSTD2, RW, a.b2, TBG, bx, L);
        pg8::Gemm g{H, W2T, MOE_F8 ? DM / 2 : DM, (unsigned)(NE * DM * 64)}; pg8::EpiMoe2 E{CTL + CW_DONE, CTL + CW_BAR, Y, (const LAS float*)tabA, (const LAS float*)tabB}; pg8::ListOrder SL{udl, nun, tabA};
        pg8::gemm_phase<pg8::EpiMoe2, pg8::ListOrder, true, false, MOE_F8, 2, W_BLK>(L + RING_OFF, g, SL, E);
    }
    xcd_barrier(bar); STAMP(7);
    { int t7 = tid; asm volatile("" : "+v"(t7)); int lane7 = t7 & 63;
      const int li = lane7 & 31, rsel = gw + (li >> 2) * NGW; const int ep = SLOTEP[rsel * 4 + (li & 3)]; const int yrv = TBG[ep >> 14] * 256 + (ep & 16383);
#pragma unroll 2
      for (int i = 0; i < 8; ++i) { const int y0 = __shfl(yrv, 4 * i), y1 = __shfl(yrv, 4 * i + 1), y2 = __shfl(yrv, 4 * i + 2), y3 = __shfl(yrv, 4 * i + 3);
        final_row<true>(X1_BF16 ? (const float*)XN : a.out, Y, SLOTEP, TBG, a.gf, a.out, gw + i * NGW, lane7, y0, y1, y2, y3); } }
    STAMP(8);
    if (PROBE_T >= 0) { const unsigned long long t0 = __builtin_amdgcn_s_memrealtime(), d = 9ull * (tsB - tsA); while (__builtin_amdgcn_s_memrealtime() - t0 < d) __builtin_amdgcn_s_sleep(8); }
#undef STAMP
}

extern "C" void kernel_launch(void* const* d_in, const int* in_sizes, int n_in, void* d_out, int out_size, void* d_ws, size_t ws_size, hipStream_t stream) {
    static int grid = 0;
    if (grid == 0) {
        if (n_in != 15 || in_sizes[0] != M * DM || out_size != M * DM || ws_size < WS_END) {
            fprintf(stderr, "kernel_launch: unexpected shapes / workspace (n_in %d, in0 %d, out %d, ws %zu, need %zu)\n", n_in, n_in > 0 ? in_sizes[0] : -1, out_size, ws_size, (size_t)WS_END); grid = -1; return; }
        int dev = 0, cus = 0, per_cu = 0;
        if (hipGetDevice(&dev) != hipSuccess || hipDeviceGetAttribute(&cus, hipDeviceAttributeMultiprocessorCount, dev) != hipSuccess) { grid = -1; return; }
        if (hipFuncSetAttribute((const void*)mega_fwd, hipFuncAttributeMaxDynamicSharedMemorySize, LDS_BYTES) != hipSuccess) { fprintf(stderr, "kernel_launch: hipFuncSetAttribute failed\n"); grid = -1; return; }
        if (hipOccupancyMaxActiveBlocksPerMultiprocessor(&per_cu, (const void*)mega_fwd, NTHREADS, LDS_BYTES) != hipSuccess || per_cu < 1) fprintf(stderr, "kernel_launch: occupancy query reports %d\n", per_cu);
        (void)hipGetLastError();
        grid = cus;
        if (cus != 256) { fprintf(stderr, "kernel_launch: built for 256 CUs (8 XCDs x 32), found %d; nothing launched\n", cus); grid = -1; return; }
    }
    if (grid < 0) return;
    if (hipMemsetAsync((char*)d_ws + WS_CTL, 0, CTL_BYTES, stream) != hipSuccess) return;
    Args a{};
    a.x = (const float*)d_in[0]; a.g1 = (const float*)d_in[1]; a.w_in = (const float*)d_in[2]; a.b_f = (const float*)d_in[3]; a.g_fox = (const float*)d_in[4]; a.g_sb = (const float*)d_in[5];
    a.w_out = (const float*)d_in[6]; a.g2 = (const float*)d_in[7]; a.w_router = (const float*)d_in[8]; a.b_router = (const float*)d_in[9]; a.w1 = (const float*)d_in[10]; a.b1 = (const float*)d_in[11];
    a.w2 = (const float*)d_in[12]; a.b2 = (const float*)d_in[13]; a.gf = (const float*)d_in[14];
    a.out = (float*)d_out; a.ws = (unsigned char*)d_ws;
    hipLaunchKernelGGL(mega_fwd, dim3(grid), dim3(NTHREADS), LDS_BYTES, stream, a);
    const hipError_t le = hipPeekAtLastError();
    if (le != hipSuccess) fprintf(stderr, "kernel_launch: launch failed: %s\n", hipGetErrorName(le));
}
```
